# Optimizing an MI355X kernel written in HIP

```python
import jax, jax.numpy as jnp
from jax import lax
import numpy as np

D_MODEL = 1024
BATCH = 2
SEQ = 8192
DEPTH = 2

GRID_W = 64
CTX_LEN = 256
HEAD_DIM = 64
FNET_GROUPS = 8
FNET_WIDTH = FNET_GROUPS * HEAD_DIM
NA_HEADS = 8
NA_WIDTH = NA_HEADS * HEAD_DIM
NA_KR_MAX = 8
NA_KC = 16
NA_QB = 16
NA_KB = 32
GQA_Q_HEADS = 16
GQA_KV_HEADS = 4
GQA_WINDOW = 128
GQA_BLOCK = 128
ROPE_THETA = 10000.0
PEER_HEADS = 8
PEER_NKEYS = 128
PEER_EXPERTS = PEER_NKEYS * PEER_NKEYS
PEER_QDIM = 256
PEER_TOPK = 16
PEER_TOKEN_CHUNK = 128
N_EVEN = (DEPTH + 1) // 2
N_ODD = DEPTH // 2
DN_ALPHA = (2 * DEPTH) ** 0.25
DN_BETA = (8 * DEPTH) ** -0.25
LN_EPS = 1e-6
NEG = -1e30

kernel_name = "hybrid_fnet_natten_swa_peer_dit"


def _layer_norm(x, gain=None, bias=None):
    xf = x.astype(jnp.float32)
    mu = jnp.mean(xf, -1, keepdims=True)
    var = jnp.mean(jnp.square(xf - mu), -1, keepdims=True)
    y = (xf - mu) * lax.rsqrt(var + LN_EPS)
    if gain is not None:
        y = y * gain.astype(jnp.float32) + bias.astype(jnp.float32)
    return y.astype(x.dtype)


def _modulate(x, shift, scale):
    return _layer_norm(x) * (1 + scale) + shift


def _heads(t, n_heads):
    b, l, _ = t.shape
    return t.reshape(b, l, n_heads, HEAD_DIM)


def _axial_rope_tables(n_tokens):
    t = jnp.arange(n_tokens)
    row = (t // GRID_W).astype(jnp.float32)
    col = (t % GRID_W).astype(jnp.float32)
    n_freq = HEAD_DIM // 4
    inv_freq = ROPE_THETA ** (-jnp.arange(n_freq, dtype=jnp.float32) / n_freq)
    ang = jnp.concatenate([row[:, None] * inv_freq, col[:, None] * inv_freq], -1)
    return jnp.cos(ang), jnp.sin(ang)


def _apply_rope(x, cos, sin):
    x1, x2 = jnp.split(x.astype(jnp.float32), 2, axis=-1)
    cs = cos[None, :, None, :]
    sn = sin[None, :, None, :]
    return jnp.concatenate([x1 * cs - x2 * sn, x1 * sn + x2 * cs], -1).astype(x.dtype)


def _fourier_mix(u):
    b, l, _ = u.shape
    ug = u.astype(jnp.float32).reshape(b, l, FNET_GROUPS, HEAD_DIM)
    y = jnp.fft.fft2(ug, axes=(1, 3), norm="ortho").real
    return y.reshape(b, l, FNET_WIDTH).astype(u.dtype)


def _ctx_attention(q, k, v, sink=None):
    b, l, hq, dh = q.shape
    hkv = k.shape[2]
    g = hq // hkv
    qg = q.reshape(b, l, hkv, g, dh)
    s = jnp.einsum('bqhgd,bkhd->bhgqk', qg, k, preferred_element_type=jnp.float32) * (dh ** -0.5)
    if sink is not None:
        sk = jnp.broadcast_to(sink.reshape(hkv, g)[None, :, :, None, None].astype(jnp.float32), s.shape[:-1] + (1,))
        p = jax.nn.softmax(jnp.concatenate([s, sk], -1), -1)[..., :l]
    else:
        p = jax.nn.softmax(s, -1)
    o = jnp.einsum('bhgqk,bkhd->bqhgd', p.astype(v.dtype), v)
    return o.reshape(b, l, hq * dh)


def _neighbourhood_attention(q, k, v, k_ctx, v_ctx, rpb):
    b, s, h, dh = q.shape
    rows = s // GRID_W
    kr = min(NA_KR_MAX, rows)
    n_cb = GRID_W // NA_QB
    r = jnp.arange(rows)
    r_start = jnp.clip(r - kr // 2, 0, rows - kr)
    row_idx = r_start[:, None] + jnp.arange(kr)[None]
    c_start = jnp.clip(jnp.arange(GRID_W) - NA_KC // 2, 0, GRID_W - NA_KC)
    blk_start = jnp.clip(jnp.arange(n_cb) * NA_QB - NA_KC // 2, 0, GRID_W - NA_KB)
    blk_col = blk_start[:, None] + jnp.arange(NA_KB)[None]
    q_col = jnp.arange(n_cb)[:, None] * NA_QB + jnp.arange(NA_QB)[None]
    qc_start = c_start[q_col]
    kc = blk_col[:, None, :]
    valid = (kc >= qc_start[:, :, None]) & (kc < qc_start[:, :, None] + NA_KC)
    dr_i = row_idx - r[:, None] + (NA_KR_MAX - 1)
    dc_i = jnp.clip(kc - q_col[:, :, None], -(NA_KC - 1), NA_KC - 1) + (NA_KC - 1)
    bias = rpb[:, dr_i[:, None, None, :, None], dc_i[None, :, :, None, :]].astype(jnp.float32)

    scale = dh ** -0.5
    qg = q.reshape(b, rows, n_cb, NA_QB, h, dh)
    kg = k.reshape(b, rows, GRID_W, h, dh)
    vg = v.reshape(b, rows, GRID_W, h, dh)
    gi_r = row_idx[:, :, None, None]
    gi_c = blk_col[None, None, :, :]
    k_blk = kg[:, gi_r, gi_c]
    v_blk = vg[:, gi_r, gi_c]
    s_loc = jnp.einsum('brjqhd,brkjchd->bhrjqkc', qg, k_blk, preferred_element_type=jnp.float32) * scale
    s_loc = jnp.where(valid[:, :, None, :], s_loc + bias[None], NEG)
    s_ctx = jnp.einsum('brjqhd,blhd->bhrjql', qg, k_ctx, preferred_element_type=jnp.float32) * scale
    n_loc = kr * NA_KB
    logits = jnp.concatenate([s_loc.reshape(s_loc.shape[:5] + (n_loc,)), s_ctx], -1)
    p = jax.nn.softmax(logits, -1).astype(v.dtype)
    p_loc = p[..., :n_loc].reshape(s_loc.shape)
    p_ctx = p[..., n_loc:]
    o = (jnp.einsum('bhrjqkc,brkjchd->brjqhd', p_loc, v_blk)
         + jnp.einsum('bhrjql,blhd->brjqhd', p_ctx, v_ctx))
    return o.reshape(b, s, h * dh)


def _window_gqa(q, k, v, k_ctx, v_ctx, sink):
    b, s, hq, dh = q.shape
    hkv = k.shape[2]
    g = hq // hkv
    nb = s // GQA_BLOCK
    qb = q.reshape(b, nb, GQA_BLOCK, hkv, g, dh)

    def band(t):
        tp = jnp.pad(t, ((0, 0), (GQA_BLOCK, GQA_BLOCK), (0, 0), (0, 0)))
        tb = tp.reshape(b, nb + 2, GQA_BLOCK, hkv, dh)
        return jnp.concatenate([tb[:, :-2], tb[:, 1:-1], tb[:, 2:]], axis=2)

    kb, vb = band(k), band(v)
    q_pos = jnp.arange(s).reshape(nb, GQA_BLOCK)
    k_pos = (jnp.arange(nb)[:, None] - 1) * GQA_BLOCK + jnp.arange(3 * GQA_BLOCK)[None]
    kp = k_pos[:, None, :]
    valid = (jnp.abs(q_pos[:, :, None] - kp) <= GQA_WINDOW) & (kp >= 0) & (kp < s)
    scale = dh ** -0.5
    s_loc = jnp.einsum('bnqhgd,bnkhd->bnhgqk', qb, kb, preferred_element_type=jnp.float32) * scale
    s_loc = jnp.where(valid[None, :, None, None], s_loc, NEG)
    s_ctx = jnp.einsum('bnqhgd,blhd->bnhgql', qb, k_ctx, preferred_element_type=jnp.float32) * scale
    sk = jnp.broadcast_to(sink.reshape(hkv, g)[None, None, :, :, None, None].astype(jnp.float32),
                          s_loc.shape[:-1] + (1,))
    n_loc = 3 * GQA_BLOCK
    n_ctx = k_ctx.shape[1]
    p = jax.nn.softmax(jnp.concatenate([s_loc, s_ctx, sk], -1), -1).astype(v.dtype)
    o = (jnp.einsum('bnhgqk,bnkhd->bnqhgd', p[..., :n_loc], vb)
         + jnp.einsum('bnhgql,blhd->bnqhgd', p[..., n_loc:n_loc + n_ctx], v_ctx))
    return o.reshape(b, s, hq * dh)


def _even_mixer(h_lat, h_ctx, w_in, w_out, rpb, ctx_out):
    split_at = [FNET_WIDTH, FNET_WIDTH + NA_WIDTH, FNET_WIDTH + 2 * NA_WIDTH]
    f_l, q_l, k_l, v_l = jnp.split(h_lat @ w_in, split_at, -1)
    if ctx_out:
        f_c, q_c, k_c, v_c = jnp.split(h_ctx @ w_in, split_at, -1)
    else:
        k_c, v_c = jnp.split(h_ctx @ w_in[:, FNET_WIDTH + NA_WIDTH:], [NA_WIDTH], -1)
    k_c, v_c = _heads(k_c, NA_HEADS), _heads(v_c, NA_HEADS)
    na_l = _neighbourhood_attention(_heads(q_l, NA_HEADS), _heads(k_l, NA_HEADS), _heads(v_l, NA_HEADS), k_c, v_c, rpb)
    y_lat = jnp.concatenate([_fourier_mix(f_l), na_l], -1) @ w_out
    y_ctx = None
    if ctx_out:
        na_c = _ctx_attention(_heads(q_c, NA_HEADS), k_c, v_c)
        y_ctx = jnp.concatenate([_fourier_mix(f_c), na_c], -1) @ w_out
    return y_lat, y_ctx


def _odd_mixer(h_lat, h_ctx, w_in, w_out, sink, cos, sin, ctx_out):
    qw = GQA_Q_HEADS * HEAD_DIM
    kvw = GQA_KV_HEADS * HEAD_DIM
    q_l, k_l, v_l = jnp.split(h_lat @ w_in, [qw, qw + kvw], -1)
    q_l = _apply_rope(_heads(q_l, GQA_Q_HEADS), cos, sin)
    k_l = _apply_rope(_heads(k_l, GQA_KV_HEADS), cos, sin)
    if ctx_out:
        q_c, k_c, v_c = jnp.split(h_ctx @ w_in, [qw, qw + kvw], -1)
    else:
        k_c, v_c = jnp.split(h_ctx @ w_in[:, qw:], [kvw], -1)
    k_c, v_c = _heads(k_c, GQA_KV_HEADS), _heads(v_c, GQA_KV_HEADS)
    y_lat = _window_gqa(q_l, k_l, _heads(v_l, GQA_KV_HEADS), k_c, v_c, sink) @ w_out
    y_ctx = None
    if ctx_out:
        y_ctx = _ctx_attention(_heads(q_c, GQA_Q_HEADS), k_c, v_c, sink) @ w_out
    return y_lat, y_ctx


def _peer(h, w_q, sub_keys, u_tab, v_tab):
    b, l, d = h.shape
    q = (h @ w_q).reshape(b, l, PEER_HEADS, 2, PEER_QDIM // 2)
    s_half = jnp.einsum('blhpd,hpnd->blhpn', q, sub_keys, preferred_element_type=jnp.float32)
    top_s, top_i = lax.top_k(s_half, PEER_TOPK)
    cand_s = (top_s[..., 0, :, None] + top_s[..., 1, None, :]).reshape(b, l, PEER_HEADS, PEER_TOPK * PEER_TOPK)
    cand_i = (top_i[..., 0, :, None] * PEER_NKEYS + top_i[..., 1, None, :]).reshape(b, l, PEER_HEADS, PEER_TOPK * PEER_TOPK)
    best_s, best_pos = lax.top_k(cand_s, PEER_TOPK)
    expert = jnp.take_along_axis(cand_i, best_pos, -1)
    gate = jax.nn.softmax(best_s, -1).astype(h.dtype)
    n_chunks = (b * l) // PEER_TOKEN_CHUNK
    hk = PEER_HEADS * PEER_TOPK
    hc = h.reshape(n_chunks, PEER_TOKEN_CHUNK, d)
    ec = expert.reshape(n_chunks, PEER_TOKEN_CHUNK, hk)
    gc = gate.reshape(n_chunks, PEER_TOKEN_CHUNK, hk)

    def chunk(args):
        hx, ex, gx = args
        a = jnp.einsum('tkd,td->tk', u_tab[ex], hx)
        w = gx * jax.nn.gelu(a, approximate=False)
        return jnp.einsum('tk,tkd->td', w, v_tab[ex])

    return lax.map(chunk, (hc, ec, gc)).reshape(b, l, d)


def setup_inputs(seed: int = 0) -> dict:
    key = jax.random.key(seed)
    ks = jax.random.split(key, 22)
    d = D_MODEL

    def nrm(k, shape, scale):
        return jax.random.normal(k, shape, jnp.float32) * scale

    even_in = FNET_WIDTH + 3 * NA_WIDTH
    even_mix = FNET_WIDTH + NA_WIDTH
    odd_in = (GQA_Q_HEADS + 2 * GQA_KV_HEADS) * HEAD_DIM
    odd_mix = GQA_Q_HEADS * HEAD_DIM
    return {
        "x": nrm(ks[0], (BATCH, SEQ, d), 1.0),
        "c": nrm(ks[1], (BATCH, d), 1.0),
        "ctx": nrm(ks[2], (BATCH, CTX_LEN, d), 1.0),
        "c_ctx": nrm(ks[3], (d,), 1.0),
        "ada_w": nrm(ks[4], (DEPTH, d, 6 * d), d ** -0.5),
        "ada_b": nrm(ks[5], (DEPTH, 6 * d), 0.01),
        "post_ln_g": 1.0 + nrm(ks[6], (DEPTH, 2, d), 0.02),
        "post_ln_b": nrm(ks[7], (DEPTH, 2, d), 0.02),
        "even_w_in": nrm(ks[8], (N_EVEN, d, even_in), d ** -0.5),
        "even_w_out": nrm(ks[9], (N_EVEN, even_mix, d), DN_BETA * even_mix ** -0.5),
        "na_rpb": nrm(ks[10], (N_EVEN, NA_HEADS, 2 * NA_KR_MAX - 1, 2 * NA_KC - 1), 0.1),
        "odd_w_in": nrm(ks[11], (N_ODD, d, odd_in), d ** -0.5),
        "odd_w_out": nrm(ks[12], (N_ODD, odd_mix, d), DN_BETA * odd_mix ** -0.5),
        "gqa_sink": nrm(ks[13], (N_ODD, GQA_Q_HEADS), 1.0),
        "peer_w_q": nrm(ks[14], (DEPTH, d, PEER_HEADS * PEER_QDIM), d ** -0.5),
        "peer_sub_keys": nrm(ks[15], (DEPTH, PEER_HEADS, 2, PEER_NKEYS, PEER_QDIM // 2), (PEER_QDIM // 2) ** -0.5),
        "peer_u": nrm(ks[16], (DEPTH, PEER_EXPERTS, d), d ** -0.5),
        "peer_v": nrm(ks[17], (DEPTH, PEER_EXPERTS, d), DN_BETA),
    }


def reference(x, c, ctx, c_ctx, ada_w, ada_b, post_ln_g, post_ln_b, even_w_in, even_w_out, na_rpb,
              odd_w_in, odd_w_out, gqa_sink, peer_w_q, peer_sub_keys, peer_u, peer_v):
    cos, sin = _axial_rope_tables(x.shape[1])
    silu_c = jax.nn.silu(c)
    silu_cc = jax.nn.silu(c_ctx)
    h_ctx = ctx
    for layer in range(DEPTH):
        ctx_out = layer < DEPTH - 1
        i = layer // 2
        m_l = jnp.split((silu_c @ ada_w[layer] + ada_b[layer])[:, None, :], 6, -1)
        m_c = jnp.split((silu_cc @ ada_w[layer] + ada_b[layer])[None, None, :], 6, -1)
        a_l = _modulate(x, m_l[0], m_l[1])
        a_c = _modulate(h_ctx, m_c[0], m_c[1])
        if layer % 2 == 0:
            y_l, y_c = _even_mixer(a_l, a_c, even_w_in[i], even_w_out[i], na_rpb[i], ctx_out)
        else:
            y_l, y_c = _odd_mixer(a_l, a_c, odd_w_in[i], odd_w_out[i], gqa_sink[i], cos, sin, ctx_out)
        x = _layer_norm(DN_ALPHA * x + m_l[2] * y_l, post_ln_g[layer, 0], post_ln_b[layer, 0])
        f_l = _peer(_modulate(x, m_l[3], m_l[4]), peer_w_q[layer], peer_sub_keys[layer], peer_u[layer], peer_v[layer])
        x = _layer_norm(DN_ALPHA * x + m_l[5] * f_l, post_ln_g[layer, 1], post_ln_b[layer, 1])
        if ctx_out:
            h_ctx = _layer_norm(DN_ALPHA * h_ctx + m_c[2] * y_c, post_ln_g[layer, 0], post_ln_b[layer, 0])
            f_c = _peer(_modulate(h_ctx, m_c[3], m_c[4]), peer_w_q[layer], peer_sub_keys[layer], peer_u[layer], peer_v[layer])
            h_ctx = _layer_norm(DN_ALPHA * h_ctx + m_c[5] * f_c, post_ln_g[layer, 1], post_ln_b[layer, 1])
    return x
```

```cpp
#include <hip/hip_runtime.h>
#include <hip/hip_bf16.h>
#include <stdint.h>
#include <math.h>

namespace {

constexpr int D = 1024;
constexpr int NB = 2;
constexpr int S = 8192;
constexpr int T = NB * S;
constexpr int CL = 256;
constexpr int TC = NB * CL;
constexpr int R = T + TC;
constexpr float DN_ALPHA = 1.4142135623730951f;
constexpr float LN_EPS = 1e-6f;

__device__ __forceinline__ float wave_sum(float v) {
#pragma unroll
  for (int off = 32; off; off >>= 1) v += __shfl_xor(v, off);
  return v;
}
__device__ __forceinline__ float wave_max(float v) {
#pragma unroll
  for (int off = 32; off; off >>= 1) v = fmaxf(v, __shfl_xor(v, off));
  return v;
}
__device__ __forceinline__ int mod_index(int row) { return row < T ? row / S : 2; }

__global__ void k_tables(float* tab) {
  int j = blockIdx.x * blockDim.x + threadIdx.x;
  if (j < 8192) {
    double a = 6.283185307179586476925286766559 * (double)j / 8192.0;
    tab[j] = (float)cos(a);
    tab[8192 + j] = (float)sin(a);
  }
}

__global__ void k_ada(const float* __restrict__ c, const float* __restrict__ c_ctx, const float* __restrict__ ada_w,
                      const float* __restrict__ ada_b, float* __restrict__ M) {
  int gid = blockIdx.x * blockDim.x + threadIdx.x;
  if (gid >= 2 * 3 * 6144) return;
  int col = gid % 6144; int idx = (gid / 6144) % 3; int layer = gid / (3 * 6144);
  const float* vec = idx < 2 ? c + idx * D : c_ctx;
  const float* w = ada_w + (size_t)layer * D * 6144 + col;
  float acc = 0.f;
  for (int k = 0; k < D; ++k) {
    float x = vec[k];
    float sx = x / (1.f + expf(-x));
    acc += sx * w[(size_t)k * 6144];
  }
  M[gid] = acc + ada_b[layer * 6144 + col];
}

__global__ __launch_bounds__(256) void k_modulate(const float* __restrict__ xa, const float* __restrict__ xb,
                                                  const float* __restrict__ M, int layer, int jshift, int jscale,
                                                  float* __restrict__ out) {
  int row = blockIdx.x;
  const float* x = row < T ? xa + (size_t)row * D : xb + (size_t)(row - T) * D;
  __shared__ float red[8];
  int tid = threadIdx.x;
  float v[4]; float s = 0.f;
#pragma unroll
  for (int i = 0; i < 4; ++i) { v[i] = x[tid + 256 * i]; s += v[i]; }
  s = wave_sum(s);
  if ((tid & 63) == 0) red[tid >> 6] = s;
  __syncthreads();
  float mu = (red[0] + red[1] + red[2] + red[3]) * (1.f / D);
  float q = 0.f;
#pragma unroll
  for (int i = 0; i < 4; ++i) { float d = v[i] - mu; q += d * d; }
  q = wave_sum(q);
  if ((tid & 63) == 0) red[4 + (tid >> 6)] = q;
  __syncthreads();
  float var = (red[4] + red[5] + red[6] + red[7]) * (1.f / D);
  float rs = rsqrtf(var + LN_EPS);
  const float* m = M + ((size_t)layer * 3 + mod_index(row)) * 6144;
#pragma unroll
  for (int i = 0; i < 4; ++i) {
    int col = tid + 256 * i;
    float y = (v[i] - mu) * rs;
    out[(size_t)row * D + col] = y * (1.f + m[jscale * D + col]) + m[jshift * D + col];
  }
}

__global__ __launch_bounds__(256) void k_post(const float* __restrict__ xa, const float* __restrict__ xb,
                                              const float* __restrict__ Y, const float* __restrict__ M, int layer, int j,
                                              const float* __restrict__ g, const float* __restrict__ bb,
                                              float* __restrict__ outa, float* __restrict__ outb) {
  int row = blockIdx.x;
  const float* x = row < T ? xa + (size_t)row * D : xb + (size_t)(row - T) * D;
  float* out = row < T ? outa + (size_t)row * D : outb + (size_t)(row - T) * D;
  __shared__ float red[8];
  int tid = threadIdx.x;
  const float* m = M + ((size_t)layer * 3 + mod_index(row)) * 6144 + j * D;
  float v[4]; float s = 0.f;
#pragma unroll
  for (int i = 0; i < 4; ++i) { int col = tid + 256 * i; v[i] = DN_ALPHA * x[col] + m[col] * Y[(size_t)row * D + col]; s += v[i]; }
  s = wave_sum(s);
  if ((tid & 63) == 0) red[tid >> 6] = s;
  __syncthreads();
  float mu = (red[0] + red[1] + red[2] + red[3]) * (1.f / D);
  float q = 0.f;
#pragma unroll
  for (int i = 0; i < 4; ++i) { float d = v[i] - mu; q += d * d; }
  q = wave_sum(q);
  if ((tid & 63) == 0) red[4 + (tid >> 6)] = q;
  __syncthreads();
  float var = (red[4] + red[5] + red[6] + red[7]) * (1.f / D);
  float rs = rsqrtf(var + LN_EPS);
#pragma unroll
  for (int i = 0; i < 4; ++i) {
    int col = tid + 256 * i;
    out[col] = (v[i] - mu) * rs * g[col] + bb[col];
  }
}

struct ARow { const float* A; int lda; int pad; __device__ float operator()(int m, int k) const { return A[(size_t)m * lda + k]; } };
struct BRow { const float* B; int ldb; int pad; __device__ float operator()(int k, int n) const { return B[(size_t)k * ldb + n]; } };
struct CRow { float* C; int ldc; float scale; __device__ void operator()(int m, int n, float v) const { C[(size_t)m * ldc + n] = v * scale; } };
struct ADft { const float* tab; int Sn; int stride; __device__ float operator()(int m, int k) const {
    int t = k % Sn; int idx = ((m * t) % Sn) * stride;
    return k < Sn ? tab[idx] : -tab[8192 + idx]; } };
struct BPQ { const float* PQ; int rowbase; int Sn; __device__ float operator()(int k, int n) const {
    int t = k % Sn; return PQ[(size_t)(rowbase + t) * 1024 + (k >= Sn ? 512 : 0) + n]; } };

template <class AF, class BF, class CF>
__global__ __launch_bounds__(256) void k_gemm(AF af, BF bf, CF cf, int K) {
  __shared__ float sA[16][68];
  __shared__ float sB[16][68];
  int tid = threadIdx.x; int tx = tid & 15, ty = tid >> 4;
  int m0 = blockIdx.y * 64, n0 = blockIdx.x * 64;
  float acc[4][4];
#pragma unroll
  for (int i = 0; i < 4; ++i)
#pragma unroll
    for (int j = 0; j < 4; ++j) acc[i][j] = 0.f;
  for (int k0 = 0; k0 < K; k0 += 16) {
#pragma unroll
    for (int i = 0; i < 4; ++i) { int e = tid + 256 * i; int m = e >> 4, k = e & 15; sA[k][m] = af(m0 + m, k0 + k); }
#pragma unroll
    for (int i = 0; i < 4; ++i) { int e = tid + 256 * i; int k = e >> 6, n = e & 63; sB[k][n] = bf(k0 + k, n0 + n); }
    __syncthreads();
#pragma unroll
    for (int k = 0; k < 16; ++k) {
      float a[4], b[4];
#pragma unroll
      for (int i = 0; i < 4; ++i) { a[i] = sA[k][ty * 4 + i]; b[i] = sB[k][tx * 4 + i]; }
#pragma unroll
      for (int i = 0; i < 4; ++i)
#pragma unroll
        for (int j = 0; j < 4; ++j) acc[i][j] += a[i] * b[j];
    }
    __syncthreads();
  }
#pragma unroll
  for (int i = 0; i < 4; ++i)
#pragma unroll
    for (int j = 0; j < 4; ++j) cf(m0 + ty * 4 + i, n0 + tx * 4 + j, acc[i][j]);
}

__global__ __launch_bounds__(256) void k_chan_dft(const float* __restrict__ F, const float* __restrict__ tab, float* __restrict__ PQ) {
  int gid = blockIdx.x * 256 + threadIdx.x;
  int row = gid >> 9; int col = gid & 511; int g = col >> 6, cp = col & 63;
  const float* f = F + (size_t)row * 2048 + g * 64;
  float p = 0.f, q = 0.f;
  for (int ch = 0; ch < 64; ++ch) {
    int idx = ((ch * cp) & 63) * 128;
    float x = f[ch];
    p += x * tab[idx]; q += x * tab[8192 + idx];
  }
  PQ[(size_t)row * 1024 + col] = p;
  PQ[(size_t)row * 1024 + 512 + col] = q;
}

__global__ __launch_bounds__(64) void k_na(const float* __restrict__ F, const float* __restrict__ rpb, float* __restrict__ MIX) {
  int item = blockIdx.x; int h = item & 7; int row = item >> 3; int lane = threadIdx.x;
  __shared__ float sq[64]; __shared__ float sp[384]; __shared__ int stok[384];
  bool is_ctx = row >= T;
  int b = is_ctx ? (row - T) / CL : row / S;
  sq[lane] = F[(size_t)row * 2048 + 512 + h * 64 + lane];
  __syncthreads();
  int r = 0, c = 0, r_start = 0, c_start = 0;
  if (!is_ctx) { int t = row % S; r = t / 64; c = t % 64; r_start = min(max(r - 4, 0), 120); c_start = min(max(c - 8, 0), 48); }
  int nk = is_ctx ? 256 : 384;
  float lg[6]; float mx = -INFINITY;
#pragma unroll
  for (int kk = 0; kk < 6; ++kk) {
    int j = kk * 64 + lane; float s = -INFINITY; int tok = 0;
    if (j < nk) {
      float bias = 0.f;
      if (!is_ctx && j < 128) {
        int kr = j >> 4, kc = j & 15; int rr = r_start + kr, cc = c_start + kc;
        tok = b * S + rr * 64 + cc;
        int dc = min(max(cc - c, -15), 15) + 15;
        bias = rpb[(h * 15 + (rr - r + 7)) * 31 + dc];
      } else {
        int l = is_ctx ? j : j - 128; tok = T + b * CL + l;
      }
      const float* kp = F + (size_t)tok * 2048 + 1024 + h * 64;
      float acc = 0.f;
      for (int d = 0; d < 64; ++d) acc += sq[d] * kp[d];
      s = acc * 0.125f + bias;
    }
    lg[kk] = s; stok[j] = tok; mx = fmaxf(mx, s);
  }
  mx = wave_max(mx);
  float sum = 0.f;
#pragma unroll
  for (int kk = 0; kk < 6; ++kk) { float e = (kk * 64 + lane < nk) ? expf(lg[kk] - mx) : 0.f; lg[kk] = e; sum += e; }
  sum = wave_sum(sum);
  float inv = 1.f / sum;
#pragma unroll
  for (int kk = 0; kk < 6; ++kk) sp[kk * 64 + lane] = lg[kk] * inv;
  __syncthreads();
  float o = 0.f;
  for (int j = 0; j < nk; ++j) o += sp[j] * F[(size_t)stok[j] * 2048 + 1536 + h * 64 + lane];
  MIX[(size_t)row * 1024 + 512 + h * 64 + lane] = o;
}

__global__ __launch_bounds__(256) void k_rope(float* __restrict__ F1) {
  int gid = blockIdx.x * 256 + threadIdx.x;
  int i = gid & 31; int hh = (gid >> 5) % 20; int row = gid / (32 * 20);
  if (row >= T) return;
  int t = row % S; float rowp = (float)(t / 64), colp = (float)(t % 64);
  int fi = i & 15;
  float inv_freq = powf(10000.0f, -(float)fi / 16.0f);
  float ang = (i < 16 ? rowp : colp) * inv_freq;
  float cs = cosf(ang), sn = sinf(ang);
  float* p = F1 + (size_t)row * 1536 + hh * 64;
  float x1 = p[i], x2 = p[i + 32];
  p[i] = x1 * cs - x2 * sn;
  p[i + 32] = x1 * sn + x2 * cs;
}

__global__ __launch_bounds__(64) void k_gqa(const float* __restrict__ F1, const float* __restrict__ sink, float* __restrict__ O) {
  int item = blockIdx.x; int qh = item & 15; int row = item >> 4; int lane = threadIdx.x;
  int kvh = qh >> 2;
  __shared__ float sq[64]; __shared__ float sp[576]; __shared__ int stok[576];
  int b = row / S; int t = row % S;
  sq[lane] = F1[(size_t)row * 1536 + qh * 64 + lane];
  __syncthreads();
  float lg[9]; float mx = -INFINITY;
#pragma unroll
  for (int kk = 0; kk < 9; ++kk) {
    int j = kk * 64 + lane; float s = -INFINITY; int tok = 0; bool valid = false;
    if (j < 257) { int pos = t - 128 + j; valid = (pos >= 0 && pos < S); tok = b * S + pos; }
    else if (j < 513) { valid = true; tok = T + b * CL + (j - 257); }
    if (valid) {
      const float* kp = F1 + (size_t)tok * 1536 + 1024 + kvh * 64;
      float acc = 0.f;
      for (int d = 0; d < 64; ++d) acc += sq[d] * kp[d];
      s = acc * 0.125f;
    } else tok = 0;
    lg[kk] = s; stok[j] = tok; mx = fmaxf(mx, s);
  }
  mx = wave_max(mx);
  float sk = sink[qh];
  mx = fmaxf(mx, sk);
  float sum = 0.f;
#pragma unroll
  for (int kk = 0; kk < 9; ++kk) { float e = (lg[kk] == -INFINITY) ? 0.f : expf(lg[kk] - mx); lg[kk] = e; sum += e; }
  sum = wave_sum(sum) + expf(sk - mx);
  float inv = 1.f / sum;
#pragma unroll
  for (int kk = 0; kk < 9; ++kk) sp[kk * 64 + lane] = lg[kk] * inv;
  __syncthreads();
  float o = 0.f;
  for (int j = 0; j < 513; ++j) { float p = sp[j]; if (p != 0.f) o += p * F1[(size_t)stok[j] * 1536 + 1280 + kvh * 64 + lane]; }
  O[(size_t)row * 1024 + qh * 64 + lane] = o;
}

__device__ __forceinline__ void wave_argmax(float& v, int& idx) {
#pragma unroll
  for (int off = 32; off; off >>= 1) {
    float ov = __shfl_xor(v, off); int oi = __shfl_xor(idx, off);
    if (ov > v || (ov == v && oi < idx)) { v = ov; idx = oi; }
  }
}
__global__ __launch_bounds__(64) void k_peer(const float* __restrict__ H, const float* __restrict__ Q, const float* __restrict__ sk,
                                             const float* __restrict__ U, const float* __restrict__ V, float* __restrict__ Fp, int nrows) {
  int row = blockIdx.x; if (row >= nrows) return;
  int lane = threadIdx.x;
  __shared__ float sq[256]; __shared__ float tops[2][16]; __shared__ int topi[2][16];
  __shared__ int se[128]; __shared__ float sg[128];
  float hreg[16];
#pragma unroll
  for (int i = 0; i < 16; ++i) hreg[i] = H[(size_t)row * D + lane + 64 * i];
  for (int h = 0; h < 8; ++h) {
    __syncthreads();
#pragma unroll
    for (int i = 0; i < 4; ++i) sq[lane + 64 * i] = Q[(size_t)row * 2048 + h * 256 + lane + 64 * i];
    __syncthreads();
    for (int p = 0; p < 2; ++p) {
      float s0 = 0.f, s1 = 0.f;
      const float* k0 = sk + ((size_t)((h * 2 + p) * 128 + lane)) * 128;
      const float* k1 = k0 + 64 * 128;
      for (int d = 0; d < 128; ++d) { float qv = sq[p * 128 + d]; s0 += qv * k0[d]; s1 += qv * k1[d]; }
      for (int i = 0; i < 16; ++i) {
        float v; int idx;
        if (s0 >= s1) { v = s0; idx = lane; } else { v = s1; idx = lane + 64; }
        wave_argmax(v, idx);
        if (lane == 0) { tops[p][i] = v; topi[p][i] = idx; }
        if (idx == lane) s0 = -INFINITY;
        if (idx == lane + 64) s1 = -INFINITY;
      }
    }
    __syncthreads();
    float cs[4];
#pragma unroll
    for (int i = 0; i < 4; ++i) { int ci = lane * 4 + i; cs[i] = tops[0][ci >> 4] + tops[1][ci & 15]; }
    float bs[16]; int be[16];
#pragma unroll
    for (int k = 0; k < 16; ++k) {
      float v = cs[0]; int idx = lane * 4;
#pragma unroll
      for (int i = 1; i < 4; ++i) if (cs[i] > v) { v = cs[i]; idx = lane * 4 + i; }
      wave_argmax(v, idx);
      bs[k] = v; be[k] = topi[0][idx >> 4] * 128 + topi[1][idx & 15];
#pragma unroll
      for (int i = 0; i < 4; ++i) if (idx == lane * 4 + i) cs[i] = -INFINITY;
    }
    float mxs = bs[0]; float sum = 0.f;
#pragma unroll
    for (int k = 0; k < 16; ++k) { bs[k] = expf(bs[k] - mxs); sum += bs[k]; }
    float inv = 1.f / sum;
    if (lane == 0) {
#pragma unroll
      for (int k = 0; k < 16; ++k) { se[h * 16 + k] = be[k]; sg[h * 16 + k] = bs[k] * inv; }
    }
  }
  __syncthreads();
  float acc[16];
#pragma unroll
  for (int i = 0; i < 16; ++i) acc[i] = 0.f;
  for (int k = 0; k < 128; ++k) {
    int e = se[k]; float g = sg[k];
    const float* u = U + (size_t)e * D; const float* v = V + (size_t)e * D;
    float a = 0.f;
#pragma unroll
    for (int i = 0; i < 16; ++i) a += u[lane + 64 * i] * hreg[i];
    a = wave_sum(a);
    float w = g * 0.5f * a * (1.f + erff(a * 0.70710678118654752f));
#pragma unroll
    for (int i = 0; i < 16; ++i) acc[i] += w * v[lane + 64 * i];
  }
#pragma unroll
  for (int i = 0; i < 16; ++i) Fp[(size_t)row * D + lane + 64 * i] = acc[i];
}

template <class AF, class BF, class CF>
void gemm(AF a, BF b, CF c, int M, int N, int K, hipStream_t st) {
  hipLaunchKernelGGL((k_gemm<AF, BF, CF>), dim3(N / 64, M / 64), dim3(256), 0, st, a, b, c, K);
}

}

extern "C" void kernel_launch(void* const* d_in, const int* in_sizes, int n_in, void* d_out, int out_size, void* d_ws,
                              size_t ws_size, hipStream_t stream) {
  const float* x = (const float*)d_in[0];
  const float* c = (const float*)d_in[1];
  const float* ctx = (const float*)d_in[2];
  const float* c_ctx = (const float*)d_in[3];
  const float* ada_w = (const float*)d_in[4];
  const float* ada_b = (const float*)d_in[5];
  const float* ln_g = (const float*)d_in[6];
  const float* ln_b = (const float*)d_in[7];
  const float* even_w_in = (const float*)d_in[8];
  const float* even_w_out = (const float*)d_in[9];
  const float* rpb = (const float*)d_in[10];
  const float* odd_w_in = (const float*)d_in[11];
  const float* odd_w_out = (const float*)d_in[12];
  const float* sink = (const float*)d_in[13];
  const float* peer_wq = (const float*)d_in[14];
  const float* peer_sk = (const float*)d_in[15];
  const float* peer_u = (const float*)d_in[16];
  const float* peer_v = (const float*)d_in[17];
  float* out = (float*)d_out;

  float* ws = (float*)d_ws;
  size_t off = 0;
  auto carve = [&](size_t n) { float* p = ws + off; off += (n + 63) & ~(size_t)63; return p; };
  float* TAB = carve(16384);
  float* Mm = carve(2 * 3 * 6144);
  float* BA = carve((size_t)R * 1024);
  float* BF_ = carve((size_t)R * 2048);
  float* BY = carve((size_t)R * 1024);
  float* X1 = carve((size_t)R * 1024);
  float* X2 = carve((size_t)R * 1024);

  hipLaunchKernelGGL(k_tables, dim3(32), dim3(256), 0, stream, TAB);
  hipLaunchKernelGGL(k_ada, dim3((2 * 3 * 6144 + 255) / 256), dim3(256), 0, stream, c, c_ctx, ada_w, ada_b, Mm);

  hipLaunchKernelGGL(k_modulate, dim3(R), dim3(256), 0, stream, x, ctx, Mm, 0, 0, 1, BA);
  gemm(ARow{BA, 1024, 0}, BRow{even_w_in, 2048, 0}, CRow{BF_, 2048, 1.f}, R, 2048, 1024, stream);
  hipLaunchKernelGGL(k_chan_dft, dim3(R * 512 / 256), dim3(256), 0, stream, BF_, TAB, BY);
  for (int b = 0; b < NB; ++b) {
    gemm(ADft{TAB, S, 1}, BPQ{BY, b * S, S}, CRow{BA + (size_t)b * S * 1024, 1024, 1.f / sqrtf((float)S * 64.f)}, S, 512, 2 * S, stream);
    gemm(ADft{TAB, CL, 8192 / CL}, BPQ{BY, T + b * CL, CL}, CRow{BA + (size_t)(T + b * CL) * 1024, 1024, 1.f / sqrtf((float)CL * 64.f)}, CL, 512, 2 * CL, stream);
  }
  hipLaunchKernelGGL(k_na, dim3(R * 8), dim3(64), 0, stream, BF_, rpb, BA);
  gemm(ARow{BA, 1024, 0}, BRow{even_w_out, 1024, 0}, CRow{BY, 1024, 1.f}, R, 1024, 1024, stream);
  hipLaunchKernelGGL(k_post, dim3(R), dim3(256), 0, stream, x, ctx, BY, Mm, 0, 2, ln_g + 0, ln_b + 0, X1, X1 + (size_t)T * D);
  hipLaunchKernelGGL(k_modulate, dim3(R), dim3(256), 0, stream, X1, X1 + (size_t)T * D, Mm, 0, 3, 4, BA);
  gemm(ARow{BA, 1024, 0}, BRow{peer_wq, 2048, 0}, CRow{BF_, 2048, 1.f}, R, 2048, 1024, stream);
  hipLaunchKernelGGL(k_peer, dim3(R), dim3(64), 0, stream, BA, BF_, peer_sk, peer_u, peer_v, BY, R);
  hipLaunchKernelGGL(k_post, dim3(R), dim3(256), 0, stream, X1, X1 + (size_t)T * D, BY, Mm, 0, 5, ln_g + 1024, ln_b + 1024, X2, X2 + (size_t)T * D);

  hipLaunchKernelGGL(k_modulate, dim3(R), dim3(256), 0, stream, X2, X2 + (size_t)T * D, Mm, 1, 0, 1, BA);
  gemm(ARow{BA, 1024, 0}, BRow{odd_w_in, 1536, 0}, CRow{BF_, 1536, 1.f}, R, 1536, 1024, stream);
  hipLaunchKernelGGL(k_rope, dim3(T * 20 * 32 / 256), dim3(256), 0, stream, BF_);
  hipLaunchKernelGGL(k_gqa, dim3(T * 16), dim3(64), 0, stream, BF_, sink, BA);
  gemm(ARow{BA, 1024, 0}, BRow{odd_w_out, 1024, 0}, CRow{BY, 1024, 1.f}, T, 1024, 1024, stream);
  hipLaunchKernelGGL(k_post, dim3(T), dim3(256), 0, stream, X2, X2, BY, Mm, 1, 2, ln_g + 2048, ln_b + 2048, X1, X1);
  hipLaunchKernelGGL(k_modulate, dim3(T), dim3(256), 0, stream, X1, X1, Mm, 1, 3, 4, BA);
  gemm(ARow{BA, 1024, 0}, BRow{peer_wq + (size_t)1024 * 2048, 2048, 0}, CRow{BF_, 2048, 1.f}, T, 2048, 1024, stream);
  hipLaunchKernelGGL(k_peer, dim3(T), dim3(64), 0, stream, BA, BF_, peer_sk + (size_t)8 * 2 * 128 * 128, peer_u + (size_t)16384 * 1024,
                     peer_v + (size_t)16384 * 1024, BY, T);
  hipLaunchKernelGGL(k_post, dim3(T), dim3(256), 0, stream, X1, X1, BY, Mm, 1, 5, ln_g + 3072, ln_b + 3072, out, out);
}
```

```cpp
#include <hip/hip_runtime.h>
#include <hip/hip_bf16.h>
#include <stdint.h>
#include <math.h>
#include <stdio.h>
#include <hip/hip_cooperative_groups.h>
namespace cg = cooperative_groups;

namespace {

constexpr int D = 1024;
constexpr int NB = 2;
constexpr int S = 8192;
constexpr int T = NB * S;
constexpr int CL = 256;
constexpr int TC = NB * CL;
constexpr int R = T + TC;
constexpr float DN_ALPHA = 1.4142135623730951f;
constexpr float LN_EPS = 1e-6f;

__device__ __forceinline__ float wave_sum(float v) {
#pragma unroll
  for (int off = 32; off; off >>= 1) v += __shfl_xor(v, off);
  return v;
}
__device__ __forceinline__ float wave_max(float v) {
#pragma unroll
  for (int off = 32; off; off >>= 1) v = fmaxf(v, __shfl_xor(v, off));
  return v;
}
__device__ __forceinline__ int mod_index(int row) { return row < T ? row / S : 2; }


struct Params {
  const float* in[18];
  float* out;
  float* ws;
};

constexpr size_t al64(size_t n) { return (n + 63) & ~(size_t)63; }
constexpr size_t OFF_TAB = 0;
constexpr size_t OFF_M = OFF_TAB + al64(16384);
constexpr size_t OFF_BA = OFF_M + al64(2 * 3 * 6144);
constexpr size_t OFF_BF = OFF_BA + al64((size_t)R * 1024);
constexpr size_t OFF_BY = OFF_BF + al64((size_t)R * 2048);
constexpr size_t OFF_X1 = OFF_BY + al64((size_t)R * 1024);
constexpr size_t OFF_X2 = OFF_X1 + al64((size_t)R * 1024);
constexpr size_t OFF_END = OFF_X2 + al64((size_t)R * 1024);

#define GRID_LOOP(var, n) for (int var = blockIdx.x; var < (n); var += gridDim.x)

__device__ void ph_tables(float* tab) {
  for (int j = blockIdx.x * 256 + threadIdx.x; j < 8192; j += gridDim.x * 256) {
    double a = 6.283185307179586476925286766559 * (double)j / 8192.0;
    tab[j] = (float)cos(a);
    tab[8192 + j] = (float)sin(a);
  }
}
__device__ void ph_ada(const float* __restrict__ c, const float* __restrict__ c_ctx, const float* __restrict__ ada_w,
                       const float* __restrict__ ada_b, float* __restrict__ M) {
  for (int gid = blockIdx.x * 256 + threadIdx.x; gid < 2 * 3 * 6144; gid += gridDim.x * 256) {
    int col = gid % 6144; int idx = (gid / 6144) % 3; int layer = gid / (3 * 6144);
    const float* vec = idx < 2 ? c + idx * D : c_ctx;
    const float* w = ada_w + (size_t)layer * D * 6144 + col;
    float acc = 0.f;
    for (int k = 0; k < D; ++k) {
      float x = vec[k];
      float sx = x / (1.f + expf(-x));
      acc += sx * w[(size_t)k * 6144];
    }
    M[gid] = acc + ada_b[layer * 6144 + col];
  }
}

__device__ void ph_modulate(const float* __restrict__ xa, const float* __restrict__ xb, const float* __restrict__ M, int layer,
                            int jshift, int jscale, float* __restrict__ out, int nrows, float* red) {
  int tid = threadIdx.x;
  GRID_LOOP(row, nrows) {
    const float* x = row < T ? xa + (size_t)row * D : xb + (size_t)(row - T) * D;
    float v[4]; float s = 0.f;
#pragma unroll
    for (int i = 0; i < 4; ++i) { v[i] = x[tid + 256 * i]; s += v[i]; }
    s = wave_sum(s);
    __syncthreads();
    if ((tid & 63) == 0) red[tid >> 6] = s;
    __syncthreads();
    float mu = (red[0] + red[1] + red[2] + red[3]) * (1.f / D);
    float q = 0.f;
#pragma unroll
    for (int i = 0; i < 4; ++i) { float d = v[i] - mu; q += d * d; }
    q = wave_sum(q);
    if ((tid & 63) == 0) red[4 + (tid >> 6)] = q;
    __syncthreads();
    float var = (red[4] + red[5] + red[6] + red[7]) * (1.f / D);
    float rs = rsqrtf(var + LN_EPS);
    const float* m = M + ((size_t)layer * 3 + mod_index(row)) * 6144;
#pragma unroll
    for (int i = 0; i < 4; ++i) {
      int col = tid + 256 * i;
      float y = (v[i] - mu) * rs;
      out[(size_t)row * D + col] = y * (1.f + m[jscale * D + col]) + m[jshift * D + col];
    }
  }
}

__device__ void ph_post(const float* __restrict__ xa, const float* __restrict__ xb, const float* __restrict__ Y,
                        const float* __restrict__ M, int layer, int j, const float* __restrict__ g, const float* __restrict__ bb,
                        float* __restrict__ outa, float* __restrict__ outb, int nrows, float* red) {
  int tid = threadIdx.x;
  GRID_LOOP(row, nrows) {
    const float* x = row < T ? xa + (size_t)row * D : xb + (size_t)(row - T) * D;
    float* out = row < T ? outa + (size_t)row * D : outb + (size_t)(row - T) * D;
    const float* m = M + ((size_t)layer * 3 + mod_index(row)) * 6144 + j * D;
    float v[4]; float s = 0.f;
#pragma unroll
    for (int i = 0; i < 4; ++i) { int col = tid + 256 * i; v[i] = DN_ALPHA * x[col] + m[col] * Y[(size_t)row * D + col]; s += v[i]; }
    s = wave_sum(s);
    __syncthreads();
    if ((tid & 63) == 0) red[tid >> 6] = s;
    __syncthreads();
    float mu = (red[0] + red[1] + red[2] + red[3]) * (1.f / D);
    float q = 0.f;
#pragma unroll
    for (int i = 0; i < 4; ++i) { float d = v[i] - mu; q += d * d; }
    q = wave_sum(q);
    if ((tid & 63) == 0) red[4 + (tid >> 6)] = q;
    __syncthreads();
    float var = (red[4] + red[5] + red[6] + red[7]) * (1.f / D);
    float rs = rsqrtf(var + LN_EPS);
#pragma unroll
    for (int i = 0; i < 4; ++i) {
      int col = tid + 256 * i;
      out[col] = (v[i] - mu) * rs * g[col] + bb[col];
    }
  }
}

struct ARow { const float* A; int lda; __device__ float operator()(int m, int k) const { return A[(size_t)m * lda + k]; } };
struct BRow { const float* B; int ldb; __device__ float operator()(int k, int n) const { return B[(size_t)k * ldb + n]; } };
struct CRow { float* C; int ldc; float scale; __device__ void operator()(int m, int n, float v) const { C[(size_t)m * ldc + n] = v * scale; } };
struct ADft { const float* tab; int Sn; int stride; __device__ float operator()(int m, int k) const {
    int t = k % Sn; int idx = ((m * t) % Sn) * stride;
    return k < Sn ? tab[idx] : -tab[8192 + idx]; } };
struct BPQ { const float* PQ; int rowbase; int Sn; __device__ float operator()(int k, int n) const {
    int t = k % Sn; return PQ[(size_t)(rowbase + t) * 1024 + (k >= Sn ? 512 : 0) + n]; } };

template <class AF, class BF, class CF>
__device__ void ph_gemm(AF af, BF bf, CF cf, int M, int N, int K, float* sm) {
  float (*sA)[68] = (float (*)[68])sm;
  float (*sB)[68] = (float (*)[68])(sm + 16 * 68);
  int tid = threadIdx.x; int tx = tid & 15, ty = tid >> 4;
  int ntn = N / 64; int ntiles = (M / 64) * ntn;
  GRID_LOOP(tile, ntiles) {
    int m0 = (tile / ntn) * 64, n0 = (tile % ntn) * 64;
    float acc[4][4];
#pragma unroll
    for (int i = 0; i < 4; ++i)
#pragma unroll
      for (int j = 0; j < 4; ++j) acc[i][j] = 0.f;
    for (int k0 = 0; k0 < K; k0 += 16) {
      __syncthreads();
#pragma unroll
      for (int i = 0; i < 4; ++i) { int e = tid + 256 * i; int m = e >> 4, k = e & 15; sA[k][m] = af(m0 + m, k0 + k); }
#pragma unroll
      for (int i = 0; i < 4; ++i) { int e = tid + 256 * i; int k = e >> 6, n = e & 63; sB[k][n] = bf(k0 + k, n0 + n); }
      __syncthreads();
#pragma unroll
      for (int k = 0; k < 16; ++k) {
        float a[4], b[4];
#pragma unroll
        for (int i = 0; i < 4; ++i) { a[i] = sA[k][ty * 4 + i]; b[i] = sB[k][tx * 4 + i]; }
#pragma unroll
        for (int i = 0; i < 4; ++i)
#pragma unroll
          for (int j = 0; j < 4; ++j) acc[i][j] += a[i] * b[j];
      }
    }
#pragma unroll
    for (int i = 0; i < 4; ++i)
#pragma unroll
      for (int j = 0; j < 4; ++j) cf(m0 + ty * 4 + i, n0 + tx * 4 + j, acc[i][j]);
  }
}

__device__ void ph_chan_dft(const float* __restrict__ F, const float* __restrict__ tab, float* __restrict__ PQ) {
  for (int gid = blockIdx.x * 256 + threadIdx.x; gid < R * 512; gid += gridDim.x * 256) {
    int row = gid >> 9; int col = gid & 511; int g = col >> 6, cp = col & 63;
    const float* f = F + (size_t)row * 2048 + g * 64;
    float p = 0.f, q = 0.f;
    for (int ch = 0; ch < 64; ++ch) {
      int idx = ((ch * cp) & 63) * 128;
      float x = f[ch];
      p += x * tab[idx]; q += x * tab[8192 + idx];
    }
    PQ[(size_t)row * 1024 + col] = p;
    PQ[(size_t)row * 1024 + 512 + col] = q;
  }
}

__device__ void ph_na(const float* __restrict__ F, const float* __restrict__ rpb, float* __restrict__ MIX, float* sm) {
  int lane = threadIdx.x & 63, wave = threadIdx.x >> 6;
  float* sq = sm + wave * 1024; float* sp = sq + 64; int* stok = (int*)(sp + 384);
  int nitems = R * 8;
  for (int item0 = blockIdx.x * 4; item0 < nitems; item0 += gridDim.x * 4) {
    int item = item0 + wave;
    int h = item & 7; int row = item >> 3;
    bool is_ctx = row >= T;
    int b = is_ctx ? (row - T) / CL : row / S;
    __syncthreads();
    sq[lane] = F[(size_t)row * 2048 + 512 + h * 64 + lane];
    __syncthreads();
    int r = 0, c = 0, r_start = 0, c_start = 0;
    if (!is_ctx) { int t = row % S; r = t / 64; c = t % 64; r_start = min(max(r - 4, 0), 120); c_start = min(max(c - 8, 0), 48); }
    int nk = is_ctx ? 256 : 384;
    float lg[6]; float mx = -INFINITY;
#pragma unroll
    for (int kk = 0; kk < 6; ++kk) {
      int j = kk * 64 + lane; float s = -INFINITY; int tok = 0;
      if (j < nk) {
        float bias = 0.f;
        if (!is_ctx && j < 128) {
          int kr = j >> 4, kc = j & 15; int rr = r_start + kr, cc = c_start + kc;
          tok = b * S + rr * 64 + cc;
          int dc = min(max(cc - c, -15), 15) + 15;
          bias = rpb[(h * 15 + (rr - r + 7)) * 31 + dc];
        } else {
          int l = is_ctx ? j : j - 128; tok = T + b * CL + l;
        }
        const float* kp = F + (size_t)tok * 2048 + 1024 + h * 64;
        float acc = 0.f;
#pragma unroll 8
        for (int d = 0; d < 64; ++d) acc += sq[d] * kp[d];
        s = acc * 0.125f + bias;
      }
      lg[kk] = s; stok[j] = tok; mx = fmaxf(mx, s);
    }
    mx = wave_max(mx);
    float sum = 0.f;
#pragma unroll
    for (int kk = 0; kk < 6; ++kk) { float e = (kk * 64 + lane < nk) ? expf(lg[kk] - mx) : 0.f; lg[kk] = e; sum += e; }
    sum = wave_sum(sum);
    float inv = 1.f / sum;
#pragma unroll
    for (int kk = 0; kk < 6; ++kk) sp[kk * 64 + lane] = lg[kk] * inv;
    __syncthreads();
    float o = 0.f;
    for (int j = 0; j < nk; ++j) o += sp[j] * F[(size_t)stok[j] * 2048 + 1536 + h * 64 + lane];
    MIX[(size_t)row * 1024 + 512 + h * 64 + lane] = o;
  }
}

__device__ void ph_rope(float* __restrict__ F1) {
  for (int gid = blockIdx.x * 256 + threadIdx.x; gid < T * 20 * 32; gid += gridDim.x * 256) {
    int i = gid & 31; int hh = (gid >> 5) % 20; int row = gid / (32 * 20);
    int t = row % S; float rowp = (float)(t / 64), colp = (float)(t % 64);
    int fi = i & 15;
    float inv_freq = powf(10000.0f, -(float)fi / 16.0f);
    float ang = (i < 16 ? rowp : colp) * inv_freq;
    float cs = cosf(ang), sn = sinf(ang);
    float* p = F1 + (size_t)row * 1536 + hh * 64;
    float x1 = p[i], x2 = p[i + 32];
    p[i] = x1 * cs - x2 * sn;
    p[i + 32] = x1 * sn + x2 * cs;
  }
}

__device__ void ph_gqa(const float* __restrict__ F1, const float* __restrict__ sink, float* __restrict__ O, float* sm) {
  int lane = threadIdx.x & 63, wave = threadIdx.x >> 6;
  float* sq = sm + wave * 1280; float* sp = sq + 64; int* stok = (int*)(sp + 576);
  int nitems = T * 16;
  for (int item0 = blockIdx.x * 4; item0 < nitems; item0 += gridDim.x * 4) {
    int item = item0 + wave;
    int qh = item & 15; int row = item >> 4; int kvh = qh >> 2;
    int b = row / S; int t = row % S;
    __syncthreads();
    sq[lane] = F1[(size_t)row * 1536 + qh * 64 + lane];
    __syncthreads();
    float lg[9]; float mx = -INFINITY;
#pragma unroll
    for (int kk = 0; kk < 9; ++kk) {
      int j = kk * 64 + lane; float s = -INFINITY; int tok = 0; bool valid = false;
      if (j < 257) { int pos = t - 128 + j; valid = (pos >= 0 && pos < S); tok = b * S + pos; }
      else if (j < 513) { valid = true; tok = T + b * CL + (j - 257); }
      if (valid) {
        const float* kp = F1 + (size_t)tok * 1536 + 1024 + kvh * 64;
        float acc = 0.f;
#pragma unroll 8
        for (int d = 0; d < 64; ++d) acc += sq[d] * kp[d];
        s = acc * 0.125f;
      } else tok = 0;
      lg[kk] = s; stok[j] = tok; mx = fmaxf(mx, s);
    }
    mx = wave_max(mx);
    float sk = sink[qh];
    mx = fmaxf(mx, sk);
    float sum = 0.f;
#pragma unroll
    for (int kk = 0; kk < 9; ++kk) { float e = (lg[kk] == -INFINITY) ? 0.f : expf(lg[kk] - mx); lg[kk] = e; sum += e; }
    sum = wave_sum(sum) + expf(sk - mx);
    float inv = 1.f / sum;
#pragma unroll
    for (int kk = 0; kk < 9; ++kk) sp[kk * 64 + lane] = lg[kk] * inv;
    __syncthreads();
    float o = 0.f;
    for (int j = 0; j < 513; ++j) { float p = sp[j]; if (p != 0.f) o += p * F1[(size_t)stok[j] * 1536 + 1280 + kvh * 64 + lane]; }
    O[(size_t)row * 1024 + qh * 64 + lane] = o;
  }
}

__device__ __forceinline__ void wave_argmax(float& v, int& idx) {
#pragma unroll
  for (int off = 32; off; off >>= 1) {
    float ov = __shfl_xor(v, off); int oi = __shfl_xor(idx, off);
    if (ov > v || (ov == v && oi < idx)) { v = ov; idx = oi; }
  }
}
__device__ void ph_peer(const float* __restrict__ H, const float* __restrict__ Q, const float* __restrict__ sk,
                        const float* __restrict__ U, const float* __restrict__ V, float* __restrict__ Fp, int nrows, float* sm) {
  int lane = threadIdx.x & 63, wave = threadIdx.x >> 6;
  float* sq = sm + wave * 640; float* tops = sq + 256; int* topi = (int*)(tops + 32); int* se = topi + 32; float* sg = (float*)(se + 128);
  for (int row0 = blockIdx.x * 4; row0 < nrows; row0 += gridDim.x * 4) {
    int row = row0 + wave;
    float hreg[16];
#pragma unroll
    for (int i = 0; i < 16; ++i) hreg[i] = H[(size_t)row * D + lane + 64 * i];
    for (int h = 0; h < 8; ++h) {
      __syncthreads();
#pragma unroll
      for (int i = 0; i < 4; ++i) sq[lane + 64 * i] = Q[(size_t)row * 2048 + h * 256 + lane + 64 * i];
      __syncthreads();
      for (int p = 0; p < 2; ++p) {
        float s0 = 0.f, s1 = 0.f;
        const float* k0 = sk + ((size_t)((h * 2 + p) * 128 + lane)) * 128;
        const float* k1 = k0 + 64 * 128;
#pragma unroll 8
        for (int d = 0; d < 128; ++d) { float qv = sq[p * 128 + d]; s0 += qv * k0[d]; s1 += qv * k1[d]; }
        for (int i = 0; i < 16; ++i) {
          float v; int idx;
          if (s0 >= s1) { v = s0; idx = lane; } else { v = s1; idx = lane + 64; }
          wave_argmax(v, idx);
          if (lane == 0) { tops[p * 16 + i] = v; topi[p * 16 + i] = idx; }
          if (idx == lane) s0 = -INFINITY;
          if (idx == lane + 64) s1 = -INFINITY;
        }
      }
      __syncthreads();
      float cs[4];
#pragma unroll
      for (int i = 0; i < 4; ++i) { int ci = lane * 4 + i; cs[i] = tops[ci >> 4] + tops[16 + (ci & 15)]; }
      float bs[16]; int be[16];
#pragma unroll
      for (int k = 0; k < 16; ++k) {
        float v = cs[0]; int idx = lane * 4;
#pragma unroll
        for (int i = 1; i < 4; ++i) if (cs[i] > v) { v = cs[i]; idx = lane * 4 + i; }
        wave_argmax(v, idx);
        bs[k] = v; be[k] = topi[idx >> 4] * 128 + topi[16 + (idx & 15)];
#pragma unroll
        for (int i = 0; i < 4; ++i) if (idx == lane * 4 + i) cs[i] = -INFINITY;
      }
      float mxs = bs[0]; float sum = 0.f;
#pragma unroll
      for (int k = 0; k < 16; ++k) { bs[k] = expf(bs[k] - mxs); sum += bs[k]; }
      float inv = 1.f / sum;
      if (lane == 0) {
#pragma unroll
        for (int k = 0; k < 16; ++k) { se[h * 16 + k] = be[k]; sg[h * 16 + k] = bs[k] * inv; }
      }
    }
    __syncthreads();
    float acc[16];
#pragma unroll
    for (int i = 0; i < 16; ++i) acc[i] = 0.f;
    for (int k = 0; k < 128; ++k) {
      int e = se[k]; float g = sg[k];
      const float* u = U + (size_t)e * D; const float* v = V + (size_t)e * D;
      float a = 0.f;
#pragma unroll
      for (int i = 0; i < 16; ++i) a += u[lane + 64 * i] * hreg[i];
      a = wave_sum(a);
      float w = g * 0.5f * a * (1.f + erff(a * 0.70710678118654752f));
#pragma unroll
      for (int i = 0; i < 16; ++i) acc[i] += w * v[lane + 64 * i];
    }
#pragma unroll
    for (int i = 0; i < 16; ++i) Fp[(size_t)row * D + lane + 64 * i] = acc[i];
  }
}

constexpr int SMEM_FLOATS = 5120 + 16;

__global__ __launch_bounds__(256, 2) void mega(Params p) {
  cg::grid_group grid = cg::this_grid();
  __shared__ __attribute__((aligned(16))) float smem[SMEM_FLOATS];
  const float* x = p.in[0]; const float* c = p.in[1]; const float* ctx = p.in[2]; const float* c_ctx = p.in[3];
  const float* ada_w = p.in[4]; const float* ada_b = p.in[5]; const float* ln_g = p.in[6]; const float* ln_b = p.in[7];
  const float* even_w_in = p.in[8]; const float* even_w_out = p.in[9]; const float* rpb = p.in[10];
  const float* odd_w_in = p.in[11]; const float* odd_w_out = p.in[12]; const float* sink = p.in[13];
  const float* peer_wq = p.in[14]; const float* peer_sk = p.in[15]; const float* peer_u = p.in[16]; const float* peer_v = p.in[17];
  float* ws = p.ws;
  float* TAB = ws + OFF_TAB; float* Mm = ws + OFF_M; float* BA = ws + OFF_BA; float* BF_ = ws + OFF_BF; float* BY = ws + OFF_BY;
  float* X1 = ws + OFF_X1; float* X2 = ws + OFF_X2;
  float* out = p.out;

  ph_tables(TAB);
  ph_ada(c, c_ctx, ada_w, ada_b, Mm);
  grid.sync();
  ph_modulate(x, ctx, Mm, 0, 0, 1, BA, R, smem);
  grid.sync();
  ph_gemm(ARow{BA, 1024}, BRow{even_w_in, 2048}, CRow{BF_, 2048, 1.f}, R, 2048, 1024, smem);
  grid.sync();
  ph_chan_dft(BF_, TAB, BY);
  grid.sync();
  for (int b = 0; b < NB; ++b) {
    ph_gemm(ADft{TAB, S, 1}, BPQ{BY, b * S, S}, CRow{BA + (size_t)b * S * 1024, 1024, 1.f / sqrtf((float)S * 64.f)}, S, 512, 2 * S, smem);
    ph_gemm(ADft{TAB, CL, 8192 / CL}, BPQ{BY, T + b * CL, CL}, CRow{BA + (size_t)(T + b * CL) * 1024, 1024, 1.f / sqrtf((float)CL * 64.f)}, CL, 512, 2 * CL, smem);
  }
  ph_na(BF_, rpb, BA, smem);
  grid.sync();
  ph_gemm(ARow{BA, 1024}, BRow{even_w_out, 1024}, CRow{BY, 1024, 1.f}, R, 1024, 1024, smem);
  grid.sync();
  ph_post(x, ctx, BY, Mm, 0, 2, ln_g + 0, ln_b + 0, X1, X1 + (size_t)T * D, R, smem);
  grid.sync();
  ph_modulate(X1, X1 + (size_t)T * D, Mm, 0, 3, 4, BA, R, smem);
  grid.sync();
  ph_gemm(ARow{BA, 1024}, BRow{peer_wq, 2048}, CRow{BF_, 2048, 1.f}, R, 2048, 1024, smem);
  grid.sync();
  ph_peer(BA, BF_, peer_sk, peer_u, peer_v, BY, R, smem);
  grid.sync();
  ph_post(X1, X1 + (size_t)T * D, BY, Mm, 0, 5, ln_g + 1024, ln_b + 1024, X2, X2 + (size_t)T * D, R, smem);
  grid.sync();
  ph_modulate(X2, X2 + (size_t)T * D, Mm, 1, 0, 1, BA, R, smem);
  grid.sync();
  ph_gemm(ARow{BA, 1024}, BRow{odd_w_in, 1536}, CRow{BF_, 1536, 1.f}, R, 1536, 1024, smem);
  grid.sync();
  ph_rope(BF_);
  grid.sync();
  ph_gqa(BF_, sink, BA, smem);
  grid.sync();
  ph_gemm(ARow{BA, 1024}, BRow{odd_w_out, 1024}, CRow{BY, 1024, 1.f}, T, 1024, 1024, smem);
  grid.sync();
  ph_post(X2, X2, BY, Mm, 1, 2, ln_g + 2048, ln_b + 2048, X1, X1, T, smem);
  grid.sync();
  ph_modulate(X1, X1, Mm, 1, 3, 4, BA, T, smem);
  grid.sync();
  ph_gemm(ARow{BA, 1024}, BRow{peer_wq + (size_t)1024 * 2048, 2048}, CRow{BF_, 2048, 1.f}, T, 2048, 1024, smem);
  grid.sync();
  ph_peer(BA, BF_, peer_sk + (size_t)8 * 2 * 128 * 128, peer_u + (size_t)16384 * 1024, peer_v + (size_t)16384 * 1024, BY, T, smem);
  grid.sync();
  ph_post(X1, X1, BY, Mm, 1, 5, ln_g + 3072, ln_b + 3072, out, out, T, smem);
}

}

extern "C" void kernel_launch(void* const* d_in, const int* in_sizes, int n_in, void* d_out, int out_size, void* d_ws,
                              size_t ws_size, hipStream_t stream) {
  static int grid_blocks = 0;
  if (!grid_blocks) {
    int dev = 0, cus = 0, per_cu = 0;
    hipGetDevice(&dev);
    hipDeviceGetAttribute(&cus, hipDeviceAttributeMultiprocessorCount, dev);
    hipOccupancyMaxActiveBlocksPerMultiprocessor(&per_cu, (const void*)mega, 256, 0);
    if (per_cu > 2) per_cu = 2;
    if (per_cu < 1) per_cu = 1;
    grid_blocks = cus * per_cu;
  }
  Params p{};
  for (int i = 0; i < 18; ++i) p.in[i] = (const float*)d_in[i];
  p.out = (float*)d_out;
  p.ws = (float*)d_ws;
  void* args[] = {&p};
  hipError_t e = hipLaunchCooperativeKernel((const void*)mega, dim3(grid_blocks), dim3(256), args, 0, stream);
  if (e != hipSuccess) fprintf(stderr, "cooperative launch failed: %s (grid %d)\n", hipGetErrorString(e), grid_blocks);
}
```

```cpp
#include <hip/hip_runtime.h>
#include <hip/hip_bf16.h>
#include <stdint.h>
#include <math.h>
#include <stdio.h>
#include <hip/hip_cooperative_groups.h>
namespace cg = cooperative_groups;

namespace {

constexpr int D = 1024;
constexpr int NB = 2;
constexpr int S = 8192;
constexpr int T = NB * S;
constexpr int CL = 256;
constexpr int TC = NB * CL;
constexpr int R = T + TC;
constexpr float DN_ALPHA = 1.4142135623730951f;
constexpr float LN_EPS = 1e-6f;

__device__ __forceinline__ float wave_sum(float v) {
#pragma unroll
  for (int off = 32; off; off >>= 1) v += __shfl_xor(v, off);
  return v;
}
__device__ __forceinline__ float wave_max(float v) {
#pragma unroll
  for (int off = 32; off; off >>= 1) v = fmaxf(v, __shfl_xor(v, off));
  return v;
}

typedef unsigned short bf16_t;
typedef __attribute__((ext_vector_type(8))) short bf16x8;
typedef __attribute__((ext_vector_type(16))) float f32x16;
typedef __attribute__((ext_vector_type(4))) float f32x4;

__device__ __forceinline__ unsigned f2bf(float f) {
  unsigned u = __float_as_uint(f);
  u += 0x7fffu + ((u >> 16) & 1u);
  return u >> 16;
}
__device__ __forceinline__ unsigned pack2bf(float a, float b) { return f2bf(a) | (f2bf(b) << 16); }
__device__ __forceinline__ float bf2f(unsigned short v) { return __uint_as_float(((unsigned)v) << 16); }

__device__ __forceinline__ int mod_index(int row) { return row < T ? row / S : 2; }


struct Params {
  const float* in[18];
  float* out;
  float* ws;
};

constexpr size_t al256(size_t n) { return (n + 255) & ~(size_t)255; }
constexpr size_t OFF_TAB = 0;
constexpr size_t OFF_M = OFF_TAB + al256(16384 * 4);
constexpr size_t OFF_WIN0 = OFF_M + al256(2 * 3 * 6144 * 4);
constexpr size_t OFF_WOUT0 = OFF_WIN0 + al256((size_t)2048 * 1024 * 2);
constexpr size_t OFF_WIN1 = OFF_WOUT0 + al256((size_t)1024 * 1024 * 2);
constexpr size_t OFF_WOUT1 = OFF_WIN1 + al256((size_t)1536 * 1024 * 2);
constexpr size_t OFF_WQ = OFF_WOUT1 + al256((size_t)1024 * 1024 * 2);
constexpr size_t OFF_SK = OFF_WQ + al256((size_t)2 * 2048 * 1024 * 2);
constexpr size_t OFF_UB = OFF_SK + al256((size_t)2 * 8 * 2 * 128 * 128 * 2);
constexpr size_t OFF_VB = OFF_UB + al256((size_t)2 * 16384 * 1024 * 2);
constexpr size_t OFF_AB = OFF_VB + al256((size_t)2 * 16384 * 1024 * 2);
constexpr size_t OFF_BF = OFF_AB + al256((size_t)R * 1024 * 2);
constexpr size_t OFF_BY = OFF_BF + al256((size_t)R * 2048 * 4);
constexpr size_t OFF_X1 = OFF_BY + al256((size_t)R * 1024 * 4);
constexpr size_t OFF_X2 = OFF_X1 + al256((size_t)R * 1024 * 4);
constexpr size_t OFF_END = OFF_X2 + al256((size_t)R * 1024 * 4);
static_assert(OFF_END <= (size_t)512 * 1024 * 1024, "workspace overflow");

#define GRID_LOOP(var, n) for (int var = blockIdx.x; var < (n); var += gridDim.x)

__device__ void ph_tables(float* tab) {
  for (int j = blockIdx.x * 256 + threadIdx.x; j < 8192; j += gridDim.x * 256) {
    double a = 6.283185307179586476925286766559 * (double)j / 8192.0;
    tab[j] = (float)cos(a);
    tab[8192 + j] = (float)sin(a);
  }
}
__device__ void ph_ada(const float* __restrict__ c, const float* __restrict__ c_ctx, const float* __restrict__ ada_w,
                       const float* __restrict__ ada_b, float* __restrict__ M) {
  for (int gid = blockIdx.x * 256 + threadIdx.x; gid < 2 * 3 * 6144; gid += gridDim.x * 256) {
    int col = gid % 6144; int idx = (gid / 6144) % 3; int layer = gid / (3 * 6144);
    const float* vec = idx < 2 ? c + idx * D : c_ctx;
    const float* w = ada_w + (size_t)layer * D * 6144 + col;
    float acc = 0.f;
    for (int k = 0; k < D; ++k) {
      float x = vec[k];
      float sx = x / (1.f + expf(-x));
      acc += sx * w[(size_t)k * 6144];
    }
    M[gid] = acc + ada_b[layer * 6144 + col];
  }
}

__device__ void ph_modulate(const float* __restrict__ xa, const float* __restrict__ xb, const float* __restrict__ M, int layer,
                            int jshift, int jscale, bf16_t* __restrict__ out, int nrows, float* red) {
  int tid = threadIdx.x;
  GRID_LOOP(row, nrows) {
    const float* x = row < T ? xa + (size_t)row * D : xb + (size_t)(row - T) * D;
    float v[4]; float s = 0.f;
#pragma unroll
    for (int i = 0; i < 4; ++i) { v[i] = x[tid + 256 * i]; s += v[i]; }
    s = wave_sum(s);
    __syncthreads();
    if ((tid & 63) == 0) red[tid >> 6] = s;
    __syncthreads();
    float mu = (red[0] + red[1] + red[2] + red[3]) * (1.f / D);
    float q = 0.f;
#pragma unroll
    for (int i = 0; i < 4; ++i) { float d = v[i] - mu; q += d * d; }
    q = wave_sum(q);
    if ((tid & 63) == 0) red[4 + (tid >> 6)] = q;
    __syncthreads();
    float var = (red[4] + red[5] + red[6] + red[7]) * (1.f / D);
    float rs = rsqrtf(var + LN_EPS);
    const float* m = M + ((size_t)layer * 3 + mod_index(row)) * 6144;
#pragma unroll
    for (int i = 0; i < 4; ++i) {
      int col = tid + 256 * i;
      float y = (v[i] - mu) * rs;
      out[(size_t)row * D + col] = (bf16_t)f2bf(y * (1.f + m[jscale * D + col]) + m[jshift * D + col]);
    }
  }
}

__device__ void ph_post(const float* __restrict__ xa, const float* __restrict__ xb, const float* __restrict__ Y,
                        const float* __restrict__ M, int layer, int j, const float* __restrict__ g, const float* __restrict__ bb,
                        float* __restrict__ outa, float* __restrict__ outb, int nrows, float* red) {
  int tid = threadIdx.x;
  GRID_LOOP(row, nrows) {
    const float* x = row < T ? xa + (size_t)row * D : xb + (size_t)(row - T) * D;
    float* out = row < T ? outa + (size_t)row * D : outb + (size_t)(row - T) * D;
    const float* m = M + ((size_t)layer * 3 + mod_index(row)) * 6144 + j * D;
    float v[4]; float s = 0.f;
#pragma unroll
    for (int i = 0; i < 4; ++i) { int col = tid + 256 * i; v[i] = DN_ALPHA * x[col] + m[col] * Y[(size_t)row * D + col]; s += v[i]; }
    s = wave_sum(s);
    __syncthreads();
    if ((tid & 63) == 0) red[tid >> 6] = s;
    __syncthreads();
    float mu = (red[0] + red[1] + red[2] + red[3]) * (1.f / D);
    float q = 0.f;
#pragma unroll
    for (int i = 0; i < 4; ++i) { float d = v[i] - mu; q += d * d; }
    q = wave_sum(q);
    if ((tid & 63) == 0) red[4 + (tid >> 6)] = q;
    __syncthreads();
    float var = (red[4] + red[5] + red[6] + red[7]) * (1.f / D);
    float rs = rsqrtf(var + LN_EPS);
#pragma unroll
    for (int i = 0; i < 4; ++i) {
      int col = tid + 256 * i;
      out[col] = (v[i] - mu) * rs * g[col] + bb[col];
    }
  }
}

struct ARow { const float* A; int lda; __device__ float operator()(int m, int k) const { return A[(size_t)m * lda + k]; } };
struct BRow { const float* B; int ldb; __device__ float operator()(int k, int n) const { return B[(size_t)k * ldb + n]; } };
struct CRow { float* C; int ldc; float scale; __device__ void operator()(int m, int n, float v) const { C[(size_t)m * ldc + n] = v * scale; } };
struct CRowB { bf16_t* C; int ldc; float scale; __device__ void operator()(int m, int n, float v) const { C[(size_t)m * ldc + n] = (bf16_t)f2bf(v * scale); } };
struct ADft { const float* tab; int Sn; int stride; __device__ float operator()(int m, int k) const {
    int t = k & (Sn - 1); int idx = ((m * t) & (Sn - 1)) * stride;
    return k < Sn ? tab[idx] : -tab[8192 + idx]; } };
struct BPQ { const float* PQ; int rowbase; int Sn; __device__ float operator()(int k, int n) const {
    int t = k & (Sn - 1); return PQ[(size_t)(rowbase + t) * 1024 + (k >= Sn ? 512 : 0) + n]; } };

template <class AF, class BF, class CF>
__device__ void ph_gemm(AF af, BF bf, CF cf, int M, int N, int K, float* sm) {
  float (*sA)[68] = (float (*)[68])sm;
  float (*sB)[68] = (float (*)[68])(sm + 16 * 68);
  int tid = threadIdx.x; int tx = tid & 15, ty = tid >> 4;
  int ntn = N / 64; int ntiles = (M / 64) * ntn;
  GRID_LOOP(tile, ntiles) {
    int m0 = (tile / ntn) * 64, n0 = (tile % ntn) * 64;
    float acc[4][4];
#pragma unroll
    for (int i = 0; i < 4; ++i)
#pragma unroll
      for (int j = 0; j < 4; ++j) acc[i][j] = 0.f;
    for (int k0 = 0; k0 < K; k0 += 16) {
      __syncthreads();
#pragma unroll
      for (int i = 0; i < 4; ++i) { int e = tid + 256 * i; int m = e >> 4, k = e & 15; sA[k][m] = af(m0 + m, k0 + k); }
#pragma unroll
      for (int i = 0; i < 4; ++i) { int e = tid + 256 * i; int k = e >> 6, n = e & 63; sB[k][n] = bf(k0 + k, n0 + n); }
      __syncthreads();
#pragma unroll
      for (int k = 0; k < 16; ++k) {
        float a[4], b[4];
#pragma unroll
        for (int i = 0; i < 4; ++i) { a[i] = sA[k][ty * 4 + i]; b[i] = sB[k][tx * 4 + i]; }
#pragma unroll
        for (int i = 0; i < 4; ++i)
#pragma unroll
          for (int j = 0; j < 4; ++j) acc[i][j] += a[i] * b[j];
      }
    }
#pragma unroll
    for (int i = 0; i < 4; ++i)
#pragma unroll
      for (int j = 0; j < 4; ++j) cf(m0 + ty * 4 + i, n0 + tx * 4 + j, acc[i][j]);
  }
}


__device__ void ph_transpose_w(const float* __restrict__ W, int K, int N, bf16_t* __restrict__ Wt, float* sm) {
  int tid = threadIdx.x;
  int tk = K / 64, tn = N / 64;
  GRID_LOOP(tile, tk * tn) {
    int k0 = (tile / tn) * 64, n0 = (tile % tn) * 64;
    __syncthreads();
#pragma unroll
    for (int i = 0; i < 16; ++i) { int e = tid + 256 * i; int k = e >> 6, n = e & 63; sm[k * 65 + n] = W[(size_t)(k0 + k) * N + n0 + n]; }
    __syncthreads();
#pragma unroll
    for (int i = 0; i < 2; ++i) {
      int e = tid + 256 * i; int n = e >> 3, kc = e & 7;
      unsigned w[4];
#pragma unroll
      for (int j = 0; j < 4; ++j) w[j] = pack2bf(sm[(kc * 8 + 2 * j) * 65 + n], sm[(kc * 8 + 2 * j + 1) * 65 + n]);
      *(uint4*)(Wt + (size_t)(n0 + n) * K + k0 + kc * 8) = make_uint4(w[0], w[1], w[2], w[3]);
    }
  }
}
__device__ void ph_convert(const float* __restrict__ src, bf16_t* __restrict__ dst, size_t n8) {
  for (size_t i = (size_t)blockIdx.x * 256 + threadIdx.x; i < n8; i += (size_t)gridDim.x * 256) {
    float4 a = ((const float4*)src)[2 * i], b = ((const float4*)src)[2 * i + 1];
    ((uint4*)dst)[i] = make_uint4(pack2bf(a.x, a.y), pack2bf(a.z, a.w), pack2bf(b.x, b.y), pack2bf(b.z, b.w));
  }
}

__device__ __forceinline__ void gemm_stage(const bf16_t* __restrict__ A, int lda, int k0, char* lds, int tid) {
#pragma unroll
  for (int i = 0; i < 4; ++i) {
    int q = tid + 256 * i; int row = q >> 3, p = q & 7; int c = p ^ ((row >> 1) & 7);
    const bf16_t* src = A + (size_t)row * lda + k0 + c * 8;
    __builtin_amdgcn_global_load_lds((const unsigned*)src, (unsigned*)(lds + q * 16), 16, 0, 0);
  }
}
struct EpiF32 {
  float* C; int ldc; float scale;
  __device__ __forceinline__ void operator()(int m0, int n0, int wm, int wn, f32x16 (&acc)[2][2], int tid, char* smem) const {
    int lane = tid & 63;
    float* t = (float*)smem;
    int rbase = wm * 64 + 4 * (lane >> 5), cbase = wn * 64 + (lane & 31);
#pragma unroll
    for (int mi = 0; mi < 2; ++mi)
#pragma unroll
      for (int ni = 0; ni < 2; ++ni)
#pragma unroll
        for (int r = 0; r < 16; ++r)
          t[(rbase + mi * 32 + (r & 3) + 8 * (r >> 2)) * 128 + cbase + ni * 32] = acc[mi][ni][r] * scale;
    __syncthreads();
    float* dst = C + (size_t)(m0 + (tid >> 5)) * ldc + n0 + (tid & 31) * 4;
    const float* src = t + (tid >> 5) * 128 + (tid & 31) * 4;
#pragma unroll 4
    for (int i = 0; i < 16; ++i) {
      *(float4*)dst = *(const float4*)src;
      dst += (size_t)8 * ldc; src += 8 * 128;
    }
  }
};
template <class Epi>
__device__ void ph_gemm_bf16(const bf16_t* __restrict__ A, int lda, const bf16_t* __restrict__ Bt, int ldb, int M, int N, int K,
                             Epi epi, char* smem) {
  int tid = threadIdx.x, lane = tid & 63, wave = tid >> 6, wm = wave >> 1, wn = wave & 1;
  int ntn = N / 128, ntiles = (M / 128) * ntn;
  int KT = K / 64;
  GRID_LOOP(tile, ntiles) {
    int mt = tile / ntn, nt = tile % ntn;
    const bf16_t* Ag = A + (size_t)mt * 128 * lda; const bf16_t* Bg = Bt + (size_t)nt * 128 * ldb;
    f32x16 acc[2][2];
#pragma unroll
    for (int mi = 0; mi < 2; ++mi)
#pragma unroll
      for (int ni = 0; ni < 2; ++ni)
#pragma unroll
        for (int r = 0; r < 16; ++r) acc[mi][ni][r] = 0.f;
    __syncthreads();
    gemm_stage(Ag, lda, 0, smem, tid); gemm_stage(Bg, ldb, 0, smem + 16384, tid);
    for (int kt = 0; kt < KT; ++kt) {
      asm volatile("s_waitcnt vmcnt(0)" ::: "memory");
      __syncthreads();
      char* cur = smem + (kt & 1) * 32768;
      if (kt + 1 < KT) {
        char* nxt = smem + ((kt + 1) & 1) * 32768;
        gemm_stage(Ag, lda, (kt + 1) * 64, nxt, tid); gemm_stage(Bg, ldb, (kt + 1) * 64, nxt + 16384, tid);
      }
#pragma unroll
      for (int s4 = 0; s4 < 4; ++s4) {
        bf16x8 a[2], b[2];
        int c = 2 * s4 + (lane >> 5);
#pragma unroll
        for (int mi = 0; mi < 2; ++mi) { int row = wm * 64 + mi * 32 + (lane & 31); a[mi] = *(const bf16x8*)(cur + row * 128 + ((c ^ ((row >> 1) & 7)) << 4)); }
#pragma unroll
        for (int ni = 0; ni < 2; ++ni) { int row = wn * 64 + ni * 32 + (lane & 31); b[ni] = *(const bf16x8*)(cur + 16384 + row * 128 + ((c ^ ((row >> 1) & 7)) << 4)); }
#pragma unroll
        for (int mi = 0; mi < 2; ++mi)
#pragma unroll
          for (int ni = 0; ni < 2; ++ni) acc[mi][ni] = __builtin_amdgcn_mfma_f32_32x32x16_bf16(a[mi], b[ni], acc[mi][ni], 0, 0, 0);
      }
    }
    __syncthreads();
    epi(mt * 128, nt * 128, wm, wn, acc, tid, smem);
  }
}

__device__ void ph_chan_dft(const float* __restrict__ F, const float* __restrict__ tab, float* __restrict__ PQ) {
  for (int gid = blockIdx.x * 256 + threadIdx.x; gid < R * 512; gid += gridDim.x * 256) {
    int row = gid >> 9; int col = gid & 511; int g = col >> 6, cp = col & 63;
    const float* f = F + (size_t)row * 2048 + g * 64;
    float p = 0.f, q = 0.f;
    for (int ch = 0; ch < 64; ++ch) {
      int idx = ((ch * cp) & 63) * 128;
      float x = f[ch];
      p += x * tab[idx]; q += x * tab[8192 + idx];
    }
    PQ[(size_t)row * 1024 + col] = p;
    PQ[(size_t)row * 1024 + 512 + col] = q;
  }
}

__device__ void ph_na(const float* __restrict__ F, const float* __restrict__ rpb, bf16_t* __restrict__ MIX, float* sm) {
  int lane = threadIdx.x & 63, wave = threadIdx.x >> 6;
  float* sq = sm + wave * 1024; float* sp = sq + 64; int* stok = (int*)(sp + 384);
  int nitems = R * 8;
  for (int item0 = blockIdx.x * 4; item0 < nitems; item0 += gridDim.x * 4) {
    int item = item0 + wave;
    int h = item & 7; int row = item >> 3;
    bool is_ctx = row >= T;
    int b = is_ctx ? (row - T) / CL : row / S;
    __syncthreads();
    sq[lane] = F[(size_t)row * 2048 + 512 + h * 64 + lane];
    __syncthreads();
    int r = 0, c = 0, r_start = 0, c_start = 0;
    if (!is_ctx) { int t = row % S; r = t / 64; c = t % 64; r_start = min(max(r - 4, 0), 120); c_start = min(max(c - 8, 0), 48); }
    int nk = is_ctx ? 256 : 384;
    float lg[6]; float mx = -INFINITY;
#pragma unroll
    for (int kk = 0; kk < 6; ++kk) {
      int j = kk * 64 + lane; float s = -INFINITY; int tok = 0;
      if (j < nk) {
        float bias = 0.f;
        if (!is_ctx && j < 128) {
          int kr = j >> 4, kc = j & 15; int rr = r_start + kr, cc = c_start + kc;
          tok = b * S + rr * 64 + cc;
          int dc = min(max(cc - c, -15), 15) + 15;
          bias = rpb[(h * 15 + (rr - r + 7)) * 31 + dc];
        } else {
          int l = is_ctx ? j : j - 128; tok = T + b * CL + l;
        }
        const float* kp = F + (size_t)tok * 2048 + 1024 + h * 64;
        float acc = 0.f;
#pragma unroll 8
        for (int d = 0; d < 64; ++d) acc += sq[d] * kp[d];
        s = acc * 0.125f + bias;
      }
      lg[kk] = s; stok[j] = tok; mx = fmaxf(mx, s);
    }
    mx = wave_max(mx);
    float sum = 0.f;
#pragma unroll
    for (int kk = 0; kk < 6; ++kk) { float e = (kk * 64 + lane < nk) ? expf(lg[kk] - mx) : 0.f; lg[kk] = e; sum += e; }
    sum = wave_sum(sum);
    float inv = 1.f / sum;
#pragma unroll
    for (int kk = 0; kk < 6; ++kk) sp[kk * 64 + lane] = lg[kk] * inv;
    __syncthreads();
    float o = 0.f;
    for (int j = 0; j < nk; ++j) o += sp[j] * F[(size_t)stok[j] * 2048 + 1536 + h * 64 + lane];
    MIX[(size_t)row * 1024 + 512 + h * 64 + lane] = (bf16_t)f2bf(o);
  }
}

__device__ void ph_rope(float* __restrict__ F1) {
  for (int gid = blockIdx.x * 256 + threadIdx.x; gid < T * 20 * 32; gid += gridDim.x * 256) {
    int i = gid & 31; int hh = (gid >> 5) % 20; int row = gid / (32 * 20);
    int t = row % S; float rowp = (float)(t / 64), colp = (float)(t % 64);
    int fi = i & 15;
    float inv_freq = powf(10000.0f, -(float)fi / 16.0f);
    float ang = (i < 16 ? rowp : colp) * inv_freq;
    float cs = cosf(ang), sn = sinf(ang);
    float* p = F1 + (size_t)row * 1536 + hh * 64;
    float x1 = p[i], x2 = p[i + 32];
    p[i] = x1 * cs - x2 * sn;
    p[i + 32] = x1 * sn + x2 * cs;
  }
}

__device__ void ph_gqa(const float* __restrict__ F1, const float* __restrict__ sink, bf16_t* __restrict__ O, float* sm) {
  int lane = threadIdx.x & 63, wave = threadIdx.x >> 6;
  float* sq = sm + wave * 1280; float* sp = sq + 64; int* stok = (int*)(sp + 576);
  int nitems = T * 16;
  for (int item0 = blockIdx.x * 4; item0 < nitems; item0 += gridDim.x * 4) {
    int item = item0 + wave;
    int qh = item & 15; int row = item >> 4; int kvh = qh >> 2;
    int b = row / S; int t = row % S;
    __syncthreads();
    sq[lane] = F1[(size_t)row * 1536 + qh * 64 + lane];
    __syncthreads();
    float lg[9]; float mx = -INFINITY;
#pragma unroll
    for (int kk = 0; kk < 9; ++kk) {
      int j = kk * 64 + lane; float s = -INFINITY; int tok = 0; bool valid = false;
      if (j < 257) { int pos = t - 128 + j; valid = (pos >= 0 && pos < S); tok = b * S + pos; }
      else if (j < 513) { valid = true; tok = T + b * CL + (j - 257); }
      if (valid) {
        const float* kp = F1 + (size_t)tok * 1536 + 1024 + kvh * 64;
        float acc = 0.f;
#pragma unroll 8
        for (int d = 0; d < 64; ++d) acc += sq[d] * kp[d];
        s = acc * 0.125f;
      } else tok = 0;
      lg[kk] = s; stok[j] = tok; mx = fmaxf(mx, s);
    }
    mx = wave_max(mx);
    float sk = sink[qh];
    mx = fmaxf(mx, sk);
    float sum = 0.f;
#pragma unroll
    for (int kk = 0; kk < 9; ++kk) { float e = (lg[kk] == -INFINITY) ? 0.f : expf(lg[kk] - mx); lg[kk] = e; sum += e; }
    sum = wave_sum(sum) + expf(sk - mx);
    float inv = 1.f / sum;
#pragma unroll
    for (int kk = 0; kk < 9; ++kk) sp[kk * 64 + lane] = lg[kk] * inv;
    __syncthreads();
    float o = 0.f;
    for (int j = 0; j < 513; ++j) { float p = sp[j]; if (p != 0.f) o += p * F1[(size_t)stok[j] * 1536 + 1280 + kvh * 64 + lane]; }
    O[(size_t)row * 1024 + qh * 64 + lane] = (bf16_t)f2bf(o);
  }
}

__device__ __forceinline__ void wave_argmax(float& v, int& idx) {
#pragma unroll
  for (int off = 32; off; off >>= 1) {
    float ov = __shfl_xor(v, off); int oi = __shfl_xor(idx, off);
    if (ov > v || (ov == v && oi < idx)) { v = ov; idx = oi; }
  }
}
__device__ void ph_peer(const bf16_t* __restrict__ H, const float* __restrict__ Q, const float* __restrict__ sk,
                        const float* __restrict__ U, const float* __restrict__ V, float* __restrict__ Fp, int nrows, float* sm) {
  int lane = threadIdx.x & 63, wave = threadIdx.x >> 6;
  float* sq = sm + wave * 640; float* tops = sq + 256; int* topi = (int*)(tops + 32); int* se = topi + 32; float* sg = (float*)(se + 128);
  for (int row0 = blockIdx.x * 4; row0 < nrows; row0 += gridDim.x * 4) {
    int row = row0 + wave;
    float hreg[16];
#pragma unroll
    for (int i = 0; i < 16; ++i) hreg[i] = bf2f(H[(size_t)row * D + lane + 64 * i]);
    for (int h = 0; h < 8; ++h) {
      __syncthreads();
#pragma unroll
      for (int i = 0; i < 4; ++i) sq[lane + 64 * i] = Q[(size_t)row * 2048 + h * 256 + lane + 64 * i];
      __syncthreads();
      for (int p = 0; p < 2; ++p) {
        float s0 = 0.f, s1 = 0.f;
        const float* k0 = sk + ((size_t)((h * 2 + p) * 128 + lane)) * 128;
        const float* k1 = k0 + 64 * 128;
#pragma unroll 8
        for (int d = 0; d < 128; ++d) { float qv = sq[p * 128 + d]; s0 += qv * k0[d]; s1 += qv * k1[d]; }
        for (int i = 0; i < 16; ++i) {
          float v; int idx;
          if (s0 >= s1) { v = s0; idx = lane; } else { v = s1; idx = lane + 64; }
          wave_argmax(v, idx);
          if (lane == 0) { tops[p * 16 + i] = v; topi[p * 16 + i] = idx; }
          if (idx == lane) s0 = -INFINITY;
          if (idx == lane + 64) s1 = -INFINITY;
        }
      }
      __syncthreads();
      float cs[4];
#pragma unroll
      for (int i = 0; i < 4; ++i) { int ci = lane * 4 + i; cs[i] = tops[ci >> 4] + tops[16 + (ci & 15)]; }
      float bs[16]; int be[16];
#pragma unroll
      for (int k = 0; k < 16; ++k) {
        float v = cs[0]; int idx = lane * 4;
#pragma unroll
        for (int i = 1; i < 4; ++i) if (cs[i] > v) { v = cs[i]; idx = lane * 4 + i; }
        wave_argmax(v, idx);
        bs[k] = v; be[k] = topi[idx >> 4] * 128 + topi[16 + (idx & 15)];
#pragma unroll
        for (int i = 0; i < 4; ++i) if (idx == lane * 4 + i) cs[i] = -INFINITY;
      }
      float mxs = bs[0]; float sum = 0.f;
#pragma unroll
      for (int k = 0; k < 16; ++k) { bs[k] = expf(bs[k] - mxs); sum += bs[k]; }
      float inv = 1.f / sum;
      if (lane == 0) {
#pragma unroll
        for (int k = 0; k < 16; ++k) { se[h * 16 + k] = be[k]; sg[h * 16 + k] = bs[k] * inv; }
      }
    }
    __syncthreads();
    float acc[16];
#pragma unroll
    for (int i = 0; i < 16; ++i) acc[i] = 0.f;
    for (int k = 0; k < 128; ++k) {
      int e = se[k]; float g = sg[k];
      const float* u = U + (size_t)e * D; const float* v = V + (size_t)e * D;
      float a = 0.f;
#pragma unroll
      for (int i = 0; i < 16; ++i) a += u[lane + 64 * i] * hreg[i];
      a = wave_sum(a);
      float w = g * 0.5f * a * (1.f + erff(a * 0.70710678118654752f));
#pragma unroll
      for (int i = 0; i < 16; ++i) acc[i] += w * v[lane + 64 * i];
    }
#pragma unroll
    for (int i = 0; i < 16; ++i) Fp[(size_t)row * D + lane + 64 * i] = acc[i];
  }
}

constexpr int SMEM_BYTES = 65536;

__global__ __launch_bounds__(256, 2) void mega(Params p) {
  cg::grid_group grid = cg::this_grid();
  __shared__ __attribute__((aligned(16))) char smem_raw[SMEM_BYTES];
  float* smem = (float*)smem_raw;
  const float* x = p.in[0]; const float* c = p.in[1]; const float* ctx = p.in[2]; const float* c_ctx = p.in[3];
  const float* ada_w = p.in[4]; const float* ada_b = p.in[5]; const float* ln_g = p.in[6]; const float* ln_b = p.in[7];
  const float* even_w_in = p.in[8]; const float* even_w_out = p.in[9]; const float* rpb = p.in[10];
  const float* odd_w_in = p.in[11]; const float* odd_w_out = p.in[12]; const float* sink = p.in[13];
  const float* peer_wq = p.in[14]; const float* peer_sk = p.in[15]; const float* peer_u = p.in[16]; const float* peer_v = p.in[17];
  char* ws = (char*)p.ws;
  float* TAB = (float*)(ws + OFF_TAB); float* Mm = (float*)(ws + OFF_M);
  bf16_t* WIN0 = (bf16_t*)(ws + OFF_WIN0); bf16_t* WOUT0 = (bf16_t*)(ws + OFF_WOUT0);
  bf16_t* WIN1 = (bf16_t*)(ws + OFF_WIN1); bf16_t* WOUT1 = (bf16_t*)(ws + OFF_WOUT1);
  bf16_t* WQ = (bf16_t*)(ws + OFF_WQ); bf16_t* SKB = (bf16_t*)(ws + OFF_SK);
  bf16_t* UB = (bf16_t*)(ws + OFF_UB); bf16_t* VB = (bf16_t*)(ws + OFF_VB);
  bf16_t* AB = (bf16_t*)(ws + OFF_AB);
  float* BF_ = (float*)(ws + OFF_BF); float* BY = (float*)(ws + OFF_BY);
  float* X1 = (float*)(ws + OFF_X1); float* X2 = (float*)(ws + OFF_X2);
  float* out = p.out;

  ph_tables(TAB);
  ph_ada(c, c_ctx, ada_w, ada_b, Mm);
  ph_transpose_w(even_w_in, 1024, 2048, WIN0, smem);
  ph_transpose_w(even_w_out, 1024, 1024, WOUT0, smem);
  ph_transpose_w(odd_w_in, 1024, 1536, WIN1, smem);
  ph_transpose_w(odd_w_out, 1024, 1024, WOUT1, smem);
  ph_transpose_w(peer_wq, 1024, 2048, WQ, smem);
  ph_transpose_w(peer_wq + (size_t)1024 * 2048, 1024, 2048, WQ + (size_t)2048 * 1024, smem);
  grid.sync();
  ph_modulate(x, ctx, Mm, 0, 0, 1, AB, R, smem);
  grid.sync();
  ph_gemm_bf16(AB, 1024, WIN0, 1024, R, 2048, 1024, EpiF32{BF_, 2048, 1.f}, smem_raw);
  grid.sync();
  ph_chan_dft(BF_, TAB, BY);
  grid.sync();
#pragma unroll 1
  for (int b = 0; b < NB; ++b) {
    ph_gemm(ADft{TAB, S, 1}, BPQ{BY, b * S, S}, CRowB{AB + (size_t)b * S * 1024, 1024, 1.f / sqrtf((float)S * 64.f)}, S, 512, 2 * S, smem);
    ph_gemm(ADft{TAB, CL, 8192 / CL}, BPQ{BY, T + b * CL, CL}, CRowB{AB + (size_t)(T + b * CL) * 1024, 1024, 1.f / sqrtf((float)CL * 64.f)}, CL, 512, 2 * CL, smem);
  }
  ph_na(BF_, rpb, AB, smem);
  grid.sync();
  ph_gemm_bf16(AB, 1024, WOUT0, 1024, R, 1024, 1024, EpiF32{BY, 1024, 1.f}, smem_raw);
  grid.sync();
  ph_post(x, ctx, BY, Mm, 0, 2, ln_g + 0, ln_b + 0, X1, X1 + (size_t)T * D, R, smem);
  grid.sync();
  ph_modulate(X1, X1 + (size_t)T * D, Mm, 0, 3, 4, AB, R, smem);
  grid.sync();
  ph_gemm_bf16(AB, 1024, WQ, 1024, R, 2048, 1024, EpiF32{BF_, 2048, 1.f}, smem_raw);
  grid.sync();
  ph_peer(AB, BF_, peer_sk, peer_u, peer_v, BY, R, smem);
  grid.sync();
  ph_post(X1, X1 + (size_t)T * D, BY, Mm, 0, 5, ln_g + 1024, ln_b + 1024, X2, X2 + (size_t)T * D, R, smem);
  grid.sync();
  ph_modulate(X2, X2 + (size_t)T * D, Mm, 1, 0, 1, AB, R, smem);
  grid.sync();
  ph_gemm_bf16(AB, 1024, WIN1, 1024, R, 1536, 1024, EpiF32{BF_, 1536, 1.f}, smem_raw);
  grid.sync();
  ph_rope(BF_);
  grid.sync();
  ph_gqa(BF_, sink, AB, smem);
  grid.sync();
  ph_gemm_bf16(AB, 1024, WOUT1, 1024, T, 1024, 1024, EpiF32{BY, 1024, 1.f}, smem_raw);
  grid.sync();
  ph_post(X2, X2, BY, Mm, 1, 2, ln_g + 2048, ln_b + 2048, X1, X1, T, smem);
  grid.sync();
  ph_modulate(X1, X1, Mm, 1, 3, 4, AB, T, smem);
  grid.sync();
  ph_gemm_bf16(AB, 1024, WQ + (size_t)2048 * 1024, 1024, T, 2048, 1024, EpiF32{BF_, 2048, 1.f}, smem_raw);
  grid.sync();
  ph_peer(AB, BF_, peer_sk + (size_t)8 * 2 * 128 * 128, peer_u + (size_t)16384 * 1024, peer_v + (size_t)16384 * 1024, BY, T, smem);
  grid.sync();
  ph_post(X1, X1, BY, Mm, 1, 5, ln_g + 3072, ln_b + 3072, out, out, T, smem);
}

}

extern "C" void kernel_launch(void* const* d_in, const int* in_sizes, int n_in, void* d_out, int out_size, void* d_ws,
                              size_t ws_size, hipStream_t stream) {
  static int grid_blocks = 0;
  if (!grid_blocks) {
    int dev = 0, cus = 0, per_cu = 0;
    hipGetDevice(&dev);
    hipDeviceGetAttribute(&cus, hipDeviceAttributeMultiprocessorCount, dev);
    hipOccupancyMaxActiveBlocksPerMultiprocessor(&per_cu, (const void*)mega, 256, 0);
    if (per_cu > 2) per_cu = 2;
    if (per_cu < 1) per_cu = 1;
    grid_blocks = cus * per_cu;
  }
  Params p{};
  for (int i = 0; i < 18; ++i) p.in[i] = (const float*)d_in[i];
  p.out = (float*)d_out;
  p.ws = (float*)d_ws;
  void* args[] = {&p};
  hipError_t e = hipLaunchCooperativeKernel((const void*)mega, dim3(grid_blocks), dim3(256), args, 0, stream);
  if (e != hipSuccess) fprintf(stderr, "cooperative launch failed: %s (grid %d)\n", hipGetErrorString(e), grid_blocks);
}
```

```cpp
#include <hip/hip_runtime.h>
#include <hip/hip_bf16.h>
#include <stdint.h>
#include <math.h>
#include <stdio.h>
#include <hip/hip_cooperative_groups.h>
namespace cg = cooperative_groups;

namespace {

constexpr int D = 1024;
constexpr int NB = 2;
constexpr int S = 8192;
constexpr int T = NB * S;
constexpr int CL = 256;
constexpr int TC = NB * CL;
constexpr int R = T + TC;
constexpr float DN_ALPHA = 1.4142135623730951f;
constexpr float LN_EPS = 1e-6f;

__device__ __forceinline__ float wave_sum(float v) {
#pragma unroll
  for (int off = 32; off; off >>= 1) v += __shfl_xor(v, off);
  return v;
}
__device__ __forceinline__ float wave_max(float v) {
#pragma unroll
  for (int off = 32; off; off >>= 1) v = fmaxf(v, __shfl_xor(v, off));
  return v;
}

typedef unsigned short bf16_t;
typedef __attribute__((ext_vector_type(8))) short bf16x8;
typedef __attribute__((ext_vector_type(16))) float f32x16;
typedef __attribute__((ext_vector_type(4))) float f32x4;

__device__ __forceinline__ unsigned f2bf(float f) {
  unsigned u = __float_as_uint(f);
  u += 0x7fffu + ((u >> 16) & 1u);
  return u >> 16;
}
__device__ __forceinline__ unsigned pack2bf(float a, float b) { return f2bf(a) | (f2bf(b) << 16); }
__device__ __forceinline__ float bf2f(unsigned short v) { return __uint_as_float(((unsigned)v) << 16); }

__device__ __forceinline__ int mod_index(int row) { return row < T ? row / S : 2; }


struct Params {
  const float* in[18];
  float* out;
  float* ws;
};

constexpr size_t al256(size_t n) { return (n + 255) & ~(size_t)255; }
constexpr size_t OFF_TAB = 0;
constexpr size_t OFF_M = OFF_TAB + al256(16384 * 4);
constexpr size_t OFF_WIN0 = OFF_M + al256(2 * 3 * 6144 * 4);
constexpr size_t OFF_WOUT0 = OFF_WIN0 + al256((size_t)2048 * 1024 * 2);
constexpr size_t OFF_WIN1 = OFF_WOUT0 + al256((size_t)1024 * 1024 * 2);
constexpr size_t OFF_WOUT1 = OFF_WIN1 + al256((size_t)1536 * 1024 * 2);
constexpr size_t OFF_WQ = OFF_WOUT1 + al256((size_t)1024 * 1024 * 2);
constexpr size_t OFF_SK = OFF_WQ + al256((size_t)2 * 2048 * 1024 * 2);
constexpr size_t OFF_UB = OFF_SK + al256((size_t)2 * 8 * 2 * 128 * 128 * 2);
constexpr size_t OFF_VB = OFF_UB + al256((size_t)2 * 16384 * 1024 * 2);
constexpr size_t OFF_AB = OFF_VB + al256((size_t)2 * 16384 * 1024 * 2);
constexpr size_t OFF_FT = OFF_AB + al256((size_t)R * 1024 * 2);
constexpr size_t OFF_BF = OFF_FT + al256((size_t)(256 * 128 + 128 * 128 + 64 * 128) * 2);
constexpr size_t OFF_BY = OFF_BF + al256((size_t)R * 2048 * 4);
constexpr size_t OFF_X1 = OFF_BY + al256((size_t)R * 1024 * 4);
constexpr size_t OFF_X2 = OFF_X1 + al256((size_t)R * 1024 * 4);
constexpr size_t OFF_END = OFF_X2 + al256((size_t)R * 1024 * 4);
constexpr size_t OFF_A1 = OFF_BY;
constexpr size_t OFF_VT0 = OFF_X2;
static_assert(OFF_END <= (size_t)512 * 1024 * 1024, "workspace overflow");

#define GRID_LOOP(var, n) for (int var = blockIdx.x; var < (n); var += gridDim.x)

__device__ __forceinline__ void ph_fft_tables(bf16_t* D1, bf16_t* D3, bf16_t* DcT) {
  const double TWO_PI = 6.283185307179586476925286766559;
  for (int i = blockIdx.x * 256 + threadIdx.x; i < 256 * 128 + 128 * 128 + 64 * 128; i += gridDim.x * 256) {
    if (i < 256 * 128) {
      int m = i >> 7, r = i & 127; int k1 = m >> 1, ri = m & 1;
      double a = TWO_PI * (double)((k1 * r) & 127) / 128.0;
      D1[i] = (bf16_t)f2bf(ri == 0 ? (float)cos(a) : (float)(-sin(a)));
    } else if (i < 256 * 128 + 128 * 128) {
      int j = i - 256 * 128; int m = j >> 7, kk = j & 127; int rip = m >> 6, k2 = m & 63; int c = kk >> 1, ri = kk & 1;
      double a = TWO_PI * (double)((k2 * c) & 63) / 64.0;
      double v = (rip == 0) ? (ri == 0 ? cos(a) : sin(a)) : (ri == 0 ? -sin(a) : cos(a));
      D3[j] = (bf16_t)f2bf((float)v);
    } else {
      int j = i - 256 * 128 - 128 * 128; int cp = j >> 7, kk = j & 127; int rip = kk >> 6, ch = kk & 63;
      double a = TWO_PI * (double)((ch * cp) & 63) / 64.0;
      DcT[j] = (bf16_t)f2bf((float)(rip == 0 ? cos(a) : sin(a)));
    }
  }
}
__device__ __forceinline__ void ph_tables(float* tab) {
  for (int j = blockIdx.x * 256 + threadIdx.x; j < 8192; j += gridDim.x * 256) {
    double a = 6.283185307179586476925286766559 * (double)j / 8192.0;
    tab[j] = (float)cos(a);
    tab[8192 + j] = (float)sin(a);
  }
}
__device__ __forceinline__ void ph_ada(const float* __restrict__ c, const float* __restrict__ c_ctx, const float* __restrict__ ada_w,
                       const float* __restrict__ ada_b, float* __restrict__ M) {
  for (int gid = blockIdx.x * 256 + threadIdx.x; gid < 2 * 3 * 6144; gid += gridDim.x * 256) {
    int col = gid % 6144; int idx = (gid / 6144) % 3; int layer = gid / (3 * 6144);
    const float* vec = idx < 2 ? c + idx * D : c_ctx;
    const float* w = ada_w + (size_t)layer * D * 6144 + col;
    float acc = 0.f;
    for (int k = 0; k < D; ++k) {
      float x = vec[k];
      float sx = x / (1.f + expf(-x));
      acc += sx * w[(size_t)k * 6144];
    }
    M[gid] = acc + ada_b[layer * 6144 + col];
  }
}

__device__ __forceinline__ void ph_modulate(const float* __restrict__ xa, const float* __restrict__ xb, const float* __restrict__ M, int layer,
                            int jshift, int jscale, bf16_t* __restrict__ out, int nrows, float* red) {
  int tid = threadIdx.x;
  GRID_LOOP(row, nrows) {
    const float* x = row < T ? xa + (size_t)row * D : xb + (size_t)(row - T) * D;
    float v[4]; float s = 0.f;
#pragma unroll
    for (int i = 0; i < 4; ++i) { v[i] = x[tid + 256 * i]; s += v[i]; }
    s = wave_sum(s);
    __syncthreads();
    if ((tid & 63) == 0) red[tid >> 6] = s;
    __syncthreads();
    float mu = (red[0] + red[1] + red[2] + red[3]) * (1.f / D);
    float q = 0.f;
#pragma unroll
    for (int i = 0; i < 4; ++i) { float d = v[i] - mu; q += d * d; }
    q = wave_sum(q);
    if ((tid & 63) == 0) red[4 + (tid >> 6)] = q;
    __syncthreads();
    float var = (red[4] + red[5] + red[6] + red[7]) * (1.f / D);
    float rs = rsqrtf(var + LN_EPS);
    const float* m = M + ((size_t)layer * 3 + mod_index(row)) * 6144;
#pragma unroll
    for (int i = 0; i < 4; ++i) {
      int col = tid + 256 * i;
      float y = (v[i] - mu) * rs;
      out[(size_t)row * D + col] = (bf16_t)f2bf(y * (1.f + m[jscale * D + col]) + m[jshift * D + col]);
    }
  }
}

__device__ __forceinline__ void ph_post(const float* __restrict__ xa, const float* __restrict__ xb, const float* __restrict__ Y,
                        const float* __restrict__ M, int layer, int j, const float* __restrict__ g, const float* __restrict__ bb,
                        float* __restrict__ outa, float* __restrict__ outb, int nrows, float* red) {
  int tid = threadIdx.x;
  GRID_LOOP(row, nrows) {
    const float* x = row < T ? xa + (size_t)row * D : xb + (size_t)(row - T) * D;
    float* out = row < T ? outa + (size_t)row * D : outb + (size_t)(row - T) * D;
    const float* m = M + ((size_t)layer * 3 + mod_index(row)) * 6144 + j * D;
    float v[4]; float s = 0.f;
#pragma unroll
    for (int i = 0; i < 4; ++i) { int col = tid + 256 * i; v[i] = DN_ALPHA * x[col] + m[col] * Y[(size_t)row * D + col]; s += v[i]; }
    s = wave_sum(s);
    __syncthreads();
    if ((tid & 63) == 0) red[tid >> 6] = s;
    __syncthreads();
    float mu = (red[0] + red[1] + red[2] + red[3]) * (1.f / D);
    float q = 0.f;
#pragma unroll
    for (int i = 0; i < 4; ++i) { float d = v[i] - mu; q += d * d; }
    q = wave_sum(q);
    if ((tid & 63) == 0) red[4 + (tid >> 6)] = q;
    __syncthreads();
    float var = (red[4] + red[5] + red[6] + red[7]) * (1.f / D);
    float rs = rsqrtf(var + LN_EPS);
#pragma unroll
    for (int i = 0; i < 4; ++i) {
      int col = tid + 256 * i;
      out[col] = (v[i] - mu) * rs * g[col] + bb[col];
    }
  }
}

struct ARow { const float* A; int lda; __device__ float operator()(int m, int k) const { return A[(size_t)m * lda + k]; } };
struct BRow { const float* B; int ldb; __device__ float operator()(int k, int n) const { return B[(size_t)k * ldb + n]; } };
struct CRow { float* C; int ldc; float scale; __device__ void operator()(int m, int n, float v) const { C[(size_t)m * ldc + n] = v * scale; } };
struct CRowB { bf16_t* C; int ldc; float scale; __device__ void operator()(int m, int n, float v) const { C[(size_t)m * ldc + n] = (bf16_t)f2bf(v * scale); } };
struct ADft { const float* tab; int Sn; int stride; __device__ float operator()(int m, int k) const {
    int t = k & (Sn - 1); int idx = ((m * t) & (Sn - 1)) * stride;
    return k < Sn ? tab[idx] : -tab[8192 + idx]; } };
struct BPQ { const float* PQ; int rowbase; int Sn; __device__ float operator()(int k, int n) const {
    int t = k & (Sn - 1); return PQ[(size_t)(rowbase + t) * 1024 + (k >= Sn ? 512 : 0) + n]; } };

template <class AF, class BF, class CF>
__device__ __forceinline__ void ph_gemm(AF af, BF bf, CF cf, int M, int N, int K, float* sm) {
  float (*sA)[68] = (float (*)[68])sm;
  float (*sB)[68] = (float (*)[68])(sm + 16 * 68);
  int tid = threadIdx.x; int tx = tid & 15, ty = tid >> 4;
  int ntn = N / 64; int ntiles = (M / 64) * ntn;
  GRID_LOOP(tile, ntiles) {
    int m0 = (tile / ntn) * 64, n0 = (tile % ntn) * 64;
    float acc[4][4];
#pragma unroll
    for (int i = 0; i < 4; ++i)
#pragma unroll
      for (int j = 0; j < 4; ++j) acc[i][j] = 0.f;
    for (int k0 = 0; k0 < K; k0 += 16) {
      __syncthreads();
#pragma unroll
      for (int i = 0; i < 4; ++i) { int e = tid + 256 * i; int m = e >> 4, k = e & 15; sA[k][m] = af(m0 + m, k0 + k); }
#pragma unroll
      for (int i = 0; i < 4; ++i) { int e = tid + 256 * i; int k = e >> 6, n = e & 63; sB[k][n] = bf(k0 + k, n0 + n); }
      __syncthreads();
#pragma unroll
      for (int k = 0; k < 16; ++k) {
        float a[4], b[4];
#pragma unroll
        for (int i = 0; i < 4; ++i) { a[i] = sA[k][ty * 4 + i]; b[i] = sB[k][tx * 4 + i]; }
#pragma unroll
        for (int i = 0; i < 4; ++i)
#pragma unroll
          for (int j = 0; j < 4; ++j) acc[i][j] += a[i] * b[j];
      }
    }
#pragma unroll
    for (int i = 0; i < 4; ++i)
#pragma unroll
      for (int j = 0; j < 4; ++j) cf(m0 + ty * 4 + i, n0 + tx * 4 + j, acc[i][j]);
  }
}


__device__ __forceinline__ void ph_transpose_w(const float* __restrict__ W, int K, int N, bf16_t* __restrict__ Wt, float* sm) {
  int tid = threadIdx.x;
  int tk = K / 64, tn = N / 64;
  GRID_LOOP(tile, tk * tn) {
    int k0 = (tile / tn) * 64, n0 = (tile % tn) * 64;
    __syncthreads();
#pragma unroll
    for (int i = 0; i < 16; ++i) { int e = tid + 256 * i; int k = e >> 6, n = e & 63; sm[k * 65 + n] = W[(size_t)(k0 + k) * N + n0 + n]; }
    __syncthreads();
#pragma unroll
    for (int i = 0; i < 2; ++i) {
      int e = tid + 256 * i; int n = e >> 3, kc = e & 7;
      unsigned w[4];
#pragma unroll
      for (int j = 0; j < 4; ++j) w[j] = pack2bf(sm[(kc * 8 + 2 * j) * 65 + n], sm[(kc * 8 + 2 * j + 1) * 65 + n]);
      *(uint4*)(Wt + (size_t)(n0 + n) * K + k0 + kc * 8) = make_uint4(w[0], w[1], w[2], w[3]);
    }
  }
}
__device__ __forceinline__ void ph_convert(const float* __restrict__ src, bf16_t* __restrict__ dst, size_t n8) {
  for (size_t i = (size_t)blockIdx.x * 256 + threadIdx.x; i < n8; i += (size_t)gridDim.x * 256) {
    float4 a = ((const float4*)src)[2 * i], b = ((const float4*)src)[2 * i + 1];
    ((uint4*)dst)[i] = make_uint4(pack2bf(a.x, a.y), pack2bf(a.z, a.w), pack2bf(b.x, b.y), pack2bf(b.z, b.w));
  }
}

__device__ __forceinline__ void gemm_stage(const bf16_t* __restrict__ A, int lda, int k0, char* lds, int tid) {
#pragma unroll
  for (int i = 0; i < 4; ++i) {
    int q = tid + 256 * i; int row = q >> 3, p = q & 7; int c = p ^ ((row >> 1) & 7);
    const bf16_t* src = A + (size_t)row * lda + k0 + c * 8;
    __builtin_amdgcn_global_load_lds((const unsigned*)src, (unsigned*)(lds + q * 16), 16, 0, 0);
  }
}
struct EpiF32 {
  float* C; int ldc; float scale;
  __device__ __forceinline__ void operator()(int m0, int n0, int wm, int wn, f32x16 (&acc)[2][2], int tid, char* smem) const {
    int lane = tid & 63;
    float* t = (float*)smem;
    int rbase = wm * 64 + 4 * (lane >> 5), cbase = wn * 64 + (lane & 31);
#pragma unroll
    for (int mi = 0; mi < 2; ++mi)
#pragma unroll
      for (int ni = 0; ni < 2; ++ni)
#pragma unroll
        for (int r = 0; r < 16; ++r)
          t[(rbase + mi * 32 + (r & 3) + 8 * (r >> 2)) * 128 + cbase + ni * 32] = acc[mi][ni][r] * scale;
    __syncthreads();
    float* dst = C + (size_t)(m0 + (tid >> 5)) * ldc + n0 + (tid & 31) * 4;
    const float* src = t + (tid >> 5) * 128 + (tid & 31) * 4;
#pragma unroll 4
    for (int i = 0; i < 16; ++i) {
      *(float4*)dst = *(const float4*)src;
      dst += (size_t)8 * ldc; src += 8 * 128;
    }
  }
};
struct EpiQKV0 {
  bf16_t* FQKV; bf16_t* VT;
  __device__ __forceinline__ void operator()(int m0, int n0, int wm, int wn, f32x16 (&acc)[2][2], int tid, char* smem) const {
    int lane = tid & 63;
    bf16_t* t = (bf16_t*)smem;
    int rbase = wm * 64 + 4 * (lane >> 5), cbase = wn * 64 + (lane & 31);
#pragma unroll
    for (int mi = 0; mi < 2; ++mi)
#pragma unroll
      for (int ni = 0; ni < 2; ++ni)
#pragma unroll
        for (int r = 0; r < 16; ++r)
          t[(rbase + mi * 32 + (r & 3) + 8 * (r >> 2)) * 136 + cbase + ni * 32] = (bf16_t)f2bf(acc[mi][ni][r]);
    __syncthreads();
    {
      bf16_t* dst = FQKV + (size_t)(m0 + (tid >> 4)) * 2048 + n0 + (tid & 15) * 8;
      const bf16_t* src = t + (tid >> 4) * 136 + (tid & 15) * 8;
#pragma unroll 4
      for (int i = 0; i < 8; ++i) {
        *(uint4*)dst = *(const uint4*)src;
        dst += (size_t)16 * 2048; src += 16 * 136;
      }
    }
    if (n0 >= 1536) {
      int col = tid >> 1, half = tid & 1;
      int hd = (n0 - 1536) / 64 + (col >> 6), d = col & 63;
      bf16_t* dst;
      if (m0 < T) { int b = m0 / S, t0 = m0 % S; dst = VT + (((size_t)b * 8 + hd) * 64 + d) * S + t0 + half * 64; }
      else { int mm = m0 - T; int b = mm / CL, l0 = mm % CL; dst = VT + (size_t)NB * 8 * 64 * S + (((size_t)b * 8 + hd) * 64 + d) * CL + l0 + half * 64; }
      const bf16_t* src = t + (half * 64) * 136 + col;
#pragma unroll
      for (int i = 0; i < 8; ++i) {
        unsigned wv[4];
#pragma unroll
        for (int j = 0; j < 4; ++j) wv[j] = (unsigned)src[(i * 8 + 2 * j) * 136] | ((unsigned)src[(i * 8 + 2 * j + 1) * 136] << 16);
        *(uint4*)(dst + i * 8) = make_uint4(wv[0], wv[1], wv[2], wv[3]);
      }
    }
  }
};
__device__ __forceinline__ void gemm_tile_mainloop(const bf16_t* __restrict__ Ag, int lda, const bf16_t* __restrict__ Bg, int ldb, int KT,
                                                   f32x16 (&acc)[2][2], char* smem) {
  int tid = threadIdx.x;
  asm volatile("" : "+v"(tid));
  int lane = tid & 63, wave = tid >> 6, wm = wave >> 1, wn = wave & 1;
#pragma unroll
  for (int mi = 0; mi < 2; ++mi)
#pragma unroll
    for (int ni = 0; ni < 2; ++ni)
#pragma unroll
      for (int r = 0; r < 16; ++r) acc[mi][ni][r] = 0.f;
  __syncthreads();
  gemm_stage(Ag, lda, 0, smem, tid); gemm_stage(Bg, ldb, 0, smem + 16384, tid);
  for (int kt = 0; kt < KT; ++kt) {
    asm volatile("s_waitcnt vmcnt(0)" ::: "memory");
    __syncthreads();
    char* cur = smem + (kt & 1) * 32768;
    if (kt + 1 < KT) {
      char* nxt = smem + ((kt + 1) & 1) * 32768;
      gemm_stage(Ag, lda, (kt + 1) * 64, nxt, tid); gemm_stage(Bg, ldb, (kt + 1) * 64, nxt + 16384, tid);
    }
#pragma unroll
    for (int s4 = 0; s4 < 4; ++s4) {
      bf16x8 a[2], b[2];
      int c = 2 * s4 + (lane >> 5);
#pragma unroll
      for (int mi = 0; mi < 2; ++mi) { int row = wm * 64 + mi * 32 + (lane & 31); a[mi] = *(const bf16x8*)(cur + row * 128 + ((c ^ ((row >> 1) & 7)) << 4)); }
#pragma unroll
      for (int ni = 0; ni < 2; ++ni) { int row = wn * 64 + ni * 32 + (lane & 31); b[ni] = *(const bf16x8*)(cur + 16384 + row * 128 + ((c ^ ((row >> 1) & 7)) << 4)); }
#pragma unroll
      for (int mi = 0; mi < 2; ++mi)
#pragma unroll
        for (int ni = 0; ni < 2; ++ni) acc[mi][ni] = __builtin_amdgcn_mfma_f32_32x32x16_bf16(a[mi], b[ni], acc[mi][ni], 0, 0, 0);
    }
  }
  __syncthreads();
}
template <class Epi>
__device__ __forceinline__ void ph_gemm_bf16(const bf16_t* __restrict__ A, int lda, const bf16_t* __restrict__ Bt, int ldb, int M, int N, int K,
                             Epi epi, char* smem) {
  int tid = threadIdx.x, wave = tid >> 6, wm = wave >> 1, wn = wave & 1;
  int ntn = N / 128, ntiles = (M / 128) * ntn;
  int KT = K / 64;
  GRID_LOOP(tile, ntiles) {
    int mt = tile / ntn, nt = tile % ntn;
    f32x16 acc[2][2];
    gemm_tile_mainloop(A + (size_t)mt * 128 * lda, lda, Bt + (size_t)nt * 128 * ldb, ldb, KT, acc, smem);
    epi(mt * 128, nt * 128, wm, wn, acc, tid, smem);
  }
}

__device__ __forceinline__ void ins16(float (&L)[16], float x) {
#pragma unroll
  for (int j = 15; j >= 1; --j) L[j] = __builtin_amdgcn_fmed3f(L[j - 1], L[j], x);
  L[0] = fmaxf(L[0], x);
}
__device__ __forceinline__ void stage_tile128(const bf16_t* __restrict__ src, int ld, char* lds, int tid) {
#pragma unroll
  for (int i = 0; i < 8; ++i) {
    int q = tid + 256 * i; int row = q >> 4, p = q & 15; int c = p ^ (row & 15);
    __builtin_amdgcn_global_load_lds((const unsigned*)(src + (size_t)row * ld + c * 8), (unsigned*)(lds + q * 16), 16, 0, 0);
  }
}
__device__ __forceinline__ void ph_peer_select(const bf16_t* __restrict__ H, const bf16_t* __restrict__ WQl, const bf16_t* __restrict__ SKl,
                                               int* __restrict__ EXP, float* __restrict__ GATE, int nrows, char* smem) {
  int tid = threadIdx.x, w = tid >> 6, wm = w >> 1, wn = w & 1;
  bf16_t* Qs = (bf16_t*)smem;
  int* KL = (int*)(smem + 36864);
  int nunits = (nrows / 128) * 8;
  GRID_LOOP(unit, nunits) {
    int mt = unit >> 3, h = unit & 7;
    float L0[16], L1[16];
#pragma unroll
    for (int p = 0; p < 2; ++p) {
      f32x16 acc[2][2];
      gemm_tile_mainloop(H + (size_t)mt * 128 * 1024, 1024, WQl + (size_t)(h * 256 + p * 128) * 1024, 1024, 16, acc, smem);
      int lane = tid & 63;
      asm volatile("" : "+v"(lane));
      {
        bf16_t* qw = Qs + (wm * 64 + 4 * (lane >> 5)) * 136 + wn * 64 + (lane & 31);
#pragma unroll
        for (int mi = 0; mi < 2; ++mi)
#pragma unroll
          for (int ni = 0; ni < 2; ++ni)
#pragma unroll
            for (int r = 0; r < 16; ++r)
              qw[(mi * 32 + (r & 3) + 8 * (r >> 2)) * 136 + ni * 32] = (bf16_t)f2bf(acc[mi][ni][r]);
      }
      __syncthreads();
      f32x16 sc[4];
#pragma unroll
      for (int m4 = 0; m4 < 4; ++m4)
#pragma unroll
        for (int r = 0; r < 16; ++r) sc[m4][r] = 0.f;
      {
        const bf16_t* qrow = Qs + (32 * w + (lane & 31)) * 136 + 8 * (lane >> 5);
        const bf16_t* krow = SKl + (size_t)(h * 2 + p) * 128 * 128 + (lane & 31) * 128 + 8 * (lane >> 5);
#pragma unroll
        for (int s8 = 0; s8 < 8; ++s8) {
          bf16x8 bq = *(const bf16x8*)(qrow + 16 * s8);
#pragma unroll
          for (int m4 = 0; m4 < 4; ++m4) {
            bf16x8 ak = *(const bf16x8*)(krow + m4 * 32 * 128 + 16 * s8);
            sc[m4] = __builtin_amdgcn_mfma_f32_32x32x16_bf16(ak, bq, sc[m4], 0, 0, 0);
          }
        }
      }
      float L[16];
#pragma unroll
      for (int j = 0; j < 16; ++j) L[j] = -INFINITY;
      unsigned kb = 4u * (unsigned)(lane >> 5);
#pragma unroll
      for (int m4 = 0; m4 < 4; ++m4)
#pragma unroll
        for (int r = 0; r < 16; ++r) {
          unsigned key = kb + (unsigned)(32 * m4 + (r & 3) + 8 * (r >> 2));
          float x = __uint_as_float((__float_as_uint(sc[m4][r]) & 0xFFFFFF80u) | key);
          ins16(L, x);
        }
      float P[16];
#pragma unroll
      for (int j = 0; j < 16; ++j) P[j] = __shfl_xor(L[j], 32);
#pragma unroll
      for (int j = 0; j < 16; ++j) ins16(L, P[j]);
      if (p == 0) {
#pragma unroll
        for (int j = 0; j < 16; ++j) L0[j] = L[j];
      } else {
#pragma unroll
        for (int j = 0; j < 16; ++j) L1[j] = L[j];
      }
    }
    float C[16];
#pragma unroll
    for (int j = 0; j < 16; ++j) C[j] = -INFINITY;
#pragma unroll
    for (int a = 0; a < 16; ++a)
#pragma unroll
      for (int b = 0; b < 16; ++b)
        if ((a + 1) * (b + 1) <= 16) {
          float sa = __uint_as_float(__float_as_uint(L0[a]) & 0xFFFFFF80u);
          float sb = __uint_as_float(__float_as_uint(L1[b]) & 0xFFFFFF80u);
          float x = __uint_as_float((__float_as_uint(sa + sb) & 0xFFFFFF00u) | (unsigned)(a * 16 + b));
          ins16(C, x);
        }
    int lane = tid & 63;
    asm volatile("" : "+v"(lane));
    int token = 32 * w + (lane & 31);
    if (lane < 32) {
#pragma unroll
      for (int j = 0; j < 16; ++j) { KL[token * 32 + j] = (int)(__float_as_uint(L0[j]) & 0x7Fu); KL[token * 32 + 16 + j] = (int)(__float_as_uint(L1[j]) & 0x7Fu); }
    }
    __syncthreads();
    if (lane < 32) {
      float c0 = __uint_as_float(__float_as_uint(C[0]) & 0xFFFFFF00u);
      float ev[16]; float sum = 0.f; int ex[16];
#pragma unroll
      for (int j = 0; j < 16; ++j) {
        unsigned bits = __float_as_uint(C[j]);
        float cv = __uint_as_float(bits & 0xFFFFFF00u);
        ev[j] = __expf(cv - c0); sum += ev[j];
        int a = (bits >> 4) & 15, b = bits & 15;
        ex[j] = KL[token * 32 + a] * 128 + KL[token * 32 + 16 + b];
      }
      float inv = 1.f / sum;
      size_t o = (size_t)(mt * 128 + token) * 128 + h * 16;
#pragma unroll
      for (int j = 0; j < 16; j += 4) {
        *(int4*)(EXP + o + j) = make_int4(ex[j], ex[j + 1], ex[j + 2], ex[j + 3]);
        *(float4*)(GATE + o + j) = make_float4(ev[j] * inv, ev[j + 1] * inv, ev[j + 2] * inv, ev[j + 3] * inv);
      }
    }
  }
}

__device__ __forceinline__ void fft1_unit(int u, const bf16_t* __restrict__ FQKV, const bf16_t* __restrict__ D1, const float* __restrict__ TAB,
                          bf16_t* __restrict__ A1, char* smem) {
  int tid = threadIdx.x, lane = tid & 63, w = tid >> 6;
  int g = u & 7, c = (u >> 3) & 63, b = u >> 9;
  bf16_t* Bt = (bf16_t*)smem;
  __syncthreads();
  {
    int r = tid >> 1, half = tid & 1;
    const uint4* src = (const uint4*)(FQKV + (size_t)(b * S + 64 * r + c) * 2048 + g * 64 + half * 32);
    unsigned wv[16];
#pragma unroll
    for (int i = 0; i < 4; ++i) { uint4 v = src[i]; wv[4 * i] = v.x; wv[4 * i + 1] = v.y; wv[4 * i + 2] = v.z; wv[4 * i + 3] = v.w; }
#pragma unroll
    for (int j = 0; j < 32; ++j) {
      unsigned e = (j & 1) ? (wv[j >> 1] >> 16) : (wv[j >> 1] & 0xffffu);
      Bt[(half * 32 + j) * 136 + r] = (bf16_t)e;
    }
  }
  __syncthreads();
  f32x16 acc[2][2];
#pragma unroll
  for (int mi = 0; mi < 2; ++mi)
#pragma unroll
    for (int ni = 0; ni < 2; ++ni)
#pragma unroll
      for (int r = 0; r < 16; ++r) acc[mi][ni][r] = 0.f;
#pragma unroll
  for (int s8 = 0; s8 < 8; ++s8) {
    bf16x8 a[2], bb[2];
    int ko = 16 * s8 + 8 * (lane >> 5);
#pragma unroll
    for (int mi = 0; mi < 2; ++mi) a[mi] = *(const bf16x8*)(D1 + (64 * w + 32 * mi + (lane & 31)) * 128 + ko);
#pragma unroll
    for (int ni = 0; ni < 2; ++ni) bb[ni] = *(const bf16x8*)(Bt + (32 * ni + (lane & 31)) * 136 + ko);
#pragma unroll
    for (int mi = 0; mi < 2; ++mi)
#pragma unroll
      for (int ni = 0; ni < 2; ++ni) acc[mi][ni] = __builtin_amdgcn_mfma_f32_32x32x16_bf16(a[mi], bb[ni], acc[mi][ni], 0, 0, 0);
  }
#pragma unroll
  for (int mi = 0; mi < 2; ++mi)
#pragma unroll
    for (int j = 0; j < 8; ++j) {
      int m = 64 * w + 32 * mi + ((2 * j) & 3) + 8 * ((2 * j) >> 2) + 4 * (lane >> 5);
      int k1 = m >> 1;
      int idx = (k1 * c) & 8191;
      float cs = TAB[idx], sn = TAB[8192 + idx];
#pragma unroll
      for (int ni = 0; ni < 2; ++ni) {
        float re = acc[mi][ni][2 * j], im = acc[mi][ni][2 * j + 1];
        float re2 = re * cs + im * sn, im2 = im * cs - re * sn;
        bf16_t* dst = A1 + ((((size_t)b * 64 + c) * 128 + k1) * 2) * 512 + g * 64 + 32 * ni + (lane & 31);
        dst[0] = (bf16_t)f2bf(re2); dst[512] = (bf16_t)f2bf(im2);
      }
    }
}

__device__ __forceinline__ void fft3_unit(int u, int mode, const bf16_t* __restrict__ FQKV, const bf16_t* __restrict__ A1, const bf16_t* __restrict__ D3,
                          const bf16_t* __restrict__ DcT, const float* __restrict__ TAB, bf16_t* __restrict__ MIX, char* smem) {
  int tid = threadIdx.x, lane = tid & 63, w = tid >> 6;
  bf16_t* Bt = (bf16_t*)smem;
  bf16_t* Xs = (bf16_t*)(smem + 17408);
  int g = u & 7, k1, b, nk1, rowbase; float norm;
  __syncthreads();
  if (mode == 0) {
    k1 = (u >> 3) & 127; b = u >> 10; nk1 = 128; rowbase = b * S; norm = 1.f / 724.0773439350247f;
    int kk = tid >> 1, half = tid & 1; int c = kk >> 1, ri = kk & 1;
    const uint4* src = (const uint4*)(A1 + ((((size_t)b * 64 + c) * 128 + k1) * 2 + ri) * 512 + g * 64 + half * 32);
    unsigned wv[16];
#pragma unroll
    for (int i = 0; i < 4; ++i) { uint4 v = src[i]; wv[4 * i] = v.x; wv[4 * i + 1] = v.y; wv[4 * i + 2] = v.z; wv[4 * i + 3] = v.w; }
#pragma unroll
    for (int j = 0; j < 32; ++j) {
      unsigned e = (j & 1) ? (wv[j >> 1] >> 16) : (wv[j >> 1] & 0xffffu);
      Bt[(half * 32 + j) * 136 + kk] = (bf16_t)e;
    }
  } else {
    k1 = (u >> 3) & 3; b = u >> 5; nk1 = 4; rowbase = T + b * CL; norm = 1.f / 128.f;
    int c = tid >> 2, q4 = tid & 3;
    float re[16], im[16];
#pragma unroll
    for (int j = 0; j < 16; ++j) { re[j] = 0.f; im[j] = 0.f; }
#pragma unroll
    for (int r = 0; r < 4; ++r) {
      const uint4* src = (const uint4*)(FQKV + (size_t)(rowbase + 64 * r + c) * 2048 + g * 64 + q4 * 16);
      uint4 v0 = src[0], v1 = src[1];
      unsigned wv[8] = {v0.x, v0.y, v0.z, v0.w, v1.x, v1.y, v1.z, v1.w};
      int ph = (k1 * r) & 3;
      float cr = (ph == 0) ? 1.f : (ph == 2 ? -1.f : 0.f);
      float ci = (ph == 1) ? -1.f : (ph == 3 ? 1.f : 0.f);
#pragma unroll
      for (int j = 0; j < 16; ++j) {
        float x = bf2f((unsigned short)((j & 1) ? (wv[j >> 1] >> 16) : (wv[j >> 1] & 0xffffu)));
        re[j] += x * cr; im[j] += x * ci;
      }
    }
    int idx = (k1 * c * 32) & 8191;
    float cs = TAB[idx], sn = TAB[8192 + idx];
#pragma unroll
    for (int j = 0; j < 16; ++j) {
      float re2 = re[j] * cs + im[j] * sn, im2 = im[j] * cs - re[j] * sn;
      *(unsigned*)(Bt + (q4 * 16 + j) * 136 + 2 * c) = pack2bf(re2, im2);
    }
  }
  __syncthreads();
  {
    f32x16 acc[2];
#pragma unroll
    for (int ni = 0; ni < 2; ++ni)
#pragma unroll
      for (int r = 0; r < 16; ++r) acc[ni][r] = 0.f;
#pragma unroll
    for (int s8 = 0; s8 < 8; ++s8) {
      int ko = 16 * s8 + 8 * (lane >> 5);
      bf16x8 a = *(const bf16x8*)(D3 + (32 * w + (lane & 31)) * 128 + ko);
#pragma unroll
      for (int ni = 0; ni < 2; ++ni) {
        bf16x8 bb = *(const bf16x8*)(Bt + (32 * ni + (lane & 31)) * 136 + ko);
        acc[ni] = __builtin_amdgcn_mfma_f32_32x32x16_bf16(a, bb, acc[ni], 0, 0, 0);
      }
    }
#pragma unroll
    for (int ni = 0; ni < 2; ++ni)
#pragma unroll
      for (int r = 0; r < 16; ++r) {
        int m = 32 * w + (r & 3) + 8 * (r >> 2) + 4 * (lane >> 5);
        Xs[(m & 63) * 136 + (m >> 6) * 64 + 32 * ni + (lane & 31)] = (bf16_t)f2bf(acc[ni][r]);
      }
  }
  __syncthreads();
  {
    int mi = w >> 1, ni = w & 1;
    f32x16 acc;
#pragma unroll
    for (int r = 0; r < 16; ++r) acc[r] = 0.f;
#pragma unroll
    for (int s8 = 0; s8 < 8; ++s8) {
      int ko = 16 * s8 + 8 * (lane >> 5);
      bf16x8 a = *(const bf16x8*)(Xs + (32 * mi + (lane & 31)) * 136 + ko);
      bf16x8 bb = *(const bf16x8*)(DcT + (32 * ni + (lane & 31)) * 128 + ko);
      acc = __builtin_amdgcn_mfma_f32_32x32x16_bf16(a, bb, acc, 0, 0, 0);
    }
#pragma unroll
    for (int r = 0; r < 16; ++r) {
      int k2 = 32 * mi + (r & 3) + 8 * (r >> 2) + 4 * (lane >> 5);
      int row = rowbase + k1 + nk1 * k2;
      MIX[(size_t)row * 1024 + g * 64 + 32 * ni + (lane & 31)] = (bf16_t)f2bf(acc[r] * norm);
    }
  }
}

__device__ __forceinline__ void ph_chan_dft(const float* __restrict__ F, const float* __restrict__ tab, float* __restrict__ PQ) {
  for (int gid = blockIdx.x * 256 + threadIdx.x; gid < R * 512; gid += gridDim.x * 256) {
    int row = gid >> 9; int col = gid & 511; int g = col >> 6, cp = col & 63;
    const float* f = F + (size_t)row * 2048 + g * 64;
    float p = 0.f, q = 0.f;
    for (int ch = 0; ch < 64; ++ch) {
      int idx = ((ch * cp) & 63) * 128;
      float x = f[ch];
      p += x * tab[idx]; q += x * tab[8192 + idx];
    }
    PQ[(size_t)row * 1024 + col] = p;
    PQ[(size_t)row * 1024 + 512 + col] = q;
  }
}

__device__ __forceinline__ void ph_na(const bf16_t* __restrict__ F, const float* __restrict__ rpb, bf16_t* __restrict__ MIX, float* sm) {
  int lane = threadIdx.x & 63, wave = threadIdx.x >> 6;
  float* sq = sm + wave * 1024; float* sp = sq + 64; int* stok = (int*)(sp + 384);
  int nitems = R * 8;
  for (int item0 = blockIdx.x * 4; item0 < nitems; item0 += gridDim.x * 4) {
    int item = item0 + wave;
    int h = item & 7; int row = item >> 3;
    bool is_ctx = row >= T;
    int b = is_ctx ? (row - T) / CL : row / S;
    __syncthreads();
    sq[lane] = bf2f(F[(size_t)row * 2048 + 512 + h * 64 + lane]);
    __syncthreads();
    int r = 0, c = 0, r_start = 0, c_start = 0;
    if (!is_ctx) { int t = row % S; r = t / 64; c = t % 64; r_start = min(max(r - 4, 0), 120); c_start = min(max(c - 8, 0), 48); }
    int nk = is_ctx ? 256 : 384;
    float lg[6]; float mx = -INFINITY;
#pragma unroll
    for (int kk = 0; kk < 6; ++kk) {
      int j = kk * 64 + lane; float s = -INFINITY; int tok = 0;
      if (j < nk) {
        float bias = 0.f;
        if (!is_ctx && j < 128) {
          int kr = j >> 4, kc = j & 15; int rr = r_start + kr, cc = c_start + kc;
          tok = b * S + rr * 64 + cc;
          int dc = min(max(cc - c, -15), 15) + 15;
          bias = rpb[(h * 15 + (rr - r + 7)) * 31 + dc];
        } else {
          int l = is_ctx ? j : j - 128; tok = T + b * CL + l;
        }
        const bf16_t* kp = F + (size_t)tok * 2048 + 1024 + h * 64;
        float acc = 0.f;
#pragma unroll 8
        for (int d = 0; d < 64; ++d) acc += sq[d] * bf2f(kp[d]);
        s = acc * 0.125f + bias;
      }
      lg[kk] = s; stok[j] = tok; mx = fmaxf(mx, s);
    }
    mx = wave_max(mx);
    float sum = 0.f;
#pragma unroll
    for (int kk = 0; kk < 6; ++kk) { float e = (kk * 64 + lane < nk) ? expf(lg[kk] - mx) : 0.f; lg[kk] = e; sum += e; }
    sum = wave_sum(sum);
    float inv = 1.f / sum;
#pragma unroll
    for (int kk = 0; kk < 6; ++kk) sp[kk * 64 + lane] = lg[kk] * inv;
    __syncthreads();
    float o = 0.f;
    for (int j = 0; j < nk; ++j) o += sp[j] * bf2f(F[(size_t)stok[j] * 2048 + 1536 + h * 64 + lane]);
    MIX[(size_t)row * 1024 + 512 + h * 64 + lane] = (bf16_t)f2bf(o);
  }
}

__device__ __forceinline__ void ph_rope(float* __restrict__ F1) {
  for (int gid = blockIdx.x * 256 + threadIdx.x; gid < T * 20 * 32; gid += gridDim.x * 256) {
    int i = gid & 31; int hh = (gid >> 5) % 20; int row = gid / (32 * 20);
    int t = row % S; float rowp = (float)(t / 64), colp = (float)(t % 64);
    int fi = i & 15;
    float inv_freq = powf(10000.0f, -(float)fi / 16.0f);
    float ang = (i < 16 ? rowp : colp) * inv_freq;
    float cs = cosf(ang), sn = sinf(ang);
    float* p = F1 + (size_t)row * 1536 + hh * 64;
    float x1 = p[i], x2 = p[i + 32];
    p[i] = x1 * cs - x2 * sn;
    p[i + 32] = x1 * sn + x2 * cs;
  }
}

__device__ __forceinline__ void ph_gqa(const float* __restrict__ F1, const float* __restrict__ sink, bf16_t* __restrict__ O, float* sm) {
  int lane = threadIdx.x & 63, wave = threadIdx.x >> 6;
  float* sq = sm + wave * 1280; float* sp = sq + 64; int* stok = (int*)(sp + 576);
  int nitems = T * 16;
  for (int item0 = blockIdx.x * 4; item0 < nitems; item0 += gridDim.x * 4) {
    int item = item0 + wave;
    int qh = item & 15; int row = item >> 4; int kvh = qh >> 2;
    int b = row / S; int t = row % S;
    __syncthreads();
    sq[lane] = F1[(size_t)row * 1536 + qh * 64 + lane];
    __syncthreads();
    float lg[9]; float mx = -INFINITY;
#pragma unroll
    for (int kk = 0; kk < 9; ++kk) {
      int j = kk * 64 + lane; float s = -INFINITY; int tok = 0; bool valid = false;
      if (j < 257) { int pos = t - 128 + j; valid = (pos >= 0 && pos < S); tok = b * S + pos; }
      else if (j < 513) { valid = true; tok = T + b * CL + (j - 257); }
      if (valid) {
        const float* kp = F1 + (size_t)tok * 1536 + 1024 + kvh * 64;
        float acc = 0.f;
#pragma unroll 8
        for (int d = 0; d < 64; ++d) acc += sq[d] * kp[d];
        s = acc * 0.125f;
      } else tok = 0;
      lg[kk] = s; stok[j] = tok; mx = fmaxf(mx, s);
    }
    mx = wave_max(mx);
    float sk = sink[qh];
    mx = fmaxf(mx, sk);
    float sum = 0.f;
#pragma unroll
    for (int kk = 0; kk < 9; ++kk) { float e = (lg[kk] == -INFINITY) ? 0.f : expf(lg[kk] - mx); lg[kk] = e; sum += e; }
    sum = wave_sum(sum) + expf(sk - mx);
    float inv = 1.f / sum;
#pragma unroll
    for (int kk = 0; kk < 9; ++kk) sp[kk * 64 + lane] = lg[kk] * inv;
    __syncthreads();
    float o = 0.f;
    for (int j = 0; j < 513; ++j) { float p = sp[j]; if (p != 0.f) o += p * F1[(size_t)stok[j] * 1536 + 1280 + kvh * 64 + lane]; }
    O[(size_t)row * 1024 + qh * 64 + lane] = (bf16_t)f2bf(o);
  }
}

__device__ __forceinline__ void wave_argmax(float& v, int& idx) {
#pragma unroll
  for (int off = 32; off; off >>= 1) {
    float ov = __shfl_xor(v, off); int oi = __shfl_xor(idx, off);
    if (ov > v || (ov == v && oi < idx)) { v = ov; idx = oi; }
  }
}
__device__ __forceinline__ void ph_peer_select_naive(const float* __restrict__ Q, const float* __restrict__ sk, int* __restrict__ EXP,
                                     float* __restrict__ GATE, int nrows, float* sm) {
  int lane = threadIdx.x & 63, wave = threadIdx.x >> 6;
  float* sq = sm + wave * 640; float* tops = sq + 256; int* topi = (int*)(tops + 32);
  for (int row0 = blockIdx.x * 4; row0 < nrows; row0 += gridDim.x * 4) {
    int row = row0 + wave;
    for (int h = 0; h < 8; ++h) {
      __syncthreads();
#pragma unroll
      for (int i = 0; i < 4; ++i) sq[lane + 64 * i] = Q[(size_t)row * 2048 + h * 256 + lane + 64 * i];
      __syncthreads();
      for (int p = 0; p < 2; ++p) {
        float s0 = 0.f, s1 = 0.f;
        const float* k0 = sk + ((size_t)((h * 2 + p) * 128 + lane)) * 128;
        const float* k1 = k0 + 64 * 128;
#pragma unroll 8
        for (int d = 0; d < 128; ++d) { float qv = sq[p * 128 + d]; s0 += qv * k0[d]; s1 += qv * k1[d]; }
        for (int i = 0; i < 16; ++i) {
          float v; int idx;
          if (s0 >= s1) { v = s0; idx = lane; } else { v = s1; idx = lane + 64; }
          wave_argmax(v, idx);
          if (lane == 0) { tops[p * 16 + i] = v; topi[p * 16 + i] = idx; }
          if (idx == lane) s0 = -INFINITY;
          if (idx == lane + 64) s1 = -INFINITY;
        }
      }
      __syncthreads();
      float cs[4];
#pragma unroll
      for (int i = 0; i < 4; ++i) { int ci = lane * 4 + i; cs[i] = tops[ci >> 4] + tops[16 + (ci & 15)]; }
      float bs[16]; int be[16];
#pragma unroll
      for (int k = 0; k < 16; ++k) {
        float v = cs[0]; int idx = lane * 4;
#pragma unroll
        for (int i = 1; i < 4; ++i) if (cs[i] > v) { v = cs[i]; idx = lane * 4 + i; }
        wave_argmax(v, idx);
        bs[k] = v; be[k] = topi[idx >> 4] * 128 + topi[16 + (idx & 15)];
#pragma unroll
        for (int i = 0; i < 4; ++i) if (idx == lane * 4 + i) cs[i] = -INFINITY;
      }
      float mxs = bs[0]; float sum = 0.f;
#pragma unroll
      for (int k = 0; k < 16; ++k) { bs[k] = expf(bs[k] - mxs); sum += bs[k]; }
      float inv = 1.f / sum;
      if (lane == 0) {
#pragma unroll
        for (int k = 0; k < 16; ++k) { EXP[(size_t)row * 128 + h * 16 + k] = be[k]; GATE[(size_t)row * 128 + h * 16 + k] = bs[k] * inv; }
      }
    }
  }
}

__device__ __forceinline__ void unpack8(uint4 v, float* f) {
  f[0] = __uint_as_float(v.x << 16); f[1] = __uint_as_float(v.x & 0xffff0000u);
  f[2] = __uint_as_float(v.y << 16); f[3] = __uint_as_float(v.y & 0xffff0000u);
  f[4] = __uint_as_float(v.z << 16); f[5] = __uint_as_float(v.z & 0xffff0000u);
  f[6] = __uint_as_float(v.w << 16); f[7] = __uint_as_float(v.w & 0xffff0000u);
}
__device__ __forceinline__ void ph_peer_gather(bf16_t* __restrict__ H, const int* __restrict__ EXP, const float* __restrict__ GATE,
                               const bf16_t* __restrict__ U, const bf16_t* __restrict__ V,
                               const float* __restrict__ xin, const float* __restrict__ M, int layer,
                               const float* __restrict__ g, const float* __restrict__ bb, float* __restrict__ xout,
                               bool write_next, int nrows) {
  int lane = threadIdx.x & 63, wave = threadIdx.x >> 6;
  for (int row = blockIdx.x * 4 + wave; row < nrows; row += gridDim.x * 4) {
    float hreg[16];
    {
      const uint4* hp = (const uint4*)(H + (size_t)row * D + 8 * lane);
      unpack8(hp[0], hreg); unpack8(hp[64], hreg + 8);
    }
    float acc[16];
#pragma unroll
    for (int i = 0; i < 16; ++i) acc[i] = 0.f;
    int e_lo = EXP[(size_t)row * 128 + lane], e_hi = EXP[(size_t)row * 128 + 64 + lane];
    float g_lo = GATE[(size_t)row * 128 + lane], g_hi = GATE[(size_t)row * 128 + 64 + lane];
    uint4 ua[4], ub[4], va[4], vb[4];
#pragma unroll
    for (int i = 0; i < 4; ++i) {
      int e = __builtin_amdgcn_readlane(e_lo, i);
      const uint4* up = (const uint4*)(U + (size_t)e * D + 8 * lane); ua[i] = up[0]; ub[i] = up[64];
    }
#pragma unroll 1
    for (int b = 0; b < 32; ++b) {
      int k0 = 4 * b;
      int ev = (b < 16) ? e_lo : e_hi; float gv = (b < 16) ? g_lo : g_hi;
      int en = (b + 1 < 16) ? e_lo : e_hi;
      float gt[4];
#pragma unroll
      for (int i = 0; i < 4; ++i) {
        int e = __builtin_amdgcn_readlane(ev, (k0 + i) & 63);
        gt[i] = __uint_as_float(__builtin_amdgcn_readlane(__float_as_uint(gv), (k0 + i) & 63));
        const uint4* vp = (const uint4*)(V + (size_t)e * D + 8 * lane); va[i] = vp[0]; vb[i] = vp[64];
      }
      float a[4];
#pragma unroll
      for (int i = 0; i < 4; ++i) {
        float f[16]; unpack8(ua[i], f); unpack8(ub[i], f + 8);
        float sacc = 0.f;
#pragma unroll
        for (int j = 0; j < 16; ++j) sacc += f[j] * hreg[j];
        a[i] = sacc;
      }
      if (b + 1 < 32) {
#pragma unroll
        for (int i = 0; i < 4; ++i) {
          int e = __builtin_amdgcn_readlane(en, (k0 + 4 + i) & 63);
          const uint4* up = (const uint4*)(U + (size_t)e * D + 8 * lane); ua[i] = up[0]; ub[i] = up[64];
        }
      }
#pragma unroll
      for (int i = 0; i < 4; ++i) a[i] = wave_sum(a[i]);
#pragma unroll
      for (int i = 0; i < 4; ++i) {
        float w = gt[i] * 0.5f * a[i] * (1.f + erff(a[i] * 0.70710678118654752f));
        float f[16]; unpack8(va[i], f); unpack8(vb[i], f + 8);
#pragma unroll
        for (int j = 0; j < 16; ++j) acc[j] += w * f[j];
      }
    }
    const float* m = M + ((size_t)layer * 3 + mod_index(row)) * 6144;
    const float* xr = xin + (size_t)row * D;
    float v[16];
#pragma unroll
    for (int hh = 0; hh < 2; ++hh) {
      int d0 = hh * 512 + 8 * lane;
      float4 x0 = *(const float4*)(xr + d0), x1 = *(const float4*)(xr + d0 + 4);
      float4 m0 = *(const float4*)(m + 5 * D + d0), m1 = *(const float4*)(m + 5 * D + d0 + 4);
      v[hh * 8 + 0] = DN_ALPHA * x0.x + m0.x * acc[hh * 8 + 0]; v[hh * 8 + 1] = DN_ALPHA * x0.y + m0.y * acc[hh * 8 + 1];
      v[hh * 8 + 2] = DN_ALPHA * x0.z + m0.z * acc[hh * 8 + 2]; v[hh * 8 + 3] = DN_ALPHA * x0.w + m0.w * acc[hh * 8 + 3];
      v[hh * 8 + 4] = DN_ALPHA * x1.x + m1.x * acc[hh * 8 + 4]; v[hh * 8 + 5] = DN_ALPHA * x1.y + m1.y * acc[hh * 8 + 5];
      v[hh * 8 + 6] = DN_ALPHA * x1.z + m1.z * acc[hh * 8 + 6]; v[hh * 8 + 7] = DN_ALPHA * x1.w + m1.w * acc[hh * 8 + 7];
    }
    float s = 0.f;
#pragma unroll
    for (int j = 0; j < 16; ++j) s += v[j];
    float mu = wave_sum(s) * (1.f / D);
    float q = 0.f;
#pragma unroll
    for (int j = 0; j < 16; ++j) { float d = v[j] - mu; q += d * d; }
    float rs = rsqrtf(wave_sum(q) * (1.f / D) + LN_EPS);
    float y[16];
#pragma unroll
    for (int hh = 0; hh < 2; ++hh) {
      int d0 = hh * 512 + 8 * lane;
#pragma unroll
      for (int j = 0; j < 8; ++j) y[hh * 8 + j] = (v[hh * 8 + j] - mu) * rs * g[d0 + j] + bb[d0 + j];
      *(float4*)(xout + (size_t)row * D + d0) = make_float4(y[hh * 8], y[hh * 8 + 1], y[hh * 8 + 2], y[hh * 8 + 3]);
      *(float4*)(xout + (size_t)row * D + d0 + 4) = make_float4(y[hh * 8 + 4], y[hh * 8 + 5], y[hh * 8 + 6], y[hh * 8 + 7]);
    }
    if (write_next) {
      const float* mn = M + ((size_t)(layer + 1) * 3 + mod_index(row)) * 6144;
      float s2 = 0.f;
#pragma unroll
      for (int j = 0; j < 16; ++j) s2 += y[j];
      float mu2 = wave_sum(s2) * (1.f / D);
      float q2 = 0.f;
#pragma unroll
      for (int j = 0; j < 16; ++j) { float d = y[j] - mu2; q2 += d * d; }
      float rs2 = rsqrtf(wave_sum(q2) * (1.f / D) + LN_EPS);
#pragma unroll
      for (int hh = 0; hh < 2; ++hh) {
        int d0 = hh * 512 + 8 * lane;
        float o[8];
#pragma unroll
        for (int j = 0; j < 8; ++j) o[j] = (y[hh * 8 + j] - mu2) * rs2 * (1.f + mn[D + d0 + j]) + mn[d0 + j];
        *(uint4*)(H + (size_t)row * D + d0) = make_uint4(pack2bf(o[0], o[1]), pack2bf(o[2], o[3]), pack2bf(o[4], o[5]), pack2bf(o[6], o[7]));
      }
    }
  }
}

constexpr int SMEM_BYTES = 65536;
#ifndef PHMASK
#define PHMASK 0xFFFFFFFFFFFFFFFFull
#endif
#define PH(n, ...) if constexpr ((((unsigned long long)(PHMASK)) >> (n)) & 1ull) { __VA_ARGS__; }

__global__ __launch_bounds__(256, 2) void mega(Params p) {
  cg::grid_group grid = cg::this_grid();
  __shared__ __attribute__((aligned(16))) char smem_raw[SMEM_BYTES];
  float* smem = (float*)smem_raw;
  const float* x = p.in[0]; const float* c = p.in[1]; const float* ctx = p.in[2]; const float* c_ctx = p.in[3];
  const float* ada_w = p.in[4]; const float* ada_b = p.in[5]; const float* ln_g = p.in[6]; const float* ln_b = p.in[7];
  const float* even_w_in = p.in[8]; const float* even_w_out = p.in[9]; const float* rpb = p.in[10];
  const float* odd_w_in = p.in[11]; const float* odd_w_out = p.in[12]; const float* sink = p.in[13];
  const float* peer_wq = p.in[14]; const float* peer_sk = p.in[15]; const float* peer_u = p.in[16]; const float* peer_v = p.in[17];
  char* ws = (char*)p.ws;
  float* TAB = (float*)(ws + OFF_TAB); float* Mm = (float*)(ws + OFF_M);
  bf16_t* WIN0 = (bf16_t*)(ws + OFF_WIN0); bf16_t* WOUT0 = (bf16_t*)(ws + OFF_WOUT0);
  bf16_t* WIN1 = (bf16_t*)(ws + OFF_WIN1); bf16_t* WOUT1 = (bf16_t*)(ws + OFF_WOUT1);
  bf16_t* WQ = (bf16_t*)(ws + OFF_WQ); bf16_t* SKB = (bf16_t*)(ws + OFF_SK);
  bf16_t* UB = (bf16_t*)(ws + OFF_UB); bf16_t* VB = (bf16_t*)(ws + OFF_VB);
  bf16_t* AB = (bf16_t*)(ws + OFF_AB);
  bf16_t* FD1 = (bf16_t*)(ws + OFF_FT); bf16_t* FD3 = FD1 + 256 * 128; bf16_t* FDC = FD3 + 128 * 128;
  bf16_t* A1 = (bf16_t*)(ws + OFF_A1); bf16_t* VT0 = (bf16_t*)(ws + OFF_VT0); bf16_t* FQKV = (bf16_t*)(ws + OFF_BF);
  float* BF_ = (float*)(ws + OFF_BF); float* BY = (float*)(ws + OFF_BY);
  float* X1 = (float*)(ws + OFF_X1); float* X2 = (float*)(ws + OFF_X2);
  int* EXPB = (int*)(ws + OFF_BY); float* GATEB = (float*)(ws + OFF_BY + (size_t)R * 128 * 4);
  float* out = p.out;

  PH(0, ph_tables(TAB))
  PH(1, ph_fft_tables(FD1, FD3, FDC))
  PH(2, ph_ada(c, c_ctx, ada_w, ada_b, Mm))
  PH(3, ph_transpose_w(even_w_in, 1024, 2048, WIN0, smem))
  PH(4, ph_transpose_w(even_w_out, 1024, 1024, WOUT0, smem))
  PH(5, ph_transpose_w(odd_w_in, 1024, 1536, WIN1, smem))
  PH(6, ph_transpose_w(odd_w_out, 1024, 1024, WOUT1, smem))
  PH(7, ph_transpose_w(peer_wq, 1024, 2048, WQ, smem))
  PH(8, ph_transpose_w(peer_wq + (size_t)1024 * 2048, 1024, 2048, WQ + (size_t)2048 * 1024, smem))
  PH(9, ph_convert(peer_u, UB, (size_t)2 * 16384 * 1024 / 8))
  PH(10, ph_convert(peer_v, VB, (size_t)2 * 16384 * 1024 / 8))
  PH(11, ph_convert(peer_sk, SKB, (size_t)2 * 8 * 2 * 128 * 128 / 8))
  grid.sync();
  PH(12, ph_modulate(x, ctx, Mm, 0, 0, 1, AB, R, smem))
  grid.sync();
  PH(13, ph_gemm_bf16(AB, 1024, WIN0, 1024, R, 2048, 1024, EpiQKV0{FQKV, VT0}, smem_raw))
  grid.sync();
  PH(14, { GRID_LOOP(u, NB * 64 * 8) fft1_unit(u, FQKV, FD1, TAB, A1, smem_raw); })
  PH(15, ph_na(FQKV, rpb, AB, smem))
  grid.sync();
  PH(16, { GRID_LOOP(u, NB * 128 * 8 + NB * 4 * 8) { if (u < NB * 128 * 8) fft3_unit(u, 0, FQKV, A1, FD3, FDC, TAB, AB, smem_raw); else fft3_unit(u - NB * 128 * 8, 1, FQKV, A1, FD3, FDC, TAB, AB, smem_raw); } })
  grid.sync();
  PH(17, ph_gemm_bf16(AB, 1024, WOUT0, 1024, R, 1024, 1024, EpiF32{BY, 1024, 1.f}, smem_raw))
  grid.sync();
  PH(18, ph_post(x, ctx, BY, Mm, 0, 2, ln_g + 0, ln_b + 0, X1, X1 + (size_t)T * D, R, smem))
  grid.sync();
  PH(19, ph_modulate(X1, X1 + (size_t)T * D, Mm, 0, 3, 4, AB, R, smem))
  grid.sync();
  PH(21, ph_peer_select(AB, WQ, SKB, EXPB, GATEB, R, smem_raw))
  grid.sync();
  PH(22, ph_peer_gather(AB, EXPB, GATEB, UB, VB, X1, Mm, 0, ln_g + 1024, ln_b + 1024, X2, true, R))
  grid.sync();
  PH(23, ph_gemm_bf16(AB, 1024, WIN1, 1024, R, 1536, 1024, EpiF32{BF_, 1536, 1.f}, smem_raw))
  grid.sync();
  PH(24, ph_rope(BF_))
  grid.sync();
  PH(25, ph_gqa(BF_, sink, AB, smem))
  grid.sync();
  PH(26, ph_gemm_bf16(AB, 1024, WOUT1, 1024, T, 1024, 1024, EpiF32{BY, 1024, 1.f}, smem_raw))
  grid.sync();
  PH(27, ph_post(X2, X2, BY, Mm, 1, 2, ln_g + 2048, ln_b + 2048, X1, X1, T, smem))
  grid.sync();
  PH(28, ph_modulate(X1, X1, Mm, 1, 3, 4, AB, T, smem))
  grid.sync();
  PH(30, ph_peer_select(AB, WQ + (size_t)2048 * 1024, SKB + (size_t)8 * 2 * 128 * 128, EXPB, GATEB, T, smem_raw))
  grid.sync();
  PH(31, ph_peer_gather(AB, EXPB, GATEB, UB + (size_t)16384 * 1024, VB + (size_t)16384 * 1024, X1, Mm, 1, ln_g + 3072, ln_b + 3072, out, false, T))
}

}

extern "C" void kernel_launch(void* const* d_in, const int* in_sizes, int n_in, void* d_out, int out_size, void* d_ws,
                              size_t ws_size, hipStream_t stream) {
  static int grid_blocks = 0;
  if (!grid_blocks) {
    int dev = 0, cus = 0, per_cu = 0;
    hipGetDevice(&dev);
    hipDeviceGetAttribute(&cus, hipDeviceAttributeMultiprocessorCount, dev);
    hipOccupancyMaxActiveBlocksPerMultiprocessor(&per_cu, (const void*)mega, 256, 0);
    if (per_cu > 2) per_cu = 2;
    if (per_cu < 1) per_cu = 1;
    grid_blocks = cus * per_cu;
  }
  Params p{};
  for (int i = 0; i < 18; ++i) p.in[i] = (const float*)d_in[i];
  p.out = (float*)d_out;
  p.ws = (float*)d_ws;
  void* args[] = {&p};
  hipError_t e = hipLaunchCooperativeKernel((const void*)mega, dim3(grid_blocks), dim3(256), args, 0, stream);
  if (e != hipSuccess) fprintf(stderr, "cooperative launch failed: %s (grid %d)\n", hipGetErrorString(e), grid_blocks);
}
```

```cpp
#include <hip/hip_runtime.h>
#include <hip/hip_bf16.h>
#include <stdint.h>
#include <math.h>
#include <stdio.h>
#include <hip/hip_cooperative_groups.h>
namespace cg = cooperative_groups;

namespace {

constexpr int D = 1024;
constexpr int NB = 2;
constexpr int S = 8192;
constexpr int T = NB * S;
constexpr int CL = 256;
constexpr int TC = NB * CL;
constexpr int R = T + TC;
constexpr float DN_ALPHA = 1.4142135623730951f;
constexpr float LN_EPS = 1e-6f;

__device__ __forceinline__ float wave_sum(float v) {
#pragma unroll
  for (int off = 32; off; off >>= 1) v += __shfl_xor(v, off);
  return v;
}
__device__ __forceinline__ float wave_max(float v) {
#pragma unroll
  for (int off = 32; off; off >>= 1) v = fmaxf(v, __shfl_xor(v, off));
  return v;
}

typedef unsigned short bf16_t;
typedef __attribute__((ext_vector_type(8))) short bf16x8;
typedef __attribute__((ext_vector_type(16))) float f32x16;
typedef __attribute__((ext_vector_type(4))) float f32x4;

__device__ __forceinline__ unsigned f2bf(float f) {
  unsigned u = __float_as_uint(f);
  u += 0x7fffu + ((u >> 16) & 1u);
  return u >> 16;
}
__device__ __forceinline__ unsigned pack2bf(float a, float b) { return f2bf(a) | (f2bf(b) << 16); }
__device__ __forceinline__ float bf2f(unsigned short v) { return __uint_as_float(((unsigned)v) << 16); }

__device__ __forceinline__ int mod_index(int row) { return row < T ? row / S : 2; }


struct Params {
  const float* in[18];
  float* out;
  float* ws;
};

constexpr size_t al256(size_t n) { return (n + 255) & ~(size_t)255; }
constexpr size_t OFF_TAB = 0;
constexpr size_t OFF_M = OFF_TAB + al256(16384 * 4 + 128 * 16 * 2 * 4);
constexpr size_t OFF_WIN0 = OFF_M + al256(2 * 3 * 6144 * 4);
constexpr size_t OFF_WOUT0 = OFF_WIN0 + al256((size_t)2048 * 1024 * 2);
constexpr size_t OFF_WIN1 = OFF_WOUT0 + al256((size_t)1024 * 1024 * 2);
constexpr size_t OFF_WOUT1 = OFF_WIN1 + al256((size_t)1536 * 1024 * 2);
constexpr size_t OFF_WQ = OFF_WOUT1 + al256((size_t)1024 * 1024 * 2);
constexpr size_t OFF_SK = OFF_WQ + al256((size_t)2 * 2048 * 1024 * 2);
constexpr size_t OFF_UB = OFF_SK + al256((size_t)2 * 8 * 2 * 128 * 128 * 2);
constexpr size_t OFF_VB = OFF_UB + al256((size_t)2 * 16384 * 1024 * 2);
constexpr size_t OFF_AB = OFF_VB + al256((size_t)2 * 16384 * 1024 * 2);
constexpr size_t OFF_FT = OFF_AB + al256((size_t)R * 1024 * 2);
constexpr size_t OFF_BF = OFF_FT + al256((size_t)(256 * 128 + 128 * 128 + 64 * 128) * 2);
constexpr size_t OFF_BY = OFF_BF + al256((size_t)R * 2048 * 4);
constexpr size_t OFF_X1 = OFF_BY + al256((size_t)R * 1024 * 4);
constexpr size_t OFF_X2 = OFF_X1 + al256((size_t)R * 1024 * 4);
constexpr size_t OFF_END = OFF_X2 + al256((size_t)R * 1024 * 4);
constexpr size_t OFF_A1 = OFF_BY;
constexpr size_t OFF_VT0 = OFF_X2;
static_assert(OFF_END <= (size_t)512 * 1024 * 1024, "workspace overflow");

#define GRID_LOOP(var, n) for (int var = blockIdx.x; var < (n); var += gridDim.x)

__device__ __forceinline__ void ph_fft_tables(bf16_t* D1, bf16_t* D3, bf16_t* DcT) {
  const double TWO_PI = 6.283185307179586476925286766559;
  for (int i = blockIdx.x * 256 + threadIdx.x; i < 256 * 128 + 128 * 128 + 64 * 128; i += gridDim.x * 256) {
    if (i < 256 * 128) {
      int m = i >> 7, r = i & 127; int k1 = m >> 1, ri = m & 1;
      double a = TWO_PI * (double)((k1 * r) & 127) / 128.0;
      D1[i] = (bf16_t)f2bf(ri == 0 ? (float)cos(a) : (float)(-sin(a)));
    } else if (i < 256 * 128 + 128 * 128) {
      int j = i - 256 * 128; int m = j >> 7, kk = j & 127; int rip = m >> 6, k2 = m & 63; int c = kk >> 1, ri = kk & 1;
      double a = TWO_PI * (double)((k2 * c) & 63) / 64.0;
      double v = (rip == 0) ? (ri == 0 ? cos(a) : sin(a)) : (ri == 0 ? -sin(a) : cos(a));
      D3[j] = (bf16_t)f2bf((float)v);
    } else {
      int j = i - 256 * 128 - 128 * 128; int cp = j >> 7, kk = j & 127; int rip = kk >> 6, ch = kk & 63;
      double a = TWO_PI * (double)((ch * cp) & 63) / 64.0;
      DcT[j] = (bf16_t)f2bf((float)(rip == 0 ? cos(a) : sin(a)));
    }
  }
}
__device__ __forceinline__ void ph_rope_table(float* RT) {
  for (int i = blockIdx.x * 256 + threadIdx.x; i < 128 * 16; i += gridDim.x * 256) {
    int pos = i >> 4, f = i & 15;
    float inv_freq = powf(10000.0f, -(float)f / 16.0f);
    float ang = (float)pos * inv_freq;
    RT[2 * i] = cosf(ang); RT[2 * i + 1] = sinf(ang);
  }
}
__device__ __forceinline__ void ph_tables(float* tab) {
  for (int j = blockIdx.x * 256 + threadIdx.x; j < 8192; j += gridDim.x * 256) {
    double a = 6.283185307179586476925286766559 * (double)j / 8192.0;
    tab[j] = (float)cos(a);
    tab[8192 + j] = (float)sin(a);
  }
}
__device__ __forceinline__ void ph_ada(const float* __restrict__ c, const float* __restrict__ c_ctx, const float* __restrict__ ada_w,
                       const float* __restrict__ ada_b, float* __restrict__ M) {
  for (int gid = blockIdx.x * 256 + threadIdx.x; gid < 2 * 3 * 6144; gid += gridDim.x * 256) {
    int col = gid % 6144; int idx = (gid / 6144) % 3; int layer = gid / (3 * 6144);
    const float* vec = idx < 2 ? c + idx * D : c_ctx;
    const float* w = ada_w + (size_t)layer * D * 6144 + col;
    float acc = 0.f;
    for (int k = 0; k < D; ++k) {
      float x = vec[k];
      float sx = x / (1.f + expf(-x));
      acc += sx * w[(size_t)k * 6144];
    }
    M[gid] = acc + ada_b[layer * 6144 + col];
  }
}

__device__ __forceinline__ void ph_modulate(const float* __restrict__ xa, const float* __restrict__ xb, const float* __restrict__ M, int layer,
                            int jshift, int jscale, bf16_t* __restrict__ out, int nrows, float* red) {
  int tid = threadIdx.x;
  GRID_LOOP(row, nrows) {
    const float* x = row < T ? xa + (size_t)row * D : xb + (size_t)(row - T) * D;
    float v[4]; float s = 0.f;
#pragma unroll
    for (int i = 0; i < 4; ++i) { v[i] = x[tid + 256 * i]; s += v[i]; }
    s = wave_sum(s);
    __syncthreads();
    if ((tid & 63) == 0) red[tid >> 6] = s;
    __syncthreads();
    float mu = (red[0] + red[1] + red[2] + red[3]) * (1.f / D);
    float q = 0.f;
#pragma unroll
    for (int i = 0; i < 4; ++i) { float d = v[i] - mu; q += d * d; }
    q = wave_sum(q);
    if ((tid & 63) == 0) red[4 + (tid >> 6)] = q;
    __syncthreads();
    float var = (red[4] + red[5] + red[6] + red[7]) * (1.f / D);
    float rs = rsqrtf(var + LN_EPS);
    const float* m = M + ((size_t)layer * 3 + mod_index(row)) * 6144;
#pragma unroll
    for (int i = 0; i < 4; ++i) {
      int col = tid + 256 * i;
      float y = (v[i] - mu) * rs;
      out[(size_t)row * D + col] = (bf16_t)f2bf(y * (1.f + m[jscale * D + col]) + m[jshift * D + col]);
    }
  }
}

__device__ __forceinline__ void ph_post(const float* __restrict__ xa, const float* __restrict__ xb, const float* __restrict__ Y,
                        const float* __restrict__ M, int layer, int j, const float* __restrict__ g, const float* __restrict__ bb,
                        float* __restrict__ outa, float* __restrict__ outb, int nrows, float* red) {
  int tid = threadIdx.x;
  GRID_LOOP(row, nrows) {
    const float* x = row < T ? xa + (size_t)row * D : xb + (size_t)(row - T) * D;
    float* out = row < T ? outa + (size_t)row * D : outb + (size_t)(row - T) * D;
    const float* m = M + ((size_t)layer * 3 + mod_index(row)) * 6144 + j * D;
    float v[4]; float s = 0.f;
#pragma unroll
    for (int i = 0; i < 4; ++i) { int col = tid + 256 * i; v[i] = DN_ALPHA * x[col] + m[col] * Y[(size_t)row * D + col]; s += v[i]; }
    s = wave_sum(s);
    __syncthreads();
    if ((tid & 63) == 0) red[tid >> 6] = s;
    __syncthreads();
    float mu = (red[0] + red[1] + red[2] + red[3]) * (1.f / D);
    float q = 0.f;
#pragma unroll
    for (int i = 0; i < 4; ++i) { float d = v[i] - mu; q += d * d; }
    q = wave_sum(q);
    if ((tid & 63) == 0) red[4 + (tid >> 6)] = q;
    __syncthreads();
    float var = (red[4] + red[5] + red[6] + red[7]) * (1.f / D);
    float rs = rsqrtf(var + LN_EPS);
#pragma unroll
    for (int i = 0; i < 4; ++i) {
      int col = tid + 256 * i;
      out[col] = (v[i] - mu) * rs * g[col] + bb[col];
    }
  }
}

struct ARow { const float* A; int lda; __device__ float operator()(int m, int k) const { return A[(size_t)m * lda + k]; } };
struct BRow { const float* B; int ldb; __device__ float operator()(int k, int n) const { return B[(size_t)k * ldb + n]; } };
struct CRow { float* C; int ldc; float scale; __device__ void operator()(int m, int n, float v) const { C[(size_t)m * ldc + n] = v * scale; } };
struct CRowB { bf16_t* C; int ldc; float scale; __device__ void operator()(int m, int n, float v) const { C[(size_t)m * ldc + n] = (bf16_t)f2bf(v * scale); } };
struct ADft { const float* tab; int Sn; int stride; __device__ float operator()(int m, int k) const {
    int t = k & (Sn - 1); int idx = ((m * t) & (Sn - 1)) * stride;
    return k < Sn ? tab[idx] : -tab[8192 + idx]; } };
struct BPQ { const float* PQ; int rowbase; int Sn; __device__ float operator()(int k, int n) const {
    int t = k & (Sn - 1); return PQ[(size_t)(rowbase + t) * 1024 + (k >= Sn ? 512 : 0) + n]; } };

template <class AF, class BF, class CF>
__device__ __forceinline__ void ph_gemm(AF af, BF bf, CF cf, int M, int N, int K, float* sm) {
  float (*sA)[68] = (float (*)[68])sm;
  float (*sB)[68] = (float (*)[68])(sm + 16 * 68);
  int tid = threadIdx.x; int tx = tid & 15, ty = tid >> 4;
  int ntn = N / 64; int ntiles = (M / 64) * ntn;
  GRID_LOOP(tile, ntiles) {
    int m0 = (tile / ntn) * 64, n0 = (tile % ntn) * 64;
    float acc[4][4];
#pragma unroll
    for (int i = 0; i < 4; ++i)
#pragma unroll
      for (int j = 0; j < 4; ++j) acc[i][j] = 0.f;
    for (int k0 = 0; k0 < K; k0 += 16) {
      __syncthreads();
#pragma unroll
      for (int i = 0; i < 4; ++i) { int e = tid + 256 * i; int m = e >> 4, k = e & 15; sA[k][m] = af(m0 + m, k0 + k); }
#pragma unroll
      for (int i = 0; i < 4; ++i) { int e = tid + 256 * i; int k = e >> 6, n = e & 63; sB[k][n] = bf(k0 + k, n0 + n); }
      __syncthreads();
#pragma unroll
      for (int k = 0; k < 16; ++k) {
        float a[4], b[4];
#pragma unroll
        for (int i = 0; i < 4; ++i) { a[i] = sA[k][ty * 4 + i]; b[i] = sB[k][tx * 4 + i]; }
#pragma unroll
        for (int i = 0; i < 4; ++i)
#pragma unroll
          for (int j = 0; j < 4; ++j) acc[i][j] += a[i] * b[j];
      }
    }
#pragma unroll
    for (int i = 0; i < 4; ++i)
#pragma unroll
      for (int j = 0; j < 4; ++j) cf(m0 + ty * 4 + i, n0 + tx * 4 + j, acc[i][j]);
  }
}


__device__ __forceinline__ void ph_transpose_w(const float* __restrict__ W, int K, int N, bf16_t* __restrict__ Wt, float* sm) {
  int tid = threadIdx.x;
  int tk = K / 64, tn = N / 64;
  GRID_LOOP(tile, tk * tn) {
    int k0 = (tile / tn) * 64, n0 = (tile % tn) * 64;
    __syncthreads();
#pragma unroll
    for (int i = 0; i < 16; ++i) { int e = tid + 256 * i; int k = e >> 6, n = e & 63; sm[k * 65 + n] = W[(size_t)(k0 + k) * N + n0 + n]; }
    __syncthreads();
#pragma unroll
    for (int i = 0; i < 2; ++i) {
      int e = tid + 256 * i; int n = e >> 3, kc = e & 7;
      unsigned w[4];
#pragma unroll
      for (int j = 0; j < 4; ++j) w[j] = pack2bf(sm[(kc * 8 + 2 * j) * 65 + n], sm[(kc * 8 + 2 * j + 1) * 65 + n]);
      *(uint4*)(Wt + (size_t)(n0 + n) * K + k0 + kc * 8) = make_uint4(w[0], w[1], w[2], w[3]);
    }
  }
}
__device__ __forceinline__ void ph_convert(const float* __restrict__ src, bf16_t* __restrict__ dst, size_t n8) {
  for (size_t i = (size_t)blockIdx.x * 256 + threadIdx.x; i < n8; i += (size_t)gridDim.x * 256) {
    float4 a = ((const float4*)src)[2 * i], b = ((const float4*)src)[2 * i + 1];
    ((uint4*)dst)[i] = make_uint4(pack2bf(a.x, a.y), pack2bf(a.z, a.w), pack2bf(b.x, b.y), pack2bf(b.z, b.w));
  }
}

__device__ __forceinline__ void gemm_stage(const bf16_t* __restrict__ A, int lda, int k0, char* lds, int tid) {
#pragma unroll
  for (int i = 0; i < 4; ++i) {
    int q = tid + 256 * i; int row = q >> 3, p = q & 7; int c = p ^ ((row >> 1) & 7);
    const bf16_t* src = A + (size_t)row * lda + k0 + c * 8;
    __builtin_amdgcn_global_load_lds((const unsigned*)src, (unsigned*)(lds + q * 16), 16, 0, 0);
  }
}
struct EpiF32 {
  float* C; int ldc; float scale;
  __device__ __forceinline__ void operator()(int m0, int n0, int wm, int wn, f32x16 (&acc)[2][2], int tid, char* smem) const {
    int lane = tid & 63;
    float* t = (float*)smem;
    int rbase = wm * 64 + 4 * (lane >> 5), cbase = wn * 64 + (lane & 31);
#pragma unroll
    for (int mi = 0; mi < 2; ++mi)
#pragma unroll
      for (int ni = 0; ni < 2; ++ni)
#pragma unroll
        for (int r = 0; r < 16; ++r)
          t[(rbase + mi * 32 + (r & 3) + 8 * (r >> 2)) * 128 + cbase + ni * 32] = acc[mi][ni][r] * scale;
    __syncthreads();
    float* dst = C + (size_t)(m0 + (tid >> 5)) * ldc + n0 + (tid & 31) * 4;
    const float* src = t + (tid >> 5) * 128 + (tid & 31) * 4;
#pragma unroll 4
    for (int i = 0; i < 16; ++i) {
      *(float4*)dst = *(const float4*)src;
      dst += (size_t)8 * ldc; src += 8 * 128;
    }
  }
};
struct EpiQKV0 {
  bf16_t* FQKV; bf16_t* VT;
  __device__ __forceinline__ void operator()(int m0, int n0, int wm, int wn, f32x16 (&acc)[2][2], int tid, char* smem) const {
    int lane = tid & 63;
    bf16_t* t = (bf16_t*)smem;
    int rbase = wm * 64 + 4 * (lane >> 5), cbase = wn * 64 + (lane & 31);
#pragma unroll
    for (int mi = 0; mi < 2; ++mi)
#pragma unroll
      for (int ni = 0; ni < 2; ++ni)
#pragma unroll
        for (int r = 0; r < 16; ++r)
          t[(rbase + mi * 32 + (r & 3) + 8 * (r >> 2)) * 136 + cbase + ni * 32] = (bf16_t)f2bf(acc[mi][ni][r]);
    __syncthreads();
    {
      bf16_t* dst = FQKV + (size_t)(m0 + (tid >> 4)) * 2048 + n0 + (tid & 15) * 8;
      const bf16_t* src = t + (tid >> 4) * 136 + (tid & 15) * 8;
#pragma unroll 4
      for (int i = 0; i < 8; ++i) {
        *(uint4*)dst = *(const uint4*)src;
        dst += (size_t)16 * 2048; src += 16 * 136;
      }
    }
    if (n0 >= 1536) {
      int col = tid >> 1, half = tid & 1;
      int hd = (n0 - 1536) / 64 + (col >> 6), d = col & 63;
      bf16_t* dst;
      if (m0 < T) { int b = m0 / S, t0 = m0 % S; dst = VT + (((size_t)b * 8 + hd) * 64 + d) * S + t0 + half * 64; }
      else { int mm = m0 - T; int b = mm / CL, l0 = mm % CL; dst = VT + (size_t)NB * 8 * 64 * S + (((size_t)b * 8 + hd) * 64 + d) * CL + l0 + half * 64; }
      const bf16_t* src = t + (half * 64) * 136 + col;
#pragma unroll
      for (int i = 0; i < 8; ++i) {
        unsigned wv[4];
#pragma unroll
        for (int j = 0; j < 4; ++j) wv[j] = (unsigned)src[(i * 8 + 2 * j) * 136] | ((unsigned)src[(i * 8 + 2 * j + 1) * 136] << 16);
        *(uint4*)(dst + i * 8) = make_uint4(wv[0], wv[1], wv[2], wv[3]);
      }
    }
  }
};
struct EpiQKV1 {
  bf16_t* Q1; bf16_t* K1; bf16_t* VT; const float* RT;
  __device__ __forceinline__ void operator()(int m0, int n0, int wm, int wn, f32x16 (&acc)[2][2], int tid, char* smem) const {
    int lane = tid & 63;
    asm volatile("" : "+v"(lane));
    bf16_t* t = (bf16_t*)smem;
    if (n0 < 1280 && m0 < T) {
      int i = lane & 31; int f = i & 15;
#pragma unroll
      for (int mi = 0; mi < 2; ++mi)
#pragma unroll
        for (int r = 0; r < 16; ++r) {
          int row = m0 + wm * 64 + 4 * (lane >> 5) + mi * 32 + (r & 3) + 8 * (r >> 2);
          int tt = row & (S - 1);
          int pos = (i < 16) ? (tt >> 6) : (tt & 63);
          float2 cs = *(const float2*)(RT + 2 * (pos * 16 + f));
          float x1 = acc[mi][0][r], x2 = acc[mi][1][r];
          acc[mi][0][r] = x1 * cs.x - x2 * cs.y;
          acc[mi][1][r] = x1 * cs.y + x2 * cs.x;
        }
    }
    {
      bf16_t* tw = t + (wm * 64 + 4 * (lane >> 5)) * 136 + wn * 64 + (lane & 31);
#pragma unroll
      for (int mi = 0; mi < 2; ++mi)
#pragma unroll
        for (int ni = 0; ni < 2; ++ni)
#pragma unroll
          for (int r = 0; r < 16; ++r)
            tw[(mi * 32 + (r & 3) + 8 * (r >> 2)) * 136 + ni * 32] = (bf16_t)f2bf(acc[mi][ni][r]);
    }
    __syncthreads();
    if (n0 < 1280) {
      bf16_t* dst; int ld;
      if (n0 < 1024) { dst = Q1 + (size_t)(m0 + (tid >> 4)) * 1024 + n0 + (tid & 15) * 8; ld = 1024; }
      else { dst = K1 + (size_t)(m0 + (tid >> 4)) * 256 + (n0 - 1024) + (tid & 15) * 8; ld = 256; }
      if (n0 >= 1024 || m0 < T) {
        const bf16_t* src = t + (tid >> 4) * 136 + (tid & 15) * 8;
#pragma unroll 4
        for (int i = 0; i < 8; ++i) {
          *(uint4*)dst = *(const uint4*)src;
          dst += (size_t)16 * ld; src += 16 * 136;
        }
      }
    } else {
      int col = tid >> 1, half = tid & 1;
      int hd = (n0 - 1280) / 64 + (col >> 6), d = col & 63;
      bf16_t* dst;
      if (m0 < T) { int b = m0 / S, t0 = m0 % S; dst = VT + (((size_t)b * 4 + hd) * 64 + d) * S + t0 + half * 64; }
      else { int mm = m0 - T; int b = mm / CL, l0 = mm % CL; dst = VT + (size_t)NB * 4 * 64 * S + (((size_t)b * 4 + hd) * 64 + d) * CL + l0 + half * 64; }
      const bf16_t* src = t + (half * 64) * 136 + col;
#pragma unroll
      for (int i = 0; i < 8; ++i) {
        unsigned wv[4];
#pragma unroll
        for (int j = 0; j < 4; ++j) wv[j] = (unsigned)src[(i * 8 + 2 * j) * 136] | ((unsigned)src[(i * 8 + 2 * j + 1) * 136] << 16);
        *(uint4*)(dst + i * 8) = make_uint4(wv[0], wv[1], wv[2], wv[3]);
      }
    }
  }
};
__device__ __forceinline__ void gemm_tile_mainloop(const bf16_t* __restrict__ Ag, int lda, const bf16_t* __restrict__ Bg, int ldb, int KT,
                                                   f32x16 (&acc)[2][2], char* smem) {
  int tid = threadIdx.x;
  asm volatile("" : "+v"(tid));
  int lane = tid & 63, wave = tid >> 6, wm = wave >> 1, wn = wave & 1;
#pragma unroll
  for (int mi = 0; mi < 2; ++mi)
#pragma unroll
    for (int ni = 0; ni < 2; ++ni)
#pragma unroll
      for (int r = 0; r < 16; ++r) acc[mi][ni][r] = 0.f;
  __syncthreads();
  gemm_stage(Ag, lda, 0, smem, tid); gemm_stage(Bg, ldb, 0, smem + 16384, tid);
  for (int kt = 0; kt < KT; ++kt) {
    asm volatile("s_waitcnt vmcnt(0)" ::: "memory");
    __syncthreads();
    char* cur = smem + (kt & 1) * 32768;
    if (kt + 1 < KT) {
      char* nxt = smem + ((kt + 1) & 1) * 32768;
      gemm_stage(Ag, lda, (kt + 1) * 64, nxt, tid); gemm_stage(Bg, ldb, (kt + 1) * 64, nxt + 16384, tid);
    }
#pragma unroll
    for (int s4 = 0; s4 < 4; ++s4) {
      bf16x8 a[2], b[2];
      int c = 2 * s4 + (lane >> 5);
#pragma unroll
      for (int mi = 0; mi < 2; ++mi) { int row = wm * 64 + mi * 32 + (lane & 31); a[mi] = *(const bf16x8*)(cur + row * 128 + ((c ^ ((row >> 1) & 7)) << 4)); }
#pragma unroll
      for (int ni = 0; ni < 2; ++ni) { int row = wn * 64 + ni * 32 + (lane & 31); b[ni] = *(const bf16x8*)(cur + 16384 + row * 128 + ((c ^ ((row >> 1) & 7)) << 4)); }
#pragma unroll
      for (int mi = 0; mi < 2; ++mi)
#pragma unroll
        for (int ni = 0; ni < 2; ++ni) acc[mi][ni] = __builtin_amdgcn_mfma_f32_32x32x16_bf16(a[mi], b[ni], acc[mi][ni], 0, 0, 0);
    }
  }
  __syncthreads();
}
template <class Epi>
__device__ __forceinline__ void ph_gemm_bf16(const bf16_t* __restrict__ A, int lda, const bf16_t* __restrict__ Bt, int ldb, int M, int N, int K,
                             Epi epi, char* smem) {
  int tid = threadIdx.x, wave = tid >> 6, wm = wave >> 1, wn = wave & 1;
  int ntn = N / 128, ntiles = (M / 128) * ntn;
  int KT = K / 64;
  GRID_LOOP(tile, ntiles) {
    int mt = tile / ntn, nt = tile % ntn;
    f32x16 acc[2][2];
    gemm_tile_mainloop(A + (size_t)mt * 128 * lda, lda, Bt + (size_t)nt * 128 * ldb, ldb, KT, acc, smem);
    epi(mt * 128, nt * 128, wm, wn, acc, tid, smem);
  }
}

__device__ __forceinline__ void ins16(float (&L)[16], float x) {
#pragma unroll
  for (int j = 15; j >= 1; --j) L[j] = __builtin_amdgcn_fmed3f(L[j - 1], L[j], x);
  L[0] = fmaxf(L[0], x);
}
__device__ __forceinline__ void stage_tile128(const bf16_t* __restrict__ src, int ld, char* lds, int tid) {
#pragma unroll
  for (int i = 0; i < 8; ++i) {
    int q = tid + 256 * i; int row = q >> 4, p = q & 15; int c = p ^ (row & 15);
    __builtin_amdgcn_global_load_lds((const unsigned*)(src + (size_t)row * ld + c * 8), (unsigned*)(lds + q * 16), 16, 0, 0);
  }
}
__device__ __forceinline__ void ph_peer_select(const bf16_t* __restrict__ H, const bf16_t* __restrict__ WQl, const bf16_t* __restrict__ SKl,
                                               int* __restrict__ EXP, float* __restrict__ GATE, int nrows, char* smem) {
  int tid = threadIdx.x, w = tid >> 6, wm = w >> 1, wn = w & 1;
  bf16_t* Qs = (bf16_t*)smem;
  int* KL = (int*)(smem + 36864);
  int nunits = (nrows / 128) * 8;
  GRID_LOOP(unit, nunits) {
    int mt = unit >> 3, h = unit & 7;
    float L0[16], L1[16];
#pragma unroll
    for (int p = 0; p < 2; ++p) {
      f32x16 acc[2][2];
      gemm_tile_mainloop(H + (size_t)mt * 128 * 1024, 1024, WQl + (size_t)(h * 256 + p * 128) * 1024, 1024, 16, acc, smem);
      int lane = tid & 63;
      asm volatile("" : "+v"(lane));
      {
        bf16_t* qw = Qs + (wm * 64 + 4 * (lane >> 5)) * 136 + wn * 64 + (lane & 31);
#pragma unroll
        for (int mi = 0; mi < 2; ++mi)
#pragma unroll
          for (int ni = 0; ni < 2; ++ni)
#pragma unroll
            for (int r = 0; r < 16; ++r)
              qw[(mi * 32 + (r & 3) + 8 * (r >> 2)) * 136 + ni * 32] = (bf16_t)f2bf(acc[mi][ni][r]);
      }
      __syncthreads();
      f32x16 sc[4];
#pragma unroll
      for (int m4 = 0; m4 < 4; ++m4)
#pragma unroll
        for (int r = 0; r < 16; ++r) sc[m4][r] = 0.f;
      {
        const bf16_t* qrow = Qs + (32 * w + (lane & 31)) * 136 + 8 * (lane >> 5);
        const bf16_t* krow = SKl + (size_t)(h * 2 + p) * 128 * 128 + (lane & 31) * 128 + 8 * (lane >> 5);
#pragma unroll
        for (int s8 = 0; s8 < 8; ++s8) {
          bf16x8 bq = *(const bf16x8*)(qrow + 16 * s8);
#pragma unroll
          for (int m4 = 0; m4 < 4; ++m4) {
            bf16x8 ak = *(const bf16x8*)(krow + m4 * 32 * 128 + 16 * s8);
            sc[m4] = __builtin_amdgcn_mfma_f32_32x32x16_bf16(ak, bq, sc[m4], 0, 0, 0);
          }
        }
      }
      float L[16];
#pragma unroll
      for (int j = 0; j < 16; ++j) L[j] = -INFINITY;
      unsigned kb = 4u * (unsigned)(lane >> 5);
#pragma unroll
      for (int m4 = 0; m4 < 4; ++m4)
#pragma unroll
        for (int r = 0; r < 16; ++r) {
          unsigned key = kb + (unsigned)(32 * m4 + (r & 3) + 8 * (r >> 2));
          float x = __uint_as_float((__float_as_uint(sc[m4][r]) & 0xFFFFFF80u) | key);
          ins16(L, x);
        }
      float P[16];
#pragma unroll
      for (int j = 0; j < 16; ++j) P[j] = __shfl_xor(L[j], 32);
#pragma unroll
      for (int j = 0; j < 16; ++j) ins16(L, P[j]);
      if (p == 0) {
#pragma unroll
        for (int j = 0; j < 16; ++j) L0[j] = L[j];
      } else {
#pragma unroll
        for (int j = 0; j < 16; ++j) L1[j] = L[j];
      }
    }
    float C[16];
#pragma unroll
    for (int j = 0; j < 16; ++j) C[j] = -INFINITY;
#pragma unroll
    for (int a = 0; a < 16; ++a)
#pragma unroll
      for (int b = 0; b < 16; ++b)
        if ((a + 1) * (b + 1) <= 16) {
          float sa = __uint_as_float(__float_as_uint(L0[a]) & 0xFFFFFF80u);
          float sb = __uint_as_float(__float_as_uint(L1[b]) & 0xFFFFFF80u);
          float x = __uint_as_float((__float_as_uint(sa + sb) & 0xFFFFFF00u) | (unsigned)(a * 16 + b));
          ins16(C, x);
        }
    int lane = tid & 63;
    asm volatile("" : "+v"(lane));
    int token = 32 * w + (lane & 31);
    if (lane < 32) {
#pragma unroll
      for (int j = 0; j < 16; ++j) { KL[token * 32 + j] = (int)(__float_as_uint(L0[j]) & 0x7Fu); KL[token * 32 + 16 + j] = (int)(__float_as_uint(L1[j]) & 0x7Fu); }
    }
    __syncthreads();
    if (lane < 32) {
      float c0 = __uint_as_float(__float_as_uint(C[0]) & 0xFFFFFF00u);
      float ev[16]; float sum = 0.f; int ex[16];
#pragma unroll
      for (int j = 0; j < 16; ++j) {
        unsigned bits = __float_as_uint(C[j]);
        float cv = __uint_as_float(bits & 0xFFFFFF00u);
        ev[j] = __expf(cv - c0); sum += ev[j];
        int a = (bits >> 4) & 15, b = bits & 15;
        ex[j] = KL[token * 32 + a] * 128 + KL[token * 32 + 16 + b];
      }
      float inv = 1.f / sum;
      size_t o = (size_t)(mt * 128 + token) * 128 + h * 16;
#pragma unroll
      for (int j = 0; j < 16; j += 4) {
        *(int4*)(EXP + o + j) = make_int4(ex[j], ex[j + 1], ex[j + 2], ex[j + 3]);
        *(float4*)(GATE + o + j) = make_float4(ev[j] * inv, ev[j + 1] * inv, ev[j + 2] * inv, ev[j + 3] * inv);
      }
    }
  }
}

__device__ __forceinline__ void fft1_unit(int u, const bf16_t* __restrict__ FQKV, const bf16_t* __restrict__ D1, const float* __restrict__ TAB,
                          bf16_t* __restrict__ A1, char* smem) {
  int tid = threadIdx.x, lane = tid & 63, w = tid >> 6;
  int g = u & 7, c = (u >> 3) & 63, b = u >> 9;
  bf16_t* Bt = (bf16_t*)smem;
  __syncthreads();
  {
    int r = tid >> 1, half = tid & 1;
    const uint4* src = (const uint4*)(FQKV + (size_t)(b * S + 64 * r + c) * 2048 + g * 64 + half * 32);
    unsigned wv[16];
#pragma unroll
    for (int i = 0; i < 4; ++i) { uint4 v = src[i]; wv[4 * i] = v.x; wv[4 * i + 1] = v.y; wv[4 * i + 2] = v.z; wv[4 * i + 3] = v.w; }
#pragma unroll
    for (int j = 0; j < 32; ++j) {
      unsigned e = (j & 1) ? (wv[j >> 1] >> 16) : (wv[j >> 1] & 0xffffu);
      Bt[(half * 32 + j) * 136 + r] = (bf16_t)e;
    }
  }
  __syncthreads();
  f32x16 acc[2][2];
#pragma unroll
  for (int mi = 0; mi < 2; ++mi)
#pragma unroll
    for (int ni = 0; ni < 2; ++ni)
#pragma unroll
      for (int r = 0; r < 16; ++r) acc[mi][ni][r] = 0.f;
#pragma unroll
  for (int s8 = 0; s8 < 8; ++s8) {
    bf16x8 a[2], bb[2];
    int ko = 16 * s8 + 8 * (lane >> 5);
#pragma unroll
    for (int mi = 0; mi < 2; ++mi) a[mi] = *(const bf16x8*)(D1 + (64 * w + 32 * mi + (lane & 31)) * 128 + ko);
#pragma unroll
    for (int ni = 0; ni < 2; ++ni) bb[ni] = *(const bf16x8*)(Bt + (32 * ni + (lane & 31)) * 136 + ko);
#pragma unroll
    for (int mi = 0; mi < 2; ++mi)
#pragma unroll
      for (int ni = 0; ni < 2; ++ni) acc[mi][ni] = __builtin_amdgcn_mfma_f32_32x32x16_bf16(a[mi], bb[ni], acc[mi][ni], 0, 0, 0);
  }
#pragma unroll
  for (int mi = 0; mi < 2; ++mi)
#pragma unroll
    for (int j = 0; j < 8; ++j) {
      int m = 64 * w + 32 * mi + ((2 * j) & 3) + 8 * ((2 * j) >> 2) + 4 * (lane >> 5);
      int k1 = m >> 1;
      int idx = (k1 * c) & 8191;
      float cs = TAB[idx], sn = TAB[8192 + idx];
#pragma unroll
      for (int ni = 0; ni < 2; ++ni) {
        float re = acc[mi][ni][2 * j], im = acc[mi][ni][2 * j + 1];
        float re2 = re * cs + im * sn, im2 = im * cs - re * sn;
        bf16_t* dst = A1 + ((((size_t)b * 64 + c) * 128 + k1) * 2) * 512 + g * 64 + 32 * ni + (lane & 31);
        dst[0] = (bf16_t)f2bf(re2); dst[512] = (bf16_t)f2bf(im2);
      }
    }
}

__device__ __forceinline__ void fft3_unit(int u, int mode, const bf16_t* __restrict__ FQKV, const bf16_t* __restrict__ A1, const bf16_t* __restrict__ D3,
                          const bf16_t* __restrict__ DcT, const float* __restrict__ TAB, bf16_t* __restrict__ MIX, char* smem) {
  int tid = threadIdx.x, lane = tid & 63, w = tid >> 6;
  bf16_t* Bt = (bf16_t*)smem;
  bf16_t* Xs = (bf16_t*)(smem + 17408);
  int g = u & 7, k1, b, nk1, rowbase; float norm;
  __syncthreads();
  if (mode == 0) {
    k1 = (u >> 3) & 127; b = u >> 10; nk1 = 128; rowbase = b * S; norm = 1.f / 724.0773439350247f;
    int kk = tid >> 1, half = tid & 1; int c = kk >> 1, ri = kk & 1;
    const uint4* src = (const uint4*)(A1 + ((((size_t)b * 64 + c) * 128 + k1) * 2 + ri) * 512 + g * 64 + half * 32);
    unsigned wv[16];
#pragma unroll
    for (int i = 0; i < 4; ++i) { uint4 v = src[i]; wv[4 * i] = v.x; wv[4 * i + 1] = v.y; wv[4 * i + 2] = v.z; wv[4 * i + 3] = v.w; }
#pragma unroll
    for (int j = 0; j < 32; ++j) {
      unsigned e = (j & 1) ? (wv[j >> 1] >> 16) : (wv[j >> 1] & 0xffffu);
      Bt[(half * 32 + j) * 136 + kk] = (bf16_t)e;
    }
  } else {
    k1 = (u >> 3) & 3; b = u >> 5; nk1 = 4; rowbase = T + b * CL; norm = 1.f / 128.f;
    int c = tid >> 2, q4 = tid & 3;
    float re[16], im[16];
#pragma unroll
    for (int j = 0; j < 16; ++j) { re[j] = 0.f; im[j] = 0.f; }
#pragma unroll
    for (int r = 0; r < 4; ++r) {
      const uint4* src = (const uint4*)(FQKV + (size_t)(rowbase + 64 * r + c) * 2048 + g * 64 + q4 * 16);
      uint4 v0 = src[0], v1 = src[1];
      unsigned wv[8] = {v0.x, v0.y, v0.z, v0.w, v1.x, v1.y, v1.z, v1.w};
      int ph = (k1 * r) & 3;
      float cr = (ph == 0) ? 1.f : (ph == 2 ? -1.f : 0.f);
      float ci = (ph == 1) ? -1.f : (ph == 3 ? 1.f : 0.f);
#pragma unroll
      for (int j = 0; j < 16; ++j) {
        float x = bf2f((unsigned short)((j & 1) ? (wv[j >> 1] >> 16) : (wv[j >> 1] & 0xffffu)));
        re[j] += x * cr; im[j] += x * ci;
      }
    }
    int idx = (k1 * c * 32) & 8191;
    float cs = TAB[idx], sn = TAB[8192 + idx];
#pragma unroll
    for (int j = 0; j < 16; ++j) {
      float re2 = re[j] * cs + im[j] * sn, im2 = im[j] * cs - re[j] * sn;
      *(unsigned*)(Bt + (q4 * 16 + j) * 136 + 2 * c) = pack2bf(re2, im2);
    }
  }
  __syncthreads();
  {
    f32x16 acc[2];
#pragma unroll
    for (int ni = 0; ni < 2; ++ni)
#pragma unroll
      for (int r = 0; r < 16; ++r) acc[ni][r] = 0.f;
#pragma unroll
    for (int s8 = 0; s8 < 8; ++s8) {
      int ko = 16 * s8 + 8 * (lane >> 5);
      bf16x8 a = *(const bf16x8*)(D3 + (32 * w + (lane & 31)) * 128 + ko);
#pragma unroll
      for (int ni = 0; ni < 2; ++ni) {
        bf16x8 bb = *(const bf16x8*)(Bt + (32 * ni + (lane & 31)) * 136 + ko);
        acc[ni] = __builtin_amdgcn_mfma_f32_32x32x16_bf16(a, bb, acc[ni], 0, 0, 0);
      }
    }
#pragma unroll
    for (int ni = 0; ni < 2; ++ni)
#pragma unroll
      for (int r = 0; r < 16; ++r) {
        int m = 32 * w + (r & 3) + 8 * (r >> 2) + 4 * (lane >> 5);
        Xs[(m & 63) * 136 + (m >> 6) * 64 + 32 * ni + (lane & 31)] = (bf16_t)f2bf(acc[ni][r]);
      }
  }
  __syncthreads();
  {
    int mi = w >> 1, ni = w & 1;
    f32x16 acc;
#pragma unroll
    for (int r = 0; r < 16; ++r) acc[r] = 0.f;
#pragma unroll
    for (int s8 = 0; s8 < 8; ++s8) {
      int ko = 16 * s8 + 8 * (lane >> 5);
      bf16x8 a = *(const bf16x8*)(Xs + (32 * mi + (lane & 31)) * 136 + ko);
      bf16x8 bb = *(const bf16x8*)(DcT + (32 * ni + (lane & 31)) * 128 + ko);
      acc = __builtin_amdgcn_mfma_f32_32x32x16_bf16(a, bb, acc, 0, 0, 0);
    }
#pragma unroll
    for (int r = 0; r < 16; ++r) {
      int k2 = 32 * mi + (r & 3) + 8 * (r >> 2) + 4 * (lane >> 5);
      int row = rowbase + k1 + nk1 * k2;
      MIX[(size_t)row * 1024 + g * 64 + 32 * ni + (lane & 31)] = (bf16_t)f2bf(acc[r] * norm);
    }
  }
}


typedef __attribute__((ext_vector_type(4))) float f32x4_t;
__device__ __forceinline__ bf16x8 ld16(const bf16_t* p) { return *(const bf16x8*)p; }
__device__ __forceinline__ float fast_exp2(float x) { return __builtin_amdgcn_exp2f(x); }

template <int NH, int MODE>
__device__ __forceinline__ void attn_unit(int unit, const bf16_t* __restrict__ Qp, int ldq, const bf16_t* __restrict__ Kp, int ldk,
                                          const bf16_t* __restrict__ VTl, const bf16_t* __restrict__ VTc, int nkvh,
                                          const float* __restrict__ rpb, const float* __restrict__ sink,
                                          bf16_t* __restrict__ Op, int ldo, int lane) {
  const float LOG2E = 1.4426950408889634f;
  const float SC = 0.125f * LOG2E;
  int ql = lane & 15, g = lane >> 4;
  int b, hk, qrow0, r = 0, jb = 0, q0 = 0;
  int nloc, lb0 = 0;
  if (MODE == 0) { hk = unit & 7; jb = (unit >> 3) & 3; r = (unit >> 5) & 127; b = unit >> 12; qrow0 = b * S + r * 64 + 16 * jb; nloc = 8; }
  else if (MODE == 1) { hk = unit & 7; int qb = (unit >> 3) & 15; b = unit >> 7; qrow0 = T + b * CL + 16 * qb; nloc = 0; }
  else { hk = unit & 3; int qb = (unit >> 2) & 511; b = unit >> 11; q0 = 16 * qb; qrow0 = b * S + q0;
         int lo = (q0 - 128) >> 5, hi = (q0 + 143) >> 5; if (lo < 0) lo = 0; if (hi > 255) hi = 255; lb0 = lo; nloc = hi - lo + 1; }
  bf16x8 qf[NH][2];
#pragma unroll
  for (int hh = 0; hh < NH; ++hh)
#pragma unroll
    for (int s2 = 0; s2 < 2; ++s2)
      qf[hh][s2] = ld16(Qp + (size_t)(qrow0 + ql) * ldq + (hk * NH + hh) * 64 + 32 * s2 + 8 * g);
  f32x4_t o[NH][4]; float mrun[NH], lrun[NH];
#pragma unroll
  for (int hh = 0; hh < NH; ++hh) {
    mrun[hh] = -1e30f; lrun[hh] = 0.f;
#pragma unroll
    for (int dt = 0; dt < 4; ++dt) o[hh][dt] = (f32x4_t){0.f, 0.f, 0.f, 0.f};
  }
  int r_start = 0, blk_start = 0, c_lo = 0, qc = 0;
  if (MODE == 0) {
    r_start = min(max(r - 4, 0), 120);
    blk_start = min(max(16 * jb - 8, 0), 32);
    qc = 16 * jb + ql; c_lo = min(max(qc - 8, 0), 48);
  }
  int nblk = nloc + 8;
  for (int kb = 0; kb < nblk; ++kb) {
    bool is_loc = kb < nloc;
    int krow0, vt0; const bf16_t* vt;
    int rr = 0;
    if (is_loc) {
      if (MODE == 0) { rr = r_start + kb; krow0 = b * S + rr * 64 + blk_start; vt0 = rr * 64 + blk_start; }
      else { krow0 = b * S + 32 * (lb0 + kb); vt0 = 32 * (lb0 + kb); }
      vt = VTl + ((size_t)(b * nkvh + hk) * 64) * S + vt0;
    } else {
      int cb = kb - nloc; krow0 = T + b * CL + 32 * cb; vt0 = 32 * cb;
      vt = VTc + ((size_t)(b * nkvh + hk) * 64) * CL + vt0;
    }
    int vld = is_loc ? S : CL;
    bf16x8 kf[2][2];
#pragma unroll
    for (int t = 0; t < 2; ++t)
#pragma unroll
      for (int s2 = 0; s2 < 2; ++s2)
        kf[t][s2] = ld16(Kp + (size_t)(krow0 + 8 * (ql >> 2) + 4 * t + (ql & 3)) * ldk + hk * 64 + 32 * s2 + 8 * g);
    bf16x8 vf[4];
#pragma unroll
    for (int dt = 0; dt < 4; ++dt) vf[dt] = ld16(vt + (size_t)(16 * dt + ql) * vld + 8 * g);
    float bias[2][4]; bool valid[2][4];
#pragma unroll
    for (int t = 0; t < 2; ++t)
#pragma unroll
      for (int i = 0; i < 4; ++i) {
        bias[t][i] = 0.f; valid[t][i] = true;
        if (MODE == 0 && is_loc) {
          int kc = blk_start + 8 * g + 4 * t + i;
          valid[t][i] = (kc >= c_lo) && (kc < c_lo + 16);
          int dc = min(max(kc - qc, -15), 15) + 15;
          bias[t][i] = rpb[(hk * 15 + (rr - r + 7)) * 31 + dc] * LOG2E;
        }
        if (MODE == 2 && is_loc) {
          int kpos = 32 * (lb0 + kb) + 8 * g + 4 * t + i; int dq = (q0 + ql) - kpos;
          valid[t][i] = (dq <= 128) && (dq >= -128);
        }
      }
#pragma unroll
    for (int hh = 0; hh < NH; ++hh) {
      f32x4_t st[2];
#pragma unroll
      for (int t = 0; t < 2; ++t) {
        st[t] = (f32x4_t){0.f, 0.f, 0.f, 0.f};
        st[t] = __builtin_amdgcn_mfma_f32_16x16x32_bf16(kf[t][0], qf[hh][0], st[t], 0, 0, 0);
        st[t] = __builtin_amdgcn_mfma_f32_16x16x32_bf16(kf[t][1], qf[hh][1], st[t], 0, 0, 0);
      }
      float lg[2][4]; float bm = -1e30f;
#pragma unroll
      for (int t = 0; t < 2; ++t)
#pragma unroll
        for (int i = 0; i < 4; ++i) {
          float v = valid[t][i] ? (st[t][i] * SC + bias[t][i]) : -1e30f;
          lg[t][i] = v; bm = fmaxf(bm, v);
        }
      bm = fmaxf(bm, __shfl_xor(bm, 16));
      bm = fmaxf(bm, __shfl_xor(bm, 32));
      float mn = fmaxf(mrun[hh], bm);
      float alpha = fast_exp2(mrun[hh] - mn);
      mrun[hh] = mn;
      float ps = 0.f; float pv[8];
#pragma unroll
      for (int t = 0; t < 2; ++t)
#pragma unroll
        for (int i = 0; i < 4; ++i) {
          float p = valid[t][i] ? fast_exp2(lg[t][i] - mn) : 0.f;
          pv[4 * t + i] = p; ps += p;
        }
      lrun[hh] = lrun[hh] * alpha + ps;
      bf16x8 pf;
      {
        unsigned w0 = pack2bf(pv[0], pv[1]), w1 = pack2bf(pv[2], pv[3]), w2 = pack2bf(pv[4], pv[5]), w3 = pack2bf(pv[6], pv[7]);
        typedef __attribute__((ext_vector_type(4))) unsigned u32x4;
        u32x4 uu = {w0, w1, w2, w3};
        pf = __builtin_bit_cast(bf16x8, uu);
      }
#pragma unroll
      for (int dt = 0; dt < 4; ++dt) {
        o[hh][dt] *= alpha;
        o[hh][dt] = __builtin_amdgcn_mfma_f32_16x16x32_bf16(vf[dt], pf, o[hh][dt], 0, 0, 0);
      }
    }
  }
#pragma unroll
  for (int hh = 0; hh < NH; ++hh) {
    float l = lrun[hh];
    l += __shfl_xor(l, 16); l += __shfl_xor(l, 32);
    float m = mrun[hh];
    if (MODE == 2) {
      float sk = sink[hk * NH + hh] * LOG2E;
      float mf = fmaxf(m, sk);
      float a = fast_exp2(m - mf);
      l = l * a + fast_exp2(sk - mf);
#pragma unroll
      for (int dt = 0; dt < 4; ++dt) o[hh][dt] *= a;
    }
    float inv = 1.f / l;
    bf16_t* orow = Op + (size_t)(qrow0 + ql) * ldo + (hk * NH + hh) * 64 + 4 * g;
#pragma unroll
    for (int dt = 0; dt < 4; ++dt) {
      f32x4_t v = o[hh][dt] * inv;
      *(uint2*)(orow + 16 * dt) = make_uint2(pack2bf(v[0], v[1]), pack2bf(v[2], v[3]));
    }
  }
}

__device__ __forceinline__ void ph_chan_dft(const float* __restrict__ F, const float* __restrict__ tab, float* __restrict__ PQ) {
  for (int gid = blockIdx.x * 256 + threadIdx.x; gid < R * 512; gid += gridDim.x * 256) {
    int row = gid >> 9; int col = gid & 511; int g = col >> 6, cp = col & 63;
    const float* f = F + (size_t)row * 2048 + g * 64;
    float p = 0.f, q = 0.f;
    for (int ch = 0; ch < 64; ++ch) {
      int idx = ((ch * cp) & 63) * 128;
      float x = f[ch];
      p += x * tab[idx]; q += x * tab[8192 + idx];
    }
    PQ[(size_t)row * 1024 + col] = p;
    PQ[(size_t)row * 1024 + 512 + col] = q;
  }
}

__device__ __forceinline__ void ph_na(const bf16_t* __restrict__ F, const float* __restrict__ rpb, bf16_t* __restrict__ MIX, float* sm) {
  int lane = threadIdx.x & 63, wave = threadIdx.x >> 6;
  float* sq = sm + wave * 1024; float* sp = sq + 64; int* stok = (int*)(sp + 384);
  int nitems = R * 8;
  for (int item0 = blockIdx.x * 4; item0 < nitems; item0 += gridDim.x * 4) {
    int item = item0 + wave;
    int h = item & 7; int row = item >> 3;
    bool is_ctx = row >= T;
    int b = is_ctx ? (row - T) / CL : row / S;
    __syncthreads();
    sq[lane] = bf2f(F[(size_t)row * 2048 + 512 + h * 64 + lane]);
    __syncthreads();
    int r = 0, c = 0, r_start = 0, c_start = 0;
    if (!is_ctx) { int t = row % S; r = t / 64; c = t % 64; r_start = min(max(r - 4, 0), 120); c_start = min(max(c - 8, 0), 48); }
    int nk = is_ctx ? 256 : 384;
    float lg[6]; float mx = -INFINITY;
#pragma unroll
    for (int kk = 0; kk < 6; ++kk) {
      int j = kk * 64 + lane; float s = -INFINITY; int tok = 0;
      if (j < nk) {
        float bias = 0.f;
        if (!is_ctx && j < 128) {
          int kr = j >> 4, kc = j & 15; int rr = r_start + kr, cc = c_start + kc;
          tok = b * S + rr * 64 + cc;
          int dc = min(max(cc - c, -15), 15) + 15;
          bias = rpb[(h * 15 + (rr - r + 7)) * 31 + dc];
        } else {
          int l = is_ctx ? j : j - 128; tok = T + b * CL + l;
        }
        const bf16_t* kp = F + (size_t)tok * 2048 + 1024 + h * 64;
        float acc = 0.f;
#pragma unroll 8
        for (int d = 0; d < 64; ++d) acc += sq[d] * bf2f(kp[d]);
        s = acc * 0.125f + bias;
      }
      lg[kk] = s; stok[j] = tok; mx = fmaxf(mx, s);
    }
    mx = wave_max(mx);
    float sum = 0.f;
#pragma unroll
    for (int kk = 0; kk < 6; ++kk) { float e = (kk * 64 + lane < nk) ? expf(lg[kk] - mx) : 0.f; lg[kk] = e; sum += e; }
    sum = wave_sum(sum);
    float inv = 1.f / sum;
#pragma unroll
    for (int kk = 0; kk < 6; ++kk) sp[kk * 64 + lane] = lg[kk] * inv;
    __syncthreads();
    float o = 0.f;
    for (int j = 0; j < nk; ++j) o += sp[j] * bf2f(F[(size_t)stok[j] * 2048 + 1536 + h * 64 + lane]);
    MIX[(size_t)row * 1024 + 512 + h * 64 + lane] = (bf16_t)f2bf(o);
  }
}

__device__ __forceinline__ void ph_rope(float* __restrict__ F1) {
  for (int gid = blockIdx.x * 256 + threadIdx.x; gid < T * 20 * 32; gid += gridDim.x * 256) {
    int i = gid & 31; int hh = (gid >> 5) % 20; int row = gid / (32 * 20);
    int t = row % S; float rowp = (float)(t / 64), colp = (float)(t % 64);
    int fi = i & 15;
    float inv_freq = powf(10000.0f, -(float)fi / 16.0f);
    float ang = (i < 16 ? rowp : colp) * inv_freq;
    float cs = cosf(ang), sn = sinf(ang);
    float* p = F1 + (size_t)row * 1536 + hh * 64;
    float x1 = p[i], x2 = p[i + 32];
    p[i] = x1 * cs - x2 * sn;
    p[i + 32] = x1 * sn + x2 * cs;
  }
}

__device__ __forceinline__ void ph_gqa(const float* __restrict__ F1, const float* __restrict__ sink, bf16_t* __restrict__ O, float* sm) {
  int lane = threadIdx.x & 63, wave = threadIdx.x >> 6;
  float* sq = sm + wave * 1280; float* sp = sq + 64; int* stok = (int*)(sp + 576);
  int nitems = T * 16;
  for (int item0 = blockIdx.x * 4; item0 < nitems; item0 += gridDim.x * 4) {
    int item = item0 + wave;
    int qh = item & 15; int row = item >> 4; int kvh = qh >> 2;
    int b = row / S; int t = row % S;
    __syncthreads();
    sq[lane] = F1[(size_t)row * 1536 + qh * 64 + lane];
    __syncthreads();
    float lg[9]; float mx = -INFINITY;
#pragma unroll
    for (int kk = 0; kk < 9; ++kk) {
      int j = kk * 64 + lane; float s = -INFINITY; int tok = 0; bool valid = false;
      if (j < 257) { int pos = t - 128 + j; valid = (pos >= 0 && pos < S); tok = b * S + pos; }
      else if (j < 513) { valid = true; tok = T + b * CL + (j - 257); }
      if (valid) {
        const float* kp = F1 + (size_t)tok * 1536 + 1024 + kvh * 64;
        float acc = 0.f;
#pragma unroll 8
        for (int d = 0; d < 64; ++d) acc += sq[d] * kp[d];
        s = acc * 0.125f;
      } else tok = 0;
      lg[kk] = s; stok[j] = tok; mx = fmaxf(mx, s);
    }
    mx = wave_max(mx);
    float sk = sink[qh];
    mx = fmaxf(mx, sk);
    float sum = 0.f;
#pragma unroll
    for (int kk = 0; kk < 9; ++kk) { float e = (lg[kk] == -INFINITY) ? 0.f : expf(lg[kk] - mx); lg[kk] = e; sum += e; }
    sum = wave_sum(sum) + expf(sk - mx);
    float inv = 1.f / sum;
#pragma unroll
    for (int kk = 0; kk < 9; ++kk) sp[kk * 64 + lane] = lg[kk] * inv;
    __syncthreads();
    float o = 0.f;
    for (int j = 0; j < 513; ++j) { float p = sp[j]; if (p != 0.f) o += p * F1[(size_t)stok[j] * 1536 + 1280 + kvh * 64 + lane]; }
    O[(size_t)row * 1024 + qh * 64 + lane] = (bf16_t)f2bf(o);
  }
}

__device__ __forceinline__ void wave_argmax(float& v, int& idx) {
#pragma unroll
  for (int off = 32; off; off >>= 1) {
    float ov = __shfl_xor(v, off); int oi = __shfl_xor(idx, off);
    if (ov > v || (ov == v && oi < idx)) { v = ov; idx = oi; }
  }
}
__device__ __forceinline__ void ph_peer_select_naive(const float* __restrict__ Q, const float* __restrict__ sk, int* __restrict__ EXP,
                                     float* __restrict__ GATE, int nrows, float* sm) {
  int lane = threadIdx.x & 63, wave = threadIdx.x >> 6;
  float* sq = sm + wave * 640; float* tops = sq + 256; int* topi = (int*)(tops + 32);
  for (int row0 = blockIdx.x * 4; row0 < nrows; row0 += gridDim.x * 4) {
    int row = row0 + wave;
    for (int h = 0; h < 8; ++h) {
      __syncthreads();
#pragma unroll
      for (int i = 0; i < 4; ++i) sq[lane + 64 * i] = Q[(size_t)row * 2048 + h * 256 + lane + 64 * i];
      __syncthreads();
      for (int p = 0; p < 2; ++p) {
        float s0 = 0.f, s1 = 0.f;
        const float* k0 = sk + ((size_t)((h * 2 + p) * 128 + lane)) * 128;
        const float* k1 = k0 + 64 * 128;
#pragma unroll 8
        for (int d = 0; d < 128; ++d) { float qv = sq[p * 128 + d]; s0 += qv * k0[d]; s1 += qv * k1[d]; }
        for (int i = 0; i < 16; ++i) {
          float v; int idx;
          if (s0 >= s1) { v = s0; idx = lane; } else { v = s1; idx = lane + 64; }
          wave_argmax(v, idx);
          if (lane == 0) { tops[p * 16 + i] = v; topi[p * 16 + i] = idx; }
          if (idx == lane) s0 = -INFINITY;
          if (idx == lane + 64) s1 = -INFINITY;
        }
      }
      __syncthreads();
      float cs[4];
#pragma unroll
      for (int i = 0; i < 4; ++i) { int ci = lane * 4 + i; cs[i] = tops[ci >> 4] + tops[16 + (ci & 15)]; }
      float bs[16]; int be[16];
#pragma unroll
      for (int k = 0; k < 16; ++k) {
        float v = cs[0]; int idx = lane * 4;
#pragma unroll
        for (int i = 1; i < 4; ++i) if (cs[i] > v) { v = cs[i]; idx = lane * 4 + i; }
        wave_argmax(v, idx);
        bs[k] = v; be[k] = topi[idx >> 4] * 128 + topi[16 + (idx & 15)];
#pragma unroll
        for (int i = 0; i < 4; ++i) if (idx == lane * 4 + i) cs[i] = -INFINITY;
      }
      float mxs = bs[0]; float sum = 0.f;
#pragma unroll
      for (int k = 0; k < 16; ++k) { bs[k] = expf(bs[k] - mxs); sum += bs[k]; }
      float inv = 1.f / sum;
      if (lane == 0) {
#pragma unroll
        for (int k = 0; k < 16; ++k) { EXP[(size_t)row * 128 + h * 16 + k] = be[k]; GATE[(size_t)row * 128 + h * 16 + k] = bs[k] * inv; }
      }
    }
  }
}

__device__ __forceinline__ void unpack8(uint4 v, float* f) {
  f[0] = __uint_as_float(v.x << 16); f[1] = __uint_as_float(v.x & 0xffff0000u);
  f[2] = __uint_as_float(v.y << 16); f[3] = __uint_as_float(v.y & 0xffff0000u);
  f[4] = __uint_as_float(v.z << 16); f[5] = __uint_as_float(v.z & 0xffff0000u);
  f[6] = __uint_as_float(v.w << 16); f[7] = __uint_as_float(v.w & 0xffff0000u);
}
__device__ __forceinline__ void ph_peer_gather(bf16_t* __restrict__ H, const int* __restrict__ EXP, const float* __restrict__ GATE,
                               const bf16_t* __restrict__ U, const bf16_t* __restrict__ V,
                               const float* __restrict__ xin, const float* __restrict__ M, int layer,
                               const float* __restrict__ g, const float* __restrict__ bb, float* __restrict__ xout,
                               bool write_next, int nrows) {
  int lane = threadIdx.x & 63, wave = threadIdx.x >> 6;
  for (int row = blockIdx.x * 4 + wave; row < nrows; row += gridDim.x * 4) {
    float hreg[16];
    {
      const uint4* hp = (const uint4*)(H + (size_t)row * D + 8 * lane);
      unpack8(hp[0], hreg); unpack8(hp[64], hreg + 8);
    }
    float acc[16];
#pragma unroll
    for (int i = 0; i < 16; ++i) acc[i] = 0.f;
    int e_lo = EXP[(size_t)row * 128 + lane], e_hi = EXP[(size_t)row * 128 + 64 + lane];
    float g_lo = GATE[(size_t)row * 128 + lane], g_hi = GATE[(size_t)row * 128 + 64 + lane];
    uint4 ua[4], ub[4], va[4], vb[4];
#pragma unroll
    for (int i = 0; i < 4; ++i) {
      int e = __builtin_amdgcn_readlane(e_lo, i);
      const uint4* up = (const uint4*)(U + (size_t)e * D + 8 * lane); ua[i] = up[0]; ub[i] = up[64];
    }
#pragma unroll 1
    for (int b = 0; b < 32; ++b) {
      int k0 = 4 * b;
      int ev = (b < 16) ? e_lo : e_hi; float gv = (b < 16) ? g_lo : g_hi;
      int en = (b + 1 < 16) ? e_lo : e_hi;
      float gt[4];
#pragma unroll
      for (int i = 0; i < 4; ++i) {
        int e = __builtin_amdgcn_readlane(ev, (k0 + i) & 63);
        gt[i] = __uint_as_float(__builtin_amdgcn_readlane(__float_as_uint(gv), (k0 + i) & 63));
        const uint4* vp = (const uint4*)(V + (size_t)e * D + 8 * lane); va[i] = vp[0]; vb[i] = vp[64];
      }
      float a[4];
#pragma unroll
      for (int i = 0; i < 4; ++i) {
        float f[16]; unpack8(ua[i], f); unpack8(ub[i], f + 8);
        float sacc = 0.f;
#pragma unroll
        for (int j = 0; j < 16; ++j) sacc += f[j] * hreg[j];
        a[i] = sacc;
      }
      if (b + 1 < 32) {
#pragma unroll
        for (int i = 0; i < 4; ++i) {
          int e = __builtin_amdgcn_readlane(en, (k0 + 4 + i) & 63);
          const uint4* up = (const uint4*)(U + (size_t)e * D + 8 * lane); ua[i] = up[0]; ub[i] = up[64];
        }
      }
#pragma unroll
      for (int i = 0; i < 4; ++i) a[i] = wave_sum(a[i]);
#pragma unroll
      for (int i = 0; i < 4; ++i) {
        float w = gt[i] * 0.5f * a[i] * (1.f + erff(a[i] * 0.70710678118654752f));
        float f[16]; unpack8(va[i], f); unpack8(vb[i], f + 8);
#pragma unroll
        for (int j = 0; j < 16; ++j) acc[j] += w * f[j];
      }
    }
    const float* m = M + ((size_t)layer * 3 + mod_index(row)) * 6144;
    const float* xr = xin + (size_t)row * D;
    float v[16];
#pragma unroll
    for (int hh = 0; hh < 2; ++hh) {
      int d0 = hh * 512 + 8 * lane;
      float4 x0 = *(const float4*)(xr + d0), x1 = *(const float4*)(xr + d0 + 4);
      float4 m0 = *(const float4*)(m + 5 * D + d0), m1 = *(const float4*)(m + 5 * D + d0 + 4);
      v[hh * 8 + 0] = DN_ALPHA * x0.x + m0.x * acc[hh * 8 + 0]; v[hh * 8 + 1] = DN_ALPHA * x0.y + m0.y * acc[hh * 8 + 1];
      v[hh * 8 + 2] = DN_ALPHA * x0.z + m0.z * acc[hh * 8 + 2]; v[hh * 8 + 3] = DN_ALPHA * x0.w + m0.w * acc[hh * 8 + 3];
      v[hh * 8 + 4] = DN_ALPHA * x1.x + m1.x * acc[hh * 8 + 4]; v[hh * 8 + 5] = DN_ALPHA * x1.y + m1.y * acc[hh * 8 + 5];
      v[hh * 8 + 6] = DN_ALPHA * x1.z + m1.z * acc[hh * 8 + 6]; v[hh * 8 + 7] = DN_ALPHA * x1.w + m1.w * acc[hh * 8 + 7];
    }
    float s = 0.f;
#pragma unroll
    for (int j = 0; j < 16; ++j) s += v[j];
    float mu = wave_sum(s) * (1.f / D);
    float q = 0.f;
#pragma unroll
    for (int j = 0; j < 16; ++j) { float d = v[j] - mu; q += d * d; }
    float rs = rsqrtf(wave_sum(q) * (1.f / D) + LN_EPS);
    float y[16];
#pragma unroll
    for (int hh = 0; hh < 2; ++hh) {
      int d0 = hh * 512 + 8 * lane;
#pragma unroll
      for (int j = 0; j < 8; ++j) y[hh * 8 + j] = (v[hh * 8 + j] - mu) * rs * g[d0 + j] + bb[d0 + j];
      *(float4*)(xout + (size_t)row * D + d0) = make_float4(y[hh * 8], y[hh * 8 + 1], y[hh * 8 + 2], y[hh * 8 + 3]);
      *(float4*)(xout + (size_t)row * D + d0 + 4) = make_float4(y[hh * 8 + 4], y[hh * 8 + 5], y[hh * 8 + 6], y[hh * 8 + 7]);
    }
    if (write_next) {
      const float* mn = M + ((size_t)(layer + 1) * 3 + mod_index(row)) * 6144;
      float s2 = 0.f;
#pragma unroll
      for (int j = 0; j < 16; ++j) s2 += y[j];
      float mu2 = wave_sum(s2) * (1.f / D);
      float q2 = 0.f;
#pragma unroll
      for (int j = 0; j < 16; ++j) { float d = y[j] - mu2; q2 += d * d; }
      float rs2 = rsqrtf(wave_sum(q2) * (1.f / D) + LN_EPS);
#pragma unroll
      for (int hh = 0; hh < 2; ++hh) {
        int d0 = hh * 512 + 8 * lane;
        float o[8];
#pragma unroll
        for (int j = 0; j < 8; ++j) o[j] = (y[hh * 8 + j] - mu2) * rs2 * (1.f + mn[D + d0 + j]) + mn[d0 + j];
        *(uint4*)(H + (size_t)row * D + d0) = make_uint4(pack2bf(o[0], o[1]), pack2bf(o[2], o[3]), pack2bf(o[4], o[5]), pack2bf(o[6], o[7]));
      }
    }
  }
}

constexpr int SMEM_BYTES = 65536;
#ifndef PHMASK
#define PHMASK 0xFFFFFFFFFFFFFFFFull
#endif
#define PH(n, ...) if constexpr ((((unsigned long long)(PHMASK)) >> (n)) & 1ull) { __VA_ARGS__; }

__global__ __launch_bounds__(256, 2) void mega(Params p) {
  cg::grid_group grid = cg::this_grid();
  __shared__ __attribute__((aligned(16))) char smem_raw[SMEM_BYTES];
  float* smem = (float*)smem_raw;
  const float* x = p.in[0]; const float* c = p.in[1]; const float* ctx = p.in[2]; const float* c_ctx = p.in[3];
  const float* ada_w = p.in[4]; const float* ada_b = p.in[5]; const float* ln_g = p.in[6]; const float* ln_b = p.in[7];
  const float* even_w_in = p.in[8]; const float* even_w_out = p.in[9]; const float* rpb = p.in[10];
  const float* odd_w_in = p.in[11]; const float* odd_w_out = p.in[12]; const float* sink = p.in[13];
  const float* peer_wq = p.in[14]; const float* peer_sk = p.in[15]; const float* peer_u = p.in[16]; const float* peer_v = p.in[17];
  char* ws = (char*)p.ws;
  float* TAB = (float*)(ws + OFF_TAB); float* Mm = (float*)(ws + OFF_M);
  bf16_t* WIN0 = (bf16_t*)(ws + OFF_WIN0); bf16_t* WOUT0 = (bf16_t*)(ws + OFF_WOUT0);
  bf16_t* WIN1 = (bf16_t*)(ws + OFF_WIN1); bf16_t* WOUT1 = (bf16_t*)(ws + OFF_WOUT1);
  bf16_t* WQ = (bf16_t*)(ws + OFF_WQ); bf16_t* SKB = (bf16_t*)(ws + OFF_SK);
  bf16_t* UB = (bf16_t*)(ws + OFF_UB); bf16_t* VB = (bf16_t*)(ws + OFF_VB);
  bf16_t* AB = (bf16_t*)(ws + OFF_AB);
  bf16_t* FD1 = (bf16_t*)(ws + OFF_FT); bf16_t* FD3 = FD1 + 256 * 128; bf16_t* FDC = FD3 + 128 * 128;
  bf16_t* A1 = (bf16_t*)(ws + OFF_A1); bf16_t* VT0 = (bf16_t*)(ws + OFF_VT0); bf16_t* FQKV = (bf16_t*)(ws + OFF_BF);
  float* BF_ = (float*)(ws + OFF_BF); float* BY = (float*)(ws + OFF_BY);
  float* X1 = (float*)(ws + OFF_X1); float* X2 = (float*)(ws + OFF_X2);
  float* RT = TAB + 16384;
  bf16_t* Q1 = (bf16_t*)(ws + OFF_BF); bf16_t* K1 = Q1 + (size_t)T * 1024; bf16_t* VT1 = K1 + (size_t)R * 256;
  int* EXPB = (int*)(ws + OFF_BY); float* GATEB = (float*)(ws + OFF_BY + (size_t)R * 128 * 4);
  float* out = p.out;

  PH(0, ph_tables(TAB); ph_rope_table(RT))
  PH(1, ph_fft_tables(FD1, FD3, FDC))
  PH(2, ph_ada(c, c_ctx, ada_w, ada_b, Mm))
  PH(3, ph_transpose_w(even_w_in, 1024, 2048, WIN0, smem))
  PH(4, ph_transpose_w(even_w_out, 1024, 1024, WOUT0, smem))
  PH(5, ph_transpose_w(odd_w_in, 1024, 1536, WIN1, smem))
  PH(6, ph_transpose_w(odd_w_out, 1024, 1024, WOUT1, smem))
  PH(7, ph_transpose_w(peer_wq, 1024, 2048, WQ, smem))
  PH(8, ph_transpose_w(peer_wq + (size_t)1024 * 2048, 1024, 2048, WQ + (size_t)2048 * 1024, smem))
  PH(9, ph_convert(peer_u, UB, (size_t)2 * 16384 * 1024 / 8))
  PH(10, ph_convert(peer_v, VB, (size_t)2 * 16384 * 1024 / 8))
  PH(11, ph_convert(peer_sk, SKB, (size_t)2 * 8 * 2 * 128 * 128 / 8))
  grid.sync();
  PH(12, ph_modulate(x, ctx, Mm, 0, 0, 1, AB, R, smem))
  grid.sync();
  PH(13, ph_gemm_bf16(AB, 1024, WIN0, 1024, R, 2048, 1024, EpiQKV0{FQKV, VT0}, smem_raw))
  grid.sync();
  PH(14, { GRID_LOOP(u, NB * 64 * 8) fft1_unit(u, FQKV, FD1, TAB, A1, smem_raw); })
  PH(15, { int lane = threadIdx.x & 63, wave = threadIdx.x >> 6;
           for (int u0 = blockIdx.x * 4; u0 < 8192 + 256; u0 += gridDim.x * 4) { int u = u0 + wave;
             if (u < 8192) attn_unit<1, 0>(u, FQKV + 512, 2048, FQKV + 1024, 2048, VT0, VT0 + (size_t)NB * 8 * 64 * S, 8, rpb, nullptr, AB + 512, 1024, lane);
             else attn_unit<1, 1>(u - 8192, FQKV + 512, 2048, FQKV + 1024, 2048, VT0, VT0 + (size_t)NB * 8 * 64 * S, 8, rpb, nullptr, AB + 512, 1024, lane); } })
  grid.sync();
  PH(16, { GRID_LOOP(u, NB * 128 * 8 + NB * 4 * 8) { if (u < NB * 128 * 8) fft3_unit(u, 0, FQKV, A1, FD3, FDC, TAB, AB, smem_raw); else fft3_unit(u - NB * 128 * 8, 1, FQKV, A1, FD3, FDC, TAB, AB, smem_raw); } })
  grid.sync();
  PH(17, ph_gemm_bf16(AB, 1024, WOUT0, 1024, R, 1024, 1024, EpiF32{BY, 1024, 1.f}, smem_raw))
  grid.sync();
  PH(18, ph_post(x, ctx, BY, Mm, 0, 2, ln_g + 0, ln_b + 0, X1, X1 + (size_t)T * D, R, smem))
  grid.sync();
  PH(19, ph_modulate(X1, X1 + (size_t)T * D, Mm, 0, 3, 4, AB, R, smem))
  grid.sync();
  PH(21, ph_peer_select(AB, WQ, SKB, EXPB, GATEB, R, smem_raw))
  grid.sync();
  PH(22, ph_peer_gather(AB, EXPB, GATEB, UB, VB, X1, Mm, 0, ln_g + 1024, ln_b + 1024, X2, true, R))
  grid.sync();
  PH(23, ph_gemm_bf16(AB, 1024, WIN1, 1024, R, 1536, 1024, EpiQKV1{Q1, K1, VT1, RT}, smem_raw))
  grid.sync();
  PH(25, { int lane = threadIdx.x & 63, wave = threadIdx.x >> 6;
           for (int u0 = blockIdx.x * 4; u0 < 4096; u0 += gridDim.x * 4) { int u = u0 + wave;
             attn_unit<4, 2>(u, Q1, 1024, K1, 256, VT1, VT1 + (size_t)NB * 4 * 64 * S, 4, nullptr, sink, AB, 1024, lane); } })
  grid.sync();
  PH(26, ph_gemm_bf16(AB, 1024, WOUT1, 1024, T, 1024, 1024, EpiF32{BY, 1024, 1.f}, smem_raw))
  grid.sync();
  PH(27, ph_post(X2, X2, BY, Mm, 1, 2, ln_g + 2048, ln_b + 2048, X1, X1, T, smem))
  grid.sync();
  PH(28, ph_modulate(X1, X1, Mm, 1, 3, 4, AB, T, smem))
  grid.sync();
  PH(30, ph_peer_select(AB, WQ + (size_t)2048 * 1024, SKB + (size_t)8 * 2 * 128 * 128, EXPB, GATEB, T, smem_raw))
  grid.sync();
  PH(31, ph_peer_gather(AB, EXPB, GATEB, UB + (size_t)16384 * 1024, VB + (size_t)16384 * 1024, X1, Mm, 1, ln_g + 3072, ln_b + 3072, out, false, T))
}

}

extern "C" void kernel_launch(void* const* d_in, const int* in_sizes, int n_in, void* d_out, int out_size, void* d_ws,
                              size_t ws_size, hipStream_t stream) {
  static int grid_blocks = 0;
  if (!grid_blocks) {
    int dev = 0, cus = 0, per_cu = 0;
    hipGetDevice(&dev);
    hipDeviceGetAttribute(&cus, hipDeviceAttributeMultiprocessorCount, dev);
    hipOccupancyMaxActiveBlocksPerMultiprocessor(&per_cu, (const void*)mega, 256, 0);
    if (per_cu > 2) per_cu = 2;
    if (per_cu < 1) per_cu = 1;
    grid_blocks = cus * per_cu;
  }
  Params p{};
  for (int i = 0; i < 18; ++i) p.in[i] = (const float*)d_in[i];
  p.out = (float*)d_out;
  p.ws = (float*)d_ws;
  void* args[] = {&p};
  hipError_t e = hipLaunchCooperativeKernel((const void*)mega, dim3(grid_blocks), dim3(256), args, 0, stream);
  if (e != hipSuccess) fprintf(stderr, "cooperative launch failed: %s (grid %d)\n", hipGetErrorString(e), grid_blocks);
}
```

```cpp
#include <hip/hip_runtime.h>
#include <hip/hip_bf16.h>
#include <stdint.h>
#include <math.h>
#include <stdio.h>
#include <hip/hip_cooperative_groups.h>
namespace cg = cooperative_groups;

namespace {

constexpr int D = 1024;
constexpr int NB = 2;
constexpr int S = 8192;
constexpr int T = NB * S;
constexpr int CL = 256;
constexpr int TC = NB * CL;
constexpr int R = T + TC;
constexpr float DN_ALPHA = 1.4142135623730951f;
constexpr float LN_EPS = 1e-6f;

__device__ __forceinline__ float wave_sum(float v) {
#pragma unroll
  for (int off = 32; off; off >>= 1) v += __shfl_xor(v, off);
  return v;
}
__device__ __forceinline__ float wave_max(float v) {
#pragma unroll
  for (int off = 32; off; off >>= 1) v = fmaxf(v, __shfl_xor(v, off));
  return v;
}

typedef unsigned short bf16_t;
typedef __attribute__((ext_vector_type(8))) short bf16x8;
typedef __attribute__((ext_vector_type(16))) float f32x16;
typedef __attribute__((ext_vector_type(4))) float f32x4;

__device__ __forceinline__ unsigned f2bf(float f) {
  unsigned u = __float_as_uint(f);
  u += 0x7fffu + ((u >> 16) & 1u);
  return u >> 16;
}
__device__ __forceinline__ unsigned pack2bf(float a, float b) { return f2bf(a) | (f2bf(b) << 16); }
__device__ __forceinline__ float bf2f(unsigned short v) { return __uint_as_float(((unsigned)v) << 16); }

__device__ __forceinline__ int mod_index(int row) { return row < T ? row / S : 2; }


struct Params {
  const float* in[18];
  float* out;
  float* ws;
};

constexpr size_t XCD_BAR_WORDS_C = 3456;
constexpr size_t al256(size_t n) { return (n + 255) & ~(size_t)255; }
constexpr size_t OFF_BAR = 0;
constexpr size_t OFF_TAB = al256(XCD_BAR_WORDS_C * 4);
constexpr size_t OFF_M = OFF_TAB + al256(16384 * 4 + 128 * 16 * 2 * 4);
constexpr size_t OFF_WIN0 = OFF_M + al256(2 * 3 * 6144 * 4);
constexpr size_t OFF_WOUT0 = OFF_WIN0 + al256((size_t)2048 * 1024 * 2);
constexpr size_t OFF_WIN1 = OFF_WOUT0 + al256((size_t)1024 * 1024 * 2);
constexpr size_t OFF_WOUT1 = OFF_WIN1 + al256((size_t)1536 * 1024 * 2);
constexpr size_t OFF_WQ = OFF_WOUT1 + al256((size_t)1024 * 1024 * 2);
constexpr size_t OFF_SK = OFF_WQ + al256((size_t)2 * 2048 * 1024 * 2);
constexpr size_t OFF_UB = OFF_SK + al256((size_t)2 * 8 * 2 * 128 * 128 * 2);
constexpr size_t OFF_VB = OFF_UB + al256((size_t)2 * 16384 * 1024);
constexpr size_t OFF_USC = OFF_VB + al256((size_t)2 * 16384 * 1024);
constexpr size_t OFF_AB = OFF_USC + al256((size_t)4 * 16384 * 4);
constexpr size_t OFF_FT = OFF_AB + al256((size_t)R * 1024 * 2);
constexpr size_t OFF_BF = OFF_FT + al256((size_t)(256 * 128 + 128 * 128 + 64 * 128) * 2);
constexpr size_t OFF_BY = OFF_BF + al256((size_t)R * 2048 * 4);
constexpr size_t OFF_X1 = OFF_BY + al256((size_t)R * 1024 * 4);
constexpr size_t OFF_X2 = OFF_X1 + al256((size_t)R * 1024 * 4);
constexpr size_t OFF_END = OFF_X2 + al256((size_t)R * 1024 * 4);
constexpr size_t OFF_A1 = OFF_BY;
constexpr size_t OFF_VT0 = OFF_X2;
static_assert(OFF_END <= (size_t)512 * 1024 * 1024, "workspace overflow");

#define GRID_LOOP(var, n) for (int var = blockIdx.x; var < (n); var += gridDim.x)

__device__ __forceinline__ void ph_fft_tables(bf16_t* D1, bf16_t* D3, bf16_t* DcT) {
  const double TWO_PI = 6.283185307179586476925286766559;
  for (int i = blockIdx.x * 256 + threadIdx.x; i < 256 * 128 + 128 * 128 + 64 * 128; i += gridDim.x * 256) {
    if (i < 256 * 128) {
      int m = i >> 7, r = i & 127; int k1 = m >> 1, ri = m & 1;
      double a = TWO_PI * (double)((k1 * r) & 127) / 128.0;
      D1[i] = (bf16_t)f2bf(ri == 0 ? (float)cos(a) : (float)(-sin(a)));
    } else if (i < 256 * 128 + 128 * 128) {
      int j = i - 256 * 128; int m = j >> 7, kk = j & 127; int rip = m >> 6, k2 = m & 63; int c = kk >> 1, ri = kk & 1;
      double a = TWO_PI * (double)((k2 * c) & 63) / 64.0;
      double v = (rip == 0) ? (ri == 0 ? cos(a) : sin(a)) : (ri == 0 ? -sin(a) : cos(a));
      D3[j] = (bf16_t)f2bf((float)v);
    } else {
      int j = i - 256 * 128 - 128 * 128; int cp = j >> 7, kk = j & 127; int rip = kk >> 6, ch = kk & 63;
      double a = TWO_PI * (double)((ch * cp) & 63) / 64.0;
      DcT[j] = (bf16_t)f2bf((float)(rip == 0 ? cos(a) : sin(a)));
    }
  }
}
__device__ __forceinline__ void ph_rope_table(float* RT) {
  for (int i = blockIdx.x * 256 + threadIdx.x; i < 128 * 16; i += gridDim.x * 256) {
    int pos = i >> 4, f = i & 15;
    float inv_freq = powf(10000.0f, -(float)f / 16.0f);
    float ang = (float)pos * inv_freq;
    RT[2 * i] = cosf(ang); RT[2 * i + 1] = sinf(ang);
  }
}
__device__ __forceinline__ void ph_tables(float* tab) {
  for (int j = blockIdx.x * 256 + threadIdx.x; j < 8192; j += gridDim.x * 256) {
    double a = 6.283185307179586476925286766559 * (double)j / 8192.0;
    tab[j] = (float)cos(a);
    tab[8192 + j] = (float)sin(a);
  }
}
__device__ __forceinline__ void ph_ada(const float* __restrict__ c, const float* __restrict__ c_ctx, const float* __restrict__ ada_w,
                       const float* __restrict__ ada_b, float* __restrict__ M) {
  for (int gid = blockIdx.x * 256 + threadIdx.x; gid < 2 * 3 * 6144; gid += gridDim.x * 256) {
    int col = gid % 6144; int idx = (gid / 6144) % 3; int layer = gid / (3 * 6144);
    const float* vec = idx < 2 ? c + idx * D : c_ctx;
    const float* w = ada_w + (size_t)layer * D * 6144 + col;
    float acc = 0.f;
    for (int k = 0; k < D; ++k) {
      float x = vec[k];
      float sx = x / (1.f + expf(-x));
      acc += sx * w[(size_t)k * 6144];
    }
    M[gid] = acc + ada_b[layer * 6144 + col];
  }
}

__device__ __forceinline__ void ph_modulate(const float* __restrict__ xa, const float* __restrict__ xb, const float* __restrict__ M, int layer,
                            int jshift, int jscale, bf16_t* __restrict__ out, int nrows, float* red) {
  int tid = threadIdx.x;
  GRID_LOOP(row, nrows) {
    const float* x = row < T ? xa + (size_t)row * D : xb + (size_t)(row - T) * D;
    float v[4]; float s = 0.f;
#pragma unroll
    for (int i = 0; i < 4; ++i) { v[i] = x[tid + 256 * i]; s += v[i]; }
    s = wave_sum(s);
    __syncthreads();
    if ((tid & 63) == 0) red[tid >> 6] = s;
    __syncthreads();
    float mu = (red[0] + red[1] + red[2] + red[3]) * (1.f / D);
    float q = 0.f;
#pragma unroll
    for (int i = 0; i < 4; ++i) { float d = v[i] - mu; q += d * d; }
    q = wave_sum(q);
    if ((tid & 63) == 0) red[4 + (tid >> 6)] = q;
    __syncthreads();
    float var = (red[4] + red[5] + red[6] + red[7]) * (1.f / D);
    float rs = rsqrtf(var + LN_EPS);
    const float* m = M + ((size_t)layer * 3 + mod_index(row)) * 6144;
#pragma unroll
    for (int i = 0; i < 4; ++i) {
      int col = tid + 256 * i;
      float y = (v[i] - mu) * rs;
      out[(size_t)row * D + col] = (bf16_t)f2bf(y * (1.f + m[jscale * D + col]) + m[jshift * D + col]);
    }
  }
}

__device__ __forceinline__ void ph_post(const float* __restrict__ xa, const float* __restrict__ xb, const float* __restrict__ Y,
                        const float* __restrict__ M, int layer, int j, const float* __restrict__ g, const float* __restrict__ bb,
                        float* __restrict__ outa, float* __restrict__ outb, int nrows, float* red) {
  int tid = threadIdx.x;
  GRID_LOOP(row, nrows) {
    const float* x = row < T ? xa + (size_t)row * D : xb + (size_t)(row - T) * D;
    float* out = row < T ? outa + (size_t)row * D : outb + (size_t)(row - T) * D;
    const float* m = M + ((size_t)layer * 3 + mod_index(row)) * 6144 + j * D;
    float v[4]; float s = 0.f;
#pragma unroll
    for (int i = 0; i < 4; ++i) { int col = tid + 256 * i; v[i] = DN_ALPHA * x[col] + m[col] * Y[(size_t)row * D + col]; s += v[i]; }
    s = wave_sum(s);
    __syncthreads();
    if ((tid & 63) == 0) red[tid >> 6] = s;
    __syncthreads();
    float mu = (red[0] + red[1] + red[2] + red[3]) * (1.f / D);
    float q = 0.f;
#pragma unroll
    for (int i = 0; i < 4; ++i) { float d = v[i] - mu; q += d * d; }
    q = wave_sum(q);
    if ((tid & 63) == 0) red[4 + (tid >> 6)] = q;
    __syncthreads();
    float var = (red[4] + red[5] + red[6] + red[7]) * (1.f / D);
    float rs = rsqrtf(var + LN_EPS);
#pragma unroll
    for (int i = 0; i < 4; ++i) {
      int col = tid + 256 * i;
      out[col] = (v[i] - mu) * rs * g[col] + bb[col];
    }
  }
}

struct ARow { const float* A; int lda; __device__ float operator()(int m, int k) const { return A[(size_t)m * lda + k]; } };
struct BRow { const float* B; int ldb; __device__ float operator()(int k, int n) const { return B[(size_t)k * ldb + n]; } };
struct CRow { float* C; int ldc; float scale; __device__ void operator()(int m, int n, float v) const { C[(size_t)m * ldc + n] = v * scale; } };
struct CRowB { bf16_t* C; int ldc; float scale; __device__ void operator()(int m, int n, float v) const { C[(size_t)m * ldc + n] = (bf16_t)f2bf(v * scale); } };
struct ADft { const float* tab; int Sn; int stride; __device__ float operator()(int m, int k) const {
    int t = k & (Sn - 1); int idx = ((m * t) & (Sn - 1)) * stride;
    return k < Sn ? tab[idx] : -tab[8192 + idx]; } };
struct BPQ { const float* PQ; int rowbase; int Sn; __device__ float operator()(int k, int n) const {
    int t = k & (Sn - 1); return PQ[(size_t)(rowbase + t) * 1024 + (k >= Sn ? 512 : 0) + n]; } };

template <class AF, class BF, class CF>
__device__ __forceinline__ void ph_gemm(AF af, BF bf, CF cf, int M, int N, int K, float* sm) {
  float (*sA)[68] = (float (*)[68])sm;
  float (*sB)[68] = (float (*)[68])(sm + 16 * 68);
  int tid = threadIdx.x; int tx = tid & 15, ty = tid >> 4;
  int ntn = N / 64; int ntiles = (M / 64) * ntn;
  GRID_LOOP(tile, ntiles) {
    int m0 = (tile / ntn) * 64, n0 = (tile % ntn) * 64;
    float acc[4][4];
#pragma unroll
    for (int i = 0; i < 4; ++i)
#pragma unroll
      for (int j = 0; j < 4; ++j) acc[i][j] = 0.f;
    for (int k0 = 0; k0 < K; k0 += 16) {
      __syncthreads();
#pragma unroll
      for (int i = 0; i < 4; ++i) { int e = tid + 256 * i; int m = e >> 4, k = e & 15; sA[k][m] = af(m0 + m, k0 + k); }
#pragma unroll
      for (int i = 0; i < 4; ++i) { int e = tid + 256 * i; int k = e >> 6, n = e & 63; sB[k][n] = bf(k0 + k, n0 + n); }
      __syncthreads();
#pragma unroll
      for (int k = 0; k < 16; ++k) {
        float a[4], b[4];
#pragma unroll
        for (int i = 0; i < 4; ++i) { a[i] = sA[k][ty * 4 + i]; b[i] = sB[k][tx * 4 + i]; }
#pragma unroll
        for (int i = 0; i < 4; ++i)
#pragma unroll
          for (int j = 0; j < 4; ++j) acc[i][j] += a[i] * b[j];
      }
    }
#pragma unroll
    for (int i = 0; i < 4; ++i)
#pragma unroll
      for (int j = 0; j < 4; ++j) cf(m0 + ty * 4 + i, n0 + tx * 4 + j, acc[i][j]);
  }
}


__device__ __forceinline__ void ph_transpose_w(const float* __restrict__ W, int K, int N, bf16_t* __restrict__ Wt, float* sm) {
  int tid = threadIdx.x;
  int tk = K / 64, tn = N / 64;
  GRID_LOOP(tile, tk * tn) {
    int k0 = (tile / tn) * 64, n0 = (tile % tn) * 64;
    __syncthreads();
#pragma unroll
    for (int i = 0; i < 16; ++i) { int e = tid + 256 * i; int k = e >> 6, n = e & 63; sm[k * 65 + n] = W[(size_t)(k0 + k) * N + n0 + n]; }
    __syncthreads();
#pragma unroll
    for (int i = 0; i < 2; ++i) {
      int e = tid + 256 * i; int n = e >> 3, kc = e & 7;
      unsigned w[4];
#pragma unroll
      for (int j = 0; j < 4; ++j) w[j] = pack2bf(sm[(kc * 8 + 2 * j) * 65 + n], sm[(kc * 8 + 2 * j + 1) * 65 + n]);
      *(uint4*)(Wt + (size_t)(n0 + n) * K + k0 + kc * 8) = make_uint4(w[0], w[1], w[2], w[3]);
    }
  }
}
__device__ __forceinline__ void ph_convert(const float* __restrict__ src, bf16_t* __restrict__ dst, size_t n8) {
  for (size_t i = (size_t)blockIdx.x * 256 + threadIdx.x; i < n8; i += (size_t)gridDim.x * 256) {
    float4 a = ((const float4*)src)[2 * i], b = ((const float4*)src)[2 * i + 1];
    ((uint4*)dst)[i] = make_uint4(pack2bf(a.x, a.y), pack2bf(a.z, a.w), pack2bf(b.x, b.y), pack2bf(b.z, b.w));
  }
}

__device__ __forceinline__ void gemm_stage(const bf16_t* __restrict__ A, int lda, int k0, char* lds, int tid) {
#pragma unroll
  for (int i = 0; i < 4; ++i) {
    int q = tid + 256 * i; int row = q >> 3, p = q & 7; int c = p ^ ((row >> 1) & 7);
    const bf16_t* src = A + (size_t)row * lda + k0 + c * 8;
    __builtin_amdgcn_global_load_lds((const unsigned*)src, (unsigned*)(lds + q * 16), 16, 0, 0);
  }
}
struct EpiF32 {
  float* C; int ldc; float scale;
  __device__ __forceinline__ void operator()(int m0, int n0, int wm, int wn, f32x16 (&acc)[2][2], int tid, char* smem) const {
    int lane = tid & 63;
    float* t = (float*)smem;
    int rbase = wm * 64 + 4 * (lane >> 5), cbase = wn * 64 + (lane & 31);
#pragma unroll
    for (int mi = 0; mi < 2; ++mi)
#pragma unroll
      for (int ni = 0; ni < 2; ++ni)
#pragma unroll
        for (int r = 0; r < 16; ++r)
          t[(rbase + mi * 32 + (r & 3) + 8 * (r >> 2)) * 128 + cbase + ni * 32] = acc[mi][ni][r] * scale;
    __syncthreads();
    float* dst = C + (size_t)(m0 + (tid >> 5)) * ldc + n0 + (tid & 31) * 4;
    const float* src = t + (tid >> 5) * 128 + (tid & 31) * 4;
#pragma unroll 4
    for (int i = 0; i < 16; ++i) {
      *(float4*)dst = *(const float4*)src;
      dst += (size_t)8 * ldc; src += 8 * 128;
    }
  }
};
struct EpiQKV0 {
  bf16_t* FQKV; bf16_t* VT;
  __device__ __forceinline__ void operator()(int m0, int n0, int wm, int wn, f32x16 (&acc)[2][2], int tid, char* smem) const {
    int lane = tid & 63;
    bf16_t* t = (bf16_t*)smem;
    int rbase = wm * 64 + 4 * (lane >> 5), cbase = wn * 64 + (lane & 31);
#pragma unroll
    for (int mi = 0; mi < 2; ++mi)
#pragma unroll
      for (int ni = 0; ni < 2; ++ni)
#pragma unroll
        for (int r = 0; r < 16; ++r)
          t[(rbase + mi * 32 + (r & 3) + 8 * (r >> 2)) * 136 + cbase + ni * 32] = (bf16_t)f2bf(acc[mi][ni][r]);
    __syncthreads();
    {
      bf16_t* dst = FQKV + (size_t)(m0 + (tid >> 4)) * 2048 + n0 + (tid & 15) * 8;
      const bf16_t* src = t + (tid >> 4) * 136 + (tid & 15) * 8;
#pragma unroll 4
      for (int i = 0; i < 8; ++i) {
        *(uint4*)dst = *(const uint4*)src;
        dst += (size_t)16 * 2048; src += 16 * 136;
      }
    }
    if (n0 >= 1536) {
      int col = tid >> 1, half = tid & 1;
      int hd = (n0 - 1536) / 64 + (col >> 6), d = col & 63;
      bf16_t* dst;
      if (m0 < T) { int b = m0 / S, t0 = m0 % S; dst = VT + (((size_t)b * 8 + hd) * 64 + d) * S + t0 + half * 64; }
      else { int mm = m0 - T; int b = mm / CL, l0 = mm % CL; dst = VT + (size_t)NB * 8 * 64 * S + (((size_t)b * 8 + hd) * 64 + d) * CL + l0 + half * 64; }
      const bf16_t* src = t + (half * 64) * 136 + col;
#pragma unroll
      for (int i = 0; i < 8; ++i) {
        unsigned wv[4];
#pragma unroll
        for (int j = 0; j < 4; ++j) wv[j] = (unsigned)src[(i * 8 + 2 * j) * 136] | ((unsigned)src[(i * 8 + 2 * j + 1) * 136] << 16);
        *(uint4*)(dst + i * 8) = make_uint4(wv[0], wv[1], wv[2], wv[3]);
      }
    }
  }
};
struct EpiQKV1 {
  bf16_t* Q1; bf16_t* K1; bf16_t* VT; const float* RT;
  __device__ __forceinline__ void operator()(int m0, int n0, int wm, int wn, f32x16 (&acc)[2][2], int tid, char* smem) const {
    int lane = tid & 63;
    asm volatile("" : "+v"(lane));
    bf16_t* t = (bf16_t*)smem;
    if (n0 < 1280 && m0 < T) {
      int i = lane & 31; int f = i & 15;
#pragma unroll
      for (int mi = 0; mi < 2; ++mi)
#pragma unroll
        for (int r = 0; r < 16; ++r) {
          int row = m0 + wm * 64 + 4 * (lane >> 5) + mi * 32 + (r & 3) + 8 * (r >> 2);
          int tt = row & (S - 1);
          int pos = (i < 16) ? (tt >> 6) : (tt & 63);
          float2 cs = *(const float2*)(RT + 2 * (pos * 16 + f));
          float x1 = acc[mi][0][r], x2 = acc[mi][1][r];
          acc[mi][0][r] = x1 * cs.x - x2 * cs.y;
          acc[mi][1][r] = x1 * cs.y + x2 * cs.x;
        }
    }
    {
      bf16_t* tw = t + (wm * 64 + 4 * (lane >> 5)) * 136 + wn * 64 + (lane & 31);
#pragma unroll
      for (int mi = 0; mi < 2; ++mi)
#pragma unroll
        for (int ni = 0; ni < 2; ++ni)
#pragma unroll
          for (int r = 0; r < 16; ++r)
            tw[(mi * 32 + (r & 3) + 8 * (r >> 2)) * 136 + ni * 32] = (bf16_t)f2bf(acc[mi][ni][r]);
    }
    __syncthreads();
    if (n0 < 1280) {
      bf16_t* dst; int ld;
      if (n0 < 1024) { dst = Q1 + (size_t)(m0 + (tid >> 4)) * 1024 + n0 + (tid & 15) * 8; ld = 1024; }
      else { dst = K1 + (size_t)(m0 + (tid >> 4)) * 256 + (n0 - 1024) + (tid & 15) * 8; ld = 256; }
      if (n0 >= 1024 || m0 < T) {
        const bf16_t* src = t + (tid >> 4) * 136 + (tid & 15) * 8;
#pragma unroll 4
        for (int i = 0; i < 8; ++i) {
          *(uint4*)dst = *(const uint4*)src;
          dst += (size_t)16 * ld; src += 16 * 136;
        }
      }
    } else {
      int col = tid >> 1, half = tid & 1;
      int hd = (n0 - 1280) / 64 + (col >> 6), d = col & 63;
      bf16_t* dst;
      if (m0 < T) { int b = m0 / S, t0 = m0 % S; dst = VT + (((size_t)b * 4 + hd) * 64 + d) * S + t0 + half * 64; }
      else { int mm = m0 - T; int b = mm / CL, l0 = mm % CL; dst = VT + (size_t)NB * 4 * 64 * S + (((size_t)b * 4 + hd) * 64 + d) * CL + l0 + half * 64; }
      const bf16_t* src = t + (half * 64) * 136 + col;
#pragma unroll
      for (int i = 0; i < 8; ++i) {
        unsigned wv[4];
#pragma unroll
        for (int j = 0; j < 4; ++j) wv[j] = (unsigned)src[(i * 8 + 2 * j) * 136] | ((unsigned)src[(i * 8 + 2 * j + 1) * 136] << 16);
        *(uint4*)(dst + i * 8) = make_uint4(wv[0], wv[1], wv[2], wv[3]);
      }
    }
  }
};
__device__ __forceinline__ void gemm_tile_mainloop(const bf16_t* __restrict__ Ag, int lda, const bf16_t* __restrict__ Bg, int ldb, int KT,
                                                   f32x16 (&acc)[2][2], char* smem) {
  int tid = threadIdx.x;
  asm volatile("" : "+v"(tid));
  int lane = tid & 63, wave = tid >> 6, wm = wave >> 1, wn = wave & 1;
#pragma unroll
  for (int mi = 0; mi < 2; ++mi)
#pragma unroll
    for (int ni = 0; ni < 2; ++ni)
#pragma unroll
      for (int r = 0; r < 16; ++r) acc[mi][ni][r] = 0.f;
  __syncthreads();
  gemm_stage(Ag, lda, 0, smem, tid); gemm_stage(Bg, ldb, 0, smem + 16384, tid);
  for (int kt = 0; kt < KT; ++kt) {
    asm volatile("s_waitcnt vmcnt(0)" ::: "memory");
    __syncthreads();
    char* cur = smem + (kt & 1) * 32768;
    if (kt + 1 < KT) {
      char* nxt = smem + ((kt + 1) & 1) * 32768;
      gemm_stage(Ag, lda, (kt + 1) * 64, nxt, tid); gemm_stage(Bg, ldb, (kt + 1) * 64, nxt + 16384, tid);
    }
#pragma unroll
    for (int s4 = 0; s4 < 4; ++s4) {
      bf16x8 a[2], b[2];
      int c = 2 * s4 + (lane >> 5);
#pragma unroll
      for (int mi = 0; mi < 2; ++mi) { int row = wm * 64 + mi * 32 + (lane & 31); a[mi] = *(const bf16x8*)(cur + row * 128 + ((c ^ ((row >> 1) & 7)) << 4)); }
#pragma unroll
      for (int ni = 0; ni < 2; ++ni) { int row = wn * 64 + ni * 32 + (lane & 31); b[ni] = *(const bf16x8*)(cur + 16384 + row * 128 + ((c ^ ((row >> 1) & 7)) << 4)); }
#pragma unroll
      for (int mi = 0; mi < 2; ++mi)
#pragma unroll
        for (int ni = 0; ni < 2; ++ni) acc[mi][ni] = __builtin_amdgcn_mfma_f32_32x32x16_bf16(a[mi], b[ni], acc[mi][ni], 0, 0, 0);
    }
  }
  __syncthreads();
}
template <class Epi>
__device__ __forceinline__ void ph_gemm_bf16(const bf16_t* __restrict__ A, int lda, const bf16_t* __restrict__ Bt, int ldb, int M, int N, int K,
                             Epi epi, char* smem) {
  int tid = threadIdx.x, wave = tid >> 6, wm = wave >> 1, wn = wave & 1;
  int ntn = N / 128, ntiles = (M / 128) * ntn;
  int KT = K / 64;
  GRID_LOOP(tile, ntiles) {
    int mt = tile / ntn, nt = tile % ntn;
    f32x16 acc[2][2];
    gemm_tile_mainloop(A + (size_t)mt * 128 * lda, lda, Bt + (size_t)nt * 128 * ldb, ldb, KT, acc, smem);
    epi(mt * 128, nt * 128, wm, wn, acc, tid, smem);
  }
}

__device__ __forceinline__ void ins16(float (&L)[16], float x) {
#pragma unroll
  for (int j = 15; j >= 1; --j) L[j] = __builtin_amdgcn_fmed3f(L[j - 1], L[j], x);
  L[0] = fmaxf(L[0], x);
}
__device__ __forceinline__ void stage_tile128(const bf16_t* __restrict__ src, int ld, char* lds, int tid) {
#pragma unroll
  for (int i = 0; i < 8; ++i) {
    int q = tid + 256 * i; int row = q >> 4, p = q & 15; int c = p ^ (row & 15);
    __builtin_amdgcn_global_load_lds((const unsigned*)(src + (size_t)row * ld + c * 8), (unsigned*)(lds + q * 16), 16, 0, 0);
  }
}
__device__ __forceinline__ void ph_peer_select(const bf16_t* __restrict__ H, const bf16_t* __restrict__ WQl, const bf16_t* __restrict__ SKl,
                                               int* __restrict__ EXP, float* __restrict__ GATE, int nrows, char* smem) {
  int tid = threadIdx.x, w = tid >> 6, wm = w >> 1, wn = w & 1;
  bf16_t* Qs = (bf16_t*)smem;
  int* KL = (int*)(smem + 36864);
  int nunits = (nrows / 128) * 8;
  GRID_LOOP(unit, nunits) {
    int mt = unit >> 3, h = unit & 7;
    float L0[16], L1[16];
#pragma unroll
    for (int p = 0; p < 2; ++p) {
      f32x16 acc[2][2];
      gemm_tile_mainloop(H + (size_t)mt * 128 * 1024, 1024, WQl + (size_t)(h * 256 + p * 128) * 1024, 1024, 16, acc, smem);
      int lane = tid & 63;
      asm volatile("" : "+v"(lane));
      {
        bf16_t* qw = Qs + (wm * 64 + 4 * (lane >> 5)) * 136 + wn * 64 + (lane & 31);
#pragma unroll
        for (int mi = 0; mi < 2; ++mi)
#pragma unroll
          for (int ni = 0; ni < 2; ++ni)
#pragma unroll
            for (int r = 0; r < 16; ++r)
              qw[(mi * 32 + (r & 3) + 8 * (r >> 2)) * 136 + ni * 32] = (bf16_t)f2bf(acc[mi][ni][r]);
      }
      __syncthreads();
      f32x16 sc[4];
#pragma unroll
      for (int m4 = 0; m4 < 4; ++m4)
#pragma unroll
        for (int r = 0; r < 16; ++r) sc[m4][r] = 0.f;
      {
        const bf16_t* qrow = Qs + (32 * w + (lane & 31)) * 136 + 8 * (lane >> 5);
        const bf16_t* krow = SKl + (size_t)(h * 2 + p) * 128 * 128 + (lane & 31) * 128 + 8 * (lane >> 5);
#pragma unroll
        for (int s8 = 0; s8 < 8; ++s8) {
          bf16x8 bq = *(const bf16x8*)(qrow + 16 * s8);
#pragma unroll
          for (int m4 = 0; m4 < 4; ++m4) {
            bf16x8 ak = *(const bf16x8*)(krow + m4 * 32 * 128 + 16 * s8);
            sc[m4] = __builtin_amdgcn_mfma_f32_32x32x16_bf16(ak, bq, sc[m4], 0, 0, 0);
          }
        }
      }
      float L[16];
#pragma unroll
      for (int j = 0; j < 16; ++j) L[j] = -INFINITY;
      unsigned kb = 4u * (unsigned)(lane >> 5);
#pragma unroll
      for (int m4 = 0; m4 < 4; ++m4)
#pragma unroll
        for (int r = 0; r < 16; ++r) {
          unsigned key = kb + (unsigned)(32 * m4 + (r & 3) + 8 * (r >> 2));
          float x = __uint_as_float((__float_as_uint(sc[m4][r]) & 0xFFFFFF80u) | key);
          ins16(L, x);
        }
      float P[16];
#pragma unroll
      for (int j = 0; j < 16; ++j) P[j] = __shfl_xor(L[j], 32);
#pragma unroll
      for (int j = 0; j < 16; ++j) ins16(L, P[j]);
      if (p == 0) {
#pragma unroll
        for (int j = 0; j < 16; ++j) L0[j] = L[j];
      } else {
#pragma unroll
        for (int j = 0; j < 16; ++j) L1[j] = L[j];
      }
    }
    float C[16];
#pragma unroll
    for (int j = 0; j < 16; ++j) C[j] = -INFINITY;
#pragma unroll
    for (int a = 0; a < 16; ++a)
#pragma unroll
      for (int b = 0; b < 16; ++b)
        if ((a + 1) * (b + 1) <= 16) {
          float sa = __uint_as_float(__float_as_uint(L0[a]) & 0xFFFFFF80u);
          float sb = __uint_as_float(__float_as_uint(L1[b]) & 0xFFFFFF80u);
          float x = __uint_as_float((__float_as_uint(sa + sb) & 0xFFFFFF00u) | (unsigned)(a * 16 + b));
          ins16(C, x);
        }
    int lane = tid & 63;
    asm volatile("" : "+v"(lane));
    int token = 32 * w + (lane & 31);
    if (lane < 32) {
#pragma unroll
      for (int j = 0; j < 16; ++j) { KL[token * 32 + j] = (int)(__float_as_uint(L0[j]) & 0x7Fu); KL[token * 32 + 16 + j] = (int)(__float_as_uint(L1[j]) & 0x7Fu); }
    }
    __syncthreads();
    if (lane < 32) {
      float c0 = __uint_as_float(__float_as_uint(C[0]) & 0xFFFFFF00u);
      float ev[16]; float sum = 0.f; int ex[16];
#pragma unroll
      for (int j = 0; j < 16; ++j) {
        unsigned bits = __float_as_uint(C[j]);
        float cv = __uint_as_float(bits & 0xFFFFFF00u);
        ev[j] = __expf(cv - c0); sum += ev[j];
        int a = (bits >> 4) & 15, b = bits & 15;
        ex[j] = KL[token * 32 + a] * 128 + KL[token * 32 + 16 + b];
      }
      float inv = 1.f / sum;
      size_t o = (size_t)(mt * 128 + token) * 128 + h * 16;
#pragma unroll
      for (int j = 0; j < 16; j += 4) {
        *(int4*)(EXP + o + j) = make_int4(ex[j], ex[j + 1], ex[j + 2], ex[j + 3]);
        *(float4*)(GATE + o + j) = make_float4(ev[j] * inv, ev[j + 1] * inv, ev[j + 2] * inv, ev[j + 3] * inv);
      }
    }
  }
}

__device__ __forceinline__ void fft1_unit(int u, const bf16_t* __restrict__ FQKV, const bf16_t* __restrict__ D1, const float* __restrict__ TAB,
                          bf16_t* __restrict__ A1, char* smem) {
  int tid = threadIdx.x, lane = tid & 63, w = tid >> 6;
  int g = u & 7, c = (u >> 3) & 63, b = u >> 9;
  bf16_t* Bt = (bf16_t*)smem;
  __syncthreads();
  {
    int r = tid >> 1, half = tid & 1;
    const uint4* src = (const uint4*)(FQKV + (size_t)(b * S + 64 * r + c) * 2048 + g * 64 + half * 32);
    unsigned wv[16];
#pragma unroll
    for (int i = 0; i < 4; ++i) { uint4 v = src[i]; wv[4 * i] = v.x; wv[4 * i + 1] = v.y; wv[4 * i + 2] = v.z; wv[4 * i + 3] = v.w; }
#pragma unroll
    for (int j = 0; j < 32; ++j) {
      unsigned e = (j & 1) ? (wv[j >> 1] >> 16) : (wv[j >> 1] & 0xffffu);
      Bt[(half * 32 + j) * 136 + r] = (bf16_t)e;
    }
  }
  __syncthreads();
  f32x16 acc[2][2];
#pragma unroll
  for (int mi = 0; mi < 2; ++mi)
#pragma unroll
    for (int ni = 0; ni < 2; ++ni)
#pragma unroll
      for (int r = 0; r < 16; ++r) acc[mi][ni][r] = 0.f;
#pragma unroll
  for (int s8 = 0; s8 < 8; ++s8) {
    bf16x8 a[2], bb[2];
    int ko = 16 * s8 + 8 * (lane >> 5);
#pragma unroll
    for (int mi = 0; mi < 2; ++mi) a[mi] = *(const bf16x8*)(D1 + (64 * w + 32 * mi + (lane & 31)) * 128 + ko);
#pragma unroll
    for (int ni = 0; ni < 2; ++ni) bb[ni] = *(const bf16x8*)(Bt + (32 * ni + (lane & 31)) * 136 + ko);
#pragma unroll
    for (int mi = 0; mi < 2; ++mi)
#pragma unroll
      for (int ni = 0; ni < 2; ++ni) acc[mi][ni] = __builtin_amdgcn_mfma_f32_32x32x16_bf16(a[mi], bb[ni], acc[mi][ni], 0, 0, 0);
  }
#pragma unroll
  for (int mi = 0; mi < 2; ++mi)
#pragma unroll
    for (int j = 0; j < 8; ++j) {
      int m = 64 * w + 32 * mi + ((2 * j) & 3) + 8 * ((2 * j) >> 2) + 4 * (lane >> 5);
      int k1 = m >> 1;
      int idx = (k1 * c) & 8191;
      float cs = TAB[idx], sn = TAB[8192 + idx];
#pragma unroll
      for (int ni = 0; ni < 2; ++ni) {
        float re = acc[mi][ni][2 * j], im = acc[mi][ni][2 * j + 1];
        float re2 = re * cs + im * sn, im2 = im * cs - re * sn;
        bf16_t* dst = A1 + ((((size_t)b * 64 + c) * 128 + k1) * 2) * 512 + g * 64 + 32 * ni + (lane & 31);
        dst[0] = (bf16_t)f2bf(re2); dst[512] = (bf16_t)f2bf(im2);
      }
    }
}

__device__ __forceinline__ void fft3_unit(int u, int mode, const bf16_t* __restrict__ FQKV, const bf16_t* __restrict__ A1, const bf16_t* __restrict__ D3,
                          const bf16_t* __restrict__ DcT, const float* __restrict__ TAB, bf16_t* __restrict__ MIX, char* smem) {
  int tid = threadIdx.x, lane = tid & 63, w = tid >> 6;
  bf16_t* Bt = (bf16_t*)smem;
  bf16_t* Xs = (bf16_t*)(smem + 17408);
  int g = u & 7, k1, b, nk1, rowbase; float norm;
  __syncthreads();
  if (mode == 0) {
    k1 = (u >> 3) & 127; b = u >> 10; nk1 = 128; rowbase = b * S; norm = 1.f / 724.0773439350247f;
    int kk = tid >> 1, half = tid & 1; int c = kk >> 1, ri = kk & 1;
    const uint4* src = (const uint4*)(A1 + ((((size_t)b * 64 + c) * 128 + k1) * 2 + ri) * 512 + g * 64 + half * 32);
    unsigned wv[16];
#pragma unroll
    for (int i = 0; i < 4; ++i) { uint4 v = src[i]; wv[4 * i] = v.x; wv[4 * i + 1] = v.y; wv[4 * i + 2] = v.z; wv[4 * i + 3] = v.w; }
#pragma unroll
    for (int j = 0; j < 32; ++j) {
      unsigned e = (j & 1) ? (wv[j >> 1] >> 16) : (wv[j >> 1] & 0xffffu);
      Bt[(half * 32 + j) * 136 + kk] = (bf16_t)e;
    }
  } else {
    k1 = (u >> 3) & 3; b = u >> 5; nk1 = 4; rowbase = T + b * CL; norm = 1.f / 128.f;
    int c = tid >> 2, q4 = tid & 3;
    float re[16], im[16];
#pragma unroll
    for (int j = 0; j < 16; ++j) { re[j] = 0.f; im[j] = 0.f; }
#pragma unroll
    for (int r = 0; r < 4; ++r) {
      const uint4* src = (const uint4*)(FQKV + (size_t)(rowbase + 64 * r + c) * 2048 + g * 64 + q4 * 16);
      uint4 v0 = src[0], v1 = src[1];
      unsigned wv[8] = {v0.x, v0.y, v0.z, v0.w, v1.x, v1.y, v1.z, v1.w};
      int ph = (k1 * r) & 3;
      float cr = (ph == 0) ? 1.f : (ph == 2 ? -1.f : 0.f);
      float ci = (ph == 1) ? -1.f : (ph == 3 ? 1.f : 0.f);
#pragma unroll
      for (int j = 0; j < 16; ++j) {
        float x = bf2f((unsigned short)((j & 1) ? (wv[j >> 1] >> 16) : (wv[j >> 1] & 0xffffu)));
        re[j] += x * cr; im[j] += x * ci;
      }
    }
    int idx = (k1 * c * 32) & 8191;
    float cs = TAB[idx], sn = TAB[8192 + idx];
#pragma unroll
    for (int j = 0; j < 16; ++j) {
      float re2 = re[j] * cs + im[j] * sn, im2 = im[j] * cs - re[j] * sn;
      *(unsigned*)(Bt + (q4 * 16 + j) * 136 + 2 * c) = pack2bf(re2, im2);
    }
  }
  __syncthreads();
  {
    f32x16 acc[2];
#pragma unroll
    for (int ni = 0; ni < 2; ++ni)
#pragma unroll
      for (int r = 0; r < 16; ++r) acc[ni][r] = 0.f;
#pragma unroll
    for (int s8 = 0; s8 < 8; ++s8) {
      int ko = 16 * s8 + 8 * (lane >> 5);
      bf16x8 a = *(const bf16x8*)(D3 + (32 * w + (lane & 31)) * 128 + ko);
#pragma unroll
      for (int ni = 0; ni < 2; ++ni) {
        bf16x8 bb = *(const bf16x8*)(Bt + (32 * ni + (lane & 31)) * 136 + ko);
        acc[ni] = __builtin_amdgcn_mfma_f32_32x32x16_bf16(a, bb, acc[ni], 0, 0, 0);
      }
    }
#pragma unroll
    for (int ni = 0; ni < 2; ++ni)
#pragma unroll
      for (int r = 0; r < 16; ++r) {
        int m = 32 * w + (r & 3) + 8 * (r >> 2) + 4 * (lane >> 5);
        Xs[(m & 63) * 136 + (m >> 6) * 64 + 32 * ni + (lane & 31)] = (bf16_t)f2bf(acc[ni][r]);
      }
  }
  __syncthreads();
  {
    int mi = w >> 1, ni = w & 1;
    f32x16 acc;
#pragma unroll
    for (int r = 0; r < 16; ++r) acc[r] = 0.f;
#pragma unroll
    for (int s8 = 0; s8 < 8; ++s8) {
      int ko = 16 * s8 + 8 * (lane >> 5);
      bf16x8 a = *(const bf16x8*)(Xs + (32 * mi + (lane & 31)) * 136 + ko);
      bf16x8 bb = *(const bf16x8*)(DcT + (32 * ni + (lane & 31)) * 128 + ko);
      acc = __builtin_amdgcn_mfma_f32_32x32x16_bf16(a, bb, acc, 0, 0, 0);
    }
#pragma unroll
    for (int r = 0; r < 16; ++r) {
      int k2 = 32 * mi + (r & 3) + 8 * (r >> 2) + 4 * (lane >> 5);
      int row = rowbase + k1 + nk1 * k2;
      MIX[(size_t)row * 1024 + g * 64 + 32 * ni + (lane & 31)] = (bf16_t)f2bf(acc[r] * norm);
    }
  }
}


typedef __attribute__((ext_vector_type(4))) float f32x4_t;
__device__ __forceinline__ bf16x8 ld16(const bf16_t* p) { return *(const bf16x8*)p; }
__device__ __forceinline__ float fast_exp2(float x) { return __builtin_amdgcn_exp2f(x); }

template <int NH, int MODE>
__device__ __forceinline__ void attn_unit(int unit, const bf16_t* __restrict__ Qp, int ldq, const bf16_t* __restrict__ Kp, int ldk,
                                          const bf16_t* __restrict__ VTl, const bf16_t* __restrict__ VTc, int nkvh,
                                          const float* __restrict__ rpb, const float* __restrict__ sink,
                                          bf16_t* __restrict__ Op, int ldo, int lane) {
  const float LOG2E = 1.4426950408889634f;
  const float SC = 0.125f * LOG2E;
  int ql = lane & 15, g = lane >> 4;
  int b, hk, qrow0, r = 0, jb = 0, q0 = 0;
  int nloc, lb0 = 0;
  if (MODE == 0) { hk = unit & 7; jb = (unit >> 3) & 3; r = (unit >> 5) & 127; b = unit >> 12; qrow0 = b * S + r * 64 + 16 * jb; nloc = 8; }
  else if (MODE == 1) { hk = unit & 7; int qb = (unit >> 3) & 15; b = unit >> 7; qrow0 = T + b * CL + 16 * qb; nloc = 0; }
  else { hk = unit & 3; int qb = (unit >> 2) & 511; b = unit >> 11; q0 = 16 * qb; qrow0 = b * S + q0;
         int lo = (q0 - 128) >> 5, hi = (q0 + 143) >> 5; if (lo < 0) lo = 0; if (hi > 255) hi = 255; lb0 = lo; nloc = hi - lo + 1; }
  bf16x8 qf[NH][2];
#pragma unroll
  for (int hh = 0; hh < NH; ++hh)
#pragma unroll
    for (int s2 = 0; s2 < 2; ++s2)
      qf[hh][s2] = ld16(Qp + (size_t)(qrow0 + ql) * ldq + (hk * NH + hh) * 64 + 32 * s2 + 8 * g);
  f32x4_t o[NH][4]; float mrun[NH], lrun[NH];
#pragma unroll
  for (int hh = 0; hh < NH; ++hh) {
    mrun[hh] = -1e30f; lrun[hh] = 0.f;
#pragma unroll
    for (int dt = 0; dt < 4; ++dt) o[hh][dt] = (f32x4_t){0.f, 0.f, 0.f, 0.f};
  }
  int r_start = 0, blk_start = 0, c_lo = 0, qc = 0;
  if (MODE == 0) {
    r_start = min(max(r - 4, 0), 120);
    blk_start = min(max(16 * jb - 8, 0), 32);
    qc = 16 * jb + ql; c_lo = min(max(qc - 8, 0), 48);
  }
  int nblk = nloc + 8;
  for (int kb = 0; kb < nblk; ++kb) {
    bool is_loc = kb < nloc;
    int krow0, vt0; const bf16_t* vt;
    int rr = 0;
    if (is_loc) {
      if (MODE == 0) { rr = r_start + kb; krow0 = b * S + rr * 64 + blk_start; vt0 = rr * 64 + blk_start; }
      else { krow0 = b * S + 32 * (lb0 + kb); vt0 = 32 * (lb0 + kb); }
      vt = VTl + ((size_t)(b * nkvh + hk) * 64) * S + vt0;
    } else {
      int cb = kb - nloc; krow0 = T + b * CL + 32 * cb; vt0 = 32 * cb;
      vt = VTc + ((size_t)(b * nkvh + hk) * 64) * CL + vt0;
    }
    int vld = is_loc ? S : CL;
    bf16x8 kf[2][2];
#pragma unroll
    for (int t = 0; t < 2; ++t)
#pragma unroll
      for (int s2 = 0; s2 < 2; ++s2)
        kf[t][s2] = ld16(Kp + (size_t)(krow0 + 8 * (ql >> 2) + 4 * t + (ql & 3)) * ldk + hk * 64 + 32 * s2 + 8 * g);
    bf16x8 vf[4];
#pragma unroll
    for (int dt = 0; dt < 4; ++dt) vf[dt] = ld16(vt + (size_t)(16 * dt + ql) * vld + 8 * g);
    float bias[2][4]; bool valid[2][4];
#pragma unroll
    for (int t = 0; t < 2; ++t)
#pragma unroll
      for (int i = 0; i < 4; ++i) {
        bias[t][i] = 0.f; valid[t][i] = true;
        if (MODE == 0 && is_loc) {
          int kc = blk_start + 8 * g + 4 * t + i;
          valid[t][i] = (kc >= c_lo) && (kc < c_lo + 16);
          int dc = min(max(kc - qc, -15), 15) + 15;
          bias[t][i] = rpb[(hk * 15 + (rr - r + 7)) * 31 + dc] * LOG2E;
        }
        if (MODE == 2 && is_loc) {
          int kpos = 32 * (lb0 + kb) + 8 * g + 4 * t + i; int dq = (q0 + ql) - kpos;
          valid[t][i] = (dq <= 128) && (dq >= -128);
        }
      }
#pragma unroll
    for (int hh = 0; hh < NH; ++hh) {
      f32x4_t st[2];
#pragma unroll
      for (int t = 0; t < 2; ++t) {
        st[t] = (f32x4_t){0.f, 0.f, 0.f, 0.f};
        st[t] = __builtin_amdgcn_mfma_f32_16x16x32_bf16(kf[t][0], qf[hh][0], st[t], 0, 0, 0);
        st[t] = __builtin_amdgcn_mfma_f32_16x16x32_bf16(kf[t][1], qf[hh][1], st[t], 0, 0, 0);
      }
      float lg[2][4]; float bm = -1e30f;
#pragma unroll
      for (int t = 0; t < 2; ++t)
#pragma unroll
        for (int i = 0; i < 4; ++i) {
          float v = valid[t][i] ? (st[t][i] * SC + bias[t][i]) : -1e30f;
          lg[t][i] = v; bm = fmaxf(bm, v);
        }
      bm = fmaxf(bm, __shfl_xor(bm, 16));
      bm = fmaxf(bm, __shfl_xor(bm, 32));
      float mn = fmaxf(mrun[hh], bm);
      float alpha = fast_exp2(mrun[hh] - mn);
      mrun[hh] = mn;
      float ps = 0.f; float pv[8];
#pragma unroll
      for (int t = 0; t < 2; ++t)
#pragma unroll
        for (int i = 0; i < 4; ++i) {
          float p = valid[t][i] ? fast_exp2(lg[t][i] - mn) : 0.f;
          pv[4 * t + i] = p; ps += p;
        }
      lrun[hh] = lrun[hh] * alpha + ps;
      bf16x8 pf;
      {
        unsigned w0 = pack2bf(pv[0], pv[1]), w1 = pack2bf(pv[2], pv[3]), w2 = pack2bf(pv[4], pv[5]), w3 = pack2bf(pv[6], pv[7]);
        typedef __attribute__((ext_vector_type(4))) unsigned u32x4;
        u32x4 uu = {w0, w1, w2, w3};
        pf = __builtin_bit_cast(bf16x8, uu);
      }
#pragma unroll
      for (int dt = 0; dt < 4; ++dt) {
        o[hh][dt] *= alpha;
        o[hh][dt] = __builtin_amdgcn_mfma_f32_16x16x32_bf16(vf[dt], pf, o[hh][dt], 0, 0, 0);
      }
    }
  }
#pragma unroll
  for (int hh = 0; hh < NH; ++hh) {
    float l = lrun[hh];
    l += __shfl_xor(l, 16); l += __shfl_xor(l, 32);
    float m = mrun[hh];
    if (MODE == 2) {
      float sk = sink[hk * NH + hh] * LOG2E;
      float mf = fmaxf(m, sk);
      float a = fast_exp2(m - mf);
      l = l * a + fast_exp2(sk - mf);
#pragma unroll
      for (int dt = 0; dt < 4; ++dt) o[hh][dt] *= a;
    }
    float inv = 1.f / l;
    bf16_t* orow = Op + (size_t)(qrow0 + ql) * ldo + (hk * NH + hh) * 64 + 4 * g;
#pragma unroll
    for (int dt = 0; dt < 4; ++dt) {
      f32x4_t v = o[hh][dt] * inv;
      *(uint2*)(orow + 16 * dt) = make_uint2(pack2bf(v[0], v[1]), pack2bf(v[2], v[3]));
    }
  }
}

__device__ __forceinline__ void ph_chan_dft(const float* __restrict__ F, const float* __restrict__ tab, float* __restrict__ PQ) {
  for (int gid = blockIdx.x * 256 + threadIdx.x; gid < R * 512; gid += gridDim.x * 256) {
    int row = gid >> 9; int col = gid & 511; int g = col >> 6, cp = col & 63;
    const float* f = F + (size_t)row * 2048 + g * 64;
    float p = 0.f, q = 0.f;
    for (int ch = 0; ch < 64; ++ch) {
      int idx = ((ch * cp) & 63) * 128;
      float x = f[ch];
      p += x * tab[idx]; q += x * tab[8192 + idx];
    }
    PQ[(size_t)row * 1024 + col] = p;
    PQ[(size_t)row * 1024 + 512 + col] = q;
  }
}

__device__ __forceinline__ void ph_na(const bf16_t* __restrict__ F, const float* __restrict__ rpb, bf16_t* __restrict__ MIX, float* sm) {
  int lane = threadIdx.x & 63, wave = threadIdx.x >> 6;
  float* sq = sm + wave * 1024; float* sp = sq + 64; int* stok = (int*)(sp + 384);
  int nitems = R * 8;
  for (int item0 = blockIdx.x * 4; item0 < nitems; item0 += gridDim.x * 4) {
    int item = item0 + wave;
    int h = item & 7; int row = item >> 3;
    bool is_ctx = row >= T;
    int b = is_ctx ? (row - T) / CL : row / S;
    __syncthreads();
    sq[lane] = bf2f(F[(size_t)row * 2048 + 512 + h * 64 + lane]);
    __syncthreads();
    int r = 0, c = 0, r_start = 0, c_start = 0;
    if (!is_ctx) { int t = row % S; r = t / 64; c = t % 64; r_start = min(max(r - 4, 0), 120); c_start = min(max(c - 8, 0), 48); }
    int nk = is_ctx ? 256 : 384;
    float lg[6]; float mx = -INFINITY;
#pragma unroll
    for (int kk = 0; kk < 6; ++kk) {
      int j = kk * 64 + lane; float s = -INFINITY; int tok = 0;
      if (j < nk) {
        float bias = 0.f;
        if (!is_ctx && j < 128) {
          int kr = j >> 4, kc = j & 15; int rr = r_start + kr, cc = c_start + kc;
          tok = b * S + rr * 64 + cc;
          int dc = min(max(cc - c, -15), 15) + 15;
          bias = rpb[(h * 15 + (rr - r + 7)) * 31 + dc];
        } else {
          int l = is_ctx ? j : j - 128; tok = T + b * CL + l;
        }
        const bf16_t* kp = F + (size_t)tok * 2048 + 1024 + h * 64;
        float acc = 0.f;
#pragma unroll 8
        for (int d = 0; d < 64; ++d) acc += sq[d] * bf2f(kp[d]);
        s = acc * 0.125f + bias;
      }
      lg[kk] = s; stok[j] = tok; mx = fmaxf(mx, s);
    }
    mx = wave_max(mx);
    float sum = 0.f;
#pragma unroll
    for (int kk = 0; kk < 6; ++kk) { float e = (kk * 64 + lane < nk) ? expf(lg[kk] - mx) : 0.f; lg[kk] = e; sum += e; }
    sum = wave_sum(sum);
    float inv = 1.f / sum;
#pragma unroll
    for (int kk = 0; kk < 6; ++kk) sp[kk * 64 + lane] = lg[kk] * inv;
    __syncthreads();
    float o = 0.f;
    for (int j = 0; j < nk; ++j) o += sp[j] * bf2f(F[(size_t)stok[j] * 2048 + 1536 + h * 64 + lane]);
    MIX[(size_t)row * 1024 + 512 + h * 64 + lane] = (bf16_t)f2bf(o);
  }
}

__device__ __forceinline__ void ph_rope(float* __restrict__ F1) {
  for (int gid = blockIdx.x * 256 + threadIdx.x; gid < T * 20 * 32; gid += gridDim.x * 256) {
    int i = gid & 31; int hh = (gid >> 5) % 20; int row = gid / (32 * 20);
    int t = row % S; float rowp = (float)(t / 64), colp = (float)(t % 64);
    int fi = i & 15;
    float inv_freq = powf(10000.0f, -(float)fi / 16.0f);
    float ang = (i < 16 ? rowp : colp) * inv_freq;
    float cs = cosf(ang), sn = sinf(ang);
    float* p = F1 + (size_t)row * 1536 + hh * 64;
    float x1 = p[i], x2 = p[i + 32];
    p[i] = x1 * cs - x2 * sn;
    p[i + 32] = x1 * sn + x2 * cs;
  }
}

__device__ __forceinline__ void ph_gqa(const float* __restrict__ F1, const float* __restrict__ sink, bf16_t* __restrict__ O, float* sm) {
  int lane = threadIdx.x & 63, wave = threadIdx.x >> 6;
  float* sq = sm + wave * 1280; float* sp = sq + 64; int* stok = (int*)(sp + 576);
  int nitems = T * 16;
  for (int item0 = blockIdx.x * 4; item0 < nitems; item0 += gridDim.x * 4) {
    int item = item0 + wave;
    int qh = item & 15; int row = item >> 4; int kvh = qh >> 2;
    int b = row / S; int t = row % S;
    __syncthreads();
    sq[lane] = F1[(size_t)row * 1536 + qh * 64 + lane];
    __syncthreads();
    float lg[9]; float mx = -INFINITY;
#pragma unroll
    for (int kk = 0; kk < 9; ++kk) {
      int j = kk * 64 + lane; float s = -INFINITY; int tok = 0; bool valid = false;
      if (j < 257) { int pos = t - 128 + j; valid = (pos >= 0 && pos < S); tok = b * S + pos; }
      else if (j < 513) { valid = true; tok = T + b * CL + (j - 257); }
      if (valid) {
        const float* kp = F1 + (size_t)tok * 1536 + 1024 + kvh * 64;
        float acc = 0.f;
#pragma unroll 8
        for (int d = 0; d < 64; ++d) acc += sq[d] * kp[d];
        s = acc * 0.125f;
      } else tok = 0;
      lg[kk] = s; stok[j] = tok; mx = fmaxf(mx, s);
    }
    mx = wave_max(mx);
    float sk = sink[qh];
    mx = fmaxf(mx, sk);
    float sum = 0.f;
#pragma unroll
    for (int kk = 0; kk < 9; ++kk) { float e = (lg[kk] == -INFINITY) ? 0.f : expf(lg[kk] - mx); lg[kk] = e; sum += e; }
    sum = wave_sum(sum) + expf(sk - mx);
    float inv = 1.f / sum;
#pragma unroll
    for (int kk = 0; kk < 9; ++kk) sp[kk * 64 + lane] = lg[kk] * inv;
    __syncthreads();
    float o = 0.f;
    for (int j = 0; j < 513; ++j) { float p = sp[j]; if (p != 0.f) o += p * F1[(size_t)stok[j] * 1536 + 1280 + kvh * 64 + lane]; }
    O[(size_t)row * 1024 + qh * 64 + lane] = (bf16_t)f2bf(o);
  }
}

__device__ __forceinline__ void wave_argmax(float& v, int& idx) {
#pragma unroll
  for (int off = 32; off; off >>= 1) {
    float ov = __shfl_xor(v, off); int oi = __shfl_xor(idx, off);
    if (ov > v || (ov == v && oi < idx)) { v = ov; idx = oi; }
  }
}
__device__ __forceinline__ void ph_peer_select_naive(const float* __restrict__ Q, const float* __restrict__ sk, int* __restrict__ EXP,
                                     float* __restrict__ GATE, int nrows, float* sm) {
  int lane = threadIdx.x & 63, wave = threadIdx.x >> 6;
  float* sq = sm + wave * 640; float* tops = sq + 256; int* topi = (int*)(tops + 32);
  for (int row0 = blockIdx.x * 4; row0 < nrows; row0 += gridDim.x * 4) {
    int row = row0 + wave;
    for (int h = 0; h < 8; ++h) {
      __syncthreads();
#pragma unroll
      for (int i = 0; i < 4; ++i) sq[lane + 64 * i] = Q[(size_t)row * 2048 + h * 256 + lane + 64 * i];
      __syncthreads();
      for (int p = 0; p < 2; ++p) {
        float s0 = 0.f, s1 = 0.f;
        const float* k0 = sk + ((size_t)((h * 2 + p) * 128 + lane)) * 128;
        const float* k1 = k0 + 64 * 128;
#pragma unroll 8
        for (int d = 0; d < 128; ++d) { float qv = sq[p * 128 + d]; s0 += qv * k0[d]; s1 += qv * k1[d]; }
        for (int i = 0; i < 16; ++i) {
          float v; int idx;
          if (s0 >= s1) { v = s0; idx = lane; } else { v = s1; idx = lane + 64; }
          wave_argmax(v, idx);
          if (lane == 0) { tops[p * 16 + i] = v; topi[p * 16 + i] = idx; }
          if (idx == lane) s0 = -INFINITY;
          if (idx == lane + 64) s1 = -INFINITY;
        }
      }
      __syncthreads();
      float cs[4];
#pragma unroll
      for (int i = 0; i < 4; ++i) { int ci = lane * 4 + i; cs[i] = tops[ci >> 4] + tops[16 + (ci & 15)]; }
      float bs[16]; int be[16];
#pragma unroll
      for (int k = 0; k < 16; ++k) {
        float v = cs[0]; int idx = lane * 4;
#pragma unroll
        for (int i = 1; i < 4; ++i) if (cs[i] > v) { v = cs[i]; idx = lane * 4 + i; }
        wave_argmax(v, idx);
        bs[k] = v; be[k] = topi[idx >> 4] * 128 + topi[16 + (idx & 15)];
#pragma unroll
        for (int i = 0; i < 4; ++i) if (idx == lane * 4 + i) cs[i] = -INFINITY;
      }
      float mxs = bs[0]; float sum = 0.f;
#pragma unroll
      for (int k = 0; k < 16; ++k) { bs[k] = expf(bs[k] - mxs); sum += bs[k]; }
      float inv = 1.f / sum;
      if (lane == 0) {
#pragma unroll
        for (int k = 0; k < 16; ++k) { EXP[(size_t)row * 128 + h * 16 + k] = be[k]; GATE[(size_t)row * 128 + h * 16 + k] = bs[k] * inv; }
      }
    }
  }
}

__device__ __forceinline__ void unpack8(uint4 v, float* f) {
  f[0] = __uint_as_float(v.x << 16); f[1] = __uint_as_float(v.x & 0xffff0000u);
  f[2] = __uint_as_float(v.y << 16); f[3] = __uint_as_float(v.y & 0xffff0000u);
  f[4] = __uint_as_float(v.z << 16); f[5] = __uint_as_float(v.z & 0xffff0000u);
  f[6] = __uint_as_float(v.w << 16); f[7] = __uint_as_float(v.w & 0xffff0000u);
}
__device__ __forceinline__ void ph_peer_gather(bf16_t* __restrict__ H, const int* __restrict__ EXP, const float* __restrict__ GATE,
                               const bf16_t* __restrict__ U, const bf16_t* __restrict__ V,
                               const float* __restrict__ xin, const float* __restrict__ M, int layer,
                               const float* __restrict__ g, const float* __restrict__ bb, float* __restrict__ xout,
                               bool write_next, int nrows) {
  int lane = threadIdx.x & 63, wave = threadIdx.x >> 6;
  for (int row = blockIdx.x * 4 + wave; row < nrows; row += gridDim.x * 4) {
    float hreg[16];
    {
      const uint4* hp = (const uint4*)(H + (size_t)row * D + 8 * lane);
      unpack8(hp[0], hreg); unpack8(hp[64], hreg + 8);
    }
    float acc[16];
#pragma unroll
    for (int i = 0; i < 16; ++i) acc[i] = 0.f;
    int e_lo = EXP[(size_t)row * 128 + lane], e_hi = EXP[(size_t)row * 128 + 64 + lane];
    float g_lo = GATE[(size_t)row * 128 + lane], g_hi = GATE[(size_t)row * 128 + 64 + lane];
    uint4 ua[4], ub[4], va[4], vb[4];
#pragma unroll
    for (int i = 0; i < 4; ++i) {
      int e = __builtin_amdgcn_readlane(e_lo, i);
      const uint4* up = (const uint4*)(U + (size_t)e * D + 8 * lane); ua[i] = up[0]; ub[i] = up[64];
    }
#pragma unroll 1
    for (int b = 0; b < 32; ++b) {
      int k0 = 4 * b;
      int ev = (b < 16) ? e_lo : e_hi; float gv = (b < 16) ? g_lo : g_hi;
      int en = (b + 1 < 16) ? e_lo : e_hi;
      float gt[4];
#pragma unroll
      for (int i = 0; i < 4; ++i) {
        int e = __builtin_amdgcn_readlane(ev, (k0 + i) & 63);
        gt[i] = __uint_as_float(__builtin_amdgcn_readlane(__float_as_uint(gv), (k0 + i) & 63));
        const uint4* vp = (const uint4*)(V + (size_t)e * D + 8 * lane); va[i] = vp[0]; vb[i] = vp[64];
      }
      float a[4];
#pragma unroll
      for (int i = 0; i < 4; ++i) {
        float f[16]; unpack8(ua[i], f); unpack8(ub[i], f + 8);
        float sacc = 0.f;
#pragma unroll
        for (int j = 0; j < 16; ++j) sacc += f[j] * hreg[j];
        a[i] = sacc;
      }
      if (b + 1 < 32) {
#pragma unroll
        for (int i = 0; i < 4; ++i) {
          int e = __builtin_amdgcn_readlane(en, (k0 + 4 + i) & 63);
          const uint4* up = (const uint4*)(U + (size_t)e * D + 8 * lane); ua[i] = up[0]; ub[i] = up[64];
        }
      }
#pragma unroll
      for (int i = 0; i < 4; ++i) a[i] = wave_sum(a[i]);
#pragma unroll
      for (int i = 0; i < 4; ++i) {
        float w = gt[i] * 0.5f * a[i] * (1.f + erff(a[i] * 0.70710678118654752f));
        float f[16]; unpack8(va[i], f); unpack8(vb[i], f + 8);
#pragma unroll
        for (int j = 0; j < 16; ++j) acc[j] += w * f[j];
      }
    }
    const float* m = M + ((size_t)layer * 3 + mod_index(row)) * 6144;
    const float* xr = xin + (size_t)row * D;
    float v[16];
#pragma unroll
    for (int hh = 0; hh < 2; ++hh) {
      int d0 = hh * 512 + 8 * lane;
      float4 x0 = *(const float4*)(xr + d0), x1 = *(const float4*)(xr + d0 + 4);
      float4 m0 = *(const float4*)(m + 5 * D + d0), m1 = *(const float4*)(m + 5 * D + d0 + 4);
      v[hh * 8 + 0] = DN_ALPHA * x0.x + m0.x * acc[hh * 8 + 0]; v[hh * 8 + 1] = DN_ALPHA * x0.y + m0.y * acc[hh * 8 + 1];
      v[hh * 8 + 2] = DN_ALPHA * x0.z + m0.z * acc[hh * 8 + 2]; v[hh * 8 + 3] = DN_ALPHA * x0.w + m0.w * acc[hh * 8 + 3];
      v[hh * 8 + 4] = DN_ALPHA * x1.x + m1.x * acc[hh * 8 + 4]; v[hh * 8 + 5] = DN_ALPHA * x1.y + m1.y * acc[hh * 8 + 5];
      v[hh * 8 + 6] = DN_ALPHA * x1.z + m1.z * acc[hh * 8 + 6]; v[hh * 8 + 7] = DN_ALPHA * x1.w + m1.w * acc[hh * 8 + 7];
    }
    float s = 0.f;
#pragma unroll
    for (int j = 0; j < 16; ++j) s += v[j];
    float mu = wave_sum(s) * (1.f / D);
    float q = 0.f;
#pragma unroll
    for (int j = 0; j < 16; ++j) { float d = v[j] - mu; q += d * d; }
    float rs = rsqrtf(wave_sum(q) * (1.f / D) + LN_EPS);
    float y[16];
#pragma unroll
    for (int hh = 0; hh < 2; ++hh) {
      int d0 = hh * 512 + 8 * lane;
#pragma unroll
      for (int j = 0; j < 8; ++j) y[hh * 8 + j] = (v[hh * 8 + j] - mu) * rs * g[d0 + j] + bb[d0 + j];
      *(float4*)(xout + (size_t)row * D + d0) = make_float4(y[hh * 8], y[hh * 8 + 1], y[hh * 8 + 2], y[hh * 8 + 3]);
      *(float4*)(xout + (size_t)row * D + d0 + 4) = make_float4(y[hh * 8 + 4], y[hh * 8 + 5], y[hh * 8 + 6], y[hh * 8 + 7]);
    }
    if (write_next) {
      const float* mn = M + ((size_t)(layer + 1) * 3 + mod_index(row)) * 6144;
      float s2 = 0.f;
#pragma unroll
      for (int j = 0; j < 16; ++j) s2 += y[j];
      float mu2 = wave_sum(s2) * (1.f / D);
      float q2 = 0.f;
#pragma unroll
      for (int j = 0; j < 16; ++j) { float d = y[j] - mu2; q2 += d * d; }
      float rs2 = rsqrtf(wave_sum(q2) * (1.f / D) + LN_EPS);
#pragma unroll
      for (int hh = 0; hh < 2; ++hh) {
        int d0 = hh * 512 + 8 * lane;
        float o[8];
#pragma unroll
        for (int j = 0; j < 8; ++j) o[j] = (y[hh * 8 + j] - mu2) * rs2 * (1.f + mn[D + d0 + j]) + mn[d0 + j];
        *(uint4*)(H + (size_t)row * D + d0) = make_uint4(pack2bf(o[0], o[1]), pack2bf(o[2], o[3]), pack2bf(o[4], o[5]), pack2bf(o[6], o[7]));
      }
    }
  }
}


__device__ __forceinline__ void ph_quant_rows(const float* __restrict__ src, unsigned char* __restrict__ dst, float* __restrict__ scale, int nrows) {
  int lane = threadIdx.x & 63, wave = threadIdx.x >> 6;
  for (int row = blockIdx.x * 4 + wave; row < nrows; row += gridDim.x * 4) {
    const float4* sp = (const float4*)(src + (size_t)row * D + 16 * lane);
    float4 v0 = sp[0], v1 = sp[1], v2 = sp[2], v3 = sp[3];
    float x[16] = {v0.x, v0.y, v0.z, v0.w, v1.x, v1.y, v1.z, v1.w, v2.x, v2.y, v2.z, v2.w, v3.x, v3.y, v3.z, v3.w};
    float am = 0.f;
#pragma unroll
    for (int j = 0; j < 16; ++j) am = fmaxf(am, fabsf(x[j]));
    am = wave_max(am);
    float inv = am > 0.f ? 127.f / am : 0.f;
    unsigned wv[4];
#pragma unroll
    for (int k = 0; k < 4; ++k) {
      unsigned w = 0;
#pragma unroll
      for (int j = 0; j < 4; ++j) {
        int q = (int)rintf(x[4 * k + j] * inv) + 128;
        w |= ((unsigned)q & 0xffu) << (8 * j);
      }
      wv[k] = w;
    }
    *(uint4*)(dst + (size_t)row * D + 16 * lane) = make_uint4(wv[0], wv[1], wv[2], wv[3]);
    if (lane == 0) scale[row] = am * (1.f / 127.f);
  }
}
__device__ __forceinline__ void unpack_u8x16(uint4 v, float* f) {
  unsigned w[4] = {v.x, v.y, v.z, v.w};
#pragma unroll
  for (int k = 0; k < 4; ++k) {
    f[4 * k + 0] = (float)(w[k] & 0xffu); f[4 * k + 1] = (float)((w[k] >> 8) & 0xffu);
    f[4 * k + 2] = (float)((w[k] >> 16) & 0xffu); f[4 * k + 3] = (float)(w[k] >> 24);
  }
}
__device__ __forceinline__ void ph_peer_gather8(bf16_t* __restrict__ H, const int* __restrict__ EXP, const float* __restrict__ GATE,
                               const unsigned char* __restrict__ U8, const float* __restrict__ USC,
                               const unsigned char* __restrict__ V8, const float* __restrict__ VSC,
                               const float* __restrict__ xin, const float* __restrict__ M, int layer,
                               const float* __restrict__ g, const float* __restrict__ bb, float* __restrict__ xout,
                               bool write_next, int nrows) {
  int lane = threadIdx.x & 63, wave = threadIdx.x >> 6;
  for (int row = blockIdx.x * 4 + wave; row < nrows; row += gridDim.x * 4) {
    float hreg[16];
    {
      const uint4* hp = (const uint4*)(H + (size_t)row * D + 16 * lane);
      unpack8(hp[0], hreg); unpack8(hp[1], hreg + 8);
    }
    float hs = 0.f;
#pragma unroll
    for (int j = 0; j < 16; ++j) hs += hreg[j];
    float hsum128 = 128.f * wave_sum(hs);
    float acc[16];
#pragma unroll
    for (int i = 0; i < 16; ++i) acc[i] = 0.f;
    float wsum = 0.f;
    int e_lo = EXP[(size_t)row * 128 + lane], e_hi = EXP[(size_t)row * 128 + 64 + lane];
    float g_lo = GATE[(size_t)row * 128 + lane], g_hi = GATE[(size_t)row * 128 + 64 + lane];
    float us_lo = USC[e_lo], us_hi = USC[e_hi], vs_lo = VSC[e_lo], vs_hi = VSC[e_hi];
    uint4 ua[8], va[8];
#pragma unroll
    for (int i = 0; i < 8; ++i) {
      int e = __builtin_amdgcn_readlane(e_lo, i);
      ua[i] = *(const uint4*)(U8 + (size_t)e * D + 16 * lane);
    }
#pragma unroll 1
    for (int b = 0; b < 16; ++b) {
      int k0 = 8 * b;
      bool lo = b < 8, lon = (b + 1) < 8;
      int ev = lo ? e_lo : e_hi; float gv = lo ? g_lo : g_hi; float usv = lo ? us_lo : us_hi; float vsv = lo ? vs_lo : vs_hi;
      int en = lon ? e_lo : e_hi;
      float gt[8], usc[8], vsc[8];
#pragma unroll
      for (int i = 0; i < 8; ++i) {
        int li = (k0 + i) & 63;
        int e = __builtin_amdgcn_readlane(ev, li);
        gt[i] = __uint_as_float(__builtin_amdgcn_readlane(__float_as_uint(gv), li));
        usc[i] = __uint_as_float(__builtin_amdgcn_readlane(__float_as_uint(usv), li));
        vsc[i] = __uint_as_float(__builtin_amdgcn_readlane(__float_as_uint(vsv), li));
        va[i] = *(const uint4*)(V8 + (size_t)e * D + 16 * lane);
      }
      float a[8];
#pragma unroll
      for (int i = 0; i < 8; ++i) {
        float f[16]; unpack_u8x16(ua[i], f);
        float sacc = 0.f;
#pragma unroll
        for (int j = 0; j < 16; ++j) sacc += f[j] * hreg[j];
        a[i] = sacc;
      }
      if (b + 1 < 16) {
#pragma unroll
        for (int i = 0; i < 8; ++i) {
          int e = __builtin_amdgcn_readlane(en, (k0 + 8 + i) & 63);
          ua[i] = *(const uint4*)(U8 + (size_t)e * D + 16 * lane);
        }
      }
#pragma unroll
      for (int i = 0; i < 8; ++i) a[i] = (wave_sum(a[i]) - hsum128) * usc[i];
#pragma unroll
      for (int i = 0; i < 8; ++i) {
        float w = gt[i] * 0.5f * a[i] * (1.f + erff(a[i] * 0.70710678118654752f)) * vsc[i];
        wsum += w;
        float f[16]; unpack_u8x16(va[i], f);
#pragma unroll
        for (int j = 0; j < 16; ++j) acc[j] += w * f[j];
      }
    }
    float corr = 128.f * wsum;
#pragma unroll
    for (int j = 0; j < 16; ++j) acc[j] -= corr;
    const float* m = M + ((size_t)layer * 3 + mod_index(row)) * 6144;
    const float* xr = xin + (size_t)row * D + 16 * lane;
    const float* m5 = m + 5 * D + 16 * lane;
    float v[16];
#pragma unroll
    for (int q4 = 0; q4 < 4; ++q4) {
      float4 x0 = *(const float4*)(xr + 4 * q4); float4 m0 = *(const float4*)(m5 + 4 * q4);
      v[4 * q4 + 0] = DN_ALPHA * x0.x + m0.x * acc[4 * q4 + 0]; v[4 * q4 + 1] = DN_ALPHA * x0.y + m0.y * acc[4 * q4 + 1];
      v[4 * q4 + 2] = DN_ALPHA * x0.z + m0.z * acc[4 * q4 + 2]; v[4 * q4 + 3] = DN_ALPHA * x0.w + m0.w * acc[4 * q4 + 3];
    }
    float s = 0.f;
#pragma unroll
    for (int j = 0; j < 16; ++j) s += v[j];
    float mu = wave_sum(s) * (1.f / D);
    float q = 0.f;
#pragma unroll
    for (int j = 0; j < 16; ++j) { float d = v[j] - mu; q += d * d; }
    float rs = rsqrtf(wave_sum(q) * (1.f / D) + LN_EPS);
    float y[16];
    {
      const float* gp = g + 16 * lane; const float* bp = bb + 16 * lane;
      float* op = xout + (size_t)row * D + 16 * lane;
#pragma unroll
      for (int q4 = 0; q4 < 4; ++q4) {
        float4 g4 = *(const float4*)(gp + 4 * q4); float4 b4 = *(const float4*)(bp + 4 * q4);
        y[4 * q4 + 0] = (v[4 * q4 + 0] - mu) * rs * g4.x + b4.x; y[4 * q4 + 1] = (v[4 * q4 + 1] - mu) * rs * g4.y + b4.y;
        y[4 * q4 + 2] = (v[4 * q4 + 2] - mu) * rs * g4.z + b4.z; y[4 * q4 + 3] = (v[4 * q4 + 3] - mu) * rs * g4.w + b4.w;
        *(float4*)(op + 4 * q4) = make_float4(y[4 * q4], y[4 * q4 + 1], y[4 * q4 + 2], y[4 * q4 + 3]);
      }
    }
    if (write_next) {
      const float* mn = M + ((size_t)(layer + 1) * 3 + mod_index(row)) * 6144 + 16 * lane;
      float s2 = 0.f;
#pragma unroll
      for (int j = 0; j < 16; ++j) s2 += y[j];
      float mu2 = wave_sum(s2) * (1.f / D);
      float q2 = 0.f;
#pragma unroll
      for (int j = 0; j < 16; ++j) { float d = y[j] - mu2; q2 += d * d; }
      float rs2 = rsqrtf(wave_sum(q2) * (1.f / D) + LN_EPS);
      float o[16];
#pragma unroll
      for (int j = 0; j < 16; ++j) o[j] = (y[j] - mu2) * rs2 * (1.f + mn[D + j]) + mn[j];
      uint4* hp = (uint4*)(H + (size_t)row * D + 16 * lane);
      hp[0] = make_uint4(pack2bf(o[0], o[1]), pack2bf(o[2], o[3]), pack2bf(o[4], o[5]), pack2bf(o[6], o[7]));
      hp[1] = make_uint4(pack2bf(o[8], o[9]), pack2bf(o[10], o[11]), pack2bf(o[12], o[13]), pack2bf(o[14], o[15]));
    }
  }
}

#define XB_TMO      128
#define XB_XCNT(j)  (256  + 64 * (j))
#define XB_XSUB(j)  (1280 + 64 * (j))
#define XB_XGEN(j)  (2304 + 64 * (j))
#define XB_TOP      3328
#define XB_TOPGEN   3392
#define XCD_BAR_WORDS 3456
#define XB_SPIN_CAP (1u << 22)
#define LAS __attribute__((address_space(3)))
__device__ __forceinline__ unsigned xb_ld(unsigned* p)              { return __hip_atomic_load(p, __ATOMIC_RELAXED, __HIP_MEMORY_SCOPE_AGENT); }
__device__ __forceinline__ unsigned xb_add(unsigned* p, unsigned v) { return __hip_atomic_fetch_add(p, v, __ATOMIC_RELAXED, __HIP_MEMORY_SCOPE_AGENT); }
__device__ __forceinline__ unsigned xb_xcc_id() { return (unsigned)__builtin_amdgcn_s_getreg((3 << 11) | 20) & 0xFu; }
#define XB_SPIN(cond, bar) do { unsigned _sp = 0; while (cond) { __builtin_amdgcn_s_sleep(1); \
    if ((++_sp & 255u) == 0u) { if (xb_ld(&(bar)[XB_TMO])) break; if (_sp > XB_SPIN_CAP) { atomicAdd(&(bar)[XB_TMO], 1u); break; } } } } while (0)
struct XcdBarrier { unsigned* bar; unsigned x; volatile LAS unsigned* st; };
__device__ __forceinline__ XcdBarrier xcd_barrier_post(unsigned* bar, volatile LAS unsigned* st) {
  XcdBarrier b; b.bar = bar; b.x = xb_xcc_id(); b.st = st;
  if (threadIdx.x == 0) (void)xb_add(&bar[XB_XCNT(b.x)], 1u);
  return b;
}
__device__ __forceinline__ void xcd_barrier_complete(unsigned* bar, unsigned x, unsigned& nloc, unsigned& nx) {
  const unsigned G = gridDim.x * gridDim.y * gridDim.z;
  unsigned sum, cnt, mine, sp = 0u;
  for (;;) {
    sum = 0u; cnt = 0u; mine = 0u;
#pragma unroll
    for (unsigned j = 0; j < 16; ++j) { const unsigned c = xb_ld(&bar[XB_XCNT(j)]); sum += c; cnt += (c > 0u) ? 1u : 0u; mine = (j == x) ? c : mine; }
    if (sum == G) break;
    __builtin_amdgcn_s_sleep(1);
    if ((++sp & 255u) == 0u) { if (xb_ld(&bar[XB_TMO])) break; if (sp > XB_SPIN_CAP) { atomicAdd(&bar[XB_TMO], 1u); break; } }
  }
  nloc = mine > 0u ? mine : 1u; nx = cnt > 0u ? cnt : 1u;
}
__device__ __forceinline__ void xcd_barrier(const XcdBarrier& b) {
  asm volatile("s_waitcnt vmcnt(0)" ::: "memory");
  __syncthreads();
  if (threadIdx.x == 0) {
    unsigned* bar = b.bar;
    __builtin_amdgcn_s_waitcnt(0);
    unsigned nloc = b.st[0], nx = b.st[1];
    if (nloc == 0u) { xcd_barrier_complete(bar, b.x, nloc, nx); b.st[0] = nloc; b.st[1] = nx; }
    const unsigned old = xb_add(&bar[XB_XSUB(b.x)], 1u);
    const unsigned gen = old / nloc;
    if (old + 1u == (gen + 1u) * nloc) {
      __builtin_amdgcn_fence(__ATOMIC_RELEASE, "agent");
      asm volatile("s_waitcnt vmcnt(0)" ::: "memory");
      const unsigned og = xb_add(&bar[XB_TOP], 1u);
      const unsigned tg = og / nx;
      if (og + 1u == (tg + 1u) * nx) xb_add(&bar[XB_TOPGEN], 1u);
      else XB_SPIN(xb_ld(&bar[XB_TOPGEN]) == tg, bar);
      __builtin_amdgcn_fence(__ATOMIC_ACQUIRE, "agent");
      xb_add(&bar[XB_XGEN(b.x)], 1u);
      asm volatile("s_waitcnt vmcnt(0)" ::: "memory");
    } else {
      XB_SPIN(xb_ld(&bar[XB_XGEN(b.x)]) == gen, bar);
      __builtin_amdgcn_fence(__ATOMIC_ACQUIRE, "agent");
      asm volatile("s_waitcnt vmcnt(0)" ::: "memory");
    }
  }
  __syncthreads();
}

constexpr int SMEM_BYTES = 65536;
#ifndef PHMASK
#define PHMASK 0xFFFFFFFFFFFFFFFFull
#endif
#ifndef PHDUP
#define PHDUP 0ull
#endif
#define PH(n, ...) if constexpr ((((unsigned long long)(PHMASK)) >> (n)) & 1ull) { __VA_ARGS__; if constexpr ((((unsigned long long)(PHDUP)) >> (n)) & 1ull) { xcd_barrier(xbar); __VA_ARGS__; } }

__global__ __launch_bounds__(256, 2) void mega(Params p) {
  __shared__ __attribute__((aligned(16))) char smem_raw[SMEM_BYTES];
  __shared__ uint4 xb_words;
  if (threadIdx.x == 0) xb_words = make_uint4(0u, 0u, 0u, 0u);
  __syncthreads();
  XcdBarrier xbar = xcd_barrier_post((unsigned*)((char*)p.ws + OFF_BAR), (volatile LAS unsigned*)&xb_words);
  float* smem = (float*)smem_raw;
  const float* x = p.in[0]; const float* c = p.in[1]; const float* ctx = p.in[2]; const float* c_ctx = p.in[3];
  const float* ada_w = p.in[4]; const float* ada_b = p.in[5]; const float* ln_g = p.in[6]; const float* ln_b = p.in[7];
  const float* even_w_in = p.in[8]; const float* even_w_out = p.in[9]; const float* rpb = p.in[10];
  const float* odd_w_in = p.in[11]; const float* odd_w_out = p.in[12]; const float* sink = p.in[13];
  const float* peer_wq = p.in[14]; const float* peer_sk = p.in[15]; const float* peer_u = p.in[16]; const float* peer_v = p.in[17];
  char* ws = (char*)p.ws;
  float* TAB = (float*)(ws + OFF_TAB); float* Mm = (float*)(ws + OFF_M);
  bf16_t* WIN0 = (bf16_t*)(ws + OFF_WIN0); bf16_t* WOUT0 = (bf16_t*)(ws + OFF_WOUT0);
  bf16_t* WIN1 = (bf16_t*)(ws + OFF_WIN1); bf16_t* WOUT1 = (bf16_t*)(ws + OFF_WOUT1);
  bf16_t* WQ = (bf16_t*)(ws + OFF_WQ); bf16_t* SKB = (bf16_t*)(ws + OFF_SK);
  unsigned char* U8 = (unsigned char*)(ws + OFF_UB); unsigned char* V8 = (unsigned char*)(ws + OFF_VB);
  float* USC = (float*)(ws + OFF_USC); float* VSC = USC + 2 * 16384;
  bf16_t* AB = (bf16_t*)(ws + OFF_AB);
  bf16_t* FD1 = (bf16_t*)(ws + OFF_FT); bf16_t* FD3 = FD1 + 256 * 128; bf16_t* FDC = FD3 + 128 * 128;
  bf16_t* A1 = (bf16_t*)(ws + OFF_A1); bf16_t* VT0 = (bf16_t*)(ws + OFF_VT0); bf16_t* FQKV = (bf16_t*)(ws + OFF_BF);
  float* BF_ = (float*)(ws + OFF_BF); float* BY = (float*)(ws + OFF_BY);
  float* X1 = (float*)(ws + OFF_X1); float* X2 = (float*)(ws + OFF_X2);
  float* RT = TAB + 16384;
  bf16_t* Q1 = (bf16_t*)(ws + OFF_BF); bf16_t* K1 = Q1 + (size_t)T * 1024; bf16_t* VT1 = K1 + (size_t)R * 256;
  int* EXPB = (int*)(ws + OFF_BY); float* GATEB = (float*)(ws + OFF_BY + (size_t)R * 128 * 4);
  float* out = p.out;

  PH(0, ph_tables(TAB); ph_rope_table(RT))
  PH(1, ph_fft_tables(FD1, FD3, FDC))
  PH(2, ph_ada(c, c_ctx, ada_w, ada_b, Mm))
  PH(3, ph_transpose_w(even_w_in, 1024, 2048, WIN0, smem))
  PH(4, ph_transpose_w(even_w_out, 1024, 1024, WOUT0, smem))
  PH(5, ph_transpose_w(odd_w_in, 1024, 1536, WIN1, smem))
  PH(6, ph_transpose_w(odd_w_out, 1024, 1024, WOUT1, smem))
  PH(7, ph_transpose_w(peer_wq, 1024, 2048, WQ, smem))
  PH(8, ph_transpose_w(peer_wq + (size_t)1024 * 2048, 1024, 2048, WQ + (size_t)2048 * 1024, smem))
  PH(9, ph_quant_rows(peer_u, U8, USC, 2 * 16384))
  PH(10, ph_quant_rows(peer_v, V8, VSC, 2 * 16384))
  PH(11, ph_convert(peer_sk, SKB, (size_t)2 * 8 * 2 * 128 * 128 / 8))
  xcd_barrier(xbar);
  PH(12, ph_modulate(x, ctx, Mm, 0, 0, 1, AB, R, smem))
  xcd_barrier(xbar);
  PH(13, ph_gemm_bf16(AB, 1024, WIN0, 1024, R, 2048, 1024, EpiQKV0{FQKV, VT0}, smem_raw))
  xcd_barrier(xbar);
  PH(14, { GRID_LOOP(u, NB * 64 * 8) fft1_unit(u, FQKV, FD1, TAB, A1, smem_raw); })
  PH(15, { int lane = threadIdx.x & 63, wave = threadIdx.x >> 6;
           for (int u0 = blockIdx.x * 4; u0 < 8192 + 256; u0 += gridDim.x * 4) { int u = u0 + wave;
             if (u < 8192) attn_unit<1, 0>(u, FQKV + 512, 2048, FQKV + 1024, 2048, VT0, VT0 + (size_t)NB * 8 * 64 * S, 8, rpb, nullptr, AB + 512, 1024, lane);
             else attn_unit<1, 1>(u - 8192, FQKV + 512, 2048, FQKV + 1024, 2048, VT0, VT0 + (size_t)NB * 8 * 64 * S, 8, rpb, nullptr, AB + 512, 1024, lane); } })
  xcd_barrier(xbar);
  PH(16, { GRID_LOOP(u, NB * 128 * 8 + NB * 4 * 8) { if (u < NB * 128 * 8) fft3_unit(u, 0, FQKV, A1, FD3, FDC, TAB, AB, smem_raw); else fft3_unit(u - NB * 128 * 8, 1, FQKV, A1, FD3, FDC, TAB, AB, smem_raw); } })
  xcd_barrier(xbar);
  PH(17, ph_gemm_bf16(AB, 1024, WOUT0, 1024, R, 1024, 1024, EpiF32{BY, 1024, 1.f}, smem_raw))
  xcd_barrier(xbar);
  PH(18, ph_post(x, ctx, BY, Mm, 0, 2, ln_g + 0, ln_b + 0, X1, X1 + (size_t)T * D, R, smem))
  xcd_barrier(xbar);
  PH(19, ph_modulate(X1, X1 + (size_t)T * D, Mm, 0, 3, 4, AB, R, smem))
  xcd_barrier(xbar);
  PH(21, ph_peer_select(AB, WQ, SKB, EXPB, GATEB, R, smem_raw))
  xcd_barrier(xbar);
  PH(22, ph_peer_gather8(AB, EXPB, GATEB, U8, USC, V8, VSC, X1, Mm, 0, ln_g + 1024, ln_b + 1024, X2, true, R))
  xcd_barrier(xbar);
  PH(23, ph_gemm_bf16(AB, 1024, WIN1, 1024, R, 1536, 1024, EpiQKV1{Q1, K1, VT1, RT}, smem_raw))
  xcd_barrier(xbar);
  PH(25, { int lane = threadIdx.x & 63, wave = threadIdx.x >> 6;
           for (int u0 = blockIdx.x * 4; u0 < 4096; u0 += gridDim.x * 4) { int u = u0 + wave;
             attn_unit<4, 2>(u, Q1, 1024, K1, 256, VT1, VT1 + (size_t)NB * 4 * 64 * S, 4, nullptr, sink, AB, 1024, lane); } })
  xcd_barrier(xbar);
  PH(26, ph_gemm_bf16(AB, 1024, WOUT1, 1024, T, 1024, 1024, EpiF32{BY, 1024, 1.f}, smem_raw))
  xcd_barrier(xbar);
  PH(27, ph_post(X2, X2, BY, Mm, 1, 2, ln_g + 2048, ln_b + 2048, X1, X1, T, smem))
  xcd_barrier(xbar);
  PH(28, ph_modulate(X1, X1, Mm, 1, 3, 4, AB, T, smem))
  xcd_barrier(xbar);
  PH(30, ph_peer_select(AB, WQ + (size_t)2048 * 1024, SKB + (size_t)8 * 2 * 128 * 128, EXPB, GATEB, T, smem_raw))
  xcd_barrier(xbar);
  PH(31, ph_peer_gather8(AB, EXPB, GATEB, U8 + (size_t)16384 * 1024, USC + 16384, V8 + (size_t)16384 * 1024, VSC + 16384, X1, Mm, 1, ln_g + 3072, ln_b + 3072, out, false, T))
}

}

extern "C" void kernel_launch(void* const* d_in, const int* in_sizes, int n_in, void* d_out, int out_size, void* d_ws,
                              size_t ws_size, hipStream_t stream) {
  static int grid_blocks = 0;
  if (!grid_blocks) {
    int dev = 0, cus = 0, per_cu = 0;
    hipGetDevice(&dev);
    hipDeviceGetAttribute(&cus, hipDeviceAttributeMultiprocessorCount, dev);
    hipOccupancyMaxActiveBlocksPerMultiprocessor(&per_cu, (const void*)mega, 256, 0);
    if (per_cu > 2) per_cu = 2;
    if (per_cu < 1) per_cu = 1;
    grid_blocks = cus * per_cu;
  }
  Params p{};
  for (int i = 0; i < 18; ++i) p.in[i] = (const float*)d_in[i];
  p.out = (float*)d_out;
  p.ws = (float*)d_ws;
  (void)hipMemsetAsync((char*)d_ws + OFF_BAR, 0, XCD_BAR_WORDS_C * 4, stream);
  void* args[] = {&p};
  hipError_t e = hipLaunchCooperativeKernel((const void*)mega, dim3(grid_blocks), dim3(256), args, 0, stream);
  if (e != hipSuccess) fprintf(stderr, "cooperative launch failed: %s (grid %d)\n", hipGetErrorString(e), grid_blocks);
}
```

```cpp
#include <hip/hip_runtime.h>
#include <hip/hip_bf16.h>
#include <stdint.h>
#include <math.h>
#include <stdio.h>
#include <hip/hip_cooperative_groups.h>
namespace cg = cooperative_groups;

namespace {

constexpr int D = 1024;
constexpr int NB = 2;
constexpr int S = 8192;
constexpr int T = NB * S;
constexpr int CL = 256;
constexpr int TC = NB * CL;
constexpr int R = T + TC;
constexpr float DN_ALPHA = 1.4142135623730951f;
constexpr float LN_EPS = 1e-6f;

__device__ __forceinline__ float wave_sum(float v) {
#pragma unroll
  for (int off = 32; off; off >>= 1) v += __shfl_xor(v, off);
  return v;
}
__device__ __forceinline__ float wave_max(float v) {
#pragma unroll
  for (int off = 32; off; off >>= 1) v = fmaxf(v, __shfl_xor(v, off));
  return v;
}

typedef unsigned short bf16_t;
typedef __attribute__((ext_vector_type(8))) short bf16x8;
typedef __attribute__((ext_vector_type(16))) float f32x16;
typedef __attribute__((ext_vector_type(4))) float f32x4;

__device__ __forceinline__ unsigned f2bf(float f) {
  unsigned u = __float_as_uint(f);
  u += 0x7fffu + ((u >> 16) & 1u);
  return u >> 16;
}
__device__ __forceinline__ unsigned pack2bf(float a, float b) { return f2bf(a) | (f2bf(b) << 16); }
__device__ __forceinline__ float bf2f(unsigned short v) { return __uint_as_float(((unsigned)v) << 16); }

__device__ __forceinline__ int mod_index(int row) { return row < T ? row / S : 2; }


struct Params {
  const float* in[18];
  float* out;
  float* ws;
};

constexpr size_t XCD_BAR_WORDS_C = 3456;
constexpr size_t al256(size_t n) { return (n + 255) & ~(size_t)255; }
constexpr size_t OFF_BAR = 0;
constexpr size_t OFF_TAB = al256(XCD_BAR_WORDS_C * 4);
constexpr size_t OFF_M = OFF_TAB + al256(16384 * 4 + 128 * 16 * 2 * 4);
constexpr size_t OFF_WIN0 = OFF_M + al256(2 * 3 * 6144 * 4);
constexpr size_t OFF_WOUT0 = OFF_WIN0 + al256((size_t)2048 * 1024 * 2);
constexpr size_t OFF_WIN1 = OFF_WOUT0 + al256((size_t)1024 * 1024 * 2);
constexpr size_t OFF_WOUT1 = OFF_WIN1 + al256((size_t)1536 * 1024 * 2);
constexpr size_t OFF_WQ = OFF_WOUT1 + al256((size_t)1024 * 1024 * 2);
constexpr size_t OFF_SK = OFF_WQ + al256((size_t)2 * 2048 * 1024 * 2);
constexpr size_t OFF_UB = OFF_SK + al256((size_t)2 * 8 * 2 * 128 * 128 * 2);
constexpr size_t OFF_VB = OFF_UB + al256((size_t)2 * 16384 * 1024);
constexpr size_t OFF_USC = OFF_VB + al256((size_t)2 * 16384 * 1024);
constexpr size_t OFF_AB = OFF_USC + al256((size_t)4 * 16384 * 4);
constexpr size_t OFF_FT = OFF_AB + al256((size_t)R * 1024 * 2);
constexpr size_t OFF_BF = OFF_FT + al256((size_t)(256 * 128 + 128 * 128 + 64 * 128) * 2);
constexpr size_t OFF_BY = OFF_BF + al256((size_t)R * 2048 * 4);
constexpr size_t OFF_X1 = OFF_BY + al256((size_t)R * 1024 * 4);
constexpr size_t OFF_X2 = OFF_X1 + al256((size_t)R * 1024 * 4);
constexpr size_t OFF_END = OFF_X2 + al256((size_t)R * 1024 * 4);
constexpr size_t OFF_A1 = OFF_BY;
constexpr size_t OFF_VT0 = OFF_X2;
static_assert(OFF_END <= (size_t)512 * 1024 * 1024, "workspace overflow");

#define GRID_LOOP(var, n) for (int var = blockIdx.x; var < (n); var += gridDim.x)

__device__ __forceinline__ void ph_fft_tables(bf16_t* D1, bf16_t* D3, bf16_t* DcT) {
  const double TWO_PI = 6.283185307179586476925286766559;
  for (int i = blockIdx.x * 256 + threadIdx.x; i < 256 * 128 + 128 * 128 + 64 * 128; i += gridDim.x * 256) {
    if (i < 256 * 128) {
      int m = i >> 7, r = i & 127; int k1 = m >> 1, ri = m & 1;
      double a = TWO_PI * (double)((k1 * r) & 127) / 128.0;
      D1[i] = (bf16_t)f2bf(ri == 0 ? (float)cos(a) : (float)(-sin(a)));
    } else if (i < 256 * 128 + 128 * 128) {
      int j = i - 256 * 128; int m = j >> 7, kk = j & 127; int rip = m >> 6, k2 = m & 63; int c = kk >> 1, ri = kk & 1;
      double a = TWO_PI * (double)((k2 * c) & 63) / 64.0;
      double v = (rip == 0) ? (ri == 0 ? cos(a) : sin(a)) : (ri == 0 ? -sin(a) : cos(a));
      D3[j] = (bf16_t)f2bf((float)v);
    } else {
      int j = i - 256 * 128 - 128 * 128; int cp = j >> 7, kk = j & 127; int rip = kk >> 6, ch = kk & 63;
      double a = TWO_PI * (double)((ch * cp) & 63) / 64.0;
      DcT[j] = (bf16_t)f2bf((float)(rip == 0 ? cos(a) : sin(a)));
    }
  }
}
__device__ __forceinline__ void ph_rope_table(float* RT) {
  for (int i = blockIdx.x * 256 + threadIdx.x; i < 128 * 16; i += gridDim.x * 256) {
    int pos = i >> 4, f = i & 15;
    float inv_freq = powf(10000.0f, -(float)f / 16.0f);
    float ang = (float)pos * inv_freq;
    RT[2 * i] = cosf(ang); RT[2 * i + 1] = sinf(ang);
  }
}
__device__ __forceinline__ void ph_tables(float* tab) {
  for (int j = blockIdx.x * 256 + threadIdx.x; j < 8192; j += gridDim.x * 256) {
    double a = 6.283185307179586476925286766559 * (double)j / 8192.0;
    tab[j] = (float)cos(a);
    tab[8192 + j] = (float)sin(a);
  }
}
__device__ __forceinline__ void ph_ada(const float* __restrict__ c, const float* __restrict__ c_ctx, const float* __restrict__ ada_w,
                       const float* __restrict__ ada_b, float* __restrict__ M) {
  for (int gid = blockIdx.x * 256 + threadIdx.x; gid < 2 * 3 * 6144; gid += gridDim.x * 256) {
    int col = gid % 6144; int idx = (gid / 6144) % 3; int layer = gid / (3 * 6144);
    const float* vec = idx < 2 ? c + idx * D : c_ctx;
    const float* w = ada_w + (size_t)layer * D * 6144 + col;
    float acc = 0.f;
    for (int k = 0; k < D; ++k) {
      float x = vec[k];
      float sx = x / (1.f + expf(-x));
      acc += sx * w[(size_t)k * 6144];
    }
    M[gid] = acc + ada_b[layer * 6144 + col];
  }
}

__device__ __forceinline__ void ph_modulate(const float* __restrict__ xa, const float* __restrict__ xb, const float* __restrict__ M, int layer,
                            int jshift, int jscale, bf16_t* __restrict__ out, int nrows, float* red) {
  int tid = threadIdx.x;
  GRID_LOOP(row, nrows) {
    const float* x = row < T ? xa + (size_t)row * D : xb + (size_t)(row - T) * D;
    float v[4]; float s = 0.f;
#pragma unroll
    for (int i = 0; i < 4; ++i) { v[i] = x[tid + 256 * i]; s += v[i]; }
    s = wave_sum(s);
    __syncthreads();
    if ((tid & 63) == 0) red[tid >> 6] = s;
    __syncthreads();
    float mu = (red[0] + red[1] + red[2] + red[3]) * (1.f / D);
    float q = 0.f;
#pragma unroll
    for (int i = 0; i < 4; ++i) { float d = v[i] - mu; q += d * d; }
    q = wave_sum(q);
    if ((tid & 63) == 0) red[4 + (tid >> 6)] = q;
    __syncthreads();
    float var = (red[4] + red[5] + red[6] + red[7]) * (1.f / D);
    float rs = rsqrtf(var + LN_EPS);
    const float* m = M + ((size_t)layer * 3 + mod_index(row)) * 6144;
#pragma unroll
    for (int i = 0; i < 4; ++i) {
      int col = tid + 256 * i;
      float y = (v[i] - mu) * rs;
      out[(size_t)row * D + col] = (bf16_t)f2bf(y * (1.f + m[jscale * D + col]) + m[jshift * D + col]);
    }
  }
}

__device__ __forceinline__ void ph_post(const float* __restrict__ xa, const float* __restrict__ xb, const float* __restrict__ Y,
                        const float* __restrict__ M, int layer, int j, const float* __restrict__ g, const float* __restrict__ bb,
                        float* __restrict__ outa, float* __restrict__ outb, int nrows, float* red) {
  int tid = threadIdx.x;
  GRID_LOOP(row, nrows) {
    const float* x = row < T ? xa + (size_t)row * D : xb + (size_t)(row - T) * D;
    float* out = row < T ? outa + (size_t)row * D : outb + (size_t)(row - T) * D;
    const float* m = M + ((size_t)layer * 3 + mod_index(row)) * 6144 + j * D;
    float v[4]; float s = 0.f;
#pragma unroll
    for (int i = 0; i < 4; ++i) { int col = tid + 256 * i; v[i] = DN_ALPHA * x[col] + m[col] * Y[(size_t)row * D + col]; s += v[i]; }
    s = wave_sum(s);
    __syncthreads();
    if ((tid & 63) == 0) red[tid >> 6] = s;
    __syncthreads();
    float mu = (red[0] + red[1] + red[2] + red[3]) * (1.f / D);
    float q = 0.f;
#pragma unroll
    for (int i = 0; i < 4; ++i) { float d = v[i] - mu; q += d * d; }
    q = wave_sum(q);
    if ((tid & 63) == 0) red[4 + (tid >> 6)] = q;
    __syncthreads();
    float var = (red[4] + red[5] + red[6] + red[7]) * (1.f / D);
    float rs = rsqrtf(var + LN_EPS);
#pragma unroll
    for (int i = 0; i < 4; ++i) {
      int col = tid + 256 * i;
      out[col] = (v[i] - mu) * rs * g[col] + bb[col];
    }
  }
}

struct ARow { const float* A; int lda; __device__ float operator()(int m, int k) const { return A[(size_t)m * lda + k]; } };
struct BRow { const float* B; int ldb; __device__ float operator()(int k, int n) const { return B[(size_t)k * ldb + n]; } };
struct CRow { float* C; int ldc; float scale; __device__ void operator()(int m, int n, float v) const { C[(size_t)m * ldc + n] = v * scale; } };
struct CRowB { bf16_t* C; int ldc; float scale; __device__ void operator()(int m, int n, float v) const { C[(size_t)m * ldc + n] = (bf16_t)f2bf(v * scale); } };
struct ADft { const float* tab; int Sn; int stride; __device__ float operator()(int m, int k) const {
    int t = k & (Sn - 1); int idx = ((m * t) & (Sn - 1)) * stride;
    return k < Sn ? tab[idx] : -tab[8192 + idx]; } };
struct BPQ { const float* PQ; int rowbase; int Sn; __device__ float operator()(int k, int n) const {
    int t = k & (Sn - 1); return PQ[(size_t)(rowbase + t) * 1024 + (k >= Sn ? 512 : 0) + n]; } };

template <class AF, class BF, class CF>
__device__ __forceinline__ void ph_gemm(AF af, BF bf, CF cf, int M, int N, int K, float* sm) {
  float (*sA)[68] = (float (*)[68])sm;
  float (*sB)[68] = (float (*)[68])(sm + 16 * 68);
  int tid = threadIdx.x; int tx = tid & 15, ty = tid >> 4;
  int ntn = N / 64; int ntiles = (M / 64) * ntn;
  GRID_LOOP(tile, ntiles) {
    int m0 = (tile / ntn) * 64, n0 = (tile % ntn) * 64;
    float acc[4][4];
#pragma unroll
    for (int i = 0; i < 4; ++i)
#pragma unroll
      for (int j = 0; j < 4; ++j) acc[i][j] = 0.f;
    for (int k0 = 0; k0 < K; k0 += 16) {
      __syncthreads();
#pragma unroll
      for (int i = 0; i < 4; ++i) { int e = tid + 256 * i; int m = e >> 4, k = e & 15; sA[k][m] = af(m0 + m, k0 + k); }
#pragma unroll
      for (int i = 0; i < 4; ++i) { int e = tid + 256 * i; int k = e >> 6, n = e & 63; sB[k][n] = bf(k0 + k, n0 + n); }
      __syncthreads();
#pragma unroll
      for (int k = 0; k < 16; ++k) {
        float a[4], b[4];
#pragma unroll
        for (int i = 0; i < 4; ++i) { a[i] = sA[k][ty * 4 + i]; b[i] = sB[k][tx * 4 + i]; }
#pragma unroll
        for (int i = 0; i < 4; ++i)
#pragma unroll
          for (int j = 0; j < 4; ++j) acc[i][j] += a[i] * b[j];
      }
    }
#pragma unroll
    for (int i = 0; i < 4; ++i)
#pragma unroll
      for (int j = 0; j < 4; ++j) cf(m0 + ty * 4 + i, n0 + tx * 4 + j, acc[i][j]);
  }
}


__device__ __forceinline__ void ph_transpose_w(const float* __restrict__ W, int K, int N, bf16_t* __restrict__ Wt, float* sm) {
  int tid = threadIdx.x;
  int tk = K / 64, tn = N / 64;
  GRID_LOOP(tile, tk * tn) {
    int k0 = (tile / tn) * 64, n0 = (tile % tn) * 64;
    __syncthreads();
#pragma unroll
    for (int i = 0; i < 16; ++i) { int e = tid + 256 * i; int k = e >> 6, n = e & 63; sm[k * 65 + n] = W[(size_t)(k0 + k) * N + n0 + n]; }
    __syncthreads();
#pragma unroll
    for (int i = 0; i < 2; ++i) {
      int e = tid + 256 * i; int n = e >> 3, kc = e & 7;
      unsigned w[4];
#pragma unroll
      for (int j = 0; j < 4; ++j) w[j] = pack2bf(sm[(kc * 8 + 2 * j) * 65 + n], sm[(kc * 8 + 2 * j + 1) * 65 + n]);
      *(uint4*)(Wt + (size_t)(n0 + n) * K + k0 + kc * 8) = make_uint4(w[0], w[1], w[2], w[3]);
    }
  }
}
__device__ __forceinline__ void ph_convert(const float* __restrict__ src, bf16_t* __restrict__ dst, size_t n8) {
  for (size_t i = (size_t)blockIdx.x * 256 + threadIdx.x; i < n8; i += (size_t)gridDim.x * 256) {
    float4 a = ((const float4*)src)[2 * i], b = ((const float4*)src)[2 * i + 1];
    ((uint4*)dst)[i] = make_uint4(pack2bf(a.x, a.y), pack2bf(a.z, a.w), pack2bf(b.x, b.y), pack2bf(b.z, b.w));
  }
}

__device__ __forceinline__ void gemm_stage(const bf16_t* __restrict__ A, int lda, int k0, char* lds, int tid) {
#pragma unroll
  for (int i = 0; i < 4; ++i) {
    int q = tid + 256 * i; int row = q >> 3, p = q & 7; int c = p ^ ((row >> 1) & 7);
    const bf16_t* src = A + (size_t)row * lda + k0 + c * 8;
    __builtin_amdgcn_global_load_lds((const unsigned*)src, (unsigned*)(lds + q * 16), 16, 0, 0);
  }
}
struct EpiF32 {
  float* C; int ldc; float scale;
  __device__ __forceinline__ void operator()(int m0, int n0, int wm, int wn, f32x16 (&acc)[2][2], int tid, char* smem) const {
    int lane = tid & 63;
    float* t = (float*)smem;
    int rbase = wm * 64 + 4 * (lane >> 5), cbase = wn * 64 + (lane & 31);
#pragma unroll
    for (int mi = 0; mi < 2; ++mi)
#pragma unroll
      for (int ni = 0; ni < 2; ++ni)
#pragma unroll
        for (int r = 0; r < 16; ++r)
          t[(rbase + mi * 32 + (r & 3) + 8 * (r >> 2)) * 128 + cbase + ni * 32] = acc[mi][ni][r] * scale;
    __syncthreads();
    float* dst = C + (size_t)(m0 + (tid >> 5)) * ldc + n0 + (tid & 31) * 4;
    const float* src = t + (tid >> 5) * 128 + (tid & 31) * 4;
#pragma unroll 4
    for (int i = 0; i < 16; ++i) {
      *(float4*)dst = *(const float4*)src;
      dst += (size_t)8 * ldc; src += 8 * 128;
    }
  }
};
struct EpiQKV0 {
  bf16_t* FQKV; bf16_t* VT;
  __device__ __forceinline__ void operator()(int m0, int n0, int wm, int wn, f32x16 (&acc)[2][2], int tid, char* smem) const {
    int lane = tid & 63;
    bf16_t* t = (bf16_t*)smem;
    int rbase = wm * 64 + 4 * (lane >> 5), cbase = wn * 64 + (lane & 31);
#pragma unroll
    for (int mi = 0; mi < 2; ++mi)
#pragma unroll
      for (int ni = 0; ni < 2; ++ni)
#pragma unroll
        for (int r = 0; r < 16; ++r)
          t[(rbase + mi * 32 + (r & 3) + 8 * (r >> 2)) * 136 + cbase + ni * 32] = (bf16_t)f2bf(acc[mi][ni][r]);
    __syncthreads();
    {
      bf16_t* dst = FQKV + (size_t)(m0 + (tid >> 4)) * 2048 + n0 + (tid & 15) * 8;
      const bf16_t* src = t + (tid >> 4) * 136 + (tid & 15) * 8;
#pragma unroll 4
      for (int i = 0; i < 8; ++i) {
        *(uint4*)dst = *(const uint4*)src;
        dst += (size_t)16 * 2048; src += 16 * 136;
      }
    }
    if (n0 >= 1536) {
      int col = tid >> 1, half = tid & 1;
      int hd = (n0 - 1536) / 64 + (col >> 6), d = col & 63;
      bf16_t* dst;
      if (m0 < T) { int b = m0 / S, t0 = m0 % S; dst = VT + (((size_t)b * 8 + hd) * 64 + d) * S + t0 + half * 64; }
      else { int mm = m0 - T; int b = mm / CL, l0 = mm % CL; dst = VT + (size_t)NB * 8 * 64 * S + (((size_t)b * 8 + hd) * 64 + d) * CL + l0 + half * 64; }
      const bf16_t* src = t + (half * 64) * 136 + col;
#pragma unroll
      for (int i = 0; i < 8; ++i) {
        unsigned wv[4];
#pragma unroll
        for (int j = 0; j < 4; ++j) wv[j] = (unsigned)src[(i * 8 + 2 * j) * 136] | ((unsigned)src[(i * 8 + 2 * j + 1) * 136] << 16);
        *(uint4*)(dst + i * 8) = make_uint4(wv[0], wv[1], wv[2], wv[3]);
      }
    }
  }
};
struct EpiBf16 {
  bf16_t* C; int ldc;
  __device__ __forceinline__ void operator()(int m0, int n0, int wm, int wn, f32x16 (&acc)[2][2], int tid, char* smem) const {
    int lane = tid & 63;
    asm volatile("" : "+v"(lane));
    bf16_t* t = (bf16_t*)smem;
    {
      bf16_t* tw = t + (wm * 64 + 4 * (lane >> 5)) * 136 + wn * 64 + (lane & 31);
#pragma unroll
      for (int mi = 0; mi < 2; ++mi)
#pragma unroll
        for (int ni = 0; ni < 2; ++ni)
#pragma unroll
          for (int r = 0; r < 16; ++r)
            tw[(mi * 32 + (r & 3) + 8 * (r >> 2)) * 136 + ni * 32] = (bf16_t)f2bf(acc[mi][ni][r]);
    }
    __syncthreads();
    bf16_t* dst = C + (size_t)(m0 + (tid >> 4)) * ldc + n0 + (tid & 15) * 8;
    const bf16_t* src = t + (tid >> 4) * 136 + (tid & 15) * 8;
#pragma unroll 4
    for (int i = 0; i < 8; ++i) {
      *(uint4*)dst = *(const uint4*)src;
      dst += (size_t)16 * ldc; src += 16 * 136;
    }
  }
};
struct EpiQKV1 {
  bf16_t* Q1; bf16_t* K1; bf16_t* VT; const float* RT;
  __device__ __forceinline__ void operator()(int m0, int n0, int wm, int wn, f32x16 (&acc)[2][2], int tid, char* smem) const {
    int lane = tid & 63;
    asm volatile("" : "+v"(lane));
    bf16_t* t = (bf16_t*)smem;
    if (n0 < 1280 && m0 < T) {
      int i = lane & 31; int f = i & 15;
#pragma unroll
      for (int mi = 0; mi < 2; ++mi)
#pragma unroll
        for (int r = 0; r < 16; ++r) {
          int row = m0 + wm * 64 + 4 * (lane >> 5) + mi * 32 + (r & 3) + 8 * (r >> 2);
          int tt = row & (S - 1);
          int pos = (i < 16) ? (tt >> 6) : (tt & 63);
          float2 cs = *(const float2*)(RT + 2 * (pos * 16 + f));
          float x1 = acc[mi][0][r], x2 = acc[mi][1][r];
          acc[mi][0][r] = x1 * cs.x - x2 * cs.y;
          acc[mi][1][r] = x1 * cs.y + x2 * cs.x;
        }
    }
    {
      bf16_t* tw = t + (wm * 64 + 4 * (lane >> 5)) * 136 + wn * 64 + (lane & 31);
#pragma unroll
      for (int mi = 0; mi < 2; ++mi)
#pragma unroll
        for (int ni = 0; ni < 2; ++ni)
#pragma unroll
          for (int r = 0; r < 16; ++r)
            tw[(mi * 32 + (r & 3) + 8 * (r >> 2)) * 136 + ni * 32] = (bf16_t)f2bf(acc[mi][ni][r]);
    }
    __syncthreads();
    if (n0 < 1280) {
      bf16_t* dst; int ld;
      if (n0 < 1024) { dst = Q1 + (size_t)(m0 + (tid >> 4)) * 1024 + n0 + (tid & 15) * 8; ld = 1024; }
      else { dst = K1 + (size_t)(m0 + (tid >> 4)) * 256 + (n0 - 1024) + (tid & 15) * 8; ld = 256; }
      if (n0 >= 1024 || m0 < T) {
        const bf16_t* src = t + (tid >> 4) * 136 + (tid & 15) * 8;
#pragma unroll 4
        for (int i = 0; i < 8; ++i) {
          *(uint4*)dst = *(const uint4*)src;
          dst += (size_t)16 * ld; src += 16 * 136;
        }
      }
    } else {
      int col = tid >> 1, half = tid & 1;
      int hd = (n0 - 1280) / 64 + (col >> 6), d = col & 63;
      bf16_t* dst;
      if (m0 < T) { int b = m0 / S, t0 = m0 % S; dst = VT + (((size_t)b * 4 + hd) * 64 + d) * S + t0 + half * 64; }
      else { int mm = m0 - T; int b = mm / CL, l0 = mm % CL; dst = VT + (size_t)NB * 4 * 64 * S + (((size_t)b * 4 + hd) * 64 + d) * CL + l0 + half * 64; }
      const bf16_t* src = t + (half * 64) * 136 + col;
#pragma unroll
      for (int i = 0; i < 8; ++i) {
        unsigned wv[4];
#pragma unroll
        for (int j = 0; j < 4; ++j) wv[j] = (unsigned)src[(i * 8 + 2 * j) * 136] | ((unsigned)src[(i * 8 + 2 * j + 1) * 136] << 16);
        *(uint4*)(dst + i * 8) = make_uint4(wv[0], wv[1], wv[2], wv[3]);
      }
    }
  }
};
__device__ __forceinline__ void gemm_tile_mainloop(const bf16_t* __restrict__ Ag, int lda, const bf16_t* __restrict__ Bg, int ldb, int KT,
                                                   f32x16 (&acc)[2][2], char* smem) {
  int tid = threadIdx.x;
  asm volatile("" : "+v"(tid));
  int lane = tid & 63, wave = tid >> 6, wm = wave >> 1, wn = wave & 1;
#pragma unroll
  for (int mi = 0; mi < 2; ++mi)
#pragma unroll
    for (int ni = 0; ni < 2; ++ni)
#pragma unroll
      for (int r = 0; r < 16; ++r) acc[mi][ni][r] = 0.f;
  __syncthreads();
  gemm_stage(Ag, lda, 0, smem, tid); gemm_stage(Bg, ldb, 0, smem + 16384, tid);
  for (int kt = 0; kt < KT; ++kt) {
    asm volatile("s_waitcnt vmcnt(0)" ::: "memory");
    __syncthreads();
    char* cur = smem + (kt & 1) * 32768;
    if (kt + 1 < KT) {
      char* nxt = smem + ((kt + 1) & 1) * 32768;
      gemm_stage(Ag, lda, (kt + 1) * 64, nxt, tid); gemm_stage(Bg, ldb, (kt + 1) * 64, nxt + 16384, tid);
    }
#pragma unroll
    for (int s4 = 0; s4 < 4; ++s4) {
      bf16x8 a[2], b[2];
      int c = 2 * s4 + (lane >> 5);
#pragma unroll
      for (int mi = 0; mi < 2; ++mi) { int row = wm * 64 + mi * 32 + (lane & 31); a[mi] = *(const bf16x8*)(cur + row * 128 + ((c ^ ((row >> 1) & 7)) << 4)); }
#pragma unroll
      for (int ni = 0; ni < 2; ++ni) { int row = wn * 64 + ni * 32 + (lane & 31); b[ni] = *(const bf16x8*)(cur + 16384 + row * 128 + ((c ^ ((row >> 1) & 7)) << 4)); }
#pragma unroll
      for (int mi = 0; mi < 2; ++mi)
#pragma unroll
        for (int ni = 0; ni < 2; ++ni) acc[mi][ni] = __builtin_amdgcn_mfma_f32_32x32x16_bf16(a[mi], b[ni], acc[mi][ni], 0, 0, 0);
    }
  }
  __syncthreads();
}
template <class Epi>
__device__ __forceinline__ void ph_gemm_bf16(const bf16_t* __restrict__ A, int lda, const bf16_t* __restrict__ Bt, int ldb, int M, int N, int K,
                             Epi epi, char* smem) {
  int tid = threadIdx.x, wave = tid >> 6, wm = wave >> 1, wn = wave & 1;
  int ntn = N / 128, ntiles = (M / 128) * ntn;
  int KT = K / 64;
  GRID_LOOP(tile, ntiles) {
    int mt = tile / ntn, nt = tile % ntn;
    f32x16 acc[2][2];
    gemm_tile_mainloop(A + (size_t)mt * 128 * lda, lda, Bt + (size_t)nt * 128 * ldb, ldb, KT, acc, smem);
    epi(mt * 128, nt * 128, wm, wn, acc, tid, smem);
  }
}

__device__ __forceinline__ void ins16(float (&L)[16], float x) {
#pragma unroll
  for (int j = 15; j >= 1; --j) L[j] = __builtin_amdgcn_fmed3f(L[j - 1], L[j], x);
  L[0] = fmaxf(L[0], x);
}
__device__ __forceinline__ void stage_tile128(const bf16_t* __restrict__ src, int ld, char* lds, int tid) {
#pragma unroll
  for (int i = 0; i < 8; ++i) {
    int q = tid + 256 * i; int row = q >> 4, p = q & 15; int c = p ^ (row & 15);
    __builtin_amdgcn_global_load_lds((const unsigned*)(src + (size_t)row * ld + c * 8), (unsigned*)(lds + q * 16), 16, 0, 0);
  }
}
__device__ __forceinline__ void ph_peer_select(const bf16_t* __restrict__ H, const bf16_t* __restrict__ WQl, const bf16_t* __restrict__ SKl,
                                               int* __restrict__ EXP, float* __restrict__ GATE, int nrows, char* smem) {
  int tid = threadIdx.x, w = tid >> 6, wm = w >> 1, wn = w & 1;
  bf16_t* Qs = (bf16_t*)smem;
  int* KL = (int*)(smem + 36864);
  int nunits = (nrows / 128) * 8;
  GRID_LOOP(unit, nunits) {
    int mt = unit >> 3, h = unit & 7;
    float L0[16], L1[16];
#pragma unroll
    for (int p = 0; p < 2; ++p) {
      f32x16 acc[2][2];
      gemm_tile_mainloop(H + (size_t)mt * 128 * 1024, 1024, WQl + (size_t)(h * 256 + p * 128) * 1024, 1024, 16, acc, smem);
      int lane = tid & 63;
      asm volatile("" : "+v"(lane));
      {
        bf16_t* qw = Qs + (wm * 64 + 4 * (lane >> 5)) * 136 + wn * 64 + (lane & 31);
#pragma unroll
        for (int mi = 0; mi < 2; ++mi)
#pragma unroll
          for (int ni = 0; ni < 2; ++ni)
#pragma unroll
            for (int r = 0; r < 16; ++r)
              qw[(mi * 32 + (r & 3) + 8 * (r >> 2)) * 136 + ni * 32] = (bf16_t)f2bf(acc[mi][ni][r]);
      }
      __syncthreads();
      f32x16 sc[4];
#pragma unroll
      for (int m4 = 0; m4 < 4; ++m4)
#pragma unroll
        for (int r = 0; r < 16; ++r) sc[m4][r] = 0.f;
      {
        const bf16_t* qrow = Qs + (32 * w + (lane & 31)) * 136 + 8 * (lane >> 5);
        const bf16_t* krow = SKl + (size_t)(h * 2 + p) * 128 * 128 + (lane & 31) * 128 + 8 * (lane >> 5);
#pragma unroll
        for (int s8 = 0; s8 < 8; ++s8) {
          bf16x8 bq = *(const bf16x8*)(qrow + 16 * s8);
#pragma unroll
          for (int m4 = 0; m4 < 4; ++m4) {
            bf16x8 ak = *(const bf16x8*)(krow + m4 * 32 * 128 + 16 * s8);
            sc[m4] = __builtin_amdgcn_mfma_f32_32x32x16_bf16(ak, bq, sc[m4], 0, 0, 0);
          }
        }
      }
      float L[16];
#pragma unroll
      for (int j = 0; j < 16; ++j) L[j] = -INFINITY;
      unsigned kb = 4u * (unsigned)(lane >> 5);
#pragma unroll
      for (int m4 = 0; m4 < 4; ++m4)
#pragma unroll
        for (int r = 0; r < 16; ++r) {
          unsigned key = kb + (unsigned)(32 * m4 + (r & 3) + 8 * (r >> 2));
          float x = __uint_as_float((__float_as_uint(sc[m4][r]) & 0xFFFFFF80u) | key);
          ins16(L, x);
        }
      float P[16];
#pragma unroll
      for (int j = 0; j < 16; ++j) P[j] = __shfl_xor(L[j], 32);
#pragma unroll
      for (int j = 0; j < 16; ++j) ins16(L, P[j]);
      if (p == 0) {
#pragma unroll
        for (int j = 0; j < 16; ++j) L0[j] = L[j];
      } else {
#pragma unroll
        for (int j = 0; j < 16; ++j) L1[j] = L[j];
      }
    }
    float C[16];
#pragma unroll
    for (int j = 0; j < 16; ++j) C[j] = -INFINITY;
#pragma unroll
    for (int a = 0; a < 16; ++a)
#pragma unroll
      for (int b = 0; b < 16; ++b)
        if ((a + 1) * (b + 1) <= 16) {
          float sa = __uint_as_float(__float_as_uint(L0[a]) & 0xFFFFFF80u);
          float sb = __uint_as_float(__float_as_uint(L1[b]) & 0xFFFFFF80u);
          float x = __uint_as_float((__float_as_uint(sa + sb) & 0xFFFFFF00u) | (unsigned)(a * 16 + b));
          ins16(C, x);
        }
    int lane = tid & 63;
    asm volatile("" : "+v"(lane));
    int token = 32 * w + (lane & 31);
    if (lane < 32) {
#pragma unroll
      for (int j = 0; j < 16; ++j) { KL[token * 32 + j] = (int)(__float_as_uint(L0[j]) & 0x7Fu); KL[token * 32 + 16 + j] = (int)(__float_as_uint(L1[j]) & 0x7Fu); }
    }
    __syncthreads();
    if (lane < 32) {
      float c0 = __uint_as_float(__float_as_uint(C[0]) & 0xFFFFFF00u);
      float ev[16]; float sum = 0.f; int ex[16];
#pragma unroll
      for (int j = 0; j < 16; ++j) {
        unsigned bits = __float_as_uint(C[j]);
        float cv = __uint_as_float(bits & 0xFFFFFF00u);
        ev[j] = __expf(cv - c0); sum += ev[j];
        int a = (bits >> 4) & 15, b = bits & 15;
        ex[j] = KL[token * 32 + a] * 128 + KL[token * 32 + 16 + b];
      }
      float inv = 1.f / sum;
      size_t o = (size_t)(mt * 128 + token) * 128 + h * 16;
#pragma unroll
      for (int j = 0; j < 16; j += 4) {
        *(int4*)(EXP + o + j) = make_int4(ex[j], ex[j + 1], ex[j + 2], ex[j + 3]);
        *(float4*)(GATE + o + j) = make_float4(ev[j] * inv, ev[j + 1] * inv, ev[j + 2] * inv, ev[j + 3] * inv);
      }
    }
  }
}

__device__ __forceinline__ void fft1_unit(int u, const bf16_t* __restrict__ FQKV, const bf16_t* __restrict__ D1, const float* __restrict__ TAB,
                          bf16_t* __restrict__ A1, char* smem) {
  int tid = threadIdx.x, lane = tid & 63, w = tid >> 6;
  int g = u & 7, c = (u >> 3) & 63, b = u >> 9;
  bf16_t* Bt = (bf16_t*)smem;
  __syncthreads();
  {
    int r = tid >> 1, half = tid & 1;
    const uint4* src = (const uint4*)(FQKV + (size_t)(b * S + 64 * r + c) * 2048 + g * 64 + half * 32);
    unsigned wv[16];
#pragma unroll
    for (int i = 0; i < 4; ++i) { uint4 v = src[i]; wv[4 * i] = v.x; wv[4 * i + 1] = v.y; wv[4 * i + 2] = v.z; wv[4 * i + 3] = v.w; }
#pragma unroll
    for (int j = 0; j < 32; ++j) {
      unsigned e = (j & 1) ? (wv[j >> 1] >> 16) : (wv[j >> 1] & 0xffffu);
      Bt[(half * 32 + j) * 136 + r] = (bf16_t)e;
    }
  }
  __syncthreads();
  f32x16 acc[2][2];
#pragma unroll
  for (int mi = 0; mi < 2; ++mi)
#pragma unroll
    for (int ni = 0; ni < 2; ++ni)
#pragma unroll
      for (int r = 0; r < 16; ++r) acc[mi][ni][r] = 0.f;
#pragma unroll
  for (int s8 = 0; s8 < 8; ++s8) {
    bf16x8 a[2], bb[2];
    int ko = 16 * s8 + 8 * (lane >> 5);
#pragma unroll
    for (int mi = 0; mi < 2; ++mi) a[mi] = *(const bf16x8*)(D1 + (64 * w + 32 * mi + (lane & 31)) * 128 + ko);
#pragma unroll
    for (int ni = 0; ni < 2; ++ni) bb[ni] = *(const bf16x8*)(Bt + (32 * ni + (lane & 31)) * 136 + ko);
#pragma unroll
    for (int mi = 0; mi < 2; ++mi)
#pragma unroll
      for (int ni = 0; ni < 2; ++ni) acc[mi][ni] = __builtin_amdgcn_mfma_f32_32x32x16_bf16(a[mi], bb[ni], acc[mi][ni], 0, 0, 0);
  }
#pragma unroll
  for (int mi = 0; mi < 2; ++mi)
#pragma unroll
    for (int j = 0; j < 8; ++j) {
      int m = 64 * w + 32 * mi + ((2 * j) & 3) + 8 * ((2 * j) >> 2) + 4 * (lane >> 5);
      int k1 = m >> 1;
      int idx = (k1 * c) & 8191;
      float cs = TAB[idx], sn = TAB[8192 + idx];
#pragma unroll
      for (int ni = 0; ni < 2; ++ni) {
        float re = acc[mi][ni][2 * j], im = acc[mi][ni][2 * j + 1];
        float re2 = re * cs + im * sn, im2 = im * cs - re * sn;
        bf16_t* dst = A1 + ((((size_t)b * 64 + c) * 128 + k1) * 2) * 512 + g * 64 + 32 * ni + (lane & 31);
        dst[0] = (bf16_t)f2bf(re2); dst[512] = (bf16_t)f2bf(im2);
      }
    }
}

__device__ __forceinline__ void fft3_unit(int u, int mode, const bf16_t* __restrict__ FQKV, const bf16_t* __restrict__ A1, const bf16_t* __restrict__ D3,
                          const bf16_t* __restrict__ DcT, const float* __restrict__ TAB, bf16_t* __restrict__ MIX, char* smem) {
  int tid = threadIdx.x, lane = tid & 63, w = tid >> 6;
  bf16_t* Bt = (bf16_t*)smem;
  bf16_t* Xs = (bf16_t*)(smem + 17408);
  int g = u & 7, k1, b, nk1, rowbase; float norm;
  __syncthreads();
  if (mode == 0) {
    k1 = (u >> 3) & 127; b = u >> 10; nk1 = 128; rowbase = b * S; norm = 1.f / 724.0773439350247f;
    int kk = tid >> 1, half = tid & 1; int c = kk >> 1, ri = kk & 1;
    const uint4* src = (const uint4*)(A1 + ((((size_t)b * 64 + c) * 128 + k1) * 2 + ri) * 512 + g * 64 + half * 32);
    unsigned wv[16];
#pragma unroll
    for (int i = 0; i < 4; ++i) { uint4 v = src[i]; wv[4 * i] = v.x; wv[4 * i + 1] = v.y; wv[4 * i + 2] = v.z; wv[4 * i + 3] = v.w; }
#pragma unroll
    for (int j = 0; j < 32; ++j) {
      unsigned e = (j & 1) ? (wv[j >> 1] >> 16) : (wv[j >> 1] & 0xffffu);
      Bt[(half * 32 + j) * 136 + kk] = (bf16_t)e;
    }
  } else {
    k1 = (u >> 3) & 3; b = u >> 5; nk1 = 4; rowbase = T + b * CL; norm = 1.f / 128.f;
    int c = tid >> 2, q4 = tid & 3;
    float re[16], im[16];
#pragma unroll
    for (int j = 0; j < 16; ++j) { re[j] = 0.f; im[j] = 0.f; }
#pragma unroll
    for (int r = 0; r < 4; ++r) {
      const uint4* src = (const uint4*)(FQKV + (size_t)(rowbase + 64 * r + c) * 2048 + g * 64 + q4 * 16);
      uint4 v0 = src[0], v1 = src[1];
      unsigned wv[8] = {v0.x, v0.y, v0.z, v0.w, v1.x, v1.y, v1.z, v1.w};
      int ph = (k1 * r) & 3;
      float cr = (ph == 0) ? 1.f : (ph == 2 ? -1.f : 0.f);
      float ci = (ph == 1) ? -1.f : (ph == 3 ? 1.f : 0.f);
#pragma unroll
      for (int j = 0; j < 16; ++j) {
        float x = bf2f((unsigned short)((j & 1) ? (wv[j >> 1] >> 16) : (wv[j >> 1] & 0xffffu)));
        re[j] += x * cr; im[j] += x * ci;
      }
    }
    int idx = (k1 * c * 32) & 8191;
    float cs = TAB[idx], sn = TAB[8192 + idx];
#pragma unroll
    for (int j = 0; j < 16; ++j) {
      float re2 = re[j] * cs + im[j] * sn, im2 = im[j] * cs - re[j] * sn;
      *(unsigned*)(Bt + (q4 * 16 + j) * 136 + 2 * c) = pack2bf(re2, im2);
    }
  }
  __syncthreads();
  {
    f32x16 acc[2];
#pragma unroll
    for (int ni = 0; ni < 2; ++ni)
#pragma unroll
      for (int r = 0; r < 16; ++r) acc[ni][r] = 0.f;
#pragma unroll
    for (int s8 = 0; s8 < 8; ++s8) {
      int ko = 16 * s8 + 8 * (lane >> 5);
      bf16x8 a = *(const bf16x8*)(D3 + (32 * w + (lane & 31)) * 128 + ko);
#pragma unroll
      for (int ni = 0; ni < 2; ++ni) {
        bf16x8 bb = *(const bf16x8*)(Bt + (32 * ni + (lane & 31)) * 136 + ko);
        acc[ni] = __builtin_amdgcn_mfma_f32_32x32x16_bf16(a, bb, acc[ni], 0, 0, 0);
      }
    }
#pragma unroll
    for (int ni = 0; ni < 2; ++ni)
#pragma unroll
      for (int r = 0; r < 16; ++r) {
        int m = 32 * w + (r & 3) + 8 * (r >> 2) + 4 * (lane >> 5);
        Xs[(m & 63) * 136 + (m >> 6) * 64 + 32 * ni + (lane & 31)] = (bf16_t)f2bf(acc[ni][r]);
      }
  }
  __syncthreads();
  {
    int mi = w >> 1, ni = w & 1;
    f32x16 acc;
#pragma unroll
    for (int r = 0; r < 16; ++r) acc[r] = 0.f;
#pragma unroll
    for (int s8 = 0; s8 < 8; ++s8) {
      int ko = 16 * s8 + 8 * (lane >> 5);
      bf16x8 a = *(const bf16x8*)(Xs + (32 * mi + (lane & 31)) * 136 + ko);
      bf16x8 bb = *(const bf16x8*)(DcT + (32 * ni + (lane & 31)) * 128 + ko);
      acc = __builtin_amdgcn_mfma_f32_32x32x16_bf16(a, bb, acc, 0, 0, 0);
    }
#pragma unroll
    for (int r = 0; r < 16; ++r) {
      int k2 = 32 * mi + (r & 3) + 8 * (r >> 2) + 4 * (lane >> 5);
      int row = rowbase + k1 + nk1 * k2;
      MIX[(size_t)row * 1024 + g * 64 + 32 * ni + (lane & 31)] = (bf16_t)f2bf(acc[r] * norm);
    }
  }
}


typedef __attribute__((ext_vector_type(4))) float f32x4_t;
__device__ __forceinline__ bf16x8 ld16(const bf16_t* p) { return *(const bf16x8*)p; }
__device__ __forceinline__ float fast_exp2(float x) { return __builtin_amdgcn_exp2f(x); }

template <int NH, int MODE>
__device__ __forceinline__ void attn_unit(int unit, const bf16_t* __restrict__ Qp, int ldq, const bf16_t* __restrict__ Kp, int ldk,
                                          const bf16_t* __restrict__ VTl, const bf16_t* __restrict__ VTc, int nkvh,
                                          const float* __restrict__ rpb, const float* __restrict__ sink,
                                          bf16_t* __restrict__ Op, int ldo, int lane) {
  const float LOG2E = 1.4426950408889634f;
  const float SC = 0.125f * LOG2E;
  int ql = lane & 15, g = lane >> 4;
  int b, hk, qrow0, r = 0, jb = 0, q0 = 0;
  int nloc, lb0 = 0;
  if (MODE == 0) { hk = unit & 7; jb = (unit >> 3) & 3; r = (unit >> 5) & 127; b = unit >> 12; qrow0 = b * S + r * 64 + 16 * jb; nloc = 8; }
  else if (MODE == 1) { hk = unit & 7; int qb = (unit >> 3) & 15; b = unit >> 7; qrow0 = T + b * CL + 16 * qb; nloc = 0; }
  else { hk = unit & 3; int qb = (unit >> 2) & 511; b = unit >> 11; q0 = 16 * qb; qrow0 = b * S + q0;
         int lo = (q0 - 128) >> 5, hi = (q0 + 143) >> 5; if (lo < 0) lo = 0; if (hi > 255) hi = 255; lb0 = lo; nloc = hi - lo + 1; }
  bf16x8 qf[NH][2];
#pragma unroll
  for (int hh = 0; hh < NH; ++hh)
#pragma unroll
    for (int s2 = 0; s2 < 2; ++s2)
      qf[hh][s2] = ld16(Qp + (size_t)(qrow0 + ql) * ldq + (hk * NH + hh) * 64 + 32 * s2 + 8 * g);
  f32x4_t o[NH][4]; float mrun[NH], lrun[NH];
#pragma unroll
  for (int hh = 0; hh < NH; ++hh) {
    mrun[hh] = -1e30f; lrun[hh] = 0.f;
#pragma unroll
    for (int dt = 0; dt < 4; ++dt) o[hh][dt] = (f32x4_t){0.f, 0.f, 0.f, 0.f};
  }
  int r_start = 0, blk_start = 0, c_lo = 0, qc = 0;
  if (MODE == 0) {
    r_start = min(max(r - 4, 0), 120);
    blk_start = min(max(16 * jb - 8, 0), 32);
    qc = 16 * jb + ql; c_lo = min(max(qc - 8, 0), 48);
  }
  int nblk = nloc + 8;
  for (int kb = 0; kb < nblk; ++kb) {
    bool is_loc = kb < nloc;
    int krow0, vt0; const bf16_t* vt;
    int rr = 0;
    if (is_loc) {
      if (MODE == 0) { rr = r_start + kb; krow0 = b * S + rr * 64 + blk_start; vt0 = rr * 64 + blk_start; }
      else { krow0 = b * S + 32 * (lb0 + kb); vt0 = 32 * (lb0 + kb); }
      vt = VTl + ((size_t)(b * nkvh + hk) * 64) * S + vt0;
    } else {
      int cb = kb - nloc; krow0 = T + b * CL + 32 * cb; vt0 = 32 * cb;
      vt = VTc + ((size_t)(b * nkvh + hk) * 64) * CL + vt0;
    }
    int vld = is_loc ? S : CL;
    bf16x8 kf[2][2];
#pragma unroll
    for (int t = 0; t < 2; ++t)
#pragma unroll
      for (int s2 = 0; s2 < 2; ++s2)
        kf[t][s2] = ld16(Kp + (size_t)(krow0 + 8 * (ql >> 2) + 4 * t + (ql & 3)) * ldk + hk * 64 + 32 * s2 + 8 * g);
    bf16x8 vf[4];
#pragma unroll
    for (int dt = 0; dt < 4; ++dt) vf[dt] = ld16(vt + (size_t)(16 * dt + ql) * vld + 8 * g);
    float bias[2][4]; bool valid[2][4];
#pragma unroll
    for (int t = 0; t < 2; ++t)
#pragma unroll
      for (int i = 0; i < 4; ++i) {
        bias[t][i] = 0.f; valid[t][i] = true;
        if (MODE == 0 && is_loc) {
          int kc = blk_start + 8 * g + 4 * t + i;
          valid[t][i] = (kc >= c_lo) && (kc < c_lo + 16);
          int dc = min(max(kc - qc, -15), 15) + 15;
          bias[t][i] = rpb[(hk * 15 + (rr - r + 7)) * 31 + dc] * LOG2E;
        }
        if (MODE == 2 && is_loc) {
          int kpos = 32 * (lb0 + kb) + 8 * g + 4 * t + i; int dq = (q0 + ql) - kpos;
          valid[t][i] = (dq <= 128) && (dq >= -128);
        }
      }
#pragma unroll
    for (int hh = 0; hh < NH; ++hh) {
      f32x4_t st[2];
#pragma unroll
      for (int t = 0; t < 2; ++t) {
        st[t] = (f32x4_t){0.f, 0.f, 0.f, 0.f};
        st[t] = __builtin_amdgcn_mfma_f32_16x16x32_bf16(kf[t][0], qf[hh][0], st[t], 0, 0, 0);
        st[t] = __builtin_amdgcn_mfma_f32_16x16x32_bf16(kf[t][1], qf[hh][1], st[t], 0, 0, 0);
      }
      float lg[2][4]; float bm = -1e30f;
#pragma unroll
      for (int t = 0; t < 2; ++t)
#pragma unroll
        for (int i = 0; i < 4; ++i) {
          float v = valid[t][i] ? (st[t][i] * SC + bias[t][i]) : -1e30f;
          lg[t][i] = v; bm = fmaxf(bm, v);
        }
      bm = fmaxf(bm, __shfl_xor(bm, 16));
      bm = fmaxf(bm, __shfl_xor(bm, 32));
      float mn = fmaxf(mrun[hh], bm);
      float alpha = fast_exp2(mrun[hh] - mn);
      mrun[hh] = mn;
      float ps = 0.f; float pv[8];
#pragma unroll
      for (int t = 0; t < 2; ++t)
#pragma unroll
        for (int i = 0; i < 4; ++i) {
          float p = valid[t][i] ? fast_exp2(lg[t][i] - mn) : 0.f;
          pv[4 * t + i] = p; ps += p;
        }
      lrun[hh] = lrun[hh] * alpha + ps;
      bf16x8 pf;
      {
        unsigned w0 = pack2bf(pv[0], pv[1]), w1 = pack2bf(pv[2], pv[3]), w2 = pack2bf(pv[4], pv[5]), w3 = pack2bf(pv[6], pv[7]);
        typedef __attribute__((ext_vector_type(4))) unsigned u32x4;
        u32x4 uu = {w0, w1, w2, w3};
        pf = __builtin_bit_cast(bf16x8, uu);
      }
#pragma unroll
      for (int dt = 0; dt < 4; ++dt) {
        o[hh][dt] *= alpha;
        o[hh][dt] = __builtin_amdgcn_mfma_f32_16x16x32_bf16(vf[dt], pf, o[hh][dt], 0, 0, 0);
      }
    }
  }
#pragma unroll
  for (int hh = 0; hh < NH; ++hh) {
    float l = lrun[hh];
    l += __shfl_xor(l, 16); l += __shfl_xor(l, 32);
    float m = mrun[hh];
    if (MODE == 2) {
      float sk = sink[hk * NH + hh] * LOG2E;
      float mf = fmaxf(m, sk);
      float a = fast_exp2(m - mf);
      l = l * a + fast_exp2(sk - mf);
#pragma unroll
      for (int dt = 0; dt < 4; ++dt) o[hh][dt] *= a;
    }
    float inv = 1.f / l;
    bf16_t* orow = Op + (size_t)(qrow0 + ql) * ldo + (hk * NH + hh) * 64 + 4 * g;
#pragma unroll
    for (int dt = 0; dt < 4; ++dt) {
      f32x4_t v = o[hh][dt] * inv;
      *(uint2*)(orow + 16 * dt) = make_uint2(pack2bf(v[0], v[1]), pack2bf(v[2], v[3]));
    }
  }
}

__device__ __forceinline__ void ph_chan_dft(const float* __restrict__ F, const float* __restrict__ tab, float* __restrict__ PQ) {
  for (int gid = blockIdx.x * 256 + threadIdx.x; gid < R * 512; gid += gridDim.x * 256) {
    int row = gid >> 9; int col = gid & 511; int g = col >> 6, cp = col & 63;
    const float* f = F + (size_t)row * 2048 + g * 64;
    float p = 0.f, q = 0.f;
    for (int ch = 0; ch < 64; ++ch) {
      int idx = ((ch * cp) & 63) * 128;
      float x = f[ch];
      p += x * tab[idx]; q += x * tab[8192 + idx];
    }
    PQ[(size_t)row * 1024 + col] = p;
    PQ[(size_t)row * 1024 + 512 + col] = q;
  }
}

__device__ __forceinline__ void ph_na(const bf16_t* __restrict__ F, const float* __restrict__ rpb, bf16_t* __restrict__ MIX, float* sm) {
  int lane = threadIdx.x & 63, wave = threadIdx.x >> 6;
  float* sq = sm + wave * 1024; float* sp = sq + 64; int* stok = (int*)(sp + 384);
  int nitems = R * 8;
  for (int item0 = blockIdx.x * 4; item0 < nitems; item0 += gridDim.x * 4) {
    int item = item0 + wave;
    int h = item & 7; int row = item >> 3;
    bool is_ctx = row >= T;
    int b = is_ctx ? (row - T) / CL : row / S;
    __syncthreads();
    sq[lane] = bf2f(F[(size_t)row * 2048 + 512 + h * 64 + lane]);
    __syncthreads();
    int r = 0, c = 0, r_start = 0, c_start = 0;
    if (!is_ctx) { int t = row % S; r = t / 64; c = t % 64; r_start = min(max(r - 4, 0), 120); c_start = min(max(c - 8, 0), 48); }
    int nk = is_ctx ? 256 : 384;
    float lg[6]; float mx = -INFINITY;
#pragma unroll
    for (int kk = 0; kk < 6; ++kk) {
      int j = kk * 64 + lane; float s = -INFINITY; int tok = 0;
      if (j < nk) {
        float bias = 0.f;
        if (!is_ctx && j < 128) {
          int kr = j >> 4, kc = j & 15; int rr = r_start + kr, cc = c_start + kc;
          tok = b * S + rr * 64 + cc;
          int dc = min(max(cc - c, -15), 15) + 15;
          bias = rpb[(h * 15 + (rr - r + 7)) * 31 + dc];
        } else {
          int l = is_ctx ? j : j - 128; tok = T + b * CL + l;
        }
        const bf16_t* kp = F + (size_t)tok * 2048 + 1024 + h * 64;
        float acc = 0.f;
#pragma unroll 8
        for (int d = 0; d < 64; ++d) acc += sq[d] * bf2f(kp[d]);
        s = acc * 0.125f + bias;
      }
      lg[kk] = s; stok[j] = tok; mx = fmaxf(mx, s);
    }
    mx = wave_max(mx);
    float sum = 0.f;
#pragma unroll
    for (int kk = 0; kk < 6; ++kk) { float e = (kk * 64 + lane < nk) ? expf(lg[kk] - mx) : 0.f; lg[kk] = e; sum += e; }
    sum = wave_sum(sum);
    float inv = 1.f / sum;
#pragma unroll
    for (int kk = 0; kk < 6; ++kk) sp[kk * 64 + lane] = lg[kk] * inv;
    __syncthreads();
    float o = 0.f;
    for (int j = 0; j < nk; ++j) o += sp[j] * bf2f(F[(size_t)stok[j] * 2048 + 1536 + h * 64 + lane]);
    MIX[(size_t)row * 1024 + 512 + h * 64 + lane] = (bf16_t)f2bf(o);
  }
}

__device__ __forceinline__ void ph_rope(float* __restrict__ F1) {
  for (int gid = blockIdx.x * 256 + threadIdx.x; gid < T * 20 * 32; gid += gridDim.x * 256) {
    int i = gid & 31; int hh = (gid >> 5) % 20; int row = gid / (32 * 20);
    int t = row % S; float rowp = (float)(t / 64), colp = (float)(t % 64);
    int fi = i & 15;
    float inv_freq = powf(10000.0f, -(float)fi / 16.0f);
    float ang = (i < 16 ? rowp : colp) * inv_freq;
    float cs = cosf(ang), sn = sinf(ang);
    float* p = F1 + (size_t)row * 1536 + hh * 64;
    float x1 = p[i], x2 = p[i + 32];
    p[i] = x1 * cs - x2 * sn;
    p[i + 32] = x1 * sn + x2 * cs;
  }
}

__device__ __forceinline__ void ph_gqa(const float* __restrict__ F1, const float* __restrict__ sink, bf16_t* __restrict__ O, float* sm) {
  int lane = threadIdx.x & 63, wave = threadIdx.x >> 6;
  float* sq = sm + wave * 1280; float* sp = sq + 64; int* stok = (int*)(sp + 576);
  int nitems = T * 16;
  for (int item0 = blockIdx.x * 4; item0 < nitems; item0 += gridDim.x * 4) {
    int item = item0 + wave;
    int qh = item & 15; int row = item >> 4; int kvh = qh >> 2;
    int b = row / S; int t = row % S;
    __syncthreads();
    sq[lane] = F1[(size_t)row * 1536 + qh * 64 + lane];
    __syncthreads();
    float lg[9]; float mx = -INFINITY;
#pragma unroll
    for (int kk = 0; kk < 9; ++kk) {
      int j = kk * 64 + lane; float s = -INFINITY; int tok = 0; bool valid = false;
      if (j < 257) { int pos = t - 128 + j; valid = (pos >= 0 && pos < S); tok = b * S + pos; }
      else if (j < 513) { valid = true; tok = T + b * CL + (j - 257); }
      if (valid) {
        const float* kp = F1 + (size_t)tok * 1536 + 1024 + kvh * 64;
        float acc = 0.f;
#pragma unroll 8
        for (int d = 0; d < 64; ++d) acc += sq[d] * kp[d];
        s = acc * 0.125f;
      } else tok = 0;
      lg[kk] = s; stok[j] = tok; mx = fmaxf(mx, s);
    }
    mx = wave_max(mx);
    float sk = sink[qh];
    mx = fmaxf(mx, sk);
    float sum = 0.f;
#pragma unroll
    for (int kk = 0; kk < 9; ++kk) { float e = (lg[kk] == -INFINITY) ? 0.f : expf(lg[kk] - mx); lg[kk] = e; sum += e; }
    sum = wave_sum(sum) + expf(sk - mx);
    float inv = 1.f / sum;
#pragma unroll
    for (int kk = 0; kk < 9; ++kk) sp[kk * 64 + lane] = lg[kk] * inv;
    __syncthreads();
    float o = 0.f;
    for (int j = 0; j < 513; ++j) { float p = sp[j]; if (p != 0.f) o += p * F1[(size_t)stok[j] * 1536 + 1280 + kvh * 64 + lane]; }
    O[(size_t)row * 1024 + qh * 64 + lane] = (bf16_t)f2bf(o);
  }
}

__device__ __forceinline__ void wave_argmax(float& v, int& idx) {
#pragma unroll
  for (int off = 32; off; off >>= 1) {
    float ov = __shfl_xor(v, off); int oi = __shfl_xor(idx, off);
    if (ov > v || (ov == v && oi < idx)) { v = ov; idx = oi; }
  }
}
__device__ __forceinline__ void ph_peer_select_naive(const float* __restrict__ Q, const float* __restrict__ sk, int* __restrict__ EXP,
                                     float* __restrict__ GATE, int nrows, float* sm) {
  int lane = threadIdx.x & 63, wave = threadIdx.x >> 6;
  float* sq = sm + wave * 640; float* tops = sq + 256; int* topi = (int*)(tops + 32);
  for (int row0 = blockIdx.x * 4; row0 < nrows; row0 += gridDim.x * 4) {
    int row = row0 + wave;
    for (int h = 0; h < 8; ++h) {
      __syncthreads();
#pragma unroll
      for (int i = 0; i < 4; ++i) sq[lane + 64 * i] = Q[(size_t)row * 2048 + h * 256 + lane + 64 * i];
      __syncthreads();
      for (int p = 0; p < 2; ++p) {
        float s0 = 0.f, s1 = 0.f;
        const float* k0 = sk + ((size_t)((h * 2 + p) * 128 + lane)) * 128;
        const float* k1 = k0 + 64 * 128;
#pragma unroll 8
        for (int d = 0; d < 128; ++d) { float qv = sq[p * 128 + d]; s0 += qv * k0[d]; s1 += qv * k1[d]; }
        for (int i = 0; i < 16; ++i) {
          float v; int idx;
          if (s0 >= s1) { v = s0; idx = lane; } else { v = s1; idx = lane + 64; }
          wave_argmax(v, idx);
          if (lane == 0) { tops[p * 16 + i] = v; topi[p * 16 + i] = idx; }
          if (idx == lane) s0 = -INFINITY;
          if (idx == lane + 64) s1 = -INFINITY;
        }
      }
      __syncthreads();
      float cs[4];
#pragma unroll
      for (int i = 0; i < 4; ++i) { int ci = lane * 4 + i; cs[i] = tops[ci >> 4] + tops[16 + (ci & 15)]; }
      float bs[16]; int be[16];
#pragma unroll
      for (int k = 0; k < 16; ++k) {
        float v = cs[0]; int idx = lane * 4;
#pragma unroll
        for (int i = 1; i < 4; ++i) if (cs[i] > v) { v = cs[i]; idx = lane * 4 + i; }
        wave_argmax(v, idx);
        bs[k] = v; be[k] = topi[idx >> 4] * 128 + topi[16 + (idx & 15)];
#pragma unroll
        for (int i = 0; i < 4; ++i) if (idx == lane * 4 + i) cs[i] = -INFINITY;
      }
      float mxs = bs[0]; float sum = 0.f;
#pragma unroll
      for (int k = 0; k < 16; ++k) { bs[k] = expf(bs[k] - mxs); sum += bs[k]; }
      float inv = 1.f / sum;
      if (lane == 0) {
#pragma unroll
        for (int k = 0; k < 16; ++k) { EXP[(size_t)row * 128 + h * 16 + k] = be[k]; GATE[(size_t)row * 128 + h * 16 + k] = bs[k] * inv; }
      }
    }
  }
}

__device__ __forceinline__ void unpack8(uint4 v, float* f) {
  f[0] = __uint_as_float(v.x << 16); f[1] = __uint_as_float(v.x & 0xffff0000u);
  f[2] = __uint_as_float(v.y << 16); f[3] = __uint_as_float(v.y & 0xffff0000u);
  f[4] = __uint_as_float(v.z << 16); f[5] = __uint_as_float(v.z & 0xffff0000u);
  f[6] = __uint_as_float(v.w << 16); f[7] = __uint_as_float(v.w & 0xffff0000u);
}
__device__ __forceinline__ void ph_peer_gather(bf16_t* __restrict__ H, const int* __restrict__ EXP, const float* __restrict__ GATE,
                               const bf16_t* __restrict__ U, const bf16_t* __restrict__ V,
                               const float* __restrict__ xin, const float* __restrict__ M, int layer,
                               const float* __restrict__ g, const float* __restrict__ bb, float* __restrict__ xout,
                               bool write_next, int nrows) {
  int lane = threadIdx.x & 63, wave = threadIdx.x >> 6;
  for (int row = blockIdx.x * 4 + wave; row < nrows; row += gridDim.x * 4) {
    float hreg[16];
    {
      const uint4* hp = (const uint4*)(H + (size_t)row * D + 8 * lane);
      unpack8(hp[0], hreg); unpack8(hp[64], hreg + 8);
    }
    float acc[16];
#pragma unroll
    for (int i = 0; i < 16; ++i) acc[i] = 0.f;
    int e_lo = EXP[(size_t)row * 128 + lane], e_hi = EXP[(size_t)row * 128 + 64 + lane];
    float g_lo = GATE[(size_t)row * 128 + lane], g_hi = GATE[(size_t)row * 128 + 64 + lane];
    uint4 ua[4], ub[4], va[4], vb[4];
#pragma unroll
    for (int i = 0; i < 4; ++i) {
      int e = __builtin_amdgcn_readlane(e_lo, i);
      const uint4* up = (const uint4*)(U + (size_t)e * D + 8 * lane); ua[i] = up[0]; ub[i] = up[64];
    }
#pragma unroll 1
    for (int b = 0; b < 32; ++b) {
      int k0 = 4 * b;
      int ev = (b < 16) ? e_lo : e_hi; float gv = (b < 16) ? g_lo : g_hi;
      int en = (b + 1 < 16) ? e_lo : e_hi;
      float gt[4];
#pragma unroll
      for (int i = 0; i < 4; ++i) {
        int e = __builtin_amdgcn_readlane(ev, (k0 + i) & 63);
        gt[i] = __uint_as_float(__builtin_amdgcn_readlane(__float_as_uint(gv), (k0 + i) & 63));
        const uint4* vp = (const uint4*)(V + (size_t)e * D + 8 * lane); va[i] = vp[0]; vb[i] = vp[64];
      }
      float a[4];
#pragma unroll
      for (int i = 0; i < 4; ++i) {
        float f[16]; unpack8(ua[i], f); unpack8(ub[i], f + 8);
        float sacc = 0.f;
#pragma unroll
        for (int j = 0; j < 16; ++j) sacc += f[j] * hreg[j];
        a[i] = sacc;
      }
      if (b + 1 < 32) {
#pragma unroll
        for (int i = 0; i < 4; ++i) {
          int e = __builtin_amdgcn_readlane(en, (k0 + 4 + i) & 63);
          const uint4* up = (const uint4*)(U + (size_t)e * D + 8 * lane); ua[i] = up[0]; ub[i] = up[64];
        }
      }
#pragma unroll
      for (int i = 0; i < 4; ++i) a[i] = wave_sum(a[i]);
#pragma unroll
      for (int i = 0; i < 4; ++i) {
        float w = gt[i] * 0.5f * a[i] * (1.f + erff(a[i] * 0.70710678118654752f));
        float f[16]; unpack8(va[i], f); unpack8(vb[i], f + 8);
#pragma unroll
        for (int j = 0; j < 16; ++j) acc[j] += w * f[j];
      }
    }
    const float* m = M + ((size_t)layer * 3 + mod_index(row)) * 6144;
    const float* xr = xin + (size_t)row * D;
    float v[16];
#pragma unroll
    for (int hh = 0; hh < 2; ++hh) {
      int d0 = hh * 512 + 8 * lane;
      float4 x0 = *(const float4*)(xr + d0), x1 = *(const float4*)(xr + d0 + 4);
      float4 m0 = *(const float4*)(m + 5 * D + d0), m1 = *(const float4*)(m + 5 * D + d0 + 4);
      v[hh * 8 + 0] = DN_ALPHA * x0.x + m0.x * acc[hh * 8 + 0]; v[hh * 8 + 1] = DN_ALPHA * x0.y + m0.y * acc[hh * 8 + 1];
      v[hh * 8 + 2] = DN_ALPHA * x0.z + m0.z * acc[hh * 8 + 2]; v[hh * 8 + 3] = DN_ALPHA * x0.w + m0.w * acc[hh * 8 + 3];
      v[hh * 8 + 4] = DN_ALPHA * x1.x + m1.x * acc[hh * 8 + 4]; v[hh * 8 + 5] = DN_ALPHA * x1.y + m1.y * acc[hh * 8 + 5];
      v[hh * 8 + 6] = DN_ALPHA * x1.z + m1.z * acc[hh * 8 + 6]; v[hh * 8 + 7] = DN_ALPHA * x1.w + m1.w * acc[hh * 8 + 7];
    }
    float s = 0.f;
#pragma unroll
    for (int j = 0; j < 16; ++j) s += v[j];
    float mu = wave_sum(s) * (1.f / D);
    float q = 0.f;
#pragma unroll
    for (int j = 0; j < 16; ++j) { float d = v[j] - mu; q += d * d; }
    float rs = rsqrtf(wave_sum(q) * (1.f / D) + LN_EPS);
    float y[16];
#pragma unroll
    for (int hh = 0; hh < 2; ++hh) {
      int d0 = hh * 512 + 8 * lane;
#pragma unroll
      for (int j = 0; j < 8; ++j) y[hh * 8 + j] = (v[hh * 8 + j] - mu) * rs * g[d0 + j] + bb[d0 + j];
      *(float4*)(xout + (size_t)row * D + d0) = make_float4(y[hh * 8], y[hh * 8 + 1], y[hh * 8 + 2], y[hh * 8 + 3]);
      *(float4*)(xout + (size_t)row * D + d0 + 4) = make_float4(y[hh * 8 + 4], y[hh * 8 + 5], y[hh * 8 + 6], y[hh * 8 + 7]);
    }
    if (write_next) {
      const float* mn = M + ((size_t)(layer + 1) * 3 + mod_index(row)) * 6144;
      float s2 = 0.f;
#pragma unroll
      for (int j = 0; j < 16; ++j) s2 += y[j];
      float mu2 = wave_sum(s2) * (1.f / D);
      float q2 = 0.f;
#pragma unroll
      for (int j = 0; j < 16; ++j) { float d = y[j] - mu2; q2 += d * d; }
      float rs2 = rsqrtf(wave_sum(q2) * (1.f / D) + LN_EPS);
#pragma unroll
      for (int hh = 0; hh < 2; ++hh) {
        int d0 = hh * 512 + 8 * lane;
        float o[8];
#pragma unroll
        for (int j = 0; j < 8; ++j) o[j] = (y[hh * 8 + j] - mu2) * rs2 * (1.f + mn[D + d0 + j]) + mn[d0 + j];
        *(uint4*)(H + (size_t)row * D + d0) = make_uint4(pack2bf(o[0], o[1]), pack2bf(o[2], o[3]), pack2bf(o[4], o[5]), pack2bf(o[6], o[7]));
      }
    }
  }
}


__device__ __forceinline__ void ph_quant_rows(const float* __restrict__ src, unsigned char* __restrict__ dst, float* __restrict__ scale, int nrows) {
  int lane = threadIdx.x & 63, wave = threadIdx.x >> 6;
  for (int row = blockIdx.x * 4 + wave; row < nrows; row += gridDim.x * 4) {
    const float4* sp = (const float4*)(src + (size_t)row * D + 16 * lane);
    float4 v0 = sp[0], v1 = sp[1], v2 = sp[2], v3 = sp[3];
    float x[16] = {v0.x, v0.y, v0.z, v0.w, v1.x, v1.y, v1.z, v1.w, v2.x, v2.y, v2.z, v2.w, v3.x, v3.y, v3.z, v3.w};
    float am = 0.f;
#pragma unroll
    for (int j = 0; j < 16; ++j) am = fmaxf(am, fabsf(x[j]));
    am = wave_max(am);
    float inv = am > 0.f ? 127.f / am : 0.f;
    unsigned wv[4];
#pragma unroll
    for (int k = 0; k < 4; ++k) {
      unsigned w = 0;
#pragma unroll
      for (int j = 0; j < 4; ++j) {
        int q = (int)rintf(x[4 * k + j] * inv) + 128;
        w |= ((unsigned)q & 0xffu) << (8 * j);
      }
      wv[k] = w;
    }
    *(uint4*)(dst + (size_t)row * D + 16 * lane) = make_uint4(wv[0], wv[1], wv[2], wv[3]);
    if (lane == 0) scale[row] = am * (1.f / 127.f);
  }
}
__device__ __forceinline__ void unpack_u8x16(uint4 v, float* f) {
  unsigned w[4] = {v.x, v.y, v.z, v.w};
#pragma unroll
  for (int k = 0; k < 4; ++k) {
    f[4 * k + 0] = (float)(w[k] & 0xffu); f[4 * k + 1] = (float)((w[k] >> 8) & 0xffu);
    f[4 * k + 2] = (float)((w[k] >> 16) & 0xffu); f[4 * k + 3] = (float)(w[k] >> 24);
  }
}
__device__ __forceinline__ void ph_peer_gather8(bf16_t* __restrict__ H, const int* __restrict__ EXP, const float* __restrict__ GATE,
                               const unsigned char* __restrict__ U8, const float* __restrict__ USC,
                               const unsigned char* __restrict__ V8, const float* __restrict__ VSC,
                               const float* __restrict__ xin, const float* __restrict__ M, int layer,
                               const float* __restrict__ g, const float* __restrict__ bb, float* __restrict__ xout,
                               bool write_next, int nrows) {
  int lane = threadIdx.x & 63, wave = threadIdx.x >> 6;
  for (int row = blockIdx.x * 4 + wave; row < nrows; row += gridDim.x * 4) {
    float hreg[16];
    {
      const uint4* hp = (const uint4*)(H + (size_t)row * D + 16 * lane);
      unpack8(hp[0], hreg); unpack8(hp[1], hreg + 8);
    }
    float hs = 0.f;
#pragma unroll
    for (int j = 0; j < 16; ++j) hs += hreg[j];
    float hsum128 = 128.f * wave_sum(hs);
    float acc[16];
#pragma unroll
    for (int i = 0; i < 16; ++i) acc[i] = 0.f;
    float wsum = 0.f;
    int e_lo = EXP[(size_t)row * 128 + lane], e_hi = EXP[(size_t)row * 128 + 64 + lane];
    float g_lo = GATE[(size_t)row * 128 + lane], g_hi = GATE[(size_t)row * 128 + 64 + lane];
    float us_lo = USC[e_lo], us_hi = USC[e_hi], vs_lo = VSC[e_lo], vs_hi = VSC[e_hi];
    uint4 ua[8], va[8];
#pragma unroll
    for (int i = 0; i < 8; ++i) {
      int e = __builtin_amdgcn_readlane(e_lo, i);
      ua[i] = *(const uint4*)(U8 + (size_t)e * D + 16 * lane);
    }
#pragma unroll 1
    for (int b = 0; b < 16; ++b) {
      int k0 = 8 * b;
      bool lo = b < 8, lon = (b + 1) < 8;
      int ev = lo ? e_lo : e_hi; float gv = lo ? g_lo : g_hi; float usv = lo ? us_lo : us_hi; float vsv = lo ? vs_lo : vs_hi;
      int en = lon ? e_lo : e_hi;
      float gt[8], usc[8], vsc[8];
#pragma unroll
      for (int i = 0; i < 8; ++i) {
        int li = (k0 + i) & 63;
        int e = __builtin_amdgcn_readlane(ev, li);
        gt[i] = __uint_as_float(__builtin_amdgcn_readlane(__float_as_uint(gv), li));
        usc[i] = __uint_as_float(__builtin_amdgcn_readlane(__float_as_uint(usv), li));
        vsc[i] = __uint_as_float(__builtin_amdgcn_readlane(__float_as_uint(vsv), li));
        va[i] = *(const uint4*)(V8 + (size_t)e * D + 16 * lane);
      }
      float a[8];
#pragma unroll
      for (int i = 0; i < 8; ++i) {
        float f[16]; unpack_u8x16(ua[i], f);
        float sacc = 0.f;
#pragma unroll
        for (int j = 0; j < 16; ++j) sacc += f[j] * hreg[j];
        a[i] = sacc;
      }
      if (b + 1 < 16) {
#pragma unroll
        for (int i = 0; i < 8; ++i) {
          int e = __builtin_amdgcn_readlane(en, (k0 + 8 + i) & 63);
          ua[i] = *(const uint4*)(U8 + (size_t)e * D + 16 * lane);
        }
      }
#pragma unroll
      for (int i = 0; i < 8; ++i) a[i] = (wave_sum(a[i]) - hsum128) * usc[i];
#pragma unroll
      for (int i = 0; i < 8; ++i) {
        float w = gt[i] * 0.5f * a[i] * (1.f + erff(a[i] * 0.70710678118654752f)) * vsc[i];
        wsum += w;
        float f[16]; unpack_u8x16(va[i], f);
#pragma unroll
        for (int j = 0; j < 16; ++j) acc[j] += w * f[j];
      }
    }
    float corr = 128.f * wsum;
#pragma unroll
    for (int j = 0; j < 16; ++j) acc[j] -= corr;
    const float* m = M + ((size_t)layer * 3 + mod_index(row)) * 6144;
    const float* xr = xin + (size_t)row * D + 16 * lane;
    const float* m5 = m + 5 * D + 16 * lane;
    float v[16];
#pragma unroll
    for (int q4 = 0; q4 < 4; ++q4) {
      float4 x0 = *(const float4*)(xr + 4 * q4); float4 m0 = *(const float4*)(m5 + 4 * q4);
      v[4 * q4 + 0] = DN_ALPHA * x0.x + m0.x * acc[4 * q4 + 0]; v[4 * q4 + 1] = DN_ALPHA * x0.y + m0.y * acc[4 * q4 + 1];
      v[4 * q4 + 2] = DN_ALPHA * x0.z + m0.z * acc[4 * q4 + 2]; v[4 * q4 + 3] = DN_ALPHA * x0.w + m0.w * acc[4 * q4 + 3];
    }
    float s = 0.f;
#pragma unroll
    for (int j = 0; j < 16; ++j) s += v[j];
    float mu = wave_sum(s) * (1.f / D);
    float q = 0.f;
#pragma unroll
    for (int j = 0; j < 16; ++j) { float d = v[j] - mu; q += d * d; }
    float rs = rsqrtf(wave_sum(q) * (1.f / D) + LN_EPS);
    float y[16];
    {
      const float* gp = g + 16 * lane; const float* bp = bb + 16 * lane;
      float* op = xout + (size_t)row * D + 16 * lane;
#pragma unroll
      for (int q4 = 0; q4 < 4; ++q4) {
        float4 g4 = *(const float4*)(gp + 4 * q4); float4 b4 = *(const float4*)(bp + 4 * q4);
        y[4 * q4 + 0] = (v[4 * q4 + 0] - mu) * rs * g4.x + b4.x; y[4 * q4 + 1] = (v[4 * q4 + 1] - mu) * rs * g4.y + b4.y;
        y[4 * q4 + 2] = (v[4 * q4 + 2] - mu) * rs * g4.z + b4.z; y[4 * q4 + 3] = (v[4 * q4 + 3] - mu) * rs * g4.w + b4.w;
        *(float4*)(op + 4 * q4) = make_float4(y[4 * q4], y[4 * q4 + 1], y[4 * q4 + 2], y[4 * q4 + 3]);
      }
    }
    if (write_next) {
      const float* mn = M + ((size_t)(layer + 1) * 3 + mod_index(row)) * 6144 + 16 * lane;
      float s2 = 0.f;
#pragma unroll
      for (int j = 0; j < 16; ++j) s2 += y[j];
      float mu2 = wave_sum(s2) * (1.f / D);
      float q2 = 0.f;
#pragma unroll
      for (int j = 0; j < 16; ++j) { float d = y[j] - mu2; q2 += d * d; }
      float rs2 = rsqrtf(wave_sum(q2) * (1.f / D) + LN_EPS);
      float o[16];
#pragma unroll
      for (int j = 0; j < 16; ++j) o[j] = (y[j] - mu2) * rs2 * (1.f + mn[D + j]) + mn[j];
      uint4* hp = (uint4*)(H + (size_t)row * D + 16 * lane);
      hp[0] = make_uint4(pack2bf(o[0], o[1]), pack2bf(o[2], o[3]), pack2bf(o[4], o[5]), pack2bf(o[6], o[7]));
      hp[1] = make_uint4(pack2bf(o[8], o[9]), pack2bf(o[10], o[11]), pack2bf(o[12], o[13]), pack2bf(o[14], o[15]));
    }
  }
}


__device__ __forceinline__ void ph_ada2(const float* __restrict__ c, const float* __restrict__ c_ctx, const float* __restrict__ ada_w,
                                        const float* __restrict__ ada_b, float* __restrict__ M, float* sm) {
  int tid = threadIdx.x, lane = tid & 63, wave = tid >> 6;
  float* sv = sm;
  float* red = sm + 3072;
  bool filled = false;
  GRID_LOOP(u, 192) {
    if (!filled) {
      for (int i = tid; i < 3072; i += 256) {
        int idx = i >> 10, k = i & 1023;
        float x = idx < 2 ? c[idx * D + k] : c_ctx[k];
        sv[i] = x / (1.f + expf(-x));
      }
      filled = true;
    }
    __syncthreads();
    int layer = u / 96, c0 = (u % 96) * 64;
    const float* w = ada_w + (size_t)layer * D * 6144 + c0 + lane;
    float a0 = 0.f, a1 = 0.f, a2 = 0.f;
    int kb = wave * 256;
#pragma unroll 16
    for (int k = 0; k < 256; ++k) {
      float wv = w[(size_t)(kb + k) * 6144];
      a0 += sv[kb + k] * wv; a1 += sv[1024 + kb + k] * wv; a2 += sv[2048 + kb + k] * wv;
    }
    red[(wave * 3 + 0) * 64 + lane] = a0; red[(wave * 3 + 1) * 64 + lane] = a1; red[(wave * 3 + 2) * 64 + lane] = a2;
    __syncthreads();
    if (wave < 3) {
      float r = red[(0 * 3 + wave) * 64 + lane] + red[(1 * 3 + wave) * 64 + lane] + red[(2 * 3 + wave) * 64 + lane] + red[(3 * 3 + wave) * 64 + lane];
      M[((size_t)layer * 3 + wave) * 6144 + c0 + lane] = r + ada_b[layer * 6144 + c0 + lane];
    }
  }
  __syncthreads();
}

__device__ __forceinline__ void ph_post_mod(const float* __restrict__ xa, const float* __restrict__ xb, const bf16_t* __restrict__ Y,
                                            const float* __restrict__ M, int layer, const float* __restrict__ g, const float* __restrict__ bb,
                                            float* __restrict__ xout, bf16_t* __restrict__ H, int nrows) {
  int lane = threadIdx.x & 63, wave = threadIdx.x >> 6;
  for (int row = blockIdx.x * 4 + wave; row < nrows; row += gridDim.x * 4) {
    const float* xr = (row < T ? xa + (size_t)row * D : xb + (size_t)(row - T) * D) + 16 * lane;
    const float* m = M + ((size_t)layer * 3 + mod_index(row)) * 6144 + 16 * lane;
    float yv[16];
    {
      const uint4* yp = (const uint4*)(Y + (size_t)row * D + 16 * lane);
      unpack8(yp[0], yv); unpack8(yp[1], yv + 8);
    }
    float v[16];
#pragma unroll
    for (int q4 = 0; q4 < 4; ++q4) {
      float4 x0 = *(const float4*)(xr + 4 * q4); float4 m0 = *(const float4*)(m + 2 * D + 4 * q4);
      v[4 * q4 + 0] = DN_ALPHA * x0.x + m0.x * yv[4 * q4 + 0]; v[4 * q4 + 1] = DN_ALPHA * x0.y + m0.y * yv[4 * q4 + 1];
      v[4 * q4 + 2] = DN_ALPHA * x0.z + m0.z * yv[4 * q4 + 2]; v[4 * q4 + 3] = DN_ALPHA * x0.w + m0.w * yv[4 * q4 + 3];
    }
    float s = 0.f;
#pragma unroll
    for (int j = 0; j < 16; ++j) s += v[j];
    float mu = wave_sum(s) * (1.f / D);
    float q = 0.f;
#pragma unroll
    for (int j = 0; j < 16; ++j) { float d = v[j] - mu; q += d * d; }
    float rs = rsqrtf(wave_sum(q) * (1.f / D) + LN_EPS);
    float y[16];
    {
      const float* gp = g + 16 * lane; const float* bp = bb + 16 * lane;
      float* op = xout + (size_t)row * D + 16 * lane;
#pragma unroll
      for (int q4 = 0; q4 < 4; ++q4) {
        float4 g4 = *(const float4*)(gp + 4 * q4); float4 b4 = *(const float4*)(bp + 4 * q4);
        y[4 * q4 + 0] = (v[4 * q4 + 0] - mu) * rs * g4.x + b4.x; y[4 * q4 + 1] = (v[4 * q4 + 1] - mu) * rs * g4.y + b4.y;
        y[4 * q4 + 2] = (v[4 * q4 + 2] - mu) * rs * g4.z + b4.z; y[4 * q4 + 3] = (v[4 * q4 + 3] - mu) * rs * g4.w + b4.w;
        *(float4*)(op + 4 * q4) = make_float4(y[4 * q4], y[4 * q4 + 1], y[4 * q4 + 2], y[4 * q4 + 3]);
      }
    }
    float s2 = 0.f;
#pragma unroll
    for (int j = 0; j < 16; ++j) s2 += y[j];
    float mu2 = wave_sum(s2) * (1.f / D);
    float q2 = 0.f;
#pragma unroll
    for (int j = 0; j < 16; ++j) { float d = y[j] - mu2; q2 += d * d; }
    float rs2 = rsqrtf(wave_sum(q2) * (1.f / D) + LN_EPS);
    float o[16];
#pragma unroll
    for (int j = 0; j < 16; ++j) o[j] = (y[j] - mu2) * rs2 * (1.f + m[4 * D + j]) + m[3 * D + j];
    uint4* hp = (uint4*)(H + (size_t)row * D + 16 * lane);
    hp[0] = make_uint4(pack2bf(o[0], o[1]), pack2bf(o[2], o[3]), pack2bf(o[4], o[5]), pack2bf(o[6], o[7]));
    hp[1] = make_uint4(pack2bf(o[8], o[9]), pack2bf(o[10], o[11]), pack2bf(o[12], o[13]), pack2bf(o[14], o[15]));
  }
}

#define XB_TMO      128
#define XB_XCNT(j)  (256  + 64 * (j))
#define XB_XSUB(j)  (1280 + 64 * (j))
#define XB_XGEN(j)  (2304 + 64 * (j))
#define XB_TOP      3328
#define XB_TOPGEN   3392
#define XCD_BAR_WORDS 3456
#define XB_SPIN_CAP (1u << 22)
#define LAS __attribute__((address_space(3)))
__device__ __forceinline__ unsigned xb_ld(unsigned* p)              { return __hip_atomic_load(p, __ATOMIC_RELAXED, __HIP_MEMORY_SCOPE_AGENT); }
__device__ __forceinline__ unsigned xb_add(unsigned* p, unsigned v) { return __hip_atomic_fetch_add(p, v, __ATOMIC_RELAXED, __HIP_MEMORY_SCOPE_AGENT); }
__device__ __forceinline__ unsigned xb_xcc_id() { return (unsigned)__builtin_amdgcn_s_getreg((3 << 11) | 20) & 0xFu; }
#define XB_SPIN(cond, bar) do { unsigned _sp = 0; while (cond) { __builtin_amdgcn_s_sleep(1); \
    if ((++_sp & 255u) == 0u) { if (xb_ld(&(bar)[XB_TMO])) break; if (_sp > XB_SPIN_CAP) { atomicAdd(&(bar)[XB_TMO], 1u); break; } } } } while (0)
struct XcdBarrier { unsigned* bar; unsigned x; volatile LAS unsigned* st; };
__device__ __forceinline__ XcdBarrier xcd_barrier_post(unsigned* bar, volatile LAS unsigned* st) {
  XcdBarrier b; b.bar = bar; b.x = xb_xcc_id(); b.st = st;
  if (threadIdx.x == 0) (void)xb_add(&bar[XB_XCNT(b.x)], 1u);
  return b;
}
__device__ __forceinline__ void xcd_barrier_complete(unsigned* bar, unsigned x, unsigned& nloc, unsigned& nx) {
  const unsigned G = gridDim.x * gridDim.y * gridDim.z;
  unsigned sum, cnt, mine, sp = 0u;
  for (;;) {
    sum = 0u; cnt = 0u; mine = 0u;
#pragma unroll
    for (unsigned j = 0; j < 16; ++j) { const unsigned c = xb_ld(&bar[XB_XCNT(j)]); sum += c; cnt += (c > 0u) ? 1u : 0u; mine = (j == x) ? c : mine; }
    if (sum == G) break;
    __builtin_amdgcn_s_sleep(1);
    if ((++sp & 255u) == 0u) { if (xb_ld(&bar[XB_TMO])) break; if (sp > XB_SPIN_CAP) { atomicAdd(&bar[XB_TMO], 1u); break; } }
  }
  nloc = mine > 0u ? mine : 1u; nx = cnt > 0u ? cnt : 1u;
}
__device__ __forceinline__ void xcd_barrier(const XcdBarrier& b) {
  asm volatile("s_waitcnt vmcnt(0)" ::: "memory");
  __syncthreads();
  if (threadIdx.x == 0) {
    unsigned* bar = b.bar;
    __builtin_amdgcn_s_waitcnt(0);
    unsigned nloc = b.st[0], nx = b.st[1];
    if (nloc == 0u) { xcd_barrier_complete(bar, b.x, nloc, nx); b.st[0] = nloc; b.st[1] = nx; }
    const unsigned old = xb_add(&bar[XB_XSUB(b.x)], 1u);
    const unsigned gen = old / nloc;
    if (old + 1u == (gen + 1u) * nloc) {
      __builtin_amdgcn_fence(__ATOMIC_RELEASE, "agent");
      asm volatile("s_waitcnt vmcnt(0)" ::: "memory");
      const unsigned og = xb_add(&bar[XB_TOP], 1u);
      const unsigned tg = og / nx;
      if (og + 1u == (tg + 1u) * nx) xb_add(&bar[XB_TOPGEN], 1u);
      else XB_SPIN(xb_ld(&bar[XB_TOPGEN]) == tg, bar);
      __builtin_amdgcn_fence(__ATOMIC_ACQUIRE, "agent");
      xb_add(&bar[XB_XGEN(b.x)], 1u);
      asm volatile("s_waitcnt vmcnt(0)" ::: "memory");
    } else {
      XB_SPIN(xb_ld(&bar[XB_XGEN(b.x)]) == gen, bar);
      __builtin_amdgcn_fence(__ATOMIC_ACQUIRE, "agent");
      asm volatile("s_waitcnt vmcnt(0)" ::: "memory");
    }
  }
  __syncthreads();
}

constexpr int SMEM_BYTES = 65536;
#ifndef PHMASK
#define PHMASK 0xFFFFFFFFFFFFFFFFull
#endif
#ifndef PHDUP
#define PHDUP 0ull
#endif
#define PH(n, ...) if constexpr ((((unsigned long long)(PHMASK)) >> (n)) & 1ull) { __VA_ARGS__; if constexpr ((((unsigned long long)(PHDUP)) >> (n)) & 1ull) { xcd_barrier(xbar); __VA_ARGS__; } }

__global__ __launch_bounds__(256, 2) void mega(Params p) {
  __shared__ __attribute__((aligned(16))) char smem_raw[SMEM_BYTES];
  __shared__ uint4 xb_words;
  if (threadIdx.x == 0) xb_words = make_uint4(0u, 0u, 0u, 0u);
  __syncthreads();
  XcdBarrier xbar = xcd_barrier_post((unsigned*)((char*)p.ws + OFF_BAR), (volatile LAS unsigned*)&xb_words);
  float* smem = (float*)smem_raw;
  const float* x = p.in[0]; const float* c = p.in[1]; const float* ctx = p.in[2]; const float* c_ctx = p.in[3];
  const float* ada_w = p.in[4]; const float* ada_b = p.in[5]; const float* ln_g = p.in[6]; const float* ln_b = p.in[7];
  const float* even_w_in = p.in[8]; const float* even_w_out = p.in[9]; const float* rpb = p.in[10];
  const float* odd_w_in = p.in[11]; const float* odd_w_out = p.in[12]; const float* sink = p.in[13];
  const float* peer_wq = p.in[14]; const float* peer_sk = p.in[15]; const float* peer_u = p.in[16]; const float* peer_v = p.in[17];
  char* ws = (char*)p.ws;
  float* TAB = (float*)(ws + OFF_TAB); float* Mm = (float*)(ws + OFF_M);
  bf16_t* WIN0 = (bf16_t*)(ws + OFF_WIN0); bf16_t* WOUT0 = (bf16_t*)(ws + OFF_WOUT0);
  bf16_t* WIN1 = (bf16_t*)(ws + OFF_WIN1); bf16_t* WOUT1 = (bf16_t*)(ws + OFF_WOUT1);
  bf16_t* WQ = (bf16_t*)(ws + OFF_WQ); bf16_t* SKB = (bf16_t*)(ws + OFF_SK);
  unsigned char* U8 = (unsigned char*)(ws + OFF_UB); unsigned char* V8 = (unsigned char*)(ws + OFF_VB);
  float* USC = (float*)(ws + OFF_USC); float* VSC = USC + 2 * 16384;
  bf16_t* AB = (bf16_t*)(ws + OFF_AB);
  bf16_t* FD1 = (bf16_t*)(ws + OFF_FT); bf16_t* FD3 = FD1 + 256 * 128; bf16_t* FDC = FD3 + 128 * 128;
  bf16_t* A1 = (bf16_t*)(ws + OFF_A1); bf16_t* VT0 = (bf16_t*)(ws + OFF_VT0); bf16_t* FQKV = (bf16_t*)(ws + OFF_BF);
  float* BF_ = (float*)(ws + OFF_BF); float* BY = (float*)(ws + OFF_BY);
  float* X1 = (float*)(ws + OFF_X1); float* X2 = (float*)(ws + OFF_X2);
  float* RT = TAB + 16384;
  bf16_t* Q1 = (bf16_t*)(ws + OFF_BF); bf16_t* K1 = Q1 + (size_t)T * 1024; bf16_t* VT1 = K1 + (size_t)R * 256;
  bf16_t* YB = (bf16_t*)(ws + OFF_BY + (size_t)2 * R * 128 * 4);
  int* EXPB = (int*)(ws + OFF_BY); float* GATEB = (float*)(ws + OFF_BY + (size_t)R * 128 * 4);
  float* out = p.out;

  PH(0, ph_tables(TAB); ph_rope_table(RT))
  PH(1, ph_fft_tables(FD1, FD3, FDC))
  PH(2, ph_ada2(c, c_ctx, ada_w, ada_b, Mm, smem))
  PH(3, ph_transpose_w(even_w_in, 1024, 2048, WIN0, smem))
  PH(4, ph_transpose_w(even_w_out, 1024, 1024, WOUT0, smem))
  PH(5, ph_transpose_w(odd_w_in, 1024, 1536, WIN1, smem))
  PH(6, ph_transpose_w(odd_w_out, 1024, 1024, WOUT1, smem))
  PH(7, ph_transpose_w(peer_wq, 1024, 2048, WQ, smem))
  PH(8, ph_transpose_w(peer_wq + (size_t)1024 * 2048, 1024, 2048, WQ + (size_t)2048 * 1024, smem))
  PH(9, ph_quant_rows(peer_u, U8, USC, 2 * 16384))
  PH(10, ph_quant_rows(peer_v, V8, VSC, 2 * 16384))
  PH(11, ph_convert(peer_sk, SKB, (size_t)2 * 8 * 2 * 128 * 128 / 8))
  xcd_barrier(xbar);
  PH(12, ph_modulate(x, ctx, Mm, 0, 0, 1, AB, R, smem))
  xcd_barrier(xbar);
  PH(13, ph_gemm_bf16(AB, 1024, WIN0, 1024, R, 2048, 1024, EpiQKV0{FQKV, VT0}, smem_raw))
  xcd_barrier(xbar);
  PH(14, { GRID_LOOP(u, NB * 64 * 8) fft1_unit(u, FQKV, FD1, TAB, A1, smem_raw); })
  PH(15, { int lane = threadIdx.x & 63, wave = threadIdx.x >> 6;
           for (int u0 = blockIdx.x * 4; u0 < 8192 + 256; u0 += gridDim.x * 4) { int u = u0 + wave;
             if (u < 8192) attn_unit<1, 0>(u, FQKV + 512, 2048, FQKV + 1024, 2048, VT0, VT0 + (size_t)NB * 8 * 64 * S, 8, rpb, nullptr, AB + 512, 1024, lane);
             else attn_unit<1, 1>(u - 8192, FQKV + 512, 2048, FQKV + 1024, 2048, VT0, VT0 + (size_t)NB * 8 * 64 * S, 8, rpb, nullptr, AB + 512, 1024, lane); } })
  xcd_barrier(xbar);
  PH(16, { GRID_LOOP(u, NB * 128 * 8 + NB * 4 * 8) { if (u < NB * 128 * 8) fft3_unit(u, 0, FQKV, A1, FD3, FDC, TAB, AB, smem_raw); else fft3_unit(u - NB * 128 * 8, 1, FQKV, A1, FD3, FDC, TAB, AB, smem_raw); } })
  xcd_barrier(xbar);
  PH(17, ph_gemm_bf16(AB, 1024, WOUT0, 1024, R, 1024, 1024, EpiBf16{YB, 1024}, smem_raw))
  xcd_barrier(xbar);
  PH(18, ph_post_mod(x, ctx, YB, Mm, 0, ln_g + 0, ln_b + 0, X1, AB, R))
  xcd_barrier(xbar);
  PH(21, ph_peer_select(AB, WQ, SKB, EXPB, GATEB, R, smem_raw))
  xcd_barrier(xbar);
  PH(22, ph_peer_gather8(AB, EXPB, GATEB, U8, USC, V8, VSC, X1, Mm, 0, ln_g + 1024, ln_b + 1024, X2, true, R))
  xcd_barrier(xbar);
  PH(23, ph_gemm_bf16(AB, 1024, WIN1, 1024, R, 1536, 1024, EpiQKV1{Q1, K1, VT1, RT}, smem_raw))
  xcd_barrier(xbar);
  PH(25, { int lane = threadIdx.x & 63, wave = threadIdx.x >> 6;
           for (int u0 = blockIdx.x * 4; u0 < 4096; u0 += gridDim.x * 4) { int u = u0 + wave;
             attn_unit<4, 2>(u, Q1, 1024, K1, 256, VT1, VT1 + (size_t)NB * 4 * 64 * S, 4, nullptr, sink, AB, 1024, lane); } })
  xcd_barrier(xbar);
  PH(26, ph_gemm_bf16(AB, 1024, WOUT1, 1024, T, 1024, 1024, EpiBf16{YB, 1024}, smem_raw))
  xcd_barrier(xbar);
  PH(27, ph_post_mod(X2, X2, YB, Mm, 1, ln_g + 2048, ln_b + 2048, X1, AB, T))
  xcd_barrier(xbar);
  PH(30, ph_peer_select(AB, WQ + (size_t)2048 * 1024, SKB + (size_t)8 * 2 * 128 * 128, EXPB, GATEB, T, smem_raw))
  xcd_barrier(xbar);
  PH(31, ph_peer_gather8(AB, EXPB, GATEB, U8 + (size_t)16384 * 1024, USC + 16384, V8 + (size_t)16384 * 1024, VSC + 16384, X1, Mm, 1, ln_g + 3072, ln_b + 3072, out, false, T))
}

}

extern "C" void kernel_launch(void* const* d_in, const int* in_sizes, int n_in, void* d_out, int out_size, void* d_ws,
                              size_t ws_size, hipStream_t stream) {
  static int grid_blocks = 0;
  if (!grid_blocks) {
    int dev = 0, cus = 0, per_cu = 0;
    hipGetDevice(&dev);
    hipDeviceGetAttribute(&cus, hipDeviceAttributeMultiprocessorCount, dev);
    hipOccupancyMaxActiveBlocksPerMultiprocessor(&per_cu, (const void*)mega, 256, 0);
    if (per_cu > 2) per_cu = 2;
    if (per_cu < 1) per_cu = 1;
    grid_blocks = cus * per_cu;
  }
  Params p{};
  for (int i = 0; i < 18; ++i) p.in[i] = (const float*)d_in[i];
  p.out = (float*)d_out;
  p.ws = (float*)d_ws;
  (void)hipMemsetAsync((char*)d_ws + OFF_BAR, 0, XCD_BAR_WORDS_C * 4, stream);
  void* args[] = {&p};
  hipError_t e = hipLaunchCooperativeKernel((const void*)mega, dim3(grid_blocks), dim3(256), args, 0, stream);
  if (e != hipSuccess) fprintf(stderr, "cooperative launch failed: %s (grid %d)\n", hipGetErrorString(e), grid_blocks);
}
```

```cpp
#include <hip/hip_runtime.h>
#include <hip/hip_bf16.h>
#include <stdint.h>
#include <math.h>
#include <stdio.h>
#include <hip/hip_cooperative_groups.h>
namespace cg = cooperative_groups;

namespace {

constexpr int D = 1024;
constexpr int NB = 2;
constexpr int S = 8192;
constexpr int T = NB * S;
constexpr int CL = 256;
constexpr int TC = NB * CL;
constexpr int R = T + TC;
constexpr float DN_ALPHA = 1.4142135623730951f;
constexpr float LN_EPS = 1e-6f;

template <int CTRL> __device__ __forceinline__ float dpp_mov(float x) {
  return __builtin_bit_cast(float, __builtin_amdgcn_mov_dpp(__builtin_bit_cast(int, x), CTRL, 0xf, 0xf, true));
}
__device__ __forceinline__ float xrow16_max(float x) {
  auto s = __builtin_amdgcn_permlane16_swap(__float_as_uint(x), __float_as_uint(x), false, false);
  x = fmaxf(__uint_as_float(s[0]), __uint_as_float(s[1]));
  auto t = __builtin_amdgcn_permlane32_swap(__float_as_uint(x), __float_as_uint(x), false, false);
  return fmaxf(__uint_as_float(t[0]), __uint_as_float(t[1]));
}
__device__ __forceinline__ float xrow16_sum(float x) {
  auto s = __builtin_amdgcn_permlane16_swap(__float_as_uint(x), __float_as_uint(x), false, false);
  x = __uint_as_float(s[0]) + __uint_as_float(s[1]);
  auto t = __builtin_amdgcn_permlane32_swap(__float_as_uint(x), __float_as_uint(x), false, false);
  return __uint_as_float(t[0]) + __uint_as_float(t[1]);
}
__device__ __forceinline__ float wave_sum(float v) {
  v += dpp_mov<0xB1>(v); v += dpp_mov<0x4E>(v); v += dpp_mov<0x124>(v); v += dpp_mov<0x128>(v);
  return xrow16_sum(v);
}
__device__ __forceinline__ float wave_max(float v) {
  v = fmaxf(v, dpp_mov<0xB1>(v)); v = fmaxf(v, dpp_mov<0x4E>(v)); v = fmaxf(v, dpp_mov<0x124>(v)); v = fmaxf(v, dpp_mov<0x128>(v));
  return xrow16_max(v);
}

typedef unsigned short bf16_t;
typedef __attribute__((ext_vector_type(8))) short bf16x8;
typedef __attribute__((ext_vector_type(16))) float f32x16;
typedef __attribute__((ext_vector_type(4))) float f32x4;

typedef __attribute__((ext_vector_type(2))) __bf16 bf16x2_t;
__device__ __forceinline__ unsigned f2bf(float f) { return (unsigned)__builtin_bit_cast(unsigned short, (__bf16)f); }
__device__ __forceinline__ unsigned pack2bf(float a, float b) { bf16x2_t v = {(__bf16)a, (__bf16)b}; return __builtin_bit_cast(unsigned, v); }
__device__ __forceinline__ float bf2f(unsigned short v) { return __uint_as_float(((unsigned)v) << 16); }

__device__ __forceinline__ int mod_index(int row) { return row < T ? row / S : 2; }


struct Params {
  const float* in[18];
  float* out;
  float* ws;
};

constexpr size_t XCD_BAR_WORDS_C = 3456;
constexpr size_t al256(size_t n) { return (n + 255) & ~(size_t)255; }
constexpr size_t OFF_BAR = 0;
constexpr size_t OFF_TAB = al256(XCD_BAR_WORDS_C * 4);
constexpr size_t OFF_M = OFF_TAB + al256(16384 * 4 + 128 * 16 * 2 * 4);
constexpr size_t OFF_WIN0 = OFF_M + al256(2 * 3 * 6144 * 4);
constexpr size_t OFF_WOUT0 = OFF_WIN0 + al256((size_t)2048 * 1024 * 2);
constexpr size_t OFF_WIN1 = OFF_WOUT0 + al256((size_t)1024 * 1024 * 2);
constexpr size_t OFF_WOUT1 = OFF_WIN1 + al256((size_t)1536 * 1024 * 2);
constexpr size_t OFF_WQ = OFF_WOUT1 + al256((size_t)1024 * 1024 * 2);
constexpr size_t OFF_SK = OFF_WQ + al256((size_t)2 * 2048 * 1024 * 2);
constexpr size_t OFF_UB = OFF_SK + al256((size_t)2 * 8 * 2 * 128 * 128 * 2);
constexpr size_t OFF_VB = OFF_UB + al256((size_t)2 * 16384 * 1024);
constexpr size_t OFF_USC = OFF_VB + al256((size_t)2 * 16384 * 1024);
constexpr size_t OFF_AB = OFF_USC + al256((size_t)4 * 16384 * 4);
constexpr size_t OFF_FT = OFF_AB + al256((size_t)R * 1024 * 2);
constexpr size_t OFF_BF = OFF_FT + al256((size_t)(256 * 128 + 128 * 128 + 64 * 128) * 2);
constexpr size_t OFF_BY = OFF_BF + al256((size_t)R * 2048 * 4);
constexpr size_t OFF_X1 = OFF_BY + al256((size_t)R * 1024 * 4);
constexpr size_t OFF_X2 = OFF_X1 + al256((size_t)R * 1024 * 4);
constexpr size_t OFF_END = OFF_X2 + al256((size_t)R * 1024 * 4);
constexpr size_t OFF_A1 = OFF_BY;
constexpr size_t OFF_VT0 = OFF_X2;
static_assert(OFF_END <= (size_t)512 * 1024 * 1024, "workspace overflow");

#define GRID_LOOP(var, n) for (int var = blockIdx.x; var < (n); var += gridDim.x)

__device__ __forceinline__ void ph_fft_tables(bf16_t* D1, bf16_t* D3, bf16_t* DcT) {
  const double TWO_PI = 6.283185307179586476925286766559;
  for (int i = blockIdx.x * 256 + threadIdx.x; i < 256 * 128 + 128 * 128 + 64 * 128; i += gridDim.x * 256) {
    if (i < 256 * 128) {
      int m = i >> 7, r = i & 127; int k1 = m >> 1, ri = m & 1;
      double a = TWO_PI * (double)((k1 * r) & 127) / 128.0;
      D1[i] = (bf16_t)f2bf(ri == 0 ? (float)cos(a) : (float)(-sin(a)));
    } else if (i < 256 * 128 + 128 * 128) {
      int j = i - 256 * 128; int m = j >> 7, kk = j & 127; int rip = m >> 6, k2 = m & 63; int c = kk >> 1, ri = kk & 1;
      double a = TWO_PI * (double)((k2 * c) & 63) / 64.0;
      double v = (rip == 0) ? (ri == 0 ? cos(a) : sin(a)) : (ri == 0 ? -sin(a) : cos(a));
      D3[j] = (bf16_t)f2bf((float)v);
    } else {
      int j = i - 256 * 128 - 128 * 128; int cp = j >> 7, kk = j & 127; int rip = kk >> 6, ch = kk & 63;
      double a = TWO_PI * (double)((ch * cp) & 63) / 64.0;
      DcT[j] = (bf16_t)f2bf((float)(rip == 0 ? cos(a) : sin(a)));
    }
  }
}
__device__ __forceinline__ void ph_rope_table(float* RT) {
  for (int i = blockIdx.x * 256 + threadIdx.x; i < 128 * 16; i += gridDim.x * 256) {
    int pos = i >> 4, f = i & 15;
    float inv_freq = powf(10000.0f, -(float)f / 16.0f);
    float ang = (float)pos * inv_freq;
    RT[2 * i] = cosf(ang); RT[2 * i + 1] = sinf(ang);
  }
}
__device__ __forceinline__ void ph_tables(float* tab) {
  for (int j = blockIdx.x * 256 + threadIdx.x; j < 8192; j += gridDim.x * 256) {
    double a = 6.283185307179586476925286766559 * (double)j / 8192.0;
    tab[j] = (float)cos(a);
    tab[8192 + j] = (float)sin(a);
  }
}
__device__ __forceinline__ void ph_ada(const float* __restrict__ c, const float* __restrict__ c_ctx, const float* __restrict__ ada_w,
                       const float* __restrict__ ada_b, float* __restrict__ M) {
  for (int gid = blockIdx.x * 256 + threadIdx.x; gid < 2 * 3 * 6144; gid += gridDim.x * 256) {
    int col = gid % 6144; int idx = (gid / 6144) % 3; int layer = gid / (3 * 6144);
    const float* vec = idx < 2 ? c + idx * D : c_ctx;
    const float* w = ada_w + (size_t)layer * D * 6144 + col;
    float acc = 0.f;
    for (int k = 0; k < D; ++k) {
      float x = vec[k];
      float sx = x / (1.f + expf(-x));
      acc += sx * w[(size_t)k * 6144];
    }
    M[gid] = acc + ada_b[layer * 6144 + col];
  }
}

__device__ __forceinline__ void ph_modulate(const float* __restrict__ xa, const float* __restrict__ xb, const float* __restrict__ M, int layer,
                            int jshift, int jscale, bf16_t* __restrict__ out, int nrows, float* red) {
  int tid = threadIdx.x;
  GRID_LOOP(row, nrows) {
    const float* x = row < T ? xa + (size_t)row * D : xb + (size_t)(row - T) * D;
    float v[4]; float s = 0.f;
#pragma unroll
    for (int i = 0; i < 4; ++i) { v[i] = x[tid + 256 * i]; s += v[i]; }
    s = wave_sum(s);
    __syncthreads();
    if ((tid & 63) == 0) red[tid >> 6] = s;
    __syncthreads();
    float mu = (red[0] + red[1] + red[2] + red[3]) * (1.f / D);
    float q = 0.f;
#pragma unroll
    for (int i = 0; i < 4; ++i) { float d = v[i] - mu; q += d * d; }
    q = wave_sum(q);
    if ((tid & 63) == 0) red[4 + (tid >> 6)] = q;
    __syncthreads();
    float var = (red[4] + red[5] + red[6] + red[7]) * (1.f / D);
    float rs = rsqrtf(var + LN_EPS);
    const float* m = M + ((size_t)layer * 3 + mod_index(row)) * 6144;
#pragma unroll
    for (int i = 0; i < 4; ++i) {
      int col = tid + 256 * i;
      float y = (v[i] - mu) * rs;
      out[(size_t)row * D + col] = (bf16_t)f2bf(y * (1.f + m[jscale * D + col]) + m[jshift * D + col]);
    }
  }
}

__device__ __forceinline__ void ph_post(const float* __restrict__ xa, const float* __restrict__ xb, const float* __restrict__ Y,
                        const float* __restrict__ M, int layer, int j, const float* __restrict__ g, const float* __restrict__ bb,
                        float* __restrict__ outa, float* __restrict__ outb, int nrows, float* red) {
  int tid = threadIdx.x;
  GRID_LOOP(row, nrows) {
    const float* x = row < T ? xa + (size_t)row * D : xb + (size_t)(row - T) * D;
    float* out = row < T ? outa + (size_t)row * D : outb + (size_t)(row - T) * D;
    const float* m = M + ((size_t)layer * 3 + mod_index(row)) * 6144 + j * D;
    float v[4]; float s = 0.f;
#pragma unroll
    for (int i = 0; i < 4; ++i) { int col = tid + 256 * i; v[i] = DN_ALPHA * x[col] + m[col] * Y[(size_t)row * D + col]; s += v[i]; }
    s = wave_sum(s);
    __syncthreads();
    if ((tid & 63) == 0) red[tid >> 6] = s;
    __syncthreads();
    float mu = (red[0] + red[1] + red[2] + red[3]) * (1.f / D);
    float q = 0.f;
#pragma unroll
    for (int i = 0; i < 4; ++i) { float d = v[i] - mu; q += d * d; }
    q = wave_sum(q);
    if ((tid & 63) == 0) red[4 + (tid >> 6)] = q;
    __syncthreads();
    float var = (red[4] + red[5] + red[6] + red[7]) * (1.f / D);
    float rs = rsqrtf(var + LN_EPS);
#pragma unroll
    for (int i = 0; i < 4; ++i) {
      int col = tid + 256 * i;
      out[col] = (v[i] - mu) * rs * g[col] + bb[col];
    }
  }
}

struct ARow { const float* A; int lda; __device__ float operator()(int m, int k) const { return A[(size_t)m * lda + k]; } };
struct BRow { const float* B; int ldb; __device__ float operator()(int k, int n) const { return B[(size_t)k * ldb + n]; } };
struct CRow { float* C; int ldc; float scale; __device__ void operator()(int m, int n, float v) const { C[(size_t)m * ldc + n] = v * scale; } };
struct CRowB { bf16_t* C; int ldc; float scale; __device__ void operator()(int m, int n, float v) const { C[(size_t)m * ldc + n] = (bf16_t)f2bf(v * scale); } };
struct ADft { const float* tab; int Sn; int stride; __device__ float operator()(int m, int k) const {
    int t = k & (Sn - 1); int idx = ((m * t) & (Sn - 1)) * stride;
    return k < Sn ? tab[idx] : -tab[8192 + idx]; } };
struct BPQ { const float* PQ; int rowbase; int Sn; __device__ float operator()(int k, int n) const {
    int t = k & (Sn - 1); return PQ[(size_t)(rowbase + t) * 1024 + (k >= Sn ? 512 : 0) + n]; } };

template <class AF, class BF, class CF>
__device__ __forceinline__ void ph_gemm(AF af, BF bf, CF cf, int M, int N, int K, float* sm) {
  float (*sA)[68] = (float (*)[68])sm;
  float (*sB)[68] = (float (*)[68])(sm + 16 * 68);
  int tid = threadIdx.x; int tx = tid & 15, ty = tid >> 4;
  int ntn = N / 64; int ntiles = (M / 64) * ntn;
  GRID_LOOP(tile, ntiles) {
    int m0 = (tile / ntn) * 64, n0 = (tile % ntn) * 64;
    float acc[4][4];
#pragma unroll
    for (int i = 0; i < 4; ++i)
#pragma unroll
      for (int j = 0; j < 4; ++j) acc[i][j] = 0.f;
    for (int k0 = 0; k0 < K; k0 += 16) {
      __syncthreads();
#pragma unroll
      for (int i = 0; i < 4; ++i) { int e = tid + 256 * i; int m = e >> 4, k = e & 15; sA[k][m] = af(m0 + m, k0 + k); }
#pragma unroll
      for (int i = 0; i < 4; ++i) { int e = tid + 256 * i; int k = e >> 6, n = e & 63; sB[k][n] = bf(k0 + k, n0 + n); }
      __syncthreads();
#pragma unroll
      for (int k = 0; k < 16; ++k) {
        float a[4], b[4];
#pragma unroll
        for (int i = 0; i < 4; ++i) { a[i] = sA[k][ty * 4 + i]; b[i] = sB[k][tx * 4 + i]; }
#pragma unroll
        for (int i = 0; i < 4; ++i)
#pragma unroll
          for (int j = 0; j < 4; ++j) acc[i][j] += a[i] * b[j];
      }
    }
#pragma unroll
    for (int i = 0; i < 4; ++i)
#pragma unroll
      for (int j = 0; j < 4; ++j) cf(m0 + ty * 4 + i, n0 + tx * 4 + j, acc[i][j]);
  }
}


__device__ __forceinline__ void ph_transpose_w(const float* __restrict__ W, int K, int N, bf16_t* __restrict__ Wt, float* sm) {
  int tid = threadIdx.x;
  int tk = K / 64, tn = N / 64;
  GRID_LOOP(tile, tk * tn) {
    int k0 = (tile / tn) * 64, n0 = (tile % tn) * 64;
    __syncthreads();
#pragma unroll
    for (int i = 0; i < 16; ++i) { int e = tid + 256 * i; int k = e >> 6, n = e & 63; sm[k * 65 + n] = W[(size_t)(k0 + k) * N + n0 + n]; }
    __syncthreads();
#pragma unroll
    for (int i = 0; i < 2; ++i) {
      int e = tid + 256 * i; int n = e >> 3, kc = e & 7;
      unsigned w[4];
#pragma unroll
      for (int j = 0; j < 4; ++j) w[j] = pack2bf(sm[(kc * 8 + 2 * j) * 65 + n], sm[(kc * 8 + 2 * j + 1) * 65 + n]);
      *(uint4*)(Wt + (size_t)(n0 + n) * K + k0 + kc * 8) = make_uint4(w[0], w[1], w[2], w[3]);
    }
  }
}
__device__ __forceinline__ void ph_convert(const float* __restrict__ src, bf16_t* __restrict__ dst, size_t n8) {
  for (size_t i = (size_t)blockIdx.x * 256 + threadIdx.x; i < n8; i += (size_t)gridDim.x * 256) {
    float4 a = ((const float4*)src)[2 * i], b = ((const float4*)src)[2 * i + 1];
    ((uint4*)dst)[i] = make_uint4(pack2bf(a.x, a.y), pack2bf(a.z, a.w), pack2bf(b.x, b.y), pack2bf(b.z, b.w));
  }
}

__device__ __forceinline__ void gemm_stage(const bf16_t* __restrict__ A, int lda, int k0, char* lds, int tid) {
#pragma unroll
  for (int i = 0; i < 4; ++i) {
    int q = tid + 256 * i; int row = q >> 3, p = q & 7; int c = p ^ ((row >> 1) & 7);
    const bf16_t* src = A + (size_t)row * lda + k0 + c * 8;
    __builtin_amdgcn_global_load_lds((const unsigned*)src, (unsigned*)(lds + q * 16), 16, 0, 0);
  }
}
struct EpiF32 {
  float* C; int ldc; float scale;
  __device__ __forceinline__ void operator()(int m0, int n0, int wm, int wn, f32x16 (&acc)[2][2], int tid, char* smem) const {
    int lane = tid & 63;
    float* t = (float*)smem;
    int rbase = wm * 64 + 4 * (lane >> 5), cbase = wn * 64 + (lane & 31);
#pragma unroll
    for (int mi = 0; mi < 2; ++mi)
#pragma unroll
      for (int ni = 0; ni < 2; ++ni)
#pragma unroll
        for (int r = 0; r < 16; ++r)
          t[(rbase + mi * 32 + (r & 3) + 8 * (r >> 2)) * 128 + cbase + ni * 32] = acc[mi][ni][r] * scale;
    __syncthreads();
    float* dst = C + (size_t)(m0 + (tid >> 5)) * ldc + n0 + (tid & 31) * 4;
    const float* src = t + (tid >> 5) * 128 + (tid & 31) * 4;
#pragma unroll 4
    for (int i = 0; i < 16; ++i) {
      *(float4*)dst = *(const float4*)src;
      dst += (size_t)8 * ldc; src += 8 * 128;
    }
  }
};
struct EpiQKV0 {
  bf16_t* FQKV; bf16_t* VT;
  __device__ __forceinline__ void operator()(int m0, int n0, int wm, int wn, f32x16 (&acc)[2][2], int tid, char* smem) const {
    int lane = tid & 63;
    bf16_t* t = (bf16_t*)smem;
    int rbase = wm * 64 + 4 * (lane >> 5), cbase = wn * 64 + (lane & 31);
#pragma unroll
    for (int mi = 0; mi < 2; ++mi)
#pragma unroll
      for (int ni = 0; ni < 2; ++ni)
#pragma unroll
        for (int r = 0; r < 16; ++r)
          t[(rbase + mi * 32 + (r & 3) + 8 * (r >> 2)) * 136 + cbase + ni * 32] = (bf16_t)f2bf(acc[mi][ni][r]);
    __syncthreads();
    {
      bf16_t* dst = FQKV + (size_t)(m0 + (tid >> 4)) * 2048 + n0 + (tid & 15) * 8;
      const bf16_t* src = t + (tid >> 4) * 136 + (tid & 15) * 8;
#pragma unroll 4
      for (int i = 0; i < 8; ++i) {
        *(uint4*)dst = *(const uint4*)src;
        dst += (size_t)16 * 2048; src += 16 * 136;
      }
    }
    if (n0 >= 1536) {
      int col = tid >> 1, half = tid & 1;
      int hd = (n0 - 1536) / 64 + (col >> 6), d = col & 63;
      bf16_t* dst;
      if (m0 < T) { int b = m0 / S, t0 = m0 % S; dst = VT + (((size_t)b * 8 + hd) * 64 + d) * S + t0 + half * 64; }
      else { int mm = m0 - T; int b = mm / CL, l0 = mm % CL; dst = VT + (size_t)NB * 8 * 64 * S + (((size_t)b * 8 + hd) * 64 + d) * CL + l0 + half * 64; }
      const bf16_t* src = t + (half * 64) * 136 + col;
#pragma unroll
      for (int i = 0; i < 8; ++i) {
        unsigned wv[4];
#pragma unroll
        for (int j = 0; j < 4; ++j) wv[j] = (unsigned)src[(i * 8 + 2 * j) * 136] | ((unsigned)src[(i * 8 + 2 * j + 1) * 136] << 16);
        *(uint4*)(dst + i * 8) = make_uint4(wv[0], wv[1], wv[2], wv[3]);
      }
    }
  }
};
struct EpiBf16 {
  bf16_t* C; int ldc;
  __device__ __forceinline__ void operator()(int m0, int n0, int wm, int wn, f32x16 (&acc)[2][2], int tid, char* smem) const {
    int lane = tid & 63;
    asm volatile("" : "+v"(lane));
    bf16_t* t = (bf16_t*)smem;
    {
      bf16_t* tw = t + (wm * 64 + 4 * (lane >> 5)) * 136 + wn * 64 + (lane & 31);
#pragma unroll
      for (int mi = 0; mi < 2; ++mi)
#pragma unroll
        for (int ni = 0; ni < 2; ++ni)
#pragma unroll
          for (int r = 0; r < 16; ++r)
            tw[(mi * 32 + (r & 3) + 8 * (r >> 2)) * 136 + ni * 32] = (bf16_t)f2bf(acc[mi][ni][r]);
    }
    __syncthreads();
    bf16_t* dst = C + (size_t)(m0 + (tid >> 4)) * ldc + n0 + (tid & 15) * 8;
    const bf16_t* src = t + (tid >> 4) * 136 + (tid & 15) * 8;
#pragma unroll 4
    for (int i = 0; i < 8; ++i) {
      *(uint4*)dst = *(const uint4*)src;
      dst += (size_t)16 * ldc; src += 16 * 136;
    }
  }
};
struct EpiQKV1 {
  bf16_t* Q1; bf16_t* K1; bf16_t* VT; const float* RT;
  __device__ __forceinline__ void operator()(int m0, int n0, int wm, int wn, f32x16 (&acc)[2][2], int tid, char* smem) const {
    int lane = tid & 63;
    asm volatile("" : "+v"(lane));
    bf16_t* t = (bf16_t*)smem;
    if (n0 < 1280 && m0 < T) {
      int i = lane & 31; int f = i & 15;
#pragma unroll
      for (int mi = 0; mi < 2; ++mi)
#pragma unroll
        for (int r = 0; r < 16; ++r) {
          int row = m0 + wm * 64 + 4 * (lane >> 5) + mi * 32 + (r & 3) + 8 * (r >> 2);
          int tt = row & (S - 1);
          int pos = (i < 16) ? (tt >> 6) : (tt & 63);
          float2 cs = *(const float2*)(RT + 2 * (pos * 16 + f));
          float x1 = acc[mi][0][r], x2 = acc[mi][1][r];
          acc[mi][0][r] = x1 * cs.x - x2 * cs.y;
          acc[mi][1][r] = x1 * cs.y + x2 * cs.x;
        }
    }
    {
      bf16_t* tw = t + (wm * 64 + 4 * (lane >> 5)) * 136 + wn * 64 + (lane & 31);
#pragma unroll
      for (int mi = 0; mi < 2; ++mi)
#pragma unroll
        for (int ni = 0; ni < 2; ++ni)
#pragma unroll
          for (int r = 0; r < 16; ++r)
            tw[(mi * 32 + (r & 3) + 8 * (r >> 2)) * 136 + ni * 32] = (bf16_t)f2bf(acc[mi][ni][r]);
    }
    __syncthreads();
    if (n0 < 1280) {
      bf16_t* dst; int ld;
      if (n0 < 1024) { dst = Q1 + (size_t)(m0 + (tid >> 4)) * 1024 + n0 + (tid & 15) * 8; ld = 1024; }
      else { dst = K1 + (size_t)(m0 + (tid >> 4)) * 256 + (n0 - 1024) + (tid & 15) * 8; ld = 256; }
      if (n0 >= 1024 || m0 < T) {
        const bf16_t* src = t + (tid >> 4) * 136 + (tid & 15) * 8;
#pragma unroll 4
        for (int i = 0; i < 8; ++i) {
          *(uint4*)dst = *(const uint4*)src;
          dst += (size_t)16 * ld; src += 16 * 136;
        }
      }
    } else {
      int col = tid >> 1, half = tid & 1;
      int hd = (n0 - 1280) / 64 + (col >> 6), d = col & 63;
      bf16_t* dst;
      if (m0 < T) { int b = m0 / S, t0 = m0 % S; dst = VT + (((size_t)b * 4 + hd) * 64 + d) * S + t0 + half * 64; }
      else { int mm = m0 - T; int b = mm / CL, l0 = mm % CL; dst = VT + (size_t)NB * 4 * 64 * S + (((size_t)b * 4 + hd) * 64 + d) * CL + l0 + half * 64; }
      const bf16_t* src = t + (half * 64) * 136 + col;
#pragma unroll
      for (int i = 0; i < 8; ++i) {
        unsigned wv[4];
#pragma unroll
        for (int j = 0; j < 4; ++j) wv[j] = (unsigned)src[(i * 8 + 2 * j) * 136] | ((unsigned)src[(i * 8 + 2 * j + 1) * 136] << 16);
        *(uint4*)(dst + i * 8) = make_uint4(wv[0], wv[1], wv[2], wv[3]);
      }
    }
  }
};
__device__ __forceinline__ void gemm_tile_mainloop(const bf16_t* __restrict__ Ag, int lda, const bf16_t* __restrict__ Bg, int ldb, int KT,
                                                   f32x16 (&acc)[2][2], char* smem) {
  int tid = threadIdx.x;
  asm volatile("" : "+v"(tid));
  int lane = tid & 63, wave = __builtin_amdgcn_readfirstlane(tid >> 6), wm = wave >> 1, wn = wave & 1;
#pragma unroll
  for (int mi = 0; mi < 2; ++mi)
#pragma unroll
    for (int ni = 0; ni < 2; ++ni)
#pragma unroll
      for (int r = 0; r < 16; ++r) acc[mi][ni][r] = 0.f;
  __syncthreads();
  gemm_stage(Ag, lda, 0, smem, tid); gemm_stage(Bg, ldb, 0, smem + 16384, tid);
  for (int kt = 0; kt < KT; ++kt) {
    asm volatile("s_waitcnt vmcnt(0)" ::: "memory");
    __syncthreads();
    char* cur = smem + (kt & 1) * 32768;
    if (kt + 1 < KT) {
      char* nxt = smem + ((kt + 1) & 1) * 32768;
      gemm_stage(Ag, lda, (kt + 1) * 64, nxt, tid); gemm_stage(Bg, ldb, (kt + 1) * 64, nxt + 16384, tid);
    }
#pragma unroll
    for (int s4 = 0; s4 < 4; ++s4) {
      bf16x8 a[2], b[2];
      int c = 2 * s4 + (lane >> 5);
#pragma unroll
      for (int mi = 0; mi < 2; ++mi) { int row = wm * 64 + mi * 32 + (lane & 31); a[mi] = *(const bf16x8*)(cur + row * 128 + ((c ^ ((row >> 1) & 7)) << 4)); }
#pragma unroll
      for (int ni = 0; ni < 2; ++ni) { int row = wn * 64 + ni * 32 + (lane & 31); b[ni] = *(const bf16x8*)(cur + 16384 + row * 128 + ((c ^ ((row >> 1) & 7)) << 4)); }
#pragma unroll
      for (int mi = 0; mi < 2; ++mi)
#pragma unroll
        for (int ni = 0; ni < 2; ++ni) acc[mi][ni] = __builtin_amdgcn_mfma_f32_32x32x16_bf16(a[mi], b[ni], acc[mi][ni], 0, 0, 0);
    }
  }
  __syncthreads();
}
template <class Epi>
__device__ __forceinline__ void ph_gemm_bf16(const bf16_t* __restrict__ A, int lda, const bf16_t* __restrict__ Bt, int ldb, int M, int N, int K,
                             Epi epi, char* smem) {
  int tid = threadIdx.x, wave = __builtin_amdgcn_readfirstlane(tid >> 6), wm = wave >> 1, wn = wave & 1;
  int ntn = N / 128, ntiles = (M / 128) * ntn;
  int KT = K / 64;
  GRID_LOOP(tile, ntiles) {
    int mt = tile / ntn, nt = tile % ntn;
    f32x16 acc[2][2];
    gemm_tile_mainloop(A + (size_t)mt * 128 * lda, lda, Bt + (size_t)nt * 128 * ldb, ldb, KT, acc, smem);
    epi(mt * 128, nt * 128, wm, wn, acc, tid, smem);
  }
}

__device__ __forceinline__ void ins16(float (&L)[16], float x) {
#pragma unroll
  for (int j = 15; j >= 1; --j) L[j] = __builtin_amdgcn_fmed3f(L[j - 1], L[j], x);
  L[0] = fmaxf(L[0], x);
}
__device__ __forceinline__ void stage_tile128(const bf16_t* __restrict__ src, int ld, char* lds, int tid) {
#pragma unroll
  for (int i = 0; i < 8; ++i) {
    int q = tid + 256 * i; int row = q >> 4, p = q & 15; int c = p ^ (row & 15);
    __builtin_amdgcn_global_load_lds((const unsigned*)(src + (size_t)row * ld + c * 8), (unsigned*)(lds + q * 16), 16, 0, 0);
  }
}
__device__ __forceinline__ void ph_peer_select(const bf16_t* __restrict__ H, const bf16_t* __restrict__ WQl, const bf16_t* __restrict__ SKl,
                                               int* __restrict__ EXP, float* __restrict__ GATE, int nrows, char* smem) {
  int tid = threadIdx.x, w = __builtin_amdgcn_readfirstlane(tid >> 6), wm = w >> 1, wn = w & 1;
  bf16_t* Qs = (bf16_t*)smem;
  int* KL = (int*)(smem + 36864);
  int nunits = (nrows / 128) * 8;
  GRID_LOOP(unit, nunits) {
    int mt = unit >> 3, h = unit & 7;
    float L0[16], L1[16];
#pragma unroll
    for (int p = 0; p < 2; ++p) {
      f32x16 acc[2][2];
      gemm_tile_mainloop(H + (size_t)mt * 128 * 1024, 1024, WQl + (size_t)(h * 256 + p * 128) * 1024, 1024, 16, acc, smem);
      int lane = tid & 63;
      asm volatile("" : "+v"(lane));
      {
        bf16_t* qw = Qs + (wm * 64 + 4 * (lane >> 5)) * 136 + wn * 64 + (lane & 31);
#pragma unroll
        for (int mi = 0; mi < 2; ++mi)
#pragma unroll
          for (int ni = 0; ni < 2; ++ni)
#pragma unroll
            for (int r = 0; r < 16; ++r)
              qw[(mi * 32 + (r & 3) + 8 * (r >> 2)) * 136 + ni * 32] = (bf16_t)f2bf(acc[mi][ni][r]);
      }
      __syncthreads();
      f32x16 sc[4];
#pragma unroll
      for (int m4 = 0; m4 < 4; ++m4)
#pragma unroll
        for (int r = 0; r < 16; ++r) sc[m4][r] = 0.f;
      {
        const bf16_t* qrow = Qs + (32 * w + (lane & 31)) * 136 + 8 * (lane >> 5);
        const bf16_t* krow = SKl + (size_t)(h * 2 + p) * 128 * 128 + (lane & 31) * 128 + 8 * (lane >> 5);
#pragma unroll
        for (int s8 = 0; s8 < 8; ++s8) {
          bf16x8 bq = *(const bf16x8*)(qrow + 16 * s8);
#pragma unroll
          for (int m4 = 0; m4 < 4; ++m4) {
            bf16x8 ak = *(const bf16x8*)(krow + m4 * 32 * 128 + 16 * s8);
            sc[m4] = __builtin_amdgcn_mfma_f32_32x32x16_bf16(ak, bq, sc[m4], 0, 0, 0);
          }
        }
      }
      float L[16];
#pragma unroll
      for (int j = 0; j < 16; ++j) L[j] = -INFINITY;
      unsigned kb = 4u * (unsigned)(lane >> 5);
#pragma unroll
      for (int m4 = 0; m4 < 4; ++m4)
#pragma unroll
        for (int r = 0; r < 16; ++r) {
          unsigned key = kb + (unsigned)(32 * m4 + (r & 3) + 8 * (r >> 2));
          float x = __uint_as_float((__float_as_uint(sc[m4][r]) & 0xFFFFFF80u) | key);
          ins16(L, x);
        }
      float P[16];
#pragma unroll
      for (int j = 0; j < 16; ++j) P[j] = __shfl_xor(L[j], 32);
#pragma unroll
      for (int j = 0; j < 16; ++j) ins16(L, P[j]);
      if (p == 0) {
#pragma unroll
        for (int j = 0; j < 16; ++j) L0[j] = L[j];
      } else {
#pragma unroll
        for (int j = 0; j < 16; ++j) L1[j] = L[j];
      }
    }
    float C[16];
#pragma unroll
    for (int j = 0; j < 16; ++j) C[j] = -INFINITY;
#pragma unroll
    for (int a = 0; a < 16; ++a)
#pragma unroll
      for (int b = 0; b < 16; ++b)
        if ((a + 1) * (b + 1) <= 16) {
          float sa = __uint_as_float(__float_as_uint(L0[a]) & 0xFFFFFF80u);
          float sb = __uint_as_float(__float_as_uint(L1[b]) & 0xFFFFFF80u);
          float x = __uint_as_float((__float_as_uint(sa + sb) & 0xFFFFFF00u) | (unsigned)(a * 16 + b));
          ins16(C, x);
        }
    int lane = tid & 63;
    asm volatile("" : "+v"(lane));
    int token = 32 * w + (lane & 31);
    if (lane < 32) {
#pragma unroll
      for (int j = 0; j < 16; ++j) { KL[token * 32 + j] = (int)(__float_as_uint(L0[j]) & 0x7Fu); KL[token * 32 + 16 + j] = (int)(__float_as_uint(L1[j]) & 0x7Fu); }
    }
    __syncthreads();
    if (lane < 32) {
      float c0 = __uint_as_float(__float_as_uint(C[0]) & 0xFFFFFF00u);
      float ev[16]; float sum = 0.f; int ex[16];
#pragma unroll
      for (int j = 0; j < 16; ++j) {
        unsigned bits = __float_as_uint(C[j]);
        float cv = __uint_as_float(bits & 0xFFFFFF00u);
        ev[j] = __expf(cv - c0); sum += ev[j];
        int a = (bits >> 4) & 15, b = bits & 15;
        ex[j] = KL[token * 32 + a] * 128 + KL[token * 32 + 16 + b];
      }
      float inv = 1.f / sum;
      size_t o = (size_t)(mt * 128 + token) * 128 + h * 16;
#pragma unroll
      for (int j = 0; j < 16; j += 4) {
        *(int4*)(EXP + o + j) = make_int4(ex[j], ex[j + 1], ex[j + 2], ex[j + 3]);
        *(float4*)(GATE + o + j) = make_float4(ev[j] * inv, ev[j + 1] * inv, ev[j + 2] * inv, ev[j + 3] * inv);
      }
    }
  }
}

__device__ __forceinline__ void fft1_unit(int u, const bf16_t* __restrict__ FQKV, const bf16_t* __restrict__ D1, const float* __restrict__ TAB,
                          bf16_t* __restrict__ A1, char* smem) {
  int tid = threadIdx.x, lane = tid & 63, w = __builtin_amdgcn_readfirstlane(tid >> 6);
  int g = u & 7, c = (u >> 3) & 63, b = u >> 9;
  bf16_t* Bt = (bf16_t*)smem;
  __syncthreads();
  {
    int r = tid >> 1, half = tid & 1;
    const uint4* src = (const uint4*)(FQKV + (size_t)(b * S + 64 * r + c) * 2048 + g * 64 + half * 32);
    unsigned wv[16];
#pragma unroll
    for (int i = 0; i < 4; ++i) { uint4 v = src[i]; wv[4 * i] = v.x; wv[4 * i + 1] = v.y; wv[4 * i + 2] = v.z; wv[4 * i + 3] = v.w; }
#pragma unroll
    for (int j = 0; j < 32; ++j) {
      unsigned e = (j & 1) ? (wv[j >> 1] >> 16) : (wv[j >> 1] & 0xffffu);
      Bt[(half * 32 + j) * 136 + r] = (bf16_t)e;
    }
  }
  __syncthreads();
  f32x16 acc[2][2];
#pragma unroll
  for (int mi = 0; mi < 2; ++mi)
#pragma unroll
    for (int ni = 0; ni < 2; ++ni)
#pragma unroll
      for (int r = 0; r < 16; ++r) acc[mi][ni][r] = 0.f;
#pragma unroll
  for (int s8 = 0; s8 < 8; ++s8) {
    bf16x8 a[2], bb[2];
    int ko = 16 * s8 + 8 * (lane >> 5);
#pragma unroll
    for (int mi = 0; mi < 2; ++mi) a[mi] = *(const bf16x8*)(D1 + (64 * w + 32 * mi + (lane & 31)) * 128 + ko);
#pragma unroll
    for (int ni = 0; ni < 2; ++ni) bb[ni] = *(const bf16x8*)(Bt + (32 * ni + (lane & 31)) * 136 + ko);
#pragma unroll
    for (int mi = 0; mi < 2; ++mi)
#pragma unroll
      for (int ni = 0; ni < 2; ++ni) acc[mi][ni] = __builtin_amdgcn_mfma_f32_32x32x16_bf16(a[mi], bb[ni], acc[mi][ni], 0, 0, 0);
  }
  bf16_t* Ot = (bf16_t*)(smem + 17408);
#pragma unroll
  for (int mi = 0; mi < 2; ++mi)
#pragma unroll
    for (int j = 0; j < 8; ++j) {
      int m = 64 * w + 32 * mi + ((2 * j) & 3) + 8 * ((2 * j) >> 2) + 4 * (lane >> 5);
      int k1 = m >> 1;
      int idx = (k1 * c) & 8191;
      float cs = TAB[idx], sn = TAB[8192 + idx];
#pragma unroll
      for (int ni = 0; ni < 2; ++ni) {
        float re = acc[mi][ni][2 * j], im = acc[mi][ni][2 * j + 1];
        float re2 = re * cs + im * sn, im2 = im * cs - re * sn;
        bf16_t* dst = Ot + m * 72 + 32 * ni + (lane & 31);
        dst[0] = (bf16_t)f2bf(re2); dst[72] = (bf16_t)f2bf(im2);
      }
    }
  __syncthreads();
  {
    bf16_t* base = A1 + (((size_t)b * 64 + c) * 128) * 2 * 512 + g * 64;
#pragma unroll
    for (int i = 0; i < 8; ++i) {
      int q = tid + 256 * i; int m = q >> 3, ch8 = q & 7;
      *(uint4*)(base + (size_t)m * 512 + ch8 * 8) = *(const uint4*)(Ot + m * 72 + ch8 * 8);
    }
  }
}

__device__ __forceinline__ void fft3_unit(int u, int mode, const bf16_t* __restrict__ FQKV, const bf16_t* __restrict__ A1, const bf16_t* __restrict__ D3,
                          const bf16_t* __restrict__ DcT, const float* __restrict__ TAB, bf16_t* __restrict__ MIX, char* smem) {
  int tid = threadIdx.x, lane = tid & 63, w = __builtin_amdgcn_readfirstlane(tid >> 6);
  bf16_t* Bt = (bf16_t*)smem;
  bf16_t* Xs = (bf16_t*)(smem + 17408);
  int g = u & 7, k1, b, nk1, rowbase; float norm;
  __syncthreads();
  if (mode == 0) {
    k1 = (u >> 3) & 127; b = u >> 10; nk1 = 128; rowbase = b * S; norm = 1.f / 724.0773439350247f;
    int kk = tid >> 1, half = tid & 1; int c = kk >> 1, ri = kk & 1;
    const uint4* src = (const uint4*)(A1 + ((((size_t)b * 64 + c) * 128 + k1) * 2 + ri) * 512 + g * 64 + half * 32);
    unsigned wv[16];
#pragma unroll
    for (int i = 0; i < 4; ++i) { uint4 v = src[i]; wv[4 * i] = v.x; wv[4 * i + 1] = v.y; wv[4 * i + 2] = v.z; wv[4 * i + 3] = v.w; }
#pragma unroll
    for (int j = 0; j < 32; ++j) {
      unsigned e = (j & 1) ? (wv[j >> 1] >> 16) : (wv[j >> 1] & 0xffffu);
      Bt[(half * 32 + j) * 136 + kk] = (bf16_t)e;
    }
  } else {
    k1 = (u >> 3) & 3; b = u >> 5; nk1 = 4; rowbase = T + b * CL; norm = 1.f / 128.f;
    int c = tid >> 2, q4 = tid & 3;
    float re[16], im[16];
#pragma unroll
    for (int j = 0; j < 16; ++j) { re[j] = 0.f; im[j] = 0.f; }
#pragma unroll
    for (int r = 0; r < 4; ++r) {
      const uint4* src = (const uint4*)(FQKV + (size_t)(rowbase + 64 * r + c) * 2048 + g * 64 + q4 * 16);
      uint4 v0 = src[0], v1 = src[1];
      unsigned wv[8] = {v0.x, v0.y, v0.z, v0.w, v1.x, v1.y, v1.z, v1.w};
      int ph = (k1 * r) & 3;
      float cr = (ph == 0) ? 1.f : (ph == 2 ? -1.f : 0.f);
      float ci = (ph == 1) ? -1.f : (ph == 3 ? 1.f : 0.f);
#pragma unroll
      for (int j = 0; j < 16; ++j) {
        float x = bf2f((unsigned short)((j & 1) ? (wv[j >> 1] >> 16) : (wv[j >> 1] & 0xffffu)));
        re[j] += x * cr; im[j] += x * ci;
      }
    }
    int idx = (k1 * c * 32) & 8191;
    float cs = TAB[idx], sn = TAB[8192 + idx];
#pragma unroll
    for (int j = 0; j < 16; ++j) {
      float re2 = re[j] * cs + im[j] * sn, im2 = im[j] * cs - re[j] * sn;
      *(unsigned*)(Bt + (q4 * 16 + j) * 136 + 2 * c) = pack2bf(re2, im2);
    }
  }
  __syncthreads();
  {
    f32x16 acc[2];
#pragma unroll
    for (int ni = 0; ni < 2; ++ni)
#pragma unroll
      for (int r = 0; r < 16; ++r) acc[ni][r] = 0.f;
#pragma unroll
    for (int s8 = 0; s8 < 8; ++s8) {
      int ko = 16 * s8 + 8 * (lane >> 5);
      bf16x8 a = *(const bf16x8*)(D3 + (32 * w + (lane & 31)) * 128 + ko);
#pragma unroll
      for (int ni = 0; ni < 2; ++ni) {
        bf16x8 bb = *(const bf16x8*)(Bt + (32 * ni + (lane & 31)) * 136 + ko);
        acc[ni] = __builtin_amdgcn_mfma_f32_32x32x16_bf16(a, bb, acc[ni], 0, 0, 0);
      }
    }
#pragma unroll
    for (int ni = 0; ni < 2; ++ni)
#pragma unroll
      for (int r = 0; r < 16; ++r) {
        int m = 32 * w + (r & 3) + 8 * (r >> 2) + 4 * (lane >> 5);
        Xs[(m & 63) * 136 + (m >> 6) * 64 + 32 * ni + (lane & 31)] = (bf16_t)f2bf(acc[ni][r]);
      }
  }
  __syncthreads();
  {
    int mi = w >> 1, ni = w & 1;
    f32x16 acc;
#pragma unroll
    for (int r = 0; r < 16; ++r) acc[r] = 0.f;
#pragma unroll
    for (int s8 = 0; s8 < 8; ++s8) {
      int ko = 16 * s8 + 8 * (lane >> 5);
      bf16x8 a = *(const bf16x8*)(Xs + (32 * mi + (lane & 31)) * 136 + ko);
      bf16x8 bb = *(const bf16x8*)(DcT + (32 * ni + (lane & 31)) * 128 + ko);
      acc = __builtin_amdgcn_mfma_f32_32x32x16_bf16(a, bb, acc, 0, 0, 0);
    }
    bf16_t* Yt = Bt;
#pragma unroll
    for (int r = 0; r < 16; ++r) {
      int k2 = 32 * mi + (r & 3) + 8 * (r >> 2) + 4 * (lane >> 5);
      Yt[k2 * 72 + 32 * ni + (lane & 31)] = (bf16_t)f2bf(acc[r] * norm);
    }
  }
  __syncthreads();
#pragma unroll
  for (int i = 0; i < 2; ++i) {
    int q = tid + 256 * i; int k2 = q >> 3, ch8 = q & 7;
    int row = rowbase + k1 + nk1 * k2;
    *(uint4*)(MIX + (size_t)row * 1024 + g * 64 + ch8 * 8) = *(const uint4*)((const bf16_t*)smem + k2 * 72 + ch8 * 8);
  }
}

typedef __attribute__((ext_vector_type(4))) float f32x4_t;
__device__ __forceinline__ bf16x8 ld16(const bf16_t* p) { return *(const bf16x8*)p; }
__device__ __forceinline__ float fast_exp2(float x) { return __builtin_amdgcn_exp2f(x); }

template <int NH, int MODE, int KPI>
__device__ __forceinline__ void attn_unit(int b, int hk, int r, int jb, int qb, const bf16_t* __restrict__ Qp, int ldq, const bf16_t* __restrict__ Kp, int ldk,
                                          const bf16_t* __restrict__ VTl, const bf16_t* __restrict__ VTc, int nkvh,
                                          const float* rpbs, const float* __restrict__ sink,
                                          bf16_t* __restrict__ Op, int ldo, int lane) {
  const float LOG2E = 1.4426950408889634f;
  const float SC = 0.125f * LOG2E;
  asm volatile("" : "+v"(lane));
  int ql = lane & 15, g = lane >> 4;
  int qrow0, q0 = 0;
  int nloc, lb0 = 0;
  if (MODE == 0) { qrow0 = b * S + r * 64 + 16 * jb; nloc = 8; }
  else if (MODE == 1) { qrow0 = T + b * CL + 16 * qb; nloc = 0; }
  else { q0 = 16 * qb; qrow0 = b * S + q0;
         int lo = (q0 - 128) >> 5, hi = (q0 + 143) >> 5; if (lo < 0) lo = 0; if (hi > 255) hi = 255; lb0 = lo; nloc = hi - lo + 1; }
  bf16x8 qf[NH][2];
#pragma unroll
  for (int hh = 0; hh < NH; ++hh)
#pragma unroll
    for (int s2 = 0; s2 < 2; ++s2)
      qf[hh][s2] = ld16(Qp + (size_t)(qrow0 + ql) * ldq + (hk * NH + hh) * 64 + 32 * s2 + 8 * g);
  f32x4_t o[NH][4]; float mrun[NH], lrun[NH];
#pragma unroll
  for (int hh = 0; hh < NH; ++hh) {
    mrun[hh] = -1e30f; lrun[hh] = 0.f;
#pragma unroll
    for (int dt = 0; dt < 4; ++dt) o[hh][dt] = (f32x4_t){0.f, 0.f, 0.f, 0.f};
  }
  int r_start = 0, blk_start = 0, c_lo = 0, qc = 0;
  if (MODE == 0) {
    r_start = min(max(r - 4, 0), 120);
    blk_start = min(max(16 * jb - 8, 0), 32);
    qc = 16 * jb + ql; c_lo = min(max(qc - 8, 0), 48);
  }
  int nit = (nloc + 8) / KPI;
#define ATT_DESC(kbx, krow0_, vtp_, vld_) \
    { bool il_ = (kbx) < nloc; int vt0_; \
      if (il_) { if (MODE == 0) { int rr_ = r_start + (kbx); krow0_ = b * S + rr_ * 64 + blk_start; vt0_ = rr_ * 64 + blk_start; } \
                 else { krow0_ = b * S + 32 * (lb0 + (kbx)); vt0_ = 32 * (lb0 + (kbx)); } \
                 vtp_ = VTl + ((size_t)(b * nkvh + hk) * 64) * S + vt0_; vld_ = S; } \
      else { int cb_ = (kbx) - nloc; krow0_ = T + b * CL + 32 * cb_; vt0_ = 32 * cb_; \
             vtp_ = VTc + ((size_t)(b * nkvh + hk) * 64) * CL + vt0_; vld_ = CL; } }
#define ATT_LOAD(kbx, KF, VF) \
    { int krow0; const bf16_t* vt; int vld; ATT_DESC(kbx, krow0, vt, vld) \
      _Pragma("unroll") for (int t = 0; t < 2; ++t) _Pragma("unroll") for (int s2 = 0; s2 < 2; ++s2) \
        KF[t][s2] = ld16(Kp + (size_t)(krow0 + 8 * (ql >> 2) + 4 * t + (ql & 3)) * ldk + hk * 64 + 32 * s2 + 8 * g); \
      _Pragma("unroll") for (int dt = 0; dt < 4; ++dt) VF[dt] = ld16(vt + (size_t)(16 * dt + ql) * vld + 8 * g); }
  bf16x8 kfn[KPI][2][2], vfn[KPI][4];
#pragma unroll
  for (int kk = 0; kk < KPI; ++kk) ATT_LOAD(kk, kfn[kk], vfn[kk])
  for (int it = 0; it < nit; ++it) {
    bf16x8 kf[KPI][2][2], vf[KPI][4];
#pragma unroll
    for (int kk = 0; kk < KPI; ++kk) {
#pragma unroll
      for (int t = 0; t < 2; ++t)
#pragma unroll
        for (int s2 = 0; s2 < 2; ++s2) kf[kk][t][s2] = kfn[kk][t][s2];
#pragma unroll
      for (int dt = 0; dt < 4; ++dt) vf[kk][dt] = vfn[kk][dt];
    }
    if (it + 1 < nit) {
#pragma unroll
      for (int kk = 0; kk < KPI; ++kk) ATT_LOAD((it + 1) * KPI + kk, kfn[kk], vfn[kk])
    }
    float bias[KPI][2][4]; bool valid[KPI][2][4];
#pragma unroll
    for (int kk = 0; kk < KPI; ++kk) {
      int kb = it * KPI + kk;
      bool is_loc = kb < nloc;
#pragma unroll
      for (int t = 0; t < 2; ++t)
#pragma unroll
        for (int i = 0; i < 4; ++i) {
          bias[kk][t][i] = 0.f; valid[kk][t][i] = true;
          if (MODE == 0 && is_loc) {
            int kc = blk_start + 8 * g + 4 * t + i;
            valid[kk][t][i] = (kc >= c_lo) && (kc < c_lo + 16);
            int dc = min(max(kc - qc, -15), 15) + 15;
            bias[kk][t][i] = rpbs[(hk * 15 + (r_start + kb - r + 7)) * 31 + dc];
          }
          if (MODE == 2 && is_loc) {
            int kpos = 32 * (lb0 + kb) + 8 * g + 4 * t + i; int dq = (q0 + ql) - kpos;
            valid[kk][t][i] = (dq <= 128) && (dq >= -128);
          }
        }
    }
#pragma unroll
    for (int hh = 0; hh < NH; ++hh) {
      f32x4_t st[KPI][2];
#pragma unroll
      for (int kk = 0; kk < KPI; ++kk)
#pragma unroll
        for (int t = 0; t < 2; ++t) {
          st[kk][t] = (f32x4_t){0.f, 0.f, 0.f, 0.f};
          st[kk][t] = __builtin_amdgcn_mfma_f32_16x16x32_bf16(kf[kk][t][0], qf[hh][0], st[kk][t], 0, 0, 0);
          st[kk][t] = __builtin_amdgcn_mfma_f32_16x16x32_bf16(kf[kk][t][1], qf[hh][1], st[kk][t], 0, 0, 0);
        }
      float lg[KPI][2][4]; float bm = -1e30f;
#pragma unroll
      for (int kk = 0; kk < KPI; ++kk)
#pragma unroll
        for (int t = 0; t < 2; ++t)
#pragma unroll
          for (int i = 0; i < 4; ++i) {
            float v = valid[kk][t][i] ? (st[kk][t][i] * SC + bias[kk][t][i]) : -1e30f;
            lg[kk][t][i] = v; bm = fmaxf(bm, v);
          }
      bm = xrow16_max(bm);
      float mn = fmaxf(mrun[hh], bm);
      float alpha = fast_exp2(mrun[hh] - mn);
      mrun[hh] = mn;
      float ps = 0.f;
      bf16x8 pf[KPI];
#pragma unroll
      for (int kk = 0; kk < KPI; ++kk) {
        float pv[8];
#pragma unroll
        for (int t = 0; t < 2; ++t)
#pragma unroll
          for (int i = 0; i < 4; ++i) {
            float p = valid[kk][t][i] ? fast_exp2(lg[kk][t][i] - mn) : 0.f;
            pv[4 * t + i] = p; ps += p;
          }
        typedef __attribute__((ext_vector_type(4))) unsigned u32x4;
        u32x4 uu = {pack2bf(pv[0], pv[1]), pack2bf(pv[2], pv[3]), pack2bf(pv[4], pv[5]), pack2bf(pv[6], pv[7])};
        pf[kk] = __builtin_bit_cast(bf16x8, uu);
      }
      lrun[hh] = lrun[hh] * alpha + ps;
#pragma unroll
      for (int dt = 0; dt < 4; ++dt) {
        o[hh][dt] *= alpha;
#pragma unroll
        for (int kk = 0; kk < KPI; ++kk)
          o[hh][dt] = __builtin_amdgcn_mfma_f32_16x16x32_bf16(vf[kk][dt], pf[kk], o[hh][dt], 0, 0, 0);
      }
    }
  }
#undef ATT_LOAD
#undef ATT_DESC
#pragma unroll
  for (int hh = 0; hh < NH; ++hh) {
    float l = xrow16_sum(lrun[hh]);
    float m = mrun[hh];
    if (MODE == 2) {
      float sk = sink[hk * NH + hh] * LOG2E;
      float mf = fmaxf(m, sk);
      float a = fast_exp2(m - mf);
      l = l * a + fast_exp2(sk - mf);
#pragma unroll
      for (int dt = 0; dt < 4; ++dt) o[hh][dt] *= a;
    }
    float inv = 1.f / l;
    bf16_t* orow = Op + (size_t)(qrow0 + ql) * ldo + (hk * NH + hh) * 64 + 4 * g;
#pragma unroll
    for (int dt = 0; dt < 4; ++dt) {
      f32x4_t v = o[hh][dt] * inv;
      *(uint2*)(orow + 16 * dt) = make_uint2(pack2bf(v[0], v[1]), pack2bf(v[2], v[3]));
    }
  }
}

struct NaState { f32x4_t o[4][4]; float m[4], l[4]; };
template <int HB>
__device__ __forceinline__ void na_block(NaState& st, const bf16x8 (&qf)[4][2], const bf16x8 (&kf)[2][2], const bf16x8 (&vf)[4],
                                         const float* rpbrow  , int ql, int g) {
  const float SC = 0.125f * 1.4426950408889634f;
#pragma unroll
  for (int jb = 0; jb < 4; ++jb) {
    if (HB == 0 && jb == 3) continue;
    if (HB == 1 && jb == 0) continue;
    f32x4_t s2[2];
#pragma unroll
    for (int t = 0; t < 2; ++t) {
      s2[t] = (f32x4_t){0.f, 0.f, 0.f, 0.f};
      s2[t] = __builtin_amdgcn_mfma_f32_16x16x32_bf16(kf[t][0], qf[jb][0], s2[t], 0, 0, 0);
      s2[t] = __builtin_amdgcn_mfma_f32_16x16x32_bf16(kf[t][1], qf[jb][1], s2[t], 0, 0, 0);
    }
    float lg[8]; bool valid[8]; float bm = -1e30f;
#pragma unroll
    for (int t = 0; t < 2; ++t)
#pragma unroll
      for (int i = 0; i < 4; ++i) {
        float v;
        if (HB < 2) {
          int qc = 16 * jb + ql; int c_lo = min(max(qc - 8, 0), 48);
          int kc = 32 * HB + 8 * g + 4 * t + i;
          bool ok = (kc >= c_lo) && (kc < c_lo + 16);
          int dc = min(max(kc - qc, -15), 15) + 15;
          v = ok ? (s2[t][i] * SC + rpbrow[dc]) : -1e30f;
          valid[4 * t + i] = ok;
        } else { v = s2[t][i] * SC; valid[4 * t + i] = true; }
        lg[4 * t + i] = v; bm = fmaxf(bm, v);
      }
    bm = xrow16_max(bm);
    float mn = fmaxf(st.m[jb], bm);
    float alpha = fast_exp2(st.m[jb] - mn);
    st.m[jb] = mn;
    float ps = 0.f; float pv[8];
#pragma unroll
    for (int e = 0; e < 8; ++e) { float p = valid[e] ? fast_exp2(lg[e] - mn) : 0.f; pv[e] = p; ps += p; }
    st.l[jb] = st.l[jb] * alpha + ps;
    typedef __attribute__((ext_vector_type(4))) unsigned u32x4;
    u32x4 uu = {pack2bf(pv[0], pv[1]), pack2bf(pv[2], pv[3]), pack2bf(pv[4], pv[5]), pack2bf(pv[6], pv[7])};
    bf16x8 pf = __builtin_bit_cast(bf16x8, uu);
#pragma unroll
    for (int dt = 0; dt < 4; ++dt) {
      st.o[jb][dt] *= alpha;
      st.o[jb][dt] = __builtin_amdgcn_mfma_f32_16x16x32_bf16(vf[dt], pf, st.o[jb][dt], 0, 0, 0);
    }
    __builtin_amdgcn_sched_barrier(0);
  }
}
__device__ __forceinline__ void na_unit(int b, int h, int r, const bf16_t* __restrict__ FQKV, const bf16_t* __restrict__ VTl,
                                        const bf16_t* __restrict__ VTc, const float* rpbs, bf16_t* __restrict__ MIX, int lane) {
  asm volatile("" : "+v"(lane));
  int ql = lane & 15, g = lane >> 4;
  int qrow0 = b * S + r * 64;
  int r_start = min(max(r - 4, 0), 120);
  bf16x8 qf[4][2];
#pragma unroll
  for (int jb = 0; jb < 4; ++jb)
#pragma unroll
    for (int s2 = 0; s2 < 2; ++s2)
      qf[jb][s2] = ld16(FQKV + (size_t)(qrow0 + 16 * jb + ql) * 2048 + 512 + h * 64 + 32 * s2 + 8 * g);
  NaState st;
#pragma unroll
  for (int jb = 0; jb < 4; ++jb) {
    st.m[jb] = -1e30f; st.l[jb] = 0.f;
#pragma unroll
    for (int dt = 0; dt < 4; ++dt) st.o[jb][dt] = (f32x4_t){0.f, 0.f, 0.f, 0.f};
  }
  unsigned koff = (unsigned)((8 * (ql >> 2) + (ql & 3)) * 2048 + 1024 + h * 64 + 8 * g);
  unsigned voffl = (unsigned)(ql * S + 8 * g), voffc = (unsigned)(ql * CL + 8 * g);
  const bf16_t* vtl = VTl + (size_t)(b * 8 + h) * 64 * S;
  const bf16_t* vtc = VTc + (size_t)(b * 8 + h) * 64 * CL;
#define NA_LOADK(kb2, KF) { \
    int krow0_; \
    if ((kb2) < 16) krow0_ = b * S + (r_start + ((kb2) >> 1)) * 64 + 32 * ((kb2) & 1); \
    else krow0_ = T + b * CL + 32 * ((kb2) - 16); \
    const bf16_t* kb_ = FQKV + (size_t)krow0_ * 2048; \
    _Pragma("unroll") for (int t = 0; t < 2; ++t) _Pragma("unroll") for (int s2 = 0; s2 < 2; ++s2) \
      KF[t][s2] = ld16(kb_ + (koff + (unsigned)(t * 4 * 2048 + 32 * s2))); }
#define NA_LOADV(kb2, VF) { \
    if ((kb2) < 16) { const bf16_t* vt_ = vtl + (r_start + ((kb2) >> 1)) * 64 + 32 * ((kb2) & 1); \
      _Pragma("unroll") for (int dt = 0; dt < 4; ++dt) VF[dt] = ld16(vt_ + (voffl + (unsigned)(16 * dt * S))); } \
    else { const bf16_t* vt_ = vtc + 32 * ((kb2) - 16); \
      _Pragma("unroll") for (int dt = 0; dt < 4; ++dt) VF[dt] = ld16(vt_ + (voffc + (unsigned)(16 * dt * CL))); } }
  bf16x8 kfa[2][2], kfb[2][2], vf[4];
  NA_LOADK(0, kfa)
#pragma unroll 1
  for (int rr = 0; rr < 8; ++rr) {
    const float* rpbrow = rpbs + (h * 15 + (r_start + rr - r + 7)) * 31;
    asm volatile("" : "+v"(lane)); ql = lane & 15; g = lane >> 4;
    koff = (unsigned)((8 * (ql >> 2) + (ql & 3)) * 2048 + 1024 + h * 64 + 8 * g); voffl = (unsigned)(ql * S + 8 * g);
    NA_LOADV(2 * rr, vf) NA_LOADK(2 * rr + 1, kfb)
    na_block<0>(st, qf, kfa, vf, rpbrow, ql, g);
    NA_LOADV(2 * rr + 1, vf) NA_LOADK(2 * rr + 2, kfa)
    na_block<1>(st, qf, kfb, vf, rpbrow, ql, g);
  }
#pragma unroll 1
  for (int cb = 0; cb < 8; cb += 2) {
    asm volatile("" : "+v"(lane)); ql = lane & 15; g = lane >> 4;
    koff = (unsigned)((8 * (ql >> 2) + (ql & 3)) * 2048 + 1024 + h * 64 + 8 * g); voffc = (unsigned)(ql * CL + 8 * g);
    NA_LOADV(16 + cb, vf) NA_LOADK(16 + cb + 1, kfb)
    na_block<2>(st, qf, kfa, vf, rpbs, ql, g);
    NA_LOADV(16 + cb + 1, vf)
    if (cb + 2 < 8) NA_LOADK(16 + cb + 2, kfa)
    na_block<2>(st, qf, kfb, vf, rpbs, ql, g);
  }
#undef NA_LOADK
#undef NA_LOADV
  asm volatile("" : "+v"(lane)); ql = lane & 15; g = lane >> 4;
#pragma unroll
  for (int jb = 0; jb < 4; ++jb) {
    float inv = 1.f / xrow16_sum(st.l[jb]);
    bf16_t* orow = MIX + (size_t)(qrow0 + 16 * jb + ql) * 1024 + 512 + h * 64 + 4 * g;
#pragma unroll
    for (int dt = 0; dt < 4; ++dt) {
      f32x4_t v = st.o[jb][dt] * inv;
      *(uint2*)(orow + 16 * dt) = make_uint2(pack2bf(v[0], v[1]), pack2bf(v[2], v[3]));
    }
  }
}

__device__ __forceinline__ void ph_chan_dft(const float* __restrict__ F, const float* __restrict__ tab, float* __restrict__ PQ) {
  for (int gid = blockIdx.x * 256 + threadIdx.x; gid < R * 512; gid += gridDim.x * 256) {
    int row = gid >> 9; int col = gid & 511; int g = col >> 6, cp = col & 63;
    const float* f = F + (size_t)row * 2048 + g * 64;
    float p = 0.f, q = 0.f;
    for (int ch = 0; ch < 64; ++ch) {
      int idx = ((ch * cp) & 63) * 128;
      float x = f[ch];
      p += x * tab[idx]; q += x * tab[8192 + idx];
    }
    PQ[(size_t)row * 1024 + col] = p;
    PQ[(size_t)row * 1024 + 512 + col] = q;
  }
}

__device__ __forceinline__ void ph_na(const bf16_t* __restrict__ F, const float* __restrict__ rpb, bf16_t* __restrict__ MIX, float* sm) {
  int lane = threadIdx.x & 63, wave = __builtin_amdgcn_readfirstlane(threadIdx.x >> 6);
  float* sq = sm + wave * 1024; float* sp = sq + 64; int* stok = (int*)(sp + 384);
  int nitems = R * 8;
  for (int item0 = blockIdx.x * 4; item0 < nitems; item0 += gridDim.x * 4) {
    int item = item0 + wave;
    int h = item & 7; int row = item >> 3;
    bool is_ctx = row >= T;
    int b = is_ctx ? (row - T) / CL : row / S;
    __syncthreads();
    sq[lane] = bf2f(F[(size_t)row * 2048 + 512 + h * 64 + lane]);
    __syncthreads();
    int r = 0, c = 0, r_start = 0, c_start = 0;
    if (!is_ctx) { int t = row % S; r = t / 64; c = t % 64; r_start = min(max(r - 4, 0), 120); c_start = min(max(c - 8, 0), 48); }
    int nk = is_ctx ? 256 : 384;
    float lg[6]; float mx = -INFINITY;
#pragma unroll
    for (int kk = 0; kk < 6; ++kk) {
      int j = kk * 64 + lane; float s = -INFINITY; int tok = 0;
      if (j < nk) {
        float bias = 0.f;
        if (!is_ctx && j < 128) {
          int kr = j >> 4, kc = j & 15; int rr = r_start + kr, cc = c_start + kc;
          tok = b * S + rr * 64 + cc;
          int dc = min(max(cc - c, -15), 15) + 15;
          bias = rpb[(h * 15 + (rr - r + 7)) * 31 + dc];
        } else {
          int l = is_ctx ? j : j - 128; tok = T + b * CL + l;
        }
        const bf16_t* kp = F + (size_t)tok * 2048 + 1024 + h * 64;
        float acc = 0.f;
#pragma unroll 8
        for (int d = 0; d < 64; ++d) acc += sq[d] * bf2f(kp[d]);
        s = acc * 0.125f + bias;
      }
      lg[kk] = s; stok[j] = tok; mx = fmaxf(mx, s);
    }
    mx = wave_max(mx);
    float sum = 0.f;
#pragma unroll
    for (int kk = 0; kk < 6; ++kk) { float e = (kk * 64 + lane < nk) ? expf(lg[kk] - mx) : 0.f; lg[kk] = e; sum += e; }
    sum = wave_sum(sum);
    float inv = 1.f / sum;
#pragma unroll
    for (int kk = 0; kk < 6; ++kk) sp[kk * 64 + lane] = lg[kk] * inv;
    __syncthreads();
    float o = 0.f;
    for (int j = 0; j < nk; ++j) o += sp[j] * bf2f(F[(size_t)stok[j] * 2048 + 1536 + h * 64 + lane]);
    MIX[(size_t)row * 1024 + 512 + h * 64 + lane] = (bf16_t)f2bf(o);
  }
}

__device__ __forceinline__ void ph_rope(float* __restrict__ F1) {
  for (int gid = blockIdx.x * 256 + threadIdx.x; gid < T * 20 * 32; gid += gridDim.x * 256) {
    int i = gid & 31; int hh = (gid >> 5) % 20; int row = gid / (32 * 20);
    int t = row % S; float rowp = (float)(t / 64), colp = (float)(t % 64);
    int fi = i & 15;
    float inv_freq = powf(10000.0f, -(float)fi / 16.0f);
    float ang = (i < 16 ? rowp : colp) * inv_freq;
    float cs = cosf(ang), sn = sinf(ang);
    float* p = F1 + (size_t)row * 1536 + hh * 64;
    float x1 = p[i], x2 = p[i + 32];
    p[i] = x1 * cs - x2 * sn;
    p[i + 32] = x1 * sn + x2 * cs;
  }
}

__device__ __forceinline__ void ph_gqa(const float* __restrict__ F1, const float* __restrict__ sink, bf16_t* __restrict__ O, float* sm) {
  int lane = threadIdx.x & 63, wave = __builtin_amdgcn_readfirstlane(threadIdx.x >> 6);
  float* sq = sm + wave * 1280; float* sp = sq + 64; int* stok = (int*)(sp + 576);
  int nitems = T * 16;
  for (int item0 = blockIdx.x * 4; item0 < nitems; item0 += gridDim.x * 4) {
    int item = item0 + wave;
    int qh = item & 15; int row = item >> 4; int kvh = qh >> 2;
    int b = row / S; int t = row % S;
    __syncthreads();
    sq[lane] = F1[(size_t)row * 1536 + qh * 64 + lane];
    __syncthreads();
    float lg[9]; float mx = -INFINITY;
#pragma unroll
    for (int kk = 0; kk < 9; ++kk) {
      int j = kk * 64 + lane; float s = -INFINITY; int tok = 0; bool valid = false;
      if (j < 257) { int pos = t - 128 + j; valid = (pos >= 0 && pos < S); tok = b * S + pos; }
      else if (j < 513) { valid = true; tok = T + b * CL + (j - 257); }
      if (valid) {
        const float* kp = F1 + (size_t)tok * 1536 + 1024 + kvh * 64;
        float acc = 0.f;
#pragma unroll 8
        for (int d = 0; d < 64; ++d) acc += sq[d] * kp[d];
        s = acc * 0.125f;
      } else tok = 0;
      lg[kk] = s; stok[j] = tok; mx = fmaxf(mx, s);
    }
    mx = wave_max(mx);
    float sk = sink[qh];
    mx = fmaxf(mx, sk);
    float sum = 0.f;
#pragma unroll
    for (int kk = 0; kk < 9; ++kk) { float e = (lg[kk] == -INFINITY) ? 0.f : expf(lg[kk] - mx); lg[kk] = e; sum += e; }
    sum = wave_sum(sum) + expf(sk - mx);
    float inv = 1.f / sum;
#pragma unroll
    for (int kk = 0; kk < 9; ++kk) sp[kk * 64 + lane] = lg[kk] * inv;
    __syncthreads();
    float o = 0.f;
    for (int j = 0; j < 513; ++j) { float p = sp[j]; if (p != 0.f) o += p * F1[(size_t)stok[j] * 1536 + 1280 + kvh * 64 + lane]; }
    O[(size_t)row * 1024 + qh * 64 + lane] = (bf16_t)f2bf(o);
  }
}

__device__ __forceinline__ void wave_argmax(float& v, int& idx) {
#pragma unroll
  for (int off = 32; off; off >>= 1) {
    float ov = __shfl_xor(v, off); int oi = __shfl_xor(idx, off);
    if (ov > v || (ov == v && oi < idx)) { v = ov; idx = oi; }
  }
}
__device__ __forceinline__ void ph_peer_select_naive(const float* __restrict__ Q, const float* __restrict__ sk, int* __restrict__ EXP,
                                     float* __restrict__ GATE, int nrows, float* sm) {
  int lane = threadIdx.x & 63, wave = __builtin_amdgcn_readfirstlane(threadIdx.x >> 6);
  float* sq = sm + wave * 640; float* tops = sq + 256; int* topi = (int*)(tops + 32);
  for (int row0 = blockIdx.x * 4; row0 < nrows; row0 += gridDim.x * 4) {
    int row = row0 + wave;
    for (int h = 0; h < 8; ++h) {
      __syncthreads();
#pragma unroll
      for (int i = 0; i < 4; ++i) sq[lane + 64 * i] = Q[(size_t)row * 2048 + h * 256 + lane + 64 * i];
      __syncthreads();
      for (int p = 0; p < 2; ++p) {
        float s0 = 0.f, s1 = 0.f;
        const float* k0 = sk + ((size_t)((h * 2 + p) * 128 + lane)) * 128;
        const float* k1 = k0 + 64 * 128;
#pragma unroll 8
        for (int d = 0; d < 128; ++d) { float qv = sq[p * 128 + d]; s0 += qv * k0[d]; s1 += qv * k1[d]; }
        for (int i = 0; i < 16; ++i) {
          float v; int idx;
          if (s0 >= s1) { v = s0; idx = lane; } else { v = s1; idx = lane + 64; }
          wave_argmax(v, idx);
          if (lane == 0) { tops[p * 16 + i] = v; topi[p * 16 + i] = idx; }
          if (idx == lane) s0 = -INFINITY;
          if (idx == lane + 64) s1 = -INFINITY;
        }
      }
      __syncthreads();
      float cs[4];
#pragma unroll
      for (int i = 0; i < 4; ++i) { int ci = lane * 4 + i; cs[i] = tops[ci >> 4] + tops[16 + (ci & 15)]; }
      float bs[16]; int be[16];
#pragma unroll
      for (int k = 0; k < 16; ++k) {
        float v = cs[0]; int idx = lane * 4;
#pragma unroll
        for (int i = 1; i < 4; ++i) if (cs[i] > v) { v = cs[i]; idx = lane * 4 + i; }
        wave_argmax(v, idx);
        bs[k] = v; be[k] = topi[idx >> 4] * 128 + topi[16 + (idx & 15)];
#pragma unroll
        for (int i = 0; i < 4; ++i) if (idx == lane * 4 + i) cs[i] = -INFINITY;
      }
      float mxs = bs[0]; float sum = 0.f;
#pragma unroll
      for (int k = 0; k < 16; ++k) { bs[k] = expf(bs[k] - mxs); sum += bs[k]; }
      float inv = 1.f / sum;
      if (lane == 0) {
#pragma unroll
        for (int k = 0; k < 16; ++k) { EXP[(size_t)row * 128 + h * 16 + k] = be[k]; GATE[(size_t)row * 128 + h * 16 + k] = bs[k] * inv; }
      }
    }
  }
}

__device__ __forceinline__ void unpack8(uint4 v, float* f) {
  f[0] = __uint_as_float(v.x << 16); f[1] = __uint_as_float(v.x & 0xffff0000u);
  f[2] = __uint_as_float(v.y << 16); f[3] = __uint_as_float(v.y & 0xffff0000u);
  f[4] = __uint_as_float(v.z << 16); f[5] = __uint_as_float(v.z & 0xffff0000u);
  f[6] = __uint_as_float(v.w << 16); f[7] = __uint_as_float(v.w & 0xffff0000u);
}
__device__ __forceinline__ void ph_peer_gather(bf16_t* __restrict__ H, const int* __restrict__ EXP, const float* __restrict__ GATE,
                               const bf16_t* __restrict__ U, const bf16_t* __restrict__ V,
                               const float* __restrict__ xin, const float* __restrict__ M, int layer,
                               const float* __restrict__ g, const float* __restrict__ bb, float* __restrict__ xout,
                               bool write_next, int nrows) {
  int lane = threadIdx.x & 63, wave = __builtin_amdgcn_readfirstlane(threadIdx.x >> 6);
  for (int row = blockIdx.x * 4 + wave; row < nrows; row += gridDim.x * 4) {
    float hreg[16];
    {
      const uint4* hp = (const uint4*)(H + (size_t)row * D + 8 * lane);
      unpack8(hp[0], hreg); unpack8(hp[64], hreg + 8);
    }
    float acc[16];
#pragma unroll
    for (int i = 0; i < 16; ++i) acc[i] = 0.f;
    int e_lo = EXP[(size_t)row * 128 + lane], e_hi = EXP[(size_t)row * 128 + 64 + lane];
    float g_lo = GATE[(size_t)row * 128 + lane], g_hi = GATE[(size_t)row * 128 + 64 + lane];
    uint4 ua[4], ub[4], va[4], vb[4];
#pragma unroll
    for (int i = 0; i < 4; ++i) {
      int e = __builtin_amdgcn_readlane(e_lo, i);
      const uint4* up = (const uint4*)(U + (size_t)e * D + 8 * lane); ua[i] = up[0]; ub[i] = up[64];
    }
#pragma unroll 1
    for (int b = 0; b < 32; ++b) {
      int k0 = 4 * b;
      int ev = (b < 16) ? e_lo : e_hi; float gv = (b < 16) ? g_lo : g_hi;
      int en = (b + 1 < 16) ? e_lo : e_hi;
      float gt[4];
#pragma unroll
      for (int i = 0; i < 4; ++i) {
        int e = __builtin_amdgcn_readlane(ev, (k0 + i) & 63);
        gt[i] = __uint_as_float(__builtin_amdgcn_readlane(__float_as_uint(gv), (k0 + i) & 63));
        const uint4* vp = (const uint4*)(V + (size_t)e * D + 8 * lane); va[i] = vp[0]; vb[i] = vp[64];
      }
      float a[4];
#pragma unroll
      for (int i = 0; i < 4; ++i) {
        float f[16]; unpack8(ua[i], f); unpack8(ub[i], f + 8);
        float sacc = 0.f;
#pragma unroll
        for (int j = 0; j < 16; ++j) sacc += f[j] * hreg[j];
        a[i] = sacc;
      }
      if (b + 1 < 32) {
#pragma unroll
        for (int i = 0; i < 4; ++i) {
          int e = __builtin_amdgcn_readlane(en, (k0 + 4 + i) & 63);
          const uint4* up = (const uint4*)(U + (size_t)e * D + 8 * lane); ua[i] = up[0]; ub[i] = up[64];
        }
      }
#pragma unroll
      for (int i = 0; i < 4; ++i) a[i] = wave_sum(a[i]);
#pragma unroll
      for (int i = 0; i < 4; ++i) {
        float w = gt[i] * 0.5f * a[i] * (1.f + erff(a[i] * 0.70710678118654752f));
        float f[16]; unpack8(va[i], f); unpack8(vb[i], f + 8);
#pragma unroll
        for (int j = 0; j < 16; ++j) acc[j] += w * f[j];
      }
    }
    const float* m = M + ((size_t)layer * 3 + mod_index(row)) * 6144;
    const float* xr = xin + (size_t)row * D;
    float v[16];
#pragma unroll
    for (int hh = 0; hh < 2; ++hh) {
      int d0 = hh * 512 + 8 * lane;
      float4 x0 = *(const float4*)(xr + d0), x1 = *(const float4*)(xr + d0 + 4);
      float4 m0 = *(const float4*)(m + 5 * D + d0), m1 = *(const float4*)(m + 5 * D + d0 + 4);
      v[hh * 8 + 0] = DN_ALPHA * x0.x + m0.x * acc[hh * 8 + 0]; v[hh * 8 + 1] = DN_ALPHA * x0.y + m0.y * acc[hh * 8 + 1];
      v[hh * 8 + 2] = DN_ALPHA * x0.z + m0.z * acc[hh * 8 + 2]; v[hh * 8 + 3] = DN_ALPHA * x0.w + m0.w * acc[hh * 8 + 3];
      v[hh * 8 + 4] = DN_ALPHA * x1.x + m1.x * acc[hh * 8 + 4]; v[hh * 8 + 5] = DN_ALPHA * x1.y + m1.y * acc[hh * 8 + 5];
      v[hh * 8 + 6] = DN_ALPHA * x1.z + m1.z * acc[hh * 8 + 6]; v[hh * 8 + 7] = DN_ALPHA * x1.w + m1.w * acc[hh * 8 + 7];
    }
    float s = 0.f;
#pragma unroll
    for (int j = 0; j < 16; ++j) s += v[j];
    float mu = wave_sum(s) * (1.f / D);
    float q = 0.f;
#pragma unroll
    for (int j = 0; j < 16; ++j) { float d = v[j] - mu; q += d * d; }
    float rs = rsqrtf(wave_sum(q) * (1.f / D) + LN_EPS);
    float y[16];
#pragma unroll
    for (int hh = 0; hh < 2; ++hh) {
      int d0 = hh * 512 + 8 * lane;
#pragma unroll
      for (int j = 0; j < 8; ++j) y[hh * 8 + j] = (v[hh * 8 + j] - mu) * rs * g[d0 + j] + bb[d0 + j];
      *(float4*)(xout + (size_t)row * D + d0) = make_float4(y[hh * 8], y[hh * 8 + 1], y[hh * 8 + 2], y[hh * 8 + 3]);
      *(float4*)(xout + (size_t)row * D + d0 + 4) = make_float4(y[hh * 8 + 4], y[hh * 8 + 5], y[hh * 8 + 6], y[hh * 8 + 7]);
    }
    if (write_next) {
      const float* mn = M + ((size_t)(layer + 1) * 3 + mod_index(row)) * 6144;
      float s2 = 0.f;
#pragma unroll
      for (int j = 0; j < 16; ++j) s2 += y[j];
      float mu2 = wave_sum(s2) * (1.f / D);
      float q2 = 0.f;
#pragma unroll
      for (int j = 0; j < 16; ++j) { float d = y[j] - mu2; q2 += d * d; }
      float rs2 = rsqrtf(wave_sum(q2) * (1.f / D) + LN_EPS);
#pragma unroll
      for (int hh = 0; hh < 2; ++hh) {
        int d0 = hh * 512 + 8 * lane;
        float o[8];
#pragma unroll
        for (int j = 0; j < 8; ++j) o[j] = (y[hh * 8 + j] - mu2) * rs2 * (1.f + mn[D + d0 + j]) + mn[d0 + j];
        *(uint4*)(H + (size_t)row * D + d0) = make_uint4(pack2bf(o[0], o[1]), pack2bf(o[2], o[3]), pack2bf(o[4], o[5]), pack2bf(o[6], o[7]));
      }
    }
  }
}


__device__ __forceinline__ void ph_quant_rows(const float* __restrict__ src, unsigned char* __restrict__ dst, float* __restrict__ scale, int nrows) {
  int lane = threadIdx.x & 63, wave = __builtin_amdgcn_readfirstlane(threadIdx.x >> 6);
  for (int row = blockIdx.x * 4 + wave; row < nrows; row += gridDim.x * 4) {
    const float4* sp = (const float4*)(src + (size_t)row * D + 16 * lane);
    float4 v0 = sp[0], v1 = sp[1], v2 = sp[2], v3 = sp[3];
    float x[16] = {v0.x, v0.y, v0.z, v0.w, v1.x, v1.y, v1.z, v1.w, v2.x, v2.y, v2.z, v2.w, v3.x, v3.y, v3.z, v3.w};
    float am = 0.f;
#pragma unroll
    for (int j = 0; j < 16; ++j) am = fmaxf(am, fabsf(x[j]));
    am = wave_max(am);
    float inv = am > 0.f ? 127.f / am : 0.f;
    unsigned wv[4];
#pragma unroll
    for (int k = 0; k < 4; ++k) {
      unsigned w = 0;
#pragma unroll
      for (int j = 0; j < 4; ++j) {
        int q = (int)rintf(x[4 * k + j] * inv) + 128;
        w |= ((unsigned)q & 0xffu) << (8 * j);
      }
      wv[k] = w;
    }
    *(uint4*)(dst + ((size_t)(row >> 14) * 8 + (lane >> 3)) * ((size_t)16384 * 128) + (size_t)(row & 16383) * 128 + 16 * (lane & 7)) = make_uint4(wv[0], wv[1], wv[2], wv[3]);
    if (lane == 0) scale[row] = am * (1.f / 127.f);
  }
}
__device__ __forceinline__ void unpack_u8x16(uint4 v, float* f) {
  unsigned w[4] = {v.x, v.y, v.z, v.w};
#pragma unroll
  for (int k = 0; k < 4; ++k) {
    f[4 * k + 0] = (float)(w[k] & 0xffu); f[4 * k + 1] = (float)((w[k] >> 8) & 0xffu);
    f[4 * k + 2] = (float)((w[k] >> 16) & 0xffu); f[4 * k + 3] = (float)(w[k] >> 24);
  }
}
__device__ __forceinline__ void ph_peer_gather8(bf16_t* __restrict__ H, const int* __restrict__ EXP, const float* __restrict__ GATE,
                               const unsigned char* __restrict__ U8, const float* __restrict__ USC,
                               const unsigned char* __restrict__ V8, const float* __restrict__ VSC,
                               const float* __restrict__ xin, const float* __restrict__ M, int layer,
                               const float* __restrict__ g, const float* __restrict__ bb, float* __restrict__ xout,
                               bool write_next, int nrows) {
  int lane = threadIdx.x & 63, wave = __builtin_amdgcn_readfirstlane(threadIdx.x >> 6);
  for (int row = blockIdx.x * 4 + wave; row < nrows; row += gridDim.x * 4) {
    float hreg[16];
    {
      const uint4* hp = (const uint4*)(H + (size_t)row * D + 16 * lane);
      unpack8(hp[0], hreg); unpack8(hp[1], hreg + 8);
    }
    float hs = 0.f;
#pragma unroll
    for (int j = 0; j < 16; ++j) hs += hreg[j];
    float hsum128 = 128.f * wave_sum(hs);
    float acc[16];
#pragma unroll
    for (int i = 0; i < 16; ++i) acc[i] = 0.f;
    float wsum = 0.f;
    int e_lo = EXP[(size_t)row * 128 + lane], e_hi = EXP[(size_t)row * 128 + 64 + lane];
    float g_lo = GATE[(size_t)row * 128 + lane], g_hi = GATE[(size_t)row * 128 + 64 + lane];
    float us_lo = USC[e_lo], us_hi = USC[e_hi], vs_lo = VSC[e_lo], vs_hi = VSC[e_hi];
    uint4 ua[8], va[8];
#pragma unroll
    for (int i = 0; i < 8; ++i) {
      int e = __builtin_amdgcn_readlane(e_lo, i);
      ua[i] = *(const uint4*)(U8 + (size_t)e * D + 16 * lane);
    }
#pragma unroll 1
    for (int b = 0; b < 16; ++b) {
      int k0 = 8 * b;
      bool lo = b < 8, lon = (b + 1) < 8;
      int ev = lo ? e_lo : e_hi; float gv = lo ? g_lo : g_hi; float usv = lo ? us_lo : us_hi; float vsv = lo ? vs_lo : vs_hi;
      int en = lon ? e_lo : e_hi;
      float gt[8], usc[8], vsc[8];
#pragma unroll
      for (int i = 0; i < 8; ++i) {
        int li = (k0 + i) & 63;
        int e = __builtin_amdgcn_readlane(ev, li);
        gt[i] = __uint_as_float(__builtin_amdgcn_readlane(__float_as_uint(gv), li));
        usc[i] = __uint_as_float(__builtin_amdgcn_readlane(__float_as_uint(usv), li));
        vsc[i] = __uint_as_float(__builtin_amdgcn_readlane(__float_as_uint(vsv), li));
        va[i] = *(const uint4*)(V8 + (size_t)e * D + 16 * lane);
      }
      float a[8];
#pragma unroll
      for (int i = 0; i < 8; ++i) {
        float f[16]; unpack_u8x16(ua[i], f);
        float sacc = 0.f;
#pragma unroll
        for (int j = 0; j < 16; ++j) sacc += f[j] * hreg[j];
        a[i] = sacc;
      }
      if (b + 1 < 16) {
#pragma unroll
        for (int i = 0; i < 8; ++i) {
          int e = __builtin_amdgcn_readlane(en, (k0 + 8 + i) & 63);
          ua[i] = *(const uint4*)(U8 + (size_t)e * D + 16 * lane);
        }
      }
#pragma unroll
      for (int i = 0; i < 8; ++i) a[i] = (wave_sum(a[i]) - hsum128) * usc[i];
#pragma unroll
      for (int i = 0; i < 8; ++i) {
        float w = gt[i] * 0.5f * a[i] * (1.f + erff(a[i] * 0.70710678118654752f)) * vsc[i];
        wsum += w;
        float f[16]; unpack_u8x16(va[i], f);
#pragma unroll
        for (int j = 0; j < 16; ++j) acc[j] += w * f[j];
      }
    }
    float corr = 128.f * wsum;
#pragma unroll
    for (int j = 0; j < 16; ++j) acc[j] -= corr;
    const float* m = M + ((size_t)layer * 3 + mod_index(row)) * 6144;
    const float* xr = xin + (size_t)row * D + 16 * lane;
    const float* m5 = m + 5 * D + 16 * lane;
    float v[16];
#pragma unroll
    for (int q4 = 0; q4 < 4; ++q4) {
      float4 x0 = *(const float4*)(xr + 4 * q4); float4 m0 = *(const float4*)(m5 + 4 * q4);
      v[4 * q4 + 0] = DN_ALPHA * x0.x + m0.x * acc[4 * q4 + 0]; v[4 * q4 + 1] = DN_ALPHA * x0.y + m0.y * acc[4 * q4 + 1];
      v[4 * q4 + 2] = DN_ALPHA * x0.z + m0.z * acc[4 * q4 + 2]; v[4 * q4 + 3] = DN_ALPHA * x0.w + m0.w * acc[4 * q4 + 3];
    }
    float s = 0.f;
#pragma unroll
    for (int j = 0; j < 16; ++j) s += v[j];
    float mu = wave_sum(s) * (1.f / D);
    float q = 0.f;
#pragma unroll
    for (int j = 0; j < 16; ++j) { float d = v[j] - mu; q += d * d; }
    float rs = rsqrtf(wave_sum(q) * (1.f / D) + LN_EPS);
    float y[16];
    {
      const float* gp = g + 16 * lane; const float* bp = bb + 16 * lane;
      float* op = xout + (size_t)row * D + 16 * lane;
#pragma unroll
      for (int q4 = 0; q4 < 4; ++q4) {
        float4 g4 = *(const float4*)(gp + 4 * q4); float4 b4 = *(const float4*)(bp + 4 * q4);
        y[4 * q4 + 0] = (v[4 * q4 + 0] - mu) * rs * g4.x + b4.x; y[4 * q4 + 1] = (v[4 * q4 + 1] - mu) * rs * g4.y + b4.y;
        y[4 * q4 + 2] = (v[4 * q4 + 2] - mu) * rs * g4.z + b4.z; y[4 * q4 + 3] = (v[4 * q4 + 3] - mu) * rs * g4.w + b4.w;
        *(float4*)(op + 4 * q4) = make_float4(y[4 * q4], y[4 * q4 + 1], y[4 * q4 + 2], y[4 * q4 + 3]);
      }
    }
    if (write_next) {
      const float* mn = M + ((size_t)(layer + 1) * 3 + mod_index(row)) * 6144 + 16 * lane;
      float s2 = 0.f;
#pragma unroll
      for (int j = 0; j < 16; ++j) s2 += y[j];
      float mu2 = wave_sum(s2) * (1.f / D);
      float q2 = 0.f;
#pragma unroll
      for (int j = 0; j < 16; ++j) { float d = y[j] - mu2; q2 += d * d; }
      float rs2 = rsqrtf(wave_sum(q2) * (1.f / D) + LN_EPS);
      float o[16];
#pragma unroll
      for (int j = 0; j < 16; ++j) o[j] = (y[j] - mu2) * rs2 * (1.f + mn[D + j]) + mn[j];
      uint4* hp = (uint4*)(H + (size_t)row * D + 16 * lane);
      hp[0] = make_uint4(pack2bf(o[0], o[1]), pack2bf(o[2], o[3]), pack2bf(o[4], o[5]), pack2bf(o[6], o[7]));
      hp[1] = make_uint4(pack2bf(o[8], o[9]), pack2bf(o[10], o[11]), pack2bf(o[12], o[13]), pack2bf(o[14], o[15]));
    }
  }
}


__device__ __forceinline__ void ph_ada2(const float* __restrict__ c, const float* __restrict__ c_ctx, const float* __restrict__ ada_w,
                                        const float* __restrict__ ada_b, float* __restrict__ M, float* sm) {
  int tid = threadIdx.x, lane = tid & 63, wave = __builtin_amdgcn_readfirstlane(tid >> 6);
  float* sv = sm;
  float* red = sm + 3072;
  bool filled = false;
  GRID_LOOP(u, 192) {
    if (!filled) {
      for (int i = tid; i < 3072; i += 256) {
        int idx = i >> 10, k = i & 1023;
        float x = idx < 2 ? c[idx * D + k] : c_ctx[k];
        sv[i] = x / (1.f + expf(-x));
      }
      filled = true;
    }
    __syncthreads();
    int layer = u / 96, c0 = (u % 96) * 64;
    const float* w = ada_w + (size_t)layer * D * 6144 + c0 + lane;
    float a0 = 0.f, a1 = 0.f, a2 = 0.f;
    int kb = wave * 256;
#pragma unroll 16
    for (int k = 0; k < 256; ++k) {
      float wv = w[(size_t)(kb + k) * 6144];
      a0 += sv[kb + k] * wv; a1 += sv[1024 + kb + k] * wv; a2 += sv[2048 + kb + k] * wv;
    }
    red[(wave * 3 + 0) * 64 + lane] = a0; red[(wave * 3 + 1) * 64 + lane] = a1; red[(wave * 3 + 2) * 64 + lane] = a2;
    __syncthreads();
    if (wave < 3) {
      float r = red[(0 * 3 + wave) * 64 + lane] + red[(1 * 3 + wave) * 64 + lane] + red[(2 * 3 + wave) * 64 + lane] + red[(3 * 3 + wave) * 64 + lane];
      M[((size_t)layer * 3 + wave) * 6144 + c0 + lane] = r + ada_b[layer * 6144 + c0 + lane];
    }
  }
  __syncthreads();
}

__device__ __forceinline__ void ph_post_mod(const float* __restrict__ xa, const float* __restrict__ xb, const bf16_t* __restrict__ Y,
                                            const float* __restrict__ M, int layer, int jres, int mlayer, int jshift, int jscale, bool do_mod,
                                            const float* __restrict__ g, const float* __restrict__ bb,
                                            float* __restrict__ xout, bf16_t* __restrict__ H, int nrows) {
  int lane = threadIdx.x & 63, wave = __builtin_amdgcn_readfirstlane(threadIdx.x >> 6);
  for (int row = blockIdx.x * 4 + wave; row < nrows; row += gridDim.x * 4) {
    const float* xr = (row < T ? xa + (size_t)row * D : xb + (size_t)(row - T) * D) + 16 * lane;
    const float* m = M + ((size_t)layer * 3 + mod_index(row)) * 6144 + 16 * lane;
    float yv[16];
    {
      const uint4* yp = (const uint4*)(Y + (size_t)row * D + 16 * lane);
      unpack8(yp[0], yv); unpack8(yp[1], yv + 8);
    }
    float v[16];
#pragma unroll
    for (int q4 = 0; q4 < 4; ++q4) {
      float4 x0 = *(const float4*)(xr + 4 * q4); float4 m0 = *(const float4*)(m + jres * D + 4 * q4);
      v[4 * q4 + 0] = DN_ALPHA * x0.x + m0.x * yv[4 * q4 + 0]; v[4 * q4 + 1] = DN_ALPHA * x0.y + m0.y * yv[4 * q4 + 1];
      v[4 * q4 + 2] = DN_ALPHA * x0.z + m0.z * yv[4 * q4 + 2]; v[4 * q4 + 3] = DN_ALPHA * x0.w + m0.w * yv[4 * q4 + 3];
    }
    float s = 0.f;
#pragma unroll
    for (int j = 0; j < 16; ++j) s += v[j];
    float mu = wave_sum(s) * (1.f / D);
    float q = 0.f;
#pragma unroll
    for (int j = 0; j < 16; ++j) { float d = v[j] - mu; q += d * d; }
    float rs = rsqrtf(wave_sum(q) * (1.f / D) + LN_EPS);
    float y[16];
    {
      const float* gp = g + 16 * lane; const float* bp = bb + 16 * lane;
      float* op = xout + (size_t)row * D + 16 * lane;
#pragma unroll
      for (int q4 = 0; q4 < 4; ++q4) {
        float4 g4 = *(const float4*)(gp + 4 * q4); float4 b4 = *(const float4*)(bp + 4 * q4);
        y[4 * q4 + 0] = (v[4 * q4 + 0] - mu) * rs * g4.x + b4.x; y[4 * q4 + 1] = (v[4 * q4 + 1] - mu) * rs * g4.y + b4.y;
        y[4 * q4 + 2] = (v[4 * q4 + 2] - mu) * rs * g4.z + b4.z; y[4 * q4 + 3] = (v[4 * q4 + 3] - mu) * rs * g4.w + b4.w;
        *(float4*)(op + 4 * q4) = make_float4(y[4 * q4], y[4 * q4 + 1], y[4 * q4 + 2], y[4 * q4 + 3]);
      }
    }
    if (do_mod) {
      const float* mm = M + ((size_t)mlayer * 3 + mod_index(row)) * 6144 + 16 * lane;
      float s2 = 0.f;
#pragma unroll
      for (int j = 0; j < 16; ++j) s2 += y[j];
      float mu2 = wave_sum(s2) * (1.f / D);
      float q2 = 0.f;
#pragma unroll
      for (int j = 0; j < 16; ++j) { float d = y[j] - mu2; q2 += d * d; }
      float rs2 = rsqrtf(wave_sum(q2) * (1.f / D) + LN_EPS);
      float o[16];
#pragma unroll
      for (int j = 0; j < 16; ++j) o[j] = (y[j] - mu2) * rs2 * (1.f + mm[jscale * D + j]) + mm[jshift * D + j];
      uint4* hp = (uint4*)(H + (size_t)row * D + 16 * lane);
      hp[0] = make_uint4(pack2bf(o[0], o[1]), pack2bf(o[2], o[3]), pack2bf(o[4], o[5]), pack2bf(o[6], o[7]));
      hp[1] = make_uint4(pack2bf(o[8], o[9]), pack2bf(o[10], o[11]), pack2bf(o[12], o[13]), pack2bf(o[14], o[15]));
    }
  }
}


template <int CTRL> __device__ __forceinline__ float dpp_add(float x) { return x + dpp_mov<CTRL>(x); }
__device__ __forceinline__ float sum8(float v) {
  v = dpp_add<0xB1>(v); v = dpp_add<0x4E>(v); v = dpp_add<0x141>(v); return v;
}
typedef _Float16 half2_t __attribute__((ext_vector_type(2)));
__device__ __forceinline__ float dot2h(unsigned a, unsigned b, float c) {
  return __builtin_amdgcn_fdot2(__builtin_bit_cast(half2_t, a), __builtin_bit_cast(half2_t, b), c, false);
}
__device__ __forceinline__ unsigned pkh(float a, float b) { return __builtin_bit_cast(unsigned, __builtin_amdgcn_cvt_pkrtz(a, b)); }
__device__ __forceinline__ void load_e16(const int* __restrict__ EXP, int t, int g8, int (&e)[16]) {
  const int4* ep = (const int4*)(EXP + (size_t)t * 128 + 16 * g8);
  int4 a = ep[0], b = ep[1], c = ep[2], d = ep[3];
  e[0] = a.x; e[1] = a.y; e[2] = a.z; e[3] = a.w; e[4] = b.x; e[5] = b.y; e[6] = b.z; e[7] = b.w;
  e[8] = c.x; e[9] = c.y; e[10] = c.z; e[11] = c.w; e[12] = d.x; e[13] = d.y; e[14] = d.z; e[15] = d.w;
}
#define U_TOKEN(tt, UV, UVN, EUSE, ELD, HUSE, HLD) { \
    int tnn_ = min((tt) + 2 * st, nrows - 1); \
    load_e16(EXP, tnn_, g8, ELD); \
    HLD[0] = *(const uint4*)(hb + (size_t)tnn_ * D); HLD[1] = *(const uint4*)(hb + (size_t)tnn_ * D + 8); \
    __builtin_amdgcn_sched_barrier(0); \
    _Pragma("unroll") for (int i = 0; i < 16; ++i) UVN[i] = *(const uint4*)(ubs + (((unsigned)EUSE[i] << 7) + loff)); \
    __builtin_amdgcn_sched_barrier(0); \
    float h16[16]; unpack8(HUSE[0], h16); unpack8(HUSE[1], h16 + 8); \
    unsigned hh[8]; float hs = 0.f; \
    _Pragma("unroll") for (int j = 0; j < 8; ++j) { hh[j] = pkh(h16[2 * j], h16[2 * j + 1]); hs = dot2h(hh[j], 0x3C003C00u, hs); } \
    float hs1152 = 1152.f * sum8(hs); \
    float k0 = 0.f, k1 = 0.f; \
    _Pragma("unroll") for (int i = 0; i < 16; ++i) { \
      unsigned dw[4] = {UV[i].x, UV[i].y, UV[i].z, UV[i].w}; \
      float p = 0.f, p2 = 0.f; \
      _Pragma("unroll") for (int k = 0; k < 4; ++k) { \
        p = dot2h(__builtin_amdgcn_perm(dw[k], 0x64646464u, 0x00050004u), hh[2 * k], p); \
        p2 = dot2h(__builtin_amdgcn_perm(dw[k], 0x64646464u, 0x00070006u), hh[2 * k + 1], p2); } \
      p = sum8(p + p2) - hs1152; \
      if ((i >> 1) == j8) { if (i & 1) k1 = p; else k0 = p; } } \
    *(float2*)(PA + ((size_t)(tt) * 8 + x) * 128 + 16 * g8 + 2 * j8) = make_float2(k0, k1); }
__device__ __forceinline__ void ph_peer_u(const bf16_t* __restrict__ H, const int* __restrict__ EXP, const unsigned char* __restrict__ U8,
                                          float* __restrict__ PA, int nrows) {
  int lane = threadIdx.x & 63, wave = __builtin_amdgcn_readfirstlane(threadIdx.x >> 6);
  int x = blockIdx.x & 7; int nb8 = gridDim.x >> 3;
  if ((int)(blockIdx.x >> 3) >= nb8) return;
  int j8 = lane & 7, g8 = lane >> 3;
  const int st = nb8 * 4;
  int t = (blockIdx.x >> 3) * 4 + wave;
  if (t >= nrows) return;
  const unsigned char* ubs = U8 + (size_t)x * ((size_t)16384 * 128);
  const unsigned loff = 16u * (unsigned)j8;
  const bf16_t* hb = H + 128 * x + 16 * j8;
  int eA[16], eB[16]; uint4 hA[2], hB[2], uvA[16], uvB[16];
  {
    int e0[16]; load_e16(EXP, t, g8, e0);
#pragma unroll
    for (int i = 0; i < 16; ++i) uvA[i] = *(const uint4*)(ubs + (((unsigned)e0[i] << 7) + loff));
    hA[0] = *(const uint4*)(hb + (size_t)t * D); hA[1] = *(const uint4*)(hb + (size_t)t * D + 8);
    int tn = min(t + st, nrows - 1);
    load_e16(EXP, tn, g8, eA);
    hB[0] = *(const uint4*)(hb + (size_t)tn * D); hB[1] = *(const uint4*)(hb + (size_t)tn * D + 8);
  }
#pragma unroll 1
  for (; t < nrows; t += 2 * st) {
    uint4 hC[2];
    U_TOKEN(t, uvA, uvB, eA, eB, hA, hC)
    if (t + st < nrows) {
      U_TOKEN(t + st, uvB, uvA, eB, eA, hB, hA)
    }
    hB[0] = hA[0]; hB[1] = hA[1]; hA[0] = hC[0]; hA[1] = hC[1];
  }
}
__device__ __forceinline__ void ph_peer_w(const float* __restrict__ PA, const int* __restrict__ EXP, const float* __restrict__ GATE,
                                          const float* __restrict__ USC, const float* __restrict__ VSC, unsigned* __restrict__ WH, int nrows) {
  int lane = threadIdx.x & 63, wave = __builtin_amdgcn_readfirstlane(threadIdx.x >> 6);
  for (int t = blockIdx.x * 4 + wave; t < nrows; t += gridDim.x * 4) {
    int2 e = *(const int2*)(EXP + (size_t)t * 128 + 2 * lane);
    float2 gt = *(const float2*)(GATE + (size_t)t * 128 + 2 * lane);
    float a0 = 0.f, a1 = 0.f;
#pragma unroll
    for (int xs = 0; xs < 8; ++xs) { float2 p = *(const float2*)(PA + ((size_t)t * 8 + xs) * 128 + 2 * lane); a0 += p.x; a1 += p.y; }
    a0 *= USC[e.x]; a1 *= USC[e.y];
    float w0 = gt.x * 0.5f * a0 * (1.f + erff(a0 * 0.70710678118654752f)) * VSC[e.x];
    float w1 = gt.y * 0.5f * a1 * (1.f + erff(a1 * 0.70710678118654752f)) * VSC[e.y];
    WH[(size_t)t * 64 + lane] = pkh(w0 * 1024.f, w1 * 1024.f);
  }
}
__device__ __forceinline__ void load_w16(const float* __restrict__ W, int t, int g8, float (&w)[16]) {
  const float4* wp = (const float4*)(W + (size_t)t * 128 + 16 * g8);
  float4 wa = wp[0], wb = wp[1], wc = wp[2], wd = wp[3];
  w[0] = wa.x; w[1] = wa.y; w[2] = wa.z; w[3] = wa.w; w[4] = wb.x; w[5] = wb.y; w[6] = wb.z; w[7] = wb.w;
  w[8] = wc.x; w[9] = wc.y; w[10] = wc.z; w[11] = wc.w; w[12] = wd.x; w[13] = wd.y; w[14] = wd.z; w[15] = wd.w;
}
#define V_TOKEN(tt, VV, VVN, EUSE, ELD, WUSE, WLD) { \
    int tnn_ = min((tt) + 2 * st, nrows - 1); \
    load_e16(EXP, tnn_, g8, ELD); \
    WLD[0] = *(const uint4*)(WH + (size_t)tnn_ * 64 + 8 * g8); WLD[1] = *(const uint4*)(WH + (size_t)tnn_ * 64 + 8 * g8 + 4); \
    __builtin_amdgcn_sched_barrier(0); \
    _Pragma("unroll") for (int i = 0; i < 16; ++i) VVN[i] = *(const uint4*)(vbs + (((unsigned)EUSE[i] << 7) + loff)); \
    __builtin_amdgcn_sched_barrier(0); \
    float acc[16]; \
    _Pragma("unroll") for (int j = 0; j < 16; ++j) acc[j] = 0.f; \
    unsigned wh[8] = {WUSE[0].x, WUSE[0].y, WUSE[0].z, WUSE[0].w, WUSE[1].x, WUSE[1].y, WUSE[1].z, WUSE[1].w}; float wsum = 0.f; \
    _Pragma("unroll") for (int m = 0; m < 8; ++m) wsum = dot2h(wh[m], 0x3C003C00u, wsum); \
    _Pragma("unroll") for (int m = 0; m < 8; ++m) { \
      unsigned ra[4] = {VV[2 * m].x, VV[2 * m].y, VV[2 * m].z, VV[2 * m].w}; \
      unsigned rb[4] = {VV[2 * m + 1].x, VV[2 * m + 1].y, VV[2 * m + 1].z, VV[2 * m + 1].w}; \
      _Pragma("unroll") for (int k = 0; k < 4; ++k) _Pragma("unroll") for (int j = 0; j < 4; ++j) { \
          unsigned pr = __builtin_amdgcn_perm(ra[k], rb[k], 0x0C000C00u | ((unsigned)j << 16) | (unsigned)(4 + j)) | 0x64006400u; \
          acc[4 * k + j] = dot2h(pr, wh[m], acc[4 * k + j]); } } \
    { float v = wsum; v += dpp_mov<0x128>(v); wsum = 1152.f * xrow16_sum(v); } \
    _Pragma("unroll") for (int j = 0; j < 16; ++j) { float v = acc[j]; v += dpp_mov<0x128>(v); acc[j] = (xrow16_sum(v) - wsum) * (1.f / 1024.f); } \
    if (g8 == 0) { \
      uint4* fp = (uint4*)(F + (size_t)(tt) * D + 128 * x + 16 * j8); \
      fp[0] = make_uint4(pack2bf(acc[0], acc[1]), pack2bf(acc[2], acc[3]), pack2bf(acc[4], acc[5]), pack2bf(acc[6], acc[7])); \
      fp[1] = make_uint4(pack2bf(acc[8], acc[9]), pack2bf(acc[10], acc[11]), pack2bf(acc[12], acc[13]), pack2bf(acc[14], acc[15])); } }
__device__ __forceinline__ void ph_peer_v(const unsigned* __restrict__ WH, const int* __restrict__ EXP,
                                          const unsigned char* __restrict__ V8, bf16_t* __restrict__ F, int nrows) {
  int lane = threadIdx.x & 63, wave = __builtin_amdgcn_readfirstlane(threadIdx.x >> 6);
  int x = blockIdx.x & 7; int nb8 = gridDim.x >> 3;
  if ((int)(blockIdx.x >> 3) >= nb8) return;
  int j8 = lane & 7, g8 = lane >> 3;
  const int st = nb8 * 4;
  int t = (blockIdx.x >> 3) * 4 + wave;
  if (t >= nrows) return;
  const unsigned char* vbs = V8 + (size_t)x * ((size_t)16384 * 128);
  const unsigned loff = 16u * (unsigned)j8;
  int eA[16], eB[16]; uint4 wA[2], wB[2], vvA[16], vvB[16];
  {
    int e0[16]; load_e16(EXP, t, g8, e0);
#pragma unroll
    for (int i = 0; i < 16; ++i) vvA[i] = *(const uint4*)(vbs + (((unsigned)e0[i] << 7) + loff));
    wA[0] = *(const uint4*)(WH + (size_t)t * 64 + 8 * g8); wA[1] = *(const uint4*)(WH + (size_t)t * 64 + 8 * g8 + 4);
    int tn = min(t + st, nrows - 1);
    load_e16(EXP, tn, g8, eA);
    wB[0] = *(const uint4*)(WH + (size_t)tn * 64 + 8 * g8); wB[1] = *(const uint4*)(WH + (size_t)tn * 64 + 8 * g8 + 4);
  }
#pragma unroll 1
  for (; t < nrows; t += 2 * st) {
    uint4 wC[2];
    V_TOKEN(t, vvA, vvB, eA, eB, wA, wC)
    if (t + st < nrows) {
      V_TOKEN(t + st, vvB, vvA, eB, eA, wB, wA)
    }
    wB[0] = wA[0]; wB[1] = wA[1]; wA[0] = wC[0]; wA[1] = wC[1];
  }
}

#define XB_TMO      128
#define XB_XCNT(j)  (256  + 64 * (j))
#define XB_XSUB(j)  (1280 + 64 * (j))
#define XB_XGEN(j)  (2304 + 64 * (j))
#define XB_TOP      3328
#define XB_TOPGEN   3392
#define XCD_BAR_WORDS 3456
#define XB_SPIN_CAP (1u << 22)
#define LAS __attribute__((address_space(3)))
__device__ __forceinline__ unsigned xb_ld(unsigned* p)              { return __hip_atomic_load(p, __ATOMIC_RELAXED, __HIP_MEMORY_SCOPE_AGENT); }
__device__ __forceinline__ unsigned xb_add(unsigned* p, unsigned v) { return __hip_atomic_fetch_add(p, v, __ATOMIC_RELAXED, __HIP_MEMORY_SCOPE_AGENT); }
__device__ __forceinline__ unsigned xb_xcc_id() { return (unsigned)__builtin_amdgcn_s_getreg((3 << 11) | 20) & 0xFu; }
#define XB_SPIN(cond, bar) do { unsigned _sp = 0; while (cond) { __builtin_amdgcn_s_sleep(1); \
    if ((++_sp & 255u) == 0u) { if (xb_ld(&(bar)[XB_TMO])) break; if (_sp > XB_SPIN_CAP) { atomicAdd(&(bar)[XB_TMO], 1u); break; } } } } while (0)
struct XcdBarrier { unsigned* bar; unsigned x; volatile LAS unsigned* st; };
__device__ __forceinline__ XcdBarrier xcd_barrier_post(unsigned* bar, volatile LAS unsigned* st) {
  XcdBarrier b; b.bar = bar; b.x = xb_xcc_id(); b.st = st;
  if (threadIdx.x == 0) (void)xb_add(&bar[XB_XCNT(b.x)], 1u);
  return b;
}
__device__ __forceinline__ void xcd_barrier_complete(unsigned* bar, unsigned x, unsigned& nloc, unsigned& nx) {
  const unsigned G = gridDim.x * gridDim.y * gridDim.z;
  unsigned sum, cnt, mine, sp = 0u;
  for (;;) {
    sum = 0u; cnt = 0u; mine = 0u;
#pragma unroll
    for (unsigned j = 0; j < 16; ++j) { const unsigned c = xb_ld(&bar[XB_XCNT(j)]); sum += c; cnt += (c > 0u) ? 1u : 0u; mine = (j == x) ? c : mine; }
    if (sum == G) break;
    __builtin_amdgcn_s_sleep(1);
    if ((++sp & 255u) == 0u) { if (xb_ld(&bar[XB_TMO])) break; if (sp > XB_SPIN_CAP) { atomicAdd(&bar[XB_TMO], 1u); break; } }
  }
  nloc = mine > 0u ? mine : 1u; nx = cnt > 0u ? cnt : 1u;
}
__device__ __forceinline__ void xcd_barrier(const XcdBarrier& b) {
  asm volatile("s_waitcnt vmcnt(0)" ::: "memory");
  __syncthreads();
  if (threadIdx.x == 0) {
    unsigned* bar = b.bar;
    __builtin_amdgcn_s_waitcnt(0);
    unsigned nloc = b.st[0], nx = b.st[1];
    if (nloc == 0u) { xcd_barrier_complete(bar, b.x, nloc, nx); b.st[0] = nloc; b.st[1] = nx; }
    const unsigned old = xb_add(&bar[XB_XSUB(b.x)], 1u);
    const unsigned gen = old / nloc;
    if (old + 1u == (gen + 1u) * nloc) {
      __builtin_amdgcn_fence(__ATOMIC_RELEASE, "agent");
      asm volatile("s_waitcnt vmcnt(0)" ::: "memory");
      const unsigned og = xb_add(&bar[XB_TOP], 1u);
      const unsigned tg = og / nx;
      if (og + 1u == (tg + 1u) * nx) xb_add(&bar[XB_TOPGEN], 1u);
      else XB_SPIN(xb_ld(&bar[XB_TOPGEN]) == tg, bar);
      __builtin_amdgcn_fence(__ATOMIC_ACQUIRE, "agent");
      xb_add(&bar[XB_XGEN(b.x)], 1u);
      asm volatile("s_waitcnt vmcnt(0)" ::: "memory");
    } else {
      XB_SPIN(xb_ld(&bar[XB_XGEN(b.x)]) == gen, bar);
      __builtin_amdgcn_fence(__ATOMIC_ACQUIRE, "agent");
      asm volatile("s_waitcnt vmcnt(0)" ::: "memory");
    }
  }
  __syncthreads();
}

constexpr int SMEM_BYTES = 65536;
#ifndef PHMASK
#define PHMASK 0xFFFFFFFFFFFFFFFFull
#endif
#ifndef PHDUP
#define PHDUP 0ull
#endif
#define PH(n, ...) if constexpr ((((unsigned long long)(PHMASK)) >> (n)) & 1ull) { __VA_ARGS__; if constexpr ((((unsigned long long)(PHDUP)) >> (n)) & 1ull) { xcd_barrier(xbar); __VA_ARGS__; } }

__global__ __launch_bounds__(256, 2) void mega(Params p) {
  __shared__ __attribute__((aligned(16))) char smem_raw[SMEM_BYTES];
  __shared__ uint4 xb_words;
  if (threadIdx.x == 0) xb_words = make_uint4(0u, 0u, 0u, 0u);
  __syncthreads();
  XcdBarrier xbar = xcd_barrier_post((unsigned*)((char*)p.ws + OFF_BAR), (volatile LAS unsigned*)&xb_words);
  float* smem = (float*)smem_raw;
  const float* x = p.in[0]; const float* c = p.in[1]; const float* ctx = p.in[2]; const float* c_ctx = p.in[3];
  const float* ada_w = p.in[4]; const float* ada_b = p.in[5]; const float* ln_g = p.in[6]; const float* ln_b = p.in[7];
  const float* even_w_in = p.in[8]; const float* even_w_out = p.in[9]; const float* rpb = p.in[10];
  const float* odd_w_in = p.in[11]; const float* odd_w_out = p.in[12]; const float* sink = p.in[13];
  const float* peer_wq = p.in[14]; const float* peer_sk = p.in[15]; const float* peer_u = p.in[16]; const float* peer_v = p.in[17];
  char* ws = (char*)p.ws;
  float* TAB = (float*)(ws + OFF_TAB); float* Mm = (float*)(ws + OFF_M);
  bf16_t* WIN0 = (bf16_t*)(ws + OFF_WIN0); bf16_t* WOUT0 = (bf16_t*)(ws + OFF_WOUT0);
  bf16_t* WIN1 = (bf16_t*)(ws + OFF_WIN1); bf16_t* WOUT1 = (bf16_t*)(ws + OFF_WOUT1);
  bf16_t* WQ = (bf16_t*)(ws + OFF_WQ); bf16_t* SKB = (bf16_t*)(ws + OFF_SK);
  unsigned char* U8 = (unsigned char*)(ws + OFF_UB); unsigned char* V8 = (unsigned char*)(ws + OFF_VB);
  float* USC = (float*)(ws + OFF_USC); float* VSC = USC + 2 * 16384;
  bf16_t* AB = (bf16_t*)(ws + OFF_AB);
  bf16_t* FD1 = (bf16_t*)(ws + OFF_FT); bf16_t* FD3 = FD1 + 256 * 128; bf16_t* FDC = FD3 + 128 * 128;
  bf16_t* A1 = (bf16_t*)(ws + OFF_A1); bf16_t* VT0 = (bf16_t*)(ws + OFF_VT0); bf16_t* FQKV = (bf16_t*)(ws + OFF_BF);
  float* BF_ = (float*)(ws + OFF_BF); float* BY = (float*)(ws + OFF_BY);
  float* X1 = (float*)(ws + OFF_X1); float* X2 = (float*)(ws + OFF_X2);
  float* RT = TAB + 16384;
  bf16_t* Q1 = (bf16_t*)(ws + OFF_BF); bf16_t* K1 = Q1 + (size_t)T * 1024; bf16_t* VT1 = K1 + (size_t)R * 256;
  bf16_t* YB = (bf16_t*)(ws + OFF_BY + (size_t)2 * R * 128 * 4);
  float* PAB = (float*)(ws + OFF_BF); bf16_t* FB = (bf16_t*)(ws + OFF_BF + (size_t)R * 8 * 128 * 4);
  float* WB = (float*)(ws + OFF_BF + (size_t)R * 8 * 128 * 4 + (size_t)R * 1024 * 2); float* CORRB = WB + (size_t)R * 128;
  int* EXPB = (int*)(ws + OFF_BY); float* GATEB = (float*)(ws + OFF_BY + (size_t)R * 128 * 4);
  float* out = p.out;

  PH(0, ph_tables(TAB); ph_rope_table(RT))
  PH(1, ph_fft_tables(FD1, FD3, FDC))
  PH(2, ph_ada2(c, c_ctx, ada_w, ada_b, Mm, smem))
  PH(3, ph_transpose_w(even_w_in, 1024, 2048, WIN0, smem))
  PH(4, ph_transpose_w(even_w_out, 1024, 1024, WOUT0, smem))
  PH(5, ph_transpose_w(odd_w_in, 1024, 1536, WIN1, smem))
  PH(6, ph_transpose_w(odd_w_out, 1024, 1024, WOUT1, smem))
  PH(7, ph_transpose_w(peer_wq, 1024, 2048, WQ, smem))
  PH(8, ph_transpose_w(peer_wq + (size_t)1024 * 2048, 1024, 2048, WQ + (size_t)2048 * 1024, smem))
  PH(9, ph_quant_rows(peer_u, U8, USC, 2 * 16384))
  PH(10, ph_quant_rows(peer_v, V8, VSC, 2 * 16384))
  PH(11, ph_convert(peer_sk, SKB, (size_t)2 * 8 * 2 * 128 * 128 / 8))
  xcd_barrier(xbar);
  PH(12, ph_modulate(x, ctx, Mm, 0, 0, 1, AB, R, smem))
  xcd_barrier(xbar);
  PH(13, ph_gemm_bf16(AB, 1024, WIN0, 1024, R, 2048, 1024, EpiQKV0{FQKV, VT0}, smem_raw))
  xcd_barrier(xbar);
  PH(14, { GRID_LOOP(u, NB * 64 * 8) fft1_unit(u, FQKV, FD1, TAB, A1, smem_raw); })
  PH(15, { int lane = threadIdx.x & 63, wave = __builtin_amdgcn_readfirstlane(threadIdx.x >> 6);
           __syncthreads();
           for (int i = threadIdx.x; i < 8 * 15 * 31; i += 256) smem[i] = rpb[i] * 1.4426950408889634f;
           __syncthreads();
           for (int bu = blockIdx.x; bu < 512 + 64; bu += gridDim.x) {
             if (bu < 512) { int h = bu & 7, rg = (bu >> 3) & 31, bb = bu >> 8;
               na_unit(bb, h, rg * 4 + wave, FQKV, VT0, VT0 + (size_t)NB * 8 * 64 * S, smem, AB, lane); }
             else { int cu = bu - 512; int h = cu & 7, qg = (cu >> 3) & 3, bb = cu >> 5;
               attn_unit<1, 1, 2>(bb, h, 0, 0, qg * 4 + wave, FQKV + 512, 2048, FQKV + 1024, 2048, VT0, VT0 + (size_t)NB * 8 * 64 * S, 8, smem, nullptr, AB + 512, 1024, lane); } } })
  xcd_barrier(xbar);
  PH(16, { GRID_LOOP(u, NB * 128 * 8 + NB * 4 * 8) { if (u < NB * 128 * 8) fft3_unit(u, 0, FQKV, A1, FD3, FDC, TAB, AB, smem_raw); else fft3_unit(u - NB * 128 * 8, 1, FQKV, A1, FD3, FDC, TAB, AB, smem_raw); } })
  xcd_barrier(xbar);
  PH(17, ph_gemm_bf16(AB, 1024, WOUT0, 1024, R, 1024, 1024, EpiBf16{YB, 1024}, smem_raw))
  xcd_barrier(xbar);
  PH(18, ph_post_mod(x, ctx, YB, Mm, 0, 2, 0, 3, 4, true, ln_g + 0, ln_b + 0, X1, AB, R))
  xcd_barrier(xbar);
  PH(21, ph_peer_select(AB, WQ, SKB, EXPB, GATEB, R, smem_raw))
  xcd_barrier(xbar);
  PH(22, ph_peer_u(AB, EXPB, U8, PAB, R))
  xcd_barrier(xbar);
  PH(32, ph_peer_w(PAB, EXPB, GATEB, USC, VSC, (unsigned*)WB, R))
  xcd_barrier(xbar);
  PH(33, ph_peer_v((const unsigned*)WB, EXPB, V8, FB, R))
  xcd_barrier(xbar);
  PH(34, ph_post_mod(X1, X1 + (size_t)T * D, FB, Mm, 0, 5, 1, 0, 1, true, ln_g + 1024, ln_b + 1024, X2, AB, R))
  xcd_barrier(xbar);
  PH(23, ph_gemm_bf16(AB, 1024, WIN1, 1024, R, 1536, 1024, EpiQKV1{Q1, K1, VT1, RT}, smem_raw))
  xcd_barrier(xbar);
  PH(25, { int lane = threadIdx.x & 63, wave = __builtin_amdgcn_readfirstlane(threadIdx.x >> 6);
           for (int bu = blockIdx.x; bu < 1024; bu += gridDim.x) { int kvh = bu & 3, bb = (bu >> 2) & 1, qg = bu >> 3;
             attn_unit<4, 2, 1>(bb, kvh, 0, 0, qg * 4 + wave, Q1, 1024, K1, 256, VT1, VT1 + (size_t)NB * 4 * 64 * S, 4, nullptr, sink, AB, 1024, lane); } })
  xcd_barrier(xbar);
  PH(26, ph_gemm_bf16(AB, 1024, WOUT1, 1024, T, 1024, 1024, EpiBf16{YB, 1024}, smem_raw))
  xcd_barrier(xbar);
  PH(27, ph_post_mod(X2, X2, YB, Mm, 1, 2, 1, 3, 4, true, ln_g + 2048, ln_b + 2048, X1, AB, T))
  xcd_barrier(xbar);
  PH(30, ph_peer_select(AB, WQ + (size_t)2048 * 1024, SKB + (size_t)8 * 2 * 128 * 128, EXPB, GATEB, T, smem_raw))
  xcd_barrier(xbar);
  PH(31, ph_peer_u(AB, EXPB, U8 + (size_t)16384 * 1024, PAB, T))
  xcd_barrier(xbar);
  PH(35, ph_peer_w(PAB, EXPB, GATEB, USC + 16384, VSC + 16384, (unsigned*)WB, T))
  xcd_barrier(xbar);
  PH(36, ph_peer_v((const unsigned*)WB, EXPB, V8 + (size_t)16384 * 1024, FB, T))
  xcd_barrier(xbar);
  PH(37, ph_post_mod(X1, X1, FB, Mm, 1, 5, 1, 0, 1, false, ln_g + 3072, ln_b + 3072, out, AB, T))
}

}

extern "C" void kernel_launch(void* const* d_in, const int* in_sizes, int n_in, void* d_out, int out_size, void* d_ws,
                              size_t ws_size, hipStream_t stream) {
  static int grid_blocks = 0;
  if (!grid_blocks) {
    int dev = 0, cus = 0, per_cu = 0;
    hipGetDevice(&dev);
    hipDeviceGetAttribute(&cus, hipDeviceAttributeMultiprocessorCount, dev);
    hipOccupancyMaxActiveBlocksPerMultiprocessor(&per_cu, (const void*)mega, 256, 0);
    if (per_cu > 2) per_cu = 2;
    if (per_cu < 1) per_cu = 1;
    grid_blocks = cus * per_cu;
  }
  Params p{};
  for (int i = 0; i < 18; ++i) p.in[i] = (const float*)d_in[i];
  p.out = (float*)d_out;
  p.ws = (float*)d_ws;
  (void)hipMemsetAsync((char*)d_ws + OFF_BAR, 0, XCD_BAR_WORDS_C * 4, stream);
  void* args[] = {&p};
  hipError_t e = hipLaunchCooperativeKernel((const void*)mega, dim3(grid_blocks), dim3(256), args, 0, stream);
  if (e != hipSuccess) fprintf(stderr, "cooperative launch failed: %s (grid %d)\n", hipGetErrorString(e), grid_blocks);
}
```

```cpp
#include <hip/hip_runtime.h>
#include <hip/hip_bf16.h>
#include <stdint.h>
#include <math.h>
#include <stdio.h>
#include <hip/hip_cooperative_groups.h>
namespace cg = cooperative_groups;

namespace {

constexpr int D = 1024;
constexpr int NB = 2;
constexpr int S = 8192;
constexpr int T = NB * S;
constexpr int CL = 256;
constexpr int TC = NB * CL;
constexpr int R = T + TC;
constexpr float DN_ALPHA = 1.4142135623730951f;
constexpr float LN_EPS = 1e-6f;

template <int CTRL> __device__ __forceinline__ float dpp_mov(float x) {
  return __builtin_bit_cast(float, __builtin_amdgcn_mov_dpp(__builtin_bit_cast(int, x), CTRL, 0xf, 0xf, true));
}
__device__ __forceinline__ float xrow16_max(float x) {
  auto s = __builtin_amdgcn_permlane16_swap(__float_as_uint(x), __float_as_uint(x), false, false);
  x = fmaxf(__uint_as_float(s[0]), __uint_as_float(s[1]));
  auto t = __builtin_amdgcn_permlane32_swap(__float_as_uint(x), __float_as_uint(x), false, false);
  return fmaxf(__uint_as_float(t[0]), __uint_as_float(t[1]));
}
__device__ __forceinline__ float xrow16_sum(float x) {
  auto s = __builtin_amdgcn_permlane16_swap(__float_as_uint(x), __float_as_uint(x), false, false);
  x = __uint_as_float(s[0]) + __uint_as_float(s[1]);
  auto t = __builtin_amdgcn_permlane32_swap(__float_as_uint(x), __float_as_uint(x), false, false);
  return __uint_as_float(t[0]) + __uint_as_float(t[1]);
}
__device__ __forceinline__ float wave_sum(float v) {
  v += dpp_mov<0xB1>(v); v += dpp_mov<0x4E>(v); v += dpp_mov<0x124>(v); v += dpp_mov<0x128>(v);
  return xrow16_sum(v);
}
__device__ __forceinline__ float wave_max(float v) {
  v = fmaxf(v, dpp_mov<0xB1>(v)); v = fmaxf(v, dpp_mov<0x4E>(v)); v = fmaxf(v, dpp_mov<0x124>(v)); v = fmaxf(v, dpp_mov<0x128>(v));
  return xrow16_max(v);
}

typedef unsigned short bf16_t;
typedef __attribute__((ext_vector_type(8))) short bf16x8;
typedef __attribute__((ext_vector_type(16))) float f32x16;
typedef __attribute__((ext_vector_type(4))) float f32x4;

typedef __attribute__((ext_vector_type(2))) __bf16 bf16x2_t;
__device__ __forceinline__ unsigned f2bf(float f) { return (unsigned)__builtin_bit_cast(unsigned short, (__bf16)f); }
__device__ __forceinline__ unsigned pack2bf(float a, float b) { bf16x2_t v = {(__bf16)a, (__bf16)b}; return __builtin_bit_cast(unsigned, v); }
__device__ __forceinline__ float bf2f(unsigned short v) { return __uint_as_float(((unsigned)v) << 16); }

__device__ __forceinline__ int mod_index(int row) { return row < T ? row / S : 2; }


struct Params {
  const float* in[18];
  float* out;
  float* ws;
};

constexpr size_t XCD_BAR_WORDS_C = 3456;
constexpr size_t al256(size_t n) { return (n + 255) & ~(size_t)255; }
constexpr size_t OFF_BAR = 0;
constexpr size_t OFF_TAB = al256(XCD_BAR_WORDS_C * 4);
constexpr size_t OFF_M = OFF_TAB + al256(16384 * 4 + 128 * 16 * 2 * 4);
constexpr size_t OFF_WIN0 = OFF_M + al256(2 * 3 * 6144 * 4);
constexpr size_t OFF_WOUT0 = OFF_WIN0 + al256((size_t)2048 * 1024 * 2);
constexpr size_t OFF_WIN1 = OFF_WOUT0 + al256((size_t)1024 * 1024 * 2);
constexpr size_t OFF_WOUT1 = OFF_WIN1 + al256((size_t)1536 * 1024 * 2);
constexpr size_t OFF_WQ = OFF_WOUT1 + al256((size_t)1024 * 1024 * 2);
constexpr size_t OFF_SK = OFF_WQ + al256((size_t)2 * 2048 * 1024 * 2);
constexpr size_t OFF_UB = OFF_SK + al256((size_t)2 * 8 * 2 * 128 * 128 * 2);
constexpr size_t OFF_VB = OFF_UB + al256((size_t)2 * 16384 * 1024);
constexpr size_t OFF_USC = OFF_VB + al256((size_t)2 * 16384 * 1024);
constexpr size_t OFF_AB = OFF_USC + al256((size_t)4 * 16384 * 4);
constexpr size_t OFF_FT = OFF_AB + al256((size_t)R * 1024 * 2);
constexpr size_t OFF_BF = OFF_FT + al256((size_t)(256 * 128 + 128 * 128 + 64 * 128) * 2);
constexpr size_t OFF_BY = OFF_BF + al256((size_t)R * 2048 * 4);
constexpr size_t OFF_X1 = OFF_BY + al256((size_t)R * 1024 * 4);
constexpr size_t OFF_X2 = OFF_X1 + al256((size_t)R * 1024 * 4);
constexpr size_t OFF_END = OFF_X2 + al256((size_t)R * 1024 * 4);
constexpr size_t OFF_A1 = OFF_BY;
constexpr size_t OFF_VT0 = OFF_X2;
static_assert(OFF_END <= (size_t)512 * 1024 * 1024, "workspace overflow");

#define GRID_LOOP(var, n) for (int var = blockIdx.x; var < (n); var += gridDim.x)

__device__ __forceinline__ void ph_fft_tables(bf16_t* D1, bf16_t* D3, bf16_t* DcT) {
  const double TWO_PI = 6.283185307179586476925286766559;
  for (int i = blockIdx.x * 256 + threadIdx.x; i < 256 * 128 + 128 * 128 + 64 * 128; i += gridDim.x * 256) {
    if (i < 256 * 128) {
      int m = i >> 7, r = i & 127; int k1 = m >> 1, ri = m & 1;
      double a = TWO_PI * (double)((k1 * r) & 127) / 128.0;
      D1[i] = (bf16_t)f2bf(ri == 0 ? (float)cos(a) : (float)(-sin(a)));
    } else if (i < 256 * 128 + 128 * 128) {
      int j = i - 256 * 128; int m = j >> 7, kk = j & 127; int rip = m >> 6, k2 = m & 63; int c = kk >> 1, ri = kk & 1;
      double a = TWO_PI * (double)((k2 * c) & 63) / 64.0;
      double v = (rip == 0) ? (ri == 0 ? cos(a) : sin(a)) : (ri == 0 ? -sin(a) : cos(a));
      D3[j] = (bf16_t)f2bf((float)v);
    } else {
      int j = i - 256 * 128 - 128 * 128; int cp = j >> 7, kk = j & 127; int rip = kk >> 6, ch = kk & 63;
      double a = TWO_PI * (double)((ch * cp) & 63) / 64.0;
      DcT[j] = (bf16_t)f2bf((float)(rip == 0 ? cos(a) : sin(a)));
    }
  }
}
__device__ __forceinline__ void ph_rope_table(float* RT) {
  for (int i = blockIdx.x * 256 + threadIdx.x; i < 128 * 16; i += gridDim.x * 256) {
    int pos = i >> 4, f = i & 15;
    float inv_freq = powf(10000.0f, -(float)f / 16.0f);
    float ang = (float)pos * inv_freq;
    RT[2 * i] = cosf(ang); RT[2 * i + 1] = sinf(ang);
  }
}
__device__ __forceinline__ void ph_tables(float* tab) {
  for (int j = blockIdx.x * 256 + threadIdx.x; j < 8192; j += gridDim.x * 256) {
    double a = 6.283185307179586476925286766559 * (double)j / 8192.0;
    tab[j] = (float)cos(a);
    tab[8192 + j] = (float)sin(a);
  }
}
__device__ __forceinline__ void ph_ada(const float* __restrict__ c, const float* __restrict__ c_ctx, const float* __restrict__ ada_w,
                       const float* __restrict__ ada_b, float* __restrict__ M) {
  for (int gid = blockIdx.x * 256 + threadIdx.x; gid < 2 * 3 * 6144; gid += gridDim.x * 256) {
    int col = gid % 6144; int idx = (gid / 6144) % 3; int layer = gid / (3 * 6144);
    const float* vec = idx < 2 ? c + idx * D : c_ctx;
    const float* w = ada_w + (size_t)layer * D * 6144 + col;
    float acc = 0.f;
    for (int k = 0; k < D; ++k) {
      float x = vec[k];
      float sx = x / (1.f + expf(-x));
      acc += sx * w[(size_t)k * 6144];
    }
    M[gid] = acc + ada_b[layer * 6144 + col];
  }
}

__device__ __forceinline__ void ph_modulate(const float* __restrict__ xa, const float* __restrict__ xb, const float* __restrict__ M, int layer,
                            int jshift, int jscale, bf16_t* __restrict__ out, int nrows, float* red) {
  int tid = threadIdx.x;
  GRID_LOOP(row, nrows) {
    const float* x = row < T ? xa + (size_t)row * D : xb + (size_t)(row - T) * D;
    float v[4]; float s = 0.f;
#pragma unroll
    for (int i = 0; i < 4; ++i) { v[i] = x[tid + 256 * i]; s += v[i]; }
    s = wave_sum(s);
    __syncthreads();
    if ((tid & 63) == 0) red[tid >> 6] = s;
    __syncthreads();
    float mu = (red[0] + red[1] + red[2] + red[3]) * (1.f / D);
    float q = 0.f;
#pragma unroll
    for (int i = 0; i < 4; ++i) { float d = v[i] - mu; q += d * d; }
    q = wave_sum(q);
    if ((tid & 63) == 0) red[4 + (tid >> 6)] = q;
    __syncthreads();
    float var = (red[4] + red[5] + red[6] + red[7]) * (1.f / D);
    float rs = rsqrtf(var + LN_EPS);
    const float* m = M + ((size_t)layer * 3 + mod_index(row)) * 6144;
#pragma unroll
    for (int i = 0; i < 4; ++i) {
      int col = tid + 256 * i;
      float y = (v[i] - mu) * rs;
      out[(size_t)row * D + col] = (bf16_t)f2bf(y * (1.f + m[jscale * D + col]) + m[jshift * D + col]);
    }
  }
}

__device__ __forceinline__ void ph_post(const float* __restrict__ xa, const float* __restrict__ xb, const float* __restrict__ Y,
                        const float* __restrict__ M, int layer, int j, const float* __restrict__ g, const float* __restrict__ bb,
                        float* __restrict__ outa, float* __restrict__ outb, int nrows, float* red) {
  int tid = threadIdx.x;
  GRID_LOOP(row, nrows) {
    const float* x = row < T ? xa + (size_t)row * D : xb + (size_t)(row - T) * D;
    float* out = row < T ? outa + (size_t)row * D : outb + (size_t)(row - T) * D;
    const float* m = M + ((size_t)layer * 3 + mod_index(row)) * 6144 + j * D;
    float v[4]; float s = 0.f;
#pragma unroll
    for (int i = 0; i < 4; ++i) { int col = tid + 256 * i; v[i] = DN_ALPHA * x[col] + m[col] * Y[(size_t)row * D + col]; s += v[i]; }
    s = wave_sum(s);
    __syncthreads();
    if ((tid & 63) == 0) red[tid >> 6] = s;
    __syncthreads();
    float mu = (red[0] + red[1] + red[2] + red[3]) * (1.f / D);
    float q = 0.f;
#pragma unroll
    for (int i = 0; i < 4; ++i) { float d = v[i] - mu; q += d * d; }
    q = wave_sum(q);
    if ((tid & 63) == 0) red[4 + (tid >> 6)] = q;
    __syncthreads();
    float var = (red[4] + red[5] + red[6] + red[7]) * (1.f / D);
    float rs = rsqrtf(var + LN_EPS);
#pragma unroll
    for (int i = 0; i < 4; ++i) {
      int col = tid + 256 * i;
      out[col] = (v[i] - mu) * rs * g[col] + bb[col];
    }
  }
}

struct ARow { const float* A; int lda; __device__ float operator()(int m, int k) const { return A[(size_t)m * lda + k]; } };
struct BRow { const float* B; int ldb; __device__ float operator()(int k, int n) const { return B[(size_t)k * ldb + n]; } };
struct CRow { float* C; int ldc; float scale; __device__ void operator()(int m, int n, float v) const { C[(size_t)m * ldc + n] = v * scale; } };
struct CRowB { bf16_t* C; int ldc; float scale; __device__ void operator()(int m, int n, float v) const { C[(size_t)m * ldc + n] = (bf16_t)f2bf(v * scale); } };
struct ADft { const float* tab; int Sn; int stride; __device__ float operator()(int m, int k) const {
    int t = k & (Sn - 1); int idx = ((m * t) & (Sn - 1)) * stride;
    return k < Sn ? tab[idx] : -tab[8192 + idx]; } };
struct BPQ { const float* PQ; int rowbase; int Sn; __device__ float operator()(int k, int n) const {
    int t = k & (Sn - 1); return PQ[(size_t)(rowbase + t) * 1024 + (k >= Sn ? 512 : 0) + n]; } };

template <class AF, class BF, class CF>
__device__ __forceinline__ void ph_gemm(AF af, BF bf, CF cf, int M, int N, int K, float* sm) {
  float (*sA)[68] = (float (*)[68])sm;
  float (*sB)[68] = (float (*)[68])(sm + 16 * 68);
  int tid = threadIdx.x; int tx = tid & 15, ty = tid >> 4;
  int ntn = N / 64; int ntiles = (M / 64) * ntn;
  GRID_LOOP(tile, ntiles) {
    int m0 = (tile / ntn) * 64, n0 = (tile % ntn) * 64;
    float acc[4][4];
#pragma unroll
    for (int i = 0; i < 4; ++i)
#pragma unroll
      for (int j = 0; j < 4; ++j) acc[i][j] = 0.f;
    for (int k0 = 0; k0 < K; k0 += 16) {
      __syncthreads();
#pragma unroll
      for (int i = 0; i < 4; ++i) { int e = tid + 256 * i; int m = e >> 4, k = e & 15; sA[k][m] = af(m0 + m, k0 + k); }
#pragma unroll
      for (int i = 0; i < 4; ++i) { int e = tid + 256 * i; int k = e >> 6, n = e & 63; sB[k][n] = bf(k0 + k, n0 + n); }
      __syncthreads();
#pragma unroll
      for (int k = 0; k < 16; ++k) {
        float a[4], b[4];
#pragma unroll
        for (int i = 0; i < 4; ++i) { a[i] = sA[k][ty * 4 + i]; b[i] = sB[k][tx * 4 + i]; }
#pragma unroll
        for (int i = 0; i < 4; ++i)
#pragma unroll
          for (int j = 0; j < 4; ++j) acc[i][j] += a[i] * b[j];
      }
    }
#pragma unroll
    for (int i = 0; i < 4; ++i)
#pragma unroll
      for (int j = 0; j < 4; ++j) cf(m0 + ty * 4 + i, n0 + tx * 4 + j, acc[i][j]);
  }
}


__device__ __forceinline__ void ph_transpose_w(const float* __restrict__ W, int K, int N, bf16_t* __restrict__ Wt, float* sm) {
  int tid = threadIdx.x;
  int tk = K / 64, tn = N / 64;
  GRID_LOOP(tile, tk * tn) {
    int k0 = (tile / tn) * 64, n0 = (tile % tn) * 64;
    __syncthreads();
#pragma unroll
    for (int i = 0; i < 16; ++i) { int e = tid + 256 * i; int k = e >> 6, n = e & 63; sm[k * 65 + n] = W[(size_t)(k0 + k) * N + n0 + n]; }
    __syncthreads();
#pragma unroll
    for (int i = 0; i < 2; ++i) {
      int e = tid + 256 * i; int n = e >> 3, kc = e & 7;
      unsigned w[4];
#pragma unroll
      for (int j = 0; j < 4; ++j) w[j] = pack2bf(sm[(kc * 8 + 2 * j) * 65 + n], sm[(kc * 8 + 2 * j + 1) * 65 + n]);
      *(uint4*)(Wt + (size_t)(n0 + n) * K + k0 + kc * 8) = make_uint4(w[0], w[1], w[2], w[3]);
    }
  }
}
__device__ __forceinline__ void ph_convert(const float* __restrict__ src, bf16_t* __restrict__ dst, size_t n8) {
  for (size_t i = (size_t)blockIdx.x * 256 + threadIdx.x; i < n8; i += (size_t)gridDim.x * 256) {
    float4 a = ((const float4*)src)[2 * i], b = ((const float4*)src)[2 * i + 1];
    ((uint4*)dst)[i] = make_uint4(pack2bf(a.x, a.y), pack2bf(a.z, a.w), pack2bf(b.x, b.y), pack2bf(b.z, b.w));
  }
}

__device__ __forceinline__ void gemm_stage(const bf16_t* __restrict__ A, int lda, int k0, char* lds, int tid) {
#pragma unroll
  for (int i = 0; i < 4; ++i) {
    int q = tid + 256 * i; int row = q >> 3, p = q & 7; int c = p ^ ((row >> 1) & 7);
    const bf16_t* src = A + (size_t)row * lda + k0 + c * 8;
    __builtin_amdgcn_global_load_lds((const unsigned*)src, (unsigned*)(lds + q * 16), 16, 0, 0);
  }
}
struct EpiF32 {
  float* C; int ldc; float scale;
  __device__ __forceinline__ void operator()(int m0, int n0, int wm, int wn, f32x16 (&acc)[2][2], int tid, char* smem) const {
    int lane = tid & 63;
    float* t = (float*)smem;
    int rbase = wm * 64 + 4 * (lane >> 5), cbase = wn * 64 + (lane & 31);
#pragma unroll
    for (int mi = 0; mi < 2; ++mi)
#pragma unroll
      for (int ni = 0; ni < 2; ++ni)
#pragma unroll
        for (int r = 0; r < 16; ++r)
          t[(rbase + mi * 32 + (r & 3) + 8 * (r >> 2)) * 128 + cbase + ni * 32] = acc[mi][ni][r] * scale;
    __syncthreads();
    float* dst = C + (size_t)(m0 + (tid >> 5)) * ldc + n0 + (tid & 31) * 4;
    const float* src = t + (tid >> 5) * 128 + (tid & 31) * 4;
#pragma unroll 4
    for (int i = 0; i < 16; ++i) {
      *(float4*)dst = *(const float4*)src;
      dst += (size_t)8 * ldc; src += 8 * 128;
    }
  }
};
struct EpiQKV0 {
  bf16_t* FQKV; bf16_t* VT;
  __device__ __forceinline__ void operator()(int m0, int n0, int wm, int wn, f32x16 (&acc)[2][2], int tid, char* smem) const {
    int lane = tid & 63;
    bf16_t* t = (bf16_t*)smem;
    int rbase = wm * 64 + 4 * (lane >> 5), cbase = wn * 64 + (lane & 31);
#pragma unroll
    for (int mi = 0; mi < 2; ++mi)
#pragma unroll
      for (int ni = 0; ni < 2; ++ni)
#pragma unroll
        for (int r = 0; r < 16; ++r)
          t[(rbase + mi * 32 + (r & 3) + 8 * (r >> 2)) * 136 + cbase + ni * 32] = (bf16_t)f2bf(acc[mi][ni][r]);
    __syncthreads();
    {
      bf16_t* dst = FQKV + (size_t)(m0 + (tid >> 4)) * 2048 + n0 + (tid & 15) * 8;
      const bf16_t* src = t + (tid >> 4) * 136 + (tid & 15) * 8;
#pragma unroll 4
      for (int i = 0; i < 8; ++i) {
        *(uint4*)dst = *(const uint4*)src;
        dst += (size_t)16 * 2048; src += 16 * 136;
      }
    }
    if (n0 >= 1536) {
      int col = tid >> 1, half = tid & 1;
      int hd = (n0 - 1536) / 64 + (col >> 6), d = col & 63;
      bf16_t* dst;
      if (m0 < T) { int b = m0 / S, t0 = m0 % S; dst = VT + (((size_t)b * 8 + hd) * 64 + d) * S + t0 + half * 64; }
      else { int mm = m0 - T; int b = mm / CL, l0 = mm % CL; dst = VT + (size_t)NB * 8 * 64 * S + (((size_t)b * 8 + hd) * 64 + d) * CL + l0 + half * 64; }
      const bf16_t* src = t + (half * 64) * 136 + col;
#pragma unroll
      for (int i = 0; i < 8; ++i) {
        unsigned wv[4];
#pragma unroll
        for (int j = 0; j < 4; ++j) wv[j] = (unsigned)src[(i * 8 + 2 * j) * 136] | ((unsigned)src[(i * 8 + 2 * j + 1) * 136] << 16);
        *(uint4*)(dst + i * 8) = make_uint4(wv[0], wv[1], wv[2], wv[3]);
      }
    }
  }
};
struct EpiBf16 {
  bf16_t* C; int ldc;
  __device__ __forceinline__ void operator()(int m0, int n0, int wm, int wn, f32x16 (&acc)[2][2], int tid, char* smem) const {
    int lane = tid & 63;
    asm volatile("" : "+v"(lane));
    bf16_t* t = (bf16_t*)smem;
    {
      bf16_t* tw = t + (wm * 64 + 4 * (lane >> 5)) * 136 + wn * 64 + (lane & 31);
#pragma unroll
      for (int mi = 0; mi < 2; ++mi)
#pragma unroll
        for (int ni = 0; ni < 2; ++ni)
#pragma unroll
          for (int r = 0; r < 16; ++r)
            tw[(mi * 32 + (r & 3) + 8 * (r >> 2)) * 136 + ni * 32] = (bf16_t)f2bf(acc[mi][ni][r]);
    }
    __syncthreads();
    bf16_t* dst = C + (size_t)(m0 + (tid >> 4)) * ldc + n0 + (tid & 15) * 8;
    const bf16_t* src = t + (tid >> 4) * 136 + (tid & 15) * 8;
#pragma unroll 4
    for (int i = 0; i < 8; ++i) {
      *(uint4*)dst = *(const uint4*)src;
      dst += (size_t)16 * ldc; src += 16 * 136;
    }
  }
};
struct EpiQKV1 {
  bf16_t* Q1; bf16_t* K1; bf16_t* VT; const float* RT;
  __device__ __forceinline__ void operator()(int m0, int n0, int wm, int wn, f32x16 (&acc)[2][2], int tid, char* smem) const {
    int lane = tid & 63;
    asm volatile("" : "+v"(lane));
    bf16_t* t = (bf16_t*)smem;
    if (n0 < 1280 && m0 < T) {
      int i = lane & 31; int f = i & 15;
#pragma unroll
      for (int mi = 0; mi < 2; ++mi)
#pragma unroll
        for (int r = 0; r < 16; ++r) {
          int row = m0 + wm * 64 + 4 * (lane >> 5) + mi * 32 + (r & 3) + 8 * (r >> 2);
          int tt = row & (S - 1);
          int pos = (i < 16) ? (tt >> 6) : (tt & 63);
          float2 cs = *(const float2*)(RT + 2 * (pos * 16 + f));
          float x1 = acc[mi][0][r], x2 = acc[mi][1][r];
          acc[mi][0][r] = x1 * cs.x - x2 * cs.y;
          acc[mi][1][r] = x1 * cs.y + x2 * cs.x;
        }
    }
    {
      bf16_t* tw = t + (wm * 64 + 4 * (lane >> 5)) * 136 + wn * 64 + (lane & 31);
#pragma unroll
      for (int mi = 0; mi < 2; ++mi)
#pragma unroll
        for (int ni = 0; ni < 2; ++ni)
#pragma unroll
          for (int r = 0; r < 16; ++r)
            tw[(mi * 32 + (r & 3) + 8 * (r >> 2)) * 136 + ni * 32] = (bf16_t)f2bf(acc[mi][ni][r]);
    }
    __syncthreads();
    if (n0 < 1280) {
      bf16_t* dst; int ld;
      if (n0 < 1024) { dst = Q1 + (size_t)(m0 + (tid >> 4)) * 1024 + n0 + (tid & 15) * 8; ld = 1024; }
      else { dst = K1 + (size_t)(m0 + (tid >> 4)) * 256 + (n0 - 1024) + (tid & 15) * 8; ld = 256; }
      if (n0 >= 1024 || m0 < T) {
        const bf16_t* src = t + (tid >> 4) * 136 + (tid & 15) * 8;
#pragma unroll 4
        for (int i = 0; i < 8; ++i) {
          *(uint4*)dst = *(const uint4*)src;
          dst += (size_t)16 * ld; src += 16 * 136;
        }
      }
    } else {
      int col = tid >> 1, half = tid & 1;
      int hd = (n0 - 1280) / 64 + (col >> 6), d = col & 63;
      bf16_t* dst;
      if (m0 < T) { int b = m0 / S, t0 = m0 % S; dst = VT + (((size_t)b * 4 + hd) * 64 + d) * S + t0 + half * 64; }
      else { int mm = m0 - T; int b = mm / CL, l0 = mm % CL; dst = VT + (size_t)NB * 4 * 64 * S + (((size_t)b * 4 + hd) * 64 + d) * CL + l0 + half * 64; }
      const bf16_t* src = t + (half * 64) * 136 + col;
#pragma unroll
      for (int i = 0; i < 8; ++i) {
        unsigned wv[4];
#pragma unroll
        for (int j = 0; j < 4; ++j) wv[j] = (unsigned)src[(i * 8 + 2 * j) * 136] | ((unsigned)src[(i * 8 + 2 * j + 1) * 136] << 16);
        *(uint4*)(dst + i * 8) = make_uint4(wv[0], wv[1], wv[2], wv[3]);
      }
    }
  }
};
__device__ __forceinline__ void gemm_tile_mainloop(const bf16_t* __restrict__ Ag, int lda, const bf16_t* __restrict__ Bg, int ldb, int KT,
                                                   f32x16 (&acc)[2][2], char* smem) {
  int tid = threadIdx.x;
  asm volatile("" : "+v"(tid));
  int lane = tid & 63, wave = __builtin_amdgcn_readfirstlane(tid >> 6), wm = wave >> 1, wn = wave & 1;
#pragma unroll
  for (int mi = 0; mi < 2; ++mi)
#pragma unroll
    for (int ni = 0; ni < 2; ++ni)
#pragma unroll
      for (int r = 0; r < 16; ++r) acc[mi][ni][r] = 0.f;
  __syncthreads();
  gemm_stage(Ag, lda, 0, smem, tid); gemm_stage(Bg, ldb, 0, smem + 16384, tid);
  for (int kt = 0; kt < KT; ++kt) {
    asm volatile("s_waitcnt vmcnt(0)" ::: "memory");
    __syncthreads();
    char* cur = smem + (kt & 1) * 32768;
    if (kt + 1 < KT) {
      char* nxt = smem + ((kt + 1) & 1) * 32768;
      gemm_stage(Ag, lda, (kt + 1) * 64, nxt, tid); gemm_stage(Bg, ldb, (kt + 1) * 64, nxt + 16384, tid);
    }
#pragma unroll
    for (int s4 = 0; s4 < 4; ++s4) {
      bf16x8 a[2], b[2];
      int c = 2 * s4 + (lane >> 5);
#pragma unroll
      for (int mi = 0; mi < 2; ++mi) { int row = wm * 64 + mi * 32 + (lane & 31); a[mi] = *(const bf16x8*)(cur + row * 128 + ((c ^ ((row >> 1) & 7)) << 4)); }
#pragma unroll
      for (int ni = 0; ni < 2; ++ni) { int row = wn * 64 + ni * 32 + (lane & 31); b[ni] = *(const bf16x8*)(cur + 16384 + row * 128 + ((c ^ ((row >> 1) & 7)) << 4)); }
#pragma unroll
      for (int mi = 0; mi < 2; ++mi)
#pragma unroll
        for (int ni = 0; ni < 2; ++ni) acc[mi][ni] = __builtin_amdgcn_mfma_f32_32x32x16_bf16(a[mi], b[ni], acc[mi][ni], 0, 0, 0);
    }
  }
  __syncthreads();
}
template <class Epi>
__device__ __forceinline__ void ph_gemm_bf16(const bf16_t* __restrict__ A, int lda, const bf16_t* __restrict__ Bt, int ldb, int M, int N, int K,
                             Epi epi, char* smem) {
  int tid = threadIdx.x, wave = __builtin_amdgcn_readfirstlane(tid >> 6), wm = wave >> 1, wn = wave & 1;
  int ntn = N / 128, ntiles = (M / 128) * ntn;
  int KT = K / 64;
  GRID_LOOP(tile, ntiles) {
    int mt = tile / ntn, nt = tile % ntn;
    f32x16 acc[2][2];
    gemm_tile_mainloop(A + (size_t)mt * 128 * lda, lda, Bt + (size_t)nt * 128 * ldb, ldb, KT, acc, smem);
    epi(mt * 128, nt * 128, wm, wn, acc, tid, smem);
  }
}

__device__ __forceinline__ void ins16(float (&L)[16], float x) {
#pragma unroll
  for (int j = 15; j >= 1; --j) L[j] = __builtin_amdgcn_fmed3f(L[j - 1], L[j], x);
  L[0] = fmaxf(L[0], x);
}
__device__ __forceinline__ void stage_tile128(const bf16_t* __restrict__ src, int ld, char* lds, int tid) {
#pragma unroll
  for (int i = 0; i < 8; ++i) {
    int q = tid + 256 * i; int row = q >> 4, p = q & 15; int c = p ^ (row & 15);
    __builtin_amdgcn_global_load_lds((const unsigned*)(src + (size_t)row * ld + c * 8), (unsigned*)(lds + q * 16), 16, 0, 0);
  }
}
__device__ __forceinline__ void ph_peer_select(const bf16_t* __restrict__ H, const bf16_t* __restrict__ WQl, const bf16_t* __restrict__ SKl,
                                               int* __restrict__ EXP, float* __restrict__ GATE, int nrows, char* smem) {
  int tid = threadIdx.x, w = __builtin_amdgcn_readfirstlane(tid >> 6), wm = w >> 1, wn = w & 1;
  bf16_t* Qs = (bf16_t*)smem;
  int* KL = (int*)(smem + 36864);
  int nunits = (nrows / 128) * 8;
  GRID_LOOP(unit, nunits) {
    int mt = unit >> 3, h = unit & 7;
    float L0[16], L1[16];
#pragma unroll
    for (int p = 0; p < 2; ++p) {
      f32x16 acc[2][2];
      gemm_tile_mainloop(H + (size_t)mt * 128 * 1024, 1024, WQl + (size_t)(h * 256 + p * 128) * 1024, 1024, 16, acc, smem);
      int lane = tid & 63;
      asm volatile("" : "+v"(lane));
      {
        bf16_t* qw = Qs + (wm * 64 + 4 * (lane >> 5)) * 136 + wn * 64 + (lane & 31);
#pragma unroll
        for (int mi = 0; mi < 2; ++mi)
#pragma unroll
          for (int ni = 0; ni < 2; ++ni)
#pragma unroll
            for (int r = 0; r < 16; ++r)
              qw[(mi * 32 + (r & 3) + 8 * (r >> 2)) * 136 + ni * 32] = (bf16_t)f2bf(acc[mi][ni][r]);
      }
      __syncthreads();
      f32x16 sc[4];
#pragma unroll
      for (int m4 = 0; m4 < 4; ++m4)
#pragma unroll
        for (int r = 0; r < 16; ++r) sc[m4][r] = 0.f;
      {
        const bf16_t* qrow = Qs + (32 * w + (lane & 31)) * 136 + 8 * (lane >> 5);
        const bf16_t* krow = SKl + (size_t)(h * 2 + p) * 128 * 128 + (lane & 31) * 128 + 8 * (lane >> 5);
#pragma unroll
        for (int s8 = 0; s8 < 8; ++s8) {
          bf16x8 bq = *(const bf16x8*)(qrow + 16 * s8);
#pragma unroll
          for (int m4 = 0; m4 < 4; ++m4) {
            bf16x8 ak = *(const bf16x8*)(krow + m4 * 32 * 128 + 16 * s8);
            sc[m4] = __builtin_amdgcn_mfma_f32_32x32x16_bf16(ak, bq, sc[m4], 0, 0, 0);
          }
        }
      }
      float L[16];
#pragma unroll
      for (int j = 0; j < 16; ++j) L[j] = -INFINITY;
      unsigned kb = 4u * (unsigned)(lane >> 5);
#pragma unroll
      for (int m4 = 0; m4 < 4; ++m4)
#pragma unroll
        for (int r = 0; r < 16; ++r) {
          unsigned key = kb + (unsigned)(32 * m4 + (r & 3) + 8 * (r >> 2));
          float x = __uint_as_float((__float_as_uint(sc[m4][r]) & 0xFFFFFF80u) | key);
          ins16(L, x);
        }
      float P[16];
#pragma unroll
      for (int j = 0; j < 16; ++j) P[j] = __shfl_xor(L[j], 32);
#pragma unroll
      for (int j = 0; j < 16; ++j) ins16(L, P[j]);
      if (p == 0) {
#pragma unroll
        for (int j = 0; j < 16; ++j) L0[j] = L[j];
      } else {
#pragma unroll
        for (int j = 0; j < 16; ++j) L1[j] = L[j];
      }
    }
    float C[16];
#pragma unroll
    for (int j = 0; j < 16; ++j) C[j] = -INFINITY;
#pragma unroll
    for (int a = 0; a < 16; ++a)
#pragma unroll
      for (int b = 0; b < 16; ++b)
        if ((a + 1) * (b + 1) <= 16) {
          float sa = __uint_as_float(__float_as_uint(L0[a]) & 0xFFFFFF80u);
          float sb = __uint_as_float(__float_as_uint(L1[b]) & 0xFFFFFF80u);
          float x = __uint_as_float((__float_as_uint(sa + sb) & 0xFFFFFF00u) | (unsigned)(a * 16 + b));
          ins16(C, x);
        }
    int lane = tid & 63;
    asm volatile("" : "+v"(lane));
    int token = 32 * w + (lane & 31);
    if (lane < 32) {
#pragma unroll
      for (int j = 0; j < 16; ++j) { KL[token * 32 + j] = (int)(__float_as_uint(L0[j]) & 0x7Fu); KL[token * 32 + 16 + j] = (int)(__float_as_uint(L1[j]) & 0x7Fu); }
    }
    __syncthreads();
    if (lane < 32) {
      float c0 = __uint_as_float(__float_as_uint(C[0]) & 0xFFFFFF00u);
      float ev[16]; float sum = 0.f; int ex[16];
#pragma unroll
      for (int j = 0; j < 16; ++j) {
        unsigned bits = __float_as_uint(C[j]);
        float cv = __uint_as_float(bits & 0xFFFFFF00u);
        ev[j] = __expf(cv - c0); sum += ev[j];
        int a = (bits >> 4) & 15, b = bits & 15;
        ex[j] = KL[token * 32 + a] * 128 + KL[token * 32 + 16 + b];
      }
      float inv = 1.f / sum;
      size_t o = (size_t)(mt * 128 + token) * 128 + h * 16;
#pragma unroll
      for (int j = 0; j < 16; j += 4) {
        *(int4*)(EXP + o + j) = make_int4(ex[j], ex[j + 1], ex[j + 2], ex[j + 3]);
        *(float4*)(GATE + o + j) = make_float4(ev[j] * inv, ev[j + 1] * inv, ev[j + 2] * inv, ev[j + 3] * inv);
      }
    }
  }
}

__device__ __forceinline__ void fft1_unit(int u, const bf16_t* __restrict__ FQKV, const bf16_t* __restrict__ D1, const float* __restrict__ TAB,
                          bf16_t* __restrict__ A1, char* smem) {
  int tid = threadIdx.x, lane = tid & 63, w = __builtin_amdgcn_readfirstlane(tid >> 6);
  int g = u & 7, c = (u >> 3) & 63, b = u >> 9;
  bf16_t* Bt = (bf16_t*)smem;
  __syncthreads();
  {
    int r = tid >> 1, half = tid & 1;
    const uint4* src = (const uint4*)(FQKV + (size_t)(b * S + 64 * r + c) * 2048 + g * 64 + half * 32);
    unsigned wv[16];
#pragma unroll
    for (int i = 0; i < 4; ++i) { uint4 v = src[i]; wv[4 * i] = v.x; wv[4 * i + 1] = v.y; wv[4 * i + 2] = v.z; wv[4 * i + 3] = v.w; }
#pragma unroll
    for (int j = 0; j < 32; ++j) {
      unsigned e = (j & 1) ? (wv[j >> 1] >> 16) : (wv[j >> 1] & 0xffffu);
      Bt[(half * 32 + j) * 136 + r] = (bf16_t)e;
    }
  }
  __syncthreads();
  f32x16 acc[2][2];
#pragma unroll
  for (int mi = 0; mi < 2; ++mi)
#pragma unroll
    for (int ni = 0; ni < 2; ++ni)
#pragma unroll
      for (int r = 0; r < 16; ++r) acc[mi][ni][r] = 0.f;
#pragma unroll
  for (int s8 = 0; s8 < 8; ++s8) {
    bf16x8 a[2], bb[2];
    int ko = 16 * s8 + 8 * (lane >> 5);
#pragma unroll
    for (int mi = 0; mi < 2; ++mi) a[mi] = *(const bf16x8*)(D1 + (64 * w + 32 * mi + (lane & 31)) * 128 + ko);
#pragma unroll
    for (int ni = 0; ni < 2; ++ni) bb[ni] = *(const bf16x8*)(Bt + (32 * ni + (lane & 31)) * 136 + ko);
#pragma unroll
    for (int mi = 0; mi < 2; ++mi)
#pragma unroll
      for (int ni = 0; ni < 2; ++ni) acc[mi][ni] = __builtin_amdgcn_mfma_f32_32x32x16_bf16(a[mi], bb[ni], acc[mi][ni], 0, 0, 0);
  }
  bf16_t* Ot = (bf16_t*)(smem + 17408);
#pragma unroll
  for (int mi = 0; mi < 2; ++mi)
#pragma unroll
    for (int j = 0; j < 8; ++j) {
      int m = 64 * w + 32 * mi + ((2 * j) & 3) + 8 * ((2 * j) >> 2) + 4 * (lane >> 5);
      int k1 = m >> 1;
      int idx = (k1 * c) & 8191;
      float cs = TAB[idx], sn = TAB[8192 + idx];
#pragma unroll
      for (int ni = 0; ni < 2; ++ni) {
        float re = acc[mi][ni][2 * j], im = acc[mi][ni][2 * j + 1];
        float re2 = re * cs + im * sn, im2 = im * cs - re * sn;
        bf16_t* dst = Ot + m * 72 + 32 * ni + (lane & 31);
        dst[0] = (bf16_t)f2bf(re2); dst[72] = (bf16_t)f2bf(im2);
      }
    }
  __syncthreads();
  {
    bf16_t* base = A1 + (((size_t)b * 64 + c) * 128) * 2 * 512 + g * 64;
#pragma unroll
    for (int i = 0; i < 8; ++i) {
      int q = tid + 256 * i; int m = q >> 3, ch8 = q & 7;
      *(uint4*)(base + (size_t)m * 512 + ch8 * 8) = *(const uint4*)(Ot + m * 72 + ch8 * 8);
    }
  }
}

__device__ __forceinline__ void fft3_unit(int u, int mode, const bf16_t* __restrict__ FQKV, const bf16_t* __restrict__ A1, const bf16_t* __restrict__ D3,
                          const bf16_t* __restrict__ DcT, const float* __restrict__ TAB, bf16_t* __restrict__ MIX, char* smem) {
  int tid = threadIdx.x, lane = tid & 63, w = __builtin_amdgcn_readfirstlane(tid >> 6);
  bf16_t* Bt = (bf16_t*)smem;
  bf16_t* Xs = (bf16_t*)(smem + 17408);
  int g = u & 7, k1, b, nk1, rowbase; float norm;
  __syncthreads();
  if (mode == 0) {
    k1 = (u >> 3) & 127; b = u >> 10; nk1 = 128; rowbase = b * S; norm = 1.f / 724.0773439350247f;
    int kk = tid >> 1, half = tid & 1; int c = kk >> 1, ri = kk & 1;
    const uint4* src = (const uint4*)(A1 + ((((size_t)b * 64 + c) * 128 + k1) * 2 + ri) * 512 + g * 64 + half * 32);
    unsigned wv[16];
#pragma unroll
    for (int i = 0; i < 4; ++i) { uint4 v = src[i]; wv[4 * i] = v.x; wv[4 * i + 1] = v.y; wv[4 * i + 2] = v.z; wv[4 * i + 3] = v.w; }
#pragma unroll
    for (int j = 0; j < 32; ++j) {
      unsigned e = (j & 1) ? (wv[j >> 1] >> 16) : (wv[j >> 1] & 0xffffu);
      Bt[(half * 32 + j) * 136 + kk] = (bf16_t)e;
    }
  } else {
    k1 = (u >> 3) & 3; b = u >> 5; nk1 = 4; rowbase = T + b * CL; norm = 1.f / 128.f;
    int c = tid >> 2, q4 = tid & 3;
    float re[16], im[16];
#pragma unroll
    for (int j = 0; j < 16; ++j) { re[j] = 0.f; im[j] = 0.f; }
#pragma unroll
    for (int r = 0; r < 4; ++r) {
      const uint4* src = (const uint4*)(FQKV + (size_t)(rowbase + 64 * r + c) * 2048 + g * 64 + q4 * 16);
      uint4 v0 = src[0], v1 = src[1];
      unsigned wv[8] = {v0.x, v0.y, v0.z, v0.w, v1.x, v1.y, v1.z, v1.w};
      int ph = (k1 * r) & 3;
      float cr = (ph == 0) ? 1.f : (ph == 2 ? -1.f : 0.f);
      float ci = (ph == 1) ? -1.f : (ph == 3 ? 1.f : 0.f);
#pragma unroll
      for (int j = 0; j < 16; ++j) {
        float x = bf2f((unsigned short)((j & 1) ? (wv[j >> 1] >> 16) : (wv[j >> 1] & 0xffffu)));
        re[j] += x * cr; im[j] += x * ci;
      }
    }
    int idx = (k1 * c * 32) & 8191;
    float cs = TAB[idx], sn = TAB[8192 + idx];
#pragma unroll
    for (int j = 0; j < 16; ++j) {
      float re2 = re[j] * cs + im[j] * sn, im2 = im[j] * cs - re[j] * sn;
      *(unsigned*)(Bt + (q4 * 16 + j) * 136 + 2 * c) = pack2bf(re2, im2);
    }
  }
  __syncthreads();
  {
    f32x16 acc[2];
#pragma unroll
    for (int ni = 0; ni < 2; ++ni)
#pragma unroll
      for (int r = 0; r < 16; ++r) acc[ni][r] = 0.f;
#pragma unroll
    for (int s8 = 0; s8 < 8; ++s8) {
      int ko = 16 * s8 + 8 * (lane >> 5);
      bf16x8 a = *(const bf16x8*)(D3 + (32 * w + (lane & 31)) * 128 + ko);
#pragma unroll
      for (int ni = 0; ni < 2; ++ni) {
        bf16x8 bb = *(const bf16x8*)(Bt + (32 * ni + (lane & 31)) * 136 + ko);
        acc[ni] = __builtin_amdgcn_mfma_f32_32x32x16_bf16(a, bb, acc[ni], 0, 0, 0);
      }
    }
#pragma unroll
    for (int ni = 0; ni < 2; ++ni)
#pragma unroll
      for (int r = 0; r < 16; ++r) {
        int m = 32 * w + (r & 3) + 8 * (r >> 2) + 4 * (lane >> 5);
        Xs[(m & 63) * 136 + (m >> 6) * 64 + 32 * ni + (lane & 31)] = (bf16_t)f2bf(acc[ni][r]);
      }
  }
  __syncthreads();
  {
    int mi = w >> 1, ni = w & 1;
    f32x16 acc;
#pragma unroll
    for (int r = 0; r < 16; ++r) acc[r] = 0.f;
#pragma unroll
    for (int s8 = 0; s8 < 8; ++s8) {
      int ko = 16 * s8 + 8 * (lane >> 5);
      bf16x8 a = *(const bf16x8*)(Xs + (32 * mi + (lane & 31)) * 136 + ko);
      bf16x8 bb = *(const bf16x8*)(DcT + (32 * ni + (lane & 31)) * 128 + ko);
      acc = __builtin_amdgcn_mfma_f32_32x32x16_bf16(a, bb, acc, 0, 0, 0);
    }
    bf16_t* Yt = Bt;
#pragma unroll
    for (int r = 0; r < 16; ++r) {
      int k2 = 32 * mi + (r & 3) + 8 * (r >> 2) + 4 * (lane >> 5);
      Yt[k2 * 72 + 32 * ni + (lane & 31)] = (bf16_t)f2bf(acc[r] * norm);
    }
  }
  __syncthreads();
#pragma unroll
  for (int i = 0; i < 2; ++i) {
    int q = tid + 256 * i; int k2 = q >> 3, ch8 = q & 7;
    int row = rowbase + k1 + nk1 * k2;
    *(uint4*)(MIX + (size_t)row * 1024 + g * 64 + ch8 * 8) = *(const uint4*)((const bf16_t*)smem + k2 * 72 + ch8 * 8);
  }
}

typedef __attribute__((ext_vector_type(4))) float f32x4_t;
__device__ __forceinline__ bf16x8 ld16(const bf16_t* p) { return *(const bf16x8*)p; }
__device__ __forceinline__ float fast_exp2(float x) { return __builtin_amdgcn_exp2f(x); }

template <int NH, int MODE, int KPI>
__device__ __forceinline__ void attn_unit(int b, int hk, int r, int jb, int qb, const bf16_t* __restrict__ Qp, int ldq, const bf16_t* __restrict__ Kp, int ldk,
                                          const bf16_t* __restrict__ VTl, const bf16_t* __restrict__ VTc, int nkvh,
                                          const float* rpbs, const float* __restrict__ sink,
                                          bf16_t* __restrict__ Op, int ldo, int lane) {
  const float LOG2E = 1.4426950408889634f;
  const float SC = 0.125f * LOG2E;
  asm volatile("" : "+v"(lane));
  int ql = lane & 15, g = lane >> 4;
  int qrow0, q0 = 0;
  int nloc, lb0 = 0;
  if (MODE == 0) { qrow0 = b * S + r * 64 + 16 * jb; nloc = 8; }
  else if (MODE == 1) { qrow0 = T + b * CL + 16 * qb; nloc = 0; }
  else { q0 = 16 * qb; qrow0 = b * S + q0;
         int lo = (q0 - 128) >> 5, hi = (q0 + 143) >> 5; if (lo < 0) lo = 0; if (hi > 255) hi = 255; lb0 = lo; nloc = hi - lo + 1; }
  bf16x8 qf[NH][2];
#pragma unroll
  for (int hh = 0; hh < NH; ++hh)
#pragma unroll
    for (int s2 = 0; s2 < 2; ++s2)
      qf[hh][s2] = ld16(Qp + (size_t)(qrow0 + ql) * ldq + (hk * NH + hh) * 64 + 32 * s2 + 8 * g);
  f32x4_t o[NH][4]; float mrun[NH], lrun[NH];
#pragma unroll
  for (int hh = 0; hh < NH; ++hh) {
    mrun[hh] = -1e30f; lrun[hh] = 0.f;
#pragma unroll
    for (int dt = 0; dt < 4; ++dt) o[hh][dt] = (f32x4_t){0.f, 0.f, 0.f, 0.f};
  }
  int r_start = 0, blk_start = 0, c_lo = 0, qc = 0;
  if (MODE == 0) {
    r_start = min(max(r - 4, 0), 120);
    blk_start = min(max(16 * jb - 8, 0), 32);
    qc = 16 * jb + ql; c_lo = min(max(qc - 8, 0), 48);
  }
  int nit = (nloc + 8) / KPI;
#define ATT_DESC(kbx, krow0_, vtp_, vld_) \
    { bool il_ = (kbx) < nloc; int vt0_; \
      if (il_) { if (MODE == 0) { int rr_ = r_start + (kbx); krow0_ = b * S + rr_ * 64 + blk_start; vt0_ = rr_ * 64 + blk_start; } \
                 else { krow0_ = b * S + 32 * (lb0 + (kbx)); vt0_ = 32 * (lb0 + (kbx)); } \
                 vtp_ = VTl + ((size_t)(b * nkvh + hk) * 64) * S + vt0_; vld_ = S; } \
      else { int cb_ = (kbx) - nloc; krow0_ = T + b * CL + 32 * cb_; vt0_ = 32 * cb_; \
             vtp_ = VTc + ((size_t)(b * nkvh + hk) * 64) * CL + vt0_; vld_ = CL; } }
#define ATT_LOAD(kbx, KF, VF) \
    { int krow0; const bf16_t* vt; int vld; ATT_DESC(kbx, krow0, vt, vld) \
      _Pragma("unroll") for (int t = 0; t < 2; ++t) _Pragma("unroll") for (int s2 = 0; s2 < 2; ++s2) \
        KF[t][s2] = ld16(Kp + (size_t)(krow0 + 8 * (ql >> 2) + 4 * t + (ql & 3)) * ldk + hk * 64 + 32 * s2 + 8 * g); \
      _Pragma("unroll") for (int dt = 0; dt < 4; ++dt) VF[dt] = ld16(vt + (size_t)(16 * dt + ql) * vld + 8 * g); }
  bf16x8 kfn[KPI][2][2], vfn[KPI][4];
#pragma unroll
  for (int kk = 0; kk < KPI; ++kk) ATT_LOAD(kk, kfn[kk], vfn[kk])
  for (int it = 0; it < nit; ++it) {
    bf16x8 kf[KPI][2][2], vf[KPI][4];
#pragma unroll
    for (int kk = 0; kk < KPI; ++kk) {
#pragma unroll
      for (int t = 0; t < 2; ++t)
#pragma unroll
        for (int s2 = 0; s2 < 2; ++s2) kf[kk][t][s2] = kfn[kk][t][s2];
#pragma unroll
      for (int dt = 0; dt < 4; ++dt) vf[kk][dt] = vfn[kk][dt];
    }
    if (it + 1 < nit) {
#pragma unroll
      for (int kk = 0; kk < KPI; ++kk) ATT_LOAD((it + 1) * KPI + kk, kfn[kk], vfn[kk])
    }
    float bias[KPI][2][4]; bool valid[KPI][2][4];
#pragma unroll
    for (int kk = 0; kk < KPI; ++kk) {
      int kb = it * KPI + kk;
      bool is_loc = kb < nloc;
#pragma unroll
      for (int t = 0; t < 2; ++t)
#pragma unroll
        for (int i = 0; i < 4; ++i) {
          bias[kk][t][i] = 0.f; valid[kk][t][i] = true;
          if (MODE == 0 && is_loc) {
            int kc = blk_start + 8 * g + 4 * t + i;
            valid[kk][t][i] = (kc >= c_lo) && (kc < c_lo + 16);
            int dc = min(max(kc - qc, -15), 15) + 15;
            bias[kk][t][i] = rpbs[(hk * 15 + (r_start + kb - r + 7)) * 31 + dc];
          }
          if (MODE == 2 && is_loc) {
            int kpos = 32 * (lb0 + kb) + 8 * g + 4 * t + i; int dq = (q0 + ql) - kpos;
            valid[kk][t][i] = (dq <= 128) && (dq >= -128);
          }
        }
    }
#pragma unroll
    for (int hh = 0; hh < NH; ++hh) {
      f32x4_t st[KPI][2];
#pragma unroll
      for (int kk = 0; kk < KPI; ++kk)
#pragma unroll
        for (int t = 0; t < 2; ++t) {
          st[kk][t] = (f32x4_t){0.f, 0.f, 0.f, 0.f};
          st[kk][t] = __builtin_amdgcn_mfma_f32_16x16x32_bf16(kf[kk][t][0], qf[hh][0], st[kk][t], 0, 0, 0);
          st[kk][t] = __builtin_amdgcn_mfma_f32_16x16x32_bf16(kf[kk][t][1], qf[hh][1], st[kk][t], 0, 0, 0);
        }
      float lg[KPI][2][4]; float bm = -1e30f;
#pragma unroll
      for (int kk = 0; kk < KPI; ++kk)
#pragma unroll
        for (int t = 0; t < 2; ++t)
#pragma unroll
          for (int i = 0; i < 4; ++i) {
            float v = valid[kk][t][i] ? (st[kk][t][i] * SC + bias[kk][t][i]) : -1e30f;
            lg[kk][t][i] = v; bm = fmaxf(bm, v);
          }
      bm = xrow16_max(bm);
      float mn = fmaxf(mrun[hh], bm);
      float alpha = fast_exp2(mrun[hh] - mn);
      mrun[hh] = mn;
      float ps = 0.f;
      bf16x8 pf[KPI];
#pragma unroll
      for (int kk = 0; kk < KPI; ++kk) {
        float pv[8];
#pragma unroll
        for (int t = 0; t < 2; ++t)
#pragma unroll
          for (int i = 0; i < 4; ++i) {
            float p = valid[kk][t][i] ? fast_exp2(lg[kk][t][i] - mn) : 0.f;
            pv[4 * t + i] = p; ps += p;
          }
        typedef __attribute__((ext_vector_type(4))) unsigned u32x4;
        u32x4 uu = {pack2bf(pv[0], pv[1]), pack2bf(pv[2], pv[3]), pack2bf(pv[4], pv[5]), pack2bf(pv[6], pv[7])};
        pf[kk] = __builtin_bit_cast(bf16x8, uu);
      }
      lrun[hh] = lrun[hh] * alpha + ps;
#pragma unroll
      for (int dt = 0; dt < 4; ++dt) {
        o[hh][dt] *= alpha;
#pragma unroll
        for (int kk = 0; kk < KPI; ++kk)
          o[hh][dt] = __builtin_amdgcn_mfma_f32_16x16x32_bf16(vf[kk][dt], pf[kk], o[hh][dt], 0, 0, 0);
      }
    }
  }
#undef ATT_LOAD
#undef ATT_DESC
#pragma unroll
  for (int hh = 0; hh < NH; ++hh) {
    float l = xrow16_sum(lrun[hh]);
    float m = mrun[hh];
    if (MODE == 2) {
      float sk = sink[hk * NH + hh] * LOG2E;
      float mf = fmaxf(m, sk);
      float a = fast_exp2(m - mf);
      l = l * a + fast_exp2(sk - mf);
#pragma unroll
      for (int dt = 0; dt < 4; ++dt) o[hh][dt] *= a;
    }
    float inv = 1.f / l;
    bf16_t* orow = Op + (size_t)(qrow0 + ql) * ldo + (hk * NH + hh) * 64 + 4 * g;
#pragma unroll
    for (int dt = 0; dt < 4; ++dt) {
      f32x4_t v = o[hh][dt] * inv;
      *(uint2*)(orow + 16 * dt) = make_uint2(pack2bf(v[0], v[1]), pack2bf(v[2], v[3]));
    }
  }
}

struct NaState { f32x4_t o[4][4]; float m[4], l[4]; };
template <int HB>
__device__ __forceinline__ void na_block(NaState& st, const bf16x8 (&qf)[4][2], const bf16x8 (&kf)[2][2], const bf16x8 (&vf)[4],
                                         const float* rpbrow  , int ql, int g) {
  const float SC = 0.125f * 1.4426950408889634f;
#pragma unroll
  for (int jb = 0; jb < 4; ++jb) {
    if (HB == 0 && jb == 3) continue;
    if (HB == 1 && jb == 0) continue;
    f32x4_t s2[2];
#pragma unroll
    for (int t = 0; t < 2; ++t) {
      s2[t] = (f32x4_t){0.f, 0.f, 0.f, 0.f};
      s2[t] = __builtin_amdgcn_mfma_f32_16x16x32_bf16(kf[t][0], qf[jb][0], s2[t], 0, 0, 0);
      s2[t] = __builtin_amdgcn_mfma_f32_16x16x32_bf16(kf[t][1], qf[jb][1], s2[t], 0, 0, 0);
    }
    float lg[8]; bool valid[8]; float bm = -1e30f;
#pragma unroll
    for (int t = 0; t < 2; ++t)
#pragma unroll
      for (int i = 0; i < 4; ++i) {
        float v;
        if (HB < 2) {
          int qc = 16 * jb + ql; int c_lo = min(max(qc - 8, 0), 48);
          int kc = 32 * HB + 8 * g + 4 * t + i;
          bool ok = (kc >= c_lo) && (kc < c_lo + 16);
          int dc = min(max(kc - qc, -15), 15) + 15;
          v = ok ? (s2[t][i] * SC + rpbrow[dc]) : -1e30f;
          valid[4 * t + i] = ok;
        } else { v = s2[t][i] * SC; valid[4 * t + i] = true; }
        lg[4 * t + i] = v; bm = fmaxf(bm, v);
      }
    bm = xrow16_max(bm);
    float mn = fmaxf(st.m[jb], bm);
    float alpha = fast_exp2(st.m[jb] - mn);
    st.m[jb] = mn;
    float ps = 0.f; float pv[8];
#pragma unroll
    for (int e = 0; e < 8; ++e) { float p = valid[e] ? fast_exp2(lg[e] - mn) : 0.f; pv[e] = p; ps += p; }
    st.l[jb] = st.l[jb] * alpha + ps;
    typedef __attribute__((ext_vector_type(4))) unsigned u32x4;
    u32x4 uu = {pack2bf(pv[0], pv[1]), pack2bf(pv[2], pv[3]), pack2bf(pv[4], pv[5]), pack2bf(pv[6], pv[7])};
    bf16x8 pf = __builtin_bit_cast(bf16x8, uu);
#pragma unroll
    for (int dt = 0; dt < 4; ++dt) {
      st.o[jb][dt] *= alpha;
      st.o[jb][dt] = __builtin_amdgcn_mfma_f32_16x16x32_bf16(vf[dt], pf, st.o[jb][dt], 0, 0, 0);
    }
    __builtin_amdgcn_sched_barrier(0);
  }
}
__device__ __forceinline__ void na_unit(int b, int h, int r, const bf16_t* __restrict__ FQKV, const bf16_t* __restrict__ VTl,
                                        const bf16_t* __restrict__ VTc, const float* rpbs, bf16_t* __restrict__ MIX, int lane) {
  asm volatile("" : "+v"(lane));
  int ql = lane & 15, g = lane >> 4;
  int qrow0 = b * S + r * 64;
  int r_start = min(max(r - 4, 0), 120);
  bf16x8 qf[4][2];
#pragma unroll
  for (int jb = 0; jb < 4; ++jb)
#pragma unroll
    for (int s2 = 0; s2 < 2; ++s2)
      qf[jb][s2] = ld16(FQKV + (size_t)(qrow0 + 16 * jb + ql) * 2048 + 512 + h * 64 + 32 * s2 + 8 * g);
  NaState st;
#pragma unroll
  for (int jb = 0; jb < 4; ++jb) {
    st.m[jb] = -1e30f; st.l[jb] = 0.f;
#pragma unroll
    for (int dt = 0; dt < 4; ++dt) st.o[jb][dt] = (f32x4_t){0.f, 0.f, 0.f, 0.f};
  }
  unsigned koff = (unsigned)((8 * (ql >> 2) + (ql & 3)) * 2048 + 1024 + h * 64 + 8 * g);
  unsigned voffl = (unsigned)(ql * S + 8 * g), voffc = (unsigned)(ql * CL + 8 * g);
  const bf16_t* vtl = VTl + (size_t)(b * 8 + h) * 64 * S;
  const bf16_t* vtc = VTc + (size_t)(b * 8 + h) * 64 * CL;
#define NA_LOADK(kb2, KF) { \
    int krow0_; \
    if ((kb2) < 16) krow0_ = b * S + (r_start + ((kb2) >> 1)) * 64 + 32 * ((kb2) & 1); \
    else krow0_ = T + b * CL + 32 * ((kb2) - 16); \
    const bf16_t* kb_ = FQKV + (size_t)krow0_ * 2048; \
    _Pragma("unroll") for (int t = 0; t < 2; ++t) _Pragma("unroll") for (int s2 = 0; s2 < 2; ++s2) \
      KF[t][s2] = ld16(kb_ + (koff + (unsigned)(t * 4 * 2048 + 32 * s2))); }
#define NA_LOADV(kb2, VF) { \
    if ((kb2) < 16) { const bf16_t* vt_ = vtl + (r_start + ((kb2) >> 1)) * 64 + 32 * ((kb2) & 1); \
      _Pragma("unroll") for (int dt = 0; dt < 4; ++dt) VF[dt] = ld16(vt_ + (voffl + (unsigned)(16 * dt * S))); } \
    else { const bf16_t* vt_ = vtc + 32 * ((kb2) - 16); \
      _Pragma("unroll") for (int dt = 0; dt < 4; ++dt) VF[dt] = ld16(vt_ + (voffc + (unsigned)(16 * dt * CL))); } }
  bf16x8 kfa[2][2], kfb[2][2], vf[4];
  NA_LOADK(0, kfa)
#pragma unroll 1
  for (int rr = 0; rr < 8; ++rr) {
    const float* rpbrow = rpbs + (h * 15 + (r_start + rr - r + 7)) * 31;
    asm volatile("" : "+v"(lane)); ql = lane & 15; g = lane >> 4;
    koff = (unsigned)((8 * (ql >> 2) + (ql & 3)) * 2048 + 1024 + h * 64 + 8 * g); voffl = (unsigned)(ql * S + 8 * g);
    NA_LOADV(2 * rr, vf) NA_LOADK(2 * rr + 1, kfb)
    na_block<0>(st, qf, kfa, vf, rpbrow, ql, g);
    NA_LOADV(2 * rr + 1, vf) NA_LOADK(2 * rr + 2, kfa)
    na_block<1>(st, qf, kfb, vf, rpbrow, ql, g);
  }
#pragma unroll 1
  for (int cb = 0; cb < 8; cb += 2) {
    asm volatile("" : "+v"(lane)); ql = lane & 15; g = lane >> 4;
    koff = (unsigned)((8 * (ql >> 2) + (ql & 3)) * 2048 + 1024 + h * 64 + 8 * g); voffc = (unsigned)(ql * CL + 8 * g);
    NA_LOADV(16 + cb, vf) NA_LOADK(16 + cb + 1, kfb)
    na_block<2>(st, qf, kfa, vf, rpbs, ql, g);
    NA_LOADV(16 + cb + 1, vf)
    if (cb + 2 < 8) NA_LOADK(16 + cb + 2, kfa)
    na_block<2>(st, qf, kfb, vf, rpbs, ql, g);
  }
#undef NA_LOADK
#undef NA_LOADV
  asm volatile("" : "+v"(lane)); ql = lane & 15; g = lane >> 4;
#pragma unroll
  for (int jb = 0; jb < 4; ++jb) {
    float inv = 1.f / xrow16_sum(st.l[jb]);
    bf16_t* orow = MIX + (size_t)(qrow0 + 16 * jb + ql) * 1024 + 512 + h * 64 + 4 * g;
#pragma unroll
    for (int dt = 0; dt < 4; ++dt) {
      f32x4_t v = st.o[jb][dt] * inv;
      *(uint2*)(orow + 16 * dt) = make_uint2(pack2bf(v[0], v[1]), pack2bf(v[2], v[3]));
    }
  }
}

__device__ __forceinline__ void ph_chan_dft(const float* __restrict__ F, const float* __restrict__ tab, float* __restrict__ PQ) {
  for (int gid = blockIdx.x * 256 + threadIdx.x; gid < R * 512; gid += gridDim.x * 256) {
    int row = gid >> 9; int col = gid & 511; int g = col >> 6, cp = col & 63;
    const float* f = F + (size_t)row * 2048 + g * 64;
    float p = 0.f, q = 0.f;
    for (int ch = 0; ch < 64; ++ch) {
      int idx = ((ch * cp) & 63) * 128;
      float x = f[ch];
      p += x * tab[idx]; q += x * tab[8192 + idx];
    }
    PQ[(size_t)row * 1024 + col] = p;
    PQ[(size_t)row * 1024 + 512 + col] = q;
  }
}

__device__ __forceinline__ void ph_na(const bf16_t* __restrict__ F, const float* __restrict__ rpb, bf16_t* __restrict__ MIX, float* sm) {
  int lane = threadIdx.x & 63, wave = __builtin_amdgcn_readfirstlane(threadIdx.x >> 6);
  float* sq = sm + wave * 1024; float* sp = sq + 64; int* stok = (int*)(sp + 384);
  int nitems = R * 8;
  for (int item0 = blockIdx.x * 4; item0 < nitems; item0 += gridDim.x * 4) {
    int item = item0 + wave;
    int h = item & 7; int row = item >> 3;
    bool is_ctx = row >= T;
    int b = is_ctx ? (row - T) / CL : row / S;
    __syncthreads();
    sq[lane] = bf2f(F[(size_t)row * 2048 + 512 + h * 64 + lane]);
    __syncthreads();
    int r = 0, c = 0, r_start = 0, c_start = 0;
    if (!is_ctx) { int t = row % S; r = t / 64; c = t % 64; r_start = min(max(r - 4, 0), 120); c_start = min(max(c - 8, 0), 48); }
    int nk = is_ctx ? 256 : 384;
    float lg[6]; float mx = -INFINITY;
#pragma unroll
    for (int kk = 0; kk < 6; ++kk) {
      int j = kk * 64 + lane; float s = -INFINITY; int tok = 0;
      if (j < nk) {
        float bias = 0.f;
        if (!is_ctx && j < 128) {
          int kr = j >> 4, kc = j & 15; int rr = r_start + kr, cc = c_start + kc;
          tok = b * S + rr * 64 + cc;
          int dc = min(max(cc - c, -15), 15) + 15;
          bias = rpb[(h * 15 + (rr - r + 7)) * 31 + dc];
        } else {
          int l = is_ctx ? j : j - 128; tok = T + b * CL + l;
        }
        const bf16_t* kp = F + (size_t)tok * 2048 + 1024 + h * 64;
        float acc = 0.f;
#pragma unroll 8
        for (int d = 0; d < 64; ++d) acc += sq[d] * bf2f(kp[d]);
        s = acc * 0.125f + bias;
      }
      lg[kk] = s; stok[j] = tok; mx = fmaxf(mx, s);
    }
    mx = wave_max(mx);
    float sum = 0.f;
#pragma unroll
    for (int kk = 0; kk < 6; ++kk) { float e = (kk * 64 + lane < nk) ? expf(lg[kk] - mx) : 0.f; lg[kk] = e; sum += e; }
    sum = wave_sum(sum);
    float inv = 1.f / sum;
#pragma unroll
    for (int kk = 0; kk < 6; ++kk) sp[kk * 64 + lane] = lg[kk] * inv;
    __syncthreads();
    float o = 0.f;
    for (int j = 0; j < nk; ++j) o += sp[j] * bf2f(F[(size_t)stok[j] * 2048 + 1536 + h * 64 + lane]);
    MIX[(size_t)row * 1024 + 512 + h * 64 + lane] = (bf16_t)f2bf(o);
  }
}

__device__ __forceinline__ void ph_rope(float* __restrict__ F1) {
  for (int gid = blockIdx.x * 256 + threadIdx.x; gid < T * 20 * 32; gid += gridDim.x * 256) {
    int i = gid & 31; int hh = (gid >> 5) % 20; int row = gid / (32 * 20);
    int t = row % S; float rowp = (float)(t / 64), colp = (float)(t % 64);
    int fi = i & 15;
    float inv_freq = powf(10000.0f, -(float)fi / 16.0f);
    float ang = (i < 16 ? rowp : colp) * inv_freq;
    float cs = cosf(ang), sn = sinf(ang);
    float* p = F1 + (size_t)row * 1536 + hh * 64;
    float x1 = p[i], x2 = p[i + 32];
    p[i] = x1 * cs - x2 * sn;
    p[i + 32] = x1 * sn + x2 * cs;
  }
}

__device__ __forceinline__ void ph_gqa(const float* __restrict__ F1, const float* __restrict__ sink, bf16_t* __restrict__ O, float* sm) {
  int lane = threadIdx.x & 63, wave = __builtin_amdgcn_readfirstlane(threadIdx.x >> 6);
  float* sq = sm + wave * 1280; float* sp = sq + 64; int* stok = (int*)(sp + 576);
  int nitems = T * 16;
  for (int item0 = blockIdx.x * 4; item0 < nitems; item0 += gridDim.x * 4) {
    int item = item0 + wave;
    int qh = item & 15; int row = item >> 4; int kvh = qh >> 2;
    int b = row / S; int t = row % S;
    __syncthreads();
    sq[lane] = F1[(size_t)row * 1536 + qh * 64 + lane];
    __syncthreads();
    float lg[9]; float mx = -INFINITY;
#pragma unroll
    for (int kk = 0; kk < 9; ++kk) {
      int j = kk * 64 + lane; float s = -INFINITY; int tok = 0; bool valid = false;
      if (j < 257) { int pos = t - 128 + j; valid = (pos >= 0 && pos < S); tok = b * S + pos; }
      else if (j < 513) { valid = true; tok = T + b * CL + (j - 257); }
      if (valid) {
        const float* kp = F1 + (size_t)tok * 1536 + 1024 + kvh * 64;
        float acc = 0.f;
#pragma unroll 8
        for (int d = 0; d < 64; ++d) acc += sq[d] * kp[d];
        s = acc * 0.125f;
      } else tok = 0;
      lg[kk] = s; stok[j] = tok; mx = fmaxf(mx, s);
    }
    mx = wave_max(mx);
    float sk = sink[qh];
    mx = fmaxf(mx, sk);
    float sum = 0.f;
#pragma unroll
    for (int kk = 0; kk < 9; ++kk) { float e = (lg[kk] == -INFINITY) ? 0.f : expf(lg[kk] - mx); lg[kk] = e; sum += e; }
    sum = wave_sum(sum) + expf(sk - mx);
    float inv = 1.f / sum;
#pragma unroll
    for (int kk = 0; kk < 9; ++kk) sp[kk * 64 + lane] = lg[kk] * inv;
    __syncthreads();
    float o = 0.f;
    for (int j = 0; j < 513; ++j) { float p = sp[j]; if (p != 0.f) o += p * F1[(size_t)stok[j] * 1536 + 1280 + kvh * 64 + lane]; }
    O[(size_t)row * 1024 + qh * 64 + lane] = (bf16_t)f2bf(o);
  }
}

__device__ __forceinline__ void wave_argmax(float& v, int& idx) {
#pragma unroll
  for (int off = 32; off; off >>= 1) {
    float ov = __shfl_xor(v, off); int oi = __shfl_xor(idx, off);
    if (ov > v || (ov == v && oi < idx)) { v = ov; idx = oi; }
  }
}
__device__ __forceinline__ void ph_peer_select_naive(const float* __restrict__ Q, const float* __restrict__ sk, int* __restrict__ EXP,
                                     float* __restrict__ GATE, int nrows, float* sm) {
  int lane = threadIdx.x & 63, wave = __builtin_amdgcn_readfirstlane(threadIdx.x >> 6);
  float* sq = sm + wave * 640; float* tops = sq + 256; int* topi = (int*)(tops + 32);
  for (int row0 = blockIdx.x * 4; row0 < nrows; row0 += gridDim.x * 4) {
    int row = row0 + wave;
    for (int h = 0; h < 8; ++h) {
      __syncthreads();
#pragma unroll
      for (int i = 0; i < 4; ++i) sq[lane + 64 * i] = Q[(size_t)row * 2048 + h * 256 + lane + 64 * i];
      __syncthreads();
      for (int p = 0; p < 2; ++p) {
        float s0 = 0.f, s1 = 0.f;
        const float* k0 = sk + ((size_t)((h * 2 + p) * 128 + lane)) * 128;
        const float* k1 = k0 + 64 * 128;
#pragma unroll 8
        for (int d = 0; d < 128; ++d) { float qv = sq[p * 128 + d]; s0 += qv * k0[d]; s1 += qv * k1[d]; }
        for (int i = 0; i < 16; ++i) {
          float v; int idx;
          if (s0 >= s1) { v = s0; idx = lane; } else { v = s1; idx = lane + 64; }
          wave_argmax(v, idx);
          if (lane == 0) { tops[p * 16 + i] = v; topi[p * 16 + i] = idx; }
          if (idx == lane) s0 = -INFINITY;
          if (idx == lane + 64) s1 = -INFINITY;
        }
      }
      __syncthreads();
      float cs[4];
#pragma unroll
      for (int i = 0; i < 4; ++i) { int ci = lane * 4 + i; cs[i] = tops[ci >> 4] + tops[16 + (ci & 15)]; }
      float bs[16]; int be[16];
#pragma unroll
      for (int k = 0; k < 16; ++k) {
        float v = cs[0]; int idx = lane * 4;
#pragma unroll
        for (int i = 1; i < 4; ++i) if (cs[i] > v) { v = cs[i]; idx = lane * 4 + i; }
        wave_argmax(v, idx);
        bs[k] = v; be[k] = topi[idx >> 4] * 128 + topi[16 + (idx & 15)];
#pragma unroll
        for (int i = 0; i < 4; ++i) if (idx == lane * 4 + i) cs[i] = -INFINITY;
      }
      float mxs = bs[0]; float sum = 0.f;
#pragma unroll
      for (int k = 0; k < 16; ++k) { bs[k] = expf(bs[k] - mxs); sum += bs[k]; }
      float inv = 1.f / sum;
      if (lane == 0) {
#pragma unroll
        for (int k = 0; k < 16; ++k) { EXP[(size_t)row * 128 + h * 16 + k] = be[k]; GATE[(size_t)row * 128 + h * 16 + k] = bs[k] * inv; }
      }
    }
  }
}

__device__ __forceinline__ void unpack8(uint4 v, float* f) {
  f[0] = __uint_as_float(v.x << 16); f[1] = __uint_as_float(v.x & 0xffff0000u);
  f[2] = __uint_as_float(v.y << 16); f[3] = __uint_as_float(v.y & 0xffff0000u);
  f[4] = __uint_as_float(v.z << 16); f[5] = __uint_as_float(v.z & 0xffff0000u);
  f[6] = __uint_as_float(v.w << 16); f[7] = __uint_as_float(v.w & 0xffff0000u);
}
__device__ __forceinline__ void ph_peer_gather(bf16_t* __restrict__ H, const int* __restrict__ EXP, const float* __restrict__ GATE,
                               const bf16_t* __restrict__ U, const bf16_t* __restrict__ V,
                               const float* __restrict__ xin, const float* __restrict__ M, int layer,
                               const float* __restrict__ g, const float* __restrict__ bb, float* __restrict__ xout,
                               bool write_next, int nrows) {
  int lane = threadIdx.x & 63, wave = __builtin_amdgcn_readfirstlane(threadIdx.x >> 6);
  for (int row = blockIdx.x * 4 + wave; row < nrows; row += gridDim.x * 4) {
    float hreg[16];
    {
      const uint4* hp = (const uint4*)(H + (size_t)row * D + 8 * lane);
      unpack8(hp[0], hreg); unpack8(hp[64], hreg + 8);
    }
    float acc[16];
#pragma unroll
    for (int i = 0; i < 16; ++i) acc[i] = 0.f;
    int e_lo = EXP[(size_t)row * 128 + lane], e_hi = EXP[(size_t)row * 128 + 64 + lane];
    float g_lo = GATE[(size_t)row * 128 + lane], g_hi = GATE[(size_t)row * 128 + 64 + lane];
    uint4 ua[4], ub[4], va[4], vb[4];
#pragma unroll
    for (int i = 0; i < 4; ++i) {
      int e = __builtin_amdgcn_readlane(e_lo, i);
      const uint4* up = (const uint4*)(U + (size_t)e * D + 8 * lane); ua[i] = up[0]; ub[i] = up[64];
    }
#pragma unroll 1
    for (int b = 0; b < 32; ++b) {
      int k0 = 4 * b;
      int ev = (b < 16) ? e_lo : e_hi; float gv = (b < 16) ? g_lo : g_hi;
      int en = (b + 1 < 16) ? e_lo : e_hi;
      float gt[4];
#pragma unroll
      for (int i = 0; i < 4; ++i) {
        int e = __builtin_amdgcn_readlane(ev, (k0 + i) & 63);
        gt[i] = __uint_as_float(__builtin_amdgcn_readlane(__float_as_uint(gv), (k0 + i) & 63));
        const uint4* vp = (const uint4*)(V + (size_t)e * D + 8 * lane); va[i] = vp[0]; vb[i] = vp[64];
      }
      float a[4];
#pragma unroll
      for (int i = 0; i < 4; ++i) {
        float f[16]; unpack8(ua[i], f); unpack8(ub[i], f + 8);
        float sacc = 0.f;
#pragma unroll
        for (int j = 0; j < 16; ++j) sacc += f[j] * hreg[j];
        a[i] = sacc;
      }
      if (b + 1 < 32) {
#pragma unroll
        for (int i = 0; i < 4; ++i) {
          int e = __builtin_amdgcn_readlane(en, (k0 + 4 + i) & 63);
          const uint4* up = (const uint4*)(U + (size_t)e * D + 8 * lane); ua[i] = up[0]; ub[i] = up[64];
        }
      }
#pragma unroll
      for (int i = 0; i < 4; ++i) a[i] = wave_sum(a[i]);
#pragma unroll
      for (int i = 0; i < 4; ++i) {
        float w = gt[i] * 0.5f * a[i] * (1.f + erff(a[i] * 0.70710678118654752f));
        float f[16]; unpack8(va[i], f); unpack8(vb[i], f + 8);
#pragma unroll
        for (int j = 0; j < 16; ++j) acc[j] += w * f[j];
      }
    }
    const float* m = M + ((size_t)layer * 3 + mod_index(row)) * 6144;
    const float* xr = xin + (size_t)row * D;
    float v[16];
#pragma unroll
    for (int hh = 0; hh < 2; ++hh) {
      int d0 = hh * 512 + 8 * lane;
      float4 x0 = *(const float4*)(xr + d0), x1 = *(const float4*)(xr + d0 + 4);
      float4 m0 = *(const float4*)(m + 5 * D + d0), m1 = *(const float4*)(m + 5 * D + d0 + 4);
      v[hh * 8 + 0] = DN_ALPHA * x0.x + m0.x * acc[hh * 8 + 0]; v[hh * 8 + 1] = DN_ALPHA * x0.y + m0.y * acc[hh * 8 + 1];
      v[hh * 8 + 2] = DN_ALPHA * x0.z + m0.z * acc[hh * 8 + 2]; v[hh * 8 + 3] = DN_ALPHA * x0.w + m0.w * acc[hh * 8 + 3];
      v[hh * 8 + 4] = DN_ALPHA * x1.x + m1.x * acc[hh * 8 + 4]; v[hh * 8 + 5] = DN_ALPHA * x1.y + m1.y * acc[hh * 8 + 5];
      v[hh * 8 + 6] = DN_ALPHA * x1.z + m1.z * acc[hh * 8 + 6]; v[hh * 8 + 7] = DN_ALPHA * x1.w + m1.w * acc[hh * 8 + 7];
    }
    float s = 0.f;
#pragma unroll
    for (int j = 0; j < 16; ++j) s += v[j];
    float mu = wave_sum(s) * (1.f / D);
    float q = 0.f;
#pragma unroll
    for (int j = 0; j < 16; ++j) { float d = v[j] - mu; q += d * d; }
    float rs = rsqrtf(wave_sum(q) * (1.f / D) + LN_EPS);
    float y[16];
#pragma unroll
    for (int hh = 0; hh < 2; ++hh) {
      int d0 = hh * 512 + 8 * lane;
#pragma unroll
      for (int j = 0; j < 8; ++j) y[hh * 8 + j] = (v[hh * 8 + j] - mu) * rs * g[d0 + j] + bb[d0 + j];
      *(float4*)(xout + (size_t)row * D + d0) = make_float4(y[hh * 8], y[hh * 8 + 1], y[hh * 8 + 2], y[hh * 8 + 3]);
      *(float4*)(xout + (size_t)row * D + d0 + 4) = make_float4(y[hh * 8 + 4], y[hh * 8 + 5], y[hh * 8 + 6], y[hh * 8 + 7]);
    }
    if (write_next) {
      const float* mn = M + ((size_t)(layer + 1) * 3 + mod_index(row)) * 6144;
      float s2 = 0.f;
#pragma unroll
      for (int j = 0; j < 16; ++j) s2 += y[j];
      float mu2 = wave_sum(s2) * (1.f / D);
      float q2 = 0.f;
#pragma unroll
      for (int j = 0; j < 16; ++j) { float d = y[j] - mu2; q2 += d * d; }
      float rs2 = rsqrtf(wave_sum(q2) * (1.f / D) + LN_EPS);
#pragma unroll
      for (int hh = 0; hh < 2; ++hh) {
        int d0 = hh * 512 + 8 * lane;
        float o[8];
#pragma unroll
        for (int j = 0; j < 8; ++j) o[j] = (y[hh * 8 + j] - mu2) * rs2 * (1.f + mn[D + d0 + j]) + mn[d0 + j];
        *(uint4*)(H + (size_t)row * D + d0) = make_uint4(pack2bf(o[0], o[1]), pack2bf(o[2], o[3]), pack2bf(o[4], o[5]), pack2bf(o[6], o[7]));
      }
    }
  }
}


__device__ __forceinline__ void ph_quant_rows(const float* __restrict__ src, unsigned char* __restrict__ dst, float* __restrict__ scale, int nrows) {
  int lane = threadIdx.x & 63, wave = __builtin_amdgcn_readfirstlane(threadIdx.x >> 6);
  for (int row = blockIdx.x * 4 + wave; row < nrows; row += gridDim.x * 4) {
    const float4* sp = (const float4*)(src + (size_t)row * D + 16 * lane);
    float4 v0 = sp[0], v1 = sp[1], v2 = sp[2], v3 = sp[3];
    float x[16] = {v0.x, v0.y, v0.z, v0.w, v1.x, v1.y, v1.z, v1.w, v2.x, v2.y, v2.z, v2.w, v3.x, v3.y, v3.z, v3.w};
    float am = 0.f;
#pragma unroll
    for (int j = 0; j < 16; ++j) am = fmaxf(am, fabsf(x[j]));
    am = wave_max(am);
    float inv = am > 0.f ? 127.f / am : 0.f;
    unsigned wv[4];
#pragma unroll
    for (int k = 0; k < 4; ++k) {
      unsigned w = 0;
#pragma unroll
      for (int j = 0; j < 4; ++j) {
        int q = (int)rintf(x[4 * k + j] * inv);
        w |= ((unsigned)q & 0xffu) << (8 * j);
      }
      wv[k] = w;
    }
    *(uint4*)(dst + ((size_t)(row >> 14) * 8 + (lane >> 3)) * ((size_t)16384 * 128) + (size_t)(row & 16383) * 128 + 16 * (lane & 7)) = make_uint4(wv[0], wv[1], wv[2], wv[3]);
    if (lane == 0) scale[row] = am * (1.f / 127.f);
  }
}
__device__ __forceinline__ void unpack_u8x16(uint4 v, float* f) {
  unsigned w[4] = {v.x, v.y, v.z, v.w};
#pragma unroll
  for (int k = 0; k < 4; ++k) {
    f[4 * k + 0] = (float)(w[k] & 0xffu); f[4 * k + 1] = (float)((w[k] >> 8) & 0xffu);
    f[4 * k + 2] = (float)((w[k] >> 16) & 0xffu); f[4 * k + 3] = (float)(w[k] >> 24);
  }
}
__device__ __forceinline__ void ph_peer_gather8(bf16_t* __restrict__ H, const int* __restrict__ EXP, const float* __restrict__ GATE,
                               const unsigned char* __restrict__ U8, const float* __restrict__ USC,
                               const unsigned char* __restrict__ V8, const float* __restrict__ VSC,
                               const float* __restrict__ xin, const float* __restrict__ M, int layer,
                               const float* __restrict__ g, const float* __restrict__ bb, float* __restrict__ xout,
                               bool write_next, int nrows) {
  int lane = threadIdx.x & 63, wave = __builtin_amdgcn_readfirstlane(threadIdx.x >> 6);
  for (int row = blockIdx.x * 4 + wave; row < nrows; row += gridDim.x * 4) {
    float hreg[16];
    {
      const uint4* hp = (const uint4*)(H + (size_t)row * D + 16 * lane);
      unpack8(hp[0], hreg); unpack8(hp[1], hreg + 8);
    }
    float hs = 0.f;
#pragma unroll
    for (int j = 0; j < 16; ++j) hs += hreg[j];
    float hsum128 = 128.f * wave_sum(hs);
    float acc[16];
#pragma unroll
    for (int i = 0; i < 16; ++i) acc[i] = 0.f;
    float wsum = 0.f;
    int e_lo = EXP[(size_t)row * 128 + lane], e_hi = EXP[(size_t)row * 128 + 64 + lane];
    float g_lo = GATE[(size_t)row * 128 + lane], g_hi = GATE[(size_t)row * 128 + 64 + lane];
    float us_lo = USC[e_lo], us_hi = USC[e_hi], vs_lo = VSC[e_lo], vs_hi = VSC[e_hi];
    uint4 ua[8], va[8];
#pragma unroll
    for (int i = 0; i < 8; ++i) {
      int e = __builtin_amdgcn_readlane(e_lo, i);
      ua[i] = *(const uint4*)(U8 + (size_t)e * D + 16 * lane);
    }
#pragma unroll 1
    for (int b = 0; b < 16; ++b) {
      int k0 = 8 * b;
      bool lo = b < 8, lon = (b + 1) < 8;
      int ev = lo ? e_lo : e_hi; float gv = lo ? g_lo : g_hi; float usv = lo ? us_lo : us_hi; float vsv = lo ? vs_lo : vs_hi;
      int en = lon ? e_lo : e_hi;
      float gt[8], usc[8], vsc[8];
#pragma unroll
      for (int i = 0; i < 8; ++i) {
        int li = (k0 + i) & 63;
        int e = __builtin_amdgcn_readlane(ev, li);
        gt[i] = __uint_as_float(__builtin_amdgcn_readlane(__float_as_uint(gv), li));
        usc[i] = __uint_as_float(__builtin_amdgcn_readlane(__float_as_uint(usv), li));
        vsc[i] = __uint_as_float(__builtin_amdgcn_readlane(__float_as_uint(vsv), li));
        va[i] = *(const uint4*)(V8 + (size_t)e * D + 16 * lane);
      }
      float a[8];
#pragma unroll
      for (int i = 0; i < 8; ++i) {
        float f[16]; unpack_u8x16(ua[i], f);
        float sacc = 0.f;
#pragma unroll
        for (int j = 0; j < 16; ++j) sacc += f[j] * hreg[j];
        a[i] = sacc;
      }
      if (b + 1 < 16) {
#pragma unroll
        for (int i = 0; i < 8; ++i) {
          int e = __builtin_amdgcn_readlane(en, (k0 + 8 + i) & 63);
          ua[i] = *(const uint4*)(U8 + (size_t)e * D + 16 * lane);
        }
      }
#pragma unroll
      for (int i = 0; i < 8; ++i) a[i] = (wave_sum(a[i]) - hsum128) * usc[i];
#pragma unroll
      for (int i = 0; i < 8; ++i) {
        float w = gt[i] * 0.5f * a[i] * (1.f + erff(a[i] * 0.70710678118654752f)) * vsc[i];
        wsum += w;
        float f[16]; unpack_u8x16(va[i], f);
#pragma unroll
        for (int j = 0; j < 16; ++j) acc[j] += w * f[j];
      }
    }
    float corr = 128.f * wsum;
#pragma unroll
    for (int j = 0; j < 16; ++j) acc[j] -= corr;
    const float* m = M + ((size_t)layer * 3 + mod_index(row)) * 6144;
    const float* xr = xin + (size_t)row * D + 16 * lane;
    const float* m5 = m + 5 * D + 16 * lane;
    float v[16];
#pragma unroll
    for (int q4 = 0; q4 < 4; ++q4) {
      float4 x0 = *(const float4*)(xr + 4 * q4); float4 m0 = *(const float4*)(m5 + 4 * q4);
      v[4 * q4 + 0] = DN_ALPHA * x0.x + m0.x * acc[4 * q4 + 0]; v[4 * q4 + 1] = DN_ALPHA * x0.y + m0.y * acc[4 * q4 + 1];
      v[4 * q4 + 2] = DN_ALPHA * x0.z + m0.z * acc[4 * q4 + 2]; v[4 * q4 + 3] = DN_ALPHA * x0.w + m0.w * acc[4 * q4 + 3];
    }
    float s = 0.f;
#pragma unroll
    for (int j = 0; j < 16; ++j) s += v[j];
    float mu = wave_sum(s) * (1.f / D);
    float q = 0.f;
#pragma unroll
    for (int j = 0; j < 16; ++j) { float d = v[j] - mu; q += d * d; }
    float rs = rsqrtf(wave_sum(q) * (1.f / D) + LN_EPS);
    float y[16];
    {
      const float* gp = g + 16 * lane; const float* bp = bb + 16 * lane;
      float* op = xout + (size_t)row * D + 16 * lane;
#pragma unroll
      for (int q4 = 0; q4 < 4; ++q4) {
        float4 g4 = *(const float4*)(gp + 4 * q4); float4 b4 = *(const float4*)(bp + 4 * q4);
        y[4 * q4 + 0] = (v[4 * q4 + 0] - mu) * rs * g4.x + b4.x; y[4 * q4 + 1] = (v[4 * q4 + 1] - mu) * rs * g4.y + b4.y;
        y[4 * q4 + 2] = (v[4 * q4 + 2] - mu) * rs * g4.z + b4.z; y[4 * q4 + 3] = (v[4 * q4 + 3] - mu) * rs * g4.w + b4.w;
        *(float4*)(op + 4 * q4) = make_float4(y[4 * q4], y[4 * q4 + 1], y[4 * q4 + 2], y[4 * q4 + 3]);
      }
    }
    if (write_next) {
      const float* mn = M + ((size_t)(layer + 1) * 3 + mod_index(row)) * 6144 + 16 * lane;
      float s2 = 0.f;
#pragma unroll
      for (int j = 0; j < 16; ++j) s2 += y[j];
      float mu2 = wave_sum(s2) * (1.f / D);
      float q2 = 0.f;
#pragma unroll
      for (int j = 0; j < 16; ++j) { float d = y[j] - mu2; q2 += d * d; }
      float rs2 = rsqrtf(wave_sum(q2) * (1.f / D) + LN_EPS);
      float o[16];
#pragma unroll
      for (int j = 0; j < 16; ++j) o[j] = (y[j] - mu2) * rs2 * (1.f + mn[D + j]) + mn[j];
      uint4* hp = (uint4*)(H + (size_t)row * D + 16 * lane);
      hp[0] = make_uint4(pack2bf(o[0], o[1]), pack2bf(o[2], o[3]), pack2bf(o[4], o[5]), pack2bf(o[6], o[7]));
      hp[1] = make_uint4(pack2bf(o[8], o[9]), pack2bf(o[10], o[11]), pack2bf(o[12], o[13]), pack2bf(o[14], o[15]));
    }
  }
}


__device__ __forceinline__ void ph_ada2(const float* __restrict__ c, const float* __restrict__ c_ctx, const float* __restrict__ ada_w,
                                        const float* __restrict__ ada_b, float* __restrict__ M, float* sm) {
  int tid = threadIdx.x, lane = tid & 63, wave = __builtin_amdgcn_readfirstlane(tid >> 6);
  float* sv = sm;
  float* red = sm + 3072;
  bool filled = false;
  GRID_LOOP(u, 192) {
    if (!filled) {
      for (int i = tid; i < 3072; i += 256) {
        int idx = i >> 10, k = i & 1023;
        float x = idx < 2 ? c[idx * D + k] : c_ctx[k];
        sv[i] = x / (1.f + expf(-x));
      }
      filled = true;
    }
    __syncthreads();
    int layer = u / 96, c0 = (u % 96) * 64;
    const float* w = ada_w + (size_t)layer * D * 6144 + c0 + lane;
    float a0 = 0.f, a1 = 0.f, a2 = 0.f;
    int kb = wave * 256;
#pragma unroll 16
    for (int k = 0; k < 256; ++k) {
      float wv = w[(size_t)(kb + k) * 6144];
      a0 += sv[kb + k] * wv; a1 += sv[1024 + kb + k] * wv; a2 += sv[2048 + kb + k] * wv;
    }
    red[(wave * 3 + 0) * 64 + lane] = a0; red[(wave * 3 + 1) * 64 + lane] = a1; red[(wave * 3 + 2) * 64 + lane] = a2;
    __syncthreads();
    if (wave < 3) {
      float r = red[(0 * 3 + wave) * 64 + lane] + red[(1 * 3 + wave) * 64 + lane] + red[(2 * 3 + wave) * 64 + lane] + red[(3 * 3 + wave) * 64 + lane];
      M[((size_t)layer * 3 + wave) * 6144 + c0 + lane] = r + ada_b[layer * 6144 + c0 + lane];
    }
  }
  __syncthreads();
}

__device__ __forceinline__ void ph_post_mod(const float* __restrict__ xa, const float* __restrict__ xb, const bf16_t* __restrict__ Y,
                                            const float* __restrict__ M, int layer, int jres, int mlayer, int jshift, int jscale, bool do_mod,
                                            const float* __restrict__ g, const float* __restrict__ bb,
                                            float* __restrict__ xout, bf16_t* __restrict__ H, int nrows) {
  int lane = threadIdx.x & 63, wave = __builtin_amdgcn_readfirstlane(threadIdx.x >> 6);
  for (int row = blockIdx.x * 4 + wave; row < nrows; row += gridDim.x * 4) {
    const float* xr = (row < T ? xa + (size_t)row * D : xb + (size_t)(row - T) * D) + 16 * lane;
    const float* m = M + ((size_t)layer * 3 + mod_index(row)) * 6144 + 16 * lane;
    float yv[16];
    {
      const uint4* yp = (const uint4*)(Y + (size_t)row * D + 16 * lane);
      unpack8(yp[0], yv); unpack8(yp[1], yv + 8);
    }
    float v[16];
#pragma unroll
    for (int q4 = 0; q4 < 4; ++q4) {
      float4 x0 = *(const float4*)(xr + 4 * q4); float4 m0 = *(const float4*)(m + jres * D + 4 * q4);
      v[4 * q4 + 0] = DN_ALPHA * x0.x + m0.x * yv[4 * q4 + 0]; v[4 * q4 + 1] = DN_ALPHA * x0.y + m0.y * yv[4 * q4 + 1];
      v[4 * q4 + 2] = DN_ALPHA * x0.z + m0.z * yv[4 * q4 + 2]; v[4 * q4 + 3] = DN_ALPHA * x0.w + m0.w * yv[4 * q4 + 3];
    }
    float s = 0.f;
#pragma unroll
    for (int j = 0; j < 16; ++j) s += v[j];
    float mu = wave_sum(s) * (1.f / D);
    float q = 0.f;
#pragma unroll
    for (int j = 0; j < 16; ++j) { float d = v[j] - mu; q += d * d; }
    float rs = rsqrtf(wave_sum(q) * (1.f / D) + LN_EPS);
    float y[16];
    {
      const float* gp = g + 16 * lane; const float* bp = bb + 16 * lane;
      float* op = xout + (size_t)row * D + 16 * lane;
#pragma unroll
      for (int q4 = 0; q4 < 4; ++q4) {
        float4 g4 = *(const float4*)(gp + 4 * q4); float4 b4 = *(const float4*)(bp + 4 * q4);
        y[4 * q4 + 0] = (v[4 * q4 + 0] - mu) * rs * g4.x + b4.x; y[4 * q4 + 1] = (v[4 * q4 + 1] - mu) * rs * g4.y + b4.y;
        y[4 * q4 + 2] = (v[4 * q4 + 2] - mu) * rs * g4.z + b4.z; y[4 * q4 + 3] = (v[4 * q4 + 3] - mu) * rs * g4.w + b4.w;
        *(float4*)(op + 4 * q4) = make_float4(y[4 * q4], y[4 * q4 + 1], y[4 * q4 + 2], y[4 * q4 + 3]);
      }
    }
    if (do_mod) {
      const float* mm = M + ((size_t)mlayer * 3 + mod_index(row)) * 6144 + 16 * lane;
      float s2 = 0.f;
#pragma unroll
      for (int j = 0; j < 16; ++j) s2 += y[j];
      float mu2 = wave_sum(s2) * (1.f / D);
      float q2 = 0.f;
#pragma unroll
      for (int j = 0; j < 16; ++j) { float d = y[j] - mu2; q2 += d * d; }
      float rs2 = rsqrtf(wave_sum(q2) * (1.f / D) + LN_EPS);
      float o[16];
#pragma unroll
      for (int j = 0; j < 16; ++j) o[j] = (y[j] - mu2) * rs2 * (1.f + mm[jscale * D + j]) + mm[jshift * D + j];
      uint4* hp = (uint4*)(H + (size_t)row * D + 16 * lane);
      hp[0] = make_uint4(pack2bf(o[0], o[1]), pack2bf(o[2], o[3]), pack2bf(o[4], o[5]), pack2bf(o[6], o[7]));
      hp[1] = make_uint4(pack2bf(o[8], o[9]), pack2bf(o[10], o[11]), pack2bf(o[12], o[13]), pack2bf(o[14], o[15]));
    }
  }
}


template <int CTRL> __device__ __forceinline__ float dpp_add(float x) { return x + dpp_mov<CTRL>(x); }
__device__ __forceinline__ float sum8(float v) {
  v = dpp_add<0xB1>(v); v = dpp_add<0x4E>(v); v = dpp_add<0x141>(v); return v;
}
typedef _Float16 half2_t __attribute__((ext_vector_type(2)));
__device__ __forceinline__ float dot2h(unsigned a, unsigned b, float c) {
  return __builtin_amdgcn_fdot2(__builtin_bit_cast(half2_t, a), __builtin_bit_cast(half2_t, b), c, false);
}
__device__ __forceinline__ unsigned pkh(float a, float b) { return __builtin_bit_cast(unsigned, __builtin_amdgcn_cvt_pkrtz(a, b)); }
__device__ __forceinline__ void load_e16(const int* __restrict__ EXP, int t, int g8, int (&e)[16]) {
  const int4* ep = (const int4*)(EXP + (size_t)t * 128 + 16 * g8);
  int4 a = ep[0], b = ep[1], c = ep[2], d = ep[3];
  e[0] = a.x; e[1] = a.y; e[2] = a.z; e[3] = a.w; e[4] = b.x; e[5] = b.y; e[6] = b.z; e[7] = b.w;
  e[8] = c.x; e[9] = c.y; e[10] = c.z; e[11] = c.w; e[12] = d.x; e[13] = d.y; e[14] = d.z; e[15] = d.w;
}
#define U_TOKEN(tt, UV, UVN, EUSE, ELD, HUSE, HLD) { \
    int tnn_ = min((tt) + 2 * st, nrows - 1); \
    load_e16(EXP, tnn_, g8, ELD); \
    HLD[0] = *(const uint4*)(hb + (size_t)tnn_ * D); HLD[1] = *(const uint4*)(hb + (size_t)tnn_ * D + 8); \
    __builtin_amdgcn_sched_barrier(0); \
    _Pragma("unroll") for (int i = 0; i < 16; ++i) UVN[i] = *(const uint4*)(ubs + (((unsigned)EUSE[i] << 7) + loff)); \
    __builtin_amdgcn_sched_barrier(0); \
    float h16[16]; unpack8(HUSE[0], h16); unpack8(HUSE[1], h16 + 8); \
    float hm = 0.f; \
    _Pragma("unroll") for (int j = 0; j < 16; ++j) hm = fmaxf(hm, fabsf(h16[j])); \
    hm = fmaxf(hm, dpp_mov<0xB1>(hm)); hm = fmaxf(hm, dpp_mov<0x4E>(hm)); hm = fmaxf(hm, dpp_mov<0x141>(hm)); \
    float hinv = hm > 0.f ? 127.f / hm : 0.f; float hsc = hm * (1.f / 127.f); \
    int hq[4]; \
    _Pragma("unroll") for (int k = 0; k < 4; ++k) { unsigned w_ = 0; \
      _Pragma("unroll") for (int j = 0; j < 4; ++j) w_ = __builtin_amdgcn_cvt_pk_u8_f32(rintf(h16[4 * k + j] * hinv) + 128.f, j, w_); \
      hq[k] = (int)(w_ ^ 0x80808080u); }        \
    float k0 = 0.f, k1 = 0.f; \
    _Pragma("unroll") for (int i = 0; i < 16; ++i) { \
      int p_ = __builtin_amdgcn_sdot4((int)UV[i].x, hq[0], 0, false); p_ = __builtin_amdgcn_sdot4((int)UV[i].y, hq[1], p_, false); \
      p_ = __builtin_amdgcn_sdot4((int)UV[i].z, hq[2], p_, false); p_ = __builtin_amdgcn_sdot4((int)UV[i].w, hq[3], p_, false); \
      float p = sum8((float)p_) * hsc; \
      if ((i >> 1) == j8) { if (i & 1) k1 = p; else k0 = p; } } \
    *(float2*)(PA + ((size_t)(tt) * 8 + x) * 128 + 16 * g8 + 2 * j8) = make_float2(k0, k1); }
__device__ __forceinline__ void ph_peer_u(const bf16_t* __restrict__ H, const int* __restrict__ EXP, const unsigned char* __restrict__ U8,
                                          float* __restrict__ PA, int nrows) {
  int lane = threadIdx.x & 63, wave = __builtin_amdgcn_readfirstlane(threadIdx.x >> 6);
  int x = blockIdx.x & 7; int nb8 = gridDim.x >> 3;
  if ((int)(blockIdx.x >> 3) >= nb8) return;
  int j8 = lane & 7, g8 = lane >> 3;
  const int st = nb8 * 4;
  int t = (blockIdx.x >> 3) * 4 + wave;
  if (t >= nrows) return;
  const unsigned char* ubs = U8 + (size_t)x * ((size_t)16384 * 128);
  const unsigned loff = 16u * (unsigned)j8;
  const bf16_t* hb = H + 128 * x + 16 * j8;
  int eA[16], eB[16]; uint4 hA[2], hB[2], uvA[16], uvB[16];
  {
    int e0[16]; load_e16(EXP, t, g8, e0);
#pragma unroll
    for (int i = 0; i < 16; ++i) uvA[i] = *(const uint4*)(ubs + (((unsigned)e0[i] << 7) + loff));
    hA[0] = *(const uint4*)(hb + (size_t)t * D); hA[1] = *(const uint4*)(hb + (size_t)t * D + 8);
    int tn = min(t + st, nrows - 1);
    load_e16(EXP, tn, g8, eA);
    hB[0] = *(const uint4*)(hb + (size_t)tn * D); hB[1] = *(const uint4*)(hb + (size_t)tn * D + 8);
  }
#pragma unroll 1
  for (; t < nrows; t += 2 * st) {
    uint4 hC[2];
    U_TOKEN(t, uvA, uvB, eA, eB, hA, hC)
    if (t + st < nrows) {
      U_TOKEN(t + st, uvB, uvA, eB, eA, hB, hA)
    }
    hB[0] = hA[0]; hB[1] = hA[1]; hA[0] = hC[0]; hA[1] = hC[1];
  }
}
__device__ __forceinline__ void ph_peer_w(const float* __restrict__ PA, const int* __restrict__ EXP, const float* __restrict__ GATE,
                                          const float* __restrict__ USC, const float* __restrict__ VSC, unsigned* __restrict__ WQ,
                                          float* __restrict__ SW, int nrows) {
  int lane = threadIdx.x & 63, wave = __builtin_amdgcn_readfirstlane(threadIdx.x >> 6);
  int l4 = lane & 31;
  for (int t = blockIdx.x * 4 + wave; t < nrows; t += gridDim.x * 4) {
    int4 e = *(const int4*)(EXP + (size_t)t * 128 + 4 * l4);
    float4 gt = *(const float4*)(GATE + (size_t)t * 128 + 4 * l4);
    float a[4] = {0.f, 0.f, 0.f, 0.f};
#pragma unroll
    for (int xs = 0; xs < 8; ++xs) { float4 p = *(const float4*)(PA + ((size_t)t * 8 + xs) * 128 + 4 * l4); a[0] += p.x; a[1] += p.y; a[2] += p.z; a[3] += p.w; }
    int ee[4] = {e.x, e.y, e.z, e.w}; float gg[4] = {gt.x, gt.y, gt.z, gt.w}; float w[4]; float wm = 0.f;
#pragma unroll
    for (int j = 0; j < 4; ++j) {
      float av = a[j] * USC[ee[j]];
      w[j] = gg[j] * 0.5f * av * (1.f + erff(av * 0.70710678118654752f)) * VSC[ee[j]];
      wm = fmaxf(wm, fabsf(w[j]));
    }
    wm = wave_max(wm);
    float winv = wm > 0.f ? 127.f / wm : 0.f;
    unsigned q = 0;
#pragma unroll
    for (int j = 0; j < 4; ++j) q = __builtin_amdgcn_cvt_pk_u8_f32(rintf(w[j] * winv) + 128.f, j, q);
    if (lane < 32) WQ[(size_t)t * 32 + l4] = q ^ 0x80808080u;
    if (lane == 0) SW[t] = wm * (1.f / 127.f);
  }
}
__device__ __forceinline__ void load_w16(const float* __restrict__ W, int t, int g8, float (&w)[16]) {
  const float4* wp = (const float4*)(W + (size_t)t * 128 + 16 * g8);
  float4 wa = wp[0], wb = wp[1], wc = wp[2], wd = wp[3];
  w[0] = wa.x; w[1] = wa.y; w[2] = wa.z; w[3] = wa.w; w[4] = wb.x; w[5] = wb.y; w[6] = wb.z; w[7] = wb.w;
  w[8] = wc.x; w[9] = wc.y; w[10] = wc.z; w[11] = wc.w; w[12] = wd.x; w[13] = wd.y; w[14] = wd.z; w[15] = wd.w;
}
#define V_TOKEN(tt, VV, VVN, EUSE, ELD, WUSE, WLD, SUSE, SLD) { \
    int tnn_ = min((tt) + 2 * st, nrows - 1); \
    load_e16(EXP, tnn_, g8, ELD); \
    WLD = *(const uint4*)(WQ + (size_t)tnn_ * 32 + 4 * g8); SLD = SW[tnn_]; \
    __builtin_amdgcn_sched_barrier(0); \
    _Pragma("unroll") for (int i = 0; i < 16; ++i) VVN[i] = *(const uint4*)(vbs + (((unsigned)EUSE[i] << 7) + loff)); \
    __builtin_amdgcn_sched_barrier(0); \
    int acc[16]; \
    _Pragma("unroll") for (int j = 0; j < 16; ++j) acc[j] = 0; \
    int wq[4] = {(int)WUSE.x, (int)WUSE.y, (int)WUSE.z, (int)WUSE.w}; \
    _Pragma("unroll") for (int m = 0; m < 4; ++m) { \
      unsigned r0[4] = {VV[4 * m].x, VV[4 * m].y, VV[4 * m].z, VV[4 * m].w}; \
      unsigned r1[4] = {VV[4 * m + 1].x, VV[4 * m + 1].y, VV[4 * m + 1].z, VV[4 * m + 1].w}; \
      unsigned r2[4] = {VV[4 * m + 2].x, VV[4 * m + 2].y, VV[4 * m + 2].z, VV[4 * m + 2].w}; \
      unsigned r3[4] = {VV[4 * m + 3].x, VV[4 * m + 3].y, VV[4 * m + 3].z, VV[4 * m + 3].w}; \
      _Pragma("unroll") for (int k = 0; k < 4; ++k) { \
          \
        unsigned a0 = __builtin_amdgcn_perm(r1[k], r0[k], 0x05010400u);     \
        unsigned a1 = __builtin_amdgcn_perm(r1[k], r0[k], 0x07030602u);     \
        unsigned a2 = __builtin_amdgcn_perm(r3[k], r2[k], 0x05010400u); \
        unsigned a3 = __builtin_amdgcn_perm(r3[k], r2[k], 0x07030602u); \
        unsigned t0 = __builtin_amdgcn_perm(a2, a0, 0x05040100u);           \
        unsigned t1 = __builtin_amdgcn_perm(a2, a0, 0x07060302u); \
        unsigned t2 = __builtin_amdgcn_perm(a3, a1, 0x05040100u); \
        unsigned t3 = __builtin_amdgcn_perm(a3, a1, 0x07060302u); \
        acc[4 * k + 0] = __builtin_amdgcn_sdot4((int)t0, wq[m], acc[4 * k + 0], false); \
        acc[4 * k + 1] = __builtin_amdgcn_sdot4((int)t1, wq[m], acc[4 * k + 1], false); \
        acc[4 * k + 2] = __builtin_amdgcn_sdot4((int)t2, wq[m], acc[4 * k + 2], false); \
        acc[4 * k + 3] = __builtin_amdgcn_sdot4((int)t3, wq[m], acc[4 * k + 3], false); } } \
    float of[16]; \
    _Pragma("unroll") for (int j = 0; j < 16; ++j) { float v = (float)acc[j]; v += dpp_mov<0x128>(v); of[j] = xrow16_sum(v) * SUSE; } \
    if (g8 == 0) { \
      uint4* fp = (uint4*)(F + (size_t)(tt) * D + 128 * x + 16 * j8); \
      fp[0] = make_uint4(pack2bf(of[0], of[1]), pack2bf(of[2], of[3]), pack2bf(of[4], of[5]), pack2bf(of[6], of[7])); \
      fp[1] = make_uint4(pack2bf(of[8], of[9]), pack2bf(of[10], of[11]), pack2bf(of[12], of[13]), pack2bf(of[14], of[15])); } }
__device__ __forceinline__ void ph_peer_v(const unsigned* __restrict__ WQ, const float* __restrict__ SW, const int* __restrict__ EXP,
                                          const unsigned char* __restrict__ V8, bf16_t* __restrict__ F, int nrows) {
  int lane = threadIdx.x & 63, wave = __builtin_amdgcn_readfirstlane(threadIdx.x >> 6);
  int x = blockIdx.x & 7; int nb8 = gridDim.x >> 3;
  if ((int)(blockIdx.x >> 3) >= nb8) return;
  int j8 = lane & 7, g8 = lane >> 3;
  const int st = nb8 * 4;
  int t = (blockIdx.x >> 3) * 4 + wave;
  if (t >= nrows) return;
  const unsigned char* vbs = V8 + (size_t)x * ((size_t)16384 * 128);
  const unsigned loff = 16u * (unsigned)j8;
  int eA[16], eB[16]; uint4 wA, wB, vvA[16], vvB[16]; float sA, sB;
  {
    int e0[16]; load_e16(EXP, t, g8, e0);
#pragma unroll
    for (int i = 0; i < 16; ++i) vvA[i] = *(const uint4*)(vbs + (((unsigned)e0[i] << 7) + loff));
    wA = *(const uint4*)(WQ + (size_t)t * 32 + 4 * g8); sA = SW[t];
    int tn = min(t + st, nrows - 1);
    load_e16(EXP, tn, g8, eA);
    wB = *(const uint4*)(WQ + (size_t)tn * 32 + 4 * g8); sB = SW[tn];
  }
#pragma unroll 1
  for (; t < nrows; t += 2 * st) {
    uint4 wC; float sC;
    V_TOKEN(t, vvA, vvB, eA, eB, wA, wC, sA, sC)
    if (t + st < nrows) {
      V_TOKEN(t + st, vvB, vvA, eB, eA, wB, wA, sB, sA)
    }
    wB = wA; sB = sA; wA = wC; sA = sC;
  }
}

#define XB_TMO      128
#define XB_XCNT(j)  (256  + 64 * (j))
#define XB_XSUB(j)  (1280 + 64 * (j))
#define XB_XGEN(j)  (2304 + 64 * (j))
#define XB_TOP      3328
#define XB_TOPGEN   3392
#define XCD_BAR_WORDS 3456
#define XB_SPIN_CAP (1u << 22)
#define LAS __attribute__((address_space(3)))
__device__ __forceinline__ unsigned xb_ld(unsigned* p)              { return __hip_atomic_load(p, __ATOMIC_RELAXED, __HIP_MEMORY_SCOPE_AGENT); }
__device__ __forceinline__ unsigned xb_add(unsigned* p, unsigned v) { return __hip_atomic_fetch_add(p, v, __ATOMIC_RELAXED, __HIP_MEMORY_SCOPE_AGENT); }
__device__ __forceinline__ unsigned xb_xcc_id() { return (unsigned)__builtin_amdgcn_s_getreg((3 << 11) | 20) & 0xFu; }
#define XB_SPIN(cond, bar) do { unsigned _sp = 0; while (cond) { __builtin_amdgcn_s_sleep(1); \
    if ((++_sp & 255u) == 0u) { if (xb_ld(&(bar)[XB_TMO])) break; if (_sp > XB_SPIN_CAP) { atomicAdd(&(bar)[XB_TMO], 1u); break; } } } } while (0)
struct XcdBarrier { unsigned* bar; unsigned x; volatile LAS unsigned* st; };
__device__ __forceinline__ XcdBarrier xcd_barrier_post(unsigned* bar, volatile LAS unsigned* st) {
  XcdBarrier b; b.bar = bar; b.x = xb_xcc_id(); b.st = st;
  if (threadIdx.x == 0) (void)xb_add(&bar[XB_XCNT(b.x)], 1u);
  return b;
}
__device__ __forceinline__ void xcd_barrier_complete(unsigned* bar, unsigned x, unsigned& nloc, unsigned& nx) {
  const unsigned G = gridDim.x * gridDim.y * gridDim.z;
  unsigned sum, cnt, mine, sp = 0u;
  for (;;) {
    sum = 0u; cnt = 0u; mine = 0u;
#pragma unroll
    for (unsigned j = 0; j < 16; ++j) { const unsigned c = xb_ld(&bar[XB_XCNT(j)]); sum += c; cnt += (c > 0u) ? 1u : 0u; mine = (j == x) ? c : mine; }
    if (sum == G) break;
    __builtin_amdgcn_s_sleep(1);
    if ((++sp & 255u) == 0u) { if (xb_ld(&bar[XB_TMO])) break; if (sp > XB_SPIN_CAP) { atomicAdd(&bar[XB_TMO], 1u); break; } }
  }
  nloc = mine > 0u ? mine : 1u; nx = cnt > 0u ? cnt : 1u;
}
__device__ __forceinline__ void xcd_barrier(const XcdBarrier& b) {
  asm volatile("s_waitcnt vmcnt(0)" ::: "memory");
  __syncthreads();
  if (threadIdx.x == 0) {
    unsigned* bar = b.bar;
    __builtin_amdgcn_s_waitcnt(0);
    unsigned nloc = b.st[0], nx = b.st[1];
    if (nloc == 0u) { xcd_barrier_complete(bar, b.x, nloc, nx); b.st[0] = nloc; b.st[1] = nx; }
    const unsigned old = xb_add(&bar[XB_XSUB(b.x)], 1u);
    const unsigned gen = old / nloc;
    if (old + 1u == (gen + 1u) * nloc) {
      __builtin_amdgcn_fence(__ATOMIC_RELEASE, "agent");
      asm volatile("s_waitcnt vmcnt(0)" ::: "memory");
      const unsigned og = xb_add(&bar[XB_TOP], 1u);
      const unsigned tg = og / nx;
      if (og + 1u == (tg + 1u) * nx) xb_add(&bar[XB_TOPGEN], 1u);
      else XB_SPIN(xb_ld(&bar[XB_TOPGEN]) == tg, bar);
      __builtin_amdgcn_fence(__ATOMIC_ACQUIRE, "agent");
      xb_add(&bar[XB_XGEN(b.x)], 1u);
      asm volatile("s_waitcnt vmcnt(0)" ::: "memory");
    } else {
      XB_SPIN(xb_ld(&bar[XB_XGEN(b.x)]) == gen, bar);
      __builtin_amdgcn_fence(__ATOMIC_ACQUIRE, "agent");
      asm volatile("s_waitcnt vmcnt(0)" ::: "memory");
    }
  }
  __syncthreads();
}

constexpr int SMEM_BYTES = 65536;
#ifndef PHMASK
#define PHMASK 0xFFFFFFFFFFFFFFFFull
#endif
#ifndef PHDUP
#define PHDUP 0ull
#endif
#define PH(n, ...) if constexpr ((((unsigned long long)(PHMASK)) >> (n)) & 1ull) { __VA_ARGS__; if constexpr ((((unsigned long long)(PHDUP)) >> (n)) & 1ull) { xcd_barrier(xbar); __VA_ARGS__; } }

__global__ __launch_bounds__(256, 2) void mega(Params p) {
  __shared__ __attribute__((aligned(16))) char smem_raw[SMEM_BYTES];
  __shared__ uint4 xb_words;
  if (threadIdx.x == 0) xb_words = make_uint4(0u, 0u, 0u, 0u);
  __syncthreads();
  XcdBarrier xbar = xcd_barrier_post((unsigned*)((char*)p.ws + OFF_BAR), (volatile LAS unsigned*)&xb_words);
  float* smem = (float*)smem_raw;
  const float* x = p.in[0]; const float* c = p.in[1]; const float* ctx = p.in[2]; const float* c_ctx = p.in[3];
  const float* ada_w = p.in[4]; const float* ada_b = p.in[5]; const float* ln_g = p.in[6]; const float* ln_b = p.in[7];
  const float* even_w_in = p.in[8]; const float* even_w_out = p.in[9]; const float* rpb = p.in[10];
  const float* odd_w_in = p.in[11]; const float* odd_w_out = p.in[12]; const float* sink = p.in[13];
  const float* peer_wq = p.in[14]; const float* peer_sk = p.in[15]; const float* peer_u = p.in[16]; const float* peer_v = p.in[17];
  char* ws = (char*)p.ws;
  float* TAB = (float*)(ws + OFF_TAB); float* Mm = (float*)(ws + OFF_M);
  bf16_t* WIN0 = (bf16_t*)(ws + OFF_WIN0); bf16_t* WOUT0 = (bf16_t*)(ws + OFF_WOUT0);
  bf16_t* WIN1 = (bf16_t*)(ws + OFF_WIN1); bf16_t* WOUT1 = (bf16_t*)(ws + OFF_WOUT1);
  bf16_t* WQ = (bf16_t*)(ws + OFF_WQ); bf16_t* SKB = (bf16_t*)(ws + OFF_SK);
  unsigned char* U8 = (unsigned char*)(ws + OFF_UB); unsigned char* V8 = (unsigned char*)(ws + OFF_VB);
  float* USC = (float*)(ws + OFF_USC); float* VSC = USC + 2 * 16384;
  bf16_t* AB = (bf16_t*)(ws + OFF_AB);
  bf16_t* FD1 = (bf16_t*)(ws + OFF_FT); bf16_t* FD3 = FD1 + 256 * 128; bf16_t* FDC = FD3 + 128 * 128;
  bf16_t* A1 = (bf16_t*)(ws + OFF_A1); bf16_t* VT0 = (bf16_t*)(ws + OFF_VT0); bf16_t* FQKV = (bf16_t*)(ws + OFF_BF);
  float* BF_ = (float*)(ws + OFF_BF); float* BY = (float*)(ws + OFF_BY);
  float* X1 = (float*)(ws + OFF_X1); float* X2 = (float*)(ws + OFF_X2);
  float* RT = TAB + 16384;
  bf16_t* Q1 = (bf16_t*)(ws + OFF_BF); bf16_t* K1 = Q1 + (size_t)T * 1024; bf16_t* VT1 = K1 + (size_t)R * 256;
  bf16_t* YB = (bf16_t*)(ws + OFF_BY + (size_t)2 * R * 128 * 4);
  float* PAB = (float*)(ws + OFF_BF); bf16_t* FB = (bf16_t*)(ws + OFF_BF + (size_t)R * 8 * 128 * 4);
  float* WB = (float*)(ws + OFF_BF + (size_t)R * 8 * 128 * 4 + (size_t)R * 1024 * 2); float* CORRB = WB + (size_t)R * 128;
  int* EXPB = (int*)(ws + OFF_BY); float* GATEB = (float*)(ws + OFF_BY + (size_t)R * 128 * 4);
  float* out = p.out;

  PH(0, ph_tables(TAB); ph_rope_table(RT))
  PH(1, ph_fft_tables(FD1, FD3, FDC))
  PH(2, ph_ada2(c, c_ctx, ada_w, ada_b, Mm, smem))
  PH(3, ph_transpose_w(even_w_in, 1024, 2048, WIN0, smem))
  PH(4, ph_transpose_w(even_w_out, 1024, 1024, WOUT0, smem))
  PH(5, ph_transpose_w(odd_w_in, 1024, 1536, WIN1, smem))
  PH(6, ph_transpose_w(odd_w_out, 1024, 1024, WOUT1, smem))
  PH(7, ph_transpose_w(peer_wq, 1024, 2048, WQ, smem))
  PH(8, ph_transpose_w(peer_wq + (size_t)1024 * 2048, 1024, 2048, WQ + (size_t)2048 * 1024, smem))
  PH(9, ph_quant_rows(peer_u, U8, USC, 2 * 16384))
  PH(10, ph_quant_rows(peer_v, V8, VSC, 2 * 16384))
  PH(11, ph_convert(peer_sk, SKB, (size_t)2 * 8 * 2 * 128 * 128 / 8))
  xcd_barrier(xbar);
  PH(12, ph_modulate(x, ctx, Mm, 0, 0, 1, AB, R, smem))
  xcd_barrier(xbar);
  PH(13, ph_gemm_bf16(AB, 1024, WIN0, 1024, R, 2048, 1024, EpiQKV0{FQKV, VT0}, smem_raw))
  xcd_barrier(xbar);
  PH(14, { GRID_LOOP(u, NB * 64 * 8) fft1_unit(u, FQKV, FD1, TAB, A1, smem_raw); })
  PH(15, { int lane = threadIdx.x & 63, wave = __builtin_amdgcn_readfirstlane(threadIdx.x >> 6);
           __syncthreads();
           for (int i = threadIdx.x; i < 8 * 15 * 31; i += 256) smem[i] = rpb[i] * 1.4426950408889634f;
           __syncthreads();
           for (int bu = blockIdx.x; bu < 512 + 64; bu += gridDim.x) {
             if (bu < 512) { int h = bu & 7, rg = (bu >> 3) & 31, bb = bu >> 8;
               na_unit(bb, h, rg * 4 + wave, FQKV, VT0, VT0 + (size_t)NB * 8 * 64 * S, smem, AB, lane); }
             else { int cu = bu - 512; int h = cu & 7, qg = (cu >> 3) & 3, bb = cu >> 5;
               attn_unit<1, 1, 2>(bb, h, 0, 0, qg * 4 + wave, FQKV + 512, 2048, FQKV + 1024, 2048, VT0, VT0 + (size_t)NB * 8 * 64 * S, 8, smem, nullptr, AB + 512, 1024, lane); } } })
  xcd_barrier(xbar);
  PH(16, { GRID_LOOP(u, NB * 128 * 8 + NB * 4 * 8) { if (u < NB * 128 * 8) fft3_unit(u, 0, FQKV, A1, FD3, FDC, TAB, AB, smem_raw); else fft3_unit(u - NB * 128 * 8, 1, FQKV, A1, FD3, FDC, TAB, AB, smem_raw); } })
  xcd_barrier(xbar);
  PH(17, ph_gemm_bf16(AB, 1024, WOUT0, 1024, R, 1024, 1024, EpiBf16{YB, 1024}, smem_raw))
  xcd_barrier(xbar);
  PH(18, ph_post_mod(x, ctx, YB, Mm, 0, 2, 0, 3, 4, true, ln_g + 0, ln_b + 0, X1, AB, R))
  xcd_barrier(xbar);
  PH(21, ph_peer_select(AB, WQ, SKB, EXPB, GATEB, R, smem_raw))
  xcd_barrier(xbar);
  PH(22, ph_peer_u(AB, EXPB, U8, PAB, R))
  xcd_barrier(xbar);
  PH(32, ph_peer_w(PAB, EXPB, GATEB, USC, VSC, (unsigned*)WB, CORRB, R))
  xcd_barrier(xbar);
  PH(33, ph_peer_v((const unsigned*)WB, CORRB, EXPB, V8, FB, R))
  xcd_barrier(xbar);
  PH(34, ph_post_mod(X1, X1 + (size_t)T * D, FB, Mm, 0, 5, 1, 0, 1, true, ln_g + 1024, ln_b + 1024, X2, AB, R))
  xcd_barrier(xbar);
  PH(23, ph_gemm_bf16(AB, 1024, WIN1, 1024, R, 1536, 1024, EpiQKV1{Q1, K1, VT1, RT}, smem_raw))
  xcd_barrier(xbar);
  PH(25, { int lane = threadIdx.x & 63, wave = __builtin_amdgcn_readfirstlane(threadIdx.x >> 6);
           for (int bu = blockIdx.x; bu < 1024; bu += gridDim.x) { int kvh = bu & 3, bb = (bu >> 2) & 1, qg = bu >> 3;
             attn_unit<4, 2, 1>(bb, kvh, 0, 0, qg * 4 + wave, Q1, 1024, K1, 256, VT1, VT1 + (size_t)NB * 4 * 64 * S, 4, nullptr, sink, AB, 1024, lane); } })
  xcd_barrier(xbar);
  PH(26, ph_gemm_bf16(AB, 1024, WOUT1, 1024, T, 1024, 1024, EpiBf16{YB, 1024}, smem_raw))
  xcd_barrier(xbar);
  PH(27, ph_post_mod(X2, X2, YB, Mm, 1, 2, 1, 3, 4, true, ln_g + 2048, ln_b + 2048, X1, AB, T))
  xcd_barrier(xbar);
  PH(30, ph_peer_select(AB, WQ + (size_t)2048 * 1024, SKB + (size_t)8 * 2 * 128 * 128, EXPB, GATEB, T, smem_raw))
  xcd_barrier(xbar);
  PH(31, ph_peer_u(AB, EXPB, U8 + (size_t)16384 * 1024, PAB, T))
  xcd_barrier(xbar);
  PH(35, ph_peer_w(PAB, EXPB, GATEB, USC + 16384, VSC + 16384, (unsigned*)WB, CORRB, T))
  xcd_barrier(xbar);
  PH(36, ph_peer_v((const unsigned*)WB, CORRB, EXPB, V8 + (size_t)16384 * 1024, FB, T))
  xcd_barrier(xbar);
  PH(37, ph_post_mod(X1, X1, FB, Mm, 1, 5, 1, 0, 1, false, ln_g + 3072, ln_b + 3072, out, AB, T))
}

}

extern "C" void kernel_launch(void* const* d_in, const int* in_sizes, int n_in, void* d_out, int out_size, void* d_ws,
                              size_t ws_size, hipStream_t stream) {
  static int grid_blocks = 0;
  if (!grid_blocks) {
    int dev = 0, cus = 0, per_cu = 0;
    hipGetDevice(&dev);
    hipDeviceGetAttribute(&cus, hipDeviceAttributeMultiprocessorCount, dev);
    hipOccupancyMaxActiveBlocksPerMultiprocessor(&per_cu, (const void*)mega, 256, 0);
    if (per_cu > 2) per_cu = 2;
    if (per_cu < 1) per_cu = 1;
    grid_blocks = cus * per_cu;
  }
  Params p{};
  for (int i = 0; i < 18; ++i) p.in[i] = (const float*)d_in[i];
  p.out = (float*)d_out;
  p.ws = (float*)d_ws;
  (void)hipMemsetAsync((char*)d_ws + OFF_BAR, 0, XCD_BAR_WORDS_C * 4, stream);
  void* args[] = {&p};
  hipError_t e = hipLaunchCooperativeKernel((const void*)mega, dim3(grid_blocks), dim3(256), args, 0, stream);
  if (e != hipSuccess) fprintf(stderr, "cooperative launch failed: %s (grid %d)\n", hipGetErrorString(e), grid_blocks);
}
```

```cpp
#include <hip/hip_runtime.h>
#include <hip/hip_bf16.h>
#include <stdint.h>
#include <math.h>
#include <stdio.h>
#include <hip/hip_cooperative_groups.h>
namespace cg = cooperative_groups;

namespace {

constexpr int D = 1024;
constexpr int NB = 2;
constexpr int S = 8192;
constexpr int T = NB * S;
constexpr int CL = 256;
constexpr int TC = NB * CL;
constexpr int R = T + TC;
constexpr float DN_ALPHA = 1.4142135623730951f;
constexpr float LN_EPS = 1e-6f;

template <int CTRL> __device__ __forceinline__ float dpp_mov(float x) {
  return __builtin_bit_cast(float, __builtin_amdgcn_mov_dpp(__builtin_bit_cast(int, x), CTRL, 0xf, 0xf, true));
}
__device__ __forceinline__ float xrow16_max(float x) {
  auto s = __builtin_amdgcn_permlane16_swap(__float_as_uint(x), __float_as_uint(x), false, false);
  x = fmaxf(__uint_as_float(s[0]), __uint_as_float(s[1]));
  auto t = __builtin_amdgcn_permlane32_swap(__float_as_uint(x), __float_as_uint(x), false, false);
  return fmaxf(__uint_as_float(t[0]), __uint_as_float(t[1]));
}
__device__ __forceinline__ float xrow16_sum(float x) {
  auto s = __builtin_amdgcn_permlane16_swap(__float_as_uint(x), __float_as_uint(x), false, false);
  x = __uint_as_float(s[0]) + __uint_as_float(s[1]);
  auto t = __builtin_amdgcn_permlane32_swap(__float_as_uint(x), __float_as_uint(x), false, false);
  return __uint_as_float(t[0]) + __uint_as_float(t[1]);
}
__device__ __forceinline__ float wave_sum(float v) {
  v += dpp_mov<0xB1>(v); v += dpp_mov<0x4E>(v); v += dpp_mov<0x124>(v); v += dpp_mov<0x128>(v);
  return xrow16_sum(v);
}
__device__ __forceinline__ float wave_max(float v) {
  v = fmaxf(v, dpp_mov<0xB1>(v)); v = fmaxf(v, dpp_mov<0x4E>(v)); v = fmaxf(v, dpp_mov<0x124>(v)); v = fmaxf(v, dpp_mov<0x128>(v));
  return xrow16_max(v);
}

typedef unsigned short bf16_t;
typedef __attribute__((ext_vector_type(8))) short bf16x8;
typedef __attribute__((ext_vector_type(16))) float f32x16;
typedef __attribute__((ext_vector_type(4))) float f32x4;

typedef __attribute__((ext_vector_type(2))) __bf16 bf16x2_t;
__device__ __forceinline__ unsigned f2bf(float f) { return (unsigned)__builtin_bit_cast(unsigned short, (__bf16)f); }
__device__ __forceinline__ unsigned pack2bf(float a, float b) { bf16x2_t v = {(__bf16)a, (__bf16)b}; return __builtin_bit_cast(unsigned, v); }
__device__ __forceinline__ float bf2f(unsigned short v) { return __uint_as_float(((unsigned)v) << 16); }

__device__ __forceinline__ int mod_index(int row) { return row < T ? row / S : 2; }


struct Params {
  const float* in[18];
  float* out;
  float* ws;
};

constexpr size_t XCD_BAR_WORDS_C = 3456;
constexpr size_t al256(size_t n) { return (n + 255) & ~(size_t)255; }
constexpr size_t OFF_BAR = 0;
constexpr size_t OFF_TAB = al256(XCD_BAR_WORDS_C * 4);
constexpr size_t OFF_M = OFF_TAB + al256(16384 * 4 + 128 * 16 * 2 * 4);
constexpr size_t OFF_WIN0 = OFF_M + al256(2 * 3 * 6144 * 4);
constexpr size_t OFF_WOUT0 = OFF_WIN0 + al256((size_t)2048 * 1024 * 2);
constexpr size_t OFF_WIN1 = OFF_WOUT0 + al256((size_t)1024 * 1024 * 2);
constexpr size_t OFF_WOUT1 = OFF_WIN1 + al256((size_t)1536 * 1024 * 2);
constexpr size_t OFF_WQ = OFF_WOUT1 + al256((size_t)1024 * 1024 * 2);
constexpr size_t OFF_SK = OFF_WQ + al256((size_t)2 * 2048 * 1024 * 2);
constexpr size_t OFF_UB = OFF_SK + al256((size_t)2 * 8 * 2 * 128 * 128 * 2);
constexpr size_t OFF_VB = OFF_UB + al256((size_t)2 * 16384 * 1024);
constexpr size_t OFF_USC = OFF_VB + al256((size_t)2 * 16384 * 1024);
constexpr size_t OFF_AB = OFF_USC + al256((size_t)4 * 16384 * 4);
constexpr size_t OFF_FT = OFF_AB + al256((size_t)R * 1024 * 2);
constexpr size_t OFF_BF = OFF_FT + al256((size_t)(256 * 128 + 128 * 128 + 64 * 128) * 2);
constexpr size_t OFF_BY = OFF_BF + al256((size_t)R * 2048 * 4);
constexpr size_t OFF_X1 = OFF_BY + al256((size_t)R * 1024 * 4);
constexpr size_t OFF_X2 = OFF_X1 + al256((size_t)R * 1024 * 4);
constexpr size_t OFF_END = OFF_X2 + al256((size_t)R * 1024 * 4);
constexpr size_t OFF_A1 = OFF_BY;
constexpr size_t OFF_VT0 = OFF_X2;
static_assert(OFF_END <= (size_t)512 * 1024 * 1024, "workspace overflow");

#define GRID_LOOP(var, n) for (int var = blockIdx.x; var < (n); var += gridDim.x)

__device__ __forceinline__ void ph_fft_tables(bf16_t* D1, bf16_t* D3, bf16_t* DcT) {
  const double TWO_PI = 6.283185307179586476925286766559;
  for (int i = blockIdx.x * 256 + threadIdx.x; i < 256 * 128 + 128 * 128 + 64 * 128; i += gridDim.x * 256) {
    if (i < 256 * 128) {
      int m = i >> 7, r = i & 127; int k1 = m >> 1, ri = m & 1;
      double a = TWO_PI * (double)((k1 * r) & 127) / 128.0;
      D1[i] = (bf16_t)f2bf(ri == 0 ? (float)cos(a) : (float)(-sin(a)));
    } else if (i < 256 * 128 + 128 * 128) {
      int j = i - 256 * 128; int m = j >> 7, kk = j & 127; int rip = m >> 6, k2 = m & 63; int c = kk >> 1, ri = kk & 1;
      double a = TWO_PI * (double)((k2 * c) & 63) / 64.0;
      double v = (rip == 0) ? (ri == 0 ? cos(a) : sin(a)) : (ri == 0 ? -sin(a) : cos(a));
      D3[j] = (bf16_t)f2bf((float)v);
    } else {
      int j = i - 256 * 128 - 128 * 128; int cp = j >> 7, kk = j & 127; int rip = kk >> 6, ch = kk & 63;
      double a = TWO_PI * (double)((ch * cp) & 63) / 64.0;
      DcT[j] = (bf16_t)f2bf((float)(rip == 0 ? cos(a) : sin(a)));
    }
  }
}
__device__ __forceinline__ void ph_rope_table(float* RT) {
  for (int i = blockIdx.x * 256 + threadIdx.x; i < 128 * 16; i += gridDim.x * 256) {
    int pos = i >> 4, f = i & 15;
    float inv_freq = powf(10000.0f, -(float)f / 16.0f);
    float ang = (float)pos * inv_freq;
    RT[2 * i] = cosf(ang); RT[2 * i + 1] = sinf(ang);
  }
}
__device__ __forceinline__ void ph_tables(float* tab) {
  for (int j = blockIdx.x * 256 + threadIdx.x; j < 8192; j += gridDim.x * 256) {
    double a = 6.283185307179586476925286766559 * (double)j / 8192.0;
    tab[j] = (float)cos(a);
    tab[8192 + j] = (float)sin(a);
  }
}
__device__ __forceinline__ void ph_ada(const float* __restrict__ c, const float* __restrict__ c_ctx, const float* __restrict__ ada_w,
                       const float* __restrict__ ada_b, float* __restrict__ M) {
  for (int gid = blockIdx.x * 256 + threadIdx.x; gid < 2 * 3 * 6144; gid += gridDim.x * 256) {
    int col = gid % 6144; int idx = (gid / 6144) % 3; int layer = gid / (3 * 6144);
    const float* vec = idx < 2 ? c + idx * D : c_ctx;
    const float* w = ada_w + (size_t)layer * D * 6144 + col;
    float acc = 0.f;
    for (int k = 0; k < D; ++k) {
      float x = vec[k];
      float sx = x / (1.f + expf(-x));
      acc += sx * w[(size_t)k * 6144];
    }
    M[gid] = acc + ada_b[layer * 6144 + col];
  }
}

__device__ __forceinline__ void ph_modulate(const float* __restrict__ xa, const float* __restrict__ xb, const float* __restrict__ M, int layer,
                            int jshift, int jscale, bf16_t* __restrict__ out, int nrows, float* red) {
  int tid = threadIdx.x;
  GRID_LOOP(row, nrows) {
    const float* x = row < T ? xa + (size_t)row * D : xb + (size_t)(row - T) * D;
    float v[4]; float s = 0.f;
#pragma unroll
    for (int i = 0; i < 4; ++i) { v[i] = x[tid + 256 * i]; s += v[i]; }
    s = wave_sum(s);
    __syncthreads();
    if ((tid & 63) == 0) red[tid >> 6] = s;
    __syncthreads();
    float mu = (red[0] + red[1] + red[2] + red[3]) * (1.f / D);
    float q = 0.f;
#pragma unroll
    for (int i = 0; i < 4; ++i) { float d = v[i] - mu; q += d * d; }
    q = wave_sum(q);
    if ((tid & 63) == 0) red[4 + (tid >> 6)] = q;
    __syncthreads();
    float var = (red[4] + red[5] + red[6] + red[7]) * (1.f / D);
    float rs = rsqrtf(var + LN_EPS);
    const float* m = M + ((size_t)layer * 3 + mod_index(row)) * 6144;
#pragma unroll
    for (int i = 0; i < 4; ++i) {
      int col = tid + 256 * i;
      float y = (v[i] - mu) * rs;
      out[(size_t)row * D + col] = (bf16_t)f2bf(y * (1.f + m[jscale * D + col]) + m[jshift * D + col]);
    }
  }
}

__device__ __forceinline__ void ph_post(const float* __restrict__ xa, const float* __restrict__ xb, const float* __restrict__ Y,
                        const float* __restrict__ M, int layer, int j, const float* __restrict__ g, const float* __restrict__ bb,
                        float* __restrict__ outa, float* __restrict__ outb, int nrows, float* red) {
  int tid = threadIdx.x;
  GRID_LOOP(row, nrows) {
    const float* x = row < T ? xa + (size_t)row * D : xb + (size_t)(row - T) * D;
    float* out = row < T ? outa + (size_t)row * D : outb + (size_t)(row - T) * D;
    const float* m = M + ((size_t)layer * 3 + mod_index(row)) * 6144 + j * D;
    float v[4]; float s = 0.f;
#pragma unroll
    for (int i = 0; i < 4; ++i) { int col = tid + 256 * i; v[i] = DN_ALPHA * x[col] + m[col] * Y[(size_t)row * D + col]; s += v[i]; }
    s = wave_sum(s);
    __syncthreads();
    if ((tid & 63) == 0) red[tid >> 6] = s;
    __syncthreads();
    float mu = (red[0] + red[1] + red[2] + red[3]) * (1.f / D);
    float q = 0.f;
#pragma unroll
    for (int i = 0; i < 4; ++i) { float d = v[i] - mu; q += d * d; }
    q = wave_sum(q);
    if ((tid & 63) == 0) red[4 + (tid >> 6)] = q;
    __syncthreads();
    float var = (red[4] + red[5] + red[6] + red[7]) * (1.f / D);
    float rs = rsqrtf(var + LN_EPS);
#pragma unroll
    for (int i = 0; i < 4; ++i) {
      int col = tid + 256 * i;
      out[col] = (v[i] - mu) * rs * g[col] + bb[col];
    }
  }
}

struct ARow { const float* A; int lda; __device__ float operator()(int m, int k) const { return A[(size_t)m * lda + k]; } };
struct BRow { const float* B; int ldb; __device__ float operator()(int k, int n) const { return B[(size_t)k * ldb + n]; } };
struct CRow { float* C; int ldc; float scale; __device__ void operator()(int m, int n, float v) const { C[(size_t)m * ldc + n] = v * scale; } };
struct CRowB { bf16_t* C; int ldc; float scale; __device__ void operator()(int m, int n, float v) const { C[(size_t)m * ldc + n] = (bf16_t)f2bf(v * scale); } };
struct ADft { const float* tab; int Sn; int stride; __device__ float operator()(int m, int k) const {
    int t = k & (Sn - 1); int idx = ((m * t) & (Sn - 1)) * stride;
    return k < Sn ? tab[idx] : -tab[8192 + idx]; } };
struct BPQ { const float* PQ; int rowbase; int Sn; __device__ float operator()(int k, int n) const {
    int t = k & (Sn - 1); return PQ[(size_t)(rowbase + t) * 1024 + (k >= Sn ? 512 : 0) + n]; } };

template <class AF, class BF, class CF>
__device__ __forceinline__ void ph_gemm(AF af, BF bf, CF cf, int M, int N, int K, float* sm) {
  float (*sA)[68] = (float (*)[68])sm;
  float (*sB)[68] = (float (*)[68])(sm + 16 * 68);
  int tid = threadIdx.x; int tx = tid & 15, ty = tid >> 4;
  int ntn = N / 64; int ntiles = (M / 64) * ntn;
  GRID_LOOP(tile, ntiles) {
    int m0 = (tile / ntn) * 64, n0 = (tile % ntn) * 64;
    float acc[4][4];
#pragma unroll
    for (int i = 0; i < 4; ++i)
#pragma unroll
      for (int j = 0; j < 4; ++j) acc[i][j] = 0.f;
    for (int k0 = 0; k0 < K; k0 += 16) {
      __syncthreads();
#pragma unroll
      for (int i = 0; i < 4; ++i) { int e = tid + 256 * i; int m = e >> 4, k = e & 15; sA[k][m] = af(m0 + m, k0 + k); }
#pragma unroll
      for (int i = 0; i < 4; ++i) { int e = tid + 256 * i; int k = e >> 6, n = e & 63; sB[k][n] = bf(k0 + k, n0 + n); }
      __syncthreads();
#pragma unroll
      for (int k = 0; k < 16; ++k) {
        float a[4], b[4];
#pragma unroll
        for (int i = 0; i < 4; ++i) { a[i] = sA[k][ty * 4 + i]; b[i] = sB[k][tx * 4 + i]; }
#pragma unroll
        for (int i = 0; i < 4; ++i)
#pragma unroll
          for (int j = 0; j < 4; ++j) acc[i][j] += a[i] * b[j];
      }
    }
#pragma unroll
    for (int i = 0; i < 4; ++i)
#pragma unroll
      for (int j = 0; j < 4; ++j) cf(m0 + ty * 4 + i, n0 + tx * 4 + j, acc[i][j]);
  }
}


__device__ __forceinline__ void ph_transpose_w(const float* __restrict__ W, int K, int N, bf16_t* __restrict__ Wt, float* sm) {
  int tid = threadIdx.x;
  int tk = K / 64, tn = N / 64;
  GRID_LOOP(tile, tk * tn) {
    int k0 = (tile / tn) * 64, n0 = (tile % tn) * 64;
    __syncthreads();
#pragma unroll
    for (int i = 0; i < 16; ++i) { int e = tid + 256 * i; int k = e >> 6, n = e & 63; sm[k * 65 + n] = W[(size_t)(k0 + k) * N + n0 + n]; }
    __syncthreads();
#pragma unroll
    for (int i = 0; i < 2; ++i) {
      int e = tid + 256 * i; int n = e >> 3, kc = e & 7;
      unsigned w[4];
#pragma unroll
      for (int j = 0; j < 4; ++j) w[j] = pack2bf(sm[(kc * 8 + 2 * j) * 65 + n], sm[(kc * 8 + 2 * j + 1) * 65 + n]);
      *(uint4*)(Wt + (size_t)(n0 + n) * K + k0 + kc * 8) = make_uint4(w[0], w[1], w[2], w[3]);
    }
  }
}
__device__ __forceinline__ void ph_convert(const float* __restrict__ src, bf16_t* __restrict__ dst, size_t n8) {
  for (size_t i = (size_t)blockIdx.x * 256 + threadIdx.x; i < n8; i += (size_t)gridDim.x * 256) {
    float4 a = ((const float4*)src)[2 * i], b = ((const float4*)src)[2 * i + 1];
    ((uint4*)dst)[i] = make_uint4(pack2bf(a.x, a.y), pack2bf(a.z, a.w), pack2bf(b.x, b.y), pack2bf(b.z, b.w));
  }
}

__device__ __forceinline__ void gemm_stage(const bf16_t* __restrict__ A, int lda, int k0, char* lds, int tid) {
#pragma unroll
  for (int i = 0; i < 4; ++i) {
    int q = tid + 256 * i; int row = q >> 3, p = q & 7; int c = p ^ ((row >> 1) & 7);
    const bf16_t* src = A + (size_t)row * lda + k0 + c * 8;
    __builtin_amdgcn_global_load_lds((const unsigned*)src, (unsigned*)(lds + q * 16), 16, 0, 0);
  }
}
struct EpiF32 {
  float* C; int ldc; float scale;
  __device__ __forceinline__ void operator()(int m0, int n0, int wm, int wn, f32x16 (&acc)[2][2], int tid, char* smem) const {
    int lane = tid & 63;
    float* t = (float*)smem;
    int rbase = wm * 64 + 4 * (lane >> 5), cbase = wn * 64 + (lane & 31);
#pragma unroll
    for (int mi = 0; mi < 2; ++mi)
#pragma unroll
      for (int ni = 0; ni < 2; ++ni)
#pragma unroll
        for (int r = 0; r < 16; ++r)
          t[(rbase + mi * 32 + (r & 3) + 8 * (r >> 2)) * 128 + cbase + ni * 32] = acc[mi][ni][r] * scale;
    __syncthreads();
    float* dst = C + (size_t)(m0 + (tid >> 5)) * ldc + n0 + (tid & 31) * 4;
    const float* src = t + (tid >> 5) * 128 + (tid & 31) * 4;
#pragma unroll 4
    for (int i = 0; i < 16; ++i) {
      *(float4*)dst = *(const float4*)src;
      dst += (size_t)8 * ldc; src += 8 * 128;
    }
  }
};
struct EpiQKV0 {
  bf16_t* FQKV; bf16_t* VT;
  __device__ __forceinline__ void operator()(int m0, int n0, int wm, int wn, f32x16 (&acc)[2][2], int tid, char* smem) const {
    int lane = tid & 63;
    bf16_t* t = (bf16_t*)smem;
    int rbase = wm * 64 + 4 * (lane >> 5), cbase = wn * 64 + (lane & 31);
#pragma unroll
    for (int mi = 0; mi < 2; ++mi)
#pragma unroll
      for (int ni = 0; ni < 2; ++ni)
#pragma unroll
        for (int r = 0; r < 16; ++r)
          t[(rbase + mi * 32 + (r & 3) + 8 * (r >> 2)) * 136 + cbase + ni * 32] = (bf16_t)f2bf(acc[mi][ni][r]);
    __syncthreads();
    {
      bf16_t* dst = FQKV + (size_t)(m0 + (tid >> 4)) * 2048 + n0 + (tid & 15) * 8;
      const bf16_t* src = t + (tid >> 4) * 136 + (tid & 15) * 8;
#pragma unroll 4
      for (int i = 0; i < 8; ++i) {
        *(uint4*)dst = *(const uint4*)src;
        dst += (size_t)16 * 2048; src += 16 * 136;
      }
    }
    if (n0 >= 1536) {
      int col = tid >> 1, half = tid & 1;
      int hd = (n0 - 1536) / 64 + (col >> 6), d = col & 63;
      bf16_t* dst;
      if (m0 < T) { int b = m0 / S, t0 = m0 % S; dst = VT + (((size_t)b * 8 + hd) * 64 + d) * S + t0 + half * 64; }
      else { int mm = m0 - T; int b = mm / CL, l0 = mm % CL; dst = VT + (size_t)NB * 8 * 64 * S + (((size_t)b * 8 + hd) * 64 + d) * CL + l0 + half * 64; }
      const bf16_t* src = t + (half * 64) * 136 + col;
#pragma unroll
      for (int i = 0; i < 8; ++i) {
        unsigned wv[4];
#pragma unroll
        for (int j = 0; j < 4; ++j) wv[j] = (unsigned)src[(i * 8 + 2 * j) * 136] | ((unsigned)src[(i * 8 + 2 * j + 1) * 136] << 16);
        *(uint4*)(dst + i * 8) = make_uint4(wv[0], wv[1], wv[2], wv[3]);
      }
    }
  }
};
struct EpiBf16 {
  bf16_t* C; int ldc;
  __device__ __forceinline__ void operator()(int m0, int n0, int wm, int wn, f32x16 (&acc)[2][2], int tid, char* smem) const {
    int lane = tid & 63;
    asm volatile("" : "+v"(lane));
    bf16_t* t = (bf16_t*)smem;
    {
      bf16_t* tw = t + (wm * 64 + 4 * (lane >> 5)) * 136 + wn * 64 + (lane & 31);
#pragma unroll
      for (int mi = 0; mi < 2; ++mi)
#pragma unroll
        for (int ni = 0; ni < 2; ++ni)
#pragma unroll
          for (int r = 0; r < 16; ++r)
            tw[(mi * 32 + (r & 3) + 8 * (r >> 2)) * 136 + ni * 32] = (bf16_t)f2bf(acc[mi][ni][r]);
    }
    __syncthreads();
    bf16_t* dst = C + (size_t)(m0 + (tid >> 4)) * ldc + n0 + (tid & 15) * 8;
    const bf16_t* src = t + (tid >> 4) * 136 + (tid & 15) * 8;
#pragma unroll 4
    for (int i = 0; i < 8; ++i) {
      *(uint4*)dst = *(const uint4*)src;
      dst += (size_t)16 * ldc; src += 16 * 136;
    }
  }
};
struct EpiQKV1 {
  bf16_t* Q1; bf16_t* K1; bf16_t* VT; const float* RT;
  __device__ __forceinline__ void operator()(int m0, int n0, int wm, int wn, f32x16 (&acc)[2][2], int tid, char* smem) const {
    int lane = tid & 63;
    asm volatile("" : "+v"(lane));
    bf16_t* t = (bf16_t*)smem;
    if (n0 < 1280 && m0 < T) {
      int i = lane & 31; int f = i & 15;
#pragma unroll
      for (int mi = 0; mi < 2; ++mi)
#pragma unroll
        for (int r = 0; r < 16; ++r) {
          int row = m0 + wm * 64 + 4 * (lane >> 5) + mi * 32 + (r & 3) + 8 * (r >> 2);
          int tt = row & (S - 1);
          int pos = (i < 16) ? (tt >> 6) : (tt & 63);
          float2 cs = *(const float2*)(RT + 2 * (pos * 16 + f));
          float x1 = acc[mi][0][r], x2 = acc[mi][1][r];
          acc[mi][0][r] = x1 * cs.x - x2 * cs.y;
          acc[mi][1][r] = x1 * cs.y + x2 * cs.x;
        }
    }
    {
      bf16_t* tw = t + (wm * 64 + 4 * (lane >> 5)) * 136 + wn * 64 + (lane & 31);
#pragma unroll
      for (int mi = 0; mi < 2; ++mi)
#pragma unroll
        for (int ni = 0; ni < 2; ++ni)
#pragma unroll
          for (int r = 0; r < 16; ++r)
            tw[(mi * 32 + (r & 3) + 8 * (r >> 2)) * 136 + ni * 32] = (bf16_t)f2bf(acc[mi][ni][r]);
    }
    __syncthreads();
    if (n0 < 1280) {
      bf16_t* dst; int ld;
      if (n0 < 1024) { dst = Q1 + (size_t)(m0 + (tid >> 4)) * 1024 + n0 + (tid & 15) * 8; ld = 1024; }
      else { dst = K1 + (size_t)(m0 + (tid >> 4)) * 256 + (n0 - 1024) + (tid & 15) * 8; ld = 256; }
      if (n0 >= 1024 || m0 < T) {
        const bf16_t* src = t + (tid >> 4) * 136 + (tid & 15) * 8;
#pragma unroll 4
        for (int i = 0; i < 8; ++i) {
          *(uint4*)dst = *(const uint4*)src;
          dst += (size_t)16 * ld; src += 16 * 136;
        }
      }
    } else {
      int col = tid >> 1, half = tid & 1;
      int hd = (n0 - 1280) / 64 + (col >> 6), d = col & 63;
      bf16_t* dst;
      if (m0 < T) { int b = m0 / S, t0 = m0 % S; dst = VT + (((size_t)b * 4 + hd) * 64 + d) * S + t0 + half * 64; }
      else { int mm = m0 - T; int b = mm / CL, l0 = mm % CL; dst = VT + (size_t)NB * 4 * 64 * S + (((size_t)b * 4 + hd) * 64 + d) * CL + l0 + half * 64; }
      const bf16_t* src = t + (half * 64) * 136 + col;
#pragma unroll
      for (int i = 0; i < 8; ++i) {
        unsigned wv[4];
#pragma unroll
        for (int j = 0; j < 4; ++j) wv[j] = (unsigned)src[(i * 8 + 2 * j) * 136] | ((unsigned)src[(i * 8 + 2 * j + 1) * 136] << 16);
        *(uint4*)(dst + i * 8) = make_uint4(wv[0], wv[1], wv[2], wv[3]);
      }
    }
  }
};
__device__ __forceinline__ void gemm_tile_mainloop(const bf16_t* __restrict__ Ag, int lda, const bf16_t* __restrict__ Bg, int ldb, int KT,
                                                   f32x16 (&acc)[2][2], char* smem) {
  int tid = threadIdx.x;
  asm volatile("" : "+v"(tid));
  int lane = tid & 63, wave = __builtin_amdgcn_readfirstlane(tid >> 6), wm = wave >> 1, wn = wave & 1;
#pragma unroll
  for (int mi = 0; mi < 2; ++mi)
#pragma unroll
    for (int ni = 0; ni < 2; ++ni)
#pragma unroll
      for (int r = 0; r < 16; ++r) acc[mi][ni][r] = 0.f;
  __syncthreads();
  gemm_stage(Ag, lda, 0, smem, tid); gemm_stage(Bg, ldb, 0, smem + 16384, tid);
  for (int kt = 0; kt < KT; ++kt) {
    asm volatile("s_waitcnt vmcnt(0)" ::: "memory");
    __syncthreads();
    char* cur = smem + (kt & 1) * 32768;
    if (kt + 1 < KT) {
      char* nxt = smem + ((kt + 1) & 1) * 32768;
      gemm_stage(Ag, lda, (kt + 1) * 64, nxt, tid); gemm_stage(Bg, ldb, (kt + 1) * 64, nxt + 16384, tid);
    }
#pragma unroll
    for (int s4 = 0; s4 < 4; ++s4) {
      bf16x8 a[2], b[2];
      int c = 2 * s4 + (lane >> 5);
#pragma unroll
      for (int mi = 0; mi < 2; ++mi) { int row = wm * 64 + mi * 32 + (lane & 31); a[mi] = *(const bf16x8*)(cur + row * 128 + ((c ^ ((row >> 1) & 7)) << 4)); }
#pragma unroll
      for (int ni = 0; ni < 2; ++ni) { int row = wn * 64 + ni * 32 + (lane & 31); b[ni] = *(const bf16x8*)(cur + 16384 + row * 128 + ((c ^ ((row >> 1) & 7)) << 4)); }
#pragma unroll
      for (int mi = 0; mi < 2; ++mi)
#pragma unroll
        for (int ni = 0; ni < 2; ++ni) acc[mi][ni] = __builtin_amdgcn_mfma_f32_32x32x16_bf16(a[mi], b[ni], acc[mi][ni], 0, 0, 0);
    }
  }
  __syncthreads();
}
template <class Epi>
__device__ __forceinline__ void ph_gemm_bf16(const bf16_t* __restrict__ A, int lda, const bf16_t* __restrict__ Bt, int ldb, int M, int N, int K,
                             Epi epi, char* smem) {
  int tid = threadIdx.x, wave = __builtin_amdgcn_readfirstlane(tid >> 6), wm = wave >> 1, wn = wave & 1;
  int ntn = N / 128, ntiles = (M / 128) * ntn;
  int KT = K / 64;
  GRID_LOOP(tile, ntiles) {
    int mt = tile / ntn, nt = tile % ntn;
    f32x16 acc[2][2];
    gemm_tile_mainloop(A + (size_t)mt * 128 * lda, lda, Bt + (size_t)nt * 128 * ldb, ldb, KT, acc, smem);
    epi(mt * 128, nt * 128, wm, wn, acc, tid, smem);
  }
}

__device__ __forceinline__ void ins16(float (&L)[16], float x) {
#pragma unroll
  for (int j = 15; j >= 1; --j) L[j] = __builtin_amdgcn_fmed3f(L[j - 1], L[j], x);
  L[0] = fmaxf(L[0], x);
}
__device__ __forceinline__ void stage_tile128(const bf16_t* __restrict__ src, int ld, char* lds, int tid) {
#pragma unroll
  for (int i = 0; i < 8; ++i) {
    int q = tid + 256 * i; int row = q >> 4, p = q & 15; int c = p ^ (row & 15);
    __builtin_amdgcn_global_load_lds((const unsigned*)(src + (size_t)row * ld + c * 8), (unsigned*)(lds + q * 16), 16, 0, 0);
  }
}
__device__ __forceinline__ void ph_peer_select(const bf16_t* __restrict__ H, const bf16_t* __restrict__ WQl, const bf16_t* __restrict__ SKl,
                                               int* __restrict__ EXP, float* __restrict__ GATE, int nrows, char* smem) {
  int tid = threadIdx.x, w = __builtin_amdgcn_readfirstlane(tid >> 6), wm = w >> 1, wn = w & 1;
  bf16_t* Qs = (bf16_t*)smem;
  int* KL = (int*)(smem + 36864);
  int nunits = (nrows / 128) * 8;
  GRID_LOOP(unit, nunits) {
    int mt = unit >> 3, h = unit & 7;
    float L0[16], L1[16];
#pragma unroll
    for (int p = 0; p < 2; ++p) {
      f32x16 acc[2][2];
      gemm_tile_mainloop(H + (size_t)mt * 128 * 1024, 1024, WQl + (size_t)(h * 256 + p * 128) * 1024, 1024, 16, acc, smem);
      int lane = tid & 63;
      asm volatile("" : "+v"(lane));
      {
        bf16_t* qw = Qs + (wm * 64 + 4 * (lane >> 5)) * 136 + wn * 64 + (lane & 31);
#pragma unroll
        for (int mi = 0; mi < 2; ++mi)
#pragma unroll
          for (int ni = 0; ni < 2; ++ni)
#pragma unroll
            for (int r = 0; r < 16; ++r)
              qw[(mi * 32 + (r & 3) + 8 * (r >> 2)) * 136 + ni * 32] = (bf16_t)f2bf(acc[mi][ni][r]);
      }
      __syncthreads();
      f32x16 sc[4];
#pragma unroll
      for (int m4 = 0; m4 < 4; ++m4)
#pragma unroll
        for (int r = 0; r < 16; ++r) sc[m4][r] = 0.f;
      {
        const bf16_t* qrow = Qs + (32 * w + (lane & 31)) * 136 + 8 * (lane >> 5);
        const bf16_t* krow = SKl + (size_t)(h * 2 + p) * 128 * 128 + (lane & 31) * 128 + 8 * (lane >> 5);
#pragma unroll
        for (int s8 = 0; s8 < 8; ++s8) {
          bf16x8 bq = *(const bf16x8*)(qrow + 16 * s8);
#pragma unroll
          for (int m4 = 0; m4 < 4; ++m4) {
            bf16x8 ak = *(const bf16x8*)(krow + m4 * 32 * 128 + 16 * s8);
            sc[m4] = __builtin_amdgcn_mfma_f32_32x32x16_bf16(ak, bq, sc[m4], 0, 0, 0);
          }
        }
      }
      float L[16];
#pragma unroll
      for (int j = 0; j < 16; ++j) L[j] = -INFINITY;
      unsigned kb = 4u * (unsigned)(lane >> 5);
#pragma unroll
      for (int m4 = 0; m4 < 4; ++m4)
#pragma unroll
        for (int r = 0; r < 16; ++r) {
          unsigned key = kb + (unsigned)(32 * m4 + (r & 3) + 8 * (r >> 2));
          float x = __uint_as_float((__float_as_uint(sc[m4][r]) & 0xFFFFFF80u) | key);
          ins16(L, x);
        }
      float P[16];
#pragma unroll
      for (int j = 0; j < 16; ++j) P[j] = __shfl_xor(L[j], 32);
#pragma unroll
      for (int j = 0; j < 16; ++j) ins16(L, P[j]);
      if (p == 0) {
#pragma unroll
        for (int j = 0; j < 16; ++j) L0[j] = L[j];
      } else {
#pragma unroll
        for (int j = 0; j < 16; ++j) L1[j] = L[j];
      }
    }
    float C[16];
#pragma unroll
    for (int j = 0; j < 16; ++j) C[j] = -INFINITY;
#pragma unroll
    for (int a = 0; a < 16; ++a)
#pragma unroll
      for (int b = 0; b < 16; ++b)
        if ((a + 1) * (b + 1) <= 16) {
          float sa = __uint_as_float(__float_as_uint(L0[a]) & 0xFFFFFF80u);
          float sb = __uint_as_float(__float_as_uint(L1[b]) & 0xFFFFFF80u);
          float x = __uint_as_float((__float_as_uint(sa + sb) & 0xFFFFFF00u) | (unsigned)(a * 16 + b));
          ins16(C, x);
        }
    int lane = tid & 63;
    asm volatile("" : "+v"(lane));
    int token = 32 * w + (lane & 31);
    if (lane < 32) {
#pragma unroll
      for (int j = 0; j < 16; ++j) { KL[token * 32 + j] = (int)(__float_as_uint(L0[j]) & 0x7Fu); KL[token * 32 + 16 + j] = (int)(__float_as_uint(L1[j]) & 0x7Fu); }
    }
    __syncthreads();
    if (lane < 32) {
      float c0 = __uint_as_float(__float_as_uint(C[0]) & 0xFFFFFF00u);
      float ev[16]; float sum = 0.f; int ex[16];
#pragma unroll
      for (int j = 0; j < 16; ++j) {
        unsigned bits = __float_as_uint(C[j]);
        float cv = __uint_as_float(bits & 0xFFFFFF00u);
        ev[j] = __expf(cv - c0); sum += ev[j];
        int a = (bits >> 4) & 15, b = bits & 15;
        ex[j] = KL[token * 32 + a] * 128 + KL[token * 32 + 16 + b];
      }
      float inv = 1.f / sum;
      size_t o = (size_t)(mt * 128 + token) * 128 + h * 16;
#pragma unroll
      for (int j = 0; j < 16; j += 4) {
        *(int4*)(EXP + o + j) = make_int4(ex[j], ex[j + 1], ex[j + 2], ex[j + 3]);
        *(float4*)(GATE + o + j) = make_float4(ev[j] * inv, ev[j + 1] * inv, ev[j + 2] * inv, ev[j + 3] * inv);
      }
    }
  }
}

__device__ __forceinline__ void fft1_unit(int u, const bf16_t* __restrict__ FQKV, const bf16_t* __restrict__ D1, const float* __restrict__ TAB,
                          bf16_t* __restrict__ A1, char* smem) {
  int tid = threadIdx.x, lane = tid & 63, w = __builtin_amdgcn_readfirstlane(tid >> 6);
  int g = u & 7, c = (u >> 3) & 63, b = u >> 9;
  bf16_t* Bt = (bf16_t*)smem;
  __syncthreads();
  {
    int r = tid >> 1, half = tid & 1;
    const uint4* src = (const uint4*)(FQKV + (size_t)(b * S + 64 * r + c) * 2048 + g * 64 + half * 32);
    unsigned wv[16];
#pragma unroll
    for (int i = 0; i < 4; ++i) { uint4 v = src[i]; wv[4 * i] = v.x; wv[4 * i + 1] = v.y; wv[4 * i + 2] = v.z; wv[4 * i + 3] = v.w; }
#pragma unroll
    for (int j = 0; j < 32; ++j) {
      unsigned e = (j & 1) ? (wv[j >> 1] >> 16) : (wv[j >> 1] & 0xffffu);
      Bt[(half * 32 + j) * 136 + r] = (bf16_t)e;
    }
  }
  __syncthreads();
  f32x16 acc[2][2];
#pragma unroll
  for (int mi = 0; mi < 2; ++mi)
#pragma unroll
    for (int ni = 0; ni < 2; ++ni)
#pragma unroll
      for (int r = 0; r < 16; ++r) acc[mi][ni][r] = 0.f;
#pragma unroll
  for (int s8 = 0; s8 < 8; ++s8) {
    bf16x8 a[2], bb[2];
    int ko = 16 * s8 + 8 * (lane >> 5);
#pragma unroll
    for (int mi = 0; mi < 2; ++mi) a[mi] = *(const bf16x8*)(D1 + (64 * w + 32 * mi + (lane & 31)) * 128 + ko);
#pragma unroll
    for (int ni = 0; ni < 2; ++ni) bb[ni] = *(const bf16x8*)(Bt + (32 * ni + (lane & 31)) * 136 + ko);
#pragma unroll
    for (int mi = 0; mi < 2; ++mi)
#pragma unroll
      for (int ni = 0; ni < 2; ++ni) acc[mi][ni] = __builtin_amdgcn_mfma_f32_32x32x16_bf16(a[mi], bb[ni], acc[mi][ni], 0, 0, 0);
  }
  bf16_t* Ot = (bf16_t*)(smem + 17408);
#pragma unroll
  for (int mi = 0; mi < 2; ++mi)
#pragma unroll
    for (int j = 0; j < 8; ++j) {
      int m = 64 * w + 32 * mi + ((2 * j) & 3) + 8 * ((2 * j) >> 2) + 4 * (lane >> 5);
      int k1 = m >> 1;
      int idx = (k1 * c) & 8191;
      float cs = TAB[idx], sn = TAB[8192 + idx];
#pragma unroll
      for (int ni = 0; ni < 2; ++ni) {
        float re = acc[mi][ni][2 * j], im = acc[mi][ni][2 * j + 1];
        float re2 = re * cs + im * sn, im2 = im * cs - re * sn;
        bf16_t* dst = Ot + m * 72 + 32 * ni + (lane & 31);
        dst[0] = (bf16_t)f2bf(re2); dst[72] = (bf16_t)f2bf(im2);
      }
    }
  __syncthreads();
  {
    bf16_t* base = A1 + (((size_t)b * 64 + c) * 128) * 2 * 512 + g * 64;
#pragma unroll
    for (int i = 0; i < 8; ++i) {
      int q = tid + 256 * i; int m = q >> 3, ch8 = q & 7;
      *(uint4*)(base + (size_t)m * 512 + ch8 * 8) = *(const uint4*)(Ot + m * 72 + ch8 * 8);
    }
  }
}

__device__ __forceinline__ void fft3_unit(int u, int mode, const bf16_t* __restrict__ FQKV, const bf16_t* __restrict__ A1, const bf16_t* __restrict__ D3,
                          const bf16_t* __restrict__ DcT, const float* __restrict__ TAB, bf16_t* __restrict__ MIX, char* smem) {
  int tid = threadIdx.x, lane = tid & 63, w = __builtin_amdgcn_readfirstlane(tid >> 6);
  bf16_t* Bt = (bf16_t*)smem;
  bf16_t* Xs = (bf16_t*)(smem + 17408);
  int g = u & 7, k1, b, nk1, rowbase; float norm;
  __syncthreads();
  if (mode == 0) {
    k1 = (u >> 3) & 127; b = u >> 10; nk1 = 128; rowbase = b * S; norm = 1.f / 724.0773439350247f;
    int kk = tid >> 1, half = tid & 1; int c = kk >> 1, ri = kk & 1;
    const uint4* src = (const uint4*)(A1 + ((((size_t)b * 64 + c) * 128 + k1) * 2 + ri) * 512 + g * 64 + half * 32);
    unsigned wv[16];
#pragma unroll
    for (int i = 0; i < 4; ++i) { uint4 v = src[i]; wv[4 * i] = v.x; wv[4 * i + 1] = v.y; wv[4 * i + 2] = v.z; wv[4 * i + 3] = v.w; }
#pragma unroll
    for (int j = 0; j < 32; ++j) {
      unsigned e = (j & 1) ? (wv[j >> 1] >> 16) : (wv[j >> 1] & 0xffffu);
      Bt[(half * 32 + j) * 136 + kk] = (bf16_t)e;
    }
  } else {
    k1 = (u >> 3) & 3; b = u >> 5; nk1 = 4; rowbase = T + b * CL; norm = 1.f / 128.f;
    int c = tid >> 2, q4 = tid & 3;
    float re[16], im[16];
#pragma unroll
    for (int j = 0; j < 16; ++j) { re[j] = 0.f; im[j] = 0.f; }
#pragma unroll
    for (int r = 0; r < 4; ++r) {
      const uint4* src = (const uint4*)(FQKV + (size_t)(rowbase + 64 * r + c) * 2048 + g * 64 + q4 * 16);
      uint4 v0 = src[0], v1 = src[1];
      unsigned wv[8] = {v0.x, v0.y, v0.z, v0.w, v1.x, v1.y, v1.z, v1.w};
      int ph = (k1 * r) & 3;
      float cr = (ph == 0) ? 1.f : (ph == 2 ? -1.f : 0.f);
      float ci = (ph == 1) ? -1.f : (ph == 3 ? 1.f : 0.f);
#pragma unroll
      for (int j = 0; j < 16; ++j) {
        float x = bf2f((unsigned short)((j & 1) ? (wv[j >> 1] >> 16) : (wv[j >> 1] & 0xffffu)));
        re[j] += x * cr; im[j] += x * ci;
      }
    }
    int idx = (k1 * c * 32) & 8191;
    float cs = TAB[idx], sn = TAB[8192 + idx];
#pragma unroll
    for (int j = 0; j < 16; ++j) {
      float re2 = re[j] * cs + im[j] * sn, im2 = im[j] * cs - re[j] * sn;
      *(unsigned*)(Bt + (q4 * 16 + j) * 136 + 2 * c) = pack2bf(re2, im2);
    }
  }
  __syncthreads();
  {
    f32x16 acc[2];
#pragma unroll
    for (int ni = 0; ni < 2; ++ni)
#pragma unroll
      for (int r = 0; r < 16; ++r) acc[ni][r] = 0.f;
#pragma unroll
    for (int s8 = 0; s8 < 8; ++s8) {
      int ko = 16 * s8 + 8 * (lane >> 5);
      bf16x8 a = *(const bf16x8*)(D3 + (32 * w + (lane & 31)) * 128 + ko);
#pragma unroll
      for (int ni = 0; ni < 2; ++ni) {
        bf16x8 bb = *(const bf16x8*)(Bt + (32 * ni + (lane & 31)) * 136 + ko);
        acc[ni] = __builtin_amdgcn_mfma_f32_32x32x16_bf16(a, bb, acc[ni], 0, 0, 0);
      }
    }
#pragma unroll
    for (int ni = 0; ni < 2; ++ni)
#pragma unroll
      for (int r = 0; r < 16; ++r) {
        int m = 32 * w + (r & 3) + 8 * (r >> 2) + 4 * (lane >> 5);
        Xs[(m & 63) * 136 + (m >> 6) * 64 + 32 * ni + (lane & 31)] = (bf16_t)f2bf(acc[ni][r]);
      }
  }
  __syncthreads();
  {
    int mi = w >> 1, ni = w & 1;
    f32x16 acc;
#pragma unroll
    for (int r = 0; r < 16; ++r) acc[r] = 0.f;
#pragma unroll
    for (int s8 = 0; s8 < 8; ++s8) {
      int ko = 16 * s8 + 8 * (lane >> 5);
      bf16x8 a = *(const bf16x8*)(Xs + (32 * mi + (lane & 31)) * 136 + ko);
      bf16x8 bb = *(const bf16x8*)(DcT + (32 * ni + (lane & 31)) * 128 + ko);
      acc = __builtin_amdgcn_mfma_f32_32x32x16_bf16(a, bb, acc, 0, 0, 0);
    }
    bf16_t* Yt = Bt;
#pragma unroll
    for (int r = 0; r < 16; ++r) {
      int k2 = 32 * mi + (r & 3) + 8 * (r >> 2) + 4 * (lane >> 5);
      Yt[k2 * 72 + 32 * ni + (lane & 31)] = (bf16_t)f2bf(acc[r] * norm);
    }
  }
  __syncthreads();
#pragma unroll
  for (int i = 0; i < 2; ++i) {
    int q = tid + 256 * i; int k2 = q >> 3, ch8 = q & 7;
    int row = rowbase + k1 + nk1 * k2;
    *(uint4*)(MIX + (size_t)row * 1024 + g * 64 + ch8 * 8) = *(const uint4*)((const bf16_t*)smem + k2 * 72 + ch8 * 8);
  }
}

typedef __attribute__((ext_vector_type(4))) float f32x4_t;
__device__ __forceinline__ bf16x8 ld16(const bf16_t* p) { return *(const bf16x8*)p; }
__device__ __forceinline__ float fast_exp2(float x) { return __builtin_amdgcn_exp2f(x); }

template <int NH, int MODE, int KPI>
__device__ __forceinline__ void attn_unit(int b, int hk, int r, int jb, int qb, const bf16_t* __restrict__ Qp, int ldq, const bf16_t* __restrict__ Kp, int ldk,
                                          const bf16_t* __restrict__ VTl, const bf16_t* __restrict__ VTc, int nkvh,
                                          const float* rpbs, const float* __restrict__ sink,
                                          bf16_t* __restrict__ Op, int ldo, int lane) {
  const float LOG2E = 1.4426950408889634f;
  const float SC = 0.125f * LOG2E;
  asm volatile("" : "+v"(lane));
  int ql = lane & 15, g = lane >> 4;
  int qrow0, q0 = 0;
  int nloc, lb0 = 0;
  if (MODE == 0) { qrow0 = b * S + r * 64 + 16 * jb; nloc = 8; }
  else if (MODE == 1) { qrow0 = T + b * CL + 16 * qb; nloc = 0; }
  else { q0 = 16 * qb; qrow0 = b * S + q0;
         int lo = (q0 - 128) >> 5, hi = (q0 + 143) >> 5; if (lo < 0) lo = 0; if (hi > 255) hi = 255; lb0 = lo; nloc = hi - lo + 1; }
  bf16x8 qf[NH][2];
#pragma unroll
  for (int hh = 0; hh < NH; ++hh)
#pragma unroll
    for (int s2 = 0; s2 < 2; ++s2)
      qf[hh][s2] = ld16(Qp + (size_t)(qrow0 + ql) * ldq + (hk * NH + hh) * 64 + 32 * s2 + 8 * g);
  f32x4_t o[NH][4]; float mrun[NH], lrun[NH];
#pragma unroll
  for (int hh = 0; hh < NH; ++hh) {
    mrun[hh] = -1e30f; lrun[hh] = 0.f;
#pragma unroll
    for (int dt = 0; dt < 4; ++dt) o[hh][dt] = (f32x4_t){0.f, 0.f, 0.f, 0.f};
  }
  int r_start = 0, blk_start = 0, c_lo = 0, qc = 0;
  if (MODE == 0) {
    r_start = min(max(r - 4, 0), 120);
    blk_start = min(max(16 * jb - 8, 0), 32);
    qc = 16 * jb + ql; c_lo = min(max(qc - 8, 0), 48);
  }
  int nit = (nloc + 8) / KPI;
#define ATT_DESC(kbx, krow0_, vtp_, vld_) \
    { bool il_ = (kbx) < nloc; int vt0_; \
      if (il_) { if (MODE == 0) { int rr_ = r_start + (kbx); krow0_ = b * S + rr_ * 64 + blk_start; vt0_ = rr_ * 64 + blk_start; } \
                 else { krow0_ = b * S + 32 * (lb0 + (kbx)); vt0_ = 32 * (lb0 + (kbx)); } \
                 vtp_ = VTl + ((size_t)(b * nkvh + hk) * 64) * S + vt0_; vld_ = S; } \
      else { int cb_ = (kbx) - nloc; krow0_ = T + b * CL + 32 * cb_; vt0_ = 32 * cb_; \
             vtp_ = VTc + ((size_t)(b * nkvh + hk) * 64) * CL + vt0_; vld_ = CL; } }
#define ATT_LOAD(kbx, KF, VF) \
    { int krow0; const bf16_t* vt; int vld; ATT_DESC(kbx, krow0, vt, vld) \
      _Pragma("unroll") for (int t = 0; t < 2; ++t) _Pragma("unroll") for (int s2 = 0; s2 < 2; ++s2) \
        KF[t][s2] = ld16(Kp + (size_t)(krow0 + 8 * (ql >> 2) + 4 * t + (ql & 3)) * ldk + hk * 64 + 32 * s2 + 8 * g); \
      _Pragma("unroll") for (int dt = 0; dt < 4; ++dt) VF[dt] = ld16(vt + (size_t)(16 * dt + ql) * vld + 8 * g); }
  bf16x8 kfn[KPI][2][2], vfn[KPI][4];
#pragma unroll
  for (int kk = 0; kk < KPI; ++kk) ATT_LOAD(kk, kfn[kk], vfn[kk])
  for (int it = 0; it < nit; ++it) {
    bf16x8 kf[KPI][2][2], vf[KPI][4];
#pragma unroll
    for (int kk = 0; kk < KPI; ++kk) {
#pragma unroll
      for (int t = 0; t < 2; ++t)
#pragma unroll
        for (int s2 = 0; s2 < 2; ++s2) kf[kk][t][s2] = kfn[kk][t][s2];
#pragma unroll
      for (int dt = 0; dt < 4; ++dt) vf[kk][dt] = vfn[kk][dt];
    }
    if (it + 1 < nit) {
#pragma unroll
      for (int kk = 0; kk < KPI; ++kk) ATT_LOAD((it + 1) * KPI + kk, kfn[kk], vfn[kk])
    }
    float bias[KPI][2][4]; bool valid[KPI][2][4];
#pragma unroll
    for (int kk = 0; kk < KPI; ++kk) {
      int kb = it * KPI + kk;
      bool is_loc = kb < nloc;
#pragma unroll
      for (int t = 0; t < 2; ++t)
#pragma unroll
        for (int i = 0; i < 4; ++i) {
          bias[kk][t][i] = 0.f; valid[kk][t][i] = true;
          if (MODE == 0 && is_loc) {
            int kc = blk_start + 8 * g + 4 * t + i;
            valid[kk][t][i] = (kc >= c_lo) && (kc < c_lo + 16);
            int dc = min(max(kc - qc, -15), 15) + 15;
            bias[kk][t][i] = rpbs[(hk * 15 + (r_start + kb - r + 7)) * 31 + dc];
          }
          if (MODE == 2 && is_loc) {
            int kpos = 32 * (lb0 + kb) + 8 * g + 4 * t + i; int dq = (q0 + ql) - kpos;
            bias[kk][t][i] = ((dq <= 128) && (dq >= -128)) ? 0.f : -1e30f;
          }
        }
    }
#pragma unroll
    for (int hh = 0; hh < NH; ++hh) {
      f32x4_t st[KPI][2];
#pragma unroll
      for (int kk = 0; kk < KPI; ++kk)
#pragma unroll
        for (int t = 0; t < 2; ++t) {
          st[kk][t] = (f32x4_t){0.f, 0.f, 0.f, 0.f};
          st[kk][t] = __builtin_amdgcn_mfma_f32_16x16x32_bf16(kf[kk][t][0], qf[hh][0], st[kk][t], 0, 0, 0);
          st[kk][t] = __builtin_amdgcn_mfma_f32_16x16x32_bf16(kf[kk][t][1], qf[hh][1], st[kk][t], 0, 0, 0);
        }
      float lg[KPI][2][4]; float bm = -1e30f;
#pragma unroll
      for (int kk = 0; kk < KPI; ++kk)
#pragma unroll
        for (int t = 0; t < 2; ++t)
#pragma unroll
          for (int i = 0; i < 4; ++i) {
            float v = (MODE == 0) ? (valid[kk][t][i] ? (st[kk][t][i] * SC + bias[kk][t][i]) : -1e30f) : fmaf(st[kk][t][i], SC, bias[kk][t][i]);
            lg[kk][t][i] = v; bm = fmaxf(bm, v);
          }
      bm = xrow16_max(bm);
      float mn = fmaxf(mrun[hh], bm);
      float alpha = fast_exp2(mrun[hh] - mn);
      mrun[hh] = mn;
      float ps = 0.f;
      bf16x8 pf[KPI];
#pragma unroll
      for (int kk = 0; kk < KPI; ++kk) {
        float pv[8];
#pragma unroll
        for (int t = 0; t < 2; ++t)
#pragma unroll
          for (int i = 0; i < 4; ++i) {
            float p = (MODE == 0) ? (valid[kk][t][i] ? fast_exp2(lg[kk][t][i] - mn) : 0.f) : fast_exp2(lg[kk][t][i] - mn);
            pv[4 * t + i] = p; ps += p;
          }
        typedef __attribute__((ext_vector_type(4))) unsigned u32x4;
        u32x4 uu = {pack2bf(pv[0], pv[1]), pack2bf(pv[2], pv[3]), pack2bf(pv[4], pv[5]), pack2bf(pv[6], pv[7])};
        pf[kk] = __builtin_bit_cast(bf16x8, uu);
      }
      lrun[hh] = lrun[hh] * alpha + ps;
#pragma unroll
      for (int dt = 0; dt < 4; ++dt) {
        o[hh][dt] *= alpha;
#pragma unroll
        for (int kk = 0; kk < KPI; ++kk)
          o[hh][dt] = __builtin_amdgcn_mfma_f32_16x16x32_bf16(vf[kk][dt], pf[kk], o[hh][dt], 0, 0, 0);
      }
    }
  }
#undef ATT_LOAD
#undef ATT_DESC
#pragma unroll
  for (int hh = 0; hh < NH; ++hh) {
    float l = xrow16_sum(lrun[hh]);
    float m = mrun[hh];
    if (MODE == 2) {
      float sk = sink[hk * NH + hh] * LOG2E;
      float mf = fmaxf(m, sk);
      float a = fast_exp2(m - mf);
      l = l * a + fast_exp2(sk - mf);
#pragma unroll
      for (int dt = 0; dt < 4; ++dt) o[hh][dt] *= a;
    }
    float inv = 1.f / l;
    bf16_t* orow = Op + (size_t)(qrow0 + ql) * ldo + (hk * NH + hh) * 64 + 4 * g;
#pragma unroll
    for (int dt = 0; dt < 4; ++dt) {
      f32x4_t v = o[hh][dt] * inv;
      *(uint2*)(orow + 16 * dt) = make_uint2(pack2bf(v[0], v[1]), pack2bf(v[2], v[3]));
    }
  }
}

struct NaState { f32x4_t o[4][4]; float m[4], l[4]; };
template <int HB>
__device__ __forceinline__ void na_block(NaState& st, const bf16x8 (&qf)[4][2], const bf16x8 (&kf)[2][2], const bf16x8 (&vf)[4],
                                         const float* rpbrow  , int ql, int g) {
  const float SC = 0.125f * 1.4426950408889634f;
#pragma unroll
  for (int jb = 0; jb < 4; ++jb) {
    if (HB == 0 && jb == 3) continue;
    if (HB == 1 && jb == 0) continue;
    f32x4_t s2[2];
#pragma unroll
    for (int t = 0; t < 2; ++t) {
      s2[t] = (f32x4_t){0.f, 0.f, 0.f, 0.f};
      s2[t] = __builtin_amdgcn_mfma_f32_16x16x32_bf16(kf[t][0], qf[jb][0], s2[t], 0, 0, 0);
      s2[t] = __builtin_amdgcn_mfma_f32_16x16x32_bf16(kf[t][1], qf[jb][1], s2[t], 0, 0, 0);
    }
    float lg[8]; bool valid[8]; float bm = -1e30f;
#pragma unroll
    for (int t = 0; t < 2; ++t)
#pragma unroll
      for (int i = 0; i < 4; ++i) {
        float v;
        if (HB < 2) {
          int qc = 16 * jb + ql; int c_lo = min(max(qc - 8, 0), 48);
          int kc = 32 * HB + 8 * g + 4 * t + i;
          bool ok = (kc >= c_lo) && (kc < c_lo + 16);
          int dc = min(max(kc - qc, -15), 15) + 15;
          v = ok ? (s2[t][i] * SC + rpbrow[dc]) : -1e30f;
          valid[4 * t + i] = ok;
        } else { v = s2[t][i] * SC; valid[4 * t + i] = true; }
        lg[4 * t + i] = v; bm = fmaxf(bm, v);
      }
    bm = xrow16_max(bm);
    float mn = fmaxf(st.m[jb], bm);
    float alpha = fast_exp2(st.m[jb] - mn);
    st.m[jb] = mn;
    float ps = 0.f; float pv[8];
#pragma unroll
    for (int e = 0; e < 8; ++e) { float p = valid[e] ? fast_exp2(lg[e] - mn) : 0.f; pv[e] = p; ps += p; }
    st.l[jb] = st.l[jb] * alpha + ps;
    typedef __attribute__((ext_vector_type(4))) unsigned u32x4;
    u32x4 uu = {pack2bf(pv[0], pv[1]), pack2bf(pv[2], pv[3]), pack2bf(pv[4], pv[5]), pack2bf(pv[6], pv[7])};
    bf16x8 pf = __builtin_bit_cast(bf16x8, uu);
#pragma unroll
    for (int dt = 0; dt < 4; ++dt) {
      st.o[jb][dt] *= alpha;
      st.o[jb][dt] = __builtin_amdgcn_mfma_f32_16x16x32_bf16(vf[dt], pf, st.o[jb][dt], 0, 0, 0);
    }
    if (jb & 1) __builtin_amdgcn_sched_barrier(0);
  }
}
__device__ __forceinline__ void na_unit(int b, int h, int r, const bf16_t* __restrict__ FQKV, const bf16_t* __restrict__ VTl,
                                        const bf16_t* __restrict__ VTc, const float* rpbs, bf16_t* __restrict__ MIX, int lane) {
  asm volatile("" : "+v"(lane));
  int ql = lane & 15, g = lane >> 4;
  int qrow0 = b * S + r * 64;
  int r_start = min(max(r - 4, 0), 120);
  bf16x8 qf[4][2];
#pragma unroll
  for (int jb = 0; jb < 4; ++jb)
#pragma unroll
    for (int s2 = 0; s2 < 2; ++s2)
      qf[jb][s2] = ld16(FQKV + (size_t)(qrow0 + 16 * jb + ql) * 2048 + 512 + h * 64 + 32 * s2 + 8 * g);
  NaState st;
#pragma unroll
  for (int jb = 0; jb < 4; ++jb) {
    st.m[jb] = -1e30f; st.l[jb] = 0.f;
#pragma unroll
    for (int dt = 0; dt < 4; ++dt) st.o[jb][dt] = (f32x4_t){0.f, 0.f, 0.f, 0.f};
  }
  unsigned koff = (unsigned)((8 * (ql >> 2) + (ql & 3)) * 2048 + 1024 + h * 64 + 8 * g);
  unsigned voffl = (unsigned)(ql * S + 8 * g), voffc = (unsigned)(ql * CL + 8 * g);
  const bf16_t* vtl = VTl + (size_t)(b * 8 + h) * 64 * S;
  const bf16_t* vtc = VTc + (size_t)(b * 8 + h) * 64 * CL;
#define NA_LOADK(kb2, KF) { \
    int krow0_; \
    if ((kb2) < 16) krow0_ = b * S + (r_start + ((kb2) >> 1)) * 64 + 32 * ((kb2) & 1); \
    else krow0_ = T + b * CL + 32 * ((kb2) - 16); \
    const bf16_t* kb_ = FQKV + (size_t)krow0_ * 2048; \
    _Pragma("unroll") for (int t = 0; t < 2; ++t) _Pragma("unroll") for (int s2 = 0; s2 < 2; ++s2) \
      KF[t][s2] = ld16(kb_ + (koff + (unsigned)(t * 4 * 2048 + 32 * s2))); }
#define NA_LOADV(kb2, VF) { \
    if ((kb2) < 16) { const bf16_t* vt_ = vtl + (r_start + ((kb2) >> 1)) * 64 + 32 * ((kb2) & 1); \
      _Pragma("unroll") for (int dt = 0; dt < 4; ++dt) VF[dt] = ld16(vt_ + (voffl + (unsigned)(16 * dt * S))); } \
    else { const bf16_t* vt_ = vtc + 32 * ((kb2) - 16); \
      _Pragma("unroll") for (int dt = 0; dt < 4; ++dt) VF[dt] = ld16(vt_ + (voffc + (unsigned)(16 * dt * CL))); } }
  bf16x8 kfa[2][2], kfb[2][2], vfa[4], vfb[4];
  NA_LOADK(0, kfa) NA_LOADV(0, vfa)
#pragma unroll 1
  for (int rr = 0; rr < 8; ++rr) {
    const float* rpbrow = rpbs + (h * 15 + (r_start + rr - r + 7)) * 31;
    asm volatile("" : "+v"(lane)); ql = lane & 15; g = lane >> 4;
    koff = (unsigned)((8 * (ql >> 2) + (ql & 3)) * 2048 + 1024 + h * 64 + 8 * g); voffl = (unsigned)(ql * S + 8 * g); voffc = (unsigned)(ql * CL + 8 * g);
    NA_LOADK(2 * rr + 1, kfb) NA_LOADV(2 * rr + 1, vfb)
    na_block<0>(st, qf, kfa, vfa, rpbrow, ql, g);
    NA_LOADK(2 * rr + 2, kfa) NA_LOADV(2 * rr + 2, vfa)
    na_block<1>(st, qf, kfb, vfb, rpbrow, ql, g);
  }
#pragma unroll 1
  for (int cb = 0; cb < 8; cb += 2) {
    asm volatile("" : "+v"(lane)); ql = lane & 15; g = lane >> 4;
    koff = (unsigned)((8 * (ql >> 2) + (ql & 3)) * 2048 + 1024 + h * 64 + 8 * g); voffc = (unsigned)(ql * CL + 8 * g);
    NA_LOADK(16 + cb + 1, kfb) NA_LOADV(16 + cb + 1, vfb)
    na_block<2>(st, qf, kfa, vfa, rpbs, ql, g);
    if (cb + 2 < 8) { NA_LOADK(16 + cb + 2, kfa) NA_LOADV(16 + cb + 2, vfa) }
    na_block<2>(st, qf, kfb, vfb, rpbs, ql, g);
  }
#undef NA_LOADK
#undef NA_LOADV
  asm volatile("" : "+v"(lane)); ql = lane & 15; g = lane >> 4;
#pragma unroll
  for (int jb = 0; jb < 4; ++jb) {
    float inv = 1.f / xrow16_sum(st.l[jb]);
    bf16_t* orow = MIX + (size_t)(qrow0 + 16 * jb + ql) * 1024 + 512 + h * 64 + 4 * g;
#pragma unroll
    for (int dt = 0; dt < 4; ++dt) {
      f32x4_t v = st.o[jb][dt] * inv;
      *(uint2*)(orow + 16 * dt) = make_uint2(pack2bf(v[0], v[1]), pack2bf(v[2], v[3]));
    }
  }
}

__device__ __forceinline__ void ph_chan_dft(const float* __restrict__ F, const float* __restrict__ tab, float* __restrict__ PQ) {
  for (int gid = blockIdx.x * 256 + threadIdx.x; gid < R * 512; gid += gridDim.x * 256) {
    int row = gid >> 9; int col = gid & 511; int g = col >> 6, cp = col & 63;
    const float* f = F + (size_t)row * 2048 + g * 64;
    float p = 0.f, q = 0.f;
    for (int ch = 0; ch < 64; ++ch) {
      int idx = ((ch * cp) & 63) * 128;
      float x = f[ch];
      p += x * tab[idx]; q += x * tab[8192 + idx];
    }
    PQ[(size_t)row * 1024 + col] = p;
    PQ[(size_t)row * 1024 + 512 + col] = q;
  }
}

__device__ __forceinline__ void ph_na(const bf16_t* __restrict__ F, const float* __restrict__ rpb, bf16_t* __restrict__ MIX, float* sm) {
  int lane = threadIdx.x & 63, wave = __builtin_amdgcn_readfirstlane(threadIdx.x >> 6);
  float* sq = sm + wave * 1024; float* sp = sq + 64; int* stok = (int*)(sp + 384);
  int nitems = R * 8;
  for (int item0 = blockIdx.x * 4; item0 < nitems; item0 += gridDim.x * 4) {
    int item = item0 + wave;
    int h = item & 7; int row = item >> 3;
    bool is_ctx = row >= T;
    int b = is_ctx ? (row - T) / CL : row / S;
    __syncthreads();
    sq[lane] = bf2f(F[(size_t)row * 2048 + 512 + h * 64 + lane]);
    __syncthreads();
    int r = 0, c = 0, r_start = 0, c_start = 0;
    if (!is_ctx) { int t = row % S; r = t / 64; c = t % 64; r_start = min(max(r - 4, 0), 120); c_start = min(max(c - 8, 0), 48); }
    int nk = is_ctx ? 256 : 384;
    float lg[6]; float mx = -INFINITY;
#pragma unroll
    for (int kk = 0; kk < 6; ++kk) {
      int j = kk * 64 + lane; float s = -INFINITY; int tok = 0;
      if (j < nk) {
        float bias = 0.f;
        if (!is_ctx && j < 128) {
          int kr = j >> 4, kc = j & 15; int rr = r_start + kr, cc = c_start + kc;
          tok = b * S + rr * 64 + cc;
          int dc = min(max(cc - c, -15), 15) + 15;
          bias = rpb[(h * 15 + (rr - r + 7)) * 31 + dc];
        } else {
          int l = is_ctx ? j : j - 128; tok = T + b * CL + l;
        }
        const bf16_t* kp = F + (size_t)tok * 2048 + 1024 + h * 64;
        float acc = 0.f;
#pragma unroll 8
        for (int d = 0; d < 64; ++d) acc += sq[d] * bf2f(kp[d]);
        s = acc * 0.125f + bias;
      }
      lg[kk] = s; stok[j] = tok; mx = fmaxf(mx, s);
    }
    mx = wave_max(mx);
    float sum = 0.f;
#pragma unroll
    for (int kk = 0; kk < 6; ++kk) { float e = (kk * 64 + lane < nk) ? expf(lg[kk] - mx) : 0.f; lg[kk] = e; sum += e; }
    sum = wave_sum(sum);
    float inv = 1.f / sum;
#pragma unroll
    for (int kk = 0; kk < 6; ++kk) sp[kk * 64 + lane] = lg[kk] * inv;
    __syncthreads();
    float o = 0.f;
    for (int j = 0; j < nk; ++j) o += sp[j] * bf2f(F[(size_t)stok[j] * 2048 + 1536 + h * 64 + lane]);
    MIX[(size_t)row * 1024 + 512 + h * 64 + lane] = (bf16_t)f2bf(o);
  }
}

__device__ __forceinline__ void ph_rope(float* __restrict__ F1) {
  for (int gid = blockIdx.x * 256 + threadIdx.x; gid < T * 20 * 32; gid += gridDim.x * 256) {
    int i = gid & 31; int hh = (gid >> 5) % 20; int row = gid / (32 * 20);
    int t = row % S; float rowp = (float)(t / 64), colp = (float)(t % 64);
    int fi = i & 15;
    float inv_freq = powf(10000.0f, -(float)fi / 16.0f);
    float ang = (i < 16 ? rowp : colp) * inv_freq;
    float cs = cosf(ang), sn = sinf(ang);
    float* p = F1 + (size_t)row * 1536 + hh * 64;
    float x1 = p[i], x2 = p[i + 32];
    p[i] = x1 * cs - x2 * sn;
    p[i + 32] = x1 * sn + x2 * cs;
  }
}

__device__ __forceinline__ void ph_gqa(const float* __restrict__ F1, const float* __restrict__ sink, bf16_t* __restrict__ O, float* sm) {
  int lane = threadIdx.x & 63, wave = __builtin_amdgcn_readfirstlane(threadIdx.x >> 6);
  float* sq = sm + wave * 1280; float* sp = sq + 64; int* stok = (int*)(sp + 576);
  int nitems = T * 16;
  for (int item0 = blockIdx.x * 4; item0 < nitems; item0 += gridDim.x * 4) {
    int item = item0 + wave;
    int qh = item & 15; int row = item >> 4; int kvh = qh >> 2;
    int b = row / S; int t = row % S;
    __syncthreads();
    sq[lane] = F1[(size_t)row * 1536 + qh * 64 + lane];
    __syncthreads();
    float lg[9]; float mx = -INFINITY;
#pragma unroll
    for (int kk = 0; kk < 9; ++kk) {
      int j = kk * 64 + lane; float s = -INFINITY; int tok = 0; bool valid = false;
      if (j < 257) { int pos = t - 128 + j; valid = (pos >= 0 && pos < S); tok = b * S + pos; }
      else if (j < 513) { valid = true; tok = T + b * CL + (j - 257); }
      if (valid) {
        const float* kp = F1 + (size_t)tok * 1536 + 1024 + kvh * 64;
        float acc = 0.f;
#pragma unroll 8
        for (int d = 0; d < 64; ++d) acc += sq[d] * kp[d];
        s = acc * 0.125f;
      } else tok = 0;
      lg[kk] = s; stok[j] = tok; mx = fmaxf(mx, s);
    }
    mx = wave_max(mx);
    float sk = sink[qh];
    mx = fmaxf(mx, sk);
    float sum = 0.f;
#pragma unroll
    for (int kk = 0; kk < 9; ++kk) { float e = (lg[kk] == -INFINITY) ? 0.f : expf(lg[kk] - mx); lg[kk] = e; sum += e; }
    sum = wave_sum(sum) + expf(sk - mx);
    float inv = 1.f / sum;
#pragma unroll
    for (int kk = 0; kk < 9; ++kk) sp[kk * 64 + lane] = lg[kk] * inv;
    __syncthreads();
    float o = 0.f;
    for (int j = 0; j < 513; ++j) { float p = sp[j]; if (p != 0.f) o += p * F1[(size_t)stok[j] * 1536 + 1280 + kvh * 64 + lane]; }
    O[(size_t)row * 1024 + qh * 64 + lane] = (bf16_t)f2bf(o);
  }
}

__device__ __forceinline__ void wave_argmax(float& v, int& idx) {
#pragma unroll
  for (int off = 32; off; off >>= 1) {
    float ov = __shfl_xor(v, off); int oi = __shfl_xor(idx, off);
    if (ov > v || (ov == v && oi < idx)) { v = ov; idx = oi; }
  }
}
__device__ __forceinline__ void ph_peer_select_naive(const float* __restrict__ Q, const float* __restrict__ sk, int* __restrict__ EXP,
                                     float* __restrict__ GATE, int nrows, float* sm) {
  int lane = threadIdx.x & 63, wave = __builtin_amdgcn_readfirstlane(threadIdx.x >> 6);
  float* sq = sm + wave * 640; float* tops = sq + 256; int* topi = (int*)(tops + 32);
  for (int row0 = blockIdx.x * 4; row0 < nrows; row0 += gridDim.x * 4) {
    int row = row0 + wave;
    for (int h = 0; h < 8; ++h) {
      __syncthreads();
#pragma unroll
      for (int i = 0; i < 4; ++i) sq[lane + 64 * i] = Q[(size_t)row * 2048 + h * 256 + lane + 64 * i];
      __syncthreads();
      for (int p = 0; p < 2; ++p) {
        float s0 = 0.f, s1 = 0.f;
        const float* k0 = sk + ((size_t)((h * 2 + p) * 128 + lane)) * 128;
        const float* k1 = k0 + 64 * 128;
#pragma unroll 8
        for (int d = 0; d < 128; ++d) { float qv = sq[p * 128 + d]; s0 += qv * k0[d]; s1 += qv * k1[d]; }
        for (int i = 0; i < 16; ++i) {
          float v; int idx;
          if (s0 >= s1) { v = s0; idx = lane; } else { v = s1; idx = lane + 64; }
          wave_argmax(v, idx);
          if (lane == 0) { tops[p * 16 + i] = v; topi[p * 16 + i] = idx; }
          if (idx == lane) s0 = -INFINITY;
          if (idx == lane + 64) s1 = -INFINITY;
        }
      }
      __syncthreads();
      float cs[4];
#pragma unroll
      for (int i = 0; i < 4; ++i) { int ci = lane * 4 + i; cs[i] = tops[ci >> 4] + tops[16 + (ci & 15)]; }
      float bs[16]; int be[16];
#pragma unroll
      for (int k = 0; k < 16; ++k) {
        float v = cs[0]; int idx = lane * 4;
#pragma unroll
        for (int i = 1; i < 4; ++i) if (cs[i] > v) { v = cs[i]; idx = lane * 4 + i; }
        wave_argmax(v, idx);
        bs[k] = v; be[k] = topi[idx >> 4] * 128 + topi[16 + (idx & 15)];
#pragma unroll
        for (int i = 0; i < 4; ++i) if (idx == lane * 4 + i) cs[i] = -INFINITY;
      }
      float mxs = bs[0]; float sum = 0.f;
#pragma unroll
      for (int k = 0; k < 16; ++k) { bs[k] = expf(bs[k] - mxs); sum += bs[k]; }
      float inv = 1.f / sum;
      if (lane == 0) {
#pragma unroll
        for (int k = 0; k < 16; ++k) { EXP[(size_t)row * 128 + h * 16 + k] = be[k]; GATE[(size_t)row * 128 + h * 16 + k] = bs[k] * inv; }
      }
    }
  }
}

__device__ __forceinline__ void unpack8(uint4 v, float* f) {
  f[0] = __uint_as_float(v.x << 16); f[1] = __uint_as_float(v.x & 0xffff0000u);
  f[2] = __uint_as_float(v.y << 16); f[3] = __uint_as_float(v.y & 0xffff0000u);
  f[4] = __uint_as_float(v.z << 16); f[5] = __uint_as_float(v.z & 0xffff0000u);
  f[6] = __uint_as_float(v.w << 16); f[7] = __uint_as_float(v.w & 0xffff0000u);
}
__device__ __forceinline__ void ph_peer_gather(bf16_t* __restrict__ H, const int* __restrict__ EXP, const float* __restrict__ GATE,
                               const bf16_t* __restrict__ U, const bf16_t* __restrict__ V,
                               const float* __restrict__ xin, const float* __restrict__ M, int layer,
                               const float* __restrict__ g, const float* __restrict__ bb, float* __restrict__ xout,
                               bool write_next, int nrows) {
  int lane = threadIdx.x & 63, wave = __builtin_amdgcn_readfirstlane(threadIdx.x >> 6);
  for (int row = blockIdx.x * 4 + wave; row < nrows; row += gridDim.x * 4) {
    float hreg[16];
    {
      const uint4* hp = (const uint4*)(H + (size_t)row * D + 8 * lane);
      unpack8(hp[0], hreg); unpack8(hp[64], hreg + 8);
    }
    float acc[16];
#pragma unroll
    for (int i = 0; i < 16; ++i) acc[i] = 0.f;
    int e_lo = EXP[(size_t)row * 128 + lane], e_hi = EXP[(size_t)row * 128 + 64 + lane];
    float g_lo = GATE[(size_t)row * 128 + lane], g_hi = GATE[(size_t)row * 128 + 64 + lane];
    uint4 ua[4], ub[4], va[4], vb[4];
#pragma unroll
    for (int i = 0; i < 4; ++i) {
      int e = __builtin_amdgcn_readlane(e_lo, i);
      const uint4* up = (const uint4*)(U + (size_t)e * D + 8 * lane); ua[i] = up[0]; ub[i] = up[64];
    }
#pragma unroll 1
    for (int b = 0; b < 32; ++b) {
      int k0 = 4 * b;
      int ev = (b < 16) ? e_lo : e_hi; float gv = (b < 16) ? g_lo : g_hi;
      int en = (b + 1 < 16) ? e_lo : e_hi;
      float gt[4];
#pragma unroll
      for (int i = 0; i < 4; ++i) {
        int e = __builtin_amdgcn_readlane(ev, (k0 + i) & 63);
        gt[i] = __uint_as_float(__builtin_amdgcn_readlane(__float_as_uint(gv), (k0 + i) & 63));
        const uint4* vp = (const uint4*)(V + (size_t)e * D + 8 * lane); va[i] = vp[0]; vb[i] = vp[64];
      }
      float a[4];
#pragma unroll
      for (int i = 0; i < 4; ++i) {
        float f[16]; unpack8(ua[i], f); unpack8(ub[i], f + 8);
        float sacc = 0.f;
#pragma unroll
        for (int j = 0; j < 16; ++j) sacc += f[j] * hreg[j];
        a[i] = sacc;
      }
      if (b + 1 < 32) {
#pragma unroll
        for (int i = 0; i < 4; ++i) {
          int e = __builtin_amdgcn_readlane(en, (k0 + 4 + i) & 63);
          const uint4* up = (const uint4*)(U + (size_t)e * D + 8 * lane); ua[i] = up[0]; ub[i] = up[64];
        }
      }
#pragma unroll
      for (int i = 0; i < 4; ++i) a[i] = wave_sum(a[i]);
#pragma unroll
      for (int i = 0; i < 4; ++i) {
        float w = gt[i] * 0.5f * a[i] * (1.f + erff(a[i] * 0.70710678118654752f));
        float f[16]; unpack8(va[i], f); unpack8(vb[i], f + 8);
#pragma unroll
        for (int j = 0; j < 16; ++j) acc[j] += w * f[j];
      }
    }
    const float* m = M + ((size_t)layer * 3 + mod_index(row)) * 6144;
    const float* xr = xin + (size_t)row * D;
    float v[16];
#pragma unroll
    for (int hh = 0; hh < 2; ++hh) {
      int d0 = hh * 512 + 8 * lane;
      float4 x0 = *(const float4*)(xr + d0), x1 = *(const float4*)(xr + d0 + 4);
      float4 m0 = *(const float4*)(m + 5 * D + d0), m1 = *(const float4*)(m + 5 * D + d0 + 4);
      v[hh * 8 + 0] = DN_ALPHA * x0.x + m0.x * acc[hh * 8 + 0]; v[hh * 8 + 1] = DN_ALPHA * x0.y + m0.y * acc[hh * 8 + 1];
      v[hh * 8 + 2] = DN_ALPHA * x0.z + m0.z * acc[hh * 8 + 2]; v[hh * 8 + 3] = DN_ALPHA * x0.w + m0.w * acc[hh * 8 + 3];
      v[hh * 8 + 4] = DN_ALPHA * x1.x + m1.x * acc[hh * 8 + 4]; v[hh * 8 + 5] = DN_ALPHA * x1.y + m1.y * acc[hh * 8 + 5];
      v[hh * 8 + 6] = DN_ALPHA * x1.z + m1.z * acc[hh * 8 + 6]; v[hh * 8 + 7] = DN_ALPHA * x1.w + m1.w * acc[hh * 8 + 7];
    }
    float s = 0.f;
#pragma unroll
    for (int j = 0; j < 16; ++j) s += v[j];
    float mu = wave_sum(s) * (1.f / D);
    float q = 0.f;
#pragma unroll
    for (int j = 0; j < 16; ++j) { float d = v[j] - mu; q += d * d; }
    float rs = rsqrtf(wave_sum(q) * (1.f / D) + LN_EPS);
    float y[16];
#pragma unroll
    for (int hh = 0; hh < 2; ++hh) {
      int d0 = hh * 512 + 8 * lane;
#pragma unroll
      for (int j = 0; j < 8; ++j) y[hh * 8 + j] = (v[hh * 8 + j] - mu) * rs * g[d0 + j] + bb[d0 + j];
      *(float4*)(xout + (size_t)row * D + d0) = make_float4(y[hh * 8], y[hh * 8 + 1], y[hh * 8 + 2], y[hh * 8 + 3]);
      *(float4*)(xout + (size_t)row * D + d0 + 4) = make_float4(y[hh * 8 + 4], y[hh * 8 + 5], y[hh * 8 + 6], y[hh * 8 + 7]);
    }
    if (write_next) {
      const float* mn = M + ((size_t)(layer + 1) * 3 + mod_index(row)) * 6144;
      float s2 = 0.f;
#pragma unroll
      for (int j = 0; j < 16; ++j) s2 += y[j];
      float mu2 = wave_sum(s2) * (1.f / D);
      float q2 = 0.f;
#pragma unroll
      for (int j = 0; j < 16; ++j) { float d = y[j] - mu2; q2 += d * d; }
      float rs2 = rsqrtf(wave_sum(q2) * (1.f / D) + LN_EPS);
#pragma unroll
      for (int hh = 0; hh < 2; ++hh) {
        int d0 = hh * 512 + 8 * lane;
        float o[8];
#pragma unroll
        for (int j = 0; j < 8; ++j) o[j] = (y[hh * 8 + j] - mu2) * rs2 * (1.f + mn[D + d0 + j]) + mn[d0 + j];
        *(uint4*)(H + (size_t)row * D + d0) = make_uint4(pack2bf(o[0], o[1]), pack2bf(o[2], o[3]), pack2bf(o[4], o[5]), pack2bf(o[6], o[7]));
      }
    }
  }
}


__device__ __forceinline__ void quant_row(const float* __restrict__ src, unsigned char* __restrict__ dst, float* __restrict__ scale, int row, int lane) {
  const float4* sp = (const float4*)(src + (size_t)row * D + 16 * lane);
  float4 v0 = sp[0], v1 = sp[1], v2 = sp[2], v3 = sp[3];
  float x[16] = {v0.x, v0.y, v0.z, v0.w, v1.x, v1.y, v1.z, v1.w, v2.x, v2.y, v2.z, v2.w, v3.x, v3.y, v3.z, v3.w};
  float am = 0.f;
#pragma unroll
  for (int j = 0; j < 16; ++j) am = fmaxf(am, fabsf(x[j]));
  am = wave_max(am);
  float inv = am > 0.f ? 127.f / am : 0.f;
  unsigned wv[4];
#pragma unroll
  for (int k = 0; k < 4; ++k) {
    unsigned w = 0;
#pragma unroll
    for (int j = 0; j < 4; ++j) {
      int q = (int)rintf(x[4 * k + j] * inv);
      w |= ((unsigned)q & 0xffu) << (8 * j);
    }
    wv[k] = w;
  }
  *(uint4*)(dst + ((size_t)(row >> 14) * 8 + (lane >> 3)) * ((size_t)16384 * 128) + (size_t)(row & 16383) * 128 + 16 * (lane & 7)) = make_uint4(wv[0], wv[1], wv[2], wv[3]);
  if (lane == 0) scale[row] = am * (1.f / 127.f);
}
__device__ __forceinline__ void quant_fill(unsigned* ctr, int layer, unsigned lo, unsigned hi, const float* __restrict__ pu, const float* __restrict__ pv,
                                           unsigned char* __restrict__ U8, unsigned char* __restrict__ V8, float* __restrict__ USC,
                                           float* __restrict__ VSC, unsigned* sh) {
  int lane = threadIdx.x & 63, wave = __builtin_amdgcn_readfirstlane(threadIdx.x >> 6);
  for (;;) {
    __syncthreads();
    if (threadIdx.x == 0) *sh = lo + __hip_atomic_fetch_add(ctr, 1u, __ATOMIC_RELAXED, __HIP_MEMORY_SCOPE_AGENT);
    __syncthreads();
    unsigned c = *sh;
    if (c >= hi) break;
    const float* src = (c >> 8) ? pv : pu; unsigned char* dst = (c >> 8) ? V8 : U8; float* sc = (c >> 8) ? VSC : USC;
    int r0 = layer * 16384 + (int)(c & 255u) * 64 + wave * 16;
#pragma unroll 4
    for (int i = 0; i < 16; ++i) quant_row(src, dst, sc, r0 + i, lane);
  }
  __syncthreads();
}
__device__ __forceinline__ void unpack_u8x16(uint4 v, float* f) {
  unsigned w[4] = {v.x, v.y, v.z, v.w};
#pragma unroll
  for (int k = 0; k < 4; ++k) {
    f[4 * k + 0] = (float)(w[k] & 0xffu); f[4 * k + 1] = (float)((w[k] >> 8) & 0xffu);
    f[4 * k + 2] = (float)((w[k] >> 16) & 0xffu); f[4 * k + 3] = (float)(w[k] >> 24);
  }
}
__device__ __forceinline__ void ph_peer_gather8(bf16_t* __restrict__ H, const int* __restrict__ EXP, const float* __restrict__ GATE,
                               const unsigned char* __restrict__ U8, const float* __restrict__ USC,
                               const unsigned char* __restrict__ V8, const float* __restrict__ VSC,
                               const float* __restrict__ xin, const float* __restrict__ M, int layer,
                               const float* __restrict__ g, const float* __restrict__ bb, float* __restrict__ xout,
                               bool write_next, int nrows) {
  int lane = threadIdx.x & 63, wave = __builtin_amdgcn_readfirstlane(threadIdx.x >> 6);
  for (int row = blockIdx.x * 4 + wave; row < nrows; row += gridDim.x * 4) {
    float hreg[16];
    {
      const uint4* hp = (const uint4*)(H + (size_t)row * D + 16 * lane);
      unpack8(hp[0], hreg); unpack8(hp[1], hreg + 8);
    }
    float hs = 0.f;
#pragma unroll
    for (int j = 0; j < 16; ++j) hs += hreg[j];
    float hsum128 = 128.f * wave_sum(hs);
    float acc[16];
#pragma unroll
    for (int i = 0; i < 16; ++i) acc[i] = 0.f;
    float wsum = 0.f;
    int e_lo = EXP[(size_t)row * 128 + lane], e_hi = EXP[(size_t)row * 128 + 64 + lane];
    float g_lo = GATE[(size_t)row * 128 + lane], g_hi = GATE[(size_t)row * 128 + 64 + lane];
    float us_lo = USC[e_lo], us_hi = USC[e_hi], vs_lo = VSC[e_lo], vs_hi = VSC[e_hi];
    uint4 ua[8], va[8];
#pragma unroll
    for (int i = 0; i < 8; ++i) {
      int e = __builtin_amdgcn_readlane(e_lo, i);
      ua[i] = *(const uint4*)(U8 + (size_t)e * D + 16 * lane);
    }
#pragma unroll 1
    for (int b = 0; b < 16; ++b) {
      int k0 = 8 * b;
      bool lo = b < 8, lon = (b + 1) < 8;
      int ev = lo ? e_lo : e_hi; float gv = lo ? g_lo : g_hi; float usv = lo ? us_lo : us_hi; float vsv = lo ? vs_lo : vs_hi;
      int en = lon ? e_lo : e_hi;
      float gt[8], usc[8], vsc[8];
#pragma unroll
      for (int i = 0; i < 8; ++i) {
        int li = (k0 + i) & 63;
        int e = __builtin_amdgcn_readlane(ev, li);
        gt[i] = __uint_as_float(__builtin_amdgcn_readlane(__float_as_uint(gv), li));
        usc[i] = __uint_as_float(__builtin_amdgcn_readlane(__float_as_uint(usv), li));
        vsc[i] = __uint_as_float(__builtin_amdgcn_readlane(__float_as_uint(vsv), li));
        va[i] = *(const uint4*)(V8 + (size_t)e * D + 16 * lane);
      }
      float a[8];
#pragma unroll
      for (int i = 0; i < 8; ++i) {
        float f[16]; unpack_u8x16(ua[i], f);
        float sacc = 0.f;
#pragma unroll
        for (int j = 0; j < 16; ++j) sacc += f[j] * hreg[j];
        a[i] = sacc;
      }
      if (b + 1 < 16) {
#pragma unroll
        for (int i = 0; i < 8; ++i) {
          int e = __builtin_amdgcn_readlane(en, (k0 + 8 + i) & 63);
          ua[i] = *(const uint4*)(U8 + (size_t)e * D + 16 * lane);
        }
      }
#pragma unroll
      for (int i = 0; i < 8; ++i) a[i] = (wave_sum(a[i]) - hsum128) * usc[i];
#pragma unroll
      for (int i = 0; i < 8; ++i) {
        float w = gt[i] * 0.5f * a[i] * (1.f + erff(a[i] * 0.70710678118654752f)) * vsc[i];
        wsum += w;
        float f[16]; unpack_u8x16(va[i], f);
#pragma unroll
        for (int j = 0; j < 16; ++j) acc[j] += w * f[j];
      }
    }
    float corr = 128.f * wsum;
#pragma unroll
    for (int j = 0; j < 16; ++j) acc[j] -= corr;
    const float* m = M + ((size_t)layer * 3 + mod_index(row)) * 6144;
    const float* xr = xin + (size_t)row * D + 16 * lane;
    const float* m5 = m + 5 * D + 16 * lane;
    float v[16];
#pragma unroll
    for (int q4 = 0; q4 < 4; ++q4) {
      float4 x0 = *(const float4*)(xr + 4 * q4); float4 m0 = *(const float4*)(m5 + 4 * q4);
      v[4 * q4 + 0] = DN_ALPHA * x0.x + m0.x * acc[4 * q4 + 0]; v[4 * q4 + 1] = DN_ALPHA * x0.y + m0.y * acc[4 * q4 + 1];
      v[4 * q4 + 2] = DN_ALPHA * x0.z + m0.z * acc[4 * q4 + 2]; v[4 * q4 + 3] = DN_ALPHA * x0.w + m0.w * acc[4 * q4 + 3];
    }
    float s = 0.f;
#pragma unroll
    for (int j = 0; j < 16; ++j) s += v[j];
    float mu = wave_sum(s) * (1.f / D);
    float q = 0.f;
#pragma unroll
    for (int j = 0; j < 16; ++j) { float d = v[j] - mu; q += d * d; }
    float rs = rsqrtf(wave_sum(q) * (1.f / D) + LN_EPS);
    float y[16];
    {
      const float* gp = g + 16 * lane; const float* bp = bb + 16 * lane;
      float* op = xout + (size_t)row * D + 16 * lane;
#pragma unroll
      for (int q4 = 0; q4 < 4; ++q4) {
        float4 g4 = *(const float4*)(gp + 4 * q4); float4 b4 = *(const float4*)(bp + 4 * q4);
        y[4 * q4 + 0] = (v[4 * q4 + 0] - mu) * rs * g4.x + b4.x; y[4 * q4 + 1] = (v[4 * q4 + 1] - mu) * rs * g4.y + b4.y;
        y[4 * q4 + 2] = (v[4 * q4 + 2] - mu) * rs * g4.z + b4.z; y[4 * q4 + 3] = (v[4 * q4 + 3] - mu) * rs * g4.w + b4.w;
        *(float4*)(op + 4 * q4) = make_float4(y[4 * q4], y[4 * q4 + 1], y[4 * q4 + 2], y[4 * q4 + 3]);
      }
    }
    if (write_next) {
      const float* mn = M + ((size_t)(layer + 1) * 3 + mod_index(row)) * 6144 + 16 * lane;
      float s2 = 0.f;
#pragma unroll
      for (int j = 0; j < 16; ++j) s2 += y[j];
      float mu2 = wave_sum(s2) * (1.f / D);
      float q2 = 0.f;
#pragma unroll
      for (int j = 0; j < 16; ++j) { float d = y[j] - mu2; q2 += d * d; }
      float rs2 = rsqrtf(wave_sum(q2) * (1.f / D) + LN_EPS);
      float o[16];
#pragma unroll
      for (int j = 0; j < 16; ++j) o[j] = (y[j] - mu2) * rs2 * (1.f + mn[D + j]) + mn[j];
      uint4* hp = (uint4*)(H + (size_t)row * D + 16 * lane);
      hp[0] = make_uint4(pack2bf(o[0], o[1]), pack2bf(o[2], o[3]), pack2bf(o[4], o[5]), pack2bf(o[6], o[7]));
      hp[1] = make_uint4(pack2bf(o[8], o[9]), pack2bf(o[10], o[11]), pack2bf(o[12], o[13]), pack2bf(o[14], o[15]));
    }
  }
}


__device__ __forceinline__ void ph_ada2(const float* __restrict__ c, const float* __restrict__ c_ctx, const float* __restrict__ ada_w,
                                        const float* __restrict__ ada_b, float* __restrict__ M, float* sm) {
  int tid = threadIdx.x, lane = tid & 63, wave = __builtin_amdgcn_readfirstlane(tid >> 6);
  float* sv = sm;
  float* red = sm + 3072;
  bool filled = false;
  GRID_LOOP(u, 192) {
    if (!filled) {
      for (int i = tid; i < 3072; i += 256) {
        int idx = i >> 10, k = i & 1023;
        float x = idx < 2 ? c[idx * D + k] : c_ctx[k];
        sv[i] = x / (1.f + expf(-x));
      }
      filled = true;
    }
    __syncthreads();
    int layer = u / 96, c0 = (u % 96) * 64;
    const float* w = ada_w + (size_t)layer * D * 6144 + c0 + lane;
    float a0 = 0.f, a1 = 0.f, a2 = 0.f;
    int kb = wave * 256;
#pragma unroll 16
    for (int k = 0; k < 256; ++k) {
      float wv = w[(size_t)(kb + k) * 6144];
      a0 += sv[kb + k] * wv; a1 += sv[1024 + kb + k] * wv; a2 += sv[2048 + kb + k] * wv;
    }
    red[(wave * 3 + 0) * 64 + lane] = a0; red[(wave * 3 + 1) * 64 + lane] = a1; red[(wave * 3 + 2) * 64 + lane] = a2;
    __syncthreads();
    if (wave < 3) {
      float r = red[(0 * 3 + wave) * 64 + lane] + red[(1 * 3 + wave) * 64 + lane] + red[(2 * 3 + wave) * 64 + lane] + red[(3 * 3 + wave) * 64 + lane];
      M[((size_t)layer * 3 + wave) * 6144 + c0 + lane] = r + ada_b[layer * 6144 + c0 + lane];
    }
  }
  __syncthreads();
}

__device__ __forceinline__ void ph_post_mod(const float* __restrict__ xa, const float* __restrict__ xb, const bf16_t* __restrict__ Y,
                                            const float* __restrict__ M, int layer, int jres, int mlayer, int jshift, int jscale, bool do_mod,
                                            const float* __restrict__ g, const float* __restrict__ bb,
                                            float* __restrict__ xout, bf16_t* __restrict__ H, int nrows) {
  int lane = threadIdx.x & 63, wave = __builtin_amdgcn_readfirstlane(threadIdx.x >> 6);
  for (int row = blockIdx.x * 4 + wave; row < nrows; row += gridDim.x * 4) {
    const float* xr = (row < T ? xa + (size_t)row * D : xb + (size_t)(row - T) * D) + 16 * lane;
    const float* m = M + ((size_t)layer * 3 + mod_index(row)) * 6144 + 16 * lane;
    float yv[16];
    {
      const uint4* yp = (const uint4*)(Y + (size_t)row * D + 16 * lane);
      unpack8(yp[0], yv); unpack8(yp[1], yv + 8);
    }
    float v[16];
#pragma unroll
    for (int q4 = 0; q4 < 4; ++q4) {
      float4 x0 = *(const float4*)(xr + 4 * q4); float4 m0 = *(const float4*)(m + jres * D + 4 * q4);
      v[4 * q4 + 0] = DN_ALPHA * x0.x + m0.x * yv[4 * q4 + 0]; v[4 * q4 + 1] = DN_ALPHA * x0.y + m0.y * yv[4 * q4 + 1];
      v[4 * q4 + 2] = DN_ALPHA * x0.z + m0.z * yv[4 * q4 + 2]; v[4 * q4 + 3] = DN_ALPHA * x0.w + m0.w * yv[4 * q4 + 3];
    }
    float s = 0.f;
#pragma unroll
    for (int j = 0; j < 16; ++j) s += v[j];
    float mu = wave_sum(s) * (1.f / D);
    float q = 0.f;
#pragma unroll
    for (int j = 0; j < 16; ++j) { float d = v[j] - mu; q += d * d; }
    float rs = rsqrtf(wave_sum(q) * (1.f / D) + LN_EPS);
    float y[16];
    {
      const float* gp = g + 16 * lane; const float* bp = bb + 16 * lane;
      float* op = xout + (size_t)row * D + 16 * lane;
#pragma unroll
      for (int q4 = 0; q4 < 4; ++q4) {
        float4 g4 = *(const float4*)(gp + 4 * q4); float4 b4 = *(const float4*)(bp + 4 * q4);
        y[4 * q4 + 0] = (v[4 * q4 + 0] - mu) * rs * g4.x + b4.x; y[4 * q4 + 1] = (v[4 * q4 + 1] - mu) * rs * g4.y + b4.y;
        y[4 * q4 + 2] = (v[4 * q4 + 2] - mu) * rs * g4.z + b4.z; y[4 * q4 + 3] = (v[4 * q4 + 3] - mu) * rs * g4.w + b4.w;
        *(float4*)(op + 4 * q4) = make_float4(y[4 * q4], y[4 * q4 + 1], y[4 * q4 + 2], y[4 * q4 + 3]);
      }
    }
    if (do_mod) {
      const float* mm = M + ((size_t)mlayer * 3 + mod_index(row)) * 6144 + 16 * lane;
      float s2 = 0.f;
#pragma unroll
      for (int j = 0; j < 16; ++j) s2 += y[j];
      float mu2 = wave_sum(s2) * (1.f / D);
      float q2 = 0.f;
#pragma unroll
      for (int j = 0; j < 16; ++j) { float d = y[j] - mu2; q2 += d * d; }
      float rs2 = rsqrtf(wave_sum(q2) * (1.f / D) + LN_EPS);
      float o[16];
#pragma unroll
      for (int j = 0; j < 16; ++j) o[j] = (y[j] - mu2) * rs2 * (1.f + mm[jscale * D + j]) + mm[jshift * D + j];
      uint4* hp = (uint4*)(H + (size_t)row * D + 16 * lane);
      hp[0] = make_uint4(pack2bf(o[0], o[1]), pack2bf(o[2], o[3]), pack2bf(o[4], o[5]), pack2bf(o[6], o[7]));
      hp[1] = make_uint4(pack2bf(o[8], o[9]), pack2bf(o[10], o[11]), pack2bf(o[12], o[13]), pack2bf(o[14], o[15]));
    }
  }
}


template <int CTRL> __device__ __forceinline__ float dpp_add(float x) { return x + dpp_mov<CTRL>(x); }
__device__ __forceinline__ float sum8(float v) {
  v = dpp_add<0xB1>(v); v = dpp_add<0x4E>(v); v = dpp_add<0x141>(v); return v;
}
typedef _Float16 half2_t __attribute__((ext_vector_type(2)));
__device__ __forceinline__ float dot2h(unsigned a, unsigned b, float c) {
  return __builtin_amdgcn_fdot2(__builtin_bit_cast(half2_t, a), __builtin_bit_cast(half2_t, b), c, false);
}
__device__ __forceinline__ unsigned pkh(float a, float b) { return __builtin_bit_cast(unsigned, __builtin_amdgcn_cvt_pkrtz(a, b)); }
__device__ __forceinline__ void load_e16(const int* __restrict__ EXP, int t, int g8, int (&e)[16]) {
  const int4* ep = (const int4*)(EXP + (size_t)t * 128 + 16 * g8);
  int4 a = ep[0], b = ep[1], c = ep[2], d = ep[3];
  e[0] = a.x; e[1] = a.y; e[2] = a.z; e[3] = a.w; e[4] = b.x; e[5] = b.y; e[6] = b.z; e[7] = b.w;
  e[8] = c.x; e[9] = c.y; e[10] = c.z; e[11] = c.w; e[12] = d.x; e[13] = d.y; e[14] = d.z; e[15] = d.w;
}
#define U_TOKEN(tt, UV, UVN, EUSE, ELD, HUSE, HLD) { \
    int tnn_ = min((tt) + 2 * st, nrows - 1); \
    load_e16(EXP, tnn_, g8, ELD); \
    HLD[0] = *(const uint4*)(hb + (size_t)tnn_ * D); HLD[1] = *(const uint4*)(hb + (size_t)tnn_ * D + 8); \
    __builtin_amdgcn_sched_barrier(0); \
    _Pragma("unroll") for (int i = 0; i < 16; ++i) UVN[i] = *(const uint4*)(ubs + (((unsigned)EUSE[i] << 7) + loff)); \
    __builtin_amdgcn_sched_barrier(0); \
    float h16[16]; unpack8(HUSE[0], h16); unpack8(HUSE[1], h16 + 8); \
    float hm = 0.f; \
    _Pragma("unroll") for (int j = 0; j < 16; ++j) hm = fmaxf(hm, fabsf(h16[j])); \
    hm = fmaxf(hm, dpp_mov<0xB1>(hm)); hm = fmaxf(hm, dpp_mov<0x4E>(hm)); hm = fmaxf(hm, dpp_mov<0x141>(hm)); \
    float hinv = hm > 0.f ? 127.f / hm : 0.f; float hsc = hm * (1.f / 127.f); \
    int hq[4]; \
    _Pragma("unroll") for (int k = 0; k < 4; ++k) { unsigned w_ = 0; \
      _Pragma("unroll") for (int j = 0; j < 4; ++j) w_ = __builtin_amdgcn_cvt_pk_u8_f32(rintf(h16[4 * k + j] * hinv) + 128.f, j, w_); \
      hq[k] = (int)(w_ ^ 0x80808080u); }        \
    float k0 = 0.f, k1 = 0.f; \
    _Pragma("unroll") for (int i = 0; i < 16; ++i) { \
      int p_ = __builtin_amdgcn_sdot4((int)UV[i].x, hq[0], 0, false); p_ = __builtin_amdgcn_sdot4((int)UV[i].y, hq[1], p_, false); \
      p_ = __builtin_amdgcn_sdot4((int)UV[i].z, hq[2], p_, false); p_ = __builtin_amdgcn_sdot4((int)UV[i].w, hq[3], p_, false); \
      float p = sum8((float)p_) * hsc; \
      if ((i >> 1) == j8) { if (i & 1) k1 = p; else k0 = p; } } \
    *(float2*)(PA + ((size_t)(tt) * 8 + x) * 128 + 16 * g8 + 2 * j8) = make_float2(k0, k1); }
__device__ __forceinline__ void ph_peer_u(const bf16_t* __restrict__ H, const int* __restrict__ EXP, const unsigned char* __restrict__ U8,
                                          float* __restrict__ PA, int nrows) {
  int lane = threadIdx.x & 63, wave = __builtin_amdgcn_readfirstlane(threadIdx.x >> 6);
  int x = blockIdx.x & 7; int nb8 = gridDim.x >> 3;
  if ((int)(blockIdx.x >> 3) >= nb8) return;
  int j8 = lane & 7, g8 = lane >> 3;
  const int st = nb8 * 4;
  int t = (blockIdx.x >> 3) * 4 + wave;
  if (t >= nrows) return;
  const unsigned char* ubs = U8 + (size_t)x * ((size_t)16384 * 128);
  const unsigned loff = 16u * (unsigned)j8;
  const bf16_t* hb = H + 128 * x + 16 * j8;
  int eA[16], eB[16]; uint4 hA[2], hB[2], uvA[16], uvB[16];
  {
    int e0[16]; load_e16(EXP, t, g8, e0);
#pragma unroll
    for (int i = 0; i < 16; ++i) uvA[i] = *(const uint4*)(ubs + (((unsigned)e0[i] << 7) + loff));
    hA[0] = *(const uint4*)(hb + (size_t)t * D); hA[1] = *(const uint4*)(hb + (size_t)t * D + 8);
    int tn = min(t + st, nrows - 1);
    load_e16(EXP, tn, g8, eA);
    hB[0] = *(const uint4*)(hb + (size_t)tn * D); hB[1] = *(const uint4*)(hb + (size_t)tn * D + 8);
  }
#pragma unroll 1
  for (; t < nrows; t += 2 * st) {
    uint4 hC[2];
    U_TOKEN(t, uvA, uvB, eA, eB, hA, hC)
    if (t + st < nrows) {
      U_TOKEN(t + st, uvB, uvA, eB, eA, hB, hA)
    }
    hB[0] = hA[0]; hB[1] = hA[1]; hA[0] = hC[0]; hA[1] = hC[1];
  }
}
__device__ __forceinline__ void ph_peer_w(const float* __restrict__ PA, const int* __restrict__ EXP, const float* __restrict__ GATE,
                                          const float* __restrict__ USC, const float* __restrict__ VSC, unsigned* __restrict__ WQ,
                                          float* __restrict__ SW, int nrows) {
  int lane = threadIdx.x & 63, wave = __builtin_amdgcn_readfirstlane(threadIdx.x >> 6);
  int l4 = lane & 31;
  for (int t = blockIdx.x * 4 + wave; t < nrows; t += gridDim.x * 4) {
    int4 e = *(const int4*)(EXP + (size_t)t * 128 + 4 * l4);
    float4 gt = *(const float4*)(GATE + (size_t)t * 128 + 4 * l4);
    float a[4] = {0.f, 0.f, 0.f, 0.f};
#pragma unroll
    for (int xs = 0; xs < 8; ++xs) { float4 p = *(const float4*)(PA + ((size_t)t * 8 + xs) * 128 + 4 * l4); a[0] += p.x; a[1] += p.y; a[2] += p.z; a[3] += p.w; }
    int ee[4] = {e.x, e.y, e.z, e.w}; float gg[4] = {gt.x, gt.y, gt.z, gt.w}; float w[4]; float wm = 0.f;
#pragma unroll
    for (int j = 0; j < 4; ++j) {
      float av = a[j] * USC[ee[j]];
      w[j] = gg[j] * 0.5f * av * (1.f + erff(av * 0.70710678118654752f)) * VSC[ee[j]];
      wm = fmaxf(wm, fabsf(w[j]));
    }
    wm = wave_max(wm);
    float winv = wm > 0.f ? 127.f / wm : 0.f;
    unsigned q = 0;
#pragma unroll
    for (int j = 0; j < 4; ++j) q = __builtin_amdgcn_cvt_pk_u8_f32(rintf(w[j] * winv) + 128.f, j, q);
    if (lane < 32) WQ[(size_t)t * 32 + l4] = q ^ 0x80808080u;
    if (lane == 0) SW[t] = wm * (1.f / 127.f);
  }
}
__device__ __forceinline__ void load_w16(const float* __restrict__ W, int t, int g8, float (&w)[16]) {
  const float4* wp = (const float4*)(W + (size_t)t * 128 + 16 * g8);
  float4 wa = wp[0], wb = wp[1], wc = wp[2], wd = wp[3];
  w[0] = wa.x; w[1] = wa.y; w[2] = wa.z; w[3] = wa.w; w[4] = wb.x; w[5] = wb.y; w[6] = wb.z; w[7] = wb.w;
  w[8] = wc.x; w[9] = wc.y; w[10] = wc.z; w[11] = wc.w; w[12] = wd.x; w[13] = wd.y; w[14] = wd.z; w[15] = wd.w;
}
#define V_TOKEN(tt, VV, VVN, EUSE, ELD, WUSE, WLD, SUSE, SLD) { \
    int tnn_ = min((tt) + 2 * st, nrows - 1); \
    load_e16(EXP, tnn_, g8, ELD); \
    WLD = *(const uint4*)(WQ + (size_t)tnn_ * 32 + 4 * g8); SLD = SW[tnn_]; \
    __builtin_amdgcn_sched_barrier(0); \
    _Pragma("unroll") for (int i = 0; i < 16; ++i) VVN[i] = *(const uint4*)(vbs + (((unsigned)EUSE[i] << 7) + loff)); \
    __builtin_amdgcn_sched_barrier(0); \
    int acc[16]; \
    _Pragma("unroll") for (int j = 0; j < 16; ++j) acc[j] = 0; \
    int wq[4] = {(int)WUSE.x, (int)WUSE.y, (int)WUSE.z, (int)WUSE.w}; \
    _Pragma("unroll") for (int m = 0; m < 4; ++m) { \
      unsigned r0[4] = {VV[4 * m].x, VV[4 * m].y, VV[4 * m].z, VV[4 * m].w}; \
      unsigned r1[4] = {VV[4 * m + 1].x, VV[4 * m + 1].y, VV[4 * m + 1].z, VV[4 * m + 1].w}; \
      unsigned r2[4] = {VV[4 * m + 2].x, VV[4 * m + 2].y, VV[4 * m + 2].z, VV[4 * m + 2].w}; \
      unsigned r3[4] = {VV[4 * m + 3].x, VV[4 * m + 3].y, VV[4 * m + 3].z, VV[4 * m + 3].w}; \
      _Pragma("unroll") for (int k = 0; k < 4; ++k) { \
          \
        unsigned a0 = __builtin_amdgcn_perm(r1[k], r0[k], 0x05010400u);     \
        unsigned a1 = __builtin_amdgcn_perm(r1[k], r0[k], 0x07030602u);     \
        unsigned a2 = __builtin_amdgcn_perm(r3[k], r2[k], 0x05010400u); \
        unsigned a3 = __builtin_amdgcn_perm(r3[k], r2[k], 0x07030602u); \
        unsigned t0 = __builtin_amdgcn_perm(a2, a0, 0x05040100u);           \
        unsigned t1 = __builtin_amdgcn_perm(a2, a0, 0x07060302u); \
        unsigned t2 = __builtin_amdgcn_perm(a3, a1, 0x05040100u); \
        unsigned t3 = __builtin_amdgcn_perm(a3, a1, 0x07060302u); \
        acc[4 * k + 0] = __builtin_amdgcn_sdot4((int)t0, wq[m], acc[4 * k + 0], false); \
        acc[4 * k + 1] = __builtin_amdgcn_sdot4((int)t1, wq[m], acc[4 * k + 1], false); \
        acc[4 * k + 2] = __builtin_amdgcn_sdot4((int)t2, wq[m], acc[4 * k + 2], false); \
        acc[4 * k + 3] = __builtin_amdgcn_sdot4((int)t3, wq[m], acc[4 * k + 3], false); } } \
    float of[16]; \
    _Pragma("unroll") for (int j = 0; j < 16; ++j) { float v = (float)acc[j]; v += dpp_mov<0x128>(v); of[j] = xrow16_sum(v) * SUSE; } \
    if (g8 == 0) { \
      uint4* fp = (uint4*)(F + (size_t)(tt) * D + 128 * x + 16 * j8); \
      fp[0] = make_uint4(pack2bf(of[0], of[1]), pack2bf(of[2], of[3]), pack2bf(of[4], of[5]), pack2bf(of[6], of[7])); \
      fp[1] = make_uint4(pack2bf(of[8], of[9]), pack2bf(of[10], of[11]), pack2bf(of[12], of[13]), pack2bf(of[14], of[15])); } }
__device__ __forceinline__ void ph_peer_v(const unsigned* __restrict__ WQ, const float* __restrict__ SW, const int* __restrict__ EXP,
                                          const unsigned char* __restrict__ V8, bf16_t* __restrict__ F, int nrows) {
  int lane = threadIdx.x & 63, wave = __builtin_amdgcn_readfirstlane(threadIdx.x >> 6);
  int x = blockIdx.x & 7; int nb8 = gridDim.x >> 3;
  if ((int)(blockIdx.x >> 3) >= nb8) return;
  int j8 = lane & 7, g8 = lane >> 3;
  const int st = nb8 * 4;
  int t = (blockIdx.x >> 3) * 4 + wave;
  if (t >= nrows) return;
  const unsigned char* vbs = V8 + (size_t)x * ((size_t)16384 * 128);
  const unsigned loff = 16u * (unsigned)j8;
  int eA[16], eB[16]; uint4 wA, wB, vvA[16], vvB[16]; float sA, sB;
  {
    int e0[16]; load_e16(EXP, t, g8, e0);
#pragma unroll
    for (int i = 0; i < 16; ++i) vvA[i] = *(const uint4*)(vbs + (((unsigned)e0[i] << 7) + loff));
    wA = *(const uint4*)(WQ + (size_t)t * 32 + 4 * g8); sA = SW[t];
    int tn = min(t + st, nrows - 1);
    load_e16(EXP, tn, g8, eA);
    wB = *(const uint4*)(WQ + (size_t)tn * 32 + 4 * g8); sB = SW[tn];
  }
#pragma unroll 1
  for (; t < nrows; t += 2 * st) {
    uint4 wC; float sC;
    V_TOKEN(t, vvA, vvB, eA, eB, wA, wC, sA, sC)
    if (t + st < nrows) {
      V_TOKEN(t + st, vvB, vvA, eB, eA, wB, wA, sB, sA)
    }
    wB = wA; sB = sA; wA = wC; sA = sC;
  }
}

#define XB_TMO      128
#define XB_XCNT(j)  (256  + 64 * (j))
#define XB_XSUB(j)  (1280 + 64 * (j))
#define XB_XGEN(j)  (2304 + 64 * (j))
#define XB_TOP      3328
#define XB_TOPGEN   3392
#define XCD_BAR_WORDS 3456
#define XB_SPIN_CAP (1u << 22)
#define LAS __attribute__((address_space(3)))
__device__ __forceinline__ unsigned xb_ld(unsigned* p)              { return __hip_atomic_load(p, __ATOMIC_RELAXED, __HIP_MEMORY_SCOPE_AGENT); }
__device__ __forceinline__ unsigned xb_add(unsigned* p, unsigned v) { return __hip_atomic_fetch_add(p, v, __ATOMIC_RELAXED, __HIP_MEMORY_SCOPE_AGENT); }
__device__ __forceinline__ unsigned xb_xcc_id() { return (unsigned)__builtin_amdgcn_s_getreg((3 << 11) | 20) & 0xFu; }
#define XB_SPIN(cond, bar) do { unsigned _sp = 0; while (cond) { __builtin_amdgcn_s_sleep(1); \
    if ((++_sp & 255u) == 0u) { if (xb_ld(&(bar)[XB_TMO])) break; if (_sp > XB_SPIN_CAP) { atomicAdd(&(bar)[XB_TMO], 1u); break; } } } } while (0)
struct XcdBarrier { unsigned* bar; unsigned x; volatile LAS unsigned* st; };
__device__ __forceinline__ XcdBarrier xcd_barrier_post(unsigned* bar, volatile LAS unsigned* st) {
  XcdBarrier b; b.bar = bar; b.x = xb_xcc_id(); b.st = st;
  if (threadIdx.x == 0) (void)xb_add(&bar[XB_XCNT(b.x)], 1u);
  return b;
}
__device__ __forceinline__ void xcd_barrier_complete(unsigned* bar, unsigned x, unsigned& nloc, unsigned& nx) {
  const unsigned G = gridDim.x * gridDim.y * gridDim.z;
  unsigned sum, cnt, mine, sp = 0u;
  for (;;) {
    sum = 0u; cnt = 0u; mine = 0u;
#pragma unroll
    for (unsigned j = 0; j < 16; ++j) { const unsigned c = xb_ld(&bar[XB_XCNT(j)]); sum += c; cnt += (c > 0u) ? 1u : 0u; mine = (j == x) ? c : mine; }
    if (sum == G) break;
    __builtin_amdgcn_s_sleep(1);
    if ((++sp & 255u) == 0u) { if (xb_ld(&bar[XB_TMO])) break; if (sp > XB_SPIN_CAP) { atomicAdd(&bar[XB_TMO], 1u); break; } }
  }
  nloc = mine > 0u ? mine : 1u; nx = cnt > 0u ? cnt : 1u;
}
__device__ __forceinline__ void xcd_barrier(const XcdBarrier& b) {
  asm volatile("s_waitcnt vmcnt(0)" ::: "memory");
  __syncthreads();
  if (threadIdx.x == 0) {
    unsigned* bar = b.bar;
    __builtin_amdgcn_s_waitcnt(0);
    unsigned nloc = b.st[0], nx = b.st[1];
    if (nloc == 0u) { xcd_barrier_complete(bar, b.x, nloc, nx); b.st[0] = nloc; b.st[1] = nx; }
    const unsigned old = xb_add(&bar[XB_XSUB(b.x)], 1u);
    const unsigned gen = old / nloc;
    if (old + 1u == (gen + 1u) * nloc) {
      __builtin_amdgcn_fence(__ATOMIC_RELEASE, "agent");
      asm volatile("s_waitcnt vmcnt(0)" ::: "memory");
      const unsigned og = xb_add(&bar[XB_TOP], 1u);
      const unsigned tg = og / nx;
      if (og + 1u == (tg + 1u) * nx) xb_add(&bar[XB_TOPGEN], 1u);
      else XB_SPIN(xb_ld(&bar[XB_TOPGEN]) == tg, bar);
      __builtin_amdgcn_fence(__ATOMIC_ACQUIRE, "agent");
      xb_add(&bar[XB_XGEN(b.x)], 1u);
      asm volatile("s_waitcnt vmcnt(0)" ::: "memory");
    } else {
      XB_SPIN(xb_ld(&bar[XB_XGEN(b.x)]) == gen, bar);
      __builtin_amdgcn_fence(__ATOMIC_ACQUIRE, "agent");
      asm volatile("s_waitcnt vmcnt(0)" ::: "memory");
    }
  }
  __syncthreads();
}

constexpr int SMEM_BYTES = 65536;
#ifndef PHMASK
#define PHMASK 0xFFFFFFFFFFFFFFFFull
#endif
#ifndef PHDUP
#define PHDUP 0ull
#endif
#define PH(n, ...) if constexpr ((((unsigned long long)(PHMASK)) >> (n)) & 1ull) { __VA_ARGS__; if constexpr ((((unsigned long long)(PHDUP)) >> (n)) & 1ull) { xcd_barrier(xbar); __VA_ARGS__; } }

__global__ __launch_bounds__(256, 2) void mega(Params p) {
  __shared__ __attribute__((aligned(16))) char smem_raw[SMEM_BYTES];
  __shared__ uint4 xb_words;
  if (threadIdx.x == 0) xb_words = make_uint4(0u, 0u, 0u, 0u);
  __syncthreads();
  XcdBarrier xbar = xcd_barrier_post((unsigned*)((char*)p.ws + OFF_BAR), (volatile LAS unsigned*)&xb_words);
  float* smem = (float*)smem_raw;
  const float* x = p.in[0]; const float* c = p.in[1]; const float* ctx = p.in[2]; const float* c_ctx = p.in[3];
  const float* ada_w = p.in[4]; const float* ada_b = p.in[5]; const float* ln_g = p.in[6]; const float* ln_b = p.in[7];
  const float* even_w_in = p.in[8]; const float* even_w_out = p.in[9]; const float* rpb = p.in[10];
  const float* odd_w_in = p.in[11]; const float* odd_w_out = p.in[12]; const float* sink = p.in[13];
  const float* peer_wq = p.in[14]; const float* peer_sk = p.in[15]; const float* peer_u = p.in[16]; const float* peer_v = p.in[17];
  char* ws = (char*)p.ws;
  float* TAB = (float*)(ws + OFF_TAB); float* Mm = (float*)(ws + OFF_M);
  bf16_t* WIN0 = (bf16_t*)(ws + OFF_WIN0); bf16_t* WOUT0 = (bf16_t*)(ws + OFF_WOUT0);
  bf16_t* WIN1 = (bf16_t*)(ws + OFF_WIN1); bf16_t* WOUT1 = (bf16_t*)(ws + OFF_WOUT1);
  bf16_t* WQ = (bf16_t*)(ws + OFF_WQ); bf16_t* SKB = (bf16_t*)(ws + OFF_SK);
  unsigned char* U8 = (unsigned char*)(ws + OFF_UB); unsigned char* V8 = (unsigned char*)(ws + OFF_VB);
  float* USC = (float*)(ws + OFF_USC); float* VSC = USC + 2 * 16384;
  bf16_t* AB = (bf16_t*)(ws + OFF_AB);
  bf16_t* FD1 = (bf16_t*)(ws + OFF_FT); bf16_t* FD3 = FD1 + 256 * 128; bf16_t* FDC = FD3 + 128 * 128;
  bf16_t* A1 = (bf16_t*)(ws + OFF_A1); bf16_t* VT0 = (bf16_t*)(ws + OFF_VT0); bf16_t* FQKV = (bf16_t*)(ws + OFF_BF);
  float* BF_ = (float*)(ws + OFF_BF); float* BY = (float*)(ws + OFF_BY);
  float* X1 = (float*)(ws + OFF_X1); float* X2 = (float*)(ws + OFF_X2);
  float* RT = TAB + 16384;
  bf16_t* Q1 = (bf16_t*)(ws + OFF_BF); bf16_t* K1 = Q1 + (size_t)T * 1024; bf16_t* VT1 = K1 + (size_t)R * 256;
  bf16_t* YB = (bf16_t*)(ws + OFF_BY + (size_t)2 * R * 128 * 4);
  float* PAB = (float*)(ws + OFF_BF); bf16_t* FB = (bf16_t*)(ws + OFF_BF + (size_t)R * 8 * 128 * 4);
  float* WB = (float*)(ws + OFF_BF + (size_t)R * 8 * 128 * 4 + (size_t)R * 1024 * 2); float* CORRB = WB + (size_t)R * 128;
  int* EXPB = (int*)(ws + OFF_BY); float* GATEB = (float*)(ws + OFF_BY + (size_t)R * 128 * 4);
  float* out = p.out;
  unsigned* QC = (unsigned*)(ws + OFF_BAR) + 32;
#define QFILL(site, layer, lo, hi) quant_fill(QC + (site), (layer), (lo), (hi), peer_u, peer_v, U8, V8, USC, VSC, (unsigned*)(smem_raw + 65024))

  PH(0, ph_tables(TAB); ph_rope_table(RT))
  PH(1, ph_fft_tables(FD1, FD3, FDC))
  PH(2, ph_ada2(c, c_ctx, ada_w, ada_b, Mm, smem))
  PH(3, ph_transpose_w(even_w_in, 1024, 2048, WIN0, smem))
  PH(4, ph_transpose_w(even_w_out, 1024, 1024, WOUT0, smem))
  PH(5, ph_transpose_w(odd_w_in, 1024, 1536, WIN1, smem))
  PH(6, ph_transpose_w(odd_w_out, 1024, 1024, WOUT1, smem))
  PH(7, ph_transpose_w(peer_wq, 1024, 2048, WQ, smem))
  PH(8, ph_transpose_w(peer_wq + (size_t)1024 * 2048, 1024, 2048, WQ + (size_t)2048 * 1024, smem))
  PH(11, ph_convert(peer_sk, SKB, (size_t)2 * 8 * 2 * 128 * 128 / 8))
  xcd_barrier(xbar);
  PH(12, ph_modulate(x, ctx, Mm, 0, 0, 1, AB, R, smem))
  xcd_barrier(xbar);
  PH(13, ph_gemm_bf16(AB, 1024, WIN0, 1024, R, 2048, 1024, EpiQKV0{FQKV, VT0}, smem_raw))
  PH(9, QFILL(0, 0, 0u, 160u))
  xcd_barrier(xbar);
  PH(14, { GRID_LOOP(u, NB * 64 * 8) fft1_unit(u, FQKV, FD1, TAB, A1, smem_raw); })
  PH(15, { int lane = threadIdx.x & 63, wave = __builtin_amdgcn_readfirstlane(threadIdx.x >> 6);
           __syncthreads();
           for (int i = threadIdx.x; i < 8 * 15 * 31; i += 256) smem[i] = rpb[i] * 1.4426950408889634f;
           __syncthreads();
           for (int bu = blockIdx.x; bu < 512 + 64; bu += gridDim.x) {
             if (bu < 512) { int h = bu & 7, rg = (bu >> 3) & 31, bb = bu >> 8;
               na_unit(bb, h, rg * 4 + wave, FQKV, VT0, VT0 + (size_t)NB * 8 * 64 * S, smem, AB, lane); }
             else { int cu = bu - 512; int h = cu & 7, qg = (cu >> 3) & 3, bb = cu >> 5;
               attn_unit<1, 1, 2>(bb, h, 0, 0, qg * 4 + wave, FQKV + 512, 2048, FQKV + 1024, 2048, VT0, VT0 + (size_t)NB * 8 * 64 * S, 8, smem, nullptr, AB + 512, 1024, lane); } } })
  xcd_barrier(xbar);
  PH(16, { GRID_LOOP(u, NB * 128 * 8 + NB * 4 * 8) { if (u < NB * 128 * 8) fft3_unit(u, 0, FQKV, A1, FD3, FDC, TAB, AB, smem_raw); else fft3_unit(u - NB * 128 * 8, 1, FQKV, A1, FD3, FDC, TAB, AB, smem_raw); } })
  xcd_barrier(xbar);
  PH(17, ph_gemm_bf16(AB, 1024, WOUT0, 1024, R, 1024, 1024, EpiBf16{YB, 1024}, smem_raw))
  PH(9, QFILL(1, 0, 160u, 260u))
  xcd_barrier(xbar);
  PH(18, ph_post_mod(x, ctx, YB, Mm, 0, 2, 0, 3, 4, true, ln_g + 0, ln_b + 0, X1, AB, R))
  xcd_barrier(xbar);
  PH(21, ph_peer_select(AB, WQ, SKB, EXPB, GATEB, R, smem_raw))
  PH(9, QFILL(2, 0, 260u, 512u))
  PH(10, QFILL(3, 1, 0u, 300u))
  xcd_barrier(xbar);
  PH(22, ph_peer_u(AB, EXPB, U8, PAB, R))
  xcd_barrier(xbar);
  PH(32, ph_peer_w(PAB, EXPB, GATEB, USC, VSC, (unsigned*)WB, CORRB, R))
  xcd_barrier(xbar);
  PH(33, ph_peer_v((const unsigned*)WB, CORRB, EXPB, V8, FB, R))
  xcd_barrier(xbar);
  PH(34, ph_post_mod(X1, X1 + (size_t)T * D, FB, Mm, 0, 5, 1, 0, 1, true, ln_g + 1024, ln_b + 1024, X2, AB, R))
  xcd_barrier(xbar);
  PH(23, ph_gemm_bf16(AB, 1024, WIN1, 1024, R, 1536, 1024, EpiQKV1{Q1, K1, VT1, RT}, smem_raw))
  PH(10, QFILL(4, 1, 300u, 420u))
  xcd_barrier(xbar);
  PH(25, { int lane = threadIdx.x & 63, wave = __builtin_amdgcn_readfirstlane(threadIdx.x >> 6);
           for (int bu = blockIdx.x; bu < 1024; bu += gridDim.x) { int kvh = bu & 3, bb = (bu >> 2) & 1, qg = bu >> 3;
             attn_unit<4, 2, 1>(bb, kvh, 0, 0, qg * 4 + wave, Q1, 1024, K1, 256, VT1, VT1 + (size_t)NB * 4 * 64 * S, 4, nullptr, sink, AB, 1024, lane); } })
  xcd_barrier(xbar);
  PH(26, ph_gemm_bf16(AB, 1024, WOUT1, 1024, T, 1024, 1024, EpiBf16{YB, 1024}, smem_raw))
  xcd_barrier(xbar);
  PH(27, ph_post_mod(X2, X2, YB, Mm, 1, 2, 1, 3, 4, true, ln_g + 2048, ln_b + 2048, X1, AB, T))
  xcd_barrier(xbar);
  PH(30, ph_peer_select(AB, WQ + (size_t)2048 * 1024, SKB + (size_t)8 * 2 * 128 * 128, EXPB, GATEB, T, smem_raw))
  PH(10, QFILL(5, 1, 420u, 512u))
  xcd_barrier(xbar);
  PH(31, ph_peer_u(AB, EXPB, U8 + (size_t)16384 * 1024, PAB, T))
  xcd_barrier(xbar);
  PH(35, ph_peer_w(PAB, EXPB, GATEB, USC + 16384, VSC + 16384, (unsigned*)WB, CORRB, T))
  xcd_barrier(xbar);
  PH(36, ph_peer_v((const unsigned*)WB, CORRB, EXPB, V8 + (size_t)16384 * 1024, FB, T))
  xcd_barrier(xbar);
  PH(37, ph_post_mod(X1, X1, FB, Mm, 1, 5, 1, 0, 1, false, ln_g + 3072, ln_b + 3072, out, AB, T))
}

}

extern "C" void kernel_launch(void* const* d_in, const int* in_sizes, int n_in, void* d_out, int out_size, void* d_ws,
                              size_t ws_size, hipStream_t stream) {
  static int grid_blocks = 0;
  if (!grid_blocks) {
    int dev = 0, cus = 0, per_cu = 0;
    hipGetDevice(&dev);
    hipDeviceGetAttribute(&cus, hipDeviceAttributeMultiprocessorCount, dev);
    hipOccupancyMaxActiveBlocksPerMultiprocessor(&per_cu, (const void*)mega, 256, 0);
    if (per_cu > 2) per_cu = 2;
    if (per_cu < 1) per_cu = 1;
    grid_blocks = cus * per_cu;
  }
  Params p{};
  for (int i = 0; i < 18; ++i) p.in[i] = (const float*)d_in[i];
  p.out = (float*)d_out;
  p.ws = (float*)d_ws;
  (void)hipMemsetAsync((char*)d_ws + OFF_BAR, 0, XCD_BAR_WORDS_C * 4, stream);
  void* args[] = {&p};
  hipError_t e = hipLaunchCooperativeKernel((const void*)mega, dim3(grid_blocks), dim3(256), args, 0, stream);
  if (e != hipSuccess) fprintf(stderr, "cooperative launch failed: %s (grid %d)\n", hipGetErrorString(e), grid_blocks);
}
```

```cpp
#include <hip/hip_runtime.h>
#include <hip/hip_bf16.h>
#include <stdint.h>
#include <math.h>
#include <stdio.h>
#include <hip/hip_cooperative_groups.h>
namespace cg = cooperative_groups;

namespace {

constexpr int D = 1024;
constexpr int NB = 2;
constexpr int S = 8192;
constexpr int T = NB * S;
constexpr int CL = 256;
constexpr int TC = NB * CL;
constexpr int R = T + TC;
constexpr float DN_ALPHA = 1.4142135623730951f;
constexpr float LN_EPS = 1e-6f;

template <int CTRL> __device__ __forceinline__ float dpp_mov(float x) {
  return __builtin_bit_cast(float, __builtin_amdgcn_mov_dpp(__builtin_bit_cast(int, x), CTRL, 0xf, 0xf, true));
}
__device__ __forceinline__ float xrow16_max(float x) {
  auto s = __builtin_amdgcn_permlane16_swap(__float_as_uint(x), __float_as_uint(x), false, false);
  x = fmaxf(__uint_as_float(s[0]), __uint_as_float(s[1]));
  auto t = __builtin_amdgcn_permlane32_swap(__float_as_uint(x), __float_as_uint(x), false, false);
  return fmaxf(__uint_as_float(t[0]), __uint_as_float(t[1]));
}
__device__ __forceinline__ float xrow16_sum(float x) {
  auto s = __builtin_amdgcn_permlane16_swap(__float_as_uint(x), __float_as_uint(x), false, false);
  x = __uint_as_float(s[0]) + __uint_as_float(s[1]);
  auto t = __builtin_amdgcn_permlane32_swap(__float_as_uint(x), __float_as_uint(x), false, false);
  return __uint_as_float(t[0]) + __uint_as_float(t[1]);
}
__device__ __forceinline__ float wave_sum(float v) {
  v += dpp_mov<0xB1>(v); v += dpp_mov<0x4E>(v); v += dpp_mov<0x124>(v); v += dpp_mov<0x128>(v);
  return xrow16_sum(v);
}
__device__ __forceinline__ float wave_max(float v) {
  v = fmaxf(v, dpp_mov<0xB1>(v)); v = fmaxf(v, dpp_mov<0x4E>(v)); v = fmaxf(v, dpp_mov<0x124>(v)); v = fmaxf(v, dpp_mov<0x128>(v));
  return xrow16_max(v);
}

typedef unsigned short bf16_t;
typedef __attribute__((ext_vector_type(8))) short bf16x8;
typedef __attribute__((ext_vector_type(16))) float f32x16;
typedef __attribute__((ext_vector_type(4))) float f32x4;

typedef __attribute__((ext_vector_type(2))) __bf16 bf16x2_t;
__device__ __forceinline__ unsigned f2bf(float f) { return (unsigned)__builtin_bit_cast(unsigned short, (__bf16)f); }
__device__ __forceinline__ unsigned pack2bf(float a, float b) { bf16x2_t v = {(__bf16)a, (__bf16)b}; return __builtin_bit_cast(unsigned, v); }
__device__ __forceinline__ float bf2f(unsigned short v) { return __uint_as_float(((unsigned)v) << 16); }

__device__ __forceinline__ int mod_index(int row) { return row < T ? row / S : 2; }


struct Params {
  const float* in[18];
  float* out;
  float* ws;
};

constexpr size_t XCD_BAR_WORDS_C = 3456;
constexpr size_t al256(size_t n) { return (n + 255) & ~(size_t)255; }
constexpr size_t OFF_BAR = 0;
constexpr size_t OFF_TAB = al256(XCD_BAR_WORDS_C * 4);
constexpr size_t OFF_M = OFF_TAB + al256(16384 * 4 + 128 * 16 * 2 * 4);
constexpr size_t OFF_WIN0 = OFF_M + al256(2 * 3 * 6144 * 4);
constexpr size_t OFF_WOUT0 = OFF_WIN0 + al256((size_t)2048 * 1024 * 2);
constexpr size_t OFF_WIN1 = OFF_WOUT0 + al256((size_t)1024 * 1024 * 2);
constexpr size_t OFF_WOUT1 = OFF_WIN1 + al256((size_t)1536 * 1024 * 2);
constexpr size_t OFF_WQ = OFF_WOUT1 + al256((size_t)1024 * 1024 * 2);
constexpr size_t OFF_SK = OFF_WQ + al256((size_t)2 * 2048 * 1024 * 2);
constexpr size_t OFF_UB = OFF_SK + al256((size_t)2 * 8 * 2 * 128 * 128 * 2);
constexpr size_t OFF_VB = OFF_UB + al256((size_t)2 * 16384 * 1024);
constexpr size_t OFF_USC = OFF_VB + al256((size_t)2 * 16384 * 1024);
constexpr size_t OFF_AB = OFF_USC + al256((size_t)4 * 16384 * 4);
constexpr size_t OFF_FT = OFF_AB + al256((size_t)R * 1024 * 2);
constexpr size_t OFF_BF = OFF_FT + al256((size_t)(256 * 128 + 128 * 128 + 64 * 128) * 2);
constexpr size_t OFF_BY = OFF_BF + al256((size_t)R * 2048 * 4);
constexpr size_t OFF_X1 = OFF_BY + al256((size_t)R * 1024 * 4);
constexpr size_t OFF_X2 = OFF_X1 + al256((size_t)R * 1024 * 4);
constexpr size_t OFF_END = OFF_X2 + al256((size_t)R * 1024 * 4);
constexpr size_t OFF_A1 = OFF_BY;
constexpr size_t OFF_VT0 = OFF_X2;
static_assert(OFF_END <= (size_t)512 * 1024 * 1024, "workspace overflow");

#define GRID_LOOP(var, n) for (int var = blockIdx.x; var < (n); var += gridDim.x)

__device__ __forceinline__ void ph_fft_tables(bf16_t* D1, bf16_t* D3, bf16_t* DcT) {
  const double TWO_PI = 6.283185307179586476925286766559;
  for (int i = blockIdx.x * 256 + threadIdx.x; i < 256 * 128 + 128 * 128 + 64 * 128; i += gridDim.x * 256) {
    if (i < 256 * 128) {
      int m = i >> 7, r = i & 127; int k1 = m >> 1, ri = m & 1;
      double a = TWO_PI * (double)((k1 * r) & 127) / 128.0;
      D1[i] = (bf16_t)f2bf(ri == 0 ? (float)cos(a) : (float)(-sin(a)));
    } else if (i < 256 * 128 + 128 * 128) {
      int j = i - 256 * 128; int m = j >> 7, kk = j & 127; int rip = m >> 6, k2 = m & 63; int c = kk >> 1, ri = kk & 1;
      double a = TWO_PI * (double)((k2 * c) & 63) / 64.0;
      double v = (rip == 0) ? (ri == 0 ? cos(a) : sin(a)) : (ri == 0 ? -sin(a) : cos(a));
      D3[j] = (bf16_t)f2bf((float)v);
    } else {
      int j = i - 256 * 128 - 128 * 128; int cp = j >> 7, kk = j & 127; int rip = kk >> 6, ch = kk & 63;
      double a = TWO_PI * (double)((ch * cp) & 63) / 64.0;
      DcT[j] = (bf16_t)f2bf((float)(rip == 0 ? cos(a) : sin(a)));
    }
  }
}
__device__ __forceinline__ void ph_rope_table(float* RT) {
  for (int i = blockIdx.x * 256 + threadIdx.x; i < 128 * 16; i += gridDim.x * 256) {
    int pos = i >> 4, f = i & 15;
    float inv_freq = powf(10000.0f, -(float)f / 16.0f);
    float ang = (float)pos * inv_freq;
    RT[2 * i] = cosf(ang); RT[2 * i + 1] = sinf(ang);
  }
}
__device__ __forceinline__ void ph_tables(float* tab) {
  for (int j = blockIdx.x * 256 + threadIdx.x; j < 8192; j += gridDim.x * 256) {
    double a = 6.283185307179586476925286766559 * (double)j / 8192.0;
    tab[j] = (float)cos(a);
    tab[8192 + j] = (float)sin(a);
  }
}
__device__ __forceinline__ void ph_ada(const float* __restrict__ c, const float* __restrict__ c_ctx, const float* __restrict__ ada_w,
                       const float* __restrict__ ada_b, float* __restrict__ M) {
  for (int gid = blockIdx.x * 256 + threadIdx.x; gid < 2 * 3 * 6144; gid += gridDim.x * 256) {
    int col = gid % 6144; int idx = (gid / 6144) % 3; int layer = gid / (3 * 6144);
    const float* vec = idx < 2 ? c + idx * D : c_ctx;
    const float* w = ada_w + (size_t)layer * D * 6144 + col;
    float acc = 0.f;
    for (int k = 0; k < D; ++k) {
      float x = vec[k];
      float sx = x / (1.f + expf(-x));
      acc += sx * w[(size_t)k * 6144];
    }
    M[gid] = acc + ada_b[layer * 6144 + col];
  }
}

__device__ __forceinline__ void ph_modulate(const float* __restrict__ xa, const float* __restrict__ xb, const float* __restrict__ M, int layer,
                            int jshift, int jscale, bf16_t* __restrict__ out, int nrows, float* red) {
  int tid = threadIdx.x;
  GRID_LOOP(row, nrows) {
    const float* x = row < T ? xa + (size_t)row * D : xb + (size_t)(row - T) * D;
    float v[4]; float s = 0.f;
#pragma unroll
    for (int i = 0; i < 4; ++i) { v[i] = x[tid + 256 * i]; s += v[i]; }
    s = wave_sum(s);
    __syncthreads();
    if ((tid & 63) == 0) red[tid >> 6] = s;
    __syncthreads();
    float mu = (red[0] + red[1] + red[2] + red[3]) * (1.f / D);
    float q = 0.f;
#pragma unroll
    for (int i = 0; i < 4; ++i) { float d = v[i] - mu; q += d * d; }
    q = wave_sum(q);
    if ((tid & 63) == 0) red[4 + (tid >> 6)] = q;
    __syncthreads();
    float var = (red[4] + red[5] + red[6] + red[7]) * (1.f / D);
    float rs = rsqrtf(var + LN_EPS);
    const float* m = M + ((size_t)layer * 3 + mod_index(row)) * 6144;
#pragma unroll
    for (int i = 0; i < 4; ++i) {
      int col = tid + 256 * i;
      float y = (v[i] - mu) * rs;
      out[(size_t)row * D + col] = (bf16_t)f2bf(y * (1.f + m[jscale * D + col]) + m[jshift * D + col]);
    }
  }
}

__device__ __forceinline__ void ph_post(const float* __restrict__ xa, const float* __restrict__ xb, const float* __restrict__ Y,
                        const float* __restrict__ M, int layer, int j, const float* __restrict__ g, const float* __restrict__ bb,
                        float* __restrict__ outa, float* __restrict__ outb, int nrows, float* red) {
  int tid = threadIdx.x;
  GRID_LOOP(row, nrows) {
    const float* x = row < T ? xa + (size_t)row * D : xb + (size_t)(row - T) * D;
    float* out = row < T ? outa + (size_t)row * D : outb + (size_t)(row - T) * D;
    const float* m = M + ((size_t)layer * 3 + mod_index(row)) * 6144 + j * D;
    float v[4]; float s = 0.f;
#pragma unroll
    for (int i = 0; i < 4; ++i) { int col = tid + 256 * i; v[i] = DN_ALPHA * x[col] + m[col] * Y[(size_t)row * D + col]; s += v[i]; }
    s = wave_sum(s);
    __syncthreads();
    if ((tid & 63) == 0) red[tid >> 6] = s;
    __syncthreads();
    float mu = (red[0] + red[1] + red[2] + red[3]) * (1.f / D);
    float q = 0.f;
#pragma unroll
    for (int i = 0; i < 4; ++i) { float d = v[i] - mu; q += d * d; }
    q = wave_sum(q);
    if ((tid & 63) == 0) red[4 + (tid >> 6)] = q;
    __syncthreads();
    float var = (red[4] + red[5] + red[6] + red[7]) * (1.f / D);
    float rs = rsqrtf(var + LN_EPS);
#pragma unroll
    for (int i = 0; i < 4; ++i) {
      int col = tid + 256 * i;
      out[col] = (v[i] - mu) * rs * g[col] + bb[col];
    }
  }
}

struct ARow { const float* A; int lda; __device__ float operator()(int m, int k) const { return A[(size_t)m * lda + k]; } };
struct BRow { const float* B; int ldb; __device__ float operator()(int k, int n) const { return B[(size_t)k * ldb + n]; } };
struct CRow { float* C; int ldc; float scale; __device__ void operator()(int m, int n, float v) const { C[(size_t)m * ldc + n] = v * scale; } };
struct CRowB { bf16_t* C; int ldc; float scale; __device__ void operator()(int m, int n, float v) const { C[(size_t)m * ldc + n] = (bf16_t)f2bf(v * scale); } };
struct ADft { const float* tab; int Sn; int stride; __device__ float operator()(int m, int k) const {
    int t = k & (Sn - 1); int idx = ((m * t) & (Sn - 1)) * stride;
    return k < Sn ? tab[idx] : -tab[8192 + idx]; } };
struct BPQ { const float* PQ; int rowbase; int Sn; __device__ float operator()(int k, int n) const {
    int t = k & (Sn - 1); return PQ[(size_t)(rowbase + t) * 1024 + (k >= Sn ? 512 : 0) + n]; } };

template <class AF, class BF, class CF>
__device__ __forceinline__ void ph_gemm(AF af, BF bf, CF cf, int M, int N, int K, float* sm) {
  float (*sA)[68] = (float (*)[68])sm;
  float (*sB)[68] = (float (*)[68])(sm + 16 * 68);
  int tid = threadIdx.x; int tx = tid & 15, ty = tid >> 4;
  int ntn = N / 64; int ntiles = (M / 64) * ntn;
  GRID_LOOP(tile, ntiles) {
    int m0 = (tile / ntn) * 64, n0 = (tile % ntn) * 64;
    float acc[4][4];
#pragma unroll
    for (int i = 0; i < 4; ++i)
#pragma unroll
      for (int j = 0; j < 4; ++j) acc[i][j] = 0.f;
    for (int k0 = 0; k0 < K; k0 += 16) {
      __syncthreads();
#pragma unroll
      for (int i = 0; i < 4; ++i) { int e = tid + 256 * i; int m = e >> 4, k = e & 15; sA[k][m] = af(m0 + m, k0 + k); }
#pragma unroll
      for (int i = 0; i < 4; ++i) { int e = tid + 256 * i; int k = e >> 6, n = e & 63; sB[k][n] = bf(k0 + k, n0 + n); }
      __syncthreads();
#pragma unroll
      for (int k = 0; k < 16; ++k) {
        float a[4], b[4];
#pragma unroll
        for (int i = 0; i < 4; ++i) { a[i] = sA[k][ty * 4 + i]; b[i] = sB[k][tx * 4 + i]; }
#pragma unroll
        for (int i = 0; i < 4; ++i)
#pragma unroll
          for (int j = 0; j < 4; ++j) acc[i][j] += a[i] * b[j];
      }
    }
#pragma unroll
    for (int i = 0; i < 4; ++i)
#pragma unroll
      for (int j = 0; j < 4; ++j) cf(m0 + ty * 4 + i, n0 + tx * 4 + j, acc[i][j]);
  }
}


__device__ __forceinline__ void ph_transpose_w(const float* __restrict__ W, int K, int N, bf16_t* __restrict__ Wt, float* sm) {
  int tid = threadIdx.x;
  int tk = K / 64, tn = N / 64;
  GRID_LOOP(tile, tk * tn) {
    int k0 = (tile / tn) * 64, n0 = (tile % tn) * 64;
    __syncthreads();
#pragma unroll
    for (int i = 0; i < 16; ++i) { int e = tid + 256 * i; int k = e >> 6, n = e & 63; sm[k * 65 + n] = W[(size_t)(k0 + k) * N + n0 + n]; }
    __syncthreads();
#pragma unroll
    for (int i = 0; i < 2; ++i) {
      int e = tid + 256 * i; int n = e >> 3, kc = e & 7;
      unsigned w[4];
#pragma unroll
      for (int j = 0; j < 4; ++j) w[j] = pack2bf(sm[(kc * 8 + 2 * j) * 65 + n], sm[(kc * 8 + 2 * j + 1) * 65 + n]);
      *(uint4*)(Wt + (size_t)(n0 + n) * K + k0 + kc * 8) = make_uint4(w[0], w[1], w[2], w[3]);
    }
  }
}
__device__ __forceinline__ void ph_convert(const float* __restrict__ src, bf16_t* __restrict__ dst, size_t n8) {
  for (size_t i = (size_t)blockIdx.x * 256 + threadIdx.x; i < n8; i += (size_t)gridDim.x * 256) {
    float4 a = ((const float4*)src)[2 * i], b = ((const float4*)src)[2 * i + 1];
    ((uint4*)dst)[i] = make_uint4(pack2bf(a.x, a.y), pack2bf(a.z, a.w), pack2bf(b.x, b.y), pack2bf(b.z, b.w));
  }
}

__device__ __forceinline__ void gemm_stage(const bf16_t* __restrict__ A, int lda, int k0, char* lds, int tid) {
#pragma unroll
  for (int i = 0; i < 4; ++i) {
    int q = tid + 256 * i; int row = q >> 3, p = q & 7; int c = p ^ ((row >> 1) & 7);
    const bf16_t* src = A + (size_t)row * lda + k0 + c * 8;
    __builtin_amdgcn_global_load_lds((const unsigned*)src, (unsigned*)(lds + q * 16), 16, 0, 0);
  }
}
struct EpiF32 {
  float* C; int ldc; float scale;
  __device__ __forceinline__ void operator()(int m0, int n0, int wm, int wn, f32x16 (&acc)[2][2], int tid, char* smem) const {
    int lane = tid & 63;
    float* t = (float*)smem;
    int rbase = wm * 64 + 4 * (lane >> 5), cbase = wn * 64 + (lane & 31);
#pragma unroll
    for (int mi = 0; mi < 2; ++mi)
#pragma unroll
      for (int ni = 0; ni < 2; ++ni)
#pragma unroll
        for (int r = 0; r < 16; ++r)
          t[(rbase + mi * 32 + (r & 3) + 8 * (r >> 2)) * 128 + cbase + ni * 32] = acc[mi][ni][r] * scale;
    __syncthreads();
    float* dst = C + (size_t)(m0 + (tid >> 5)) * ldc + n0 + (tid & 31) * 4;
    const float* src = t + (tid >> 5) * 128 + (tid & 31) * 4;
#pragma unroll 4
    for (int i = 0; i < 16; ++i) {
      *(float4*)dst = *(const float4*)src;
      dst += (size_t)8 * ldc; src += 8 * 128;
    }
  }
};
struct EpiQKV0 {
  bf16_t* FQKV; bf16_t* VT;
  __device__ __forceinline__ void operator()(int m0, int n0, int wm, int wn, f32x16 (&acc)[2][2], int tid, char* smem) const {
    int lane = tid & 63;
    bf16_t* t = (bf16_t*)smem;
    int rbase = wm * 64 + 4 * (lane >> 5), cbase = wn * 64 + (lane & 31);
#pragma unroll
    for (int mi = 0; mi < 2; ++mi)
#pragma unroll
      for (int ni = 0; ni < 2; ++ni)
#pragma unroll
        for (int r = 0; r < 16; ++r)
          t[(rbase + mi * 32 + (r & 3) + 8 * (r >> 2)) * 136 + cbase + ni * 32] = (bf16_t)f2bf(acc[mi][ni][r]);
    __syncthreads();
    {
      bf16_t* dst = FQKV + (size_t)(m0 + (tid >> 4)) * 2048 + n0 + (tid & 15) * 8;
      const bf16_t* src = t + (tid >> 4) * 136 + (tid & 15) * 8;
#pragma unroll 4
      for (int i = 0; i < 8; ++i) {
        *(uint4*)dst = *(const uint4*)src;
        dst += (size_t)16 * 2048; src += 16 * 136;
      }
    }
    if (n0 >= 1536) {
      int col = tid >> 1, half = tid & 1;
      int hd = (n0 - 1536) / 64 + (col >> 6), d = col & 63;
      bf16_t* dst;
      if (m0 < T) { int b = m0 / S, t0 = m0 % S; dst = VT + (((size_t)b * 8 + hd) * 64 + d) * S + t0 + half * 64; }
      else { int mm = m0 - T; int b = mm / CL, l0 = mm % CL; dst = VT + (size_t)NB * 8 * 64 * S + (((size_t)b * 8 + hd) * 64 + d) * CL + l0 + half * 64; }
      const bf16_t* src = t + (half * 64) * 136 + col;
#pragma unroll
      for (int i = 0; i < 8; ++i) {
        unsigned wv[4];
#pragma unroll
        for (int j = 0; j < 4; ++j) wv[j] = (unsigned)src[(i * 8 + 2 * j) * 136] | ((unsigned)src[(i * 8 + 2 * j + 1) * 136] << 16);
        *(uint4*)(dst + i * 8) = make_uint4(wv[0], wv[1], wv[2], wv[3]);
      }
    }
  }
};
struct EpiBf16 {
  bf16_t* C; int ldc;
  __device__ __forceinline__ void operator()(int m0, int n0, int wm, int wn, f32x16 (&acc)[2][2], int tid, char* smem) const {
    int lane = tid & 63;
    asm volatile("" : "+v"(lane));
    bf16_t* t = (bf16_t*)smem;
    {
      bf16_t* tw = t + (wm * 64 + 4 * (lane >> 5)) * 136 + wn * 64 + (lane & 31);
#pragma unroll
      for (int mi = 0; mi < 2; ++mi)
#pragma unroll
        for (int ni = 0; ni < 2; ++ni)
#pragma unroll
          for (int r = 0; r < 16; ++r)
            tw[(mi * 32 + (r & 3) + 8 * (r >> 2)) * 136 + ni * 32] = (bf16_t)f2bf(acc[mi][ni][r]);
    }
    __syncthreads();
    bf16_t* dst = C + (size_t)(m0 + (tid >> 4)) * ldc + n0 + (tid & 15) * 8;
    const bf16_t* src = t + (tid >> 4) * 136 + (tid & 15) * 8;
#pragma unroll 4
    for (int i = 0; i < 8; ++i) {
      *(uint4*)dst = *(const uint4*)src;
      dst += (size_t)16 * ldc; src += 16 * 136;
    }
  }
};
struct EpiQKV1 {
  bf16_t* Q1; bf16_t* K1; bf16_t* VT; const float* RT;
  __device__ __forceinline__ void operator()(int m0, int n0, int wm, int wn, f32x16 (&acc)[2][2], int tid, char* smem) const {
    int lane = tid & 63;
    asm volatile("" : "+v"(lane));
    bf16_t* t = (bf16_t*)smem;
    if (n0 < 1280 && m0 < T) {
      int i = lane & 31; int f = i & 15;
#pragma unroll
      for (int mi = 0; mi < 2; ++mi)
#pragma unroll
        for (int r = 0; r < 16; ++r) {
          int row = m0 + wm * 64 + 4 * (lane >> 5) + mi * 32 + (r & 3) + 8 * (r >> 2);
          int tt = row & (S - 1);
          int pos = (i < 16) ? (tt >> 6) : (tt & 63);
          float2 cs = *(const float2*)(RT + 2 * (pos * 16 + f));
          float x1 = acc[mi][0][r], x2 = acc[mi][1][r];
          acc[mi][0][r] = x1 * cs.x - x2 * cs.y;
          acc[mi][1][r] = x1 * cs.y + x2 * cs.x;
        }
    }
    {
      bf16_t* tw = t + (wm * 64 + 4 * (lane >> 5)) * 136 + wn * 64 + (lane & 31);
#pragma unroll
      for (int mi = 0; mi < 2; ++mi)
#pragma unroll
        for (int ni = 0; ni < 2; ++ni)
#pragma unroll
          for (int r = 0; r < 16; ++r)
            tw[(mi * 32 + (r & 3) + 8 * (r >> 2)) * 136 + ni * 32] = (bf16_t)f2bf(acc[mi][ni][r]);
    }
    __syncthreads();
    if (n0 < 1280) {
      bf16_t* dst; int ld;
      if (n0 < 1024) { dst = Q1 + (size_t)(m0 + (tid >> 4)) * 1024 + n0 + (tid & 15) * 8; ld = 1024; }
      else { dst = K1 + (size_t)(m0 + (tid >> 4)) * 256 + (n0 - 1024) + (tid & 15) * 8; ld = 256; }
      if (n0 >= 1024 || m0 < T) {
        const bf16_t* src = t + (tid >> 4) * 136 + (tid & 15) * 8;
#pragma unroll 4
        for (int i = 0; i < 8; ++i) {
          *(uint4*)dst = *(const uint4*)src;
          dst += (size_t)16 * ld; src += 16 * 136;
        }
      }
    } else {
      int col = tid >> 1, half = tid & 1;
      int hd = (n0 - 1280) / 64 + (col >> 6), d = col & 63;
      bf16_t* dst;
      if (m0 < T) { int b = m0 / S, t0 = m0 % S; dst = VT + (((size_t)b * 4 + hd) * 64 + d) * S + t0 + half * 64; }
      else { int mm = m0 - T; int b = mm / CL, l0 = mm % CL; dst = VT + (size_t)NB * 4 * 64 * S + (((size_t)b * 4 + hd) * 64 + d) * CL + l0 + half * 64; }
      const bf16_t* src = t + (half * 64) * 136 + col;
#pragma unroll
      for (int i = 0; i < 8; ++i) {
        unsigned wv[4];
#pragma unroll
        for (int j = 0; j < 4; ++j) wv[j] = (unsigned)src[(i * 8 + 2 * j) * 136] | ((unsigned)src[(i * 8 + 2 * j + 1) * 136] << 16);
        *(uint4*)(dst + i * 8) = make_uint4(wv[0], wv[1], wv[2], wv[3]);
      }
    }
  }
};
__device__ __forceinline__ void gemm_tile_mainloop(const bf16_t* __restrict__ Ag, int lda, const bf16_t* __restrict__ Bg, int ldb, int KT,
                                                   f32x16 (&acc)[2][2], char* smem) {
  int tid = threadIdx.x;
  asm volatile("" : "+v"(tid));
  int lane = tid & 63, wave = __builtin_amdgcn_readfirstlane(tid >> 6), wm = wave >> 1, wn = wave & 1;
#pragma unroll
  for (int mi = 0; mi < 2; ++mi)
#pragma unroll
    for (int ni = 0; ni < 2; ++ni)
#pragma unroll
      for (int r = 0; r < 16; ++r) acc[mi][ni][r] = 0.f;
  __syncthreads();
  gemm_stage(Ag, lda, 0, smem, tid); gemm_stage(Bg, ldb, 0, smem + 16384, tid);
  for (int kt = 0; kt < KT; ++kt) {
    asm volatile("s_waitcnt vmcnt(0)" ::: "memory");
    __syncthreads();
    char* cur = smem + (kt & 1) * 32768;
    if (kt + 1 < KT) {
      char* nxt = smem + ((kt + 1) & 1) * 32768;
      gemm_stage(Ag, lda, (kt + 1) * 64, nxt, tid); gemm_stage(Bg, ldb, (kt + 1) * 64, nxt + 16384, tid);
    }
#pragma unroll
    for (int s4 = 0; s4 < 4; ++s4) {
      bf16x8 a[2], b[2];
      int c = 2 * s4 + (lane >> 5);
#pragma unroll
      for (int mi = 0; mi < 2; ++mi) { int row = wm * 64 + mi * 32 + (lane & 31); a[mi] = *(const bf16x8*)(cur + row * 128 + ((c ^ ((row >> 1) & 7)) << 4)); }
#pragma unroll
      for (int ni = 0; ni < 2; ++ni) { int row = wn * 64 + ni * 32 + (lane & 31); b[ni] = *(const bf16x8*)(cur + 16384 + row * 128 + ((c ^ ((row >> 1) & 7)) << 4)); }
#pragma unroll
      for (int mi = 0; mi < 2; ++mi)
#pragma unroll
        for (int ni = 0; ni < 2; ++ni) acc[mi][ni] = __builtin_amdgcn_mfma_f32_32x32x16_bf16(a[mi], b[ni], acc[mi][ni], 0, 0, 0);
    }
  }
  __syncthreads();
}
template <class Epi>
__device__ __forceinline__ void ph_gemm_bf16(const bf16_t* __restrict__ A, int lda, const bf16_t* __restrict__ Bt, int ldb, int M, int N, int K,
                             Epi epi, char* smem) {
  int tid = threadIdx.x, wave = __builtin_amdgcn_readfirstlane(tid >> 6), wm = wave >> 1, wn = wave & 1;
  int ntn = N / 128, ntiles = (M / 128) * ntn;
  int KT = K / 64;
  GRID_LOOP(tile, ntiles) {
    int mt = tile / ntn, nt = tile % ntn;
    f32x16 acc[2][2];
    gemm_tile_mainloop(A + (size_t)mt * 128 * lda, lda, Bt + (size_t)nt * 128 * ldb, ldb, KT, acc, smem);
    epi(mt * 128, nt * 128, wm, wn, acc, tid, smem);
  }
}

__device__ __forceinline__ void ins16(float (&L)[16], float x) {
#pragma unroll
  for (int j = 15; j >= 1; --j) L[j] = __builtin_amdgcn_fmed3f(L[j - 1], L[j], x);
  L[0] = fmaxf(L[0], x);
}
__device__ __forceinline__ void stage_tile128(const bf16_t* __restrict__ src, int ld, char* lds, int tid) {
#pragma unroll
  for (int i = 0; i < 8; ++i) {
    int q = tid + 256 * i; int row = q >> 4, p = q & 15; int c = p ^ (row & 15);
    __builtin_amdgcn_global_load_lds((const unsigned*)(src + (size_t)row * ld + c * 8), (unsigned*)(lds + q * 16), 16, 0, 0);
  }
}
__device__ __forceinline__ void ph_peer_select(const bf16_t* __restrict__ H, const bf16_t* __restrict__ WQl, const bf16_t* __restrict__ SKl,
                                               int* __restrict__ EXP, float* __restrict__ GATE, int nrows, char* smem) {
  int tid = threadIdx.x, w = __builtin_amdgcn_readfirstlane(tid >> 6), wm = w >> 1, wn = w & 1;
  bf16_t* Qs = (bf16_t*)smem;
  int* KL = (int*)(smem + 36864);
  int nunits = (nrows / 128) * 8;
  GRID_LOOP(unit, nunits) {
    int mt = unit >> 3, h = unit & 7;
    float L0[16], L1[16];
#pragma unroll
    for (int p = 0; p < 2; ++p) {
      f32x16 acc[2][2];
      gemm_tile_mainloop(H + (size_t)mt * 128 * 1024, 1024, WQl + (size_t)(h * 256 + p * 128) * 1024, 1024, 16, acc, smem);
      int lane = tid & 63;
      asm volatile("" : "+v"(lane));
      {
        bf16_t* qw = Qs + (wm * 64 + 4 * (lane >> 5)) * 136 + wn * 64 + (lane & 31);
#pragma unroll
        for (int mi = 0; mi < 2; ++mi)
#pragma unroll
          for (int ni = 0; ni < 2; ++ni)
#pragma unroll
            for (int r = 0; r < 16; ++r)
              qw[(mi * 32 + (r & 3) + 8 * (r >> 2)) * 136 + ni * 32] = (bf16_t)f2bf(acc[mi][ni][r]);
      }
      __syncthreads();
      f32x16 sc[4];
#pragma unroll
      for (int m4 = 0; m4 < 4; ++m4)
#pragma unroll
        for (int r = 0; r < 16; ++r) sc[m4][r] = 0.f;
      {
        const bf16_t* qrow = Qs + (32 * w + (lane & 31)) * 136 + 8 * (lane >> 5);
        const bf16_t* krow = SKl + (size_t)(h * 2 + p) * 128 * 128 + (lane & 31) * 128 + 8 * (lane >> 5);
#pragma unroll
        for (int s8 = 0; s8 < 8; ++s8) {
          bf16x8 bq = *(const bf16x8*)(qrow + 16 * s8);
#pragma unroll
          for (int m4 = 0; m4 < 4; ++m4) {
            bf16x8 ak = *(const bf16x8*)(krow + m4 * 32 * 128 + 16 * s8);
            sc[m4] = __builtin_amdgcn_mfma_f32_32x32x16_bf16(ak, bq, sc[m4], 0, 0, 0);
          }
        }
      }
      float L[16];
#pragma unroll
      for (int j = 0; j < 16; ++j) L[j] = -INFINITY;
      unsigned kb = 4u * (unsigned)(lane >> 5);
#pragma unroll
      for (int m4 = 0; m4 < 4; ++m4)
#pragma unroll
        for (int r = 0; r < 16; ++r) {
          unsigned key = kb + (unsigned)(32 * m4 + (r & 3) + 8 * (r >> 2));
          float x = __uint_as_float((__float_as_uint(sc[m4][r]) & 0xFFFFFF80u) | key);
          ins16(L, x);
        }
      float P[16];
#pragma unroll
      for (int j = 0; j < 16; ++j) P[j] = __shfl_xor(L[j], 32);
#pragma unroll
      for (int j = 0; j < 16; ++j) ins16(L, P[j]);
      if (p == 0) {
#pragma unroll
        for (int j = 0; j < 16; ++j) L0[j] = L[j];
      } else {
#pragma unroll
        for (int j = 0; j < 16; ++j) L1[j] = L[j];
      }
    }
    float C[16];
#pragma unroll
    for (int j = 0; j < 16; ++j) C[j] = -INFINITY;
#pragma unroll
    for (int a = 0; a < 16; ++a)
#pragma unroll
      for (int b = 0; b < 16; ++b)
        if ((a + 1) * (b + 1) <= 16) {
          float sa = __uint_as_float(__float_as_uint(L0[a]) & 0xFFFFFF80u);
          float sb = __uint_as_float(__float_as_uint(L1[b]) & 0xFFFFFF80u);
          float x = __uint_as_float((__float_as_uint(sa + sb) & 0xFFFFFF00u) | (unsigned)(a * 16 + b));
          ins16(C, x);
        }
    int lane = tid & 63;
    asm volatile("" : "+v"(lane));
    int token = 32 * w + (lane & 31);
    if (lane < 32) {
#pragma unroll
      for (int j = 0; j < 16; ++j) { KL[token * 32 + j] = (int)(__float_as_uint(L0[j]) & 0x7Fu); KL[token * 32 + 16 + j] = (int)(__float_as_uint(L1[j]) & 0x7Fu); }
    }
    __syncthreads();
    if (lane < 32) {
      float c0 = __uint_as_float(__float_as_uint(C[0]) & 0xFFFFFF00u);
      float ev[16]; float sum = 0.f; int ex[16];
#pragma unroll
      for (int j = 0; j < 16; ++j) {
        unsigned bits = __float_as_uint(C[j]);
        float cv = __uint_as_float(bits & 0xFFFFFF00u);
        ev[j] = __expf(cv - c0); sum += ev[j];
        int a = (bits >> 4) & 15, b = bits & 15;
        ex[j] = KL[token * 32 + a] * 128 + KL[token * 32 + 16 + b];
      }
      float inv = 1.f / sum;
      size_t o = (size_t)(mt * 128 + token) * 128 + h * 16;
#pragma unroll
      for (int j = 0; j < 16; j += 4) {
        *(int4*)(EXP + o + j) = make_int4(ex[j], ex[j + 1], ex[j + 2], ex[j + 3]);
        *(float4*)(GATE + o + j) = make_float4(ev[j] * inv, ev[j + 1] * inv, ev[j + 2] * inv, ev[j + 3] * inv);
      }
    }
  }
}

__device__ __forceinline__ void fft1_unit(int u, const bf16_t* __restrict__ FQKV, const bf16_t* __restrict__ D1, const float* __restrict__ TAB,
                          bf16_t* __restrict__ A1, char* smem) {
  int tid = threadIdx.x, lane = tid & 63, w = __builtin_amdgcn_readfirstlane(tid >> 6);
  int g = u & 7, c = (u >> 3) & 63, b = u >> 9;
  bf16_t* Bt = (bf16_t*)smem;
  __syncthreads();
  {
    int r = tid >> 1, half = tid & 1;
    const uint4* src = (const uint4*)(FQKV + (size_t)(b * S + 64 * r + c) * 2048 + g * 64 + half * 32);
    unsigned wv[16];
#pragma unroll
    for (int i = 0; i < 4; ++i) { uint4 v = src[i]; wv[4 * i] = v.x; wv[4 * i + 1] = v.y; wv[4 * i + 2] = v.z; wv[4 * i + 3] = v.w; }
#pragma unroll
    for (int j = 0; j < 32; ++j) {
      unsigned e = (j & 1) ? (wv[j >> 1] >> 16) : (wv[j >> 1] & 0xffffu);
      Bt[(half * 32 + j) * 136 + r] = (bf16_t)e;
    }
  }
  __syncthreads();
  f32x16 acc[2][2];
#pragma unroll
  for (int mi = 0; mi < 2; ++mi)
#pragma unroll
    for (int ni = 0; ni < 2; ++ni)
#pragma unroll
      for (int r = 0; r < 16; ++r) acc[mi][ni][r] = 0.f;
#pragma unroll
  for (int s8 = 0; s8 < 8; ++s8) {
    bf16x8 a[2], bb[2];
    int ko = 16 * s8 + 8 * (lane >> 5);
#pragma unroll
    for (int mi = 0; mi < 2; ++mi) a[mi] = *(const bf16x8*)(D1 + (64 * w + 32 * mi + (lane & 31)) * 128 + ko);
#pragma unroll
    for (int ni = 0; ni < 2; ++ni) bb[ni] = *(const bf16x8*)(Bt + (32 * ni + (lane & 31)) * 136 + ko);
#pragma unroll
    for (int mi = 0; mi < 2; ++mi)
#pragma unroll
      for (int ni = 0; ni < 2; ++ni) acc[mi][ni] = __builtin_amdgcn_mfma_f32_32x32x16_bf16(a[mi], bb[ni], acc[mi][ni], 0, 0, 0);
  }
  bf16_t* Ot = (bf16_t*)(smem + 17408);
#pragma unroll
  for (int mi = 0; mi < 2; ++mi)
#pragma unroll
    for (int j = 0; j < 8; ++j) {
      int m = 64 * w + 32 * mi + ((2 * j) & 3) + 8 * ((2 * j) >> 2) + 4 * (lane >> 5);
      int k1 = m >> 1;
      int idx = (k1 * c) & 8191;
      float cs = TAB[idx], sn = TAB[8192 + idx];
#pragma unroll
      for (int ni = 0; ni < 2; ++ni) {
        float re = acc[mi][ni][2 * j], im = acc[mi][ni][2 * j + 1];
        float re2 = re * cs + im * sn, im2 = im * cs - re * sn;
        bf16_t* dst = Ot + m * 72 + 32 * ni + (lane & 31);
        dst[0] = (bf16_t)f2bf(re2); dst[72] = (bf16_t)f2bf(im2);
      }
    }
  __syncthreads();
  {
    bf16_t* base = A1 + (((size_t)b * 64 + c) * 128) * 2 * 512 + g * 64;
#pragma unroll
    for (int i = 0; i < 8; ++i) {
      int q = tid + 256 * i; int m = q >> 3, ch8 = q & 7;
      *(uint4*)(base + (size_t)m * 512 + ch8 * 8) = *(const uint4*)(Ot + m * 72 + ch8 * 8);
    }
  }
}

__device__ __forceinline__ void fft3_unit(int u, int mode, const bf16_t* __restrict__ FQKV, const bf16_t* __restrict__ A1, const bf16_t* __restrict__ D3,
                          const bf16_t* __restrict__ DcT, const float* __restrict__ TAB, bf16_t* __restrict__ MIX, char* smem) {
  int tid = threadIdx.x, lane = tid & 63, w = __builtin_amdgcn_readfirstlane(tid >> 6);
  bf16_t* Bt = (bf16_t*)smem;
  bf16_t* Xs = (bf16_t*)(smem + 17408);
  int g = u & 7, k1, b, nk1, rowbase; float norm;
  __syncthreads();
  if (mode == 0) {
    k1 = (u >> 3) & 127; b = u >> 10; nk1 = 128; rowbase = b * S; norm = 1.f / 724.0773439350247f;
    int kk = tid >> 1, half = tid & 1; int c = kk >> 1, ri = kk & 1;
    const uint4* src = (const uint4*)(A1 + ((((size_t)b * 64 + c) * 128 + k1) * 2 + ri) * 512 + g * 64 + half * 32);
    unsigned wv[16];
#pragma unroll
    for (int i = 0; i < 4; ++i) { uint4 v = src[i]; wv[4 * i] = v.x; wv[4 * i + 1] = v.y; wv[4 * i + 2] = v.z; wv[4 * i + 3] = v.w; }
#pragma unroll
    for (int j = 0; j < 32; ++j) {
      unsigned e = (j & 1) ? (wv[j >> 1] >> 16) : (wv[j >> 1] & 0xffffu);
      Bt[(half * 32 + j) * 136 + kk] = (bf16_t)e;
    }
  } else {
    k1 = (u >> 3) & 3; b = u >> 5; nk1 = 4; rowbase = T + b * CL; norm = 1.f / 128.f;
    int c = tid >> 2, q4 = tid & 3;
    float re[16], im[16];
#pragma unroll
    for (int j = 0; j < 16; ++j) { re[j] = 0.f; im[j] = 0.f; }
#pragma unroll
    for (int r = 0; r < 4; ++r) {
      const uint4* src = (const uint4*)(FQKV + (size_t)(rowbase + 64 * r + c) * 2048 + g * 64 + q4 * 16);
      uint4 v0 = src[0], v1 = src[1];
      unsigned wv[8] = {v0.x, v0.y, v0.z, v0.w, v1.x, v1.y, v1.z, v1.w};
      int ph = (k1 * r) & 3;
      float cr = (ph == 0) ? 1.f : (ph == 2 ? -1.f : 0.f);
      float ci = (ph == 1) ? -1.f : (ph == 3 ? 1.f : 0.f);
#pragma unroll
      for (int j = 0; j < 16; ++j) {
        float x = bf2f((unsigned short)((j & 1) ? (wv[j >> 1] >> 16) : (wv[j >> 1] & 0xffffu)));
        re[j] += x * cr; im[j] += x * ci;
      }
    }
    int idx = (k1 * c * 32) & 8191;
    float cs = TAB[idx], sn = TAB[8192 + idx];
#pragma unroll
    for (int j = 0; j < 16; ++j) {
      float re2 = re[j] * cs + im[j] * sn, im2 = im[j] * cs - re[j] * sn;
      *(unsigned*)(Bt + (q4 * 16 + j) * 136 + 2 * c) = pack2bf(re2, im2);
    }
  }
  __syncthreads();
  {
    f32x16 acc[2];
#pragma unroll
    for (int ni = 0; ni < 2; ++ni)
#pragma unroll
      for (int r = 0; r < 16; ++r) acc[ni][r] = 0.f;
#pragma unroll
    for (int s8 = 0; s8 < 8; ++s8) {
      int ko = 16 * s8 + 8 * (lane >> 5);
      bf16x8 a = *(const bf16x8*)(D3 + (32 * w + (lane & 31)) * 128 + ko);
#pragma unroll
      for (int ni = 0; ni < 2; ++ni) {
        bf16x8 bb = *(const bf16x8*)(Bt + (32 * ni + (lane & 31)) * 136 + ko);
        acc[ni] = __builtin_amdgcn_mfma_f32_32x32x16_bf16(a, bb, acc[ni], 0, 0, 0);
      }
    }
#pragma unroll
    for (int ni = 0; ni < 2; ++ni)
#pragma unroll
      for (int r = 0; r < 16; ++r) {
        int m = 32 * w + (r & 3) + 8 * (r >> 2) + 4 * (lane >> 5);
        Xs[(m & 63) * 136 + (m >> 6) * 64 + 32 * ni + (lane & 31)] = (bf16_t)f2bf(acc[ni][r]);
      }
  }
  __syncthreads();
  {
    int mi = w >> 1, ni = w & 1;
    f32x16 acc;
#pragma unroll
    for (int r = 0; r < 16; ++r) acc[r] = 0.f;
#pragma unroll
    for (int s8 = 0; s8 < 8; ++s8) {
      int ko = 16 * s8 + 8 * (lane >> 5);
      bf16x8 a = *(const bf16x8*)(Xs + (32 * mi + (lane & 31)) * 136 + ko);
      bf16x8 bb = *(const bf16x8*)(DcT + (32 * ni + (lane & 31)) * 128 + ko);
      acc = __builtin_amdgcn_mfma_f32_32x32x16_bf16(a, bb, acc, 0, 0, 0);
    }
    bf16_t* Yt = Bt;
#pragma unroll
    for (int r = 0; r < 16; ++r) {
      int k2 = 32 * mi + (r & 3) + 8 * (r >> 2) + 4 * (lane >> 5);
      Yt[k2 * 72 + 32 * ni + (lane & 31)] = (bf16_t)f2bf(acc[r] * norm);
    }
  }
  __syncthreads();
#pragma unroll
  for (int i = 0; i < 2; ++i) {
    int q = tid + 256 * i; int k2 = q >> 3, ch8 = q & 7;
    int row = rowbase + k1 + nk1 * k2;
    *(uint4*)(MIX + (size_t)row * 1024 + g * 64 + ch8 * 8) = *(const uint4*)((const bf16_t*)smem + k2 * 72 + ch8 * 8);
  }
}

typedef __attribute__((ext_vector_type(4))) float f32x4_t;
__device__ __forceinline__ bf16x8 ld16(const bf16_t* p) { return *(const bf16x8*)p; }
__device__ __forceinline__ float fast_exp2(float x) { return __builtin_amdgcn_exp2f(x); }

template <int NH, int MODE, int KPI, bool PF>
__device__ __forceinline__ void attn_unit(int b, int hk, int r, int jb, int qb, const bf16_t* __restrict__ Qp, int ldq, const bf16_t* __restrict__ Kp, int ldk,
                                          const bf16_t* __restrict__ VTl, const bf16_t* __restrict__ VTc, int nkvh,
                                          const float* rpbs, const float* __restrict__ sink,
                                          bf16_t* __restrict__ Op, int ldo, int lane) {
  const float LOG2E = 1.4426950408889634f;
  const float SC = 0.125f * LOG2E;
  asm volatile("" : "+v"(lane));
  int ql = lane & 15, g = lane >> 4;
  int qrow0, q0 = 0;
  int nloc, lb0 = 0;
  if (MODE == 0) { qrow0 = b * S + r * 64 + 16 * jb; nloc = 8; }
  else if (MODE == 1) { qrow0 = T + b * CL + 16 * qb; nloc = 0; }
  else { q0 = 16 * qb; qrow0 = b * S + q0;
         int lo = (q0 - 128) >> 5, hi = (q0 + 143) >> 5; if (lo < 0) lo = 0; if (hi > 255) hi = 255; lb0 = lo; nloc = hi - lo + 1; }
  bf16x8 qf[NH][2];
#pragma unroll
  for (int hh = 0; hh < NH; ++hh)
#pragma unroll
    for (int s2 = 0; s2 < 2; ++s2)
      qf[hh][s2] = ld16(Qp + (size_t)(qrow0 + ql) * ldq + (hk * NH + hh) * 64 + 32 * s2 + 8 * g);
  f32x4_t o[NH][4]; float mrun[NH], lrun[NH];
#pragma unroll
  for (int hh = 0; hh < NH; ++hh) {
    mrun[hh] = -1e30f; lrun[hh] = 0.f;
#pragma unroll
    for (int dt = 0; dt < 4; ++dt) o[hh][dt] = (f32x4_t){0.f, 0.f, 0.f, 0.f};
  }
  int r_start = 0, blk_start = 0, c_lo = 0, qc = 0;
  if (MODE == 0) {
    r_start = min(max(r - 4, 0), 120);
    blk_start = min(max(16 * jb - 8, 0), 32);
    qc = 16 * jb + ql; c_lo = min(max(qc - 8, 0), 48);
  }
  if (MODE == 2 && KPI == 2) nloc = (nloc + 1) & ~1;
  int nit = (nloc + 8) / KPI;
#define ATT_DESC(kbx, krow0_, vtp_, vld_) \
    { bool il_ = (kbx) < nloc; int vt0_; \
      if (il_) { if (MODE == 0) { int rr_ = r_start + (kbx); krow0_ = b * S + rr_ * 64 + blk_start; vt0_ = rr_ * 64 + blk_start; } \
                 else { krow0_ = b * S + 32 * (lb0 + (kbx)); vt0_ = 32 * (lb0 + (kbx)); } \
                 vtp_ = VTl + ((size_t)(b * nkvh + hk) * 64) * S + vt0_; vld_ = S; } \
      else { int cb_ = (kbx) - nloc; krow0_ = T + b * CL + 32 * cb_; vt0_ = 32 * cb_; \
             vtp_ = VTc + ((size_t)(b * nkvh + hk) * 64) * CL + vt0_; vld_ = CL; } }
#define ATT_LOAD(kbx, KF, VF) \
    { int krow0; const bf16_t* vt; int vld; ATT_DESC(kbx, krow0, vt, vld) \
      _Pragma("unroll") for (int t = 0; t < 2; ++t) _Pragma("unroll") for (int s2 = 0; s2 < 2; ++s2) \
        KF[t][s2] = ld16(Kp + (size_t)(krow0 + 8 * (ql >> 2) + 4 * t + (ql & 3)) * ldk + hk * 64 + 32 * s2 + 8 * g); \
      _Pragma("unroll") for (int dt = 0; dt < 4; ++dt) VF[dt] = ld16(vt + (size_t)(16 * dt + ql) * vld + 8 * g); }
  bf16x8 kfn[PF ? KPI : 1][2][2], vfn[PF ? KPI : 1][4];
  if (PF) {
#pragma unroll
    for (int kk = 0; kk < KPI; ++kk) ATT_LOAD(kk, kfn[kk], vfn[kk])
  }
  for (int it = 0; it < nit; ++it) {
    bf16x8 kf[KPI][2][2], vf[KPI][4];
    if (PF) {
#pragma unroll
      for (int kk = 0; kk < KPI; ++kk) {
#pragma unroll
        for (int t = 0; t < 2; ++t)
#pragma unroll
          for (int s2 = 0; s2 < 2; ++s2) kf[kk][t][s2] = kfn[kk][t][s2];
#pragma unroll
        for (int dt = 0; dt < 4; ++dt) vf[kk][dt] = vfn[kk][dt];
      }
      if (it + 1 < nit) {
#pragma unroll
        for (int kk = 0; kk < KPI; ++kk) ATT_LOAD((it + 1) * KPI + kk, kfn[kk], vfn[kk])
      }
    } else {
#pragma unroll
      for (int kk = 0; kk < KPI; ++kk) ATT_LOAD(it * KPI + kk, kf[kk], vf[kk])
    }
    float bias[KPI][2][4]; bool valid[KPI][2][4];
#pragma unroll
    for (int kk = 0; kk < KPI; ++kk) {
      int kb = it * KPI + kk;
      bool is_loc = kb < nloc;
#pragma unroll
      for (int t = 0; t < 2; ++t)
#pragma unroll
        for (int i = 0; i < 4; ++i) {
          bias[kk][t][i] = 0.f; valid[kk][t][i] = true;
          if (MODE == 0 && is_loc) {
            int kc = blk_start + 8 * g + 4 * t + i;
            valid[kk][t][i] = (kc >= c_lo) && (kc < c_lo + 16);
            int dc = min(max(kc - qc, -15), 15) + 15;
            bias[kk][t][i] = rpbs[(hk * 15 + (r_start + kb - r + 7)) * 31 + dc];
          }
          if (MODE == 2 && is_loc) {
            int kpos = 32 * (lb0 + kb) + 8 * g + 4 * t + i; int dq = (q0 + ql) - kpos;
            bias[kk][t][i] = ((dq <= 128) && (dq >= -128)) ? 0.f : -1e30f;
          }
        }
    }
#pragma unroll
    for (int hh = 0; hh < NH; ++hh) {
      f32x4_t st[KPI][2];
#pragma unroll
      for (int kk = 0; kk < KPI; ++kk)
#pragma unroll
        for (int t = 0; t < 2; ++t) {
          st[kk][t] = (f32x4_t){0.f, 0.f, 0.f, 0.f};
          st[kk][t] = __builtin_amdgcn_mfma_f32_16x16x32_bf16(kf[kk][t][0], qf[hh][0], st[kk][t], 0, 0, 0);
          st[kk][t] = __builtin_amdgcn_mfma_f32_16x16x32_bf16(kf[kk][t][1], qf[hh][1], st[kk][t], 0, 0, 0);
        }
      float lg[KPI][2][4]; float bm = -1e30f;
#pragma unroll
      for (int kk = 0; kk < KPI; ++kk)
#pragma unroll
        for (int t = 0; t < 2; ++t)
#pragma unroll
          for (int i = 0; i < 4; ++i) {
            float v = (MODE == 0) ? (valid[kk][t][i] ? (st[kk][t][i] * SC + bias[kk][t][i]) : -1e30f) : fmaf(st[kk][t][i], SC, bias[kk][t][i]);
            lg[kk][t][i] = v; bm = fmaxf(bm, v);
          }
      bm = xrow16_max(bm);
      float mn = fmaxf(mrun[hh], bm);
      float alpha = fast_exp2(mrun[hh] - mn);
      mrun[hh] = mn;
      float ps = 0.f;
      bf16x8 pf[KPI];
#pragma unroll
      for (int kk = 0; kk < KPI; ++kk) {
        float pv[8];
#pragma unroll
        for (int t = 0; t < 2; ++t)
#pragma unroll
          for (int i = 0; i < 4; ++i) {
            float p = (MODE == 0) ? (valid[kk][t][i] ? fast_exp2(lg[kk][t][i] - mn) : 0.f) : fast_exp2(lg[kk][t][i] - mn);
            pv[4 * t + i] = p; ps += p;
          }
        typedef __attribute__((ext_vector_type(4))) unsigned u32x4;
        u32x4 uu = {pack2bf(pv[0], pv[1]), pack2bf(pv[2], pv[3]), pack2bf(pv[4], pv[5]), pack2bf(pv[6], pv[7])};
        pf[kk] = __builtin_bit_cast(bf16x8, uu);
      }
      lrun[hh] = lrun[hh] * alpha + ps;
#pragma unroll
      for (int dt = 0; dt < 4; ++dt) {
        o[hh][dt] *= alpha;
#pragma unroll
        for (int kk = 0; kk < KPI; ++kk)
          o[hh][dt] = __builtin_amdgcn_mfma_f32_16x16x32_bf16(vf[kk][dt], pf[kk], o[hh][dt], 0, 0, 0);
      }
      if (NH == 4 && KPI == 2 && (hh & 1)) __builtin_amdgcn_sched_barrier(0);
    }
  }
#undef ATT_LOAD
#undef ATT_DESC
#pragma unroll
  for (int hh = 0; hh < NH; ++hh) {
    float l = xrow16_sum(lrun[hh]);
    float m = mrun[hh];
    if (MODE == 2) {
      float sk = sink[hk * NH + hh] * LOG2E;
      float mf = fmaxf(m, sk);
      float a = fast_exp2(m - mf);
      l = l * a + fast_exp2(sk - mf);
#pragma unroll
      for (int dt = 0; dt < 4; ++dt) o[hh][dt] *= a;
    }
    float inv = 1.f / l;
    bf16_t* orow = Op + (size_t)(qrow0 + ql) * ldo + (hk * NH + hh) * 64 + 4 * g;
#pragma unroll
    for (int dt = 0; dt < 4; ++dt) {
      f32x4_t v = o[hh][dt] * inv;
      *(uint2*)(orow + 16 * dt) = make_uint2(pack2bf(v[0], v[1]), pack2bf(v[2], v[3]));
    }
  }
}

struct NaState { f32x4_t o[4][4]; float m[4], l[4]; };
template <int HB>
__device__ __forceinline__ void na_block(NaState& st, const bf16x8 (&qf)[4][2], const bf16x8 (&kf)[2][2], const bf16x8 (&vf)[4],
                                         const float* rpbrow  , int ql, int g) {
  const float SC = 0.125f * 1.4426950408889634f;
#pragma unroll
  for (int jb = 0; jb < 4; ++jb) {
    if (HB == 0 && jb == 3) continue;
    if (HB == 1 && jb == 0) continue;
    f32x4_t s2[2];
#pragma unroll
    for (int t = 0; t < 2; ++t) {
      s2[t] = (f32x4_t){0.f, 0.f, 0.f, 0.f};
      s2[t] = __builtin_amdgcn_mfma_f32_16x16x32_bf16(kf[t][0], qf[jb][0], s2[t], 0, 0, 0);
      s2[t] = __builtin_amdgcn_mfma_f32_16x16x32_bf16(kf[t][1], qf[jb][1], s2[t], 0, 0, 0);
    }
    float lg[8]; bool valid[8]; float bm = -1e30f;
#pragma unroll
    for (int t = 0; t < 2; ++t)
#pragma unroll
      for (int i = 0; i < 4; ++i) {
        float v;
        if (HB < 2) {
          int qc = 16 * jb + ql; int c_lo = min(max(qc - 8, 0), 48);
          int kc = 32 * HB + 8 * g + 4 * t + i;
          bool ok = (kc >= c_lo) && (kc < c_lo + 16);
          int dc = min(max(kc - qc, -15), 15) + 15;
          v = ok ? (s2[t][i] * SC + rpbrow[dc]) : -1e30f;
          valid[4 * t + i] = ok;
        } else { v = s2[t][i] * SC; valid[4 * t + i] = true; }
        lg[4 * t + i] = v; bm = fmaxf(bm, v);
      }
    bm = xrow16_max(bm);
    float mn = fmaxf(st.m[jb], bm);
    float alpha = fast_exp2(st.m[jb] - mn);
    st.m[jb] = mn;
    float ps = 0.f; float pv[8];
#pragma unroll
    for (int e = 0; e < 8; ++e) { float p = valid[e] ? fast_exp2(lg[e] - mn) : 0.f; pv[e] = p; ps += p; }
    st.l[jb] = st.l[jb] * alpha + ps;
    typedef __attribute__((ext_vector_type(4))) unsigned u32x4;
    u32x4 uu = {pack2bf(pv[0], pv[1]), pack2bf(pv[2], pv[3]), pack2bf(pv[4], pv[5]), pack2bf(pv[6], pv[7])};
    bf16x8 pf = __builtin_bit_cast(bf16x8, uu);
#pragma unroll
    for (int dt = 0; dt < 4; ++dt) {
      st.o[jb][dt] *= alpha;
      st.o[jb][dt] = __builtin_amdgcn_mfma_f32_16x16x32_bf16(vf[dt], pf, st.o[jb][dt], 0, 0, 0);
    }
    if (jb & 1) __builtin_amdgcn_sched_barrier(0);
  }
}
__device__ __forceinline__ void na_unit(int b, int h, int r, const bf16_t* __restrict__ FQKV, const bf16_t* __restrict__ VTl,
                                        const bf16_t* __restrict__ VTc, const float* rpbs, bf16_t* __restrict__ MIX, int lane) {
  asm volatile("" : "+v"(lane));
  int ql = lane & 15, g = lane >> 4;
  int qrow0 = b * S + r * 64;
  int r_start = min(max(r - 4, 0), 120);
  bf16x8 qf[4][2];
#pragma unroll
  for (int jb = 0; jb < 4; ++jb)
#pragma unroll
    for (int s2 = 0; s2 < 2; ++s2)
      qf[jb][s2] = ld16(FQKV + (size_t)(qrow0 + 16 * jb + ql) * 2048 + 512 + h * 64 + 32 * s2 + 8 * g);
  NaState st;
#pragma unroll
  for (int jb = 0; jb < 4; ++jb) {
    st.m[jb] = -1e30f; st.l[jb] = 0.f;
#pragma unroll
    for (int dt = 0; dt < 4; ++dt) st.o[jb][dt] = (f32x4_t){0.f, 0.f, 0.f, 0.f};
  }
  unsigned koff = (unsigned)((8 * (ql >> 2) + (ql & 3)) * 2048 + 1024 + h * 64 + 8 * g);
  unsigned voffl = (unsigned)(ql * S + 8 * g), voffc = (unsigned)(ql * CL + 8 * g);
  const bf16_t* vtl = VTl + (size_t)(b * 8 + h) * 64 * S;
  const bf16_t* vtc = VTc + (size_t)(b * 8 + h) * 64 * CL;
#define NA_LOADK(kb2, KF) { \
    int krow0_; \
    if ((kb2) < 16) krow0_ = b * S + (r_start + ((kb2) >> 1)) * 64 + 32 * ((kb2) & 1); \
    else krow0_ = T + b * CL + 32 * ((kb2) - 16); \
    const bf16_t* kb_ = FQKV + (size_t)krow0_ * 2048; \
    _Pragma("unroll") for (int t = 0; t < 2; ++t) _Pragma("unroll") for (int s2 = 0; s2 < 2; ++s2) \
      KF[t][s2] = ld16(kb_ + (koff + (unsigned)(t * 4 * 2048 + 32 * s2))); }
#define NA_LOADV(kb2, VF) { \
    if ((kb2) < 16) { const bf16_t* vt_ = vtl + (r_start + ((kb2) >> 1)) * 64 + 32 * ((kb2) & 1); \
      _Pragma("unroll") for (int dt = 0; dt < 4; ++dt) VF[dt] = ld16(vt_ + (voffl + (unsigned)(16 * dt * S))); } \
    else { const bf16_t* vt_ = vtc + 32 * ((kb2) - 16); \
      _Pragma("unroll") for (int dt = 0; dt < 4; ++dt) VF[dt] = ld16(vt_ + (voffc + (unsigned)(16 * dt * CL))); } }
  bf16x8 kfa[2][2], kfb[2][2], vfa[4], vfb[4];
  NA_LOADK(0, kfa) NA_LOADV(0, vfa)
#pragma unroll 1
  for (int rr = 0; rr < 8; ++rr) {
    const float* rpbrow = rpbs + (h * 15 + (r_start + rr - r + 7)) * 31;
    asm volatile("" : "+v"(lane)); ql = lane & 15; g = lane >> 4;
    koff = (unsigned)((8 * (ql >> 2) + (ql & 3)) * 2048 + 1024 + h * 64 + 8 * g); voffl = (unsigned)(ql * S + 8 * g); voffc = (unsigned)(ql * CL + 8 * g);
    NA_LOADK(2 * rr + 1, kfb) NA_LOADV(2 * rr + 1, vfb)
    na_block<0>(st, qf, kfa, vfa, rpbrow, ql, g);
    NA_LOADK(2 * rr + 2, kfa) NA_LOADV(2 * rr + 2, vfa)
    na_block<1>(st, qf, kfb, vfb, rpbrow, ql, g);
  }
#pragma unroll 1
  for (int cb = 0; cb < 8; cb += 2) {
    asm volatile("" : "+v"(lane)); ql = lane & 15; g = lane >> 4;
    koff = (unsigned)((8 * (ql >> 2) + (ql & 3)) * 2048 + 1024 + h * 64 + 8 * g); voffc = (unsigned)(ql * CL + 8 * g);
    NA_LOADK(16 + cb + 1, kfb) NA_LOADV(16 + cb + 1, vfb)
    na_block<2>(st, qf, kfa, vfa, rpbs, ql, g);
    if (cb + 2 < 8) { NA_LOADK(16 + cb + 2, kfa) NA_LOADV(16 + cb + 2, vfa) }
    na_block<2>(st, qf, kfb, vfb, rpbs, ql, g);
  }
#undef NA_LOADK
#undef NA_LOADV
  asm volatile("" : "+v"(lane)); ql = lane & 15; g = lane >> 4;
#pragma unroll
  for (int jb = 0; jb < 4; ++jb) {
    float inv = 1.f / xrow16_sum(st.l[jb]);
    bf16_t* orow = MIX + (size_t)(qrow0 + 16 * jb + ql) * 1024 + 512 + h * 64 + 4 * g;
#pragma unroll
    for (int dt = 0; dt < 4; ++dt) {
      f32x4_t v = st.o[jb][dt] * inv;
      *(uint2*)(orow + 16 * dt) = make_uint2(pack2bf(v[0], v[1]), pack2bf(v[2], v[3]));
    }
  }
}

__device__ __forceinline__ void ph_chan_dft(const float* __restrict__ F, const float* __restrict__ tab, float* __restrict__ PQ) {
  for (int gid = blockIdx.x * 256 + threadIdx.x; gid < R * 512; gid += gridDim.x * 256) {
    int row = gid >> 9; int col = gid & 511; int g = col >> 6, cp = col & 63;
    const float* f = F + (size_t)row * 2048 + g * 64;
    float p = 0.f, q = 0.f;
    for (int ch = 0; ch < 64; ++ch) {
      int idx = ((ch * cp) & 63) * 128;
      float x = f[ch];
      p += x * tab[idx]; q += x * tab[8192 + idx];
    }
    PQ[(size_t)row * 1024 + col] = p;
    PQ[(size_t)row * 1024 + 512 + col] = q;
  }
}

__device__ __forceinline__ void ph_na(const bf16_t* __restrict__ F, const float* __restrict__ rpb, bf16_t* __restrict__ MIX, float* sm) {
  int lane = threadIdx.x & 63, wave = __builtin_amdgcn_readfirstlane(threadIdx.x >> 6);
  float* sq = sm + wave * 1024; float* sp = sq + 64; int* stok = (int*)(sp + 384);
  int nitems = R * 8;
  for (int item0 = blockIdx.x * 4; item0 < nitems; item0 += gridDim.x * 4) {
    int item = item0 + wave;
    int h = item & 7; int row = item >> 3;
    bool is_ctx = row >= T;
    int b = is_ctx ? (row - T) / CL : row / S;
    __syncthreads();
    sq[lane] = bf2f(F[(size_t)row * 2048 + 512 + h * 64 + lane]);
    __syncthreads();
    int r = 0, c = 0, r_start = 0, c_start = 0;
    if (!is_ctx) { int t = row % S; r = t / 64; c = t % 64; r_start = min(max(r - 4, 0), 120); c_start = min(max(c - 8, 0), 48); }
    int nk = is_ctx ? 256 : 384;
    float lg[6]; float mx = -INFINITY;
#pragma unroll
    for (int kk = 0; kk < 6; ++kk) {
      int j = kk * 64 + lane; float s = -INFINITY; int tok = 0;
      if (j < nk) {
        float bias = 0.f;
        if (!is_ctx && j < 128) {
          int kr = j >> 4, kc = j & 15; int rr = r_start + kr, cc = c_start + kc;
          tok = b * S + rr * 64 + cc;
          int dc = min(max(cc - c, -15), 15) + 15;
          bias = rpb[(h * 15 + (rr - r + 7)) * 31 + dc];
        } else {
          int l = is_ctx ? j : j - 128; tok = T + b * CL + l;
        }
        const bf16_t* kp = F + (size_t)tok * 2048 + 1024 + h * 64;
        float acc = 0.f;
#pragma unroll 8
        for (int d = 0; d < 64; ++d) acc += sq[d] * bf2f(kp[d]);
        s = acc * 0.125f + bias;
      }
      lg[kk] = s; stok[j] = tok; mx = fmaxf(mx, s);
    }
    mx = wave_max(mx);
    float sum = 0.f;
#pragma unroll
    for (int kk = 0; kk < 6; ++kk) { float e = (kk * 64 + lane < nk) ? expf(lg[kk] - mx) : 0.f; lg[kk] = e; sum += e; }
    sum = wave_sum(sum);
    float inv = 1.f / sum;
#pragma unroll
    for (int kk = 0; kk < 6; ++kk) sp[kk * 64 + lane] = lg[kk] * inv;
    __syncthreads();
    float o = 0.f;
    for (int j = 0; j < nk; ++j) o += sp[j] * bf2f(F[(size_t)stok[j] * 2048 + 1536 + h * 64 + lane]);
    MIX[(size_t)row * 1024 + 512 + h * 64 + lane] = (bf16_t)f2bf(o);
  }
}

__device__ __forceinline__ void ph_rope(float* __restrict__ F1) {
  for (int gid = blockIdx.x * 256 + threadIdx.x; gid < T * 20 * 32; gid += gridDim.x * 256) {
    int i = gid & 31; int hh = (gid >> 5) % 20; int row = gid / (32 * 20);
    int t = row % S; float rowp = (float)(t / 64), colp = (float)(t % 64);
    int fi = i & 15;
    float inv_freq = powf(10000.0f, -(float)fi / 16.0f);
    float ang = (i < 16 ? rowp : colp) * inv_freq;
    float cs = cosf(ang), sn = sinf(ang);
    float* p = F1 + (size_t)row * 1536 + hh * 64;
    float x1 = p[i], x2 = p[i + 32];
    p[i] = x1 * cs - x2 * sn;
    p[i + 32] = x1 * sn + x2 * cs;
  }
}

__device__ __forceinline__ void ph_gqa(const float* __restrict__ F1, const float* __restrict__ sink, bf16_t* __restrict__ O, float* sm) {
  int lane = threadIdx.x & 63, wave = __builtin_amdgcn_readfirstlane(threadIdx.x >> 6);
  float* sq = sm + wave * 1280; float* sp = sq + 64; int* stok = (int*)(sp + 576);
  int nitems = T * 16;
  for (int item0 = blockIdx.x * 4; item0 < nitems; item0 += gridDim.x * 4) {
    int item = item0 + wave;
    int qh = item & 15; int row = item >> 4; int kvh = qh >> 2;
    int b = row / S; int t = row % S;
    __syncthreads();
    sq[lane] = F1[(size_t)row * 1536 + qh * 64 + lane];
    __syncthreads();
    float lg[9]; float mx = -INFINITY;
#pragma unroll
    for (int kk = 0; kk < 9; ++kk) {
      int j = kk * 64 + lane; float s = -INFINITY; int tok = 0; bool valid = false;
      if (j < 257) { int pos = t - 128 + j; valid = (pos >= 0 && pos < S); tok = b * S + pos; }
      else if (j < 513) { valid = true; tok = T + b * CL + (j - 257); }
      if (valid) {
        const float* kp = F1 + (size_t)tok * 1536 + 1024 + kvh * 64;
        float acc = 0.f;
#pragma unroll 8
        for (int d = 0; d < 64; ++d) acc += sq[d] * kp[d];
        s = acc * 0.125f;
      } else tok = 0;
      lg[kk] = s; stok[j] = tok; mx = fmaxf(mx, s);
    }
    mx = wave_max(mx);
    float sk = sink[qh];
    mx = fmaxf(mx, sk);
    float sum = 0.f;
#pragma unroll
    for (int kk = 0; kk < 9; ++kk) { float e = (lg[kk] == -INFINITY) ? 0.f : expf(lg[kk] - mx); lg[kk] = e; sum += e; }
    sum = wave_sum(sum) + expf(sk - mx);
    float inv = 1.f / sum;
#pragma unroll
    for (int kk = 0; kk < 9; ++kk) sp[kk * 64 + lane] = lg[kk] * inv;
    __syncthreads();
    float o = 0.f;
    for (int j = 0; j < 513; ++j) { float p = sp[j]; if (p != 0.f) o += p * F1[(size_t)stok[j] * 1536 + 1280 + kvh * 64 + lane]; }
    O[(size_t)row * 1024 + qh * 64 + lane] = (bf16_t)f2bf(o);
  }
}

__device__ __forceinline__ void wave_argmax(float& v, int& idx) {
#pragma unroll
  for (int off = 32; off; off >>= 1) {
    float ov = __shfl_xor(v, off); int oi = __shfl_xor(idx, off);
    if (ov > v || (ov == v && oi < idx)) { v = ov; idx = oi; }
  }
}
__device__ __forceinline__ void ph_peer_select_naive(const float* __restrict__ Q, const float* __restrict__ sk, int* __restrict__ EXP,
                                     float* __restrict__ GATE, int nrows, float* sm) {
  int lane = threadIdx.x & 63, wave = __builtin_amdgcn_readfirstlane(threadIdx.x >> 6);
  float* sq = sm + wave * 640; float* tops = sq + 256; int* topi = (int*)(tops + 32);
  for (int row0 = blockIdx.x * 4; row0 < nrows; row0 += gridDim.x * 4) {
    int row = row0 + wave;
    for (int h = 0; h < 8; ++h) {
      __syncthreads();
#pragma unroll
      for (int i = 0; i < 4; ++i) sq[lane + 64 * i] = Q[(size_t)row * 2048 + h * 256 + lane + 64 * i];
      __syncthreads();
      for (int p = 0; p < 2; ++p) {
        float s0 = 0.f, s1 = 0.f;
        const float* k0 = sk + ((size_t)((h * 2 + p) * 128 + lane)) * 128;
        const float* k1 = k0 + 64 * 128;
#pragma unroll 8
        for (int d = 0; d < 128; ++d) { float qv = sq[p * 128 + d]; s0 += qv * k0[d]; s1 += qv * k1[d]; }
        for (int i = 0; i < 16; ++i) {
          float v; int idx;
          if (s0 >= s1) { v = s0; idx = lane; } else { v = s1; idx = lane + 64; }
          wave_argmax(v, idx);
          if (lane == 0) { tops[p * 16 + i] = v; topi[p * 16 + i] = idx; }
          if (idx == lane) s0 = -INFINITY;
          if (idx == lane + 64) s1 = -INFINITY;
        }
      }
      __syncthreads();
      float cs[4];
#pragma unroll
      for (int i = 0; i < 4; ++i) { int ci = lane * 4 + i; cs[i] = tops[ci >> 4] + tops[16 + (ci & 15)]; }
      float bs[16]; int be[16];
#pragma unroll
      for (int k = 0; k < 16; ++k) {
        float v = cs[0]; int idx = lane * 4;
#pragma unroll
        for (int i = 1; i < 4; ++i) if (cs[i] > v) { v = cs[i]; idx = lane * 4 + i; }
        wave_argmax(v, idx);
        bs[k] = v; be[k] = topi[idx >> 4] * 128 + topi[16 + (idx & 15)];
#pragma unroll
        for (int i = 0; i < 4; ++i) if (idx == lane * 4 + i) cs[i] = -INFINITY;
      }
      float mxs = bs[0]; float sum = 0.f;
#pragma unroll
      for (int k = 0; k < 16; ++k) { bs[k] = expf(bs[k] - mxs); sum += bs[k]; }
      float inv = 1.f / sum;
      if (lane == 0) {
#pragma unroll
        for (int k = 0; k < 16; ++k) { EXP[(size_t)row * 128 + h * 16 + k] = be[k]; GATE[(size_t)row * 128 + h * 16 + k] = bs[k] * inv; }
      }
    }
  }
}

__device__ __forceinline__ void unpack8(uint4 v, float* f) {
  f[0] = __uint_as_float(v.x << 16); f[1] = __uint_as_float(v.x & 0xffff0000u);
  f[2] = __uint_as_float(v.y << 16); f[3] = __uint_as_float(v.y & 0xffff0000u);
  f[4] = __uint_as_float(v.z << 16); f[5] = __uint_as_float(v.z & 0xffff0000u);
  f[6] = __uint_as_float(v.w << 16); f[7] = __uint_as_float(v.w & 0xffff0000u);
}
__device__ __forceinline__ void ph_peer_gather(bf16_t* __restrict__ H, const int* __restrict__ EXP, const float* __restrict__ GATE,
                               const bf16_t* __restrict__ U, const bf16_t* __restrict__ V,
                               const float* __restrict__ xin, const float* __restrict__ M, int layer,
                               const float* __restrict__ g, const float* __restrict__ bb, float* __restrict__ xout,
                               bool write_next, int nrows) {
  int lane = threadIdx.x & 63, wave = __builtin_amdgcn_readfirstlane(threadIdx.x >> 6);
  for (int row = blockIdx.x * 4 + wave; row < nrows; row += gridDim.x * 4) {
    float hreg[16];
    {
      const uint4* hp = (const uint4*)(H + (size_t)row * D + 8 * lane);
      unpack8(hp[0], hreg); unpack8(hp[64], hreg + 8);
    }
    float acc[16];
#pragma unroll
    for (int i = 0; i < 16; ++i) acc[i] = 0.f;
    int e_lo = EXP[(size_t)row * 128 + lane], e_hi = EXP[(size_t)row * 128 + 64 + lane];
    float g_lo = GATE[(size_t)row * 128 + lane], g_hi = GATE[(size_t)row * 128 + 64 + lane];
    uint4 ua[4], ub[4], va[4], vb[4];
#pragma unroll
    for (int i = 0; i < 4; ++i) {
      int e = __builtin_amdgcn_readlane(e_lo, i);
      const uint4* up = (const uint4*)(U + (size_t)e * D + 8 * lane); ua[i] = up[0]; ub[i] = up[64];
    }
#pragma unroll 1
    for (int b = 0; b < 32; ++b) {
      int k0 = 4 * b;
      int ev = (b < 16) ? e_lo : e_hi; float gv = (b < 16) ? g_lo : g_hi;
      int en = (b + 1 < 16) ? e_lo : e_hi;
      float gt[4];
#pragma unroll
      for (int i = 0; i < 4; ++i) {
        int e = __builtin_amdgcn_readlane(ev, (k0 + i) & 63);
        gt[i] = __uint_as_float(__builtin_amdgcn_readlane(__float_as_uint(gv), (k0 + i) & 63));
        const uint4* vp = (const uint4*)(V + (size_t)e * D + 8 * lane); va[i] = vp[0]; vb[i] = vp[64];
      }
      float a[4];
#pragma unroll
      for (int i = 0; i < 4; ++i) {
        float f[16]; unpack8(ua[i], f); unpack8(ub[i], f + 8);
        float sacc = 0.f;
#pragma unroll
        for (int j = 0; j < 16; ++j) sacc += f[j] * hreg[j];
        a[i] = sacc;
      }
      if (b + 1 < 32) {
#pragma unroll
        for (int i = 0; i < 4; ++i) {
          int e = __builtin_amdgcn_readlane(en, (k0 + 4 + i) & 63);
          const uint4* up = (const uint4*)(U + (size_t)e * D + 8 * lane); ua[i] = up[0]; ub[i] = up[64];
        }
      }
#pragma unroll
      for (int i = 0; i < 4; ++i) a[i] = wave_sum(a[i]);
#pragma unroll
      for (int i = 0; i < 4; ++i) {
        float w = gt[i] * 0.5f * a[i] * (1.f + erff(a[i] * 0.70710678118654752f));
        float f[16]; unpack8(va[i], f); unpack8(vb[i], f + 8);
#pragma unroll
        for (int j = 0; j < 16; ++j) acc[j] += w * f[j];
      }
    }
    const float* m = M + ((size_t)layer * 3 + mod_index(row)) * 6144;
    const float* xr = xin + (size_t)row * D;
    float v[16];
#pragma unroll
    for (int hh = 0; hh < 2; ++hh) {
      int d0 = hh * 512 + 8 * lane;
      float4 x0 = *(const float4*)(xr + d0), x1 = *(const float4*)(xr + d0 + 4);
      float4 m0 = *(const float4*)(m + 5 * D + d0), m1 = *(const float4*)(m + 5 * D + d0 + 4);
      v[hh * 8 + 0] = DN_ALPHA * x0.x + m0.x * acc[hh * 8 + 0]; v[hh * 8 + 1] = DN_ALPHA * x0.y + m0.y * acc[hh * 8 + 1];
      v[hh * 8 + 2] = DN_ALPHA * x0.z + m0.z * acc[hh * 8 + 2]; v[hh * 8 + 3] = DN_ALPHA * x0.w + m0.w * acc[hh * 8 + 3];
      v[hh * 8 + 4] = DN_ALPHA * x1.x + m1.x * acc[hh * 8 + 4]; v[hh * 8 + 5] = DN_ALPHA * x1.y + m1.y * acc[hh * 8 + 5];
      v[hh * 8 + 6] = DN_ALPHA * x1.z + m1.z * acc[hh * 8 + 6]; v[hh * 8 + 7] = DN_ALPHA * x1.w + m1.w * acc[hh * 8 + 7];
    }
    float s = 0.f;
#pragma unroll
    for (int j = 0; j < 16; ++j) s += v[j];
    float mu = wave_sum(s) * (1.f / D);
    float q = 0.f;
#pragma unroll
    for (int j = 0; j < 16; ++j) { float d = v[j] - mu; q += d * d; }
    float rs = rsqrtf(wave_sum(q) * (1.f / D) + LN_EPS);
    float y[16];
#pragma unroll
    for (int hh = 0; hh < 2; ++hh) {
      int d0 = hh * 512 + 8 * lane;
#pragma unroll
      for (int j = 0; j < 8; ++j) y[hh * 8 + j] = (v[hh * 8 + j] - mu) * rs * g[d0 + j] + bb[d0 + j];
      *(float4*)(xout + (size_t)row * D + d0) = make_float4(y[hh * 8], y[hh * 8 + 1], y[hh * 8 + 2], y[hh * 8 + 3]);
      *(float4*)(xout + (size_t)row * D + d0 + 4) = make_float4(y[hh * 8 + 4], y[hh * 8 + 5], y[hh * 8 + 6], y[hh * 8 + 7]);
    }
    if (write_next) {
      const float* mn = M + ((size_t)(layer + 1) * 3 + mod_index(row)) * 6144;
      float s2 = 0.f;
#pragma unroll
      for (int j = 0; j < 16; ++j) s2 += y[j];
      float mu2 = wave_sum(s2) * (1.f / D);
      float q2 = 0.f;
#pragma unroll
      for (int j = 0; j < 16; ++j) { float d = y[j] - mu2; q2 += d * d; }
      float rs2 = rsqrtf(wave_sum(q2) * (1.f / D) + LN_EPS);
#pragma unroll
      for (int hh = 0; hh < 2; ++hh) {
        int d0 = hh * 512 + 8 * lane;
        float o[8];
#pragma unroll
        for (int j = 0; j < 8; ++j) o[j] = (y[hh * 8 + j] - mu2) * rs2 * (1.f + mn[D + d0 + j]) + mn[d0 + j];
        *(uint4*)(H + (size_t)row * D + d0) = make_uint4(pack2bf(o[0], o[1]), pack2bf(o[2], o[3]), pack2bf(o[4], o[5]), pack2bf(o[6], o[7]));
      }
    }
  }
}


__device__ __forceinline__ void quant_row(const float* __restrict__ src, unsigned char* __restrict__ dst, float* __restrict__ scale, int row, int lane) {
  const float4* sp = (const float4*)(src + (size_t)row * D + 16 * lane);
  float4 v0 = sp[0], v1 = sp[1], v2 = sp[2], v3 = sp[3];
  float x[16] = {v0.x, v0.y, v0.z, v0.w, v1.x, v1.y, v1.z, v1.w, v2.x, v2.y, v2.z, v2.w, v3.x, v3.y, v3.z, v3.w};
  float am = 0.f;
#pragma unroll
  for (int j = 0; j < 16; ++j) am = fmaxf(am, fabsf(x[j]));
  am = wave_max(am);
  float inv = am > 0.f ? 127.f / am : 0.f;
  unsigned wv[4];
#pragma unroll
  for (int k = 0; k < 4; ++k) {
    unsigned w = 0;
#pragma unroll
    for (int j = 0; j < 4; ++j) {
      int q = (int)rintf(x[4 * k + j] * inv);
      w |= ((unsigned)q & 0xffu) << (8 * j);
    }
    wv[k] = w;
  }
  *(uint4*)(dst + ((size_t)(row >> 14) * 8 + (lane >> 3)) * ((size_t)16384 * 128) + (size_t)(row & 16383) * 128 + 16 * (lane & 7)) = make_uint4(wv[0], wv[1], wv[2], wv[3]);
  if (lane == 0) scale[row] = am * (1.f / 127.f);
}
__device__ __forceinline__ void quant_fill(unsigned* ctr, int layer, unsigned lo, unsigned hi, const float* __restrict__ pu, const float* __restrict__ pv,
                                           unsigned char* __restrict__ U8, unsigned char* __restrict__ V8, float* __restrict__ USC,
                                           float* __restrict__ VSC, unsigned* sh) {
  int lane = threadIdx.x & 63, wave = __builtin_amdgcn_readfirstlane(threadIdx.x >> 6);
  for (;;) {
    __syncthreads();
    if (threadIdx.x == 0) *sh = lo + __hip_atomic_fetch_add(ctr, 1u, __ATOMIC_RELAXED, __HIP_MEMORY_SCOPE_AGENT);
    __syncthreads();
    unsigned c = *sh;
    if (c >= hi) break;
    const float* src = (c >> 8) ? pv : pu; unsigned char* dst = (c >> 8) ? V8 : U8; float* sc = (c >> 8) ? VSC : USC;
    int r0 = layer * 16384 + (int)(c & 255u) * 64 + wave * 16;
#pragma unroll 4
    for (int i = 0; i < 16; ++i) quant_row(src, dst, sc, r0 + i, lane);
  }
  __syncthreads();
}
__device__ __forceinline__ void unpack_u8x16(uint4 v, float* f) {
  unsigned w[4] = {v.x, v.y, v.z, v.w};
#pragma unroll
  for (int k = 0; k < 4; ++k) {
    f[4 * k + 0] = (float)(w[k] & 0xffu); f[4 * k + 1] = (float)((w[k] >> 8) & 0xffu);
    f[4 * k + 2] = (float)((w[k] >> 16) & 0xffu); f[4 * k + 3] = (float)(w[k] >> 24);
  }
}
__device__ __forceinline__ void ph_peer_gather8(bf16_t* __restrict__ H, const int* __restrict__ EXP, const float* __restrict__ GATE,
                               const unsigned char* __restrict__ U8, const float* __restrict__ USC,
                               const unsigned char* __restrict__ V8, const float* __restrict__ VSC,
                               const float* __restrict__ xin, const float* __restrict__ M, int layer,
                               const float* __restrict__ g, const float* __restrict__ bb, float* __restrict__ xout,
                               bool write_next, int nrows) {
  int lane = threadIdx.x & 63, wave = __builtin_amdgcn_readfirstlane(threadIdx.x >> 6);
  for (int row = blockIdx.x * 4 + wave; row < nrows; row += gridDim.x * 4) {
    float hreg[16];
    {
      const uint4* hp = (const uint4*)(H + (size_t)row * D + 16 * lane);
      unpack8(hp[0], hreg); unpack8(hp[1], hreg + 8);
    }
    float hs = 0.f;
#pragma unroll
    for (int j = 0; j < 16; ++j) hs += hreg[j];
    float hsum128 = 128.f * wave_sum(hs);
    float acc[16];
#pragma unroll
    for (int i = 0; i < 16; ++i) acc[i] = 0.f;
    float wsum = 0.f;
    int e_lo = EXP[(size_t)row * 128 + lane], e_hi = EXP[(size_t)row * 128 + 64 + lane];
    float g_lo = GATE[(size_t)row * 128 + lane], g_hi = GATE[(size_t)row * 128 + 64 + lane];
    float us_lo = USC[e_lo], us_hi = USC[e_hi], vs_lo = VSC[e_lo], vs_hi = VSC[e_hi];
    uint4 ua[8], va[8];
#pragma unroll
    for (int i = 0; i < 8; ++i) {
      int e = __builtin_amdgcn_readlane(e_lo, i);
      ua[i] = *(const uint4*)(U8 + (size_t)e * D + 16 * lane);
    }
#pragma unroll 1
    for (int b = 0; b < 16; ++b) {
      int k0 = 8 * b;
      bool lo = b < 8, lon = (b + 1) < 8;
      int ev = lo ? e_lo : e_hi; float gv = lo ? g_lo : g_hi; float usv = lo ? us_lo : us_hi; float vsv = lo ? vs_lo : vs_hi;
      int en = lon ? e_lo : e_hi;
      float gt[8], usc[8], vsc[8];
#pragma unroll
      for (int i = 0; i < 8; ++i) {
        int li = (k0 + i) & 63;
        int e = __builtin_amdgcn_readlane(ev, li);
        gt[i] = __uint_as_float(__builtin_amdgcn_readlane(__float_as_uint(gv), li));
        usc[i] = __uint_as_float(__builtin_amdgcn_readlane(__float_as_uint(usv), li));
        vsc[i] = __uint_as_float(__builtin_amdgcn_readlane(__float_as_uint(vsv), li));
        va[i] = *(const uint4*)(V8 + (size_t)e * D + 16 * lane);
      }
      float a[8];
#pragma unroll
      for (int i = 0; i < 8; ++i) {
        float f[16]; unpack_u8x16(ua[i], f);
        float sacc = 0.f;
#pragma unroll
        for (int j = 0; j < 16; ++j) sacc += f[j] * hreg[j];
        a[i] = sacc;
      }
      if (b + 1 < 16) {
#pragma unroll
        for (int i = 0; i < 8; ++i) {
          int e = __builtin_amdgcn_readlane(en, (k0 + 8 + i) & 63);
          ua[i] = *(const uint4*)(U8 + (size_t)e * D + 16 * lane);
        }
      }
#pragma unroll
      for (int i = 0; i < 8; ++i) a[i] = (wave_sum(a[i]) - hsum128) * usc[i];
#pragma unroll
      for (int i = 0; i < 8; ++i) {
        float w = gt[i] * 0.5f * a[i] * (1.f + erff(a[i] * 0.70710678118654752f)) * vsc[i];
        wsum += w;
        float f[16]; unpack_u8x16(va[i], f);
#pragma unroll
        for (int j = 0; j < 16; ++j) acc[j] += w * f[j];
      }
    }
    float corr = 128.f * wsum;
#pragma unroll
    for (int j = 0; j < 16; ++j) acc[j] -= corr;
    const float* m = M + ((size_t)layer * 3 + mod_index(row)) * 6144;
    const float* xr = xin + (size_t)row * D + 16 * lane;
    const float* m5 = m + 5 * D + 16 * lane;
    float v[16];
#pragma unroll
    for (int q4 = 0; q4 < 4; ++q4) {
      float4 x0 = *(const float4*)(xr + 4 * q4); float4 m0 = *(const float4*)(m5 + 4 * q4);
      v[4 * q4 + 0] = DN_ALPHA * x0.x + m0.x * acc[4 * q4 + 0]; v[4 * q4 + 1] = DN_ALPHA * x0.y + m0.y * acc[4 * q4 + 1];
      v[4 * q4 + 2] = DN_ALPHA * x0.z + m0.z * acc[4 * q4 + 2]; v[4 * q4 + 3] = DN_ALPHA * x0.w + m0.w * acc[4 * q4 + 3];
    }
    float s = 0.f;
#pragma unroll
    for (int j = 0; j < 16; ++j) s += v[j];
    float mu = wave_sum(s) * (1.f / D);
    float q = 0.f;
#pragma unroll
    for (int j = 0; j < 16; ++j) { float d = v[j] - mu; q += d * d; }
    float rs = rsqrtf(wave_sum(q) * (1.f / D) + LN_EPS);
    float y[16];
    {
      const float* gp = g + 16 * lane; const float* bp = bb + 16 * lane;
      float* op = xout + (size_t)row * D + 16 * lane;
#pragma unroll
      for (int q4 = 0; q4 < 4; ++q4) {
        float4 g4 = *(const float4*)(gp + 4 * q4); float4 b4 = *(const float4*)(bp + 4 * q4);
        y[4 * q4 + 0] = (v[4 * q4 + 0] - mu) * rs * g4.x + b4.x; y[4 * q4 + 1] = (v[4 * q4 + 1] - mu) * rs * g4.y + b4.y;
        y[4 * q4 + 2] = (v[4 * q4 + 2] - mu) * rs * g4.z + b4.z; y[4 * q4 + 3] = (v[4 * q4 + 3] - mu) * rs * g4.w + b4.w;
        *(float4*)(op + 4 * q4) = make_float4(y[4 * q4], y[4 * q4 + 1], y[4 * q4 + 2], y[4 * q4 + 3]);
      }
    }
    if (write_next) {
      const float* mn = M + ((size_t)(layer + 1) * 3 + mod_index(row)) * 6144 + 16 * lane;
      float s2 = 0.f;
#pragma unroll
      for (int j = 0; j < 16; ++j) s2 += y[j];
      float mu2 = wave_sum(s2) * (1.f / D);
      float q2 = 0.f;
#pragma unroll
      for (int j = 0; j < 16; ++j) { float d = y[j] - mu2; q2 += d * d; }
      float rs2 = rsqrtf(wave_sum(q2) * (1.f / D) + LN_EPS);
      float o[16];
#pragma unroll
      for (int j = 0; j < 16; ++j) o[j] = (y[j] - mu2) * rs2 * (1.f + mn[D + j]) + mn[j];
      uint4* hp = (uint4*)(H + (size_t)row * D + 16 * lane);
      hp[0] = make_uint4(pack2bf(o[0], o[1]), pack2bf(o[2], o[3]), pack2bf(o[4], o[5]), pack2bf(o[6], o[7]));
      hp[1] = make_uint4(pack2bf(o[8], o[9]), pack2bf(o[10], o[11]), pack2bf(o[12], o[13]), pack2bf(o[14], o[15]));
    }
  }
}


__device__ __forceinline__ void ph_ada2(const float* __restrict__ c, const float* __restrict__ c_ctx, const float* __restrict__ ada_w,
                                        const float* __restrict__ ada_b, float* __restrict__ M, float* sm) {
  int tid = threadIdx.x, lane = tid & 63, wave = __builtin_amdgcn_readfirstlane(tid >> 6);
  float* sv = sm;
  float* red = sm + 3072;
  bool filled = false;
  GRID_LOOP(u, 192) {
    if (!filled) {
      for (int i = tid; i < 3072; i += 256) {
        int idx = i >> 10, k = i & 1023;
        float x = idx < 2 ? c[idx * D + k] : c_ctx[k];
        sv[i] = x / (1.f + expf(-x));
      }
      filled = true;
    }
    __syncthreads();
    int layer = u / 96, c0 = (u % 96) * 64;
    const float* w = ada_w + (size_t)layer * D * 6144 + c0 + lane;
    float a0 = 0.f, a1 = 0.f, a2 = 0.f;
    int kb = wave * 256;
#pragma unroll 16
    for (int k = 0; k < 256; ++k) {
      float wv = w[(size_t)(kb + k) * 6144];
      a0 += sv[kb + k] * wv; a1 += sv[1024 + kb + k] * wv; a2 += sv[2048 + kb + k] * wv;
    }
    red[(wave * 3 + 0) * 64 + lane] = a0; red[(wave * 3 + 1) * 64 + lane] = a1; red[(wave * 3 + 2) * 64 + lane] = a2;
    __syncthreads();
    if (wave < 3) {
      float r = red[(0 * 3 + wave) * 64 + lane] + red[(1 * 3 + wave) * 64 + lane] + red[(2 * 3 + wave) * 64 + lane] + red[(3 * 3 + wave) * 64 + lane];
      M[((size_t)layer * 3 + wave) * 6144 + c0 + lane] = r + ada_b[layer * 6144 + c0 + lane];
    }
  }
  __syncthreads();
}

__device__ __forceinline__ void ph_post_mod(const float* __restrict__ xa, const float* __restrict__ xb, const bf16_t* __restrict__ Y,
                                            const float* __restrict__ M, int layer, int jres, int mlayer, int jshift, int jscale, bool do_mod,
                                            const float* __restrict__ g, const float* __restrict__ bb,
                                            float* __restrict__ xout, bf16_t* __restrict__ H, int nrows) {
  int lane = threadIdx.x & 63, wave = __builtin_amdgcn_readfirstlane(threadIdx.x >> 6);
  for (int row = blockIdx.x * 4 + wave; row < nrows; row += gridDim.x * 4) {
    const float* xr = (row < T ? xa + (size_t)row * D : xb + (size_t)(row - T) * D) + 16 * lane;
    const float* m = M + ((size_t)layer * 3 + mod_index(row)) * 6144 + 16 * lane;
    float yv[16];
    {
      const uint4* yp = (const uint4*)(Y + (size_t)row * D + 16 * lane);
      unpack8(yp[0], yv); unpack8(yp[1], yv + 8);
    }
    float v[16];
#pragma unroll
    for (int q4 = 0; q4 < 4; ++q4) {
      float4 x0 = *(const float4*)(xr + 4 * q4); float4 m0 = *(const float4*)(m + jres * D + 4 * q4);
      v[4 * q4 + 0] = DN_ALPHA * x0.x + m0.x * yv[4 * q4 + 0]; v[4 * q4 + 1] = DN_ALPHA * x0.y + m0.y * yv[4 * q4 + 1];
      v[4 * q4 + 2] = DN_ALPHA * x0.z + m0.z * yv[4 * q4 + 2]; v[4 * q4 + 3] = DN_ALPHA * x0.w + m0.w * yv[4 * q4 + 3];
    }
    float s = 0.f;
#pragma unroll
    for (int j = 0; j < 16; ++j) s += v[j];
    float mu = wave_sum(s) * (1.f / D);
    float q = 0.f;
#pragma unroll
    for (int j = 0; j < 16; ++j) { float d = v[j] - mu; q += d * d; }
    float rs = rsqrtf(wave_sum(q) * (1.f / D) + LN_EPS);
    float y[16];
    {
      const float* gp = g + 16 * lane; const float* bp = bb + 16 * lane;
      float* op = xout + (size_t)row * D + 16 * lane;
#pragma unroll
      for (int q4 = 0; q4 < 4; ++q4) {
        float4 g4 = *(const float4*)(gp + 4 * q4); float4 b4 = *(const float4*)(bp + 4 * q4);
        y[4 * q4 + 0] = (v[4 * q4 + 0] - mu) * rs * g4.x + b4.x; y[4 * q4 + 1] = (v[4 * q4 + 1] - mu) * rs * g4.y + b4.y;
        y[4 * q4 + 2] = (v[4 * q4 + 2] - mu) * rs * g4.z + b4.z; y[4 * q4 + 3] = (v[4 * q4 + 3] - mu) * rs * g4.w + b4.w;
        *(float4*)(op + 4 * q4) = make_float4(y[4 * q4], y[4 * q4 + 1], y[4 * q4 + 2], y[4 * q4 + 3]);
      }
    }
    if (do_mod) {
      const float* mm = M + ((size_t)mlayer * 3 + mod_index(row)) * 6144 + 16 * lane;
      float s2 = 0.f;
#pragma unroll
      for (int j = 0; j < 16; ++j) s2 += y[j];
      float mu2 = wave_sum(s2) * (1.f / D);
      float q2 = 0.f;
#pragma unroll
      for (int j = 0; j < 16; ++j) { float d = y[j] - mu2; q2 += d * d; }
      float rs2 = rsqrtf(wave_sum(q2) * (1.f / D) + LN_EPS);
      float o[16];
#pragma unroll
      for (int j = 0; j < 16; ++j) o[j] = (y[j] - mu2) * rs2 * (1.f + mm[jscale * D + j]) + mm[jshift * D + j];
      uint4* hp = (uint4*)(H + (size_t)row * D + 16 * lane);
      hp[0] = make_uint4(pack2bf(o[0], o[1]), pack2bf(o[2], o[3]), pack2bf(o[4], o[5]), pack2bf(o[6], o[7]));
      hp[1] = make_uint4(pack2bf(o[8], o[9]), pack2bf(o[10], o[11]), pack2bf(o[12], o[13]), pack2bf(o[14], o[15]));
    }
  }
}


template <int CTRL> __device__ __forceinline__ float dpp_add(float x) { return x + dpp_mov<CTRL>(x); }
__device__ __forceinline__ float sum8(float v) {
  v = dpp_add<0xB1>(v); v = dpp_add<0x4E>(v); v = dpp_add<0x141>(v); return v;
}
typedef _Float16 half2_t __attribute__((ext_vector_type(2)));
__device__ __forceinline__ float dot2h(unsigned a, unsigned b, float c) {
  return __builtin_amdgcn_fdot2(__builtin_bit_cast(half2_t, a), __builtin_bit_cast(half2_t, b), c, false);
}
__device__ __forceinline__ unsigned pkh(float a, float b) { return __builtin_bit_cast(unsigned, __builtin_amdgcn_cvt_pkrtz(a, b)); }
__device__ __forceinline__ void load_e16(const int* __restrict__ EXP, int t, int g8, int (&e)[16]) {
  const int4* ep = (const int4*)(EXP + (size_t)t * 128 + 16 * g8);
  int4 a = ep[0], b = ep[1], c = ep[2], d = ep[3];
  e[0] = a.x; e[1] = a.y; e[2] = a.z; e[3] = a.w; e[4] = b.x; e[5] = b.y; e[6] = b.z; e[7] = b.w;
  e[8] = c.x; e[9] = c.y; e[10] = c.z; e[11] = c.w; e[12] = d.x; e[13] = d.y; e[14] = d.z; e[15] = d.w;
}
#define U_TOKEN(tt, UV, UVN, EUSE, ELD, HUSE, HLD) { \
    int tnn_ = min((tt) + 2 * st, nrows - 1); \
    load_e16(EXP, tnn_, g8, ELD); \
    HLD[0] = *(const uint4*)(hb + (size_t)tnn_ * D); HLD[1] = *(const uint4*)(hb + (size_t)tnn_ * D + 8); \
    __builtin_amdgcn_sched_barrier(0); \
    _Pragma("unroll") for (int i = 0; i < 16; ++i) UVN[i] = *(const uint4*)(ubs + (((unsigned)EUSE[i] << 7) + loff)); \
    __builtin_amdgcn_sched_barrier(0); \
    float h16[16]; unpack8(HUSE[0], h16); unpack8(HUSE[1], h16 + 8); \
    float hm = 0.f; \
    _Pragma("unroll") for (int j = 0; j < 16; ++j) hm = fmaxf(hm, fabsf(h16[j])); \
    hm = fmaxf(hm, dpp_mov<0xB1>(hm)); hm = fmaxf(hm, dpp_mov<0x4E>(hm)); hm = fmaxf(hm, dpp_mov<0x141>(hm)); \
    float hinv = hm > 0.f ? 127.f / hm : 0.f; float hsc = hm * (1.f / 127.f); \
    int hq[4]; \
    _Pragma("unroll") for (int k = 0; k < 4; ++k) { unsigned w_ = 0; \
      _Pragma("unroll") for (int j = 0; j < 4; ++j) w_ = __builtin_amdgcn_cvt_pk_u8_f32(rintf(h16[4 * k + j] * hinv) + 128.f, j, w_); \
      hq[k] = (int)(w_ ^ 0x80808080u); }        \
    float k0 = 0.f, k1 = 0.f; \
    _Pragma("unroll") for (int i = 0; i < 16; ++i) { \
      int p_ = __builtin_amdgcn_sdot4((int)UV[i].x, hq[0], 0, false); p_ = __builtin_amdgcn_sdot4((int)UV[i].y, hq[1], p_, false); \
      p_ = __builtin_amdgcn_sdot4((int)UV[i].z, hq[2], p_, false); p_ = __builtin_amdgcn_sdot4((int)UV[i].w, hq[3], p_, false); \
      float p = sum8((float)p_) * hsc; \
      if ((i >> 1) == j8) { if (i & 1) k1 = p; else k0 = p; } } \
    *(float2*)(PA + ((size_t)(tt) * 8 + x) * 128 + 16 * g8 + 2 * j8) = make_float2(k0, k1); }
__device__ __forceinline__ void ph_peer_u(const bf16_t* __restrict__ H, const int* __restrict__ EXP, const unsigned char* __restrict__ U8,
                                          float* __restrict__ PA, int nrows) {
  int lane = threadIdx.x & 63, wave = __builtin_amdgcn_readfirstlane(threadIdx.x >> 6);
  int x = blockIdx.x & 7; int nb8 = gridDim.x >> 3;
  if ((int)(blockIdx.x >> 3) >= nb8) return;
  int j8 = lane & 7, g8 = lane >> 3;
  const int st = nb8 * 4;
  int t = (blockIdx.x >> 3) * 4 + wave;
  if (t >= nrows) return;
  const unsigned char* ubs = U8 + (size_t)x * ((size_t)16384 * 128);
  const unsigned loff = 16u * (unsigned)j8;
  const bf16_t* hb = H + 128 * x + 16 * j8;
  int eA[16], eB[16]; uint4 hA[2], hB[2], uvA[16], uvB[16];
  {
    int e0[16]; load_e16(EXP, t, g8, e0);
#pragma unroll
    for (int i = 0; i < 16; ++i) uvA[i] = *(const uint4*)(ubs + (((unsigned)e0[i] << 7) + loff));
    hA[0] = *(const uint4*)(hb + (size_t)t * D); hA[1] = *(const uint4*)(hb + (size_t)t * D + 8);
    int tn = min(t + st, nrows - 1);
    load_e16(EXP, tn, g8, eA);
    hB[0] = *(const uint4*)(hb + (size_t)tn * D); hB[1] = *(const uint4*)(hb + (size_t)tn * D + 8);
  }
#pragma unroll 1
  for (; t < nrows; t += 2 * st) {
    uint4 hC[2];
    U_TOKEN(t, uvA, uvB, eA, eB, hA, hC)
    if (t + st < nrows) {
      U_TOKEN(t + st, uvB, uvA, eB, eA, hB, hA)
    }
    hB[0] = hA[0]; hB[1] = hA[1]; hA[0] = hC[0]; hA[1] = hC[1];
  }
}
__device__ __forceinline__ void ph_peer_w(const float* __restrict__ PA, const int* __restrict__ EXP, const float* __restrict__ GATE,
                                          const float* __restrict__ USC, const float* __restrict__ VSC, unsigned* __restrict__ WQ,
                                          float* __restrict__ SW, int nrows) {
  int lane = threadIdx.x & 63, wave = __builtin_amdgcn_readfirstlane(threadIdx.x >> 6);
  int l4 = lane & 31;
  for (int t = blockIdx.x * 4 + wave; t < nrows; t += gridDim.x * 4) {
    int4 e = *(const int4*)(EXP + (size_t)t * 128 + 4 * l4);
    float4 gt = *(const float4*)(GATE + (size_t)t * 128 + 4 * l4);
    float a[4] = {0.f, 0.f, 0.f, 0.f};
#pragma unroll
    for (int xs = 0; xs < 8; ++xs) { float4 p = *(const float4*)(PA + ((size_t)t * 8 + xs) * 128 + 4 * l4); a[0] += p.x; a[1] += p.y; a[2] += p.z; a[3] += p.w; }
    int ee[4] = {e.x, e.y, e.z, e.w}; float gg[4] = {gt.x, gt.y, gt.z, gt.w}; float w[4]; float wm = 0.f;
#pragma unroll
    for (int j = 0; j < 4; ++j) {
      float av = a[j] * USC[ee[j]];
      w[j] = gg[j] * 0.5f * av * (1.f + erff(av * 0.70710678118654752f)) * VSC[ee[j]];
      wm = fmaxf(wm, fabsf(w[j]));
    }
    wm = wave_max(wm);
    float winv = wm > 0.f ? 127.f / wm : 0.f;
    unsigned q = 0;
#pragma unroll
    for (int j = 0; j < 4; ++j) q = __builtin_amdgcn_cvt_pk_u8_f32(rintf(w[j] * winv) + 128.f, j, q);
    if (lane < 32) WQ[(size_t)t * 32 + l4] = q ^ 0x80808080u;
    if (lane == 0) SW[t] = wm * (1.f / 127.f);
  }
}
__device__ __forceinline__ void load_w16(const float* __restrict__ W, int t, int g8, float (&w)[16]) {
  const float4* wp = (const float4*)(W + (size_t)t * 128 + 16 * g8);
  float4 wa = wp[0], wb = wp[1], wc = wp[2], wd = wp[3];
  w[0] = wa.x; w[1] = wa.y; w[2] = wa.z; w[3] = wa.w; w[4] = wb.x; w[5] = wb.y; w[6] = wb.z; w[7] = wb.w;
  w[8] = wc.x; w[9] = wc.y; w[10] = wc.z; w[11] = wc.w; w[12] = wd.x; w[13] = wd.y; w[14] = wd.z; w[15] = wd.w;
}
#define V_TOKEN(tt, VV, VVN, EUSE, ELD, WUSE, WLD, SUSE, SLD) { \
    int tnn_ = min((tt) + 2 * st, nrows - 1); \
    load_e16(EXP, tnn_, g8, ELD); \
    WLD = *(const uint4*)(WQ + (size_t)tnn_ * 32 + 4 * g8); SLD = SW[tnn_]; \
    __builtin_amdgcn_sched_barrier(0); \
    _Pragma("unroll") for (int i = 0; i < 16; ++i) VVN[i] = *(const uint4*)(vbs + (((unsigned)EUSE[i] << 7) + loff)); \
    __builtin_amdgcn_sched_barrier(0); \
    int acc[16]; \
    _Pragma("unroll") for (int j = 0; j < 16; ++j) acc[j] = 0; \
    int wq[4] = {(int)WUSE.x, (int)WUSE.y, (int)WUSE.z, (int)WUSE.w}; \
    _Pragma("unroll") for (int m = 0; m < 4; ++m) { \
      unsigned r0[4] = {VV[4 * m].x, VV[4 * m].y, VV[4 * m].z, VV[4 * m].w}; \
      unsigned r1[4] = {VV[4 * m + 1].x, VV[4 * m + 1].y, VV[4 * m + 1].z, VV[4 * m + 1].w}; \
      unsigned r2[4] = {VV[4 * m + 2].x, VV[4 * m + 2].y, VV[4 * m + 2].z, VV[4 * m + 2].w}; \
      unsigned r3[4] = {VV[4 * m + 3].x, VV[4 * m + 3].y, VV[4 * m + 3].z, VV[4 * m + 3].w}; \
      _Pragma("unroll") for (int k = 0; k < 4; ++k) { \
          \
        unsigned a0 = __builtin_amdgcn_perm(r1[k], r0[k], 0x05010400u);     \
        unsigned a1 = __builtin_amdgcn_perm(r1[k], r0[k], 0x07030602u);     \
        unsigned a2 = __builtin_amdgcn_perm(r3[k], r2[k], 0x05010400u); \
        unsigned a3 = __builtin_amdgcn_perm(r3[k], r2[k], 0x07030602u); \
        unsigned t0 = __builtin_amdgcn_perm(a2, a0, 0x05040100u);           \
        unsigned t1 = __builtin_amdgcn_perm(a2, a0, 0x07060302u); \
        unsigned t2 = __builtin_amdgcn_perm(a3, a1, 0x05040100u); \
        unsigned t3 = __builtin_amdgcn_perm(a3, a1, 0x07060302u); \
        acc[4 * k + 0] = __builtin_amdgcn_sdot4((int)t0, wq[m], acc[4 * k + 0], false); \
        acc[4 * k + 1] = __builtin_amdgcn_sdot4((int)t1, wq[m], acc[4 * k + 1], false); \
        acc[4 * k + 2] = __builtin_amdgcn_sdot4((int)t2, wq[m], acc[4 * k + 2], false); \
        acc[4 * k + 3] = __builtin_amdgcn_sdot4((int)t3, wq[m], acc[4 * k + 3], false); } } \
    float of[16]; \
    _Pragma("unroll") for (int j = 0; j < 16; ++j) { float v = (float)acc[j]; v += dpp_mov<0x128>(v); of[j] = xrow16_sum(v) * SUSE; } \
    if (g8 == 0) { \
      uint4* fp = (uint4*)(F + (size_t)(tt) * D + 128 * x + 16 * j8); \
      fp[0] = make_uint4(pack2bf(of[0], of[1]), pack2bf(of[2], of[3]), pack2bf(of[4], of[5]), pack2bf(of[6], of[7])); \
      fp[1] = make_uint4(pack2bf(of[8], of[9]), pack2bf(of[10], of[11]), pack2bf(of[12], of[13]), pack2bf(of[14], of[15])); } }
__device__ __forceinline__ void ph_peer_v(const unsigned* __restrict__ WQ, const float* __restrict__ SW, const int* __restrict__ EXP,
                                          const unsigned char* __restrict__ V8, bf16_t* __restrict__ F, int nrows) {
  int lane = threadIdx.x & 63, wave = __builtin_amdgcn_readfirstlane(threadIdx.x >> 6);
  int x = blockIdx.x & 7; int nb8 = gridDim.x >> 3;
  if ((int)(blockIdx.x >> 3) >= nb8) return;
  int j8 = lane & 7, g8 = lane >> 3;
  const int st = nb8 * 4;
  int t = (blockIdx.x >> 3) * 4 + wave;
  if (t >= nrows) return;
  const unsigned char* vbs = V8 + (size_t)x * ((size_t)16384 * 128);
  const unsigned loff = 16u * (unsigned)j8;
  int eA[16], eB[16]; uint4 wA, wB, vvA[16], vvB[16]; float sA, sB;
  {
    int e0[16]; load_e16(EXP, t, g8, e0);
#pragma unroll
    for (int i = 0; i < 16; ++i) vvA[i] = *(const uint4*)(vbs + (((unsigned)e0[i] << 7) + loff));
    wA = *(const uint4*)(WQ + (size_t)t * 32 + 4 * g8); sA = SW[t];
    int tn = min(t + st, nrows - 1);
    load_e16(EXP, tn, g8, eA);
    wB = *(const uint4*)(WQ + (size_t)tn * 32 + 4 * g8); sB = SW[tn];
  }
#pragma unroll 1
  for (; t < nrows; t += 2 * st) {
    uint4 wC; float sC;
    V_TOKEN(t, vvA, vvB, eA, eB, wA, wC, sA, sC)
    if (t + st < nrows) {
      V_TOKEN(t + st, vvB, vvA, eB, eA, wB, wA, sB, sA)
    }
    wB = wA; sB = sA; wA = wC; sA = sC;
  }
}

#define XB_TMO      128
#define XB_XCNT(j)  (256  + 64 * (j))
#define XB_XSUB(j)  (1280 + 64 * (j))
#define XB_XGEN(j)  (2304 + 64 * (j))
#define XB_TOP      3328
#define XB_TOPGEN   3392
#define XCD_BAR_WORDS 3456
#define XB_SPIN_CAP (1u << 22)
#define LAS __attribute__((address_space(3)))
__device__ __forceinline__ unsigned xb_ld(unsigned* p)              { return __hip_atomic_load(p, __ATOMIC_RELAXED, __HIP_MEMORY_SCOPE_AGENT); }
__device__ __forceinline__ unsigned xb_add(unsigned* p, unsigned v) { return __hip_atomic_fetch_add(p, v, __ATOMIC_RELAXED, __HIP_MEMORY_SCOPE_AGENT); }
__device__ __forceinline__ unsigned xb_xcc_id() { return (unsigned)__builtin_amdgcn_s_getreg((3 << 11) | 20) & 0xFu; }
#define XB_SPIN(cond, bar) do { unsigned _sp = 0; while (cond) { __builtin_amdgcn_s_sleep(1); \
    if ((++_sp & 255u) == 0u) { if (xb_ld(&(bar)[XB_TMO])) break; if (_sp > XB_SPIN_CAP) { atomicAdd(&(bar)[XB_TMO], 1u); break; } } } } while (0)
struct XcdBarrier { unsigned* bar; unsigned x; volatile LAS unsigned* st; };
__device__ __forceinline__ XcdBarrier xcd_barrier_post(unsigned* bar, volatile LAS unsigned* st) {
  XcdBarrier b; b.bar = bar; b.x = xb_xcc_id(); b.st = st;
  if (threadIdx.x == 0) (void)xb_add(&bar[XB_XCNT(b.x)], 1u);
  return b;
}
__device__ __forceinline__ void xcd_barrier_complete(unsigned* bar, unsigned x, unsigned& nloc, unsigned& nx) {
  const unsigned G = gridDim.x * gridDim.y * gridDim.z;
  unsigned sum, cnt, mine, sp = 0u;
  for (;;) {
    sum = 0u; cnt = 0u; mine = 0u;
#pragma unroll
    for (unsigned j = 0; j < 16; ++j) { const unsigned c = xb_ld(&bar[XB_XCNT(j)]); sum += c; cnt += (c > 0u) ? 1u : 0u; mine = (j == x) ? c : mine; }
    if (sum == G) break;
    __builtin_amdgcn_s_sleep(1);
    if ((++sp & 255u) == 0u) { if (xb_ld(&bar[XB_TMO])) break; if (sp > XB_SPIN_CAP) { atomicAdd(&bar[XB_TMO], 1u); break; } }
  }
  nloc = mine > 0u ? mine : 1u; nx = cnt > 0u ? cnt : 1u;
}
__device__ __forceinline__ void xcd_barrier(const XcdBarrier& b) {
  asm volatile("s_waitcnt vmcnt(0)" ::: "memory");
  __syncthreads();
  if (threadIdx.x == 0) {
    unsigned* bar = b.bar;
    __builtin_amdgcn_s_waitcnt(0);
    unsigned nloc = b.st[0], nx = b.st[1];
    if (nloc == 0u) { xcd_barrier_complete(bar, b.x, nloc, nx); b.st[0] = nloc; b.st[1] = nx; }
    const unsigned old = xb_add(&bar[XB_XSUB(b.x)], 1u);
    const unsigned gen = old / nloc;
    if (old + 1u == (gen + 1u) * nloc) {
      __builtin_amdgcn_fence(__ATOMIC_RELEASE, "agent");
      asm volatile("s_waitcnt vmcnt(0)" ::: "memory");
      const unsigned og = xb_add(&bar[XB_TOP], 1u);
      const unsigned tg = og / nx;
      if (og + 1u == (tg + 1u) * nx) xb_add(&bar[XB_TOPGEN], 1u);
      else XB_SPIN(xb_ld(&bar[XB_TOPGEN]) == tg, bar);
      __builtin_amdgcn_fence(__ATOMIC_ACQUIRE, "agent");
      xb_add(&bar[XB_XGEN(b.x)], 1u);
      asm volatile("s_waitcnt vmcnt(0)" ::: "memory");
    } else {
      XB_SPIN(xb_ld(&bar[XB_XGEN(b.x)]) == gen, bar);
      __builtin_amdgcn_fence(__ATOMIC_ACQUIRE, "agent");
      asm volatile("s_waitcnt vmcnt(0)" ::: "memory");
    }
  }
  __syncthreads();
}

constexpr int SMEM_BYTES = 65536;
#ifndef PHMASK
#define PHMASK 0xFFFFFFFFFFFFFFFFull
#endif
#ifndef PHDUP
#define PHDUP 0ull
#endif
#define PH(n, ...) if constexpr ((((unsigned long long)(PHMASK)) >> (n)) & 1ull) { __VA_ARGS__; if constexpr ((((unsigned long long)(PHDUP)) >> (n)) & 1ull) { xcd_barrier(xbar); __VA_ARGS__; } }

__global__ __launch_bounds__(256, 2) void mega(Params p) {
  __shared__ __attribute__((aligned(16))) char smem_raw[SMEM_BYTES];
  __shared__ uint4 xb_words;
  if (threadIdx.x == 0) xb_words = make_uint4(0u, 0u, 0u, 0u);
  __syncthreads();
  XcdBarrier xbar = xcd_barrier_post((unsigned*)((char*)p.ws + OFF_BAR), (volatile LAS unsigned*)&xb_words);
  float* smem = (float*)smem_raw;
  const float* x = p.in[0]; const float* c = p.in[1]; const float* ctx = p.in[2]; const float* c_ctx = p.in[3];
  const float* ada_w = p.in[4]; const float* ada_b = p.in[5]; const float* ln_g = p.in[6]; const float* ln_b = p.in[7];
  const float* even_w_in = p.in[8]; const float* even_w_out = p.in[9]; const float* rpb = p.in[10];
  const float* odd_w_in = p.in[11]; const float* odd_w_out = p.in[12]; const float* sink = p.in[13];
  const float* peer_wq = p.in[14]; const float* peer_sk = p.in[15]; const float* peer_u = p.in[16]; const float* peer_v = p.in[17];
  char* ws = (char*)p.ws;
  float* TAB = (float*)(ws + OFF_TAB); float* Mm = (float*)(ws + OFF_M);
  bf16_t* WIN0 = (bf16_t*)(ws + OFF_WIN0); bf16_t* WOUT0 = (bf16_t*)(ws + OFF_WOUT0);
  bf16_t* WIN1 = (bf16_t*)(ws + OFF_WIN1); bf16_t* WOUT1 = (bf16_t*)(ws + OFF_WOUT1);
  bf16_t* WQ = (bf16_t*)(ws + OFF_WQ); bf16_t* SKB = (bf16_t*)(ws + OFF_SK);
  unsigned char* U8 = (unsigned char*)(ws + OFF_UB); unsigned char* V8 = (unsigned char*)(ws + OFF_VB);
  float* USC = (float*)(ws + OFF_USC); float* VSC = USC + 2 * 16384;
  bf16_t* AB = (bf16_t*)(ws + OFF_AB);
  bf16_t* FD1 = (bf16_t*)(ws + OFF_FT); bf16_t* FD3 = FD1 + 256 * 128; bf16_t* FDC = FD3 + 128 * 128;
  bf16_t* A1 = (bf16_t*)(ws + OFF_A1); bf16_t* VT0 = (bf16_t*)(ws + OFF_VT0); bf16_t* FQKV = (bf16_t*)(ws + OFF_BF);
  float* BF_ = (float*)(ws + OFF_BF); float* BY = (float*)(ws + OFF_BY);
  float* X1 = (float*)(ws + OFF_X1); float* X2 = (float*)(ws + OFF_X2);
  float* RT = TAB + 16384;
  bf16_t* Q1 = (bf16_t*)(ws + OFF_BF); bf16_t* K1 = Q1 + (size_t)T * 1024; bf16_t* VT1 = K1 + (size_t)R * 256;
  bf16_t* YB = (bf16_t*)(ws + OFF_BY + (size_t)2 * R * 128 * 4);
  float* PAB = (float*)(ws + OFF_BF); bf16_t* FB = (bf16_t*)(ws + OFF_BF + (size_t)R * 8 * 128 * 4);
  float* WB = (float*)(ws + OFF_BF + (size_t)R * 8 * 128 * 4 + (size_t)R * 1024 * 2); float* CORRB = WB + (size_t)R * 128;
  int* EXPB = (int*)(ws + OFF_BY); float* GATEB = (float*)(ws + OFF_BY + (size_t)R * 128 * 4);
  float* out = p.out;
  unsigned* QC = (unsigned*)(ws + OFF_BAR) + 32;
#define QFILL(site, layer, lo, hi) quant_fill(QC + (site), (layer), (lo), (hi), peer_u, peer_v, U8, V8, USC, VSC, (unsigned*)(smem_raw + 65024))

  PH(0, ph_tables(TAB); ph_rope_table(RT))
  PH(1, ph_fft_tables(FD1, FD3, FDC))
  PH(2, ph_ada2(c, c_ctx, ada_w, ada_b, Mm, smem))
  PH(3, ph_transpose_w(even_w_in, 1024, 2048, WIN0, smem))
  PH(4, ph_transpose_w(even_w_out, 1024, 1024, WOUT0, smem))
  PH(5, ph_transpose_w(odd_w_in, 1024, 1536, WIN1, smem))
  PH(6, ph_transpose_w(odd_w_out, 1024, 1024, WOUT1, smem))
  PH(7, ph_transpose_w(peer_wq, 1024, 2048, WQ, smem))
  PH(8, ph_transpose_w(peer_wq + (size_t)1024 * 2048, 1024, 2048, WQ + (size_t)2048 * 1024, smem))
  PH(11, ph_convert(peer_sk, SKB, (size_t)2 * 8 * 2 * 128 * 128 / 8))
  xcd_barrier(xbar);
  PH(12, ph_modulate(x, ctx, Mm, 0, 0, 1, AB, R, smem))
  xcd_barrier(xbar);
  PH(13, ph_gemm_bf16(AB, 1024, WIN0, 1024, R, 2048, 1024, EpiQKV0{FQKV, VT0}, smem_raw))
  PH(9, QFILL(0, 0, 0u, 160u))
  xcd_barrier(xbar);
  PH(14, { GRID_LOOP(u, NB * 64 * 8) fft1_unit(u, FQKV, FD1, TAB, A1, smem_raw); })
  PH(15, { int lane = threadIdx.x & 63, wave = __builtin_amdgcn_readfirstlane(threadIdx.x >> 6);
           __syncthreads();
           for (int i = threadIdx.x; i < 8 * 15 * 31; i += 256) smem[i] = rpb[i] * 1.4426950408889634f;
           __syncthreads();
           for (int bu = blockIdx.x; bu < 512 + 64; bu += gridDim.x) {
             if (bu < 512) { int h = bu & 7, rg = (bu >> 3) & 31, bb = bu >> 8;
               na_unit(bb, h, rg * 4 + wave, FQKV, VT0, VT0 + (size_t)NB * 8 * 64 * S, smem, AB, lane); }
             else { int cu = bu - 512; int h = cu & 7, qg = (cu >> 3) & 3, bb = cu >> 5;
               attn_unit<1, 1, 2, true>(bb, h, 0, 0, qg * 4 + wave, FQKV + 512, 2048, FQKV + 1024, 2048, VT0, VT0 + (size_t)NB * 8 * 64 * S, 8, smem, nullptr, AB + 512, 1024, lane); } } })
  xcd_barrier(xbar);
  PH(16, { GRID_LOOP(u, NB * 128 * 8 + NB * 4 * 8) { if (u < NB * 128 * 8) fft3_unit(u, 0, FQKV, A1, FD3, FDC, TAB, AB, smem_raw); else fft3_unit(u - NB * 128 * 8, 1, FQKV, A1, FD3, FDC, TAB, AB, smem_raw); } })
  xcd_barrier(xbar);
  PH(17, ph_gemm_bf16(AB, 1024, WOUT0, 1024, R, 1024, 1024, EpiBf16{YB, 1024}, smem_raw))
  PH(9, QFILL(1, 0, 160u, 260u))
  xcd_barrier(xbar);
  PH(18, ph_post_mod(x, ctx, YB, Mm, 0, 2, 0, 3, 4, true, ln_g + 0, ln_b + 0, X1, AB, R))
  xcd_barrier(xbar);
  PH(21, ph_peer_select(AB, WQ, SKB, EXPB, GATEB, R, smem_raw))
  PH(9, QFILL(2, 0, 260u, 512u))
  PH(10, QFILL(3, 1, 0u, 300u))
  xcd_barrier(xbar);
  PH(22, ph_peer_u(AB, EXPB, U8, PAB, R))
  xcd_barrier(xbar);
  PH(32, ph_peer_w(PAB, EXPB, GATEB, USC, VSC, (unsigned*)WB, CORRB, R))
  xcd_barrier(xbar);
  PH(33, ph_peer_v((const unsigned*)WB, CORRB, EXPB, V8, FB, R))
  xcd_barrier(xbar);
  PH(34, ph_post_mod(X1, X1 + (size_t)T * D, FB, Mm, 0, 5, 1, 0, 1, true, ln_g + 1024, ln_b + 1024, X2, AB, R))
  xcd_barrier(xbar);
  PH(23, ph_gemm_bf16(AB, 1024, WIN1, 1024, R, 1536, 1024, EpiQKV1{Q1, K1, VT1, RT}, smem_raw))
  PH(10, QFILL(4, 1, 300u, 420u))
  xcd_barrier(xbar);
  PH(25, { int lane = threadIdx.x & 63, wave = __builtin_amdgcn_readfirstlane(threadIdx.x >> 6);
           for (int bu = blockIdx.x; bu < 1024; bu += gridDim.x) { int kvh = bu & 3, bb = (bu >> 2) & 1, qg = bu >> 3;
             attn_unit<4, 2, 1, true>(bb, kvh, 0, 0, qg * 4 + wave, Q1, 1024, K1, 256, VT1, VT1 + (size_t)NB * 4 * 64 * S, 4, nullptr, sink, AB, 1024, lane); } })
  xcd_barrier(xbar);
  PH(26, ph_gemm_bf16(AB, 1024, WOUT1, 1024, T, 1024, 1024, EpiBf16{YB, 1024}, smem_raw))
  xcd_barrier(xbar);
  PH(27, ph_post_mod(X2, X2, YB, Mm, 1, 2, 1, 3, 4, true, ln_g + 2048, ln_b + 2048, X1, AB, T))
  xcd_barrier(xbar);
  PH(30, ph_peer_select(AB, WQ + (size_t)2048 * 1024, SKB + (size_t)8 * 2 * 128 * 128, EXPB, GATEB, T, smem_raw))
  PH(10, QFILL(5, 1, 420u, 512u))
  xcd_barrier(xbar);
  PH(31, ph_peer_u(AB, EXPB, U8 + (size_t)16384 * 1024, PAB, T))
  xcd_barrier(xbar);
  PH(35, ph_peer_w(PAB, EXPB, GATEB, USC + 16384, VSC + 16384, (unsigned*)WB, CORRB, T))
  xcd_barrier(xbar);
  PH(36, ph_peer_v((const unsigned*)WB, CORRB, EXPB, V8 + (size_t)16384 * 1024, FB, T))
  xcd_barrier(xbar);
  PH(37, ph_post_mod(X1, X1, FB, Mm, 1, 5, 1, 0, 1, false, ln_g + 3072, ln_b + 3072, out, AB, T))
}

}

extern "C" void kernel_launch(void* const* d_in, const int* in_sizes, int n_in, void* d_out, int out_size, void* d_ws,
                              size_t ws_size, hipStream_t stream) {
  static int grid_blocks = 0;
  if (!grid_blocks) {
    int dev = 0, cus = 0, per_cu = 0;
    hipGetDevice(&dev);
    hipDeviceGetAttribute(&cus, hipDeviceAttributeMultiprocessorCount, dev);
    hipOccupancyMaxActiveBlocksPerMultiprocessor(&per_cu, (const void*)mega, 256, 0);
    if (per_cu > 2) per_cu = 2;
    if (per_cu < 1) per_cu = 1;
    grid_blocks = cus * per_cu;
  }
  Params p{};
  for (int i = 0; i < 18; ++i) p.in[i] = (const float*)d_in[i];
  p.out = (float*)d_out;
  p.ws = (float*)d_ws;
  (void)hipMemsetAsync((char*)d_ws + OFF_BAR, 0, XCD_BAR_WORDS_C * 4, stream);
  void* args[] = {&p};
  hipError_t e = hipLaunchCooperativeKernel((const void*)mega, dim3(grid_blocks), dim3(256), args, 0, stream);
  if (e != hipSuccess) fprintf(stderr, "cooperative launch failed: %s (grid %d)\n", hipGetErrorString(e), grid_blocks);
}
```

```cpp
#include <hip/hip_runtime.h>
#include <hip/hip_bf16.h>
#include <stdint.h>
#include <math.h>
#include <stdio.h>
#include <hip/hip_cooperative_groups.h>
namespace cg = cooperative_groups;

namespace {

constexpr int D = 1024;
constexpr int NB = 2;
constexpr int S = 8192;
constexpr int T = NB * S;
constexpr int CL = 256;
constexpr int TC = NB * CL;
constexpr int R = T + TC;
constexpr float DN_ALPHA = 1.4142135623730951f;
constexpr float LN_EPS = 1e-6f;

template <int CTRL> __device__ __forceinline__ float dpp_mov(float x) {
  return __builtin_bit_cast(float, __builtin_amdgcn_mov_dpp(__builtin_bit_cast(int, x), CTRL, 0xf, 0xf, true));
}
__device__ __forceinline__ float xrow16_max(float x) {
  auto s = __builtin_amdgcn_permlane16_swap(__float_as_uint(x), __float_as_uint(x), false, false);
  x = fmaxf(__uint_as_float(s[0]), __uint_as_float(s[1]));
  auto t = __builtin_amdgcn_permlane32_swap(__float_as_uint(x), __float_as_uint(x), false, false);
  return fmaxf(__uint_as_float(t[0]), __uint_as_float(t[1]));
}
__device__ __forceinline__ float xrow16_sum(float x) {
  auto s = __builtin_amdgcn_permlane16_swap(__float_as_uint(x), __float_as_uint(x), false, false);
  x = __uint_as_float(s[0]) + __uint_as_float(s[1]);
  auto t = __builtin_amdgcn_permlane32_swap(__float_as_uint(x), __float_as_uint(x), false, false);
  return __uint_as_float(t[0]) + __uint_as_float(t[1]);
}
__device__ __forceinline__ float wave_sum(float v) {
  v += dpp_mov<0xB1>(v); v += dpp_mov<0x4E>(v); v += dpp_mov<0x124>(v); v += dpp_mov<0x128>(v);
  return xrow16_sum(v);
}
__device__ __forceinline__ float wave_max(float v) {
  v = fmaxf(v, dpp_mov<0xB1>(v)); v = fmaxf(v, dpp_mov<0x4E>(v)); v = fmaxf(v, dpp_mov<0x124>(v)); v = fmaxf(v, dpp_mov<0x128>(v));
  return xrow16_max(v);
}

typedef unsigned short bf16_t;
typedef __attribute__((ext_vector_type(8))) short bf16x8;
typedef __attribute__((ext_vector_type(16))) float f32x16;
typedef __attribute__((ext_vector_type(4))) float f32x4;

typedef __attribute__((ext_vector_type(2))) __bf16 bf16x2_t;
__device__ __forceinline__ unsigned f2bf(float f) { return (unsigned)__builtin_bit_cast(unsigned short, (__bf16)f); }
__device__ __forceinline__ unsigned pack2bf(float a, float b) { bf16x2_t v = {(__bf16)a, (__bf16)b}; return __builtin_bit_cast(unsigned, v); }
__device__ __forceinline__ float bf2f(unsigned short v) { return __uint_as_float(((unsigned)v) << 16); }

__device__ __forceinline__ int mod_index(int row) { return row < T ? row / S : 2; }


struct Params {
  const float* in[18];
  float* out;
  float* ws;
};

constexpr size_t XCD_BAR_WORDS_C = 3456;
constexpr size_t al256(size_t n) { return (n + 255) & ~(size_t)255; }
constexpr size_t OFF_BAR = 0;
constexpr size_t OFF_TAB = al256(XCD_BAR_WORDS_C * 4);
constexpr size_t OFF_M = OFF_TAB + al256(16384 * 4 + 128 * 16 * 2 * 4);
constexpr size_t OFF_WIN0 = OFF_M + al256(2 * 3 * 6144 * 4);
constexpr size_t OFF_WOUT0 = OFF_WIN0 + al256((size_t)2048 * 1024 * 2);
constexpr size_t OFF_WIN1 = OFF_WOUT0 + al256((size_t)1024 * 1024 * 2);
constexpr size_t OFF_WOUT1 = OFF_WIN1 + al256((size_t)1536 * 1024 * 2);
constexpr size_t OFF_WQ = OFF_WOUT1 + al256((size_t)1024 * 1024 * 2);
constexpr size_t OFF_SK = OFF_WQ + al256((size_t)2 * 2048 * 1024 * 2);
constexpr size_t OFF_UB = OFF_SK + al256((size_t)2 * 8 * 2 * 128 * 128 * 2);
constexpr size_t OFF_VB = OFF_UB + al256((size_t)2 * 16384 * 1024);
constexpr size_t OFF_USC = OFF_VB + al256((size_t)2 * 16384 * 1024);
constexpr size_t OFF_AB = OFF_USC + al256((size_t)4 * 16384 * 4);
constexpr size_t OFF_FT = OFF_AB + al256((size_t)R * 1024 * 2);
constexpr size_t OFF_BF = OFF_FT + al256((size_t)(256 * 128 + 128 * 128 + 64 * 128) * 2);
constexpr size_t OFF_BY = OFF_BF + al256((size_t)R * 2048 * 4);
constexpr size_t OFF_X1 = OFF_BY + al256((size_t)R * 1024 * 4);
constexpr size_t OFF_X2 = OFF_X1 + al256((size_t)R * 1024 * 4);
constexpr size_t OFF_END = OFF_X2 + al256((size_t)R * 1024 * 4);
constexpr size_t OFF_A1 = OFF_BY;
constexpr size_t OFF_VT0 = OFF_X2;
static_assert(OFF_END <= (size_t)512 * 1024 * 1024, "workspace overflow");

#define GRID_LOOP(var, n) for (int var = blockIdx.x; var < (n); var += gridDim.x)

__device__ __forceinline__ void ph_fft_tables(bf16_t* D1, bf16_t* D3, bf16_t* DcT) {
  const double TWO_PI = 6.283185307179586476925286766559;
  for (int i = blockIdx.x * 256 + threadIdx.x; i < 256 * 128 + 128 * 128 + 64 * 128; i += gridDim.x * 256) {
    if (i < 256 * 128) {
      int m = i >> 7, r = i & 127; int k1 = m >> 1, ri = m & 1;
      double a = TWO_PI * (double)((k1 * r) & 127) / 128.0;
      D1[i] = (bf16_t)f2bf(ri == 0 ? (float)cos(a) : (float)(-sin(a)));
    } else if (i < 256 * 128 + 128 * 128) {
      int j = i - 256 * 128; int m = j >> 7, kk = j & 127; int rip = m >> 6, k2 = m & 63; int c = kk >> 1, ri = kk & 1;
      double a = TWO_PI * (double)((k2 * c) & 63) / 64.0;
      double v = (rip == 0) ? (ri == 0 ? cos(a) : sin(a)) : (ri == 0 ? -sin(a) : cos(a));
      D3[j] = (bf16_t)f2bf((float)v);
    } else {
      int j = i - 256 * 128 - 128 * 128; int cp = j >> 7, kk = j & 127; int rip = kk >> 6, ch = kk & 63;
      double a = TWO_PI * (double)((ch * cp) & 63) / 64.0;
      DcT[j] = (bf16_t)f2bf((float)(rip == 0 ? cos(a) : sin(a)));
    }
  }
}
__device__ __forceinline__ void ph_rope_table(float* RT) {
  for (int i = blockIdx.x * 256 + threadIdx.x; i < 128 * 16; i += gridDim.x * 256) {
    int pos = i >> 4, f = i & 15;
    float inv_freq = powf(10000.0f, -(float)f / 16.0f);
    float ang = (float)pos * inv_freq;
    RT[2 * i] = cosf(ang); RT[2 * i + 1] = sinf(ang);
  }
}
__device__ __forceinline__ void ph_tables(float* tab) {
  for (int j = blockIdx.x * 256 + threadIdx.x; j < 8192; j += gridDim.x * 256) {
    double a = 6.283185307179586476925286766559 * (double)j / 8192.0;
    tab[j] = (float)cos(a);
    tab[8192 + j] = (float)sin(a);
  }
}
__device__ __forceinline__ void ph_ada(const float* __restrict__ c, const float* __restrict__ c_ctx, const float* __restrict__ ada_w,
                       const float* __restrict__ ada_b, float* __restrict__ M) {
  for (int gid = blockIdx.x * 256 + threadIdx.x; gid < 2 * 3 * 6144; gid += gridDim.x * 256) {
    int col = gid % 6144; int idx = (gid / 6144) % 3; int layer = gid / (3 * 6144);
    const float* vec = idx < 2 ? c + idx * D : c_ctx;
    const float* w = ada_w + (size_t)layer * D * 6144 + col;
    float acc = 0.f;
    for (int k = 0; k < D; ++k) {
      float x = vec[k];
      float sx = x / (1.f + expf(-x));
      acc += sx * w[(size_t)k * 6144];
    }
    M[gid] = acc + ada_b[layer * 6144 + col];
  }
}

__device__ __forceinline__ void ph_modulate(const float* __restrict__ xa, const float* __restrict__ xb, const float* __restrict__ M, int layer,
                            int jshift, int jscale, bf16_t* __restrict__ out, int nrows, float* red) {
  int tid = threadIdx.x;
  GRID_LOOP(row, nrows) {
    const float* x = row < T ? xa + (size_t)row * D : xb + (size_t)(row - T) * D;
    float v[4]; float s = 0.f;
#pragma unroll
    for (int i = 0; i < 4; ++i) { v[i] = x[tid + 256 * i]; s += v[i]; }
    s = wave_sum(s);
    __syncthreads();
    if ((tid & 63) == 0) red[tid >> 6] = s;
    __syncthreads();
    float mu = (red[0] + red[1] + red[2] + red[3]) * (1.f / D);
    float q = 0.f;
#pragma unroll
    for (int i = 0; i < 4; ++i) { float d = v[i] - mu; q += d * d; }
    q = wave_sum(q);
    if ((tid & 63) == 0) red[4 + (tid >> 6)] = q;
    __syncthreads();
    float var = (red[4] + red[5] + red[6] + red[7]) * (1.f / D);
    float rs = rsqrtf(var + LN_EPS);
    const float* m = M + ((size_t)layer * 3 + mod_index(row)) * 6144;
#pragma unroll
    for (int i = 0; i < 4; ++i) {
      int col = tid + 256 * i;
      float y = (v[i] - mu) * rs;
      out[(size_t)row * D + col] = (bf16_t)f2bf(y * (1.f + m[jscale * D + col]) + m[jshift * D + col]);
    }
  }
}

__device__ __forceinline__ void ph_post(const float* __restrict__ xa, const float* __restrict__ xb, const float* __restrict__ Y,
                        const float* __restrict__ M, int layer, int j, const float* __restrict__ g, const float* __restrict__ bb,
                        float* __restrict__ outa, float* __restrict__ outb, int nrows, float* red) {
  int tid = threadIdx.x;
  GRID_LOOP(row, nrows) {
    const float* x = row < T ? xa + (size_t)row * D : xb + (size_t)(row - T) * D;
    float* out = row < T ? outa + (size_t)row * D : outb + (size_t)(row - T) * D;
    const float* m = M + ((size_t)layer * 3 + mod_index(row)) * 6144 + j * D;
    float v[4]; float s = 0.f;
#pragma unroll
    for (int i = 0; i < 4; ++i) { int col = tid + 256 * i; v[i] = DN_ALPHA * x[col] + m[col] * Y[(size_t)row * D + col]; s += v[i]; }
    s = wave_sum(s);
    __syncthreads();
    if ((tid & 63) == 0) red[tid >> 6] = s;
    __syncthreads();
    float mu = (red[0] + red[1] + red[2] + red[3]) * (1.f / D);
    float q = 0.f;
#pragma unroll
    for (int i = 0; i < 4; ++i) { float d = v[i] - mu; q += d * d; }
    q = wave_sum(q);
    if ((tid & 63) == 0) red[4 + (tid >> 6)] = q;
    __syncthreads();
    float var = (red[4] + red[5] + red[6] + red[7]) * (1.f / D);
    float rs = rsqrtf(var + LN_EPS);
#pragma unroll
    for (int i = 0; i < 4; ++i) {
      int col = tid + 256 * i;
      out[col] = (v[i] - mu) * rs * g[col] + bb[col];
    }
  }
}

struct ARow { const float* A; int lda; __device__ float operator()(int m, int k) const { return A[(size_t)m * lda + k]; } };
struct BRow { const float* B; int ldb; __device__ float operator()(int k, int n) const { return B[(size_t)k * ldb + n]; } };
struct CRow { float* C; int ldc; float scale; __device__ void operator()(int m, int n, float v) const { C[(size_t)m * ldc + n] = v * scale; } };
struct CRowB { bf16_t* C; int ldc; float scale; __device__ void operator()(int m, int n, float v) const { C[(size_t)m * ldc + n] = (bf16_t)f2bf(v * scale); } };
struct ADft { const float* tab; int Sn; int stride; __device__ float operator()(int m, int k) const {
    int t = k & (Sn - 1); int idx = ((m * t) & (Sn - 1)) * stride;
    return k < Sn ? tab[idx] : -tab[8192 + idx]; } };
struct BPQ { const float* PQ; int rowbase; int Sn; __device__ float operator()(int k, int n) const {
    int t = k & (Sn - 1); return PQ[(size_t)(rowbase + t) * 1024 + (k >= Sn ? 512 : 0) + n]; } };

template <class AF, class BF, class CF>
__device__ __forceinline__ void ph_gemm(AF af, BF bf, CF cf, int M, int N, int K, float* sm) {
  float (*sA)[68] = (float (*)[68])sm;
  float (*sB)[68] = (float (*)[68])(sm + 16 * 68);
  int tid = threadIdx.x; int tx = tid & 15, ty = tid >> 4;
  int ntn = N / 64; int ntiles = (M / 64) * ntn;
  GRID_LOOP(tile, ntiles) {
    int m0 = (tile / ntn) * 64, n0 = (tile % ntn) * 64;
    float acc[4][4];
#pragma unroll
    for (int i = 0; i < 4; ++i)
#pragma unroll
      for (int j = 0; j < 4; ++j) acc[i][j] = 0.f;
    for (int k0 = 0; k0 < K; k0 += 16) {
      __syncthreads();
#pragma unroll
      for (int i = 0; i < 4; ++i) { int e = tid + 256 * i; int m = e >> 4, k = e & 15; sA[k][m] = af(m0 + m, k0 + k); }
#pragma unroll
      for (int i = 0; i < 4; ++i) { int e = tid + 256 * i; int k = e >> 6, n = e & 63; sB[k][n] = bf(k0 + k, n0 + n); }
      __syncthreads();
#pragma unroll
      for (int k = 0; k < 16; ++k) {
        float a[4], b[4];
#pragma unroll
        for (int i = 0; i < 4; ++i) { a[i] = sA[k][ty * 4 + i]; b[i] = sB[k][tx * 4 + i]; }
#pragma unroll
        for (int i = 0; i < 4; ++i)
#pragma unroll
          for (int j = 0; j < 4; ++j) acc[i][j] += a[i] * b[j];
      }
    }
#pragma unroll
    for (int i = 0; i < 4; ++i)
#pragma unroll
      for (int j = 0; j < 4; ++j) cf(m0 + ty * 4 + i, n0 + tx * 4 + j, acc[i][j]);
  }
}


__device__ __forceinline__ void ph_transpose_w(const float* __restrict__ W, int K, int N, bf16_t* __restrict__ Wt, float* sm) {
  int tid = threadIdx.x;
  int tk = K / 64, tn = N / 64;
  GRID_LOOP(tile, tk * tn) {
    int k0 = (tile / tn) * 64, n0 = (tile % tn) * 64;
    __syncthreads();
#pragma unroll
    for (int i = 0; i < 16; ++i) { int e = tid + 256 * i; int k = e >> 6, n = e & 63; sm[k * 65 + n] = W[(size_t)(k0 + k) * N + n0 + n]; }
    __syncthreads();
#pragma unroll
    for (int i = 0; i < 2; ++i) {
      int e = tid + 256 * i; int n = e >> 3, kc = e & 7;
      unsigned w[4];
#pragma unroll
      for (int j = 0; j < 4; ++j) w[j] = pack2bf(sm[(kc * 8 + 2 * j) * 65 + n], sm[(kc * 8 + 2 * j + 1) * 65 + n]);
      *(uint4*)(Wt + (size_t)(n0 + n) * K + k0 + kc * 8) = make_uint4(w[0], w[1], w[2], w[3]);
    }
  }
}
__device__ __forceinline__ void ph_convert(const float* __restrict__ src, bf16_t* __restrict__ dst, size_t n8) {
  for (size_t i = (size_t)blockIdx.x * 256 + threadIdx.x; i < n8; i += (size_t)gridDim.x * 256) {
    float4 a = ((const float4*)src)[2 * i], b = ((const float4*)src)[2 * i + 1];
    ((uint4*)dst)[i] = make_uint4(pack2bf(a.x, a.y), pack2bf(a.z, a.w), pack2bf(b.x, b.y), pack2bf(b.z, b.w));
  }
}

__device__ __forceinline__ void gemm_stage(const bf16_t* __restrict__ A, int lda, int k0, char* lds, int tid) {
#pragma unroll
  for (int i = 0; i < 4; ++i) {
    int q = tid + 256 * i; int row = q >> 3, p = q & 7; int c = p ^ ((row >> 1) & 7);
    const bf16_t* src = A + (size_t)row * lda + k0 + c * 8;
    __builtin_amdgcn_global_load_lds((const unsigned*)src, (unsigned*)(lds + q * 16), 16, 0, 0);
  }
}
struct EpiF32 {
  float* C; int ldc; float scale;
  __device__ __forceinline__ void operator()(int m0, int n0, int wm, int wn, f32x16 (&acc)[2][2], int tid, char* smem) const {
    int lane = tid & 63;
    float* t = (float*)smem;
    int rbase = wm * 64 + 4 * (lane >> 5), cbase = wn * 64 + (lane & 31);
#pragma unroll
    for (int mi = 0; mi < 2; ++mi)
#pragma unroll
      for (int ni = 0; ni < 2; ++ni)
#pragma unroll
        for (int r = 0; r < 16; ++r)
          t[(rbase + mi * 32 + (r & 3) + 8 * (r >> 2)) * 128 + cbase + ni * 32] = acc[mi][ni][r] * scale;
    __syncthreads();
    float* dst = C + (size_t)(m0 + (tid >> 5)) * ldc + n0 + (tid & 31) * 4;
    const float* src = t + (tid >> 5) * 128 + (tid & 31) * 4;
#pragma unroll 4
    for (int i = 0; i < 16; ++i) {
      *(float4*)dst = *(const float4*)src;
      dst += (size_t)8 * ldc; src += 8 * 128;
    }
  }
};
struct EpiQKV0 {
  bf16_t* FQKV; bf16_t* VT;
  __device__ __forceinline__ void operator()(int m0, int n0, int wm, int wn, f32x16 (&acc)[2][2], int tid, char* smem) const {
    int lane = tid & 63;
    bf16_t* t = (bf16_t*)smem;
    int rbase = wm * 64 + 4 * (lane >> 5), cbase = wn * 64 + (lane & 31);
#pragma unroll
    for (int mi = 0; mi < 2; ++mi)
#pragma unroll
      for (int ni = 0; ni < 2; ++ni)
#pragma unroll
        for (int r = 0; r < 16; ++r)
          t[(rbase + mi * 32 + (r & 3) + 8 * (r >> 2)) * 136 + cbase + ni * 32] = (bf16_t)f2bf(acc[mi][ni][r]);
    __syncthreads();
    {
      bf16_t* dst = FQKV + (size_t)(m0 + (tid >> 4)) * 2048 + n0 + (tid & 15) * 8;
      const bf16_t* src = t + (tid >> 4) * 136 + (tid & 15) * 8;
#pragma unroll 4
      for (int i = 0; i < 8; ++i) {
        *(uint4*)dst = *(const uint4*)src;
        dst += (size_t)16 * 2048; src += 16 * 136;
      }
    }
    if (n0 >= 1536) {
      int col = tid >> 1, half = tid & 1;
      int hd = (n0 - 1536) / 64 + (col >> 6), d = col & 63;
      bf16_t* dst;
      if (m0 < T) { int b = m0 / S, t0 = m0 % S; dst = VT + (((size_t)b * 8 + hd) * 64 + d) * S + t0 + half * 64; }
      else { int mm = m0 - T; int b = mm / CL, l0 = mm % CL; dst = VT + (size_t)NB * 8 * 64 * S + (((size_t)b * 8 + hd) * 64 + d) * CL + l0 + half * 64; }
      const bf16_t* src = t + (half * 64) * 136 + col;
#pragma unroll
      for (int i = 0; i < 8; ++i) {
        unsigned wv[4];
#pragma unroll
        for (int j = 0; j < 4; ++j) wv[j] = (unsigned)src[(i * 8 + 2 * j) * 136] | ((unsigned)src[(i * 8 + 2 * j + 1) * 136] << 16);
        *(uint4*)(dst + i * 8) = make_uint4(wv[0], wv[1], wv[2], wv[3]);
      }
    }
  }
};
struct EpiBf16 {
  bf16_t* C; int ldc;
  __device__ __forceinline__ void operator()(int m0, int n0, int wm, int wn, f32x16 (&acc)[2][2], int tid, char* smem) const {
    int lane = tid & 63;
    asm volatile("" : "+v"(lane));
    bf16_t* t = (bf16_t*)smem;
    {
      bf16_t* tw = t + (wm * 64 + 4 * (lane >> 5)) * 136 + wn * 64 + (lane & 31);
#pragma unroll
      for (int mi = 0; mi < 2; ++mi)
#pragma unroll
        for (int ni = 0; ni < 2; ++ni)
#pragma unroll
          for (int r = 0; r < 16; ++r)
            tw[(mi * 32 + (r & 3) + 8 * (r >> 2)) * 136 + ni * 32] = (bf16_t)f2bf(acc[mi][ni][r]);
    }
    __syncthreads();
    bf16_t* dst = C + (size_t)(m0 + (tid >> 4)) * ldc + n0 + (tid & 15) * 8;
    const bf16_t* src = t + (tid >> 4) * 136 + (tid & 15) * 8;
#pragma unroll 4
    for (int i = 0; i < 8; ++i) {
      *(uint4*)dst = *(const uint4*)src;
      dst += (size_t)16 * ldc; src += 16 * 136;
    }
  }
};
struct EpiQKV1 {
  bf16_t* Q1; bf16_t* K1; bf16_t* VT; const float* RT;
  __device__ __forceinline__ void operator()(int m0, int n0, int wm, int wn, f32x16 (&acc)[2][2], int tid, char* smem) const {
    int lane = tid & 63;
    asm volatile("" : "+v"(lane));
    bf16_t* t = (bf16_t*)smem;
    if (n0 < 1280 && m0 < T) {
      int i = lane & 31; int f = i & 15;
#pragma unroll
      for (int mi = 0; mi < 2; ++mi)
#pragma unroll
        for (int r = 0; r < 16; ++r) {
          int row = m0 + wm * 64 + 4 * (lane >> 5) + mi * 32 + (r & 3) + 8 * (r >> 2);
          int tt = row & (S - 1);
          int pos = (i < 16) ? (tt >> 6) : (tt & 63);
          float2 cs = *(const float2*)(RT + 2 * (pos * 16 + f));
          float x1 = acc[mi][0][r], x2 = acc[mi][1][r];
          acc[mi][0][r] = x1 * cs.x - x2 * cs.y;
          acc[mi][1][r] = x1 * cs.y + x2 * cs.x;
        }
    }
    {
      bf16_t* tw = t + (wm * 64 + 4 * (lane >> 5)) * 136 + wn * 64 + (lane & 31);
#pragma unroll
      for (int mi = 0; mi < 2; ++mi)
#pragma unroll
        for (int ni = 0; ni < 2; ++ni)
#pragma unroll
          for (int r = 0; r < 16; ++r)
            tw[(mi * 32 + (r & 3) + 8 * (r >> 2)) * 136 + ni * 32] = (bf16_t)f2bf(acc[mi][ni][r]);
    }
    __syncthreads();
    if (n0 < 1280) {
      bf16_t* dst; int ld;
      if (n0 < 1024) { dst = Q1 + (size_t)(m0 + (tid >> 4)) * 1024 + n0 + (tid & 15) * 8; ld = 1024; }
      else { dst = K1 + (size_t)(m0 + (tid >> 4)) * 256 + (n0 - 1024) + (tid & 15) * 8; ld = 256; }
      if (n0 >= 1024 || m0 < T) {
        const bf16_t* src = t + (tid >> 4) * 136 + (tid & 15) * 8;
#pragma unroll 4
        for (int i = 0; i < 8; ++i) {
          *(uint4*)dst = *(const uint4*)src;
          dst += (size_t)16 * ld; src += 16 * 136;
        }
      }
    } else {
      int col = tid >> 1, half = tid & 1;
      int hd = (n0 - 1280) / 64 + (col >> 6), d = col & 63;
      bf16_t* dst;
      if (m0 < T) { int b = m0 / S, t0 = m0 % S; dst = VT + (((size_t)b * 4 + hd) * 64 + d) * S + t0 + half * 64; }
      else { int mm = m0 - T; int b = mm / CL, l0 = mm % CL; dst = VT + (size_t)NB * 4 * 64 * S + (((size_t)b * 4 + hd) * 64 + d) * CL + l0 + half * 64; }
      const bf16_t* src = t + (half * 64) * 136 + col;
#pragma unroll
      for (int i = 0; i < 8; ++i) {
        unsigned wv[4];
#pragma unroll
        for (int j = 0; j < 4; ++j) wv[j] = (unsigned)src[(i * 8 + 2 * j) * 136] | ((unsigned)src[(i * 8 + 2 * j + 1) * 136] << 16);
        *(uint4*)(dst + i * 8) = make_uint4(wv[0], wv[1], wv[2], wv[3]);
      }
    }
  }
};
__device__ __forceinline__ void gemm_tile_mainloop(const bf16_t* __restrict__ Ag, int lda, const bf16_t* __restrict__ Bg, int ldb, int KT,
                                                   f32x16 (&acc)[2][2], char* smem) {
  int tid = threadIdx.x;
  asm volatile("" : "+v"(tid));
  int lane = tid & 63, wave = __builtin_amdgcn_readfirstlane(tid >> 6), wm = wave >> 1, wn = wave & 1;
#pragma unroll
  for (int mi = 0; mi < 2; ++mi)
#pragma unroll
    for (int ni = 0; ni < 2; ++ni)
#pragma unroll
      for (int r = 0; r < 16; ++r) acc[mi][ni][r] = 0.f;
  __syncthreads();
  gemm_stage(Ag, lda, 0, smem, tid); gemm_stage(Bg, ldb, 0, smem + 16384, tid);
  for (int kt = 0; kt < KT; ++kt) {
    asm volatile("s_waitcnt vmcnt(0)" ::: "memory");
    __syncthreads();
    char* cur = smem + (kt & 1) * 32768;
    if (kt + 1 < KT) {
      char* nxt = smem + ((kt + 1) & 1) * 32768;
      gemm_stage(Ag, lda, (kt + 1) * 64, nxt, tid); gemm_stage(Bg, ldb, (kt + 1) * 64, nxt + 16384, tid);
    }
#pragma unroll
    for (int s4 = 0; s4 < 4; ++s4) {
      bf16x8 a[2], b[2];
      int c = 2 * s4 + (lane >> 5);
#pragma unroll
      for (int mi = 0; mi < 2; ++mi) { int row = wm * 64 + mi * 32 + (lane & 31); a[mi] = *(const bf16x8*)(cur + row * 128 + ((c ^ ((row >> 1) & 7)) << 4)); }
#pragma unroll
      for (int ni = 0; ni < 2; ++ni) { int row = wn * 64 + ni * 32 + (lane & 31); b[ni] = *(const bf16x8*)(cur + 16384 + row * 128 + ((c ^ ((row >> 1) & 7)) << 4)); }
#pragma unroll
      for (int mi = 0; mi < 2; ++mi)
#pragma unroll
        for (int ni = 0; ni < 2; ++ni) acc[mi][ni] = __builtin_amdgcn_mfma_f32_32x32x16_bf16(a[mi], b[ni], acc[mi][ni], 0, 0, 0);
    }
  }
  __syncthreads();
}
template <class Epi>
__device__ __forceinline__ void ph_gemm_bf16(const bf16_t* __restrict__ A, int lda, const bf16_t* __restrict__ Bt, int ldb, int M, int N, int K,
                             Epi epi, char* smem) {
  int tid = threadIdx.x, wave = __builtin_amdgcn_readfirstlane(tid >> 6), wm = wave >> 1, wn = wave & 1;
  int ntn = N / 128, ntiles = (M / 128) * ntn;
  int KT = K / 64;
  GRID_LOOP(tile, ntiles) {
    int mt = tile / ntn, nt = tile % ntn;
    f32x16 acc[2][2];
    gemm_tile_mainloop(A + (size_t)mt * 128 * lda, lda, Bt + (size_t)nt * 128 * ldb, ldb, KT, acc, smem);
    epi(mt * 128, nt * 128, wm, wn, acc, tid, smem);
  }
}


#define RAW_BARRIER() do { asm volatile("s_waitcnt lgkmcnt(0)" ::: "memory"); __builtin_amdgcn_s_barrier(); } while (0)
__device__ __forceinline__ void gemm_stage32x(const bf16_t* __restrict__ Ag, int lda, const bf16_t* __restrict__ Bg, int ldb, int k0, char* lds, int tid) {
#pragma unroll
  for (int i = 0; i < 2; ++i) { int q = tid + 256 * i; int row = q >> 2, p = q & 3; int c = p ^ ((row >> 2) & 3);
    __builtin_amdgcn_global_load_lds((const unsigned*)(Ag + (size_t)row * lda + k0 + c * 8), (unsigned*)(lds + q * 16), 16, 0, 0); }
#pragma unroll
  for (int i = 0; i < 2; ++i) { int q = tid + 256 * i; int row = q >> 2, p = q & 3; int c = p ^ ((row >> 2) & 3);
    __builtin_amdgcn_global_load_lds((const unsigned*)(Bg + (size_t)row * ldb + k0 + c * 8), (unsigned*)(lds + 8192 + q * 16), 16, 0, 0); }
}
__device__ __forceinline__ void gemm_tile_mainloop3(const bf16_t* __restrict__ Ag, int lda, const bf16_t* __restrict__ Bg, int ldb, int KT,
                                                    f32x16 (&acc)[2][2], char* smem) {
  int tid = threadIdx.x;
  asm volatile("" : "+v"(tid));
  int lane = tid & 63, wave = tid >> 6, wm = wave >> 1, wn = wave & 1;
#pragma unroll
  for (int mi = 0; mi < 2; ++mi)
#pragma unroll
    for (int ni = 0; ni < 2; ++ni)
#pragma unroll
      for (int r = 0; r < 16; ++r) acc[mi][ni][r] = 0.f;
  __syncthreads();
  gemm_stage32x(Ag, lda, Bg, ldb, 0, smem, tid);
  gemm_stage32x(Ag, lda, Bg, ldb, 32, smem + 16384, tid);
  gemm_stage32x(Ag, lda, Bg, ldb, 64, smem + 32768, tid);
  for (int kt = 0; kt < KT; ++kt) {
    if (kt + 2 < KT) asm volatile("s_waitcnt vmcnt(8)" ::: "memory");
    else if (kt + 1 < KT) asm volatile("s_waitcnt vmcnt(4)" ::: "memory");
    else asm volatile("s_waitcnt vmcnt(0)" ::: "memory");
    RAW_BARRIER();
    if (kt + 3 < KT) gemm_stage32x(Ag, lda, Bg, ldb, (kt + 3) * 32, smem + ((kt + 3) & 3) * 16384, tid);
    char* cur = smem + (kt & 3) * 16384;
#pragma unroll
    for (int s2 = 0; s2 < 2; ++s2) {
      bf16x8 a[2], b[2];
      int c = 2 * s2 + (lane >> 5);
#pragma unroll
      for (int mi = 0; mi < 2; ++mi) { int row = wm * 64 + mi * 32 + (lane & 31); a[mi] = *(const bf16x8*)(cur + row * 64 + ((c ^ ((row >> 2) & 3)) << 4)); }
#pragma unroll
      for (int ni = 0; ni < 2; ++ni) { int row = wn * 64 + ni * 32 + (lane & 31); b[ni] = *(const bf16x8*)(cur + 8192 + row * 64 + ((c ^ ((row >> 2) & 3)) << 4)); }
#pragma unroll
      for (int mi = 0; mi < 2; ++mi)
#pragma unroll
        for (int ni = 0; ni < 2; ++ni) acc[mi][ni] = __builtin_amdgcn_mfma_f32_32x32x16_bf16(a[mi], b[ni], acc[mi][ni], 0, 0, 0);
    }
  }
  __syncthreads();
}
template <class Epi>
__device__ __forceinline__ void ph_gemm_bf16_3(const bf16_t* __restrict__ A, int lda, const bf16_t* __restrict__ Bt, int ldb, int M, int N, int K,
                             Epi epi, char* smem) {
  int tid = threadIdx.x, wave = __builtin_amdgcn_readfirstlane(tid >> 6), wm = wave >> 1, wn = wave & 1;
  int ntn = N / 128, ntiles = (M / 128) * ntn;
  GRID_LOOP(tile, ntiles) {
    int mt = tile / ntn, nt = tile % ntn;
    f32x16 acc[2][2];
    gemm_tile_mainloop3(A + (size_t)mt * 128 * lda, lda, Bt + (size_t)nt * 128 * ldb, ldb, K / 32, acc, smem);
    epi(mt * 128, nt * 128, wm, wn, acc, tid, smem);
  }
}
__device__ __forceinline__ void ins16(float (&L)[16], float x) {
#pragma unroll
  for (int j = 15; j >= 1; --j) L[j] = __builtin_amdgcn_fmed3f(L[j - 1], L[j], x);
  L[0] = fmaxf(L[0], x);
}
__device__ __forceinline__ void stage_tile128(const bf16_t* __restrict__ src, int ld, char* lds, int tid) {
#pragma unroll
  for (int i = 0; i < 8; ++i) {
    int q = tid + 256 * i; int row = q >> 4, p = q & 15; int c = p ^ (row & 15);
    __builtin_amdgcn_global_load_lds((const unsigned*)(src + (size_t)row * ld + c * 8), (unsigned*)(lds + q * 16), 16, 0, 0);
  }
}
__device__ __forceinline__ void ph_peer_select(const bf16_t* __restrict__ H, const bf16_t* __restrict__ WQl, const bf16_t* __restrict__ SKl,
                                               int* __restrict__ EXP, float* __restrict__ GATE, int nrows, char* smem) {
  int tid = threadIdx.x, w = __builtin_amdgcn_readfirstlane(tid >> 6), wm = w >> 1, wn = w & 1;
  bf16_t* Qs = (bf16_t*)smem;
  int* KL = (int*)(smem + 36864);
  int nunits = (nrows / 128) * 8;
  GRID_LOOP(unit, nunits) {
    int mt = unit >> 3, h = unit & 7;
    float L0[16], L1[16];
#pragma unroll
    for (int p = 0; p < 2; ++p) {
      f32x16 acc[2][2];
      gemm_tile_mainloop(H + (size_t)mt * 128 * 1024, 1024, WQl + (size_t)(h * 256 + p * 128) * 1024, 1024, 16, acc, smem);
      int lane = tid & 63;
      asm volatile("" : "+v"(lane));
      {
        bf16_t* qw = Qs + (wm * 64 + 4 * (lane >> 5)) * 136 + wn * 64 + (lane & 31);
#pragma unroll
        for (int mi = 0; mi < 2; ++mi)
#pragma unroll
          for (int ni = 0; ni < 2; ++ni)
#pragma unroll
            for (int r = 0; r < 16; ++r)
              qw[(mi * 32 + (r & 3) + 8 * (r >> 2)) * 136 + ni * 32] = (bf16_t)f2bf(acc[mi][ni][r]);
      }
      __syncthreads();
      f32x16 sc[4];
#pragma unroll
      for (int m4 = 0; m4 < 4; ++m4)
#pragma unroll
        for (int r = 0; r < 16; ++r) sc[m4][r] = 0.f;
      {
        const bf16_t* qrow = Qs + (32 * w + (lane & 31)) * 136 + 8 * (lane >> 5);
        const bf16_t* krow = SKl + (size_t)(h * 2 + p) * 128 * 128 + (lane & 31) * 128 + 8 * (lane >> 5);
#pragma unroll
        for (int s8 = 0; s8 < 8; ++s8) {
          bf16x8 bq = *(const bf16x8*)(qrow + 16 * s8);
#pragma unroll
          for (int m4 = 0; m4 < 4; ++m4) {
            bf16x8 ak = *(const bf16x8*)(krow + m4 * 32 * 128 + 16 * s8);
            sc[m4] = __builtin_amdgcn_mfma_f32_32x32x16_bf16(ak, bq, sc[m4], 0, 0, 0);
          }
        }
      }
      float L[16];
#pragma unroll
      for (int j = 0; j < 16; ++j) L[j] = -INFINITY;
      unsigned kb = 4u * (unsigned)(lane >> 5);
#pragma unroll
      for (int m4 = 0; m4 < 4; ++m4)
#pragma unroll
        for (int r = 0; r < 16; ++r) {
          unsigned key = kb + (unsigned)(32 * m4 + (r & 3) + 8 * (r >> 2));
          float x = __uint_as_float((__float_as_uint(sc[m4][r]) & 0xFFFFFF80u) | key);
          ins16(L, x);
        }
      float P[16];
#pragma unroll
      for (int j = 0; j < 16; ++j) P[j] = __shfl_xor(L[j], 32);
#pragma unroll
      for (int j = 0; j < 16; ++j) ins16(L, P[j]);
      if (p == 0) {
#pragma unroll
        for (int j = 0; j < 16; ++j) L0[j] = L[j];
      } else {
#pragma unroll
        for (int j = 0; j < 16; ++j) L1[j] = L[j];
      }
    }
    float C[16];
#pragma unroll
    for (int j = 0; j < 16; ++j) C[j] = -INFINITY;
#pragma unroll
    for (int a = 0; a < 16; ++a)
#pragma unroll
      for (int b = 0; b < 16; ++b)
        if ((a + 1) * (b + 1) <= 16) {
          float sa = __uint_as_float(__float_as_uint(L0[a]) & 0xFFFFFF80u);
          float sb = __uint_as_float(__float_as_uint(L1[b]) & 0xFFFFFF80u);
          float x = __uint_as_float((__float_as_uint(sa + sb) & 0xFFFFFF00u) | (unsigned)(a * 16 + b));
          ins16(C, x);
        }
    int lane = tid & 63;
    asm volatile("" : "+v"(lane));
    int token = 32 * w + (lane & 31);
    if (lane < 32) {
#pragma unroll
      for (int j = 0; j < 16; ++j) { KL[token * 32 + j] = (int)(__float_as_uint(L0[j]) & 0x7Fu); KL[token * 32 + 16 + j] = (int)(__float_as_uint(L1[j]) & 0x7Fu); }
    }
    __syncthreads();
    if (lane < 32) {
      float c0 = __uint_as_float(__float_as_uint(C[0]) & 0xFFFFFF00u);
      float ev[16]; float sum = 0.f; int ex[16];
#pragma unroll
      for (int j = 0; j < 16; ++j) {
        unsigned bits = __float_as_uint(C[j]);
        float cv = __uint_as_float(bits & 0xFFFFFF00u);
        ev[j] = __expf(cv - c0); sum += ev[j];
        int a = (bits >> 4) & 15, b = bits & 15;
        ex[j] = KL[token * 32 + a] * 128 + KL[token * 32 + 16 + b];
      }
      float inv = 1.f / sum;
      size_t o = (size_t)(mt * 128 + token) * 128 + h * 16;
#pragma unroll
      for (int j = 0; j < 16; j += 4) {
        *(int4*)(EXP + o + j) = make_int4(ex[j], ex[j + 1], ex[j + 2], ex[j + 3]);
        *(float4*)(GATE + o + j) = make_float4(ev[j] * inv, ev[j + 1] * inv, ev[j + 2] * inv, ev[j + 3] * inv);
      }
    }
  }
}

__device__ __forceinline__ void fft1_unit(int u, const bf16_t* __restrict__ FQKV, const bf16_t* __restrict__ D1, const float* __restrict__ TAB,
                          bf16_t* __restrict__ A1, char* smem) {
  int tid = threadIdx.x, lane = tid & 63, w = __builtin_amdgcn_readfirstlane(tid >> 6);
  int g = u & 7, c = (u >> 3) & 63, b = u >> 9;
  bf16_t* Bt = (bf16_t*)smem;
  __syncthreads();
  {
    int r = tid >> 1, half = tid & 1;
    const uint4* src = (const uint4*)(FQKV + (size_t)(b * S + 64 * r + c) * 2048 + g * 64 + half * 32);
    unsigned wv[16];
#pragma unroll
    for (int i = 0; i < 4; ++i) { uint4 v = src[i]; wv[4 * i] = v.x; wv[4 * i + 1] = v.y; wv[4 * i + 2] = v.z; wv[4 * i + 3] = v.w; }
#pragma unroll
    for (int j = 0; j < 32; ++j) {
      unsigned e = (j & 1) ? (wv[j >> 1] >> 16) : (wv[j >> 1] & 0xffffu);
      Bt[(half * 32 + j) * 136 + r] = (bf16_t)e;
    }
  }
  __syncthreads();
  f32x16 acc[2][2];
#pragma unroll
  for (int mi = 0; mi < 2; ++mi)
#pragma unroll
    for (int ni = 0; ni < 2; ++ni)
#pragma unroll
      for (int r = 0; r < 16; ++r) acc[mi][ni][r] = 0.f;
#pragma unroll
  for (int s8 = 0; s8 < 8; ++s8) {
    bf16x8 a[2], bb[2];
    int ko = 16 * s8 + 8 * (lane >> 5);
#pragma unroll
    for (int mi = 0; mi < 2; ++mi) a[mi] = *(const bf16x8*)(D1 + (64 * w + 32 * mi + (lane & 31)) * 128 + ko);
#pragma unroll
    for (int ni = 0; ni < 2; ++ni) bb[ni] = *(const bf16x8*)(Bt + (32 * ni + (lane & 31)) * 136 + ko);
#pragma unroll
    for (int mi = 0; mi < 2; ++mi)
#pragma unroll
      for (int ni = 0; ni < 2; ++ni) acc[mi][ni] = __builtin_amdgcn_mfma_f32_32x32x16_bf16(a[mi], bb[ni], acc[mi][ni], 0, 0, 0);
  }
  bf16_t* Ot = (bf16_t*)(smem + 17408);
#pragma unroll
  for (int mi = 0; mi < 2; ++mi)
#pragma unroll
    for (int j = 0; j < 8; ++j) {
      int m = 64 * w + 32 * mi + ((2 * j) & 3) + 8 * ((2 * j) >> 2) + 4 * (lane >> 5);
      int k1 = m >> 1;
      int idx = (k1 * c) & 8191;
      float cs = TAB[idx], sn = TAB[8192 + idx];
#pragma unroll
      for (int ni = 0; ni < 2; ++ni) {
        float re = acc[mi][ni][2 * j], im = acc[mi][ni][2 * j + 1];
        float re2 = re * cs + im * sn, im2 = im * cs - re * sn;
        bf16_t* dst = Ot + m * 72 + 32 * ni + (lane & 31);
        dst[0] = (bf16_t)f2bf(re2); dst[72] = (bf16_t)f2bf(im2);
      }
    }
  __syncthreads();
  {
    bf16_t* base = A1 + (((size_t)b * 64 + c) * 128) * 2 * 512 + g * 64;
#pragma unroll
    for (int i = 0; i < 8; ++i) {
      int q = tid + 256 * i; int m = q >> 3, ch8 = q & 7;
      *(uint4*)(base + (size_t)m * 512 + ch8 * 8) = *(const uint4*)(Ot + m * 72 + ch8 * 8);
    }
  }
}

__device__ __forceinline__ void fft3_unit(int u, int mode, const bf16_t* __restrict__ FQKV, const bf16_t* __restrict__ A1, const bf16_t* __restrict__ D3,
                          const bf16_t* __restrict__ DcT, const float* __restrict__ TAB, bf16_t* __restrict__ MIX, char* smem) {
  int tid = threadIdx.x, lane = tid & 63, w = __builtin_amdgcn_readfirstlane(tid >> 6);
  bf16_t* Bt = (bf16_t*)smem;
  bf16_t* Xs = (bf16_t*)(smem + 17408);
  int g = u & 7, k1, b, nk1, rowbase; float norm;
  __syncthreads();
  if (mode == 0) {
    k1 = (u >> 3) & 127; b = u >> 10; nk1 = 128; rowbase = b * S; norm = 1.f / 724.0773439350247f;
    int kk = tid >> 1, half = tid & 1; int c = kk >> 1, ri = kk & 1;
    const uint4* src = (const uint4*)(A1 + ((((size_t)b * 64 + c) * 128 + k1) * 2 + ri) * 512 + g * 64 + half * 32);
    unsigned wv[16];
#pragma unroll
    for (int i = 0; i < 4; ++i) { uint4 v = src[i]; wv[4 * i] = v.x; wv[4 * i + 1] = v.y; wv[4 * i + 2] = v.z; wv[4 * i + 3] = v.w; }
#pragma unroll
    for (int j = 0; j < 32; ++j) {
      unsigned e = (j & 1) ? (wv[j >> 1] >> 16) : (wv[j >> 1] & 0xffffu);
      Bt[(half * 32 + j) * 136 + kk] = (bf16_t)e;
    }
  } else {
    k1 = (u >> 3) & 3; b = u >> 5; nk1 = 4; rowbase = T + b * CL; norm = 1.f / 128.f;
    int c = tid >> 2, q4 = tid & 3;
    float re[16], im[16];
#pragma unroll
    for (int j = 0; j < 16; ++j) { re[j] = 0.f; im[j] = 0.f; }
#pragma unroll
    for (int r = 0; r < 4; ++r) {
      const uint4* src = (const uint4*)(FQKV + (size_t)(rowbase + 64 * r + c) * 2048 + g * 64 + q4 * 16);
      uint4 v0 = src[0], v1 = src[1];
      unsigned wv[8] = {v0.x, v0.y, v0.z, v0.w, v1.x, v1.y, v1.z, v1.w};
      int ph = (k1 * r) & 3;
      float cr = (ph == 0) ? 1.f : (ph == 2 ? -1.f : 0.f);
      float ci = (ph == 1) ? -1.f : (ph == 3 ? 1.f : 0.f);
#pragma unroll
      for (int j = 0; j < 16; ++j) {
        float x = bf2f((unsigned short)((j & 1) ? (wv[j >> 1] >> 16) : (wv[j >> 1] & 0xffffu)));
        re[j] += x * cr; im[j] += x * ci;
      }
    }
    int idx = (k1 * c * 32) & 8191;
    float cs = TAB[idx], sn = TAB[8192 + idx];
#pragma unroll
    for (int j = 0; j < 16; ++j) {
      float re2 = re[j] * cs + im[j] * sn, im2 = im[j] * cs - re[j] * sn;
      *(unsigned*)(Bt + (q4 * 16 + j) * 136 + 2 * c) = pack2bf(re2, im2);
    }
  }
  __syncthreads();
  {
    f32x16 acc[2];
#pragma unroll
    for (int ni = 0; ni < 2; ++ni)
#pragma unroll
      for (int r = 0; r < 16; ++r) acc[ni][r] = 0.f;
#pragma unroll
    for (int s8 = 0; s8 < 8; ++s8) {
      int ko = 16 * s8 + 8 * (lane >> 5);
      bf16x8 a = *(const bf16x8*)(D3 + (32 * w + (lane & 31)) * 128 + ko);
#pragma unroll
      for (int ni = 0; ni < 2; ++ni) {
        bf16x8 bb = *(const bf16x8*)(Bt + (32 * ni + (lane & 31)) * 136 + ko);
        acc[ni] = __builtin_amdgcn_mfma_f32_32x32x16_bf16(a, bb, acc[ni], 0, 0, 0);
      }
    }
#pragma unroll
    for (int ni = 0; ni < 2; ++ni)
#pragma unroll
      for (int r = 0; r < 16; ++r) {
        int m = 32 * w + (r & 3) + 8 * (r >> 2) + 4 * (lane >> 5);
        Xs[(m & 63) * 136 + (m >> 6) * 64 + 32 * ni + (lane & 31)] = (bf16_t)f2bf(acc[ni][r]);
      }
  }
  __syncthreads();
  {
    int mi = w >> 1, ni = w & 1;
    f32x16 acc;
#pragma unroll
    for (int r = 0; r < 16; ++r) acc[r] = 0.f;
#pragma unroll
    for (int s8 = 0; s8 < 8; ++s8) {
      int ko = 16 * s8 + 8 * (lane >> 5);
      bf16x8 a = *(const bf16x8*)(Xs + (32 * mi + (lane & 31)) * 136 + ko);
      bf16x8 bb = *(const bf16x8*)(DcT + (32 * ni + (lane & 31)) * 128 + ko);
      acc = __builtin_amdgcn_mfma_f32_32x32x16_bf16(a, bb, acc, 0, 0, 0);
    }
    bf16_t* Yt = Bt;
#pragma unroll
    for (int r = 0; r < 16; ++r) {
      int k2 = 32 * mi + (r & 3) + 8 * (r >> 2) + 4 * (lane >> 5);
      Yt[k2 * 72 + 32 * ni + (lane & 31)] = (bf16_t)f2bf(acc[r] * norm);
    }
  }
  __syncthreads();
#pragma unroll
  for (int i = 0; i < 2; ++i) {
    int q = tid + 256 * i; int k2 = q >> 3, ch8 = q & 7;
    int row = rowbase + k1 + nk1 * k2;
    *(uint4*)(MIX + (size_t)row * 1024 + g * 64 + ch8 * 8) = *(const uint4*)((const bf16_t*)smem + k2 * 72 + ch8 * 8);
  }
}

typedef __attribute__((ext_vector_type(4))) float f32x4_t;
__device__ __forceinline__ bf16x8 ld16(const bf16_t* p) { return *(const bf16x8*)p; }
__device__ __forceinline__ float fast_exp2(float x) { return __builtin_amdgcn_exp2f(x); }

template <int NH, int MODE, int KPI, bool PF>
__device__ __forceinline__ void attn_unit(int b, int hk, int r, int jb, int qb, const bf16_t* __restrict__ Qp, int ldq, const bf16_t* __restrict__ Kp, int ldk,
                                          const bf16_t* __restrict__ VTl, const bf16_t* __restrict__ VTc, int nkvh,
                                          const float* rpbs, const float* __restrict__ sink,
                                          bf16_t* __restrict__ Op, int ldo, int lane) {
  const float LOG2E = 1.4426950408889634f;
  const float SC = 0.125f * LOG2E;
  asm volatile("" : "+v"(lane));
  int ql = lane & 15, g = lane >> 4;
  int qrow0, q0 = 0;
  int nloc, lb0 = 0;
  if (MODE == 0) { qrow0 = b * S + r * 64 + 16 * jb; nloc = 8; }
  else if (MODE == 1) { qrow0 = T + b * CL + 16 * qb; nloc = 0; }
  else { q0 = 16 * qb; qrow0 = b * S + q0;
         int lo = (q0 - 128) >> 5, hi = (q0 + 143) >> 5; if (lo < 0) lo = 0; if (hi > 255) hi = 255; lb0 = lo; nloc = hi - lo + 1; }
  bf16x8 qf[NH][2];
#pragma unroll
  for (int hh = 0; hh < NH; ++hh)
#pragma unroll
    for (int s2 = 0; s2 < 2; ++s2)
      qf[hh][s2] = ld16(Qp + (size_t)(qrow0 + ql) * ldq + (hk * NH + hh) * 64 + 32 * s2 + 8 * g);
  f32x4_t o[NH][4]; float mrun[NH], lrun[NH];
#pragma unroll
  for (int hh = 0; hh < NH; ++hh) {
    mrun[hh] = -1e30f; lrun[hh] = 0.f;
#pragma unroll
    for (int dt = 0; dt < 4; ++dt) o[hh][dt] = (f32x4_t){0.f, 0.f, 0.f, 0.f};
  }
  int r_start = 0, blk_start = 0, c_lo = 0, qc = 0;
  if (MODE == 0) {
    r_start = min(max(r - 4, 0), 120);
    blk_start = min(max(16 * jb - 8, 0), 32);
    qc = 16 * jb + ql; c_lo = min(max(qc - 8, 0), 48);
  }
  if (MODE == 2 && KPI == 2) nloc = (nloc + 1) & ~1;
  int nit = (nloc + 8) / KPI;
#define ATT_DESC(kbx, krow0_, vtp_, vld_) \
    { bool il_ = (kbx) < nloc; int vt0_; \
      if (il_) { if (MODE == 0) { int rr_ = r_start + (kbx); krow0_ = b * S + rr_ * 64 + blk_start; vt0_ = rr_ * 64 + blk_start; } \
                 else { krow0_ = b * S + 32 * (lb0 + (kbx)); vt0_ = 32 * (lb0 + (kbx)); } \
                 vtp_ = VTl + ((size_t)(b * nkvh + hk) * 64) * S + vt0_; vld_ = S; } \
      else { int cb_ = (kbx) - nloc; krow0_ = T + b * CL + 32 * cb_; vt0_ = 32 * cb_; \
             vtp_ = VTc + ((size_t)(b * nkvh + hk) * 64) * CL + vt0_; vld_ = CL; } }
#define ATT_LOAD(kbx, KF, VF) \
    { int krow0; const bf16_t* vt; int vld; ATT_DESC(kbx, krow0, vt, vld) \
      _Pragma("unroll") for (int t = 0; t < 2; ++t) _Pragma("unroll") for (int s2 = 0; s2 < 2; ++s2) \
        KF[t][s2] = ld16(Kp + (size_t)(krow0 + 8 * (ql >> 2) + 4 * t + (ql & 3)) * ldk + hk * 64 + 32 * s2 + 8 * g); \
      _Pragma("unroll") for (int dt = 0; dt < 4; ++dt) VF[dt] = ld16(vt + (size_t)(16 * dt + ql) * vld + 8 * g); }
  bf16x8 kfn[PF ? KPI : 1][2][2], vfn[PF ? KPI : 1][4];
  if (PF) {
#pragma unroll
    for (int kk = 0; kk < KPI; ++kk) ATT_LOAD(kk, kfn[kk], vfn[kk])
  }
  for (int it = 0; it < nit; ++it) {
    bf16x8 kf[KPI][2][2], vf[KPI][4];
    if (PF) {
#pragma unroll
      for (int kk = 0; kk < KPI; ++kk) {
#pragma unroll
        for (int t = 0; t < 2; ++t)
#pragma unroll
          for (int s2 = 0; s2 < 2; ++s2) kf[kk][t][s2] = kfn[kk][t][s2];
#pragma unroll
        for (int dt = 0; dt < 4; ++dt) vf[kk][dt] = vfn[kk][dt];
      }
      if (it + 1 < nit) {
#pragma unroll
        for (int kk = 0; kk < KPI; ++kk) ATT_LOAD((it + 1) * KPI + kk, kfn[kk], vfn[kk])
      }
    } else {
#pragma unroll
      for (int kk = 0; kk < KPI; ++kk) ATT_LOAD(it * KPI + kk, kf[kk], vf[kk])
    }
    float bias[KPI][2][4]; bool valid[KPI][2][4];
#pragma unroll
    for (int kk = 0; kk < KPI; ++kk) {
      int kb = it * KPI + kk;
      bool is_loc = kb < nloc;
#pragma unroll
      for (int t = 0; t < 2; ++t)
#pragma unroll
        for (int i = 0; i < 4; ++i) {
          bias[kk][t][i] = 0.f; valid[kk][t][i] = true;
          if (MODE == 0 && is_loc) {
            int kc = blk_start + 8 * g + 4 * t + i;
            valid[kk][t][i] = (kc >= c_lo) && (kc < c_lo + 16);
            int dc = min(max(kc - qc, -15), 15) + 15;
            bias[kk][t][i] = rpbs[(hk * 15 + (r_start + kb - r + 7)) * 31 + dc];
          }
          if (MODE == 2 && is_loc) {
            int kpos = 32 * (lb0 + kb) + 8 * g + 4 * t + i; int dq = (q0 + ql) - kpos;
            bias[kk][t][i] = ((dq <= 128) && (dq >= -128)) ? 0.f : -1e30f;
          }
        }
    }
#pragma unroll
    for (int hh = 0; hh < NH; ++hh) {
      f32x4_t st[KPI][2];
#pragma unroll
      for (int kk = 0; kk < KPI; ++kk)
#pragma unroll
        for (int t = 0; t < 2; ++t) {
          st[kk][t] = (f32x4_t){0.f, 0.f, 0.f, 0.f};
          st[kk][t] = __builtin_amdgcn_mfma_f32_16x16x32_bf16(kf[kk][t][0], qf[hh][0], st[kk][t], 0, 0, 0);
          st[kk][t] = __builtin_amdgcn_mfma_f32_16x16x32_bf16(kf[kk][t][1], qf[hh][1], st[kk][t], 0, 0, 0);
        }
      float lg[KPI][2][4]; float bm = -1e30f;
#pragma unroll
      for (int kk = 0; kk < KPI; ++kk)
#pragma unroll
        for (int t = 0; t < 2; ++t)
#pragma unroll
          for (int i = 0; i < 4; ++i) {
            float v = (MODE == 0) ? (valid[kk][t][i] ? (st[kk][t][i] * SC + bias[kk][t][i]) : -1e30f) : fmaf(st[kk][t][i], SC, bias[kk][t][i]);
            lg[kk][t][i] = v; bm = fmaxf(bm, v);
          }
      bm = xrow16_max(bm);
      float mn = fmaxf(mrun[hh], bm);
      float alpha = fast_exp2(mrun[hh] - mn);
      mrun[hh] = mn;
      float ps = 0.f;
      bf16x8 pf[KPI];
#pragma unroll
      for (int kk = 0; kk < KPI; ++kk) {
        float pv[8];
#pragma unroll
        for (int t = 0; t < 2; ++t)
#pragma unroll
          for (int i = 0; i < 4; ++i) {
            float p = (MODE == 0) ? (valid[kk][t][i] ? fast_exp2(lg[kk][t][i] - mn) : 0.f) : fast_exp2(lg[kk][t][i] - mn);
            pv[4 * t + i] = p; ps += p;
          }
        typedef __attribute__((ext_vector_type(4))) unsigned u32x4;
        u32x4 uu = {pack2bf(pv[0], pv[1]), pack2bf(pv[2], pv[3]), pack2bf(pv[4], pv[5]), pack2bf(pv[6], pv[7])};
        pf[kk] = __builtin_bit_cast(bf16x8, uu);
      }
      lrun[hh] = lrun[hh] * alpha + ps;
#pragma unroll
      for (int dt = 0; dt < 4; ++dt) {
        o[hh][dt] *= alpha;
#pragma unroll
        for (int kk = 0; kk < KPI; ++kk)
          o[hh][dt] = __builtin_amdgcn_mfma_f32_16x16x32_bf16(vf[kk][dt], pf[kk], o[hh][dt], 0, 0, 0);
      }
      if (NH == 4 && KPI == 2 && (hh & 1)) __builtin_amdgcn_sched_barrier(0);
    }
  }
#undef ATT_LOAD
#undef ATT_DESC
#pragma unroll
  for (int hh = 0; hh < NH; ++hh) {
    float l = xrow16_sum(lrun[hh]);
    float m = mrun[hh];
    if (MODE == 2) {
      float sk = sink[hk * NH + hh] * LOG2E;
      float mf = fmaxf(m, sk);
      float a = fast_exp2(m - mf);
      l = l * a + fast_exp2(sk - mf);
#pragma unroll
      for (int dt = 0; dt < 4; ++dt) o[hh][dt] *= a;
    }
    float inv = 1.f / l;
    bf16_t* orow = Op + (size_t)(qrow0 + ql) * ldo + (hk * NH + hh) * 64 + 4 * g;
#pragma unroll
    for (int dt = 0; dt < 4; ++dt) {
      f32x4_t v = o[hh][dt] * inv;
      *(uint2*)(orow + 16 * dt) = make_uint2(pack2bf(v[0], v[1]), pack2bf(v[2], v[3]));
    }
  }
}

struct NaState { f32x4_t o[4][4]; float m[4], l[4]; };
template <int HB>
__device__ __forceinline__ void na_block(NaState& st, const bf16x8 (&qf)[4][2], const bf16x8 (&kf)[2][2], const bf16x8 (&vf)[4],
                                         const float* rpbrow  , int ql, int g) {
  const float SC = 0.125f * 1.4426950408889634f;
#pragma unroll
  for (int jb = 0; jb < 4; ++jb) {
    if (HB == 0 && jb == 3) continue;
    if (HB == 1 && jb == 0) continue;
    f32x4_t s2[2];
#pragma unroll
    for (int t = 0; t < 2; ++t) {
      s2[t] = (f32x4_t){0.f, 0.f, 0.f, 0.f};
      s2[t] = __builtin_amdgcn_mfma_f32_16x16x32_bf16(kf[t][0], qf[jb][0], s2[t], 0, 0, 0);
      s2[t] = __builtin_amdgcn_mfma_f32_16x16x32_bf16(kf[t][1], qf[jb][1], s2[t], 0, 0, 0);
    }
    float lg[8]; bool valid[8]; float bm = -1e30f;
#pragma unroll
    for (int t = 0; t < 2; ++t)
#pragma unroll
      for (int i = 0; i < 4; ++i) {
        float v;
        if (HB < 2) {
          int qc = 16 * jb + ql; int c_lo = min(max(qc - 8, 0), 48);
          int kc = 32 * HB + 8 * g + 4 * t + i;
          bool ok = (kc >= c_lo) && (kc < c_lo + 16);
          int dc = min(max(kc - qc, -15), 15) + 15;
          v = ok ? (s2[t][i] * SC + rpbrow[dc]) : -1e30f;
          valid[4 * t + i] = ok;
        } else { v = s2[t][i] * SC; valid[4 * t + i] = true; }
        lg[4 * t + i] = v; bm = fmaxf(bm, v);
      }
    bm = xrow16_max(bm);
    float mn = fmaxf(st.m[jb], bm);
    float alpha = fast_exp2(st.m[jb] - mn);
    st.m[jb] = mn;
    float ps = 0.f; float pv[8];
#pragma unroll
    for (int e = 0; e < 8; ++e) { float p = valid[e] ? fast_exp2(lg[e] - mn) : 0.f; pv[e] = p; ps += p; }
    st.l[jb] = st.l[jb] * alpha + ps;
    typedef __attribute__((ext_vector_type(4))) unsigned u32x4;
    u32x4 uu = {pack2bf(pv[0], pv[1]), pack2bf(pv[2], pv[3]), pack2bf(pv[4], pv[5]), pack2bf(pv[6], pv[7])};
    bf16x8 pf = __builtin_bit_cast(bf16x8, uu);
#pragma unroll
    for (int dt = 0; dt < 4; ++dt) {
      st.o[jb][dt] *= alpha;
      st.o[jb][dt] = __builtin_amdgcn_mfma_f32_16x16x32_bf16(vf[dt], pf, st.o[jb][dt], 0, 0, 0);
    }
    if (jb & 1) __builtin_amdgcn_sched_barrier(0);
  }
}
__device__ __forceinline__ void na_unit(int b, int h, int r, const bf16_t* __restrict__ FQKV, const bf16_t* __restrict__ VTl,
                                        const bf16_t* __restrict__ VTc, const float* rpbs, bf16_t* __restrict__ MIX, int lane) {
  asm volatile("" : "+v"(lane));
  int ql = lane & 15, g = lane >> 4;
  int qrow0 = b * S + r * 64;
  int r_start = min(max(r - 4, 0), 120);
  bf16x8 qf[4][2];
#pragma unroll
  for (int jb = 0; jb < 4; ++jb)
#pragma unroll
    for (int s2 = 0; s2 < 2; ++s2)
      qf[jb][s2] = ld16(FQKV + (size_t)(qrow0 + 16 * jb + ql) * 2048 + 512 + h * 64 + 32 * s2 + 8 * g);
  NaState st;
#pragma unroll
  for (int jb = 0; jb < 4; ++jb) {
    st.m[jb] = -1e30f; st.l[jb] = 0.f;
#pragma unroll
    for (int dt = 0; dt < 4; ++dt) st.o[jb][dt] = (f32x4_t){0.f, 0.f, 0.f, 0.f};
  }
  unsigned koff = (unsigned)((8 * (ql >> 2) + (ql & 3)) * 2048 + 1024 + h * 64 + 8 * g);
  unsigned voffl = (unsigned)(ql * S + 8 * g), voffc = (unsigned)(ql * CL + 8 * g);
  const bf16_t* vtl = VTl + (size_t)(b * 8 + h) * 64 * S;
  const bf16_t* vtc = VTc + (size_t)(b * 8 + h) * 64 * CL;
#define NA_LOADK(kb2, KF) { \
    int krow0_; \
    if ((kb2) < 16) krow0_ = b * S + (r_start + ((kb2) >> 1)) * 64 + 32 * ((kb2) & 1); \
    else krow0_ = T + b * CL + 32 * ((kb2) - 16); \
    const bf16_t* kb_ = FQKV + (size_t)krow0_ * 2048; \
    _Pragma("unroll") for (int t = 0; t < 2; ++t) _Pragma("unroll") for (int s2 = 0; s2 < 2; ++s2) \
      KF[t][s2] = ld16(kb_ + (koff + (unsigned)(t * 4 * 2048 + 32 * s2))); }
#define NA_LOADV(kb2, VF) { \
    if ((kb2) < 16) { const bf16_t* vt_ = vtl + (r_start + ((kb2) >> 1)) * 64 + 32 * ((kb2) & 1); \
      _Pragma("unroll") for (int dt = 0; dt < 4; ++dt) VF[dt] = ld16(vt_ + (voffl + (unsigned)(16 * dt * S))); } \
    else { const bf16_t* vt_ = vtc + 32 * ((kb2) - 16); \
      _Pragma("unroll") for (int dt = 0; dt < 4; ++dt) VF[dt] = ld16(vt_ + (voffc + (unsigned)(16 * dt * CL))); } }
  bf16x8 kfa[2][2], kfb[2][2], vfa[4], vfb[4];
  NA_LOADK(0, kfa) NA_LOADV(0, vfa)
#pragma unroll 1
  for (int rr = 0; rr < 8; ++rr) {
    const float* rpbrow = rpbs + (h * 15 + (r_start + rr - r + 7)) * 31;
    asm volatile("" : "+v"(lane)); ql = lane & 15; g = lane >> 4;
    koff = (unsigned)((8 * (ql >> 2) + (ql & 3)) * 2048 + 1024 + h * 64 + 8 * g); voffl = (unsigned)(ql * S + 8 * g); voffc = (unsigned)(ql * CL + 8 * g);
    NA_LOADK(2 * rr + 1, kfb) NA_LOADV(2 * rr + 1, vfb)
    na_block<0>(st, qf, kfa, vfa, rpbrow, ql, g);
    NA_LOADK(2 * rr + 2, kfa) NA_LOADV(2 * rr + 2, vfa)
    na_block<1>(st, qf, kfb, vfb, rpbrow, ql, g);
  }
#pragma unroll 1
  for (int cb = 0; cb < 8; cb += 2) {
    asm volatile("" : "+v"(lane)); ql = lane & 15; g = lane >> 4;
    koff = (unsigned)((8 * (ql >> 2) + (ql & 3)) * 2048 + 1024 + h * 64 + 8 * g); voffc = (unsigned)(ql * CL + 8 * g);
    NA_LOADK(16 + cb + 1, kfb) NA_LOADV(16 + cb + 1, vfb)
    na_block<2>(st, qf, kfa, vfa, rpbs, ql, g);
    if (cb + 2 < 8) { NA_LOADK(16 + cb + 2, kfa) NA_LOADV(16 + cb + 2, vfa) }
    na_block<2>(st, qf, kfb, vfb, rpbs, ql, g);
  }
#undef NA_LOADK
#undef NA_LOADV
  asm volatile("" : "+v"(lane)); ql = lane & 15; g = lane >> 4;
#pragma unroll
  for (int jb = 0; jb < 4; ++jb) {
    float inv = 1.f / xrow16_sum(st.l[jb]);
    bf16_t* orow = MIX + (size_t)(qrow0 + 16 * jb + ql) * 1024 + 512 + h * 64 + 4 * g;
#pragma unroll
    for (int dt = 0; dt < 4; ++dt) {
      f32x4_t v = st.o[jb][dt] * inv;
      *(uint2*)(orow + 16 * dt) = make_uint2(pack2bf(v[0], v[1]), pack2bf(v[2], v[3]));
    }
  }
}

__device__ __forceinline__ void ph_chan_dft(const float* __restrict__ F, const float* __restrict__ tab, float* __restrict__ PQ) {
  for (int gid = blockIdx.x * 256 + threadIdx.x; gid < R * 512; gid += gridDim.x * 256) {
    int row = gid >> 9; int col = gid & 511; int g = col >> 6, cp = col & 63;
    const float* f = F + (size_t)row * 2048 + g * 64;
    float p = 0.f, q = 0.f;
    for (int ch = 0; ch < 64; ++ch) {
      int idx = ((ch * cp) & 63) * 128;
      float x = f[ch];
      p += x * tab[idx]; q += x * tab[8192 + idx];
    }
    PQ[(size_t)row * 1024 + col] = p;
    PQ[(size_t)row * 1024 + 512 + col] = q;
  }
}

__device__ __forceinline__ void ph_na(const bf16_t* __restrict__ F, const float* __restrict__ rpb, bf16_t* __restrict__ MIX, float* sm) {
  int lane = threadIdx.x & 63, wave = __builtin_amdgcn_readfirstlane(threadIdx.x >> 6);
  float* sq = sm + wave * 1024; float* sp = sq + 64; int* stok = (int*)(sp + 384);
  int nitems = R * 8;
  for (int item0 = blockIdx.x * 4; item0 < nitems; item0 += gridDim.x * 4) {
    int item = item0 + wave;
    int h = item & 7; int row = item >> 3;
    bool is_ctx = row >= T;
    int b = is_ctx ? (row - T) / CL : row / S;
    __syncthreads();
    sq[lane] = bf2f(F[(size_t)row * 2048 + 512 + h * 64 + lane]);
    __syncthreads();
    int r = 0, c = 0, r_start = 0, c_start = 0;
    if (!is_ctx) { int t = row % S; r = t / 64; c = t % 64; r_start = min(max(r - 4, 0), 120); c_start = min(max(c - 8, 0), 48); }
    int nk = is_ctx ? 256 : 384;
    float lg[6]; float mx = -INFINITY;
#pragma unroll
    for (int kk = 0; kk < 6; ++kk) {
      int j = kk * 64 + lane; float s = -INFINITY; int tok = 0;
      if (j < nk) {
        float bias = 0.f;
        if (!is_ctx && j < 128) {
          int kr = j >> 4, kc = j & 15; int rr = r_start + kr, cc = c_start + kc;
          tok = b * S + rr * 64 + cc;
          int dc = min(max(cc - c, -15), 15) + 15;
          bias = rpb[(h * 15 + (rr - r + 7)) * 31 + dc];
        } else {
          int l = is_ctx ? j : j - 128; tok = T + b * CL + l;
        }
        const bf16_t* kp = F + (size_t)tok * 2048 + 1024 + h * 64;
        float acc = 0.f;
#pragma unroll 8
        for (int d = 0; d < 64; ++d) acc += sq[d] * bf2f(kp[d]);
        s = acc * 0.125f + bias;
      }
      lg[kk] = s; stok[j] = tok; mx = fmaxf(mx, s);
    }
    mx = wave_max(mx);
    float sum = 0.f;
#pragma unroll
    for (int kk = 0; kk < 6; ++kk) { float e = (kk * 64 + lane < nk) ? expf(lg[kk] - mx) : 0.f; lg[kk] = e; sum += e; }
    sum = wave_sum(sum);
    float inv = 1.f / sum;
#pragma unroll
    for (int kk = 0; kk < 6; ++kk) sp[kk * 64 + lane] = lg[kk] * inv;
    __syncthreads();
    float o = 0.f;
    for (int j = 0; j < nk; ++j) o += sp[j] * bf2f(F[(size_t)stok[j] * 2048 + 1536 + h * 64 + lane]);
    MIX[(size_t)row * 1024 + 512 + h * 64 + lane] = (bf16_t)f2bf(o);
  }
}

__device__ __forceinline__ void ph_rope(float* __restrict__ F1) {
  for (int gid = blockIdx.x * 256 + threadIdx.x; gid < T * 20 * 32; gid += gridDim.x * 256) {
    int i = gid & 31; int hh = (gid >> 5) % 20; int row = gid / (32 * 20);
    int t = row % S; float rowp = (float)(t / 64), colp = (float)(t % 64);
    int fi = i & 15;
    float inv_freq = powf(10000.0f, -(float)fi / 16.0f);
    float ang = (i < 16 ? rowp : colp) * inv_freq;
    float cs = cosf(ang), sn = sinf(ang);
    float* p = F1 + (size_t)row * 1536 + hh * 64;
    float x1 = p[i], x2 = p[i + 32];
    p[i] = x1 * cs - x2 * sn;
    p[i + 32] = x1 * sn + x2 * cs;
  }
}

__device__ __forceinline__ void ph_gqa(const float* __restrict__ F1, const float* __restrict__ sink, bf16_t* __restrict__ O, float* sm) {
  int lane = threadIdx.x & 63, wave = __builtin_amdgcn_readfirstlane(threadIdx.x >> 6);
  float* sq = sm + wave * 1280; float* sp = sq + 64; int* stok = (int*)(sp + 576);
  int nitems = T * 16;
  for (int item0 = blockIdx.x * 4; item0 < nitems; item0 += gridDim.x * 4) {
    int item = item0 + wave;
    int qh = item & 15; int row = item >> 4; int kvh = qh >> 2;
    int b = row / S; int t = row % S;
    __syncthreads();
    sq[lane] = F1[(size_t)row * 1536 + qh * 64 + lane];
    __syncthreads();
    float lg[9]; float mx = -INFINITY;
#pragma unroll
    for (int kk = 0; kk < 9; ++kk) {
      int j = kk * 64 + lane; float s = -INFINITY; int tok = 0; bool valid = false;
      if (j < 257) { int pos = t - 128 + j; valid = (pos >= 0 && pos < S); tok = b * S + pos; }
      else if (j < 513) { valid = true; tok = T + b * CL + (j - 257); }
      if (valid) {
        const float* kp = F1 + (size_t)tok * 1536 + 1024 + kvh * 64;
        float acc = 0.f;
#pragma unroll 8
        for (int d = 0; d < 64; ++d) acc += sq[d] * kp[d];
        s = acc * 0.125f;
      } else tok = 0;
      lg[kk] = s; stok[j] = tok; mx = fmaxf(mx, s);
    }
    mx = wave_max(mx);
    float sk = sink[qh];
    mx = fmaxf(mx, sk);
    float sum = 0.f;
#pragma unroll
    for (int kk = 0; kk < 9; ++kk) { float e = (lg[kk] == -INFINITY) ? 0.f : expf(lg[kk] - mx); lg[kk] = e; sum += e; }
    sum = wave_sum(sum) + expf(sk - mx);
    float inv = 1.f / sum;
#pragma unroll
    for (int kk = 0; kk < 9; ++kk) sp[kk * 64 + lane] = lg[kk] * inv;
    __syncthreads();
    float o = 0.f;
    for (int j = 0; j < 513; ++j) { float p = sp[j]; if (p != 0.f) o += p * F1[(size_t)stok[j] * 1536 + 1280 + kvh * 64 + lane]; }
    O[(size_t)row * 1024 + qh * 64 + lane] = (bf16_t)f2bf(o);
  }
}

__device__ __forceinline__ void wave_argmax(float& v, int& idx) {
#pragma unroll
  for (int off = 32; off; off >>= 1) {
    float ov = __shfl_xor(v, off); int oi = __shfl_xor(idx, off);
    if (ov > v || (ov == v && oi < idx)) { v = ov; idx = oi; }
  }
}
__device__ __forceinline__ void ph_peer_select_naive(const float* __restrict__ Q, const float* __restrict__ sk, int* __restrict__ EXP,
                                     float* __restrict__ GATE, int nrows, float* sm) {
  int lane = threadIdx.x & 63, wave = __builtin_amdgcn_readfirstlane(threadIdx.x >> 6);
  float* sq = sm + wave * 640; float* tops = sq + 256; int* topi = (int*)(tops + 32);
  for (int row0 = blockIdx.x * 4; row0 < nrows; row0 += gridDim.x * 4) {
    int row = row0 + wave;
    for (int h = 0; h < 8; ++h) {
      __syncthreads();
#pragma unroll
      for (int i = 0; i < 4; ++i) sq[lane + 64 * i] = Q[(size_t)row * 2048 + h * 256 + lane + 64 * i];
      __syncthreads();
      for (int p = 0; p < 2; ++p) {
        float s0 = 0.f, s1 = 0.f;
        const float* k0 = sk + ((size_t)((h * 2 + p) * 128 + lane)) * 128;
        const float* k1 = k0 + 64 * 128;
#pragma unroll 8
        for (int d = 0; d < 128; ++d) { float qv = sq[p * 128 + d]; s0 += qv * k0[d]; s1 += qv * k1[d]; }
        for (int i = 0; i < 16; ++i) {
          float v; int idx;
          if (s0 >= s1) { v = s0; idx = lane; } else { v = s1; idx = lane + 64; }
          wave_argmax(v, idx);
          if (lane == 0) { tops[p * 16 + i] = v; topi[p * 16 + i] = idx; }
          if (idx == lane) s0 = -INFINITY;
          if (idx == lane + 64) s1 = -INFINITY;
        }
      }
      __syncthreads();
      float cs[4];
#pragma unroll
      for (int i = 0; i < 4; ++i) { int ci = lane * 4 + i; cs[i] = tops[ci >> 4] + tops[16 + (ci & 15)]; }
      float bs[16]; int be[16];
#pragma unroll
      for (int k = 0; k < 16; ++k) {
        float v = cs[0]; int idx = lane * 4;
#pragma unroll
        for (int i = 1; i < 4; ++i) if (cs[i] > v) { v = cs[i]; idx = lane * 4 + i; }
        wave_argmax(v, idx);
        bs[k] = v; be[k] = topi[idx >> 4] * 128 + topi[16 + (idx & 15)];
#pragma unroll
        for (int i = 0; i < 4; ++i) if (idx == lane * 4 + i) cs[i] = -INFINITY;
      }
      float mxs = bs[0]; float sum = 0.f;
#pragma unroll
      for (int k = 0; k < 16; ++k) { bs[k] = expf(bs[k] - mxs); sum += bs[k]; }
      float inv = 1.f / sum;
      if (lane == 0) {
#pragma unroll
        for (int k = 0; k < 16; ++k) { EXP[(size_t)row * 128 + h * 16 + k] = be[k]; GATE[(size_t)row * 128 + h * 16 + k] = bs[k] * inv; }
      }
    }
  }
}

__device__ __forceinline__ void unpack8(uint4 v, float* f) {
  f[0] = __uint_as_float(v.x << 16); f[1] = __uint_as_float(v.x & 0xffff0000u);
  f[2] = __uint_as_float(v.y << 16); f[3] = __uint_as_float(v.y & 0xffff0000u);
  f[4] = __uint_as_float(v.z << 16); f[5] = __uint_as_float(v.z & 0xffff0000u);
  f[6] = __uint_as_float(v.w << 16); f[7] = __uint_as_float(v.w & 0xffff0000u);
}
__device__ __forceinline__ void ph_peer_gather(bf16_t* __restrict__ H, const int* __restrict__ EXP, const float* __restrict__ GATE,
                               const bf16_t* __restrict__ U, const bf16_t* __restrict__ V,
                               const float* __restrict__ xin, const float* __restrict__ M, int layer,
                               const float* __restrict__ g, const float* __restrict__ bb, float* __restrict__ xout,
                               bool write_next, int nrows) {
  int lane = threadIdx.x & 63, wave = __builtin_amdgcn_readfirstlane(threadIdx.x >> 6);
  for (int row = blockIdx.x * 4 + wave; row < nrows; row += gridDim.x * 4) {
    float hreg[16];
    {
      const uint4* hp = (const uint4*)(H + (size_t)row * D + 8 * lane);
      unpack8(hp[0], hreg); unpack8(hp[64], hreg + 8);
    }
    float acc[16];
#pragma unroll
    for (int i = 0; i < 16; ++i) acc[i] = 0.f;
    int e_lo = EXP[(size_t)row * 128 + lane], e_hi = EXP[(size_t)row * 128 + 64 + lane];
    float g_lo = GATE[(size_t)row * 128 + lane], g_hi = GATE[(size_t)row * 128 + 64 + lane];
    uint4 ua[4], ub[4], va[4], vb[4];
#pragma unroll
    for (int i = 0; i < 4; ++i) {
      int e = __builtin_amdgcn_readlane(e_lo, i);
      const uint4* up = (const uint4*)(U + (size_t)e * D + 8 * lane); ua[i] = up[0]; ub[i] = up[64];
    }
#pragma unroll 1
    for (int b = 0; b < 32; ++b) {
      int k0 = 4 * b;
      int ev = (b < 16) ? e_lo : e_hi; float gv = (b < 16) ? g_lo : g_hi;
      int en = (b + 1 < 16) ? e_lo : e_hi;
      float gt[4];
#pragma unroll
      for (int i = 0; i < 4; ++i) {
        int e = __builtin_amdgcn_readlane(ev, (k0 + i) & 63);
        gt[i] = __uint_as_float(__builtin_amdgcn_readlane(__float_as_uint(gv), (k0 + i) & 63));
        const uint4* vp = (const uint4*)(V + (size_t)e * D + 8 * lane); va[i] = vp[0]; vb[i] = vp[64];
      }
      float a[4];
#pragma unroll
      for (int i = 0; i < 4; ++i) {
        float f[16]; unpack8(ua[i], f); unpack8(ub[i], f + 8);
        float sacc = 0.f;
#pragma unroll
        for (int j = 0; j < 16; ++j) sacc += f[j] * hreg[j];
        a[i] = sacc;
      }
      if (b + 1 < 32) {
#pragma unroll
        for (int i = 0; i < 4; ++i) {
          int e = __builtin_amdgcn_readlane(en, (k0 + 4 + i) & 63);
          const uint4* up = (const uint4*)(U + (size_t)e * D + 8 * lane); ua[i] = up[0]; ub[i] = up[64];
        }
      }
#pragma unroll
      for (int i = 0; i < 4; ++i) a[i] = wave_sum(a[i]);
#pragma unroll
      for (int i = 0; i < 4; ++i) {
        float w = gt[i] * 0.5f * a[i] * (1.f + erff(a[i] * 0.70710678118654752f));
        float f[16]; unpack8(va[i], f); unpack8(vb[i], f + 8);
#pragma unroll
        for (int j = 0; j < 16; ++j) acc[j] += w * f[j];
      }
    }
    const float* m = M + ((size_t)layer * 3 + mod_index(row)) * 6144;
    const float* xr = xin + (size_t)row * D;
    float v[16];
#pragma unroll
    for (int hh = 0; hh < 2; ++hh) {
      int d0 = hh * 512 + 8 * lane;
      float4 x0 = *(const float4*)(xr + d0), x1 = *(const float4*)(xr + d0 + 4);
      float4 m0 = *(const float4*)(m + 5 * D + d0), m1 = *(const float4*)(m + 5 * D + d0 + 4);
      v[hh * 8 + 0] = DN_ALPHA * x0.x + m0.x * acc[hh * 8 + 0]; v[hh * 8 + 1] = DN_ALPHA * x0.y + m0.y * acc[hh * 8 + 1];
      v[hh * 8 + 2] = DN_ALPHA * x0.z + m0.z * acc[hh * 8 + 2]; v[hh * 8 + 3] = DN_ALPHA * x0.w + m0.w * acc[hh * 8 + 3];
      v[hh * 8 + 4] = DN_ALPHA * x1.x + m1.x * acc[hh * 8 + 4]; v[hh * 8 + 5] = DN_ALPHA * x1.y + m1.y * acc[hh * 8 + 5];
      v[hh * 8 + 6] = DN_ALPHA * x1.z + m1.z * acc[hh * 8 + 6]; v[hh * 8 + 7] = DN_ALPHA * x1.w + m1.w * acc[hh * 8 + 7];
    }
    float s = 0.f;
#pragma unroll
    for (int j = 0; j < 16; ++j) s += v[j];
    float mu = wave_sum(s) * (1.f / D);
    float q = 0.f;
#pragma unroll
    for (int j = 0; j < 16; ++j) { float d = v[j] - mu; q += d * d; }
    float rs = rsqrtf(wave_sum(q) * (1.f / D) + LN_EPS);
    float y[16];
#pragma unroll
    for (int hh = 0; hh < 2; ++hh) {
      int d0 = hh * 512 + 8 * lane;
#pragma unroll
      for (int j = 0; j < 8; ++j) y[hh * 8 + j] = (v[hh * 8 + j] - mu) * rs * g[d0 + j] + bb[d0 + j];
      *(float4*)(xout + (size_t)row * D + d0) = make_float4(y[hh * 8], y[hh * 8 + 1], y[hh * 8 + 2], y[hh * 8 + 3]);
      *(float4*)(xout + (size_t)row * D + d0 + 4) = make_float4(y[hh * 8 + 4], y[hh * 8 + 5], y[hh * 8 + 6], y[hh * 8 + 7]);
    }
    if (write_next) {
      const float* mn = M + ((size_t)(layer + 1) * 3 + mod_index(row)) * 6144;
      float s2 = 0.f;
#pragma unroll
      for (int j = 0; j < 16; ++j) s2 += y[j];
      float mu2 = wave_sum(s2) * (1.f / D);
      float q2 = 0.f;
#pragma unroll
      for (int j = 0; j < 16; ++j) { float d = y[j] - mu2; q2 += d * d; }
      float rs2 = rsqrtf(wave_sum(q2) * (1.f / D) + LN_EPS);
#pragma unroll
      for (int hh = 0; hh < 2; ++hh) {
        int d0 = hh * 512 + 8 * lane;
        float o[8];
#pragma unroll
        for (int j = 0; j < 8; ++j) o[j] = (y[hh * 8 + j] - mu2) * rs2 * (1.f + mn[D + d0 + j]) + mn[d0 + j];
        *(uint4*)(H + (size_t)row * D + d0) = make_uint4(pack2bf(o[0], o[1]), pack2bf(o[2], o[3]), pack2bf(o[4], o[5]), pack2bf(o[6], o[7]));
      }
    }
  }
}


__device__ __forceinline__ void quant_row(const float* __restrict__ src, unsigned char* __restrict__ dst, float* __restrict__ scale, int row, int lane) {
  const float4* sp = (const float4*)(src + (size_t)row * D + 16 * lane);
  float4 v0 = sp[0], v1 = sp[1], v2 = sp[2], v3 = sp[3];
  float x[16] = {v0.x, v0.y, v0.z, v0.w, v1.x, v1.y, v1.z, v1.w, v2.x, v2.y, v2.z, v2.w, v3.x, v3.y, v3.z, v3.w};
  float am = 0.f;
#pragma unroll
  for (int j = 0; j < 16; ++j) am = fmaxf(am, fabsf(x[j]));
  am = wave_max(am);
  float inv = am > 0.f ? 127.f / am : 0.f;
  unsigned wv[4];
#pragma unroll
  for (int k = 0; k < 4; ++k) {
    unsigned w = 0;
#pragma unroll
    for (int j = 0; j < 4; ++j) {
      int q = (int)rintf(x[4 * k + j] * inv);
      w |= ((unsigned)q & 0xffu) << (8 * j);
    }
    wv[k] = w;
  }
  *(uint4*)(dst + ((size_t)(row >> 14) * 8 + (lane >> 3)) * ((size_t)16384 * 128) + (size_t)(row & 16383) * 128 + 16 * (lane & 7)) = make_uint4(wv[0], wv[1], wv[2], wv[3]);
  if (lane == 0) scale[row] = am * (1.f / 127.f);
}
__device__ __forceinline__ void quant_fill(unsigned* ctr, int layer, unsigned lo, unsigned hi, const float* __restrict__ pu, const float* __restrict__ pv,
                                           unsigned char* __restrict__ U8, unsigned char* __restrict__ V8, float* __restrict__ USC,
                                           float* __restrict__ VSC, unsigned* sh) {
  int lane = threadIdx.x & 63, wave = __builtin_amdgcn_readfirstlane(threadIdx.x >> 6);
  for (;;) {
    __syncthreads();
    if (threadIdx.x == 0) *sh = lo + __hip_atomic_fetch_add(ctr, 1u, __ATOMIC_RELAXED, __HIP_MEMORY_SCOPE_AGENT);
    __syncthreads();
    unsigned c = *sh;
    if (c >= hi) break;
    const float* src = (c >> 8) ? pv : pu; unsigned char* dst = (c >> 8) ? V8 : U8; float* sc = (c >> 8) ? VSC : USC;
    int r0 = layer * 16384 + (int)(c & 255u) * 64 + wave * 16;
#pragma unroll 4
    for (int i = 0; i < 16; ++i) quant_row(src, dst, sc, r0 + i, lane);
  }
  __syncthreads();
}
__device__ __forceinline__ void unpack_u8x16(uint4 v, float* f) {
  unsigned w[4] = {v.x, v.y, v.z, v.w};
#pragma unroll
  for (int k = 0; k < 4; ++k) {
    f[4 * k + 0] = (float)(w[k] & 0xffu); f[4 * k + 1] = (float)((w[k] >> 8) & 0xffu);
    f[4 * k + 2] = (float)((w[k] >> 16) & 0xffu); f[4 * k + 3] = (float)(w[k] >> 24);
  }
}
__device__ __forceinline__ void ph_peer_gather8(bf16_t* __restrict__ H, const int* __restrict__ EXP, const float* __restrict__ GATE,
                               const unsigned char* __restrict__ U8, const float* __restrict__ USC,
                               const unsigned char* __restrict__ V8, const float* __restrict__ VSC,
                               const float* __restrict__ xin, const float* __restrict__ M, int layer,
                               const float* __restrict__ g, const float* __restrict__ bb, float* __restrict__ xout,
                               bool write_next, int nrows) {
  int lane = threadIdx.x & 63, wave = __builtin_amdgcn_readfirstlane(threadIdx.x >> 6);
  for (int row = blockIdx.x * 4 + wave; row < nrows; row += gridDim.x * 4) {
    float hreg[16];
    {
      const uint4* hp = (const uint4*)(H + (size_t)row * D + 16 * lane);
      unpack8(hp[0], hreg); unpack8(hp[1], hreg + 8);
    }
    float hs = 0.f;
#pragma unroll
    for (int j = 0; j < 16; ++j) hs += hreg[j];
    float hsum128 = 128.f * wave_sum(hs);
    float acc[16];
#pragma unroll
    for (int i = 0; i < 16; ++i) acc[i] = 0.f;
    float wsum = 0.f;
    int e_lo = EXP[(size_t)row * 128 + lane], e_hi = EXP[(size_t)row * 128 + 64 + lane];
    float g_lo = GATE[(size_t)row * 128 + lane], g_hi = GATE[(size_t)row * 128 + 64 + lane];
    float us_lo = USC[e_lo], us_hi = USC[e_hi], vs_lo = VSC[e_lo], vs_hi = VSC[e_hi];
    uint4 ua[8], va[8];
#pragma unroll
    for (int i = 0; i < 8; ++i) {
      int e = __builtin_amdgcn_readlane(e_lo, i);
      ua[i] = *(const uint4*)(U8 + (size_t)e * D + 16 * lane);
    }
#pragma unroll 1
    for (int b = 0; b < 16; ++b) {
      int k0 = 8 * b;
      bool lo = b < 8, lon = (b + 1) < 8;
      int ev = lo ? e_lo : e_hi; float gv = lo ? g_lo : g_hi; float usv = lo ? us_lo : us_hi; float vsv = lo ? vs_lo : vs_hi;
      int en = lon ? e_lo : e_hi;
      float gt[8], usc[8], vsc[8];
#pragma unroll
      for (int i = 0; i < 8; ++i) {
        int li = (k0 + i) & 63;
        int e = __builtin_amdgcn_readlane(ev, li);
        gt[i] = __uint_as_float(__builtin_amdgcn_readlane(__float_as_uint(gv), li));
        usc[i] = __uint_as_float(__builtin_amdgcn_readlane(__float_as_uint(usv), li));
        vsc[i] = __uint_as_float(__builtin_amdgcn_readlane(__float_as_uint(vsv), li));
        va[i] = *(const uint4*)(V8 + (size_t)e * D + 16 * lane);
      }
      float a[8];
#pragma unroll
      for (int i = 0; i < 8; ++i) {
        float f[16]; unpack_u8x16(ua[i], f);
        float sacc = 0.f;
#pragma unroll
        for (int j = 0; j < 16; ++j) sacc += f[j] * hreg[j];
        a[i] = sacc;
      }
      if (b + 1 < 16) {
#pragma unroll
        for (int i = 0; i < 8; ++i) {
          int e = __builtin_amdgcn_readlane(en, (k0 + 8 + i) & 63);
          ua[i] = *(const uint4*)(U8 + (size_t)e * D + 16 * lane);
        }
      }
#pragma unroll
      for (int i = 0; i < 8; ++i) a[i] = (wave_sum(a[i]) - hsum128) * usc[i];
#pragma unroll
      for (int i = 0; i < 8; ++i) {
        float w = gt[i] * 0.5f * a[i] * (1.f + erff(a[i] * 0.70710678118654752f)) * vsc[i];
        wsum += w;
        float f[16]; unpack_u8x16(va[i], f);
#pragma unroll
        for (int j = 0; j < 16; ++j) acc[j] += w * f[j];
      }
    }
    float corr = 128.f * wsum;
#pragma unroll
    for (int j = 0; j < 16; ++j) acc[j] -= corr;
    const float* m = M + ((size_t)layer * 3 + mod_index(row)) * 6144;
    const float* xr = xin + (size_t)row * D + 16 * lane;
    const float* m5 = m + 5 * D + 16 * lane;
    float v[16];
#pragma unroll
    for (int q4 = 0; q4 < 4; ++q4) {
      float4 x0 = *(const float4*)(xr + 4 * q4); float4 m0 = *(const float4*)(m5 + 4 * q4);
      v[4 * q4 + 0] = DN_ALPHA * x0.x + m0.x * acc[4 * q4 + 0]; v[4 * q4 + 1] = DN_ALPHA * x0.y + m0.y * acc[4 * q4 + 1];
      v[4 * q4 + 2] = DN_ALPHA * x0.z + m0.z * acc[4 * q4 + 2]; v[4 * q4 + 3] = DN_ALPHA * x0.w + m0.w * acc[4 * q4 + 3];
    }
    float s = 0.f;
#pragma unroll
    for (int j = 0; j < 16; ++j) s += v[j];
    float mu = wave_sum(s) * (1.f / D);
    float q = 0.f;
#pragma unroll
    for (int j = 0; j < 16; ++j) { float d = v[j] - mu; q += d * d; }
    float rs = rsqrtf(wave_sum(q) * (1.f / D) + LN_EPS);
    float y[16];
    {
      const float* gp = g + 16 * lane; const float* bp = bb + 16 * lane;
      float* op = xout + (size_t)row * D + 16 * lane;
#pragma unroll
      for (int q4 = 0; q4 < 4; ++q4) {
        float4 g4 = *(const float4*)(gp + 4 * q4); float4 b4 = *(const float4*)(bp + 4 * q4);
        y[4 * q4 + 0] = (v[4 * q4 + 0] - mu) * rs * g4.x + b4.x; y[4 * q4 + 1] = (v[4 * q4 + 1] - mu) * rs * g4.y + b4.y;
        y[4 * q4 + 2] = (v[4 * q4 + 2] - mu) * rs * g4.z + b4.z; y[4 * q4 + 3] = (v[4 * q4 + 3] - mu) * rs * g4.w + b4.w;
        *(float4*)(op + 4 * q4) = make_float4(y[4 * q4], y[4 * q4 + 1], y[4 * q4 + 2], y[4 * q4 + 3]);
      }
    }
    if (write_next) {
      const float* mn = M + ((size_t)(layer + 1) * 3 + mod_index(row)) * 6144 + 16 * lane;
      float s2 = 0.f;
#pragma unroll
      for (int j = 0; j < 16; ++j) s2 += y[j];
      float mu2 = wave_sum(s2) * (1.f / D);
      float q2 = 0.f;
#pragma unroll
      for (int j = 0; j < 16; ++j) { float d = y[j] - mu2; q2 += d * d; }
      float rs2 = rsqrtf(wave_sum(q2) * (1.f / D) + LN_EPS);
      float o[16];
#pragma unroll
      for (int j = 0; j < 16; ++j) o[j] = (y[j] - mu2) * rs2 * (1.f + mn[D + j]) + mn[j];
      uint4* hp = (uint4*)(H + (size_t)row * D + 16 * lane);
      hp[0] = make_uint4(pack2bf(o[0], o[1]), pack2bf(o[2], o[3]), pack2bf(o[4], o[5]), pack2bf(o[6], o[7]));
      hp[1] = make_uint4(pack2bf(o[8], o[9]), pack2bf(o[10], o[11]), pack2bf(o[12], o[13]), pack2bf(o[14], o[15]));
    }
  }
}


__device__ __forceinline__ void ph_ada2(const float* __restrict__ c, const float* __restrict__ c_ctx, const float* __restrict__ ada_w,
                                        const float* __restrict__ ada_b, float* __restrict__ M, float* sm) {
  int tid = threadIdx.x, lane = tid & 63, wave = __builtin_amdgcn_readfirstlane(tid >> 6);
  float* sv = sm;
  float* red = sm + 3072;
  bool filled = false;
  GRID_LOOP(u, 192) {
    if (!filled) {
      for (int i = tid; i < 3072; i += 256) {
        int idx = i >> 10, k = i & 1023;
        float x = idx < 2 ? c[idx * D + k] : c_ctx[k];
        sv[i] = x / (1.f + expf(-x));
      }
      filled = true;
    }
    __syncthreads();
    int layer = u / 96, c0 = (u % 96) * 64;
    const float* w = ada_w + (size_t)layer * D * 6144 + c0 + lane;
    float a0 = 0.f, a1 = 0.f, a2 = 0.f;
    int kb = wave * 256;
#pragma unroll 16
    for (int k = 0; k < 256; ++k) {
      float wv = w[(size_t)(kb + k) * 6144];
      a0 += sv[kb + k] * wv; a1 += sv[1024 + kb + k] * wv; a2 += sv[2048 + kb + k] * wv;
    }
    red[(wave * 3 + 0) * 64 + lane] = a0; red[(wave * 3 + 1) * 64 + lane] = a1; red[(wave * 3 + 2) * 64 + lane] = a2;
    __syncthreads();
    if (wave < 3) {
      float r = red[(0 * 3 + wave) * 64 + lane] + red[(1 * 3 + wave) * 64 + lane] + red[(2 * 3 + wave) * 64 + lane] + red[(3 * 3 + wave) * 64 + lane];
      M[((size_t)layer * 3 + wave) * 6144 + c0 + lane] = r + ada_b[layer * 6144 + c0 + lane];
    }
  }
  __syncthreads();
}

__device__ __forceinline__ void ph_post_mod(const float* __restrict__ xa, const float* __restrict__ xb, const bf16_t* __restrict__ Y,
                                            const float* __restrict__ M, int layer, int jres, int mlayer, int jshift, int jscale, bool do_mod,
                                            const float* __restrict__ g, const float* __restrict__ bb,
                                            float* __restrict__ xout, bf16_t* __restrict__ H, int nrows) {
  int lane = threadIdx.x & 63, wave = __builtin_amdgcn_readfirstlane(threadIdx.x >> 6);
  for (int row = blockIdx.x * 4 + wave; row < nrows; row += gridDim.x * 4) {
    const float* xr = (row < T ? xa + (size_t)row * D : xb + (size_t)(row - T) * D) + 16 * lane;
    const float* m = M + ((size_t)layer * 3 + mod_index(row)) * 6144 + 16 * lane;
    float yv[16];
    {
      const uint4* yp = (const uint4*)(Y + (size_t)row * D + 16 * lane);
      unpack8(yp[0], yv); unpack8(yp[1], yv + 8);
    }
    float v[16];
#pragma unroll
    for (int q4 = 0; q4 < 4; ++q4) {
      float4 x0 = *(const float4*)(xr + 4 * q4); float4 m0 = *(const float4*)(m + jres * D + 4 * q4);
      v[4 * q4 + 0] = DN_ALPHA * x0.x + m0.x * yv[4 * q4 + 0]; v[4 * q4 + 1] = DN_ALPHA * x0.y + m0.y * yv[4 * q4 + 1];
      v[4 * q4 + 2] = DN_ALPHA * x0.z + m0.z * yv[4 * q4 + 2]; v[4 * q4 + 3] = DN_ALPHA * x0.w + m0.w * yv[4 * q4 + 3];
    }
    float s = 0.f;
#pragma unroll
    for (int j = 0; j < 16; ++j) s += v[j];
    float mu = wave_sum(s) * (1.f / D);
    float q = 0.f;
#pragma unroll
    for (int j = 0; j < 16; ++j) { float d = v[j] - mu; q += d * d; }
    float rs = rsqrtf(wave_sum(q) * (1.f / D) + LN_EPS);
    float y[16];
    {
      const float* gp = g + 16 * lane; const float* bp = bb + 16 * lane;
      float* op = xout + (size_t)row * D + 16 * lane;
#pragma unroll
      for (int q4 = 0; q4 < 4; ++q4) {
        float4 g4 = *(const float4*)(gp + 4 * q4); float4 b4 = *(const float4*)(bp + 4 * q4);
        y[4 * q4 + 0] = (v[4 * q4 + 0] - mu) * rs * g4.x + b4.x; y[4 * q4 + 1] = (v[4 * q4 + 1] - mu) * rs * g4.y + b4.y;
        y[4 * q4 + 2] = (v[4 * q4 + 2] - mu) * rs * g4.z + b4.z; y[4 * q4 + 3] = (v[4 * q4 + 3] - mu) * rs * g4.w + b4.w;
        *(float4*)(op + 4 * q4) = make_float4(y[4 * q4], y[4 * q4 + 1], y[4 * q4 + 2], y[4 * q4 + 3]);
      }
    }
    if (do_mod) {
      const float* mm = M + ((size_t)mlayer * 3 + mod_index(row)) * 6144 + 16 * lane;
      float s2 = 0.f;
#pragma unroll
      for (int j = 0; j < 16; ++j) s2 += y[j];
      float mu2 = wave_sum(s2) * (1.f / D);
      float q2 = 0.f;
#pragma unroll
      for (int j = 0; j < 16; ++j) { float d = y[j] - mu2; q2 += d * d; }
      float rs2 = rsqrtf(wave_sum(q2) * (1.f / D) + LN_EPS);
      float o[16];
#pragma unroll
      for (int j = 0; j < 16; ++j) o[j] = (y[j] - mu2) * rs2 * (1.f + mm[jscale * D + j]) + mm[jshift * D + j];
      uint4* hp = (uint4*)(H + (size_t)row * D + 16 * lane);
      hp[0] = make_uint4(pack2bf(o[0], o[1]), pack2bf(o[2], o[3]), pack2bf(o[4], o[5]), pack2bf(o[6], o[7]));
      hp[1] = make_uint4(pack2bf(o[8], o[9]), pack2bf(o[10], o[11]), pack2bf(o[12], o[13]), pack2bf(o[14], o[15]));
    }
  }
}


template <int CTRL> __device__ __forceinline__ float dpp_add(float x) { return x + dpp_mov<CTRL>(x); }
__device__ __forceinline__ float sum8(float v) {
  v = dpp_add<0xB1>(v); v = dpp_add<0x4E>(v); v = dpp_add<0x141>(v); return v;
}
typedef _Float16 half2_t __attribute__((ext_vector_type(2)));
__device__ __forceinline__ float dot2h(unsigned a, unsigned b, float c) {
  return __builtin_amdgcn_fdot2(__builtin_bit_cast(half2_t, a), __builtin_bit_cast(half2_t, b), c, false);
}
__device__ __forceinline__ unsigned pkh(float a, float b) { return __builtin_bit_cast(unsigned, __builtin_amdgcn_cvt_pkrtz(a, b)); }
__device__ __forceinline__ void load_e16(const int* __restrict__ EXP, int t, int g8, int (&e)[16]) {
  const int4* ep = (const int4*)(EXP + (size_t)t * 128 + 16 * g8);
  int4 a = ep[0], b = ep[1], c = ep[2], d = ep[3];
  e[0] = a.x; e[1] = a.y; e[2] = a.z; e[3] = a.w; e[4] = b.x; e[5] = b.y; e[6] = b.z; e[7] = b.w;
  e[8] = c.x; e[9] = c.y; e[10] = c.z; e[11] = c.w; e[12] = d.x; e[13] = d.y; e[14] = d.z; e[15] = d.w;
}
#define U_TOKEN(tt, UV, UVN, EUSE, ELD, HUSE, HLD) { \
    int tnn_ = min((tt) + 2 * st, nrows - 1); \
    load_e16(EXP, tnn_, g8, ELD); \
    HLD[0] = *(const uint4*)(hb + (size_t)tnn_ * D); HLD[1] = *(const uint4*)(hb + (size_t)tnn_ * D + 8); \
    __builtin_amdgcn_sched_barrier(0); \
    _Pragma("unroll") for (int i = 0; i < 16; ++i) UVN[i] = *(const uint4*)(ubs + (((unsigned)EUSE[i] << 7) + loff)); \
    __builtin_amdgcn_sched_barrier(0); \
    float h16[16]; unpack8(HUSE[0], h16); unpack8(HUSE[1], h16 + 8); \
    float hm = 0.f; \
    _Pragma("unroll") for (int j = 0; j < 16; ++j) hm = fmaxf(hm, fabsf(h16[j])); \
    hm = fmaxf(hm, dpp_mov<0xB1>(hm)); hm = fmaxf(hm, dpp_mov<0x4E>(hm)); hm = fmaxf(hm, dpp_mov<0x141>(hm)); \
    float hinv = hm > 0.f ? 127.f / hm : 0.f; float hsc = hm * (1.f / 127.f); \
    int hq[4]; \
    _Pragma("unroll") for (int k = 0; k < 4; ++k) { unsigned w_ = 0; \
      _Pragma("unroll") for (int j = 0; j < 4; ++j) w_ = __builtin_amdgcn_cvt_pk_u8_f32(rintf(h16[4 * k + j] * hinv) + 128.f, j, w_); \
      hq[k] = (int)(w_ ^ 0x80808080u); }        \
    float k0 = 0.f, k1 = 0.f; \
    _Pragma("unroll") for (int i = 0; i < 16; ++i) { \
      int p_ = __builtin_amdgcn_sdot4((int)UV[i].x, hq[0], 0, false); p_ = __builtin_amdgcn_sdot4((int)UV[i].y, hq[1], p_, false); \
      p_ = __builtin_amdgcn_sdot4((int)UV[i].z, hq[2], p_, false); p_ = __builtin_amdgcn_sdot4((int)UV[i].w, hq[3], p_, false); \
      float p = sum8((float)p_) * hsc; \
      if ((i >> 1) == j8) { if (i & 1) k1 = p; else k0 = p; } } \
    *(float2*)(PA + ((size_t)(tt) * 8 + x) * 128 + 16 * g8 + 2 * j8) = make_float2(k0, k1); }
__device__ __forceinline__ void ph_peer_u(const bf16_t* __restrict__ H, const int* __restrict__ EXP, const unsigned char* __restrict__ U8,
                                          float* __restrict__ PA, int nrows) {
  int lane = threadIdx.x & 63, wave = __builtin_amdgcn_readfirstlane(threadIdx.x >> 6);
  int x = blockIdx.x & 7; int nb8 = gridDim.x >> 3;
  if ((int)(blockIdx.x >> 3) >= nb8) return;
  int j8 = lane & 7, g8 = lane >> 3;
  const int st = nb8 * 4;
  int t = (blockIdx.x >> 3) * 4 + wave;
  if (t >= nrows) return;
  const unsigned char* ubs = U8 + (size_t)x * ((size_t)16384 * 128);
  const unsigned loff = 16u * (unsigned)j8;
  const bf16_t* hb = H + 128 * x + 16 * j8;
  int eA[16], eB[16]; uint4 hA[2], hB[2], uvA[16], uvB[16];
  {
    int e0[16]; load_e16(EXP, t, g8, e0);
#pragma unroll
    for (int i = 0; i < 16; ++i) uvA[i] = *(const uint4*)(ubs + (((unsigned)e0[i] << 7) + loff));
    hA[0] = *(const uint4*)(hb + (size_t)t * D); hA[1] = *(const uint4*)(hb + (size_t)t * D + 8);
    int tn = min(t + st, nrows - 1);
    load_e16(EXP, tn, g8, eA);
    hB[0] = *(const uint4*)(hb + (size_t)tn * D); hB[1] = *(const uint4*)(hb + (size_t)tn * D + 8);
  }
#pragma unroll 1
  for (; t < nrows; t += 2 * st) {
    uint4 hC[2];
    U_TOKEN(t, uvA, uvB, eA, eB, hA, hC)
    if (t + st < nrows) {
      U_TOKEN(t + st, uvB, uvA, eB, eA, hB, hA)
    }
    hB[0] = hA[0]; hB[1] = hA[1]; hA[0] = hC[0]; hA[1] = hC[1];
  }
}
__device__ __forceinline__ void ph_peer_w(const float* __restrict__ PA, const int* __restrict__ EXP, const float* __restrict__ GATE,
                                          const float* __restrict__ USC, const float* __restrict__ VSC, unsigned* __restrict__ WQ,
                                          float* __restrict__ SW, int nrows) {
  int lane = threadIdx.x & 63, wave = __builtin_amdgcn_readfirstlane(threadIdx.x >> 6);
  int l4 = lane & 31;
  for (int t = blockIdx.x * 4 + wave; t < nrows; t += gridDim.x * 4) {
    int4 e = *(const int4*)(EXP + (size_t)t * 128 + 4 * l4);
    float4 gt = *(const float4*)(GATE + (size_t)t * 128 + 4 * l4);
    float a[4] = {0.f, 0.f, 0.f, 0.f};
#pragma unroll
    for (int xs = 0; xs < 8; ++xs) { float4 p = *(const float4*)(PA + ((size_t)t * 8 + xs) * 128 + 4 * l4); a[0] += p.x; a[1] += p.y; a[2] += p.z; a[3] += p.w; }
    int ee[4] = {e.x, e.y, e.z, e.w}; float gg[4] = {gt.x, gt.y, gt.z, gt.w}; float w[4]; float wm = 0.f;
#pragma unroll
    for (int j = 0; j < 4; ++j) {
      float av = a[j] * USC[ee[j]];
      w[j] = gg[j] * 0.5f * av * (1.f + erff(av * 0.70710678118654752f)) * VSC[ee[j]];
      wm = fmaxf(wm, fabsf(w[j]));
    }
    wm = wave_max(wm);
    float winv = wm > 0.f ? 127.f / wm : 0.f;
    unsigned q = 0;
#pragma unroll
    for (int j = 0; j < 4; ++j) q = __builtin_amdgcn_cvt_pk_u8_f32(rintf(w[j] * winv) + 128.f, j, q);
    if (lane < 32) WQ[(size_t)t * 32 + l4] = q ^ 0x80808080u;
    if (lane == 0) SW[t] = wm * (1.f / 127.f);
  }
}
__device__ __forceinline__ void load_w16(const float* __restrict__ W, int t, int g8, float (&w)[16]) {
  const float4* wp = (const float4*)(W + (size_t)t * 128 + 16 * g8);
  float4 wa = wp[0], wb = wp[1], wc = wp[2], wd = wp[3];
  w[0] = wa.x; w[1] = wa.y; w[2] = wa.z; w[3] = wa.w; w[4] = wb.x; w[5] = wb.y; w[6] = wb.z; w[7] = wb.w;
  w[8] = wc.x; w[9] = wc.y; w[10] = wc.z; w[11] = wc.w; w[12] = wd.x; w[13] = wd.y; w[14] = wd.z; w[15] = wd.w;
}
#define V_TOKEN(tt, VV, VVN, EUSE, ELD, WUSE, WLD, SUSE, SLD) { \
    int tnn_ = min((tt) + 2 * st, nrows - 1); \
    load_e16(EXP, tnn_, g8, ELD); \
    WLD = *(const uint4*)(WQ + (size_t)tnn_ * 32 + 4 * g8); SLD = SW[tnn_]; \
    __builtin_amdgcn_sched_barrier(0); \
    _Pragma("unroll") for (int i = 0; i < 16; ++i) VVN[i] = *(const uint4*)(vbs + (((unsigned)EUSE[i] << 7) + loff)); \
    __builtin_amdgcn_sched_barrier(0); \
    int acc[16]; \
    _Pragma("unroll") for (int j = 0; j < 16; ++j) acc[j] = 0; \
    int wq[4] = {(int)WUSE.x, (int)WUSE.y, (int)WUSE.z, (int)WUSE.w}; \
    _Pragma("unroll") for (int m = 0; m < 4; ++m) { \
      unsigned r0[4] = {VV[4 * m].x, VV[4 * m].y, VV[4 * m].z, VV[4 * m].w}; \
      unsigned r1[4] = {VV[4 * m + 1].x, VV[4 * m + 1].y, VV[4 * m + 1].z, VV[4 * m + 1].w}; \
      unsigned r2[4] = {VV[4 * m + 2].x, VV[4 * m + 2].y, VV[4 * m + 2].z, VV[4 * m + 2].w}; \
      unsigned r3[4] = {VV[4 * m + 3].x, VV[4 * m + 3].y, VV[4 * m + 3].z, VV[4 * m + 3].w}; \
      _Pragma("unroll") for (int k = 0; k < 4; ++k) { \
          \
        unsigned a0 = __builtin_amdgcn_perm(r1[k], r0[k], 0x05010400u);     \
        unsigned a1 = __builtin_amdgcn_perm(r1[k], r0[k], 0x07030602u);     \
        unsigned a2 = __builtin_amdgcn_perm(r3[k], r2[k], 0x05010400u); \
        unsigned a3 = __builtin_amdgcn_perm(r3[k], r2[k], 0x07030602u); \
        unsigned t0 = __builtin_amdgcn_perm(a2, a0, 0x05040100u);           \
        unsigned t1 = __builtin_amdgcn_perm(a2, a0, 0x07060302u); \
        unsigned t2 = __builtin_amdgcn_perm(a3, a1, 0x05040100u); \
        unsigned t3 = __builtin_amdgcn_perm(a3, a1, 0x07060302u); \
        acc[4 * k + 0] = __builtin_amdgcn_sdot4((int)t0, wq[m], acc[4 * k + 0], false); \
        acc[4 * k + 1] = __builtin_amdgcn_sdot4((int)t1, wq[m], acc[4 * k + 1], false); \
        acc[4 * k + 2] = __builtin_amdgcn_sdot4((int)t2, wq[m], acc[4 * k + 2], false); \
        acc[4 * k + 3] = __builtin_amdgcn_sdot4((int)t3, wq[m], acc[4 * k + 3], false); } } \
    float of[16]; \
    _Pragma("unroll") for (int j = 0; j < 16; ++j) { float v = (float)acc[j]; v += dpp_mov<0x128>(v); of[j] = xrow16_sum(v) * SUSE; } \
    if (g8 == 0) { \
      uint4* fp = (uint4*)(F + (size_t)(tt) * D + 128 * x + 16 * j8); \
      fp[0] = make_uint4(pack2bf(of[0], of[1]), pack2bf(of[2], of[3]), pack2bf(of[4], of[5]), pack2bf(of[6], of[7])); \
      fp[1] = make_uint4(pack2bf(of[8], of[9]), pack2bf(of[10], of[11]), pack2bf(of[12], of[13]), pack2bf(of[14], of[15])); } }
__device__ __forceinline__ void ph_peer_v(const unsigned* __restrict__ WQ, const float* __restrict__ SW, const int* __restrict__ EXP,
                                          const unsigned char* __restrict__ V8, bf16_t* __restrict__ F, int nrows) {
  int lane = threadIdx.x & 63, wave = __builtin_amdgcn_readfirstlane(threadIdx.x >> 6);
  int x = blockIdx.x & 7; int nb8 = gridDim.x >> 3;
  if ((int)(blockIdx.x >> 3) >= nb8) return;
  int j8 = lane & 7, g8 = lane >> 3;
  const int st = nb8 * 4;
  int t = (blockIdx.x >> 3) * 4 + wave;
  if (t >= nrows) return;
  const unsigned char* vbs = V8 + (size_t)x * ((size_t)16384 * 128);
  const unsigned loff = 16u * (unsigned)j8;
  int eA[16], eB[16]; uint4 wA, wB, vvA[16], vvB[16]; float sA, sB;
  {
    int e0[16]; load_e16(EXP, t, g8, e0);
#pragma unroll
    for (int i = 0; i < 16; ++i) vvA[i] = *(const uint4*)(vbs + (((unsigned)e0[i] << 7) + loff));
    wA = *(const uint4*)(WQ + (size_t)t * 32 + 4 * g8); sA = SW[t];
    int tn = min(t + st, nrows - 1);
    load_e16(EXP, tn, g8, eA);
    wB = *(const uint4*)(WQ + (size_t)tn * 32 + 4 * g8); sB = SW[tn];
  }
#pragma unroll 1
  for (; t < nrows; t += 2 * st) {
    uint4 wC; float sC;
    V_TOKEN(t, vvA, vvB, eA, eB, wA, wC, sA, sC)
    if (t + st < nrows) {
      V_TOKEN(t + st, vvB, vvA, eB, eA, wB, wA, sB, sA)
    }
    wB = wA; sB = sA; wA = wC; sA = sC;
  }
}

#define XB_TMO      128
#define XB_XCNT(j)  (256  + 64 * (j))
#define XB_XSUB(j)  (1280 + 64 * (j))
#define XB_XGEN(j)  (2304 + 64 * (j))
#define XB_TOP      3328
#define XB_TOPGEN   3392
#define XCD_BAR_WORDS 3456
#define XB_SPIN_CAP (1u << 22)
#define LAS __attribute__((address_space(3)))
__device__ __forceinline__ unsigned xb_ld(unsigned* p)              { return __hip_atomic_load(p, __ATOMIC_RELAXED, __HIP_MEMORY_SCOPE_AGENT); }
__device__ __forceinline__ unsigned xb_add(unsigned* p, unsigned v) { return __hip_atomic_fetch_add(p, v, __ATOMIC_RELAXED, __HIP_MEMORY_SCOPE_AGENT); }
__device__ __forceinline__ unsigned xb_xcc_id() { return (unsigned)__builtin_amdgcn_s_getreg((3 << 11) | 20) & 0xFu; }
#define XB_SPIN(cond, bar) do { unsigned _sp = 0; while (cond) { __builtin_amdgcn_s_sleep(1); \
    if ((++_sp & 255u) == 0u) { if (xb_ld(&(bar)[XB_TMO])) break; if (_sp > XB_SPIN_CAP) { atomicAdd(&(bar)[XB_TMO], 1u); break; } } } } while (0)
struct XcdBarrier { unsigned* bar; unsigned x; volatile LAS unsigned* st; };
__device__ __forceinline__ XcdBarrier xcd_barrier_post(unsigned* bar, volatile LAS unsigned* st) {
  XcdBarrier b; b.bar = bar; b.x = xb_xcc_id(); b.st = st;
  if (threadIdx.x == 0) (void)xb_add(&bar[XB_XCNT(b.x)], 1u);
  return b;
}
__device__ __forceinline__ void xcd_barrier_complete(unsigned* bar, unsigned x, unsigned& nloc, unsigned& nx) {
  const unsigned G = gridDim.x * gridDim.y * gridDim.z;
  unsigned sum, cnt, mine, sp = 0u;
  for (;;) {
    sum = 0u; cnt = 0u; mine = 0u;
#pragma unroll
    for (unsigned j = 0; j < 16; ++j) { const unsigned c = xb_ld(&bar[XB_XCNT(j)]); sum += c; cnt += (c > 0u) ? 1u : 0u; mine = (j == x) ? c : mine; }
    if (sum == G) break;
    __builtin_amdgcn_s_sleep(1);
    if ((++sp & 255u) == 0u) { if (xb_ld(&bar[XB_TMO])) break; if (sp > XB_SPIN_CAP) { atomicAdd(&bar[XB_TMO], 1u); break; } }
  }
  nloc = mine > 0u ? mine : 1u; nx = cnt > 0u ? cnt : 1u;
}
__device__ __forceinline__ void xcd_barrier(const XcdBarrier& b) {
  asm volatile("s_waitcnt vmcnt(0)" ::: "memory");
  __syncthreads();
  if (threadIdx.x == 0) {
    unsigned* bar = b.bar;
    __builtin_amdgcn_s_waitcnt(0);
    unsigned nloc = b.st[0], nx = b.st[1];
    if (nloc == 0u) { xcd_barrier_complete(bar, b.x, nloc, nx); b.st[0] = nloc; b.st[1] = nx; }
    const unsigned old = xb_add(&bar[XB_XSUB(b.x)], 1u);
    const unsigned gen = old / nloc;
    if (old + 1u == (gen + 1u) * nloc) {
      __builtin_amdgcn_fence(__ATOMIC_RELEASE, "agent");
      asm volatile("s_waitcnt vmcnt(0)" ::: "memory");
      const unsigned og = xb_add(&bar[XB_TOP], 1u);
      const unsigned tg = og / nx;
      if (og + 1u == (tg + 1u) * nx) xb_add(&bar[XB_TOPGEN], 1u);
      else XB_SPIN(xb_ld(&bar[XB_TOPGEN]) == tg, bar);
      __builtin_amdgcn_fence(__ATOMIC_ACQUIRE, "agent");
      xb_add(&bar[XB_XGEN(b.x)], 1u);
      asm volatile("s_waitcnt vmcnt(0)" ::: "memory");
    } else {
      XB_SPIN(xb_ld(&bar[XB_XGEN(b.x)]) == gen, bar);
      __builtin_amdgcn_fence(__ATOMIC_ACQUIRE, "agent");
      asm volatile("s_waitcnt vmcnt(0)" ::: "memory");
    }
  }
  __syncthreads();
}

constexpr int SMEM_BYTES = 65536;
#ifndef PHMASK
#define PHMASK 0xFFFFFFFFFFFFFFFFull
#endif
#ifndef PHDUP
#define PHDUP 0ull
#endif
#define PH(n, ...) if constexpr ((((unsigned long long)(PHMASK)) >> (n)) & 1ull) { __VA_ARGS__; if constexpr ((((unsigned long long)(PHDUP)) >> (n)) & 1ull) { xcd_barrier(xbar); __VA_ARGS__; } }

__global__ __launch_bounds__(256, 2) void mega(Params p) {
  __shared__ __attribute__((aligned(16))) char smem_raw[SMEM_BYTES + 16];
  if (threadIdx.x == 0) *(uint4*)(smem_raw + SMEM_BYTES) = make_uint4(0u, 0u, 0u, 0u);
  __syncthreads();
  XcdBarrier xbar = xcd_barrier_post((unsigned*)((char*)p.ws + OFF_BAR), (volatile LAS unsigned*)(smem_raw + SMEM_BYTES));
  float* smem = (float*)smem_raw;
  const float* x = p.in[0]; const float* c = p.in[1]; const float* ctx = p.in[2]; const float* c_ctx = p.in[3];
  const float* ada_w = p.in[4]; const float* ada_b = p.in[5]; const float* ln_g = p.in[6]; const float* ln_b = p.in[7];
  const float* even_w_in = p.in[8]; const float* even_w_out = p.in[9]; const float* rpb = p.in[10];
  const float* odd_w_in = p.in[11]; const float* odd_w_out = p.in[12]; const float* sink = p.in[13];
  const float* peer_wq = p.in[14]; const float* peer_sk = p.in[15]; const float* peer_u = p.in[16]; const float* peer_v = p.in[17];
  char* ws = (char*)p.ws;
  float* TAB = (float*)(ws + OFF_TAB); float* Mm = (float*)(ws + OFF_M);
  bf16_t* WIN0 = (bf16_t*)(ws + OFF_WIN0); bf16_t* WOUT0 = (bf16_t*)(ws + OFF_WOUT0);
  bf16_t* WIN1 = (bf16_t*)(ws + OFF_WIN1); bf16_t* WOUT1 = (bf16_t*)(ws + OFF_WOUT1);
  bf16_t* WQ = (bf16_t*)(ws + OFF_WQ); bf16_t* SKB = (bf16_t*)(ws + OFF_SK);
  unsigned char* U8 = (unsigned char*)(ws + OFF_UB); unsigned char* V8 = (unsigned char*)(ws + OFF_VB);
  float* USC = (float*)(ws + OFF_USC); float* VSC = USC + 2 * 16384;
  bf16_t* AB = (bf16_t*)(ws + OFF_AB);
  bf16_t* FD1 = (bf16_t*)(ws + OFF_FT); bf16_t* FD3 = FD1 + 256 * 128; bf16_t* FDC = FD3 + 128 * 128;
  bf16_t* A1 = (bf16_t*)(ws + OFF_A1); bf16_t* VT0 = (bf16_t*)(ws + OFF_VT0); bf16_t* FQKV = (bf16_t*)(ws + OFF_BF);
  float* BF_ = (float*)(ws + OFF_BF); float* BY = (float*)(ws + OFF_BY);
  float* X1 = (float*)(ws + OFF_X1); float* X2 = (float*)(ws + OFF_X2);
  float* RT = TAB + 16384;
  bf16_t* Q1 = (bf16_t*)(ws + OFF_BF); bf16_t* K1 = Q1 + (size_t)T * 1024; bf16_t* VT1 = K1 + (size_t)R * 256;
  bf16_t* YB = (bf16_t*)(ws + OFF_BY + (size_t)2 * R * 128 * 4);
  float* PAB = (float*)(ws + OFF_BF); bf16_t* FB = (bf16_t*)(ws + OFF_BF + (size_t)R * 8 * 128 * 4);
  float* WB = (float*)(ws + OFF_BF + (size_t)R * 8 * 128 * 4 + (size_t)R * 1024 * 2); float* CORRB = WB + (size_t)R * 128;
  int* EXPB = (int*)(ws + OFF_BY); float* GATEB = (float*)(ws + OFF_BY + (size_t)R * 128 * 4);
  float* out = p.out;
  unsigned* QC = (unsigned*)(ws + OFF_BAR) + 32;
#define QFILL(site, layer, lo, hi) quant_fill(QC + (site), (layer), (lo), (hi), peer_u, peer_v, U8, V8, USC, VSC, (unsigned*)(smem_raw + 65024))

  PH(0, ph_tables(TAB); ph_rope_table(RT))
  PH(1, ph_fft_tables(FD1, FD3, FDC))
  PH(2, ph_ada2(c, c_ctx, ada_w, ada_b, Mm, smem))
  PH(3, ph_transpose_w(even_w_in, 1024, 2048, WIN0, smem))
  PH(4, ph_transpose_w(even_w_out, 1024, 1024, WOUT0, smem))
  PH(5, ph_transpose_w(odd_w_in, 1024, 1536, WIN1, smem))
  PH(6, ph_transpose_w(odd_w_out, 1024, 1024, WOUT1, smem))
  PH(7, ph_transpose_w(peer_wq, 1024, 2048, WQ, smem))
  PH(8, ph_transpose_w(peer_wq + (size_t)1024 * 2048, 1024, 2048, WQ + (size_t)2048 * 1024, smem))
  PH(11, ph_convert(peer_sk, SKB, (size_t)2 * 8 * 2 * 128 * 128 / 8))
  xcd_barrier(xbar);
  PH(12, ph_modulate(x, ctx, Mm, 0, 0, 1, AB, R, smem))
  xcd_barrier(xbar);
  PH(13, ph_gemm_bf16(AB, 1024, WIN0, 1024, R, 2048, 1024, EpiQKV0{FQKV, VT0}, smem_raw))
  PH(9, QFILL(0, 0, 0u, 160u))
  xcd_barrier(xbar);
  PH(14, { GRID_LOOP(u, NB * 64 * 8) fft1_unit(u, FQKV, FD1, TAB, A1, smem_raw); })
  PH(15, { int lane = threadIdx.x & 63, wave = __builtin_amdgcn_readfirstlane(threadIdx.x >> 6);
           __syncthreads();
           for (int i = threadIdx.x; i < 8 * 15 * 31; i += 256) smem[i] = rpb[i] * 1.4426950408889634f;
           __syncthreads();
           for (int bu = blockIdx.x; bu < 512 + 64; bu += gridDim.x) {
             if (bu < 512) { int h = bu & 7, rg = (bu >> 3) & 31, bb = bu >> 8;
               na_unit(bb, h, rg * 4 + wave, FQKV, VT0, VT0 + (size_t)NB * 8 * 64 * S, smem, AB, lane); }
             else { int cu = bu - 512; int h = cu & 7, qg = (cu >> 3) & 3, bb = cu >> 5;
               attn_unit<1, 1, 2, true>(bb, h, 0, 0, qg * 4 + wave, FQKV + 512, 2048, FQKV + 1024, 2048, VT0, VT0 + (size_t)NB * 8 * 64 * S, 8, smem, nullptr, AB + 512, 1024, lane); } } })
  xcd_barrier(xbar);
  PH(16, { GRID_LOOP(u, NB * 128 * 8 + NB * 4 * 8) { if (u < NB * 128 * 8) fft3_unit(u, 0, FQKV, A1, FD3, FDC, TAB, AB, smem_raw); else fft3_unit(u - NB * 128 * 8, 1, FQKV, A1, FD3, FDC, TAB, AB, smem_raw); } })
  xcd_barrier(xbar);
  PH(17, ph_gemm_bf16(AB, 1024, WOUT0, 1024, R, 1024, 1024, EpiBf16{YB, 1024}, smem_raw))
  PH(9, QFILL(1, 0, 160u, 260u))
  xcd_barrier(xbar);
  PH(18, ph_post_mod(x, ctx, YB, Mm, 0, 2, 0, 3, 4, true, ln_g + 0, ln_b + 0, X1, AB, R))
  xcd_barrier(xbar);
  PH(21, ph_peer_select(AB, WQ, SKB, EXPB, GATEB, R, smem_raw))
  PH(9, QFILL(2, 0, 260u, 512u))
  PH(10, QFILL(3, 1, 0u, 300u))
  xcd_barrier(xbar);
  PH(22, ph_peer_u(AB, EXPB, U8, PAB, R))
  xcd_barrier(xbar);
  PH(32, ph_peer_w(PAB, EXPB, GATEB, USC, VSC, (unsigned*)WB, CORRB, R))
  xcd_barrier(xbar);
  PH(33, ph_peer_v((const unsigned*)WB, CORRB, EXPB, V8, FB, R))
  xcd_barrier(xbar);
  PH(34, ph_post_mod(X1, X1 + (size_t)T * D, FB, Mm, 0, 5, 1, 0, 1, true, ln_g + 1024, ln_b + 1024, X2, AB, R))
  xcd_barrier(xbar);
  PH(23, ph_gemm_bf16(AB, 1024, WIN1, 1024, R, 1536, 1024, EpiQKV1{Q1, K1, VT1, RT}, smem_raw))
  PH(10, QFILL(4, 1, 300u, 420u))
  xcd_barrier(xbar);
  PH(25, { int lane = threadIdx.x & 63, wave = __builtin_amdgcn_readfirstlane(threadIdx.x >> 6);
           for (int bu = blockIdx.x; bu < 1024; bu += gridDim.x) { int kvh = bu & 3, bb = (bu >> 2) & 1, qg = bu >> 3;
             attn_unit<4, 2, 1, true>(bb, kvh, 0, 0, qg * 4 + wave, Q1, 1024, K1, 256, VT1, VT1 + (size_t)NB * 4 * 64 * S, 4, nullptr, sink, AB, 1024, lane); } })
  xcd_barrier(xbar);
  PH(26, ph_gemm_bf16(AB, 1024, WOUT1, 1024, T, 1024, 1024, EpiBf16{YB, 1024}, smem_raw))
  xcd_barrier(xbar);
  PH(27, ph_post_mod(X2, X2, YB, Mm, 1, 2, 1, 3, 4, true, ln_g + 2048, ln_b + 2048, X1, AB, T))
  xcd_barrier(xbar);
  PH(30, ph_peer_select(AB, WQ + (size_t)2048 * 1024, SKB + (size_t)8 * 2 * 128 * 128, EXPB, GATEB, T, smem_raw))
  PH(10, QFILL(5, 1, 420u, 512u))
  xcd_barrier(xbar);
  PH(31, ph_peer_u(AB, EXPB, U8 + (size_t)16384 * 1024, PAB, T))
  xcd_barrier(xbar);
  PH(35, ph_peer_w(PAB, EXPB, GATEB, USC + 16384, VSC + 16384, (unsigned*)WB, CORRB, T))
  xcd_barrier(xbar);
  PH(36, ph_peer_v((const unsigned*)WB, CORRB, EXPB, V8 + (size_t)16384 * 1024, FB, T))
  xcd_barrier(xbar);
  PH(37, ph_post_mod(X1, X1, FB, Mm, 1, 5, 1, 0, 1, false, ln_g + 3072, ln_b + 3072, out, AB, T))
}

}

extern "C" void kernel_launch(void* const* d_in, const int* in_sizes, int n_in, void* d_out, int out_size, void* d_ws,
                              size_t ws_size, hipStream_t stream) {
  static int grid_blocks = 0;
  if (!grid_blocks) {
    int dev = 0, cus = 0, per_cu = 0;
    hipGetDevice(&dev);
    hipDeviceGetAttribute(&cus, hipDeviceAttributeMultiprocessorCount, dev);
    hipOccupancyMaxActiveBlocksPerMultiprocessor(&per_cu, (const void*)mega, 256, 0);
    if (per_cu > 2) per_cu = 2;
    if (per_cu < 1) per_cu = 1;
    grid_blocks = cus * per_cu;
  }
  Params p{};
  for (int i = 0; i < 18; ++i) p.in[i] = (const float*)d_in[i];
  p.out = (float*)d_out;
  p.ws = (float*)d_ws;
  (void)hipMemsetAsync((char*)d_ws + OFF_BAR, 0, XCD_BAR_WORDS_C * 4, stream);
  void* args[] = {&p};
  hipError_t e = hipLaunchCooperativeKernel((const void*)mega, dim3(grid_blocks), dim3(256), args, 0, stream);
  if (e != hipSuccess) fprintf(stderr, "cooperative launch failed: %s (grid %d)\n", hipGetErrorString(e), grid_blocks);
}
```

```cpp
#include <hip/hip_runtime.h>
#include <hip/hip_bf16.h>
#include <stdint.h>
#include <math.h>
#include <stdio.h>
#include <hip/hip_cooperative_groups.h>
namespace cg = cooperative_groups;

namespace {

constexpr int D = 1024;
constexpr int NB = 2;
constexpr int S = 8192;
constexpr int T = NB * S;
constexpr int CL = 256;
constexpr int TC = NB * CL;
constexpr int R = T + TC;
constexpr float DN_ALPHA = 1.4142135623730951f;
constexpr float LN_EPS = 1e-6f;

template <int CTRL> __device__ __forceinline__ float dpp_mov(float x) {
  return __builtin_bit_cast(float, __builtin_amdgcn_mov_dpp(__builtin_bit_cast(int, x), CTRL, 0xf, 0xf, true));
}
__device__ __forceinline__ float xrow16_max(float x) {
  auto s = __builtin_amdgcn_permlane16_swap(__float_as_uint(x), __float_as_uint(x), false, false);
  x = fmaxf(__uint_as_float(s[0]), __uint_as_float(s[1]));
  auto t = __builtin_amdgcn_permlane32_swap(__float_as_uint(x), __float_as_uint(x), false, false);
  return fmaxf(__uint_as_float(t[0]), __uint_as_float(t[1]));
}
__device__ __forceinline__ float xrow16_sum(float x) {
  auto s = __builtin_amdgcn_permlane16_swap(__float_as_uint(x), __float_as_uint(x), false, false);
  x = __uint_as_float(s[0]) + __uint_as_float(s[1]);
  auto t = __builtin_amdgcn_permlane32_swap(__float_as_uint(x), __float_as_uint(x), false, false);
  return __uint_as_float(t[0]) + __uint_as_float(t[1]);
}
__device__ __forceinline__ float wave_sum(float v) {
  v += dpp_mov<0xB1>(v); v += dpp_mov<0x4E>(v); v += dpp_mov<0x124>(v); v += dpp_mov<0x128>(v);
  return xrow16_sum(v);
}
__device__ __forceinline__ float wave_max(float v) {
  v = fmaxf(v, dpp_mov<0xB1>(v)); v = fmaxf(v, dpp_mov<0x4E>(v)); v = fmaxf(v, dpp_mov<0x124>(v)); v = fmaxf(v, dpp_mov<0x128>(v));
  return xrow16_max(v);
}

typedef unsigned short bf16_t;
typedef __attribute__((ext_vector_type(8))) short bf16x8;
typedef __attribute__((ext_vector_type(16))) float f32x16;
typedef __attribute__((ext_vector_type(4))) float f32x4;

typedef __attribute__((ext_vector_type(2))) __bf16 bf16x2_t;
__device__ __forceinline__ unsigned f2bf(float f) { return (unsigned)__builtin_bit_cast(unsigned short, (__bf16)f); }
__device__ __forceinline__ unsigned pack2bf(float a, float b) { bf16x2_t v = {(__bf16)a, (__bf16)b}; return __builtin_bit_cast(unsigned, v); }
__device__ __forceinline__ float bf2f(unsigned short v) { return __uint_as_float(((unsigned)v) << 16); }

__device__ __forceinline__ int mod_index(int row) { return row < T ? row / S : 2; }


struct Params {
  const float* in[18];
  float* out;
  float* ws;
};

constexpr size_t XCD_BAR_WORDS_C = 3456;
constexpr size_t al256(size_t n) { return (n + 255) & ~(size_t)255; }
constexpr size_t OFF_BAR = 0;
constexpr size_t OFF_TAB = al256(XCD_BAR_WORDS_C * 4);
constexpr size_t OFF_M = OFF_TAB + al256(16384 * 4 + 128 * 16 * 2 * 4);
constexpr size_t OFF_WIN0 = OFF_M + al256(2 * 3 * 6144 * 4);
constexpr size_t OFF_WOUT0 = OFF_WIN0 + al256((size_t)2048 * 1024 * 2);
constexpr size_t OFF_WIN1 = OFF_WOUT0 + al256((size_t)1024 * 1024 * 2);
constexpr size_t OFF_WOUT1 = OFF_WIN1 + al256((size_t)1536 * 1024 * 2);
constexpr size_t OFF_WQ = OFF_WOUT1 + al256((size_t)1024 * 1024 * 2);
constexpr size_t OFF_SK = OFF_WQ + al256((size_t)2 * 2048 * 1024 * 2);
constexpr size_t OFF_UB = OFF_SK + al256((size_t)2 * 8 * 2 * 128 * 128 * 2);
constexpr size_t OFF_VB = OFF_UB + al256((size_t)2 * 16384 * 1024);
constexpr size_t OFF_USC = OFF_VB + al256((size_t)2 * 16384 * 1024);
constexpr size_t OFF_AB = OFF_USC + al256((size_t)4 * 16384 * 4);
constexpr size_t OFF_FT = OFF_AB + al256((size_t)R * 1024 * 2);
constexpr size_t OFF_BF = OFF_FT + al256((size_t)(256 * 128 + 128 * 128 + 64 * 128) * 2);
constexpr size_t OFF_BY = OFF_BF + al256((size_t)R * 2048 * 4);
constexpr size_t OFF_X1 = OFF_BY + al256((size_t)R * 1024 * 4);
constexpr size_t OFF_X2 = OFF_X1 + al256((size_t)R * 1024 * 4);
constexpr size_t OFF_END = OFF_X2 + al256((size_t)R * 1024 * 4);
constexpr size_t OFF_A1 = OFF_BY;
constexpr size_t OFF_VT0 = OFF_X2;
static_assert(OFF_END <= (size_t)512 * 1024 * 1024, "workspace overflow");

#define GRID_LOOP(var, n) for (int var = blockIdx.x; var < (n); var += gridDim.x)

__device__ __forceinline__ void ph_fft_tables(bf16_t* D1, bf16_t* D3, bf16_t* DcT) {
  const double TWO_PI = 6.283185307179586476925286766559;
  for (int i = blockIdx.x * 256 + threadIdx.x; i < 256 * 128 + 128 * 128 + 64 * 128; i += gridDim.x * 256) {
    if (i < 256 * 128) {
      int m = i >> 7, r = i & 127; int k1 = m >> 1, ri = m & 1;
      double a = TWO_PI * (double)((k1 * r) & 127) / 128.0;
      D1[i] = (bf16_t)f2bf(ri == 0 ? (float)cos(a) : (float)(-sin(a)));
    } else if (i < 256 * 128 + 128 * 128) {
      int j = i - 256 * 128; int m = j >> 7, kk = j & 127; int rip = m >> 6, k2 = m & 63; int c = kk >> 1, ri = kk & 1;
      double a = TWO_PI * (double)((k2 * c) & 63) / 64.0;
      double v = (rip == 0) ? (ri == 0 ? cos(a) : sin(a)) : (ri == 0 ? -sin(a) : cos(a));
      D3[j] = (bf16_t)f2bf((float)v);
    } else {
      int j = i - 256 * 128 - 128 * 128; int cp = j >> 7, kk = j & 127; int rip = kk >> 6, ch = kk & 63;
      double a = TWO_PI * (double)((ch * cp) & 63) / 64.0;
      DcT[j] = (bf16_t)f2bf((float)(rip == 0 ? cos(a) : sin(a)));
    }
  }
}
__device__ __forceinline__ void ph_rope_table(float* RT) {
  for (int i = blockIdx.x * 256 + threadIdx.x; i < 128 * 16; i += gridDim.x * 256) {
    int pos = i >> 4, f = i & 15;
    float inv_freq = powf(10000.0f, -(float)f / 16.0f);
    float ang = (float)pos * inv_freq;
    RT[2 * i] = cosf(ang); RT[2 * i + 1] = sinf(ang);
  }
}
__device__ __forceinline__ void ph_tables(float* tab) {
  for (int j = blockIdx.x * 256 + threadIdx.x; j < 8192; j += gridDim.x * 256) {
    double a = 6.283185307179586476925286766559 * (double)j / 8192.0;
    tab[j] = (float)cos(a);
    tab[8192 + j] = (float)sin(a);
  }
}
__device__ __forceinline__ void ph_ada(const float* __restrict__ c, const float* __restrict__ c_ctx, const float* __restrict__ ada_w,
                       const float* __restrict__ ada_b, float* __restrict__ M) {
  for (int gid = blockIdx.x * 256 + threadIdx.x; gid < 2 * 3 * 6144; gid += gridDim.x * 256) {
    int col = gid % 6144; int idx = (gid / 6144) % 3; int layer = gid / (3 * 6144);
    const float* vec = idx < 2 ? c + idx * D : c_ctx;
    const float* w = ada_w + (size_t)layer * D * 6144 + col;
    float acc = 0.f;
    for (int k = 0; k < D; ++k) {
      float x = vec[k];
      float sx = x / (1.f + expf(-x));
      acc += sx * w[(size_t)k * 6144];
    }
    M[gid] = acc + ada_b[layer * 6144 + col];
  }
}

__device__ __forceinline__ void ph_modulate(const float* __restrict__ xa, const float* __restrict__ xb, const float* __restrict__ M, int layer,
                            int jshift, int jscale, bf16_t* __restrict__ out, int nrows, float* red) {
  int tid = threadIdx.x;
  GRID_LOOP(row, nrows) {
    const float* x = row < T ? xa + (size_t)row * D : xb + (size_t)(row - T) * D;
    float v[4]; float s = 0.f;
#pragma unroll
    for (int i = 0; i < 4; ++i) { v[i] = x[tid + 256 * i]; s += v[i]; }
    s = wave_sum(s);
    __syncthreads();
    if ((tid & 63) == 0) red[tid >> 6] = s;
    __syncthreads();
    float mu = (red[0] + red[1] + red[2] + red[3]) * (1.f / D);
    float q = 0.f;
#pragma unroll
    for (int i = 0; i < 4; ++i) { float d = v[i] - mu; q += d * d; }
    q = wave_sum(q);
    if ((tid & 63) == 0) red[4 + (tid >> 6)] = q;
    __syncthreads();
    float var = (red[4] + red[5] + red[6] + red[7]) * (1.f / D);
    float rs = rsqrtf(var + LN_EPS);
    const float* m = M + ((size_t)layer * 3 + mod_index(row)) * 6144;
#pragma unroll
    for (int i = 0; i < 4; ++i) {
      int col = tid + 256 * i;
      float y = (v[i] - mu) * rs;
      out[(size_t)row * D + col] = (bf16_t)f2bf(y * (1.f + m[jscale * D + col]) + m[jshift * D + col]);
    }
  }
}

__device__ __forceinline__ void ph_post(const float* __restrict__ xa, const float* __restrict__ xb, const float* __restrict__ Y,
                        const float* __restrict__ M, int layer, int j, const float* __restrict__ g, const float* __restrict__ bb,
                        float* __restrict__ outa, float* __restrict__ outb, int nrows, float* red) {
  int tid = threadIdx.x;
  GRID_LOOP(row, nrows) {
    const float* x = row < T ? xa + (size_t)row * D : xb + (size_t)(row - T) * D;
    float* out = row < T ? outa + (size_t)row * D : outb + (size_t)(row - T) * D;
    const float* m = M + ((size_t)layer * 3 + mod_index(row)) * 6144 + j * D;
    float v[4]; float s = 0.f;
#pragma unroll
    for (int i = 0; i < 4; ++i) { int col = tid + 256 * i; v[i] = DN_ALPHA * x[col] + m[col] * Y[(size_t)row * D + col]; s += v[i]; }
    s = wave_sum(s);
    __syncthreads();
    if ((tid & 63) == 0) red[tid >> 6] = s;
    __syncthreads();
    float mu = (red[0] + red[1] + red[2] + red[3]) * (1.f / D);
    float q = 0.f;
#pragma unroll
    for (int i = 0; i < 4; ++i) { float d = v[i] - mu; q += d * d; }
    q = wave_sum(q);
    if ((tid & 63) == 0) red[4 + (tid >> 6)] = q;
    __syncthreads();
    float var = (red[4] + red[5] + red[6] + red[7]) * (1.f / D);
    float rs = rsqrtf(var + LN_EPS);
#pragma unroll
    for (int i = 0; i < 4; ++i) {
      int col = tid + 256 * i;
      out[col] = (v[i] - mu) * rs * g[col] + bb[col];
    }
  }
}

struct ARow { const float* A; int lda; __device__ float operator()(int m, int k) const { return A[(size_t)m * lda + k]; } };
struct BRow { const float* B; int ldb; __device__ float operator()(int k, int n) const { return B[(size_t)k * ldb + n]; } };
struct CRow { float* C; int ldc; float scale; __device__ void operator()(int m, int n, float v) const { C[(size_t)m * ldc + n] = v * scale; } };
struct CRowB { bf16_t* C; int ldc; float scale; __device__ void operator()(int m, int n, float v) const { C[(size_t)m * ldc + n] = (bf16_t)f2bf(v * scale); } };
struct ADft { const float* tab; int Sn; int stride; __device__ float operator()(int m, int k) const {
    int t = k & (Sn - 1); int idx = ((m * t) & (Sn - 1)) * stride;
    return k < Sn ? tab[idx] : -tab[8192 + idx]; } };
struct BPQ { const float* PQ; int rowbase; int Sn; __device__ float operator()(int k, int n) const {
    int t = k & (Sn - 1); return PQ[(size_t)(rowbase + t) * 1024 + (k >= Sn ? 512 : 0) + n]; } };

template <class AF, class BF, class CF>
__device__ __forceinline__ void ph_gemm(AF af, BF bf, CF cf, int M, int N, int K, float* sm) {
  float (*sA)[68] = (float (*)[68])sm;
  float (*sB)[68] = (float (*)[68])(sm + 16 * 68);
  int tid = threadIdx.x; int tx = tid & 15, ty = tid >> 4;
  int ntn = N / 64; int ntiles = (M / 64) * ntn;
  GRID_LOOP(tile, ntiles) {
    int m0 = (tile / ntn) * 64, n0 = (tile % ntn) * 64;
    float acc[4][4];
#pragma unroll
    for (int i = 0; i < 4; ++i)
#pragma unroll
      for (int j = 0; j < 4; ++j) acc[i][j] = 0.f;
    for (int k0 = 0; k0 < K; k0 += 16) {
      __syncthreads();
#pragma unroll
      for (int i = 0; i < 4; ++i) { int e = tid + 256 * i; int m = e >> 4, k = e & 15; sA[k][m] = af(m0 + m, k0 + k); }
#pragma unroll
      for (int i = 0; i < 4; ++i) { int e = tid + 256 * i; int k = e >> 6, n = e & 63; sB[k][n] = bf(k0 + k, n0 + n); }
      __syncthreads();
#pragma unroll
      for (int k = 0; k < 16; ++k) {
        float a[4], b[4];
#pragma unroll
        for (int i = 0; i < 4; ++i) { a[i] = sA[k][ty * 4 + i]; b[i] = sB[k][tx * 4 + i]; }
#pragma unroll
        for (int i = 0; i < 4; ++i)
#pragma unroll
          for (int j = 0; j < 4; ++j) acc[i][j] += a[i] * b[j];
      }
    }
#pragma unroll
    for (int i = 0; i < 4; ++i)
#pragma unroll
      for (int j = 0; j < 4; ++j) cf(m0 + ty * 4 + i, n0 + tx * 4 + j, acc[i][j]);
  }
}


__device__ __forceinline__ void ph_transpose_w(const float* __restrict__ W, int K, int N, bf16_t* __restrict__ Wt, float* sm) {
  int tid = threadIdx.x;
  int tk = K / 64, tn = N / 64;
  GRID_LOOP(tile, tk * tn) {
    int k0 = (tile / tn) * 64, n0 = (tile % tn) * 64;
    __syncthreads();
#pragma unroll
    for (int i = 0; i < 16; ++i) { int e = tid + 256 * i; int k = e >> 6, n = e & 63; sm[k * 65 + n] = W[(size_t)(k0 + k) * N + n0 + n]; }
    __syncthreads();
#pragma unroll
    for (int i = 0; i < 2; ++i) {
      int e = tid + 256 * i; int n = e >> 3, kc = e & 7;
      unsigned w[4];
#pragma unroll
      for (int j = 0; j < 4; ++j) w[j] = pack2bf(sm[(kc * 8 + 2 * j) * 65 + n], sm[(kc * 8 + 2 * j + 1) * 65 + n]);
      *(uint4*)(Wt + (size_t)(n0 + n) * K + k0 + kc * 8) = make_uint4(w[0], w[1], w[2], w[3]);
    }
  }
}
__device__ __forceinline__ void ph_convert(const float* __restrict__ src, bf16_t* __restrict__ dst, size_t n8) {
  for (size_t i = (size_t)blockIdx.x * 256 + threadIdx.x; i < n8; i += (size_t)gridDim.x * 256) {
    float4 a = ((const float4*)src)[2 * i], b = ((const float4*)src)[2 * i + 1];
    ((uint4*)dst)[i] = make_uint4(pack2bf(a.x, a.y), pack2bf(a.z, a.w), pack2bf(b.x, b.y), pack2bf(b.z, b.w));
  }
}

__device__ __forceinline__ void gemm_stage(const bf16_t* __restrict__ A, int lda, int k0, char* lds, int tid) {
#pragma unroll
  for (int i = 0; i < 4; ++i) {
    int q = tid + 256 * i; int row = q >> 3, p = q & 7; int c = p ^ ((row >> 1) & 7);
    const bf16_t* src = A + (size_t)row * lda + k0 + c * 8;
    __builtin_amdgcn_global_load_lds((const unsigned*)src, (unsigned*)(lds + q * 16), 16, 0, 0);
  }
}
struct EpiF32 {
  float* C; int ldc; float scale;
  __device__ __forceinline__ void operator()(int m0, int n0, int wm, int wn, f32x16 (&acc)[2][2], int tid, char* smem) const {
    int lane = tid & 63;
    float* t = (float*)smem;
    int rbase = wm * 64 + 4 * (lane >> 5), cbase = wn * 64 + (lane & 31);
#pragma unroll
    for (int mi = 0; mi < 2; ++mi)
#pragma unroll
      for (int ni = 0; ni < 2; ++ni)
#pragma unroll
        for (int r = 0; r < 16; ++r)
          t[(rbase + mi * 32 + (r & 3) + 8 * (r >> 2)) * 128 + cbase + ni * 32] = acc[mi][ni][r] * scale;
    __syncthreads();
    float* dst = C + (size_t)(m0 + (tid >> 5)) * ldc + n0 + (tid & 31) * 4;
    const float* src = t + (tid >> 5) * 128 + (tid & 31) * 4;
#pragma unroll 4
    for (int i = 0; i < 16; ++i) {
      *(float4*)dst = *(const float4*)src;
      dst += (size_t)8 * ldc; src += 8 * 128;
    }
  }
};
struct EpiQKV0 {
  bf16_t* FQKV; bf16_t* VT;
  __device__ __forceinline__ void operator()(int m0, int n0, int wm, int wn, f32x16 (&acc)[2][2], int tid, char* smem) const {
    int lane = tid & 63;
    bf16_t* t = (bf16_t*)smem;
    int rbase = wm * 64 + 4 * (lane >> 5), cbase = wn * 64 + (lane & 31);
#pragma unroll
    for (int mi = 0; mi < 2; ++mi)
#pragma unroll
      for (int ni = 0; ni < 2; ++ni)
#pragma unroll
        for (int r = 0; r < 16; ++r)
          t[(rbase + mi * 32 + (r & 3) + 8 * (r >> 2)) * 136 + cbase + ni * 32] = (bf16_t)f2bf(acc[mi][ni][r]);
    __syncthreads();
    {
      bf16_t* dst = FQKV + (size_t)(m0 + (tid >> 4)) * 2048 + n0 + (tid & 15) * 8;
      const bf16_t* src = t + (tid >> 4) * 136 + (tid & 15) * 8;
#pragma unroll 4
      for (int i = 0; i < 8; ++i) {
        *(uint4*)dst = *(const uint4*)src;
        dst += (size_t)16 * 2048; src += 16 * 136;
      }
    }
    if (n0 >= 1536) {
      int col = tid >> 1, half = tid & 1;
      int hd = (n0 - 1536) / 64 + (col >> 6), d = col & 63;
      bf16_t* dst;
      if (m0 < T) { int b = m0 / S, t0 = m0 % S; dst = VT + (((size_t)b * 8 + hd) * 64 + d) * S + t0 + half * 64; }
      else { int mm = m0 - T; int b = mm / CL, l0 = mm % CL; dst = VT + (size_t)NB * 8 * 64 * S + (((size_t)b * 8 + hd) * 64 + d) * CL + l0 + half * 64; }
      const bf16_t* src = t + (half * 64) * 136 + col;
#pragma unroll
      for (int i = 0; i < 8; ++i) {
        unsigned wv[4];
#pragma unroll
        for (int j = 0; j < 4; ++j) wv[j] = (unsigned)src[(i * 8 + 2 * j) * 136] | ((unsigned)src[(i * 8 + 2 * j + 1) * 136] << 16);
        *(uint4*)(dst + i * 8) = make_uint4(wv[0], wv[1], wv[2], wv[3]);
      }
    }
  }
};
struct EpiBf16 {
  bf16_t* C; int ldc;
  __device__ __forceinline__ void operator()(int m0, int n0, int wm, int wn, f32x16 (&acc)[2][2], int tid, char* smem) const {
    int lane = tid & 63;
    asm volatile("" : "+v"(lane));
    bf16_t* t = (bf16_t*)smem;
    {
      bf16_t* tw = t + (wm * 64 + 4 * (lane >> 5)) * 136 + wn * 64 + (lane & 31);
#pragma unroll
      for (int mi = 0; mi < 2; ++mi)
#pragma unroll
        for (int ni = 0; ni < 2; ++ni)
#pragma unroll
          for (int r = 0; r < 16; ++r)
            tw[(mi * 32 + (r & 3) + 8 * (r >> 2)) * 136 + ni * 32] = (bf16_t)f2bf(acc[mi][ni][r]);
    }
    __syncthreads();
    bf16_t* dst = C + (size_t)(m0 + (tid >> 4)) * ldc + n0 + (tid & 15) * 8;
    const bf16_t* src = t + (tid >> 4) * 136 + (tid & 15) * 8;
#pragma unroll 4
    for (int i = 0; i < 8; ++i) {
      *(uint4*)dst = *(const uint4*)src;
      dst += (size_t)16 * ldc; src += 16 * 136;
    }
  }
};
struct EpiQKV1 {
  bf16_t* Q1; bf16_t* K1; bf16_t* VT; const float* RT;
  __device__ __forceinline__ void operator()(int m0, int n0, int wm, int wn, f32x16 (&acc)[2][2], int tid, char* smem) const {
    int lane = tid & 63;
    asm volatile("" : "+v"(lane));
    bf16_t* t = (bf16_t*)smem;
    if (n0 < 1280 && m0 < T) {
      int i = lane & 31; int f = i & 15;
#pragma unroll
      for (int mi = 0; mi < 2; ++mi)
#pragma unroll
        for (int r = 0; r < 16; ++r) {
          int row = m0 + wm * 64 + 4 * (lane >> 5) + mi * 32 + (r & 3) + 8 * (r >> 2);
          int tt = row & (S - 1);
          int pos = (i < 16) ? (tt >> 6) : (tt & 63);
          float2 cs = *(const float2*)(RT + 2 * (pos * 16 + f));
          float x1 = acc[mi][0][r], x2 = acc[mi][1][r];
          acc[mi][0][r] = x1 * cs.x - x2 * cs.y;
          acc[mi][1][r] = x1 * cs.y + x2 * cs.x;
        }
    }
    {
      bf16_t* tw = t + (wm * 64 + 4 * (lane >> 5)) * 136 + wn * 64 + (lane & 31);
#pragma unroll
      for (int mi = 0; mi < 2; ++mi)
#pragma unroll
        for (int ni = 0; ni < 2; ++ni)
#pragma unroll
          for (int r = 0; r < 16; ++r)
            tw[(mi * 32 + (r & 3) + 8 * (r >> 2)) * 136 + ni * 32] = (bf16_t)f2bf(acc[mi][ni][r]);
    }
    __syncthreads();
    if (n0 < 1280) {
      bf16_t* dst; int ld;
      if (n0 < 1024) { dst = Q1 + (size_t)(m0 + (tid >> 4)) * 1024 + n0 + (tid & 15) * 8; ld = 1024; }
      else { dst = K1 + (size_t)(m0 + (tid >> 4)) * 256 + (n0 - 1024) + (tid & 15) * 8; ld = 256; }
      if (n0 >= 1024 || m0 < T) {
        const bf16_t* src = t + (tid >> 4) * 136 + (tid & 15) * 8;
#pragma unroll 4
        for (int i = 0; i < 8; ++i) {
          *(uint4*)dst = *(const uint4*)src;
          dst += (size_t)16 * ld; src += 16 * 136;
        }
      }
    } else {
      int col = tid >> 1, half = tid & 1;
      int hd = (n0 - 1280) / 64 + (col >> 6), d = col & 63;
      bf16_t* dst;
      if (m0 < T) { int b = m0 / S, t0 = m0 % S; dst = VT + (((size_t)b * 4 + hd) * 64 + d) * S + t0 + half * 64; }
      else { int mm = m0 - T; int b = mm / CL, l0 = mm % CL; dst = VT + (size_t)NB * 4 * 64 * S + (((size_t)b * 4 + hd) * 64 + d) * CL + l0 + half * 64; }
      const bf16_t* src = t + (half * 64) * 136 + col;
#pragma unroll
      for (int i = 0; i < 8; ++i) {
        unsigned wv[4];
#pragma unroll
        for (int j = 0; j < 4; ++j) wv[j] = (unsigned)src[(i * 8 + 2 * j) * 136] | ((unsigned)src[(i * 8 + 2 * j + 1) * 136] << 16);
        *(uint4*)(dst + i * 8) = make_uint4(wv[0], wv[1], wv[2], wv[3]);
      }
    }
  }
};
__device__ __forceinline__ void gemm_tile_mainloop(const bf16_t* __restrict__ Ag, int lda, const bf16_t* __restrict__ Bg, int ldb, int KT,
                                                   f32x16 (&acc)[2][2], char* smem) {
  int tid = threadIdx.x;
  asm volatile("" : "+v"(tid));
  int lane = tid & 63, wave = __builtin_amdgcn_readfirstlane(tid >> 6), wm = wave >> 1, wn = wave & 1;
#pragma unroll
  for (int mi = 0; mi < 2; ++mi)
#pragma unroll
    for (int ni = 0; ni < 2; ++ni)
#pragma unroll
      for (int r = 0; r < 16; ++r) acc[mi][ni][r] = 0.f;
  __syncthreads();
  gemm_stage(Ag, lda, 0, smem, tid); gemm_stage(Bg, ldb, 0, smem + 16384, tid);
  for (int kt = 0; kt < KT; ++kt) {
    asm volatile("s_waitcnt vmcnt(0)" ::: "memory");
    __syncthreads();
    char* cur = smem + (kt & 1) * 32768;
    if (kt + 1 < KT) {
      char* nxt = smem + ((kt + 1) & 1) * 32768;
      gemm_stage(Ag, lda, (kt + 1) * 64, nxt, tid); gemm_stage(Bg, ldb, (kt + 1) * 64, nxt + 16384, tid);
    }
#pragma unroll
    for (int s4 = 0; s4 < 4; ++s4) {
      bf16x8 a[2], b[2];
      int c = 2 * s4 + (lane >> 5);
#pragma unroll
      for (int mi = 0; mi < 2; ++mi) { int row = wm * 64 + mi * 32 + (lane & 31); a[mi] = *(const bf16x8*)(cur + row * 128 + ((c ^ ((row >> 1) & 7)) << 4)); }
#pragma unroll
      for (int ni = 0; ni < 2; ++ni) { int row = wn * 64 + ni * 32 + (lane & 31); b[ni] = *(const bf16x8*)(cur + 16384 + row * 128 + ((c ^ ((row >> 1) & 7)) << 4)); }
#pragma unroll
      for (int mi = 0; mi < 2; ++mi)
#pragma unroll
        for (int ni = 0; ni < 2; ++ni) acc[mi][ni] = __builtin_amdgcn_mfma_f32_32x32x16_bf16(a[mi], b[ni], acc[mi][ni], 0, 0, 0);
    }
  }
  __syncthreads();
}
template <class Epi>
__device__ __forceinline__ void ph_gemm_bf16(const bf16_t* __restrict__ A, int lda, const bf16_t* __restrict__ Bt, int ldb, int M, int N, int K,
                             Epi epi, char* smem) {
  int tid = threadIdx.x, wave = __builtin_amdgcn_readfirstlane(tid >> 6), wm = wave >> 1, wn = wave & 1;
  int ntn = N / 128, ntiles = (M / 128) * ntn;
  int KT = K / 64;
  (void)ntiles;
  int nb8 = gridDim.x >> 3, xq = blockIdx.x & 7, xm = xq >> 1, xn = xq & 1;
  int MT = M / 128, mq = (MT + 3) >> 2, nh = ntn >> 1;
  for (int lt = (int)(blockIdx.x >> 3); lt < mq * nh; lt += nb8) {
    int mt = xm * mq + lt / nh, nt = xn * nh + lt % nh;
    if (mt >= MT) continue;
    f32x16 acc[2][2];
    gemm_tile_mainloop(A + (size_t)mt * 128 * lda, lda, Bt + (size_t)nt * 128 * ldb, ldb, KT, acc, smem);
    epi(mt * 128, nt * 128, wm, wn, acc, tid, smem);
  }
}


#define RAW_BARRIER() do { asm volatile("s_waitcnt lgkmcnt(0)" ::: "memory"); __builtin_amdgcn_s_barrier(); } while (0)
__device__ __forceinline__ void gemm_stage32x(const bf16_t* __restrict__ Ag, int lda, const bf16_t* __restrict__ Bg, int ldb, int k0, char* lds, int tid) {
#pragma unroll
  for (int i = 0; i < 2; ++i) { int q = tid + 256 * i; int row = q >> 2, p = q & 3; int c = p ^ ((row >> 2) & 3);
    __builtin_amdgcn_global_load_lds((const unsigned*)(Ag + (size_t)row * lda + k0 + c * 8), (unsigned*)(lds + q * 16), 16, 0, 0); }
#pragma unroll
  for (int i = 0; i < 2; ++i) { int q = tid + 256 * i; int row = q >> 2, p = q & 3; int c = p ^ ((row >> 2) & 3);
    __builtin_amdgcn_global_load_lds((const unsigned*)(Bg + (size_t)row * ldb + k0 + c * 8), (unsigned*)(lds + 8192 + q * 16), 16, 0, 0); }
}
__device__ __forceinline__ void gemm_tile_mainloop3(const bf16_t* __restrict__ Ag, int lda, const bf16_t* __restrict__ Bg, int ldb, int KT,
                                                    f32x16 (&acc)[2][2], char* smem) {
  int tid = threadIdx.x;
  asm volatile("" : "+v"(tid));
  int lane = tid & 63, wave = tid >> 6, wm = wave >> 1, wn = wave & 1;
#pragma unroll
  for (int mi = 0; mi < 2; ++mi)
#pragma unroll
    for (int ni = 0; ni < 2; ++ni)
#pragma unroll
      for (int r = 0; r < 16; ++r) acc[mi][ni][r] = 0.f;
  __syncthreads();
  gemm_stage32x(Ag, lda, Bg, ldb, 0, smem, tid);
  gemm_stage32x(Ag, lda, Bg, ldb, 32, smem + 16384, tid);
  gemm_stage32x(Ag, lda, Bg, ldb, 64, smem + 32768, tid);
  for (int kt = 0; kt < KT; ++kt) {
    if (kt + 2 < KT) asm volatile("s_waitcnt vmcnt(8)" ::: "memory");
    else if (kt + 1 < KT) asm volatile("s_waitcnt vmcnt(4)" ::: "memory");
    else asm volatile("s_waitcnt vmcnt(0)" ::: "memory");
    RAW_BARRIER();
    if (kt + 3 < KT) gemm_stage32x(Ag, lda, Bg, ldb, (kt + 3) * 32, smem + ((kt + 3) & 3) * 16384, tid);
    char* cur = smem + (kt & 3) * 16384;
#pragma unroll
    for (int s2 = 0; s2 < 2; ++s2) {
      bf16x8 a[2], b[2];
      int c = 2 * s2 + (lane >> 5);
#pragma unroll
      for (int mi = 0; mi < 2; ++mi) { int row = wm * 64 + mi * 32 + (lane & 31); a[mi] = *(const bf16x8*)(cur + row * 64 + ((c ^ ((row >> 2) & 3)) << 4)); }
#pragma unroll
      for (int ni = 0; ni < 2; ++ni) { int row = wn * 64 + ni * 32 + (lane & 31); b[ni] = *(const bf16x8*)(cur + 8192 + row * 64 + ((c ^ ((row >> 2) & 3)) << 4)); }
#pragma unroll
      for (int mi = 0; mi < 2; ++mi)
#pragma unroll
        for (int ni = 0; ni < 2; ++ni) acc[mi][ni] = __builtin_amdgcn_mfma_f32_32x32x16_bf16(a[mi], b[ni], acc[mi][ni], 0, 0, 0);
    }
  }
  __syncthreads();
}
template <class Epi>
__device__ __forceinline__ void ph_gemm_bf16_3(const bf16_t* __restrict__ A, int lda, const bf16_t* __restrict__ Bt, int ldb, int M, int N, int K,
                             Epi epi, char* smem) {
  int tid = threadIdx.x, wave = __builtin_amdgcn_readfirstlane(tid >> 6), wm = wave >> 1, wn = wave & 1;
  int ntn = N / 128, ntiles = (M / 128) * ntn;
  GRID_LOOP(tile, ntiles) {
    int mt = tile / ntn, nt = tile % ntn;
    f32x16 acc[2][2];
    gemm_tile_mainloop3(A + (size_t)mt * 128 * lda, lda, Bt + (size_t)nt * 128 * ldb, ldb, K / 32, acc, smem);
    epi(mt * 128, nt * 128, wm, wn, acc, tid, smem);
  }
}
__device__ __forceinline__ void ins16(float (&L)[16], float x) {
#pragma unroll
  for (int j = 15; j >= 1; --j) L[j] = __builtin_amdgcn_fmed3f(L[j - 1], L[j], x);
  L[0] = fmaxf(L[0], x);
}
__device__ __forceinline__ void stage_tile128(const bf16_t* __restrict__ src, int ld, char* lds, int tid) {
#pragma unroll
  for (int i = 0; i < 8; ++i) {
    int q = tid + 256 * i; int row = q >> 4, p = q & 15; int c = p ^ (row & 15);
    __builtin_amdgcn_global_load_lds((const unsigned*)(src + (size_t)row * ld + c * 8), (unsigned*)(lds + q * 16), 16, 0, 0);
  }
}
__device__ __forceinline__ void ph_peer_select(const bf16_t* __restrict__ H, const bf16_t* __restrict__ WQl, const bf16_t* __restrict__ SKl,
                                               int* __restrict__ EXP, float* __restrict__ GATE, int nrows, char* smem) {
  int tid = threadIdx.x, w = __builtin_amdgcn_readfirstlane(tid >> 6), wm = w >> 1, wn = w & 1;
  bf16_t* Qs = (bf16_t*)smem;
  int* KL = (int*)(smem + 36864);
  int nb8 = gridDim.x >> 3, xq = blockIdx.x & 7, xm = xq >> 1, xn = xq & 1;
  int MT = nrows / 128, mq = (MT + 3) >> 2;
  for (int lu = (int)(blockIdx.x >> 3); lu < mq * 4; lu += nb8) {
    int mt = xm * mq + (lu >> 2), h = xn * 4 + (lu & 3);
    if (mt >= MT) continue;
    float L0[16], L1[16];
#pragma unroll
    for (int p = 0; p < 2; ++p) {
      f32x16 acc[2][2];
      gemm_tile_mainloop(H + (size_t)mt * 128 * 1024, 1024, WQl + (size_t)(h * 256 + p * 128) * 1024, 1024, 16, acc, smem);
      int lane = tid & 63;
      asm volatile("" : "+v"(lane));
      {
        bf16_t* qw = Qs + (wm * 64 + 4 * (lane >> 5)) * 136 + wn * 64 + (lane & 31);
#pragma unroll
        for (int mi = 0; mi < 2; ++mi)
#pragma unroll
          for (int ni = 0; ni < 2; ++ni)
#pragma unroll
            for (int r = 0; r < 16; ++r)
              qw[(mi * 32 + (r & 3) + 8 * (r >> 2)) * 136 + ni * 32] = (bf16_t)f2bf(acc[mi][ni][r]);
      }
      __syncthreads();
      f32x16 sc[4];
#pragma unroll
      for (int m4 = 0; m4 < 4; ++m4)
#pragma unroll
        for (int r = 0; r < 16; ++r) sc[m4][r] = 0.f;
      {
        const bf16_t* qrow = Qs + (32 * w + (lane & 31)) * 136 + 8 * (lane >> 5);
        const bf16_t* krow = SKl + (size_t)(h * 2 + p) * 128 * 128 + (lane & 31) * 128 + 8 * (lane >> 5);
#pragma unroll
        for (int s8 = 0; s8 < 8; ++s8) {
          bf16x8 bq = *(const bf16x8*)(qrow + 16 * s8);
#pragma unroll
          for (int m4 = 0; m4 < 4; ++m4) {
            bf16x8 ak = *(const bf16x8*)(krow + m4 * 32 * 128 + 16 * s8);
            sc[m4] = __builtin_amdgcn_mfma_f32_32x32x16_bf16(ak, bq, sc[m4], 0, 0, 0);
          }
        }
      }
      float L[16];
#pragma unroll
      for (int j = 0; j < 16; ++j) L[j] = -INFINITY;
      unsigned kb = 4u * (unsigned)(lane >> 5);
#pragma unroll
      for (int m4 = 0; m4 < 4; ++m4)
#pragma unroll
        for (int r = 0; r < 16; ++r) {
          unsigned key = kb + (unsigned)(32 * m4 + (r & 3) + 8 * (r >> 2));
          float x = __uint_as_float((__float_as_uint(sc[m4][r]) & 0xFFFFFF80u) | key);
          ins16(L, x);
        }
      float P[16];
#pragma unroll
      for (int j = 0; j < 16; ++j) P[j] = __shfl_xor(L[j], 32);
#pragma unroll
      for (int j = 0; j < 16; ++j) ins16(L, P[j]);
      if (p == 0) {
#pragma unroll
        for (int j = 0; j < 16; ++j) L0[j] = L[j];
      } else {
#pragma unroll
        for (int j = 0; j < 16; ++j) L1[j] = L[j];
      }
    }
    float C[16];
#pragma unroll
    for (int j = 0; j < 16; ++j) C[j] = -INFINITY;
#pragma unroll
    for (int a = 0; a < 16; ++a)
#pragma unroll
      for (int b = 0; b < 16; ++b)
        if ((a + 1) * (b + 1) <= 16) {
          float sa = __uint_as_float(__float_as_uint(L0[a]) & 0xFFFFFF80u);
          float sb = __uint_as_float(__float_as_uint(L1[b]) & 0xFFFFFF80u);
          float x = __uint_as_float((__float_as_uint(sa + sb) & 0xFFFFFF00u) | (unsigned)(a * 16 + b));
          ins16(C, x);
        }
    int lane = tid & 63;
    asm volatile("" : "+v"(lane));
    int token = 32 * w + (lane & 31);
    if (lane < 32) {
#pragma unroll
      for (int j = 0; j < 16; ++j) { KL[token * 32 + j] = (int)(__float_as_uint(L0[j]) & 0x7Fu); KL[token * 32 + 16 + j] = (int)(__float_as_uint(L1[j]) & 0x7Fu); }
    }
    __syncthreads();
    if (lane < 32) {
      float c0 = __uint_as_float(__float_as_uint(C[0]) & 0xFFFFFF00u);
      float ev[16]; float sum = 0.f; int ex[16];
#pragma unroll
      for (int j = 0; j < 16; ++j) {
        unsigned bits = __float_as_uint(C[j]);
        float cv = __uint_as_float(bits & 0xFFFFFF00u);
        ev[j] = __expf(cv - c0); sum += ev[j];
        int a = (bits >> 4) & 15, b = bits & 15;
        ex[j] = KL[token * 32 + a] * 128 + KL[token * 32 + 16 + b];
      }
      float inv = 1.f / sum;
      size_t o = (size_t)(mt * 128 + token) * 128 + h * 16;
#pragma unroll
      for (int j = 0; j < 16; j += 4) {
        *(int4*)(EXP + o + j) = make_int4(ex[j], ex[j + 1], ex[j + 2], ex[j + 3]);
        *(float4*)(GATE + o + j) = make_float4(ev[j] * inv, ev[j + 1] * inv, ev[j + 2] * inv, ev[j + 3] * inv);
      }
    }
  }
}

__device__ __forceinline__ void fft1_unit(int u, const bf16_t* __restrict__ FQKV, const bf16_t* __restrict__ D1, const float* __restrict__ TAB,
                          bf16_t* __restrict__ A1, char* smem) {
  int tid = threadIdx.x, lane = tid & 63, w = __builtin_amdgcn_readfirstlane(tid >> 6);
  int g = u & 7, c = (u >> 3) & 63, b = u >> 9;
  bf16_t* Bt = (bf16_t*)smem;
  __syncthreads();
  {
    int r = tid >> 1, half = tid & 1;
    const uint4* src = (const uint4*)(FQKV + (size_t)(b * S + 64 * r + c) * 2048 + g * 64 + half * 32);
    unsigned wv[16];
#pragma unroll
    for (int i = 0; i < 4; ++i) { uint4 v = src[i]; wv[4 * i] = v.x; wv[4 * i + 1] = v.y; wv[4 * i + 2] = v.z; wv[4 * i + 3] = v.w; }
#pragma unroll
    for (int j = 0; j < 32; ++j) {
      unsigned e = (j & 1) ? (wv[j >> 1] >> 16) : (wv[j >> 1] & 0xffffu);
      Bt[(half * 32 + j) * 136 + r] = (bf16_t)e;
    }
  }
  __syncthreads();
  f32x16 acc[2][2];
#pragma unroll
  for (int mi = 0; mi < 2; ++mi)
#pragma unroll
    for (int ni = 0; ni < 2; ++ni)
#pragma unroll
      for (int r = 0; r < 16; ++r) acc[mi][ni][r] = 0.f;
#pragma unroll
  for (int s8 = 0; s8 < 8; ++s8) {
    bf16x8 a[2], bb[2];
    int ko = 16 * s8 + 8 * (lane >> 5);
#pragma unroll
    for (int mi = 0; mi < 2; ++mi) a[mi] = *(const bf16x8*)(D1 + (64 * w + 32 * mi + (lane & 31)) * 128 + ko);
#pragma unroll
    for (int ni = 0; ni < 2; ++ni) bb[ni] = *(const bf16x8*)(Bt + (32 * ni + (lane & 31)) * 136 + ko);
#pragma unroll
    for (int mi = 0; mi < 2; ++mi)
#pragma unroll
      for (int ni = 0; ni < 2; ++ni) acc[mi][ni] = __builtin_amdgcn_mfma_f32_32x32x16_bf16(a[mi], bb[ni], acc[mi][ni], 0, 0, 0);
  }
  bf16_t* Ot = (bf16_t*)(smem + 17408);
#pragma unroll
  for (int mi = 0; mi < 2; ++mi)
#pragma unroll
    for (int j = 0; j < 8; ++j) {
      int m = 64 * w + 32 * mi + ((2 * j) & 3) + 8 * ((2 * j) >> 2) + 4 * (lane >> 5);
      int k1 = m >> 1;
      int idx = (k1 * c) & 8191;
      float cs = TAB[idx], sn = TAB[8192 + idx];
#pragma unroll
      for (int ni = 0; ni < 2; ++ni) {
        float re = acc[mi][ni][2 * j], im = acc[mi][ni][2 * j + 1];
        float re2 = re * cs + im * sn, im2 = im * cs - re * sn;
        bf16_t* dst = Ot + m * 72 + 32 * ni + (lane & 31);
        dst[0] = (bf16_t)f2bf(re2); dst[72] = (bf16_t)f2bf(im2);
      }
    }
  __syncthreads();
  {
    bf16_t* base = A1 + (((size_t)b * 64 + c) * 128) * 2 * 512 + g * 64;
#pragma unroll
    for (int i = 0; i < 8; ++i) {
      int q = tid + 256 * i; int m = q >> 3, ch8 = q & 7;
      *(uint4*)(base + (size_t)m * 512 + ch8 * 8) = *(const uint4*)(Ot + m * 72 + ch8 * 8);
    }
  }
}

__device__ __forceinline__ void fft3_unit(int u, int mode, const bf16_t* __restrict__ FQKV, const bf16_t* __restrict__ A1, const bf16_t* __restrict__ D3,
                          const bf16_t* __restrict__ DcT, const float* __restrict__ TAB, bf16_t* __restrict__ MIX, char* smem) {
  int tid = threadIdx.x, lane = tid & 63, w = __builtin_amdgcn_readfirstlane(tid >> 6);
  bf16_t* Bt = (bf16_t*)smem;
  bf16_t* Xs = (bf16_t*)(smem + 17408);
  int g = u & 7, k1, b, nk1, rowbase; float norm;
  __syncthreads();
  if (mode == 0) {
    k1 = (u >> 3) & 127; b = u >> 10; nk1 = 128; rowbase = b * S; norm = 1.f / 724.0773439350247f;
    int kk = tid >> 1, half = tid & 1; int c = kk >> 1, ri = kk & 1;
    const uint4* src = (const uint4*)(A1 + ((((size_t)b * 64 + c) * 128 + k1) * 2 + ri) * 512 + g * 64 + half * 32);
    unsigned wv[16];
#pragma unroll
    for (int i = 0; i < 4; ++i) { uint4 v = src[i]; wv[4 * i] = v.x; wv[4 * i + 1] = v.y; wv[4 * i + 2] = v.z; wv[4 * i + 3] = v.w; }
#pragma unroll
    for (int j = 0; j < 32; ++j) {
      unsigned e = (j & 1) ? (wv[j >> 1] >> 16) : (wv[j >> 1] & 0xffffu);
      Bt[(half * 32 + j) * 136 + kk] = (bf16_t)e;
    }
  } else {
    k1 = (u >> 3) & 3; b = u >> 5; nk1 = 4; rowbase = T + b * CL; norm = 1.f / 128.f;
    int c = tid >> 2, q4 = tid & 3;
    float re[16], im[16];
#pragma unroll
    for (int j = 0; j < 16; ++j) { re[j] = 0.f; im[j] = 0.f; }
#pragma unroll
    for (int r = 0; r < 4; ++r) {
      const uint4* src = (const uint4*)(FQKV + (size_t)(rowbase + 64 * r + c) * 2048 + g * 64 + q4 * 16);
      uint4 v0 = src[0], v1 = src[1];
      unsigned wv[8] = {v0.x, v0.y, v0.z, v0.w, v1.x, v1.y, v1.z, v1.w};
      int ph = (k1 * r) & 3;
      float cr = (ph == 0) ? 1.f : (ph == 2 ? -1.f : 0.f);
      float ci = (ph == 1) ? -1.f : (ph == 3 ? 1.f : 0.f);
#pragma unroll
      for (int j = 0; j < 16; ++j) {
        float x = bf2f((unsigned short)((j & 1) ? (wv[j >> 1] >> 16) : (wv[j >> 1] & 0xffffu)));
        re[j] += x * cr; im[j] += x * ci;
      }
    }
    int idx = (k1 * c * 32) & 8191;
    float cs = TAB[idx], sn = TAB[8192 + idx];
#pragma unroll
    for (int j = 0; j < 16; ++j) {
      float re2 = re[j] * cs + im[j] * sn, im2 = im[j] * cs - re[j] * sn;
      *(unsigned*)(Bt + (q4 * 16 + j) * 136 + 2 * c) = pack2bf(re2, im2);
    }
  }
  __syncthreads();
  {
    f32x16 acc[2];
#pragma unroll
    for (int ni = 0; ni < 2; ++ni)
#pragma unroll
      for (int r = 0; r < 16; ++r) acc[ni][r] = 0.f;
#pragma unroll
    for (int s8 = 0; s8 < 8; ++s8) {
      int ko = 16 * s8 + 8 * (lane >> 5);
      bf16x8 a = *(const bf16x8*)(D3 + (32 * w + (lane & 31)) * 128 + ko);
#pragma unroll
      for (int ni = 0; ni < 2; ++ni) {
        bf16x8 bb = *(const bf16x8*)(Bt + (32 * ni + (lane & 31)) * 136 + ko);
        acc[ni] = __builtin_amdgcn_mfma_f32_32x32x16_bf16(a, bb, acc[ni], 0, 0, 0);
      }
    }
#pragma unroll
    for (int ni = 0; ni < 2; ++ni)
#pragma unroll
      for (int r = 0; r < 16; ++r) {
        int m = 32 * w + (r & 3) + 8 * (r >> 2) + 4 * (lane >> 5);
        Xs[(m & 63) * 136 + (m >> 6) * 64 + 32 * ni + (lane & 31)] = (bf16_t)f2bf(acc[ni][r]);
      }
  }
  __syncthreads();
  {
    int mi = w >> 1, ni = w & 1;
    f32x16 acc;
#pragma unroll
    for (int r = 0; r < 16; ++r) acc[r] = 0.f;
#pragma unroll
    for (int s8 = 0; s8 < 8; ++s8) {
      int ko = 16 * s8 + 8 * (lane >> 5);
      bf16x8 a = *(const bf16x8*)(Xs + (32 * mi + (lane & 31)) * 136 + ko);
      bf16x8 bb = *(const bf16x8*)(DcT + (32 * ni + (lane & 31)) * 128 + ko);
      acc = __builtin_amdgcn_mfma_f32_32x32x16_bf16(a, bb, acc, 0, 0, 0);
    }
    bf16_t* Yt = Bt;
#pragma unroll
    for (int r = 0; r < 16; ++r) {
      int k2 = 32 * mi + (r & 3) + 8 * (r >> 2) + 4 * (lane >> 5);
      Yt[k2 * 72 + 32 * ni + (lane & 31)] = (bf16_t)f2bf(acc[r] * norm);
    }
  }
  __syncthreads();
#pragma unroll
  for (int i = 0; i < 2; ++i) {
    int q = tid + 256 * i; int k2 = q >> 3, ch8 = q & 7;
    int row = rowbase + k1 + nk1 * k2;
    *(uint4*)(MIX + (size_t)row * 1024 + g * 64 + ch8 * 8) = *(const uint4*)((const bf16_t*)smem + k2 * 72 + ch8 * 8);
  }
}

typedef __attribute__((ext_vector_type(4))) float f32x4_t;
__device__ __forceinline__ bf16x8 ld16(const bf16_t* p) { return *(const bf16x8*)p; }
__device__ __forceinline__ float fast_exp2(float x) { return __builtin_amdgcn_exp2f(x); }

template <int NH, int MODE, int KPI, bool PF>
__device__ __forceinline__ void attn_unit(int b, int hk, int r, int jb, int qb, const bf16_t* __restrict__ Qp, int ldq, const bf16_t* __restrict__ Kp, int ldk,
                                          const bf16_t* __restrict__ VTl, const bf16_t* __restrict__ VTc, int nkvh,
                                          const float* rpbs, const float* __restrict__ sink,
                                          bf16_t* __restrict__ Op, int ldo, int lane) {
  const float LOG2E = 1.4426950408889634f;
  const float SC = 0.125f * LOG2E;
  asm volatile("" : "+v"(lane));
  int ql = lane & 15, g = lane >> 4;
  int qrow0, q0 = 0;
  int nloc, lb0 = 0;
  if (MODE == 0) { qrow0 = b * S + r * 64 + 16 * jb; nloc = 8; }
  else if (MODE == 1) { qrow0 = T + b * CL + 16 * qb; nloc = 0; }
  else { q0 = 16 * qb; qrow0 = b * S + q0;
         int lo = (q0 - 128) >> 5, hi = (q0 + 143) >> 5; if (lo < 0) lo = 0; if (hi > 255) hi = 255; lb0 = lo; nloc = hi - lo + 1; }
  bf16x8 qf[NH][2];
#pragma unroll
  for (int hh = 0; hh < NH; ++hh)
#pragma unroll
    for (int s2 = 0; s2 < 2; ++s2)
      qf[hh][s2] = ld16(Qp + (size_t)(qrow0 + ql) * ldq + (hk * NH + hh) * 64 + 32 * s2 + 8 * g);
  f32x4_t o[NH][4]; float mrun[NH], lrun[NH];
#pragma unroll
  for (int hh = 0; hh < NH; ++hh) {
    mrun[hh] = -1e30f; lrun[hh] = 0.f;
#pragma unroll
    for (int dt = 0; dt < 4; ++dt) o[hh][dt] = (f32x4_t){0.f, 0.f, 0.f, 0.f};
  }
  int r_start = 0, blk_start = 0, c_lo = 0, qc = 0;
  if (MODE == 0) {
    r_start = min(max(r - 4, 0), 120);
    blk_start = min(max(16 * jb - 8, 0), 32);
    qc = 16 * jb + ql; c_lo = min(max(qc - 8, 0), 48);
  }
  if (MODE == 2 && KPI == 2) nloc = (nloc + 1) & ~1;
  int nit = (nloc + 8) / KPI;
#define ATT_DESC(kbx, krow0_, vtp_, vld_) \
    { bool il_ = (kbx) < nloc; int vt0_; \
      if (il_) { if (MODE == 0) { int rr_ = r_start + (kbx); krow0_ = b * S + rr_ * 64 + blk_start; vt0_ = rr_ * 64 + blk_start; } \
                 else { krow0_ = b * S + 32 * (lb0 + (kbx)); vt0_ = 32 * (lb0 + (kbx)); } \
                 vtp_ = VTl + ((size_t)(b * nkvh + hk) * 64) * S + vt0_; vld_ = S; } \
      else { int cb_ = (kbx) - nloc; krow0_ = T + b * CL + 32 * cb_; vt0_ = 32 * cb_; \
             vtp_ = VTc + ((size_t)(b * nkvh + hk) * 64) * CL + vt0_; vld_ = CL; } }
#define ATT_LOAD(kbx, KF, VF) \
    { int krow0; const bf16_t* vt; int vld; ATT_DESC(kbx, krow0, vt, vld) \
      _Pragma("unroll") for (int t = 0; t < 2; ++t) _Pragma("unroll") for (int s2 = 0; s2 < 2; ++s2) \
        KF[t][s2] = ld16(Kp + (size_t)(krow0 + 8 * (ql >> 2) + 4 * t + (ql & 3)) * ldk + hk * 64 + 32 * s2 + 8 * g); \
      _Pragma("unroll") for (int dt = 0; dt < 4; ++dt) VF[dt] = ld16(vt + (size_t)(16 * dt + ql) * vld + 8 * g); }
  bf16x8 kfn[PF ? KPI : 1][2][2], vfn[PF ? KPI : 1][4];
  if (PF) {
#pragma unroll
    for (int kk = 0; kk < KPI; ++kk) ATT_LOAD(kk, kfn[kk], vfn[kk])
  }
  for (int it = 0; it < nit; ++it) {
    bf16x8 kf[KPI][2][2], vf[KPI][4];
    if (PF) {
#pragma unroll
      for (int kk = 0; kk < KPI; ++kk) {
#pragma unroll
        for (int t = 0; t < 2; ++t)
#pragma unroll
          for (int s2 = 0; s2 < 2; ++s2) kf[kk][t][s2] = kfn[kk][t][s2];
#pragma unroll
        for (int dt = 0; dt < 4; ++dt) vf[kk][dt] = vfn[kk][dt];
      }
      if (it + 1 < nit) {
#pragma unroll
        for (int kk = 0; kk < KPI; ++kk) ATT_LOAD((it + 1) * KPI + kk, kfn[kk], vfn[kk])
      }
    } else {
#pragma unroll
      for (int kk = 0; kk < KPI; ++kk) ATT_LOAD(it * KPI + kk, kf[kk], vf[kk])
    }
    float bias[KPI][2][4]; bool valid[KPI][2][4];
#pragma unroll
    for (int kk = 0; kk < KPI; ++kk) {
      int kb = it * KPI + kk;
      bool is_loc = kb < nloc;
#pragma unroll
      for (int t = 0; t < 2; ++t)
#pragma unroll
        for (int i = 0; i < 4; ++i) {
          bias[kk][t][i] = 0.f; valid[kk][t][i] = true;
          if (MODE == 0 && is_loc) {
            int kc = blk_start + 8 * g + 4 * t + i;
            valid[kk][t][i] = (kc >= c_lo) && (kc < c_lo + 16);
            int dc = min(max(kc - qc, -15), 15) + 15;
            bias[kk][t][i] = rpbs[(hk * 15 + (r_start + kb - r + 7)) * 31 + dc];
          }
          if (MODE == 2 && is_loc) {
            int kpos = 32 * (lb0 + kb) + 8 * g + 4 * t + i; int dq = (q0 + ql) - kpos;
            bias[kk][t][i] = ((dq <= 128) && (dq >= -128)) ? 0.f : -1e30f;
          }
        }
    }
#pragma unroll
    for (int hh = 0; hh < NH; ++hh) {
      f32x4_t st[KPI][2];
#pragma unroll
      for (int kk = 0; kk < KPI; ++kk)
#pragma unroll
        for (int t = 0; t < 2; ++t) {
          st[kk][t] = (f32x4_t){0.f, 0.f, 0.f, 0.f};
          st[kk][t] = __builtin_amdgcn_mfma_f32_16x16x32_bf16(kf[kk][t][0], qf[hh][0], st[kk][t], 0, 0, 0);
          st[kk][t] = __builtin_amdgcn_mfma_f32_16x16x32_bf16(kf[kk][t][1], qf[hh][1], st[kk][t], 0, 0, 0);
        }
      float lg[KPI][2][4]; float bm = -1e30f;
#pragma unroll
      for (int kk = 0; kk < KPI; ++kk)
#pragma unroll
        for (int t = 0; t < 2; ++t)
#pragma unroll
          for (int i = 0; i < 4; ++i) {
            float v = (MODE == 0) ? (valid[kk][t][i] ? (st[kk][t][i] * SC + bias[kk][t][i]) : -1e30f) : fmaf(st[kk][t][i], SC, bias[kk][t][i]);
            lg[kk][t][i] = v; bm = fmaxf(bm, v);
          }
      bm = xrow16_max(bm);
      float mn = fmaxf(mrun[hh], bm);
      float alpha = fast_exp2(mrun[hh] - mn);
      mrun[hh] = mn;
      float ps = 0.f;
      bf16x8 pf[KPI];
#pragma unroll
      for (int kk = 0; kk < KPI; ++kk) {
        float pv[8];
#pragma unroll
        for (int t = 0; t < 2; ++t)
#pragma unroll
          for (int i = 0; i < 4; ++i) {
            float p = (MODE == 0) ? (valid[kk][t][i] ? fast_exp2(lg[kk][t][i] - mn) : 0.f) : fast_exp2(lg[kk][t][i] - mn);
            pv[4 * t + i] = p; ps += p;
          }
        typedef __attribute__((ext_vector_type(4))) unsigned u32x4;
        u32x4 uu = {pack2bf(pv[0], pv[1]), pack2bf(pv[2], pv[3]), pack2bf(pv[4], pv[5]), pack2bf(pv[6], pv[7])};
        pf[kk] = __builtin_bit_cast(bf16x8, uu);
      }
      lrun[hh] = lrun[hh] * alpha + ps;
#pragma unroll
      for (int dt = 0; dt < 4; ++dt) {
        o[hh][dt] *= alpha;
#pragma unroll
        for (int kk = 0; kk < KPI; ++kk)
          o[hh][dt] = __builtin_amdgcn_mfma_f32_16x16x32_bf16(vf[kk][dt], pf[kk], o[hh][dt], 0, 0, 0);
      }
      if (NH == 4 && KPI == 2 && (hh & 1)) __builtin_amdgcn_sched_barrier(0);
    }
  }
#undef ATT_LOAD
#undef ATT_DESC
#pragma unroll
  for (int hh = 0; hh < NH; ++hh) {
    float l = xrow16_sum(lrun[hh]);
    float m = mrun[hh];
    if (MODE == 2) {
      float sk = sink[hk * NH + hh] * LOG2E;
      float mf = fmaxf(m, sk);
      float a = fast_exp2(m - mf);
      l = l * a + fast_exp2(sk - mf);
#pragma unroll
      for (int dt = 0; dt < 4; ++dt) o[hh][dt] *= a;
    }
    float inv = 1.f / l;
    bf16_t* orow = Op + (size_t)(qrow0 + ql) * ldo + (hk * NH + hh) * 64 + 4 * g;
#pragma unroll
    for (int dt = 0; dt < 4; ++dt) {
      f32x4_t v = o[hh][dt] * inv;
      *(uint2*)(orow + 16 * dt) = make_uint2(pack2bf(v[0], v[1]), pack2bf(v[2], v[3]));
    }
  }
}

struct NaState { f32x4_t o[4][4]; float m[4], l[4]; };
template <int HB>
__device__ __forceinline__ void na_block(NaState& st, const bf16x8 (&qf)[4][2], const bf16x8 (&kf)[2][2], const bf16x8 (&vf)[4],
                                         const float* rpbrow  , int ql, int g) {
  const float SC = 0.125f * 1.4426950408889634f;
#pragma unroll
  for (int jb = 0; jb < 4; ++jb) {
    if (HB == 0 && jb == 3) continue;
    if (HB == 1 && jb == 0) continue;
    f32x4_t s2[2];
#pragma unroll
    for (int t = 0; t < 2; ++t) {
      s2[t] = (f32x4_t){0.f, 0.f, 0.f, 0.f};
      s2[t] = __builtin_amdgcn_mfma_f32_16x16x32_bf16(kf[t][0], qf[jb][0], s2[t], 0, 0, 0);
      s2[t] = __builtin_amdgcn_mfma_f32_16x16x32_bf16(kf[t][1], qf[jb][1], s2[t], 0, 0, 0);
    }
    float lg[8]; bool valid[8]; float bm = -1e30f;
#pragma unroll
    for (int t = 0; t < 2; ++t)
#pragma unroll
      for (int i = 0; i < 4; ++i) {
        float v;
        if (HB < 2) {
          int qc = 16 * jb + ql; int c_lo = min(max(qc - 8, 0), 48);
          int kc = 32 * HB + 8 * g + 4 * t + i;
          bool ok = (kc >= c_lo) && (kc < c_lo + 16);
          int dc = min(max(kc - qc, -15), 15) + 15;
          v = ok ? (s2[t][i] * SC + rpbrow[dc]) : -1e30f;
          valid[4 * t + i] = ok;
        } else { v = s2[t][i] * SC; valid[4 * t + i] = true; }
        lg[4 * t + i] = v; bm = fmaxf(bm, v);
      }
    bm = xrow16_max(bm);
    float mn = fmaxf(st.m[jb], bm);
    float alpha = fast_exp2(st.m[jb] - mn);
    st.m[jb] = mn;
    float ps = 0.f; float pv[8];
#pragma unroll
    for (int e = 0; e < 8; ++e) { float p = valid[e] ? fast_exp2(lg[e] - mn) : 0.f; pv[e] = p; ps += p; }
    st.l[jb] = st.l[jb] * alpha + ps;
    typedef __attribute__((ext_vector_type(4))) unsigned u32x4;
    u32x4 uu = {pack2bf(pv[0], pv[1]), pack2bf(pv[2], pv[3]), pack2bf(pv[4], pv[5]), pack2bf(pv[6], pv[7])};
    bf16x8 pf = __builtin_bit_cast(bf16x8, uu);
#pragma unroll
    for (int dt = 0; dt < 4; ++dt) {
      st.o[jb][dt] *= alpha;
      st.o[jb][dt] = __builtin_amdgcn_mfma_f32_16x16x32_bf16(vf[dt], pf, st.o[jb][dt], 0, 0, 0);
    }
    if (jb & 1) __builtin_amdgcn_sched_barrier(0);
  }
}
__device__ __forceinline__ void na_unit(int b, int h, int r, const bf16_t* __restrict__ FQKV, const bf16_t* __restrict__ VTl,
                                        const bf16_t* __restrict__ VTc, const float* rpbs, bf16_t* __restrict__ MIX, int lane) {
  asm volatile("" : "+v"(lane));
  int ql = lane & 15, g = lane >> 4;
  int qrow0 = b * S + r * 64;
  int r_start = min(max(r - 4, 0), 120);
  bf16x8 qf[4][2];
#pragma unroll
  for (int jb = 0; jb < 4; ++jb)
#pragma unroll
    for (int s2 = 0; s2 < 2; ++s2)
      qf[jb][s2] = ld16(FQKV + (size_t)(qrow0 + 16 * jb + ql) * 2048 + 512 + h * 64 + 32 * s2 + 8 * g);
  NaState st;
#pragma unroll
  for (int jb = 0; jb < 4; ++jb) {
    st.m[jb] = -1e30f; st.l[jb] = 0.f;
#pragma unroll
    for (int dt = 0; dt < 4; ++dt) st.o[jb][dt] = (f32x4_t){0.f, 0.f, 0.f, 0.f};
  }
  unsigned koff = (unsigned)((8 * (ql >> 2) + (ql & 3)) * 2048 + 1024 + h * 64 + 8 * g);
  unsigned voffl = (unsigned)(ql * S + 8 * g), voffc = (unsigned)(ql * CL + 8 * g);
  const bf16_t* vtl = VTl + (size_t)(b * 8 + h) * 64 * S;
  const bf16_t* vtc = VTc + (size_t)(b * 8 + h) * 64 * CL;
#define NA_LOADK(kb2, KF) { \
    int krow0_; \
    if ((kb2) < 16) krow0_ = b * S + (r_start + ((kb2) >> 1)) * 64 + 32 * ((kb2) & 1); \
    else krow0_ = T + b * CL + 32 * ((kb2) - 16); \
    const bf16_t* kb_ = FQKV + (size_t)krow0_ * 2048; \
    _Pragma("unroll") for (int t = 0; t < 2; ++t) _Pragma("unroll") for (int s2 = 0; s2 < 2; ++s2) \
      KF[t][s2] = ld16(kb_ + (koff + (unsigned)(t * 4 * 2048 + 32 * s2))); }
#define NA_LOADV(kb2, VF) { \
    if ((kb2) < 16) { const bf16_t* vt_ = vtl + (r_start + ((kb2) >> 1)) * 64 + 32 * ((kb2) & 1); \
      _Pragma("unroll") for (int dt = 0; dt < 4; ++dt) VF[dt] = ld16(vt_ + (voffl + (unsigned)(16 * dt * S))); } \
    else { const bf16_t* vt_ = vtc + 32 * ((kb2) - 16); \
      _Pragma("unroll") for (int dt = 0; dt < 4; ++dt) VF[dt] = ld16(vt_ + (voffc + (unsigned)(16 * dt * CL))); } }
  bf16x8 kfa[2][2], kfb[2][2], vfa[4], vfb[4];
  NA_LOADK(0, kfa) NA_LOADV(0, vfa)
#pragma unroll 1
  for (int rr = 0; rr < 8; ++rr) {
    const float* rpbrow = rpbs + (h * 15 + (r_start + rr - r + 7)) * 31;
    asm volatile("" : "+v"(lane)); ql = lane & 15; g = lane >> 4;
    koff = (unsigned)((8 * (ql >> 2) + (ql & 3)) * 2048 + 1024 + h * 64 + 8 * g); voffl = (unsigned)(ql * S + 8 * g); voffc = (unsigned)(ql * CL + 8 * g);
    NA_LOADK(2 * rr + 1, kfb) NA_LOADV(2 * rr + 1, vfb)
    na_block<0>(st, qf, kfa, vfa, rpbrow, ql, g);
    NA_LOADK(2 * rr + 2, kfa) NA_LOADV(2 * rr + 2, vfa)
    na_block<1>(st, qf, kfb, vfb, rpbrow, ql, g);
  }
#pragma unroll 1
  for (int cb = 0; cb < 8; cb += 2) {
    asm volatile("" : "+v"(lane)); ql = lane & 15; g = lane >> 4;
    koff = (unsigned)((8 * (ql >> 2) + (ql & 3)) * 2048 + 1024 + h * 64 + 8 * g); voffc = (unsigned)(ql * CL + 8 * g);
    NA_LOADK(16 + cb + 1, kfb) NA_LOADV(16 + cb + 1, vfb)
    na_block<2>(st, qf, kfa, vfa, rpbs, ql, g);
    if (cb + 2 < 8) { NA_LOADK(16 + cb + 2, kfa) NA_LOADV(16 + cb + 2, vfa) }
    na_block<2>(st, qf, kfb, vfb, rpbs, ql, g);
  }
#undef NA_LOADK
#undef NA_LOADV
  asm volatile("" : "+v"(lane)); ql = lane & 15; g = lane >> 4;
#pragma unroll
  for (int jb = 0; jb < 4; ++jb) {
    float inv = 1.f / xrow16_sum(st.l[jb]);
    bf16_t* orow = MIX + (size_t)(qrow0 + 16 * jb + ql) * 1024 + 512 + h * 64 + 4 * g;
#pragma unroll
    for (int dt = 0; dt < 4; ++dt) {
      f32x4_t v = st.o[jb][dt] * inv;
      *(uint2*)(orow + 16 * dt) = make_uint2(pack2bf(v[0], v[1]), pack2bf(v[2], v[3]));
    }
  }
}

__device__ __forceinline__ void ph_chan_dft(const float* __restrict__ F, const float* __restrict__ tab, float* __restrict__ PQ) {
  for (int gid = blockIdx.x * 256 + threadIdx.x; gid < R * 512; gid += gridDim.x * 256) {
    int row = gid >> 9; int col = gid & 511; int g = col >> 6, cp = col & 63;
    const float* f = F + (size_t)row * 2048 + g * 64;
    float p = 0.f, q = 0.f;
    for (int ch = 0; ch < 64; ++ch) {
      int idx = ((ch * cp) & 63) * 128;
      float x = f[ch];
      p += x * tab[idx]; q += x * tab[8192 + idx];
    }
    PQ[(size_t)row * 1024 + col] = p;
    PQ[(size_t)row * 1024 + 512 + col] = q;
  }
}

__device__ __forceinline__ void ph_na(const bf16_t* __restrict__ F, const float* __restrict__ rpb, bf16_t* __restrict__ MIX, float* sm) {
  int lane = threadIdx.x & 63, wave = __builtin_amdgcn_readfirstlane(threadIdx.x >> 6);
  float* sq = sm + wave * 1024; float* sp = sq + 64; int* stok = (int*)(sp + 384);
  int nitems = R * 8;
  for (int item0 = blockIdx.x * 4; item0 < nitems; item0 += gridDim.x * 4) {
    int item = item0 + wave;
    int h = item & 7; int row = item >> 3;
    bool is_ctx = row >= T;
    int b = is_ctx ? (row - T) / CL : row / S;
    __syncthreads();
    sq[lane] = bf2f(F[(size_t)row * 2048 + 512 + h * 64 + lane]);
    __syncthreads();
    int r = 0, c = 0, r_start = 0, c_start = 0;
    if (!is_ctx) { int t = row % S; r = t / 64; c = t % 64; r_start = min(max(r - 4, 0), 120); c_start = min(max(c - 8, 0), 48); }
    int nk = is_ctx ? 256 : 384;
    float lg[6]; float mx = -INFINITY;
#pragma unroll
    for (int kk = 0; kk < 6; ++kk) {
      int j = kk * 64 + lane; float s = -INFINITY; int tok = 0;
      if (j < nk) {
        float bias = 0.f;
        if (!is_ctx && j < 128) {
          int kr = j >> 4, kc = j & 15; int rr = r_start + kr, cc = c_start + kc;
          tok = b * S + rr * 64 + cc;
          int dc = min(max(cc - c, -15), 15) + 15;
          bias = rpb[(h * 15 + (rr - r + 7)) * 31 + dc];
        } else {
          int l = is_ctx ? j : j - 128; tok = T + b * CL + l;
        }
        const bf16_t* kp = F + (size_t)tok * 2048 + 1024 + h * 64;
        float acc = 0.f;
#pragma unroll 8
        for (int d = 0; d < 64; ++d) acc += sq[d] * bf2f(kp[d]);
        s = acc * 0.125f + bias;
      }
      lg[kk] = s; stok[j] = tok; mx = fmaxf(mx, s);
    }
    mx = wave_max(mx);
    float sum = 0.f;
#pragma unroll
    for (int kk = 0; kk < 6; ++kk) { float e = (kk * 64 + lane < nk) ? expf(lg[kk] - mx) : 0.f; lg[kk] = e; sum += e; }
    sum = wave_sum(sum);
    float inv = 1.f / sum;
#pragma unroll
    for (int kk = 0; kk < 6; ++kk) sp[kk * 64 + lane] = lg[kk] * inv;
    __syncthreads();
    float o = 0.f;
    for (int j = 0; j < nk; ++j) o += sp[j] * bf2f(F[(size_t)stok[j] * 2048 + 1536 + h * 64 + lane]);
    MIX[(size_t)row * 1024 + 512 + h * 64 + lane] = (bf16_t)f2bf(o);
  }
}

__device__ __forceinline__ void ph_rope(float* __restrict__ F1) {
  for (int gid = blockIdx.x * 256 + threadIdx.x; gid < T * 20 * 32; gid += gridDim.x * 256) {
    int i = gid & 31; int hh = (gid >> 5) % 20; int row = gid / (32 * 20);
    int t = row % S; float rowp = (float)(t / 64), colp = (float)(t % 64);
    int fi = i & 15;
    float inv_freq = powf(10000.0f, -(float)fi / 16.0f);
    float ang = (i < 16 ? rowp : colp) * inv_freq;
    float cs = cosf(ang), sn = sinf(ang);
    float* p = F1 + (size_t)row * 1536 + hh * 64;
    float x1 = p[i], x2 = p[i + 32];
    p[i] = x1 * cs - x2 * sn;
    p[i + 32] = x1 * sn + x2 * cs;
  }
}

__device__ __forceinline__ void ph_gqa(const float* __restrict__ F1, const float* __restrict__ sink, bf16_t* __restrict__ O, float* sm) {
  int lane = threadIdx.x & 63, wave = __builtin_amdgcn_readfirstlane(threadIdx.x >> 6);
  float* sq = sm + wave * 1280; float* sp = sq + 64; int* stok = (int*)(sp + 576);
  int nitems = T * 16;
  for (int item0 = blockIdx.x * 4; item0 < nitems; item0 += gridDim.x * 4) {
    int item = item0 + wave;
    int qh = item & 15; int row = item >> 4; int kvh = qh >> 2;
    int b = row / S; int t = row % S;
    __syncthreads();
    sq[lane] = F1[(size_t)row * 1536 + qh * 64 + lane];
    __syncthreads();
    float lg[9]; float mx = -INFINITY;
#pragma unroll
    for (int kk = 0; kk < 9; ++kk) {
      int j = kk * 64 + lane; float s = -INFINITY; int tok = 0; bool valid = false;
      if (j < 257) { int pos = t - 128 + j; valid = (pos >= 0 && pos < S); tok = b * S + pos; }
      else if (j < 513) { valid = true; tok = T + b * CL + (j - 257); }
      if (valid) {
        const float* kp = F1 + (size_t)tok * 1536 + 1024 + kvh * 64;
        float acc = 0.f;
#pragma unroll 8
        for (int d = 0; d < 64; ++d) acc += sq[d] * kp[d];
        s = acc * 0.125f;
      } else tok = 0;
      lg[kk] = s; stok[j] = tok; mx = fmaxf(mx, s);
    }
    mx = wave_max(mx);
    float sk = sink[qh];
    mx = fmaxf(mx, sk);
    float sum = 0.f;
#pragma unroll
    for (int kk = 0; kk < 9; ++kk) { float e = (lg[kk] == -INFINITY) ? 0.f : expf(lg[kk] - mx); lg[kk] = e; sum += e; }
    sum = wave_sum(sum) + expf(sk - mx);
    float inv = 1.f / sum;
#pragma unroll
    for (int kk = 0; kk < 9; ++kk) sp[kk * 64 + lane] = lg[kk] * inv;
    __syncthreads();
    float o = 0.f;
    for (int j = 0; j < 513; ++j) { float p = sp[j]; if (p != 0.f) o += p * F1[(size_t)stok[j] * 1536 + 1280 + kvh * 64 + lane]; }
    O[(size_t)row * 1024 + qh * 64 + lane] = (bf16_t)f2bf(o);
  }
}

__device__ __forceinline__ void wave_argmax(float& v, int& idx) {
#pragma unroll
  for (int off = 32; off; off >>= 1) {
    float ov = __shfl_xor(v, off); int oi = __shfl_xor(idx, off);
    if (ov > v || (ov == v && oi < idx)) { v = ov; idx = oi; }
  }
}
__device__ __forceinline__ void ph_peer_select_naive(const float* __restrict__ Q, const float* __restrict__ sk, int* __restrict__ EXP,
                                     float* __restrict__ GATE, int nrows, float* sm) {
  int lane = threadIdx.x & 63, wave = __builtin_amdgcn_readfirstlane(threadIdx.x >> 6);
  float* sq = sm + wave * 640; float* tops = sq + 256; int* topi = (int*)(tops + 32);
  for (int row0 = blockIdx.x * 4; row0 < nrows; row0 += gridDim.x * 4) {
    int row = row0 + wave;
    for (int h = 0; h < 8; ++h) {
      __syncthreads();
#pragma unroll
      for (int i = 0; i < 4; ++i) sq[lane + 64 * i] = Q[(size_t)row * 2048 + h * 256 + lane + 64 * i];
      __syncthreads();
      for (int p = 0; p < 2; ++p) {
        float s0 = 0.f, s1 = 0.f;
        const float* k0 = sk + ((size_t)((h * 2 + p) * 128 + lane)) * 128;
        const float* k1 = k0 + 64 * 128;
#pragma unroll 8
        for (int d = 0; d < 128; ++d) { float qv = sq[p * 128 + d]; s0 += qv * k0[d]; s1 += qv * k1[d]; }
        for (int i = 0; i < 16; ++i) {
          float v; int idx;
          if (s0 >= s1) { v = s0; idx = lane; } else { v = s1; idx = lane + 64; }
          wave_argmax(v, idx);
          if (lane == 0) { tops[p * 16 + i] = v; topi[p * 16 + i] = idx; }
          if (idx == lane) s0 = -INFINITY;
          if (idx == lane + 64) s1 = -INFINITY;
        }
      }
      __syncthreads();
      float cs[4];
#pragma unroll
      for (int i = 0; i < 4; ++i) { int ci = lane * 4 + i; cs[i] = tops[ci >> 4] + tops[16 + (ci & 15)]; }
      float bs[16]; int be[16];
#pragma unroll
      for (int k = 0; k < 16; ++k) {
        float v = cs[0]; int idx = lane * 4;
#pragma unroll
        for (int i = 1; i < 4; ++i) if (cs[i] > v) { v = cs[i]; idx = lane * 4 + i; }
        wave_argmax(v, idx);
        bs[k] = v; be[k] = topi[idx >> 4] * 128 + topi[16 + (idx & 15)];
#pragma unroll
        for (int i = 0; i < 4; ++i) if (idx == lane * 4 + i) cs[i] = -INFINITY;
      }
      float mxs = bs[0]; float sum = 0.f;
#pragma unroll
      for (int k = 0; k < 16; ++k) { bs[k] = expf(bs[k] - mxs); sum += bs[k]; }
      float inv = 1.f / sum;
      if (lane == 0) {
#pragma unroll
        for (int k = 0; k < 16; ++k) { EXP[(size_t)row * 128 + h * 16 + k] = be[k]; GATE[(size_t)row * 128 + h * 16 + k] = bs[k] * inv; }
      }
    }
  }
}

__device__ __forceinline__ void unpack8(uint4 v, float* f) {
  f[0] = __uint_as_float(v.x << 16); f[1] = __uint_as_float(v.x & 0xffff0000u);
  f[2] = __uint_as_float(v.y << 16); f[3] = __uint_as_float(v.y & 0xffff0000u);
  f[4] = __uint_as_float(v.z << 16); f[5] = __uint_as_float(v.z & 0xffff0000u);
  f[6] = __uint_as_float(v.w << 16); f[7] = __uint_as_float(v.w & 0xffff0000u);
}
__device__ __forceinline__ void ph_peer_gather(bf16_t* __restrict__ H, const int* __restrict__ EXP, const float* __restrict__ GATE,
                               const bf16_t* __restrict__ U, const bf16_t* __restrict__ V,
                               const float* __restrict__ xin, const float* __restrict__ M, int layer,
                               const float* __restrict__ g, const float* __restrict__ bb, float* __restrict__ xout,
                               bool write_next, int nrows) {
  int lane = threadIdx.x & 63, wave = __builtin_amdgcn_readfirstlane(threadIdx.x >> 6);
  for (int row = blockIdx.x * 4 + wave; row < nrows; row += gridDim.x * 4) {
    float hreg[16];
    {
      const uint4* hp = (const uint4*)(H + (size_t)row * D + 8 * lane);
      unpack8(hp[0], hreg); unpack8(hp[64], hreg + 8);
    }
    float acc[16];
#pragma unroll
    for (int i = 0; i < 16; ++i) acc[i] = 0.f;
    int e_lo = EXP[(size_t)row * 128 + lane], e_hi = EXP[(size_t)row * 128 + 64 + lane];
    float g_lo = GATE[(size_t)row * 128 + lane], g_hi = GATE[(size_t)row * 128 + 64 + lane];
    uint4 ua[4], ub[4], va[4], vb[4];
#pragma unroll
    for (int i = 0; i < 4; ++i) {
      int e = __builtin_amdgcn_readlane(e_lo, i);
      const uint4* up = (const uint4*)(U + (size_t)e * D + 8 * lane); ua[i] = up[0]; ub[i] = up[64];
    }
#pragma unroll 1
    for (int b = 0; b < 32; ++b) {
      int k0 = 4 * b;
      int ev = (b < 16) ? e_lo : e_hi; float gv = (b < 16) ? g_lo : g_hi;
      int en = (b + 1 < 16) ? e_lo : e_hi;
      float gt[4];
#pragma unroll
      for (int i = 0; i < 4; ++i) {
        int e = __builtin_amdgcn_readlane(ev, (k0 + i) & 63);
        gt[i] = __uint_as_float(__builtin_amdgcn_readlane(__float_as_uint(gv), (k0 + i) & 63));
        const uint4* vp = (const uint4*)(V + (size_t)e * D + 8 * lane); va[i] = vp[0]; vb[i] = vp[64];
      }
      float a[4];
#pragma unroll
      for (int i = 0; i < 4; ++i) {
        float f[16]; unpack8(ua[i], f); unpack8(ub[i], f + 8);
        float sacc = 0.f;
#pragma unroll
        for (int j = 0; j < 16; ++j) sacc += f[j] * hreg[j];
        a[i] = sacc;
      }
      if (b + 1 < 32) {
#pragma unroll
        for (int i = 0; i < 4; ++i) {
          int e = __builtin_amdgcn_readlane(en, (k0 + 4 + i) & 63);
          const uint4* up = (const uint4*)(U + (size_t)e * D + 8 * lane); ua[i] = up[0]; ub[i] = up[64];
        }
      }
#pragma unroll
      for (int i = 0; i < 4; ++i) a[i] = wave_sum(a[i]);
#pragma unroll
      for (int i = 0; i < 4; ++i) {
        float w = gt[i] * 0.5f * a[i] * (1.f + erff(a[i] * 0.70710678118654752f));
        float f[16]; unpack8(va[i], f); unpack8(vb[i], f + 8);
#pragma unroll
        for (int j = 0; j < 16; ++j) acc[j] += w * f[j];
      }
    }
    const float* m = M + ((size_t)layer * 3 + mod_index(row)) * 6144;
    const float* xr = xin + (size_t)row * D;
    float v[16];
#pragma unroll
    for (int hh = 0; hh < 2; ++hh) {
      int d0 = hh * 512 + 8 * lane;
      float4 x0 = *(const float4*)(xr + d0), x1 = *(const float4*)(xr + d0 + 4);
      float4 m0 = *(const float4*)(m + 5 * D + d0), m1 = *(const float4*)(m + 5 * D + d0 + 4);
      v[hh * 8 + 0] = DN_ALPHA * x0.x + m0.x * acc[hh * 8 + 0]; v[hh * 8 + 1] = DN_ALPHA * x0.y + m0.y * acc[hh * 8 + 1];
      v[hh * 8 + 2] = DN_ALPHA * x0.z + m0.z * acc[hh * 8 + 2]; v[hh * 8 + 3] = DN_ALPHA * x0.w + m0.w * acc[hh * 8 + 3];
      v[hh * 8 + 4] = DN_ALPHA * x1.x + m1.x * acc[hh * 8 + 4]; v[hh * 8 + 5] = DN_ALPHA * x1.y + m1.y * acc[hh * 8 + 5];
      v[hh * 8 + 6] = DN_ALPHA * x1.z + m1.z * acc[hh * 8 + 6]; v[hh * 8 + 7] = DN_ALPHA * x1.w + m1.w * acc[hh * 8 + 7];
    }
    float s = 0.f;
#pragma unroll
    for (int j = 0; j < 16; ++j) s += v[j];
    float mu = wave_sum(s) * (1.f / D);
    float q = 0.f;
#pragma unroll
    for (int j = 0; j < 16; ++j) { float d = v[j] - mu; q += d * d; }
    float rs = rsqrtf(wave_sum(q) * (1.f / D) + LN_EPS);
    float y[16];
#pragma unroll
    for (int hh = 0; hh < 2; ++hh) {
      int d0 = hh * 512 + 8 * lane;
#pragma unroll
      for (int j = 0; j < 8; ++j) y[hh * 8 + j] = (v[hh * 8 + j] - mu) * rs * g[d0 + j] + bb[d0 + j];
      *(float4*)(xout + (size_t)row * D + d0) = make_float4(y[hh * 8], y[hh * 8 + 1], y[hh * 8 + 2], y[hh * 8 + 3]);
      *(float4*)(xout + (size_t)row * D + d0 + 4) = make_float4(y[hh * 8 + 4], y[hh * 8 + 5], y[hh * 8 + 6], y[hh * 8 + 7]);
    }
    if (write_next) {
      const float* mn = M + ((size_t)(layer + 1) * 3 + mod_index(row)) * 6144;
      float s2 = 0.f;
#pragma unroll
      for (int j = 0; j < 16; ++j) s2 += y[j];
      float mu2 = wave_sum(s2) * (1.f / D);
      float q2 = 0.f;
#pragma unroll
      for (int j = 0; j < 16; ++j) { float d = y[j] - mu2; q2 += d * d; }
      float rs2 = rsqrtf(wave_sum(q2) * (1.f / D) + LN_EPS);
#pragma unroll
      for (int hh = 0; hh < 2; ++hh) {
        int d0 = hh * 512 + 8 * lane;
        float o[8];
#pragma unroll
        for (int j = 0; j < 8; ++j) o[j] = (y[hh * 8 + j] - mu2) * rs2 * (1.f + mn[D + d0 + j]) + mn[d0 + j];
        *(uint4*)(H + (size_t)row * D + d0) = make_uint4(pack2bf(o[0], o[1]), pack2bf(o[2], o[3]), pack2bf(o[4], o[5]), pack2bf(o[6], o[7]));
      }
    }
  }
}


__device__ __forceinline__ void quant_row(const float* __restrict__ src, unsigned char* __restrict__ dst, float* __restrict__ scale, int row, int lane) {
  const float4* sp = (const float4*)(src + (size_t)row * D + 16 * lane);
  float4 v0 = sp[0], v1 = sp[1], v2 = sp[2], v3 = sp[3];
  float x[16] = {v0.x, v0.y, v0.z, v0.w, v1.x, v1.y, v1.z, v1.w, v2.x, v2.y, v2.z, v2.w, v3.x, v3.y, v3.z, v3.w};
  float am = 0.f;
#pragma unroll
  for (int j = 0; j < 16; ++j) am = fmaxf(am, fabsf(x[j]));
  am = wave_max(am);
  float inv = am > 0.f ? 127.f / am : 0.f;
  unsigned wv[4];
#pragma unroll
  for (int k = 0; k < 4; ++k) {
    unsigned w = 0;
#pragma unroll
    for (int j = 0; j < 4; ++j) {
      int q = (int)rintf(x[4 * k + j] * inv);
      w |= ((unsigned)q & 0xffu) << (8 * j);
    }
    wv[k] = w;
  }
  *(uint4*)(dst + ((size_t)(row >> 14) * 8 + (lane >> 3)) * ((size_t)16384 * 128) + (size_t)(row & 16383) * 128 + 16 * (lane & 7)) = make_uint4(wv[0], wv[1], wv[2], wv[3]);
  if (lane == 0) scale[row] = am * (1.f / 127.f);
}
__device__ __forceinline__ void quant_fill(unsigned* ctr, int layer, unsigned lo, unsigned hi, const float* __restrict__ pu, const float* __restrict__ pv,
                                           unsigned char* __restrict__ U8, unsigned char* __restrict__ V8, float* __restrict__ USC,
                                           float* __restrict__ VSC, unsigned* sh) {
  int lane = threadIdx.x & 63, wave = __builtin_amdgcn_readfirstlane(threadIdx.x >> 6);
  for (;;) {
    __syncthreads();
    if (threadIdx.x == 0) *sh = lo + __hip_atomic_fetch_add(ctr, 1u, __ATOMIC_RELAXED, __HIP_MEMORY_SCOPE_AGENT);
    __syncthreads();
    unsigned c = *sh;
    if (c >= hi) break;
    const float* src = (c >> 8) ? pv : pu; unsigned char* dst = (c >> 8) ? V8 : U8; float* sc = (c >> 8) ? VSC : USC;
    int r0 = layer * 16384 + (int)(c & 255u) * 64 + wave * 16;
#pragma unroll 4
    for (int i = 0; i < 16; ++i) quant_row(src, dst, sc, r0 + i, lane);
  }
  __syncthreads();
}
__device__ __forceinline__ void unpack_u8x16(uint4 v, float* f) {
  unsigned w[4] = {v.x, v.y, v.z, v.w};
#pragma unroll
  for (int k = 0; k < 4; ++k) {
    f[4 * k + 0] = (float)(w[k] & 0xffu); f[4 * k + 1] = (float)((w[k] >> 8) & 0xffu);
    f[4 * k + 2] = (float)((w[k] >> 16) & 0xffu); f[4 * k + 3] = (float)(w[k] >> 24);
  }
}
__device__ __forceinline__ void ph_peer_gather8(bf16_t* __restrict__ H, const int* __restrict__ EXP, const float* __restrict__ GATE,
                               const unsigned char* __restrict__ U8, const float* __restrict__ USC,
                               const unsigned char* __restrict__ V8, const float* __restrict__ VSC,
                               const float* __restrict__ xin, const float* __restrict__ M, int layer,
                               const float* __restrict__ g, const float* __restrict__ bb, float* __restrict__ xout,
                               bool write_next, int nrows) {
  int lane = threadIdx.x & 63, wave = __builtin_amdgcn_readfirstlane(threadIdx.x >> 6);
  for (int row = blockIdx.x * 4 + wave; row < nrows; row += gridDim.x * 4) {
    float hreg[16];
    {
      const uint4* hp = (const uint4*)(H + (size_t)row * D + 16 * lane);
      unpack8(hp[0], hreg); unpack8(hp[1], hreg + 8);
    }
    float hs = 0.f;
#pragma unroll
    for (int j = 0; j < 16; ++j) hs += hreg[j];
    float hsum128 = 128.f * wave_sum(hs);
    float acc[16];
#pragma unroll
    for (int i = 0; i < 16; ++i) acc[i] = 0.f;
    float wsum = 0.f;
    int e_lo = EXP[(size_t)row * 128 + lane], e_hi = EXP[(size_t)row * 128 + 64 + lane];
    float g_lo = GATE[(size_t)row * 128 + lane], g_hi = GATE[(size_t)row * 128 + 64 + lane];
    float us_lo = USC[e_lo], us_hi = USC[e_hi], vs_lo = VSC[e_lo], vs_hi = VSC[e_hi];
    uint4 ua[8], va[8];
#pragma unroll
    for (int i = 0; i < 8; ++i) {
      int e = __builtin_amdgcn_readlane(e_lo, i);
      ua[i] = *(const uint4*)(U8 + (size_t)e * D + 16 * lane);
    }
#pragma unroll 1
    for (int b = 0; b < 16; ++b) {
      int k0 = 8 * b;
      bool lo = b < 8, lon = (b + 1) < 8;
      int ev = lo ? e_lo : e_hi; float gv = lo ? g_lo : g_hi; float usv = lo ? us_lo : us_hi; float vsv = lo ? vs_lo : vs_hi;
      int en = lon ? e_lo : e_hi;
      float gt[8], usc[8], vsc[8];
#pragma unroll
      for (int i = 0; i < 8; ++i) {
        int li = (k0 + i) & 63;
        int e = __builtin_amdgcn_readlane(ev, li);
        gt[i] = __uint_as_float(__builtin_amdgcn_readlane(__float_as_uint(gv), li));
        usc[i] = __uint_as_float(__builtin_amdgcn_readlane(__float_as_uint(usv), li));
        vsc[i] = __uint_as_float(__builtin_amdgcn_readlane(__float_as_uint(vsv), li));
        va[i] = *(const uint4*)(V8 + (size_t)e * D + 16 * lane);
      }
      float a[8];
#pragma unroll
      for (int i = 0; i < 8; ++i) {
        float f[16]; unpack_u8x16(ua[i], f);
        float sacc = 0.f;
#pragma unroll
        for (int j = 0; j < 16; ++j) sacc += f[j] * hreg[j];
        a[i] = sacc;
      }
      if (b + 1 < 16) {
#pragma unroll
        for (int i = 0; i < 8; ++i) {
          int e = __builtin_amdgcn_readlane(en, (k0 + 8 + i) & 63);
          ua[i] = *(const uint4*)(U8 + (size_t)e * D + 16 * lane);
        }
      }
#pragma unroll
      for (int i = 0; i < 8; ++i) a[i] = (wave_sum(a[i]) - hsum128) * usc[i];
#pragma unroll
      for (int i = 0; i < 8; ++i) {
        float w = gt[i] * 0.5f * a[i] * (1.f + erff(a[i] * 0.70710678118654752f)) * vsc[i];
        wsum += w;
        float f[16]; unpack_u8x16(va[i], f);
#pragma unroll
        for (int j = 0; j < 16; ++j) acc[j] += w * f[j];
      }
    }
    float corr = 128.f * wsum;
#pragma unroll
    for (int j = 0; j < 16; ++j) acc[j] -= corr;
    const float* m = M + ((size_t)layer * 3 + mod_index(row)) * 6144;
    const float* xr = xin + (size_t)row * D + 16 * lane;
    const float* m5 = m + 5 * D + 16 * lane;
    float v[16];
#pragma unroll
    for (int q4 = 0; q4 < 4; ++q4) {
      float4 x0 = *(const float4*)(xr + 4 * q4); float4 m0 = *(const float4*)(m5 + 4 * q4);
      v[4 * q4 + 0] = DN_ALPHA * x0.x + m0.x * acc[4 * q4 + 0]; v[4 * q4 + 1] = DN_ALPHA * x0.y + m0.y * acc[4 * q4 + 1];
      v[4 * q4 + 2] = DN_ALPHA * x0.z + m0.z * acc[4 * q4 + 2]; v[4 * q4 + 3] = DN_ALPHA * x0.w + m0.w * acc[4 * q4 + 3];
    }
    float s = 0.f;
#pragma unroll
    for (int j = 0; j < 16; ++j) s += v[j];
    float mu = wave_sum(s) * (1.f / D);
    float q = 0.f;
#pragma unroll
    for (int j = 0; j < 16; ++j) { float d = v[j] - mu; q += d * d; }
    float rs = rsqrtf(wave_sum(q) * (1.f / D) + LN_EPS);
    float y[16];
    {
      const float* gp = g + 16 * lane; const float* bp = bb + 16 * lane;
      float* op = xout + (size_t)row * D + 16 * lane;
#pragma unroll
      for (int q4 = 0; q4 < 4; ++q4) {
        float4 g4 = *(const float4*)(gp + 4 * q4); float4 b4 = *(const float4*)(bp + 4 * q4);
        y[4 * q4 + 0] = (v[4 * q4 + 0] - mu) * rs * g4.x + b4.x; y[4 * q4 + 1] = (v[4 * q4 + 1] - mu) * rs * g4.y + b4.y;
        y[4 * q4 + 2] = (v[4 * q4 + 2] - mu) * rs * g4.z + b4.z; y[4 * q4 + 3] = (v[4 * q4 + 3] - mu) * rs * g4.w + b4.w;
        *(float4*)(op + 4 * q4) = make_float4(y[4 * q4], y[4 * q4 + 1], y[4 * q4 + 2], y[4 * q4 + 3]);
      }
    }
    if (write_next) {
      const float* mn = M + ((size_t)(layer + 1) * 3 + mod_index(row)) * 6144 + 16 * lane;
      float s2 = 0.f;
#pragma unroll
      for (int j = 0; j < 16; ++j) s2 += y[j];
      float mu2 = wave_sum(s2) * (1.f / D);
      float q2 = 0.f;
#pragma unroll
      for (int j = 0; j < 16; ++j) { float d = y[j] - mu2; q2 += d * d; }
      float rs2 = rsqrtf(wave_sum(q2) * (1.f / D) + LN_EPS);
      float o[16];
#pragma unroll
      for (int j = 0; j < 16; ++j) o[j] = (y[j] - mu2) * rs2 * (1.f + mn[D + j]) + mn[j];
      uint4* hp = (uint4*)(H + (size_t)row * D + 16 * lane);
      hp[0] = make_uint4(pack2bf(o[0], o[1]), pack2bf(o[2], o[3]), pack2bf(o[4], o[5]), pack2bf(o[6], o[7]));
      hp[1] = make_uint4(pack2bf(o[8], o[9]), pack2bf(o[10], o[11]), pack2bf(o[12], o[13]), pack2bf(o[14], o[15]));
    }
  }
}


__device__ __forceinline__ void ph_ada2(const float* __restrict__ c, const float* __restrict__ c_ctx, const float* __restrict__ ada_w,
                                        const float* __restrict__ ada_b, float* __restrict__ M, float* sm) {
  int tid = threadIdx.x, lane = tid & 63, wave = __builtin_amdgcn_readfirstlane(tid >> 6);
  float* sv = sm;
  float* red = sm + 3072;
  bool filled = false;
  GRID_LOOP(u, 192) {
    if (!filled) {
      for (int i = tid; i < 3072; i += 256) {
        int idx = i >> 10, k = i & 1023;
        float x = idx < 2 ? c[idx * D + k] : c_ctx[k];
        sv[i] = x / (1.f + expf(-x));
      }
      filled = true;
    }
    __syncthreads();
    int layer = u / 96, c0 = (u % 96) * 64;
    const float* w = ada_w + (size_t)layer * D * 6144 + c0 + lane;
    float a0 = 0.f, a1 = 0.f, a2 = 0.f;
    int kb = wave * 256;
#pragma unroll 16
    for (int k = 0; k < 256; ++k) {
      float wv = w[(size_t)(kb + k) * 6144];
      a0 += sv[kb + k] * wv; a1 += sv[1024 + kb + k] * wv; a2 += sv[2048 + kb + k] * wv;
    }
    red[(wave * 3 + 0) * 64 + lane] = a0; red[(wave * 3 + 1) * 64 + lane] = a1; red[(wave * 3 + 2) * 64 + lane] = a2;
    __syncthreads();
    if (wave < 3) {
      float r = red[(0 * 3 + wave) * 64 + lane] + red[(1 * 3 + wave) * 64 + lane] + red[(2 * 3 + wave) * 64 + lane] + red[(3 * 3 + wave) * 64 + lane];
      M[((size_t)layer * 3 + wave) * 6144 + c0 + lane] = r + ada_b[layer * 6144 + c0 + lane];
    }
  }
  __syncthreads();
}

__device__ __forceinline__ void ph_post_mod(const float* __restrict__ xa, const float* __restrict__ xb, const bf16_t* __restrict__ Y,
                                            const float* __restrict__ M, int layer, int jres, int mlayer, int jshift, int jscale, bool do_mod,
                                            const float* __restrict__ g, const float* __restrict__ bb,
                                            float* __restrict__ xout, bf16_t* __restrict__ H, int nrows) {
  int lane = threadIdx.x & 63, wave = __builtin_amdgcn_readfirstlane(threadIdx.x >> 6);
  for (int row = blockIdx.x * 4 + wave; row < nrows; row += gridDim.x * 4) {
    const float* xr = (row < T ? xa + (size_t)row * D : xb + (size_t)(row - T) * D) + 16 * lane;
    const float* m = M + ((size_t)layer * 3 + mod_index(row)) * 6144 + 16 * lane;
    float yv[16];
    {
      const uint4* yp = (const uint4*)(Y + (size_t)row * D + 16 * lane);
      unpack8(yp[0], yv); unpack8(yp[1], yv + 8);
    }
    float v[16];
#pragma unroll
    for (int q4 = 0; q4 < 4; ++q4) {
      float4 x0 = *(const float4*)(xr + 4 * q4); float4 m0 = *(const float4*)(m + jres * D + 4 * q4);
      v[4 * q4 + 0] = DN_ALPHA * x0.x + m0.x * yv[4 * q4 + 0]; v[4 * q4 + 1] = DN_ALPHA * x0.y + m0.y * yv[4 * q4 + 1];
      v[4 * q4 + 2] = DN_ALPHA * x0.z + m0.z * yv[4 * q4 + 2]; v[4 * q4 + 3] = DN_ALPHA * x0.w + m0.w * yv[4 * q4 + 3];
    }
    float s = 0.f;
#pragma unroll
    for (int j = 0; j < 16; ++j) s += v[j];
    float mu = wave_sum(s) * (1.f / D);
    float q = 0.f;
#pragma unroll
    for (int j = 0; j < 16; ++j) { float d = v[j] - mu; q += d * d; }
    float rs = rsqrtf(wave_sum(q) * (1.f / D) + LN_EPS);
    float y[16];
    {
      const float* gp = g + 16 * lane; const float* bp = bb + 16 * lane;
      float* op = xout + (size_t)row * D + 16 * lane;
#pragma unroll
      for (int q4 = 0; q4 < 4; ++q4) {
        float4 g4 = *(const float4*)(gp + 4 * q4); float4 b4 = *(const float4*)(bp + 4 * q4);
        y[4 * q4 + 0] = (v[4 * q4 + 0] - mu) * rs * g4.x + b4.x; y[4 * q4 + 1] = (v[4 * q4 + 1] - mu) * rs * g4.y + b4.y;
        y[4 * q4 + 2] = (v[4 * q4 + 2] - mu) * rs * g4.z + b4.z; y[4 * q4 + 3] = (v[4 * q4 + 3] - mu) * rs * g4.w + b4.w;
        *(float4*)(op + 4 * q4) = make_float4(y[4 * q4], y[4 * q4 + 1], y[4 * q4 + 2], y[4 * q4 + 3]);
      }
    }
    if (do_mod) {
      const float* mm = M + ((size_t)mlayer * 3 + mod_index(row)) * 6144 + 16 * lane;
      float s2 = 0.f;
#pragma unroll
      for (int j = 0; j < 16; ++j) s2 += y[j];
      float mu2 = wave_sum(s2) * (1.f / D);
      float q2 = 0.f;
#pragma unroll
      for (int j = 0; j < 16; ++j) { float d = y[j] - mu2; q2 += d * d; }
      float rs2 = rsqrtf(wave_sum(q2) * (1.f / D) + LN_EPS);
      float o[16];
#pragma unroll
      for (int j = 0; j < 16; ++j) o[j] = (y[j] - mu2) * rs2 * (1.f + mm[jscale * D + j]) + mm[jshift * D + j];
      uint4* hp = (uint4*)(H + (size_t)row * D + 16 * lane);
      hp[0] = make_uint4(pack2bf(o[0], o[1]), pack2bf(o[2], o[3]), pack2bf(o[4], o[5]), pack2bf(o[6], o[7]));
      hp[1] = make_uint4(pack2bf(o[8], o[9]), pack2bf(o[10], o[11]), pack2bf(o[12], o[13]), pack2bf(o[14], o[15]));
    }
  }
}


template <int CTRL> __device__ __forceinline__ float dpp_add(float x) { return x + dpp_mov<CTRL>(x); }
__device__ __forceinline__ float sum8(float v) {
  v = dpp_add<0xB1>(v); v = dpp_add<0x4E>(v); v = dpp_add<0x141>(v); return v;
}
typedef _Float16 half2_t __attribute__((ext_vector_type(2)));
__device__ __forceinline__ float dot2h(unsigned a, unsigned b, float c) {
  return __builtin_amdgcn_fdot2(__builtin_bit_cast(half2_t, a), __builtin_bit_cast(half2_t, b), c, false);
}
__device__ __forceinline__ unsigned pkh(float a, float b) { return __builtin_bit_cast(unsigned, __builtin_amdgcn_cvt_pkrtz(a, b)); }
__device__ __forceinline__ void load_e16(const int* __restrict__ EXP, int t, int g8, int (&e)[16]) {
  const int4* ep = (const int4*)(EXP + (size_t)t * 128 + 16 * g8);
  int4 a = ep[0], b = ep[1], c = ep[2], d = ep[3];
  e[0] = a.x; e[1] = a.y; e[2] = a.z; e[3] = a.w; e[4] = b.x; e[5] = b.y; e[6] = b.z; e[7] = b.w;
  e[8] = c.x; e[9] = c.y; e[10] = c.z; e[11] = c.w; e[12] = d.x; e[13] = d.y; e[14] = d.z; e[15] = d.w;
}
#define U_TOKEN(tt, UV, UVN, EUSE, ELD, HUSE, HLD) { \
    int tnn_ = min((tt) + 2 * st, nrows - 1); \
    load_e16(EXP, tnn_, g8, ELD); \
    HLD[0] = *(const uint4*)(hb + (size_t)tnn_ * D); HLD[1] = *(const uint4*)(hb + (size_t)tnn_ * D + 8); \
    __builtin_amdgcn_sched_barrier(0); \
    _Pragma("unroll") for (int i = 0; i < 16; ++i) UVN[i] = *(const uint4*)(ubs + (((unsigned)EUSE[i] << 7) + loff)); \
    __builtin_amdgcn_sched_barrier(0); \
    float h16[16]; unpack8(HUSE[0], h16); unpack8(HUSE[1], h16 + 8); \
    float hm = 0.f; \
    _Pragma("unroll") for (int j = 0; j < 16; ++j) hm = fmaxf(hm, fabsf(h16[j])); \
    hm = fmaxf(hm, dpp_mov<0xB1>(hm)); hm = fmaxf(hm, dpp_mov<0x4E>(hm)); hm = fmaxf(hm, dpp_mov<0x141>(hm)); \
    float hinv = hm > 0.f ? 127.f / hm : 0.f; float hsc = hm * (1.f / 127.f); \
    int hq[4]; \
    _Pragma("unroll") for (int k = 0; k < 4; ++k) { unsigned w_ = 0; \
      _Pragma("unroll") for (int j = 0; j < 4; ++j) w_ = __builtin_amdgcn_cvt_pk_u8_f32(rintf(h16[4 * k + j] * hinv) + 128.f, j, w_); \
      hq[k] = (int)(w_ ^ 0x80808080u); }        \
    float k0 = 0.f, k1 = 0.f; \
    _Pragma("unroll") for (int i = 0; i < 16; ++i) { \
      int p_ = __builtin_amdgcn_sdot4((int)UV[i].x, hq[0], 0, false); p_ = __builtin_amdgcn_sdot4((int)UV[i].y, hq[1], p_, false); \
      p_ = __builtin_amdgcn_sdot4((int)UV[i].z, hq[2], p_, false); p_ = __builtin_amdgcn_sdot4((int)UV[i].w, hq[3], p_, false); \
      float p = sum8((float)p_) * hsc; \
      if ((i >> 1) == j8) { if (i & 1) k1 = p; else k0 = p; } } \
    *(float2*)(PA + ((size_t)(tt) * 8 + x) * 128 + 16 * g8 + 2 * j8) = make_float2(k0, k1); }
__device__ __forceinline__ void ph_peer_u(const bf16_t* __restrict__ H, const int* __restrict__ EXP, const unsigned char* __restrict__ U8,
                                          float* __restrict__ PA, int nrows) {
  int lane = threadIdx.x & 63, wave = __builtin_amdgcn_readfirstlane(threadIdx.x >> 6);
  int x = blockIdx.x & 7; int nb8 = gridDim.x >> 3;
  if ((int)(blockIdx.x >> 3) >= nb8) return;
  int j8 = lane & 7, g8 = lane >> 3;
  const int st = nb8 * 4;
  int t = (blockIdx.x >> 3) * 4 + wave;
  if (t >= nrows) return;
  const unsigned char* ubs = U8 + (size_t)x * ((size_t)16384 * 128);
  const unsigned loff = 16u * (unsigned)j8;
  const bf16_t* hb = H + 128 * x + 16 * j8;
  int eA[16], eB[16]; uint4 hA[2], hB[2], uvA[16], uvB[16];
  {
    int e0[16]; load_e16(EXP, t, g8, e0);
#pragma unroll
    for (int i = 0; i < 16; ++i) uvA[i] = *(const uint4*)(ubs + (((unsigned)e0[i] << 7) + loff));
    hA[0] = *(const uint4*)(hb + (size_t)t * D); hA[1] = *(const uint4*)(hb + (size_t)t * D + 8);
    int tn = min(t + st, nrows - 1);
    load_e16(EXP, tn, g8, eA);
    hB[0] = *(const uint4*)(hb + (size_t)tn * D); hB[1] = *(const uint4*)(hb + (size_t)tn * D + 8);
  }
#pragma unroll 1
  for (; t < nrows; t += 2 * st) {
    uint4 hC[2];
    U_TOKEN(t, uvA, uvB, eA, eB, hA, hC)
    if (t + st < nrows) {
      U_TOKEN(t + st, uvB, uvA, eB, eA, hB, hA)
    }
    hB[0] = hA[0]; hB[1] = hA[1]; hA[0] = hC[0]; hA[1] = hC[1];
  }
}
__device__ __forceinline__ void ph_peer_w(const float* __restrict__ PA, const int* __restrict__ EXP, const float* __restrict__ GATE,
                                          const float* __restrict__ USC, const float* __restrict__ VSC, unsigned* __restrict__ WQ,
                                          float* __restrict__ SW, int nrows) {
  int lane = threadIdx.x & 63, wave = __builtin_amdgcn_readfirstlane(threadIdx.x >> 6);
  int l4 = lane & 31;
  for (int t = blockIdx.x * 4 + wave; t < nrows; t += gridDim.x * 4) {
    int4 e = *(const int4*)(EXP + (size_t)t * 128 + 4 * l4);
    float4 gt = *(const float4*)(GATE + (size_t)t * 128 + 4 * l4);
    float a[4] = {0.f, 0.f, 0.f, 0.f};
#pragma unroll
    for (int xs = 0; xs < 8; ++xs) { float4 p = *(const float4*)(PA + ((size_t)t * 8 + xs) * 128 + 4 * l4); a[0] += p.x; a[1] += p.y; a[2] += p.z; a[3] += p.w; }
    int ee[4] = {e.x, e.y, e.z, e.w}; float gg[4] = {gt.x, gt.y, gt.z, gt.w}; float w[4]; float wm = 0.f;
#pragma unroll
    for (int j = 0; j < 4; ++j) {
      float av = a[j] * USC[ee[j]];
      w[j] = gg[j] * 0.5f * av * (1.f + erff(av * 0.70710678118654752f)) * VSC[ee[j]];
      wm = fmaxf(wm, fabsf(w[j]));
    }
    wm = wave_max(wm);
    float winv = wm > 0.f ? 127.f / wm : 0.f;
    unsigned q = 0;
#pragma unroll
    for (int j = 0; j < 4; ++j) q = __builtin_amdgcn_cvt_pk_u8_f32(rintf(w[j] * winv) + 128.f, j, q);
    if (lane < 32) WQ[(size_t)t * 32 + l4] = q ^ 0x80808080u;
    if (lane == 0) SW[t] = wm * (1.f / 127.f);
  }
}
__device__ __forceinline__ void load_w16(const float* __restrict__ W, int t, int g8, float (&w)[16]) {
  const float4* wp = (const float4*)(W + (size_t)t * 128 + 16 * g8);
  float4 wa = wp[0], wb = wp[1], wc = wp[2], wd = wp[3];
  w[0] = wa.x; w[1] = wa.y; w[2] = wa.z; w[3] = wa.w; w[4] = wb.x; w[5] = wb.y; w[6] = wb.z; w[7] = wb.w;
  w[8] = wc.x; w[9] = wc.y; w[10] = wc.z; w[11] = wc.w; w[12] = wd.x; w[13] = wd.y; w[14] = wd.z; w[15] = wd.w;
}
#define V_TOKEN(tt, VV, VVN, EUSE, ELD, WUSE, WLD, SUSE, SLD) { \
    int tnn_ = min((tt) + 2 * st, nrows - 1); \
    load_e16(EXP, tnn_, g8, ELD); \
    WLD = *(const uint4*)(WQ + (size_t)tnn_ * 32 + 4 * g8); SLD = SW[tnn_]; \
    __builtin_amdgcn_sched_barrier(0); \
    _Pragma("unroll") for (int i = 0; i < 16; ++i) VVN[i] = *(const uint4*)(vbs + (((unsigned)EUSE[i] << 7) + loff)); \
    __builtin_amdgcn_sched_barrier(0); \
    int acc[16]; \
    _Pragma("unroll") for (int j = 0; j < 16; ++j) acc[j] = 0; \
    int wq[4] = {(int)WUSE.x, (int)WUSE.y, (int)WUSE.z, (int)WUSE.w}; \
    _Pragma("unroll") for (int m = 0; m < 4; ++m) { \
      unsigned r0[4] = {VV[4 * m].x, VV[4 * m].y, VV[4 * m].z, VV[4 * m].w}; \
      unsigned r1[4] = {VV[4 * m + 1].x, VV[4 * m + 1].y, VV[4 * m + 1].z, VV[4 * m + 1].w}; \
      unsigned r2[4] = {VV[4 * m + 2].x, VV[4 * m + 2].y, VV[4 * m + 2].z, VV[4 * m + 2].w}; \
      unsigned r3[4] = {VV[4 * m + 3].x, VV[4 * m + 3].y, VV[4 * m + 3].z, VV[4 * m + 3].w}; \
      _Pragma("unroll") for (int k = 0; k < 4; ++k) { \
          \
        unsigned a0 = __builtin_amdgcn_perm(r1[k], r0[k], 0x05010400u);     \
        unsigned a1 = __builtin_amdgcn_perm(r1[k], r0[k], 0x07030602u);     \
        unsigned a2 = __builtin_amdgcn_perm(r3[k], r2[k], 0x05010400u); \
        unsigned a3 = __builtin_amdgcn_perm(r3[k], r2[k], 0x07030602u); \
        unsigned t0 = __builtin_amdgcn_perm(a2, a0, 0x05040100u);           \
        unsigned t1 = __builtin_amdgcn_perm(a2, a0, 0x07060302u); \
        unsigned t2 = __builtin_amdgcn_perm(a3, a1, 0x05040100u); \
        unsigned t3 = __builtin_amdgcn_perm(a3, a1, 0x07060302u); \
        acc[4 * k + 0] = __builtin_amdgcn_sdot4((int)t0, wq[m], acc[4 * k + 0], false); \
        acc[4 * k + 1] = __builtin_amdgcn_sdot4((int)t1, wq[m], acc[4 * k + 1], false); \
        acc[4 * k + 2] = __builtin_amdgcn_sdot4((int)t2, wq[m], acc[4 * k + 2], false); \
        acc[4 * k + 3] = __builtin_amdgcn_sdot4((int)t3, wq[m], acc[4 * k + 3], false); } } \
    float of[16]; \
    _Pragma("unroll") for (int j = 0; j < 16; ++j) { float v = (float)acc[j]; v += dpp_mov<0x128>(v); of[j] = xrow16_sum(v) * SUSE; } \
    if (g8 == 0) { \
      uint4* fp = (uint4*)(F + (size_t)(tt) * D + 128 * x + 16 * j8); \
      fp[0] = make_uint4(pack2bf(of[0], of[1]), pack2bf(of[2], of[3]), pack2bf(of[4], of[5]), pack2bf(of[6], of[7])); \
      fp[1] = make_uint4(pack2bf(of[8], of[9]), pack2bf(of[10], of[11]), pack2bf(of[12], of[13]), pack2bf(of[14], of[15])); } }
__device__ __forceinline__ void ph_peer_v(const unsigned* __restrict__ WQ, const float* __restrict__ SW, const int* __restrict__ EXP,
                                          const unsigned char* __restrict__ V8, bf16_t* __restrict__ F, int nrows) {
  int lane = threadIdx.x & 63, wave = __builtin_amdgcn_readfirstlane(threadIdx.x >> 6);
  int x = blockIdx.x & 7; int nb8 = gridDim.x >> 3;
  if ((int)(blockIdx.x >> 3) >= nb8) return;
  int j8 = lane & 7, g8 = lane >> 3;
  const int st = nb8 * 4;
  int t = (blockIdx.x >> 3) * 4 + wave;
  if (t >= nrows) return;
  const unsigned char* vbs = V8 + (size_t)x * ((size_t)16384 * 128);
  const unsigned loff = 16u * (unsigned)j8;
  int eA[16], eB[16]; uint4 wA, wB, vvA[16], vvB[16]; float sA, sB;
  {
    int e0[16]; load_e16(EXP, t, g8, e0);
#pragma unroll
    for (int i = 0; i < 16; ++i) vvA[i] = *(const uint4*)(vbs + (((unsigned)e0[i] << 7) + loff));
    wA = *(const uint4*)(WQ + (size_t)t * 32 + 4 * g8); sA = SW[t];
    int tn = min(t + st, nrows - 1);
    load_e16(EXP, tn, g8, eA);
    wB = *(const uint4*)(WQ + (size_t)tn * 32 + 4 * g8); sB = SW[tn];
  }
#pragma unroll 1
  for (; t < nrows; t += 2 * st) {
    uint4 wC; float sC;
    V_TOKEN(t, vvA, vvB, eA, eB, wA, wC, sA, sC)
    if (t + st < nrows) {
      V_TOKEN(t + st, vvB, vvA, eB, eA, wB, wA, sB, sA)
    }
    wB = wA; sB = sA; wA = wC; sA = sC;
  }
}

#define XB_TMO      128
#define XB_XCNT(j)  (256  + 64 * (j))
#define XB_XSUB(j)  (1280 + 64 * (j))
#define XB_XGEN(j)  (2304 + 64 * (j))
#define XB_TOP      3328
#define XB_TOPGEN   3392
#define XCD_BAR_WORDS 3456
#define XB_SPIN_CAP (1u << 22)
#define LAS __attribute__((address_space(3)))
__device__ __forceinline__ unsigned xb_ld(unsigned* p)              { return __hip_atomic_load(p, __ATOMIC_RELAXED, __HIP_MEMORY_SCOPE_AGENT); }
__device__ __forceinline__ unsigned xb_add(unsigned* p, unsigned v) { return __hip_atomic_fetch_add(p, v, __ATOMIC_RELAXED, __HIP_MEMORY_SCOPE_AGENT); }
__device__ __forceinline__ unsigned xb_xcc_id() { return (unsigned)__builtin_amdgcn_s_getreg((3 << 11) | 20) & 0xFu; }
#define XB_SPIN(cond, bar) do { unsigned _sp = 0; while (cond) { __builtin_amdgcn_s_sleep(1); \
    if ((++_sp & 255u) == 0u) { if (xb_ld(&(bar)[XB_TMO])) break; if (_sp > XB_SPIN_CAP) { atomicAdd(&(bar)[XB_TMO], 1u); break; } } } } while (0)
struct XcdBarrier { unsigned* bar; unsigned x; volatile LAS unsigned* st; };
__device__ __forceinline__ XcdBarrier xcd_barrier_post(unsigned* bar, volatile LAS unsigned* st) {
  XcdBarrier b; b.bar = bar; b.x = xb_xcc_id(); b.st = st;
  if (threadIdx.x == 0) (void)xb_add(&bar[XB_XCNT(b.x)], 1u);
  return b;
}
__device__ __forceinline__ void xcd_barrier_complete(unsigned* bar, unsigned x, unsigned& nloc, unsigned& nx) {
  const unsigned G = gridDim.x * gridDim.y * gridDim.z;
  unsigned sum, cnt, mine, sp = 0u;
  for (;;) {
    sum = 0u; cnt = 0u; mine = 0u;
#pragma unroll
    for (unsigned j = 0; j < 16; ++j) { const unsigned c = xb_ld(&bar[XB_XCNT(j)]); sum += c; cnt += (c > 0u) ? 1u : 0u; mine = (j == x) ? c : mine; }
    if (sum == G) break;
    __builtin_amdgcn_s_sleep(1);
    if ((++sp & 255u) == 0u) { if (xb_ld(&bar[XB_TMO])) break; if (sp > XB_SPIN_CAP) { atomicAdd(&bar[XB_TMO], 1u); break; } }
  }
  nloc = mine > 0u ? mine : 1u; nx = cnt > 0u ? cnt : 1u;
}
__device__ __forceinline__ void xcd_barrier(const XcdBarrier& b) {
  asm volatile("s_waitcnt vmcnt(0)" ::: "memory");
  __syncthreads();
  if (threadIdx.x == 0) {
    unsigned* bar = b.bar;
    __builtin_amdgcn_s_waitcnt(0);
    unsigned nloc = b.st[0], nx = b.st[1];
    if (nloc == 0u) { xcd_barrier_complete(bar, b.x, nloc, nx); b.st[0] = nloc; b.st[1] = nx; }
    const unsigned old = xb_add(&bar[XB_XSUB(b.x)], 1u);
    const unsigned gen = old / nloc;
    if (old + 1u == (gen + 1u) * nloc) {
      __builtin_amdgcn_fence(__ATOMIC_RELEASE, "agent");
      asm volatile("s_waitcnt vmcnt(0)" ::: "memory");
      const unsigned og = xb_add(&bar[XB_TOP], 1u);
      const unsigned tg = og / nx;
      if (og + 1u == (tg + 1u) * nx) xb_add(&bar[XB_TOPGEN], 1u);
      else XB_SPIN(xb_ld(&bar[XB_TOPGEN]) == tg, bar);
      __builtin_amdgcn_fence(__ATOMIC_ACQUIRE, "agent");
      xb_add(&bar[XB_XGEN(b.x)], 1u);
      asm volatile("s_waitcnt vmcnt(0)" ::: "memory");
    } else {
      XB_SPIN(xb_ld(&bar[XB_XGEN(b.x)]) == gen, bar);
      __builtin_amdgcn_fence(__ATOMIC_ACQUIRE, "agent");
      asm volatile("s_waitcnt vmcnt(0)" ::: "memory");
    }
  }
  __syncthreads();
}

constexpr int SMEM_BYTES = 65536;
#ifndef PHMASK
#define PHMASK 0xFFFFFFFFFFFFFFFFull
#endif
#ifndef PHDUP
#define PHDUP 0ull
#endif
#define PH(n, ...) if constexpr ((((unsigned long long)(PHMASK)) >> (n)) & 1ull) { __VA_ARGS__; if constexpr ((((unsigned long long)(PHDUP)) >> (n)) & 1ull) { xcd_barrier(xbar); __VA_ARGS__; } }

__global__ __launch_bounds__(256, 2) void mega(Params p) {
  __shared__ __attribute__((aligned(16))) char smem_raw[SMEM_BYTES + 16];
  if (threadIdx.x == 0) *(uint4*)(smem_raw + SMEM_BYTES) = make_uint4(0u, 0u, 0u, 0u);
  __syncthreads();
  XcdBarrier xbar = xcd_barrier_post((unsigned*)((char*)p.ws + OFF_BAR), (volatile LAS unsigned*)(smem_raw + SMEM_BYTES));
  float* smem = (float*)smem_raw;
  const float* x = p.in[0]; const float* c = p.in[1]; const float* ctx = p.in[2]; const float* c_ctx = p.in[3];
  const float* ada_w = p.in[4]; const float* ada_b = p.in[5]; const float* ln_g = p.in[6]; const float* ln_b = p.in[7];
  const float* even_w_in = p.in[8]; const float* even_w_out = p.in[9]; const float* rpb = p.in[10];
  const float* odd_w_in = p.in[11]; const float* odd_w_out = p.in[12]; const float* sink = p.in[13];
  const float* peer_wq = p.in[14]; const float* peer_sk = p.in[15]; const float* peer_u = p.in[16]; const float* peer_v = p.in[17];
  char* ws = (char*)p.ws;
  float* TAB = (float*)(ws + OFF_TAB); float* Mm = (float*)(ws + OFF_M);
  bf16_t* WIN0 = (bf16_t*)(ws + OFF_WIN0); bf16_t* WOUT0 = (bf16_t*)(ws + OFF_WOUT0);
  bf16_t* WIN1 = (bf16_t*)(ws + OFF_WIN1); bf16_t* WOUT1 = (bf16_t*)(ws + OFF_WOUT1);
  bf16_t* WQ = (bf16_t*)(ws + OFF_WQ); bf16_t* SKB = (bf16_t*)(ws + OFF_SK);
  unsigned char* U8 = (unsigned char*)(ws + OFF_UB); unsigned char* V8 = (unsigned char*)(ws + OFF_VB);
  float* USC = (float*)(ws + OFF_USC); float* VSC = USC + 2 * 16384;
  bf16_t* AB = (bf16_t*)(ws + OFF_AB);
  bf16_t* FD1 = (bf16_t*)(ws + OFF_FT); bf16_t* FD3 = FD1 + 256 * 128; bf16_t* FDC = FD3 + 128 * 128;
  bf16_t* A1 = (bf16_t*)(ws + OFF_A1); bf16_t* VT0 = (bf16_t*)(ws + OFF_VT0); bf16_t* FQKV = (bf16_t*)(ws + OFF_BF);
  float* BF_ = (float*)(ws + OFF_BF); float* BY = (float*)(ws + OFF_BY);
  float* X1 = (float*)(ws + OFF_X1); float* X2 = (float*)(ws + OFF_X2);
  float* RT = TAB + 16384;
  bf16_t* Q1 = (bf16_t*)(ws + OFF_BF); bf16_t* K1 = Q1 + (size_t)T * 1024; bf16_t* VT1 = K1 + (size_t)R * 256;
  bf16_t* YB = (bf16_t*)(ws + OFF_BY + (size_t)2 * R * 128 * 4);
  float* PAB = (float*)(ws + OFF_BF); bf16_t* FB = (bf16_t*)(ws + OFF_BF + (size_t)R * 8 * 128 * 4);
  float* WB = (float*)(ws + OFF_BF + (size_t)R * 8 * 128 * 4 + (size_t)R * 1024 * 2); float* CORRB = WB + (size_t)R * 128;
  int* EXPB = (int*)(ws + OFF_BY); float* GATEB = (float*)(ws + OFF_BY + (size_t)R * 128 * 4);
  float* out = p.out;
  unsigned* QC = (unsigned*)(ws + OFF_BAR) + 32;
#define QFILL(site, layer, lo, hi) quant_fill(QC + (site), (layer), (lo), (hi), peer_u, peer_v, U8, V8, USC, VSC, (unsigned*)(smem_raw + 65024))

  PH(0, ph_tables(TAB); ph_rope_table(RT))
  PH(1, ph_fft_tables(FD1, FD3, FDC))
  PH(2, ph_ada2(c, c_ctx, ada_w, ada_b, Mm, smem))
  PH(3, ph_transpose_w(even_w_in, 1024, 2048, WIN0, smem))
  PH(4, ph_transpose_w(even_w_out, 1024, 1024, WOUT0, smem))
  PH(5, ph_transpose_w(odd_w_in, 1024, 1536, WIN1, smem))
  PH(6, ph_transpose_w(odd_w_out, 1024, 1024, WOUT1, smem))
  PH(7, ph_transpose_w(peer_wq, 1024, 2048, WQ, smem))
  PH(8, ph_transpose_w(peer_wq + (size_t)1024 * 2048, 1024, 2048, WQ + (size_t)2048 * 1024, smem))
  PH(11, ph_convert(peer_sk, SKB, (size_t)2 * 8 * 2 * 128 * 128 / 8))
  xcd_barrier(xbar);
  PH(12, ph_modulate(x, ctx, Mm, 0, 0, 1, AB, R, smem))
  xcd_barrier(xbar);
  PH(13, ph_gemm_bf16(AB, 1024, WIN0, 1024, R, 2048, 1024, EpiQKV0{FQKV, VT0}, smem_raw))
  PH(9, QFILL(0, 0, 0u, 160u))
  xcd_barrier(xbar);
  PH(14, { GRID_LOOP(u, NB * 64 * 8) fft1_unit(u, FQKV, FD1, TAB, A1, smem_raw); })
  PH(15, { int lane = threadIdx.x & 63, wave = __builtin_amdgcn_readfirstlane(threadIdx.x >> 6);
           __syncthreads();
           for (int i = threadIdx.x; i < 8 * 15 * 31; i += 256) smem[i] = rpb[i] * 1.4426950408889634f;
           __syncthreads();
           for (int bu = blockIdx.x; bu < 512 + 64; bu += gridDim.x) {
             if (bu < 512) { int h = bu & 7, rg = (bu >> 3) & 31, bb = bu >> 8;
               na_unit(bb, h, rg * 4 + wave, FQKV, VT0, VT0 + (size_t)NB * 8 * 64 * S, smem, AB, lane); }
             else { int cu = bu - 512; int h = cu & 7, qg = (cu >> 3) & 3, bb = cu >> 5;
               attn_unit<1, 1, 2, true>(bb, h, 0, 0, qg * 4 + wave, FQKV + 512, 2048, FQKV + 1024, 2048, VT0, VT0 + (size_t)NB * 8 * 64 * S, 8, smem, nullptr, AB + 512, 1024, lane); } } })
  xcd_barrier(xbar);
  PH(16, { GRID_LOOP(u, NB * 128 * 8 + NB * 4 * 8) { if (u < NB * 128 * 8) fft3_unit(u, 0, FQKV, A1, FD3, FDC, TAB, AB, smem_raw); else fft3_unit(u - NB * 128 * 8, 1, FQKV, A1, FD3, FDC, TAB, AB, smem_raw); } })
  xcd_barrier(xbar);
  PH(17, ph_gemm_bf16(AB, 1024, WOUT0, 1024, R, 1024, 1024, EpiBf16{YB, 1024}, smem_raw))
  PH(9, QFILL(1, 0, 160u, 260u))
  xcd_barrier(xbar);
  PH(18, ph_post_mod(x, ctx, YB, Mm, 0, 2, 0, 3, 4, true, ln_g + 0, ln_b + 0, X1, AB, R))
  xcd_barrier(xbar);
  PH(21, ph_peer_select(AB, WQ, SKB, EXPB, GATEB, R, smem_raw))
  PH(9, QFILL(2, 0, 260u, 512u))
  PH(10, QFILL(3, 1, 0u, 300u))
  xcd_barrier(xbar);
  PH(22, ph_peer_u(AB, EXPB, U8, PAB, R))
  xcd_barrier(xbar);
  PH(32, ph_peer_w(PAB, EXPB, GATEB, USC, VSC, (unsigned*)WB, CORRB, R))
  xcd_barrier(xbar);
  PH(33, ph_peer_v((const unsigned*)WB, CORRB, EXPB, V8, FB, R))
  xcd_barrier(xbar);
  PH(34, ph_post_mod(X1, X1 + (size_t)T * D, FB, Mm, 0, 5, 1, 0, 1, true, ln_g + 1024, ln_b + 1024, X2, AB, R))
  xcd_barrier(xbar);
  PH(23, ph_gemm_bf16(AB, 1024, WIN1, 1024, R, 1536, 1024, EpiQKV1{Q1, K1, VT1, RT}, smem_raw))
  PH(10, QFILL(4, 1, 300u, 420u))
  xcd_barrier(xbar);
  PH(25, { int lane = threadIdx.x & 63, wave = __builtin_amdgcn_readfirstlane(threadIdx.x >> 6);
           for (int bu = blockIdx.x; bu < 1024; bu += gridDim.x) { int kvh = bu & 3, bb = (bu >> 2) & 1, qg = bu >> 3;
             attn_unit<4, 2, 1, true>(bb, kvh, 0, 0, qg * 4 + wave, Q1, 1024, K1, 256, VT1, VT1 + (size_t)NB * 4 * 64 * S, 4, nullptr, sink, AB, 1024, lane); } })
  xcd_barrier(xbar);
  PH(26, ph_gemm_bf16(AB, 1024, WOUT1, 1024, T, 1024, 1024, EpiBf16{YB, 1024}, smem_raw))
  xcd_barrier(xbar);
  PH(27, ph_post_mod(X2, X2, YB, Mm, 1, 2, 1, 3, 4, true, ln_g + 2048, ln_b + 2048, X1, AB, T))
  xcd_barrier(xbar);
  PH(30, ph_peer_select(AB, WQ + (size_t)2048 * 1024, SKB + (size_t)8 * 2 * 128 * 128, EXPB, GATEB, T, smem_raw))
  PH(10, QFILL(5, 1, 420u, 512u))
  xcd_barrier(xbar);
  PH(31, ph_peer_u(AB, EXPB, U8 + (size_t)16384 * 1024, PAB, T))
  xcd_barrier(xbar);
  PH(35, ph_peer_w(PAB, EXPB, GATEB, USC + 16384, VSC + 16384, (unsigned*)WB, CORRB, T))
  xcd_barrier(xbar);
  PH(36, ph_peer_v((const unsigned*)WB, CORRB, EXPB, V8 + (size_t)16384 * 1024, FB, T))
  xcd_barrier(xbar);
  PH(37, ph_post_mod(X1, X1, FB, Mm, 1, 5, 1, 0, 1, false, ln_g + 3072, ln_b + 3072, out, AB, T))
}

}

extern "C" void kernel_launch(void* const* d_in, const int* in_sizes, int n_in, void* d_out, int out_size, void* d_ws,
                              size_t ws_size, hipStream_t stream) {
  static int grid_blocks = 0;
  if (!grid_blocks) {
    int dev = 0, cus = 0, per_cu = 0;
    hipGetDevice(&dev);
    hipDeviceGetAttribute(&cus, hipDeviceAttributeMultiprocessorCount, dev);
    hipOccupancyMaxActiveBlocksPerMultiprocessor(&per_cu, (const void*)mega, 256, 0);
    if (per_cu > 2) per_cu = 2;
    if (per_cu < 1) per_cu = 1;
    grid_blocks = cus * per_cu;
  }
  Params p{};
  for (int i = 0; i < 18; ++i) p.in[i] = (const float*)d_in[i];
  p.out = (float*)d_out;
  p.ws = (float*)d_ws;
  (void)hipMemsetAsync((char*)d_ws + OFF_BAR, 0, XCD_BAR_WORDS_C * 4, stream);
  void* args[] = {&p};
  hipError_t e = hipLaunchCooperativeKernel((const void*)mega, dim3(grid_blocks), dim3(256), args, 0, stream);
  if (e != hipSuccess) fprintf(stderr, "cooperative launch failed: %s (grid %d)\n", hipGetErrorString(e), grid_blocks);
}
```

```cpp
#include <hip/hip_runtime.h>
#include <hip/hip_bf16.h>
#include <stdint.h>
#include <math.h>
#include <stdio.h>
#include <hip/hip_cooperative_groups.h>
namespace cg = cooperative_groups;

namespace {

constexpr int D = 1024;
constexpr int NB = 2;
constexpr int S = 8192;
constexpr int T = NB * S;
constexpr int CL = 256;
constexpr int TC = NB * CL;
constexpr int R = T + TC;
constexpr float DN_ALPHA = 1.4142135623730951f;
constexpr float LN_EPS = 1e-6f;

template <int CTRL> __device__ __forceinline__ float dpp_mov(float x) {
  return __builtin_bit_cast(float, __builtin_amdgcn_mov_dpp(__builtin_bit_cast(int, x), CTRL, 0xf, 0xf, true));
}
__device__ __forceinline__ float xrow16_max(float x) {
  auto s = __builtin_amdgcn_permlane16_swap(__float_as_uint(x), __float_as_uint(x), false, false);
  x = fmaxf(__uint_as_float(s[0]), __uint_as_float(s[1]));
  auto t = __builtin_amdgcn_permlane32_swap(__float_as_uint(x), __float_as_uint(x), false, false);
  return fmaxf(__uint_as_float(t[0]), __uint_as_float(t[1]));
}
__device__ __forceinline__ float xrow16_sum(float x) {
  auto s = __builtin_amdgcn_permlane16_swap(__float_as_uint(x), __float_as_uint(x), false, false);
  x = __uint_as_float(s[0]) + __uint_as_float(s[1]);
  auto t = __builtin_amdgcn_permlane32_swap(__float_as_uint(x), __float_as_uint(x), false, false);
  return __uint_as_float(t[0]) + __uint_as_float(t[1]);
}
__device__ __forceinline__ float wave_sum(float v) {
  v += dpp_mov<0xB1>(v); v += dpp_mov<0x4E>(v); v += dpp_mov<0x124>(v); v += dpp_mov<0x128>(v);
  return xrow16_sum(v);
}
__device__ __forceinline__ float wave_max(float v) {
  v = fmaxf(v, dpp_mov<0xB1>(v)); v = fmaxf(v, dpp_mov<0x4E>(v)); v = fmaxf(v, dpp_mov<0x124>(v)); v = fmaxf(v, dpp_mov<0x128>(v));
  return xrow16_max(v);
}

typedef unsigned short bf16_t;
typedef __attribute__((ext_vector_type(8))) short bf16x8;
typedef __attribute__((ext_vector_type(16))) float f32x16;
typedef __attribute__((ext_vector_type(4))) float f32x4;

typedef __attribute__((ext_vector_type(2))) __bf16 bf16x2_t;
__device__ __forceinline__ unsigned f2bf(float f) { return (unsigned)__builtin_bit_cast(unsigned short, (__bf16)f); }
__device__ __forceinline__ unsigned pack2bf(float a, float b) { bf16x2_t v = {(__bf16)a, (__bf16)b}; return __builtin_bit_cast(unsigned, v); }
__device__ __forceinline__ float bf2f(unsigned short v) { return __uint_as_float(((unsigned)v) << 16); }

__device__ __forceinline__ int mod_index(int row) { return row < T ? row / S : 2; }


struct Params {
  const float* in[18];
  float* out;
  float* ws;
};

constexpr size_t XCD_BAR_WORDS_C = 3456;
constexpr size_t al256(size_t n) { return (n + 255) & ~(size_t)255; }
constexpr size_t OFF_BAR = 0;
constexpr size_t OFF_TAB = al256(XCD_BAR_WORDS_C * 4);
constexpr size_t OFF_M = OFF_TAB + al256(16384 * 4 + 128 * 16 * 2 * 4);
constexpr size_t OFF_WIN0 = OFF_M + al256(2 * 3 * 6144 * 4);
constexpr size_t OFF_WOUT0 = OFF_WIN0 + al256((size_t)2048 * 1024 * 2);
constexpr size_t OFF_WIN1 = OFF_WOUT0 + al256((size_t)1024 * 1024 * 2);
constexpr size_t OFF_WOUT1 = OFF_WIN1 + al256((size_t)1536 * 1024 * 2);
constexpr size_t OFF_WQ = OFF_WOUT1 + al256((size_t)1024 * 1024 * 2);
constexpr size_t OFF_SK = OFF_WQ + al256((size_t)2 * 2048 * 1024 * 2);
constexpr size_t OFF_UB = OFF_SK + al256((size_t)2 * 8 * 2 * 128 * 128 * 2);
constexpr size_t OFF_VB = OFF_UB + al256((size_t)2 * 16384 * 1024);
constexpr size_t OFF_USC = OFF_VB + al256((size_t)2 * 16384 * 1024);
constexpr size_t OFF_AB = OFF_USC + al256((size_t)4 * 16384 * 4);
constexpr size_t OFF_FT = OFF_AB + al256((size_t)R * 1024 * 2);
constexpr size_t OFF_BF = OFF_FT + al256((size_t)(256 * 128 + 128 * 128 + 64 * 128) * 2);
constexpr size_t OFF_BY = OFF_BF + al256((size_t)R * 2048 * 4);
constexpr size_t OFF_X1 = OFF_BY + al256((size_t)R * 1024 * 4);
constexpr size_t OFF_X2 = OFF_X1 + al256((size_t)R * 1024 * 4);
constexpr size_t OFF_END = OFF_X2 + al256((size_t)R * 1024 * 4);
constexpr size_t OFF_A1 = OFF_BY;
constexpr size_t OFF_VT0 = OFF_X2;
static_assert(OFF_END <= (size_t)512 * 1024 * 1024, "workspace overflow");

#define GRID_LOOP(var, n) for (int var = blockIdx.x; var < (n); var += gridDim.x)

__device__ __forceinline__ void ph_fft_tables(bf16_t* D1, bf16_t* D3, bf16_t* DcT) {
  const double TWO_PI = 6.283185307179586476925286766559;
  for (int i = blockIdx.x * 256 + threadIdx.x; i < 256 * 128 + 128 * 128 + 64 * 128; i += gridDim.x * 256) {
    if (i < 256 * 128) {
      int m = i >> 7, r = i & 127; int k1 = m >> 1, ri = m & 1;
      double a = TWO_PI * (double)((k1 * r) & 127) / 128.0;
      D1[i] = (bf16_t)f2bf(ri == 0 ? (float)cos(a) : (float)(-sin(a)));
    } else if (i < 256 * 128 + 128 * 128) {
      int j = i - 256 * 128; int m = j >> 7, kk = j & 127; int rip = m >> 6, k2 = m & 63; int c = kk >> 1, ri = kk & 1;
      double a = TWO_PI * (double)((k2 * c) & 63) / 64.0;
      double v = (rip == 0) ? (ri == 0 ? cos(a) : sin(a)) : (ri == 0 ? -sin(a) : cos(a));
      D3[j] = (bf16_t)f2bf((float)v);
    } else {
      int j = i - 256 * 128 - 128 * 128; int cp = j >> 7, kk = j & 127; int rip = kk >> 6, ch = kk & 63;
      double a = TWO_PI * (double)((ch * cp) & 63) / 64.0;
      DcT[j] = (bf16_t)f2bf((float)(rip == 0 ? cos(a) : sin(a)));
    }
  }
}
__device__ __forceinline__ void ph_rope_table(float* RT) {
  for (int i = blockIdx.x * 256 + threadIdx.x; i < 128 * 16; i += gridDim.x * 256) {
    int pos = i >> 4, f = i & 15;
    float inv_freq = powf(10000.0f, -(float)f / 16.0f);
    float ang = (float)pos * inv_freq;
    RT[2 * i] = cosf(ang); RT[2 * i + 1] = sinf(ang);
  }
}
__device__ __forceinline__ void ph_tables(float* tab) {
  for (int j = blockIdx.x * 256 + threadIdx.x; j < 8192; j += gridDim.x * 256) {
    double a = 6.283185307179586476925286766559 * (double)j / 8192.0;
    tab[j] = (float)cos(a);
    tab[8192 + j] = (float)sin(a);
  }
}
__device__ __forceinline__ void ph_ada(const float* __restrict__ c, const float* __restrict__ c_ctx, const float* __restrict__ ada_w,
                       const float* __restrict__ ada_b, float* __restrict__ M) {
  for (int gid = blockIdx.x * 256 + threadIdx.x; gid < 2 * 3 * 6144; gid += gridDim.x * 256) {
    int col = gid % 6144; int idx = (gid / 6144) % 3; int layer = gid / (3 * 6144);
    const float* vec = idx < 2 ? c + idx * D : c_ctx;
    const float* w = ada_w + (size_t)layer * D * 6144 + col;
    float acc = 0.f;
    for (int k = 0; k < D; ++k) {
      float x = vec[k];
      float sx = x / (1.f + expf(-x));
      acc += sx * w[(size_t)k * 6144];
    }
    M[gid] = acc + ada_b[layer * 6144 + col];
  }
}

__device__ __forceinline__ void ph_modulate(const float* __restrict__ xa, const float* __restrict__ xb, const float* __restrict__ M, int layer,
                            int jshift, int jscale, bf16_t* __restrict__ out, int nrows, float* red) {
  int tid = threadIdx.x;
  GRID_LOOP(row, nrows) {
    const float* x = row < T ? xa + (size_t)row * D : xb + (size_t)(row - T) * D;
    float v[4]; float s = 0.f;
#pragma unroll
    for (int i = 0; i < 4; ++i) { v[i] = x[tid + 256 * i]; s += v[i]; }
    s = wave_sum(s);
    __syncthreads();
    if ((tid & 63) == 0) red[tid >> 6] = s;
    __syncthreads();
    float mu = (red[0] + red[1] + red[2] + red[3]) * (1.f / D);
    float q = 0.f;
#pragma unroll
    for (int i = 0; i < 4; ++i) { float d = v[i] - mu; q += d * d; }
    q = wave_sum(q);
    if ((tid & 63) == 0) red[4 + (tid >> 6)] = q;
    __syncthreads();
    float var = (red[4] + red[5] + red[6] + red[7]) * (1.f / D);
    float rs = rsqrtf(var + LN_EPS);
    const float* m = M + ((size_t)layer * 3 + mod_index(row)) * 6144;
#pragma unroll
    for (int i = 0; i < 4; ++i) {
      int col = tid + 256 * i;
      float y = (v[i] - mu) * rs;
      out[(size_t)row * D + col] = (bf16_t)f2bf(y * (1.f + m[jscale * D + col]) + m[jshift * D + col]);
    }
  }
}

__device__ __forceinline__ void ph_post(const float* __restrict__ xa, const float* __restrict__ xb, const float* __restrict__ Y,
                        const float* __restrict__ M, int layer, int j, const float* __restrict__ g, const float* __restrict__ bb,
                        float* __restrict__ outa, float* __restrict__ outb, int nrows, float* red) {
  int tid = threadIdx.x;
  GRID_LOOP(row, nrows) {
    const float* x = row < T ? xa + (size_t)row * D : xb + (size_t)(row - T) * D;
    float* out = row < T ? outa + (size_t)row * D : outb + (size_t)(row - T) * D;
    const float* m = M + ((size_t)layer * 3 + mod_index(row)) * 6144 + j * D;
    float v[4]; float s = 0.f;
#pragma unroll
    for (int i = 0; i < 4; ++i) { int col = tid + 256 * i; v[i] = DN_ALPHA * x[col] + m[col] * Y[(size_t)row * D + col]; s += v[i]; }
    s = wave_sum(s);
    __syncthreads();
    if ((tid & 63) == 0) red[tid >> 6] = s;
    __syncthreads();
    float mu = (red[0] + red[1] + red[2] + red[3]) * (1.f / D);
    float q = 0.f;
#pragma unroll
    for (int i = 0; i < 4; ++i) { float d = v[i] - mu; q += d * d; }
    q = wave_sum(q);
    if ((tid & 63) == 0) red[4 + (tid >> 6)] = q;
    __syncthreads();
    float var = (red[4] + red[5] + red[6] + red[7]) * (1.f / D);
    float rs = rsqrtf(var + LN_EPS);
#pragma unroll
    for (int i = 0; i < 4; ++i) {
      int col = tid + 256 * i;
      out[col] = (v[i] - mu) * rs * g[col] + bb[col];
    }
  }
}

struct ARow { const float* A; int lda; __device__ float operator()(int m, int k) const { return A[(size_t)m * lda + k]; } };
struct BRow { const float* B; int ldb; __device__ float operator()(int k, int n) const { return B[(size_t)k * ldb + n]; } };
struct CRow { float* C; int ldc; float scale; __device__ void operator()(int m, int n, float v) const { C[(size_t)m * ldc + n] = v * scale; } };
struct CRowB { bf16_t* C; int ldc; float scale; __device__ void operator()(int m, int n, float v) const { C[(size_t)m * ldc + n] = (bf16_t)f2bf(v * scale); } };
struct ADft { const float* tab; int Sn; int stride; __device__ float operator()(int m, int k) const {
    int t = k & (Sn - 1); int idx = ((m * t) & (Sn - 1)) * stride;
    return k < Sn ? tab[idx] : -tab[8192 + idx]; } };
struct BPQ { const float* PQ; int rowbase; int Sn; __device__ float operator()(int k, int n) const {
    int t = k & (Sn - 1); return PQ[(size_t)(rowbase + t) * 1024 + (k >= Sn ? 512 : 0) + n]; } };

template <class AF, class BF, class CF>
__device__ __forceinline__ void ph_gemm(AF af, BF bf, CF cf, int M, int N, int K, float* sm) {
  float (*sA)[68] = (float (*)[68])sm;
  float (*sB)[68] = (float (*)[68])(sm + 16 * 68);
  int tid = threadIdx.x; int tx = tid & 15, ty = tid >> 4;
  int ntn = N / 64; int ntiles = (M / 64) * ntn;
  GRID_LOOP(tile, ntiles) {
    int m0 = (tile / ntn) * 64, n0 = (tile % ntn) * 64;
    float acc[4][4];
#pragma unroll
    for (int i = 0; i < 4; ++i)
#pragma unroll
      for (int j = 0; j < 4; ++j) acc[i][j] = 0.f;
    for (int k0 = 0; k0 < K; k0 += 16) {
      __syncthreads();
#pragma unroll
      for (int i = 0; i < 4; ++i) { int e = tid + 256 * i; int m = e >> 4, k = e & 15; sA[k][m] = af(m0 + m, k0 + k); }
#pragma unroll
      for (int i = 0; i < 4; ++i) { int e = tid + 256 * i; int k = e >> 6, n = e & 63; sB[k][n] = bf(k0 + k, n0 + n); }
      __syncthreads();
#pragma unroll
      for (int k = 0; k < 16; ++k) {
        float a[4], b[4];
#pragma unroll
        for (int i = 0; i < 4; ++i) { a[i] = sA[k][ty * 4 + i]; b[i] = sB[k][tx * 4 + i]; }
#pragma unroll
        for (int i = 0; i < 4; ++i)
#pragma unroll
          for (int j = 0; j < 4; ++j) acc[i][j] += a[i] * b[j];
      }
    }
#pragma unroll
    for (int i = 0; i < 4; ++i)
#pragma unroll
      for (int j = 0; j < 4; ++j) cf(m0 + ty * 4 + i, n0 + tx * 4 + j, acc[i][j]);
  }
}


__device__ __forceinline__ void ph_transpose_w(const float* __restrict__ W, int K, int N, bf16_t* __restrict__ Wt, float* sm) {
  int tid = threadIdx.x;
  int tk = K / 64, tn = N / 64;
  GRID_LOOP(tile, tk * tn) {
    int k0 = (tile / tn) * 64, n0 = (tile % tn) * 64;
    __syncthreads();
#pragma unroll
    for (int i = 0; i < 16; ++i) { int e = tid + 256 * i; int k = e >> 6, n = e & 63; sm[k * 65 + n] = W[(size_t)(k0 + k) * N + n0 + n]; }
    __syncthreads();
#pragma unroll
    for (int i = 0; i < 2; ++i) {
      int e = tid + 256 * i; int n = e >> 3, kc = e & 7;
      unsigned w[4];
#pragma unroll
      for (int j = 0; j < 4; ++j) w[j] = pack2bf(sm[(kc * 8 + 2 * j) * 65 + n], sm[(kc * 8 + 2 * j + 1) * 65 + n]);
      *(uint4*)(Wt + (size_t)(n0 + n) * K + k0 + kc * 8) = make_uint4(w[0], w[1], w[2], w[3]);
    }
  }
}
__device__ __forceinline__ void ph_convert(const float* __restrict__ src, bf16_t* __restrict__ dst, size_t n8) {
  for (size_t i = (size_t)blockIdx.x * 256 + threadIdx.x; i < n8; i += (size_t)gridDim.x * 256) {
    float4 a = ((const float4*)src)[2 * i], b = ((const float4*)src)[2 * i + 1];
    ((uint4*)dst)[i] = make_uint4(pack2bf(a.x, a.y), pack2bf(a.z, a.w), pack2bf(b.x, b.y), pack2bf(b.z, b.w));
  }
}

__device__ __forceinline__ void gemm_stage(const bf16_t* __restrict__ A, int lda, int k0, char* lds, int tid) {
#pragma unroll
  for (int i = 0; i < 4; ++i) {
    int q = tid + 256 * i; int row = q >> 3, p = q & 7; int c = p ^ ((row >> 1) & 7);
    const bf16_t* src = A + (size_t)row * lda + k0 + c * 8;
    __builtin_amdgcn_global_load_lds((const unsigned*)src, (unsigned*)(lds + q * 16), 16, 0, 0);
  }
}
struct EpiF32 {
  float* C; int ldc; float scale;
  __device__ __forceinline__ void operator()(int m0, int n0, int wm, int wn, f32x16 (&acc)[2][2], int tid, char* smem) const {
    int lane = tid & 63;
    float* t = (float*)smem;
    int rbase = wm * 64 + 4 * (lane >> 5), cbase = wn * 64 + (lane & 31);
#pragma unroll
    for (int mi = 0; mi < 2; ++mi)
#pragma unroll
      for (int ni = 0; ni < 2; ++ni)
#pragma unroll
        for (int r = 0; r < 16; ++r)
          t[(rbase + mi * 32 + (r & 3) + 8 * (r >> 2)) * 128 + cbase + ni * 32] = acc[mi][ni][r] * scale;
    __syncthreads();
    float* dst = C + (size_t)(m0 + (tid >> 5)) * ldc + n0 + (tid & 31) * 4;
    const float* src = t + (tid >> 5) * 128 + (tid & 31) * 4;
#pragma unroll 4
    for (int i = 0; i < 16; ++i) {
      *(float4*)dst = *(const float4*)src;
      dst += (size_t)8 * ldc; src += 8 * 128;
    }
  }
};
struct EpiQKV0 {
  bf16_t* FQKV; bf16_t* VT;
  __device__ __forceinline__ void operator()(int m0, int n0, int wm, int wn, f32x16 (&acc)[2][2], int tid, char* smem) const {
    int lane = tid & 63;
    bf16_t* t = (bf16_t*)smem;
    int rbase = wm * 64 + 4 * (lane >> 5), cbase = wn * 64 + (lane & 31);
#pragma unroll
    for (int mi = 0; mi < 2; ++mi)
#pragma unroll
      for (int ni = 0; ni < 2; ++ni)
#pragma unroll
        for (int r = 0; r < 16; ++r)
          t[(rbase + mi * 32 + (r & 3) + 8 * (r >> 2)) * 136 + cbase + ni * 32] = (bf16_t)f2bf(acc[mi][ni][r]);
    __syncthreads();
    {
      bf16_t* dst = FQKV + (size_t)(m0 + (tid >> 4)) * 2048 + n0 + (tid & 15) * 8;
      const bf16_t* src = t + (tid >> 4) * 136 + (tid & 15) * 8;
#pragma unroll 4
      for (int i = 0; i < 8; ++i) {
        *(uint4*)dst = *(const uint4*)src;
        dst += (size_t)16 * 2048; src += 16 * 136;
      }
    }
    if (n0 >= 1536) {
      int col = tid >> 1, half = tid & 1;
      int hd = (n0 - 1536) / 64 + (col >> 6), d = col & 63;
      bf16_t* dst;
      if (m0 < T) { int b = m0 / S, t0 = m0 % S; dst = VT + (((size_t)b * 8 + hd) * 64 + d) * S + t0 + half * 64; }
      else { int mm = m0 - T; int b = mm / CL, l0 = mm % CL; dst = VT + (size_t)NB * 8 * 64 * S + (((size_t)b * 8 + hd) * 64 + d) * CL + l0 + half * 64; }
      const bf16_t* src = t + (half * 64) * 136 + col;
#pragma unroll
      for (int i = 0; i < 8; ++i) {
        unsigned wv[4];
#pragma unroll
        for (int j = 0; j < 4; ++j) wv[j] = (unsigned)src[(i * 8 + 2 * j) * 136] | ((unsigned)src[(i * 8 + 2 * j + 1) * 136] << 16);
        *(uint4*)(dst + i * 8) = make_uint4(wv[0], wv[1], wv[2], wv[3]);
      }
    }
  }
};
struct EpiBf16 {
  bf16_t* C; int ldc;
  __device__ __forceinline__ void operator()(int m0, int n0, int wm, int wn, f32x16 (&acc)[2][2], int tid, char* smem) const {
    int lane = tid & 63;
    asm volatile("" : "+v"(lane));
    bf16_t* t = (bf16_t*)smem;
    {
      bf16_t* tw = t + (wm * 64 + 4 * (lane >> 5)) * 136 + wn * 64 + (lane & 31);
#pragma unroll
      for (int mi = 0; mi < 2; ++mi)
#pragma unroll
        for (int ni = 0; ni < 2; ++ni)
#pragma unroll
          for (int r = 0; r < 16; ++r)
            tw[(mi * 32 + (r & 3) + 8 * (r >> 2)) * 136 + ni * 32] = (bf16_t)f2bf(acc[mi][ni][r]);
    }
    __syncthreads();
    bf16_t* dst = C + (size_t)(m0 + (tid >> 4)) * ldc + n0 + (tid & 15) * 8;
    const bf16_t* src = t + (tid >> 4) * 136 + (tid & 15) * 8;
#pragma unroll 4
    for (int i = 0; i < 8; ++i) {
      *(uint4*)dst = *(const uint4*)src;
      dst += (size_t)16 * ldc; src += 16 * 136;
    }
  }
};
struct EpiQKV1 {
  bf16_t* Q1; bf16_t* K1; bf16_t* VT; const float* RT;
  __device__ __forceinline__ void operator()(int m0, int n0, int wm, int wn, f32x16 (&acc)[2][2], int tid, char* smem) const {
    int lane = tid & 63;
    asm volatile("" : "+v"(lane));
    bf16_t* t = (bf16_t*)smem;
    if (n0 < 1280 && m0 < T) {
      int i = lane & 31; int f = i & 15;
#pragma unroll
      for (int mi = 0; mi < 2; ++mi)
#pragma unroll
        for (int r = 0; r < 16; ++r) {
          int row = m0 + wm * 64 + 4 * (lane >> 5) + mi * 32 + (r & 3) + 8 * (r >> 2);
          int tt = row & (S - 1);
          int pos = (i < 16) ? (tt >> 6) : (tt & 63);
          float2 cs = *(const float2*)(RT + 2 * (pos * 16 + f));
          float x1 = acc[mi][0][r], x2 = acc[mi][1][r];
          acc[mi][0][r] = x1 * cs.x - x2 * cs.y;
          acc[mi][1][r] = x1 * cs.y + x2 * cs.x;
        }
    }
    {
      bf16_t* tw = t + (wm * 64 + 4 * (lane >> 5)) * 136 + wn * 64 + (lane & 31);
#pragma unroll
      for (int mi = 0; mi < 2; ++mi)
#pragma unroll
        for (int ni = 0; ni < 2; ++ni)
#pragma unroll
          for (int r = 0; r < 16; ++r)
            tw[(mi * 32 + (r & 3) + 8 * (r >> 2)) * 136 + ni * 32] = (bf16_t)f2bf(acc[mi][ni][r]);
    }
    __syncthreads();
    if (n0 < 1280) {
      bf16_t* dst; int ld;
      if (n0 < 1024) { dst = Q1 + (size_t)(m0 + (tid >> 4)) * 1024 + n0 + (tid & 15) * 8; ld = 1024; }
      else { dst = K1 + (size_t)(m0 + (tid >> 4)) * 256 + (n0 - 1024) + (tid & 15) * 8; ld = 256; }
      if (n0 >= 1024 || m0 < T) {
        const bf16_t* src = t + (tid >> 4) * 136 + (tid & 15) * 8;
#pragma unroll 4
        for (int i = 0; i < 8; ++i) {
          *(uint4*)dst = *(const uint4*)src;
          dst += (size_t)16 * ld; src += 16 * 136;
        }
      }
    } else {
      int col = tid >> 1, half = tid & 1;
      int hd = (n0 - 1280) / 64 + (col >> 6), d = col & 63;
      bf16_t* dst;
      if (m0 < T) { int b = m0 / S, t0 = m0 % S; dst = VT + (((size_t)b * 4 + hd) * 64 + d) * S + t0 + half * 64; }
      else { int mm = m0 - T; int b = mm / CL, l0 = mm % CL; dst = VT + (size_t)NB * 4 * 64 * S + (((size_t)b * 4 + hd) * 64 + d) * CL + l0 + half * 64; }
      const bf16_t* src = t + (half * 64) * 136 + col;
#pragma unroll
      for (int i = 0; i < 8; ++i) {
        unsigned wv[4];
#pragma unroll
        for (int j = 0; j < 4; ++j) wv[j] = (unsigned)src[(i * 8 + 2 * j) * 136] | ((unsigned)src[(i * 8 + 2 * j + 1) * 136] << 16);
        *(uint4*)(dst + i * 8) = make_uint4(wv[0], wv[1], wv[2], wv[3]);
      }
    }
  }
};
__device__ __forceinline__ void gemm_tile_mainloop(const bf16_t* __restrict__ Ag, int lda, const bf16_t* __restrict__ Bg, int ldb, int KT,
                                                   f32x16 (&acc)[2][2], char* smem) {
  int tid = threadIdx.x;
  asm volatile("" : "+v"(tid));
  int lane = tid & 63, wave = __builtin_amdgcn_readfirstlane(tid >> 6), wm = wave >> 1, wn = wave & 1;
#pragma unroll
  for (int mi = 0; mi < 2; ++mi)
#pragma unroll
    for (int ni = 0; ni < 2; ++ni)
#pragma unroll
      for (int r = 0; r < 16; ++r) acc[mi][ni][r] = 0.f;
  __syncthreads();
  gemm_stage(Ag, lda, 0, smem, tid); gemm_stage(Bg, ldb, 0, smem + 16384, tid);
  for (int kt = 0; kt < KT; ++kt) {
    asm volatile("s_waitcnt vmcnt(0)" ::: "memory");
    __syncthreads();
    char* cur = smem + (kt & 1) * 32768;
    if (kt + 1 < KT) {
      char* nxt = smem + ((kt + 1) & 1) * 32768;
      gemm_stage(Ag, lda, (kt + 1) * 64, nxt, tid); gemm_stage(Bg, ldb, (kt + 1) * 64, nxt + 16384, tid);
    }
#pragma unroll
    for (int s4 = 0; s4 < 4; ++s4) {
      bf16x8 a[2], b[2];
      int c = 2 * s4 + (lane >> 5);
#pragma unroll
      for (int mi = 0; mi < 2; ++mi) { int row = wm * 64 + mi * 32 + (lane & 31); a[mi] = *(const bf16x8*)(cur + row * 128 + ((c ^ ((row >> 1) & 7)) << 4)); }
#pragma unroll
      for (int ni = 0; ni < 2; ++ni) { int row = wn * 64 + ni * 32 + (lane & 31); b[ni] = *(const bf16x8*)(cur + 16384 + row * 128 + ((c ^ ((row >> 1) & 7)) << 4)); }
#pragma unroll
      for (int mi = 0; mi < 2; ++mi)
#pragma unroll
        for (int ni = 0; ni < 2; ++ni) acc[mi][ni] = __builtin_amdgcn_mfma_f32_32x32x16_bf16(a[mi], b[ni], acc[mi][ni], 0, 0, 0);
    }
  }
  __syncthreads();
}
template <class Epi>
__device__ __forceinline__ void ph_gemm_bf16(const bf16_t* __restrict__ A, int lda, const bf16_t* __restrict__ Bt, int ldb, int M, int N, int K,
                             Epi epi, char* smem) {
  int tid = threadIdx.x, wave = __builtin_amdgcn_readfirstlane(tid >> 6), wm = wave >> 1, wn = wave & 1;
  int ntn = N / 128, ntiles = (M / 128) * ntn;
  int KT = K / 64;
  (void)ntiles;
  int nb8 = gridDim.x >> 3, xq = blockIdx.x & 7, xm = xq >> 1, xn = xq & 1;
  int MT = M / 128, mq = (MT + 3) >> 2, nh = ntn >> 1;
  for (int lt = (int)(blockIdx.x >> 3); lt < mq * nh; lt += nb8) {
    int mt = xm * mq + lt / nh, nt = xn * nh + lt % nh;
    if (mt >= MT) continue;
    f32x16 acc[2][2];
    gemm_tile_mainloop(A + (size_t)mt * 128 * lda, lda, Bt + (size_t)nt * 128 * ldb, ldb, KT, acc, smem);
    epi(mt * 128, nt * 128, wm, wn, acc, tid, smem);
  }
}


#define RAW_BARRIER() do { asm volatile("s_waitcnt lgkmcnt(0)" ::: "memory"); __builtin_amdgcn_s_barrier(); } while (0)
__device__ __forceinline__ void gemm_stage32x(const bf16_t* __restrict__ Ag, int lda, const bf16_t* __restrict__ Bg, int ldb, int k0, char* lds, int tid) {
#pragma unroll
  for (int i = 0; i < 2; ++i) { int q = tid + 256 * i; int row = q >> 2, p = q & 3; int c = p ^ ((row >> 2) & 3);
    __builtin_amdgcn_global_load_lds((const unsigned*)(Ag + (size_t)row * lda + k0 + c * 8), (unsigned*)(lds + q * 16), 16, 0, 0); }
#pragma unroll
  for (int i = 0; i < 2; ++i) { int q = tid + 256 * i; int row = q >> 2, p = q & 3; int c = p ^ ((row >> 2) & 3);
    __builtin_amdgcn_global_load_lds((const unsigned*)(Bg + (size_t)row * ldb + k0 + c * 8), (unsigned*)(lds + 8192 + q * 16), 16, 0, 0); }
}
__device__ __forceinline__ void gemm_tile_mainloop3(const bf16_t* __restrict__ Ag, int lda, const bf16_t* __restrict__ Bg, int ldb, int KT,
                                                    f32x16 (&acc)[2][2], char* smem) {
  int tid = threadIdx.x;
  asm volatile("" : "+v"(tid));
  int lane = tid & 63, wave = tid >> 6, wm = wave >> 1, wn = wave & 1;
#pragma unroll
  for (int mi = 0; mi < 2; ++mi)
#pragma unroll
    for (int ni = 0; ni < 2; ++ni)
#pragma unroll
      for (int r = 0; r < 16; ++r) acc[mi][ni][r] = 0.f;
  __syncthreads();
  gemm_stage32x(Ag, lda, Bg, ldb, 0, smem, tid);
  gemm_stage32x(Ag, lda, Bg, ldb, 32, smem + 16384, tid);
  gemm_stage32x(Ag, lda, Bg, ldb, 64, smem + 32768, tid);
  for (int kt = 0; kt < KT; ++kt) {
    if (kt + 2 < KT) asm volatile("s_waitcnt vmcnt(8)" ::: "memory");
    else if (kt + 1 < KT) asm volatile("s_waitcnt vmcnt(4)" ::: "memory");
    else asm volatile("s_waitcnt vmcnt(0)" ::: "memory");
    RAW_BARRIER();
    if (kt + 3 < KT) gemm_stage32x(Ag, lda, Bg, ldb, (kt + 3) * 32, smem + ((kt + 3) & 3) * 16384, tid);
    char* cur = smem + (kt & 3) * 16384;
#pragma unroll
    for (int s2 = 0; s2 < 2; ++s2) {
      bf16x8 a[2], b[2];
      int c = 2 * s2 + (lane >> 5);
#pragma unroll
      for (int mi = 0; mi < 2; ++mi) { int row = wm * 64 + mi * 32 + (lane & 31); a[mi] = *(const bf16x8*)(cur + row * 64 + ((c ^ ((row >> 2) & 3)) << 4)); }
#pragma unroll
      for (int ni = 0; ni < 2; ++ni) { int row = wn * 64 + ni * 32 + (lane & 31); b[ni] = *(const bf16x8*)(cur + 8192 + row * 64 + ((c ^ ((row >> 2) & 3)) << 4)); }
#pragma unroll
      for (int mi = 0; mi < 2; ++mi)
#pragma unroll
        for (int ni = 0; ni < 2; ++ni) acc[mi][ni] = __builtin_amdgcn_mfma_f32_32x32x16_bf16(a[mi], b[ni], acc[mi][ni], 0, 0, 0);
    }
  }
  __syncthreads();
}
template <class Epi>
__device__ __forceinline__ void ph_gemm_bf16_3(const bf16_t* __restrict__ A, int lda, const bf16_t* __restrict__ Bt, int ldb, int M, int N, int K,
                             Epi epi, char* smem) {
  int tid = threadIdx.x, wave = __builtin_amdgcn_readfirstlane(tid >> 6), wm = wave >> 1, wn = wave & 1;
  int ntn = N / 128, ntiles = (M / 128) * ntn;
  GRID_LOOP(tile, ntiles) {
    int mt = tile / ntn, nt = tile % ntn;
    f32x16 acc[2][2];
    gemm_tile_mainloop3(A + (size_t)mt * 128 * lda, lda, Bt + (size_t)nt * 128 * ldb, ldb, K / 32, acc, smem);
    epi(mt * 128, nt * 128, wm, wn, acc, tid, smem);
  }
}
__device__ __forceinline__ void ins16(float (&L)[16], float x) {
#pragma unroll
  for (int j = 15; j >= 1; --j) L[j] = __builtin_amdgcn_fmed3f(L[j - 1], L[j], x);
  L[0] = fmaxf(L[0], x);
}
__device__ __forceinline__ void stage_tile128(const bf16_t* __restrict__ src, int ld, char* lds, int tid) {
#pragma unroll
  for (int i = 0; i < 8; ++i) {
    int q = tid + 256 * i; int row = q >> 4, p = q & 15; int c = p ^ (row & 15);
    __builtin_amdgcn_global_load_lds((const unsigned*)(src + (size_t)row * ld + c * 8), (unsigned*)(lds + q * 16), 16, 0, 0);
  }
}
__device__ __forceinline__ void ph_peer_select(const bf16_t* __restrict__ H, const bf16_t* __restrict__ WQl, const bf16_t* __restrict__ SKl,
                                               int* __restrict__ EXP, float* __restrict__ GATE, int nrows, char* smem) {
  int tid = threadIdx.x, w = __builtin_amdgcn_readfirstlane(tid >> 6), wm = w >> 1, wn = w & 1;
  bf16_t* Qs = (bf16_t*)smem;
  int* KL = (int*)(smem + 36864);
  int nb8 = gridDim.x >> 3, xq = blockIdx.x & 7, xm = xq >> 1, xn = xq & 1;
  int MT = nrows / 128, mq = (MT + 3) >> 2;
  for (int lu = (int)(blockIdx.x >> 3); lu < mq * 4; lu += nb8) {
    int mt = xm * mq + (lu >> 2), h = xn * 4 + (lu & 3);
    if (mt >= MT) continue;
    float L0[16], L1[16];
#pragma unroll
    for (int p = 0; p < 2; ++p) {
      f32x16 acc[2][2];
      gemm_tile_mainloop(H + (size_t)mt * 128 * 1024, 1024, WQl + (size_t)(h * 256 + p * 128) * 1024, 1024, 16, acc, smem);
      int lane = tid & 63;
      asm volatile("" : "+v"(lane));
      {
        bf16_t* qw = Qs + (wm * 64 + 4 * (lane >> 5)) * 136 + wn * 64 + (lane & 31);
#pragma unroll
        for (int mi = 0; mi < 2; ++mi)
#pragma unroll
          for (int ni = 0; ni < 2; ++ni)
#pragma unroll
            for (int r = 0; r < 16; ++r)
              qw[(mi * 32 + (r & 3) + 8 * (r >> 2)) * 136 + ni * 32] = (bf16_t)f2bf(acc[mi][ni][r]);
      }
      __syncthreads();
      f32x16 sc[4];
#pragma unroll
      for (int m4 = 0; m4 < 4; ++m4)
#pragma unroll
        for (int r = 0; r < 16; ++r) sc[m4][r] = 0.f;
      {
        const bf16_t* qrow = Qs + (32 * w + (lane & 31)) * 136 + 8 * (lane >> 5);
        const bf16_t* krow = SKl + (size_t)(h * 2 + p) * 128 * 128 + (lane & 31) * 128 + 8 * (lane >> 5);
#pragma unroll
        for (int s8 = 0; s8 < 8; ++s8) {
          bf16x8 bq = *(const bf16x8*)(qrow + 16 * s8);
#pragma unroll
          for (int m4 = 0; m4 < 4; ++m4) {
            bf16x8 ak = *(const bf16x8*)(krow + m4 * 32 * 128 + 16 * s8);
            sc[m4] = __builtin_amdgcn_mfma_f32_32x32x16_bf16(ak, bq, sc[m4], 0, 0, 0);
          }
        }
      }
      float L[16];
#pragma unroll
      for (int j = 0; j < 16; ++j) L[j] = -INFINITY;
      unsigned kb = 4u * (unsigned)(lane >> 5);
#pragma unroll
      for (int m4 = 0; m4 < 4; ++m4)
#pragma unroll
        for (int r = 0; r < 16; ++r) {
          unsigned key = kb + (unsigned)(32 * m4 + (r & 3) + 8 * (r >> 2));
          float x = __uint_as_float((__float_as_uint(sc[m4][r]) & 0xFFFFFF80u) | key);
          ins16(L, x);
        }
      float P[16];
#pragma unroll
      for (int j = 0; j < 16; ++j) P[j] = __shfl_xor(L[j], 32);
#pragma unroll
      for (int j = 0; j < 16; ++j) ins16(L, P[j]);
      if (p == 0) {
#pragma unroll
        for (int j = 0; j < 16; ++j) L0[j] = L[j];
      } else {
#pragma unroll
        for (int j = 0; j < 16; ++j) L1[j] = L[j];
      }
    }
    float C[16];
#pragma unroll
    for (int j = 0; j < 16; ++j) C[j] = -INFINITY;
#pragma unroll
    for (int a = 0; a < 16; ++a)
#pragma unroll
      for (int b = 0; b < 16; ++b)
        if ((a + 1) * (b + 1) <= 16) {
          float sa = __uint_as_float(__float_as_uint(L0[a]) & 0xFFFFFF80u);
          float sb = __uint_as_float(__float_as_uint(L1[b]) & 0xFFFFFF80u);
          float x = __uint_as_float((__float_as_uint(sa + sb) & 0xFFFFFF00u) | (unsigned)(a * 16 + b));
          ins16(C, x);
        }
    int lane = tid & 63;
    asm volatile("" : "+v"(lane));
    int token = 32 * w + (lane & 31);
    if (lane < 32) {
#pragma unroll
      for (int j = 0; j < 16; ++j) { KL[token * 32 + j] = (int)(__float_as_uint(L0[j]) & 0x7Fu); KL[token * 32 + 16 + j] = (int)(__float_as_uint(L1[j]) & 0x7Fu); }
    }
    __syncthreads();
    if (lane < 32) {
      float c0 = __uint_as_float(__float_as_uint(C[0]) & 0xFFFFFF00u);
      float ev[16]; float sum = 0.f; int ex[16];
#pragma unroll
      for (int j = 0; j < 16; ++j) {
        unsigned bits = __float_as_uint(C[j]);
        float cv = __uint_as_float(bits & 0xFFFFFF00u);
        ev[j] = __expf(cv - c0); sum += ev[j];
        int a = (bits >> 4) & 15, b = bits & 15;
        ex[j] = KL[token * 32 + a] * 128 + KL[token * 32 + 16 + b];
      }
      float inv = 1.f / sum;
      size_t o = (size_t)(mt * 128 + token) * 128 + h * 16;
#pragma unroll
      for (int j = 0; j < 16; j += 4) {
        *(int4*)(EXP + o + j) = make_int4(ex[j], ex[j + 1], ex[j + 2], ex[j + 3]);
        *(float4*)(GATE + o + j) = make_float4(ev[j] * inv, ev[j + 1] * inv, ev[j + 2] * inv, ev[j + 3] * inv);
      }
    }
  }
}

__device__ __forceinline__ void fft1_unit(int u, const bf16_t* __restrict__ FQKV, const bf16_t* __restrict__ D1, const float* __restrict__ TAB,
                          bf16_t* __restrict__ A1, char* smem) {
  int tid = threadIdx.x, lane = tid & 63, w = __builtin_amdgcn_readfirstlane(tid >> 6);
  int g = u & 7, c = (u >> 3) & 63, b = u >> 9;
  bf16_t* Bt = (bf16_t*)smem;
  __syncthreads();
  {
    int r = tid >> 1, half = tid & 1;
    const uint4* src = (const uint4*)(FQKV + (size_t)(b * S + 64 * r + c) * 2048 + g * 64 + half * 32);
    unsigned wv[16];
#pragma unroll
    for (int i = 0; i < 4; ++i) { uint4 v = src[i]; wv[4 * i] = v.x; wv[4 * i + 1] = v.y; wv[4 * i + 2] = v.z; wv[4 * i + 3] = v.w; }
#pragma unroll
    for (int j = 0; j < 32; ++j) {
      unsigned e = (j & 1) ? (wv[j >> 1] >> 16) : (wv[j >> 1] & 0xffffu);
      Bt[(half * 32 + j) * 136 + r] = (bf16_t)e;
    }
  }
  __syncthreads();
  f32x16 acc[2][2];
#pragma unroll
  for (int mi = 0; mi < 2; ++mi)
#pragma unroll
    for (int ni = 0; ni < 2; ++ni)
#pragma unroll
      for (int r = 0; r < 16; ++r) acc[mi][ni][r] = 0.f;
#pragma unroll
  for (int s8 = 0; s8 < 8; ++s8) {
    bf16x8 a[2], bb[2];
    int ko = 16 * s8 + 8 * (lane >> 5);
#pragma unroll
    for (int mi = 0; mi < 2; ++mi) a[mi] = *(const bf16x8*)(D1 + (64 * w + 32 * mi + (lane & 31)) * 128 + ko);
#pragma unroll
    for (int ni = 0; ni < 2; ++ni) bb[ni] = *(const bf16x8*)(Bt + (32 * ni + (lane & 31)) * 136 + ko);
#pragma unroll
    for (int mi = 0; mi < 2; ++mi)
#pragma unroll
      for (int ni = 0; ni < 2; ++ni) acc[mi][ni] = __builtin_amdgcn_mfma_f32_32x32x16_bf16(a[mi], bb[ni], acc[mi][ni], 0, 0, 0);
  }
  bf16_t* Ot = (bf16_t*)(smem + 17408);
#pragma unroll
  for (int mi = 0; mi < 2; ++mi)
#pragma unroll
    for (int j = 0; j < 8; ++j) {
      int m = 64 * w + 32 * mi + ((2 * j) & 3) + 8 * ((2 * j) >> 2) + 4 * (lane >> 5);
      int k1 = m >> 1;
      int idx = (k1 * c) & 8191;
      float cs = TAB[idx], sn = TAB[8192 + idx];
#pragma unroll
      for (int ni = 0; ni < 2; ++ni) {
        float re = acc[mi][ni][2 * j], im = acc[mi][ni][2 * j + 1];
        float re2 = re * cs + im * sn, im2 = im * cs - re * sn;
        bf16_t* dst = Ot + m * 72 + 32 * ni + (lane & 31);
        dst[0] = (bf16_t)f2bf(re2); dst[72] = (bf16_t)f2bf(im2);
      }
    }
  __syncthreads();
  {
    bf16_t* base = A1 + (((size_t)b * 64 + c) * 128) * 2 * 512 + g * 64;
#pragma unroll
    for (int i = 0; i < 8; ++i) {
      int q = tid + 256 * i; int m = q >> 3, ch8 = q & 7;
      *(uint4*)(base + (size_t)m * 512 + ch8 * 8) = *(const uint4*)(Ot + m * 72 + ch8 * 8);
    }
  }
}

__device__ __forceinline__ void fft3_unit(int u, int mode, const bf16_t* __restrict__ FQKV, const bf16_t* __restrict__ A1, const bf16_t* __restrict__ D3,
                          const bf16_t* __restrict__ DcT, const float* __restrict__ TAB, bf16_t* __restrict__ MIX, char* smem) {
  int tid = threadIdx.x, lane = tid & 63, w = __builtin_amdgcn_readfirstlane(tid >> 6);
  bf16_t* Bt = (bf16_t*)smem;
  bf16_t* Xs = (bf16_t*)(smem + 17408);
  int g = u & 7, k1, b, nk1, rowbase; float norm;
  __syncthreads();
  if (mode == 0) {
    k1 = (u >> 3) & 127; b = u >> 10; nk1 = 128; rowbase = b * S; norm = 1.f / 724.0773439350247f;
    int kk = tid >> 1, half = tid & 1; int c = kk >> 1, ri = kk & 1;
    const uint4* src = (const uint4*)(A1 + ((((size_t)b * 64 + c) * 128 + k1) * 2 + ri) * 512 + g * 64 + half * 32);
    unsigned wv[16];
#pragma unroll
    for (int i = 0; i < 4; ++i) { uint4 v = src[i]; wv[4 * i] = v.x; wv[4 * i + 1] = v.y; wv[4 * i + 2] = v.z; wv[4 * i + 3] = v.w; }
#pragma unroll
    for (int j = 0; j < 32; ++j) {
      unsigned e = (j & 1) ? (wv[j >> 1] >> 16) : (wv[j >> 1] & 0xffffu);
      Bt[(half * 32 + j) * 136 + kk] = (bf16_t)e;
    }
  } else {
    k1 = (u >> 3) & 3; b = u >> 5; nk1 = 4; rowbase = T + b * CL; norm = 1.f / 128.f;
    int c = tid >> 2, q4 = tid & 3;
    float re[16], im[16];
#pragma unroll
    for (int j = 0; j < 16; ++j) { re[j] = 0.f; im[j] = 0.f; }
#pragma unroll
    for (int r = 0; r < 4; ++r) {
      const uint4* src = (const uint4*)(FQKV + (size_t)(rowbase + 64 * r + c) * 2048 + g * 64 + q4 * 16);
      uint4 v0 = src[0], v1 = src[1];
      unsigned wv[8] = {v0.x, v0.y, v0.z, v0.w, v1.x, v1.y, v1.z, v1.w};
      int ph = (k1 * r) & 3;
      float cr = (ph == 0) ? 1.f : (ph == 2 ? -1.f : 0.f);
      float ci = (ph == 1) ? -1.f : (ph == 3 ? 1.f : 0.f);
#pragma unroll
      for (int j = 0; j < 16; ++j) {
        float x = bf2f((unsigned short)((j & 1) ? (wv[j >> 1] >> 16) : (wv[j >> 1] & 0xffffu)));
        re[j] += x * cr; im[j] += x * ci;
      }
    }
    int idx = (k1 * c * 32) & 8191;
    float cs = TAB[idx], sn = TAB[8192 + idx];
#pragma unroll
    for (int j = 0; j < 16; ++j) {
      float re2 = re[j] * cs + im[j] * sn, im2 = im[j] * cs - re[j] * sn;
      *(unsigned*)(Bt + (q4 * 16 + j) * 136 + 2 * c) = pack2bf(re2, im2);
    }
  }
  __syncthreads();
  {
    f32x16 acc[2];
#pragma unroll
    for (int ni = 0; ni < 2; ++ni)
#pragma unroll
      for (int r = 0; r < 16; ++r) acc[ni][r] = 0.f;
#pragma unroll
    for (int s8 = 0; s8 < 8; ++s8) {
      int ko = 16 * s8 + 8 * (lane >> 5);
      bf16x8 a = *(const bf16x8*)(D3 + (32 * w + (lane & 31)) * 128 + ko);
#pragma unroll
      for (int ni = 0; ni < 2; ++ni) {
        bf16x8 bb = *(const bf16x8*)(Bt + (32 * ni + (lane & 31)) * 136 + ko);
        acc[ni] = __builtin_amdgcn_mfma_f32_32x32x16_bf16(a, bb, acc[ni], 0, 0, 0);
      }
    }
#pragma unroll
    for (int ni = 0; ni < 2; ++ni)
#pragma unroll
      for (int r = 0; r < 16; ++r) {
        int m = 32 * w + (r & 3) + 8 * (r >> 2) + 4 * (lane >> 5);
        Xs[(m & 63) * 136 + (m >> 6) * 64 + 32 * ni + (lane & 31)] = (bf16_t)f2bf(acc[ni][r]);
      }
  }
  __syncthreads();
  {
    int mi = w >> 1, ni = w & 1;
    f32x16 acc;
#pragma unroll
    for (int r = 0; r < 16; ++r) acc[r] = 0.f;
#pragma unroll
    for (int s8 = 0; s8 < 8; ++s8) {
      int ko = 16 * s8 + 8 * (lane >> 5);
      bf16x8 a = *(const bf16x8*)(Xs + (32 * mi + (lane & 31)) * 136 + ko);
      bf16x8 bb = *(const bf16x8*)(DcT + (32 * ni + (lane & 31)) * 128 + ko);
      acc = __builtin_amdgcn_mfma_f32_32x32x16_bf16(a, bb, acc, 0, 0, 0);
    }
    bf16_t* Yt = Bt;
#pragma unroll
    for (int r = 0; r < 16; ++r) {
      int k2 = 32 * mi + (r & 3) + 8 * (r >> 2) + 4 * (lane >> 5);
      Yt[k2 * 72 + 32 * ni + (lane & 31)] = (bf16_t)f2bf(acc[r] * norm);
    }
  }
  __syncthreads();
#pragma unroll
  for (int i = 0; i < 2; ++i) {
    int q = tid + 256 * i; int k2 = q >> 3, ch8 = q & 7;
    int row = rowbase + k1 + nk1 * k2;
    *(uint4*)(MIX + (size_t)row * 1024 + g * 64 + ch8 * 8) = *(const uint4*)((const bf16_t*)smem + k2 * 72 + ch8 * 8);
  }
}

typedef __attribute__((ext_vector_type(4))) float f32x4_t;
__device__ __forceinline__ bf16x8 ld16(const bf16_t* p) { return *(const bf16x8*)p; }
__device__ __forceinline__ float fast_exp2(float x) { return __builtin_amdgcn_exp2f(x); }

template <int NH, int MODE, int KPI, bool PF>
__device__ __forceinline__ void attn_unit(int b, int hk, int r, int jb, int qb, const bf16_t* __restrict__ Qp, int ldq, const bf16_t* __restrict__ Kp, int ldk,
                                          const bf16_t* __restrict__ VTl, const bf16_t* __restrict__ VTc, int nkvh,
                                          const float* rpbs, const float* __restrict__ sink,
                                          bf16_t* __restrict__ Op, int ldo, int lane) {
  const float LOG2E = 1.4426950408889634f;
  const float SC = 0.125f * LOG2E;
  asm volatile("" : "+v"(lane));
  int ql = lane & 15, g = lane >> 4;
  int qrow0, q0 = 0;
  int nloc, lb0 = 0;
  if (MODE == 0) { qrow0 = b * S + r * 64 + 16 * jb; nloc = 8; }
  else if (MODE == 1) { qrow0 = T + b * CL + 16 * qb; nloc = 0; }
  else { q0 = 16 * qb; qrow0 = b * S + q0;
         int lo = (q0 - 128) >> 5, hi = (q0 + 143) >> 5; if (lo < 0) lo = 0; if (hi > 255) hi = 255; lb0 = lo; nloc = hi - lo + 1; }
  bf16x8 qf[NH][2];
#pragma unroll
  for (int hh = 0; hh < NH; ++hh)
#pragma unroll
    for (int s2 = 0; s2 < 2; ++s2)
      qf[hh][s2] = ld16(Qp + (size_t)(qrow0 + ql) * ldq + (hk * NH + hh) * 64 + 32 * s2 + 8 * g);
  f32x4_t o[NH][4]; float mrun[NH], lrun[NH];
#pragma unroll
  for (int hh = 0; hh < NH; ++hh) {
    mrun[hh] = -1e30f; lrun[hh] = 0.f;
#pragma unroll
    for (int dt = 0; dt < 4; ++dt) o[hh][dt] = (f32x4_t){0.f, 0.f, 0.f, 0.f};
  }
  int r_start = 0, blk_start = 0, c_lo = 0, qc = 0;
  if (MODE == 0) {
    r_start = min(max(r - 4, 0), 120);
    blk_start = min(max(16 * jb - 8, 0), 32);
    qc = 16 * jb + ql; c_lo = min(max(qc - 8, 0), 48);
  }
  if (MODE == 2 && KPI == 2) nloc = (nloc + 1) & ~1;
  int nit = (nloc + 8) / KPI;
#define ATT_DESC(kbx, krow0_, vtp_, vld_) \
    { bool il_ = (kbx) < nloc; int vt0_; \
      if (il_) { if (MODE == 0) { int rr_ = r_start + (kbx); krow0_ = b * S + rr_ * 64 + blk_start; vt0_ = rr_ * 64 + blk_start; } \
                 else { krow0_ = b * S + 32 * (lb0 + (kbx)); vt0_ = 32 * (lb0 + (kbx)); } \
                 vtp_ = VTl + ((size_t)(b * nkvh + hk) * 64) * S + vt0_; vld_ = S; } \
      else { int cb_ = (kbx) - nloc; krow0_ = T + b * CL + 32 * cb_; vt0_ = 32 * cb_; \
             vtp_ = VTc + ((size_t)(b * nkvh + hk) * 64) * CL + vt0_; vld_ = CL; } }
#define ATT_LOAD(kbx, KF, VF) \
    { int krow0; const bf16_t* vt; int vld; ATT_DESC(kbx, krow0, vt, vld) \
      _Pragma("unroll") for (int t = 0; t < 2; ++t) _Pragma("unroll") for (int s2 = 0; s2 < 2; ++s2) \
        KF[t][s2] = ld16(Kp + (size_t)(krow0 + 8 * (ql >> 2) + 4 * t + (ql & 3)) * ldk + hk * 64 + 32 * s2 + 8 * g); \
      _Pragma("unroll") for (int dt = 0; dt < 4; ++dt) VF[dt] = ld16(vt + (size_t)(16 * dt + ql) * vld + 8 * g); }
  bf16x8 kfn[PF ? KPI : 1][2][2], vfn[PF ? KPI : 1][4];
  if (PF) {
#pragma unroll
    for (int kk = 0; kk < KPI; ++kk) ATT_LOAD(kk, kfn[kk], vfn[kk])
  }
  for (int it = 0; it < nit; ++it) {
    bf16x8 kf[KPI][2][2], vf[KPI][4];
    if (PF) {
#pragma unroll
      for (int kk = 0; kk < KPI; ++kk) {
#pragma unroll
        for (int t = 0; t < 2; ++t)
#pragma unroll
          for (int s2 = 0; s2 < 2; ++s2) kf[kk][t][s2] = kfn[kk][t][s2];
#pragma unroll
        for (int dt = 0; dt < 4; ++dt) vf[kk][dt] = vfn[kk][dt];
      }
      if (it + 1 < nit) {
#pragma unroll
        for (int kk = 0; kk < KPI; ++kk) ATT_LOAD((it + 1) * KPI + kk, kfn[kk], vfn[kk])
      }
    } else {
#pragma unroll
      for (int kk = 0; kk < KPI; ++kk) ATT_LOAD(it * KPI + kk, kf[kk], vf[kk])
    }
    float bias[KPI][2][4]; bool valid[KPI][2][4];
#pragma unroll
    for (int kk = 0; kk < KPI; ++kk) {
      int kb = it * KPI + kk;
      bool is_loc = kb < nloc;
#pragma unroll
      for (int t = 0; t < 2; ++t)
#pragma unroll
        for (int i = 0; i < 4; ++i) {
          bias[kk][t][i] = 0.f; valid[kk][t][i] = true;
          if (MODE == 0 && is_loc) {
            int kc = blk_start + 8 * g + 4 * t + i;
            valid[kk][t][i] = (kc >= c_lo) && (kc < c_lo + 16);
            int dc = min(max(kc - qc, -15), 15) + 15;
            bias[kk][t][i] = rpbs[(hk * 15 + (r_start + kb - r + 7)) * 31 + dc];
          }
          if (MODE == 2 && is_loc) {
            int kpos = 32 * (lb0 + kb) + 8 * g + 4 * t + i; int dq = (q0 + ql) - kpos;
            bias[kk][t][i] = ((dq <= 128) && (dq >= -128)) ? 0.f : -1e30f;
          }
        }
    }
#pragma unroll
    for (int hh = 0; hh < NH; ++hh) {
      f32x4_t st[KPI][2];
#pragma unroll
      for (int kk = 0; kk < KPI; ++kk)
#pragma unroll
        for (int t = 0; t < 2; ++t) {
          st[kk][t] = (f32x4_t){0.f, 0.f, 0.f, 0.f};
          st[kk][t] = __builtin_amdgcn_mfma_f32_16x16x32_bf16(kf[kk][t][0], qf[hh][0], st[kk][t], 0, 0, 0);
          st[kk][t] = __builtin_amdgcn_mfma_f32_16x16x32_bf16(kf[kk][t][1], qf[hh][1], st[kk][t], 0, 0, 0);
        }
      float lg[KPI][2][4]; float bm = -1e30f;
#pragma unroll
      for (int kk = 0; kk < KPI; ++kk)
#pragma unroll
        for (int t = 0; t < 2; ++t)
#pragma unroll
          for (int i = 0; i < 4; ++i) {
            float v = (MODE == 0) ? (valid[kk][t][i] ? (st[kk][t][i] * SC + bias[kk][t][i]) : -1e30f) : fmaf(st[kk][t][i], SC, bias[kk][t][i]);
            lg[kk][t][i] = v; bm = fmaxf(bm, v);
          }
      bm = xrow16_max(bm);
      float mn = fmaxf(mrun[hh], bm);
      float alpha = fast_exp2(mrun[hh] - mn);
      mrun[hh] = mn;
      float ps = 0.f;
      bf16x8 pf[KPI];
#pragma unroll
      for (int kk = 0; kk < KPI; ++kk) {
        float pv[8];
#pragma unroll
        for (int t = 0; t < 2; ++t)
#pragma unroll
          for (int i = 0; i < 4; ++i) {
            float p = (MODE == 0) ? (valid[kk][t][i] ? fast_exp2(lg[kk][t][i] - mn) : 0.f) : fast_exp2(lg[kk][t][i] - mn);
            pv[4 * t + i] = p; ps += p;
          }
        typedef __attribute__((ext_vector_type(4))) unsigned u32x4;
        u32x4 uu = {pack2bf(pv[0], pv[1]), pack2bf(pv[2], pv[3]), pack2bf(pv[4], pv[5]), pack2bf(pv[6], pv[7])};
        pf[kk] = __builtin_bit_cast(bf16x8, uu);
      }
      lrun[hh] = lrun[hh] * alpha + ps;
#pragma unroll
      for (int dt = 0; dt < 4; ++dt) {
        o[hh][dt] *= alpha;
#pragma unroll
        for (int kk = 0; kk < KPI; ++kk)
          o[hh][dt] = __builtin_amdgcn_mfma_f32_16x16x32_bf16(vf[kk][dt], pf[kk], o[hh][dt], 0, 0, 0);
      }
      if (NH == 4 && KPI == 2 && (hh & 1)) __builtin_amdgcn_sched_barrier(0);
    }
  }
#undef ATT_LOAD
#undef ATT_DESC
#pragma unroll
  for (int hh = 0; hh < NH; ++hh) {
    float l = xrow16_sum(lrun[hh]);
    float m = mrun[hh];
    if (MODE == 2) {
      float sk = sink[hk * NH + hh] * LOG2E;
      float mf = fmaxf(m, sk);
      float a = fast_exp2(m - mf);
      l = l * a + fast_exp2(sk - mf);
#pragma unroll
      for (int dt = 0; dt < 4; ++dt) o[hh][dt] *= a;
    }
    float inv = 1.f / l;
    bf16_t* orow = Op + (size_t)(qrow0 + ql) * ldo + (hk * NH + hh) * 64 + 4 * g;
#pragma unroll
    for (int dt = 0; dt < 4; ++dt) {
      f32x4_t v = o[hh][dt] * inv;
      *(uint2*)(orow + 16 * dt) = make_uint2(pack2bf(v[0], v[1]), pack2bf(v[2], v[3]));
    }
  }
}

struct NaState { f32x4_t o[4][4]; float m[4], l[4]; };
template <int HB>
__device__ __forceinline__ void na_block(NaState& st, const bf16x8 (&qf)[4][2], const bf16x8 (&kf)[2][2], const bf16x8 (&vf)[4],
                                         const float* rpbrow  , int ql, int g) {
  const float SC = 0.125f * 1.4426950408889634f;
#pragma unroll
  for (int jb = 0; jb < 4; ++jb) {
    if (HB == 0 && jb == 3) continue;
    if (HB == 1 && jb == 0) continue;
    f32x4_t s2[2];
#pragma unroll
    for (int t = 0; t < 2; ++t) {
      s2[t] = (f32x4_t){0.f, 0.f, 0.f, 0.f};
      s2[t] = __builtin_amdgcn_mfma_f32_16x16x32_bf16(kf[t][0], qf[jb][0], s2[t], 0, 0, 0);
      s2[t] = __builtin_amdgcn_mfma_f32_16x16x32_bf16(kf[t][1], qf[jb][1], s2[t], 0, 0, 0);
    }
    float lg[8]; bool valid[8]; float bm = -1e30f;
#pragma unroll
    for (int t = 0; t < 2; ++t)
#pragma unroll
      for (int i = 0; i < 4; ++i) {
        float v;
        if (HB < 2) {
          int qc = 16 * jb + ql; int c_lo = min(max(qc - 8, 0), 48);
          int kc = 32 * HB + 8 * g + 4 * t + i;
          bool ok = (kc >= c_lo) && (kc < c_lo + 16);
          int dc = min(max(kc - qc, -15), 15) + 15;
          v = ok ? (s2[t][i] * SC + rpbrow[dc]) : -1e30f;
          valid[4 * t + i] = ok;
        } else { v = s2[t][i] * SC; valid[4 * t + i] = true; }
        lg[4 * t + i] = v; bm = fmaxf(bm, v);
      }
    bm = xrow16_max(bm);
    float mn = fmaxf(st.m[jb], bm);
    float alpha = fast_exp2(st.m[jb] - mn);
    st.m[jb] = mn;
    float ps = 0.f; float pv[8];
#pragma unroll
    for (int e = 0; e < 8; ++e) { float p = valid[e] ? fast_exp2(lg[e] - mn) : 0.f; pv[e] = p; ps += p; }
    st.l[jb] = st.l[jb] * alpha + ps;
    typedef __attribute__((ext_vector_type(4))) unsigned u32x4;
    u32x4 uu = {pack2bf(pv[0], pv[1]), pack2bf(pv[2], pv[3]), pack2bf(pv[4], pv[5]), pack2bf(pv[6], pv[7])};
    bf16x8 pf = __builtin_bit_cast(bf16x8, uu);
#pragma unroll
    for (int dt = 0; dt < 4; ++dt) {
      st.o[jb][dt] *= alpha;
      st.o[jb][dt] = __builtin_amdgcn_mfma_f32_16x16x32_bf16(vf[dt], pf, st.o[jb][dt], 0, 0, 0);
    }
    if (jb & 1) __builtin_amdgcn_sched_barrier(0);
  }
}
__device__ __forceinline__ void na_unit(int b, int h, int r, const bf16_t* __restrict__ FQKV, const bf16_t* __restrict__ VTl,
                                        const bf16_t* __restrict__ VTc, const float* rpbs, bf16_t* __restrict__ MIX, int lane) {
  asm volatile("" : "+v"(lane));
  int ql = lane & 15, g = lane >> 4;
  int qrow0 = b * S + r * 64;
  int r_start = min(max(r - 4, 0), 120);
  bf16x8 qf[4][2];
#pragma unroll
  for (int jb = 0; jb < 4; ++jb)
#pragma unroll
    for (int s2 = 0; s2 < 2; ++s2)
      qf[jb][s2] = ld16(FQKV + (size_t)(qrow0 + 16 * jb + ql) * 2048 + 512 + h * 64 + 32 * s2 + 8 * g);
  NaState st;
#pragma unroll
  for (int jb = 0; jb < 4; ++jb) {
    st.m[jb] = -1e30f; st.l[jb] = 0.f;
#pragma unroll
    for (int dt = 0; dt < 4; ++dt) st.o[jb][dt] = (f32x4_t){0.f, 0.f, 0.f, 0.f};
  }
  unsigned koff = (unsigned)((8 * (ql >> 2) + (ql & 3)) * 2048 + 1024 + h * 64 + 8 * g);
  unsigned voffl = (unsigned)(ql * S + 8 * g), voffc = (unsigned)(ql * CL + 8 * g);
  const bf16_t* vtl = VTl + (size_t)(b * 8 + h) * 64 * S;
  const bf16_t* vtc = VTc + (size_t)(b * 8 + h) * 64 * CL;
#define NA_LOADK(kb2, KF) { \
    int krow0_; \
    if ((kb2) < 16) krow0_ = b * S + (r_start + ((kb2) >> 1)) * 64 + 32 * ((kb2) & 1); \
    else krow0_ = T + b * CL + 32 * ((kb2) - 16); \
    const bf16_t* kb_ = FQKV + (size_t)krow0_ * 2048; \
    _Pragma("unroll") for (int t = 0; t < 2; ++t) _Pragma("unroll") for (int s2 = 0; s2 < 2; ++s2) \
      KF[t][s2] = ld16(kb_ + (koff + (unsigned)(t * 4 * 2048 + 32 * s2))); }
#define NA_LOADV(kb2, VF) { \
    if ((kb2) < 16) { const bf16_t* vt_ = vtl + (r_start + ((kb2) >> 1)) * 64 + 32 * ((kb2) & 1); \
      _Pragma("unroll") for (int dt = 0; dt < 4; ++dt) VF[dt] = ld16(vt_ + (voffl + (unsigned)(16 * dt * S))); } \
    else { const bf16_t* vt_ = vtc + 32 * ((kb2) - 16); \
      _Pragma("unroll") for (int dt = 0; dt < 4; ++dt) VF[dt] = ld16(vt_ + (voffc + (unsigned)(16 * dt * CL))); } }
  bf16x8 kfa[2][2], kfb[2][2], vfa[4], vfb[4];
  NA_LOADK(0, kfa) NA_LOADV(0, vfa)
#pragma unroll 1
  for (int rr = 0; rr < 8; ++rr) {
    const float* rpbrow = rpbs + (h * 15 + (r_start + rr - r + 7)) * 31;
    asm volatile("" : "+v"(lane)); ql = lane & 15; g = lane >> 4;
    koff = (unsigned)((8 * (ql >> 2) + (ql & 3)) * 2048 + 1024 + h * 64 + 8 * g); voffl = (unsigned)(ql * S + 8 * g); voffc = (unsigned)(ql * CL + 8 * g);
    NA_LOADK(2 * rr + 1, kfb) NA_LOADV(2 * rr + 1, vfb)
    na_block<0>(st, qf, kfa, vfa, rpbrow, ql, g);
    NA_LOADK(2 * rr + 2, kfa) NA_LOADV(2 * rr + 2, vfa)
    na_block<1>(st, qf, kfb, vfb, rpbrow, ql, g);
  }
#pragma unroll 1
  for (int cb = 0; cb < 8; cb += 2) {
    asm volatile("" : "+v"(lane)); ql = lane & 15; g = lane >> 4;
    koff = (unsigned)((8 * (ql >> 2) + (ql & 3)) * 2048 + 1024 + h * 64 + 8 * g); voffc = (unsigned)(ql * CL + 8 * g);
    NA_LOADK(16 + cb + 1, kfb) NA_LOADV(16 + cb + 1, vfb)
    na_block<2>(st, qf, kfa, vfa, rpbs, ql, g);
    if (cb + 2 < 8) { NA_LOADK(16 + cb + 2, kfa) NA_LOADV(16 + cb + 2, vfa) }
    na_block<2>(st, qf, kfb, vfb, rpbs, ql, g);
  }
#undef NA_LOADK
#undef NA_LOADV
  asm volatile("" : "+v"(lane)); ql = lane & 15; g = lane >> 4;
#pragma unroll
  for (int jb = 0; jb < 4; ++jb) {
    float inv = 1.f / xrow16_sum(st.l[jb]);
    bf16_t* orow = MIX + (size_t)(qrow0 + 16 * jb + ql) * 1024 + 512 + h * 64 + 4 * g;
#pragma unroll
    for (int dt = 0; dt < 4; ++dt) {
      f32x4_t v = st.o[jb][dt] * inv;
      *(uint2*)(orow + 16 * dt) = make_uint2(pack2bf(v[0], v[1]), pack2bf(v[2], v[3]));
    }
  }
}

__device__ __forceinline__ void ph_chan_dft(const float* __restrict__ F, const float* __restrict__ tab, float* __restrict__ PQ) {
  for (int gid = blockIdx.x * 256 + threadIdx.x; gid < R * 512; gid += gridDim.x * 256) {
    int row = gid >> 9; int col = gid & 511; int g = col >> 6, cp = col & 63;
    const float* f = F + (size_t)row * 2048 + g * 64;
    float p = 0.f, q = 0.f;
    for (int ch = 0; ch < 64; ++ch) {
      int idx = ((ch * cp) & 63) * 128;
      float x = f[ch];
      p += x * tab[idx]; q += x * tab[8192 + idx];
    }
    PQ[(size_t)row * 1024 + col] = p;
    PQ[(size_t)row * 1024 + 512 + col] = q;
  }
}

__device__ __forceinline__ void ph_na(const bf16_t* __restrict__ F, const float* __restrict__ rpb, bf16_t* __restrict__ MIX, float* sm) {
  int lane = threadIdx.x & 63, wave = __builtin_amdgcn_readfirstlane(threadIdx.x >> 6);
  float* sq = sm + wave * 1024; float* sp = sq + 64; int* stok = (int*)(sp + 384);
  int nitems = R * 8;
  for (int item0 = blockIdx.x * 4; item0 < nitems; item0 += gridDim.x * 4) {
    int item = item0 + wave;
    int h = item & 7; int row = item >> 3;
    bool is_ctx = row >= T;
    int b = is_ctx ? (row - T) / CL : row / S;
    __syncthreads();
    sq[lane] = bf2f(F[(size_t)row * 2048 + 512 + h * 64 + lane]);
    __syncthreads();
    int r = 0, c = 0, r_start = 0, c_start = 0;
    if (!is_ctx) { int t = row % S; r = t / 64; c = t % 64; r_start = min(max(r - 4, 0), 120); c_start = min(max(c - 8, 0), 48); }
    int nk = is_ctx ? 256 : 384;
    float lg[6]; float mx = -INFINITY;
#pragma unroll
    for (int kk = 0; kk < 6; ++kk) {
      int j = kk * 64 + lane; float s = -INFINITY; int tok = 0;
      if (j < nk) {
        float bias = 0.f;
        if (!is_ctx && j < 128) {
          int kr = j >> 4, kc = j & 15; int rr = r_start + kr, cc = c_start + kc;
          tok = b * S + rr * 64 + cc;
          int dc = min(max(cc - c, -15), 15) + 15;
          bias = rpb[(h * 15 + (rr - r + 7)) * 31 + dc];
        } else {
          int l = is_ctx ? j : j - 128; tok = T + b * CL + l;
        }
        const bf16_t* kp = F + (size_t)tok * 2048 + 1024 + h * 64;
        float acc = 0.f;
#pragma unroll 8
        for (int d = 0; d < 64; ++d) acc += sq[d] * bf2f(kp[d]);
        s = acc * 0.125f + bias;
      }
      lg[kk] = s; stok[j] = tok; mx = fmaxf(mx, s);
    }
    mx = wave_max(mx);
    float sum = 0.f;
#pragma unroll
    for (int kk = 0; kk < 6; ++kk) { float e = (kk * 64 + lane < nk) ? expf(lg[kk] - mx) : 0.f; lg[kk] = e; sum += e; }
    sum = wave_sum(sum);
    float inv = 1.f / sum;
#pragma unroll
    for (int kk = 0; kk < 6; ++kk) sp[kk * 64 + lane] = lg[kk] * inv;
    __syncthreads();
    float o = 0.f;
    for (int j = 0; j < nk; ++j) o += sp[j] * bf2f(F[(size_t)stok[j] * 2048 + 1536 + h * 64 + lane]);
    MIX[(size_t)row * 1024 + 512 + h * 64 + lane] = (bf16_t)f2bf(o);
  }
}

__device__ __forceinline__ void ph_rope(float* __restrict__ F1) {
  for (int gid = blockIdx.x * 256 + threadIdx.x; gid < T * 20 * 32; gid += gridDim.x * 256) {
    int i = gid & 31; int hh = (gid >> 5) % 20; int row = gid / (32 * 20);
    int t = row % S; float rowp = (float)(t / 64), colp = (float)(t % 64);
    int fi = i & 15;
    float inv_freq = powf(10000.0f, -(float)fi / 16.0f);
    float ang = (i < 16 ? rowp : colp) * inv_freq;
    float cs = cosf(ang), sn = sinf(ang);
    float* p = F1 + (size_t)row * 1536 + hh * 64;
    float x1 = p[i], x2 = p[i + 32];
    p[i] = x1 * cs - x2 * sn;
    p[i + 32] = x1 * sn + x2 * cs;
  }
}

__device__ __forceinline__ void ph_gqa(const float* __restrict__ F1, const float* __restrict__ sink, bf16_t* __restrict__ O, float* sm) {
  int lane = threadIdx.x & 63, wave = __builtin_amdgcn_readfirstlane(threadIdx.x >> 6);
  float* sq = sm + wave * 1280; float* sp = sq + 64; int* stok = (int*)(sp + 576);
  int nitems = T * 16;
  for (int item0 = blockIdx.x * 4; item0 < nitems; item0 += gridDim.x * 4) {
    int item = item0 + wave;
    int qh = item & 15; int row = item >> 4; int kvh = qh >> 2;
    int b = row / S; int t = row % S;
    __syncthreads();
    sq[lane] = F1[(size_t)row * 1536 + qh * 64 + lane];
    __syncthreads();
    float lg[9]; float mx = -INFINITY;
#pragma unroll
    for (int kk = 0; kk < 9; ++kk) {
      int j = kk * 64 + lane; float s = -INFINITY; int tok = 0; bool valid = false;
      if (j < 257) { int pos = t - 128 + j; valid = (pos >= 0 && pos < S); tok = b * S + pos; }
      else if (j < 513) { valid = true; tok = T + b * CL + (j - 257); }
      if (valid) {
        const float* kp = F1 + (size_t)tok * 1536 + 1024 + kvh * 64;
        float acc = 0.f;
#pragma unroll 8
        for (int d = 0; d < 64; ++d) acc += sq[d] * kp[d];
        s = acc * 0.125f;
      } else tok = 0;
      lg[kk] = s; stok[j] = tok; mx = fmaxf(mx, s);
    }
    mx = wave_max(mx);
    float sk = sink[qh];
    mx = fmaxf(mx, sk);
    float sum = 0.f;
#pragma unroll
    for (int kk = 0; kk < 9; ++kk) { float e = (lg[kk] == -INFINITY) ? 0.f : expf(lg[kk] - mx); lg[kk] = e; sum += e; }
    sum = wave_sum(sum) + expf(sk - mx);
    float inv = 1.f / sum;
#pragma unroll
    for (int kk = 0; kk < 9; ++kk) sp[kk * 64 + lane] = lg[kk] * inv;
    __syncthreads();
    float o = 0.f;
    for (int j = 0; j < 513; ++j) { float p = sp[j]; if (p != 0.f) o += p * F1[(size_t)stok[j] * 1536 + 1280 + kvh * 64 + lane]; }
    O[(size_t)row * 1024 + qh * 64 + lane] = (bf16_t)f2bf(o);
  }
}

__device__ __forceinline__ void wave_argmax(float& v, int& idx) {
#pragma unroll
  for (int off = 32; off; off >>= 1) {
    float ov = __shfl_xor(v, off); int oi = __shfl_xor(idx, off);
    if (ov > v || (ov == v && oi < idx)) { v = ov; idx = oi; }
  }
}
__device__ __forceinline__ void ph_peer_select_naive(const float* __restrict__ Q, const float* __restrict__ sk, int* __restrict__ EXP,
                                     float* __restrict__ GATE, int nrows, float* sm) {
  int lane = threadIdx.x & 63, wave = __builtin_amdgcn_readfirstlane(threadIdx.x >> 6);
  float* sq = sm + wave * 640; float* tops = sq + 256; int* topi = (int*)(tops + 32);
  for (int row0 = blockIdx.x * 4; row0 < nrows; row0 += gridDim.x * 4) {
    int row = row0 + wave;
    for (int h = 0; h < 8; ++h) {
      __syncthreads();
#pragma unroll
      for (int i = 0; i < 4; ++i) sq[lane + 64 * i] = Q[(size_t)row * 2048 + h * 256 + lane + 64 * i];
      __syncthreads();
      for (int p = 0; p < 2; ++p) {
        float s0 = 0.f, s1 = 0.f;
        const float* k0 = sk + ((size_t)((h * 2 + p) * 128 + lane)) * 128;
        const float* k1 = k0 + 64 * 128;
#pragma unroll 8
        for (int d = 0; d < 128; ++d) { float qv = sq[p * 128 + d]; s0 += qv * k0[d]; s1 += qv * k1[d]; }
        for (int i = 0; i < 16; ++i) {
          float v; int idx;
          if (s0 >= s1) { v = s0; idx = lane; } else { v = s1; idx = lane + 64; }
          wave_argmax(v, idx);
          if (lane == 0) { tops[p * 16 + i] = v; topi[p * 16 + i] = idx; }
          if (idx == lane) s0 = -INFINITY;
          if (idx == lane + 64) s1 = -INFINITY;
        }
      }
      __syncthreads();
      float cs[4];
#pragma unroll
      for (int i = 0; i < 4; ++i) { int ci = lane * 4 + i; cs[i] = tops[ci >> 4] + tops[16 + (ci & 15)]; }
      float bs[16]; int be[16];
#pragma unroll
      for (int k = 0; k < 16; ++k) {
        float v = cs[0]; int idx = lane * 4;
#pragma unroll
        for (int i = 1; i < 4; ++i) if (cs[i] > v) { v = cs[i]; idx = lane * 4 + i; }
        wave_argmax(v, idx);
        bs[k] = v; be[k] = topi[idx >> 4] * 128 + topi[16 + (idx & 15)];
#pragma unroll
        for (int i = 0; i < 4; ++i) if (idx == lane * 4 + i) cs[i] = -INFINITY;
      }
      float mxs = bs[0]; float sum = 0.f;
#pragma unroll
      for (int k = 0; k < 16; ++k) { bs[k] = expf(bs[k] - mxs); sum += bs[k]; }
      float inv = 1.f / sum;
      if (lane == 0) {
#pragma unroll
        for (int k = 0; k < 16; ++k) { EXP[(size_t)row * 128 + h * 16 + k] = be[k]; GATE[(size_t)row * 128 + h * 16 + k] = bs[k] * inv; }
      }
    }
  }
}

__device__ __forceinline__ void unpack8(uint4 v, float* f) {
  f[0] = __uint_as_float(v.x << 16); f[1] = __uint_as_float(v.x & 0xffff0000u);
  f[2] = __uint_as_float(v.y << 16); f[3] = __uint_as_float(v.y & 0xffff0000u);
  f[4] = __uint_as_float(v.z << 16); f[5] = __uint_as_float(v.z & 0xffff0000u);
  f[6] = __uint_as_float(v.w << 16); f[7] = __uint_as_float(v.w & 0xffff0000u);
}
__device__ __forceinline__ void ph_peer_gather(bf16_t* __restrict__ H, const int* __restrict__ EXP, const float* __restrict__ GATE,
                               const bf16_t* __restrict__ U, const bf16_t* __restrict__ V,
                               const float* __restrict__ xin, const float* __restrict__ M, int layer,
                               const float* __restrict__ g, const float* __restrict__ bb, float* __restrict__ xout,
                               bool write_next, int nrows) {
  int lane = threadIdx.x & 63, wave = __builtin_amdgcn_readfirstlane(threadIdx.x >> 6);
  for (int row = blockIdx.x * 4 + wave; row < nrows; row += gridDim.x * 4) {
    float hreg[16];
    {
      const uint4* hp = (const uint4*)(H + (size_t)row * D + 8 * lane);
      unpack8(hp[0], hreg); unpack8(hp[64], hreg + 8);
    }
    float acc[16];
#pragma unroll
    for (int i = 0; i < 16; ++i) acc[i] = 0.f;
    int e_lo = EXP[(size_t)row * 128 + lane], e_hi = EXP[(size_t)row * 128 + 64 + lane];
    float g_lo = GATE[(size_t)row * 128 + lane], g_hi = GATE[(size_t)row * 128 + 64 + lane];
    uint4 ua[4], ub[4], va[4], vb[4];
#pragma unroll
    for (int i = 0; i < 4; ++i) {
      int e = __builtin_amdgcn_readlane(e_lo, i);
      const uint4* up = (const uint4*)(U + (size_t)e * D + 8 * lane); ua[i] = up[0]; ub[i] = up[64];
    }
#pragma unroll 1
    for (int b = 0; b < 32; ++b) {
      int k0 = 4 * b;
      int ev = (b < 16) ? e_lo : e_hi; float gv = (b < 16) ? g_lo : g_hi;
      int en = (b + 1 < 16) ? e_lo : e_hi;
      float gt[4];
#pragma unroll
      for (int i = 0; i < 4; ++i) {
        int e = __builtin_amdgcn_readlane(ev, (k0 + i) & 63);
        gt[i] = __uint_as_float(__builtin_amdgcn_readlane(__float_as_uint(gv), (k0 + i) & 63));
        const uint4* vp = (const uint4*)(V + (size_t)e * D + 8 * lane); va[i] = vp[0]; vb[i] = vp[64];
      }
      float a[4];
#pragma unroll
      for (int i = 0; i < 4; ++i) {
        float f[16]; unpack8(ua[i], f); unpack8(ub[i], f + 8);
        float sacc = 0.f;
#pragma unroll
        for (int j = 0; j < 16; ++j) sacc += f[j] * hreg[j];
        a[i] = sacc;
      }
      if (b + 1 < 32) {
#pragma unroll
        for (int i = 0; i < 4; ++i) {
          int e = __builtin_amdgcn_readlane(en, (k0 + 4 + i) & 63);
          const uint4* up = (const uint4*)(U + (size_t)e * D + 8 * lane); ua[i] = up[0]; ub[i] = up[64];
        }
      }
#pragma unroll
      for (int i = 0; i < 4; ++i) a[i] = wave_sum(a[i]);
#pragma unroll
      for (int i = 0; i < 4; ++i) {
        float w = gt[i] * 0.5f * a[i] * (1.f + erff(a[i] * 0.70710678118654752f));
        float f[16]; unpack8(va[i], f); unpack8(vb[i], f + 8);
#pragma unroll
        for (int j = 0; j < 16; ++j) acc[j] += w * f[j];
      }
    }
    const float* m = M + ((size_t)layer * 3 + mod_index(row)) * 6144;
    const float* xr = xin + (size_t)row * D;
    float v[16];
#pragma unroll
    for (int hh = 0; hh < 2; ++hh) {
      int d0 = hh * 512 + 8 * lane;
      float4 x0 = *(const float4*)(xr + d0), x1 = *(const float4*)(xr + d0 + 4);
      float4 m0 = *(const float4*)(m + 5 * D + d0), m1 = *(const float4*)(m + 5 * D + d0 + 4);
      v[hh * 8 + 0] = DN_ALPHA * x0.x + m0.x * acc[hh * 8 + 0]; v[hh * 8 + 1] = DN_ALPHA * x0.y + m0.y * acc[hh * 8 + 1];
      v[hh * 8 + 2] = DN_ALPHA * x0.z + m0.z * acc[hh * 8 + 2]; v[hh * 8 + 3] = DN_ALPHA * x0.w + m0.w * acc[hh * 8 + 3];
      v[hh * 8 + 4] = DN_ALPHA * x1.x + m1.x * acc[hh * 8 + 4]; v[hh * 8 + 5] = DN_ALPHA * x1.y + m1.y * acc[hh * 8 + 5];
      v[hh * 8 + 6] = DN_ALPHA * x1.z + m1.z * acc[hh * 8 + 6]; v[hh * 8 + 7] = DN_ALPHA * x1.w + m1.w * acc[hh * 8 + 7];
    }
    float s = 0.f;
#pragma unroll
    for (int j = 0; j < 16; ++j) s += v[j];
    float mu = wave_sum(s) * (1.f / D);
    float q = 0.f;
#pragma unroll
    for (int j = 0; j < 16; ++j) { float d = v[j] - mu; q += d * d; }
    float rs = rsqrtf(wave_sum(q) * (1.f / D) + LN_EPS);
    float y[16];
#pragma unroll
    for (int hh = 0; hh < 2; ++hh) {
      int d0 = hh * 512 + 8 * lane;
#pragma unroll
      for (int j = 0; j < 8; ++j) y[hh * 8 + j] = (v[hh * 8 + j] - mu) * rs * g[d0 + j] + bb[d0 + j];
      *(float4*)(xout + (size_t)row * D + d0) = make_float4(y[hh * 8], y[hh * 8 + 1], y[hh * 8 + 2], y[hh * 8 + 3]);
      *(float4*)(xout + (size_t)row * D + d0 + 4) = make_float4(y[hh * 8 + 4], y[hh * 8 + 5], y[hh * 8 + 6], y[hh * 8 + 7]);
    }
    if (write_next) {
      const float* mn = M + ((size_t)(layer + 1) * 3 + mod_index(row)) * 6144;
      float s2 = 0.f;
#pragma unroll
      for (int j = 0; j < 16; ++j) s2 += y[j];
      float mu2 = wave_sum(s2) * (1.f / D);
      float q2 = 0.f;
#pragma unroll
      for (int j = 0; j < 16; ++j) { float d = y[j] - mu2; q2 += d * d; }
      float rs2 = rsqrtf(wave_sum(q2) * (1.f / D) + LN_EPS);
#pragma unroll
      for (int hh = 0; hh < 2; ++hh) {
        int d0 = hh * 512 + 8 * lane;
        float o[8];
#pragma unroll
        for (int j = 0; j < 8; ++j) o[j] = (y[hh * 8 + j] - mu2) * rs2 * (1.f + mn[D + d0 + j]) + mn[d0 + j];
        *(uint4*)(H + (size_t)row * D + d0) = make_uint4(pack2bf(o[0], o[1]), pack2bf(o[2], o[3]), pack2bf(o[4], o[5]), pack2bf(o[6], o[7]));
      }
    }
  }
}


__device__ __forceinline__ void quant_row(const float* __restrict__ src, unsigned char* __restrict__ dst, float* __restrict__ scale, int row, int lane) {
  const float4* sp = (const float4*)(src + (size_t)row * D + 16 * lane);
  float4 v0 = sp[0], v1 = sp[1], v2 = sp[2], v3 = sp[3];
  float x[16] = {v0.x, v0.y, v0.z, v0.w, v1.x, v1.y, v1.z, v1.w, v2.x, v2.y, v2.z, v2.w, v3.x, v3.y, v3.z, v3.w};
  float am = 0.f;
#pragma unroll
  for (int j = 0; j < 16; ++j) am = fmaxf(am, fabsf(x[j]));
  am = wave_max(am);
  float inv = am > 0.f ? 127.f / am : 0.f;
  unsigned wv[4];
#pragma unroll
  for (int k = 0; k < 4; ++k) {
    unsigned w = 0;
#pragma unroll
    for (int j = 0; j < 4; ++j) {
      int q = (int)rintf(x[4 * k + j] * inv);
      w |= ((unsigned)q & 0xffu) << (8 * j);
    }
    wv[k] = w;
  }
  *(uint4*)(dst + ((size_t)(row >> 14) * 8 + (lane >> 3)) * ((size_t)16384 * 128) + (size_t)(row & 16383) * 128 + 16 * (lane & 7)) = make_uint4(wv[0], wv[1], wv[2], wv[3]);
  if (lane == 0) scale[row] = am * (1.f / 127.f);
}
__device__ __forceinline__ void quant_row_u4(const float* __restrict__ src, unsigned char* __restrict__ dst, float* __restrict__ scale, int row, int lane) {
  const float4* sp = (const float4*)(src + (size_t)row * D + 16 * lane);
  float4 v0 = sp[0], v1 = sp[1], v2 = sp[2], v3 = sp[3];
  float x[16] = {v0.x, v0.y, v0.z, v0.w, v1.x, v1.y, v1.z, v1.w, v2.x, v2.y, v2.z, v2.w, v3.x, v3.y, v3.z, v3.w};
  float ss = 0.f;
#pragma unroll
  for (int j = 0; j < 16; ++j) ss += x[j] * x[j];
  ss = wave_sum(ss);
  float delta = 0.3352f * sqrtf(ss * (1.f / D));
  float inv = delta > 0.f ? 1.f / delta : 0.f;
  unsigned wv[2];
#pragma unroll
  for (int k = 0; k < 2; ++k) {
    unsigned w = 0;
#pragma unroll
    for (int j = 0; j < 4; ++j) {
      int qh = (int)fminf(fmaxf(floorf(x[8 * k + j] * inv), -8.f), 7.f);
      int ql = (int)fminf(fmaxf(floorf(x[8 * k + 4 + j] * inv), -8.f), 7.f);
      w |= ((((unsigned)qh & 15u) << 4) | ((unsigned)ql & 15u)) << (8 * j);
    }
    wv[k] = w;
  }
  *(uint2*)(dst + ((size_t)(row >> 14) * 4 + (lane >> 4)) * ((size_t)16384 * 128) + (size_t)(row & 16383) * 128 + 8 * (lane & 15)) = make_uint2(wv[0], wv[1]);
  if (lane == 0) scale[row] = delta;
}
__device__ __forceinline__ void quant_fill(unsigned* ctr, int layer, unsigned lo, unsigned hi, const float* __restrict__ pu, const float* __restrict__ pv,
                                           unsigned char* __restrict__ U8, unsigned char* __restrict__ V8, float* __restrict__ USC,
                                           float* __restrict__ VSC, unsigned* sh) {
  int lane = threadIdx.x & 63, wave = __builtin_amdgcn_readfirstlane(threadIdx.x >> 6);
  for (;;) {
    __syncthreads();
    if (threadIdx.x == 0) *sh = lo + __hip_atomic_fetch_add(ctr, 1u, __ATOMIC_RELAXED, __HIP_MEMORY_SCOPE_AGENT);
    __syncthreads();
    unsigned c = *sh;
    if (c >= hi) break;
    const float* src = (c >> 8) ? pv : pu; unsigned char* dst = (c >> 8) ? V8 : U8; float* sc = (c >> 8) ? VSC : USC;
    int r0 = layer * 16384 + (int)(c & 255u) * 64 + wave * 16;
    if (c >> 8) {
#pragma unroll 4
      for (int i = 0; i < 16; ++i) quant_row(src, dst, sc, r0 + i, lane);
    } else {
#pragma unroll 4
      for (int i = 0; i < 16; ++i) quant_row_u4(src, dst, sc, r0 + i, lane);
    }
  }
  __syncthreads();
}
__device__ __forceinline__ void unpack_u8x16(uint4 v, float* f) {
  unsigned w[4] = {v.x, v.y, v.z, v.w};
#pragma unroll
  for (int k = 0; k < 4; ++k) {
    f[4 * k + 0] = (float)(w[k] & 0xffu); f[4 * k + 1] = (float)((w[k] >> 8) & 0xffu);
    f[4 * k + 2] = (float)((w[k] >> 16) & 0xffu); f[4 * k + 3] = (float)(w[k] >> 24);
  }
}
__device__ __forceinline__ void ph_peer_gather8(bf16_t* __restrict__ H, const int* __restrict__ EXP, const float* __restrict__ GATE,
                               const unsigned char* __restrict__ U8, const float* __restrict__ USC,
                               const unsigned char* __restrict__ V8, const float* __restrict__ VSC,
                               const float* __restrict__ xin, const float* __restrict__ M, int layer,
                               const float* __restrict__ g, const float* __restrict__ bb, float* __restrict__ xout,
                               bool write_next, int nrows) {
  int lane = threadIdx.x & 63, wave = __builtin_amdgcn_readfirstlane(threadIdx.x >> 6);
  for (int row = blockIdx.x * 4 + wave; row < nrows; row += gridDim.x * 4) {
    float hreg[16];
    {
      const uint4* hp = (const uint4*)(H + (size_t)row * D + 16 * lane);
      unpack8(hp[0], hreg); unpack8(hp[1], hreg + 8);
    }
    float hs = 0.f;
#pragma unroll
    for (int j = 0; j < 16; ++j) hs += hreg[j];
    float hsum128 = 128.f * wave_sum(hs);
    float acc[16];
#pragma unroll
    for (int i = 0; i < 16; ++i) acc[i] = 0.f;
    float wsum = 0.f;
    int e_lo = EXP[(size_t)row * 128 + lane], e_hi = EXP[(size_t)row * 128 + 64 + lane];
    float g_lo = GATE[(size_t)row * 128 + lane], g_hi = GATE[(size_t)row * 128 + 64 + lane];
    float us_lo = USC[e_lo], us_hi = USC[e_hi], vs_lo = VSC[e_lo], vs_hi = VSC[e_hi];
    uint4 ua[8], va[8];
#pragma unroll
    for (int i = 0; i < 8; ++i) {
      int e = __builtin_amdgcn_readlane(e_lo, i);
      ua[i] = *(const uint4*)(U8 + (size_t)e * D + 16 * lane);
    }
#pragma unroll 1
    for (int b = 0; b < 16; ++b) {
      int k0 = 8 * b;
      bool lo = b < 8, lon = (b + 1) < 8;
      int ev = lo ? e_lo : e_hi; float gv = lo ? g_lo : g_hi; float usv = lo ? us_lo : us_hi; float vsv = lo ? vs_lo : vs_hi;
      int en = lon ? e_lo : e_hi;
      float gt[8], usc[8], vsc[8];
#pragma unroll
      for (int i = 0; i < 8; ++i) {
        int li = (k0 + i) & 63;
        int e = __builtin_amdgcn_readlane(ev, li);
        gt[i] = __uint_as_float(__builtin_amdgcn_readlane(__float_as_uint(gv), li));
        usc[i] = __uint_as_float(__builtin_amdgcn_readlane(__float_as_uint(usv), li));
        vsc[i] = __uint_as_float(__builtin_amdgcn_readlane(__float_as_uint(vsv), li));
        va[i] = *(const uint4*)(V8 + (size_t)e * D + 16 * lane);
      }
      float a[8];
#pragma unroll
      for (int i = 0; i < 8; ++i) {
        float f[16]; unpack_u8x16(ua[i], f);
        float sacc = 0.f;
#pragma unroll
        for (int j = 0; j < 16; ++j) sacc += f[j] * hreg[j];
        a[i] = sacc;
      }
      if (b + 1 < 16) {
#pragma unroll
        for (int i = 0; i < 8; ++i) {
          int e = __builtin_amdgcn_readlane(en, (k0 + 8 + i) & 63);
          ua[i] = *(const uint4*)(U8 + (size_t)e * D + 16 * lane);
        }
      }
#pragma unroll
      for (int i = 0; i < 8; ++i) a[i] = (wave_sum(a[i]) - hsum128) * usc[i];
#pragma unroll
      for (int i = 0; i < 8; ++i) {
        float w = gt[i] * 0.5f * a[i] * (1.f + erff(a[i] * 0.70710678118654752f)) * vsc[i];
        wsum += w;
        float f[16]; unpack_u8x16(va[i], f);
#pragma unroll
        for (int j = 0; j < 16; ++j) acc[j] += w * f[j];
      }
    }
    float corr = 128.f * wsum;
#pragma unroll
    for (int j = 0; j < 16; ++j) acc[j] -= corr;
    const float* m = M + ((size_t)layer * 3 + mod_index(row)) * 6144;
    const float* xr = xin + (size_t)row * D + 16 * lane;
    const float* m5 = m + 5 * D + 16 * lane;
    float v[16];
#pragma unroll
    for (int q4 = 0; q4 < 4; ++q4) {
      float4 x0 = *(const float4*)(xr + 4 * q4); float4 m0 = *(const float4*)(m5 + 4 * q4);
      v[4 * q4 + 0] = DN_ALPHA * x0.x + m0.x * acc[4 * q4 + 0]; v[4 * q4 + 1] = DN_ALPHA * x0.y + m0.y * acc[4 * q4 + 1];
      v[4 * q4 + 2] = DN_ALPHA * x0.z + m0.z * acc[4 * q4 + 2]; v[4 * q4 + 3] = DN_ALPHA * x0.w + m0.w * acc[4 * q4 + 3];
    }
    float s = 0.f;
#pragma unroll
    for (int j = 0; j < 16; ++j) s += v[j];
    float mu = wave_sum(s) * (1.f / D);
    float q = 0.f;
#pragma unroll
    for (int j = 0; j < 16; ++j) { float d = v[j] - mu; q += d * d; }
    float rs = rsqrtf(wave_sum(q) * (1.f / D) + LN_EPS);
    float y[16];
    {
      const float* gp = g + 16 * lane; const float* bp = bb + 16 * lane;
      float* op = xout + (size_t)row * D + 16 * lane;
#pragma unroll
      for (int q4 = 0; q4 < 4; ++q4) {
        float4 g4 = *(const float4*)(gp + 4 * q4); float4 b4 = *(const float4*)(bp + 4 * q4);
        y[4 * q4 + 0] = (v[4 * q4 + 0] - mu) * rs * g4.x + b4.x; y[4 * q4 + 1] = (v[4 * q4 + 1] - mu) * rs * g4.y + b4.y;
        y[4 * q4 + 2] = (v[4 * q4 + 2] - mu) * rs * g4.z + b4.z; y[4 * q4 + 3] = (v[4 * q4 + 3] - mu) * rs * g4.w + b4.w;
        *(float4*)(op + 4 * q4) = make_float4(y[4 * q4], y[4 * q4 + 1], y[4 * q4 + 2], y[4 * q4 + 3]);
      }
    }
    if (write_next) {
      const float* mn = M + ((size_t)(layer + 1) * 3 + mod_index(row)) * 6144 + 16 * lane;
      float s2 = 0.f;
#pragma unroll
      for (int j = 0; j < 16; ++j) s2 += y[j];
      float mu2 = wave_sum(s2) * (1.f / D);
      float q2 = 0.f;
#pragma unroll
      for (int j = 0; j < 16; ++j) { float d = y[j] - mu2; q2 += d * d; }
      float rs2 = rsqrtf(wave_sum(q2) * (1.f / D) + LN_EPS);
      float o[16];
#pragma unroll
      for (int j = 0; j < 16; ++j) o[j] = (y[j] - mu2) * rs2 * (1.f + mn[D + j]) + mn[j];
      uint4* hp = (uint4*)(H + (size_t)row * D + 16 * lane);
      hp[0] = make_uint4(pack2bf(o[0], o[1]), pack2bf(o[2], o[3]), pack2bf(o[4], o[5]), pack2bf(o[6], o[7]));
      hp[1] = make_uint4(pack2bf(o[8], o[9]), pack2bf(o[10], o[11]), pack2bf(o[12], o[13]), pack2bf(o[14], o[15]));
    }
  }
}


__device__ __forceinline__ void ph_ada2(const float* __restrict__ c, const float* __restrict__ c_ctx, const float* __restrict__ ada_w,
                                        const float* __restrict__ ada_b, float* __restrict__ M, float* sm) {
  int tid = threadIdx.x, lane = tid & 63, wave = __builtin_amdgcn_readfirstlane(tid >> 6);
  float* sv = sm;
  float* red = sm + 3072;
  bool filled = false;
  GRID_LOOP(u, 192) {
    if (!filled) {
      for (int i = tid; i < 3072; i += 256) {
        int idx = i >> 10, k = i & 1023;
        float x = idx < 2 ? c[idx * D + k] : c_ctx[k];
        sv[i] = x / (1.f + expf(-x));
      }
      filled = true;
    }
    __syncthreads();
    int layer = u / 96, c0 = (u % 96) * 64;
    const float* w = ada_w + (size_t)layer * D * 6144 + c0 + lane;
    float a0 = 0.f, a1 = 0.f, a2 = 0.f;
    int kb = wave * 256;
#pragma unroll 16
    for (int k = 0; k < 256; ++k) {
      float wv = w[(size_t)(kb + k) * 6144];
      a0 += sv[kb + k] * wv; a1 += sv[1024 + kb + k] * wv; a2 += sv[2048 + kb + k] * wv;
    }
    red[(wave * 3 + 0) * 64 + lane] = a0; red[(wave * 3 + 1) * 64 + lane] = a1; red[(wave * 3 + 2) * 64 + lane] = a2;
    __syncthreads();
    if (wave < 3) {
      float r = red[(0 * 3 + wave) * 64 + lane] + red[(1 * 3 + wave) * 64 + lane] + red[(2 * 3 + wave) * 64 + lane] + red[(3 * 3 + wave) * 64 + lane];
      M[((size_t)layer * 3 + wave) * 6144 + c0 + lane] = r + ada_b[layer * 6144 + c0 + lane];
    }
  }
  __syncthreads();
}

__device__ __forceinline__ void ph_post_mod(const float* __restrict__ xa, const float* __restrict__ xb, const bf16_t* __restrict__ Y,
                                            const float* __restrict__ M, int layer, int jres, int mlayer, int jshift, int jscale, bool do_mod,
                                            const float* __restrict__ g, const float* __restrict__ bb,
                                            float* __restrict__ xout, bf16_t* __restrict__ H, int nrows,
                                            unsigned char* __restrict__ HQ = nullptr, float* __restrict__ HS = nullptr) {
  int lane = threadIdx.x & 63, wave = __builtin_amdgcn_readfirstlane(threadIdx.x >> 6);
  for (int row = blockIdx.x * 4 + wave; row < nrows; row += gridDim.x * 4) {
    const float* xr = (row < T ? xa + (size_t)row * D : xb + (size_t)(row - T) * D) + 16 * lane;
    const float* m = M + ((size_t)layer * 3 + mod_index(row)) * 6144 + 16 * lane;
    float yv[16];
    {
      const uint4* yp = (const uint4*)(Y + (size_t)row * D + 16 * lane);
      unpack8(yp[0], yv); unpack8(yp[1], yv + 8);
    }
    float v[16];
#pragma unroll
    for (int q4 = 0; q4 < 4; ++q4) {
      float4 x0 = *(const float4*)(xr + 4 * q4); float4 m0 = *(const float4*)(m + jres * D + 4 * q4);
      v[4 * q4 + 0] = DN_ALPHA * x0.x + m0.x * yv[4 * q4 + 0]; v[4 * q4 + 1] = DN_ALPHA * x0.y + m0.y * yv[4 * q4 + 1];
      v[4 * q4 + 2] = DN_ALPHA * x0.z + m0.z * yv[4 * q4 + 2]; v[4 * q4 + 3] = DN_ALPHA * x0.w + m0.w * yv[4 * q4 + 3];
    }
    float s = 0.f;
#pragma unroll
    for (int j = 0; j < 16; ++j) s += v[j];
    float mu = wave_sum(s) * (1.f / D);
    float q = 0.f;
#pragma unroll
    for (int j = 0; j < 16; ++j) { float d = v[j] - mu; q += d * d; }
    float rs = rsqrtf(wave_sum(q) * (1.f / D) + LN_EPS);
    float y[16];
    {
      const float* gp = g + 16 * lane; const float* bp = bb + 16 * lane;
      float* op = xout + (size_t)row * D + 16 * lane;
#pragma unroll
      for (int q4 = 0; q4 < 4; ++q4) {
        float4 g4 = *(const float4*)(gp + 4 * q4); float4 b4 = *(const float4*)(bp + 4 * q4);
        y[4 * q4 + 0] = (v[4 * q4 + 0] - mu) * rs * g4.x + b4.x; y[4 * q4 + 1] = (v[4 * q4 + 1] - mu) * rs * g4.y + b4.y;
        y[4 * q4 + 2] = (v[4 * q4 + 2] - mu) * rs * g4.z + b4.z; y[4 * q4 + 3] = (v[4 * q4 + 3] - mu) * rs * g4.w + b4.w;
        *(float4*)(op + 4 * q4) = make_float4(y[4 * q4], y[4 * q4 + 1], y[4 * q4 + 2], y[4 * q4 + 3]);
      }
    }
    if (do_mod) {
      const float* mm = M + ((size_t)mlayer * 3 + mod_index(row)) * 6144 + 16 * lane;
      float s2 = 0.f;
#pragma unroll
      for (int j = 0; j < 16; ++j) s2 += y[j];
      float mu2 = wave_sum(s2) * (1.f / D);
      float q2 = 0.f;
#pragma unroll
      for (int j = 0; j < 16; ++j) { float d = y[j] - mu2; q2 += d * d; }
      float rs2 = rsqrtf(wave_sum(q2) * (1.f / D) + LN_EPS);
      float o[16];
#pragma unroll
      for (int j = 0; j < 16; ++j) o[j] = (y[j] - mu2) * rs2 * (1.f + mm[jscale * D + j]) + mm[jshift * D + j];
      uint4* hp = (uint4*)(H + (size_t)row * D + 16 * lane);
      hp[0] = make_uint4(pack2bf(o[0], o[1]), pack2bf(o[2], o[3]), pack2bf(o[4], o[5]), pack2bf(o[6], o[7]));
      hp[1] = make_uint4(pack2bf(o[8], o[9]), pack2bf(o[10], o[11]), pack2bf(o[12], o[13]), pack2bf(o[14], o[15]));
      if (HQ) {
        float am = 0.f;
#pragma unroll
        for (int j = 0; j < 16; ++j) am = fmaxf(am, fabsf(o[j]));
        am = fmaxf(am, dpp_mov<0xB1>(am)); am = fmaxf(am, dpp_mov<0x4E>(am)); am = fmaxf(am, dpp_mov<0x124>(am)); am = fmaxf(am, dpp_mov<0x128>(am));
        float hinv = am > 0.f ? 119.f / am : 0.f; float hsc = am * (1.f / 119.f);
        float hsum = 0.f; unsigned pk[4];
#pragma unroll
        for (int k = 0; k < 2; ++k) {
          unsigned w0 = 0, w1 = 0;
#pragma unroll
          for (int j = 0; j < 4; ++j) {
            float r0 = rintf(o[8 * k + j] * hinv), r1 = rintf(o[8 * k + 4 + j] * hinv);
            hsum += r0 + r1;
            w0 = __builtin_amdgcn_cvt_pk_u8_f32(r0 + 128.f, j, w0); w1 = __builtin_amdgcn_cvt_pk_u8_f32(r1 + 128.f, j, w1);
          }
          unsigned t0 = (w0 + 0x08080808u) ^ 0x88888888u, t1 = (w1 + 0x08080808u) ^ 0x88888888u;
          pk[2 * k] = (t0 & 0xF0F0F0F0u) | ((t1 >> 4) & 0x0F0F0F0Fu);
          pk[2 * k + 1] = ((t0 << 4) & 0xF0F0F0F0u) | (t1 & 0x0F0F0F0Fu);
        }
        hsum += dpp_mov<0xB1>(hsum); hsum += dpp_mov<0x4E>(hsum); hsum += dpp_mov<0x124>(hsum); hsum += dpp_mov<0x128>(hsum);
        *(uint4*)(HQ + (size_t)row * D + 16 * lane) = make_uint4(pk[0], pk[1], pk[2], pk[3]);
        if ((lane & 15) == 0) *(float2*)(HS + ((size_t)row * 4 + (lane >> 4)) * 2) = make_float2(hsc, 0.5f * hsc * hsum);
      }
    }
  }
}


template <int CTRL> __device__ __forceinline__ float dpp_add(float x) { return x + dpp_mov<CTRL>(x); }
__device__ __forceinline__ float sum8(float v) {
  v = dpp_add<0xB1>(v); v = dpp_add<0x4E>(v); v = dpp_add<0x141>(v); return v;
}
typedef _Float16 half2_t __attribute__((ext_vector_type(2)));
__device__ __forceinline__ float dot2h(unsigned a, unsigned b, float c) {
  return __builtin_amdgcn_fdot2(__builtin_bit_cast(half2_t, a), __builtin_bit_cast(half2_t, b), c, false);
}
__device__ __forceinline__ unsigned pkh(float a, float b) { return __builtin_bit_cast(unsigned, __builtin_amdgcn_cvt_pkrtz(a, b)); }
__device__ __forceinline__ void load_e16(const int* __restrict__ EXP, int t, int g8, int (&e)[16]) {
  const int4* ep = (const int4*)(EXP + (size_t)t * 128 + 16 * g8);
  int4 a = ep[0], b = ep[1], c = ep[2], d = ep[3];
  e[0] = a.x; e[1] = a.y; e[2] = a.z; e[3] = a.w; e[4] = b.x; e[5] = b.y; e[6] = b.z; e[7] = b.w;
  e[8] = c.x; e[9] = c.y; e[10] = c.z; e[11] = c.w; e[12] = d.x; e[13] = d.y; e[14] = d.z; e[15] = d.w;
}
__device__ __forceinline__ int dpp_iadd_b1(int v) { return v + __builtin_amdgcn_mov_dpp(v, 0xB1, 0xf, 0xf, true); }
__device__ __forceinline__ int dpp_iadd_4e(int v) { return v + __builtin_amdgcn_mov_dpp(v, 0x4E, 0xf, 0xf, true); }
__device__ __forceinline__ int dpp_iadd_141(int v) { return v + __builtin_amdgcn_mov_dpp(v, 0x141, 0xf, 0xf, true); }
#define U_TOKEN(tt, UV, UVN, EUSE, ELD, HUSE, HLD, SUSE, SLD) { \
    int tnn_ = min((tt) + 2 * st, nrows - 1); \
    load_e16(EXP, tnn_, g8, ELD); \
    HLD[0] = *(const uint4*)(hb + (size_t)tnn_ * D); HLD[1] = *(const uint4*)(hb + (size_t)tnn_ * D + 16); \
    SLD = *(const float2*)(HS + ((size_t)tnn_ * 4 + x) * 2); \
    __builtin_amdgcn_sched_barrier(0); \
    _Pragma("unroll") for (int i = 0; i < 16; ++i) UVN[i] = *(const uint4*)(ubs + (((unsigned)EUSE[i] << 7) + loff)); \
    __builtin_amdgcn_sched_barrier(0); \
    int a0_ = (int)HUSE[0].x, b0_ = (int)HUSE[0].y, a1_ = (int)HUSE[0].z, b1_ = (int)HUSE[0].w; \
    int a2_ = (int)HUSE[1].x, b2_ = (int)HUSE[1].y, a3_ = (int)HUSE[1].z, b3_ = (int)HUSE[1].w; \
    int k0 = 0, k1 = 0; \
    _Pragma("unroll") for (int i = 0; i < 16; ++i) { \
      int pa_ = __builtin_amdgcn_sdot8((int)UV[i].x, a0_, 0, false); pa_ = __builtin_amdgcn_sdot8((int)UV[i].y, a1_, pa_, false); \
      pa_ = __builtin_amdgcn_sdot8((int)UV[i].z, a2_, pa_, false); pa_ = __builtin_amdgcn_sdot8((int)UV[i].w, a3_, pa_, false); \
      int pb_ = __builtin_amdgcn_sdot8((int)UV[i].x, b0_, 0, false); pb_ = __builtin_amdgcn_sdot8((int)UV[i].y, b1_, pb_, false); \
      pb_ = __builtin_amdgcn_sdot8((int)UV[i].z, b2_, pb_, false); pb_ = __builtin_amdgcn_sdot8((int)UV[i].w, b3_, pb_, false); \
      int p_ = dpp_iadd_141(dpp_iadd_4e(dpp_iadd_b1((pa_ << 4) + pb_))); \
      if ((i >> 1) == j8) { if (i & 1) k1 = p_; else k0 = p_; } } \
    *(float2*)(PA + ((size_t)(tt) * 4 + x) * 128 + 16 * g8 + 2 * j8) = make_float2(fmaf((float)k0, SUSE.x, SUSE.y), fmaf((float)k1, SUSE.x, SUSE.y)); }
__device__ __forceinline__ void ph_peer_u(const unsigned char* __restrict__ HQ, const float* __restrict__ HS, const int* __restrict__ EXP,
                                          const unsigned char* __restrict__ U4, float* __restrict__ PA, int nrows) {
  int lane = threadIdx.x & 63, wave = __builtin_amdgcn_readfirstlane(threadIdx.x >> 6);
  int x = (blockIdx.x & 7) >> 1; int nb8 = gridDim.x >> 3;
  if ((int)(blockIdx.x >> 3) >= nb8) return;
  int j8 = lane & 7, g8 = lane >> 3;
  const int st = nb8 * 8;
  int t = ((blockIdx.x >> 3) * 2 + (blockIdx.x & 1)) * 4 + wave;
  if (t >= nrows) return;
  const unsigned char* ubs = U4 + (size_t)x * ((size_t)16384 * 128);
  const unsigned loff = 16u * (unsigned)j8;
  const unsigned char* hb = HQ + 256 * x + 32 * j8;
  int eA[16], eB[16]; uint4 hA[2], hB[2], uvA[16], uvB[16]; float2 sA, sB;
  {
    int e0[16]; load_e16(EXP, t, g8, e0);
#pragma unroll
    for (int i = 0; i < 16; ++i) uvA[i] = *(const uint4*)(ubs + (((unsigned)e0[i] << 7) + loff));
    hA[0] = *(const uint4*)(hb + (size_t)t * D); hA[1] = *(const uint4*)(hb + (size_t)t * D + 16);
    sA = *(const float2*)(HS + ((size_t)t * 4 + x) * 2);
    int tn = min(t + st, nrows - 1);
    load_e16(EXP, tn, g8, eA);
    hB[0] = *(const uint4*)(hb + (size_t)tn * D); hB[1] = *(const uint4*)(hb + (size_t)tn * D + 16);
    sB = *(const float2*)(HS + ((size_t)tn * 4 + x) * 2);
  }
#pragma unroll 1
  for (; t < nrows; t += 2 * st) {
    uint4 hC[2]; float2 sC;
    U_TOKEN(t, uvA, uvB, eA, eB, hA, hC, sA, sC)
    if (t + st < nrows) {
      U_TOKEN(t + st, uvB, uvA, eB, eA, hB, hA, sB, sA)
    }
    hB[0] = hA[0]; hB[1] = hA[1]; hA[0] = hC[0]; hA[1] = hC[1]; sB = sA; sA = sC;
  }
}
__device__ __forceinline__ void ph_peer_w(const float* __restrict__ PA, const int* __restrict__ EXP, const float* __restrict__ GATE,
                                          const float* __restrict__ USC, const float* __restrict__ VSC, unsigned* __restrict__ WQ,
                                          float* __restrict__ SW, int nrows) {
  int lane = threadIdx.x & 63, wave = __builtin_amdgcn_readfirstlane(threadIdx.x >> 6);
  int l4 = lane & 31;
  for (int t = blockIdx.x * 4 + wave; t < nrows; t += gridDim.x * 4) {
    int4 e = *(const int4*)(EXP + (size_t)t * 128 + 4 * l4);
    float4 gt = *(const float4*)(GATE + (size_t)t * 128 + 4 * l4);
    float a[4] = {0.f, 0.f, 0.f, 0.f};
#pragma unroll
    for (int xs = 0; xs < 4; ++xs) { float4 p = *(const float4*)(PA + ((size_t)t * 4 + xs) * 128 + 4 * l4); a[0] += p.x; a[1] += p.y; a[2] += p.z; a[3] += p.w; }
    int ee[4] = {e.x, e.y, e.z, e.w}; float gg[4] = {gt.x, gt.y, gt.z, gt.w}; float w[4]; float wm = 0.f;
#pragma unroll
    for (int j = 0; j < 4; ++j) {
      float av = a[j] * USC[ee[j]];
      w[j] = gg[j] * 0.5f * av * (1.f + erff(av * 0.70710678118654752f)) * VSC[ee[j]];
      wm = fmaxf(wm, fabsf(w[j]));
    }
    wm = wave_max(wm);
    float winv = wm > 0.f ? 127.f / wm : 0.f;
    unsigned q = 0;
#pragma unroll
    for (int j = 0; j < 4; ++j) q = __builtin_amdgcn_cvt_pk_u8_f32(rintf(w[j] * winv) + 128.f, j, q);
    if (lane < 32) WQ[(size_t)t * 32 + l4] = q ^ 0x80808080u;
    if (lane == 0) SW[t] = wm * (1.f / 127.f);
  }
}
__device__ __forceinline__ void load_w16(const float* __restrict__ W, int t, int g8, float (&w)[16]) {
  const float4* wp = (const float4*)(W + (size_t)t * 128 + 16 * g8);
  float4 wa = wp[0], wb = wp[1], wc = wp[2], wd = wp[3];
  w[0] = wa.x; w[1] = wa.y; w[2] = wa.z; w[3] = wa.w; w[4] = wb.x; w[5] = wb.y; w[6] = wb.z; w[7] = wb.w;
  w[8] = wc.x; w[9] = wc.y; w[10] = wc.z; w[11] = wc.w; w[12] = wd.x; w[13] = wd.y; w[14] = wd.z; w[15] = wd.w;
}
#define V_TOKEN(tt, VV, VVN, EUSE, ELD, WUSE, WLD, SUSE, SLD) { \
    int tnn_ = min((tt) + 2 * st, nrows - 1); \
    load_e16(EXP, tnn_, g8, ELD); \
    WLD = *(const uint4*)(WQ + (size_t)tnn_ * 32 + 4 * g8); SLD = SW[tnn_]; \
    __builtin_amdgcn_sched_barrier(0); \
    _Pragma("unroll") for (int i = 0; i < 16; ++i) VVN[i] = *(const uint4*)(vbs + (((unsigned)EUSE[i] << 7) + loff)); \
    __builtin_amdgcn_sched_barrier(0); \
    int acc[16]; \
    _Pragma("unroll") for (int j = 0; j < 16; ++j) acc[j] = 0; \
    int wq[4] = {(int)WUSE.x, (int)WUSE.y, (int)WUSE.z, (int)WUSE.w}; \
    _Pragma("unroll") for (int m = 0; m < 4; ++m) { \
      unsigned r0[4] = {VV[4 * m].x, VV[4 * m].y, VV[4 * m].z, VV[4 * m].w}; \
      unsigned r1[4] = {VV[4 * m + 1].x, VV[4 * m + 1].y, VV[4 * m + 1].z, VV[4 * m + 1].w}; \
      unsigned r2[4] = {VV[4 * m + 2].x, VV[4 * m + 2].y, VV[4 * m + 2].z, VV[4 * m + 2].w}; \
      unsigned r3[4] = {VV[4 * m + 3].x, VV[4 * m + 3].y, VV[4 * m + 3].z, VV[4 * m + 3].w}; \
      _Pragma("unroll") for (int k = 0; k < 4; ++k) { \
          \
        unsigned a0 = __builtin_amdgcn_perm(r1[k], r0[k], 0x05010400u);     \
        unsigned a1 = __builtin_amdgcn_perm(r1[k], r0[k], 0x07030602u);     \
        unsigned a2 = __builtin_amdgcn_perm(r3[k], r2[k], 0x05010400u); \
        unsigned a3 = __builtin_amdgcn_perm(r3[k], r2[k], 0x07030602u); \
        unsigned t0 = __builtin_amdgcn_perm(a2, a0, 0x05040100u);           \
        unsigned t1 = __builtin_amdgcn_perm(a2, a0, 0x07060302u); \
        unsigned t2 = __builtin_amdgcn_perm(a3, a1, 0x05040100u); \
        unsigned t3 = __builtin_amdgcn_perm(a3, a1, 0x07060302u); \
        acc[4 * k + 0] = __builtin_amdgcn_sdot4((int)t0, wq[m], acc[4 * k + 0], false); \
        acc[4 * k + 1] = __builtin_amdgcn_sdot4((int)t1, wq[m], acc[4 * k + 1], false); \
        acc[4 * k + 2] = __builtin_amdgcn_sdot4((int)t2, wq[m], acc[4 * k + 2], false); \
        acc[4 * k + 3] = __builtin_amdgcn_sdot4((int)t3, wq[m], acc[4 * k + 3], false); } } \
    float of[16]; \
    _Pragma("unroll") for (int j = 0; j < 16; ++j) { float v = (float)acc[j]; v += dpp_mov<0x128>(v); of[j] = xrow16_sum(v) * SUSE; } \
    if (g8 == 0) { \
      uint4* fp = (uint4*)(F + (size_t)(tt) * D + 128 * x + 16 * j8); \
      fp[0] = make_uint4(pack2bf(of[0], of[1]), pack2bf(of[2], of[3]), pack2bf(of[4], of[5]), pack2bf(of[6], of[7])); \
      fp[1] = make_uint4(pack2bf(of[8], of[9]), pack2bf(of[10], of[11]), pack2bf(of[12], of[13]), pack2bf(of[14], of[15])); } }
__device__ __forceinline__ void ph_peer_v(const unsigned* __restrict__ WQ, const float* __restrict__ SW, const int* __restrict__ EXP,
                                          const unsigned char* __restrict__ V8, bf16_t* __restrict__ F, int nrows) {
  int lane = threadIdx.x & 63, wave = __builtin_amdgcn_readfirstlane(threadIdx.x >> 6);
  int x = blockIdx.x & 7; int nb8 = gridDim.x >> 3;
  if ((int)(blockIdx.x >> 3) >= nb8) return;
  int j8 = lane & 7, g8 = lane >> 3;
  const int st = nb8 * 4;
  int t = (blockIdx.x >> 3) * 4 + wave;
  if (t >= nrows) return;
  const unsigned char* vbs = V8 + (size_t)x * ((size_t)16384 * 128);
  const unsigned loff = 16u * (unsigned)j8;
  int eA[16], eB[16]; uint4 wA, wB, vvA[16], vvB[16]; float sA, sB;
  {
    int e0[16]; load_e16(EXP, t, g8, e0);
#pragma unroll
    for (int i = 0; i < 16; ++i) vvA[i] = *(const uint4*)(vbs + (((unsigned)e0[i] << 7) + loff));
    wA = *(const uint4*)(WQ + (size_t)t * 32 + 4 * g8); sA = SW[t];
    int tn = min(t + st, nrows - 1);
    load_e16(EXP, tn, g8, eA);
    wB = *(const uint4*)(WQ + (size_t)tn * 32 + 4 * g8); sB = SW[tn];
  }
#pragma unroll 1
  for (; t < nrows; t += 2 * st) {
    uint4 wC; float sC;
    V_TOKEN(t, vvA, vvB, eA, eB, wA, wC, sA, sC)
    if (t + st < nrows) {
      V_TOKEN(t + st, vvB, vvA, eB, eA, wB, wA, sB, sA)
    }
    wB = wA; sB = sA; wA = wC; sA = sC;
  }
}

#define XB_TMO      128
#define XB_XCNT(j)  (256  + 64 * (j))
#define XB_XSUB(j)  (1280 + 64 * (j))
#define XB_XGEN(j)  (2304 + 64 * (j))
#define XB_TOP      3328
#define XB_TOPGEN   3392
#define XCD_BAR_WORDS 3456
#define XB_SPIN_CAP (1u << 22)
#define LAS __attribute__((address_space(3)))
__device__ __forceinline__ unsigned xb_ld(unsigned* p)              { return __hip_atomic_load(p, __ATOMIC_RELAXED, __HIP_MEMORY_SCOPE_AGENT); }
__device__ __forceinline__ unsigned xb_add(unsigned* p, unsigned v) { return __hip_atomic_fetch_add(p, v, __ATOMIC_RELAXED, __HIP_MEMORY_SCOPE_AGENT); }
__device__ __forceinline__ unsigned xb_xcc_id() { return (unsigned)__builtin_amdgcn_s_getreg((3 << 11) | 20) & 0xFu; }
#define XB_SPIN(cond, bar) do { unsigned _sp = 0; while (cond) { __builtin_amdgcn_s_sleep(1); \
    if ((++_sp & 255u) == 0u) { if (xb_ld(&(bar)[XB_TMO])) break; if (_sp > XB_SPIN_CAP) { atomicAdd(&(bar)[XB_TMO], 1u); break; } } } } while (0)
struct XcdBarrier { unsigned* bar; unsigned x; volatile LAS unsigned* st; };
__device__ __forceinline__ XcdBarrier xcd_barrier_post(unsigned* bar, volatile LAS unsigned* st) {
  XcdBarrier b; b.bar = bar; b.x = xb_xcc_id(); b.st = st;
  if (threadIdx.x == 0) (void)xb_add(&bar[XB_XCNT(b.x)], 1u);
  return b;
}
__device__ __forceinline__ void xcd_barrier_complete(unsigned* bar, unsigned x, unsigned& nloc, unsigned& nx) {
  const unsigned G = gridDim.x * gridDim.y * gridDim.z;
  unsigned sum, cnt, mine, sp = 0u;
  for (;;) {
    sum = 0u; cnt = 0u; mine = 0u;
#pragma unroll
    for (unsigned j = 0; j < 16; ++j) { const unsigned c = xb_ld(&bar[XB_XCNT(j)]); sum += c; cnt += (c > 0u) ? 1u : 0u; mine = (j == x) ? c : mine; }
    if (sum == G) break;
    __builtin_amdgcn_s_sleep(1);
    if ((++sp & 255u) == 0u) { if (xb_ld(&bar[XB_TMO])) break; if (sp > XB_SPIN_CAP) { atomicAdd(&bar[XB_TMO], 1u); break; } }
  }
  nloc = mine > 0u ? mine : 1u; nx = cnt > 0u ? cnt : 1u;
}
__device__ __forceinline__ void xcd_barrier(const XcdBarrier& b) {
  asm volatile("s_waitcnt vmcnt(0)" ::: "memory");
  __syncthreads();
  if (threadIdx.x == 0) {
    unsigned* bar = b.bar;
    __builtin_amdgcn_s_waitcnt(0);
    unsigned nloc = b.st[0], nx = b.st[1];
    if (nloc == 0u) { xcd_barrier_complete(bar, b.x, nloc, nx); b.st[0] = nloc; b.st[1] = nx; }
    const unsigned old = xb_add(&bar[XB_XSUB(b.x)], 1u);
    const unsigned gen = old / nloc;
    if (old + 1u == (gen + 1u) * nloc) {
      __builtin_amdgcn_fence(__ATOMIC_RELEASE, "agent");
      asm volatile("s_waitcnt vmcnt(0)" ::: "memory");
      const unsigned og = xb_add(&bar[XB_TOP], 1u);
      const unsigned tg = og / nx;
      if (og + 1u == (tg + 1u) * nx) xb_add(&bar[XB_TOPGEN], 1u);
      else XB_SPIN(xb_ld(&bar[XB_TOPGEN]) == tg, bar);
      __builtin_amdgcn_fence(__ATOMIC_ACQUIRE, "agent");
      xb_add(&bar[XB_XGEN(b.x)], 1u);
      asm volatile("s_waitcnt vmcnt(0)" ::: "memory");
    } else {
      XB_SPIN(xb_ld(&bar[XB_XGEN(b.x)]) == gen, bar);
      __builtin_amdgcn_fence(__ATOMIC_ACQUIRE, "agent");
      asm volatile("s_waitcnt vmcnt(0)" ::: "memory");
    }
  }
  __syncthreads();
}

constexpr int SMEM_BYTES = 65536;
#ifndef PHMASK
#define PHMASK 0xFFFFFFFFFFFFFFFFull
#endif
#ifndef PHDUP
#define PHDUP 0ull
#endif
#define PH(n, ...) if constexpr ((((unsigned long long)(PHMASK)) >> (n)) & 1ull) { __VA_ARGS__; if constexpr ((((unsigned long long)(PHDUP)) >> (n)) & 1ull) { xcd_barrier(xbar); __VA_ARGS__; } }

__global__ __launch_bounds__(256, 2) void mega(Params p) {
  __shared__ __attribute__((aligned(16))) char smem_raw[SMEM_BYTES + 16];
  if (threadIdx.x == 0) *(uint4*)(smem_raw + SMEM_BYTES) = make_uint4(0u, 0u, 0u, 0u);
  __syncthreads();
  XcdBarrier xbar = xcd_barrier_post((unsigned*)((char*)p.ws + OFF_BAR), (volatile LAS unsigned*)(smem_raw + SMEM_BYTES));
  float* smem = (float*)smem_raw;
  const float* x = p.in[0]; const float* c = p.in[1]; const float* ctx = p.in[2]; const float* c_ctx = p.in[3];
  const float* ada_w = p.in[4]; const float* ada_b = p.in[5]; const float* ln_g = p.in[6]; const float* ln_b = p.in[7];
  const float* even_w_in = p.in[8]; const float* even_w_out = p.in[9]; const float* rpb = p.in[10];
  const float* odd_w_in = p.in[11]; const float* odd_w_out = p.in[12]; const float* sink = p.in[13];
  const float* peer_wq = p.in[14]; const float* peer_sk = p.in[15]; const float* peer_u = p.in[16]; const float* peer_v = p.in[17];
  char* ws = (char*)p.ws;
  float* TAB = (float*)(ws + OFF_TAB); float* Mm = (float*)(ws + OFF_M);
  bf16_t* WIN0 = (bf16_t*)(ws + OFF_WIN0); bf16_t* WOUT0 = (bf16_t*)(ws + OFF_WOUT0);
  bf16_t* WIN1 = (bf16_t*)(ws + OFF_WIN1); bf16_t* WOUT1 = (bf16_t*)(ws + OFF_WOUT1);
  bf16_t* WQ = (bf16_t*)(ws + OFF_WQ); bf16_t* SKB = (bf16_t*)(ws + OFF_SK);
  unsigned char* U8 = (unsigned char*)(ws + OFF_UB); unsigned char* V8 = (unsigned char*)(ws + OFF_VB);
  float* USC = (float*)(ws + OFF_USC); float* VSC = USC + 2 * 16384;
  bf16_t* AB = (bf16_t*)(ws + OFF_AB);
  bf16_t* FD1 = (bf16_t*)(ws + OFF_FT); bf16_t* FD3 = FD1 + 256 * 128; bf16_t* FDC = FD3 + 128 * 128;
  bf16_t* A1 = (bf16_t*)(ws + OFF_A1); bf16_t* VT0 = (bf16_t*)(ws + OFF_VT0); bf16_t* FQKV = (bf16_t*)(ws + OFF_BF);
  float* BF_ = (float*)(ws + OFF_BF); float* BY = (float*)(ws + OFF_BY);
  float* X1 = (float*)(ws + OFF_X1); float* X2 = (float*)(ws + OFF_X2);
  float* RT = TAB + 16384;
  bf16_t* Q1 = (bf16_t*)(ws + OFF_BF); bf16_t* K1 = Q1 + (size_t)T * 1024; bf16_t* VT1 = K1 + (size_t)R * 256;
  bf16_t* YB = (bf16_t*)(ws + OFF_BY + (size_t)2 * R * 128 * 4);
  float* PAB = (float*)(ws + OFF_BF); bf16_t* FB = (bf16_t*)(ws + OFF_BF + (size_t)R * 8 * 128 * 4);
  float* WB = (float*)(ws + OFF_BF + (size_t)R * 8 * 128 * 4 + (size_t)R * 1024 * 2); float* CORRB = WB + (size_t)R * 128;
  unsigned char* HQB = (unsigned char*)(ws + OFF_BF + (size_t)R * 8 * 128 * 4 + (size_t)R * 1024 * 2 + (size_t)R * 129 * 4);
  float* HSB = (float*)(HQB + (size_t)R * 1024);
  int* EXPB = (int*)(ws + OFF_BY); float* GATEB = (float*)(ws + OFF_BY + (size_t)R * 128 * 4);
  float* out = p.out;
  unsigned* QC = (unsigned*)(ws + OFF_BAR) + 32;
#define QFILL(site, layer, lo, hi) quant_fill(QC + (site), (layer), (lo), (hi), peer_u, peer_v, U8, V8, USC, VSC, (unsigned*)(smem_raw + 65024))

  PH(0, ph_tables(TAB); ph_rope_table(RT))
  PH(1, ph_fft_tables(FD1, FD3, FDC))
  PH(2, ph_ada2(c, c_ctx, ada_w, ada_b, Mm, smem))
  PH(3, ph_transpose_w(even_w_in, 1024, 2048, WIN0, smem))
  PH(4, ph_transpose_w(even_w_out, 1024, 1024, WOUT0, smem))
  PH(5, ph_transpose_w(odd_w_in, 1024, 1536, WIN1, smem))
  PH(6, ph_transpose_w(odd_w_out, 1024, 1024, WOUT1, smem))
  PH(7, ph_transpose_w(peer_wq, 1024, 2048, WQ, smem))
  PH(8, ph_transpose_w(peer_wq + (size_t)1024 * 2048, 1024, 2048, WQ + (size_t)2048 * 1024, smem))
  PH(11, ph_convert(peer_sk, SKB, (size_t)2 * 8 * 2 * 128 * 128 / 8))
  xcd_barrier(xbar);
  PH(12, ph_modulate(x, ctx, Mm, 0, 0, 1, AB, R, smem))
  xcd_barrier(xbar);
  PH(13, ph_gemm_bf16(AB, 1024, WIN0, 1024, R, 2048, 1024, EpiQKV0{FQKV, VT0}, smem_raw))
  PH(9, QFILL(0, 0, 0u, 160u))
  xcd_barrier(xbar);
  PH(14, { GRID_LOOP(u, NB * 64 * 8) fft1_unit(u, FQKV, FD1, TAB, A1, smem_raw); })
  PH(15, { int lane = threadIdx.x & 63, wave = __builtin_amdgcn_readfirstlane(threadIdx.x >> 6);
           __syncthreads();
           for (int i = threadIdx.x; i < 8 * 15 * 31; i += 256) smem[i] = rpb[i] * 1.4426950408889634f;
           __syncthreads();
           for (int bu = blockIdx.x; bu < 512 + 64; bu += gridDim.x) {
             if (bu < 512) { int h = bu & 7, rg = (bu >> 3) & 31, bb = bu >> 8;
               na_unit(bb, h, rg * 4 + wave, FQKV, VT0, VT0 + (size_t)NB * 8 * 64 * S, smem, AB, lane); }
             else { int cu = bu - 512; int h = cu & 7, qg = (cu >> 3) & 3, bb = cu >> 5;
               attn_unit<1, 1, 2, true>(bb, h, 0, 0, qg * 4 + wave, FQKV + 512, 2048, FQKV + 1024, 2048, VT0, VT0 + (size_t)NB * 8 * 64 * S, 8, smem, nullptr, AB + 512, 1024, lane); } } })
  xcd_barrier(xbar);
  PH(16, { GRID_LOOP(u, NB * 128 * 8 + NB * 4 * 8) { if (u < NB * 128 * 8) fft3_unit(u, 0, FQKV, A1, FD3, FDC, TAB, AB, smem_raw); else fft3_unit(u - NB * 128 * 8, 1, FQKV, A1, FD3, FDC, TAB, AB, smem_raw); } })
  xcd_barrier(xbar);
  PH(17, ph_gemm_bf16(AB, 1024, WOUT0, 1024, R, 1024, 1024, EpiBf16{YB, 1024}, smem_raw))
  PH(9, QFILL(1, 0, 160u, 260u))
  xcd_barrier(xbar);
  PH(18, ph_post_mod(x, ctx, YB, Mm, 0, 2, 0, 3, 4, true, ln_g + 0, ln_b + 0, X1, AB, R, HQB, HSB))
  xcd_barrier(xbar);
  PH(21, ph_peer_select(AB, WQ, SKB, EXPB, GATEB, R, smem_raw))
  PH(9, QFILL(2, 0, 260u, 512u))
  PH(10, QFILL(3, 1, 0u, 300u))
  xcd_barrier(xbar);
  PH(22, ph_peer_u(HQB, HSB, EXPB, U8, PAB, R))
  xcd_barrier(xbar);
  PH(32, ph_peer_w(PAB, EXPB, GATEB, USC, VSC, (unsigned*)WB, CORRB, R))
  xcd_barrier(xbar);
  PH(33, ph_peer_v((const unsigned*)WB, CORRB, EXPB, V8, FB, R))
  xcd_barrier(xbar);
  PH(34, ph_post_mod(X1, X1 + (size_t)T * D, FB, Mm, 0, 5, 1, 0, 1, true, ln_g + 1024, ln_b + 1024, X2, AB, R))
  xcd_barrier(xbar);
  PH(23, ph_gemm_bf16(AB, 1024, WIN1, 1024, R, 1536, 1024, EpiQKV1{Q1, K1, VT1, RT}, smem_raw))
  PH(10, QFILL(4, 1, 300u, 420u))
  xcd_barrier(xbar);
  PH(25, { int lane = threadIdx.x & 63, wave = __builtin_amdgcn_readfirstlane(threadIdx.x >> 6);
           for (int bu = blockIdx.x; bu < 1024; bu += gridDim.x) { int kvh = bu & 3, bb = (bu >> 2) & 1, qg = bu >> 3;
             attn_unit<4, 2, 1, true>(bb, kvh, 0, 0, qg * 4 + wave, Q1, 1024, K1, 256, VT1, VT1 + (size_t)NB * 4 * 64 * S, 4, nullptr, sink, AB, 1024, lane); } })
  xcd_barrier(xbar);
  PH(26, ph_gemm_bf16(AB, 1024, WOUT1, 1024, T, 1024, 1024, EpiBf16{YB, 1024}, smem_raw))
  xcd_barrier(xbar);
  PH(27, ph_post_mod(X2, X2, YB, Mm, 1, 2, 1, 3, 4, true, ln_g + 2048, ln_b + 2048, X1, AB, T, HQB, HSB))
  xcd_barrier(xbar);
  PH(30, ph_peer_select(AB, WQ + (size_t)2048 * 1024, SKB + (size_t)8 * 2 * 128 * 128, EXPB, GATEB, T, smem_raw))
  PH(10, QFILL(5, 1, 420u, 512u))
  xcd_barrier(xbar);
  PH(31, ph_peer_u(HQB, HSB, EXPB, U8 + (size_t)16384 * 512, PAB, T))
  xcd_barrier(xbar);
  PH(35, ph_peer_w(PAB, EXPB, GATEB, USC + 16384, VSC + 16384, (unsigned*)WB, CORRB, T))
  xcd_barrier(xbar);
  PH(36, ph_peer_v((const unsigned*)WB, CORRB, EXPB, V8 + (size_t)16384 * 1024, FB, T))
  xcd_barrier(xbar);
  PH(37, ph_post_mod(X1, X1, FB, Mm, 1, 5, 1, 0, 1, false, ln_g + 3072, ln_b + 3072, out, AB, T))
}

}

extern "C" void kernel_launch(void* const* d_in, const int* in_sizes, int n_in, void* d_out, int out_size, void* d_ws,
                              size_t ws_size, hipStream_t stream) {
  static int grid_blocks = 0;
  if (!grid_blocks) {
    int dev = 0, cus = 0, per_cu = 0;
    hipGetDevice(&dev);
    hipDeviceGetAttribute(&cus, hipDeviceAttributeMultiprocessorCount, dev);
    hipOccupancyMaxActiveBlocksPerMultiprocessor(&per_cu, (const void*)mega, 256, 0);
    if (per_cu > 2) per_cu = 2;
    if (per_cu < 1) per_cu = 1;
    grid_blocks = cus * per_cu;
  }
  Params p{};
  for (int i = 0; i < 18; ++i) p.in[i] = (const float*)d_in[i];
  p.out = (float*)d_out;
  p.ws = (float*)d_ws;
  (void)hipMemsetAsync((char*)d_ws + OFF_BAR, 0, XCD_BAR_WORDS_C * 4, stream);
  void* args[] = {&p};
  hipError_t e = hipLaunchCooperativeKernel((const void*)mega, dim3(grid_blocks), dim3(256), args, 0, stream);
  if (e != hipSuccess) fprintf(stderr, "cooperative launch failed: %s (grid %d)\n", hipGetErrorString(e), grid_blocks);
}
```

```cpp
#include <hip/hip_runtime.h>
#include <hip/hip_bf16.h>
#include <stdint.h>
#include <math.h>
#include <stdio.h>
#include <hip/hip_cooperative_groups.h>
namespace cg = cooperative_groups;

namespace {

constexpr int D = 1024;
constexpr int NB = 2;
constexpr int S = 8192;
constexpr int T = NB * S;
constexpr int CL = 256;
constexpr int TC = NB * CL;
constexpr int R = T + TC;
constexpr float DN_ALPHA = 1.4142135623730951f;
constexpr float LN_EPS = 1e-6f;

template <int CTRL> __device__ __forceinline__ float dpp_mov(float x) {
  return __builtin_bit_cast(float, __builtin_amdgcn_mov_dpp(__builtin_bit_cast(int, x), CTRL, 0xf, 0xf, true));
}
__device__ __forceinline__ float xrow16_max(float x) {
  auto s = __builtin_amdgcn_permlane16_swap(__float_as_uint(x), __float_as_uint(x), false, false);
  x = fmaxf(__uint_as_float(s[0]), __uint_as_float(s[1]));
  auto t = __builtin_amdgcn_permlane32_swap(__float_as_uint(x), __float_as_uint(x), false, false);
  return fmaxf(__uint_as_float(t[0]), __uint_as_float(t[1]));
}
__device__ __forceinline__ float xrow16_sum(float x) {
  auto s = __builtin_amdgcn_permlane16_swap(__float_as_uint(x), __float_as_uint(x), false, false);
  x = __uint_as_float(s[0]) + __uint_as_float(s[1]);
  auto t = __builtin_amdgcn_permlane32_swap(__float_as_uint(x), __float_as_uint(x), false, false);
  return __uint_as_float(t[0]) + __uint_as_float(t[1]);
}
__device__ __forceinline__ float wave_sum(float v) {
  v += dpp_mov<0xB1>(v); v += dpp_mov<0x4E>(v); v += dpp_mov<0x124>(v); v += dpp_mov<0x128>(v);
  return xrow16_sum(v);
}
__device__ __forceinline__ float wave_max(float v) {
  v = fmaxf(v, dpp_mov<0xB1>(v)); v = fmaxf(v, dpp_mov<0x4E>(v)); v = fmaxf(v, dpp_mov<0x124>(v)); v = fmaxf(v, dpp_mov<0x128>(v));
  return xrow16_max(v);
}

typedef unsigned short bf16_t;
typedef __attribute__((ext_vector_type(8))) short bf16x8;
typedef __attribute__((ext_vector_type(16))) float f32x16;
typedef __attribute__((ext_vector_type(4))) float f32x4;

typedef __attribute__((ext_vector_type(2))) __bf16 bf16x2_t;
__device__ __forceinline__ unsigned f2bf(float f) { return (unsigned)__builtin_bit_cast(unsigned short, (__bf16)f); }
__device__ __forceinline__ unsigned pack2bf(float a, float b) { bf16x2_t v = {(__bf16)a, (__bf16)b}; return __builtin_bit_cast(unsigned, v); }
__device__ __forceinline__ float bf2f(unsigned short v) { return __uint_as_float(((unsigned)v) << 16); }

__device__ __forceinline__ int mod_index(int row) { return row < T ? row / S : 2; }


struct Params {
  const float* in[18];
  float* out;
  float* ws;
};

constexpr size_t XCD_BAR_WORDS_C = 3456;
constexpr size_t al256(size_t n) { return (n + 255) & ~(size_t)255; }
constexpr size_t OFF_BAR = 0;
constexpr size_t OFF_TAB = al256(XCD_BAR_WORDS_C * 4);
constexpr size_t OFF_M = OFF_TAB + al256(16384 * 4 + 128 * 16 * 2 * 4);
constexpr size_t OFF_WIN0 = OFF_M + al256(2 * 3 * 6144 * 4);
constexpr size_t OFF_WOUT0 = OFF_WIN0 + al256((size_t)2048 * 1024 * 2);
constexpr size_t OFF_WIN1 = OFF_WOUT0 + al256((size_t)1024 * 1024 * 2);
constexpr size_t OFF_WOUT1 = OFF_WIN1 + al256((size_t)1536 * 1024 * 2);
constexpr size_t OFF_WQ = OFF_WOUT1 + al256((size_t)1024 * 1024 * 2);
constexpr size_t OFF_SK = OFF_WQ + al256((size_t)2 * 2048 * 1024 * 2);
constexpr size_t OFF_UB = OFF_SK + al256((size_t)2 * 8 * 2 * 128 * 128 * 2);
constexpr size_t OFF_VB = OFF_UB + al256((size_t)2 * 16384 * 1024);
constexpr size_t OFF_USC = OFF_VB + al256((size_t)2 * 16384 * 1024);
constexpr size_t OFF_AB = OFF_USC + al256((size_t)4 * 16384 * 4);
constexpr size_t OFF_FT = OFF_AB + al256((size_t)R * 1024 * 2);
constexpr size_t OFF_BF = OFF_FT + al256((size_t)(256 * 128 + 128 * 128 + 64 * 128) * 2);
constexpr size_t OFF_BY = OFF_BF + al256((size_t)R * 2048 * 4);
constexpr size_t OFF_X1 = OFF_BY + al256((size_t)R * 1024 * 4);
constexpr size_t OFF_X2 = OFF_X1 + al256((size_t)R * 1024 * 4);
constexpr size_t OFF_END = OFF_X2 + al256((size_t)R * 1024 * 4);
constexpr size_t OFF_A1 = OFF_BY;
constexpr size_t OFF_VT0 = OFF_X2;
static_assert(OFF_END <= (size_t)512 * 1024 * 1024, "workspace overflow");

#define GRID_LOOP(var, n) for (int var = blockIdx.x; var < (n); var += gridDim.x)

__device__ __forceinline__ void ph_fft_tables(bf16_t* D1, bf16_t* D3, bf16_t* DcT) {
  const double TWO_PI = 6.283185307179586476925286766559;
  for (int i = blockIdx.x * 256 + threadIdx.x; i < 256 * 128 + 128 * 128 + 64 * 128; i += gridDim.x * 256) {
    if (i < 256 * 128) {
      int m = i >> 7, r = i & 127; int k1 = m >> 1, ri = m & 1;
      double a = TWO_PI * (double)((k1 * r) & 127) / 128.0;
      D1[i] = (bf16_t)f2bf(ri == 0 ? (float)cos(a) : (float)(-sin(a)));
    } else if (i < 256 * 128 + 128 * 128) {
      int j = i - 256 * 128; int m = j >> 7, kk = j & 127; int rip = m >> 6, k2 = m & 63; int c = kk >> 1, ri = kk & 1;
      double a = TWO_PI * (double)((k2 * c) & 63) / 64.0;
      double v = (rip == 0) ? (ri == 0 ? cos(a) : sin(a)) : (ri == 0 ? -sin(a) : cos(a));
      D3[j] = (bf16_t)f2bf((float)v);
    } else {
      int j = i - 256 * 128 - 128 * 128; int cp = j >> 7, kk = j & 127; int rip = kk >> 6, ch = kk & 63;
      double a = TWO_PI * (double)((ch * cp) & 63) / 64.0;
      DcT[j] = (bf16_t)f2bf((float)(rip == 0 ? cos(a) : sin(a)));
    }
  }
}
__device__ __forceinline__ void ph_rope_table(float* RT) {
  for (int i = blockIdx.x * 256 + threadIdx.x; i < 128 * 16; i += gridDim.x * 256) {
    int pos = i >> 4, f = i & 15;
    float inv_freq = powf(10000.0f, -(float)f / 16.0f);
    float ang = (float)pos * inv_freq;
    RT[2 * i] = cosf(ang); RT[2 * i + 1] = sinf(ang);
  }
}
__device__ __forceinline__ void ph_tables(float* tab) {
  for (int j = blockIdx.x * 256 + threadIdx.x; j < 8192; j += gridDim.x * 256) {
    double a = 6.283185307179586476925286766559 * (double)j / 8192.0;
    tab[j] = (float)cos(a);
    tab[8192 + j] = (float)sin(a);
  }
}
__device__ __forceinline__ void ph_ada(const float* __restrict__ c, const float* __restrict__ c_ctx, const float* __restrict__ ada_w,
                       const float* __restrict__ ada_b, float* __restrict__ M) {
  for (int gid = blockIdx.x * 256 + threadIdx.x; gid < 2 * 3 * 6144; gid += gridDim.x * 256) {
    int col = gid % 6144; int idx = (gid / 6144) % 3; int layer = gid / (3 * 6144);
    const float* vec = idx < 2 ? c + idx * D : c_ctx;
    const float* w = ada_w + (size_t)layer * D * 6144 + col;
    float acc = 0.f;
    for (int k = 0; k < D; ++k) {
      float x = vec[k];
      float sx = x / (1.f + expf(-x));
      acc += sx * w[(size_t)k * 6144];
    }
    M[gid] = acc + ada_b[layer * 6144 + col];
  }
}

__device__ __forceinline__ void ph_modulate(const float* __restrict__ xa, const float* __restrict__ xb, const float* __restrict__ M, int layer,
                            int jshift, int jscale, bf16_t* __restrict__ out, int nrows, float* red) {
  int tid = threadIdx.x;
  GRID_LOOP(row, nrows) {
    const float* x = row < T ? xa + (size_t)row * D : xb + (size_t)(row - T) * D;
    float v[4]; float s = 0.f;
#pragma unroll
    for (int i = 0; i < 4; ++i) { v[i] = x[tid + 256 * i]; s += v[i]; }
    s = wave_sum(s);
    __syncthreads();
    if ((tid & 63) == 0) red[tid >> 6] = s;
    __syncthreads();
    float mu = (red[0] + red[1] + red[2] + red[3]) * (1.f / D);
    float q = 0.f;
#pragma unroll
    for (int i = 0; i < 4; ++i) { float d = v[i] - mu; q += d * d; }
    q = wave_sum(q);
    if ((tid & 63) == 0) red[4 + (tid >> 6)] = q;
    __syncthreads();
    float var = (red[4] + red[5] + red[6] + red[7]) * (1.f / D);
    float rs = rsqrtf(var + LN_EPS);
    const float* m = M + ((size_t)layer * 3 + mod_index(row)) * 6144;
#pragma unroll
    for (int i = 0; i < 4; ++i) {
      int col = tid + 256 * i;
      float y = (v[i] - mu) * rs;
      out[(size_t)row * D + col] = (bf16_t)f2bf(y * (1.f + m[jscale * D + col]) + m[jshift * D + col]);
    }
  }
}

__device__ __forceinline__ void ph_post(const float* __restrict__ xa, const float* __restrict__ xb, const float* __restrict__ Y,
                        const float* __restrict__ M, int layer, int j, const float* __restrict__ g, const float* __restrict__ bb,
                        float* __restrict__ outa, float* __restrict__ outb, int nrows, float* red) {
  int tid = threadIdx.x;
  GRID_LOOP(row, nrows) {
    const float* x = row < T ? xa + (size_t)row * D : xb + (size_t)(row - T) * D;
    float* out = row < T ? outa + (size_t)row * D : outb + (size_t)(row - T) * D;
    const float* m = M + ((size_t)layer * 3 + mod_index(row)) * 6144 + j * D;
    float v[4]; float s = 0.f;
#pragma unroll
    for (int i = 0; i < 4; ++i) { int col = tid + 256 * i; v[i] = DN_ALPHA * x[col] + m[col] * Y[(size_t)row * D + col]; s += v[i]; }
    s = wave_sum(s);
    __syncthreads();
    if ((tid & 63) == 0) red[tid >> 6] = s;
    __syncthreads();
    float mu = (red[0] + red[1] + red[2] + red[3]) * (1.f / D);
    float q = 0.f;
#pragma unroll
    for (int i = 0; i < 4; ++i) { float d = v[i] - mu; q += d * d; }
    q = wave_sum(q);
    if ((tid & 63) == 0) red[4 + (tid >> 6)] = q;
    __syncthreads();
    float var = (red[4] + red[5] + red[6] + red[7]) * (1.f / D);
    float rs = rsqrtf(var + LN_EPS);
#pragma unroll
    for (int i = 0; i < 4; ++i) {
      int col = tid + 256 * i;
      out[col] = (v[i] - mu) * rs * g[col] + bb[col];
    }
  }
}

struct ARow { const float* A; int lda; __device__ float operator()(int m, int k) const { return A[(size_t)m * lda + k]; } };
struct BRow { const float* B; int ldb; __device__ float operator()(int k, int n) const { return B[(size_t)k * ldb + n]; } };
struct CRow { float* C; int ldc; float scale; __device__ void operator()(int m, int n, float v) const { C[(size_t)m * ldc + n] = v * scale; } };
struct CRowB { bf16_t* C; int ldc; float scale; __device__ void operator()(int m, int n, float v) const { C[(size_t)m * ldc + n] = (bf16_t)f2bf(v * scale); } };
struct ADft { const float* tab; int Sn; int stride; __device__ float operator()(int m, int k) const {
    int t = k & (Sn - 1); int idx = ((m * t) & (Sn - 1)) * stride;
    return k < Sn ? tab[idx] : -tab[8192 + idx]; } };
struct BPQ { const float* PQ; int rowbase; int Sn; __device__ float operator()(int k, int n) const {
    int t = k & (Sn - 1); return PQ[(size_t)(rowbase + t) * 1024 + (k >= Sn ? 512 : 0) + n]; } };

template <class AF, class BF, class CF>
__device__ __forceinline__ void ph_gemm(AF af, BF bf, CF cf, int M, int N, int K, float* sm) {
  float (*sA)[68] = (float (*)[68])sm;
  float (*sB)[68] = (float (*)[68])(sm + 16 * 68);
  int tid = threadIdx.x; int tx = tid & 15, ty = tid >> 4;
  int ntn = N / 64; int ntiles = (M / 64) * ntn;
  GRID_LOOP(tile, ntiles) {
    int m0 = (tile / ntn) * 64, n0 = (tile % ntn) * 64;
    float acc[4][4];
#pragma unroll
    for (int i = 0; i < 4; ++i)
#pragma unroll
      for (int j = 0; j < 4; ++j) acc[i][j] = 0.f;
    for (int k0 = 0; k0 < K; k0 += 16) {
      __syncthreads();
#pragma unroll
      for (int i = 0; i < 4; ++i) { int e = tid + 256 * i; int m = e >> 4, k = e & 15; sA[k][m] = af(m0 + m, k0 + k); }
#pragma unroll
      for (int i = 0; i < 4; ++i) { int e = tid + 256 * i; int k = e >> 6, n = e & 63; sB[k][n] = bf(k0 + k, n0 + n); }
      __syncthreads();
#pragma unroll
      for (int k = 0; k < 16; ++k) {
        float a[4], b[4];
#pragma unroll
        for (int i = 0; i < 4; ++i) { a[i] = sA[k][ty * 4 + i]; b[i] = sB[k][tx * 4 + i]; }
#pragma unroll
        for (int i = 0; i < 4; ++i)
#pragma unroll
          for (int j = 0; j < 4; ++j) acc[i][j] += a[i] * b[j];
      }
    }
#pragma unroll
    for (int i = 0; i < 4; ++i)
#pragma unroll
      for (int j = 0; j < 4; ++j) cf(m0 + ty * 4 + i, n0 + tx * 4 + j, acc[i][j]);
  }
}


__device__ __forceinline__ void ph_transpose_w(const float* __restrict__ W, int K, int N, bf16_t* __restrict__ Wt, float* sm) {
  int tid = threadIdx.x;
  int tk = K / 64, tn = N / 64;
  GRID_LOOP(tile, tk * tn) {
    int k0 = (tile / tn) * 64, n0 = (tile % tn) * 64;
    __syncthreads();
#pragma unroll
    for (int i = 0; i < 16; ++i) { int e = tid + 256 * i; int k = e >> 6, n = e & 63; sm[k * 65 + n] = W[(size_t)(k0 + k) * N + n0 + n]; }
    __syncthreads();
#pragma unroll
    for (int i = 0; i < 2; ++i) {
      int e = tid + 256 * i; int n = e >> 3, kc = e & 7;
      unsigned w[4];
#pragma unroll
      for (int j = 0; j < 4; ++j) w[j] = pack2bf(sm[(kc * 8 + 2 * j) * 65 + n], sm[(kc * 8 + 2 * j + 1) * 65 + n]);
      *(uint4*)(Wt + (size_t)(n0 + n) * K + k0 + kc * 8) = make_uint4(w[0], w[1], w[2], w[3]);
    }
  }
}
__device__ __forceinline__ void ph_convert(const float* __restrict__ src, bf16_t* __restrict__ dst, size_t n8) {
  for (size_t i = (size_t)blockIdx.x * 256 + threadIdx.x; i < n8; i += (size_t)gridDim.x * 256) {
    float4 a = ((const float4*)src)[2 * i], b = ((const float4*)src)[2 * i + 1];
    ((uint4*)dst)[i] = make_uint4(pack2bf(a.x, a.y), pack2bf(a.z, a.w), pack2bf(b.x, b.y), pack2bf(b.z, b.w));
  }
}

__device__ __forceinline__ void gemm_stage(const bf16_t* __restrict__ A, int lda, int k0, char* lds, int tid) {
#pragma unroll
  for (int i = 0; i < 4; ++i) {
    int q = tid + 256 * i; int row = q >> 3, p = q & 7; int c = p ^ ((row >> 1) & 7);
    const bf16_t* src = A + (size_t)row * lda + k0 + c * 8;
    __builtin_amdgcn_global_load_lds((const unsigned*)src, (unsigned*)(lds + q * 16), 16, 0, 0);
  }
}
struct EpiF32 {
  float* C; int ldc; float scale;
  __device__ __forceinline__ void operator()(int m0, int n0, int wm, int wn, f32x16 (&acc)[2][2], int tid, char* smem) const {
    int lane = tid & 63;
    float* t = (float*)smem;
    int rbase = wm * 64 + 4 * (lane >> 5), cbase = wn * 64 + (lane & 31);
#pragma unroll
    for (int mi = 0; mi < 2; ++mi)
#pragma unroll
      for (int ni = 0; ni < 2; ++ni)
#pragma unroll
        for (int r = 0; r < 16; ++r)
          t[(rbase + mi * 32 + (r & 3) + 8 * (r >> 2)) * 128 + cbase + ni * 32] = acc[mi][ni][r] * scale;
    __syncthreads();
    float* dst = C + (size_t)(m0 + (tid >> 5)) * ldc + n0 + (tid & 31) * 4;
    const float* src = t + (tid >> 5) * 128 + (tid & 31) * 4;
#pragma unroll 4
    for (int i = 0; i < 16; ++i) {
      *(float4*)dst = *(const float4*)src;
      dst += (size_t)8 * ldc; src += 8 * 128;
    }
  }
};
struct EpiQKV0 {
  bf16_t* FQKV; bf16_t* VT;
  __device__ __forceinline__ void operator()(int m0, int n0, int wm, int wn, f32x16 (&acc)[2][2], int tid, char* smem) const {
    int lane = tid & 63;
    bf16_t* t = (bf16_t*)smem;
    int rbase = wm * 64 + 4 * (lane >> 5), cbase = wn * 64 + (lane & 31);
#pragma unroll
    for (int mi = 0; mi < 2; ++mi)
#pragma unroll
      for (int ni = 0; ni < 2; ++ni)
#pragma unroll
        for (int r = 0; r < 16; ++r)
          t[(rbase + mi * 32 + (r & 3) + 8 * (r >> 2)) * 136 + cbase + ni * 32] = (bf16_t)f2bf(acc[mi][ni][r]);
    __syncthreads();
    {
      bf16_t* dst = FQKV + (size_t)(m0 + (tid >> 4)) * 2048 + n0 + (tid & 15) * 8;
      const bf16_t* src = t + (tid >> 4) * 136 + (tid & 15) * 8;
#pragma unroll 4
      for (int i = 0; i < 8; ++i) {
        *(uint4*)dst = *(const uint4*)src;
        dst += (size_t)16 * 2048; src += 16 * 136;
      }
    }
    if (n0 >= 1536) {
      int col = tid >> 1, half = tid & 1;
      int hd = (n0 - 1536) / 64 + (col >> 6), d = col & 63;
      bf16_t* dst;
      if (m0 < T) { int b = m0 / S, t0 = m0 % S; dst = VT + (((size_t)b * 8 + hd) * 64 + d) * S + t0 + half * 64; }
      else { int mm = m0 - T; int b = mm / CL, l0 = mm % CL; dst = VT + (size_t)NB * 8 * 64 * S + (((size_t)b * 8 + hd) * 64 + d) * CL + l0 + half * 64; }
      const bf16_t* src = t + (half * 64) * 136 + col;
#pragma unroll
      for (int i = 0; i < 8; ++i) {
        unsigned wv[4];
#pragma unroll
        for (int j = 0; j < 4; ++j) wv[j] = (unsigned)src[(i * 8 + 2 * j) * 136] | ((unsigned)src[(i * 8 + 2 * j + 1) * 136] << 16);
        *(uint4*)(dst + i * 8) = make_uint4(wv[0], wv[1], wv[2], wv[3]);
      }
    }
  }
};
struct EpiBf16 {
  bf16_t* C; int ldc;
  __device__ __forceinline__ void operator()(int m0, int n0, int wm, int wn, f32x16 (&acc)[2][2], int tid, char* smem) const {
    int lane = tid & 63;
    asm volatile("" : "+v"(lane));
    bf16_t* t = (bf16_t*)smem;
    {
      bf16_t* tw = t + (wm * 64 + 4 * (lane >> 5)) * 136 + wn * 64 + (lane & 31);
#pragma unroll
      for (int mi = 0; mi < 2; ++mi)
#pragma unroll
        for (int ni = 0; ni < 2; ++ni)
#pragma unroll
          for (int r = 0; r < 16; ++r)
            tw[(mi * 32 + (r & 3) + 8 * (r >> 2)) * 136 + ni * 32] = (bf16_t)f2bf(acc[mi][ni][r]);
    }
    __syncthreads();
    bf16_t* dst = C + (size_t)(m0 + (tid >> 4)) * ldc + n0 + (tid & 15) * 8;
    const bf16_t* src = t + (tid >> 4) * 136 + (tid & 15) * 8;
#pragma unroll 4
    for (int i = 0; i < 8; ++i) {
      *(uint4*)dst = *(const uint4*)src;
      dst += (size_t)16 * ldc; src += 16 * 136;
    }
  }
};
struct EpiQKV1 {
  bf16_t* Q1; bf16_t* K1; bf16_t* VT; const float* RT;
  __device__ __forceinline__ void operator()(int m0, int n0, int wm, int wn, f32x16 (&acc)[2][2], int tid, char* smem) const {
    int lane = tid & 63;
    asm volatile("" : "+v"(lane));
    bf16_t* t = (bf16_t*)smem;
    if (n0 < 1280 && m0 < T) {
      int i = lane & 31; int f = i & 15;
#pragma unroll
      for (int mi = 0; mi < 2; ++mi)
#pragma unroll
        for (int r = 0; r < 16; ++r) {
          int row = m0 + wm * 64 + 4 * (lane >> 5) + mi * 32 + (r & 3) + 8 * (r >> 2);
          int tt = row & (S - 1);
          int pos = (i < 16) ? (tt >> 6) : (tt & 63);
          float2 cs = *(const float2*)(RT + 2 * (pos * 16 + f));
          float x1 = acc[mi][0][r], x2 = acc[mi][1][r];
          acc[mi][0][r] = x1 * cs.x - x2 * cs.y;
          acc[mi][1][r] = x1 * cs.y + x2 * cs.x;
        }
    }
    {
      bf16_t* tw = t + (wm * 64 + 4 * (lane >> 5)) * 136 + wn * 64 + (lane & 31);
#pragma unroll
      for (int mi = 0; mi < 2; ++mi)
#pragma unroll
        for (int ni = 0; ni < 2; ++ni)
#pragma unroll
          for (int r = 0; r < 16; ++r)
            tw[(mi * 32 + (r & 3) + 8 * (r >> 2)) * 136 + ni * 32] = (bf16_t)f2bf(acc[mi][ni][r]);
    }
    __syncthreads();
    if (n0 < 1280) {
      bf16_t* dst; int ld;
      if (n0 < 1024) { dst = Q1 + (size_t)(m0 + (tid >> 4)) * 1024 + n0 + (tid & 15) * 8; ld = 1024; }
      else { dst = K1 + (size_t)(m0 + (tid >> 4)) * 256 + (n0 - 1024) + (tid & 15) * 8; ld = 256; }
      if (n0 >= 1024 || m0 < T) {
        const bf16_t* src = t + (tid >> 4) * 136 + (tid & 15) * 8;
#pragma unroll 4
        for (int i = 0; i < 8; ++i) {
          *(uint4*)dst = *(const uint4*)src;
          dst += (size_t)16 * ld; src += 16 * 136;
        }
      }
    } else {
      int col = tid >> 1, half = tid & 1;
      int hd = (n0 - 1280) / 64 + (col >> 6), d = col & 63;
      bf16_t* dst;
      if (m0 < T) { int b = m0 / S, t0 = m0 % S; dst = VT + (((size_t)b * 4 + hd) * 64 + d) * S + t0 + half * 64; }
      else { int mm = m0 - T; int b = mm / CL, l0 = mm % CL; dst = VT + (size_t)NB * 4 * 64 * S + (((size_t)b * 4 + hd) * 64 + d) * CL + l0 + half * 64; }
      const bf16_t* src = t + (half * 64) * 136 + col;
#pragma unroll
      for (int i = 0; i < 8; ++i) {
        unsigned wv[4];
#pragma unroll
        for (int j = 0; j < 4; ++j) wv[j] = (unsigned)src[(i * 8 + 2 * j) * 136] | ((unsigned)src[(i * 8 + 2 * j + 1) * 136] << 16);
        *(uint4*)(dst + i * 8) = make_uint4(wv[0], wv[1], wv[2], wv[3]);
      }
    }
  }
};
__device__ __forceinline__ void gemm_tile_mainloop(const bf16_t* __restrict__ Ag, int lda, const bf16_t* __restrict__ Bg, int ldb, int KT,
                                                   f32x16 (&acc)[2][2], char* smem) {
  int tid = threadIdx.x;
  asm volatile("" : "+v"(tid));
  int lane = tid & 63, wave = __builtin_amdgcn_readfirstlane(tid >> 6), wm = wave >> 1, wn = wave & 1;
#pragma unroll
  for (int mi = 0; mi < 2; ++mi)
#pragma unroll
    for (int ni = 0; ni < 2; ++ni)
#pragma unroll
      for (int r = 0; r < 16; ++r) acc[mi][ni][r] = 0.f;
  __syncthreads();
  gemm_stage(Ag, lda, 0, smem, tid); gemm_stage(Bg, ldb, 0, smem + 16384, tid);
  for (int kt = 0; kt < KT; ++kt) {
    asm volatile("s_waitcnt vmcnt(0)" ::: "memory");
    __syncthreads();
    char* cur = smem + (kt & 1) * 32768;
    if (kt + 1 < KT) {
      char* nxt = smem + ((kt + 1) & 1) * 32768;
      gemm_stage(Ag, lda, (kt + 1) * 64, nxt, tid); gemm_stage(Bg, ldb, (kt + 1) * 64, nxt + 16384, tid);
    }
#pragma unroll
    for (int s4 = 0; s4 < 4; ++s4) {
      bf16x8 a[2], b[2];
      int c = 2 * s4 + (lane >> 5);
#pragma unroll
      for (int mi = 0; mi < 2; ++mi) { int row = wm * 64 + mi * 32 + (lane & 31); a[mi] = *(const bf16x8*)(cur + row * 128 + ((c ^ ((row >> 1) & 7)) << 4)); }
#pragma unroll
      for (int ni = 0; ni < 2; ++ni) { int row = wn * 64 + ni * 32 + (lane & 31); b[ni] = *(const bf16x8*)(cur + 16384 + row * 128 + ((c ^ ((row >> 1) & 7)) << 4)); }
#pragma unroll
      for (int mi = 0; mi < 2; ++mi)
#pragma unroll
        for (int ni = 0; ni < 2; ++ni) acc[mi][ni] = __builtin_amdgcn_mfma_f32_32x32x16_bf16(a[mi], b[ni], acc[mi][ni], 0, 0, 0);
    }
  }
  __syncthreads();
}
template <class Epi>
__device__ __forceinline__ void ph_gemm_bf16(const bf16_t* __restrict__ A, int lda, const bf16_t* __restrict__ Bt, int ldb, int M, int N, int K,
                             Epi epi, char* smem) {
  int tid = threadIdx.x, wave = __builtin_amdgcn_readfirstlane(tid >> 6), wm = wave >> 1, wn = wave & 1;
  int ntn = N / 128, ntiles = (M / 128) * ntn;
  int KT = K / 64;
  (void)ntiles;
  int nb8 = gridDim.x >> 3, xq = blockIdx.x & 7, xm = xq >> 1, xn = xq & 1;
  int MT = M / 128, mq = (MT + 3) >> 2, nh = ntn >> 1;
  for (int lt = (int)(blockIdx.x >> 3); lt < mq * nh; lt += nb8) {
    int mt = xm * mq + lt / nh, nt = xn * nh + lt % nh;
    if (mt >= MT) continue;
    f32x16 acc[2][2];
    gemm_tile_mainloop(A + (size_t)mt * 128 * lda, lda, Bt + (size_t)nt * 128 * ldb, ldb, KT, acc, smem);
    epi(mt * 128, nt * 128, wm, wn, acc, tid, smem);
  }
}


#define RAW_BARRIER() do { asm volatile("s_waitcnt lgkmcnt(0)" ::: "memory"); __builtin_amdgcn_s_barrier(); } while (0)
__device__ __forceinline__ void gemm_stage32x(const bf16_t* __restrict__ Ag, int lda, const bf16_t* __restrict__ Bg, int ldb, int k0, char* lds, int tid) {
#pragma unroll
  for (int i = 0; i < 2; ++i) { int q = tid + 256 * i; int row = q >> 2, p = q & 3; int c = p ^ ((row >> 2) & 3);
    __builtin_amdgcn_global_load_lds((const unsigned*)(Ag + (size_t)row * lda + k0 + c * 8), (unsigned*)(lds + q * 16), 16, 0, 0); }
#pragma unroll
  for (int i = 0; i < 2; ++i) { int q = tid + 256 * i; int row = q >> 2, p = q & 3; int c = p ^ ((row >> 2) & 3);
    __builtin_amdgcn_global_load_lds((const unsigned*)(Bg + (size_t)row * ldb + k0 + c * 8), (unsigned*)(lds + 8192 + q * 16), 16, 0, 0); }
}
__device__ __forceinline__ void gemm_tile_mainloop3(const bf16_t* __restrict__ Ag, int lda, const bf16_t* __restrict__ Bg, int ldb, int KT,
                                                    f32x16 (&acc)[2][2], char* smem) {
  int tid = threadIdx.x;
  asm volatile("" : "+v"(tid));
  int lane = tid & 63, wave = tid >> 6, wm = wave >> 1, wn = wave & 1;
#pragma unroll
  for (int mi = 0; mi < 2; ++mi)
#pragma unroll
    for (int ni = 0; ni < 2; ++ni)
#pragma unroll
      for (int r = 0; r < 16; ++r) acc[mi][ni][r] = 0.f;
  __syncthreads();
  gemm_stage32x(Ag, lda, Bg, ldb, 0, smem, tid);
  gemm_stage32x(Ag, lda, Bg, ldb, 32, smem + 16384, tid);
  gemm_stage32x(Ag, lda, Bg, ldb, 64, smem + 32768, tid);
  for (int kt = 0; kt < KT; ++kt) {
    if (kt + 2 < KT) asm volatile("s_waitcnt vmcnt(8)" ::: "memory");
    else if (kt + 1 < KT) asm volatile("s_waitcnt vmcnt(4)" ::: "memory");
    else asm volatile("s_waitcnt vmcnt(0)" ::: "memory");
    RAW_BARRIER();
    if (kt + 3 < KT) gemm_stage32x(Ag, lda, Bg, ldb, (kt + 3) * 32, smem + ((kt + 3) & 3) * 16384, tid);
    char* cur = smem + (kt & 3) * 16384;
#pragma unroll
    for (int s2 = 0; s2 < 2; ++s2) {
      bf16x8 a[2], b[2];
      int c = 2 * s2 + (lane >> 5);
#pragma unroll
      for (int mi = 0; mi < 2; ++mi) { int row = wm * 64 + mi * 32 + (lane & 31); a[mi] = *(const bf16x8*)(cur + row * 64 + ((c ^ ((row >> 2) & 3)) << 4)); }
#pragma unroll
      for (int ni = 0; ni < 2; ++ni) { int row = wn * 64 + ni * 32 + (lane & 31); b[ni] = *(const bf16x8*)(cur + 8192 + row * 64 + ((c ^ ((row >> 2) & 3)) << 4)); }
#pragma unroll
      for (int mi = 0; mi < 2; ++mi)
#pragma unroll
        for (int ni = 0; ni < 2; ++ni) acc[mi][ni] = __builtin_amdgcn_mfma_f32_32x32x16_bf16(a[mi], b[ni], acc[mi][ni], 0, 0, 0);
    }
  }
  __syncthreads();
}
template <class Epi>
__device__ __forceinline__ void ph_gemm_bf16_3(const bf16_t* __restrict__ A, int lda, const bf16_t* __restrict__ Bt, int ldb, int M, int N, int K,
                             Epi epi, char* smem) {
  int tid = threadIdx.x, wave = __builtin_amdgcn_readfirstlane(tid >> 6), wm = wave >> 1, wn = wave & 1;
  int ntn = N / 128, ntiles = (M / 128) * ntn;
  GRID_LOOP(tile, ntiles) {
    int mt = tile / ntn, nt = tile % ntn;
    f32x16 acc[2][2];
    gemm_tile_mainloop3(A + (size_t)mt * 128 * lda, lda, Bt + (size_t)nt * 128 * ldb, ldb, K / 32, acc, smem);
    epi(mt * 128, nt * 128, wm, wn, acc, tid, smem);
  }
}
__device__ __forceinline__ void ins16(float (&L)[16], float x) {
#pragma unroll
  for (int j = 15; j >= 1; --j) L[j] = __builtin_amdgcn_fmed3f(L[j - 1], L[j], x);
  L[0] = fmaxf(L[0], x);
}
__device__ __forceinline__ void stage_tile128(const bf16_t* __restrict__ src, int ld, char* lds, int tid) {
#pragma unroll
  for (int i = 0; i < 8; ++i) {
    int q = tid + 256 * i; int row = q >> 4, p = q & 15; int c = p ^ (row & 15);
    __builtin_amdgcn_global_load_lds((const unsigned*)(src + (size_t)row * ld + c * 8), (unsigned*)(lds + q * 16), 16, 0, 0);
  }
}
__device__ __forceinline__ void ph_peer_select(const bf16_t* __restrict__ H, const bf16_t* __restrict__ WQl, const bf16_t* __restrict__ SKl,
                                               int* __restrict__ EXP, float* __restrict__ GATE, int nrows, char* smem) {
  int tid = threadIdx.x, w = __builtin_amdgcn_readfirstlane(tid >> 6), wm = w >> 1, wn = w & 1;
  bf16_t* Qs = (bf16_t*)smem;
  int* KL = (int*)(smem + 36864);
  int nb8 = gridDim.x >> 3, xq = blockIdx.x & 7, xm = xq >> 1, xn = xq & 1;
  int MT = nrows / 128, mq = (MT + 3) >> 2;
  for (int lu = (int)(blockIdx.x >> 3); lu < mq * 4; lu += nb8) {
    int mt = xm * mq + (lu >> 2), h = xn * 4 + (lu & 3);
    if (mt >= MT) continue;
    float L0[16], L1[16];
#pragma unroll
    for (int p = 0; p < 2; ++p) {
      f32x16 acc[2][2];
      gemm_tile_mainloop(H + (size_t)mt * 128 * 1024, 1024, WQl + (size_t)(h * 256 + p * 128) * 1024, 1024, 16, acc, smem);
      int lane = tid & 63;
      asm volatile("" : "+v"(lane));
      {
        bf16_t* qw = Qs + (wm * 64 + 4 * (lane >> 5)) * 136 + wn * 64 + (lane & 31);
#pragma unroll
        for (int mi = 0; mi < 2; ++mi)
#pragma unroll
          for (int ni = 0; ni < 2; ++ni)
#pragma unroll
            for (int r = 0; r < 16; ++r)
              qw[(mi * 32 + (r & 3) + 8 * (r >> 2)) * 136 + ni * 32] = (bf16_t)f2bf(acc[mi][ni][r]);
      }
      __syncthreads();
      f32x16 sc[4];
#pragma unroll
      for (int m4 = 0; m4 < 4; ++m4)
#pragma unroll
        for (int r = 0; r < 16; ++r) sc[m4][r] = 0.f;
      {
        const bf16_t* qrow = Qs + (32 * w + (lane & 31)) * 136 + 8 * (lane >> 5);
        const bf16_t* krow = SKl + (size_t)(h * 2 + p) * 128 * 128 + (lane & 31) * 128 + 8 * (lane >> 5);
#pragma unroll
        for (int s8 = 0; s8 < 8; ++s8) {
          bf16x8 bq = *(const bf16x8*)(qrow + 16 * s8);
#pragma unroll
          for (int m4 = 0; m4 < 4; ++m4) {
            bf16x8 ak = *(const bf16x8*)(krow + m4 * 32 * 128 + 16 * s8);
            sc[m4] = __builtin_amdgcn_mfma_f32_32x32x16_bf16(ak, bq, sc[m4], 0, 0, 0);
          }
        }
      }
      float L[16];
#pragma unroll
      for (int j = 0; j < 16; ++j) L[j] = -INFINITY;
      unsigned kb = 4u * (unsigned)(lane >> 5);
#pragma unroll
      for (int m4 = 0; m4 < 4; ++m4)
#pragma unroll
        for (int r = 0; r < 16; ++r) {
          unsigned key = kb + (unsigned)(32 * m4 + (r & 3) + 8 * (r >> 2));
          float x = __uint_as_float((__float_as_uint(sc[m4][r]) & 0xFFFFFF80u) | key);
          ins16(L, x);
        }
      float P[16];
#pragma unroll
      for (int j = 0; j < 16; ++j) P[j] = __shfl_xor(L[j], 32);
#pragma unroll
      for (int j = 0; j < 16; ++j) ins16(L, P[j]);
      if (p == 0) {
#pragma unroll
        for (int j = 0; j < 16; ++j) L0[j] = L[j];
      } else {
#pragma unroll
        for (int j = 0; j < 16; ++j) L1[j] = L[j];
      }
    }
    float C[16];
#pragma unroll
    for (int j = 0; j < 16; ++j) C[j] = -INFINITY;
#pragma unroll
    for (int a = 0; a < 16; ++a)
#pragma unroll
      for (int b = 0; b < 16; ++b)
        if ((a + 1) * (b + 1) <= 16) {
          float sa = __uint_as_float(__float_as_uint(L0[a]) & 0xFFFFFF80u);
          float sb = __uint_as_float(__float_as_uint(L1[b]) & 0xFFFFFF80u);
          float x = __uint_as_float((__float_as_uint(sa + sb) & 0xFFFFFF00u) | (unsigned)(a * 16 + b));
          ins16(C, x);
        }
    int lane = tid & 63;
    asm volatile("" : "+v"(lane));
    int token = 32 * w + (lane & 31);
    if (lane < 32) {
#pragma unroll
      for (int j = 0; j < 16; ++j) { KL[token * 32 + j] = (int)(__float_as_uint(L0[j]) & 0x7Fu); KL[token * 32 + 16 + j] = (int)(__float_as_uint(L1[j]) & 0x7Fu); }
    }
    __syncthreads();
    if (lane < 32) {
      float c0 = __uint_as_float(__float_as_uint(C[0]) & 0xFFFFFF00u);
      float ev[16]; float sum = 0.f; int ex[16];
#pragma unroll
      for (int j = 0; j < 16; ++j) {
        unsigned bits = __float_as_uint(C[j]);
        float cv = __uint_as_float(bits & 0xFFFFFF00u);
        ev[j] = __expf(cv - c0); sum += ev[j];
        int a = (bits >> 4) & 15, b = bits & 15;
        ex[j] = KL[token * 32 + a] * 128 + KL[token * 32 + 16 + b];
      }
      float inv = 1.f / sum;
      size_t o = (size_t)(mt * 128 + token) * 128 + h * 16;
#pragma unroll
      for (int j = 0; j < 16; j += 4) {
        *(int4*)(EXP + o + j) = make_int4(ex[j], ex[j + 1], ex[j + 2], ex[j + 3]);
        *(float4*)(GATE + o + j) = make_float4(ev[j] * inv, ev[j + 1] * inv, ev[j + 2] * inv, ev[j + 3] * inv);
      }
    }
  }
}

__device__ __forceinline__ void fft1_unit(int u, const bf16_t* __restrict__ FQKV, const bf16_t* __restrict__ D1, const float* __restrict__ TAB,
                          bf16_t* __restrict__ A1, char* smem) {
  int tid = threadIdx.x, lane = tid & 63, w = __builtin_amdgcn_readfirstlane(tid >> 6);
  int g = u & 7, c = (u >> 3) & 63, b = u >> 9;
  bf16_t* Bt = (bf16_t*)smem;
  __syncthreads();
  {
    int r = tid >> 1, half = tid & 1;
    const uint4* src = (const uint4*)(FQKV + (size_t)(b * S + 64 * r + c) * 2048 + g * 64 + half * 32);
    unsigned wv[16];
#pragma unroll
    for (int i = 0; i < 4; ++i) { uint4 v = src[i]; wv[4 * i] = v.x; wv[4 * i + 1] = v.y; wv[4 * i + 2] = v.z; wv[4 * i + 3] = v.w; }
#pragma unroll
    for (int j = 0; j < 32; ++j) {
      unsigned e = (j & 1) ? (wv[j >> 1] >> 16) : (wv[j >> 1] & 0xffffu);
      Bt[(half * 32 + j) * 136 + r] = (bf16_t)e;
    }
  }
  __syncthreads();
  f32x16 acc[2][2];
#pragma unroll
  for (int mi = 0; mi < 2; ++mi)
#pragma unroll
    for (int ni = 0; ni < 2; ++ni)
#pragma unroll
      for (int r = 0; r < 16; ++r) acc[mi][ni][r] = 0.f;
#pragma unroll
  for (int s8 = 0; s8 < 8; ++s8) {
    bf16x8 a[2], bb[2];
    int ko = 16 * s8 + 8 * (lane >> 5);
#pragma unroll
    for (int mi = 0; mi < 2; ++mi) a[mi] = *(const bf16x8*)(D1 + (64 * w + 32 * mi + (lane & 31)) * 128 + ko);
#pragma unroll
    for (int ni = 0; ni < 2; ++ni) bb[ni] = *(const bf16x8*)(Bt + (32 * ni + (lane & 31)) * 136 + ko);
#pragma unroll
    for (int mi = 0; mi < 2; ++mi)
#pragma unroll
      for (int ni = 0; ni < 2; ++ni) acc[mi][ni] = __builtin_amdgcn_mfma_f32_32x32x16_bf16(a[mi], bb[ni], acc[mi][ni], 0, 0, 0);
  }
  bf16_t* Ot = (bf16_t*)(smem + 17408);
#pragma unroll
  for (int mi = 0; mi < 2; ++mi)
#pragma unroll
    for (int j = 0; j < 8; ++j) {
      int m = 64 * w + 32 * mi + ((2 * j) & 3) + 8 * ((2 * j) >> 2) + 4 * (lane >> 5);
      int k1 = m >> 1;
      int idx = (k1 * c) & 8191;
      float cs = TAB[idx], sn = TAB[8192 + idx];
#pragma unroll
      for (int ni = 0; ni < 2; ++ni) {
        float re = acc[mi][ni][2 * j], im = acc[mi][ni][2 * j + 1];
        float re2 = re * cs + im * sn, im2 = im * cs - re * sn;
        bf16_t* dst = Ot + m * 72 + 32 * ni + (lane & 31);
        dst[0] = (bf16_t)f2bf(re2); dst[72] = (bf16_t)f2bf(im2);
      }
    }
  __syncthreads();
  {
    bf16_t* base = A1 + (((size_t)b * 64 + c) * 128) * 2 * 512 + g * 64;
#pragma unroll
    for (int i = 0; i < 8; ++i) {
      int q = tid + 256 * i; int m = q >> 3, ch8 = q & 7;
      *(uint4*)(base + (size_t)m * 512 + ch8 * 8) = *(const uint4*)(Ot + m * 72 + ch8 * 8);
    }
  }
}

__device__ __forceinline__ void fft3_unit(int u, int mode, const bf16_t* __restrict__ FQKV, const bf16_t* __restrict__ A1, const bf16_t* __restrict__ D3,
                          const bf16_t* __restrict__ DcT, const float* __restrict__ TAB, bf16_t* __restrict__ MIX, char* smem) {
  int tid = threadIdx.x, lane = tid & 63, w = __builtin_amdgcn_readfirstlane(tid >> 6);
  bf16_t* Bt = (bf16_t*)smem;
  bf16_t* Xs = (bf16_t*)(smem + 17408);
  int g = u & 7, k1, b, nk1, rowbase; float norm;
  __syncthreads();
  if (mode == 0) {
    k1 = (u >> 3) & 127; b = u >> 10; nk1 = 128; rowbase = b * S; norm = 1.f / 724.0773439350247f;
    int kk = tid >> 1, half = tid & 1; int c = kk >> 1, ri = kk & 1;
    const uint4* src = (const uint4*)(A1 + ((((size_t)b * 64 + c) * 128 + k1) * 2 + ri) * 512 + g * 64 + half * 32);
    unsigned wv[16];
#pragma unroll
    for (int i = 0; i < 4; ++i) { uint4 v = src[i]; wv[4 * i] = v.x; wv[4 * i + 1] = v.y; wv[4 * i + 2] = v.z; wv[4 * i + 3] = v.w; }
#pragma unroll
    for (int j = 0; j < 32; ++j) {
      unsigned e = (j & 1) ? (wv[j >> 1] >> 16) : (wv[j >> 1] & 0xffffu);
      Bt[(half * 32 + j) * 136 + kk] = (bf16_t)e;
    }
  } else {
    k1 = (u >> 3) & 3; b = u >> 5; nk1 = 4; rowbase = T + b * CL; norm = 1.f / 128.f;
    int c = tid >> 2, q4 = tid & 3;
    float re[16], im[16];
#pragma unroll
    for (int j = 0; j < 16; ++j) { re[j] = 0.f; im[j] = 0.f; }
#pragma unroll
    for (int r = 0; r < 4; ++r) {
      const uint4* src = (const uint4*)(FQKV + (size_t)(rowbase + 64 * r + c) * 2048 + g * 64 + q4 * 16);
      uint4 v0 = src[0], v1 = src[1];
      unsigned wv[8] = {v0.x, v0.y, v0.z, v0.w, v1.x, v1.y, v1.z, v1.w};
      int ph = (k1 * r) & 3;
      float cr = (ph == 0) ? 1.f : (ph == 2 ? -1.f : 0.f);
      float ci = (ph == 1) ? -1.f : (ph == 3 ? 1.f : 0.f);
#pragma unroll
      for (int j = 0; j < 16; ++j) {
        float x = bf2f((unsigned short)((j & 1) ? (wv[j >> 1] >> 16) : (wv[j >> 1] & 0xffffu)));
        re[j] += x * cr; im[j] += x * ci;
      }
    }
    int idx = (k1 * c * 32) & 8191;
    float cs = TAB[idx], sn = TAB[8192 + idx];
#pragma unroll
    for (int j = 0; j < 16; ++j) {
      float re2 = re[j] * cs + im[j] * sn, im2 = im[j] * cs - re[j] * sn;
      *(unsigned*)(Bt + (q4 * 16 + j) * 136 + 2 * c) = pack2bf(re2, im2);
    }
  }
  __syncthreads();
  {
    f32x16 acc[2];
#pragma unroll
    for (int ni = 0; ni < 2; ++ni)
#pragma unroll
      for (int r = 0; r < 16; ++r) acc[ni][r] = 0.f;
#pragma unroll
    for (int s8 = 0; s8 < 8; ++s8) {
      int ko = 16 * s8 + 8 * (lane >> 5);
      bf16x8 a = *(const bf16x8*)(D3 + (32 * w + (lane & 31)) * 128 + ko);
#pragma unroll
      for (int ni = 0; ni < 2; ++ni) {
        bf16x8 bb = *(const bf16x8*)(Bt + (32 * ni + (lane & 31)) * 136 + ko);
        acc[ni] = __builtin_amdgcn_mfma_f32_32x32x16_bf16(a, bb, acc[ni], 0, 0, 0);
      }
    }
#pragma unroll
    for (int ni = 0; ni < 2; ++ni)
#pragma unroll
      for (int r = 0; r < 16; ++r) {
        int m = 32 * w + (r & 3) + 8 * (r >> 2) + 4 * (lane >> 5);
        Xs[(m & 63) * 136 + (m >> 6) * 64 + 32 * ni + (lane & 31)] = (bf16_t)f2bf(acc[ni][r]);
      }
  }
  __syncthreads();
  {
    int mi = w >> 1, ni = w & 1;
    f32x16 acc;
#pragma unroll
    for (int r = 0; r < 16; ++r) acc[r] = 0.f;
#pragma unroll
    for (int s8 = 0; s8 < 8; ++s8) {
      int ko = 16 * s8 + 8 * (lane >> 5);
      bf16x8 a = *(const bf16x8*)(Xs + (32 * mi + (lane & 31)) * 136 + ko);
      bf16x8 bb = *(const bf16x8*)(DcT + (32 * ni + (lane & 31)) * 128 + ko);
      acc = __builtin_amdgcn_mfma_f32_32x32x16_bf16(a, bb, acc, 0, 0, 0);
    }
    bf16_t* Yt = Bt;
#pragma unroll
    for (int r = 0; r < 16; ++r) {
      int k2 = 32 * mi + (r & 3) + 8 * (r >> 2) + 4 * (lane >> 5);
      Yt[k2 * 72 + 32 * ni + (lane & 31)] = (bf16_t)f2bf(acc[r] * norm);
    }
  }
  __syncthreads();
#pragma unroll
  for (int i = 0; i < 2; ++i) {
    int q = tid + 256 * i; int k2 = q >> 3, ch8 = q & 7;
    int row = rowbase + k1 + nk1 * k2;
    *(uint4*)(MIX + (size_t)row * 1024 + g * 64 + ch8 * 8) = *(const uint4*)((const bf16_t*)smem + k2 * 72 + ch8 * 8);
  }
}

typedef __attribute__((ext_vector_type(4))) float f32x4_t;
__device__ __forceinline__ bf16x8 ld16(const bf16_t* p) { return *(const bf16x8*)p; }
__device__ __forceinline__ float fast_exp2(float x) { return __builtin_amdgcn_exp2f(x); }

template <int NH, int MODE, int KPI, bool PF>
__device__ __forceinline__ void attn_unit(int b, int hk, int r, int jb, int qb, const bf16_t* __restrict__ Qp, int ldq, const bf16_t* __restrict__ Kp, int ldk,
                                          const bf16_t* __restrict__ VTl, const bf16_t* __restrict__ VTc, int nkvh,
                                          const float* rpbs, const float* __restrict__ sink,
                                          bf16_t* __restrict__ Op, int ldo, int lane) {
  const float LOG2E = 1.4426950408889634f;
  const float SC = 0.125f * LOG2E;
  asm volatile("" : "+v"(lane));
  int ql = lane & 15, g = lane >> 4;
  int qrow0, q0 = 0;
  int nloc, lb0 = 0;
  if (MODE == 0) { qrow0 = b * S + r * 64 + 16 * jb; nloc = 8; }
  else if (MODE == 1) { qrow0 = T + b * CL + 16 * qb; nloc = 0; }
  else { q0 = 16 * qb; qrow0 = b * S + q0;
         int lo = (q0 - 128) >> 5, hi = (q0 + 143) >> 5; if (lo < 0) lo = 0; if (hi > 255) hi = 255; lb0 = lo; nloc = hi - lo + 1; }
  bf16x8 qf[NH][2];
#pragma unroll
  for (int hh = 0; hh < NH; ++hh)
#pragma unroll
    for (int s2 = 0; s2 < 2; ++s2)
      qf[hh][s2] = ld16(Qp + (size_t)(qrow0 + ql) * ldq + (hk * NH + hh) * 64 + 32 * s2 + 8 * g);
  f32x4_t o[NH][4]; float mrun[NH], lrun[NH];
#pragma unroll
  for (int hh = 0; hh < NH; ++hh) {
    mrun[hh] = -1e30f; lrun[hh] = 0.f;
#pragma unroll
    for (int dt = 0; dt < 4; ++dt) o[hh][dt] = (f32x4_t){0.f, 0.f, 0.f, 0.f};
  }
  int r_start = 0, blk_start = 0, c_lo = 0, qc = 0;
  if (MODE == 0) {
    r_start = min(max(r - 4, 0), 120);
    blk_start = min(max(16 * jb - 8, 0), 32);
    qc = 16 * jb + ql; c_lo = min(max(qc - 8, 0), 48);
  }
  if (MODE == 2 && KPI == 2) nloc = (nloc + 1) & ~1;
  int nit = (nloc + 8) / KPI;
#define ATT_DESC(kbx, krow0_, vtp_, vld_) \
    { bool il_ = (kbx) < nloc; int vt0_; \
      if (il_) { if (MODE == 0) { int rr_ = r_start + (kbx); krow0_ = b * S + rr_ * 64 + blk_start; vt0_ = rr_ * 64 + blk_start; } \
                 else { krow0_ = b * S + 32 * (lb0 + (kbx)); vt0_ = 32 * (lb0 + (kbx)); } \
                 vtp_ = VTl + ((size_t)(b * nkvh + hk) * 64) * S + vt0_; vld_ = S; } \
      else { int cb_ = (kbx) - nloc; krow0_ = T + b * CL + 32 * cb_; vt0_ = 32 * cb_; \
             vtp_ = VTc + ((size_t)(b * nkvh + hk) * 64) * CL + vt0_; vld_ = CL; } }
#define ATT_LOAD(kbx, KF, VF) \
    { int krow0; const bf16_t* vt; int vld; ATT_DESC(kbx, krow0, vt, vld) \
      _Pragma("unroll") for (int t = 0; t < 2; ++t) _Pragma("unroll") for (int s2 = 0; s2 < 2; ++s2) \
        KF[t][s2] = ld16(Kp + (size_t)(krow0 + 8 * (ql >> 2) + 4 * t + (ql & 3)) * ldk + hk * 64 + 32 * s2 + 8 * g); \
      _Pragma("unroll") for (int dt = 0; dt < 4; ++dt) VF[dt] = ld16(vt + (size_t)(16 * dt + ql) * vld + 8 * g); }
  bf16x8 kfn[PF ? KPI : 1][2][2], vfn[PF ? KPI : 1][4];
  if (PF) {
#pragma unroll
    for (int kk = 0; kk < KPI; ++kk) ATT_LOAD(kk, kfn[kk], vfn[kk])
  }
  for (int it = 0; it < nit; ++it) {
    bf16x8 kf[KPI][2][2], vf[KPI][4];
    if (PF) {
#pragma unroll
      for (int kk = 0; kk < KPI; ++kk) {
#pragma unroll
        for (int t = 0; t < 2; ++t)
#pragma unroll
          for (int s2 = 0; s2 < 2; ++s2) kf[kk][t][s2] = kfn[kk][t][s2];
#pragma unroll
        for (int dt = 0; dt < 4; ++dt) vf[kk][dt] = vfn[kk][dt];
      }
      if (it + 1 < nit) {
#pragma unroll
        for (int kk = 0; kk < KPI; ++kk) ATT_LOAD((it + 1) * KPI + kk, kfn[kk], vfn[kk])
      }
    } else {
#pragma unroll
      for (int kk = 0; kk < KPI; ++kk) ATT_LOAD(it * KPI + kk, kf[kk], vf[kk])
    }
    float bias[KPI][2][4]; bool valid[KPI][2][4];
#pragma unroll
    for (int kk = 0; kk < KPI; ++kk) {
      int kb = it * KPI + kk;
      bool is_loc = kb < nloc;
#pragma unroll
      for (int t = 0; t < 2; ++t)
#pragma unroll
        for (int i = 0; i < 4; ++i) {
          bias[kk][t][i] = 0.f; valid[kk][t][i] = true;
          if (MODE == 0 && is_loc) {
            int kc = blk_start + 8 * g + 4 * t + i;
            valid[kk][t][i] = (kc >= c_lo) && (kc < c_lo + 16);
            int dc = min(max(kc - qc, -15), 15) + 15;
            bias[kk][t][i] = rpbs[(hk * 15 + (r_start + kb - r + 7)) * 31 + dc];
          }
          if (MODE == 2 && is_loc) {
            int kpos = 32 * (lb0 + kb) + 8 * g + 4 * t + i; int dq = (q0 + ql) - kpos;
            bias[kk][t][i] = ((dq <= 128) && (dq >= -128)) ? 0.f : -1e30f;
          }
        }
    }
#pragma unroll
    for (int hh = 0; hh < NH; ++hh) {
      f32x4_t st[KPI][2];
#pragma unroll
      for (int kk = 0; kk < KPI; ++kk)
#pragma unroll
        for (int t = 0; t < 2; ++t) {
          st[kk][t] = (f32x4_t){0.f, 0.f, 0.f, 0.f};
          st[kk][t] = __builtin_amdgcn_mfma_f32_16x16x32_bf16(kf[kk][t][0], qf[hh][0], st[kk][t], 0, 0, 0);
          st[kk][t] = __builtin_amdgcn_mfma_f32_16x16x32_bf16(kf[kk][t][1], qf[hh][1], st[kk][t], 0, 0, 0);
        }
      float lg[KPI][2][4]; float bm = -1e30f;
#pragma unroll
      for (int kk = 0; kk < KPI; ++kk)
#pragma unroll
        for (int t = 0; t < 2; ++t)
#pragma unroll
          for (int i = 0; i < 4; ++i) {
            float v = (MODE == 0) ? (valid[kk][t][i] ? (st[kk][t][i] * SC + bias[kk][t][i]) : -1e30f) : fmaf(st[kk][t][i], SC, bias[kk][t][i]);
            lg[kk][t][i] = v; bm = fmaxf(bm, v);
          }
      bm = xrow16_max(bm);
      float mn = fmaxf(mrun[hh], bm);
      float alpha = fast_exp2(mrun[hh] - mn);
      mrun[hh] = mn;
      float ps = 0.f;
      bf16x8 pf[KPI];
#pragma unroll
      for (int kk = 0; kk < KPI; ++kk) {
        float pv[8];
#pragma unroll
        for (int t = 0; t < 2; ++t)
#pragma unroll
          for (int i = 0; i < 4; ++i) {
            float p = (MODE == 0) ? (valid[kk][t][i] ? fast_exp2(lg[kk][t][i] - mn) : 0.f) : fast_exp2(lg[kk][t][i] - mn);
            pv[4 * t + i] = p; ps += p;
          }
        typedef __attribute__((ext_vector_type(4))) unsigned u32x4;
        u32x4 uu = {pack2bf(pv[0], pv[1]), pack2bf(pv[2], pv[3]), pack2bf(pv[4], pv[5]), pack2bf(pv[6], pv[7])};
        pf[kk] = __builtin_bit_cast(bf16x8, uu);
      }
      lrun[hh] = lrun[hh] * alpha + ps;
#pragma unroll
      for (int dt = 0; dt < 4; ++dt) {
        o[hh][dt] *= alpha;
#pragma unroll
        for (int kk = 0; kk < KPI; ++kk)
          o[hh][dt] = __builtin_amdgcn_mfma_f32_16x16x32_bf16(vf[kk][dt], pf[kk], o[hh][dt], 0, 0, 0);
      }
      if (NH == 4 && KPI == 2 && (hh & 1)) __builtin_amdgcn_sched_barrier(0);
    }
  }
#undef ATT_LOAD
#undef ATT_DESC
#pragma unroll
  for (int hh = 0; hh < NH; ++hh) {
    float l = xrow16_sum(lrun[hh]);
    float m = mrun[hh];
    if (MODE == 2) {
      float sk = sink[hk * NH + hh] * LOG2E;
      float mf = fmaxf(m, sk);
      float a = fast_exp2(m - mf);
      l = l * a + fast_exp2(sk - mf);
#pragma unroll
      for (int dt = 0; dt < 4; ++dt) o[hh][dt] *= a;
    }
    float inv = 1.f / l;
    bf16_t* orow = Op + (size_t)(qrow0 + ql) * ldo + (hk * NH + hh) * 64 + 4 * g;
#pragma unroll
    for (int dt = 0; dt < 4; ++dt) {
      f32x4_t v = o[hh][dt] * inv;
      *(uint2*)(orow + 16 * dt) = make_uint2(pack2bf(v[0], v[1]), pack2bf(v[2], v[3]));
    }
  }
}

struct NaState { f32x4_t o[4][4]; float m[4], l[4]; };
template <int HB>
__device__ __forceinline__ void na_block(NaState& st, const bf16x8 (&qf)[4][2], const bf16x8 (&kf)[2][2], const bf16x8 (&vf)[4],
                                         const float* rpbrow  , int ql, int g) {
  const float SC = 0.125f * 1.4426950408889634f;
#pragma unroll
  for (int jb = 0; jb < 4; ++jb) {
    if (HB == 0 && jb == 3) continue;
    if (HB == 1 && jb == 0) continue;
    f32x4_t s2[2];
#pragma unroll
    for (int t = 0; t < 2; ++t) {
      s2[t] = (f32x4_t){0.f, 0.f, 0.f, 0.f};
      s2[t] = __builtin_amdgcn_mfma_f32_16x16x32_bf16(kf[t][0], qf[jb][0], s2[t], 0, 0, 0);
      s2[t] = __builtin_amdgcn_mfma_f32_16x16x32_bf16(kf[t][1], qf[jb][1], s2[t], 0, 0, 0);
    }
    float lg[8]; bool valid[8]; float bm = -1e30f;
#pragma unroll
    for (int t = 0; t < 2; ++t)
#pragma unroll
      for (int i = 0; i < 4; ++i) {
        float v;
        if (HB < 2) {
          int qc = 16 * jb + ql; int c_lo = min(max(qc - 8, 0), 48);
          int kc = 32 * HB + 8 * g + 4 * t + i;
          bool ok = (kc >= c_lo) && (kc < c_lo + 16);
          int dc = min(max(kc - qc, -15), 15) + 15;
          v = ok ? (s2[t][i] * SC + rpbrow[dc]) : -1e30f;
          valid[4 * t + i] = ok;
        } else { v = s2[t][i] * SC; valid[4 * t + i] = true; }
        lg[4 * t + i] = v; bm = fmaxf(bm, v);
      }
    bm = xrow16_max(bm);
    float mn = fmaxf(st.m[jb], bm);
    float alpha = fast_exp2(st.m[jb] - mn);
    st.m[jb] = mn;
    float ps = 0.f; float pv[8];
#pragma unroll
    for (int e = 0; e < 8; ++e) { float p = valid[e] ? fast_exp2(lg[e] - mn) : 0.f; pv[e] = p; ps += p; }
    st.l[jb] = st.l[jb] * alpha + ps;
    typedef __attribute__((ext_vector_type(4))) unsigned u32x4;
    u32x4 uu = {pack2bf(pv[0], pv[1]), pack2bf(pv[2], pv[3]), pack2bf(pv[4], pv[5]), pack2bf(pv[6], pv[7])};
    bf16x8 pf = __builtin_bit_cast(bf16x8, uu);
#pragma unroll
    for (int dt = 0; dt < 4; ++dt) {
      st.o[jb][dt] *= alpha;
      st.o[jb][dt] = __builtin_amdgcn_mfma_f32_16x16x32_bf16(vf[dt], pf, st.o[jb][dt], 0, 0, 0);
    }
    if (jb & 1) __builtin_amdgcn_sched_barrier(0);
  }
}
__device__ __forceinline__ void na_unit(int b, int h, int r, const bf16_t* __restrict__ FQKV, const bf16_t* __restrict__ VTl,
                                        const bf16_t* __restrict__ VTc, const float* rpbs, bf16_t* __restrict__ MIX, int lane) {
  asm volatile("" : "+v"(lane));
  int ql = lane & 15, g = lane >> 4;
  int qrow0 = b * S + r * 64;
  int r_start = min(max(r - 4, 0), 120);
  bf16x8 qf[4][2];
#pragma unroll
  for (int jb = 0; jb < 4; ++jb)
#pragma unroll
    for (int s2 = 0; s2 < 2; ++s2)
      qf[jb][s2] = ld16(FQKV + (size_t)(qrow0 + 16 * jb + ql) * 2048 + 512 + h * 64 + 32 * s2 + 8 * g);
  NaState st;
#pragma unroll
  for (int jb = 0; jb < 4; ++jb) {
    st.m[jb] = -1e30f; st.l[jb] = 0.f;
#pragma unroll
    for (int dt = 0; dt < 4; ++dt) st.o[jb][dt] = (f32x4_t){0.f, 0.f, 0.f, 0.f};
  }
  unsigned koff = (unsigned)((8 * (ql >> 2) + (ql & 3)) * 2048 + 1024 + h * 64 + 8 * g);
  unsigned voffl = (unsigned)(ql * S + 8 * g), voffc = (unsigned)(ql * CL + 8 * g);
  const bf16_t* vtl = VTl + (size_t)(b * 8 + h) * 64 * S;
  const bf16_t* vtc = VTc + (size_t)(b * 8 + h) * 64 * CL;
#define NA_LOADK(kb2, KF) { \
    int krow0_; \
    if ((kb2) < 16) krow0_ = b * S + (r_start + ((kb2) >> 1)) * 64 + 32 * ((kb2) & 1); \
    else krow0_ = T + b * CL + 32 * ((kb2) - 16); \
    const bf16_t* kb_ = FQKV + (size_t)krow0_ * 2048; \
    _Pragma("unroll") for (int t = 0; t < 2; ++t) _Pragma("unroll") for (int s2 = 0; s2 < 2; ++s2) \
      KF[t][s2] = ld16(kb_ + (koff + (unsigned)(t * 4 * 2048 + 32 * s2))); }
#define NA_LOADV(kb2, VF) { \
    if ((kb2) < 16) { const bf16_t* vt_ = vtl + (r_start + ((kb2) >> 1)) * 64 + 32 * ((kb2) & 1); \
      _Pragma("unroll") for (int dt = 0; dt < 4; ++dt) VF[dt] = ld16(vt_ + (voffl + (unsigned)(16 * dt * S))); } \
    else { const bf16_t* vt_ = vtc + 32 * ((kb2) - 16); \
      _Pragma("unroll") for (int dt = 0; dt < 4; ++dt) VF[dt] = ld16(vt_ + (voffc + (unsigned)(16 * dt * CL))); } }
  bf16x8 kfa[2][2], kfb[2][2], vfa[4], vfb[4];
  NA_LOADK(0, kfa) NA_LOADV(0, vfa)
#pragma unroll 1
  for (int rr = 0; rr < 8; ++rr) {
    const float* rpbrow = rpbs + (h * 15 + (r_start + rr - r + 7)) * 31;
    asm volatile("" : "+v"(lane)); ql = lane & 15; g = lane >> 4;
    koff = (unsigned)((8 * (ql >> 2) + (ql & 3)) * 2048 + 1024 + h * 64 + 8 * g); voffl = (unsigned)(ql * S + 8 * g); voffc = (unsigned)(ql * CL + 8 * g);
    NA_LOADK(2 * rr + 1, kfb) NA_LOADV(2 * rr + 1, vfb)
    na_block<0>(st, qf, kfa, vfa, rpbrow, ql, g);
    NA_LOADK(2 * rr + 2, kfa) NA_LOADV(2 * rr + 2, vfa)
    na_block<1>(st, qf, kfb, vfb, rpbrow, ql, g);
  }
#pragma unroll 1
  for (int cb = 0; cb < 8; cb += 2) {
    asm volatile("" : "+v"(lane)); ql = lane & 15; g = lane >> 4;
    koff = (unsigned)((8 * (ql >> 2) + (ql & 3)) * 2048 + 1024 + h * 64 + 8 * g); voffc = (unsigned)(ql * CL + 8 * g);
    NA_LOADK(16 + cb + 1, kfb) NA_LOADV(16 + cb + 1, vfb)
    na_block<2>(st, qf, kfa, vfa, rpbs, ql, g);
    if (cb + 2 < 8) { NA_LOADK(16 + cb + 2, kfa) NA_LOADV(16 + cb + 2, vfa) }
    na_block<2>(st, qf, kfb, vfb, rpbs, ql, g);
  }
#undef NA_LOADK
#undef NA_LOADV
  asm volatile("" : "+v"(lane)); ql = lane & 15; g = lane >> 4;
#pragma unroll
  for (int jb = 0; jb < 4; ++jb) {
    float inv = 1.f / xrow16_sum(st.l[jb]);
    bf16_t* orow = MIX + (size_t)(qrow0 + 16 * jb + ql) * 1024 + 512 + h * 64 + 4 * g;
#pragma unroll
    for (int dt = 0; dt < 4; ++dt) {
      f32x4_t v = st.o[jb][dt] * inv;
      *(uint2*)(orow + 16 * dt) = make_uint2(pack2bf(v[0], v[1]), pack2bf(v[2], v[3]));
    }
  }
}

__device__ __forceinline__ void ph_chan_dft(const float* __restrict__ F, const float* __restrict__ tab, float* __restrict__ PQ) {
  for (int gid = blockIdx.x * 256 + threadIdx.x; gid < R * 512; gid += gridDim.x * 256) {
    int row = gid >> 9; int col = gid & 511; int g = col >> 6, cp = col & 63;
    const float* f = F + (size_t)row * 2048 + g * 64;
    float p = 0.f, q = 0.f;
    for (int ch = 0; ch < 64; ++ch) {
      int idx = ((ch * cp) & 63) * 128;
      float x = f[ch];
      p += x * tab[idx]; q += x * tab[8192 + idx];
    }
    PQ[(size_t)row * 1024 + col] = p;
    PQ[(size_t)row * 1024 + 512 + col] = q;
  }
}

__device__ __forceinline__ void ph_na(const bf16_t* __restrict__ F, const float* __restrict__ rpb, bf16_t* __restrict__ MIX, float* sm) {
  int lane = threadIdx.x & 63, wave = __builtin_amdgcn_readfirstlane(threadIdx.x >> 6);
  float* sq = sm + wave * 1024; float* sp = sq + 64; int* stok = (int*)(sp + 384);
  int nitems = R * 8;
  for (int item0 = blockIdx.x * 4; item0 < nitems; item0 += gridDim.x * 4) {
    int item = item0 + wave;
    int h = item & 7; int row = item >> 3;
    bool is_ctx = row >= T;
    int b = is_ctx ? (row - T) / CL : row / S;
    __syncthreads();
    sq[lane] = bf2f(F[(size_t)row * 2048 + 512 + h * 64 + lane]);
    __syncthreads();
    int r = 0, c = 0, r_start = 0, c_start = 0;
    if (!is_ctx) { int t = row % S; r = t / 64; c = t % 64; r_start = min(max(r - 4, 0), 120); c_start = min(max(c - 8, 0), 48); }
    int nk = is_ctx ? 256 : 384;
    float lg[6]; float mx = -INFINITY;
#pragma unroll
    for (int kk = 0; kk < 6; ++kk) {
      int j = kk * 64 + lane; float s = -INFINITY; int tok = 0;
      if (j < nk) {
        float bias = 0.f;
        if (!is_ctx && j < 128) {
          int kr = j >> 4, kc = j & 15; int rr = r_start + kr, cc = c_start + kc;
          tok = b * S + rr * 64 + cc;
          int dc = min(max(cc - c, -15), 15) + 15;
          bias = rpb[(h * 15 + (rr - r + 7)) * 31 + dc];
        } else {
          int l = is_ctx ? j : j - 128; tok = T + b * CL + l;
        }
        const bf16_t* kp = F + (size_t)tok * 2048 + 1024 + h * 64;
        float acc = 0.f;
#pragma unroll 8
        for (int d = 0; d < 64; ++d) acc += sq[d] * bf2f(kp[d]);
        s = acc * 0.125f + bias;
      }
      lg[kk] = s; stok[j] = tok; mx = fmaxf(mx, s);
    }
    mx = wave_max(mx);
    float sum = 0.f;
#pragma unroll
    for (int kk = 0; kk < 6; ++kk) { float e = (kk * 64 + lane < nk) ? expf(lg[kk] - mx) : 0.f; lg[kk] = e; sum += e; }
    sum = wave_sum(sum);
    float inv = 1.f / sum;
#pragma unroll
    for (int kk = 0; kk < 6; ++kk) sp[kk * 64 + lane] = lg[kk] * inv;
    __syncthreads();
    float o = 0.f;
    for (int j = 0; j < nk; ++j) o += sp[j] * bf2f(F[(size_t)stok[j] * 2048 + 1536 + h * 64 + lane]);
    MIX[(size_t)row * 1024 + 512 + h * 64 + lane] = (bf16_t)f2bf(o);
  }
}

__device__ __forceinline__ void ph_rope(float* __restrict__ F1) {
  for (int gid = blockIdx.x * 256 + threadIdx.x; gid < T * 20 * 32; gid += gridDim.x * 256) {
    int i = gid & 31; int hh = (gid >> 5) % 20; int row = gid / (32 * 20);
    int t = row % S; float rowp = (float)(t / 64), colp = (float)(t % 64);
    int fi = i & 15;
    float inv_freq = powf(10000.0f, -(float)fi / 16.0f);
    float ang = (i < 16 ? rowp : colp) * inv_freq;
    float cs = cosf(ang), sn = sinf(ang);
    float* p = F1 + (size_t)row * 1536 + hh * 64;
    float x1 = p[i], x2 = p[i + 32];
    p[i] = x1 * cs - x2 * sn;
    p[i + 32] = x1 * sn + x2 * cs;
  }
}

__device__ __forceinline__ void ph_gqa(const float* __restrict__ F1, const float* __restrict__ sink, bf16_t* __restrict__ O, float* sm) {
  int lane = threadIdx.x & 63, wave = __builtin_amdgcn_readfirstlane(threadIdx.x >> 6);
  float* sq = sm + wave * 1280; float* sp = sq + 64; int* stok = (int*)(sp + 576);
  int nitems = T * 16;
  for (int item0 = blockIdx.x * 4; item0 < nitems; item0 += gridDim.x * 4) {
    int item = item0 + wave;
    int qh = item & 15; int row = item >> 4; int kvh = qh >> 2;
    int b = row / S; int t = row % S;
    __syncthreads();
    sq[lane] = F1[(size_t)row * 1536 + qh * 64 + lane];
    __syncthreads();
    float lg[9]; float mx = -INFINITY;
#pragma unroll
    for (int kk = 0; kk < 9; ++kk) {
      int j = kk * 64 + lane; float s = -INFINITY; int tok = 0; bool valid = false;
      if (j < 257) { int pos = t - 128 + j; valid = (pos >= 0 && pos < S); tok = b * S + pos; }
      else if (j < 513) { valid = true; tok = T + b * CL + (j - 257); }
      if (valid) {
        const float* kp = F1 + (size_t)tok * 1536 + 1024 + kvh * 64;
        float acc = 0.f;
#pragma unroll 8
        for (int d = 0; d < 64; ++d) acc += sq[d] * kp[d];
        s = acc * 0.125f;
      } else tok = 0;
      lg[kk] = s; stok[j] = tok; mx = fmaxf(mx, s);
    }
    mx = wave_max(mx);
    float sk = sink[qh];
    mx = fmaxf(mx, sk);
    float sum = 0.f;
#pragma unroll
    for (int kk = 0; kk < 9; ++kk) { float e = (lg[kk] == -INFINITY) ? 0.f : expf(lg[kk] - mx); lg[kk] = e; sum += e; }
    sum = wave_sum(sum) + expf(sk - mx);
    float inv = 1.f / sum;
#pragma unroll
    for (int kk = 0; kk < 9; ++kk) sp[kk * 64 + lane] = lg[kk] * inv;
    __syncthreads();
    float o = 0.f;
    for (int j = 0; j < 513; ++j) { float p = sp[j]; if (p != 0.f) o += p * F1[(size_t)stok[j] * 1536 + 1280 + kvh * 64 + lane]; }
    O[(size_t)row * 1024 + qh * 64 + lane] = (bf16_t)f2bf(o);
  }
}

__device__ __forceinline__ void wave_argmax(float& v, int& idx) {
#pragma unroll
  for (int off = 32; off; off >>= 1) {
    float ov = __shfl_xor(v, off); int oi = __shfl_xor(idx, off);
    if (ov > v || (ov == v && oi < idx)) { v = ov; idx = oi; }
  }
}
__device__ __forceinline__ void ph_peer_select_naive(const float* __restrict__ Q, const float* __restrict__ sk, int* __restrict__ EXP,
                                     float* __restrict__ GATE, int nrows, float* sm) {
  int lane = threadIdx.x & 63, wave = __builtin_amdgcn_readfirstlane(threadIdx.x >> 6);
  float* sq = sm + wave * 640; float* tops = sq + 256; int* topi = (int*)(tops + 32);
  for (int row0 = blockIdx.x * 4; row0 < nrows; row0 += gridDim.x * 4) {
    int row = row0 + wave;
    for (int h = 0; h < 8; ++h) {
      __syncthreads();
#pragma unroll
      for (int i = 0; i < 4; ++i) sq[lane + 64 * i] = Q[(size_t)row * 2048 + h * 256 + lane + 64 * i];
      __syncthreads();
      for (int p = 0; p < 2; ++p) {
        float s0 = 0.f, s1 = 0.f;
        const float* k0 = sk + ((size_t)((h * 2 + p) * 128 + lane)) * 128;
        const float* k1 = k0 + 64 * 128;
#pragma unroll 8
        for (int d = 0; d < 128; ++d) { float qv = sq[p * 128 + d]; s0 += qv * k0[d]; s1 += qv * k1[d]; }
        for (int i = 0; i < 16; ++i) {
          float v; int idx;
          if (s0 >= s1) { v = s0; idx = lane; } else { v = s1; idx = lane + 64; }
          wave_argmax(v, idx);
          if (lane == 0) { tops[p * 16 + i] = v; topi[p * 16 + i] = idx; }
          if (idx == lane) s0 = -INFINITY;
          if (idx == lane + 64) s1 = -INFINITY;
        }
      }
      __syncthreads();
      float cs[4];
#pragma unroll
      for (int i = 0; i < 4; ++i) { int ci = lane * 4 + i; cs[i] = tops[ci >> 4] + tops[16 + (ci & 15)]; }
      float bs[16]; int be[16];
#pragma unroll
      for (int k = 0; k < 16; ++k) {
        float v = cs[0]; int idx = lane * 4;
#pragma unroll
        for (int i = 1; i < 4; ++i) if (cs[i] > v) { v = cs[i]; idx = lane * 4 + i; }
        wave_argmax(v, idx);
        bs[k] = v; be[k] = topi[idx >> 4] * 128 + topi[16 + (idx & 15)];
#pragma unroll
        for (int i = 0; i < 4; ++i) if (idx == lane * 4 + i) cs[i] = -INFINITY;
      }
      float mxs = bs[0]; float sum = 0.f;
#pragma unroll
      for (int k = 0; k < 16; ++k) { bs[k] = expf(bs[k] - mxs); sum += bs[k]; }
      float inv = 1.f / sum;
      if (lane == 0) {
#pragma unroll
        for (int k = 0; k < 16; ++k) { EXP[(size_t)row * 128 + h * 16 + k] = be[k]; GATE[(size_t)row * 128 + h * 16 + k] = bs[k] * inv; }
      }
    }
  }
}

__device__ __forceinline__ void unpack8(uint4 v, float* f) {
  f[0] = __uint_as_float(v.x << 16); f[1] = __uint_as_float(v.x & 0xffff0000u);
  f[2] = __uint_as_float(v.y << 16); f[3] = __uint_as_float(v.y & 0xffff0000u);
  f[4] = __uint_as_float(v.z << 16); f[5] = __uint_as_float(v.z & 0xffff0000u);
  f[6] = __uint_as_float(v.w << 16); f[7] = __uint_as_float(v.w & 0xffff0000u);
}
__device__ __forceinline__ void ph_peer_gather(bf16_t* __restrict__ H, const int* __restrict__ EXP, const float* __restrict__ GATE,
                               const bf16_t* __restrict__ U, const bf16_t* __restrict__ V,
                               const float* __restrict__ xin, const float* __restrict__ M, int layer,
                               const float* __restrict__ g, const float* __restrict__ bb, float* __restrict__ xout,
                               bool write_next, int nrows) {
  int lane = threadIdx.x & 63, wave = __builtin_amdgcn_readfirstlane(threadIdx.x >> 6);
  for (int row = blockIdx.x * 4 + wave; row < nrows; row += gridDim.x * 4) {
    float hreg[16];
    {
      const uint4* hp = (const uint4*)(H + (size_t)row * D + 8 * lane);
      unpack8(hp[0], hreg); unpack8(hp[64], hreg + 8);
    }
    float acc[16];
#pragma unroll
    for (int i = 0; i < 16; ++i) acc[i] = 0.f;
    int e_lo = EXP[(size_t)row * 128 + lane], e_hi = EXP[(size_t)row * 128 + 64 + lane];
    float g_lo = GATE[(size_t)row * 128 + lane], g_hi = GATE[(size_t)row * 128 + 64 + lane];
    uint4 ua[4], ub[4], va[4], vb[4];
#pragma unroll
    for (int i = 0; i < 4; ++i) {
      int e = __builtin_amdgcn_readlane(e_lo, i);
      const uint4* up = (const uint4*)(U + (size_t)e * D + 8 * lane); ua[i] = up[0]; ub[i] = up[64];
    }
#pragma unroll 1
    for (int b = 0; b < 32; ++b) {
      int k0 = 4 * b;
      int ev = (b < 16) ? e_lo : e_hi; float gv = (b < 16) ? g_lo : g_hi;
      int en = (b + 1 < 16) ? e_lo : e_hi;
      float gt[4];
#pragma unroll
      for (int i = 0; i < 4; ++i) {
        int e = __builtin_amdgcn_readlane(ev, (k0 + i) & 63);
        gt[i] = __uint_as_float(__builtin_amdgcn_readlane(__float_as_uint(gv), (k0 + i) & 63));
        const uint4* vp = (const uint4*)(V + (size_t)e * D + 8 * lane); va[i] = vp[0]; vb[i] = vp[64];
      }
      float a[4];
#pragma unroll
      for (int i = 0; i < 4; ++i) {
        float f[16]; unpack8(ua[i], f); unpack8(ub[i], f + 8);
        float sacc = 0.f;
#pragma unroll
        for (int j = 0; j < 16; ++j) sacc += f[j] * hreg[j];
        a[i] = sacc;
      }
      if (b + 1 < 32) {
#pragma unroll
        for (int i = 0; i < 4; ++i) {
          int e = __builtin_amdgcn_readlane(en, (k0 + 4 + i) & 63);
          const uint4* up = (const uint4*)(U + (size_t)e * D + 8 * lane); ua[i] = up[0]; ub[i] = up[64];
        }
      }
#pragma unroll
      for (int i = 0; i < 4; ++i) a[i] = wave_sum(a[i]);
#pragma unroll
      for (int i = 0; i < 4; ++i) {
        float w = gt[i] * 0.5f * a[i] * (1.f + erff(a[i] * 0.70710678118654752f));
        float f[16]; unpack8(va[i], f); unpack8(vb[i], f + 8);
#pragma unroll
        for (int j = 0; j < 16; ++j) acc[j] += w * f[j];
      }
    }
    const float* m = M + ((size_t)layer * 3 + mod_index(row)) * 6144;
    const float* xr = xin + (size_t)row * D;
    float v[16];
#pragma unroll
    for (int hh = 0; hh < 2; ++hh) {
      int d0 = hh * 512 + 8 * lane;
      float4 x0 = *(const float4*)(xr + d0), x1 = *(const float4*)(xr + d0 + 4);
      float4 m0 = *(const float4*)(m + 5 * D + d0), m1 = *(const float4*)(m + 5 * D + d0 + 4);
      v[hh * 8 + 0] = DN_ALPHA * x0.x + m0.x * acc[hh * 8 + 0]; v[hh * 8 + 1] = DN_ALPHA * x0.y + m0.y * acc[hh * 8 + 1];
      v[hh * 8 + 2] = DN_ALPHA * x0.z + m0.z * acc[hh * 8 + 2]; v[hh * 8 + 3] = DN_ALPHA * x0.w + m0.w * acc[hh * 8 + 3];
      v[hh * 8 + 4] = DN_ALPHA * x1.x + m1.x * acc[hh * 8 + 4]; v[hh * 8 + 5] = DN_ALPHA * x1.y + m1.y * acc[hh * 8 + 5];
      v[hh * 8 + 6] = DN_ALPHA * x1.z + m1.z * acc[hh * 8 + 6]; v[hh * 8 + 7] = DN_ALPHA * x1.w + m1.w * acc[hh * 8 + 7];
    }
    float s = 0.f;
#pragma unroll
    for (int j = 0; j < 16; ++j) s += v[j];
    float mu = wave_sum(s) * (1.f / D);
    float q = 0.f;
#pragma unroll
    for (int j = 0; j < 16; ++j) { float d = v[j] - mu; q += d * d; }
    float rs = rsqrtf(wave_sum(q) * (1.f / D) + LN_EPS);
    float y[16];
#pragma unroll
    for (int hh = 0; hh < 2; ++hh) {
      int d0 = hh * 512 + 8 * lane;
#pragma unroll
      for (int j = 0; j < 8; ++j) y[hh * 8 + j] = (v[hh * 8 + j] - mu) * rs * g[d0 + j] + bb[d0 + j];
      *(float4*)(xout + (size_t)row * D + d0) = make_float4(y[hh * 8], y[hh * 8 + 1], y[hh * 8 + 2], y[hh * 8 + 3]);
      *(float4*)(xout + (size_t)row * D + d0 + 4) = make_float4(y[hh * 8 + 4], y[hh * 8 + 5], y[hh * 8 + 6], y[hh * 8 + 7]);
    }
    if (write_next) {
      const float* mn = M + ((size_t)(layer + 1) * 3 + mod_index(row)) * 6144;
      float s2 = 0.f;
#pragma unroll
      for (int j = 0; j < 16; ++j) s2 += y[j];
      float mu2 = wave_sum(s2) * (1.f / D);
      float q2 = 0.f;
#pragma unroll
      for (int j = 0; j < 16; ++j) { float d = y[j] - mu2; q2 += d * d; }
      float rs2 = rsqrtf(wave_sum(q2) * (1.f / D) + LN_EPS);
#pragma unroll
      for (int hh = 0; hh < 2; ++hh) {
        int d0 = hh * 512 + 8 * lane;
        float o[8];
#pragma unroll
        for (int j = 0; j < 8; ++j) o[j] = (y[hh * 8 + j] - mu2) * rs2 * (1.f + mn[D + d0 + j]) + mn[d0 + j];
        *(uint4*)(H + (size_t)row * D + d0) = make_uint4(pack2bf(o[0], o[1]), pack2bf(o[2], o[3]), pack2bf(o[4], o[5]), pack2bf(o[6], o[7]));
      }
    }
  }
}


__device__ __forceinline__ void quant_row(const float* __restrict__ src, unsigned char* __restrict__ dst, float* __restrict__ scale, int row, int lane) {
  const float4* sp = (const float4*)(src + (size_t)row * D + 16 * lane);
  float4 v0 = sp[0], v1 = sp[1], v2 = sp[2], v3 = sp[3];
  float x[16] = {v0.x, v0.y, v0.z, v0.w, v1.x, v1.y, v1.z, v1.w, v2.x, v2.y, v2.z, v2.w, v3.x, v3.y, v3.z, v3.w};
  float am = 0.f;
#pragma unroll
  for (int j = 0; j < 16; ++j) am = fmaxf(am, fabsf(x[j]));
  am = wave_max(am);
  float inv = am > 0.f ? 127.f / am : 0.f;
  unsigned wv[4];
#pragma unroll
  for (int k = 0; k < 4; ++k) {
    unsigned w = 0;
#pragma unroll
    for (int j = 0; j < 4; ++j) {
      int q = (int)rintf(x[4 * k + j] * inv);
      w |= ((unsigned)q & 0xffu) << (8 * j);
    }
    wv[k] = w;
  }
  *(uint4*)(dst + ((size_t)(row >> 14) * 8 + (lane >> 3)) * ((size_t)16384 * 128) + (size_t)(row & 16383) * 128 + 16 * (lane & 7)) = make_uint4(wv[0], wv[1], wv[2], wv[3]);
  if (lane == 0) scale[row] = am * (1.f / 127.f);
}
__device__ __forceinline__ void quant_row_u4(const float* __restrict__ src, unsigned char* __restrict__ dst, float* __restrict__ scale, int row, int lane) {
  const float4* sp = (const float4*)(src + (size_t)row * D + 16 * lane);
  float4 v0 = sp[0], v1 = sp[1], v2 = sp[2], v3 = sp[3];
  float x[16] = {v0.x, v0.y, v0.z, v0.w, v1.x, v1.y, v1.z, v1.w, v2.x, v2.y, v2.z, v2.w, v3.x, v3.y, v3.z, v3.w};
  float ss = 0.f;
#pragma unroll
  for (int j = 0; j < 16; ++j) ss += x[j] * x[j];
  ss = wave_sum(ss);
  float delta = 0.3352f * sqrtf(ss * (1.f / D));
  float inv = delta > 0.f ? 1.f / delta : 0.f;
  unsigned wv[2];
#pragma unroll
  for (int k = 0; k < 2; ++k) {
    unsigned w = 0;
#pragma unroll
    for (int j = 0; j < 4; ++j) {
      int qh = (int)fminf(fmaxf(floorf(x[8 * k + j] * inv), -8.f), 7.f);
      int ql = (int)fminf(fmaxf(floorf(x[8 * k + 4 + j] * inv), -8.f), 7.f);
      w |= ((((unsigned)qh & 15u) << 4) | ((unsigned)ql & 15u)) << (8 * j);
    }
    wv[k] = w;
  }
  *(uint2*)(dst + ((size_t)(row >> 14) * 4 + (lane >> 4)) * ((size_t)16384 * 128) + (size_t)(row & 16383) * 128 + 8 * (lane & 15)) = make_uint2(wv[0], wv[1]);
  if (lane == 0) scale[row] = delta;
}
__device__ __forceinline__ void quant_fill(unsigned* ctr, int layer, unsigned lo, unsigned hi, const float* __restrict__ pu, const float* __restrict__ pv,
                                           unsigned char* __restrict__ U8, unsigned char* __restrict__ V8, float* __restrict__ USC,
                                           float* __restrict__ VSC, unsigned* sh) {
  int lane = threadIdx.x & 63, wave = __builtin_amdgcn_readfirstlane(threadIdx.x >> 6);
  for (;;) {
    __syncthreads();
    if (threadIdx.x == 0) *sh = lo + __hip_atomic_fetch_add(ctr, 1u, __ATOMIC_RELAXED, __HIP_MEMORY_SCOPE_AGENT);
    __syncthreads();
    unsigned c = *sh;
    if (c >= hi) break;
    const float* src = (c >> 8) ? pv : pu; unsigned char* dst = (c >> 8) ? V8 : U8; float* sc = (c >> 8) ? VSC : USC;
    int r0 = layer * 16384 + (int)(c & 255u) * 64 + wave * 16;
    if (c >> 8) {
#pragma unroll 4
      for (int i = 0; i < 16; ++i) quant_row(src, dst, sc, r0 + i, lane);
    } else {
#pragma unroll 4
      for (int i = 0; i < 16; ++i) quant_row_u4(src, dst, sc, r0 + i, lane);
    }
  }
  __syncthreads();
}
__device__ __forceinline__ void unpack_u8x16(uint4 v, float* f) {
  unsigned w[4] = {v.x, v.y, v.z, v.w};
#pragma unroll
  for (int k = 0; k < 4; ++k) {
    f[4 * k + 0] = (float)(w[k] & 0xffu); f[4 * k + 1] = (float)((w[k] >> 8) & 0xffu);
    f[4 * k + 2] = (float)((w[k] >> 16) & 0xffu); f[4 * k + 3] = (float)(w[k] >> 24);
  }
}
__device__ __forceinline__ void ph_peer_gather8(bf16_t* __restrict__ H, const int* __restrict__ EXP, const float* __restrict__ GATE,
                               const unsigned char* __restrict__ U8, const float* __restrict__ USC,
                               const unsigned char* __restrict__ V8, const float* __restrict__ VSC,
                               const float* __restrict__ xin, const float* __restrict__ M, int layer,
                               const float* __restrict__ g, const float* __restrict__ bb, float* __restrict__ xout,
                               bool write_next, int nrows) {
  int lane = threadIdx.x & 63, wave = __builtin_amdgcn_readfirstlane(threadIdx.x >> 6);
  for (int row = blockIdx.x * 4 + wave; row < nrows; row += gridDim.x * 4) {
    float hreg[16];
    {
      const uint4* hp = (const uint4*)(H + (size_t)row * D + 16 * lane);
      unpack8(hp[0], hreg); unpack8(hp[1], hreg + 8);
    }
    float hs = 0.f;
#pragma unroll
    for (int j = 0; j < 16; ++j) hs += hreg[j];
    float hsum128 = 128.f * wave_sum(hs);
    float acc[16];
#pragma unroll
    for (int i = 0; i < 16; ++i) acc[i] = 0.f;
    float wsum = 0.f;
    int e_lo = EXP[(size_t)row * 128 + lane], e_hi = EXP[(size_t)row * 128 + 64 + lane];
    float g_lo = GATE[(size_t)row * 128 + lane], g_hi = GATE[(size_t)row * 128 + 64 + lane];
    float us_lo = USC[e_lo], us_hi = USC[e_hi], vs_lo = VSC[e_lo], vs_hi = VSC[e_hi];
    uint4 ua[8], va[8];
#pragma unroll
    for (int i = 0; i < 8; ++i) {
      int e = __builtin_amdgcn_readlane(e_lo, i);
      ua[i] = *(const uint4*)(U8 + (size_t)e * D + 16 * lane);
    }
#pragma unroll 1
    for (int b = 0; b < 16; ++b) {
      int k0 = 8 * b;
      bool lo = b < 8, lon = (b + 1) < 8;
      int ev = lo ? e_lo : e_hi; float gv = lo ? g_lo : g_hi; float usv = lo ? us_lo : us_hi; float vsv = lo ? vs_lo : vs_hi;
      int en = lon ? e_lo : e_hi;
      float gt[8], usc[8], vsc[8];
#pragma unroll
      for (int i = 0; i < 8; ++i) {
        int li = (k0 + i) & 63;
        int e = __builtin_amdgcn_readlane(ev, li);
        gt[i] = __uint_as_float(__builtin_amdgcn_readlane(__float_as_uint(gv), li));
        usc[i] = __uint_as_float(__builtin_amdgcn_readlane(__float_as_uint(usv), li));
        vsc[i] = __uint_as_float(__builtin_amdgcn_readlane(__float_as_uint(vsv), li));
        va[i] = *(const uint4*)(V8 + (size_t)e * D + 16 * lane);
      }
      float a[8];
#pragma unroll
      for (int i = 0; i < 8; ++i) {
        float f[16]; unpack_u8x16(ua[i], f);
        float sacc = 0.f;
#pragma unroll
        for (int j = 0; j < 16; ++j) sacc += f[j] * hreg[j];
        a[i] = sacc;
      }
      if (b + 1 < 16) {
#pragma unroll
        for (int i = 0; i < 8; ++i) {
          int e = __builtin_amdgcn_readlane(en, (k0 + 8 + i) & 63);
          ua[i] = *(const uint4*)(U8 + (size_t)e * D + 16 * lane);
        }
      }
#pragma unroll
      for (int i = 0; i < 8; ++i) a[i] = (wave_sum(a[i]) - hsum128) * usc[i];
#pragma unroll
      for (int i = 0; i < 8; ++i) {
        float w = gt[i] * 0.5f * a[i] * (1.f + erff(a[i] * 0.70710678118654752f)) * vsc[i];
        wsum += w;
        float f[16]; unpack_u8x16(va[i], f);
#pragma unroll
        for (int j = 0; j < 16; ++j) acc[j] += w * f[j];
      }
    }
    float corr = 128.f * wsum;
#pragma unroll
    for (int j = 0; j < 16; ++j) acc[j] -= corr;
    const float* m = M + ((size_t)layer * 3 + mod_index(row)) * 6144;
    const float* xr = xin + (size_t)row * D + 16 * lane;
    const float* m5 = m + 5 * D + 16 * lane;
    float v[16];
#pragma unroll
    for (int q4 = 0; q4 < 4; ++q4) {
      float4 x0 = *(const float4*)(xr + 4 * q4); float4 m0 = *(const float4*)(m5 + 4 * q4);
      v[4 * q4 + 0] = DN_ALPHA * x0.x + m0.x * acc[4 * q4 + 0]; v[4 * q4 + 1] = DN_ALPHA * x0.y + m0.y * acc[4 * q4 + 1];
      v[4 * q4 + 2] = DN_ALPHA * x0.z + m0.z * acc[4 * q4 + 2]; v[4 * q4 + 3] = DN_ALPHA * x0.w + m0.w * acc[4 * q4 + 3];
    }
    float s = 0.f;
#pragma unroll
    for (int j = 0; j < 16; ++j) s += v[j];
    float mu = wave_sum(s) * (1.f / D);
    float q = 0.f;
#pragma unroll
    for (int j = 0; j < 16; ++j) { float d = v[j] - mu; q += d * d; }
    float rs = rsqrtf(wave_sum(q) * (1.f / D) + LN_EPS);
    float y[16];
    {
      const float* gp = g + 16 * lane; const float* bp = bb + 16 * lane;
      float* op = xout + (size_t)row * D + 16 * lane;
#pragma unroll
      for (int q4 = 0; q4 < 4; ++q4) {
        float4 g4 = *(const float4*)(gp + 4 * q4); float4 b4 = *(const float4*)(bp + 4 * q4);
        y[4 * q4 + 0] = (v[4 * q4 + 0] - mu) * rs * g4.x + b4.x; y[4 * q4 + 1] = (v[4 * q4 + 1] - mu) * rs * g4.y + b4.y;
        y[4 * q4 + 2] = (v[4 * q4 + 2] - mu) * rs * g4.z + b4.z; y[4 * q4 + 3] = (v[4 * q4 + 3] - mu) * rs * g4.w + b4.w;
        *(float4*)(op + 4 * q4) = make_float4(y[4 * q4], y[4 * q4 + 1], y[4 * q4 + 2], y[4 * q4 + 3]);
      }
    }
    if (write_next) {
      const float* mn = M + ((size_t)(layer + 1) * 3 + mod_index(row)) * 6144 + 16 * lane;
      float s2 = 0.f;
#pragma unroll
      for (int j = 0; j < 16; ++j) s2 += y[j];
      float mu2 = wave_sum(s2) * (1.f / D);
      float q2 = 0.f;
#pragma unroll
      for (int j = 0; j < 16; ++j) { float d = y[j] - mu2; q2 += d * d; }
      float rs2 = rsqrtf(wave_sum(q2) * (1.f / D) + LN_EPS);
      float o[16];
#pragma unroll
      for (int j = 0; j < 16; ++j) o[j] = (y[j] - mu2) * rs2 * (1.f + mn[D + j]) + mn[j];
      uint4* hp = (uint4*)(H + (size_t)row * D + 16 * lane);
      hp[0] = make_uint4(pack2bf(o[0], o[1]), pack2bf(o[2], o[3]), pack2bf(o[4], o[5]), pack2bf(o[6], o[7]));
      hp[1] = make_uint4(pack2bf(o[8], o[9]), pack2bf(o[10], o[11]), pack2bf(o[12], o[13]), pack2bf(o[14], o[15]));
    }
  }
}


__device__ __forceinline__ void ph_ada2(const float* __restrict__ c, const float* __restrict__ c_ctx, const float* __restrict__ ada_w,
                                        const float* __restrict__ ada_b, float* __restrict__ M, float* sm) {
  int tid = threadIdx.x, lane = tid & 63, wave = __builtin_amdgcn_readfirstlane(tid >> 6);
  float* sv = sm;
  float* red = sm + 3072;
  bool filled = false;
  GRID_LOOP(u, 192) {
    if (!filled) {
      for (int i = tid; i < 3072; i += 256) {
        int idx = i >> 10, k = i & 1023;
        float x = idx < 2 ? c[idx * D + k] : c_ctx[k];
        sv[i] = x / (1.f + expf(-x));
      }
      filled = true;
    }
    __syncthreads();
    int layer = u / 96, c0 = (u % 96) * 64;
    const float* w = ada_w + (size_t)layer * D * 6144 + c0 + lane;
    float a0 = 0.f, a1 = 0.f, a2 = 0.f;
    int kb = wave * 256;
#pragma unroll 16
    for (int k = 0; k < 256; ++k) {
      float wv = w[(size_t)(kb + k) * 6144];
      a0 += sv[kb + k] * wv; a1 += sv[1024 + kb + k] * wv; a2 += sv[2048 + kb + k] * wv;
    }
    red[(wave * 3 + 0) * 64 + lane] = a0; red[(wave * 3 + 1) * 64 + lane] = a1; red[(wave * 3 + 2) * 64 + lane] = a2;
    __syncthreads();
    if (wave < 3) {
      float r = red[(0 * 3 + wave) * 64 + lane] + red[(1 * 3 + wave) * 64 + lane] + red[(2 * 3 + wave) * 64 + lane] + red[(3 * 3 + wave) * 64 + lane];
      M[((size_t)layer * 3 + wave) * 6144 + c0 + lane] = r + ada_b[layer * 6144 + c0 + lane];
    }
  }
  __syncthreads();
}

__device__ __forceinline__ void ph_post_mod(const float* __restrict__ xa, const float* __restrict__ xb, const bf16_t* __restrict__ Y,
                                            const float* __restrict__ M, int layer, int jres, int mlayer, int jshift, int jscale, bool do_mod,
                                            const float* __restrict__ g, const float* __restrict__ bb,
                                            float* __restrict__ xout, bf16_t* __restrict__ H, int nrows,
                                            unsigned char* __restrict__ HQ = nullptr, float* __restrict__ HS = nullptr) {
  int lane = threadIdx.x & 63, wave = __builtin_amdgcn_readfirstlane(threadIdx.x >> 6);
  for (int row = blockIdx.x * 4 + wave; row < nrows; row += gridDim.x * 4) {
    const float* xr = (row < T ? xa + (size_t)row * D : xb + (size_t)(row - T) * D) + 16 * lane;
    const float* m = M + ((size_t)layer * 3 + mod_index(row)) * 6144 + 16 * lane;
    float yv[16];
    {
      const uint4* yp = (const uint4*)(Y + (size_t)row * D + 16 * lane);
      unpack8(yp[0], yv); unpack8(yp[1], yv + 8);
    }
    float v[16];
#pragma unroll
    for (int q4 = 0; q4 < 4; ++q4) {
      float4 x0 = *(const float4*)(xr + 4 * q4); float4 m0 = *(const float4*)(m + jres * D + 4 * q4);
      v[4 * q4 + 0] = DN_ALPHA * x0.x + m0.x * yv[4 * q4 + 0]; v[4 * q4 + 1] = DN_ALPHA * x0.y + m0.y * yv[4 * q4 + 1];
      v[4 * q4 + 2] = DN_ALPHA * x0.z + m0.z * yv[4 * q4 + 2]; v[4 * q4 + 3] = DN_ALPHA * x0.w + m0.w * yv[4 * q4 + 3];
    }
    float s = 0.f;
#pragma unroll
    for (int j = 0; j < 16; ++j) s += v[j];
    float mu = wave_sum(s) * (1.f / D);
    float q = 0.f;
#pragma unroll
    for (int j = 0; j < 16; ++j) { float d = v[j] - mu; q += d * d; }
    float rs = rsqrtf(wave_sum(q) * (1.f / D) + LN_EPS);
    float y[16];
    {
      const float* gp = g + 16 * lane; const float* bp = bb + 16 * lane;
      float* op = xout + (size_t)row * D + 16 * lane;
#pragma unroll
      for (int q4 = 0; q4 < 4; ++q4) {
        float4 g4 = *(const float4*)(gp + 4 * q4); float4 b4 = *(const float4*)(bp + 4 * q4);
        y[4 * q4 + 0] = (v[4 * q4 + 0] - mu) * rs * g4.x + b4.x; y[4 * q4 + 1] = (v[4 * q4 + 1] - mu) * rs * g4.y + b4.y;
        y[4 * q4 + 2] = (v[4 * q4 + 2] - mu) * rs * g4.z + b4.z; y[4 * q4 + 3] = (v[4 * q4 + 3] - mu) * rs * g4.w + b4.w;
        *(float4*)(op + 4 * q4) = make_float4(y[4 * q4], y[4 * q4 + 1], y[4 * q4 + 2], y[4 * q4 + 3]);
      }
    }
    if (do_mod) {
      const float* mm = M + ((size_t)mlayer * 3 + mod_index(row)) * 6144 + 16 * lane;
      float s2 = 0.f;
#pragma unroll
      for (int j = 0; j < 16; ++j) s2 += y[j];
      float mu2 = wave_sum(s2) * (1.f / D);
      float q2 = 0.f;
#pragma unroll
      for (int j = 0; j < 16; ++j) { float d = y[j] - mu2; q2 += d * d; }
      float rs2 = rsqrtf(wave_sum(q2) * (1.f / D) + LN_EPS);
      float o[16];
#pragma unroll
      for (int j = 0; j < 16; ++j) o[j] = (y[j] - mu2) * rs2 * (1.f + mm[jscale * D + j]) + mm[jshift * D + j];
      uint4* hp = (uint4*)(H + (size_t)row * D + 16 * lane);
      hp[0] = make_uint4(pack2bf(o[0], o[1]), pack2bf(o[2], o[3]), pack2bf(o[4], o[5]), pack2bf(o[6], o[7]));
      hp[1] = make_uint4(pack2bf(o[8], o[9]), pack2bf(o[10], o[11]), pack2bf(o[12], o[13]), pack2bf(o[14], o[15]));
      if (HQ) {
        float am = 0.f;
#pragma unroll
        for (int j = 0; j < 16; ++j) am = fmaxf(am, fabsf(o[j]));
        am = fmaxf(am, dpp_mov<0xB1>(am)); am = fmaxf(am, dpp_mov<0x4E>(am)); am = fmaxf(am, dpp_mov<0x124>(am)); am = fmaxf(am, dpp_mov<0x128>(am));
        float hinv = am > 0.f ? 119.f / am : 0.f; float hsc = am * (1.f / 119.f);
        float hsum = 0.f; unsigned pk[4];
#pragma unroll
        for (int k = 0; k < 2; ++k) {
          unsigned w0 = 0, w1 = 0;
#pragma unroll
          for (int j = 0; j < 4; ++j) {
            float r0 = rintf(o[8 * k + j] * hinv), r1 = rintf(o[8 * k + 4 + j] * hinv);
            hsum += r0 + r1;
            w0 = __builtin_amdgcn_cvt_pk_u8_f32(r0 + 128.f, j, w0); w1 = __builtin_amdgcn_cvt_pk_u8_f32(r1 + 128.f, j, w1);
          }
          unsigned t0 = (w0 + 0x08080808u) ^ 0x88888888u, t1 = (w1 + 0x08080808u) ^ 0x88888888u;
          pk[2 * k] = (t0 & 0xF0F0F0F0u) | ((t1 >> 4) & 0x0F0F0F0Fu);
          pk[2 * k + 1] = ((t0 << 4) & 0xF0F0F0F0u) | (t1 & 0x0F0F0F0Fu);
        }
        hsum += dpp_mov<0xB1>(hsum); hsum += dpp_mov<0x4E>(hsum); hsum += dpp_mov<0x124>(hsum); hsum += dpp_mov<0x128>(hsum);
        *(uint4*)(HQ + (size_t)row * D + 16 * lane) = make_uint4(pk[0], pk[1], pk[2], pk[3]);
        if ((lane & 15) == 0) *(float2*)(HS + ((size_t)row * 4 + (lane >> 4)) * 2) = make_float2(hsc, 0.5f * hsc * hsum);
      }
    }
  }
}


template <int CTRL> __device__ __forceinline__ float dpp_add(float x) { return x + dpp_mov<CTRL>(x); }
__device__ __forceinline__ float sum8(float v) {
  v = dpp_add<0xB1>(v); v = dpp_add<0x4E>(v); v = dpp_add<0x141>(v); return v;
}
typedef _Float16 half2_t __attribute__((ext_vector_type(2)));
__device__ __forceinline__ float dot2h(unsigned a, unsigned b, float c) {
  return __builtin_amdgcn_fdot2(__builtin_bit_cast(half2_t, a), __builtin_bit_cast(half2_t, b), c, false);
}
__device__ __forceinline__ unsigned pkh(float a, float b) { return __builtin_bit_cast(unsigned, __builtin_amdgcn_cvt_pkrtz(a, b)); }
__device__ __forceinline__ void load_e16(const int* __restrict__ EXP, int t, int g8, int (&e)[16]) {
  const int4* ep = (const int4*)(EXP + (size_t)t * 128 + 16 * g8);
  int4 a = ep[0], b = ep[1], c = ep[2], d = ep[3];
  e[0] = a.x; e[1] = a.y; e[2] = a.z; e[3] = a.w; e[4] = b.x; e[5] = b.y; e[6] = b.z; e[7] = b.w;
  e[8] = c.x; e[9] = c.y; e[10] = c.z; e[11] = c.w; e[12] = d.x; e[13] = d.y; e[14] = d.z; e[15] = d.w;
}
__device__ __forceinline__ int dpp_iadd_b1(int v) { return v + __builtin_amdgcn_mov_dpp(v, 0xB1, 0xf, 0xf, true); }
__device__ __forceinline__ int dpp_iadd_4e(int v) { return v + __builtin_amdgcn_mov_dpp(v, 0x4E, 0xf, 0xf, true); }
__device__ __forceinline__ int dpp_iadd_141(int v) { return v + __builtin_amdgcn_mov_dpp(v, 0x141, 0xf, 0xf, true); }
#define U_TOKEN(tt, UV, UVN, EUSE, ELD, HUSE, HLD, SUSE, SLD) { \
    int tnn_ = min((tt) + 2 * st, nrows - 1); \
    load_e16(EXP, tnn_, g8, ELD); \
    HLD[0] = *(const uint4*)(hb + (size_t)tnn_ * D); HLD[1] = *(const uint4*)(hb + (size_t)tnn_ * D + 16); \
    SLD = *(const float2*)(HS + ((size_t)tnn_ * 4 + x) * 2); \
    __builtin_amdgcn_sched_barrier(0); \
    _Pragma("unroll") for (int i = 0; i < 16; ++i) UVN[i] = *(const uint4*)(ubs + (((unsigned)EUSE[i] << 7) + loff)); \
    __builtin_amdgcn_sched_barrier(0); \
    int a0_ = (int)HUSE[0].x, b0_ = (int)HUSE[0].y, a1_ = (int)HUSE[0].z, b1_ = (int)HUSE[0].w; \
    int a2_ = (int)HUSE[1].x, b2_ = (int)HUSE[1].y, a3_ = (int)HUSE[1].z, b3_ = (int)HUSE[1].w; \
    int k0 = 0, k1 = 0; \
    _Pragma("unroll") for (int i = 0; i < 16; ++i) { \
      int pa_ = __builtin_amdgcn_sdot8((int)UV[i].x, a0_, 0, false); pa_ = __builtin_amdgcn_sdot8((int)UV[i].y, a1_, pa_, false); \
      pa_ = __builtin_amdgcn_sdot8((int)UV[i].z, a2_, pa_, false); pa_ = __builtin_amdgcn_sdot8((int)UV[i].w, a3_, pa_, false); \
      int pb_ = __builtin_amdgcn_sdot8((int)UV[i].x, b0_, 0, false); pb_ = __builtin_amdgcn_sdot8((int)UV[i].y, b1_, pb_, false); \
      pb_ = __builtin_amdgcn_sdot8((int)UV[i].z, b2_, pb_, false); pb_ = __builtin_amdgcn_sdot8((int)UV[i].w, b3_, pb_, false); \
      int p_ = dpp_iadd_141(dpp_iadd_4e(dpp_iadd_b1((pa_ << 4) + pb_))); \
      if ((i >> 1) == j8) { if (i & 1) k1 = p_; else k0 = p_; } } \
    *(float2*)(PA + ((size_t)(tt) * 4 + x) * 128 + 16 * g8 + 2 * j8) = make_float2(fmaf((float)k0, SUSE.x, SUSE.y), fmaf((float)k1, SUSE.x, SUSE.y)); }
__device__ __forceinline__ void ph_peer_u(const unsigned char* __restrict__ HQ, const float* __restrict__ HS, const int* __restrict__ EXP,
                                          const unsigned char* __restrict__ U4, float* __restrict__ PA, int nrows) {
  int lane = threadIdx.x & 63, wave = __builtin_amdgcn_readfirstlane(threadIdx.x >> 6);
  int x = (blockIdx.x & 7) >> 1; int nb8 = gridDim.x >> 3;
  if ((int)(blockIdx.x >> 3) >= nb8) return;
  int j8 = lane & 7, g8 = lane >> 3;
  const int st = nb8 * 8;
  int t = ((blockIdx.x >> 3) * 2 + (blockIdx.x & 1)) * 4 + wave;
  if (t >= nrows) return;
  const unsigned char* ubs = U4 + (size_t)x * ((size_t)16384 * 128);
  const unsigned loff = 16u * (unsigned)j8;
  const unsigned char* hb = HQ + 256 * x + 32 * j8;
  int eA[16], eB[16]; uint4 hA[2], hB[2], uvA[16], uvB[16]; float2 sA, sB;
  {
    int e0[16]; load_e16(EXP, t, g8, e0);
#pragma unroll
    for (int i = 0; i < 16; ++i) uvA[i] = *(const uint4*)(ubs + (((unsigned)e0[i] << 7) + loff));
    hA[0] = *(const uint4*)(hb + (size_t)t * D); hA[1] = *(const uint4*)(hb + (size_t)t * D + 16);
    sA = *(const float2*)(HS + ((size_t)t * 4 + x) * 2);
    int tn = min(t + st, nrows - 1);
    load_e16(EXP, tn, g8, eA);
    hB[0] = *(const uint4*)(hb + (size_t)tn * D); hB[1] = *(const uint4*)(hb + (size_t)tn * D + 16);
    sB = *(const float2*)(HS + ((size_t)tn * 4 + x) * 2);
  }
#pragma unroll 1
  for (; t < nrows; t += 2 * st) {
    uint4 hC[2]; float2 sC;
    U_TOKEN(t, uvA, uvB, eA, eB, hA, hC, sA, sC)
    if (t + st < nrows) {
      U_TOKEN(t + st, uvB, uvA, eB, eA, hB, hA, sB, sA)
    }
    hB[0] = hA[0]; hB[1] = hA[1]; hA[0] = hC[0]; hA[1] = hC[1]; sB = sA; sA = sC;
  }
}
template <int FMT> __device__ __forceinline__ void ph_peer_w(const float* __restrict__ PA, const int* __restrict__ EXP, const float* __restrict__ GATE,
                                          const float* __restrict__ USC, const float* __restrict__ VSC, unsigned* __restrict__ WQ,
                                          float* __restrict__ SW, int nrows) {
  int lane = threadIdx.x & 63, wave = __builtin_amdgcn_readfirstlane(threadIdx.x >> 6);
  int l4 = lane & 31;
  for (int t = blockIdx.x * 4 + wave; t < nrows; t += gridDim.x * 4) {
    int4 e = *(const int4*)(EXP + (size_t)t * 128 + 4 * l4);
    float4 gt = *(const float4*)(GATE + (size_t)t * 128 + 4 * l4);
    float a[4] = {0.f, 0.f, 0.f, 0.f};
#pragma unroll
    for (int xs = 0; xs < 4; ++xs) { float4 p = *(const float4*)(PA + ((size_t)t * 4 + xs) * 128 + 4 * l4); a[0] += p.x; a[1] += p.y; a[2] += p.z; a[3] += p.w; }
    int ee[4] = {e.x, e.y, e.z, e.w}; float gg[4] = {gt.x, gt.y, gt.z, gt.w}; float w[4]; float wm = 0.f;
#pragma unroll
    for (int j = 0; j < 4; ++j) {
      float av = a[j] * USC[ee[j]];
      w[j] = gg[j] * 0.5f * av * (1.f + erff(av * 0.70710678118654752f)) * VSC[ee[j]];
      wm = fmaxf(wm, fabsf(w[j]));
    }
    wm = wave_max(wm);
    float winv = wm > 0.f ? 127.f / wm : 0.f;
    unsigned q = 0;
#pragma unroll
    for (int j = 0; j < 4; ++j) q = __builtin_amdgcn_cvt_pk_u8_f32(rintf(w[j] * winv) + 128.f, j, q);
    q ^= 0x80808080u;
    if (FMT == 0) { if (lane < 32) WQ[(size_t)t * 32 + l4] = q; }
    else if (lane < 32) {
      unsigned char* wp = (unsigned char*)WQ + (size_t)t * 128 + 64 * ((l4 >> 1) & 1) + 32 * (l4 & 1) + (l4 >> 2);
      wp[0] = (unsigned char)q; wp[8] = (unsigned char)(q >> 8); wp[16] = (unsigned char)(q >> 16); wp[24] = (unsigned char)(q >> 24);
    }
    if (lane == 0) SW[t] = wm * (1.f / 127.f);
  }
}
__device__ __forceinline__ void load_w16(const float* __restrict__ W, int t, int g8, float (&w)[16]) {
  const float4* wp = (const float4*)(W + (size_t)t * 128 + 16 * g8);
  float4 wa = wp[0], wb = wp[1], wc = wp[2], wd = wp[3];
  w[0] = wa.x; w[1] = wa.y; w[2] = wa.z; w[3] = wa.w; w[4] = wb.x; w[5] = wb.y; w[6] = wb.z; w[7] = wb.w;
  w[8] = wc.x; w[9] = wc.y; w[10] = wc.z; w[11] = wc.w; w[12] = wd.x; w[13] = wd.y; w[14] = wd.z; w[15] = wd.w;
}
#define V_TOKEN(tt, VV, VVN, EUSE, ELD, WUSE, WLD, SUSE, SLD) { \
    int tnn_ = min((tt) + 2 * st, nrows - 1); \
    load_e16(EXP, tnn_, g8, ELD); \
    WLD = *(const uint4*)(WQ + (size_t)tnn_ * 32 + 4 * g8); SLD = SW[tnn_]; \
    __builtin_amdgcn_sched_barrier(0); \
    _Pragma("unroll") for (int i = 0; i < 16; ++i) VVN[i] = *(const uint4*)(vbs + (((unsigned)EUSE[i] << 7) + loff)); \
    __builtin_amdgcn_sched_barrier(0); \
    int acc[16]; \
    _Pragma("unroll") for (int j = 0; j < 16; ++j) acc[j] = 0; \
    int wq[4] = {(int)WUSE.x, (int)WUSE.y, (int)WUSE.z, (int)WUSE.w}; \
    _Pragma("unroll") for (int m = 0; m < 4; ++m) { \
      unsigned r0[4] = {VV[4 * m].x, VV[4 * m].y, VV[4 * m].z, VV[4 * m].w}; \
      unsigned r1[4] = {VV[4 * m + 1].x, VV[4 * m + 1].y, VV[4 * m + 1].z, VV[4 * m + 1].w}; \
      unsigned r2[4] = {VV[4 * m + 2].x, VV[4 * m + 2].y, VV[4 * m + 2].z, VV[4 * m + 2].w}; \
      unsigned r3[4] = {VV[4 * m + 3].x, VV[4 * m + 3].y, VV[4 * m + 3].z, VV[4 * m + 3].w}; \
      _Pragma("unroll") for (int k = 0; k < 4; ++k) { \
          \
        unsigned a0 = __builtin_amdgcn_perm(r1[k], r0[k], 0x05010400u);     \
        unsigned a1 = __builtin_amdgcn_perm(r1[k], r0[k], 0x07030602u);     \
        unsigned a2 = __builtin_amdgcn_perm(r3[k], r2[k], 0x05010400u); \
        unsigned a3 = __builtin_amdgcn_perm(r3[k], r2[k], 0x07030602u); \
        unsigned t0 = __builtin_amdgcn_perm(a2, a0, 0x05040100u);           \
        unsigned t1 = __builtin_amdgcn_perm(a2, a0, 0x07060302u); \
        unsigned t2 = __builtin_amdgcn_perm(a3, a1, 0x05040100u); \
        unsigned t3 = __builtin_amdgcn_perm(a3, a1, 0x07060302u); \
        acc[4 * k + 0] = __builtin_amdgcn_sdot4((int)t0, wq[m], acc[4 * k + 0], false); \
        acc[4 * k + 1] = __builtin_amdgcn_sdot4((int)t1, wq[m], acc[4 * k + 1], false); \
        acc[4 * k + 2] = __builtin_amdgcn_sdot4((int)t2, wq[m], acc[4 * k + 2], false); \
        acc[4 * k + 3] = __builtin_amdgcn_sdot4((int)t3, wq[m], acc[4 * k + 3], false); } } \
    float of[16]; \
    _Pragma("unroll") for (int j = 0; j < 16; ++j) { float v = (float)acc[j]; v += dpp_mov<0x128>(v); of[j] = xrow16_sum(v) * SUSE; } \
    if (g8 == 0) { \
      uint4* fp = (uint4*)(F + (size_t)(tt) * D + 128 * x + 16 * j8); \
      fp[0] = make_uint4(pack2bf(of[0], of[1]), pack2bf(of[2], of[3]), pack2bf(of[4], of[5]), pack2bf(of[6], of[7])); \
      fp[1] = make_uint4(pack2bf(of[8], of[9]), pack2bf(of[10], of[11]), pack2bf(of[12], of[13]), pack2bf(of[14], of[15])); } }
__device__ __forceinline__ void ph_peer_v(const unsigned* __restrict__ WQ, const float* __restrict__ SW, const int* __restrict__ EXP,
                                          const unsigned char* __restrict__ V8, bf16_t* __restrict__ F, int nrows) {
  int lane = threadIdx.x & 63, wave = __builtin_amdgcn_readfirstlane(threadIdx.x >> 6);
  int x = blockIdx.x & 7; int nb8 = gridDim.x >> 3;
  if ((int)(blockIdx.x >> 3) >= nb8) return;
  int j8 = lane & 7, g8 = lane >> 3;
  const int st = nb8 * 4;
  int t = (blockIdx.x >> 3) * 4 + wave;
  if (t >= nrows) return;
  const unsigned char* vbs = V8 + (size_t)x * ((size_t)16384 * 128);
  const unsigned loff = 16u * (unsigned)j8;
  int eA[16], eB[16]; uint4 wA, wB, vvA[16], vvB[16]; float sA, sB;
  {
    int e0[16]; load_e16(EXP, t, g8, e0);
#pragma unroll
    for (int i = 0; i < 16; ++i) vvA[i] = *(const uint4*)(vbs + (((unsigned)e0[i] << 7) + loff));
    wA = *(const uint4*)(WQ + (size_t)t * 32 + 4 * g8); sA = SW[t];
    int tn = min(t + st, nrows - 1);
    load_e16(EXP, tn, g8, eA);
    wB = *(const uint4*)(WQ + (size_t)tn * 32 + 4 * g8); sB = SW[tn];
  }
#pragma unroll 1
  for (; t < nrows; t += 2 * st) {
    uint4 wC; float sC;
    V_TOKEN(t, vvA, vvB, eA, eB, wA, wC, sA, sC)
    if (t + st < nrows) {
      V_TOKEN(t + st, vvB, vvA, eB, eA, wB, wA, sB, sA)
    }
    wB = wA; sB = sA; wA = wC; sA = sC;
  }
}

typedef int v4i_t __attribute__((ext_vector_type(4)));
typedef int v2i_t __attribute__((ext_vector_type(2)));
__device__ __forceinline__ v2i_t lds_tr8(const char* p) { return __builtin_amdgcn_ds_read_tr8_b64_v2i32((__attribute__((address_space(3))) v2i_t*)p); }
#define V2_DMA_HALF(E, h, buf) { _Pragma("unroll") for (int pi = 0; pi < 8; ++pi) \
    __builtin_amdgcn_global_load_lds((const unsigned*)(vbs + (((unsigned)E[8 * (h) + pi] << 7) + ((pi & 2) ? offO : offE))), \
                                     (unsigned*)((buf) + pi * 1024 + lane * 16), 16, 0, 0); }
#define V2_COMPUTE(buf, WQH) { _Pragma("unroll") for (int mt = 0; mt < 8; ++mt) { \
      v2i_t r0_ = lds_tr8((buf) + rdoff[mt]); v2i_t r1_ = lds_tr8((buf) + rdoff[mt] + 1024); \
      v4i_t a_ = {r0_.x, r0_.y, r1_.x, r1_.y}; \
      acc[mt] = __builtin_amdgcn_mfma_i32_16x16x64_i8(a_, WQH, acc[mt], 0, 0, 0); } }
__device__ __forceinline__ void ph_peer_v2(const unsigned char* WQ2, const float* SW, const int* EXP,
                                           const unsigned char* __restrict__ V8, bf16_t* F, int nrows, char* smem) {
  int lane = threadIdx.x & 63, wave = __builtin_amdgcn_readfirstlane(threadIdx.x >> 6);
  int x = blockIdx.x & 7; int nb8 = gridDim.x >> 3;
  if ((int)(blockIdx.x >> 3) >= nb8) return;
  const int q8 = lane >> 3, c8 = lane & 7, n16 = lane & 15, g = lane >> 4;
  const int st = nb8 * 4;
  int t = (blockIdx.x >> 3) * 4 + wave;
  if (t >= nrows) return;
  const unsigned char* vbs = V8 + (size_t)x * ((size_t)16384 * 128);
  char* buf0 = smem + wave * 16384; char* buf1 = buf0 + 8192;
  const unsigned offE = 16u * (unsigned)(c8 ^ (q8 >> 1)), offO = offE ^ 64u;
  int rdoff[8];
#pragma unroll
  for (int mt = 0; mt < 8; ++mt) rdoff[mt] = 2048 * g + 128 * (n16 >> 1) + 16 * (mt ^ (n16 >> 2) ^ ((g & 1) << 2)) + 8 * (n16 & 1);
  int eC[16], eN[16];
  load_e16(EXP, t, q8, eC);
  v4i_t w0 = *(const v4i_t*)(WQ2 + (size_t)t * 128 + 16 * g), w1 = *(const v4i_t*)(WQ2 + (size_t)t * 128 + 64 + 16 * g);
  float sw = SW[t];
  V2_DMA_HALF(eC, 0, buf0)
#pragma unroll 1
  for (; t < nrows; t += st) {
    int tn = min(t + st, nrows - 1);
    asm volatile("s_waitcnt vmcnt(0)" ::: "memory");
    __builtin_amdgcn_sched_barrier(0);
    V2_DMA_HALF(eC, 1, buf1)
    load_e16(EXP, tn, q8, eN);
    v4i_t w0n = *(const v4i_t*)(WQ2 + (size_t)tn * 128 + 16 * g), w1n = *(const v4i_t*)(WQ2 + (size_t)tn * 128 + 64 + 16 * g);
    float swn = SW[tn];
    __builtin_amdgcn_sched_barrier(0);
    v4i_t acc[8];
#pragma unroll
    for (int mt = 0; mt < 8; ++mt) acc[mt] = (v4i_t){0, 0, 0, 0};
    V2_COMPUTE(buf0, w0)
    __builtin_amdgcn_sched_barrier(0);
    asm volatile("s_waitcnt vmcnt(0)" ::: "memory");
    asm volatile("" : "+v"(eN[0]), "+v"(eN[1]), "+v"(eN[2]), "+v"(eN[3]), "+v"(eN[4]), "+v"(eN[5]), "+v"(eN[6]), "+v"(eN[7]));
    V2_DMA_HALF(eN, 0, buf0)
    __builtin_amdgcn_sched_barrier(0);
    V2_COMPUTE(buf1, w1)
    v4i_t sel = acc[0];
#pragma unroll
    for (int mt = 1; mt < 8; ++mt) { bool pk = (n16 & 7) == mt; sel.x = pk ? acc[mt].x : sel.x; sel.y = pk ? acc[mt].y : sel.y; sel.z = pk ? acc[mt].z : sel.z; sel.w = pk ? acc[mt].w : sel.w; }
    if (n16 < 8)
      *(uint2*)(F + (size_t)t * D + 128 * x + 16 * n16 + 4 * g) = make_uint2(pack2bf((float)sel.x * sw, (float)sel.y * sw), pack2bf((float)sel.z * sw, (float)sel.w * sw));
    __builtin_amdgcn_sched_barrier(0);
#pragma unroll
    for (int i = 0; i < 16; ++i) eC[i] = eN[i];
    w0 = w0n; w1 = w1n; sw = swn;
  }
  asm volatile("s_waitcnt vmcnt(0)" ::: "memory");
}

#define XB_TMO      128
#define XB_XCNT(j)  (256  + 64 * (j))
#define XB_XSUB(j)  (1280 + 64 * (j))
#define XB_XGEN(j)  (2304 + 64 * (j))
#define XB_TOP      3328
#define XB_TOPGEN   3392
#define XCD_BAR_WORDS 3456
#define XB_SPIN_CAP (1u << 22)
#define LAS __attribute__((address_space(3)))
__device__ __forceinline__ unsigned xb_ld(unsigned* p)              { return __hip_atomic_load(p, __ATOMIC_RELAXED, __HIP_MEMORY_SCOPE_AGENT); }
__device__ __forceinline__ unsigned xb_add(unsigned* p, unsigned v) { return __hip_atomic_fetch_add(p, v, __ATOMIC_RELAXED, __HIP_MEMORY_SCOPE_AGENT); }
__device__ __forceinline__ unsigned xb_xcc_id() { return (unsigned)__builtin_amdgcn_s_getreg((3 << 11) | 20) & 0xFu; }
#define XB_SPIN(cond, bar) do { unsigned _sp = 0; while (cond) { __builtin_amdgcn_s_sleep(1); \
    if ((++_sp & 255u) == 0u) { if (xb_ld(&(bar)[XB_TMO])) break; if (_sp > XB_SPIN_CAP) { atomicAdd(&(bar)[XB_TMO], 1u); break; } } } } while (0)
struct XcdBarrier { unsigned* bar; unsigned x; volatile LAS unsigned* st; };
__device__ __forceinline__ XcdBarrier xcd_barrier_post(unsigned* bar, volatile LAS unsigned* st) {
  XcdBarrier b; b.bar = bar; b.x = xb_xcc_id(); b.st = st;
  if (threadIdx.x == 0) (void)xb_add(&bar[XB_XCNT(b.x)], 1u);
  return b;
}
__device__ __forceinline__ void xcd_barrier_complete(unsigned* bar, unsigned x, unsigned& nloc, unsigned& nx) {
  const unsigned G = gridDim.x * gridDim.y * gridDim.z;
  unsigned sum, cnt, mine, sp = 0u;
  for (;;) {
    sum = 0u; cnt = 0u; mine = 0u;
#pragma unroll
    for (unsigned j = 0; j < 16; ++j) { const unsigned c = xb_ld(&bar[XB_XCNT(j)]); sum += c; cnt += (c > 0u) ? 1u : 0u; mine = (j == x) ? c : mine; }
    if (sum == G) break;
    __builtin_amdgcn_s_sleep(1);
    if ((++sp & 255u) == 0u) { if (xb_ld(&bar[XB_TMO])) break; if (sp > XB_SPIN_CAP) { atomicAdd(&bar[XB_TMO], 1u); break; } }
  }
  nloc = mine > 0u ? mine : 1u; nx = cnt > 0u ? cnt : 1u;
}
__device__ __forceinline__ void xcd_barrier(const XcdBarrier& b) {
  asm volatile("s_waitcnt vmcnt(0)" ::: "memory");
  __syncthreads();
  if (threadIdx.x == 0) {
    unsigned* bar = b.bar;
    __builtin_amdgcn_s_waitcnt(0);
    unsigned nloc = b.st[0], nx = b.st[1];
    if (nloc == 0u) { xcd_barrier_complete(bar, b.x, nloc, nx); b.st[0] = nloc; b.st[1] = nx; }
    const unsigned old = xb_add(&bar[XB_XSUB(b.x)], 1u);
    const unsigned gen = old / nloc;
    if (old + 1u == (gen + 1u) * nloc) {
      __builtin_amdgcn_fence(__ATOMIC_RELEASE, "agent");
      asm volatile("s_waitcnt vmcnt(0)" ::: "memory");
      const unsigned og = xb_add(&bar[XB_TOP], 1u);
      const unsigned tg = og / nx;
      if (og + 1u == (tg + 1u) * nx) xb_add(&bar[XB_TOPGEN], 1u);
      else XB_SPIN(xb_ld(&bar[XB_TOPGEN]) == tg, bar);
      __builtin_amdgcn_fence(__ATOMIC_ACQUIRE, "agent");
      xb_add(&bar[XB_XGEN(b.x)], 1u);
      asm volatile("s_waitcnt vmcnt(0)" ::: "memory");
    } else {
      XB_SPIN(xb_ld(&bar[XB_XGEN(b.x)]) == gen, bar);
      __builtin_amdgcn_fence(__ATOMIC_ACQUIRE, "agent");
      asm volatile("s_waitcnt vmcnt(0)" ::: "memory");
    }
  }
  __syncthreads();
}

constexpr int SMEM_BYTES = 65536;
#ifndef PHMASK
#define PHMASK 0xFFFFFFFFFFFFFFFFull
#endif
#ifndef PHDUP
#define PHDUP 0ull
#endif
#define PH(n, ...) if constexpr ((((unsigned long long)(PHMASK)) >> (n)) & 1ull) { __VA_ARGS__; if constexpr ((((unsigned long long)(PHDUP)) >> (n)) & 1ull) { xcd_barrier(xbar); __VA_ARGS__; } }

__global__ __launch_bounds__(256, 2) void mega(Params p) {
  __shared__ __attribute__((aligned(16))) char smem_raw[SMEM_BYTES + 16];
  if (threadIdx.x == 0) *(uint4*)(smem_raw + SMEM_BYTES) = make_uint4(0u, 0u, 0u, 0u);
  __syncthreads();
  XcdBarrier xbar = xcd_barrier_post((unsigned*)((char*)p.ws + OFF_BAR), (volatile LAS unsigned*)(smem_raw + SMEM_BYTES));
  float* smem = (float*)smem_raw;
  const float* x = p.in[0]; const float* c = p.in[1]; const float* ctx = p.in[2]; const float* c_ctx = p.in[3];
  const float* ada_w = p.in[4]; const float* ada_b = p.in[5]; const float* ln_g = p.in[6]; const float* ln_b = p.in[7];
  const float* even_w_in = p.in[8]; const float* even_w_out = p.in[9]; const float* rpb = p.in[10];
  const float* odd_w_in = p.in[11]; const float* odd_w_out = p.in[12]; const float* sink = p.in[13];
  const float* peer_wq = p.in[14]; const float* peer_sk = p.in[15]; const float* peer_u = p.in[16]; const float* peer_v = p.in[17];
  char* ws = (char*)p.ws;
  float* TAB = (float*)(ws + OFF_TAB); float* Mm = (float*)(ws + OFF_M);
  bf16_t* WIN0 = (bf16_t*)(ws + OFF_WIN0); bf16_t* WOUT0 = (bf16_t*)(ws + OFF_WOUT0);
  bf16_t* WIN1 = (bf16_t*)(ws + OFF_WIN1); bf16_t* WOUT1 = (bf16_t*)(ws + OFF_WOUT1);
  bf16_t* WQ = (bf16_t*)(ws + OFF_WQ); bf16_t* SKB = (bf16_t*)(ws + OFF_SK);
  unsigned char* U8 = (unsigned char*)(ws + OFF_UB); unsigned char* V8 = (unsigned char*)(ws + OFF_VB);
  float* USC = (float*)(ws + OFF_USC); float* VSC = USC + 2 * 16384;
  bf16_t* AB = (bf16_t*)(ws + OFF_AB);
  bf16_t* FD1 = (bf16_t*)(ws + OFF_FT); bf16_t* FD3 = FD1 + 256 * 128; bf16_t* FDC = FD3 + 128 * 128;
  bf16_t* A1 = (bf16_t*)(ws + OFF_A1); bf16_t* VT0 = (bf16_t*)(ws + OFF_VT0); bf16_t* FQKV = (bf16_t*)(ws + OFF_BF);
  float* BF_ = (float*)(ws + OFF_BF); float* BY = (float*)(ws + OFF_BY);
  float* X1 = (float*)(ws + OFF_X1); float* X2 = (float*)(ws + OFF_X2);
  float* RT = TAB + 16384;
  bf16_t* Q1 = (bf16_t*)(ws + OFF_BF); bf16_t* K1 = Q1 + (size_t)T * 1024; bf16_t* VT1 = K1 + (size_t)R * 256;
  bf16_t* YB = (bf16_t*)(ws + OFF_BY + (size_t)2 * R * 128 * 4);
  float* PAB = (float*)(ws + OFF_BF); bf16_t* FB = (bf16_t*)(ws + OFF_BF + (size_t)R * 8 * 128 * 4);
  float* WB = (float*)(ws + OFF_BF + (size_t)R * 8 * 128 * 4 + (size_t)R * 1024 * 2); float* CORRB = WB + (size_t)R * 128;
  unsigned char* HQB = (unsigned char*)(ws + OFF_BF + (size_t)R * 8 * 128 * 4 + (size_t)R * 1024 * 2 + (size_t)R * 129 * 4);
  float* HSB = (float*)(HQB + (size_t)R * 1024);
  int* EXPB = (int*)(ws + OFF_BY); float* GATEB = (float*)(ws + OFF_BY + (size_t)R * 128 * 4);
  float* out = p.out;
  unsigned* QC = (unsigned*)(ws + OFF_BAR) + 32;
#define QFILL(site, layer, lo, hi) quant_fill(QC + (site), (layer), (lo), (hi), peer_u, peer_v, U8, V8, USC, VSC, (unsigned*)(smem_raw + 65024))

  PH(0, ph_tables(TAB); ph_rope_table(RT))
  PH(1, ph_fft_tables(FD1, FD3, FDC))
  PH(2, ph_ada2(c, c_ctx, ada_w, ada_b, Mm, smem))
  PH(3, ph_transpose_w(even_w_in, 1024, 2048, WIN0, smem))
  PH(4, ph_transpose_w(even_w_out, 1024, 1024, WOUT0, smem))
  PH(5, ph_transpose_w(odd_w_in, 1024, 1536, WIN1, smem))
  PH(6, ph_transpose_w(odd_w_out, 1024, 1024, WOUT1, smem))
  PH(7, ph_transpose_w(peer_wq, 1024, 2048, WQ, smem))
  PH(8, ph_transpose_w(peer_wq + (size_t)1024 * 2048, 1024, 2048, WQ + (size_t)2048 * 1024, smem))
  PH(11, ph_convert(peer_sk, SKB, (size_t)2 * 8 * 2 * 128 * 128 / 8))
  xcd_barrier(xbar);
  PH(12, ph_modulate(x, ctx, Mm, 0, 0, 1, AB, R, smem))
  xcd_barrier(xbar);
  PH(13, ph_gemm_bf16(AB, 1024, WIN0, 1024, R, 2048, 1024, EpiQKV0{FQKV, VT0}, smem_raw))
  PH(9, QFILL(0, 0, 0u, 160u))
  xcd_barrier(xbar);
  PH(14, { GRID_LOOP(u, NB * 64 * 8) fft1_unit(u, FQKV, FD1, TAB, A1, smem_raw); })
  PH(15, { int lane = threadIdx.x & 63, wave = __builtin_amdgcn_readfirstlane(threadIdx.x >> 6);
           __syncthreads();
           for (int i = threadIdx.x; i < 8 * 15 * 31; i += 256) smem[i] = rpb[i] * 1.4426950408889634f;
           __syncthreads();
           for (int bu = blockIdx.x; bu < 512 + 64; bu += gridDim.x) {
             if (bu < 512) { int h = bu & 7, rg = (bu >> 3) & 31, bb = bu >> 8;
               na_unit(bb, h, rg * 4 + wave, FQKV, VT0, VT0 + (size_t)NB * 8 * 64 * S, smem, AB, lane); }
             else { int cu = bu - 512; int h = cu & 7, qg = (cu >> 3) & 3, bb = cu >> 5;
               attn_unit<1, 1, 2, true>(bb, h, 0, 0, qg * 4 + wave, FQKV + 512, 2048, FQKV + 1024, 2048, VT0, VT0 + (size_t)NB * 8 * 64 * S, 8, smem, nullptr, AB + 512, 1024, lane); } } })
  xcd_barrier(xbar);
  PH(16, { GRID_LOOP(u, NB * 128 * 8 + NB * 4 * 8) { if (u < NB * 128 * 8) fft3_unit(u, 0, FQKV, A1, FD3, FDC, TAB, AB, smem_raw); else fft3_unit(u - NB * 128 * 8, 1, FQKV, A1, FD3, FDC, TAB, AB, smem_raw); } })
  xcd_barrier(xbar);
  PH(17, ph_gemm_bf16(AB, 1024, WOUT0, 1024, R, 1024, 1024, EpiBf16{YB, 1024}, smem_raw))
  PH(9, QFILL(1, 0, 160u, 260u))
  xcd_barrier(xbar);
  PH(18, ph_post_mod(x, ctx, YB, Mm, 0, 2, 0, 3, 4, true, ln_g + 0, ln_b + 0, X1, AB, R, HQB, HSB))
  xcd_barrier(xbar);
  PH(21, ph_peer_select(AB, WQ, SKB, EXPB, GATEB, R, smem_raw))
  PH(9, QFILL(2, 0, 260u, 512u))
  PH(10, QFILL(3, 1, 0u, 300u))
  xcd_barrier(xbar);
  PH(22, ph_peer_u(HQB, HSB, EXPB, U8, PAB, R))
  xcd_barrier(xbar);
  PH(32, ph_peer_w<1>(PAB, EXPB, GATEB, USC, VSC, (unsigned*)WB, CORRB, R))
  xcd_barrier(xbar);
  PH(33, ph_peer_v2((const unsigned char*)WB, CORRB, EXPB, V8, FB, R, smem_raw))
  xcd_barrier(xbar);
  PH(34, ph_post_mod(X1, X1 + (size_t)T * D, FB, Mm, 0, 5, 1, 0, 1, true, ln_g + 1024, ln_b + 1024, X2, AB, R))
  xcd_barrier(xbar);
  PH(23, ph_gemm_bf16(AB, 1024, WIN1, 1024, R, 1536, 1024, EpiQKV1{Q1, K1, VT1, RT}, smem_raw))
  PH(10, QFILL(4, 1, 300u, 420u))
  xcd_barrier(xbar);
  PH(25, { int lane = threadIdx.x & 63, wave = __builtin_amdgcn_readfirstlane(threadIdx.x >> 6);
           for (int bu = blockIdx.x; bu < 1024; bu += gridDim.x) { int kvh = bu & 3, bb = (bu >> 2) & 1, qg = bu >> 3;
             attn_unit<4, 2, 1, true>(bb, kvh, 0, 0, qg * 4 + wave, Q1, 1024, K1, 256, VT1, VT1 + (size_t)NB * 4 * 64 * S, 4, nullptr, sink, AB, 1024, lane); } })
  xcd_barrier(xbar);
  PH(26, ph_gemm_bf16(AB, 1024, WOUT1, 1024, T, 1024, 1024, EpiBf16{YB, 1024}, smem_raw))
  xcd_barrier(xbar);
  PH(27, ph_post_mod(X2, X2, YB, Mm, 1, 2, 1, 3, 4, true, ln_g + 2048, ln_b + 2048, X1, AB, T, HQB, HSB))
  xcd_barrier(xbar);
  PH(30, ph_peer_select(AB, WQ + (size_t)2048 * 1024, SKB + (size_t)8 * 2 * 128 * 128, EXPB, GATEB, T, smem_raw))
  PH(10, QFILL(5, 1, 420u, 512u))
  xcd_barrier(xbar);
  PH(31, ph_peer_u(HQB, HSB, EXPB, U8 + (size_t)16384 * 512, PAB, T))
  xcd_barrier(xbar);
  PH(35, ph_peer_w<1>(PAB, EXPB, GATEB, USC + 16384, VSC + 16384, (unsigned*)WB, CORRB, T))
  xcd_barrier(xbar);
  PH(36, ph_peer_v2((const unsigned char*)WB, CORRB, EXPB, V8 + (size_t)16384 * 1024, FB, T, smem_raw))
  xcd_barrier(xbar);
  PH(37, ph_post_mod(X1, X1, FB, Mm, 1, 5, 1, 0, 1, false, ln_g + 3072, ln_b + 3072, out, AB, T))
}

}

extern "C" void kernel_launch(void* const* d_in, const int* in_sizes, int n_in, void* d_out, int out_size, void* d_ws,
                              size_t ws_size, hipStream_t stream) {
  static int grid_blocks = 0;
  if (!grid_blocks) {
    int dev = 0, cus = 0, per_cu = 0;
    hipGetDevice(&dev);
    hipDeviceGetAttribute(&cus, hipDeviceAttributeMultiprocessorCount, dev);
    hipOccupancyMaxActiveBlocksPerMultiprocessor(&per_cu, (const void*)mega, 256, 0);
    if (per_cu > 2) per_cu = 2;
    if (per_cu < 1) per_cu = 1;
    grid_blocks = cus * per_cu;
  }
  Params p{};
  for (int i = 0; i < 18; ++i) p.in[i] = (const float*)d_in[i];
  p.out = (float*)d_out;
  p.ws = (float*)d_ws;
  (void)hipMemsetAsync((char*)d_ws + OFF_BAR, 0, XCD_BAR_WORDS_C * 4, stream);
  void* args[] = {&p};
  hipError_t e = hipLaunchCooperativeKernel((const void*)mega, dim3(grid_blocks), dim3(256), args, 0, stream);
  if (e != hipSuccess) fprintf(stderr, "cooperative launch failed: %s (grid %d)\n", hipGetErrorString(e), grid_blocks);
}
```

```cpp
#include <hip/hip_runtime.h>
#include <hip/hip_bf16.h>
#include <stdint.h>
#include <math.h>
#include <stdio.h>
#include <hip/hip_cooperative_groups.h>
namespace cg = cooperative_groups;

namespace {

constexpr int D = 1024;
constexpr int NB = 2;
constexpr int S = 8192;
constexpr int T = NB * S;
constexpr int CL = 256;
constexpr int TC = NB * CL;
constexpr int R = T + TC;
constexpr float DN_ALPHA = 1.4142135623730951f;
constexpr float LN_EPS = 1e-6f;

template <int CTRL> __device__ __forceinline__ float dpp_mov(float x) {
  return __builtin_bit_cast(float, __builtin_amdgcn_mov_dpp(__builtin_bit_cast(int, x), CTRL, 0xf, 0xf, true));
}
__device__ __forceinline__ float xrow16_max(float x) {
  auto s = __builtin_amdgcn_permlane16_swap(__float_as_uint(x), __float_as_uint(x), false, false);
  x = fmaxf(__uint_as_float(s[0]), __uint_as_float(s[1]));
  auto t = __builtin_amdgcn_permlane32_swap(__float_as_uint(x), __float_as_uint(x), false, false);
  return fmaxf(__uint_as_float(t[0]), __uint_as_float(t[1]));
}
__device__ __forceinline__ float xrow16_sum(float x) {
  auto s = __builtin_amdgcn_permlane16_swap(__float_as_uint(x), __float_as_uint(x), false, false);
  x = __uint_as_float(s[0]) + __uint_as_float(s[1]);
  auto t = __builtin_amdgcn_permlane32_swap(__float_as_uint(x), __float_as_uint(x), false, false);
  return __uint_as_float(t[0]) + __uint_as_float(t[1]);
}
__device__ __forceinline__ float wave_sum(float v) {
  v += dpp_mov<0xB1>(v); v += dpp_mov<0x4E>(v); v += dpp_mov<0x124>(v); v += dpp_mov<0x128>(v);
  return xrow16_sum(v);
}
__device__ __forceinline__ float wave_max(float v) {
  v = fmaxf(v, dpp_mov<0xB1>(v)); v = fmaxf(v, dpp_mov<0x4E>(v)); v = fmaxf(v, dpp_mov<0x124>(v)); v = fmaxf(v, dpp_mov<0x128>(v));
  return xrow16_max(v);
}

typedef unsigned short bf16_t;
typedef __attribute__((ext_vector_type(8))) short bf16x8;
typedef __attribute__((ext_vector_type(16))) float f32x16;
typedef __attribute__((ext_vector_type(4))) float f32x4;

typedef __attribute__((ext_vector_type(2))) __bf16 bf16x2_t;
__device__ __forceinline__ unsigned f2bf(float f) { return (unsigned)__builtin_bit_cast(unsigned short, (__bf16)f); }
__device__ __forceinline__ unsigned pack2bf(float a, float b) { bf16x2_t v = {(__bf16)a, (__bf16)b}; return __builtin_bit_cast(unsigned, v); }
__device__ __forceinline__ float bf2f(unsigned short v) { return __uint_as_float(((unsigned)v) << 16); }

__device__ __forceinline__ int mod_index(int row) { return row < T ? row / S : 2; }


struct Params {
  const float* in[18];
  float* out;
  float* ws;
};

constexpr size_t XCD_BAR_WORDS_C = 3456;
constexpr size_t al256(size_t n) { return (n + 255) & ~(size_t)255; }
constexpr size_t OFF_BAR = 0;
constexpr size_t OFF_TAB = al256(XCD_BAR_WORDS_C * 4);
constexpr size_t OFF_M = OFF_TAB + al256(16384 * 4 + 128 * 16 * 2 * 4);
constexpr size_t OFF_WIN0 = OFF_M + al256(2 * 3 * 6144 * 4);
constexpr size_t OFF_WOUT0 = OFF_WIN0 + al256((size_t)2048 * 1024 * 2);
constexpr size_t OFF_WIN1 = OFF_WOUT0 + al256((size_t)1024 * 1024 * 2);
constexpr size_t OFF_WOUT1 = OFF_WIN1 + al256((size_t)1536 * 1024 * 2);
constexpr size_t OFF_WQ = OFF_WOUT1 + al256((size_t)1024 * 1024 * 2);
constexpr size_t OFF_SK = OFF_WQ + al256((size_t)2 * 2048 * 1024 * 2);
constexpr size_t OFF_UB = OFF_SK + al256((size_t)2 * 8 * 2 * 128 * 128 * 2);
constexpr size_t OFF_VB = OFF_UB + al256((size_t)2 * 16384 * 1024);
constexpr size_t OFF_USC = OFF_VB + al256((size_t)2 * 16384 * 1024);
constexpr size_t OFF_AB = OFF_USC + al256((size_t)4 * 16384 * 4);
constexpr size_t OFF_FT = OFF_AB + al256((size_t)R * 1024 * 2);
constexpr size_t OFF_BF = OFF_FT + al256((size_t)(256 * 128 + 128 * 128 + 64 * 128) * 2);
constexpr size_t OFF_BY = OFF_BF + al256((size_t)R * 2048 * 4);
constexpr size_t OFF_X1 = OFF_BY + al256((size_t)R * 1024 * 4);
constexpr size_t OFF_X2 = OFF_X1 + al256((size_t)R * 1024 * 4);
constexpr size_t OFF_END = OFF_X2 + al256((size_t)R * 1024 * 4);
constexpr size_t OFF_A1 = OFF_BY;
constexpr size_t OFF_VT0 = OFF_X2;
static_assert(OFF_END <= (size_t)512 * 1024 * 1024, "workspace overflow");

#define GRID_LOOP(var, n) for (int var = blockIdx.x; var < (n); var += gridDim.x)

__device__ __forceinline__ void ph_fft_tables(bf16_t* D1, bf16_t* D3, bf16_t* DcT) {
  const double TWO_PI = 6.283185307179586476925286766559;
  for (int i = blockIdx.x * 256 + threadIdx.x; i < 256 * 128 + 128 * 128 + 64 * 128; i += gridDim.x * 256) {
    if (i < 256 * 128) {
      int m = i >> 7, r = i & 127; int k1 = m >> 1, ri = m & 1;
      double a = TWO_PI * (double)((k1 * r) & 127) / 128.0;
      D1[i] = (bf16_t)f2bf(ri == 0 ? (float)cos(a) : (float)(-sin(a)));
    } else if (i < 256 * 128 + 128 * 128) {
      int j = i - 256 * 128; int m = j >> 7, kk = j & 127; int rip = m >> 6, k2 = m & 63; int c = kk >> 1, ri = kk & 1;
      double a = TWO_PI * (double)((k2 * c) & 63) / 64.0;
      double v = (rip == 0) ? (ri == 0 ? cos(a) : sin(a)) : (ri == 0 ? -sin(a) : cos(a));
      D3[j] = (bf16_t)f2bf((float)v);
    } else {
      int j = i - 256 * 128 - 128 * 128; int cp = j >> 7, kk = j & 127; int rip = kk >> 6, ch = kk & 63;
      double a = TWO_PI * (double)((ch * cp) & 63) / 64.0;
      DcT[j] = (bf16_t)f2bf((float)(rip == 0 ? cos(a) : sin(a)));
    }
  }
}
__device__ __forceinline__ void ph_rope_table(float* RT) {
  for (int i = blockIdx.x * 256 + threadIdx.x; i < 128 * 16; i += gridDim.x * 256) {
    int pos = i >> 4, f = i & 15;
    float inv_freq = powf(10000.0f, -(float)f / 16.0f);
    float ang = (float)pos * inv_freq;
    RT[2 * i] = cosf(ang); RT[2 * i + 1] = sinf(ang);
  }
}
__device__ __forceinline__ void ph_tables(float* tab) {
  for (int j = blockIdx.x * 256 + threadIdx.x; j < 8192; j += gridDim.x * 256) {
    double a = 6.283185307179586476925286766559 * (double)j / 8192.0;
    tab[j] = (float)cos(a);
    tab[8192 + j] = (float)sin(a);
  }
}
__device__ __forceinline__ void ph_ada(const float* __restrict__ c, const float* __restrict__ c_ctx, const float* __restrict__ ada_w,
                       const float* __restrict__ ada_b, float* __restrict__ M) {
  for (int gid = blockIdx.x * 256 + threadIdx.x; gid < 2 * 3 * 6144; gid += gridDim.x * 256) {
    int col = gid % 6144; int idx = (gid / 6144) % 3; int layer = gid / (3 * 6144);
    const float* vec = idx < 2 ? c + idx * D : c_ctx;
    const float* w = ada_w + (size_t)layer * D * 6144 + col;
    float acc = 0.f;
    for (int k = 0; k < D; ++k) {
      float x = vec[k];
      float sx = x / (1.f + expf(-x));
      acc += sx * w[(size_t)k * 6144];
    }
    M[gid] = acc + ada_b[layer * 6144 + col];
  }
}

__device__ __forceinline__ void ph_modulate(const float* __restrict__ xa, const float* __restrict__ xb, const float* __restrict__ M, int layer,
                            int jshift, int jscale, bf16_t* __restrict__ out, int nrows, float* red) {
  int tid = threadIdx.x;
  GRID_LOOP(row, nrows) {
    const float* x = row < T ? xa + (size_t)row * D : xb + (size_t)(row - T) * D;
    float v[4]; float s = 0.f;
#pragma unroll
    for (int i = 0; i < 4; ++i) { v[i] = x[tid + 256 * i]; s += v[i]; }
    s = wave_sum(s);
    __syncthreads();
    if ((tid & 63) == 0) red[tid >> 6] = s;
    __syncthreads();
    float mu = (red[0] + red[1] + red[2] + red[3]) * (1.f / D);
    float q = 0.f;
#pragma unroll
    for (int i = 0; i < 4; ++i) { float d = v[i] - mu; q += d * d; }
    q = wave_sum(q);
    if ((tid & 63) == 0) red[4 + (tid >> 6)] = q;
    __syncthreads();
    float var = (red[4] + red[5] + red[6] + red[7]) * (1.f / D);
    float rs = rsqrtf(var + LN_EPS);
    const float* m = M + ((size_t)layer * 3 + mod_index(row)) * 6144;
#pragma unroll
    for (int i = 0; i < 4; ++i) {
      int col = tid + 256 * i;
      float y = (v[i] - mu) * rs;
      out[(size_t)row * D + col] = (bf16_t)f2bf(y * (1.f + m[jscale * D + col]) + m[jshift * D + col]);
    }
  }
}

__device__ __forceinline__ void ph_post(const float* __restrict__ xa, const float* __restrict__ xb, const float* __restrict__ Y,
                        const float* __restrict__ M, int layer, int j, const float* __restrict__ g, const float* __restrict__ bb,
                        float* __restrict__ outa, float* __restrict__ outb, int nrows, float* red) {
  int tid = threadIdx.x;
  GRID_LOOP(row, nrows) {
    const float* x = row < T ? xa + (size_t)row * D : xb + (size_t)(row - T) * D;
    float* out = row < T ? outa + (size_t)row * D : outb + (size_t)(row - T) * D;
    const float* m = M + ((size_t)layer * 3 + mod_index(row)) * 6144 + j * D;
    float v[4]; float s = 0.f;
#pragma unroll
    for (int i = 0; i < 4; ++i) { int col = tid + 256 * i; v[i] = DN_ALPHA * x[col] + m[col] * Y[(size_t)row * D + col]; s += v[i]; }
    s = wave_sum(s);
    __syncthreads();
    if ((tid & 63) == 0) red[tid >> 6] = s;
    __syncthreads();
    float mu = (red[0] + red[1] + red[2] + red[3]) * (1.f / D);
    float q = 0.f;
#pragma unroll
    for (int i = 0; i < 4; ++i) { float d = v[i] - mu; q += d * d; }
    q = wave_sum(q);
    if ((tid & 63) == 0) red[4 + (tid >> 6)] = q;
    __syncthreads();
    float var = (red[4] + red[5] + red[6] + red[7]) * (1.f / D);
    float rs = rsqrtf(var + LN_EPS);
#pragma unroll
    for (int i = 0; i < 4; ++i) {
      int col = tid + 256 * i;
      out[col] = (v[i] - mu) * rs * g[col] + bb[col];
    }
  }
}

struct ARow { const float* A; int lda; __device__ float operator()(int m, int k) const { return A[(size_t)m * lda + k]; } };
struct BRow { const float* B; int ldb; __device__ float operator()(int k, int n) const { return B[(size_t)k * ldb + n]; } };
struct CRow { float* C; int ldc; float scale; __device__ void operator()(int m, int n, float v) const { C[(size_t)m * ldc + n] = v * scale; } };
struct CRowB { bf16_t* C; int ldc; float scale; __device__ void operator()(int m, int n, float v) const { C[(size_t)m * ldc + n] = (bf16_t)f2bf(v * scale); } };
struct ADft { const float* tab; int Sn; int stride; __device__ float operator()(int m, int k) const {
    int t = k & (Sn - 1); int idx = ((m * t) & (Sn - 1)) * stride;
    return k < Sn ? tab[idx] : -tab[8192 + idx]; } };
struct BPQ { const float* PQ; int rowbase; int Sn; __device__ float operator()(int k, int n) const {
    int t = k & (Sn - 1); return PQ[(size_t)(rowbase + t) * 1024 + (k >= Sn ? 512 : 0) + n]; } };

template <class AF, class BF, class CF>
__device__ __forceinline__ void ph_gemm(AF af, BF bf, CF cf, int M, int N, int K, float* sm) {
  float (*sA)[68] = (float (*)[68])sm;
  float (*sB)[68] = (float (*)[68])(sm + 16 * 68);
  int tid = threadIdx.x; int tx = tid & 15, ty = tid >> 4;
  int ntn = N / 64; int ntiles = (M / 64) * ntn;
  GRID_LOOP(tile, ntiles) {
    int m0 = (tile / ntn) * 64, n0 = (tile % ntn) * 64;
    float acc[4][4];
#pragma unroll
    for (int i = 0; i < 4; ++i)
#pragma unroll
      for (int j = 0; j < 4; ++j) acc[i][j] = 0.f;
    for (int k0 = 0; k0 < K; k0 += 16) {
      __syncthreads();
#pragma unroll
      for (int i = 0; i < 4; ++i) { int e = tid + 256 * i; int m = e >> 4, k = e & 15; sA[k][m] = af(m0 + m, k0 + k); }
#pragma unroll
      for (int i = 0; i < 4; ++i) { int e = tid + 256 * i; int k = e >> 6, n = e & 63; sB[k][n] = bf(k0 + k, n0 + n); }
      __syncthreads();
#pragma unroll
      for (int k = 0; k < 16; ++k) {
        float a[4], b[4];
#pragma unroll
        for (int i = 0; i < 4; ++i) { a[i] = sA[k][ty * 4 + i]; b[i] = sB[k][tx * 4 + i]; }
#pragma unroll
        for (int i = 0; i < 4; ++i)
#pragma unroll
          for (int j = 0; j < 4; ++j) acc[i][j] += a[i] * b[j];
      }
    }
#pragma unroll
    for (int i = 0; i < 4; ++i)
#pragma unroll
      for (int j = 0; j < 4; ++j) cf(m0 + ty * 4 + i, n0 + tx * 4 + j, acc[i][j]);
  }
}


__device__ __forceinline__ void ph_transpose_w(const float* __restrict__ W, int K, int N, bf16_t* __restrict__ Wt, float* sm) {
  int tid = threadIdx.x;
  int tk = K / 64, tn = N / 64;
  GRID_LOOP(tile, tk * tn) {
    int k0 = (tile / tn) * 64, n0 = (tile % tn) * 64;
    __syncthreads();
#pragma unroll
    for (int i = 0; i < 16; ++i) { int e = tid + 256 * i; int k = e >> 6, n = e & 63; sm[k * 65 + n] = W[(size_t)(k0 + k) * N + n0 + n]; }
    __syncthreads();
#pragma unroll
    for (int i = 0; i < 2; ++i) {
      int e = tid + 256 * i; int n = e >> 3, kc = e & 7;
      unsigned w[4];
#pragma unroll
      for (int j = 0; j < 4; ++j) w[j] = pack2bf(sm[(kc * 8 + 2 * j) * 65 + n], sm[(kc * 8 + 2 * j + 1) * 65 + n]);
      *(uint4*)(Wt + (size_t)(n0 + n) * K + k0 + kc * 8) = make_uint4(w[0], w[1], w[2], w[3]);
    }
  }
}
__device__ __forceinline__ void ph_convert(const float* __restrict__ src, bf16_t* __restrict__ dst, size_t n8) {
  for (size_t i = (size_t)blockIdx.x * 256 + threadIdx.x; i < n8; i += (size_t)gridDim.x * 256) {
    float4 a = ((const float4*)src)[2 * i], b = ((const float4*)src)[2 * i + 1];
    ((uint4*)dst)[i] = make_uint4(pack2bf(a.x, a.y), pack2bf(a.z, a.w), pack2bf(b.x, b.y), pack2bf(b.z, b.w));
  }
}

__device__ __forceinline__ void gemm_stage(const bf16_t* __restrict__ A, int lda, int k0, char* lds, int tid) {
#pragma unroll
  for (int i = 0; i < 4; ++i) {
    int q = tid + 256 * i; int row = q >> 3, p = q & 7; int c = p ^ ((row >> 1) & 7);
    const bf16_t* src = A + (size_t)row * lda + k0 + c * 8;
    __builtin_amdgcn_global_load_lds((const unsigned*)src, (unsigned*)(lds + q * 16), 16, 0, 0);
  }
}
struct EpiF32 {
  float* C; int ldc; float scale;
  __device__ __forceinline__ void operator()(int m0, int n0, int wm, int wn, f32x16 (&acc)[2][2], int tid, char* smem) const {
    int lane = tid & 63;
    float* t = (float*)smem;
    int rbase = wm * 64 + 4 * (lane >> 5), cbase = wn * 64 + (lane & 31);
#pragma unroll
    for (int mi = 0; mi < 2; ++mi)
#pragma unroll
      for (int ni = 0; ni < 2; ++ni)
#pragma unroll
        for (int r = 0; r < 16; ++r)
          t[(rbase + mi * 32 + (r & 3) + 8 * (r >> 2)) * 128 + cbase + ni * 32] = acc[mi][ni][r] * scale;
    __syncthreads();
    float* dst = C + (size_t)(m0 + (tid >> 5)) * ldc + n0 + (tid & 31) * 4;
    const float* src = t + (tid >> 5) * 128 + (tid & 31) * 4;
#pragma unroll 4
    for (int i = 0; i < 16; ++i) {
      *(float4*)dst = *(const float4*)src;
      dst += (size_t)8 * ldc; src += 8 * 128;
    }
  }
};
struct EpiQKV0 {
  bf16_t* FQKV; bf16_t* VT;
  __device__ __forceinline__ void operator()(int m0, int n0, int wm, int wn, f32x16 (&acc)[2][2], int tid, char* smem) const {
    int lane = tid & 63;
    bf16_t* t = (bf16_t*)smem;
    int rbase = wm * 64 + 4 * (lane >> 5), cbase = wn * 64 + (lane & 31);
#pragma unroll
    for (int mi = 0; mi < 2; ++mi)
#pragma unroll
      for (int ni = 0; ni < 2; ++ni)
#pragma unroll
        for (int r = 0; r < 16; ++r)
          t[(rbase + mi * 32 + (r & 3) + 8 * (r >> 2)) * 136 + cbase + ni * 32] = (bf16_t)f2bf(acc[mi][ni][r]);
    __syncthreads();
    {
      bf16_t* dst = FQKV + (size_t)(m0 + (tid >> 4)) * 2048 + n0 + (tid & 15) * 8;
      const bf16_t* src = t + (tid >> 4) * 136 + (tid & 15) * 8;
#pragma unroll 4
      for (int i = 0; i < 8; ++i) {
        *(uint4*)dst = *(const uint4*)src;
        dst += (size_t)16 * 2048; src += 16 * 136;
      }
    }
    if (n0 >= 1536) {
      int col = tid >> 1, half = tid & 1;
      int hd = (n0 - 1536) / 64 + (col >> 6), d = col & 63;
      bf16_t* dst;
      if (m0 < T) { int b = m0 / S, t0 = m0 % S; dst = VT + (((size_t)b * 8 + hd) * 64 + d) * S + t0 + half * 64; }
      else { int mm = m0 - T; int b = mm / CL, l0 = mm % CL; dst = VT + (size_t)NB * 8 * 64 * S + (((size_t)b * 8 + hd) * 64 + d) * CL + l0 + half * 64; }
      const bf16_t* src = t + (half * 64) * 136 + col;
#pragma unroll
      for (int i = 0; i < 8; ++i) {
        unsigned wv[4];
#pragma unroll
        for (int j = 0; j < 4; ++j) wv[j] = (unsigned)src[(i * 8 + 2 * j) * 136] | ((unsigned)src[(i * 8 + 2 * j + 1) * 136] << 16);
        *(uint4*)(dst + i * 8) = make_uint4(wv[0], wv[1], wv[2], wv[3]);
      }
    }
  }
};
struct EpiBf16 {
  bf16_t* C; int ldc;
  __device__ __forceinline__ void operator()(int m0, int n0, int wm, int wn, f32x16 (&acc)[2][2], int tid, char* smem) const {
    int lane = tid & 63;
    asm volatile("" : "+v"(lane));
    bf16_t* t = (bf16_t*)smem;
    {
      bf16_t* tw = t + (wm * 64 + 4 * (lane >> 5)) * 136 + wn * 64 + (lane & 31);
#pragma unroll
      for (int mi = 0; mi < 2; ++mi)
#pragma unroll
        for (int ni = 0; ni < 2; ++ni)
#pragma unroll
          for (int r = 0; r < 16; ++r)
            tw[(mi * 32 + (r & 3) + 8 * (r >> 2)) * 136 + ni * 32] = (bf16_t)f2bf(acc[mi][ni][r]);
    }
    __syncthreads();
    bf16_t* dst = C + (size_t)(m0 + (tid >> 4)) * ldc + n0 + (tid & 15) * 8;
    const bf16_t* src = t + (tid >> 4) * 136 + (tid & 15) * 8;
#pragma unroll 4
    for (int i = 0; i < 8; ++i) {
      *(uint4*)dst = *(const uint4*)src;
      dst += (size_t)16 * ldc; src += 16 * 136;
    }
  }
};
struct EpiQKV1 {
  bf16_t* Q1; bf16_t* K1; bf16_t* VT; const float* RT;
  __device__ __forceinline__ void operator()(int m0, int n0, int wm, int wn, f32x16 (&acc)[2][2], int tid, char* smem) const {
    int lane = tid & 63;
    asm volatile("" : "+v"(lane));
    bf16_t* t = (bf16_t*)smem;
    if (n0 < 1280 && m0 < T) {
      int i = lane & 31; int f = i & 15;
#pragma unroll
      for (int mi = 0; mi < 2; ++mi)
#pragma unroll
        for (int r = 0; r < 16; ++r) {
          int row = m0 + wm * 64 + 4 * (lane >> 5) + mi * 32 + (r & 3) + 8 * (r >> 2);
          int tt = row & (S - 1);
          int pos = (i < 16) ? (tt >> 6) : (tt & 63);
          float2 cs = *(const float2*)(RT + 2 * (pos * 16 + f));
          float x1 = acc[mi][0][r], x2 = acc[mi][1][r];
          acc[mi][0][r] = x1 * cs.x - x2 * cs.y;
          acc[mi][1][r] = x1 * cs.y + x2 * cs.x;
        }
    }
    {
      bf16_t* tw = t + (wm * 64 + 4 * (lane >> 5)) * 136 + wn * 64 + (lane & 31);
#pragma unroll
      for (int mi = 0; mi < 2; ++mi)
#pragma unroll
        for (int ni = 0; ni < 2; ++ni)
#pragma unroll
          for (int r = 0; r < 16; ++r)
            tw[(mi * 32 + (r & 3) + 8 * (r >> 2)) * 136 + ni * 32] = (bf16_t)f2bf(acc[mi][ni][r]);
    }
    __syncthreads();
    if (n0 < 1280) {
      bf16_t* dst; int ld;
      if (n0 < 1024) { dst = Q1 + (size_t)(m0 + (tid >> 4)) * 1024 + n0 + (tid & 15) * 8; ld = 1024; }
      else { dst = K1 + (size_t)(m0 + (tid >> 4)) * 256 + (n0 - 1024) + (tid & 15) * 8; ld = 256; }
      if (n0 >= 1024 || m0 < T) {
        const bf16_t* src = t + (tid >> 4) * 136 + (tid & 15) * 8;
#pragma unroll 4
        for (int i = 0; i < 8; ++i) {
          *(uint4*)dst = *(const uint4*)src;
          dst += (size_t)16 * ld; src += 16 * 136;
        }
      }
    } else {
      int col = tid >> 1, half = tid & 1;
      int hd = (n0 - 1280) / 64 + (col >> 6), d = col & 63;
      bf16_t* dst;
      if (m0 < T) { int b = m0 / S, t0 = m0 % S; dst = VT + (((size_t)b * 4 + hd) * 64 + d) * S + t0 + half * 64; }
      else { int mm = m0 - T; int b = mm / CL, l0 = mm % CL; dst = VT + (size_t)NB * 4 * 64 * S + (((size_t)b * 4 + hd) * 64 + d) * CL + l0 + half * 64; }
      const bf16_t* src = t + (half * 64) * 136 + col;
#pragma unroll
      for (int i = 0; i < 8; ++i) {
        unsigned wv[4];
#pragma unroll
        for (int j = 0; j < 4; ++j) wv[j] = (unsigned)src[(i * 8 + 2 * j) * 136] | ((unsigned)src[(i * 8 + 2 * j + 1) * 136] << 16);
        *(uint4*)(dst + i * 8) = make_uint4(wv[0], wv[1], wv[2], wv[3]);
      }
    }
  }
};
__device__ __forceinline__ void gemm_tile_mainloop(const bf16_t* __restrict__ Ag, int lda, const bf16_t* __restrict__ Bg, int ldb, int KT,
                                                   f32x16 (&acc)[2][2], char* smem) {
  int tid = threadIdx.x;
  asm volatile("" : "+v"(tid));
  int lane = tid & 63, wave = __builtin_amdgcn_readfirstlane(tid >> 6), wm = wave >> 1, wn = wave & 1;
#pragma unroll
  for (int mi = 0; mi < 2; ++mi)
#pragma unroll
    for (int ni = 0; ni < 2; ++ni)
#pragma unroll
      for (int r = 0; r < 16; ++r) acc[mi][ni][r] = 0.f;
  __syncthreads();
  gemm_stage(Ag, lda, 0, smem, tid); gemm_stage(Bg, ldb, 0, smem + 16384, tid);
  for (int kt = 0; kt < KT; ++kt) {
    asm volatile("s_waitcnt vmcnt(0)" ::: "memory");
    __syncthreads();
    char* cur = smem + (kt & 1) * 32768;
    if (kt + 1 < KT) {
      char* nxt = smem + ((kt + 1) & 1) * 32768;
      gemm_stage(Ag, lda, (kt + 1) * 64, nxt, tid); gemm_stage(Bg, ldb, (kt + 1) * 64, nxt + 16384, tid);
    }
#pragma unroll
    for (int s4 = 0; s4 < 4; ++s4) {
      bf16x8 a[2], b[2];
      int c = 2 * s4 + (lane >> 5);
#pragma unroll
      for (int mi = 0; mi < 2; ++mi) { int row = wm * 64 + mi * 32 + (lane & 31); a[mi] = *(const bf16x8*)(cur + row * 128 + ((c ^ ((row >> 1) & 7)) << 4)); }
#pragma unroll
      for (int ni = 0; ni < 2; ++ni) { int row = wn * 64 + ni * 32 + (lane & 31); b[ni] = *(const bf16x8*)(cur + 16384 + row * 128 + ((c ^ ((row >> 1) & 7)) << 4)); }
#pragma unroll
      for (int mi = 0; mi < 2; ++mi)
#pragma unroll
        for (int ni = 0; ni < 2; ++ni) acc[mi][ni] = __builtin_amdgcn_mfma_f32_32x32x16_bf16(a[mi], b[ni], acc[mi][ni], 0, 0, 0);
    }
  }
  __syncthreads();
}
template <class Epi>
__device__ __forceinline__ void ph_gemm_bf16(const bf16_t* __restrict__ A, int lda, const bf16_t* __restrict__ Bt, int ldb, int M, int N, int K,
                             Epi epi, char* smem) {
  int tid = threadIdx.x, wave = __builtin_amdgcn_readfirstlane(tid >> 6), wm = wave >> 1, wn = wave & 1;
  int ntn = N / 128, ntiles = (M / 128) * ntn;
  int KT = K / 64;
  (void)ntiles;
  int nb8 = gridDim.x >> 3, xq = blockIdx.x & 7, xm = xq >> 1, xn = xq & 1;
  int MT = M / 128, mq = (MT + 3) >> 2, nh = ntn >> 1;
  for (int lt = (int)(blockIdx.x >> 3); lt < mq * nh; lt += nb8) {
    int mt = xm * mq + lt / nh, nt = xn * nh + lt % nh;
    if (mt >= MT) continue;
    f32x16 acc[2][2];
    gemm_tile_mainloop(A + (size_t)mt * 128 * lda, lda, Bt + (size_t)nt * 128 * ldb, ldb, KT, acc, smem);
    epi(mt * 128, nt * 128, wm, wn, acc, tid, smem);
  }
}


#define RAW_BARRIER() do { asm volatile("s_waitcnt lgkmcnt(0)" ::: "memory"); __builtin_amdgcn_s_barrier(); } while (0)
__device__ __forceinline__ void gemm_stage32x(const bf16_t* __restrict__ Ag, int lda, const bf16_t* __restrict__ Bg, int ldb, int k0, char* lds, int tid) {
#pragma unroll
  for (int i = 0; i < 2; ++i) { int q = tid + 256 * i; int row = q >> 2, p = q & 3; int c = p ^ ((row >> 2) & 3);
    __builtin_amdgcn_global_load_lds((const unsigned*)(Ag + (size_t)row * lda + k0 + c * 8), (unsigned*)(lds + q * 16), 16, 0, 0); }
#pragma unroll
  for (int i = 0; i < 2; ++i) { int q = tid + 256 * i; int row = q >> 2, p = q & 3; int c = p ^ ((row >> 2) & 3);
    __builtin_amdgcn_global_load_lds((const unsigned*)(Bg + (size_t)row * ldb + k0 + c * 8), (unsigned*)(lds + 8192 + q * 16), 16, 0, 0); }
}
__device__ __forceinline__ void gemm_tile_mainloop3(const bf16_t* __restrict__ Ag, int lda, const bf16_t* __restrict__ Bg, int ldb, int KT,
                                                    f32x16 (&acc)[2][2], char* smem) {
  int tid = threadIdx.x;
  asm volatile("" : "+v"(tid));
  int lane = tid & 63, wave = tid >> 6, wm = wave >> 1, wn = wave & 1;
#pragma unroll
  for (int mi = 0; mi < 2; ++mi)
#pragma unroll
    for (int ni = 0; ni < 2; ++ni)
#pragma unroll
      for (int r = 0; r < 16; ++r) acc[mi][ni][r] = 0.f;
  __syncthreads();
  gemm_stage32x(Ag, lda, Bg, ldb, 0, smem, tid);
  gemm_stage32x(Ag, lda, Bg, ldb, 32, smem + 16384, tid);
  gemm_stage32x(Ag, lda, Bg, ldb, 64, smem + 32768, tid);
  for (int kt = 0; kt < KT; ++kt) {
    if (kt + 2 < KT) asm volatile("s_waitcnt vmcnt(8)" ::: "memory");
    else if (kt + 1 < KT) asm volatile("s_waitcnt vmcnt(4)" ::: "memory");
    else asm volatile("s_waitcnt vmcnt(0)" ::: "memory");
    RAW_BARRIER();
    if (kt + 3 < KT) gemm_stage32x(Ag, lda, Bg, ldb, (kt + 3) * 32, smem + ((kt + 3) & 3) * 16384, tid);
    char* cur = smem + (kt & 3) * 16384;
#pragma unroll
    for (int s2 = 0; s2 < 2; ++s2) {
      bf16x8 a[2], b[2];
      int c = 2 * s2 + (lane >> 5);
#pragma unroll
      for (int mi = 0; mi < 2; ++mi) { int row = wm * 64 + mi * 32 + (lane & 31); a[mi] = *(const bf16x8*)(cur + row * 64 + ((c ^ ((row >> 2) & 3)) << 4)); }
#pragma unroll
      for (int ni = 0; ni < 2; ++ni) { int row = wn * 64 + ni * 32 + (lane & 31); b[ni] = *(const bf16x8*)(cur + 8192 + row * 64 + ((c ^ ((row >> 2) & 3)) << 4)); }
#pragma unroll
      for (int mi = 0; mi < 2; ++mi)
#pragma unroll
        for (int ni = 0; ni < 2; ++ni) acc[mi][ni] = __builtin_amdgcn_mfma_f32_32x32x16_bf16(a[mi], b[ni], acc[mi][ni], 0, 0, 0);
    }
  }
  __syncthreads();
}
template <class Epi>
__device__ __forceinline__ void ph_gemm_bf16_3(const bf16_t* __restrict__ A, int lda, const bf16_t* __restrict__ Bt, int ldb, int M, int N, int K,
                             Epi epi, char* smem) {
  int tid = threadIdx.x, wave = __builtin_amdgcn_readfirstlane(tid >> 6), wm = wave >> 1, wn = wave & 1;
  int ntn = N / 128, ntiles = (M / 128) * ntn;
  GRID_LOOP(tile, ntiles) {
    int mt = tile / ntn, nt = tile % ntn;
    f32x16 acc[2][2];
    gemm_tile_mainloop3(A + (size_t)mt * 128 * lda, lda, Bt + (size_t)nt * 128 * ldb, ldb, K / 32, acc, smem);
    epi(mt * 128, nt * 128, wm, wn, acc, tid, smem);
  }
}
__device__ __forceinline__ void ins16(float (&L)[16], float x) {
#pragma unroll
  for (int j = 15; j >= 1; --j) L[j] = __builtin_amdgcn_fmed3f(L[j - 1], L[j], x);
  L[0] = fmaxf(L[0], x);
}
__device__ __forceinline__ void stage_tile128(const bf16_t* __restrict__ src, int ld, char* lds, int tid) {
#pragma unroll
  for (int i = 0; i < 8; ++i) {
    int q = tid + 256 * i; int row = q >> 4, p = q & 15; int c = p ^ (row & 15);
    __builtin_amdgcn_global_load_lds((const unsigned*)(src + (size_t)row * ld + c * 8), (unsigned*)(lds + q * 16), 16, 0, 0);
  }
}
__device__ __forceinline__ void ph_peer_select(const bf16_t* __restrict__ H, const bf16_t* __restrict__ WQl, const bf16_t* __restrict__ SKl,
                                               int* __restrict__ EXP, float* __restrict__ GATE, int nrows, char* smem) {
  int tid = threadIdx.x, w = __builtin_amdgcn_readfirstlane(tid >> 6), wm = w >> 1, wn = w & 1;
  bf16_t* Qs = (bf16_t*)smem;
  int* KL = (int*)(smem + 36864);
  int nb8 = gridDim.x >> 3, xq = blockIdx.x & 7, xm = xq >> 1, xn = xq & 1;
  int MT = nrows / 128, mq = (MT + 3) >> 2;
  for (int lu = (int)(blockIdx.x >> 3); lu < mq * 4; lu += nb8) {
    int mt = xm * mq + (lu >> 2), h = xn * 4 + (lu & 3);
    if (mt >= MT) continue;
    float L0[16], L1[16];
#pragma unroll
    for (int p = 0; p < 2; ++p) {
      f32x16 acc[2][2];
      gemm_tile_mainloop(H + (size_t)mt * 128 * 1024, 1024, WQl + (size_t)(h * 256 + p * 128) * 1024, 1024, 16, acc, smem);
      int lane = tid & 63;
      asm volatile("" : "+v"(lane));
      {
        bf16_t* qw = Qs + (wm * 64 + 4 * (lane >> 5)) * 136 + wn * 64 + (lane & 31);
#pragma unroll
        for (int mi = 0; mi < 2; ++mi)
#pragma unroll
          for (int ni = 0; ni < 2; ++ni)
#pragma unroll
            for (int r = 0; r < 16; ++r)
              qw[(mi * 32 + (r & 3) + 8 * (r >> 2)) * 136 + ni * 32] = (bf16_t)f2bf(acc[mi][ni][r]);
      }
      __syncthreads();
      f32x16 sc[4];
#pragma unroll
      for (int m4 = 0; m4 < 4; ++m4)
#pragma unroll
        for (int r = 0; r < 16; ++r) sc[m4][r] = 0.f;
      {
        const bf16_t* qrow = Qs + (32 * w + (lane & 31)) * 136 + 8 * (lane >> 5);
        const bf16_t* krow = SKl + (size_t)(h * 2 + p) * 128 * 128 + (lane & 31) * 128 + 8 * (lane >> 5);
#pragma unroll
        for (int s8 = 0; s8 < 8; ++s8) {
          bf16x8 bq = *(const bf16x8*)(qrow + 16 * s8);
#pragma unroll
          for (int m4 = 0; m4 < 4; ++m4) {
            bf16x8 ak = *(const bf16x8*)(krow + m4 * 32 * 128 + 16 * s8);
            sc[m4] = __builtin_amdgcn_mfma_f32_32x32x16_bf16(ak, bq, sc[m4], 0, 0, 0);
          }
        }
      }
      float L[16];
#pragma unroll
      for (int j = 0; j < 16; ++j) L[j] = -INFINITY;
      unsigned kb = 4u * (unsigned)(lane >> 5);
#pragma unroll
      for (int m4 = 0; m4 < 4; ++m4)
#pragma unroll
        for (int r = 0; r < 16; ++r) {
          unsigned key = kb + (unsigned)(32 * m4 + (r & 3) + 8 * (r >> 2));
          float x = __uint_as_float((__float_as_uint(sc[m4][r]) & 0xFFFFFF80u) | key);
          ins16(L, x);
        }
      float P[16];
#pragma unroll
      for (int j = 0; j < 16; ++j) P[j] = __shfl_xor(L[j], 32);
#pragma unroll
      for (int j = 0; j < 16; ++j) ins16(L, P[j]);
      if (p == 0) {
#pragma unroll
        for (int j = 0; j < 16; ++j) L0[j] = L[j];
      } else {
#pragma unroll
        for (int j = 0; j < 16; ++j) L1[j] = L[j];
      }
    }
    float C[16];
#pragma unroll
    for (int j = 0; j < 16; ++j) C[j] = -INFINITY;
#pragma unroll
    for (int a = 0; a < 16; ++a)
#pragma unroll
      for (int b = 0; b < 16; ++b)
        if ((a + 1) * (b + 1) <= 16) {
          float sa = __uint_as_float(__float_as_uint(L0[a]) & 0xFFFFFF80u);
          float sb = __uint_as_float(__float_as_uint(L1[b]) & 0xFFFFFF80u);
          float x = __uint_as_float((__float_as_uint(sa + sb) & 0xFFFFFF00u) | (unsigned)(a * 16 + b));
          ins16(C, x);
        }
    int lane = tid & 63;
    asm volatile("" : "+v"(lane));
    int token = 32 * w + (lane & 31);
    if (lane < 32) {
#pragma unroll
      for (int j = 0; j < 16; ++j) { KL[token * 32 + j] = (int)(__float_as_uint(L0[j]) & 0x7Fu); KL[token * 32 + 16 + j] = (int)(__float_as_uint(L1[j]) & 0x7Fu); }
    }
    __syncthreads();
    if (lane < 32) {
      float c0 = __uint_as_float(__float_as_uint(C[0]) & 0xFFFFFF00u);
      float ev[16]; float sum = 0.f; int ex[16];
#pragma unroll
      for (int j = 0; j < 16; ++j) {
        unsigned bits = __float_as_uint(C[j]);
        float cv = __uint_as_float(bits & 0xFFFFFF00u);
        ev[j] = __expf(cv - c0); sum += ev[j];
        int a = (bits >> 4) & 15, b = bits & 15;
        ex[j] = KL[token * 32 + a] * 128 + KL[token * 32 + 16 + b];
      }
      float inv = 1.f / sum;
      size_t o = (size_t)(mt * 128 + token) * 128 + h * 16;
#pragma unroll
      for (int j = 0; j < 16; j += 4) {
        *(int4*)(EXP + o + j) = make_int4(ex[j], ex[j + 1], ex[j + 2], ex[j + 3]);
        *(float4*)(GATE + o + j) = make_float4(ev[j] * inv, ev[j + 1] * inv, ev[j + 2] * inv, ev[j + 3] * inv);
      }
    }
  }
}

__device__ __forceinline__ void fft1_unit(int u, const bf16_t* __restrict__ FQKV, const bf16_t* __restrict__ D1, const float* __restrict__ TAB,
                          bf16_t* __restrict__ A1, char* smem) {
  int tid = threadIdx.x, lane = tid & 63, w = __builtin_amdgcn_readfirstlane(tid >> 6);
  int g = u & 7, c = (u >> 3) & 63, b = u >> 9;
  bf16_t* Bt = (bf16_t*)smem;
  __syncthreads();
  {
    int r = tid >> 1, half = tid & 1;
    const uint4* src = (const uint4*)(FQKV + (size_t)(b * S + 64 * r + c) * 2048 + g * 64 + half * 32);
    unsigned wv[16];
#pragma unroll
    for (int i = 0; i < 4; ++i) { uint4 v = src[i]; wv[4 * i] = v.x; wv[4 * i + 1] = v.y; wv[4 * i + 2] = v.z; wv[4 * i + 3] = v.w; }
#pragma unroll
    for (int j = 0; j < 32; ++j) {
      unsigned e = (j & 1) ? (wv[j >> 1] >> 16) : (wv[j >> 1] & 0xffffu);
      Bt[(half * 32 + j) * 136 + r] = (bf16_t)e;
    }
  }
  __syncthreads();
  f32x16 acc[2][2];
#pragma unroll
  for (int mi = 0; mi < 2; ++mi)
#pragma unroll
    for (int ni = 0; ni < 2; ++ni)
#pragma unroll
      for (int r = 0; r < 16; ++r) acc[mi][ni][r] = 0.f;
#pragma unroll
  for (int s8 = 0; s8 < 8; ++s8) {
    bf16x8 a[2], bb[2];
    int ko = 16 * s8 + 8 * (lane >> 5);
#pragma unroll
    for (int mi = 0; mi < 2; ++mi) a[mi] = *(const bf16x8*)(D1 + (64 * w + 32 * mi + (lane & 31)) * 128 + ko);
#pragma unroll
    for (int ni = 0; ni < 2; ++ni) bb[ni] = *(const bf16x8*)(Bt + (32 * ni + (lane & 31)) * 136 + ko);
#pragma unroll
    for (int mi = 0; mi < 2; ++mi)
#pragma unroll
      for (int ni = 0; ni < 2; ++ni) acc[mi][ni] = __builtin_amdgcn_mfma_f32_32x32x16_bf16(a[mi], bb[ni], acc[mi][ni], 0, 0, 0);
  }
  bf16_t* Ot = (bf16_t*)(smem + 17408);
#pragma unroll
  for (int mi = 0; mi < 2; ++mi)
#pragma unroll
    for (int j = 0; j < 8; ++j) {
      int m = 64 * w + 32 * mi + ((2 * j) & 3) + 8 * ((2 * j) >> 2) + 4 * (lane >> 5);
      int k1 = m >> 1;
      int idx = (k1 * c) & 8191;
      float cs = TAB[idx], sn = TAB[8192 + idx];
#pragma unroll
      for (int ni = 0; ni < 2; ++ni) {
        float re = acc[mi][ni][2 * j], im = acc[mi][ni][2 * j + 1];
        float re2 = re * cs + im * sn, im2 = im * cs - re * sn;
        bf16_t* dst = Ot + m * 72 + 32 * ni + (lane & 31);
        dst[0] = (bf16_t)f2bf(re2); dst[72] = (bf16_t)f2bf(im2);
      }
    }
  __syncthreads();
  {
    bf16_t* base = A1 + (((size_t)b * 64 + c) * 128) * 2 * 512 + g * 64;
#pragma unroll
    for (int i = 0; i < 8; ++i) {
      int q = tid + 256 * i; int m = q >> 3, ch8 = q & 7;
      *(uint4*)(base + (size_t)m * 512 + ch8 * 8) = *(const uint4*)(Ot + m * 72 + ch8 * 8);
    }
  }
}

__device__ __forceinline__ void fft3_unit(int u, int mode, const bf16_t* __restrict__ FQKV, const bf16_t* __restrict__ A1, const bf16_t* __restrict__ D3,
                          const bf16_t* __restrict__ DcT, const float* __restrict__ TAB, bf16_t* __restrict__ MIX, char* smem) {
  int tid = threadIdx.x, lane = tid & 63, w = __builtin_amdgcn_readfirstlane(tid >> 6);
  bf16_t* Bt = (bf16_t*)smem;
  bf16_t* Xs = (bf16_t*)(smem + 17408);
  int g = u & 7, k1, b, nk1, rowbase; float norm;
  __syncthreads();
  if (mode == 0) {
    k1 = (u >> 3) & 127; b = u >> 10; nk1 = 128; rowbase = b * S; norm = 1.f / 724.0773439350247f;
    int kk = tid >> 1, half = tid & 1; int c = kk >> 1, ri = kk & 1;
    const uint4* src = (const uint4*)(A1 + ((((size_t)b * 64 + c) * 128 + k1) * 2 + ri) * 512 + g * 64 + half * 32);
    unsigned wv[16];
#pragma unroll
    for (int i = 0; i < 4; ++i) { uint4 v = src[i]; wv[4 * i] = v.x; wv[4 * i + 1] = v.y; wv[4 * i + 2] = v.z; wv[4 * i + 3] = v.w; }
#pragma unroll
    for (int j = 0; j < 32; ++j) {
      unsigned e = (j & 1) ? (wv[j >> 1] >> 16) : (wv[j >> 1] & 0xffffu);
      Bt[(half * 32 + j) * 136 + kk] = (bf16_t)e;
    }
  } else {
    k1 = (u >> 3) & 3; b = u >> 5; nk1 = 4; rowbase = T + b * CL; norm = 1.f / 128.f;
    int c = tid >> 2, q4 = tid & 3;
    float re[16], im[16];
#pragma unroll
    for (int j = 0; j < 16; ++j) { re[j] = 0.f; im[j] = 0.f; }
#pragma unroll
    for (int r = 0; r < 4; ++r) {
      const uint4* src = (const uint4*)(FQKV + (size_t)(rowbase + 64 * r + c) * 2048 + g * 64 + q4 * 16);
      uint4 v0 = src[0], v1 = src[1];
      unsigned wv[8] = {v0.x, v0.y, v0.z, v0.w, v1.x, v1.y, v1.z, v1.w};
      int ph = (k1 * r) & 3;
      float cr = (ph == 0) ? 1.f : (ph == 2 ? -1.f : 0.f);
      float ci = (ph == 1) ? -1.f : (ph == 3 ? 1.f : 0.f);
#pragma unroll
      for (int j = 0; j < 16; ++j) {
        float x = bf2f((unsigned short)((j & 1) ? (wv[j >> 1] >> 16) : (wv[j >> 1] & 0xffffu)));
        re[j] += x * cr; im[j] += x * ci;
      }
    }
    int idx = (k1 * c * 32) & 8191;
    float cs = TAB[idx], sn = TAB[8192 + idx];
#pragma unroll
    for (int j = 0; j < 16; ++j) {
      float re2 = re[j] * cs + im[j] * sn, im2 = im[j] * cs - re[j] * sn;
      *(unsigned*)(Bt + (q4 * 16 + j) * 136 + 2 * c) = pack2bf(re2, im2);
    }
  }
  __syncthreads();
  {
    f32x16 acc[2];
#pragma unroll
    for (int ni = 0; ni < 2; ++ni)
#pragma unroll
      for (int r = 0; r < 16; ++r) acc[ni][r] = 0.f;
#pragma unroll
    for (int s8 = 0; s8 < 8; ++s8) {
      int ko = 16 * s8 + 8 * (lane >> 5);
      bf16x8 a = *(const bf16x8*)(D3 + (32 * w + (lane & 31)) * 128 + ko);
#pragma unroll
      for (int ni = 0; ni < 2; ++ni) {
        bf16x8 bb = *(const bf16x8*)(Bt + (32 * ni + (lane & 31)) * 136 + ko);
        acc[ni] = __builtin_amdgcn_mfma_f32_32x32x16_bf16(a, bb, acc[ni], 0, 0, 0);
      }
    }
#pragma unroll
    for (int ni = 0; ni < 2; ++ni)
#pragma unroll
      for (int r = 0; r < 16; ++r) {
        int m = 32 * w + (r & 3) + 8 * (r >> 2) + 4 * (lane >> 5);
        Xs[(m & 63) * 136 + (m >> 6) * 64 + 32 * ni + (lane & 31)] = (bf16_t)f2bf(acc[ni][r]);
      }
  }
  __syncthreads();
  {
    int mi = w >> 1, ni = w & 1;
    f32x16 acc;
#pragma unroll
    for (int r = 0; r < 16; ++r) acc[r] = 0.f;
#pragma unroll
    for (int s8 = 0; s8 < 8; ++s8) {
      int ko = 16 * s8 + 8 * (lane >> 5);
      bf16x8 a = *(const bf16x8*)(Xs + (32 * mi + (lane & 31)) * 136 + ko);
      bf16x8 bb = *(const bf16x8*)(DcT + (32 * ni + (lane & 31)) * 128 + ko);
      acc = __builtin_amdgcn_mfma_f32_32x32x16_bf16(a, bb, acc, 0, 0, 0);
    }
    bf16_t* Yt = Bt;
#pragma unroll
    for (int r = 0; r < 16; ++r) {
      int k2 = 32 * mi + (r & 3) + 8 * (r >> 2) + 4 * (lane >> 5);
      Yt[k2 * 72 + 32 * ni + (lane & 31)] = (bf16_t)f2bf(acc[r] * norm);
    }
  }
  __syncthreads();
#pragma unroll
  for (int i = 0; i < 2; ++i) {
    int q = tid + 256 * i; int k2 = q >> 3, ch8 = q & 7;
    int row = rowbase + k1 + nk1 * k2;
    *(uint4*)(MIX + (size_t)row * 1024 + g * 64 + ch8 * 8) = *(const uint4*)((const bf16_t*)smem + k2 * 72 + ch8 * 8);
  }
}

typedef __attribute__((ext_vector_type(4))) float f32x4_t;
__device__ __forceinline__ bf16x8 ld16(const bf16_t* p) { return *(const bf16x8*)p; }
__device__ __forceinline__ float fast_exp2(float x) { return __builtin_amdgcn_exp2f(x); }

template <int NH, int MODE, int KPI, bool PF>
__device__ __forceinline__ void attn_unit(int b, int hk, int r, int jb, int qb, const bf16_t* __restrict__ Qp, int ldq, const bf16_t* __restrict__ Kp, int ldk,
                                          const bf16_t* __restrict__ VTl, const bf16_t* __restrict__ VTc, int nkvh,
                                          const float* rpbs, const float* __restrict__ sink,
                                          bf16_t* __restrict__ Op, int ldo, int lane) {
  const float LOG2E = 1.4426950408889634f;
  const float SC = 0.125f * LOG2E;
  asm volatile("" : "+v"(lane));
  int ql = lane & 15, g = lane >> 4;
  int qrow0, q0 = 0;
  int nloc, lb0 = 0;
  if (MODE == 0) { qrow0 = b * S + r * 64 + 16 * jb; nloc = 8; }
  else if (MODE == 1) { qrow0 = T + b * CL + 16 * qb; nloc = 0; }
  else { q0 = 16 * qb; qrow0 = b * S + q0;
         int lo = (q0 - 128) >> 5, hi = (q0 + 143) >> 5; if (lo < 0) lo = 0; if (hi > 255) hi = 255; lb0 = lo; nloc = hi - lo + 1; }
  bf16x8 qf[NH][2];
#pragma unroll
  for (int hh = 0; hh < NH; ++hh)
#pragma unroll
    for (int s2 = 0; s2 < 2; ++s2)
      qf[hh][s2] = ld16(Qp + (size_t)(qrow0 + ql) * ldq + (hk * NH + hh) * 64 + 32 * s2 + 8 * g);
  f32x4_t o[NH][4]; float mrun[NH], lrun[NH];
#pragma unroll
  for (int hh = 0; hh < NH; ++hh) {
    mrun[hh] = -1e30f; lrun[hh] = 0.f;
#pragma unroll
    for (int dt = 0; dt < 4; ++dt) o[hh][dt] = (f32x4_t){0.f, 0.f, 0.f, 0.f};
  }
  int r_start = 0, blk_start = 0, c_lo = 0, qc = 0;
  if (MODE == 0) {
    r_start = min(max(r - 4, 0), 120);
    blk_start = min(max(16 * jb - 8, 0), 32);
    qc = 16 * jb + ql; c_lo = min(max(qc - 8, 0), 48);
  }
  if (MODE == 2 && KPI == 2) nloc = (nloc + 1) & ~1;
  int nit = (nloc + 8) / KPI;
#define ATT_DESC(kbx, krow0_, vtp_, vld_) \
    { bool il_ = (kbx) < nloc; int vt0_; \
      if (il_) { if (MODE == 0) { int rr_ = r_start + (kbx); krow0_ = b * S + rr_ * 64 + blk_start; vt0_ = rr_ * 64 + blk_start; } \
                 else { krow0_ = b * S + 32 * (lb0 + (kbx)); vt0_ = 32 * (lb0 + (kbx)); } \
                 vtp_ = VTl + ((size_t)(b * nkvh + hk) * 64) * S + vt0_; vld_ = S; } \
      else { int cb_ = (kbx) - nloc; krow0_ = T + b * CL + 32 * cb_; vt0_ = 32 * cb_; \
             vtp_ = VTc + ((size_t)(b * nkvh + hk) * 64) * CL + vt0_; vld_ = CL; } }
#define ATT_LOAD(kbx, KF, VF) \
    { int krow0; const bf16_t* vt; int vld; ATT_DESC(kbx, krow0, vt, vld) \
      _Pragma("unroll") for (int t = 0; t < 2; ++t) _Pragma("unroll") for (int s2 = 0; s2 < 2; ++s2) \
        KF[t][s2] = ld16(Kp + (size_t)(krow0 + 8 * (ql >> 2) + 4 * t + (ql & 3)) * ldk + hk * 64 + 32 * s2 + 8 * g); \
      _Pragma("unroll") for (int dt = 0; dt < 4; ++dt) VF[dt] = ld16(vt + (size_t)(16 * dt + ql) * vld + 8 * g); }
  bf16x8 kfn[PF ? KPI : 1][2][2], vfn[PF ? KPI : 1][4];
  if (PF) {
#pragma unroll
    for (int kk = 0; kk < KPI; ++kk) ATT_LOAD(kk, kfn[kk], vfn[kk])
  }
  for (int it = 0; it < nit; ++it) {
    bf16x8 kf[KPI][2][2], vf[KPI][4];
    if (PF) {
#pragma unroll
      for (int kk = 0; kk < KPI; ++kk) {
#pragma unroll
        for (int t = 0; t < 2; ++t)
#pragma unroll
          for (int s2 = 0; s2 < 2; ++s2) kf[kk][t][s2] = kfn[kk][t][s2];
#pragma unroll
        for (int dt = 0; dt < 4; ++dt) vf[kk][dt] = vfn[kk][dt];
      }
      if (it + 1 < nit) {
#pragma unroll
        for (int kk = 0; kk < KPI; ++kk) ATT_LOAD((it + 1) * KPI + kk, kfn[kk], vfn[kk])
      }
    } else {
#pragma unroll
      for (int kk = 0; kk < KPI; ++kk) ATT_LOAD(it * KPI + kk, kf[kk], vf[kk])
    }
    float bias[KPI][2][4]; bool valid[KPI][2][4];
#pragma unroll
    for (int kk = 0; kk < KPI; ++kk) {
      int kb = it * KPI + kk;
      bool is_loc = kb < nloc;
#pragma unroll
      for (int t = 0; t < 2; ++t)
#pragma unroll
        for (int i = 0; i < 4; ++i) {
          bias[kk][t][i] = 0.f; valid[kk][t][i] = true;
          if (MODE == 0 && is_loc) {
            int kc = blk_start + 8 * g + 4 * t + i;
            valid[kk][t][i] = (kc >= c_lo) && (kc < c_lo + 16);
            int dc = min(max(kc - qc, -15), 15) + 15;
            bias[kk][t][i] = rpbs[(hk * 15 + (r_start + kb - r + 7)) * 31 + dc];
          }
          if (MODE == 2 && is_loc) {
            int kpos = 32 * (lb0 + kb) + 8 * g + 4 * t + i; int dq = (q0 + ql) - kpos;
            bias[kk][t][i] = ((dq <= 128) && (dq >= -128)) ? 0.f : -1e30f;
          }
        }
    }
#pragma unroll
    for (int hh = 0; hh < NH; ++hh) {
      f32x4_t st[KPI][2];
#pragma unroll
      for (int kk = 0; kk < KPI; ++kk)
#pragma unroll
        for (int t = 0; t < 2; ++t) {
          st[kk][t] = (f32x4_t){0.f, 0.f, 0.f, 0.f};
          st[kk][t] = __builtin_amdgcn_mfma_f32_16x16x32_bf16(kf[kk][t][0], qf[hh][0], st[kk][t], 0, 0, 0);
          st[kk][t] = __builtin_amdgcn_mfma_f32_16x16x32_bf16(kf[kk][t][1], qf[hh][1], st[kk][t], 0, 0, 0);
        }
      float lg[KPI][2][4]; float bm = -1e30f;
#pragma unroll
      for (int kk = 0; kk < KPI; ++kk)
#pragma unroll
        for (int t = 0; t < 2; ++t)
#pragma unroll
          for (int i = 0; i < 4; ++i) {
            float v = (MODE == 0) ? (valid[kk][t][i] ? (st[kk][t][i] * SC + bias[kk][t][i]) : -1e30f) : fmaf(st[kk][t][i], SC, bias[kk][t][i]);
            lg[kk][t][i] = v; bm = fmaxf(bm, v);
          }
      bm = xrow16_max(bm);
      float mn = fmaxf(mrun[hh], bm);
      float alpha = fast_exp2(mrun[hh] - mn);
      mrun[hh] = mn;
      float ps = 0.f;
      bf16x8 pf[KPI];
#pragma unroll
      for (int kk = 0; kk < KPI; ++kk) {
        float pv[8];
#pragma unroll
        for (int t = 0; t < 2; ++t)
#pragma unroll
          for (int i = 0; i < 4; ++i) {
            float p = (MODE == 0) ? (valid[kk][t][i] ? fast_exp2(lg[kk][t][i] - mn) : 0.f) : fast_exp2(lg[kk][t][i] - mn);
            pv[4 * t + i] = p; ps += p;
          }
        typedef __attribute__((ext_vector_type(4))) unsigned u32x4;
        u32x4 uu = {pack2bf(pv[0], pv[1]), pack2bf(pv[2], pv[3]), pack2bf(pv[4], pv[5]), pack2bf(pv[6], pv[7])};
        pf[kk] = __builtin_bit_cast(bf16x8, uu);
      }
      lrun[hh] = lrun[hh] * alpha + ps;
#pragma unroll
      for (int dt = 0; dt < 4; ++dt) {
        o[hh][dt] *= alpha;
#pragma unroll
        for (int kk = 0; kk < KPI; ++kk)
          o[hh][dt] = __builtin_amdgcn_mfma_f32_16x16x32_bf16(vf[kk][dt], pf[kk], o[hh][dt], 0, 0, 0);
      }
      if (NH == 4 && KPI == 2 && (hh & 1)) __builtin_amdgcn_sched_barrier(0);
    }
  }
#undef ATT_LOAD
#undef ATT_DESC
#pragma unroll
  for (int hh = 0; hh < NH; ++hh) {
    float l = xrow16_sum(lrun[hh]);
    float m = mrun[hh];
    if (MODE == 2) {
      float sk = sink[hk * NH + hh] * LOG2E;
      float mf = fmaxf(m, sk);
      float a = fast_exp2(m - mf);
      l = l * a + fast_exp2(sk - mf);
#pragma unroll
      for (int dt = 0; dt < 4; ++dt) o[hh][dt] *= a;
    }
    float inv = 1.f / l;
    bf16_t* orow = Op + (size_t)(qrow0 + ql) * ldo + (hk * NH + hh) * 64 + 4 * g;
#pragma unroll
    for (int dt = 0; dt < 4; ++dt) {
      f32x4_t v = o[hh][dt] * inv;
      *(uint2*)(orow + 16 * dt) = make_uint2(pack2bf(v[0], v[1]), pack2bf(v[2], v[3]));
    }
  }
}

struct NaState { f32x4_t o[4][4]; float m[4], l[4]; };
template <int HB>
__device__ __forceinline__ void na_block(NaState& st, const bf16x8 (&qf)[4][2], const bf16x8 (&kf)[2][2], const bf16x8 (&vf)[4],
                                         const float* rpbrow  , int ql, int g) {
  const float SC = 0.125f * 1.4426950408889634f;
#pragma unroll
  for (int jb = 0; jb < 4; ++jb) {
    if (HB == 0 && jb == 3) continue;
    if (HB == 1 && jb == 0) continue;
    f32x4_t s2[2];
#pragma unroll
    for (int t = 0; t < 2; ++t) {
      s2[t] = (f32x4_t){0.f, 0.f, 0.f, 0.f};
      s2[t] = __builtin_amdgcn_mfma_f32_16x16x32_bf16(kf[t][0], qf[jb][0], s2[t], 0, 0, 0);
      s2[t] = __builtin_amdgcn_mfma_f32_16x16x32_bf16(kf[t][1], qf[jb][1], s2[t], 0, 0, 0);
    }
    float lg[8]; bool valid[8]; float bm = -1e30f;
#pragma unroll
    for (int t = 0; t < 2; ++t)
#pragma unroll
      for (int i = 0; i < 4; ++i) {
        float v;
        if (HB < 2) {
          int qc = 16 * jb + ql; int c_lo = min(max(qc - 8, 0), 48);
          int kc = 32 * HB + 8 * g + 4 * t + i;
          bool ok = (kc >= c_lo) && (kc < c_lo + 16);
          int dc = min(max(kc - qc, -15), 15) + 15;
          v = ok ? (s2[t][i] * SC + rpbrow[dc]) : -1e30f;
          valid[4 * t + i] = ok;
        } else { v = s2[t][i] * SC; valid[4 * t + i] = true; }
        lg[4 * t + i] = v; bm = fmaxf(bm, v);
      }
    bm = xrow16_max(bm);
    float mn = fmaxf(st.m[jb], bm);
    float alpha = fast_exp2(st.m[jb] - mn);
    st.m[jb] = mn;
    float ps = 0.f; float pv[8];
#pragma unroll
    for (int e = 0; e < 8; ++e) { float p = valid[e] ? fast_exp2(lg[e] - mn) : 0.f; pv[e] = p; ps += p; }
    st.l[jb] = st.l[jb] * alpha + ps;
    typedef __attribute__((ext_vector_type(4))) unsigned u32x4;
    u32x4 uu = {pack2bf(pv[0], pv[1]), pack2bf(pv[2], pv[3]), pack2bf(pv[4], pv[5]), pack2bf(pv[6], pv[7])};
    bf16x8 pf = __builtin_bit_cast(bf16x8, uu);
#pragma unroll
    for (int dt = 0; dt < 4; ++dt) {
      st.o[jb][dt] *= alpha;
      st.o[jb][dt] = __builtin_amdgcn_mfma_f32_16x16x32_bf16(vf[dt], pf, st.o[jb][dt], 0, 0, 0);
    }
    if (jb & 1) __builtin_amdgcn_sched_barrier(0);
  }
}
__device__ __forceinline__ void na_unit(int b, int h, int r, const bf16_t* __restrict__ FQKV, const bf16_t* __restrict__ VTl,
                                        const bf16_t* __restrict__ VTc, const float* rpbs, bf16_t* __restrict__ MIX, int lane) {
  asm volatile("" : "+v"(lane));
  int ql = lane & 15, g = lane >> 4;
  int qrow0 = b * S + r * 64;
  int r_start = min(max(r - 4, 0), 120);
  bf16x8 qf[4][2];
#pragma unroll
  for (int jb = 0; jb < 4; ++jb)
#pragma unroll
    for (int s2 = 0; s2 < 2; ++s2)
      qf[jb][s2] = ld16(FQKV + (size_t)(qrow0 + 16 * jb + ql) * 2048 + 512 + h * 64 + 32 * s2 + 8 * g);
  NaState st;
#pragma unroll
  for (int jb = 0; jb < 4; ++jb) {
    st.m[jb] = -1e30f; st.l[jb] = 0.f;
#pragma unroll
    for (int dt = 0; dt < 4; ++dt) st.o[jb][dt] = (f32x4_t){0.f, 0.f, 0.f, 0.f};
  }
  unsigned koff = (unsigned)((8 * (ql >> 2) + (ql & 3)) * 2048 + 1024 + h * 64 + 8 * g);
  unsigned voffl = (unsigned)(ql * S + 8 * g), voffc = (unsigned)(ql * CL + 8 * g);
  const bf16_t* vtl = VTl + (size_t)(b * 8 + h) * 64 * S;
  const bf16_t* vtc = VTc + (size_t)(b * 8 + h) * 64 * CL;
#define NA_LOADK(kb2, KF) { \
    int krow0_; \
    if ((kb2) < 16) krow0_ = b * S + (r_start + ((kb2) >> 1)) * 64 + 32 * ((kb2) & 1); \
    else krow0_ = T + b * CL + 32 * ((kb2) - 16); \
    const bf16_t* kb_ = FQKV + (size_t)krow0_ * 2048; \
    _Pragma("unroll") for (int t = 0; t < 2; ++t) _Pragma("unroll") for (int s2 = 0; s2 < 2; ++s2) \
      KF[t][s2] = ld16(kb_ + (koff + (unsigned)(t * 4 * 2048 + 32 * s2))); }
#define NA_LOADV(kb2, VF) { \
    if ((kb2) < 16) { const bf16_t* vt_ = vtl + (r_start + ((kb2) >> 1)) * 64 + 32 * ((kb2) & 1); \
      _Pragma("unroll") for (int dt = 0; dt < 4; ++dt) VF[dt] = ld16(vt_ + (voffl + (unsigned)(16 * dt * S))); } \
    else { const bf16_t* vt_ = vtc + 32 * ((kb2) - 16); \
      _Pragma("unroll") for (int dt = 0; dt < 4; ++dt) VF[dt] = ld16(vt_ + (voffc + (unsigned)(16 * dt * CL))); } }
  bf16x8 kfa[2][2], kfb[2][2], vfa[4], vfb[4];
  NA_LOADK(0, kfa) NA_LOADV(0, vfa)
#pragma unroll 1
  for (int rr = 0; rr < 8; ++rr) {
    const float* rpbrow = rpbs + (h * 15 + (r_start + rr - r + 7)) * 31;
    asm volatile("" : "+v"(lane)); ql = lane & 15; g = lane >> 4;
    koff = (unsigned)((8 * (ql >> 2) + (ql & 3)) * 2048 + 1024 + h * 64 + 8 * g); voffl = (unsigned)(ql * S + 8 * g); voffc = (unsigned)(ql * CL + 8 * g);
    NA_LOADK(2 * rr + 1, kfb) NA_LOADV(2 * rr + 1, vfb)
    na_block<0>(st, qf, kfa, vfa, rpbrow, ql, g);
    NA_LOADK(2 * rr + 2, kfa) NA_LOADV(2 * rr + 2, vfa)
    na_block<1>(st, qf, kfb, vfb, rpbrow, ql, g);
  }
#pragma unroll 1
  for (int cb = 0; cb < 8; cb += 2) {
    asm volatile("" : "+v"(lane)); ql = lane & 15; g = lane >> 4;
    koff = (unsigned)((8 * (ql >> 2) + (ql & 3)) * 2048 + 1024 + h * 64 + 8 * g); voffc = (unsigned)(ql * CL + 8 * g);
    NA_LOADK(16 + cb + 1, kfb) NA_LOADV(16 + cb + 1, vfb)
    na_block<2>(st, qf, kfa, vfa, rpbs, ql, g);
    if (cb + 2 < 8) { NA_LOADK(16 + cb + 2, kfa) NA_LOADV(16 + cb + 2, vfa) }
    na_block<2>(st, qf, kfb, vfb, rpbs, ql, g);
  }
#undef NA_LOADK
#undef NA_LOADV
  asm volatile("" : "+v"(lane)); ql = lane & 15; g = lane >> 4;
#pragma unroll
  for (int jb = 0; jb < 4; ++jb) {
    float inv = 1.f / xrow16_sum(st.l[jb]);
    bf16_t* orow = MIX + (size_t)(qrow0 + 16 * jb + ql) * 1024 + 512 + h * 64 + 4 * g;
#pragma unroll
    for (int dt = 0; dt < 4; ++dt) {
      f32x4_t v = st.o[jb][dt] * inv;
      *(uint2*)(orow + 16 * dt) = make_uint2(pack2bf(v[0], v[1]), pack2bf(v[2], v[3]));
    }
  }
}

__device__ __forceinline__ void ph_chan_dft(const float* __restrict__ F, const float* __restrict__ tab, float* __restrict__ PQ) {
  for (int gid = blockIdx.x * 256 + threadIdx.x; gid < R * 512; gid += gridDim.x * 256) {
    int row = gid >> 9; int col = gid & 511; int g = col >> 6, cp = col & 63;
    const float* f = F + (size_t)row * 2048 + g * 64;
    float p = 0.f, q = 0.f;
    for (int ch = 0; ch < 64; ++ch) {
      int idx = ((ch * cp) & 63) * 128;
      float x = f[ch];
      p += x * tab[idx]; q += x * tab[8192 + idx];
    }
    PQ[(size_t)row * 1024 + col] = p;
    PQ[(size_t)row * 1024 + 512 + col] = q;
  }
}

__device__ __forceinline__ void ph_na(const bf16_t* __restrict__ F, const float* __restrict__ rpb, bf16_t* __restrict__ MIX, float* sm) {
  int lane = threadIdx.x & 63, wave = __builtin_amdgcn_readfirstlane(threadIdx.x >> 6);
  float* sq = sm + wave * 1024; float* sp = sq + 64; int* stok = (int*)(sp + 384);
  int nitems = R * 8;
  for (int item0 = blockIdx.x * 4; item0 < nitems; item0 += gridDim.x * 4) {
    int item = item0 + wave;
    int h = item & 7; int row = item >> 3;
    bool is_ctx = row >= T;
    int b = is_ctx ? (row - T) / CL : row / S;
    __syncthreads();
    sq[lane] = bf2f(F[(size_t)row * 2048 + 512 + h * 64 + lane]);
    __syncthreads();
    int r = 0, c = 0, r_start = 0, c_start = 0;
    if (!is_ctx) { int t = row % S; r = t / 64; c = t % 64; r_start = min(max(r - 4, 0), 120); c_start = min(max(c - 8, 0), 48); }
    int nk = is_ctx ? 256 : 384;
    float lg[6]; float mx = -INFINITY;
#pragma unroll
    for (int kk = 0; kk < 6; ++kk) {
      int j = kk * 64 + lane; float s = -INFINITY; int tok = 0;
      if (j < nk) {
        float bias = 0.f;
        if (!is_ctx && j < 128) {
          int kr = j >> 4, kc = j & 15; int rr = r_start + kr, cc = c_start + kc;
          tok = b * S + rr * 64 + cc;
          int dc = min(max(cc - c, -15), 15) + 15;
          bias = rpb[(h * 15 + (rr - r + 7)) * 31 + dc];
        } else {
          int l = is_ctx ? j : j - 128; tok = T + b * CL + l;
        }
        const bf16_t* kp = F + (size_t)tok * 2048 + 1024 + h * 64;
        float acc = 0.f;
#pragma unroll 8
        for (int d = 0; d < 64; ++d) acc += sq[d] * bf2f(kp[d]);
        s = acc * 0.125f + bias;
      }
      lg[kk] = s; stok[j] = tok; mx = fmaxf(mx, s);
    }
    mx = wave_max(mx);
    float sum = 0.f;
#pragma unroll
    for (int kk = 0; kk < 6; ++kk) { float e = (kk * 64 + lane < nk) ? expf(lg[kk] - mx) : 0.f; lg[kk] = e; sum += e; }
    sum = wave_sum(sum);
    float inv = 1.f / sum;
#pragma unroll
    for (int kk = 0; kk < 6; ++kk) sp[kk * 64 + lane] = lg[kk] * inv;
    __syncthreads();
    float o = 0.f;
    for (int j = 0; j < nk; ++j) o += sp[j] * bf2f(F[(size_t)stok[j] * 2048 + 1536 + h * 64 + lane]);
    MIX[(size_t)row * 1024 + 512 + h * 64 + lane] = (bf16_t)f2bf(o);
  }
}

__device__ __forceinline__ void ph_rope(float* __restrict__ F1) {
  for (int gid = blockIdx.x * 256 + threadIdx.x; gid < T * 20 * 32; gid += gridDim.x * 256) {
    int i = gid & 31; int hh = (gid >> 5) % 20; int row = gid / (32 * 20);
    int t = row % S; float rowp = (float)(t / 64), colp = (float)(t % 64);
    int fi = i & 15;
    float inv_freq = powf(10000.0f, -(float)fi / 16.0f);
    float ang = (i < 16 ? rowp : colp) * inv_freq;
    float cs = cosf(ang), sn = sinf(ang);
    float* p = F1 + (size_t)row * 1536 + hh * 64;
    float x1 = p[i], x2 = p[i + 32];
    p[i] = x1 * cs - x2 * sn;
    p[i + 32] = x1 * sn + x2 * cs;
  }
}

__device__ __forceinline__ void ph_gqa(const float* __restrict__ F1, const float* __restrict__ sink, bf16_t* __restrict__ O, float* sm) {
  int lane = threadIdx.x & 63, wave = __builtin_amdgcn_readfirstlane(threadIdx.x >> 6);
  float* sq = sm + wave * 1280; float* sp = sq + 64; int* stok = (int*)(sp + 576);
  int nitems = T * 16;
  for (int item0 = blockIdx.x * 4; item0 < nitems; item0 += gridDim.x * 4) {
    int item = item0 + wave;
    int qh = item & 15; int row = item >> 4; int kvh = qh >> 2;
    int b = row / S; int t = row % S;
    __syncthreads();
    sq[lane] = F1[(size_t)row * 1536 + qh * 64 + lane];
    __syncthreads();
    float lg[9]; float mx = -INFINITY;
#pragma unroll
    for (int kk = 0; kk < 9; ++kk) {
      int j = kk * 64 + lane; float s = -INFINITY; int tok = 0; bool valid = false;
      if (j < 257) { int pos = t - 128 + j; valid = (pos >= 0 && pos < S); tok = b * S + pos; }
      else if (j < 513) { valid = true; tok = T + b * CL + (j - 257); }
      if (valid) {
        const float* kp = F1 + (size_t)tok * 1536 + 1024 + kvh * 64;
        float acc = 0.f;
#pragma unroll 8
        for (int d = 0; d < 64; ++d) acc += sq[d] * kp[d];
        s = acc * 0.125f;
      } else tok = 0;
      lg[kk] = s; stok[j] = tok; mx = fmaxf(mx, s);
    }
    mx = wave_max(mx);
    float sk = sink[qh];
    mx = fmaxf(mx, sk);
    float sum = 0.f;
#pragma unroll
    for (int kk = 0; kk < 9; ++kk) { float e = (lg[kk] == -INFINITY) ? 0.f : expf(lg[kk] - mx); lg[kk] = e; sum += e; }
    sum = wave_sum(sum) + expf(sk - mx);
    float inv = 1.f / sum;
#pragma unroll
    for (int kk = 0; kk < 9; ++kk) sp[kk * 64 + lane] = lg[kk] * inv;
    __syncthreads();
    float o = 0.f;
    for (int j = 0; j < 513; ++j) { float p = sp[j]; if (p != 0.f) o += p * F1[(size_t)stok[j] * 1536 + 1280 + kvh * 64 + lane]; }
    O[(size_t)row * 1024 + qh * 64 + lane] = (bf16_t)f2bf(o);
  }
}

__device__ __forceinline__ void wave_argmax(float& v, int& idx) {
#pragma unroll
  for (int off = 32; off; off >>= 1) {
    float ov = __shfl_xor(v, off); int oi = __shfl_xor(idx, off);
    if (ov > v || (ov == v && oi < idx)) { v = ov; idx = oi; }
  }
}
__device__ __forceinline__ void ph_peer_select_naive(const float* __restrict__ Q, const float* __restrict__ sk, int* __restrict__ EXP,
                                     float* __restrict__ GATE, int nrows, float* sm) {
  int lane = threadIdx.x & 63, wave = __builtin_amdgcn_readfirstlane(threadIdx.x >> 6);
  float* sq = sm + wave * 640; float* tops = sq + 256; int* topi = (int*)(tops + 32);
  for (int row0 = blockIdx.x * 4; row0 < nrows; row0 += gridDim.x * 4) {
    int row = row0 + wave;
    for (int h = 0; h < 8; ++h) {
      __syncthreads();
#pragma unroll
      for (int i = 0; i < 4; ++i) sq[lane + 64 * i] = Q[(size_t)row * 2048 + h * 256 + lane + 64 * i];
      __syncthreads();
      for (int p = 0; p < 2; ++p) {
        float s0 = 0.f, s1 = 0.f;
        const float* k0 = sk + ((size_t)((h * 2 + p) * 128 + lane)) * 128;
        const float* k1 = k0 + 64 * 128;
#pragma unroll 8
        for (int d = 0; d < 128; ++d) { float qv = sq[p * 128 + d]; s0 += qv * k0[d]; s1 += qv * k1[d]; }
        for (int i = 0; i < 16; ++i) {
          float v; int idx;
          if (s0 >= s1) { v = s0; idx = lane; } else { v = s1; idx = lane + 64; }
          wave_argmax(v, idx);
          if (lane == 0) { tops[p * 16 + i] = v; topi[p * 16 + i] = idx; }
          if (idx == lane) s0 = -INFINITY;
          if (idx == lane + 64) s1 = -INFINITY;
        }
      }
      __syncthreads();
      float cs[4];
#pragma unroll
      for (int i = 0; i < 4; ++i) { int ci = lane * 4 + i; cs[i] = tops[ci >> 4] + tops[16 + (ci & 15)]; }
      float bs[16]; int be[16];
#pragma unroll
      for (int k = 0; k < 16; ++k) {
        float v = cs[0]; int idx = lane * 4;
#pragma unroll
        for (int i = 1; i < 4; ++i) if (cs[i] > v) { v = cs[i]; idx = lane * 4 + i; }
        wave_argmax(v, idx);
        bs[k] = v; be[k] = topi[idx >> 4] * 128 + topi[16 + (idx & 15)];
#pragma unroll
        for (int i = 0; i < 4; ++i) if (idx == lane * 4 + i) cs[i] = -INFINITY;
      }
      float mxs = bs[0]; float sum = 0.f;
#pragma unroll
      for (int k = 0; k < 16; ++k) { bs[k] = expf(bs[k] - mxs); sum += bs[k]; }
      float inv = 1.f / sum;
      if (lane == 0) {
#pragma unroll
        for (int k = 0; k < 16; ++k) { EXP[(size_t)row * 128 + h * 16 + k] = be[k]; GATE[(size_t)row * 128 + h * 16 + k] = bs[k] * inv; }
      }
    }
  }
}

__device__ __forceinline__ void unpack8(uint4 v, float* f) {
  f[0] = __uint_as_float(v.x << 16); f[1] = __uint_as_float(v.x & 0xffff0000u);
  f[2] = __uint_as_float(v.y << 16); f[3] = __uint_as_float(v.y & 0xffff0000u);
  f[4] = __uint_as_float(v.z << 16); f[5] = __uint_as_float(v.z & 0xffff0000u);
  f[6] = __uint_as_float(v.w << 16); f[7] = __uint_as_float(v.w & 0xffff0000u);
}
__device__ __forceinline__ void ph_peer_gather(bf16_t* __restrict__ H, const int* __restrict__ EXP, const float* __restrict__ GATE,
                               const bf16_t* __restrict__ U, const bf16_t* __restrict__ V,
                               const float* __restrict__ xin, const float* __restrict__ M, int layer,
                               const float* __restrict__ g, const float* __restrict__ bb, float* __restrict__ xout,
                               bool write_next, int nrows) {
  int lane = threadIdx.x & 63, wave = __builtin_amdgcn_readfirstlane(threadIdx.x >> 6);
  for (int row = blockIdx.x * 4 + wave; row < nrows; row += gridDim.x * 4) {
    float hreg[16];
    {
      const uint4* hp = (const uint4*)(H + (size_t)row * D + 8 * lane);
      unpack8(hp[0], hreg); unpack8(hp[64], hreg + 8);
    }
    float acc[16];
#pragma unroll
    for (int i = 0; i < 16; ++i) acc[i] = 0.f;
    int e_lo = EXP[(size_t)row * 128 + lane], e_hi = EXP[(size_t)row * 128 + 64 + lane];
    float g_lo = GATE[(size_t)row * 128 + lane], g_hi = GATE[(size_t)row * 128 + 64 + lane];
    uint4 ua[4], ub[4], va[4], vb[4];
#pragma unroll
    for (int i = 0; i < 4; ++i) {
      int e = __builtin_amdgcn_readlane(e_lo, i);
      const uint4* up = (const uint4*)(U + (size_t)e * D + 8 * lane); ua[i] = up[0]; ub[i] = up[64];
    }
#pragma unroll 1
    for (int b = 0; b < 32; ++b) {
      int k0 = 4 * b;
      int ev = (b < 16) ? e_lo : e_hi; float gv = (b < 16) ? g_lo : g_hi;
      int en = (b + 1 < 16) ? e_lo : e_hi;
      float gt[4];
#pragma unroll
      for (int i = 0; i < 4; ++i) {
        int e = __builtin_amdgcn_readlane(ev, (k0 + i) & 63);
        gt[i] = __uint_as_float(__builtin_amdgcn_readlane(__float_as_uint(gv), (k0 + i) & 63));
        const uint4* vp = (const uint4*)(V + (size_t)e * D + 8 * lane); va[i] = vp[0]; vb[i] = vp[64];
      }
      float a[4];
#pragma unroll
      for (int i = 0; i < 4; ++i) {
        float f[16]; unpack8(ua[i], f); unpack8(ub[i], f + 8);
        float sacc = 0.f;
#pragma unroll
        for (int j = 0; j < 16; ++j) sacc += f[j] * hreg[j];
        a[i] = sacc;
      }
      if (b + 1 < 32) {
#pragma unroll
        for (int i = 0; i < 4; ++i) {
          int e = __builtin_amdgcn_readlane(en, (k0 + 4 + i) & 63);
          const uint4* up = (const uint4*)(U + (size_t)e * D + 8 * lane); ua[i] = up[0]; ub[i] = up[64];
        }
      }
#pragma unroll
      for (int i = 0; i < 4; ++i) a[i] = wave_sum(a[i]);
#pragma unroll
      for (int i = 0; i < 4; ++i) {
        float w = gt[i] * 0.5f * a[i] * (1.f + erff(a[i] * 0.70710678118654752f));
        float f[16]; unpack8(va[i], f); unpack8(vb[i], f + 8);
#pragma unroll
        for (int j = 0; j < 16; ++j) acc[j] += w * f[j];
      }
    }
    const float* m = M + ((size_t)layer * 3 + mod_index(row)) * 6144;
    const float* xr = xin + (size_t)row * D;
    float v[16];
#pragma unroll
    for (int hh = 0; hh < 2; ++hh) {
      int d0 = hh * 512 + 8 * lane;
      float4 x0 = *(const float4*)(xr + d0), x1 = *(const float4*)(xr + d0 + 4);
      float4 m0 = *(const float4*)(m + 5 * D + d0), m1 = *(const float4*)(m + 5 * D + d0 + 4);
      v[hh * 8 + 0] = DN_ALPHA * x0.x + m0.x * acc[hh * 8 + 0]; v[hh * 8 + 1] = DN_ALPHA * x0.y + m0.y * acc[hh * 8 + 1];
      v[hh * 8 + 2] = DN_ALPHA * x0.z + m0.z * acc[hh * 8 + 2]; v[hh * 8 + 3] = DN_ALPHA * x0.w + m0.w * acc[hh * 8 + 3];
      v[hh * 8 + 4] = DN_ALPHA * x1.x + m1.x * acc[hh * 8 + 4]; v[hh * 8 + 5] = DN_ALPHA * x1.y + m1.y * acc[hh * 8 + 5];
      v[hh * 8 + 6] = DN_ALPHA * x1.z + m1.z * acc[hh * 8 + 6]; v[hh * 8 + 7] = DN_ALPHA * x1.w + m1.w * acc[hh * 8 + 7];
    }
    float s = 0.f;
#pragma unroll
    for (int j = 0; j < 16; ++j) s += v[j];
    float mu = wave_sum(s) * (1.f / D);
    float q = 0.f;
#pragma unroll
    for (int j = 0; j < 16; ++j) { float d = v[j] - mu; q += d * d; }
    float rs = rsqrtf(wave_sum(q) * (1.f / D) + LN_EPS);
    float y[16];
#pragma unroll
    for (int hh = 0; hh < 2; ++hh) {
      int d0 = hh * 512 + 8 * lane;
#pragma unroll
      for (int j = 0; j < 8; ++j) y[hh * 8 + j] = (v[hh * 8 + j] - mu) * rs * g[d0 + j] + bb[d0 + j];
      *(float4*)(xout + (size_t)row * D + d0) = make_float4(y[hh * 8], y[hh * 8 + 1], y[hh * 8 + 2], y[hh * 8 + 3]);
      *(float4*)(xout + (size_t)row * D + d0 + 4) = make_float4(y[hh * 8 + 4], y[hh * 8 + 5], y[hh * 8 + 6], y[hh * 8 + 7]);
    }
    if (write_next) {
      const float* mn = M + ((size_t)(layer + 1) * 3 + mod_index(row)) * 6144;
      float s2 = 0.f;
#pragma unroll
      for (int j = 0; j < 16; ++j) s2 += y[j];
      float mu2 = wave_sum(s2) * (1.f / D);
      float q2 = 0.f;
#pragma unroll
      for (int j = 0; j < 16; ++j) { float d = y[j] - mu2; q2 += d * d; }
      float rs2 = rsqrtf(wave_sum(q2) * (1.f / D) + LN_EPS);
#pragma unroll
      for (int hh = 0; hh < 2; ++hh) {
        int d0 = hh * 512 + 8 * lane;
        float o[8];
#pragma unroll
        for (int j = 0; j < 8; ++j) o[j] = (y[hh * 8 + j] - mu2) * rs2 * (1.f + mn[D + d0 + j]) + mn[d0 + j];
        *(uint4*)(H + (size_t)row * D + d0) = make_uint4(pack2bf(o[0], o[1]), pack2bf(o[2], o[3]), pack2bf(o[4], o[5]), pack2bf(o[6], o[7]));
      }
    }
  }
}


__device__ __forceinline__ void quant_row(const float* __restrict__ src, unsigned char* __restrict__ dst, float* __restrict__ scale, int row, int lane) {
  const float4* sp = (const float4*)(src + (size_t)row * D + 16 * lane);
  float4 v0 = sp[0], v1 = sp[1], v2 = sp[2], v3 = sp[3];
  float x[16] = {v0.x, v0.y, v0.z, v0.w, v1.x, v1.y, v1.z, v1.w, v2.x, v2.y, v2.z, v2.w, v3.x, v3.y, v3.z, v3.w};
  float am = 0.f;
#pragma unroll
  for (int j = 0; j < 16; ++j) am = fmaxf(am, fabsf(x[j]));
  am = wave_max(am);
  float inv = am > 0.f ? 127.f / am : 0.f;
  unsigned wv[4];
#pragma unroll
  for (int k = 0; k < 4; ++k) {
    unsigned w = 0;
#pragma unroll
    for (int j = 0; j < 4; ++j) {
      int q = (int)rintf(x[4 * k + j] * inv);
      w |= ((unsigned)q & 0xffu) << (8 * j);
    }
    wv[k] = w;
  }
  *(uint4*)(dst + ((size_t)(row >> 14) * 8 + (lane >> 3)) * ((size_t)16384 * 128) + (size_t)(row & 16383) * 128 + 16 * (lane & 7)) = make_uint4(wv[0], wv[1], wv[2], wv[3]);
  if (lane == 0) scale[row] = am * (1.f / 127.f);
}
__device__ __forceinline__ void quant_row_u4(const float* __restrict__ src, unsigned char* __restrict__ dst, float* __restrict__ scale, int row, int lane) {
  const float4* sp = (const float4*)(src + (size_t)row * D + 16 * lane);
  float4 v0 = sp[0], v1 = sp[1], v2 = sp[2], v3 = sp[3];
  float x[16] = {v0.x, v0.y, v0.z, v0.w, v1.x, v1.y, v1.z, v1.w, v2.x, v2.y, v2.z, v2.w, v3.x, v3.y, v3.z, v3.w};
  float ss = 0.f;
#pragma unroll
  for (int j = 0; j < 16; ++j) ss += x[j] * x[j];
  ss = wave_sum(ss);
  float delta = 0.3352f * sqrtf(ss * (1.f / D));
  float inv = delta > 0.f ? 1.f / delta : 0.f;
  unsigned wv[2];
#pragma unroll
  for (int k = 0; k < 2; ++k) {
    unsigned w = 0;
#pragma unroll
    for (int j = 0; j < 4; ++j) {
      int qh = (int)fminf(fmaxf(floorf(x[8 * k + j] * inv), -8.f), 7.f);
      int ql = (int)fminf(fmaxf(floorf(x[8 * k + 4 + j] * inv), -8.f), 7.f);
      w |= ((((unsigned)qh & 15u) << 4) | ((unsigned)ql & 15u)) << (8 * j);
    }
    wv[k] = w;
  }
  *(uint2*)(dst + ((size_t)(row >> 14) * 4 + (lane >> 4)) * ((size_t)16384 * 128) + (size_t)(row & 16383) * 128 + 8 * (lane & 15)) = make_uint2(wv[0], wv[1]);
  if (lane == 0) scale[row] = delta;
}
__device__ __forceinline__ void quant_fill(unsigned* ctr, int layer, unsigned lo, unsigned hi, const float* __restrict__ pu, const float* __restrict__ pv,
                                           unsigned char* __restrict__ U8, unsigned char* __restrict__ V8, float* __restrict__ USC,
                                           float* __restrict__ VSC, unsigned* sh) {
  int lane = threadIdx.x & 63, wave = __builtin_amdgcn_readfirstlane(threadIdx.x >> 6);
  for (;;) {
    __syncthreads();
    if (threadIdx.x == 0) *sh = lo + __hip_atomic_fetch_add(ctr, 1u, __ATOMIC_RELAXED, __HIP_MEMORY_SCOPE_AGENT);
    __syncthreads();
    unsigned c = *sh;
    if (c >= hi) break;
    const float* src = (c >> 8) ? pv : pu; unsigned char* dst = (c >> 8) ? V8 : U8; float* sc = (c >> 8) ? VSC : USC;
    int r0 = layer * 16384 + (int)(c & 255u) * 64 + wave * 16;
#pragma unroll 4
    for (int i = 0; i < 16; ++i) quant_row_u4(src, dst, sc, r0 + i, lane);
  }
  __syncthreads();
}
__device__ __forceinline__ void unpack_u8x16(uint4 v, float* f) {
  unsigned w[4] = {v.x, v.y, v.z, v.w};
#pragma unroll
  for (int k = 0; k < 4; ++k) {
    f[4 * k + 0] = (float)(w[k] & 0xffu); f[4 * k + 1] = (float)((w[k] >> 8) & 0xffu);
    f[4 * k + 2] = (float)((w[k] >> 16) & 0xffu); f[4 * k + 3] = (float)(w[k] >> 24);
  }
}
__device__ __forceinline__ void ph_peer_gather8(bf16_t* __restrict__ H, const int* __restrict__ EXP, const float* __restrict__ GATE,
                               const unsigned char* __restrict__ U8, const float* __restrict__ USC,
                               const unsigned char* __restrict__ V8, const float* __restrict__ VSC,
                               const float* __restrict__ xin, const float* __restrict__ M, int layer,
                               const float* __restrict__ g, const float* __restrict__ bb, float* __restrict__ xout,
                               bool write_next, int nrows) {
  int lane = threadIdx.x & 63, wave = __builtin_amdgcn_readfirstlane(threadIdx.x >> 6);
  for (int row = blockIdx.x * 4 + wave; row < nrows; row += gridDim.x * 4) {
    float hreg[16];
    {
      const uint4* hp = (const uint4*)(H + (size_t)row * D + 16 * lane);
      unpack8(hp[0], hreg); unpack8(hp[1], hreg + 8);
    }
    float hs = 0.f;
#pragma unroll
    for (int j = 0; j < 16; ++j) hs += hreg[j];
    float hsum128 = 128.f * wave_sum(hs);
    float acc[16];
#pragma unroll
    for (int i = 0; i < 16; ++i) acc[i] = 0.f;
    float wsum = 0.f;
    int e_lo = EXP[(size_t)row * 128 + lane], e_hi = EXP[(size_t)row * 128 + 64 + lane];
    float g_lo = GATE[(size_t)row * 128 + lane], g_hi = GATE[(size_t)row * 128 + 64 + lane];
    float us_lo = USC[e_lo], us_hi = USC[e_hi], vs_lo = VSC[e_lo], vs_hi = VSC[e_hi];
    uint4 ua[8], va[8];
#pragma unroll
    for (int i = 0; i < 8; ++i) {
      int e = __builtin_amdgcn_readlane(e_lo, i);
      ua[i] = *(const uint4*)(U8 + (size_t)e * D + 16 * lane);
    }
#pragma unroll 1
    for (int b = 0; b < 16; ++b) {
      int k0 = 8 * b;
      bool lo = b < 8, lon = (b + 1) < 8;
      int ev = lo ? e_lo : e_hi; float gv = lo ? g_lo : g_hi; float usv = lo ? us_lo : us_hi; float vsv = lo ? vs_lo : vs_hi;
      int en = lon ? e_lo : e_hi;
      float gt[8], usc[8], vsc[8];
#pragma unroll
      for (int i = 0; i < 8; ++i) {
        int li = (k0 + i) & 63;
        int e = __builtin_amdgcn_readlane(ev, li);
        gt[i] = __uint_as_float(__builtin_amdgcn_readlane(__float_as_uint(gv), li));
        usc[i] = __uint_as_float(__builtin_amdgcn_readlane(__float_as_uint(usv), li));
        vsc[i] = __uint_as_float(__builtin_amdgcn_readlane(__float_as_uint(vsv), li));
        va[i] = *(const uint4*)(V8 + (size_t)e * D + 16 * lane);
      }
      float a[8];
#pragma unroll
      for (int i = 0; i < 8; ++i) {
        float f[16]; unpack_u8x16(ua[i], f);
        float sacc = 0.f;
#pragma unroll
        for (int j = 0; j < 16; ++j) sacc += f[j] * hreg[j];
        a[i] = sacc;
      }
      if (b + 1 < 16) {
#pragma unroll
        for (int i = 0; i < 8; ++i) {
          int e = __builtin_amdgcn_readlane(en, (k0 + 8 + i) & 63);
          ua[i] = *(const uint4*)(U8 + (size_t)e * D + 16 * lane);
        }
      }
#pragma unroll
      for (int i = 0; i < 8; ++i) a[i] = (wave_sum(a[i]) - hsum128) * usc[i];
#pragma unroll
      for (int i = 0; i < 8; ++i) {
        float w = gt[i] * 0.5f * a[i] * (1.f + erff(a[i] * 0.70710678118654752f)) * vsc[i];
        wsum += w;
        float f[16]; unpack_u8x16(va[i], f);
#pragma unroll
        for (int j = 0; j < 16; ++j) acc[j] += w * f[j];
      }
    }
    float corr = 128.f * wsum;
#pragma unroll
    for (int j = 0; j < 16; ++j) acc[j] -= corr;
    const float* m = M + ((size_t)layer * 3 + mod_index(row)) * 6144;
    const float* xr = xin + (size_t)row * D + 16 * lane;
    const float* m5 = m + 5 * D + 16 * lane;
    float v[16];
#pragma unroll
    for (int q4 = 0; q4 < 4; ++q4) {
      float4 x0 = *(const float4*)(xr + 4 * q4); float4 m0 = *(const float4*)(m5 + 4 * q4);
      v[4 * q4 + 0] = DN_ALPHA * x0.x + m0.x * acc[4 * q4 + 0]; v[4 * q4 + 1] = DN_ALPHA * x0.y + m0.y * acc[4 * q4 + 1];
      v[4 * q4 + 2] = DN_ALPHA * x0.z + m0.z * acc[4 * q4 + 2]; v[4 * q4 + 3] = DN_ALPHA * x0.w + m0.w * acc[4 * q4 + 3];
    }
    float s = 0.f;
#pragma unroll
    for (int j = 0; j < 16; ++j) s += v[j];
    float mu = wave_sum(s) * (1.f / D);
    float q = 0.f;
#pragma unroll
    for (int j = 0; j < 16; ++j) { float d = v[j] - mu; q += d * d; }
    float rs = rsqrtf(wave_sum(q) * (1.f / D) + LN_EPS);
    float y[16];
    {
      const float* gp = g + 16 * lane; const float* bp = bb + 16 * lane;
      float* op = xout + (size_t)row * D + 16 * lane;
#pragma unroll
      for (int q4 = 0; q4 < 4; ++q4) {
        float4 g4 = *(const float4*)(gp + 4 * q4); float4 b4 = *(const float4*)(bp + 4 * q4);
        y[4 * q4 + 0] = (v[4 * q4 + 0] - mu) * rs * g4.x + b4.x; y[4 * q4 + 1] = (v[4 * q4 + 1] - mu) * rs * g4.y + b4.y;
        y[4 * q4 + 2] = (v[4 * q4 + 2] - mu) * rs * g4.z + b4.z; y[4 * q4 + 3] = (v[4 * q4 + 3] - mu) * rs * g4.w + b4.w;
        *(float4*)(op + 4 * q4) = make_float4(y[4 * q4], y[4 * q4 + 1], y[4 * q4 + 2], y[4 * q4 + 3]);
      }
    }
    if (write_next) {
      const float* mn = M + ((size_t)(layer + 1) * 3 + mod_index(row)) * 6144 + 16 * lane;
      float s2 = 0.f;
#pragma unroll
      for (int j = 0; j < 16; ++j) s2 += y[j];
      float mu2 = wave_sum(s2) * (1.f / D);
      float q2 = 0.f;
#pragma unroll
      for (int j = 0; j < 16; ++j) { float d = y[j] - mu2; q2 += d * d; }
      float rs2 = rsqrtf(wave_sum(q2) * (1.f / D) + LN_EPS);
      float o[16];
#pragma unroll
      for (int j = 0; j < 16; ++j) o[j] = (y[j] - mu2) * rs2 * (1.f + mn[D + j]) + mn[j];
      uint4* hp = (uint4*)(H + (size_t)row * D + 16 * lane);
      hp[0] = make_uint4(pack2bf(o[0], o[1]), pack2bf(o[2], o[3]), pack2bf(o[4], o[5]), pack2bf(o[6], o[7]));
      hp[1] = make_uint4(pack2bf(o[8], o[9]), pack2bf(o[10], o[11]), pack2bf(o[12], o[13]), pack2bf(o[14], o[15]));
    }
  }
}


__device__ __forceinline__ void ph_ada2(const float* __restrict__ c, const float* __restrict__ c_ctx, const float* __restrict__ ada_w,
                                        const float* __restrict__ ada_b, float* __restrict__ M, float* sm) {
  int tid = threadIdx.x, lane = tid & 63, wave = __builtin_amdgcn_readfirstlane(tid >> 6);
  float* sv = sm;
  float* red = sm + 3072;
  bool filled = false;
  GRID_LOOP(u, 192) {
    if (!filled) {
      for (int i = tid; i < 3072; i += 256) {
        int idx = i >> 10, k = i & 1023;
        float x = idx < 2 ? c[idx * D + k] : c_ctx[k];
        sv[i] = x / (1.f + expf(-x));
      }
      filled = true;
    }
    __syncthreads();
    int layer = u / 96, c0 = (u % 96) * 64;
    const float* w = ada_w + (size_t)layer * D * 6144 + c0 + lane;
    float a0 = 0.f, a1 = 0.f, a2 = 0.f;
    int kb = wave * 256;
#pragma unroll 16
    for (int k = 0; k < 256; ++k) {
      float wv = w[(size_t)(kb + k) * 6144];
      a0 += sv[kb + k] * wv; a1 += sv[1024 + kb + k] * wv; a2 += sv[2048 + kb + k] * wv;
    }
    red[(wave * 3 + 0) * 64 + lane] = a0; red[(wave * 3 + 1) * 64 + lane] = a1; red[(wave * 3 + 2) * 64 + lane] = a2;
    __syncthreads();
    if (wave < 3) {
      float r = red[(0 * 3 + wave) * 64 + lane] + red[(1 * 3 + wave) * 64 + lane] + red[(2 * 3 + wave) * 64 + lane] + red[(3 * 3 + wave) * 64 + lane];
      M[((size_t)layer * 3 + wave) * 6144 + c0 + lane] = r + ada_b[layer * 6144 + c0 + lane];
    }
  }
  __syncthreads();
}

__device__ __forceinline__ void ph_post_mod(const float* __restrict__ xa, const float* __restrict__ xb, const bf16_t* __restrict__ Y,
                                            const float* __restrict__ M, int layer, int jres, int mlayer, int jshift, int jscale, bool do_mod,
                                            const float* __restrict__ g, const float* __restrict__ bb,
                                            float* __restrict__ xout, bf16_t* __restrict__ H, int nrows,
                                            unsigned char* __restrict__ HQ = nullptr, float* __restrict__ HS = nullptr) {
  int lane = threadIdx.x & 63, wave = __builtin_amdgcn_readfirstlane(threadIdx.x >> 6);
  for (int row = blockIdx.x * 4 + wave; row < nrows; row += gridDim.x * 4) {
    const float* xr = (row < T ? xa + (size_t)row * D : xb + (size_t)(row - T) * D) + 16 * lane;
    const float* m = M + ((size_t)layer * 3 + mod_index(row)) * 6144 + 16 * lane;
    float yv[16];
    {
      const uint4* yp = (const uint4*)(Y + (size_t)row * D + 16 * lane);
      unpack8(yp[0], yv); unpack8(yp[1], yv + 8);
    }
    float v[16];
#pragma unroll
    for (int q4 = 0; q4 < 4; ++q4) {
      float4 x0 = *(const float4*)(xr + 4 * q4); float4 m0 = *(const float4*)(m + jres * D + 4 * q4);
      v[4 * q4 + 0] = DN_ALPHA * x0.x + m0.x * yv[4 * q4 + 0]; v[4 * q4 + 1] = DN_ALPHA * x0.y + m0.y * yv[4 * q4 + 1];
      v[4 * q4 + 2] = DN_ALPHA * x0.z + m0.z * yv[4 * q4 + 2]; v[4 * q4 + 3] = DN_ALPHA * x0.w + m0.w * yv[4 * q4 + 3];
    }
    float s = 0.f;
#pragma unroll
    for (int j = 0; j < 16; ++j) s += v[j];
    float mu = wave_sum(s) * (1.f / D);
    float q = 0.f;
#pragma unroll
    for (int j = 0; j < 16; ++j) { float d = v[j] - mu; q += d * d; }
    float rs = rsqrtf(wave_sum(q) * (1.f / D) + LN_EPS);
    float y[16];
    {
      const float* gp = g + 16 * lane; const float* bp = bb + 16 * lane;
      float* op = xout + (size_t)row * D + 16 * lane;
#pragma unroll
      for (int q4 = 0; q4 < 4; ++q4) {
        float4 g4 = *(const float4*)(gp + 4 * q4); float4 b4 = *(const float4*)(bp + 4 * q4);
        y[4 * q4 + 0] = (v[4 * q4 + 0] - mu) * rs * g4.x + b4.x; y[4 * q4 + 1] = (v[4 * q4 + 1] - mu) * rs * g4.y + b4.y;
        y[4 * q4 + 2] = (v[4 * q4 + 2] - mu) * rs * g4.z + b4.z; y[4 * q4 + 3] = (v[4 * q4 + 3] - mu) * rs * g4.w + b4.w;
        *(float4*)(op + 4 * q4) = make_float4(y[4 * q4], y[4 * q4 + 1], y[4 * q4 + 2], y[4 * q4 + 3]);
      }
    }
    if (do_mod) {
      const float* mm = M + ((size_t)mlayer * 3 + mod_index(row)) * 6144 + 16 * lane;
      float s2 = 0.f;
#pragma unroll
      for (int j = 0; j < 16; ++j) s2 += y[j];
      float mu2 = wave_sum(s2) * (1.f / D);
      float q2 = 0.f;
#pragma unroll
      for (int j = 0; j < 16; ++j) { float d = y[j] - mu2; q2 += d * d; }
      float rs2 = rsqrtf(wave_sum(q2) * (1.f / D) + LN_EPS);
      float o[16];
#pragma unroll
      for (int j = 0; j < 16; ++j) o[j] = (y[j] - mu2) * rs2 * (1.f + mm[jscale * D + j]) + mm[jshift * D + j];
      uint4* hp = (uint4*)(H + (size_t)row * D + 16 * lane);
      hp[0] = make_uint4(pack2bf(o[0], o[1]), pack2bf(o[2], o[3]), pack2bf(o[4], o[5]), pack2bf(o[6], o[7]));
      hp[1] = make_uint4(pack2bf(o[8], o[9]), pack2bf(o[10], o[11]), pack2bf(o[12], o[13]), pack2bf(o[14], o[15]));
      if (HQ) {
        float am = 0.f;
#pragma unroll
        for (int j = 0; j < 16; ++j) am = fmaxf(am, fabsf(o[j]));
        am = fmaxf(am, dpp_mov<0xB1>(am)); am = fmaxf(am, dpp_mov<0x4E>(am)); am = fmaxf(am, dpp_mov<0x124>(am)); am = fmaxf(am, dpp_mov<0x128>(am));
        float hinv = am > 0.f ? 119.f / am : 0.f; float hsc = am * (1.f / 119.f);
        float hsum = 0.f; unsigned pk[4];
#pragma unroll
        for (int k = 0; k < 2; ++k) {
          unsigned w0 = 0, w1 = 0;
#pragma unroll
          for (int j = 0; j < 4; ++j) {
            float r0 = rintf(o[8 * k + j] * hinv), r1 = rintf(o[8 * k + 4 + j] * hinv);
            hsum += r0 + r1;
            w0 = __builtin_amdgcn_cvt_pk_u8_f32(r0 + 128.f, j, w0); w1 = __builtin_amdgcn_cvt_pk_u8_f32(r1 + 128.f, j, w1);
          }
          unsigned t0 = (w0 + 0x08080808u) ^ 0x88888888u, t1 = (w1 + 0x08080808u) ^ 0x88888888u;
          pk[2 * k] = (t0 & 0xF0F0F0F0u) | ((t1 >> 4) & 0x0F0F0F0Fu);
          pk[2 * k + 1] = ((t0 << 4) & 0xF0F0F0F0u) | (t1 & 0x0F0F0F0Fu);
        }
        hsum += dpp_mov<0xB1>(hsum); hsum += dpp_mov<0x4E>(hsum); hsum += dpp_mov<0x124>(hsum); hsum += dpp_mov<0x128>(hsum);
        *(uint4*)(HQ + (size_t)row * D + 16 * lane) = make_uint4(pk[0], pk[1], pk[2], pk[3]);
        if ((lane & 15) == 0) *(float2*)(HS + ((size_t)row * 4 + (lane >> 4)) * 2) = make_float2(hsc, 0.5f * hsc * hsum);
      }
    }
  }
}


template <int CTRL> __device__ __forceinline__ float dpp_add(float x) { return x + dpp_mov<CTRL>(x); }
__device__ __forceinline__ float sum8(float v) {
  v = dpp_add<0xB1>(v); v = dpp_add<0x4E>(v); v = dpp_add<0x141>(v); return v;
}
typedef _Float16 half2_t __attribute__((ext_vector_type(2)));
__device__ __forceinline__ float dot2h(unsigned a, unsigned b, float c) {
  return __builtin_amdgcn_fdot2(__builtin_bit_cast(half2_t, a), __builtin_bit_cast(half2_t, b), c, false);
}
__device__ __forceinline__ unsigned pkh(float a, float b) { return __builtin_bit_cast(unsigned, __builtin_amdgcn_cvt_pkrtz(a, b)); }
__device__ __forceinline__ void load_e16(const int* __restrict__ EXP, int t, int g8, int (&e)[16]) {
  const int4* ep = (const int4*)(EXP + (size_t)t * 128 + 16 * g8);
  int4 a = ep[0], b = ep[1], c = ep[2], d = ep[3];
  e[0] = a.x; e[1] = a.y; e[2] = a.z; e[3] = a.w; e[4] = b.x; e[5] = b.y; e[6] = b.z; e[7] = b.w;
  e[8] = c.x; e[9] = c.y; e[10] = c.z; e[11] = c.w; e[12] = d.x; e[13] = d.y; e[14] = d.z; e[15] = d.w;
}
__device__ __forceinline__ int dpp_iadd_b1(int v) { return v + __builtin_amdgcn_mov_dpp(v, 0xB1, 0xf, 0xf, true); }
__device__ __forceinline__ int dpp_iadd_4e(int v) { return v + __builtin_amdgcn_mov_dpp(v, 0x4E, 0xf, 0xf, true); }
__device__ __forceinline__ int dpp_iadd_141(int v) { return v + __builtin_amdgcn_mov_dpp(v, 0x141, 0xf, 0xf, true); }
#define U_TOKEN(tt, UV, UVN, EUSE, ELD, HUSE, HLD, SUSE, SLD) { \
    int tnn_ = min((tt) + 2 * st, nrows - 1); \
    load_e16(EXP, tnn_, g8, ELD); \
    HLD[0] = *(const uint4*)(hb + (size_t)tnn_ * D); HLD[1] = *(const uint4*)(hb + (size_t)tnn_ * D + 16); \
    SLD = *(const float2*)(HS + ((size_t)tnn_ * 4 + x) * 2); \
    __builtin_amdgcn_sched_barrier(0); \
    _Pragma("unroll") for (int i = 0; i < 16; ++i) UVN[i] = *(const uint4*)(ubs + (((unsigned)EUSE[i] << 7) + loff)); \
    __builtin_amdgcn_sched_barrier(0); \
    int a0_ = (int)HUSE[0].x, b0_ = (int)HUSE[0].y, a1_ = (int)HUSE[0].z, b1_ = (int)HUSE[0].w; \
    int a2_ = (int)HUSE[1].x, b2_ = (int)HUSE[1].y, a3_ = (int)HUSE[1].z, b3_ = (int)HUSE[1].w; \
    int k0 = 0, k1 = 0; \
    _Pragma("unroll") for (int i = 0; i < 16; ++i) { \
      int pa_ = __builtin_amdgcn_sdot8((int)UV[i].x, a0_, 0, false); pa_ = __builtin_amdgcn_sdot8((int)UV[i].y, a1_, pa_, false); \
      pa_ = __builtin_amdgcn_sdot8((int)UV[i].z, a2_, pa_, false); pa_ = __builtin_amdgcn_sdot8((int)UV[i].w, a3_, pa_, false); \
      int pb_ = __builtin_amdgcn_sdot8((int)UV[i].x, b0_, 0, false); pb_ = __builtin_amdgcn_sdot8((int)UV[i].y, b1_, pb_, false); \
      pb_ = __builtin_amdgcn_sdot8((int)UV[i].z, b2_, pb_, false); pb_ = __builtin_amdgcn_sdot8((int)UV[i].w, b3_, pb_, false); \
      int p_ = dpp_iadd_141(dpp_iadd_4e(dpp_iadd_b1((pa_ << 4) + pb_))); \
      if ((i >> 1) == j8) { if (i & 1) k1 = p_; else k0 = p_; } } \
    *(float2*)(PA + ((size_t)(tt) * 4 + x) * 128 + 16 * g8 + 2 * j8) = make_float2(fmaf((float)k0, SUSE.x, SUSE.y), fmaf((float)k1, SUSE.x, SUSE.y)); }
__device__ __forceinline__ void ph_peer_u(const unsigned char* __restrict__ HQ, const float* __restrict__ HS, const int* __restrict__ EXP,
                                          const unsigned char* __restrict__ U4, float* __restrict__ PA, int nrows) {
  int lane = threadIdx.x & 63, wave = __builtin_amdgcn_readfirstlane(threadIdx.x >> 6);
  int x = (blockIdx.x & 7) >> 1; int nb8 = gridDim.x >> 3;
  if ((int)(blockIdx.x >> 3) >= nb8) return;
  int j8 = lane & 7, g8 = lane >> 3;
  const int st = nb8 * 8;
  int t = ((blockIdx.x >> 3) * 2 + (blockIdx.x & 1)) * 4 + wave;
  if (t >= nrows) return;
  const unsigned char* ubs = U4 + (size_t)x * ((size_t)16384 * 128);
  const unsigned loff = 16u * (unsigned)j8;
  const unsigned char* hb = HQ + 256 * x + 32 * j8;
  int eA[16], eB[16]; uint4 hA[2], hB[2], uvA[16], uvB[16]; float2 sA, sB;
  {
    int e0[16]; load_e16(EXP, t, g8, e0);
#pragma unroll
    for (int i = 0; i < 16; ++i) uvA[i] = *(const uint4*)(ubs + (((unsigned)e0[i] << 7) + loff));
    hA[0] = *(const uint4*)(hb + (size_t)t * D); hA[1] = *(const uint4*)(hb + (size_t)t * D + 16);
    sA = *(const float2*)(HS + ((size_t)t * 4 + x) * 2);
    int tn = min(t + st, nrows - 1);
    load_e16(EXP, tn, g8, eA);
    hB[0] = *(const uint4*)(hb + (size_t)tn * D); hB[1] = *(const uint4*)(hb + (size_t)tn * D + 16);
    sB = *(const float2*)(HS + ((size_t)tn * 4 + x) * 2);
  }
#pragma unroll 1
  for (; t < nrows; t += 2 * st) {
    uint4 hC[2]; float2 sC;
    U_TOKEN(t, uvA, uvB, eA, eB, hA, hC, sA, sC)
    if (t + st < nrows) {
      U_TOKEN(t + st, uvB, uvA, eB, eA, hB, hA, sB, sA)
    }
    hB[0] = hA[0]; hB[1] = hA[1]; hA[0] = hC[0]; hA[1] = hC[1]; sB = sA; sA = sC;
  }
}
template <int FMT> __device__ __forceinline__ void ph_peer_w(const float* __restrict__ PA, const int* __restrict__ EXP, const float* __restrict__ GATE,
                                          const float* __restrict__ USC, const float* __restrict__ VSC, unsigned* __restrict__ WQ,
                                          float* __restrict__ SW, int nrows) {
  int lane = threadIdx.x & 63, wave = __builtin_amdgcn_readfirstlane(threadIdx.x >> 6);
  int l4 = lane & 31;
  for (int t = blockIdx.x * 4 + wave; t < nrows; t += gridDim.x * 4) {
    int4 e = *(const int4*)(EXP + (size_t)t * 128 + 4 * l4);
    float4 gt = *(const float4*)(GATE + (size_t)t * 128 + 4 * l4);
    float a[4] = {0.f, 0.f, 0.f, 0.f};
#pragma unroll
    for (int xs = 0; xs < 4; ++xs) { float4 p = *(const float4*)(PA + ((size_t)t * 4 + xs) * 128 + 4 * l4); a[0] += p.x; a[1] += p.y; a[2] += p.z; a[3] += p.w; }
    int ee[4] = {e.x, e.y, e.z, e.w}; float gg[4] = {gt.x, gt.y, gt.z, gt.w}; float w[4]; float wm = 0.f;
#pragma unroll
    for (int j = 0; j < 4; ++j) {
      float av = a[j] * USC[ee[j]];
      w[j] = gg[j] * 0.5f * av * (1.f + erff(av * 0.70710678118654752f)) * VSC[ee[j]];
      wm = fmaxf(wm, fabsf(w[j]));
    }
    wm = wave_max(wm);
    float winv = wm > 0.f ? 127.f / wm : 0.f;
    unsigned q = 0;
#pragma unroll
    for (int j = 0; j < 4; ++j) q = __builtin_amdgcn_cvt_pk_u8_f32(rintf(w[j] * winv) + 128.f, j, q);
    q ^= 0x80808080u;
    if (FMT == 0) { if (lane < 32) WQ[(size_t)t * 32 + l4] = q; }
    else if (lane < 32) {
      unsigned char* wp = (unsigned char*)WQ + (size_t)t * 128 + 64 * ((l4 >> 1) & 1) + 32 * (l4 & 1) + (l4 >> 2);
      wp[0] = (unsigned char)q; wp[8] = (unsigned char)(q >> 8); wp[16] = (unsigned char)(q >> 16); wp[24] = (unsigned char)(q >> 24);
    }
    if (FMT == 2) {
      float qs = 0.f;
#pragma unroll
      for (int j = 0; j < 4; ++j) qs += rintf(w[j] * winv);
      qs = wave_sum(lane < 32 ? qs : 0.f);
      if (lane == 0) *(float2*)(SW + 2 * (size_t)t) = make_float2(wm * (1.f / (127.f * 16.f)), 0.5f * wm * (1.f / 127.f) * qs);
    } else
    if (lane == 0) SW[t] = wm * (1.f / 127.f);
  }
}
__device__ __forceinline__ void load_w16(const float* __restrict__ W, int t, int g8, float (&w)[16]) {
  const float4* wp = (const float4*)(W + (size_t)t * 128 + 16 * g8);
  float4 wa = wp[0], wb = wp[1], wc = wp[2], wd = wp[3];
  w[0] = wa.x; w[1] = wa.y; w[2] = wa.z; w[3] = wa.w; w[4] = wb.x; w[5] = wb.y; w[6] = wb.z; w[7] = wb.w;
  w[8] = wc.x; w[9] = wc.y; w[10] = wc.z; w[11] = wc.w; w[12] = wd.x; w[13] = wd.y; w[14] = wd.z; w[15] = wd.w;
}
#define V_TOKEN(tt, VV, VVN, EUSE, ELD, WUSE, WLD, SUSE, SLD) { \
    int tnn_ = min((tt) + 2 * st, nrows - 1); \
    load_e16(EXP, tnn_, g8, ELD); \
    WLD = *(const uint4*)(WQ + (size_t)tnn_ * 32 + 4 * g8); SLD = SW[tnn_]; \
    __builtin_amdgcn_sched_barrier(0); \
    _Pragma("unroll") for (int i = 0; i < 16; ++i) VVN[i] = *(const uint4*)(vbs + (((unsigned)EUSE[i] << 7) + loff)); \
    __builtin_amdgcn_sched_barrier(0); \
    int acc[16]; \
    _Pragma("unroll") for (int j = 0; j < 16; ++j) acc[j] = 0; \
    int wq[4] = {(int)WUSE.x, (int)WUSE.y, (int)WUSE.z, (int)WUSE.w}; \
    _Pragma("unroll") for (int m = 0; m < 4; ++m) { \
      unsigned r0[4] = {VV[4 * m].x, VV[4 * m].y, VV[4 * m].z, VV[4 * m].w}; \
      unsigned r1[4] = {VV[4 * m + 1].x, VV[4 * m + 1].y, VV[4 * m + 1].z, VV[4 * m + 1].w}; \
      unsigned r2[4] = {VV[4 * m + 2].x, VV[4 * m + 2].y, VV[4 * m + 2].z, VV[4 * m + 2].w}; \
      unsigned r3[4] = {VV[4 * m + 3].x, VV[4 * m + 3].y, VV[4 * m + 3].z, VV[4 * m + 3].w}; \
      _Pragma("unroll") for (int k = 0; k < 4; ++k) { \
          \
        unsigned a0 = __builtin_amdgcn_perm(r1[k], r0[k], 0x05010400u);     \
        unsigned a1 = __builtin_amdgcn_perm(r1[k], r0[k], 0x07030602u);     \
        unsigned a2 = __builtin_amdgcn_perm(r3[k], r2[k], 0x05010400u); \
        unsigned a3 = __builtin_amdgcn_perm(r3[k], r2[k], 0x07030602u); \
        unsigned t0 = __builtin_amdgcn_perm(a2, a0, 0x05040100u);           \
        unsigned t1 = __builtin_amdgcn_perm(a2, a0, 0x07060302u); \
        unsigned t2 = __builtin_amdgcn_perm(a3, a1, 0x05040100u); \
        unsigned t3 = __builtin_amdgcn_perm(a3, a1, 0x07060302u); \
        acc[4 * k + 0] = __builtin_amdgcn_sdot4((int)t0, wq[m], acc[4 * k + 0], false); \
        acc[4 * k + 1] = __builtin_amdgcn_sdot4((int)t1, wq[m], acc[4 * k + 1], false); \
        acc[4 * k + 2] = __builtin_amdgcn_sdot4((int)t2, wq[m], acc[4 * k + 2], false); \
        acc[4 * k + 3] = __builtin_amdgcn_sdot4((int)t3, wq[m], acc[4 * k + 3], false); } } \
    float of[16]; \
    _Pragma("unroll") for (int j = 0; j < 16; ++j) { float v = (float)acc[j]; v += dpp_mov<0x128>(v); of[j] = xrow16_sum(v) * SUSE; } \
    if (g8 == 0) { \
      uint4* fp = (uint4*)(F + (size_t)(tt) * D + 128 * x + 16 * j8); \
      fp[0] = make_uint4(pack2bf(of[0], of[1]), pack2bf(of[2], of[3]), pack2bf(of[4], of[5]), pack2bf(of[6], of[7])); \
      fp[1] = make_uint4(pack2bf(of[8], of[9]), pack2bf(of[10], of[11]), pack2bf(of[12], of[13]), pack2bf(of[14], of[15])); } }
__device__ __forceinline__ void ph_peer_v(const unsigned* __restrict__ WQ, const float* __restrict__ SW, const int* __restrict__ EXP,
                                          const unsigned char* __restrict__ V8, bf16_t* __restrict__ F, int nrows) {
  int lane = threadIdx.x & 63, wave = __builtin_amdgcn_readfirstlane(threadIdx.x >> 6);
  int x = blockIdx.x & 7; int nb8 = gridDim.x >> 3;
  if ((int)(blockIdx.x >> 3) >= nb8) return;
  int j8 = lane & 7, g8 = lane >> 3;
  const int st = nb8 * 4;
  int t = (blockIdx.x >> 3) * 4 + wave;
  if (t >= nrows) return;
  const unsigned char* vbs = V8 + (size_t)x * ((size_t)16384 * 128);
  const unsigned loff = 16u * (unsigned)j8;
  int eA[16], eB[16]; uint4 wA, wB, vvA[16], vvB[16]; float sA, sB;
  {
    int e0[16]; load_e16(EXP, t, g8, e0);
#pragma unroll
    for (int i = 0; i < 16; ++i) vvA[i] = *(const uint4*)(vbs + (((unsigned)e0[i] << 7) + loff));
    wA = *(const uint4*)(WQ + (size_t)t * 32 + 4 * g8); sA = SW[t];
    int tn = min(t + st, nrows - 1);
    load_e16(EXP, tn, g8, eA);
    wB = *(const uint4*)(WQ + (size_t)tn * 32 + 4 * g8); sB = SW[tn];
  }
#pragma unroll 1
  for (; t < nrows; t += 2 * st) {
    uint4 wC; float sC;
    V_TOKEN(t, vvA, vvB, eA, eB, wA, wC, sA, sC)
    if (t + st < nrows) {
      V_TOKEN(t + st, vvB, vvA, eB, eA, wB, wA, sB, sA)
    }
    wB = wA; sB = sA; wA = wC; sA = sC;
  }
}

typedef int v4i_t __attribute__((ext_vector_type(4)));
typedef int v2i_t __attribute__((ext_vector_type(2)));
__device__ __forceinline__ v2i_t lds_tr8(const char* p) { return __builtin_amdgcn_ds_read_tr8_b64_v2i32((__attribute__((address_space(3))) v2i_t*)p); }
#define V2_DMA_HALF(E, h, buf) { _Pragma("unroll") for (int pi = 0; pi < 8; ++pi) \
    __builtin_amdgcn_global_load_lds((const unsigned*)(vbs + (((unsigned)E[8 * (h) + pi] << 7) + ((pi & 2) ? offO : offE))), \
                                     (unsigned*)((buf) + pi * 1024 + lane * 16), 16, 0, 0); }
#define V2_COMPUTE(buf, WQH) { _Pragma("unroll") for (int mt = 0; mt < 8; ++mt) { \
      v2i_t r0_ = lds_tr8((buf) + rdoff[mt]); v2i_t r1_ = lds_tr8((buf) + rdoff[mt] + 1024); \
      v4i_t a_ = {r0_.x, r0_.y, r1_.x, r1_.y}; \
      acc[mt] = __builtin_amdgcn_mfma_i32_16x16x64_i8(a_, WQH, acc[mt], 0, 0, 0); } }
__device__ __forceinline__ void ph_peer_v2(const unsigned char* WQ2, const float* SW, const int* EXP,
                                           const unsigned char* __restrict__ V8, bf16_t* F, int nrows, char* smem) {
  int lane = threadIdx.x & 63, wave = __builtin_amdgcn_readfirstlane(threadIdx.x >> 6);
  int x = blockIdx.x & 7; int nb8 = gridDim.x >> 3;
  if ((int)(blockIdx.x >> 3) >= nb8) return;
  const int q8 = lane >> 3, c8 = lane & 7, n16 = lane & 15, g = lane >> 4;
  const int st = nb8 * 4;
  int t = (blockIdx.x >> 3) * 4 + wave;
  if (t >= nrows) return;
  const unsigned char* vbs = V8 + (size_t)x * ((size_t)16384 * 128);
  char* buf0 = smem + wave * 16384; char* buf1 = buf0 + 8192;
  const unsigned offE = 16u * (unsigned)(c8 ^ (q8 >> 1)), offO = offE ^ 64u;
  int rdoff[8];
#pragma unroll
  for (int mt = 0; mt < 8; ++mt) rdoff[mt] = 2048 * g + 128 * (n16 >> 1) + 16 * (mt ^ (n16 >> 2) ^ ((g & 1) << 2)) + 8 * (n16 & 1);
  int eC[16], eN[16];
  load_e16(EXP, t, q8, eC);
  v4i_t w0 = *(const v4i_t*)(WQ2 + (size_t)t * 128 + 16 * g), w1 = *(const v4i_t*)(WQ2 + (size_t)t * 128 + 64 + 16 * g);
  float sw = SW[t];
  V2_DMA_HALF(eC, 0, buf0)
#pragma unroll 1
  for (; t < nrows; t += st) {
    int tn = min(t + st, nrows - 1);
    asm volatile("s_waitcnt vmcnt(0)" ::: "memory");
    __builtin_amdgcn_sched_barrier(0);
    V2_DMA_HALF(eC, 1, buf1)
    load_e16(EXP, tn, q8, eN);
    v4i_t w0n = *(const v4i_t*)(WQ2 + (size_t)tn * 128 + 16 * g), w1n = *(const v4i_t*)(WQ2 + (size_t)tn * 128 + 64 + 16 * g);
    float swn = SW[tn];
    __builtin_amdgcn_sched_barrier(0);
    v4i_t acc[8];
#pragma unroll
    for (int mt = 0; mt < 8; ++mt) acc[mt] = (v4i_t){0, 0, 0, 0};
    V2_COMPUTE(buf0, w0)
    __builtin_amdgcn_sched_barrier(0);
    asm volatile("s_waitcnt vmcnt(0)" ::: "memory");
    asm volatile("" : "+v"(eN[0]), "+v"(eN[1]), "+v"(eN[2]), "+v"(eN[3]), "+v"(eN[4]), "+v"(eN[5]), "+v"(eN[6]), "+v"(eN[7]));
    V2_DMA_HALF(eN, 0, buf0)
    __builtin_amdgcn_sched_barrier(0);
    V2_COMPUTE(buf1, w1)
    v4i_t sel = acc[0];
#pragma unroll
    for (int mt = 1; mt < 8; ++mt) { bool pk = (n16 & 7) == mt; sel.x = pk ? acc[mt].x : sel.x; sel.y = pk ? acc[mt].y : sel.y; sel.z = pk ? acc[mt].z : sel.z; sel.w = pk ? acc[mt].w : sel.w; }
    if (n16 < 8)
      *(uint2*)(F + (size_t)t * D + 128 * x + 16 * n16 + 4 * g) = make_uint2(pack2bf((float)sel.x * sw, (float)sel.y * sw), pack2bf((float)sel.z * sw, (float)sel.w * sw));
    __builtin_amdgcn_sched_barrier(0);
#pragma unroll
    for (int i = 0; i < 16; ++i) eC[i] = eN[i];
    w0 = w0n; w1 = w1n; sw = swn;
  }
  asm volatile("s_waitcnt vmcnt(0)" ::: "memory");
}

#define V4_COMPUTE(buf, WQH) { _Pragma("unroll") for (int cg = 0; cg < 8; ++cg) { \
      v2i_t r0_ = lds_tr8((buf) + rdoff[cg]); v2i_t r1_ = lds_tr8((buf) + rdoff[cg] + 1024); \
      const int NM_ = (int)0xF0F0F0F0u; \
      v4i_t ah_ = {r0_.x & NM_, r0_.y & NM_, r1_.x & NM_, r1_.y & NM_}; \
      v4i_t al_ = {(r0_.x << 4) & NM_, (r0_.y << 4) & NM_, (r1_.x << 4) & NM_, (r1_.y << 4) & NM_}; \
      accH[cg] = __builtin_amdgcn_mfma_i32_16x16x64_i8(ah_, WQH, accH[cg], 0, 0, 0); \
      accL[cg] = __builtin_amdgcn_mfma_i32_16x16x64_i8(al_, WQH, accL[cg], 0, 0, 0); } }
__device__ __forceinline__ void ph_peer_v4(const unsigned char* WQ2, const float* SW2, const int* EXP,
                                           const unsigned char* __restrict__ V4, bf16_t* F, int nrows, char* smem) {
  int lane = threadIdx.x & 63, wave = __builtin_amdgcn_readfirstlane(threadIdx.x >> 6);
  int x = (blockIdx.x & 7) >> 1; int nb8 = gridDim.x >> 3;
  if ((int)(blockIdx.x >> 3) >= nb8) return;
  const int q8 = lane >> 3, c8 = lane & 7, n16 = lane & 15, g = lane >> 4;
  const int st = nb8 * 8;
  int t = ((blockIdx.x >> 3) * 2 + (blockIdx.x & 1)) * 4 + wave;
  if (t >= nrows) return;
  const unsigned char* vbs = V4 + (size_t)x * ((size_t)16384 * 128);
  char* buf0 = smem + wave * 16384; char* buf1 = buf0 + 8192;
  const unsigned offE = 16u * (unsigned)(c8 ^ (q8 >> 1)), offO = offE ^ 64u;
  int rdoff[8];
#pragma unroll
  for (int mt = 0; mt < 8; ++mt) rdoff[mt] = 2048 * g + 128 * (n16 >> 1) + 16 * (mt ^ (n16 >> 2) ^ ((g & 1) << 2)) + 8 * (n16 & 1);
  int eC[16], eN[16];
  load_e16(EXP, t, q8, eC);
  v4i_t w0 = *(const v4i_t*)(WQ2 + (size_t)t * 128 + 16 * g), w1 = *(const v4i_t*)(WQ2 + (size_t)t * 128 + 64 + 16 * g);
  float2 sw = *(const float2*)(SW2 + 2 * (size_t)t);
  V2_DMA_HALF(eC, 0, buf0)
#pragma unroll 1
  for (; t < nrows; t += st) {
    int tn = min(t + st, nrows - 1);
    asm volatile("s_waitcnt vmcnt(0)" ::: "memory");
    __builtin_amdgcn_sched_barrier(0);
    V2_DMA_HALF(eC, 1, buf1)
    load_e16(EXP, tn, q8, eN);
    v4i_t w0n = *(const v4i_t*)(WQ2 + (size_t)tn * 128 + 16 * g), w1n = *(const v4i_t*)(WQ2 + (size_t)tn * 128 + 64 + 16 * g);
    float2 swn = *(const float2*)(SW2 + 2 * (size_t)tn);
    __builtin_amdgcn_sched_barrier(0);
    v4i_t accH[8], accL[8];
#pragma unroll
    for (int cg = 0; cg < 8; ++cg) { accH[cg] = (v4i_t){0, 0, 0, 0}; accL[cg] = (v4i_t){0, 0, 0, 0}; }
    V4_COMPUTE(buf0, w0)
    __builtin_amdgcn_sched_barrier(0);
    asm volatile("s_waitcnt vmcnt(0)" ::: "memory");
    asm volatile("" : "+v"(eN[0]), "+v"(eN[1]), "+v"(eN[2]), "+v"(eN[3]), "+v"(eN[4]), "+v"(eN[5]), "+v"(eN[6]), "+v"(eN[7]));
    V2_DMA_HALF(eN, 0, buf0)
    __builtin_amdgcn_sched_barrier(0);
    V4_COMPUTE(buf1, w1)
    v4i_t sh = accH[0], sl = accL[0];
#pragma unroll
    for (int cg = 1; cg < 8; ++cg) { bool pk = (n16 & 7) == cg;
      sh.x = pk ? accH[cg].x : sh.x; sh.y = pk ? accH[cg].y : sh.y; sh.z = pk ? accH[cg].z : sh.z; sh.w = pk ? accH[cg].w : sh.w;
      sl.x = pk ? accL[cg].x : sl.x; sl.y = pk ? accL[cg].y : sl.y; sl.z = pk ? accL[cg].z : sl.z; sl.w = pk ? accL[cg].w : sl.w; }
    if (n16 < 8)
      *(uint4*)(F + (size_t)t * D + 256 * x + 32 * n16 + 8 * g) =
          make_uint4(pack2bf(fmaf((float)sh.x, sw.x, sw.y), fmaf((float)sh.y, sw.x, sw.y)), pack2bf(fmaf((float)sh.z, sw.x, sw.y), fmaf((float)sh.w, sw.x, sw.y)),
                     pack2bf(fmaf((float)sl.x, sw.x, sw.y), fmaf((float)sl.y, sw.x, sw.y)), pack2bf(fmaf((float)sl.z, sw.x, sw.y), fmaf((float)sl.w, sw.x, sw.y)));
    __builtin_amdgcn_sched_barrier(0);
#pragma unroll
    for (int i = 0; i < 16; ++i) eC[i] = eN[i];
    w0 = w0n; w1 = w1n; sw = swn;
  }
  asm volatile("s_waitcnt vmcnt(0)" ::: "memory");
}

#define XB_TMO      128
#define XB_XCNT(j)  (256  + 64 * (j))
#define XB_XSUB(j)  (1280 + 64 * (j))
#define XB_XGEN(j)  (2304 + 64 * (j))
#define XB_TOP      3328
#define XB_TOPGEN   3392
#define XCD_BAR_WORDS 3456
#define XB_SPIN_CAP (1u << 22)
#define LAS __attribute__((address_space(3)))
__device__ __forceinline__ unsigned xb_ld(unsigned* p)              { return __hip_atomic_load(p, __ATOMIC_RELAXED, __HIP_MEMORY_SCOPE_AGENT); }
__device__ __forceinline__ unsigned xb_add(unsigned* p, unsigned v) { return __hip_atomic_fetch_add(p, v, __ATOMIC_RELAXED, __HIP_MEMORY_SCOPE_AGENT); }
__device__ __forceinline__ unsigned xb_xcc_id() { return (unsigned)__builtin_amdgcn_s_getreg((3 << 11) | 20) & 0xFu; }
#define XB_SPIN(cond, bar) do { unsigned _sp = 0; while (cond) { __builtin_amdgcn_s_sleep(1); \
    if ((++_sp & 255u) == 0u) { if (xb_ld(&(bar)[XB_TMO])) break; if (_sp > XB_SPIN_CAP) { atomicAdd(&(bar)[XB_TMO], 1u); break; } } } } while (0)
struct XcdBarrier { unsigned* bar; unsigned x; volatile LAS unsigned* st; };
__device__ __forceinline__ XcdBarrier xcd_barrier_post(unsigned* bar, volatile LAS unsigned* st) {
  XcdBarrier b; b.bar = bar; b.x = xb_xcc_id(); b.st = st;
  if (threadIdx.x == 0) (void)xb_add(&bar[XB_XCNT(b.x)], 1u);
  return b;
}
__device__ __forceinline__ void xcd_barrier_complete(unsigned* bar, unsigned x, unsigned& nloc, unsigned& nx) {
  const unsigned G = gridDim.x * gridDim.y * gridDim.z;
  unsigned sum, cnt, mine, sp = 0u;
  for (;;) {
    sum = 0u; cnt = 0u; mine = 0u;
#pragma unroll
    for (unsigned j = 0; j < 16; ++j) { const unsigned c = xb_ld(&bar[XB_XCNT(j)]); sum += c; cnt += (c > 0u) ? 1u : 0u; mine = (j == x) ? c : mine; }
    if (sum == G) break;
    __builtin_amdgcn_s_sleep(1);
    if ((++sp & 255u) == 0u) { if (xb_ld(&bar[XB_TMO])) break; if (sp > XB_SPIN_CAP) { atomicAdd(&bar[XB_TMO], 1u); break; } }
  }
  nloc = mine > 0u ? mine : 1u; nx = cnt > 0u ? cnt : 1u;
}
__device__ __forceinline__ void xcd_barrier(const XcdBarrier& b) {
  asm volatile("s_waitcnt vmcnt(0)" ::: "memory");
  __syncthreads();
  if (threadIdx.x == 0) {
    unsigned* bar = b.bar;
    __builtin_amdgcn_s_waitcnt(0);
    unsigned nloc = b.st[0], nx = b.st[1];
    if (nloc == 0u) { xcd_barrier_complete(bar, b.x, nloc, nx); b.st[0] = nloc; b.st[1] = nx; }
    const unsigned old = xb_add(&bar[XB_XSUB(b.x)], 1u);
    const unsigned gen = old / nloc;
    if (old + 1u == (gen + 1u) * nloc) {
      __builtin_amdgcn_fence(__ATOMIC_RELEASE, "agent");
      asm volatile("s_waitcnt vmcnt(0)" ::: "memory");
      const unsigned og = xb_add(&bar[XB_TOP], 1u);
      const unsigned tg = og / nx;
      if (og + 1u == (tg + 1u) * nx) xb_add(&bar[XB_TOPGEN], 1u);
      else XB_SPIN(xb_ld(&bar[XB_TOPGEN]) == tg, bar);
      __builtin_amdgcn_fence(__ATOMIC_ACQUIRE, "agent");
      xb_add(&bar[XB_XGEN(b.x)], 1u);
      asm volatile("s_waitcnt vmcnt(0)" ::: "memory");
    } else {
      XB_SPIN(xb_ld(&bar[XB_XGEN(b.x)]) == gen, bar);
      __builtin_amdgcn_fence(__ATOMIC_ACQUIRE, "agent");
      asm volatile("s_waitcnt vmcnt(0)" ::: "memory");
    }
  }
  __syncthreads();
}

constexpr int SMEM_BYTES = 65536;
#ifndef PHMASK
#define PHMASK 0xFFFFFFFFFFFFFFFFull
#endif
#ifndef PHDUP
#define PHDUP 0ull
#endif
#define PH(n, ...) if constexpr ((((unsigned long long)(PHMASK)) >> (n)) & 1ull) { __VA_ARGS__; if constexpr ((((unsigned long long)(PHDUP)) >> (n)) & 1ull) { xcd_barrier(xbar); __VA_ARGS__; } }

__global__ __launch_bounds__(256, 2) void mega(Params p) {
  __shared__ __attribute__((aligned(16))) char smem_raw[SMEM_BYTES + 16];
  if (threadIdx.x == 0) *(uint4*)(smem_raw + SMEM_BYTES) = make_uint4(0u, 0u, 0u, 0u);
  __syncthreads();
  XcdBarrier xbar = xcd_barrier_post((unsigned*)((char*)p.ws + OFF_BAR), (volatile LAS unsigned*)(smem_raw + SMEM_BYTES));
  float* smem = (float*)smem_raw;
  const float* x = p.in[0]; const float* c = p.in[1]; const float* ctx = p.in[2]; const float* c_ctx = p.in[3];
  const float* ada_w = p.in[4]; const float* ada_b = p.in[5]; const float* ln_g = p.in[6]; const float* ln_b = p.in[7];
  const float* even_w_in = p.in[8]; const float* even_w_out = p.in[9]; const float* rpb = p.in[10];
  const float* odd_w_in = p.in[11]; const float* odd_w_out = p.in[12]; const float* sink = p.in[13];
  const float* peer_wq = p.in[14]; const float* peer_sk = p.in[15]; const float* peer_u = p.in[16]; const float* peer_v = p.in[17];
  char* ws = (char*)p.ws;
  float* TAB = (float*)(ws + OFF_TAB); float* Mm = (float*)(ws + OFF_M);
  bf16_t* WIN0 = (bf16_t*)(ws + OFF_WIN0); bf16_t* WOUT0 = (bf16_t*)(ws + OFF_WOUT0);
  bf16_t* WIN1 = (bf16_t*)(ws + OFF_WIN1); bf16_t* WOUT1 = (bf16_t*)(ws + OFF_WOUT1);
  bf16_t* WQ = (bf16_t*)(ws + OFF_WQ); bf16_t* SKB = (bf16_t*)(ws + OFF_SK);
  unsigned char* U8 = (unsigned char*)(ws + OFF_UB); unsigned char* V8 = (unsigned char*)(ws + OFF_VB);
  float* USC = (float*)(ws + OFF_USC); float* VSC = USC + 2 * 16384;
  bf16_t* AB = (bf16_t*)(ws + OFF_AB);
  bf16_t* FD1 = (bf16_t*)(ws + OFF_FT); bf16_t* FD3 = FD1 + 256 * 128; bf16_t* FDC = FD3 + 128 * 128;
  bf16_t* A1 = (bf16_t*)(ws + OFF_A1); bf16_t* VT0 = (bf16_t*)(ws + OFF_VT0); bf16_t* FQKV = (bf16_t*)(ws + OFF_BF);
  float* BF_ = (float*)(ws + OFF_BF); float* BY = (float*)(ws + OFF_BY);
  float* X1 = (float*)(ws + OFF_X1); float* X2 = (float*)(ws + OFF_X2);
  float* RT = TAB + 16384;
  bf16_t* Q1 = (bf16_t*)(ws + OFF_BF); bf16_t* K1 = Q1 + (size_t)T * 1024; bf16_t* VT1 = K1 + (size_t)R * 256;
  bf16_t* YB = (bf16_t*)(ws + OFF_BY + (size_t)2 * R * 128 * 4);
  float* PAB = (float*)(ws + OFF_BF); bf16_t* FB = (bf16_t*)(ws + OFF_BF + (size_t)R * 8 * 128 * 4);
  float* WB = (float*)(ws + OFF_BF + (size_t)R * 8 * 128 * 4 + (size_t)R * 1024 * 2); float* CORRB = WB + (size_t)R * 128;
  unsigned char* HQB = (unsigned char*)(ws + OFF_BF + (size_t)R * 8 * 128 * 4 + (size_t)R * 1024 * 2 + (size_t)R * 130 * 4);
  float* HSB = (float*)(HQB + (size_t)R * 1024);
  int* EXPB = (int*)(ws + OFF_BY); float* GATEB = (float*)(ws + OFF_BY + (size_t)R * 128 * 4);
  float* out = p.out;
  unsigned* QC = (unsigned*)(ws + OFF_BAR) + 32;
#define QFILL(site, layer, lo, hi) quant_fill(QC + (site), (layer), (lo), (hi), peer_u, peer_v, U8, V8, USC, VSC, (unsigned*)(smem_raw + 65024))

  PH(0, ph_tables(TAB); ph_rope_table(RT))
  PH(1, ph_fft_tables(FD1, FD3, FDC))
  PH(2, ph_ada2(c, c_ctx, ada_w, ada_b, Mm, smem))
  PH(3, ph_transpose_w(even_w_in, 1024, 2048, WIN0, smem))
  PH(4, ph_transpose_w(even_w_out, 1024, 1024, WOUT0, smem))
  PH(5, ph_transpose_w(odd_w_in, 1024, 1536, WIN1, smem))
  PH(6, ph_transpose_w(odd_w_out, 1024, 1024, WOUT1, smem))
  PH(7, ph_transpose_w(peer_wq, 1024, 2048, WQ, smem))
  PH(8, ph_transpose_w(peer_wq + (size_t)1024 * 2048, 1024, 2048, WQ + (size_t)2048 * 1024, smem))
  PH(11, ph_convert(peer_sk, SKB, (size_t)2 * 8 * 2 * 128 * 128 / 8))
  xcd_barrier(xbar);
  PH(12, ph_modulate(x, ctx, Mm, 0, 0, 1, AB, R, smem))
  xcd_barrier(xbar);
  PH(13, ph_gemm_bf16(AB, 1024, WIN0, 1024, R, 2048, 1024, EpiQKV0{FQKV, VT0}, smem_raw))
  PH(9, QFILL(0, 0, 0u, 160u))
  xcd_barrier(xbar);
  PH(14, { GRID_LOOP(u, NB * 64 * 8) fft1_unit(u, FQKV, FD1, TAB, A1, smem_raw); })
  PH(15, { int lane = threadIdx.x & 63, wave = __builtin_amdgcn_readfirstlane(threadIdx.x >> 6);
           __syncthreads();
           for (int i = threadIdx.x; i < 8 * 15 * 31; i += 256) smem[i] = rpb[i] * 1.4426950408889634f;
           __syncthreads();
           for (int bu = blockIdx.x; bu < 512 + 64; bu += gridDim.x) {
             if (bu < 512) { int h = bu & 7, rg = (bu >> 3) & 31, bb = bu >> 8;
               na_unit(bb, h, rg * 4 + wave, FQKV, VT0, VT0 + (size_t)NB * 8 * 64 * S, smem, AB, lane); }
             else { int cu = bu - 512; int h = cu & 7, qg = (cu >> 3) & 3, bb = cu >> 5;
               attn_unit<1, 1, 2, true>(bb, h, 0, 0, qg * 4 + wave, FQKV + 512, 2048, FQKV + 1024, 2048, VT0, VT0 + (size_t)NB * 8 * 64 * S, 8, smem, nullptr, AB + 512, 1024, lane); } } })
  xcd_barrier(xbar);
  PH(16, { GRID_LOOP(u, NB * 128 * 8 + NB * 4 * 8) { if (u < NB * 128 * 8) fft3_unit(u, 0, FQKV, A1, FD3, FDC, TAB, AB, smem_raw); else fft3_unit(u - NB * 128 * 8, 1, FQKV, A1, FD3, FDC, TAB, AB, smem_raw); } })
  xcd_barrier(xbar);
  PH(17, ph_gemm_bf16(AB, 1024, WOUT0, 1024, R, 1024, 1024, EpiBf16{YB, 1024}, smem_raw))
  PH(9, QFILL(1, 0, 160u, 260u))
  xcd_barrier(xbar);
  PH(18, ph_post_mod(x, ctx, YB, Mm, 0, 2, 0, 3, 4, true, ln_g + 0, ln_b + 0, X1, AB, R, HQB, HSB))
  xcd_barrier(xbar);
  PH(21, ph_peer_select(AB, WQ, SKB, EXPB, GATEB, R, smem_raw))
  PH(9, QFILL(2, 0, 260u, 512u))
  PH(10, QFILL(3, 1, 0u, 300u))
  xcd_barrier(xbar);
  PH(22, ph_peer_u(HQB, HSB, EXPB, U8, PAB, R))
  xcd_barrier(xbar);
  PH(32, ph_peer_w<2>(PAB, EXPB, GATEB, USC, VSC, (unsigned*)WB, CORRB, R))
  xcd_barrier(xbar);
  PH(33, ph_peer_v4((const unsigned char*)WB, CORRB, EXPB, V8, FB, R, smem_raw))
  xcd_barrier(xbar);
  PH(34, ph_post_mod(X1, X1 + (size_t)T * D, FB, Mm, 0, 5, 1, 0, 1, true, ln_g + 1024, ln_b + 1024, X2, AB, R))
  xcd_barrier(xbar);
  PH(23, ph_gemm_bf16(AB, 1024, WIN1, 1024, R, 1536, 1024, EpiQKV1{Q1, K1, VT1, RT}, smem_raw))
  PH(10, QFILL(4, 1, 300u, 420u))
  xcd_barrier(xbar);
  PH(25, { int lane = threadIdx.x & 63, wave = __builtin_amdgcn_readfirstlane(threadIdx.x >> 6);
           for (int bu = blockIdx.x; bu < 1024; bu += gridDim.x) { int kvh = bu & 3, bb = (bu >> 2) & 1, qg = bu >> 3;
             attn_unit<4, 2, 1, true>(bb, kvh, 0, 0, qg * 4 + wave, Q1, 1024, K1, 256, VT1, VT1 + (size_t)NB * 4 * 64 * S, 4, nullptr, sink, AB, 1024, lane); } })
  xcd_barrier(xbar);
  PH(26, ph_gemm_bf16(AB, 1024, WOUT1, 1024, T, 1024, 1024, EpiBf16{YB, 1024}, smem_raw))
  xcd_barrier(xbar);
  PH(27, ph_post_mod(X2, X2, YB, Mm, 1, 2, 1, 3, 4, true, ln_g + 2048, ln_b + 2048, X1, AB, T, HQB, HSB))
  xcd_barrier(xbar);
  PH(30, ph_peer_select(AB, WQ + (size_t)2048 * 1024, SKB + (size_t)8 * 2 * 128 * 128, EXPB, GATEB, T, smem_raw))
  PH(10, QFILL(5, 1, 420u, 512u))
  xcd_barrier(xbar);
  PH(31, ph_peer_u(HQB, HSB, EXPB, U8 + (size_t)16384 * 512, PAB, T))
  xcd_barrier(xbar);
  PH(35, ph_peer_w<2>(PAB, EXPB, GATEB, USC + 16384, VSC + 16384, (unsigned*)WB, CORRB, T))
  xcd_barrier(xbar);
  PH(36, ph_peer_v4((const unsigned char*)WB, CORRB, EXPB, V8 + (size_t)16384 * 512, FB, T, smem_raw))
  xcd_barrier(xbar);
  PH(37, ph_post_mod(X1, X1, FB, Mm, 1, 5, 1, 0, 1, false, ln_g + 3072, ln_b + 3072, out, AB, T))
}

}

extern "C" void kernel_launch(void* const* d_in, const int* in_sizes, int n_in, void* d_out, int out_size, void* d_ws,
                              size_t ws_size, hipStream_t stream) {
  static int grid_blocks = 0;
  if (!grid_blocks) {
    int dev = 0, cus = 0, per_cu = 0;
    hipGetDevice(&dev);
    hipDeviceGetAttribute(&cus, hipDeviceAttributeMultiprocessorCount, dev);
    hipOccupancyMaxActiveBlocksPerMultiprocessor(&per_cu, (const void*)mega, 256, 0);
    if (per_cu > 2) per_cu = 2;
    if (per_cu < 1) per_cu = 1;
    grid_blocks = cus * per_cu;
  }
  Params p{};
  for (int i = 0; i < 18; ++i) p.in[i] = (const float*)d_in[i];
  p.out = (float*)d_out;
  p.ws = (float*)d_ws;
  (void)hipMemsetAsync((char*)d_ws + OFF_BAR, 0, XCD_BAR_WORDS_C * 4, stream);
  void* args[] = {&p};
  hipError_t e = hipLaunchCooperativeKernel((const void*)mega, dim3(grid_blocks), dim3(256), args, 0, stream);
  if (e != hipSuccess) fprintf(stderr, "cooperative launch failed: %s (grid %d)\n", hipGetErrorString(e), grid_blocks);
}
```

```cpp
#include <hip/hip_runtime.h>
#include <hip/hip_bf16.h>
#include <stdint.h>
#include <math.h>
#include <stdio.h>
#include <hip/hip_cooperative_groups.h>
namespace cg = cooperative_groups;

namespace {

constexpr int D = 1024;
constexpr int NB = 2;
constexpr int S = 8192;
constexpr int T = NB * S;
constexpr int CL = 256;
constexpr int TC = NB * CL;
constexpr int R = T + TC;
constexpr float DN_ALPHA = 1.4142135623730951f;
constexpr float LN_EPS = 1e-6f;

template <int CTRL> __device__ __forceinline__ float dpp_mov(float x) {
  return __builtin_bit_cast(float, __builtin_amdgcn_mov_dpp(__builtin_bit_cast(int, x), CTRL, 0xf, 0xf, true));
}
__device__ __forceinline__ float xrow16_max(float x) {
  auto s = __builtin_amdgcn_permlane16_swap(__float_as_uint(x), __float_as_uint(x), false, false);
  x = fmaxf(__uint_as_float(s[0]), __uint_as_float(s[1]));
  auto t = __builtin_amdgcn_permlane32_swap(__float_as_uint(x), __float_as_uint(x), false, false);
  return fmaxf(__uint_as_float(t[0]), __uint_as_float(t[1]));
}
__device__ __forceinline__ float xrow16_sum(float x) {
  auto s = __builtin_amdgcn_permlane16_swap(__float_as_uint(x), __float_as_uint(x), false, false);
  x = __uint_as_float(s[0]) + __uint_as_float(s[1]);
  auto t = __builtin_amdgcn_permlane32_swap(__float_as_uint(x), __float_as_uint(x), false, false);
  return __uint_as_float(t[0]) + __uint_as_float(t[1]);
}
__device__ __forceinline__ float wave_sum(float v) {
  v += dpp_mov<0xB1>(v); v += dpp_mov<0x4E>(v); v += dpp_mov<0x124>(v); v += dpp_mov<0x128>(v);
  return xrow16_sum(v);
}
__device__ __forceinline__ float wave_max(float v) {
  v = fmaxf(v, dpp_mov<0xB1>(v)); v = fmaxf(v, dpp_mov<0x4E>(v)); v = fmaxf(v, dpp_mov<0x124>(v)); v = fmaxf(v, dpp_mov<0x128>(v));
  return xrow16_max(v);
}

typedef unsigned short bf16_t;
typedef __attribute__((ext_vector_type(8))) short bf16x8;
typedef __attribute__((ext_vector_type(16))) float f32x16;
typedef __attribute__((ext_vector_type(4))) float f32x4;

typedef __attribute__((ext_vector_type(2))) __bf16 bf16x2_t;
__device__ __forceinline__ unsigned f2bf(float f) { return (unsigned)__builtin_bit_cast(unsigned short, (__bf16)f); }
__device__ __forceinline__ unsigned pack2bf(float a, float b) { bf16x2_t v = {(__bf16)a, (__bf16)b}; return __builtin_bit_cast(unsigned, v); }
__device__ __forceinline__ float bf2f(unsigned short v) { return __uint_as_float(((unsigned)v) << 16); }

__device__ __forceinline__ int mod_index(int row) { return row < T ? row / S : 2; }


struct Params {
  const float* in[18];
  float* out;
  float* ws;
};

constexpr size_t XCD_BAR_WORDS_C = 3456;
constexpr size_t al256(size_t n) { return (n + 255) & ~(size_t)255; }
constexpr size_t OFF_BAR = 0;
constexpr size_t OFF_TAB = al256(XCD_BAR_WORDS_C * 4);
constexpr size_t OFF_M = OFF_TAB + al256(16384 * 4 + 128 * 16 * 2 * 4);
constexpr size_t OFF_WIN0 = OFF_M + al256(2 * 3 * 6144 * 4);
constexpr size_t OFF_WOUT0 = OFF_WIN0 + al256((size_t)2048 * 1024 * 2);
constexpr size_t OFF_WIN1 = OFF_WOUT0 + al256((size_t)1024 * 1024 * 2);
constexpr size_t OFF_WOUT1 = OFF_WIN1 + al256((size_t)1536 * 1024 * 2);
constexpr size_t OFF_WQ = OFF_WOUT1 + al256((size_t)1024 * 1024 * 2);
constexpr size_t OFF_SK = OFF_WQ + al256((size_t)2 * 2048 * 1024 * 2);
constexpr size_t OFF_UB = OFF_SK + al256((size_t)2 * 8 * 2 * 128 * 128 * 2);
constexpr size_t OFF_VB = OFF_UB + al256((size_t)2 * 16384 * 1024);
constexpr size_t OFF_USC = OFF_VB + al256((size_t)2 * 16384 * 1024);
constexpr size_t OFF_AB = OFF_USC + al256((size_t)4 * 16384 * 4);
constexpr size_t OFF_FT = OFF_AB + al256((size_t)R * 1024 * 2);
constexpr size_t OFF_BF = OFF_FT + al256((size_t)(256 * 128 + 128 * 128 + 64 * 128) * 2);
constexpr size_t OFF_BY = OFF_BF + al256((size_t)R * 2048 * 4);
constexpr size_t OFF_X1 = OFF_BY + al256((size_t)R * 1024 * 4);
constexpr size_t OFF_X2 = OFF_X1 + al256((size_t)R * 1024 * 4);
constexpr size_t OFF_END = OFF_X2 + al256((size_t)R * 1024 * 4);
constexpr size_t OFF_A1 = OFF_BY;
constexpr size_t OFF_VT0 = OFF_X2;
static_assert(OFF_END <= (size_t)512 * 1024 * 1024, "workspace overflow");

#define GRID_LOOP(var, n) for (int var = blockIdx.x; var < (n); var += gridDim.x)

__device__ __forceinline__ void ph_fft_tables(bf16_t* D1, bf16_t* D3, bf16_t* DcT) {
  const double TWO_PI = 6.283185307179586476925286766559;
  for (int i = blockIdx.x * 256 + threadIdx.x; i < 256 * 128 + 128 * 128 + 64 * 128; i += gridDim.x * 256) {
    if (i < 256 * 128) {
      int m = i >> 7, r = i & 127; int k1 = m >> 1, ri = m & 1;
      double a = TWO_PI * (double)((k1 * r) & 127) / 128.0;
      D1[i] = (bf16_t)f2bf(ri == 0 ? (float)cos(a) : (float)(-sin(a)));
    } else if (i < 256 * 128 + 128 * 128) {
      int j = i - 256 * 128; int m = j >> 7, kk = j & 127; int rip = m >> 6, k2 = m & 63; int c = kk >> 1, ri = kk & 1;
      double a = TWO_PI * (double)((k2 * c) & 63) / 64.0;
      double v = (rip == 0) ? (ri == 0 ? cos(a) : sin(a)) : (ri == 0 ? -sin(a) : cos(a));
      D3[j] = (bf16_t)f2bf((float)v);
    } else {
      int j = i - 256 * 128 - 128 * 128; int cp = j >> 7, kk = j & 127; int rip = kk >> 6, ch = kk & 63;
      double a = TWO_PI * (double)((ch * cp) & 63) / 64.0;
      DcT[j] = (bf16_t)f2bf((float)(rip == 0 ? cos(a) : sin(a)));
    }
  }
}
__device__ __forceinline__ void ph_rope_table(float* RT) {
  for (int i = blockIdx.x * 256 + threadIdx.x; i < 128 * 16; i += gridDim.x * 256) {
    int pos = i >> 4, f = i & 15;
    float inv_freq = powf(10000.0f, -(float)f / 16.0f);
    float ang = (float)pos * inv_freq;
    RT[2 * i] = cosf(ang); RT[2 * i + 1] = sinf(ang);
  }
}
__device__ __forceinline__ void ph_tables(float* tab) {
  for (int j = blockIdx.x * 256 + threadIdx.x; j < 8192; j += gridDim.x * 256) {
    double a = 6.283185307179586476925286766559 * (double)j / 8192.0;
    tab[j] = (float)cos(a);
    tab[8192 + j] = (float)sin(a);
  }
}
__device__ __forceinline__ void ph_ada(const float* __restrict__ c, const float* __restrict__ c_ctx, const float* __restrict__ ada_w,
                       const float* __restrict__ ada_b, float* __restrict__ M) {
  for (int gid = blockIdx.x * 256 + threadIdx.x; gid < 2 * 3 * 6144; gid += gridDim.x * 256) {
    int col = gid % 6144; int idx = (gid / 6144) % 3; int layer = gid / (3 * 6144);
    const float* vec = idx < 2 ? c + idx * D : c_ctx;
    const float* w = ada_w + (size_t)layer * D * 6144 + col;
    float acc = 0.f;
    for (int k = 0; k < D; ++k) {
      float x = vec[k];
      float sx = x / (1.f + expf(-x));
      acc += sx * w[(size_t)k * 6144];
    }
    M[gid] = acc + ada_b[layer * 6144 + col];
  }
}

__device__ __forceinline__ void ph_modulate(const float* __restrict__ xa, const float* __restrict__ xb, const float* __restrict__ M, int layer,
                            int jshift, int jscale, bf16_t* __restrict__ out, int nrows, float* red) {
  int tid = threadIdx.x;
  GRID_LOOP(row, nrows) {
    const float* x = row < T ? xa + (size_t)row * D : xb + (size_t)(row - T) * D;
    float v[4]; float s = 0.f;
#pragma unroll
    for (int i = 0; i < 4; ++i) { v[i] = x[tid + 256 * i]; s += v[i]; }
    s = wave_sum(s);
    __syncthreads();
    if ((tid & 63) == 0) red[tid >> 6] = s;
    __syncthreads();
    float mu = (red[0] + red[1] + red[2] + red[3]) * (1.f / D);
    float q = 0.f;
#pragma unroll
    for (int i = 0; i < 4; ++i) { float d = v[i] - mu; q += d * d; }
    q = wave_sum(q);
    if ((tid & 63) == 0) red[4 + (tid >> 6)] = q;
    __syncthreads();
    float var = (red[4] + red[5] + red[6] + red[7]) * (1.f / D);
    float rs = rsqrtf(var + LN_EPS);
    const float* m = M + ((size_t)layer * 3 + mod_index(row)) * 6144;
#pragma unroll
    for (int i = 0; i < 4; ++i) {
      int col = tid + 256 * i;
      float y = (v[i] - mu) * rs;
      out[(size_t)row * D + col] = (bf16_t)f2bf(y * (1.f + m[jscale * D + col]) + m[jshift * D + col]);
    }
  }
}

__device__ __forceinline__ void ph_post(const float* __restrict__ xa, const float* __restrict__ xb, const float* __restrict__ Y,
                        const float* __restrict__ M, int layer, int j, const float* __restrict__ g, const float* __restrict__ bb,
                        float* __restrict__ outa, float* __restrict__ outb, int nrows, float* red) {
  int tid = threadIdx.x;
  GRID_LOOP(row, nrows) {
    const float* x = row < T ? xa + (size_t)row * D : xb + (size_t)(row - T) * D;
    float* out = row < T ? outa + (size_t)row * D : outb + (size_t)(row - T) * D;
    const float* m = M + ((size_t)layer * 3 + mod_index(row)) * 6144 + j * D;
    float v[4]; float s = 0.f;
#pragma unroll
    for (int i = 0; i < 4; ++i) { int col = tid + 256 * i; v[i] = DN_ALPHA * x[col] + m[col] * Y[(size_t)row * D + col]; s += v[i]; }
    s = wave_sum(s);
    __syncthreads();
    if ((tid & 63) == 0) red[tid >> 6] = s;
    __syncthreads();
    float mu = (red[0] + red[1] + red[2] + red[3]) * (1.f / D);
    float q = 0.f;
#pragma unroll
    for (int i = 0; i < 4; ++i) { float d = v[i] - mu; q += d * d; }
    q = wave_sum(q);
    if ((tid & 63) == 0) red[4 + (tid >> 6)] = q;
    __syncthreads();
    float var = (red[4] + red[5] + red[6] + red[7]) * (1.f / D);
    float rs = rsqrtf(var + LN_EPS);
#pragma unroll
    for (int i = 0; i < 4; ++i) {
      int col = tid + 256 * i;
      out[col] = (v[i] - mu) * rs * g[col] + bb[col];
    }
  }
}

struct ARow { const float* A; int lda; __device__ float operator()(int m, int k) const { return A[(size_t)m * lda + k]; } };
struct BRow { const float* B; int ldb; __device__ float operator()(int k, int n) const { return B[(size_t)k * ldb + n]; } };
struct CRow { float* C; int ldc; float scale; __device__ void operator()(int m, int n, float v) const { C[(size_t)m * ldc + n] = v * scale; } };
struct CRowB { bf16_t* C; int ldc; float scale; __device__ void operator()(int m, int n, float v) const { C[(size_t)m * ldc + n] = (bf16_t)f2bf(v * scale); } };
struct ADft { const float* tab; int Sn; int stride; __device__ float operator()(int m, int k) const {
    int t = k & (Sn - 1); int idx = ((m * t) & (Sn - 1)) * stride;
    return k < Sn ? tab[idx] : -tab[8192 + idx]; } };
struct BPQ { const float* PQ; int rowbase; int Sn; __device__ float operator()(int k, int n) const {
    int t = k & (Sn - 1); return PQ[(size_t)(rowbase + t) * 1024 + (k >= Sn ? 512 : 0) + n]; } };

template <class AF, class BF, class CF>
__device__ __forceinline__ void ph_gemm(AF af, BF bf, CF cf, int M, int N, int K, float* sm) {
  float (*sA)[68] = (float (*)[68])sm;
  float (*sB)[68] = (float (*)[68])(sm + 16 * 68);
  int tid = threadIdx.x; int tx = tid & 15, ty = tid >> 4;
  int ntn = N / 64; int ntiles = (M / 64) * ntn;
  GRID_LOOP(tile, ntiles) {
    int m0 = (tile / ntn) * 64, n0 = (tile % ntn) * 64;
    float acc[4][4];
#pragma unroll
    for (int i = 0; i < 4; ++i)
#pragma unroll
      for (int j = 0; j < 4; ++j) acc[i][j] = 0.f;
    for (int k0 = 0; k0 < K; k0 += 16) {
      __syncthreads();
#pragma unroll
      for (int i = 0; i < 4; ++i) { int e = tid + 256 * i; int m = e >> 4, k = e & 15; sA[k][m] = af(m0 + m, k0 + k); }
#pragma unroll
      for (int i = 0; i < 4; ++i) { int e = tid + 256 * i; int k = e >> 6, n = e & 63; sB[k][n] = bf(k0 + k, n0 + n); }
      __syncthreads();
#pragma unroll
      for (int k = 0; k < 16; ++k) {
        float a[4], b[4];
#pragma unroll
        for (int i = 0; i < 4; ++i) { a[i] = sA[k][ty * 4 + i]; b[i] = sB[k][tx * 4 + i]; }
#pragma unroll
        for (int i = 0; i < 4; ++i)
#pragma unroll
          for (int j = 0; j < 4; ++j) acc[i][j] += a[i] * b[j];
      }
    }
#pragma unroll
    for (int i = 0; i < 4; ++i)
#pragma unroll
      for (int j = 0; j < 4; ++j) cf(m0 + ty * 4 + i, n0 + tx * 4 + j, acc[i][j]);
  }
}


__device__ __forceinline__ void ph_transpose_w(const float* __restrict__ W, int K, int N, bf16_t* __restrict__ Wt, float* sm) {
  int tid = threadIdx.x;
  int tk = K / 64, tn = N / 64;
  GRID_LOOP(tile, tk * tn) {
    int k0 = (tile / tn) * 64, n0 = (tile % tn) * 64;
    __syncthreads();
#pragma unroll
    for (int i = 0; i < 16; ++i) { int e = tid + 256 * i; int k = e >> 6, n = e & 63; sm[k * 65 + n] = W[(size_t)(k0 + k) * N + n0 + n]; }
    __syncthreads();
#pragma unroll
    for (int i = 0; i < 2; ++i) {
      int e = tid + 256 * i; int n = e >> 3, kc = e & 7;
      unsigned w[4];
#pragma unroll
      for (int j = 0; j < 4; ++j) w[j] = pack2bf(sm[(kc * 8 + 2 * j) * 65 + n], sm[(kc * 8 + 2 * j + 1) * 65 + n]);
      *(uint4*)(Wt + (size_t)(n0 + n) * K + k0 + kc * 8) = make_uint4(w[0], w[1], w[2], w[3]);
    }
  }
}
__device__ __forceinline__ void ph_convert(const float* __restrict__ src, bf16_t* __restrict__ dst, size_t n8) {
  for (size_t i = (size_t)blockIdx.x * 256 + threadIdx.x; i < n8; i += (size_t)gridDim.x * 256) {
    float4 a = ((const float4*)src)[2 * i], b = ((const float4*)src)[2 * i + 1];
    ((uint4*)dst)[i] = make_uint4(pack2bf(a.x, a.y), pack2bf(a.z, a.w), pack2bf(b.x, b.y), pack2bf(b.z, b.w));
  }
}

__device__ __forceinline__ void gemm_stage(const bf16_t* __restrict__ A, int lda, int k0, char* lds, int tid) {
#pragma unroll
  for (int i = 0; i < 4; ++i) {
    int q = tid + 256 * i; int row = q >> 3, p = q & 7; int c = p ^ ((row >> 1) & 7);
    const bf16_t* src = A + (size_t)row * lda + k0 + c * 8;
    __builtin_amdgcn_global_load_lds((const unsigned*)src, (unsigned*)(lds + q * 16), 16, 0, 0);
  }
}
struct EpiF32 {
  float* C; int ldc; float scale;
  __device__ __forceinline__ void operator()(int m0, int n0, int wm, int wn, f32x16 (&acc)[2][2], int tid, char* smem) const {
    int lane = tid & 63;
    float* t = (float*)smem;
    int rbase = wm * 64 + 4 * (lane >> 5), cbase = wn * 64 + (lane & 31);
#pragma unroll
    for (int mi = 0; mi < 2; ++mi)
#pragma unroll
      for (int ni = 0; ni < 2; ++ni)
#pragma unroll
        for (int r = 0; r < 16; ++r)
          t[(rbase + mi * 32 + (r & 3) + 8 * (r >> 2)) * 128 + cbase + ni * 32] = acc[mi][ni][r] * scale;
    __syncthreads();
    float* dst = C + (size_t)(m0 + (tid >> 5)) * ldc + n0 + (tid & 31) * 4;
    const float* src = t + (tid >> 5) * 128 + (tid & 31) * 4;
#pragma unroll 4
    for (int i = 0; i < 16; ++i) {
      *(float4*)dst = *(const float4*)src;
      dst += (size_t)8 * ldc; src += 8 * 128;
    }
  }
};
struct EpiQKV0 {
  bf16_t* FQKV; bf16_t* VT;
  __device__ __forceinline__ void operator()(int m0, int n0, int wm, int wn, f32x16 (&acc)[2][2], int tid, char* smem) const {
    int lane = tid & 63;
    bf16_t* t = (bf16_t*)smem;
    int rbase = wm * 64 + 4 * (lane >> 5), cbase = wn * 64 + (lane & 31);
#pragma unroll
    for (int mi = 0; mi < 2; ++mi)
#pragma unroll
      for (int ni = 0; ni < 2; ++ni)
#pragma unroll
        for (int r = 0; r < 16; ++r)
          t[(rbase + mi * 32 + (r & 3) + 8 * (r >> 2)) * 136 + cbase + ni * 32] = (bf16_t)f2bf(acc[mi][ni][r]);
    __syncthreads();
    {
      bf16_t* dst = FQKV + (size_t)(m0 + (tid >> 4)) * 2048 + n0 + (tid & 15) * 8;
      const bf16_t* src = t + (tid >> 4) * 136 + (tid & 15) * 8;
#pragma unroll 4
      for (int i = 0; i < 8; ++i) {
        *(uint4*)dst = *(const uint4*)src;
        dst += (size_t)16 * 2048; src += 16 * 136;
      }
    }
    if (n0 >= 1536) {
      int col = tid >> 1, half = tid & 1;
      int hd = (n0 - 1536) / 64 + (col >> 6), d = col & 63;
      bf16_t* dst;
      if (m0 < T) { int b = m0 / S, t0 = m0 % S; dst = VT + (((size_t)b * 8 + hd) * 64 + d) * S + t0 + half * 64; }
      else { int mm = m0 - T; int b = mm / CL, l0 = mm % CL; dst = VT + (size_t)NB * 8 * 64 * S + (((size_t)b * 8 + hd) * 64 + d) * CL + l0 + half * 64; }
      const bf16_t* src = t + (half * 64) * 136 + col;
#pragma unroll
      for (int i = 0; i < 8; ++i) {
        unsigned wv[4];
#pragma unroll
        for (int j = 0; j < 4; ++j) wv[j] = (unsigned)src[(i * 8 + 2 * j) * 136] | ((unsigned)src[(i * 8 + 2 * j + 1) * 136] << 16);
        *(uint4*)(dst + i * 8) = make_uint4(wv[0], wv[1], wv[2], wv[3]);
      }
    }
  }
};
struct EpiBf16 {
  bf16_t* C; int ldc;
  __device__ __forceinline__ void operator()(int m0, int n0, int wm, int wn, f32x16 (&acc)[2][2], int tid, char* smem) const {
    int lane = tid & 63;
    asm volatile("" : "+v"(lane));
    bf16_t* t = (bf16_t*)smem;
    {
      bf16_t* tw = t + (wm * 64 + 4 * (lane >> 5)) * 136 + wn * 64 + (lane & 31);
#pragma unroll
      for (int mi = 0; mi < 2; ++mi)
#pragma unroll
        for (int ni = 0; ni < 2; ++ni)
#pragma unroll
          for (int r = 0; r < 16; ++r)
            tw[(mi * 32 + (r & 3) + 8 * (r >> 2)) * 136 + ni * 32] = (bf16_t)f2bf(acc[mi][ni][r]);
    }
    __syncthreads();
    bf16_t* dst = C + (size_t)(m0 + (tid >> 4)) * ldc + n0 + (tid & 15) * 8;
    const bf16_t* src = t + (tid >> 4) * 136 + (tid & 15) * 8;
#pragma unroll 4
    for (int i = 0; i < 8; ++i) {
      *(uint4*)dst = *(const uint4*)src;
      dst += (size_t)16 * ldc; src += 16 * 136;
    }
  }
};
struct EpiQKV1 {
  bf16_t* Q1; bf16_t* K1; bf16_t* VT; const float* RT;
  __device__ __forceinline__ void operator()(int m0, int n0, int wm, int wn, f32x16 (&acc)[2][2], int tid, char* smem) const {
    int lane = tid & 63;
    asm volatile("" : "+v"(lane));
    bf16_t* t = (bf16_t*)smem;
    if (n0 < 1280 && m0 < T) {
      int i = lane & 31; int f = i & 15;
#pragma unroll
      for (int mi = 0; mi < 2; ++mi)
#pragma unroll
        for (int r = 0; r < 16; ++r) {
          int row = m0 + wm * 64 + 4 * (lane >> 5) + mi * 32 + (r & 3) + 8 * (r >> 2);
          int tt = row & (S - 1);
          int pos = (i < 16) ? (tt >> 6) : (tt & 63);
          float2 cs = *(const float2*)(RT + 2 * (pos * 16 + f));
          float x1 = acc[mi][0][r], x2 = acc[mi][1][r];
          acc[mi][0][r] = x1 * cs.x - x2 * cs.y;
          acc[mi][1][r] = x1 * cs.y + x2 * cs.x;
        }
    }
    {
      bf16_t* tw = t + (wm * 64 + 4 * (lane >> 5)) * 136 + wn * 64 + (lane & 31);
#pragma unroll
      for (int mi = 0; mi < 2; ++mi)
#pragma unroll
        for (int ni = 0; ni < 2; ++ni)
#pragma unroll
          for (int r = 0; r < 16; ++r)
            tw[(mi * 32 + (r & 3) + 8 * (r >> 2)) * 136 + ni * 32] = (bf16_t)f2bf(acc[mi][ni][r]);
    }
    __syncthreads();
    if (n0 < 1280) {
      bf16_t* dst; int ld;
      if (n0 < 1024) { dst = Q1 + (size_t)(m0 + (tid >> 4)) * 1024 + n0 + (tid & 15) * 8; ld = 1024; }
      else { dst = K1 + (size_t)(m0 + (tid >> 4)) * 256 + (n0 - 1024) + (tid & 15) * 8; ld = 256; }
      if (n0 >= 1024 || m0 < T) {
        const bf16_t* src = t + (tid >> 4) * 136 + (tid & 15) * 8;
#pragma unroll 4
        for (int i = 0; i < 8; ++i) {
          *(uint4*)dst = *(const uint4*)src;
          dst += (size_t)16 * ld; src += 16 * 136;
        }
      }
    } else {
      int col = tid >> 1, half = tid & 1;
      int hd = (n0 - 1280) / 64 + (col >> 6), d = col & 63;
      bf16_t* dst;
      if (m0 < T) { int b = m0 / S, t0 = m0 % S; dst = VT + (((size_t)b * 4 + hd) * 64 + d) * S + t0 + half * 64; }
      else { int mm = m0 - T; int b = mm / CL, l0 = mm % CL; dst = VT + (size_t)NB * 4 * 64 * S + (((size_t)b * 4 + hd) * 64 + d) * CL + l0 + half * 64; }
      const bf16_t* src = t + (half * 64) * 136 + col;
#pragma unroll
      for (int i = 0; i < 8; ++i) {
        unsigned wv[4];
#pragma unroll
        for (int j = 0; j < 4; ++j) wv[j] = (unsigned)src[(i * 8 + 2 * j) * 136] | ((unsigned)src[(i * 8 + 2 * j + 1) * 136] << 16);
        *(uint4*)(dst + i * 8) = make_uint4(wv[0], wv[1], wv[2], wv[3]);
      }
    }
  }
};
__device__ __forceinline__ void gemm_tile_mainloop3(const bf16_t* __restrict__ Ag, int lda, const bf16_t* __restrict__ Bg, int ldb, int KT,
                                                    f32x16 (&acc)[2][2], char* smem);
#ifndef GEMM_ML
#define GEMM_ML 2
#endif
__device__ __forceinline__ void gemm_tile_mainloop(const bf16_t* __restrict__ Ag, int lda, const bf16_t* __restrict__ Bg, int ldb, int KT,
                                                   f32x16 (&acc)[2][2], char* smem) {
  if (GEMM_ML == 3) { gemm_tile_mainloop3(Ag, lda, Bg, ldb, 2 * KT, acc, smem); return; }
  int tid = threadIdx.x;
  asm volatile("" : "+v"(tid));
  int lane = tid & 63, wave = __builtin_amdgcn_readfirstlane(tid >> 6), wm = wave >> 1, wn = wave & 1;
#pragma unroll
  for (int mi = 0; mi < 2; ++mi)
#pragma unroll
    for (int ni = 0; ni < 2; ++ni)
#pragma unroll
      for (int r = 0; r < 16; ++r) acc[mi][ni][r] = 0.f;
  __syncthreads();
  const int ks = (int)(blockIdx.x >> 3) & (KT - 1);
  gemm_stage(Ag, lda, ks * 64, smem, tid); gemm_stage(Bg, ldb, ks * 64, smem + 16384, tid);
  for (int kt = 0; kt < KT; ++kt) {
    asm volatile("s_waitcnt vmcnt(0)" ::: "memory");
    __syncthreads();
    char* cur = smem + (kt & 1) * 32768;
    char* nxt = smem + ((kt + 1) & 1) * 32768;
    const int kn = ((kt + 1 + ks) & (KT - 1)) * 64;
    const bool more = kt + 1 < KT;
#pragma unroll
    for (int s4 = 0; s4 < 4; ++s4) {
      bf16x8 a[2], b[2];
      int c = 2 * s4 + (lane >> 5);
#pragma unroll
      for (int mi = 0; mi < 2; ++mi) { int row = wm * 64 + mi * 32 + (lane & 31); a[mi] = *(const bf16x8*)(cur + row * 128 + ((c ^ ((row >> 1) & 7)) << 4)); }
#pragma unroll
      for (int ni = 0; ni < 2; ++ni) { int row = wn * 64 + ni * 32 + (lane & 31); b[ni] = *(const bf16x8*)(cur + 16384 + row * 128 + ((c ^ ((row >> 1) & 7)) << 4)); }
      if (more) {
        int q = tid + 256 * s4; int row = q >> 3, p = q & 7; int cc = p ^ ((row >> 1) & 7);
        __builtin_amdgcn_global_load_lds((const unsigned*)(Ag + (size_t)row * lda + kn + cc * 8), (unsigned*)(nxt + q * 16), 16, 0, 0);
        __builtin_amdgcn_global_load_lds((const unsigned*)(Bg + (size_t)row * ldb + kn + cc * 8), (unsigned*)(nxt + 16384 + q * 16), 16, 0, 0);
      }
#pragma unroll
      for (int mi = 0; mi < 2; ++mi)
#pragma unroll
        for (int ni = 0; ni < 2; ++ni) acc[mi][ni] = __builtin_amdgcn_mfma_f32_32x32x16_bf16(a[mi], b[ni], acc[mi][ni], 0, 0, 0);
      __builtin_amdgcn_sched_barrier(0);
    }
  }
  __syncthreads();
}
#ifdef GPROBE
template <int MODE>
__device__ __forceinline__ void ph_gemm_probe(const bf16_t* __restrict__ A, int lda, const bf16_t* __restrict__ Bt, int ldb, int M, int N, int K, float* dummy, char* smem) {
  int tid = threadIdx.x;
  int lane = tid & 63, wave = __builtin_amdgcn_readfirstlane(tid >> 6), wm = wave >> 1, wn = wave & 1;
  int ntn = N / 128, KT = K / 64;
  int nb8 = gridDim.x >> 3, xq = blockIdx.x & 7, xm = xq >> 1, xn = xq & 1;
  int MT = M / 128, mq = (MT + 3) >> 2, nh = ntn >> 1;
  for (int lt = (int)(blockIdx.x >> 3); lt < mq * nh; lt += nb8) {
    int mt = xm * mq + lt / nh, nt = xn * nh + lt % nh;
    if (mt >= MT) continue;
    const bf16_t* Ag = A + (size_t)mt * 128 * lda; const bf16_t* Bg = Bt + (size_t)nt * 128 * ldb;
    f32x16 acc[2][2];
#pragma unroll
    for (int mi = 0; mi < 2; ++mi)
#pragma unroll
      for (int ni = 0; ni < 2; ++ni)
#pragma unroll
        for (int r = 0; r < 16; ++r) acc[mi][ni][r] = 0.f;
    __syncthreads();
    if (MODE & 1) { gemm_stage(Ag, lda, 0, smem, tid); gemm_stage(Bg, ldb, 0, smem + 16384, tid); }
    for (int kt = 0; kt < KT; ++kt) {
      asm volatile("s_waitcnt vmcnt(0)" ::: "memory");
      __syncthreads();
      char* cur = smem + (kt & 1) * 32768;
      if ((MODE & 1) && kt + 1 < KT) {
        char* nxt = smem + ((kt + 1) & 1) * 32768;
        gemm_stage(Ag, lda, (kt + 1) * 64, nxt, tid); gemm_stage(Bg, ldb, (kt + 1) * 64, nxt + 16384, tid);
      }
      if (MODE & 2) {
#pragma unroll
        for (int s4 = 0; s4 < 4; ++s4) {
          bf16x8 a[2], b[2];
          int c = 2 * s4 + (lane >> 5);
#pragma unroll
          for (int mi = 0; mi < 2; ++mi) { int row = wm * 64 + mi * 32 + (lane & 31); a[mi] = *(const bf16x8*)(cur + row * 128 + ((c ^ ((row >> 1) & 7)) << 4)); }
#pragma unroll
          for (int ni = 0; ni < 2; ++ni) { int row = wn * 64 + ni * 32 + (lane & 31); b[ni] = *(const bf16x8*)(cur + 16384 + row * 128 + ((c ^ ((row >> 1) & 7)) << 4)); }
#pragma unroll
          for (int mi = 0; mi < 2; ++mi)
#pragma unroll
            for (int ni = 0; ni < 2; ++ni) acc[mi][ni] = __builtin_amdgcn_mfma_f32_32x32x16_bf16(a[mi], b[ni], acc[mi][ni], 0, 0, 0);
        }
      }
    }
    __syncthreads();
    float sum = 0.f;
#pragma unroll
    for (int mi = 0; mi < 2; ++mi)
#pragma unroll
      for (int ni = 0; ni < 2; ++ni)
#pragma unroll
        for (int r = 0; r < 16; ++r) sum += acc[mi][ni][r];
    if (sum == 12345.678f) dummy[tid] = sum;
  }
}
#endif
template <class Epi>
__device__ __forceinline__ void ph_gemm_bf16(const bf16_t* __restrict__ A, int lda, const bf16_t* __restrict__ Bt, int ldb, int M, int N, int K,
                             Epi epi, char* smem) {
  int tid = threadIdx.x, wave = __builtin_amdgcn_readfirstlane(tid >> 6), wm = wave >> 1, wn = wave & 1;
  int ntn = N / 128, ntiles = (M / 128) * ntn;
  int KT = K / 64;
  (void)ntiles;
  int nb8 = gridDim.x >> 3, xq = blockIdx.x & 7, xm = xq >> 1, xn = xq & 1;
  int MT = M / 128, mq = (MT + 3) >> 2, nh = ntn >> 1;
  for (int lt = (int)(blockIdx.x >> 3); lt < mq * nh; lt += nb8) {
    int mt = xm * mq + lt / nh, nt = xn * nh + lt % nh;
    if (mt >= MT) continue;
    f32x16 acc[2][2];
    gemm_tile_mainloop(A + (size_t)mt * 128 * lda, lda, Bt + (size_t)nt * 128 * ldb, ldb, KT, acc, smem);
    epi(mt * 128, nt * 128, wm, wn, acc, tid, smem);
  }
}


#define RAW_BARRIER() do { asm volatile("s_waitcnt lgkmcnt(0)" ::: "memory"); __builtin_amdgcn_s_barrier(); } while (0)
__device__ __forceinline__ void gemm_stage32x(const bf16_t* __restrict__ Ag, int lda, const bf16_t* __restrict__ Bg, int ldb, int k0, char* lds, int tid) {
#pragma unroll
  for (int i = 0; i < 2; ++i) { int q = tid + 256 * i; int row = q >> 2, p = q & 3; int c = p ^ ((row >> 2) & 3);
    __builtin_amdgcn_global_load_lds((const unsigned*)(Ag + (size_t)row * lda + k0 + c * 8), (unsigned*)(lds + q * 16), 16, 0, 0); }
#pragma unroll
  for (int i = 0; i < 2; ++i) { int q = tid + 256 * i; int row = q >> 2, p = q & 3; int c = p ^ ((row >> 2) & 3);
    __builtin_amdgcn_global_load_lds((const unsigned*)(Bg + (size_t)row * ldb + k0 + c * 8), (unsigned*)(lds + 8192 + q * 16), 16, 0, 0); }
}
__device__ __forceinline__ void gemm_tile_mainloop3(const bf16_t* __restrict__ Ag, int lda, const bf16_t* __restrict__ Bg, int ldb, int KT,
                                                    f32x16 (&acc)[2][2], char* smem) {
  int tid = threadIdx.x;
  asm volatile("" : "+v"(tid));
  int lane = tid & 63, wave = tid >> 6, wm = wave >> 1, wn = wave & 1;
#pragma unroll
  for (int mi = 0; mi < 2; ++mi)
#pragma unroll
    for (int ni = 0; ni < 2; ++ni)
#pragma unroll
      for (int r = 0; r < 16; ++r) acc[mi][ni][r] = 0.f;
  __syncthreads();
  gemm_stage32x(Ag, lda, Bg, ldb, 0, smem, tid);
  gemm_stage32x(Ag, lda, Bg, ldb, 32, smem + 16384, tid);
  gemm_stage32x(Ag, lda, Bg, ldb, 64, smem + 32768, tid);
  for (int kt = 0; kt < KT; ++kt) {
    if (kt + 2 < KT) asm volatile("s_waitcnt vmcnt(8)" ::: "memory");
    else if (kt + 1 < KT) asm volatile("s_waitcnt vmcnt(4)" ::: "memory");
    else asm volatile("s_waitcnt vmcnt(0)" ::: "memory");
    RAW_BARRIER();
    if (kt + 3 < KT) gemm_stage32x(Ag, lda, Bg, ldb, (kt + 3) * 32, smem + ((kt + 3) & 3) * 16384, tid);
    char* cur = smem + (kt & 3) * 16384;
#pragma unroll
    for (int s2 = 0; s2 < 2; ++s2) {
      bf16x8 a[2], b[2];
      int c = 2 * s2 + (lane >> 5);
#pragma unroll
      for (int mi = 0; mi < 2; ++mi) { int row = wm * 64 + mi * 32 + (lane & 31); a[mi] = *(const bf16x8*)(cur + row * 64 + ((c ^ ((row >> 2) & 3)) << 4)); }
#pragma unroll
      for (int ni = 0; ni < 2; ++ni) { int row = wn * 64 + ni * 32 + (lane & 31); b[ni] = *(const bf16x8*)(cur + 8192 + row * 64 + ((c ^ ((row >> 2) & 3)) << 4)); }
#pragma unroll
      for (int mi = 0; mi < 2; ++mi)
#pragma unroll
        for (int ni = 0; ni < 2; ++ni) acc[mi][ni] = __builtin_amdgcn_mfma_f32_32x32x16_bf16(a[mi], b[ni], acc[mi][ni], 0, 0, 0);
    }
  }
  __syncthreads();
}
template <class Epi>
__device__ __forceinline__ void ph_gemm_bf16_3(const bf16_t* __restrict__ A, int lda, const bf16_t* __restrict__ Bt, int ldb, int M, int N, int K,
                             Epi epi, char* smem) {
  int tid = threadIdx.x, wave = __builtin_amdgcn_readfirstlane(tid >> 6), wm = wave >> 1, wn = wave & 1;
  int ntn = N / 128, ntiles = (M / 128) * ntn;
  GRID_LOOP(tile, ntiles) {
    int mt = tile / ntn, nt = tile % ntn;
    f32x16 acc[2][2];
    gemm_tile_mainloop3(A + (size_t)mt * 128 * lda, lda, Bt + (size_t)nt * 128 * ldb, ldb, K / 32, acc, smem);
    epi(mt * 128, nt * 128, wm, wn, acc, tid, smem);
  }
}
__device__ __forceinline__ void ins16(float (&L)[16], float x) {
#pragma unroll
  for (int j = 15; j >= 1; --j) L[j] = __builtin_amdgcn_fmed3f(L[j - 1], L[j], x);
  L[0] = fmaxf(L[0], x);
}
__device__ __forceinline__ void stage_tile128(const bf16_t* __restrict__ src, int ld, char* lds, int tid) {
#pragma unroll
  for (int i = 0; i < 8; ++i) {
    int q = tid + 256 * i; int row = q >> 4, p = q & 15; int c = p ^ (row & 15);
    __builtin_amdgcn_global_load_lds((const unsigned*)(src + (size_t)row * ld + c * 8), (unsigned*)(lds + q * 16), 16, 0, 0);
  }
}
__device__ __forceinline__ void ph_peer_select(const bf16_t* __restrict__ H, const bf16_t* __restrict__ WQl, const bf16_t* __restrict__ SKl,
                                               int* __restrict__ EXP, float* __restrict__ GATE, int nrows, char* smem) {
  int tid = threadIdx.x, w = __builtin_amdgcn_readfirstlane(tid >> 6), wm = w >> 1, wn = w & 1;
  bf16_t* Qs = (bf16_t*)smem;
  int* KL = (int*)(smem + 36864);
  int nb8 = gridDim.x >> 3, xq = blockIdx.x & 7, xm = xq >> 1, xn = xq & 1;
  int MT = nrows / 128, mq = (MT + 3) >> 2;
  for (int lu = (int)(blockIdx.x >> 3); lu < mq * 4; lu += nb8) {
    int mt = xm * mq + (lu >> 2), h = xn * 4 + (lu & 3);
    if (mt >= MT) continue;
    float L0[16], L1[16];
#pragma unroll
    for (int p = 0; p < 2; ++p) {
      f32x16 acc[2][2];
      gemm_tile_mainloop(H + (size_t)mt * 128 * 1024, 1024, WQl + (size_t)(h * 256 + p * 128) * 1024, 1024, 16, acc, smem);
      int lane = tid & 63;
      asm volatile("" : "+v"(lane));
      {
        bf16_t* qw = Qs + (wm * 64 + 4 * (lane >> 5)) * 136 + wn * 64 + (lane & 31);
#pragma unroll
        for (int mi = 0; mi < 2; ++mi)
#pragma unroll
          for (int ni = 0; ni < 2; ++ni)
#pragma unroll
            for (int r = 0; r < 16; ++r)
              qw[(mi * 32 + (r & 3) + 8 * (r >> 2)) * 136 + ni * 32] = (bf16_t)f2bf(acc[mi][ni][r]);
      }
      __syncthreads();
      f32x16 sc[4];
#pragma unroll
      for (int m4 = 0; m4 < 4; ++m4)
#pragma unroll
        for (int r = 0; r < 16; ++r) sc[m4][r] = 0.f;
      {
        const bf16_t* qrow = Qs + (32 * w + (lane & 31)) * 136 + 8 * (lane >> 5);
        const bf16_t* krow = SKl + (size_t)(h * 2 + p) * 128 * 128 + (lane & 31) * 128 + 8 * (lane >> 5);
#pragma unroll
        for (int s8 = 0; s8 < 8; ++s8) {
          bf16x8 bq = *(const bf16x8*)(qrow + 16 * s8);
#pragma unroll
          for (int m4 = 0; m4 < 4; ++m4) {
            bf16x8 ak = *(const bf16x8*)(krow + m4 * 32 * 128 + 16 * s8);
            sc[m4] = __builtin_amdgcn_mfma_f32_32x32x16_bf16(ak, bq, sc[m4], 0, 0, 0);
          }
        }
      }
      float L[16];
#pragma unroll
      for (int j = 0; j < 16; ++j) L[j] = -INFINITY;
      unsigned kb = 4u * (unsigned)(lane >> 5);
#pragma unroll
      for (int m4 = 0; m4 < 4; ++m4)
#pragma unroll
        for (int r = 0; r < 16; ++r) {
          unsigned key = kb + (unsigned)(32 * m4 + (r & 3) + 8 * (r >> 2));
          float x = __uint_as_float((__float_as_uint(sc[m4][r]) & 0xFFFFFF80u) | key);
          ins16(L, x);
        }
      float P[16];
#pragma unroll
      for (int j = 0; j < 16; ++j) P[j] = __shfl_xor(L[j], 32);
#pragma unroll
      for (int j = 0; j < 16; ++j) ins16(L, P[j]);
      if (p == 0) {
#pragma unroll
        for (int j = 0; j < 16; ++j) L0[j] = L[j];
      } else {
#pragma unroll
        for (int j = 0; j < 16; ++j) L1[j] = L[j];
      }
    }
    float C[16];
#pragma unroll
    for (int j = 0; j < 16; ++j) C[j] = -INFINITY;
#pragma unroll
    for (int a = 0; a < 16; ++a)
#pragma unroll
      for (int b = 0; b < 16; ++b)
        if ((a + 1) * (b + 1) <= 16) {
          float sa = __uint_as_float(__float_as_uint(L0[a]) & 0xFFFFFF80u);
          float sb = __uint_as_float(__float_as_uint(L1[b]) & 0xFFFFFF80u);
          float x = __uint_as_float((__float_as_uint(sa + sb) & 0xFFFFFF00u) | (unsigned)(a * 16 + b));
          ins16(C, x);
        }
    int lane = tid & 63;
    asm volatile("" : "+v"(lane));
    int token = 32 * w + (lane & 31);
    if (lane < 32) {
#pragma unroll
      for (int j = 0; j < 16; ++j) { KL[token * 32 + j] = (int)(__float_as_uint(L0[j]) & 0x7Fu); KL[token * 32 + 16 + j] = (int)(__float_as_uint(L1[j]) & 0x7Fu); }
    }
    __syncthreads();
    if (lane < 32) {
      float c0 = __uint_as_float(__float_as_uint(C[0]) & 0xFFFFFF00u);
      float ev[16]; float sum = 0.f; int ex[16];
#pragma unroll
      for (int j = 0; j < 16; ++j) {
        unsigned bits = __float_as_uint(C[j]);
        float cv = __uint_as_float(bits & 0xFFFFFF00u);
        ev[j] = __expf(cv - c0); sum += ev[j];
        int a = (bits >> 4) & 15, b = bits & 15;
        ex[j] = KL[token * 32 + a] * 128 + KL[token * 32 + 16 + b];
      }
      float inv = 1.f / sum;
      size_t o = (size_t)(mt * 128 + token) * 128 + h * 16;
#pragma unroll
      for (int j = 0; j < 16; j += 4) {
        *(int4*)(EXP + o + j) = make_int4(ex[j], ex[j + 1], ex[j + 2], ex[j + 3]);
        *(float4*)(GATE + o + j) = make_float4(ev[j] * inv, ev[j + 1] * inv, ev[j + 2] * inv, ev[j + 3] * inv);
      }
    }
  }
}

__device__ __forceinline__ void fft1_unit(int u, const bf16_t* __restrict__ FQKV, const bf16_t* __restrict__ D1, const float* __restrict__ TAB,
                          bf16_t* __restrict__ A1, char* smem) {
  int tid = threadIdx.x, lane = tid & 63, w = __builtin_amdgcn_readfirstlane(tid >> 6);
  int g = u & 7, c = (u >> 3) & 63, b = u >> 9;
  bf16_t* Bt = (bf16_t*)smem;
  __syncthreads();
  {
    int r = tid >> 1, half = tid & 1;
    const uint4* src = (const uint4*)(FQKV + (size_t)(b * S + 64 * r + c) * 2048 + g * 64 + half * 32);
    unsigned wv[16];
#pragma unroll
    for (int i = 0; i < 4; ++i) { uint4 v = src[i]; wv[4 * i] = v.x; wv[4 * i + 1] = v.y; wv[4 * i + 2] = v.z; wv[4 * i + 3] = v.w; }
#pragma unroll
    for (int j = 0; j < 32; ++j) {
      unsigned e = (j & 1) ? (wv[j >> 1] >> 16) : (wv[j >> 1] & 0xffffu);
      Bt[(half * 32 + j) * 136 + r] = (bf16_t)e;
    }
  }
  __syncthreads();
  f32x16 acc[2][2];
#pragma unroll
  for (int mi = 0; mi < 2; ++mi)
#pragma unroll
    for (int ni = 0; ni < 2; ++ni)
#pragma unroll
      for (int r = 0; r < 16; ++r) acc[mi][ni][r] = 0.f;
#pragma unroll
  for (int s8 = 0; s8 < 8; ++s8) {
    bf16x8 a[2], bb[2];
    int ko = 16 * s8 + 8 * (lane >> 5);
#pragma unroll
    for (int mi = 0; mi < 2; ++mi) a[mi] = *(const bf16x8*)(D1 + (64 * w + 32 * mi + (lane & 31)) * 128 + ko);
#pragma unroll
    for (int ni = 0; ni < 2; ++ni) bb[ni] = *(const bf16x8*)(Bt + (32 * ni + (lane & 31)) * 136 + ko);
#pragma unroll
    for (int mi = 0; mi < 2; ++mi)
#pragma unroll
      for (int ni = 0; ni < 2; ++ni) acc[mi][ni] = __builtin_amdgcn_mfma_f32_32x32x16_bf16(a[mi], bb[ni], acc[mi][ni], 0, 0, 0);
  }
  bf16_t* Ot = (bf16_t*)(smem + 17408);
#pragma unroll
  for (int mi = 0; mi < 2; ++mi)
#pragma unroll
    for (int j = 0; j < 8; ++j) {
      int m = 64 * w + 32 * mi + ((2 * j) & 3) + 8 * ((2 * j) >> 2) + 4 * (lane >> 5);
      int k1 = m >> 1;
      int idx = (k1 * c) & 8191;
      float cs = TAB[idx], sn = TAB[8192 + idx];
#pragma unroll
      for (int ni = 0; ni < 2; ++ni) {
        float re = acc[mi][ni][2 * j], im = acc[mi][ni][2 * j + 1];
        float re2 = re * cs + im * sn, im2 = im * cs - re * sn;
        bf16_t* dst = Ot + m * 72 + 32 * ni + (lane & 31);
        dst[0] = (bf16_t)f2bf(re2); dst[72] = (bf16_t)f2bf(im2);
      }
    }
  __syncthreads();
  {
    bf16_t* base = A1 + (((size_t)b * 64 + c) * 128) * 2 * 512 + g * 64;
#pragma unroll
    for (int i = 0; i < 8; ++i) {
      int q = tid + 256 * i; int m = q >> 3, ch8 = q & 7;
      *(uint4*)(base + (size_t)m * 512 + ch8 * 8) = *(const uint4*)(Ot + m * 72 + ch8 * 8);
    }
  }
}

__device__ __forceinline__ void fft3_unit(int u, int mode, const bf16_t* __restrict__ FQKV, const bf16_t* __restrict__ A1, const bf16_t* __restrict__ D3,
                          const bf16_t* __restrict__ DcT, const float* __restrict__ TAB, bf16_t* __restrict__ MIX, char* smem) {
  int tid = threadIdx.x, lane = tid & 63, w = __builtin_amdgcn_readfirstlane(tid >> 6);
  bf16_t* Bt = (bf16_t*)smem;
  bf16_t* Xs = (bf16_t*)(smem + 17408);
  int g = u & 7, k1, b, nk1, rowbase; float norm;
  __syncthreads();
  if (mode == 0) {
    k1 = (u >> 3) & 127; b = u >> 10; nk1 = 128; rowbase = b * S; norm = 1.f / 724.0773439350247f;
    int kk = tid >> 1, half = tid & 1; int c = kk >> 1, ri = kk & 1;
    const uint4* src = (const uint4*)(A1 + ((((size_t)b * 64 + c) * 128 + k1) * 2 + ri) * 512 + g * 64 + half * 32);
    unsigned wv[16];
#pragma unroll
    for (int i = 0; i < 4; ++i) { uint4 v = src[i]; wv[4 * i] = v.x; wv[4 * i + 1] = v.y; wv[4 * i + 2] = v.z; wv[4 * i + 3] = v.w; }
#pragma unroll
    for (int j = 0; j < 32; ++j) {
      unsigned e = (j & 1) ? (wv[j >> 1] >> 16) : (wv[j >> 1] & 0xffffu);
      Bt[(half * 32 + j) * 136 + kk] = (bf16_t)e;
    }
  } else {
    k1 = (u >> 3) & 3; b = u >> 5; nk1 = 4; rowbase = T + b * CL; norm = 1.f / 128.f;
    int c = tid >> 2, q4 = tid & 3;
    float re[16], im[16];
#pragma unroll
    for (int j = 0; j < 16; ++j) { re[j] = 0.f; im[j] = 0.f; }
#pragma unroll
    for (int r = 0; r < 4; ++r) {
      const uint4* src = (const uint4*)(FQKV + (size_t)(rowbase + 64 * r + c) * 2048 + g * 64 + q4 * 16);
      uint4 v0 = src[0], v1 = src[1];
      unsigned wv[8] = {v0.x, v0.y, v0.z, v0.w, v1.x, v1.y, v1.z, v1.w};
      int ph = (k1 * r) & 3;
      float cr = (ph == 0) ? 1.f : (ph == 2 ? -1.f : 0.f);
      float ci = (ph == 1) ? -1.f : (ph == 3 ? 1.f : 0.f);
#pragma unroll
      for (int j = 0; j < 16; ++j) {
        float x = bf2f((unsigned short)((j & 1) ? (wv[j >> 1] >> 16) : (wv[j >> 1] & 0xffffu)));
        re[j] += x * cr; im[j] += x * ci;
      }
    }
    int idx = (k1 * c * 32) & 8191;
    float cs = TAB[idx], sn = TAB[8192 + idx];
#pragma unroll
    for (int j = 0; j < 16; ++j) {
      float re2 = re[j] * cs + im[j] * sn, im2 = im[j] * cs - re[j] * sn;
      *(unsigned*)(Bt + (q4 * 16 + j) * 136 + 2 * c) = pack2bf(re2, im2);
    }
  }
  __syncthreads();
  {
    f32x16 acc[2];
#pragma unroll
    for (int ni = 0; ni < 2; ++ni)
#pragma unroll
      for (int r = 0; r < 16; ++r) acc[ni][r] = 0.f;
#pragma unroll
    for (int s8 = 0; s8 < 8; ++s8) {
      int ko = 16 * s8 + 8 * (lane >> 5);
      bf16x8 a = *(const bf16x8*)(D3 + (32 * w + (lane & 31)) * 128 + ko);
#pragma unroll
      for (int ni = 0; ni < 2; ++ni) {
        bf16x8 bb = *(const bf16x8*)(Bt + (32 * ni + (lane & 31)) * 136 + ko);
        acc[ni] = __builtin_amdgcn_mfma_f32_32x32x16_bf16(a, bb, acc[ni], 0, 0, 0);
      }
    }
#pragma unroll
    for (int ni = 0; ni < 2; ++ni)
#pragma unroll
      for (int r = 0; r < 16; ++r) {
        int m = 32 * w + (r & 3) + 8 * (r >> 2) + 4 * (lane >> 5);
        Xs[(m & 63) * 136 + (m >> 6) * 64 + 32 * ni + (lane & 31)] = (bf16_t)f2bf(acc[ni][r]);
      }
  }
  __syncthreads();
  {
    int mi = w >> 1, ni = w & 1;
    f32x16 acc;
#pragma unroll
    for (int r = 0; r < 16; ++r) acc[r] = 0.f;
#pragma unroll
    for (int s8 = 0; s8 < 8; ++s8) {
      int ko = 16 * s8 + 8 * (lane >> 5);
      bf16x8 a = *(const bf16x8*)(Xs + (32 * mi + (lane & 31)) * 136 + ko);
      bf16x8 bb = *(const bf16x8*)(DcT + (32 * ni + (lane & 31)) * 128 + ko);
      acc = __builtin_amdgcn_mfma_f32_32x32x16_bf16(a, bb, acc, 0, 0, 0);
    }
    bf16_t* Yt = Bt;
#pragma unroll
    for (int r = 0; r < 16; ++r) {
      int k2 = 32 * mi + (r & 3) + 8 * (r >> 2) + 4 * (lane >> 5);
      Yt[k2 * 72 + 32 * ni + (lane & 31)] = (bf16_t)f2bf(acc[r] * norm);
    }
  }
  __syncthreads();
#pragma unroll
  for (int i = 0; i < 2; ++i) {
    int q = tid + 256 * i; int k2 = q >> 3, ch8 = q & 7;
    int row = rowbase + k1 + nk1 * k2;
    *(uint4*)(MIX + (size_t)row * 1024 + g * 64 + ch8 * 8) = *(const uint4*)((const bf16_t*)smem + k2 * 72 + ch8 * 8);
  }
}

typedef __attribute__((ext_vector_type(4))) float f32x4_t;
__device__ __forceinline__ bf16x8 ld16(const bf16_t* p) { return *(const bf16x8*)p; }
__device__ __forceinline__ float fast_exp2(float x) { return __builtin_amdgcn_exp2f(x); }

template <int NH, int MODE, int KPI, bool PF>
__device__ __forceinline__ void attn_unit(int b, int hk, int r, int jb, int qb, const bf16_t* __restrict__ Qp, int ldq, const bf16_t* __restrict__ Kp, int ldk,
                                          const bf16_t* __restrict__ VTl, const bf16_t* __restrict__ VTc, int nkvh,
                                          const float* rpbs, const float* __restrict__ sink,
                                          bf16_t* __restrict__ Op, int ldo, int lane) {
  const float LOG2E = 1.4426950408889634f;
  const float SC = 0.125f * LOG2E;
  asm volatile("" : "+v"(lane));
  int ql = lane & 15, g = lane >> 4;
  int qrow0, q0 = 0;
  int nloc, lb0 = 0;
  if (MODE == 0) { qrow0 = b * S + r * 64 + 16 * jb; nloc = 8; }
  else if (MODE == 1) { qrow0 = T + b * CL + 16 * qb; nloc = 0; }
  else { q0 = 16 * qb; qrow0 = b * S + q0;
         int lo = (q0 - 128) >> 5, hi = (q0 + 143) >> 5; if (lo < 0) lo = 0; if (hi > 255) hi = 255; lb0 = lo; nloc = hi - lo + 1; }
  bf16x8 qf[NH][2];
#pragma unroll
  for (int hh = 0; hh < NH; ++hh)
#pragma unroll
    for (int s2 = 0; s2 < 2; ++s2)
      qf[hh][s2] = ld16(Qp + (size_t)(qrow0 + ql) * ldq + (hk * NH + hh) * 64 + 32 * s2 + 8 * g);
  f32x4_t o[NH][4]; float mrun[NH], lrun[NH];
#pragma unroll
  for (int hh = 0; hh < NH; ++hh) {
    mrun[hh] = -1e30f; lrun[hh] = 0.f;
#pragma unroll
    for (int dt = 0; dt < 4; ++dt) o[hh][dt] = (f32x4_t){0.f, 0.f, 0.f, 0.f};
  }
  int r_start = 0, blk_start = 0, c_lo = 0, qc = 0;
  if (MODE == 0) {
    r_start = min(max(r - 4, 0), 120);
    blk_start = min(max(16 * jb - 8, 0), 32);
    qc = 16 * jb + ql; c_lo = min(max(qc - 8, 0), 48);
  }
  if (MODE == 2 && KPI == 2) nloc = (nloc + 1) & ~1;
  int nit = (nloc + 8) / KPI;
#define ATT_DESC(kbx, krow0_, vtp_, vld_) \
    { bool il_ = (kbx) < nloc; int vt0_; \
      if (il_) { if (MODE == 0) { int rr_ = r_start + (kbx); krow0_ = b * S + rr_ * 64 + blk_start; vt0_ = rr_ * 64 + blk_start; } \
                 else { krow0_ = b * S + 32 * (lb0 + (kbx)); vt0_ = 32 * (lb0 + (kbx)); } \
                 vtp_ = VTl + ((size_t)(b * nkvh + hk) * 64) * S + vt0_; vld_ = S; } \
      else { int cb_ = (kbx) - nloc; krow0_ = T + b * CL + 32 * cb_; vt0_ = 32 * cb_; \
             vtp_ = VTc + ((size_t)(b * nkvh + hk) * 64) * CL + vt0_; vld_ = CL; } }
#define ATT_LOAD(kbx, KF, VF) \
    { int krow0; const bf16_t* vt; int vld; ATT_DESC(kbx, krow0, vt, vld) \
      _Pragma("unroll") for (int t = 0; t < 2; ++t) _Pragma("unroll") for (int s2 = 0; s2 < 2; ++s2) \
        KF[t][s2] = ld16(Kp + (size_t)(krow0 + 8 * (ql >> 2) + 4 * t + (ql & 3)) * ldk + hk * 64 + 32 * s2 + 8 * g); \
      _Pragma("unroll") for (int dt = 0; dt < 4; ++dt) VF[dt] = ld16(vt + (size_t)(16 * dt + ql) * vld + 8 * g); }
  bf16x8 kfn[PF ? KPI : 1][2][2], vfn[PF ? KPI : 1][4];
  if (PF) {
#pragma unroll
    for (int kk = 0; kk < KPI; ++kk) ATT_LOAD(kk, kfn[kk], vfn[kk])
  }
  for (int it = 0; it < nit; ++it) {
    bf16x8 kf[KPI][2][2], vf[KPI][4];
    if (PF) {
#pragma unroll
      for (int kk = 0; kk < KPI; ++kk) {
#pragma unroll
        for (int t = 0; t < 2; ++t)
#pragma unroll
          for (int s2 = 0; s2 < 2; ++s2) kf[kk][t][s2] = kfn[kk][t][s2];
#pragma unroll
        for (int dt = 0; dt < 4; ++dt) vf[kk][dt] = vfn[kk][dt];
      }
      if (it + 1 < nit) {
#pragma unroll
        for (int kk = 0; kk < KPI; ++kk) ATT_LOAD((it + 1) * KPI + kk, kfn[kk], vfn[kk])
      }
    } else {
#pragma unroll
      for (int kk = 0; kk < KPI; ++kk) ATT_LOAD(it * KPI + kk, kf[kk], vf[kk])
    }
    float bias[KPI][2][4]; bool valid[KPI][2][4];
#pragma unroll
    for (int kk = 0; kk < KPI; ++kk) {
      int kb = it * KPI + kk;
      bool is_loc = kb < nloc;
#pragma unroll
      for (int t = 0; t < 2; ++t)
#pragma unroll
        for (int i = 0; i < 4; ++i) {
          bias[kk][t][i] = 0.f; valid[kk][t][i] = true;
          if (MODE == 0 && is_loc) {
            int kc = blk_start + 8 * g + 4 * t + i;
            valid[kk][t][i] = (kc >= c_lo) && (kc < c_lo + 16);
            int dc = min(max(kc - qc, -15), 15) + 15;
            bias[kk][t][i] = rpbs[(hk * 15 + (r_start + kb - r + 7)) * 31 + dc];
          }
          if (MODE == 2 && is_loc) {
            int kpos = 32 * (lb0 + kb) + 8 * g + 4 * t + i; int dq = (q0 + ql) - kpos;
            bias[kk][t][i] = ((dq <= 128) && (dq >= -128)) ? 0.f : -1e30f;
          }
        }
    }
#pragma unroll
    for (int hh = 0; hh < NH; ++hh) {
      f32x4_t st[KPI][2];
#pragma unroll
      for (int kk = 0; kk < KPI; ++kk)
#pragma unroll
        for (int t = 0; t < 2; ++t) {
          st[kk][t] = (f32x4_t){0.f, 0.f, 0.f, 0.f};
          st[kk][t] = __builtin_amdgcn_mfma_f32_16x16x32_bf16(kf[kk][t][0], qf[hh][0], st[kk][t], 0, 0, 0);
          st[kk][t] = __builtin_amdgcn_mfma_f32_16x16x32_bf16(kf[kk][t][1], qf[hh][1], st[kk][t], 0, 0, 0);
        }
      float lg[KPI][2][4]; float bm = -1e30f;
#pragma unroll
      for (int kk = 0; kk < KPI; ++kk)
#pragma unroll
        for (int t = 0; t < 2; ++t)
#pragma unroll
          for (int i = 0; i < 4; ++i) {
            float v = (MODE == 0) ? (valid[kk][t][i] ? (st[kk][t][i] * SC + bias[kk][t][i]) : -1e30f) : fmaf(st[kk][t][i], SC, bias[kk][t][i]);
            lg[kk][t][i] = v; bm = fmaxf(bm, v);
          }
      bm = xrow16_max(bm);
      float mn = fmaxf(mrun[hh], bm);
      float alpha = fast_exp2(mrun[hh] - mn);
      mrun[hh] = mn;
      float ps = 0.f;
      bf16x8 pf[KPI];
#pragma unroll
      for (int kk = 0; kk < KPI; ++kk) {
        float pv[8];
#pragma unroll
        for (int t = 0; t < 2; ++t)
#pragma unroll
          for (int i = 0; i < 4; ++i) {
            float p = (MODE == 0) ? (valid[kk][t][i] ? fast_exp2(lg[kk][t][i] - mn) : 0.f) : fast_exp2(lg[kk][t][i] - mn);
            pv[4 * t + i] = p; ps += p;
          }
        typedef __attribute__((ext_vector_type(4))) unsigned u32x4;
        u32x4 uu = {pack2bf(pv[0], pv[1]), pack2bf(pv[2], pv[3]), pack2bf(pv[4], pv[5]), pack2bf(pv[6], pv[7])};
        pf[kk] = __builtin_bit_cast(bf16x8, uu);
      }
      lrun[hh] = lrun[hh] * alpha + ps;
#pragma unroll
      for (int dt = 0; dt < 4; ++dt) {
        o[hh][dt] *= alpha;
#pragma unroll
        for (int kk = 0; kk < KPI; ++kk)
          o[hh][dt] = __builtin_amdgcn_mfma_f32_16x16x32_bf16(vf[kk][dt], pf[kk], o[hh][dt], 0, 0, 0);
      }
      if (NH == 4 && KPI == 2 && (hh & 1)) __builtin_amdgcn_sched_barrier(0);
    }
  }
#undef ATT_LOAD
#undef ATT_DESC
#pragma unroll
  for (int hh = 0; hh < NH; ++hh) {
    float l = xrow16_sum(lrun[hh]);
    float m = mrun[hh];
    if (MODE == 2) {
      float sk = sink[hk * NH + hh] * LOG2E;
      float mf = fmaxf(m, sk);
      float a = fast_exp2(m - mf);
      l = l * a + fast_exp2(sk - mf);
#pragma unroll
      for (int dt = 0; dt < 4; ++dt) o[hh][dt] *= a;
    }
    float inv = 1.f / l;
    bf16_t* orow = Op + (size_t)(qrow0 + ql) * ldo + (hk * NH + hh) * 64 + 4 * g;
#pragma unroll
    for (int dt = 0; dt < 4; ++dt) {
      f32x4_t v = o[hh][dt] * inv;
      *(uint2*)(orow + 16 * dt) = make_uint2(pack2bf(v[0], v[1]), pack2bf(v[2], v[3]));
    }
  }
}

struct NaState { f32x4_t o[4][4]; float m[4], l[4]; };
template <int HB>
__device__ __forceinline__ void na_block(NaState& st, const bf16x8 (&qf)[4][2], const bf16x8 (&kf)[2][2], const bf16x8 (&vf)[4],
                                         const float* rpbrow  , int ql, int g) {
  const float SC = 0.125f * 1.4426950408889634f;
#pragma unroll
  for (int jb = 0; jb < 4; ++jb) {
    if (HB == 0 && jb == 3) continue;
    if (HB == 1 && jb == 0) continue;
    f32x4_t s2[2];
#pragma unroll
    for (int t = 0; t < 2; ++t) {
      s2[t] = (f32x4_t){0.f, 0.f, 0.f, 0.f};
      s2[t] = __builtin_amdgcn_mfma_f32_16x16x32_bf16(kf[t][0], qf[jb][0], s2[t], 0, 0, 0);
      s2[t] = __builtin_amdgcn_mfma_f32_16x16x32_bf16(kf[t][1], qf[jb][1], s2[t], 0, 0, 0);
    }
    float lg[8]; bool valid[8]; float bm = -1e30f;
#pragma unroll
    for (int t = 0; t < 2; ++t)
#pragma unroll
      for (int i = 0; i < 4; ++i) {
        float v;
        if (HB < 2) {
          int qc = 16 * jb + ql; int c_lo = min(max(qc - 8, 0), 48);
          int kc = 32 * HB + 8 * g + 4 * t + i;
          bool ok = (kc >= c_lo) && (kc < c_lo + 16);
          int dc = min(max(kc - qc, -15), 15) + 15;
          v = ok ? (s2[t][i] * SC + rpbrow[dc]) : -1e30f;
          valid[4 * t + i] = ok;
        } else { v = s2[t][i] * SC; valid[4 * t + i] = true; }
        lg[4 * t + i] = v; bm = fmaxf(bm, v);
      }
    bm = xrow16_max(bm);
    float mn = fmaxf(st.m[jb], bm);
    float alpha = fast_exp2(st.m[jb] - mn);
    st.m[jb] = mn;
    float ps = 0.f; float pv[8];
#pragma unroll
    for (int e = 0; e < 8; ++e) { float p = valid[e] ? fast_exp2(lg[e] - mn) : 0.f; pv[e] = p; ps += p; }
    st.l[jb] = st.l[jb] * alpha + ps;
    typedef __attribute__((ext_vector_type(4))) unsigned u32x4;
    u32x4 uu = {pack2bf(pv[0], pv[1]), pack2bf(pv[2], pv[3]), pack2bf(pv[4], pv[5]), pack2bf(pv[6], pv[7])};
    bf16x8 pf = __builtin_bit_cast(bf16x8, uu);
#pragma unroll
    for (int dt = 0; dt < 4; ++dt) {
      st.o[jb][dt] *= alpha;
      st.o[jb][dt] = __builtin_amdgcn_mfma_f32_16x16x32_bf16(vf[dt], pf, st.o[jb][dt], 0, 0, 0);
    }
    if (jb & 1) __builtin_amdgcn_sched_barrier(0);
  }
}
__device__ __forceinline__ void na_unit(int b, int h, int r, const bf16_t* __restrict__ FQKV, const bf16_t* __restrict__ VTl,
                                        const bf16_t* __restrict__ VTc, const float* rpbs, bf16_t* __restrict__ MIX, int lane) {
  asm volatile("" : "+v"(lane));
  int ql = lane & 15, g = lane >> 4;
  int qrow0 = b * S + r * 64;
  int r_start = min(max(r - 4, 0), 120);
  bf16x8 qf[4][2];
#pragma unroll
  for (int jb = 0; jb < 4; ++jb)
#pragma unroll
    for (int s2 = 0; s2 < 2; ++s2)
      qf[jb][s2] = ld16(FQKV + (size_t)(qrow0 + 16 * jb + ql) * 2048 + 512 + h * 64 + 32 * s2 + 8 * g);
  NaState st;
#pragma unroll
  for (int jb = 0; jb < 4; ++jb) {
    st.m[jb] = -1e30f; st.l[jb] = 0.f;
#pragma unroll
    for (int dt = 0; dt < 4; ++dt) st.o[jb][dt] = (f32x4_t){0.f, 0.f, 0.f, 0.f};
  }
  unsigned koff = (unsigned)((8 * (ql >> 2) + (ql & 3)) * 2048 + 1024 + h * 64 + 8 * g);
  unsigned voffl = (unsigned)(ql * S + 8 * g), voffc = (unsigned)(ql * CL + 8 * g);
  const bf16_t* vtl = VTl + (size_t)(b * 8 + h) * 64 * S;
  const bf16_t* vtc = VTc + (size_t)(b * 8 + h) * 64 * CL;
#define NA_LOADK(kb2, KF) { \
    int krow0_; \
    if ((kb2) < 16) krow0_ = b * S + (r_start + ((kb2) >> 1)) * 64 + 32 * ((kb2) & 1); \
    else krow0_ = T + b * CL + 32 * ((kb2) - 16); \
    const bf16_t* kb_ = FQKV + (size_t)krow0_ * 2048; \
    _Pragma("unroll") for (int t = 0; t < 2; ++t) _Pragma("unroll") for (int s2 = 0; s2 < 2; ++s2) \
      KF[t][s2] = ld16(kb_ + (koff + (unsigned)(t * 4 * 2048 + 32 * s2))); }
#define NA_LOADV(kb2, VF) { \
    if ((kb2) < 16) { const bf16_t* vt_ = vtl + (r_start + ((kb2) >> 1)) * 64 + 32 * ((kb2) & 1); \
      _Pragma("unroll") for (int dt = 0; dt < 4; ++dt) VF[dt] = ld16(vt_ + (voffl + (unsigned)(16 * dt * S))); } \
    else { const bf16_t* vt_ = vtc + 32 * ((kb2) - 16); \
      _Pragma("unroll") for (int dt = 0; dt < 4; ++dt) VF[dt] = ld16(vt_ + (voffc + (unsigned)(16 * dt * CL))); } }
  bf16x8 kfa[2][2], kfb[2][2], vfa[4], vfb[4];
  NA_LOADK(0, kfa) NA_LOADV(0, vfa)
#pragma unroll 1
  for (int rr = 0; rr < 8; ++rr) {
    const float* rpbrow = rpbs + (h * 15 + (r_start + rr - r + 7)) * 31;
    asm volatile("" : "+v"(lane)); ql = lane & 15; g = lane >> 4;
    koff = (unsigned)((8 * (ql >> 2) + (ql & 3)) * 2048 + 1024 + h * 64 + 8 * g); voffl = (unsigned)(ql * S + 8 * g); voffc = (unsigned)(ql * CL + 8 * g);
    NA_LOADK(2 * rr + 1, kfb) NA_LOADV(2 * rr + 1, vfb)
    na_block<0>(st, qf, kfa, vfa, rpbrow, ql, g);
    NA_LOADK(2 * rr + 2, kfa) NA_LOADV(2 * rr + 2, vfa)
    na_block<1>(st, qf, kfb, vfb, rpbrow, ql, g);
  }
#pragma unroll 1
  for (int cb = 0; cb < 8; cb += 2) {
    asm volatile("" : "+v"(lane)); ql = lane & 15; g = lane >> 4;
    koff = (unsigned)((8 * (ql >> 2) + (ql & 3)) * 2048 + 1024 + h * 64 + 8 * g); voffc = (unsigned)(ql * CL + 8 * g);
    NA_LOADK(16 + cb + 1, kfb) NA_LOADV(16 + cb + 1, vfb)
    na_block<2>(st, qf, kfa, vfa, rpbs, ql, g);
    if (cb + 2 < 8) { NA_LOADK(16 + cb + 2, kfa) NA_LOADV(16 + cb + 2, vfa) }
    na_block<2>(st, qf, kfb, vfb, rpbs, ql, g);
  }
#undef NA_LOADK
#undef NA_LOADV
  asm volatile("" : "+v"(lane)); ql = lane & 15; g = lane >> 4;
#pragma unroll
  for (int jb = 0; jb < 4; ++jb) {
    float inv = 1.f / xrow16_sum(st.l[jb]);
    bf16_t* orow = MIX + (size_t)(qrow0 + 16 * jb + ql) * 1024 + 512 + h * 64 + 4 * g;
#pragma unroll
    for (int dt = 0; dt < 4; ++dt) {
      f32x4_t v = st.o[jb][dt] * inv;
      *(uint2*)(orow + 16 * dt) = make_uint2(pack2bf(v[0], v[1]), pack2bf(v[2], v[3]));
    }
  }
}

__device__ __forceinline__ void ph_chan_dft(const float* __restrict__ F, const float* __restrict__ tab, float* __restrict__ PQ) {
  for (int gid = blockIdx.x * 256 + threadIdx.x; gid < R * 512; gid += gridDim.x * 256) {
    int row = gid >> 9; int col = gid & 511; int g = col >> 6, cp = col & 63;
    const float* f = F + (size_t)row * 2048 + g * 64;
    float p = 0.f, q = 0.f;
    for (int ch = 0; ch < 64; ++ch) {
      int idx = ((ch * cp) & 63) * 128;
      float x = f[ch];
      p += x * tab[idx]; q += x * tab[8192 + idx];
    }
    PQ[(size_t)row * 1024 + col] = p;
    PQ[(size_t)row * 1024 + 512 + col] = q;
  }
}

__device__ __forceinline__ void ph_na(const bf16_t* __restrict__ F, const float* __restrict__ rpb, bf16_t* __restrict__ MIX, float* sm) {
  int lane = threadIdx.x & 63, wave = __builtin_amdgcn_readfirstlane(threadIdx.x >> 6);
  float* sq = sm + wave * 1024; float* sp = sq + 64; int* stok = (int*)(sp + 384);
  int nitems = R * 8;
  for (int item0 = blockIdx.x * 4; item0 < nitems; item0 += gridDim.x * 4) {
    int item = item0 + wave;
    int h = item & 7; int row = item >> 3;
    bool is_ctx = row >= T;
    int b = is_ctx ? (row - T) / CL : row / S;
    __syncthreads();
    sq[lane] = bf2f(F[(size_t)row * 2048 + 512 + h * 64 + lane]);
    __syncthreads();
    int r = 0, c = 0, r_start = 0, c_start = 0;
    if (!is_ctx) { int t = row % S; r = t / 64; c = t % 64; r_start = min(max(r - 4, 0), 120); c_start = min(max(c - 8, 0), 48); }
    int nk = is_ctx ? 256 : 384;
    float lg[6]; float mx = -INFINITY;
#pragma unroll
    for (int kk = 0; kk < 6; ++kk) {
      int j = kk * 64 + lane; float s = -INFINITY; int tok = 0;
      if (j < nk) {
        float bias = 0.f;
        if (!is_ctx && j < 128) {
          int kr = j >> 4, kc = j & 15; int rr = r_start + kr, cc = c_start + kc;
          tok = b * S + rr * 64 + cc;
          int dc = min(max(cc - c, -15), 15) + 15;
          bias = rpb[(h * 15 + (rr - r + 7)) * 31 + dc];
        } else {
          int l = is_ctx ? j : j - 128; tok = T + b * CL + l;
        }
        const bf16_t* kp = F + (size_t)tok * 2048 + 1024 + h * 64;
        float acc = 0.f;
#pragma unroll 8
        for (int d = 0; d < 64; ++d) acc += sq[d] * bf2f(kp[d]);
        s = acc * 0.125f + bias;
      }
      lg[kk] = s; stok[j] = tok; mx = fmaxf(mx, s);
    }
    mx = wave_max(mx);
    float sum = 0.f;
#pragma unroll
    for (int kk = 0; kk < 6; ++kk) { float e = (kk * 64 + lane < nk) ? expf(lg[kk] - mx) : 0.f; lg[kk] = e; sum += e; }
    sum = wave_sum(sum);
    float inv = 1.f / sum;
#pragma unroll
    for (int kk = 0; kk < 6; ++kk) sp[kk * 64 + lane] = lg[kk] * inv;
    __syncthreads();
    float o = 0.f;
    for (int j = 0; j < nk; ++j) o += sp[j] * bf2f(F[(size_t)stok[j] * 2048 + 1536 + h * 64 + lane]);
    MIX[(size_t)row * 1024 + 512 + h * 64 + lane] = (bf16_t)f2bf(o);
  }
}

__device__ __forceinline__ void ph_rope(float* __restrict__ F1) {
  for (int gid = blockIdx.x * 256 + threadIdx.x; gid < T * 20 * 32; gid += gridDim.x * 256) {
    int i = gid & 31; int hh = (gid >> 5) % 20; int row = gid / (32 * 20);
    int t = row % S; float rowp = (float)(t / 64), colp = (float)(t % 64);
    int fi = i & 15;
    float inv_freq = powf(10000.0f, -(float)fi / 16.0f);
    float ang = (i < 16 ? rowp : colp) * inv_freq;
    float cs = cosf(ang), sn = sinf(ang);
    float* p = F1 + (size_t)row * 1536 + hh * 64;
    float x1 = p[i], x2 = p[i + 32];
    p[i] = x1 * cs - x2 * sn;
    p[i + 32] = x1 * sn + x2 * cs;
  }
}

__device__ __forceinline__ void ph_gqa(const float* __restrict__ F1, const float* __restrict__ sink, bf16_t* __restrict__ O, float* sm) {
  int lane = threadIdx.x & 63, wave = __builtin_amdgcn_readfirstlane(threadIdx.x >> 6);
  float* sq = sm + wave * 1280; float* sp = sq + 64; int* stok = (int*)(sp + 576);
  int nitems = T * 16;
  for (int item0 = blockIdx.x * 4; item0 < nitems; item0 += gridDim.x * 4) {
    int item = item0 + wave;
    int qh = item & 15; int row = item >> 4; int kvh = qh >> 2;
    int b = row / S; int t = row % S;
    __syncthreads();
    sq[lane] = F1[(size_t)row * 1536 + qh * 64 + lane];
    __syncthreads();
    float lg[9]; float mx = -INFINITY;
#pragma unroll
    for (int kk = 0; kk < 9; ++kk) {
      int j = kk * 64 + lane; float s = -INFINITY; int tok = 0; bool valid = false;
      if (j < 257) { int pos = t - 128 + j; valid = (pos >= 0 && pos < S); tok = b * S + pos; }
      else if (j < 513) { valid = true; tok = T + b * CL + (j - 257); }
      if (valid) {
        const float* kp = F1 + (size_t)tok * 1536 + 1024 + kvh * 64;
        float acc = 0.f;
#pragma unroll 8
        for (int d = 0; d < 64; ++d) acc += sq[d] * kp[d];
        s = acc * 0.125f;
      } else tok = 0;
      lg[kk] = s; stok[j] = tok; mx = fmaxf(mx, s);
    }
    mx = wave_max(mx);
    float sk = sink[qh];
    mx = fmaxf(mx, sk);
    float sum = 0.f;
#pragma unroll
    for (int kk = 0; kk < 9; ++kk) { float e = (lg[kk] == -INFINITY) ? 0.f : expf(lg[kk] - mx); lg[kk] = e; sum += e; }
    sum = wave_sum(sum) + expf(sk - mx);
    float inv = 1.f / sum;
#pragma unroll
    for (int kk = 0; kk < 9; ++kk) sp[kk * 64 + lane] = lg[kk] * inv;
    __syncthreads();
    float o = 0.f;
    for (int j = 0; j < 513; ++j) { float p = sp[j]; if (p != 0.f) o += p * F1[(size_t)stok[j] * 1536 + 1280 + kvh * 64 + lane]; }
    O[(size_t)row * 1024 + qh * 64 + lane] = (bf16_t)f2bf(o);
  }
}

__device__ __forceinline__ void wave_argmax(float& v, int& idx) {
#pragma unroll
  for (int off = 32; off; off >>= 1) {
    float ov = __shfl_xor(v, off); int oi = __shfl_xor(idx, off);
    if (ov > v || (ov == v && oi < idx)) { v = ov; idx = oi; }
  }
}
__device__ __forceinline__ void ph_peer_select_naive(const float* __restrict__ Q, const float* __restrict__ sk, int* __restrict__ EXP,
                                     float* __restrict__ GATE, int nrows, float* sm) {
  int lane = threadIdx.x & 63, wave = __builtin_amdgcn_readfirstlane(threadIdx.x >> 6);
  float* sq = sm + wave * 640; float* tops = sq + 256; int* topi = (int*)(tops + 32);
  for (int row0 = blockIdx.x * 4; row0 < nrows; row0 += gridDim.x * 4) {
    int row = row0 + wave;
    for (int h = 0; h < 8; ++h) {
      __syncthreads();
#pragma unroll
      for (int i = 0; i < 4; ++i) sq[lane + 64 * i] = Q[(size_t)row * 2048 + h * 256 + lane + 64 * i];
      __syncthreads();
      for (int p = 0; p < 2; ++p) {
        float s0 = 0.f, s1 = 0.f;
        const float* k0 = sk + ((size_t)((h * 2 + p) * 128 + lane)) * 128;
        const float* k1 = k0 + 64 * 128;
#pragma unroll 8
        for (int d = 0; d < 128; ++d) { float qv = sq[p * 128 + d]; s0 += qv * k0[d]; s1 += qv * k1[d]; }
        for (int i = 0; i < 16; ++i) {
          float v; int idx;
          if (s0 >= s1) { v = s0; idx = lane; } else { v = s1; idx = lane + 64; }
          wave_argmax(v, idx);
          if (lane == 0) { tops[p * 16 + i] = v; topi[p * 16 + i] = idx; }
          if (idx == lane) s0 = -INFINITY;
          if (idx == lane + 64) s1 = -INFINITY;
        }
      }
      __syncthreads();
      float cs[4];
#pragma unroll
      for (int i = 0; i < 4; ++i) { int ci = lane * 4 + i; cs[i] = tops[ci >> 4] + tops[16 + (ci & 15)]; }
      float bs[16]; int be[16];
#pragma unroll
      for (int k = 0; k < 16; ++k) {
        float v = cs[0]; int idx = lane * 4;
#pragma unroll
        for (int i = 1; i < 4; ++i) if (cs[i] > v) { v = cs[i]; idx = lane * 4 + i; }
        wave_argmax(v, idx);
        bs[k] = v; be[k] = topi[idx >> 4] * 128 + topi[16 + (idx & 15)];
#pragma unroll
        for (int i = 0; i < 4; ++i) if (idx == lane * 4 + i) cs[i] = -INFINITY;
      }
      float mxs = bs[0]; float sum = 0.f;
#pragma unroll
      for (int k = 0; k < 16; ++k) { bs[k] = expf(bs[k] - mxs); sum += bs[k]; }
      float inv = 1.f / sum;
      if (lane == 0) {
#pragma unroll
        for (int k = 0; k < 16; ++k) { EXP[(size_t)row * 128 + h * 16 + k] = be[k]; GATE[(size_t)row * 128 + h * 16 + k] = bs[k] * inv; }
      }
    }
  }
}

__device__ __forceinline__ void unpack8(uint4 v, float* f) {
  f[0] = __uint_as_float(v.x << 16); f[1] = __uint_as_float(v.x & 0xffff0000u);
  f[2] = __uint_as_float(v.y << 16); f[3] = __uint_as_float(v.y & 0xffff0000u);
  f[4] = __uint_as_float(v.z << 16); f[5] = __uint_as_float(v.z & 0xffff0000u);
  f[6] = __uint_as_float(v.w << 16); f[7] = __uint_as_float(v.w & 0xffff0000u);
}
__device__ __forceinline__ void ph_peer_gather(bf16_t* __restrict__ H, const int* __restrict__ EXP, const float* __restrict__ GATE,
                               const bf16_t* __restrict__ U, const bf16_t* __restrict__ V,
                               const float* __restrict__ xin, const float* __restrict__ M, int layer,
                               const float* __restrict__ g, const float* __restrict__ bb, float* __restrict__ xout,
                               bool write_next, int nrows) {
  int lane = threadIdx.x & 63, wave = __builtin_amdgcn_readfirstlane(threadIdx.x >> 6);
  for (int row = blockIdx.x * 4 + wave; row < nrows; row += gridDim.x * 4) {
    float hreg[16];
    {
      const uint4* hp = (const uint4*)(H + (size_t)row * D + 8 * lane);
      unpack8(hp[0], hreg); unpack8(hp[64], hreg + 8);
    }
    float acc[16];
#pragma unroll
    for (int i = 0; i < 16; ++i) acc[i] = 0.f;
    int e_lo = EXP[(size_t)row * 128 + lane], e_hi = EXP[(size_t)row * 128 + 64 + lane];
    float g_lo = GATE[(size_t)row * 128 + lane], g_hi = GATE[(size_t)row * 128 + 64 + lane];
    uint4 ua[4], ub[4], va[4], vb[4];
#pragma unroll
    for (int i = 0; i < 4; ++i) {
      int e = __builtin_amdgcn_readlane(e_lo, i);
      const uint4* up = (const uint4*)(U + (size_t)e * D + 8 * lane); ua[i] = up[0]; ub[i] = up[64];
    }
#pragma unroll 1
    for (int b = 0; b < 32; ++b) {
      int k0 = 4 * b;
      int ev = (b < 16) ? e_lo : e_hi; float gv = (b < 16) ? g_lo : g_hi;
      int en = (b + 1 < 16) ? e_lo : e_hi;
      float gt[4];
#pragma unroll
      for (int i = 0; i < 4; ++i) {
        int e = __builtin_amdgcn_readlane(ev, (k0 + i) & 63);
        gt[i] = __uint_as_float(__builtin_amdgcn_readlane(__float_as_uint(gv), (k0 + i) & 63));
        const uint4* vp = (const uint4*)(V + (size_t)e * D + 8 * lane); va[i] = vp[0]; vb[i] = vp[64];
      }
      float a[4];
#pragma unroll
      for (int i = 0; i < 4; ++i) {
        float f[16]; unpack8(ua[i], f); unpack8(ub[i], f + 8);
        float sacc = 0.f;
#pragma unroll
        for (int j = 0; j < 16; ++j) sacc += f[j] * hreg[j];
        a[i] = sacc;
      }
      if (b + 1 < 32) {
#pragma unroll
        for (int i = 0; i < 4; ++i) {
          int e = __builtin_amdgcn_readlane(en, (k0 + 4 + i) & 63);
          const uint4* up = (const uint4*)(U + (size_t)e * D + 8 * lane); ua[i] = up[0]; ub[i] = up[64];
        }
      }
#pragma unroll
      for (int i = 0; i < 4; ++i) a[i] = wave_sum(a[i]);
#pragma unroll
      for (int i = 0; i < 4; ++i) {
        float w = gt[i] * 0.5f * a[i] * (1.f + erff(a[i] * 0.70710678118654752f));
        float f[16]; unpack8(va[i], f); unpack8(vb[i], f + 8);
#pragma unroll
        for (int j = 0; j < 16; ++j) acc[j] += w * f[j];
      }
    }
    const float* m = M + ((size_t)layer * 3 + mod_index(row)) * 6144;
    const float* xr = xin + (size_t)row * D;
    float v[16];
#pragma unroll
    for (int hh = 0; hh < 2; ++hh) {
      int d0 = hh * 512 + 8 * lane;
      float4 x0 = *(const float4*)(xr + d0), x1 = *(const float4*)(xr + d0 + 4);
      float4 m0 = *(const float4*)(m + 5 * D + d0), m1 = *(const float4*)(m + 5 * D + d0 + 4);
      v[hh * 8 + 0] = DN_ALPHA * x0.x + m0.x * acc[hh * 8 + 0]; v[hh * 8 + 1] = DN_ALPHA * x0.y + m0.y * acc[hh * 8 + 1];
      v[hh * 8 + 2] = DN_ALPHA * x0.z + m0.z * acc[hh * 8 + 2]; v[hh * 8 + 3] = DN_ALPHA * x0.w + m0.w * acc[hh * 8 + 3];
      v[hh * 8 + 4] = DN_ALPHA * x1.x + m1.x * acc[hh * 8 + 4]; v[hh * 8 + 5] = DN_ALPHA * x1.y + m1.y * acc[hh * 8 + 5];
      v[hh * 8 + 6] = DN_ALPHA * x1.z + m1.z * acc[hh * 8 + 6]; v[hh * 8 + 7] = DN_ALPHA * x1.w + m1.w * acc[hh * 8 + 7];
    }
    float s = 0.f;
#pragma unroll
    for (int j = 0; j < 16; ++j) s += v[j];
    float mu = wave_sum(s) * (1.f / D);
    float q = 0.f;
#pragma unroll
    for (int j = 0; j < 16; ++j) { float d = v[j] - mu; q += d * d; }
    float rs = rsqrtf(wave_sum(q) * (1.f / D) + LN_EPS);
    float y[16];
#pragma unroll
    for (int hh = 0; hh < 2; ++hh) {
      int d0 = hh * 512 + 8 * lane;
#pragma unroll
      for (int j = 0; j < 8; ++j) y[hh * 8 + j] = (v[hh * 8 + j] - mu) * rs * g[d0 + j] + bb[d0 + j];
      *(float4*)(xout + (size_t)row * D + d0) = make_float4(y[hh * 8], y[hh * 8 + 1], y[hh * 8 + 2], y[hh * 8 + 3]);
      *(float4*)(xout + (size_t)row * D + d0 + 4) = make_float4(y[hh * 8 + 4], y[hh * 8 + 5], y[hh * 8 + 6], y[hh * 8 + 7]);
    }
    if (write_next) {
      const float* mn = M + ((size_t)(layer + 1) * 3 + mod_index(row)) * 6144;
      float s2 = 0.f;
#pragma unroll
      for (int j = 0; j < 16; ++j) s2 += y[j];
      float mu2 = wave_sum(s2) * (1.f / D);
      float q2 = 0.f;
#pragma unroll
      for (int j = 0; j < 16; ++j) { float d = y[j] - mu2; q2 += d * d; }
      float rs2 = rsqrtf(wave_sum(q2) * (1.f / D) + LN_EPS);
#pragma unroll
      for (int hh = 0; hh < 2; ++hh) {
        int d0 = hh * 512 + 8 * lane;
        float o[8];
#pragma unroll
        for (int j = 0; j < 8; ++j) o[j] = (y[hh * 8 + j] - mu2) * rs2 * (1.f + mn[D + d0 + j]) + mn[d0 + j];
        *(uint4*)(H + (size_t)row * D + d0) = make_uint4(pack2bf(o[0], o[1]), pack2bf(o[2], o[3]), pack2bf(o[4], o[5]), pack2bf(o[6], o[7]));
      }
    }
  }
}


__device__ __forceinline__ void quant_row(const float* __restrict__ src, unsigned char* __restrict__ dst, float* __restrict__ scale, int row, int lane) {
  const float4* sp = (const float4*)(src + (size_t)row * D + 16 * lane);
  float4 v0 = sp[0], v1 = sp[1], v2 = sp[2], v3 = sp[3];
  float x[16] = {v0.x, v0.y, v0.z, v0.w, v1.x, v1.y, v1.z, v1.w, v2.x, v2.y, v2.z, v2.w, v3.x, v3.y, v3.z, v3.w};
  float am = 0.f;
#pragma unroll
  for (int j = 0; j < 16; ++j) am = fmaxf(am, fabsf(x[j]));
  am = wave_max(am);
  float inv = am > 0.f ? 127.f / am : 0.f;
  unsigned wv[4];
#pragma unroll
  for (int k = 0; k < 4; ++k) {
    unsigned w = 0;
#pragma unroll
    for (int j = 0; j < 4; ++j) {
      int q = (int)rintf(x[4 * k + j] * inv);
      w |= ((unsigned)q & 0xffu) << (8 * j);
    }
    wv[k] = w;
  }
  *(uint4*)(dst + ((size_t)(row >> 14) * 8 + (lane >> 3)) * ((size_t)16384 * 128) + (size_t)(row & 16383) * 128 + 16 * (lane & 7)) = make_uint4(wv[0], wv[1], wv[2], wv[3]);
  if (lane == 0) scale[row] = am * (1.f / 127.f);
}
__device__ __forceinline__ void quant_row_u4(const float* __restrict__ src, unsigned char* __restrict__ dst, float* __restrict__ scale, int row, int lane) {
  const float4* sp = (const float4*)(src + (size_t)row * D + 16 * lane);
  float4 v0 = sp[0], v1 = sp[1], v2 = sp[2], v3 = sp[3];
  float x[16] = {v0.x, v0.y, v0.z, v0.w, v1.x, v1.y, v1.z, v1.w, v2.x, v2.y, v2.z, v2.w, v3.x, v3.y, v3.z, v3.w};
  float ss = 0.f;
#pragma unroll
  for (int j = 0; j < 16; ++j) ss += x[j] * x[j];
  ss = wave_sum(ss);
  float delta = 0.3352f * sqrtf(ss * (1.f / D));
  float inv = delta > 0.f ? 1.f / delta : 0.f;
  unsigned wv[2];
#pragma unroll
  for (int k = 0; k < 2; ++k) {
    unsigned w = 0;
#pragma unroll
    for (int j = 0; j < 4; ++j) {
      int qh = (int)fminf(fmaxf(floorf(x[8 * k + j] * inv), -8.f), 7.f);
      int ql = (int)fminf(fmaxf(floorf(x[8 * k + 4 + j] * inv), -8.f), 7.f);
      w |= ((((unsigned)qh & 15u) << 4) | ((unsigned)ql & 15u)) << (8 * j);
    }
    wv[k] = w;
  }
  *(uint2*)(dst + ((size_t)(row >> 14) * 4 + (lane >> 4)) * ((size_t)16384 * 128) + (size_t)(row & 16383) * 128 + 8 * (lane & 15)) = make_uint2(wv[0], wv[1]);
  if (lane == 0) scale[row] = delta;
}
__device__ __forceinline__ void quant_fill(unsigned* ctr, int layer, unsigned lo, unsigned hi, const float* __restrict__ pu, const float* __restrict__ pv,
                                           unsigned char* __restrict__ U8, unsigned char* __restrict__ V8, float* __restrict__ USC,
                                           float* __restrict__ VSC, unsigned* sh) {
  int lane = threadIdx.x & 63, wave = __builtin_amdgcn_readfirstlane(threadIdx.x >> 6);
  for (;;) {
    __syncthreads();
    if (threadIdx.x == 0) *sh = lo + __hip_atomic_fetch_add(ctr, 1u, __ATOMIC_RELAXED, __HIP_MEMORY_SCOPE_AGENT);
    __syncthreads();
    unsigned c = *sh;
    if (c >= hi) break;
    const float* src = (c >> 8) ? pv : pu; unsigned char* dst = (c >> 8) ? V8 : U8; float* sc = (c >> 8) ? VSC : USC;
    int r0 = layer * 16384 + (int)(c & 255u) * 64 + wave * 16;
#pragma unroll 4
    for (int i = 0; i < 16; ++i) quant_row_u4(src, dst, sc, r0 + i, lane);
  }
  __syncthreads();
}
__device__ __forceinline__ void unpack_u8x16(uint4 v, float* f) {
  unsigned w[4] = {v.x, v.y, v.z, v.w};
#pragma unroll
  for (int k = 0; k < 4; ++k) {
    f[4 * k + 0] = (float)(w[k] & 0xffu); f[4 * k + 1] = (float)((w[k] >> 8) & 0xffu);
    f[4 * k + 2] = (float)((w[k] >> 16) & 0xffu); f[4 * k + 3] = (float)(w[k] >> 24);
  }
}
__device__ __forceinline__ void ph_peer_gather8(bf16_t* __restrict__ H, const int* __restrict__ EXP, const float* __restrict__ GATE,
                               const unsigned char* __restrict__ U8, const float* __restrict__ USC,
                               const unsigned char* __restrict__ V8, const float* __restrict__ VSC,
                               const float* __restrict__ xin, const float* __restrict__ M, int layer,
                               const float* __restrict__ g, const float* __restrict__ bb, float* __restrict__ xout,
                               bool write_next, int nrows) {
  int lane = threadIdx.x & 63, wave = __builtin_amdgcn_readfirstlane(threadIdx.x >> 6);
  for (int row = blockIdx.x * 4 + wave; row < nrows; row += gridDim.x * 4) {
    float hreg[16];
    {
      const uint4* hp = (const uint4*)(H + (size_t)row * D + 16 * lane);
      unpack8(hp[0], hreg); unpack8(hp[1], hreg + 8);
    }
    float hs = 0.f;
#pragma unroll
    for (int j = 0; j < 16; ++j) hs += hreg[j];
    float hsum128 = 128.f * wave_sum(hs);
    float acc[16];
#pragma unroll
    for (int i = 0; i < 16; ++i) acc[i] = 0.f;
    float wsum = 0.f;
    int e_lo = EXP[(size_t)row * 128 + lane], e_hi = EXP[(size_t)row * 128 + 64 + lane];
    float g_lo = GATE[(size_t)row * 128 + lane], g_hi = GATE[(size_t)row * 128 + 64 + lane];
    float us_lo = USC[e_lo], us_hi = USC[e_hi], vs_lo = VSC[e_lo], vs_hi = VSC[e_hi];
    uint4 ua[8], va[8];
#pragma unroll
    for (int i = 0; i < 8; ++i) {
      int e = __builtin_amdgcn_readlane(e_lo, i);
      ua[i] = *(const uint4*)(U8 + (size_t)e * D + 16 * lane);
    }
#pragma unroll 1
    for (int b = 0; b < 16; ++b) {
      int k0 = 8 * b;
      bool lo = b < 8, lon = (b + 1) < 8;
      int ev = lo ? e_lo : e_hi; float gv = lo ? g_lo : g_hi; float usv = lo ? us_lo : us_hi; float vsv = lo ? vs_lo : vs_hi;
      int en = lon ? e_lo : e_hi;
      float gt[8], usc[8], vsc[8];
#pragma unroll
      for (int i = 0; i < 8; ++i) {
        int li = (k0 + i) & 63;
        int e = __builtin_amdgcn_readlane(ev, li);
        gt[i] = __uint_as_float(__builtin_amdgcn_readlane(__float_as_uint(gv), li));
        usc[i] = __uint_as_float(__builtin_amdgcn_readlane(__float_as_uint(usv), li));
        vsc[i] = __uint_as_float(__builtin_amdgcn_readlane(__float_as_uint(vsv), li));
        va[i] = *(const uint4*)(V8 + (size_t)e * D + 16 * lane);
      }
      float a[8];
#pragma unroll
      for (int i = 0; i < 8; ++i) {
        float f[16]; unpack_u8x16(ua[i], f);
        float sacc = 0.f;
#pragma unroll
        for (int j = 0; j < 16; ++j) sacc += f[j] * hreg[j];
        a[i] = sacc;
      }
      if (b + 1 < 16) {
#pragma unroll
        for (int i = 0; i < 8; ++i) {
          int e = __builtin_amdgcn_readlane(en, (k0 + 8 + i) & 63);
          ua[i] = *(const uint4*)(U8 + (size_t)e * D + 16 * lane);
        }
      }
#pragma unroll
      for (int i = 0; i < 8; ++i) a[i] = (wave_sum(a[i]) - hsum128) * usc[i];
#pragma unroll
      for (int i = 0; i < 8; ++i) {
        float w = gt[i] * 0.5f * a[i] * (1.f + erff(a[i] * 0.70710678118654752f)) * vsc[i];
        wsum += w;
        float f[16]; unpack_u8x16(va[i], f);
#pragma unroll
        for (int j = 0; j < 16; ++j) acc[j] += w * f[j];
      }
    }
    float corr = 128.f * wsum;
#pragma unroll
    for (int j = 0; j < 16; ++j) acc[j] -= corr;
    const float* m = M + ((size_t)layer * 3 + mod_index(row)) * 6144;
    const float* xr = xin + (size_t)row * D + 16 * lane;
    const float* m5 = m + 5 * D + 16 * lane;
    float v[16];
#pragma unroll
    for (int q4 = 0; q4 < 4; ++q4) {
      float4 x0 = *(const float4*)(xr + 4 * q4); float4 m0 = *(const float4*)(m5 + 4 * q4);
      v[4 * q4 + 0] = DN_ALPHA * x0.x + m0.x * acc[4 * q4 + 0]; v[4 * q4 + 1] = DN_ALPHA * x0.y + m0.y * acc[4 * q4 + 1];
      v[4 * q4 + 2] = DN_ALPHA * x0.z + m0.z * acc[4 * q4 + 2]; v[4 * q4 + 3] = DN_ALPHA * x0.w + m0.w * acc[4 * q4 + 3];
    }
    float s = 0.f;
#pragma unroll
    for (int j = 0; j < 16; ++j) s += v[j];
    float mu = wave_sum(s) * (1.f / D);
    float q = 0.f;
#pragma unroll
    for (int j = 0; j < 16; ++j) { float d = v[j] - mu; q += d * d; }
    float rs = rsqrtf(wave_sum(q) * (1.f / D) + LN_EPS);
    float y[16];
    {
      const float* gp = g + 16 * lane; const float* bp = bb + 16 * lane;
      float* op = xout + (size_t)row * D + 16 * lane;
#pragma unroll
      for (int q4 = 0; q4 < 4; ++q4) {
        float4 g4 = *(const float4*)(gp + 4 * q4); float4 b4 = *(const float4*)(bp + 4 * q4);
        y[4 * q4 + 0] = (v[4 * q4 + 0] - mu) * rs * g4.x + b4.x; y[4 * q4 + 1] = (v[4 * q4 + 1] - mu) * rs * g4.y + b4.y;
        y[4 * q4 + 2] = (v[4 * q4 + 2] - mu) * rs * g4.z + b4.z; y[4 * q4 + 3] = (v[4 * q4 + 3] - mu) * rs * g4.w + b4.w;
        *(float4*)(op + 4 * q4) = make_float4(y[4 * q4], y[4 * q4 + 1], y[4 * q4 + 2], y[4 * q4 + 3]);
      }
    }
    if (write_next) {
      const float* mn = M + ((size_t)(layer + 1) * 3 + mod_index(row)) * 6144 + 16 * lane;
      float s2 = 0.f;
#pragma unroll
      for (int j = 0; j < 16; ++j) s2 += y[j];
      float mu2 = wave_sum(s2) * (1.f / D);
      float q2 = 0.f;
#pragma unroll
      for (int j = 0; j < 16; ++j) { float d = y[j] - mu2; q2 += d * d; }
      float rs2 = rsqrtf(wave_sum(q2) * (1.f / D) + LN_EPS);
      float o[16];
#pragma unroll
      for (int j = 0; j < 16; ++j) o[j] = (y[j] - mu2) * rs2 * (1.f + mn[D + j]) + mn[j];
      uint4* hp = (uint4*)(H + (size_t)row * D + 16 * lane);
      hp[0] = make_uint4(pack2bf(o[0], o[1]), pack2bf(o[2], o[3]), pack2bf(o[4], o[5]), pack2bf(o[6], o[7]));
      hp[1] = make_uint4(pack2bf(o[8], o[9]), pack2bf(o[10], o[11]), pack2bf(o[12], o[13]), pack2bf(o[14], o[15]));
    }
  }
}


__device__ __forceinline__ void ph_ada2(const float* __restrict__ c, const float* __restrict__ c_ctx, const float* __restrict__ ada_w,
                                        const float* __restrict__ ada_b, float* __restrict__ M, float* sm) {
  int tid = threadIdx.x, lane = tid & 63, wave = __builtin_amdgcn_readfirstlane(tid >> 6);
  float* sv = sm;
  float* red = sm + 3072;
  bool filled = false;
  GRID_LOOP(u, 192) {
    if (!filled) {
      for (int i = tid; i < 3072; i += 256) {
        int idx = i >> 10, k = i & 1023;
        float x = idx < 2 ? c[idx * D + k] : c_ctx[k];
        sv[i] = x / (1.f + expf(-x));
      }
      filled = true;
    }
    __syncthreads();
    int layer = u / 96, c0 = (u % 96) * 64;
    const float* w = ada_w + (size_t)layer * D * 6144 + c0 + lane;
    float a0 = 0.f, a1 = 0.f, a2 = 0.f;
    int kb = wave * 256;
#pragma unroll 16
    for (int k = 0; k < 256; ++k) {
      float wv = w[(size_t)(kb + k) * 6144];
      a0 += sv[kb + k] * wv; a1 += sv[1024 + kb + k] * wv; a2 += sv[2048 + kb + k] * wv;
    }
    red[(wave * 3 + 0) * 64 + lane] = a0; red[(wave * 3 + 1) * 64 + lane] = a1; red[(wave * 3 + 2) * 64 + lane] = a2;
    __syncthreads();
    if (wave < 3) {
      float r = red[(0 * 3 + wave) * 64 + lane] + red[(1 * 3 + wave) * 64 + lane] + red[(2 * 3 + wave) * 64 + lane] + red[(3 * 3 + wave) * 64 + lane];
      M[((size_t)layer * 3 + wave) * 6144 + c0 + lane] = r + ada_b[layer * 6144 + c0 + lane];
    }
  }
  __syncthreads();
}

__device__ __forceinline__ void ph_post_mod(const float* __restrict__ xa, const float* __restrict__ xb, const bf16_t* __restrict__ Y,
                                            const float* __restrict__ M, int layer, int jres, int mlayer, int jshift, int jscale, bool do_mod,
                                            const float* __restrict__ g, const float* __restrict__ bb,
                                            float* __restrict__ xout, bf16_t* __restrict__ H, int nrows,
                                            unsigned char* __restrict__ HQ = nullptr, float* __restrict__ HS = nullptr) {
  int lane = threadIdx.x & 63, wave = __builtin_amdgcn_readfirstlane(threadIdx.x >> 6);
  for (int row = blockIdx.x * 4 + wave; row < nrows; row += gridDim.x * 4) {
    const float* xr = (row < T ? xa + (size_t)row * D : xb + (size_t)(row - T) * D) + 16 * lane;
    const float* m = M + ((size_t)layer * 3 + mod_index(row)) * 6144 + 16 * lane;
    float yv[16];
    {
      const uint4* yp = (const uint4*)(Y + (size_t)row * D + 16 * lane);
      unpack8(yp[0], yv); unpack8(yp[1], yv + 8);
    }
    float v[16];
#pragma unroll
    for (int q4 = 0; q4 < 4; ++q4) {
      float4 x0 = *(const float4*)(xr + 4 * q4); float4 m0 = *(const float4*)(m + jres * D + 4 * q4);
      v[4 * q4 + 0] = DN_ALPHA * x0.x + m0.x * yv[4 * q4 + 0]; v[4 * q4 + 1] = DN_ALPHA * x0.y + m0.y * yv[4 * q4 + 1];
      v[4 * q4 + 2] = DN_ALPHA * x0.z + m0.z * yv[4 * q4 + 2]; v[4 * q4 + 3] = DN_ALPHA * x0.w + m0.w * yv[4 * q4 + 3];
    }
    float s = 0.f;
#pragma unroll
    for (int j = 0; j < 16; ++j) s += v[j];
    float mu = wave_sum(s) * (1.f / D);
    float q = 0.f;
#pragma unroll
    for (int j = 0; j < 16; ++j) { float d = v[j] - mu; q += d * d; }
    float rs = rsqrtf(wave_sum(q) * (1.f / D) + LN_EPS);
    float y[16];
    {
      const float* gp = g + 16 * lane; const float* bp = bb + 16 * lane;
      float* op = xout + (size_t)row * D + 16 * lane;
#pragma unroll
      for (int q4 = 0; q4 < 4; ++q4) {
        float4 g4 = *(const float4*)(gp + 4 * q4); float4 b4 = *(const float4*)(bp + 4 * q4);
        y[4 * q4 + 0] = (v[4 * q4 + 0] - mu) * rs * g4.x + b4.x; y[4 * q4 + 1] = (v[4 * q4 + 1] - mu) * rs * g4.y + b4.y;
        y[4 * q4 + 2] = (v[4 * q4 + 2] - mu) * rs * g4.z + b4.z; y[4 * q4 + 3] = (v[4 * q4 + 3] - mu) * rs * g4.w + b4.w;
        *(float4*)(op + 4 * q4) = make_float4(y[4 * q4], y[4 * q4 + 1], y[4 * q4 + 2], y[4 * q4 + 3]);
      }
    }
    if (do_mod) {
      const float* mm = M + ((size_t)mlayer * 3 + mod_index(row)) * 6144 + 16 * lane;
      float s2 = 0.f;
#pragma unroll
      for (int j = 0; j < 16; ++j) s2 += y[j];
      float mu2 = wave_sum(s2) * (1.f / D);
      float q2 = 0.f;
#pragma unroll
      for (int j = 0; j < 16; ++j) { float d = y[j] - mu2; q2 += d * d; }
      float rs2 = rsqrtf(wave_sum(q2) * (1.f / D) + LN_EPS);
      float o[16];
#pragma unroll
      for (int j = 0; j < 16; ++j) o[j] = (y[j] - mu2) * rs2 * (1.f + mm[jscale * D + j]) + mm[jshift * D + j];
      uint4* hp = (uint4*)(H + (size_t)row * D + 16 * lane);
      hp[0] = make_uint4(pack2bf(o[0], o[1]), pack2bf(o[2], o[3]), pack2bf(o[4], o[5]), pack2bf(o[6], o[7]));
      hp[1] = make_uint4(pack2bf(o[8], o[9]), pack2bf(o[10], o[11]), pack2bf(o[12], o[13]), pack2bf(o[14], o[15]));
      if (HQ) {
        float am = 0.f;
#pragma unroll
        for (int j = 0; j < 16; ++j) am = fmaxf(am, fabsf(o[j]));
        am = fmaxf(am, dpp_mov<0xB1>(am)); am = fmaxf(am, dpp_mov<0x4E>(am)); am = fmaxf(am, dpp_mov<0x124>(am)); am = fmaxf(am, dpp_mov<0x128>(am));
        float hinv = am > 0.f ? 119.f / am : 0.f; float hsc = am * (1.f / 119.f);
        float hsum = 0.f; unsigned pk[4];
#pragma unroll
        for (int k = 0; k < 2; ++k) {
          unsigned w0 = 0, w1 = 0;
#pragma unroll
          for (int j = 0; j < 4; ++j) {
            float r0 = rintf(o[8 * k + j] * hinv), r1 = rintf(o[8 * k + 4 + j] * hinv);
            hsum += r0 + r1;
            w0 = __builtin_amdgcn_cvt_pk_u8_f32(r0 + 128.f, j, w0); w1 = __builtin_amdgcn_cvt_pk_u8_f32(r1 + 128.f, j, w1);
          }
          unsigned t0 = (w0 + 0x08080808u) ^ 0x88888888u, t1 = (w1 + 0x08080808u) ^ 0x88888888u;
          pk[2 * k] = (t0 & 0xF0F0F0F0u) | ((t1 >> 4) & 0x0F0F0F0Fu);
          pk[2 * k + 1] = ((t0 << 4) & 0xF0F0F0F0u) | (t1 & 0x0F0F0F0Fu);
        }
        hsum += dpp_mov<0xB1>(hsum); hsum += dpp_mov<0x4E>(hsum); hsum += dpp_mov<0x124>(hsum); hsum += dpp_mov<0x128>(hsum);
        *(uint4*)(HQ + (size_t)row * D + 16 * lane) = make_uint4(pk[0], pk[1], pk[2], pk[3]);
        if ((lane & 15) == 0) *(float2*)(HS + ((size_t)row * 4 + (lane >> 4)) * 2) = make_float2(hsc, 0.5f * hsc * hsum);
      }
    }
  }
}


template <int CTRL> __device__ __forceinline__ float dpp_add(float x) { return x + dpp_mov<CTRL>(x); }
__device__ __forceinline__ float sum8(float v) {
  v = dpp_add<0xB1>(v); v = dpp_add<0x4E>(v); v = dpp_add<0x141>(v); return v;
}
typedef _Float16 half2_t __attribute__((ext_vector_type(2)));
__device__ __forceinline__ float dot2h(unsigned a, unsigned b, float c) {
  return __builtin_amdgcn_fdot2(__builtin_bit_cast(half2_t, a), __builtin_bit_cast(half2_t, b), c, false);
}
__device__ __forceinline__ unsigned pkh(float a, float b) { return __builtin_bit_cast(unsigned, __builtin_amdgcn_cvt_pkrtz(a, b)); }
__device__ __forceinline__ void load_e16(const int* __restrict__ EXP, int t, int g8, int (&e)[16]) {
  const int4* ep = (const int4*)(EXP + (size_t)t * 128 + 16 * g8);
  int4 a = ep[0], b = ep[1], c = ep[2], d = ep[3];
  e[0] = a.x; e[1] = a.y; e[2] = a.z; e[3] = a.w; e[4] = b.x; e[5] = b.y; e[6] = b.z; e[7] = b.w;
  e[8] = c.x; e[9] = c.y; e[10] = c.z; e[11] = c.w; e[12] = d.x; e[13] = d.y; e[14] = d.z; e[15] = d.w;
}
__device__ __forceinline__ int dpp_iadd_b1(int v) { return v + __builtin_amdgcn_mov_dpp(v, 0xB1, 0xf, 0xf, true); }
__device__ __forceinline__ int dpp_iadd_4e(int v) { return v + __builtin_amdgcn_mov_dpp(v, 0x4E, 0xf, 0xf, true); }
__device__ __forceinline__ int dpp_iadd_141(int v) { return v + __builtin_amdgcn_mov_dpp(v, 0x141, 0xf, 0xf, true); }
#define U_TOKEN(tt, UV, UVN, EUSE, ELD, HUSE, HLD, SUSE, SLD) { \
    int tnn_ = min((tt) + 2 * st, nrows - 1); \
    load_e16(EXP, tnn_, g8, ELD); \
    HLD[0] = *(const uint4*)(hb + (size_t)tnn_ * D); HLD[1] = *(const uint4*)(hb + (size_t)tnn_ * D + 16); \
    SLD = *(const float2*)(HS + ((size_t)tnn_ * 4 + x) * 2); \
    __builtin_amdgcn_sched_barrier(0); \
    _Pragma("unroll") for (int i = 0; i < 16; ++i) UVN[i] = *(const uint4*)(ubs + (((unsigned)EUSE[i] << 7) + loff)); \
    __builtin_amdgcn_sched_barrier(0); \
    int a0_ = (int)HUSE[0].x, b0_ = (int)HUSE[0].y, a1_ = (int)HUSE[0].z, b1_ = (int)HUSE[0].w; \
    int a2_ = (int)HUSE[1].x, b2_ = (int)HUSE[1].y, a3_ = (int)HUSE[1].z, b3_ = (int)HUSE[1].w; \
    int k0 = 0, k1 = 0; \
    _Pragma("unroll") for (int i = 0; i < 16; ++i) { \
      int pa_ = __builtin_amdgcn_sdot8((int)UV[i].x, a0_, 0, false); pa_ = __builtin_amdgcn_sdot8((int)UV[i].y, a1_, pa_, false); \
      pa_ = __builtin_amdgcn_sdot8((int)UV[i].z, a2_, pa_, false); pa_ = __builtin_amdgcn_sdot8((int)UV[i].w, a3_, pa_, false); \
      int pb_ = __builtin_amdgcn_sdot8((int)UV[i].x, b0_, 0, false); pb_ = __builtin_amdgcn_sdot8((int)UV[i].y, b1_, pb_, false); \
      pb_ = __builtin_amdgcn_sdot8((int)UV[i].z, b2_, pb_, false); pb_ = __builtin_amdgcn_sdot8((int)UV[i].w, b3_, pb_, false); \
      int p_ = dpp_iadd_141(dpp_iadd_4e(dpp_iadd_b1((pa_ << 4) + pb_))); \
      if ((i >> 1) == j8) { if (i & 1) k1 = p_; else k0 = p_; } } \
    *(float2*)(PA + ((size_t)(tt) * 4 + x) * 128 + 16 * g8 + 2 * j8) = make_float2(fmaf((float)k0, SUSE.x, SUSE.y), fmaf((float)k1, SUSE.x, SUSE.y)); }
__device__ __forceinline__ void ph_peer_u(const unsigned char* __restrict__ HQ, const float* __restrict__ HS, const int* __restrict__ EXP,
                                          const unsigned char* __restrict__ U4, float* __restrict__ PA, int nrows) {
  int lane = threadIdx.x & 63, wave = __builtin_amdgcn_readfirstlane(threadIdx.x >> 6);
  int x = (blockIdx.x & 7) >> 1; int nb8 = gridDim.x >> 3;
  if ((int)(blockIdx.x >> 3) >= nb8) return;
  int j8 = lane & 7, g8 = lane >> 3;
  const int st = nb8 * 8;
  int t = ((blockIdx.x >> 3) * 2 + (blockIdx.x & 1)) * 4 + wave;
  if (t >= nrows) return;
  const unsigned char* ubs = U4 + (size_t)x * ((size_t)16384 * 128);
  const unsigned loff = 16u * (unsigned)j8;
  const unsigned char* hb = HQ + 256 * x + 32 * j8;
  int eA[16], eB[16]; uint4 hA[2], hB[2], uvA[16], uvB[16]; float2 sA, sB;
  {
    int e0[16]; load_e16(EXP, t, g8, e0);
#pragma unroll
    for (int i = 0; i < 16; ++i) uvA[i] = *(const uint4*)(ubs + (((unsigned)e0[i] << 7) + loff));
    hA[0] = *(const uint4*)(hb + (size_t)t * D); hA[1] = *(const uint4*)(hb + (size_t)t * D + 16);
    sA = *(const float2*)(HS + ((size_t)t * 4 + x) * 2);
    int tn = min(t + st, nrows - 1);
    load_e16(EXP, tn, g8, eA);
    hB[0] = *(const uint4*)(hb + (size_t)tn * D); hB[1] = *(const uint4*)(hb + (size_t)tn * D + 16);
    sB = *(const float2*)(HS + ((size_t)tn * 4 + x) * 2);
  }
#pragma unroll 1
  for (; t < nrows; t += 2 * st) {
    uint4 hC[2]; float2 sC;
    U_TOKEN(t, uvA, uvB, eA, eB, hA, hC, sA, sC)
    if (t + st < nrows) {
      U_TOKEN(t + st, uvB, uvA, eB, eA, hB, hA, sB, sA)
    }
    hB[0] = hA[0]; hB[1] = hA[1]; hA[0] = hC[0]; hA[1] = hC[1]; sB = sA; sA = sC;
  }
}
template <int FMT> __device__ __forceinline__ void ph_peer_w(const float* __restrict__ PA, const int* __restrict__ EXP, const float* __restrict__ GATE,
                                          const float* __restrict__ USC, const float* __restrict__ VSC, unsigned* __restrict__ WQ,
                                          float* __restrict__ SW, int nrows) {
  int lane = threadIdx.x & 63, wave = __builtin_amdgcn_readfirstlane(threadIdx.x >> 6);
  int l4 = lane & 31;
  for (int t = blockIdx.x * 4 + wave; t < nrows; t += gridDim.x * 4) {
    int4 e = *(const int4*)(EXP + (size_t)t * 128 + 4 * l4);
    float4 gt = *(const float4*)(GATE + (size_t)t * 128 + 4 * l4);
    float a[4] = {0.f, 0.f, 0.f, 0.f};
#pragma unroll
    for (int xs = 0; xs < 4; ++xs) { float4 p = *(const float4*)(PA + ((size_t)t * 4 + xs) * 128 + 4 * l4); a[0] += p.x; a[1] += p.y; a[2] += p.z; a[3] += p.w; }
    int ee[4] = {e.x, e.y, e.z, e.w}; float gg[4] = {gt.x, gt.y, gt.z, gt.w}; float w[4]; float wm = 0.f;
#pragma unroll
    for (int j = 0; j < 4; ++j) {
      float av = a[j] * USC[ee[j]];
      w[j] = gg[j] * 0.5f * av * (1.f + erff(av * 0.70710678118654752f)) * VSC[ee[j]];
      wm = fmaxf(wm, fabsf(w[j]));
    }
    wm = wave_max(wm);
    float winv = wm > 0.f ? 127.f / wm : 0.f;
    unsigned q = 0;
#pragma unroll
    for (int j = 0; j < 4; ++j) q = __builtin_amdgcn_cvt_pk_u8_f32(rintf(w[j] * winv) + 128.f, j, q);
    q ^= 0x80808080u;
    if (FMT == 0) { if (lane < 32) WQ[(size_t)t * 32 + l4] = q; }
    else if (lane < 32) {
      unsigned char* wp = (unsigned char*)WQ + (size_t)t * 128 + 64 * ((l4 >> 1) & 1) + 32 * (l4 & 1) + (l4 >> 2);
      wp[0] = (unsigned char)q; wp[8] = (unsigned char)(q >> 8); wp[16] = (unsigned char)(q >> 16); wp[24] = (unsigned char)(q >> 24);
    }
    if (FMT == 2) {
      float qs = 0.f;
#pragma unroll
      for (int j = 0; j < 4; ++j) qs += rintf(w[j] * winv);
      qs = wave_sum(lane < 32 ? qs : 0.f);
      if (lane == 0) *(float2*)(SW + 2 * (size_t)t) = make_float2(wm * (1.f / (127.f * 16.f)), 0.5f * wm * (1.f / 127.f) * qs);
    } else
    if (lane == 0) SW[t] = wm * (1.f / 127.f);
  }
}
__device__ __forceinline__ void load_w16(const float* __restrict__ W, int t, int g8, float (&w)[16]) {
  const float4* wp = (const float4*)(W + (size_t)t * 128 + 16 * g8);
  float4 wa = wp[0], wb = wp[1], wc = wp[2], wd = wp[3];
  w[0] = wa.x; w[1] = wa.y; w[2] = wa.z; w[3] = wa.w; w[4] = wb.x; w[5] = wb.y; w[6] = wb.z; w[7] = wb.w;
  w[8] = wc.x; w[9] = wc.y; w[10] = wc.z; w[11] = wc.w; w[12] = wd.x; w[13] = wd.y; w[14] = wd.z; w[15] = wd.w;
}
#define V_TOKEN(tt, VV, VVN, EUSE, ELD, WUSE, WLD, SUSE, SLD) { \
    int tnn_ = min((tt) + 2 * st, nrows - 1); \
    load_e16(EXP, tnn_, g8, ELD); \
    WLD = *(const uint4*)(WQ + (size_t)tnn_ * 32 + 4 * g8); SLD = SW[tnn_]; \
    __builtin_amdgcn_sched_barrier(0); \
    _Pragma("unroll") for (int i = 0; i < 16; ++i) VVN[i] = *(const uint4*)(vbs + (((unsigned)EUSE[i] << 7) + loff)); \
    __builtin_amdgcn_sched_barrier(0); \
    int acc[16]; \
    _Pragma("unroll") for (int j = 0; j < 16; ++j) acc[j] = 0; \
    int wq[4] = {(int)WUSE.x, (int)WUSE.y, (int)WUSE.z, (int)WUSE.w}; \
    _Pragma("unroll") for (int m = 0; m < 4; ++m) { \
      unsigned r0[4] = {VV[4 * m].x, VV[4 * m].y, VV[4 * m].z, VV[4 * m].w}; \
      unsigned r1[4] = {VV[4 * m + 1].x, VV[4 * m + 1].y, VV[4 * m + 1].z, VV[4 * m + 1].w}; \
      unsigned r2[4] = {VV[4 * m + 2].x, VV[4 * m + 2].y, VV[4 * m + 2].z, VV[4 * m + 2].w}; \
      unsigned r3[4] = {VV[4 * m + 3].x, VV[4 * m + 3].y, VV[4 * m + 3].z, VV[4 * m + 3].w}; \
      _Pragma("unroll") for (int k = 0; k < 4; ++k) { \
          \
        unsigned a0 = __builtin_amdgcn_perm(r1[k], r0[k], 0x05010400u);     \
        unsigned a1 = __builtin_amdgcn_perm(r1[k], r0[k], 0x07030602u);     \
        unsigned a2 = __builtin_amdgcn_perm(r3[k], r2[k], 0x05010400u); \
        unsigned a3 = __builtin_amdgcn_perm(r3[k], r2[k], 0x07030602u); \
        unsigned t0 = __builtin_amdgcn_perm(a2, a0, 0x05040100u);           \
        unsigned t1 = __builtin_amdgcn_perm(a2, a0, 0x07060302u); \
        unsigned t2 = __builtin_amdgcn_perm(a3, a1, 0x05040100u); \
        unsigned t3 = __builtin_amdgcn_perm(a3, a1, 0x07060302u); \
        acc[4 * k + 0] = __builtin_amdgcn_sdot4((int)t0, wq[m], acc[4 * k + 0], false); \
        acc[4 * k + 1] = __builtin_amdgcn_sdot4((int)t1, wq[m], acc[4 * k + 1], false); \
        acc[4 * k + 2] = __builtin_amdgcn_sdot4((int)t2, wq[m], acc[4 * k + 2], false); \
        acc[4 * k + 3] = __builtin_amdgcn_sdot4((int)t3, wq[m], acc[4 * k + 3], false); } } \
    float of[16]; \
    _Pragma("unroll") for (int j = 0; j < 16; ++j) { float v = (float)acc[j]; v += dpp_mov<0x128>(v); of[j] = xrow16_sum(v) * SUSE; } \
    if (g8 == 0) { \
      uint4* fp = (uint4*)(F + (size_t)(tt) * D + 128 * x + 16 * j8); \
      fp[0] = make_uint4(pack2bf(of[0], of[1]), pack2bf(of[2], of[3]), pack2bf(of[4], of[5]), pack2bf(of[6], of[7])); \
      fp[1] = make_uint4(pack2bf(of[8], of[9]), pack2bf(of[10], of[11]), pack2bf(of[12], of[13]), pack2bf(of[14], of[15])); } }
__device__ __forceinline__ void ph_peer_v(const unsigned* __restrict__ WQ, const float* __restrict__ SW, const int* __restrict__ EXP,
                                          const unsigned char* __restrict__ V8, bf16_t* __restrict__ F, int nrows) {
  int lane = threadIdx.x & 63, wave = __builtin_amdgcn_readfirstlane(threadIdx.x >> 6);
  int x = blockIdx.x & 7; int nb8 = gridDim.x >> 3;
  if ((int)(blockIdx.x >> 3) >= nb8) return;
  int j8 = lane & 7, g8 = lane >> 3;
  const int st = nb8 * 4;
  int t = (blockIdx.x >> 3) * 4 + wave;
  if (t >= nrows) return;
  const unsigned char* vbs = V8 + (size_t)x * ((size_t)16384 * 128);
  const unsigned loff = 16u * (unsigned)j8;
  int eA[16], eB[16]; uint4 wA, wB, vvA[16], vvB[16]; float sA, sB;
  {
    int e0[16]; load_e16(EXP, t, g8, e0);
#pragma unroll
    for (int i = 0; i < 16; ++i) vvA[i] = *(const uint4*)(vbs + (((unsigned)e0[i] << 7) + loff));
    wA = *(const uint4*)(WQ + (size_t)t * 32 + 4 * g8); sA = SW[t];
    int tn = min(t + st, nrows - 1);
    load_e16(EXP, tn, g8, eA);
    wB = *(const uint4*)(WQ + (size_t)tn * 32 + 4 * g8); sB = SW[tn];
  }
#pragma unroll 1
  for (; t < nrows; t += 2 * st) {
    uint4 wC; float sC;
    V_TOKEN(t, vvA, vvB, eA, eB, wA, wC, sA, sC)
    if (t + st < nrows) {
      V_TOKEN(t + st, vvB, vvA, eB, eA, wB, wA, sB, sA)
    }
    wB = wA; sB = sA; wA = wC; sA = sC;
  }
}

typedef int v4i_t __attribute__((ext_vector_type(4)));
typedef int v2i_t __attribute__((ext_vector_type(2)));
__device__ __forceinline__ v2i_t lds_tr8(const char* p) { return __builtin_amdgcn_ds_read_tr8_b64_v2i32((__attribute__((address_space(3))) v2i_t*)p); }
#define V2_DMA_HALF(E, h, buf) { _Pragma("unroll") for (int pi = 0; pi < 8; ++pi) \
    __builtin_amdgcn_global_load_lds((const unsigned*)(vbs + (((unsigned)E[8 * (h) + pi] << 7) + ((pi & 2) ? offO : offE))), \
                                     (unsigned*)((buf) + pi * 1024 + lane * 16), 16, 0, 0); }
#define V2_COMPUTE(buf, WQH) { _Pragma("unroll") for (int mt = 0; mt < 8; ++mt) { \
      v2i_t r0_ = lds_tr8((buf) + rdoff[mt]); v2i_t r1_ = lds_tr8((buf) + rdoff[mt] + 1024); \
      v4i_t a_ = {r0_.x, r0_.y, r1_.x, r1_.y}; \
      acc[mt] = __builtin_amdgcn_mfma_i32_16x16x64_i8(a_, WQH, acc[mt], 0, 0, 0); } }
__device__ __forceinline__ void ph_peer_v2(const unsigned char* WQ2, const float* SW, const int* EXP,
                                           const unsigned char* __restrict__ V8, bf16_t* F, int nrows, char* smem) {
  int lane = threadIdx.x & 63, wave = __builtin_amdgcn_readfirstlane(threadIdx.x >> 6);
  int x = blockIdx.x & 7; int nb8 = gridDim.x >> 3;
  if ((int)(blockIdx.x >> 3) >= nb8) return;
  const int q8 = lane >> 3, c8 = lane & 7, n16 = lane & 15, g = lane >> 4;
  const int st = nb8 * 4;
  int t = (blockIdx.x >> 3) * 4 + wave;
  if (t >= nrows) return;
  const unsigned char* vbs = V8 + (size_t)x * ((size_t)16384 * 128);
  char* buf0 = smem + wave * 16384; char* buf1 = buf0 + 8192;
  const unsigned offE = 16u * (unsigned)(c8 ^ (q8 >> 1)), offO = offE ^ 64u;
  int rdoff[8];
#pragma unroll
  for (int mt = 0; mt < 8; ++mt) rdoff[mt] = 2048 * g + 128 * (n16 >> 1) + 16 * (mt ^ (n16 >> 2) ^ ((g & 1) << 2)) + 8 * (n16 & 1);
  int eC[16], eN[16];
  load_e16(EXP, t, q8, eC);
  v4i_t w0 = *(const v4i_t*)(WQ2 + (size_t)t * 128 + 16 * g), w1 = *(const v4i_t*)(WQ2 + (size_t)t * 128 + 64 + 16 * g);
  float sw = SW[t];
  V2_DMA_HALF(eC, 0, buf0)
#pragma unroll 1
  for (; t < nrows; t += st) {
    int tn = min(t + st, nrows - 1);
    asm volatile("s_waitcnt vmcnt(0)" ::: "memory");
    __builtin_amdgcn_sched_barrier(0);
    V2_DMA_HALF(eC, 1, buf1)
    load_e16(EXP, tn, q8, eN);
    v4i_t w0n = *(const v4i_t*)(WQ2 + (size_t)tn * 128 + 16 * g), w1n = *(const v4i_t*)(WQ2 + (size_t)tn * 128 + 64 + 16 * g);
    float swn = SW[tn];
    __builtin_amdgcn_sched_barrier(0);
    v4i_t acc[8];
#pragma unroll
    for (int mt = 0; mt < 8; ++mt) acc[mt] = (v4i_t){0, 0, 0, 0};
    V2_COMPUTE(buf0, w0)
    __builtin_amdgcn_sched_barrier(0);
    asm volatile("s_waitcnt vmcnt(0)" ::: "memory");
    asm volatile("" : "+v"(eN[0]), "+v"(eN[1]), "+v"(eN[2]), "+v"(eN[3]), "+v"(eN[4]), "+v"(eN[5]), "+v"(eN[6]), "+v"(eN[7]));
    V2_DMA_HALF(eN, 0, buf0)
    __builtin_amdgcn_sched_barrier(0);
    V2_COMPUTE(buf1, w1)
    v4i_t sel = acc[0];
#pragma unroll
    for (int mt = 1; mt < 8; ++mt) { bool pk = (n16 & 7) == mt; sel.x = pk ? acc[mt].x : sel.x; sel.y = pk ? acc[mt].y : sel.y; sel.z = pk ? acc[mt].z : sel.z; sel.w = pk ? acc[mt].w : sel.w; }
    if (n16 < 8)
      *(uint2*)(F + (size_t)t * D + 128 * x + 16 * n16 + 4 * g) = make_uint2(pack2bf((float)sel.x * sw, (float)sel.y * sw), pack2bf((float)sel.z * sw, (float)sel.w * sw));
    __builtin_amdgcn_sched_barrier(0);
#pragma unroll
    for (int i = 0; i < 16; ++i) eC[i] = eN[i];
    w0 = w0n; w1 = w1n; sw = swn;
  }
  asm volatile("s_waitcnt vmcnt(0)" ::: "memory");
}

#define V4_COMPUTE(buf, WQH) { _Pragma("unroll") for (int cg = 0; cg < 8; ++cg) { \
      v2i_t r0_ = lds_tr8((buf) + rdoff[cg]); v2i_t r1_ = lds_tr8((buf) + rdoff[cg] + 1024); \
      const int NM_ = (int)0xF0F0F0F0u; \
      v4i_t ah_ = {r0_.x & NM_, r0_.y & NM_, r1_.x & NM_, r1_.y & NM_}; \
      v4i_t al_ = {(r0_.x << 4) & NM_, (r0_.y << 4) & NM_, (r1_.x << 4) & NM_, (r1_.y << 4) & NM_}; \
      accH[cg] = __builtin_amdgcn_mfma_i32_16x16x64_i8(ah_, WQH, accH[cg], 0, 0, 0); \
      accL[cg] = __builtin_amdgcn_mfma_i32_16x16x64_i8(al_, WQH, accL[cg], 0, 0, 0); } }
__device__ __forceinline__ void ph_peer_v4(const unsigned char* WQ2, const float* SW2, const int* EXP,
                                           const unsigned char* __restrict__ V4, bf16_t* F, int nrows, char* smem) {
  int lane = threadIdx.x & 63, wave = __builtin_amdgcn_readfirstlane(threadIdx.x >> 6);
  int x = (blockIdx.x & 7) >> 1; int nb8 = gridDim.x >> 3;
  if ((int)(blockIdx.x >> 3) >= nb8) return;
  const int q8 = lane >> 3, c8 = lane & 7, n16 = lane & 15, g = lane >> 4;
  const int st = nb8 * 8;
  int t = ((blockIdx.x >> 3) * 2 + (blockIdx.x & 1)) * 4 + wave;
  if (t >= nrows) return;
  const unsigned char* vbs = V4 + (size_t)x * ((size_t)16384 * 128);
  char* buf0 = smem + wave * 16384; char* buf1 = buf0 + 8192;
  const unsigned offE = 16u * (unsigned)(c8 ^ (q8 >> 1)), offO = offE ^ 64u;
  int rdoff[8];
#pragma unroll
  for (int mt = 0; mt < 8; ++mt) rdoff[mt] = 2048 * g + 128 * (n16 >> 1) + 16 * (mt ^ (n16 >> 2) ^ ((g & 1) << 2)) + 8 * (n16 & 1);
  int eC[16], eN[16];
  load_e16(EXP, t, q8, eC);
  v4i_t w0 = *(const v4i_t*)(WQ2 + (size_t)t * 128 + 16 * g), w1 = *(const v4i_t*)(WQ2 + (size_t)t * 128 + 64 + 16 * g);
  float2 sw = *(const float2*)(SW2 + 2 * (size_t)t);
  V2_DMA_HALF(eC, 0, buf0)
#pragma unroll 1
  for (; t < nrows; t += st) {
    int tn = min(t + st, nrows - 1);
    asm volatile("s_waitcnt vmcnt(0)" ::: "memory");
    __builtin_amdgcn_sched_barrier(0);
    V2_DMA_HALF(eC, 1, buf1)
    load_e16(EXP, tn, q8, eN);
    v4i_t w0n = *(const v4i_t*)(WQ2 + (size_t)tn * 128 + 16 * g), w1n = *(const v4i_t*)(WQ2 + (size_t)tn * 128 + 64 + 16 * g);
    float2 swn = *(const float2*)(SW2 + 2 * (size_t)tn);
    __builtin_amdgcn_sched_barrier(0);
    v4i_t accH[8], accL[8];
#pragma unroll
    for (int cg = 0; cg < 8; ++cg) { accH[cg] = (v4i_t){0, 0, 0, 0}; accL[cg] = (v4i_t){0, 0, 0, 0}; }
    V4_COMPUTE(buf0, w0)
    __builtin_amdgcn_sched_barrier(0);
    asm volatile("s_waitcnt vmcnt(0)" ::: "memory");
    asm volatile("" : "+v"(eN[0]), "+v"(eN[1]), "+v"(eN[2]), "+v"(eN[3]), "+v"(eN[4]), "+v"(eN[5]), "+v"(eN[6]), "+v"(eN[7]));
    V2_DMA_HALF(eN, 0, buf0)
    __builtin_amdgcn_sched_barrier(0);
    V4_COMPUTE(buf1, w1)
    v4i_t sh = accH[0], sl = accL[0];
#pragma unroll
    for (int cg = 1; cg < 8; ++cg) { bool pk = (n16 & 7) == cg;
      sh.x = pk ? accH[cg].x : sh.x; sh.y = pk ? accH[cg].y : sh.y; sh.z = pk ? accH[cg].z : sh.z; sh.w = pk ? accH[cg].w : sh.w;
      sl.x = pk ? accL[cg].x : sl.x; sl.y = pk ? accL[cg].y : sl.y; sl.z = pk ? accL[cg].z : sl.z; sl.w = pk ? accL[cg].w : sl.w; }
    if (n16 < 8)
      *(uint4*)(F + (size_t)t * D + 256 * x + 32 * n16 + 8 * g) =
          make_uint4(pack2bf(fmaf((float)sh.x, sw.x, sw.y), fmaf((float)sh.y, sw.x, sw.y)), pack2bf(fmaf((float)sh.z, sw.x, sw.y), fmaf((float)sh.w, sw.x, sw.y)),
                     pack2bf(fmaf((float)sl.x, sw.x, sw.y), fmaf((float)sl.y, sw.x, sw.y)), pack2bf(fmaf((float)sl.z, sw.x, sw.y), fmaf((float)sl.w, sw.x, sw.y)));
    __builtin_amdgcn_sched_barrier(0);
#pragma unroll
    for (int i = 0; i < 16; ++i) eC[i] = eN[i];
    w0 = w0n; w1 = w1n; sw = swn;
  }
  asm volatile("s_waitcnt vmcnt(0)" ::: "memory");
}

#define XB_TMO      128
#define XB_XCNT(j)  (256  + 64 * (j))
#define XB_XSUB(j)  (1280 + 64 * (j))
#define XB_XGEN(j)  (2304 + 64 * (j))
#define XB_TOP      3328
#define XB_TOPGEN   3392
#define XCD_BAR_WORDS 3456
#define XB_SPIN_CAP (1u << 22)
#define LAS __attribute__((address_space(3)))
__device__ __forceinline__ unsigned xb_ld(unsigned* p)              { return __hip_atomic_load(p, __ATOMIC_RELAXED, __HIP_MEMORY_SCOPE_AGENT); }
__device__ __forceinline__ unsigned xb_add(unsigned* p, unsigned v) { return __hip_atomic_fetch_add(p, v, __ATOMIC_RELAXED, __HIP_MEMORY_SCOPE_AGENT); }
__device__ __forceinline__ unsigned xb_xcc_id() { return (unsigned)__builtin_amdgcn_s_getreg((3 << 11) | 20) & 0xFu; }
#define XB_SPIN(cond, bar) do { unsigned _sp = 0; while (cond) { __builtin_amdgcn_s_sleep(1); \
    if ((++_sp & 255u) == 0u) { if (xb_ld(&(bar)[XB_TMO])) break; if (_sp > XB_SPIN_CAP) { atomicAdd(&(bar)[XB_TMO], 1u); break; } } } } while (0)
struct XcdBarrier { unsigned* bar; unsigned x; volatile LAS unsigned* st; };
__device__ __forceinline__ XcdBarrier xcd_barrier_post(unsigned* bar, volatile LAS unsigned* st) {
  XcdBarrier b; b.bar = bar; b.x = xb_xcc_id(); b.st = st;
  if (threadIdx.x == 0) (void)xb_add(&bar[XB_XCNT(b.x)], 1u);
  return b;
}
__device__ __forceinline__ void xcd_barrier_complete(unsigned* bar, unsigned x, unsigned& nloc, unsigned& nx) {
  const unsigned G = gridDim.x * gridDim.y * gridDim.z;
  unsigned sum, cnt, mine, sp = 0u;
  for (;;) {
    sum = 0u; cnt = 0u; mine = 0u;
#pragma unroll
    for (unsigned j = 0; j < 16; ++j) { const unsigned c = xb_ld(&bar[XB_XCNT(j)]); sum += c; cnt += (c > 0u) ? 1u : 0u; mine = (j == x) ? c : mine; }
    if (sum == G) break;
    __builtin_amdgcn_s_sleep(1);
    if ((++sp & 255u) == 0u) { if (xb_ld(&bar[XB_TMO])) break; if (sp > XB_SPIN_CAP) { atomicAdd(&bar[XB_TMO], 1u); break; } }
  }
  nloc = mine > 0u ? mine : 1u; nx = cnt > 0u ? cnt : 1u;
}
__device__ __forceinline__ void xcd_barrier(const XcdBarrier& b) {
  asm volatile("s_waitcnt vmcnt(0)" ::: "memory");
  __syncthreads();
  if (threadIdx.x == 0) {
    unsigned* bar = b.bar;
    __builtin_amdgcn_s_waitcnt(0);
    unsigned nloc = b.st[0], nx = b.st[1];
    if (nloc == 0u) { xcd_barrier_complete(bar, b.x, nloc, nx); b.st[0] = nloc; b.st[1] = nx; }
    const unsigned old = xb_add(&bar[XB_XSUB(b.x)], 1u);
    const unsigned gen = old / nloc;
    if (old + 1u == (gen + 1u) * nloc) {
      __builtin_amdgcn_fence(__ATOMIC_RELEASE, "agent");
      asm volatile("s_waitcnt vmcnt(0)" ::: "memory");
      const unsigned og = xb_add(&bar[XB_TOP], 1u);
      const unsigned tg = og / nx;
      if (og + 1u == (tg + 1u) * nx) xb_add(&bar[XB_TOPGEN], 1u);
      else XB_SPIN(xb_ld(&bar[XB_TOPGEN]) == tg, bar);
      __builtin_amdgcn_fence(__ATOMIC_ACQUIRE, "agent");
      xb_add(&bar[XB_XGEN(b.x)], 1u);
      asm volatile("s_waitcnt vmcnt(0)" ::: "memory");
    } else {
      XB_SPIN(xb_ld(&bar[XB_XGEN(b.x)]) == gen, bar);
      __builtin_amdgcn_fence(__ATOMIC_ACQUIRE, "agent");
      asm volatile("s_waitcnt vmcnt(0)" ::: "memory");
    }
  }
  __syncthreads();
}

constexpr int SMEM_BYTES = 65536;
#ifndef PHMASK
#define PHMASK 0xFFFFFFFFFFFFFFFFull
#endif
#ifndef PHDUP
#define PHDUP 0ull
#endif
#define PH(n, ...) if constexpr ((((unsigned long long)(PHMASK)) >> (n)) & 1ull) { __VA_ARGS__; if constexpr ((((unsigned long long)(PHDUP)) >> (n)) & 1ull) { xcd_barrier(xbar); __VA_ARGS__; } }

__global__ __launch_bounds__(256, 2) void mega(Params p) {
  __shared__ __attribute__((aligned(16))) char smem_raw[SMEM_BYTES + 16];
  if (threadIdx.x == 0) *(uint4*)(smem_raw + SMEM_BYTES) = make_uint4(0u, 0u, 0u, 0u);
  __syncthreads();
  XcdBarrier xbar = xcd_barrier_post((unsigned*)((char*)p.ws + OFF_BAR), (volatile LAS unsigned*)(smem_raw + SMEM_BYTES));
  float* smem = (float*)smem_raw;
  const float* x = p.in[0]; const float* c = p.in[1]; const float* ctx = p.in[2]; const float* c_ctx = p.in[3];
  const float* ada_w = p.in[4]; const float* ada_b = p.in[5]; const float* ln_g = p.in[6]; const float* ln_b = p.in[7];
  const float* even_w_in = p.in[8]; const float* even_w_out = p.in[9]; const float* rpb = p.in[10];
  const float* odd_w_in = p.in[11]; const float* odd_w_out = p.in[12]; const float* sink = p.in[13];
  const float* peer_wq = p.in[14]; const float* peer_sk = p.in[15]; const float* peer_u = p.in[16]; const float* peer_v = p.in[17];
  char* ws = (char*)p.ws;
  float* TAB = (float*)(ws + OFF_TAB); float* Mm = (float*)(ws + OFF_M);
  bf16_t* WIN0 = (bf16_t*)(ws + OFF_WIN0); bf16_t* WOUT0 = (bf16_t*)(ws + OFF_WOUT0);
  bf16_t* WIN1 = (bf16_t*)(ws + OFF_WIN1); bf16_t* WOUT1 = (bf16_t*)(ws + OFF_WOUT1);
  bf16_t* WQ = (bf16_t*)(ws + OFF_WQ); bf16_t* SKB = (bf16_t*)(ws + OFF_SK);
  unsigned char* U8 = (unsigned char*)(ws + OFF_UB); unsigned char* V8 = (unsigned char*)(ws + OFF_VB);
  float* USC = (float*)(ws + OFF_USC); float* VSC = USC + 2 * 16384;
  bf16_t* AB = (bf16_t*)(ws + OFF_AB);
  bf16_t* FD1 = (bf16_t*)(ws + OFF_FT); bf16_t* FD3 = FD1 + 256 * 128; bf16_t* FDC = FD3 + 128 * 128;
  bf16_t* A1 = (bf16_t*)(ws + OFF_A1); bf16_t* VT0 = (bf16_t*)(ws + OFF_VT0); bf16_t* FQKV = (bf16_t*)(ws + OFF_BF);
  float* BF_ = (float*)(ws + OFF_BF); float* BY = (float*)(ws + OFF_BY);
  float* X1 = (float*)(ws + OFF_X1); float* X2 = (float*)(ws + OFF_X2);
  float* RT = TAB + 16384;
  bf16_t* Q1 = (bf16_t*)(ws + OFF_BF); bf16_t* K1 = Q1 + (size_t)T * 1024; bf16_t* VT1 = K1 + (size_t)R * 256;
  bf16_t* YB = (bf16_t*)(ws + OFF_BY + (size_t)2 * R * 128 * 4);
  float* PAB = (float*)(ws + OFF_BF); bf16_t* FB = (bf16_t*)(ws + OFF_BF + (size_t)R * 8 * 128 * 4);
  float* WB = (float*)(ws + OFF_BF + (size_t)R * 8 * 128 * 4 + (size_t)R * 1024 * 2); float* CORRB = WB + (size_t)R * 128;
  unsigned char* HQB = (unsigned char*)(ws + OFF_BF + (size_t)R * 8 * 128 * 4 + (size_t)R * 1024 * 2 + (size_t)R * 130 * 4);
  float* HSB = (float*)(HQB + (size_t)R * 1024);
  int* EXPB = (int*)(ws + OFF_BY); float* GATEB = (float*)(ws + OFF_BY + (size_t)R * 128 * 4);
  float* out = p.out;
  unsigned* QC = (unsigned*)(ws + OFF_BAR) + 32;
#define QFILL(site, layer, lo, hi) quant_fill(QC + (site), (layer), (lo), (hi), peer_u, peer_v, U8, V8, USC, VSC, (unsigned*)(smem_raw + 65024))

  PH(0, ph_tables(TAB); ph_rope_table(RT))
  PH(1, ph_fft_tables(FD1, FD3, FDC))
  PH(2, ph_ada2(c, c_ctx, ada_w, ada_b, Mm, smem))
  PH(3, ph_transpose_w(even_w_in, 1024, 2048, WIN0, smem))
  PH(4, ph_transpose_w(even_w_out, 1024, 1024, WOUT0, smem))
  PH(5, ph_transpose_w(odd_w_in, 1024, 1536, WIN1, smem))
  PH(6, ph_transpose_w(odd_w_out, 1024, 1024, WOUT1, smem))
  PH(7, ph_transpose_w(peer_wq, 1024, 2048, WQ, smem))
  PH(8, ph_transpose_w(peer_wq + (size_t)1024 * 2048, 1024, 2048, WQ + (size_t)2048 * 1024, smem))
  PH(11, ph_convert(peer_sk, SKB, (size_t)2 * 8 * 2 * 128 * 128 / 8))
  xcd_barrier(xbar);
  PH(12, ph_modulate(x, ctx, Mm, 0, 0, 1, AB, R, smem))
  xcd_barrier(xbar);
  PH(13, ph_gemm_bf16(AB, 1024, WIN0, 1024, R, 2048, 1024, EpiQKV0{FQKV, VT0}, smem_raw))
  PH(9, QFILL(0, 0, 0u, 160u))
  xcd_barrier(xbar);
#ifdef GPROBE
  ph_gemm_probe<GPROBE>(AB, 1024, WIN0, 1024, R, 2048, 1024, X2, smem_raw);
  xcd_barrier(xbar);
#endif
  PH(14, { GRID_LOOP(u, NB * 64 * 8) fft1_unit(u, FQKV, FD1, TAB, A1, smem_raw); })
  PH(15, { int lane = threadIdx.x & 63, wave = __builtin_amdgcn_readfirstlane(threadIdx.x >> 6);
           __syncthreads();
           for (int i = threadIdx.x; i < 8 * 15 * 31; i += 256) smem[i] = rpb[i] * 1.4426950408889634f;
           __syncthreads();
           for (int bu = blockIdx.x; bu < 512 + 64; bu += gridDim.x) {
             if (bu < 512) { int h = bu & 7, rg = (bu >> 3) & 31, bb = bu >> 8;
               na_unit(bb, h, rg * 4 + wave, FQKV, VT0, VT0 + (size_t)NB * 8 * 64 * S, smem, AB, lane); }
             else { int cu = bu - 512; int h = cu & 7, qg = (cu >> 3) & 3, bb = cu >> 5;
               attn_unit<1, 1, 2, true>(bb, h, 0, 0, qg * 4 + wave, FQKV + 512, 2048, FQKV + 1024, 2048, VT0, VT0 + (size_t)NB * 8 * 64 * S, 8, smem, nullptr, AB + 512, 1024, lane); } } })
  xcd_barrier(xbar);
  PH(16, { GRID_LOOP(u, NB * 128 * 8 + NB * 4 * 8) { if (u < NB * 128 * 8) fft3_unit(u, 0, FQKV, A1, FD3, FDC, TAB, AB, smem_raw); else fft3_unit(u - NB * 128 * 8, 1, FQKV, A1, FD3, FDC, TAB, AB, smem_raw); } })
  xcd_barrier(xbar);
  PH(17, ph_gemm_bf16(AB, 1024, WOUT0, 1024, R, 1024, 1024, EpiBf16{YB, 1024}, smem_raw))
  PH(9, QFILL(1, 0, 160u, 260u))
  xcd_barrier(xbar);
  PH(18, ph_post_mod(x, ctx, YB, Mm, 0, 2, 0, 3, 4, true, ln_g + 0, ln_b + 0, X1, AB, R, HQB, HSB))
  xcd_barrier(xbar);
  PH(21, ph_peer_select(AB, WQ, SKB, EXPB, GATEB, R, smem_raw))
  PH(9, QFILL(2, 0, 260u, 512u))
  PH(10, QFILL(3, 1, 0u, 300u))
  xcd_barrier(xbar);
  PH(22, ph_peer_u(HQB, HSB, EXPB, U8, PAB, R))
  xcd_barrier(xbar);
  PH(32, ph_peer_w<2>(PAB, EXPB, GATEB, USC, VSC, (unsigned*)WB, CORRB, R))
  xcd_barrier(xbar);
  PH(33, ph_peer_v4((const unsigned char*)WB, CORRB, EXPB, V8, FB, R, smem_raw))
  xcd_barrier(xbar);
  PH(34, ph_post_mod(X1, X1 + (size_t)T * D, FB, Mm, 0, 5, 1, 0, 1, true, ln_g + 1024, ln_b + 1024, X2, AB, R))
  xcd_barrier(xbar);
  PH(23, ph_gemm_bf16(AB, 1024, WIN1, 1024, R, 1536, 1024, EpiQKV1{Q1, K1, VT1, RT}, smem_raw))
  PH(10, QFILL(4, 1, 300u, 420u))
  xcd_barrier(xbar);
  PH(25, { int lane = threadIdx.x & 63, wave = __builtin_amdgcn_readfirstlane(threadIdx.x >> 6);
           for (int bu = blockIdx.x; bu < 1024; bu += gridDim.x) { int kvh = bu & 3, bb = (bu >> 2) & 1, qg = bu >> 3;
             attn_unit<4, 2, 1, true>(bb, kvh, 0, 0, qg * 4 + wave, Q1, 1024, K1, 256, VT1, VT1 + (size_t)NB * 4 * 64 * S, 4, nullptr, sink, AB, 1024, lane); } })
  xcd_barrier(xbar);
  PH(26, ph_gemm_bf16(AB, 1024, WOUT1, 1024, T, 1024, 1024, EpiBf16{YB, 1024}, smem_raw))
  xcd_barrier(xbar);
  PH(27, ph_post_mod(X2, X2, YB, Mm, 1, 2, 1, 3, 4, true, ln_g + 2048, ln_b + 2048, X1, AB, T, HQB, HSB))
  xcd_barrier(xbar);
  PH(30, ph_peer_select(AB, WQ + (size_t)2048 * 1024, SKB + (size_t)8 * 2 * 128 * 128, EXPB, GATEB, T, smem_raw))
  PH(10, QFILL(5, 1, 420u, 512u))
  xcd_barrier(xbar);
  PH(31, ph_peer_u(HQB, HSB, EXPB, U8 + (size_t)16384 * 512, PAB, T))
  xcd_barrier(xbar);
  PH(35, ph_peer_w<2>(PAB, EXPB, GATEB, USC + 16384, VSC + 16384, (unsigned*)WB, CORRB, T))
  xcd_barrier(xbar);
  PH(36, ph_peer_v4((const unsigned char*)WB, CORRB, EXPB, V8 + (size_t)16384 * 512, FB, T, smem_raw))
  xcd_barrier(xbar);
  PH(37, ph_post_mod(X1, X1, FB, Mm, 1, 5, 1, 0, 1, false, ln_g + 3072, ln_b + 3072, out, AB, T))
}

}

extern "C" void kernel_launch(void* const* d_in, const int* in_sizes, int n_in, void* d_out, int out_size, void* d_ws,
                              size_t ws_size, hipStream_t stream) {
  static int grid_blocks = 0;
  if (!grid_blocks) {
    int dev = 0, cus = 0, per_cu = 0;
    hipGetDevice(&dev);
    hipDeviceGetAttribute(&cus, hipDeviceAttributeMultiprocessorCount, dev);
    hipOccupancyMaxActiveBlocksPerMultiprocessor(&per_cu, (const void*)mega, 256, 0);
    if (per_cu > 2) per_cu = 2;
    if (per_cu < 1) per_cu = 1;
    grid_blocks = cus * per_cu;
  }
  Params p{};
  for (int i = 0; i < 18; ++i) p.in[i] = (const float*)d_in[i];
  p.out = (float*)d_out;
  p.ws = (float*)d_ws;
  (void)hipMemsetAsync((char*)d_ws + OFF_BAR, 0, XCD_BAR_WORDS_C * 4, stream);
  void* args[] = {&p};
  hipError_t e = hipLaunchCooperativeKernel((const void*)mega, dim3(grid_blocks), dim3(256), args, 0, stream);
  if (e != hipSuccess) fprintf(stderr, "cooperative launch failed: %s (grid %d)\n", hipGetErrorString(e), grid_blocks);
}
```

```cpp
#include <hip/hip_runtime.h>
#include <hip/hip_bf16.h>
#include <stdint.h>
#include <math.h>
#include <stdio.h>
#include <hip/hip_cooperative_groups.h>
namespace cg = cooperative_groups;

namespace {

constexpr int D = 1024;
constexpr int NB = 2;
constexpr int S = 8192;
constexpr int T = NB * S;
constexpr int CL = 256;
constexpr int TC = NB * CL;
constexpr int R = T + TC;
constexpr float DN_ALPHA = 1.4142135623730951f;
constexpr float LN_EPS = 1e-6f;

template <int CTRL> __device__ __forceinline__ float dpp_mov(float x) {
  return __builtin_bit_cast(float, __builtin_amdgcn_mov_dpp(__builtin_bit_cast(int, x), CTRL, 0xf, 0xf, true));
}
__device__ __forceinline__ float xrow16_max(float x) {
  auto s = __builtin_amdgcn_permlane16_swap(__float_as_uint(x), __float_as_uint(x), false, false);
  x = fmaxf(__uint_as_float(s[0]), __uint_as_float(s[1]));
  auto t = __builtin_amdgcn_permlane32_swap(__float_as_uint(x), __float_as_uint(x), false, false);
  return fmaxf(__uint_as_float(t[0]), __uint_as_float(t[1]));
}
__device__ __forceinline__ float xrow16_sum(float x) {
  auto s = __builtin_amdgcn_permlane16_swap(__float_as_uint(x), __float_as_uint(x), false, false);
  x = __uint_as_float(s[0]) + __uint_as_float(s[1]);
  auto t = __builtin_amdgcn_permlane32_swap(__float_as_uint(x), __float_as_uint(x), false, false);
  return __uint_as_float(t[0]) + __uint_as_float(t[1]);
}
__device__ __forceinline__ float wave_sum(float v) {
  v += dpp_mov<0xB1>(v); v += dpp_mov<0x4E>(v); v += dpp_mov<0x124>(v); v += dpp_mov<0x128>(v);
  return xrow16_sum(v);
}
__device__ __forceinline__ float wave_max(float v) {
  v = fmaxf(v, dpp_mov<0xB1>(v)); v = fmaxf(v, dpp_mov<0x4E>(v)); v = fmaxf(v, dpp_mov<0x124>(v)); v = fmaxf(v, dpp_mov<0x128>(v));
  return xrow16_max(v);
}

typedef unsigned short bf16_t;
typedef __attribute__((ext_vector_type(8))) short bf16x8;
typedef __attribute__((ext_vector_type(16))) float f32x16;
typedef __attribute__((ext_vector_type(4))) float f32x4;

typedef __attribute__((ext_vector_type(2))) __bf16 bf16x2_t;
__device__ __forceinline__ unsigned f2bf(float f) { return (unsigned)__builtin_bit_cast(unsigned short, (__bf16)f); }
__device__ __forceinline__ unsigned pack2bf(float a, float b) { bf16x2_t v = {(__bf16)a, (__bf16)b}; return __builtin_bit_cast(unsigned, v); }
__device__ __forceinline__ float bf2f(unsigned short v) { return __uint_as_float(((unsigned)v) << 16); }

__device__ __forceinline__ int mod_index(int row) { return row < T ? row / S : 2; }


struct Params {
  const float* in[18];
  float* out;
  float* ws;
};

constexpr size_t XCD_BAR_WORDS_C = 3456;
constexpr size_t al256(size_t n) { return (n + 255) & ~(size_t)255; }
constexpr size_t OFF_BAR = 0;
constexpr size_t OFF_TAB = al256(XCD_BAR_WORDS_C * 4);
constexpr size_t OFF_M = OFF_TAB + al256(16384 * 4 + 128 * 16 * 2 * 4);
constexpr size_t OFF_WIN0 = OFF_M + al256(2 * 3 * 6144 * 4);
constexpr size_t OFF_WOUT0 = OFF_WIN0 + al256((size_t)2048 * 1024 * 2);
constexpr size_t OFF_WIN1 = OFF_WOUT0 + al256((size_t)1024 * 1024 * 2);
constexpr size_t OFF_WOUT1 = OFF_WIN1 + al256((size_t)1536 * 1024 * 2);
constexpr size_t OFF_WQ = OFF_WOUT1 + al256((size_t)1024 * 1024 * 2);
constexpr size_t OFF_SK = OFF_WQ + al256((size_t)2 * 2048 * 1024 * 2);
constexpr size_t OFF_UB = OFF_SK + al256((size_t)2 * 8 * 2 * 128 * 128 * 2);
constexpr size_t OFF_VB = OFF_UB + al256((size_t)2 * 16384 * 1024);
constexpr size_t OFF_USC = OFF_VB + al256((size_t)2 * 16384 * 1024);
constexpr size_t OFF_AB = OFF_USC + al256((size_t)4 * 16384 * 4);
constexpr size_t OFF_FT = OFF_AB + al256((size_t)R * 1024 * 2);
constexpr size_t OFF_BF = OFF_FT + al256((size_t)(256 * 128 + 128 * 128 + 64 * 128) * 2);
constexpr size_t OFF_BY = OFF_BF + al256((size_t)R * 2048 * 4);
constexpr size_t OFF_X1 = OFF_BY + al256((size_t)R * 1024 * 4);
constexpr size_t OFF_X2 = OFF_X1 + al256((size_t)R * 1024 * 4);
constexpr size_t OFF_END = OFF_X2 + al256((size_t)R * 1024 * 4);
constexpr size_t OFF_A1 = OFF_BY;
constexpr size_t OFF_VT0 = OFF_X2;
static_assert(OFF_END <= (size_t)512 * 1024 * 1024, "workspace overflow");

#define GRID_LOOP(var, n) for (int var = blockIdx.x; var < (n); var += gridDim.x)

__device__ __forceinline__ void ph_fft_tables(bf16_t* D1, bf16_t* D3, bf16_t* DcT) {
  const double TWO_PI = 6.283185307179586476925286766559;
  for (int i = blockIdx.x * 256 + threadIdx.x; i < 256 * 128 + 128 * 128 + 64 * 128; i += gridDim.x * 256) {
    if (i < 256 * 128) {
      int m = i >> 7, r = i & 127; int k1 = m >> 1, ri = m & 1;
      double a = TWO_PI * (double)((k1 * r) & 127) / 128.0;
      int pos = (((((m >> 6) * 2 + ((m >> 5) & 1)) * 8 + (r >> 4)) * 64 + 32 * ((r >> 3) & 1) + (m & 31)) << 3) + (r & 7);
      D1[pos] = (bf16_t)f2bf(ri == 0 ? (float)cos(a) : (float)(-sin(a)));
    } else if (i < 256 * 128 + 128 * 128) {
      int j = i - 256 * 128; int m = j >> 7, kk = j & 127; int rip = m >> 6, k2 = m & 63; int c = kk >> 1, ri = kk & 1;
      double a = TWO_PI * (double)((k2 * c) & 63) / 64.0;
      double v = (rip == 0) ? (ri == 0 ? cos(a) : sin(a)) : (ri == 0 ? -sin(a) : cos(a));
      D3[j] = (bf16_t)f2bf((float)v);
    } else {
      int j = i - 256 * 128 - 128 * 128; int cp = j >> 7, kk = j & 127; int rip = kk >> 6, ch = kk & 63;
      double a = TWO_PI * (double)((ch * cp) & 63) / 64.0;
      DcT[j] = (bf16_t)f2bf((float)(rip == 0 ? cos(a) : sin(a)));
    }
  }
}
__device__ __forceinline__ void ph_rope_table(float* RT) {
  for (int i = blockIdx.x * 256 + threadIdx.x; i < 128 * 16; i += gridDim.x * 256) {
    int pos = i >> 4, f = i & 15;
    float inv_freq = powf(10000.0f, -(float)f / 16.0f);
    float ang = (float)pos * inv_freq;
    RT[2 * i] = cosf(ang); RT[2 * i + 1] = sinf(ang);
  }
}
__device__ __forceinline__ void ph_tables(float* tab) {
  for (int j = blockIdx.x * 256 + threadIdx.x; j < 8192; j += gridDim.x * 256) {
    double a = 6.283185307179586476925286766559 * (double)j / 8192.0;
    tab[j] = (float)cos(a);
    tab[8192 + j] = (float)sin(a);
  }
}
__device__ __forceinline__ void ph_ada(const float* __restrict__ c, const float* __restrict__ c_ctx, const float* __restrict__ ada_w,
                       const float* __restrict__ ada_b, float* __restrict__ M) {
  for (int gid = blockIdx.x * 256 + threadIdx.x; gid < 2 * 3 * 6144; gid += gridDim.x * 256) {
    int col = gid % 6144; int idx = (gid / 6144) % 3; int layer = gid / (3 * 6144);
    const float* vec = idx < 2 ? c + idx * D : c_ctx;
    const float* w = ada_w + (size_t)layer * D * 6144 + col;
    float acc = 0.f;
    for (int k = 0; k < D; ++k) {
      float x = vec[k];
      float sx = x / (1.f + expf(-x));
      acc += sx * w[(size_t)k * 6144];
    }
    M[gid] = acc + ada_b[layer * 6144 + col];
  }
}

typedef __attribute__((ext_vector_type(2))) float f32x2_t;
__device__ __forceinline__ float sum16_pk(const float (&v)[16]) {
  f32x2_t a = {v[0], v[1]};
#pragma unroll
  for (int j = 1; j < 8; ++j) a += (f32x2_t){v[2 * j], v[2 * j + 1]};
  return a.x + a.y;
}
__device__ __forceinline__ float sumsq16_pk(const float (&v)[16], float mu) {
  f32x2_t m = {mu, mu}, a = {0.f, 0.f};
#pragma unroll
  for (int j = 0; j < 8; ++j) { f32x2_t d = (f32x2_t){v[2 * j], v[2 * j + 1]} - m; a = d * d + a; }
  return a.x + a.y;
}
__device__ __forceinline__ void ph_modulate(const float* __restrict__ xa, const float* __restrict__ xb, const float* __restrict__ M, int layer,
                            int jshift, int jscale, bf16_t* __restrict__ out, int nrows, float* red) {
  (void)red;
  int lane = threadIdx.x & 63, wave = __builtin_amdgcn_readfirstlane(threadIdx.x >> 6);
  float4 scr[4], shr[4]; int cur_mi = -1;
#pragma unroll
  for (int q4 = 0; q4 < 4; ++q4) { scr[q4] = make_float4(0.f, 0.f, 0.f, 0.f); shr[q4] = scr[q4]; }
  for (int row = blockIdx.x * 4 + wave; row < nrows; row += gridDim.x * 4) {
    { int mi = mod_index(row);
      if (mi != cur_mi) { cur_mi = mi; const float* m_ = M + ((size_t)layer * 3 + mi) * 6144 + 4 * lane;
#pragma unroll
        for (int q4 = 0; q4 < 4; ++q4) { scr[q4] = *(const float4*)(m_ + jscale * D + 256 * q4); shr[q4] = *(const float4*)(m_ + jshift * D + 256 * q4); } } }
    const float* x = (row < T ? xa + (size_t)row * D : xb + (size_t)(row - T) * D) + 4 * lane;
    float v[16]; float s = 0.f;
#pragma unroll
    for (int q4 = 0; q4 < 4; ++q4) { float4 x0 = *(const float4*)(x + 256 * q4); v[4 * q4] = x0.x; v[4 * q4 + 1] = x0.y; v[4 * q4 + 2] = x0.z; v[4 * q4 + 3] = x0.w; }
    s = sum16_pk(v);
    float mu = wave_sum(s) * (1.f / D);
    float q = sumsq16_pk(v, mu);
    float rs = rsqrtf(wave_sum(q) * (1.f / D) + LN_EPS);
    float o[16];
#pragma unroll
    for (int q4 = 0; q4 < 4; ++q4) {
      float4 sc4 = scr[q4]; float4 sh4 = shr[q4];
      o[4 * q4 + 0] = (v[4 * q4 + 0] - mu) * rs * (1.f + sc4.x) + sh4.x; o[4 * q4 + 1] = (v[4 * q4 + 1] - mu) * rs * (1.f + sc4.y) + sh4.y;
      o[4 * q4 + 2] = (v[4 * q4 + 2] - mu) * rs * (1.f + sc4.z) + sh4.z; o[4 * q4 + 3] = (v[4 * q4 + 3] - mu) * rs * (1.f + sc4.w) + sh4.w;
    }
    uint2* op = (uint2*)(out + (size_t)row * D + 4 * lane);
#pragma unroll
    for (int q4 = 0; q4 < 4; ++q4) op[64 * q4] = make_uint2(pack2bf(o[4 * q4], o[4 * q4 + 1]), pack2bf(o[4 * q4 + 2], o[4 * q4 + 3]));
  }
}

__device__ __forceinline__ void ph_post(const float* __restrict__ xa, const float* __restrict__ xb, const float* __restrict__ Y,
                        const float* __restrict__ M, int layer, int j, const float* __restrict__ g, const float* __restrict__ bb,
                        float* __restrict__ outa, float* __restrict__ outb, int nrows, float* red) {
  int tid = threadIdx.x;
  GRID_LOOP(row, nrows) {
    const float* x = row < T ? xa + (size_t)row * D : xb + (size_t)(row - T) * D;
    float* out = row < T ? outa + (size_t)row * D : outb + (size_t)(row - T) * D;
    const float* m = M + ((size_t)layer * 3 + mod_index(row)) * 6144 + j * D;
    float v[4]; float s = 0.f;
#pragma unroll
    for (int i = 0; i < 4; ++i) { int col = tid + 256 * i; v[i] = DN_ALPHA * x[col] + m[col] * Y[(size_t)row * D + col]; s += v[i]; }
    s = wave_sum(s);
    __syncthreads();
    if ((tid & 63) == 0) red[tid >> 6] = s;
    __syncthreads();
    float mu = (red[0] + red[1] + red[2] + red[3]) * (1.f / D);
    float q = 0.f;
#pragma unroll
    for (int i = 0; i < 4; ++i) { float d = v[i] - mu; q += d * d; }
    q = wave_sum(q);
    if ((tid & 63) == 0) red[4 + (tid >> 6)] = q;
    __syncthreads();
    float var = (red[4] + red[5] + red[6] + red[7]) * (1.f / D);
    float rs = rsqrtf(var + LN_EPS);
#pragma unroll
    for (int i = 0; i < 4; ++i) {
      int col = tid + 256 * i;
      out[col] = (v[i] - mu) * rs * g[col] + bb[col];
    }
  }
}

struct ARow { const float* A; int lda; __device__ float operator()(int m, int k) const { return A[(size_t)m * lda + k]; } };
struct BRow { const float* B; int ldb; __device__ float operator()(int k, int n) const { return B[(size_t)k * ldb + n]; } };
struct CRow { float* C; int ldc; float scale; __device__ void operator()(int m, int n, float v) const { C[(size_t)m * ldc + n] = v * scale; } };
struct CRowB { bf16_t* C; int ldc; float scale; __device__ void operator()(int m, int n, float v) const { C[(size_t)m * ldc + n] = (bf16_t)f2bf(v * scale); } };
struct ADft { const float* tab; int Sn; int stride; __device__ float operator()(int m, int k) const {
    int t = k & (Sn - 1); int idx = ((m * t) & (Sn - 1)) * stride;
    return k < Sn ? tab[idx] : -tab[8192 + idx]; } };
struct BPQ { const float* PQ; int rowbase; int Sn; __device__ float operator()(int k, int n) const {
    int t = k & (Sn - 1); return PQ[(size_t)(rowbase + t) * 1024 + (k >= Sn ? 512 : 0) + n]; } };

template <class AF, class BF, class CF>
__device__ __forceinline__ void ph_gemm(AF af, BF bf, CF cf, int M, int N, int K, float* sm) {
  float (*sA)[68] = (float (*)[68])sm;
  float (*sB)[68] = (float (*)[68])(sm + 16 * 68);
  int tid = threadIdx.x; int tx = tid & 15, ty = tid >> 4;
  int ntn = N / 64; int ntiles = (M / 64) * ntn;
  GRID_LOOP(tile, ntiles) {
    int m0 = (tile / ntn) * 64, n0 = (tile % ntn) * 64;
    float acc[4][4];
#pragma unroll
    for (int i = 0; i < 4; ++i)
#pragma unroll
      for (int j = 0; j < 4; ++j) acc[i][j] = 0.f;
    for (int k0 = 0; k0 < K; k0 += 16) {
      __syncthreads();
#pragma unroll
      for (int i = 0; i < 4; ++i) { int e = tid + 256 * i; int m = e >> 4, k = e & 15; sA[k][m] = af(m0 + m, k0 + k); }
#pragma unroll
      for (int i = 0; i < 4; ++i) { int e = tid + 256 * i; int k = e >> 6, n = e & 63; sB[k][n] = bf(k0 + k, n0 + n); }
      __syncthreads();
#pragma unroll
      for (int k = 0; k < 16; ++k) {
        float a[4], b[4];
#pragma unroll
        for (int i = 0; i < 4; ++i) { a[i] = sA[k][ty * 4 + i]; b[i] = sB[k][tx * 4 + i]; }
#pragma unroll
        for (int i = 0; i < 4; ++i)
#pragma unroll
          for (int j = 0; j < 4; ++j) acc[i][j] += a[i] * b[j];
      }
    }
#pragma unroll
    for (int i = 0; i < 4; ++i)
#pragma unroll
      for (int j = 0; j < 4; ++j) cf(m0 + ty * 4 + i, n0 + tx * 4 + j, acc[i][j]);
  }
}


__device__ __forceinline__ void ph_transpose_w(const float* __restrict__ W, int K, int N, bf16_t* __restrict__ Wt, float* sm) {
  int tid = threadIdx.x;
  int tk = K / 64, tn = N / 64;
  GRID_LOOP(tile, tk * tn) {
    int k0 = (tile / tn) * 64, n0 = (tile % tn) * 64;
    __syncthreads();
#pragma unroll
    for (int i = 0; i < 16; ++i) { int e = tid + 256 * i; int k = e >> 6, n = e & 63; sm[k * 65 + n] = W[(size_t)(k0 + k) * N + n0 + n]; }
    __syncthreads();
#pragma unroll
    for (int i = 0; i < 2; ++i) {
      int e = tid + 256 * i; int n = e >> 3, kc = e & 7;
      unsigned w[4];
#pragma unroll
      for (int j = 0; j < 4; ++j) w[j] = pack2bf(sm[(kc * 8 + 2 * j) * 65 + n], sm[(kc * 8 + 2 * j + 1) * 65 + n]);
      *(uint4*)(Wt + (size_t)(n0 + n) * K + k0 + kc * 8) = make_uint4(w[0], w[1], w[2], w[3]);
    }
  }
}
__device__ __forceinline__ void ph_convert_sk(const float* __restrict__ src, bf16_t* __restrict__ dst, size_t n8) {
  for (size_t i = (size_t)blockIdx.x * 256 + threadIdx.x; i < n8; i += (size_t)gridDim.x * 256) {
    unsigned ln = (unsigned)i & 63u, s8 = ((unsigned)i >> 6) & 7u, m4 = ((unsigned)i >> 9) & 3u; size_t hp = i >> 11;
    const float4* sp = (const float4*)(src + hp * 16384 + (size_t)(32u * m4 + (ln & 31u)) * 128 + 16u * s8 + 8u * (ln >> 5));
    float4 a = sp[0], b = sp[1];
    ((uint4*)dst)[i] = make_uint4(pack2bf(a.x, a.y), pack2bf(a.z, a.w), pack2bf(b.x, b.y), pack2bf(b.z, b.w));
  }
}
__device__ __forceinline__ void ph_convert(const float* __restrict__ src, bf16_t* __restrict__ dst, size_t n8) {
  for (size_t i = (size_t)blockIdx.x * 256 + threadIdx.x; i < n8; i += (size_t)gridDim.x * 256) {
    float4 a = ((const float4*)src)[2 * i], b = ((const float4*)src)[2 * i + 1];
    ((uint4*)dst)[i] = make_uint4(pack2bf(a.x, a.y), pack2bf(a.z, a.w), pack2bf(b.x, b.y), pack2bf(b.z, b.w));
  }
}

__device__ __forceinline__ void gemm_stage(const bf16_t* __restrict__ A, int lda, int k0, char* lds, int tid) {
#pragma unroll
  for (int i = 0; i < 4; ++i) {
    int q = tid + 256 * i; int row = q >> 3, p = q & 7; int c = p ^ ((row >> 1) & 7);
    const bf16_t* src = A + (size_t)row * lda + k0 + c * 8;
    __builtin_amdgcn_global_load_lds((const unsigned*)src, (unsigned*)(lds + q * 16), 16, 0, 0);
  }
}
struct EpiF32 {
  float* C; int ldc; float scale;
  __device__ __forceinline__ void operator()(int m0, int n0, int wm, int wn, f32x16 (&acc)[2][2], int tid, char* smem) const {
    int lane = tid & 63;
    float* t = (float*)smem;
    int rbase = wm * 64 + 4 * (lane >> 5), cbase = wn * 64 + (lane & 31);
#pragma unroll
    for (int mi = 0; mi < 2; ++mi)
#pragma unroll
      for (int ni = 0; ni < 2; ++ni)
#pragma unroll
        for (int r = 0; r < 16; ++r)
          t[(rbase + mi * 32 + (r & 3) + 8 * (r >> 2)) * 128 + cbase + ni * 32] = acc[mi][ni][r] * scale;
    __syncthreads();
    float* dst = C + (size_t)(m0 + (tid >> 5)) * ldc + n0 + (tid & 31) * 4;
    const float* src = t + (tid >> 5) * 128 + (tid & 31) * 4;
#pragma unroll 4
    for (int i = 0; i < 16; ++i) {
      *(float4*)dst = *(const float4*)src;
      dst += (size_t)8 * ldc; src += 8 * 128;
    }
  }
};
struct EpiQKV0 {
  bf16_t* FQKV; bf16_t* VT;
  __device__ __forceinline__ void operator()(int m0, int n0, int wm, int wn, f32x16 (&acc)[2][2], int tid, char* smem) const {
    int lane = tid & 63;
    bf16_t* t = (bf16_t*)smem;
    int rbase = wm * 64 + 4 * (lane >> 5), cbase = wn * 64 + (lane & 31);
#pragma unroll
    for (int mi = 0; mi < 2; ++mi)
#pragma unroll
      for (int ni = 0; ni < 2; ++ni)
#pragma unroll
        for (int r = 0; r < 16; ++r)
          t[(rbase + mi * 32 + (r & 3) + 8 * (r >> 2)) * 136 + cbase + ni * 32] = (bf16_t)f2bf(acc[mi][ni][r]);
    __syncthreads();
    if (n0 >= 1024 && n0 < 1536) {
      int w_ = tid >> 6, ql_ = tid & 15, g_ = (tid >> 4) & 3;
#pragma unroll 4
      for (int i = 0; i < 8; ++i) {
        int hl = i >> 2, frag = i & 3;
        const bf16_t* src = t + (32 * w_ + 8 * (ql_ >> 2) + 4 * (frag >> 1) + (ql_ & 3)) * 136 + (hl * 8 + 4 * (frag & 1) + g_) * 8;
        *(uint4*)(FQKV + (size_t)(m0 + 32 * w_ + ((n0 - 1024) / 64 + hl) * 4 + frag) * 2048 + 1024 + 8 * (tid & 63)) = *(const uint4*)src;
      }
    }
    if (n0 < 1024) {
      bf16_t* dst = FQKV + (size_t)(m0 + (tid >> 4)) * 2048 + n0 + (tid & 15) * 8;
      const bf16_t* src = t + (tid >> 4) * 136 + (tid & 15) * 8;
#pragma unroll 4
      for (int i = 0; i < 8; ++i) {
        *(uint4*)dst = *(const uint4*)src;
        dst += (size_t)16 * 2048; src += 16 * 136;
      }
    }
    if (n0 >= 1536) {
      int col = tid >> 1, half = tid & 1;
      int hd = (n0 - 1536) / 64 + (col >> 6), d = col & 63;
      const bf16_t* src = t + (half * 64) * 136 + col;
#pragma unroll
      for (int i = 0; i < 8; ++i) {
        unsigned wv[4];
#pragma unroll
        for (int j = 0; j < 4; ++j) wv[j] = (unsigned)src[(i * 8 + 2 * j) * 136] | ((unsigned)src[(i * 8 + 2 * j + 1) * 136] << 16);
        int tok = m0 + half * 64 + 8 * i;
        *(uint4*)(VT + ((size_t)((tok >> 5) * 8 + hd) * 4 + (d >> 4)) * 512 + 8 * (16 * ((tok >> 3) & 3) + (d & 15))) = make_uint4(wv[0], wv[1], wv[2], wv[3]);
      }
    }
  }
};
struct EpiBf16 {
  bf16_t* C; int ldc;
  __device__ __forceinline__ void operator()(int m0, int n0, int wm, int wn, f32x16 (&acc)[2][2], int tid, char* smem) const {
    int lane = tid & 63;
    asm volatile("" : "+v"(lane));
    bf16_t* t = (bf16_t*)smem;
    {
      bf16_t* tw = t + (wm * 64 + 4 * (lane >> 5)) * 136 + wn * 64 + (lane & 31);
#pragma unroll
      for (int mi = 0; mi < 2; ++mi)
#pragma unroll
        for (int ni = 0; ni < 2; ++ni)
#pragma unroll
          for (int r = 0; r < 16; ++r)
            tw[(mi * 32 + (r & 3) + 8 * (r >> 2)) * 136 + ni * 32] = (bf16_t)f2bf(acc[mi][ni][r]);
    }
    __syncthreads();
    bf16_t* dst = C + (size_t)(m0 + (tid >> 4)) * ldc + n0 + (tid & 15) * 8;
    const bf16_t* src = t + (tid >> 4) * 136 + (tid & 15) * 8;
#pragma unroll 4
    for (int i = 0; i < 8; ++i) {
      *(uint4*)dst = *(const uint4*)src;
      dst += (size_t)16 * ldc; src += 16 * 136;
    }
  }
};
struct EpiQKV1 {
  bf16_t* Q1; bf16_t* K1; bf16_t* VT; const float* RT;
  __device__ __forceinline__ void operator()(int m0, int n0, int wm, int wn, f32x16 (&acc)[2][2], int tid, char* smem) const {
    int lane = tid & 63;
    asm volatile("" : "+v"(lane));
    bf16_t* t = (bf16_t*)smem;
    if (n0 < 1280 && m0 < T) {
      int i = lane & 31; int f = i & 15;
#pragma unroll
      for (int mi = 0; mi < 2; ++mi)
#pragma unroll
        for (int r = 0; r < 16; ++r) {
          int row = m0 + wm * 64 + 4 * (lane >> 5) + mi * 32 + (r & 3) + 8 * (r >> 2);
          int tt = row & (S - 1);
          int pos = (i < 16) ? (tt >> 6) : (tt & 63);
          float2 cs = *(const float2*)(RT + 2 * (pos * 16 + f));
          float x1 = acc[mi][0][r], x2 = acc[mi][1][r];
          acc[mi][0][r] = x1 * cs.x - x2 * cs.y;
          acc[mi][1][r] = x1 * cs.y + x2 * cs.x;
        }
    }
    {
      bf16_t* tw = t + (wm * 64 + 4 * (lane >> 5)) * 136 + wn * 64 + (lane & 31);
#pragma unroll
      for (int mi = 0; mi < 2; ++mi)
#pragma unroll
        for (int ni = 0; ni < 2; ++ni)
#pragma unroll
          for (int r = 0; r < 16; ++r)
            tw[(mi * 32 + (r & 3) + 8 * (r >> 2)) * 136 + ni * 32] = (bf16_t)f2bf(acc[mi][ni][r]);
    }
    __syncthreads();
    if (n0 < 1280) {
      bf16_t* dst; int ld;
      if (n0 < 1024) { dst = Q1 + (size_t)(m0 + (tid >> 4)) * 1024 + n0 + (tid & 15) * 8; ld = 1024; }
      else { dst = K1 + (size_t)(m0 + (tid >> 4)) * 256 + (n0 - 1024) + (tid & 15) * 8; ld = 256; }
      if (n0 >= 1024 || m0 < T) {
        const bf16_t* src = t + (tid >> 4) * 136 + (tid & 15) * 8;
#pragma unroll 4
        for (int i = 0; i < 8; ++i) {
          *(uint4*)dst = *(const uint4*)src;
          dst += (size_t)16 * ld; src += 16 * 136;
        }
      }
    } else {
      int col = tid >> 1, half = tid & 1;
      int hd = (n0 - 1280) / 64 + (col >> 6), d = col & 63;
      const bf16_t* src = t + (half * 64) * 136 + col;
#pragma unroll
      for (int i = 0; i < 8; ++i) {
        unsigned wv[4];
#pragma unroll
        for (int j = 0; j < 4; ++j) wv[j] = (unsigned)src[(i * 8 + 2 * j) * 136] | ((unsigned)src[(i * 8 + 2 * j + 1) * 136] << 16);
        int tok = m0 + half * 64 + 8 * i;
        *(uint4*)(VT + ((size_t)((tok >> 5) * 4 + hd) * 4 + ((tok >> 3) & 3)) * 512 + d * 8) = make_uint4(wv[0], wv[1], wv[2], wv[3]);
      }
    }
  }
};
__device__ __forceinline__ void gemm_tile_mainloop3(const bf16_t* __restrict__ Ag, int lda, const bf16_t* __restrict__ Bg, int ldb, int KT,
                                                    f32x16 (&acc)[2][2], char* smem);
#ifndef GEMM_ML
#define GEMM_ML 2
#endif
__device__ __forceinline__ void gemm_tile_mainloop(const bf16_t* __restrict__ Ag, int lda, const bf16_t* __restrict__ Bg, int ldb, int KT,
                                                   f32x16 (&acc)[2][2], char* smem) {
  if (GEMM_ML == 3) { gemm_tile_mainloop3(Ag, lda, Bg, ldb, 2 * KT, acc, smem); return; }
  int tid = threadIdx.x;
  asm volatile("" : "+v"(tid));
  int lane = tid & 63, wave = __builtin_amdgcn_readfirstlane(tid >> 6), wm = wave >> 1, wn = wave & 1;
#pragma unroll
  for (int mi = 0; mi < 2; ++mi)
#pragma unroll
    for (int ni = 0; ni < 2; ++ni)
#pragma unroll
      for (int r = 0; r < 16; ++r) acc[mi][ni][r] = 0.f;
  __syncthreads();
  const int ks = (int)(blockIdx.x >> 3) & (KT - 1);
  gemm_stage(Ag, lda, ks * 64, smem, tid); gemm_stage(Bg, ldb, ks * 64, smem + 16384, tid);
  for (int kt = 0; kt < KT; ++kt) {
    asm volatile("s_waitcnt vmcnt(0)" ::: "memory");
    __syncthreads();
    char* cur = smem + (kt & 1) * 32768;
    char* nxt = smem + ((kt + 1) & 1) * 32768;
    const int kn = ((kt + 1 + ks) & (KT - 1)) * 64;
    const bool more = kt + 1 < KT;
#pragma unroll
    for (int s4 = 0; s4 < 4; ++s4) {
      bf16x8 a[2], b[2];
      int c = 2 * s4 + (lane >> 5);
#pragma unroll
      for (int mi = 0; mi < 2; ++mi) { int row = wm * 64 + mi * 32 + (lane & 31); a[mi] = *(const bf16x8*)(cur + row * 128 + ((c ^ ((row >> 1) & 7)) << 4)); }
#pragma unroll
      for (int ni = 0; ni < 2; ++ni) { int row = wn * 64 + ni * 32 + (lane & 31); b[ni] = *(const bf16x8*)(cur + 16384 + row * 128 + ((c ^ ((row >> 1) & 7)) << 4)); }
      if (more) {
        int q = tid + 256 * s4; int row = q >> 3, p = q & 7; int cc = p ^ ((row >> 1) & 7);
        __builtin_amdgcn_global_load_lds((const unsigned*)(Ag + (size_t)row * lda + kn + cc * 8), (unsigned*)(nxt + q * 16), 16, 0, 0);
        __builtin_amdgcn_global_load_lds((const unsigned*)(Bg + (size_t)row * ldb + kn + cc * 8), (unsigned*)(nxt + 16384 + q * 16), 16, 0, 0);
      }
#pragma unroll
      for (int mi = 0; mi < 2; ++mi)
#pragma unroll
        for (int ni = 0; ni < 2; ++ni) acc[mi][ni] = __builtin_amdgcn_mfma_f32_32x32x16_bf16(a[mi], b[ni], acc[mi][ni], 0, 0, 0);
      __builtin_amdgcn_sched_barrier(0);
    }
  }
  __syncthreads();
}
#ifdef GPROBE
__device__ __forceinline__ void gstage_128x256(const bf16_t* __restrict__ Ag, int lda, const bf16_t* __restrict__ Bg, int ldb, int k0, char* lds, int tid) {
#pragma unroll
  for (int i = 0; i < 2; ++i) { int q = tid + 256 * i; int row = q >> 2, p = q & 3; int c = p ^ ((row >> 2) & 3);
    __builtin_amdgcn_global_load_lds((const unsigned*)(Ag + (size_t)row * lda + k0 + c * 8), (unsigned*)(lds + q * 16), 16, 0, 0); }
#pragma unroll
  for (int i = 0; i < 4; ++i) { int q = tid + 256 * i; int row = q >> 2, p = q & 3; int c = p ^ ((row >> 2) & 3);
    __builtin_amdgcn_global_load_lds((const unsigned*)(Bg + (size_t)row * ldb + k0 + c * 8), (unsigned*)(lds + 8192 + q * 16), 16, 0, 0); }
}
__device__ __forceinline__ void ph_gemm_probe5(const bf16_t* __restrict__ A, int lda, const bf16_t* __restrict__ Bt, int ldb, int M, int N, int K, float* dummy, char* smem) {
  int tid = threadIdx.x;
  int lane = tid & 63, wave = __builtin_amdgcn_readfirstlane(tid >> 6), wm = wave >> 1, wn = wave & 1;
  int ntn = N / 256, KT = K / 32;
  int nb8 = gridDim.x >> 3, xq = blockIdx.x & 7, xm = xq >> 1, xn = xq & 1;
  int MT = M / 128, mq = (MT + 3) >> 2, nh = ntn >> 1;
  for (int lt = (int)(blockIdx.x >> 3); lt < mq * nh; lt += nb8) {
    int mt = xm * mq + lt / nh, nt = xn * nh + lt % nh;
    if (mt >= MT) continue;
    const bf16_t* Ag = A + (size_t)mt * 128 * lda; const bf16_t* Bg = Bt + (size_t)nt * 256 * ldb;
    f32x16 acc[2][4];
#pragma unroll
    for (int mi = 0; mi < 2; ++mi)
#pragma unroll
      for (int ni = 0; ni < 4; ++ni)
#pragma unroll
        for (int r = 0; r < 16; ++r) acc[mi][ni][r] = 0.f;
    __syncthreads();
    gstage_128x256(Ag, lda, Bg, ldb, 0, smem, tid);
    for (int kt = 0; kt < KT; ++kt) {
      asm volatile("s_waitcnt vmcnt(0)" ::: "memory");
      __syncthreads();
      char* cur = smem + (kt & 1) * 24576;
      if (kt + 1 < KT) gstage_128x256(Ag, lda, Bg, ldb, (kt + 1) * 32, smem + ((kt + 1) & 1) * 24576, tid);
#pragma unroll
      for (int s2 = 0; s2 < 2; ++s2) {
        bf16x8 a[2], b[4];
        int c = 2 * s2 + (lane >> 5);
#pragma unroll
        for (int mi = 0; mi < 2; ++mi) { int row = wm * 64 + mi * 32 + (lane & 31); a[mi] = *(const bf16x8*)(cur + row * 64 + ((c ^ ((row >> 2) & 3)) << 4)); }
#pragma unroll
        for (int ni = 0; ni < 4; ++ni) { int row = wn * 128 + ni * 32 + (lane & 31); b[ni] = *(const bf16x8*)(cur + 8192 + row * 64 + ((c ^ ((row >> 2) & 3)) << 4)); }
#pragma unroll
        for (int mi = 0; mi < 2; ++mi)
#pragma unroll
          for (int ni = 0; ni < 4; ++ni) acc[mi][ni] = __builtin_amdgcn_mfma_f32_32x32x16_bf16(a[mi], b[ni], acc[mi][ni], 0, 0, 0);
      }
    }
    __syncthreads();
    float sum = 0.f;
#pragma unroll
    for (int mi = 0; mi < 2; ++mi)
#pragma unroll
      for (int ni = 0; ni < 4; ++ni)
#pragma unroll
        for (int r = 0; r < 16; ++r) sum += acc[mi][ni][r];
    if (sum == 12345.678f) dummy[tid] = sum;
  }
}
#endif
#ifdef GPROBE
template <int MODE>
__device__ __forceinline__ void ph_gemm_probe(const bf16_t* __restrict__ A, int lda, const bf16_t* __restrict__ Bt, int ldb, int M, int N, int K, float* dummy, char* smem) {
  int tid = threadIdx.x;
  int lane = tid & 63, wave = __builtin_amdgcn_readfirstlane(tid >> 6), wm = wave >> 1, wn = wave & 1;
  int ntn = N / 128, KT = K / 64;
  int nb8 = gridDim.x >> 3, xq = blockIdx.x & 7, xm = xq >> 1, xn = xq & 1;
  int MT = M / 128, mq = (MT + 3) >> 2, nh = ntn >> 1;
  for (int lt = (int)(blockIdx.x >> 3); lt < mq * nh; lt += nb8) {
    int mt = xm * mq + lt / nh, nt = xn * nh + lt % nh;
    if (mt >= MT) continue;
    const bf16_t* Ag = A + (size_t)mt * 128 * lda; const bf16_t* Bg = Bt + (size_t)nt * 128 * ldb;
    f32x16 acc[2][2];
#pragma unroll
    for (int mi = 0; mi < 2; ++mi)
#pragma unroll
      for (int ni = 0; ni < 2; ++ni)
#pragma unroll
        for (int r = 0; r < 16; ++r) acc[mi][ni][r] = 0.f;
    __syncthreads();
    if (MODE & 1) { gemm_stage(Ag, lda, 0, smem, tid); gemm_stage(Bg, ldb, 0, smem + 16384, tid); }
    for (int kt = 0; kt < KT; ++kt) {
      asm volatile("s_waitcnt vmcnt(0)" ::: "memory");
      __syncthreads();
      char* cur = smem + (kt & 1) * 32768;
      if ((MODE & 1) && kt + 1 < KT) {
        char* nxt = smem + ((kt + 1) & 1) * 32768;
        gemm_stage(Ag, lda, (kt + 1) * 64, nxt, tid); gemm_stage(Bg, ldb, (kt + 1) * 64, nxt + 16384, tid);
      }
      if (MODE & 2) {
#pragma unroll
        for (int s4 = 0; s4 < 4; ++s4) {
          bf16x8 a[2], b[2];
          int c = 2 * s4 + (lane >> 5);
#pragma unroll
          for (int mi = 0; mi < 2; ++mi) { int row = wm * 64 + mi * 32 + (lane & 31); a[mi] = *(const bf16x8*)(cur + row * 128 + ((c ^ ((row >> 1) & 7)) << 4)); }
#pragma unroll
          for (int ni = 0; ni < 2; ++ni) { int row = wn * 64 + ni * 32 + (lane & 31); b[ni] = *(const bf16x8*)(cur + 16384 + row * 128 + ((c ^ ((row >> 1) & 7)) << 4)); }
#pragma unroll
          for (int mi = 0; mi < 2; ++mi)
#pragma unroll
            for (int ni = 0; ni < 2; ++ni) acc[mi][ni] = __builtin_amdgcn_mfma_f32_32x32x16_bf16(a[mi], b[ni], acc[mi][ni], 0, 0, 0);
        }
      }
    }
    __syncthreads();
    float sum = 0.f;
#pragma unroll
    for (int mi = 0; mi < 2; ++mi)
#pragma unroll
      for (int ni = 0; ni < 2; ++ni)
#pragma unroll
        for (int r = 0; r < 16; ++r) sum += acc[mi][ni][r];
    if (sum == 12345.678f) dummy[tid] = sum;
  }
}
#endif
template <class Epi>
__device__ __forceinline__ void ph_gemm_bf16(const bf16_t* __restrict__ A, int lda, const bf16_t* __restrict__ Bt, int ldb, int M, int N, int K,
                             Epi epi, char* smem) {
  int tid = threadIdx.x, wave = __builtin_amdgcn_readfirstlane(tid >> 6), wm = wave >> 1, wn = wave & 1;
  int ntn = N / 128, ntiles = (M / 128) * ntn;
  int KT = K / 64;
  (void)ntiles;
  int nb8 = gridDim.x >> 3, xq = blockIdx.x & 7, xm = xq >> 1, xn = xq & 1;
  int MT = M / 128, mq = (MT + 3) >> 2, nh = ntn >> 1;
  for (int lt = (int)(blockIdx.x >> 3); lt < mq * nh; lt += nb8) {
    int mt = xm * mq + lt / nh, nt = xn * nh + lt % nh;
    if (mt >= MT) continue;
    f32x16 acc[2][2];
    gemm_tile_mainloop(A + (size_t)mt * 128 * lda, lda, Bt + (size_t)nt * 128 * ldb, ldb, KT, acc, smem);
    epi(mt * 128, nt * 128, wm, wn, acc, tid, smem);
  }
}


#define RAW_BARRIER() do { asm volatile("s_waitcnt lgkmcnt(0)" ::: "memory"); __builtin_amdgcn_s_barrier(); } while (0)
__device__ __forceinline__ void gemm_stage32x(const bf16_t* __restrict__ Ag, int lda, const bf16_t* __restrict__ Bg, int ldb, int k0, char* lds, int tid) {
#pragma unroll
  for (int i = 0; i < 2; ++i) { int q = tid + 256 * i; int row = q >> 2, p = q & 3; int c = p ^ ((row >> 2) & 3);
    __builtin_amdgcn_global_load_lds((const unsigned*)(Ag + (size_t)row * lda + k0 + c * 8), (unsigned*)(lds + q * 16), 16, 0, 0); }
#pragma unroll
  for (int i = 0; i < 2; ++i) { int q = tid + 256 * i; int row = q >> 2, p = q & 3; int c = p ^ ((row >> 2) & 3);
    __builtin_amdgcn_global_load_lds((const unsigned*)(Bg + (size_t)row * ldb + k0 + c * 8), (unsigned*)(lds + 8192 + q * 16), 16, 0, 0); }
}
__device__ __forceinline__ void gemm_tile_mainloop3(const bf16_t* __restrict__ Ag, int lda, const bf16_t* __restrict__ Bg, int ldb, int KT,
                                                    f32x16 (&acc)[2][2], char* smem) {
  int tid = threadIdx.x;
  asm volatile("" : "+v"(tid));
  int lane = tid & 63, wave = tid >> 6, wm = wave >> 1, wn = wave & 1;
#pragma unroll
  for (int mi = 0; mi < 2; ++mi)
#pragma unroll
    for (int ni = 0; ni < 2; ++ni)
#pragma unroll
      for (int r = 0; r < 16; ++r) acc[mi][ni][r] = 0.f;
  __syncthreads();
  gemm_stage32x(Ag, lda, Bg, ldb, 0, smem, tid);
  gemm_stage32x(Ag, lda, Bg, ldb, 32, smem + 16384, tid);
  gemm_stage32x(Ag, lda, Bg, ldb, 64, smem + 32768, tid);
  for (int kt = 0; kt < KT; ++kt) {
    if (kt + 2 < KT) asm volatile("s_waitcnt vmcnt(8)" ::: "memory");
    else if (kt + 1 < KT) asm volatile("s_waitcnt vmcnt(4)" ::: "memory");
    else asm volatile("s_waitcnt vmcnt(0)" ::: "memory");
    RAW_BARRIER();
    if (kt + 3 < KT) gemm_stage32x(Ag, lda, Bg, ldb, (kt + 3) * 32, smem + ((kt + 3) & 3) * 16384, tid);
    char* cur = smem + (kt & 3) * 16384;
#pragma unroll
    for (int s2 = 0; s2 < 2; ++s2) {
      bf16x8 a[2], b[2];
      int c = 2 * s2 + (lane >> 5);
#pragma unroll
      for (int mi = 0; mi < 2; ++mi) { int row = wm * 64 + mi * 32 + (lane & 31); a[mi] = *(const bf16x8*)(cur + row * 64 + ((c ^ ((row >> 2) & 3)) << 4)); }
#pragma unroll
      for (int ni = 0; ni < 2; ++ni) { int row = wn * 64 + ni * 32 + (lane & 31); b[ni] = *(const bf16x8*)(cur + 8192 + row * 64 + ((c ^ ((row >> 2) & 3)) << 4)); }
#pragma unroll
      for (int mi = 0; mi < 2; ++mi)
#pragma unroll
        for (int ni = 0; ni < 2; ++ni) acc[mi][ni] = __builtin_amdgcn_mfma_f32_32x32x16_bf16(a[mi], b[ni], acc[mi][ni], 0, 0, 0);
    }
  }
  __syncthreads();
}
template <class Epi>
__device__ __forceinline__ void ph_gemm_bf16_3(const bf16_t* __restrict__ A, int lda, const bf16_t* __restrict__ Bt, int ldb, int M, int N, int K,
                             Epi epi, char* smem) {
  int tid = threadIdx.x, wave = __builtin_amdgcn_readfirstlane(tid >> 6), wm = wave >> 1, wn = wave & 1;
  int ntn = N / 128, ntiles = (M / 128) * ntn;
  GRID_LOOP(tile, ntiles) {
    int mt = tile / ntn, nt = tile % ntn;
    f32x16 acc[2][2];
    gemm_tile_mainloop3(A + (size_t)mt * 128 * lda, lda, Bt + (size_t)nt * 128 * ldb, ldb, K / 32, acc, smem);
    epi(mt * 128, nt * 128, wm, wn, acc, tid, smem);
  }
}
__device__ __forceinline__ void ins16(float (&L)[16], float x) {
#pragma unroll
  for (int j = 15; j >= 1; --j) L[j] = __builtin_amdgcn_fmed3f(L[j - 1], L[j], x);
  L[0] = fmaxf(L[0], x);
}
__device__ __forceinline__ void stage_tile128(const bf16_t* __restrict__ src, int ld, char* lds, int tid) {
#pragma unroll
  for (int i = 0; i < 8; ++i) {
    int q = tid + 256 * i; int row = q >> 4, p = q & 15; int c = p ^ (row & 15);
    __builtin_amdgcn_global_load_lds((const unsigned*)(src + (size_t)row * ld + c * 8), (unsigned*)(lds + q * 16), 16, 0, 0);
  }
}
__device__ __forceinline__ void ph_peer_select(const bf16_t* __restrict__ H, const bf16_t* __restrict__ WQl, const bf16_t* __restrict__ SKl,
                                               int* __restrict__ EXP, float* __restrict__ GATE, int nrows, char* smem) {
  int tid = threadIdx.x, w = __builtin_amdgcn_readfirstlane(tid >> 6), wm = w >> 1, wn = w & 1;
  bf16_t* Qs = (bf16_t*)smem;
  int* KL = (int*)(smem + 36864);
  int nb8 = gridDim.x >> 3, xq = blockIdx.x & 7, xm = xq >> 1, xn = xq & 1;
  int MT = nrows / 128, mq = (MT + 3) >> 2;
  for (int lu = (int)(blockIdx.x >> 3); lu < mq * 4; lu += nb8) {
    int mt = xm * mq + (lu >> 2), h = xn * 4 + (lu & 3);
    if (mt >= MT) continue;
    float L0[16], L1[16];
#pragma unroll
    for (int p = 0; p < 2; ++p) {
      f32x16 acc[2][2];
      gemm_tile_mainloop(H + (size_t)mt * 128 * 1024, 1024, WQl + (size_t)(h * 256 + p * 128) * 1024, 1024, 16, acc, smem);
      int lane = tid & 63;
      asm volatile("" : "+v"(lane));
      const bf16_t* krow = SKl + (size_t)(h * 2 + p) * 128 * 128 + 8 * lane;
      bf16x8 akA[4][4], akB[4][4];
#pragma unroll
      for (int s8 = 0; s8 < 4; ++s8)
#pragma unroll
        for (int m4 = 0; m4 < 4; ++m4) akA[s8][m4] = *(const bf16x8*)(krow + (m4 * 8 + s8) * 512);
      {
        bf16_t* qw = Qs + (wm * 64 + 4 * (lane >> 5)) * 136 + wn * 64 + (lane & 31);
#pragma unroll
        for (int mi = 0; mi < 2; ++mi)
#pragma unroll
          for (int ni = 0; ni < 2; ++ni)
#pragma unroll
            for (int r = 0; r < 16; ++r)
              qw[(mi * 32 + (r & 3) + 8 * (r >> 2)) * 136 + ni * 32] = (bf16_t)f2bf(acc[mi][ni][r]);
      }
      __syncthreads();
      float L[16];
#ifndef SELREP
#define SELREP 1
#endif
      {
      f32x16 sc[4];
#pragma unroll
      for (int m4 = 0; m4 < 4; ++m4)
#pragma unroll
        for (int r = 0; r < 16; ++r) sc[m4][r] = 0.f;
      {
        const bf16_t* qrow = Qs + (32 * w + (lane & 31)) * 136 + 8 * (lane >> 5);
#pragma unroll
        for (int s8 = 0; s8 < 4; ++s8) { asm volatile("" : "+v"(akA[s8][0]), "+v"(akA[s8][1]), "+v"(akA[s8][2]), "+v"(akA[s8][3])); }
#pragma unroll
        for (int s8 = 0; s8 < 4; ++s8)
#pragma unroll
          for (int m4 = 0; m4 < 4; ++m4) akB[s8][m4] = *(const bf16x8*)(krow + (m4 * 8 + s8 + 4) * 512);
#pragma unroll
        for (int s8 = 0; s8 < 4; ++s8) {
          bf16x8 bq = *(const bf16x8*)(qrow + 16 * s8);
#pragma unroll
          for (int m4 = 0; m4 < 4; ++m4) sc[m4] = __builtin_amdgcn_mfma_f32_32x32x16_bf16(akA[s8][m4], bq, sc[m4], 0, 0, 0);
        }
#pragma unroll
        for (int s8 = 0; s8 < 4; ++s8) { asm volatile("" : "+v"(akB[s8][0]), "+v"(akB[s8][1]), "+v"(akB[s8][2]), "+v"(akB[s8][3])); }
#pragma unroll
        for (int s8 = 0; s8 < 4; ++s8) {
          bf16x8 bq = *(const bf16x8*)(qrow + 16 * (s8 + 4));
#pragma unroll
          for (int m4 = 0; m4 < 4; ++m4) sc[m4] = __builtin_amdgcn_mfma_f32_32x32x16_bf16(akB[s8][m4], bq, sc[m4], 0, 0, 0);
        }
      }
#pragma unroll
      for (int j = 0; j < 16; ++j) L[j] = -INFINITY;
      unsigned kb = 4u * (unsigned)(lane >> 5);
#pragma unroll
      for (int m4 = 0; m4 < 4; ++m4)
#pragma unroll
        for (int r = 0; r < 16; ++r) {
          unsigned key = kb + (unsigned)(32 * m4 + (r & 3) + 8 * (r >> 2));
          float x = __uint_as_float((__float_as_uint(sc[m4][r]) & 0xFFFFFF80u) | key);
          ins16(L, x);
        }
      float P[16];
#pragma unroll
      for (int j = 0; j < 16; ++j) P[j] = __shfl_xor(L[j], 32);
#pragma unroll
      for (int j = 0; j < 16; ++j) ins16(L, P[j]);
      }
      if (p == 0) {
#pragma unroll
        for (int j = 0; j < 16; ++j) L0[j] = L[j];
      } else {
#pragma unroll
        for (int j = 0; j < 16; ++j) L1[j] = L[j];
      }
    }
    float C[16];
#pragma unroll
    for (int j = 0; j < 16; ++j) C[j] = -INFINITY;
#pragma unroll
    for (int a = 0; a < 16; ++a)
#pragma unroll
      for (int b = 0; b < 16; ++b)
        if ((a + 1) * (b + 1) <= 16) {
          float sa = __uint_as_float(__float_as_uint(L0[a]) & 0xFFFFFF80u);
          float sb = __uint_as_float(__float_as_uint(L1[b]) & 0xFFFFFF80u);
          float x = __uint_as_float((__float_as_uint(sa + sb) & 0xFFFFFF00u) | (unsigned)(a * 16 + b));
          ins16(C, x);
        }
    int lane = tid & 63;
    asm volatile("" : "+v"(lane));
    int token = 32 * w + (lane & 31);
    if (lane < 32) {
#pragma unroll
      for (int j = 0; j < 16; ++j) { KL[token * 32 + j] = (int)(__float_as_uint(L0[j]) & 0x7Fu); KL[token * 32 + 16 + j] = (int)(__float_as_uint(L1[j]) & 0x7Fu); }
    }
    __syncthreads();
    if (lane < 32) {
      float c0 = __uint_as_float(__float_as_uint(C[0]) & 0xFFFFFF00u);
      float ev[16]; float sum = 0.f; int ex[16];
#pragma unroll
      for (int j = 0; j < 16; ++j) {
        unsigned bits = __float_as_uint(C[j]);
        float cv = __uint_as_float(bits & 0xFFFFFF00u);
        ev[j] = __expf(cv - c0); sum += ev[j];
        int a = (bits >> 4) & 15, b = bits & 15;
        ex[j] = KL[token * 32 + a] * 128 + KL[token * 32 + 16 + b];
      }
      float inv = 1.f / sum;
      size_t o = (size_t)(mt * 128 + token) * 128 + h * 16;
#pragma unroll
      for (int j = 0; j < 16; j += 4) {
        *(uint2*)((unsigned short*)EXP + o + j) = make_uint2((unsigned)ex[j] | ((unsigned)ex[j + 1] << 16), (unsigned)ex[j + 2] | ((unsigned)ex[j + 3] << 16));
        *(uint2*)((bf16_t*)GATE + o + j) = make_uint2(pack2bf(ev[j] * inv, ev[j + 1] * inv), pack2bf(ev[j + 2] * inv, ev[j + 3] * inv));
      }
    }
  }
}

__device__ __forceinline__ void fft1_unit(int u, const bf16_t* __restrict__ FQKV, const bf16_t* __restrict__ D1, const float* __restrict__ TAB,
                          bf16_t* __restrict__ A1, char* smem) {
  int tid = threadIdx.x, lane = tid & 63, w = __builtin_amdgcn_readfirstlane(tid >> 6);
  int g = u & 7, c = (u >> 3) & 63, b = u >> 9;
  bf16_t* Bt = (bf16_t*)smem;
  __syncthreads();
  {
    int r = tid >> 1, half = tid & 1;
    const uint4* src = (const uint4*)(FQKV + (size_t)(b * S + 64 * r + c) * 2048 + g * 64 + half * 32);
    unsigned wv[16];
#pragma unroll
    for (int i = 0; i < 4; ++i) { uint4 v = src[i]; wv[4 * i] = v.x; wv[4 * i + 1] = v.y; wv[4 * i + 2] = v.z; wv[4 * i + 3] = v.w; }
#pragma unroll
    for (int j = 0; j < 32; ++j) {
      unsigned e = (j & 1) ? (wv[j >> 1] >> 16) : (wv[j >> 1] & 0xffffu);
      Bt[(half * 32 + j) * 136 + r] = (bf16_t)e;
    }
  }
  __syncthreads();
  f32x16 acc[2][2];
#pragma unroll
  for (int mi = 0; mi < 2; ++mi)
#pragma unroll
    for (int ni = 0; ni < 2; ++ni)
#pragma unroll
      for (int r = 0; r < 16; ++r) acc[mi][ni][r] = 0.f;
#pragma unroll
  for (int s8 = 0; s8 < 8; ++s8) {
    bf16x8 a[2], bb[2];
    int ko = 16 * s8 + 8 * (lane >> 5);
#pragma unroll
    for (int mi = 0; mi < 2; ++mi) a[mi] = *(const bf16x8*)(D1 + ((((w * 2 + mi) * 8 + s8) * 64 + lane) << 3));
#pragma unroll
    for (int ni = 0; ni < 2; ++ni) bb[ni] = *(const bf16x8*)(Bt + (32 * ni + (lane & 31)) * 136 + ko);
#pragma unroll
    for (int mi = 0; mi < 2; ++mi)
#pragma unroll
      for (int ni = 0; ni < 2; ++ni) acc[mi][ni] = __builtin_amdgcn_mfma_f32_32x32x16_bf16(a[mi], bb[ni], acc[mi][ni], 0, 0, 0);
  }
  bf16_t* Ot = (bf16_t*)(smem + 17408);
#pragma unroll
  for (int mi = 0; mi < 2; ++mi)
#pragma unroll
    for (int j = 0; j < 8; ++j) {
      int m = 64 * w + 32 * mi + ((2 * j) & 3) + 8 * ((2 * j) >> 2) + 4 * (lane >> 5);
      int k1 = m >> 1;
      int idx = (k1 * c) & 8191;
      float cs = TAB[idx], sn = TAB[8192 + idx];
#pragma unroll
      for (int ni = 0; ni < 2; ++ni) {
        float re = acc[mi][ni][2 * j], im = acc[mi][ni][2 * j + 1];
        float re2 = re * cs + im * sn, im2 = im * cs - re * sn;
        bf16_t* dst = Ot + m * 72 + 32 * ni + (lane & 31);
        dst[0] = (bf16_t)f2bf(re2); dst[72] = (bf16_t)f2bf(im2);
      }
    }
  __syncthreads();
  {
    bf16_t* base = A1 + (((size_t)b * 64 + c) * 128) * 2 * 512 + g * 64;
#pragma unroll
    for (int i = 0; i < 8; ++i) {
      int q = tid + 256 * i; int m = q >> 3, ch8 = q & 7;
      *(uint4*)(base + (size_t)m * 512 + ch8 * 8) = *(const uint4*)(Ot + m * 72 + ch8 * 8);
    }
  }
}

__device__ __forceinline__ void fft3_unit(int u, int mode, const bf16_t* __restrict__ FQKV, const bf16_t* __restrict__ A1, const bf16_t* __restrict__ D3,
                          const bf16_t* __restrict__ DcT, const float* __restrict__ TAB, bf16_t* __restrict__ MIX, char* smem,
                          const bf16x8 (&d3f)[8], const bf16x8 (&dcf)[8]) {
  int tid = threadIdx.x, lane = tid & 63, w = __builtin_amdgcn_readfirstlane(tid >> 6);
  bf16_t* Bt = (bf16_t*)smem;
  bf16_t* Xs = (bf16_t*)(smem + 17408);
  int g = u & 7, k1, b, nk1, rowbase; float norm;
  __syncthreads();
  if (mode == 0) {
    k1 = (u >> 3) & 127; b = u >> 10; nk1 = 128; rowbase = b * S; norm = 1.f / 724.0773439350247f;
    int kk = tid >> 1, half = tid & 1; int c = kk >> 1, ri = kk & 1;
    const uint4* src = (const uint4*)(A1 + ((((size_t)b * 64 + c) * 128 + k1) * 2 + ri) * 512 + g * 64 + half * 32);
    unsigned wv[16];
#pragma unroll
    for (int i = 0; i < 4; ++i) { uint4 v = src[i]; wv[4 * i] = v.x; wv[4 * i + 1] = v.y; wv[4 * i + 2] = v.z; wv[4 * i + 3] = v.w; }
#pragma unroll
    for (int j = 0; j < 32; ++j) {
      unsigned e = (j & 1) ? (wv[j >> 1] >> 16) : (wv[j >> 1] & 0xffffu);
      Bt[(half * 32 + j) * 136 + kk] = (bf16_t)e;
    }
  } else {
    k1 = (u >> 3) & 3; b = u >> 5; nk1 = 4; rowbase = T + b * CL; norm = 1.f / 128.f;
    int c = tid >> 2, q4 = tid & 3;
    float re[16], im[16];
#pragma unroll
    for (int j = 0; j < 16; ++j) { re[j] = 0.f; im[j] = 0.f; }
#pragma unroll
    for (int r = 0; r < 4; ++r) {
      const uint4* src = (const uint4*)(FQKV + (size_t)(rowbase + 64 * r + c) * 2048 + g * 64 + q4 * 16);
      uint4 v0 = src[0], v1 = src[1];
      unsigned wv[8] = {v0.x, v0.y, v0.z, v0.w, v1.x, v1.y, v1.z, v1.w};
      int ph = (k1 * r) & 3;
      float cr = (ph == 0) ? 1.f : (ph == 2 ? -1.f : 0.f);
      float ci = (ph == 1) ? -1.f : (ph == 3 ? 1.f : 0.f);
#pragma unroll
      for (int j = 0; j < 16; ++j) {
        float x = bf2f((unsigned short)((j & 1) ? (wv[j >> 1] >> 16) : (wv[j >> 1] & 0xffffu)));
        re[j] += x * cr; im[j] += x * ci;
      }
    }
    int idx = (k1 * c * 32) & 8191;
    float cs = TAB[idx], sn = TAB[8192 + idx];
#pragma unroll
    for (int j = 0; j < 16; ++j) {
      float re2 = re[j] * cs + im[j] * sn, im2 = im[j] * cs - re[j] * sn;
      *(unsigned*)(Bt + (q4 * 16 + j) * 136 + 2 * c) = pack2bf(re2, im2);
    }
  }
  __syncthreads();
  {
    f32x16 acc[2];
#pragma unroll
    for (int ni = 0; ni < 2; ++ni)
#pragma unroll
      for (int r = 0; r < 16; ++r) acc[ni][r] = 0.f;
#pragma unroll
    for (int s8 = 0; s8 < 8; ++s8) {
      int ko = 16 * s8 + 8 * (lane >> 5);
      bf16x8 a = d3f[s8];
#pragma unroll
      for (int ni = 0; ni < 2; ++ni) {
        bf16x8 bb = *(const bf16x8*)(Bt + (32 * ni + (lane & 31)) * 136 + ko);
        acc[ni] = __builtin_amdgcn_mfma_f32_32x32x16_bf16(a, bb, acc[ni], 0, 0, 0);
      }
    }
#pragma unroll
    for (int ni = 0; ni < 2; ++ni)
#pragma unroll
      for (int r = 0; r < 16; ++r) {
        int m = 32 * w + (r & 3) + 8 * (r >> 2) + 4 * (lane >> 5);
        Xs[(m & 63) * 136 + (m >> 6) * 64 + 32 * ni + (lane & 31)] = (bf16_t)f2bf(acc[ni][r]);
      }
  }
  __syncthreads();
  {
    int mi = w >> 1, ni = w & 1;
    f32x16 acc;
#pragma unroll
    for (int r = 0; r < 16; ++r) acc[r] = 0.f;
#pragma unroll
    for (int s8 = 0; s8 < 8; ++s8) {
      int ko = 16 * s8 + 8 * (lane >> 5);
      bf16x8 a = *(const bf16x8*)(Xs + (32 * mi + (lane & 31)) * 136 + ko);
      bf16x8 bb = dcf[s8];
      acc = __builtin_amdgcn_mfma_f32_32x32x16_bf16(a, bb, acc, 0, 0, 0);
    }
    bf16_t* Yt = Bt;
#pragma unroll
    for (int r = 0; r < 16; ++r) {
      int k2 = 32 * mi + (r & 3) + 8 * (r >> 2) + 4 * (lane >> 5);
      Yt[k2 * 72 + 32 * ni + (lane & 31)] = (bf16_t)f2bf(acc[r] * norm);
    }
  }
  __syncthreads();
#pragma unroll
  for (int i = 0; i < 2; ++i) {
    int q = tid + 256 * i; int k2 = q >> 3, ch8 = q & 7;
    int row = rowbase + k1 + nk1 * k2;
    *(uint4*)(MIX + (size_t)row * 1024 + g * 64 + ch8 * 8) = *(const uint4*)((const bf16_t*)smem + k2 * 72 + ch8 * 8);
  }
}

typedef __attribute__((ext_vector_type(4))) float f32x4_t;
__device__ __forceinline__ bf16x8 ld16(const bf16_t* p) { return *(const bf16x8*)p; }
__device__ __forceinline__ float fast_exp2(float x) { return __builtin_amdgcn_exp2f(x); }

template <int NH, int MODE, int KPI, bool PF>
__device__ __forceinline__ void attn_unit(int b, int hk, int r, int jb, int qb, const bf16_t* __restrict__ Qp, int ldq, const bf16_t* __restrict__ Kp, int ldk,
                                          const bf16_t* __restrict__ VTl, const bf16_t* __restrict__ VTc, int nkvh,
                                          const float* rpbs, const float* __restrict__ sink,
                                          bf16_t* __restrict__ Op, int ldo, int lane) {
  const float LOG2E = 1.4426950408889634f;
  const float SC = 0.125f * LOG2E;
  asm volatile("" : "+v"(lane));
  int ql = lane & 15, g = lane >> 4;
  int qrow0, q0 = 0;
  int nloc, lb0 = 0;
  if (MODE == 0) { qrow0 = b * S + r * 64 + 16 * jb; nloc = 8; }
  else if (MODE == 1) { qrow0 = T + b * CL + 16 * qb; nloc = 0; }
  else { q0 = 16 * qb; qrow0 = b * S + q0;
         int lo = (q0 - 128) >> 5, hi = (q0 + 143) >> 5; if (lo < 0) lo = 0; if (hi > 255) hi = 255; lb0 = lo; nloc = hi - lo + 1; }
  bf16x8 qf[NH][2];
#pragma unroll
  for (int hh = 0; hh < NH; ++hh)
#pragma unroll
    for (int s2 = 0; s2 < 2; ++s2)
      qf[hh][s2] = ld16(Qp + (size_t)(qrow0 + ql) * ldq + (hk * NH + hh) * 64 + 32 * s2 + 8 * g);
  f32x4_t o[NH][4]; float mrun[NH], lrun[NH];
#pragma unroll
  for (int hh = 0; hh < NH; ++hh) {
    mrun[hh] = -1e30f; lrun[hh] = 0.f;
#pragma unroll
    for (int dt = 0; dt < 4; ++dt) o[hh][dt] = (f32x4_t){0.f, 0.f, 0.f, 0.f};
  }
  int r_start = 0, blk_start = 0, c_lo = 0, qc = 0;
  if (MODE == 0) {
    r_start = min(max(r - 4, 0), 120);
    blk_start = min(max(16 * jb - 8, 0), 32);
    qc = 16 * jb + ql; c_lo = min(max(qc - 8, 0), 48);
  }
  if (MODE == 2 && KPI == 2) nloc = (nloc + 1) & ~1;
  int nit = (nloc + 8) / KPI;
#define ATT_DESC(kbx, krow0_, vtp_, vld_) \
    { bool il_ = (kbx) < nloc; int vt0_; \
      if (il_) { if (MODE == 0) { int rr_ = r_start + (kbx); krow0_ = b * S + rr_ * 64 + blk_start; vt0_ = rr_ * 64 + blk_start; } \
                 else { krow0_ = b * S + 32 * (lb0 + (kbx)); vt0_ = 32 * (lb0 + (kbx)); } \
                 vtp_ = VTl + ((size_t)(b * nkvh + hk) * 64) * S + vt0_; vld_ = S; } \
      else { int cb_ = (kbx) - nloc; krow0_ = T + b * CL + 32 * cb_; vt0_ = 32 * cb_; \
             vtp_ = VTc + ((size_t)(b * nkvh + hk) * 64) * CL + vt0_; vld_ = CL; } }
#define ATT_LOAD(kbx, KF, VF) \
    { int krow0; const bf16_t* vt; int vld; ATT_DESC(kbx, krow0, vt, vld) \
      _Pragma("unroll") for (int t = 0; t < 2; ++t) _Pragma("unroll") for (int s2 = 0; s2 < 2; ++s2) \
        KF[t][s2] = ld16(Kp + (size_t)(krow0 + hk * 4 + t * 2 + s2) * ldk + 8 * (16 * g + ql));   \
      (void)vt; (void)vld; \
      _Pragma("unroll") for (int dt = 0; dt < 4; ++dt) VF[dt] = ld16(VTl + ((size_t)((krow0 >> 5) * 8 + hk) * 4 + dt) * 512 + 8 * (16 * g + ql));   }
  bf16x8 kfn[PF ? KPI : 1][2][2], vfn[PF ? KPI : 1][4];
  if (PF) {
#pragma unroll
    for (int kk = 0; kk < KPI; ++kk) ATT_LOAD(kk, kfn[kk], vfn[kk])
  }
  for (int it = 0; it < nit; ++it) {
    bf16x8 kf[KPI][2][2], vf[KPI][4];
    if (PF) {
#pragma unroll
      for (int kk = 0; kk < KPI; ++kk) {
#pragma unroll
        for (int t = 0; t < 2; ++t)
#pragma unroll
          for (int s2 = 0; s2 < 2; ++s2) kf[kk][t][s2] = kfn[kk][t][s2];
#pragma unroll
        for (int dt = 0; dt < 4; ++dt) vf[kk][dt] = vfn[kk][dt];
      }
      if (it + 1 < nit) {
#pragma unroll
        for (int kk = 0; kk < KPI; ++kk) ATT_LOAD((it + 1) * KPI + kk, kfn[kk], vfn[kk])
      }
    } else {
#pragma unroll
      for (int kk = 0; kk < KPI; ++kk) ATT_LOAD(it * KPI + kk, kf[kk], vf[kk])
    }
    float bias[KPI][2][4]; bool valid[KPI][2][4];
#pragma unroll
    for (int kk = 0; kk < KPI; ++kk) {
      int kb = it * KPI + kk;
      bool is_loc = kb < nloc;
#pragma unroll
      for (int t = 0; t < 2; ++t)
#pragma unroll
        for (int i = 0; i < 4; ++i) {
          bias[kk][t][i] = 0.f; valid[kk][t][i] = true;
          if (MODE == 0 && is_loc) {
            int kc = blk_start + 8 * g + 4 * t + i;
            valid[kk][t][i] = (kc >= c_lo) && (kc < c_lo + 16);
            int dc = min(max(kc - qc, -15), 15) + 15;
            bias[kk][t][i] = rpbs[(hk * 15 + (r_start + kb - r + 7)) * 31 + dc];
          }
          if (MODE == 2 && is_loc) {
            int kpos = 32 * (lb0 + kb) + 8 * g + 4 * t + i; int dq = (q0 + ql) - kpos;
            bias[kk][t][i] = ((dq <= 128) && (dq >= -128)) ? 0.f : -1e30f;
          }
        }
    }
#pragma unroll
    for (int hh = 0; hh < NH; ++hh) {
      f32x4_t st[KPI][2];
#pragma unroll
      for (int kk = 0; kk < KPI; ++kk)
#pragma unroll
        for (int t = 0; t < 2; ++t) {
          st[kk][t] = (f32x4_t){0.f, 0.f, 0.f, 0.f};
          st[kk][t] = __builtin_amdgcn_mfma_f32_16x16x32_bf16(kf[kk][t][0], qf[hh][0], st[kk][t], 0, 0, 0);
          st[kk][t] = __builtin_amdgcn_mfma_f32_16x16x32_bf16(kf[kk][t][1], qf[hh][1], st[kk][t], 0, 0, 0);
        }
      float lg[KPI][2][4]; float bm = -1e30f;
#pragma unroll
      for (int kk = 0; kk < KPI; ++kk)
#pragma unroll
        for (int t = 0; t < 2; ++t)
#pragma unroll
          for (int i = 0; i < 4; ++i) {
            float v = (MODE == 0) ? (valid[kk][t][i] ? (st[kk][t][i] * SC + bias[kk][t][i]) : -1e30f) : fmaf(st[kk][t][i], SC, bias[kk][t][i]);
            lg[kk][t][i] = v; bm = fmaxf(bm, v);
          }
      bm = xrow16_max(bm);
      float mn = fmaxf(mrun[hh], bm);
      float alpha = fast_exp2(mrun[hh] - mn);
      mrun[hh] = mn;
      float ps = 0.f;
      bf16x8 pf[KPI];
#pragma unroll
      for (int kk = 0; kk < KPI; ++kk) {
        float pv[8];
#pragma unroll
        for (int t = 0; t < 2; ++t)
#pragma unroll
          for (int i = 0; i < 4; ++i) {
            float p = (MODE == 0) ? (valid[kk][t][i] ? fast_exp2(lg[kk][t][i] - mn) : 0.f) : fast_exp2(lg[kk][t][i] - mn);
            pv[4 * t + i] = p; ps += p;
          }
        typedef __attribute__((ext_vector_type(4))) unsigned u32x4;
        u32x4 uu = {pack2bf(pv[0], pv[1]), pack2bf(pv[2], pv[3]), pack2bf(pv[4], pv[5]), pack2bf(pv[6], pv[7])};
        pf[kk] = __builtin_bit_cast(bf16x8, uu);
      }
      lrun[hh] = lrun[hh] * alpha + ps;
#pragma unroll
      for (int dt = 0; dt < 4; ++dt) {
        o[hh][dt] *= alpha;
#pragma unroll
        for (int kk = 0; kk < KPI; ++kk)
          o[hh][dt] = __builtin_amdgcn_mfma_f32_16x16x32_bf16(vf[kk][dt], pf[kk], o[hh][dt], 0, 0, 0);
      }
      if (NH == 4 && KPI == 2 && (hh & 1)) __builtin_amdgcn_sched_barrier(0);
    }
  }
#undef ATT_LOAD
#undef ATT_DESC
#pragma unroll
  for (int hh = 0; hh < NH; ++hh) {
    float l = xrow16_sum(lrun[hh]);
    float m = mrun[hh];
    if (MODE == 2) {
      float sk = sink[hk * NH + hh] * LOG2E;
      float mf = fmaxf(m, sk);
      float a = fast_exp2(m - mf);
      l = l * a + fast_exp2(sk - mf);
#pragma unroll
      for (int dt = 0; dt < 4; ++dt) o[hh][dt] *= a;
    }
    float inv = 1.f / l;
    bf16_t* orow = Op + (size_t)(qrow0 + ql) * ldo + (hk * NH + hh) * 64 + 4 * g;
#pragma unroll
    for (int dt = 0; dt < 4; ++dt) {
      f32x4_t v = o[hh][dt] * inv;
      *(uint2*)(orow + 16 * dt) = make_uint2(pack2bf(v[0], v[1]), pack2bf(v[2], v[3]));
    }
  }
}

__device__ __forceinline__ void gqa_block(int b, int hk, int qg, const bf16_t* __restrict__ Qp, const bf16_t* __restrict__ Kp,
                                          const bf16_t* __restrict__ VTl, const bf16_t* __restrict__ VTc, const float* __restrict__ sink,
                                          bf16_t* __restrict__ Op, char* smem) {
  const float LOG2E = 1.4426950408889634f;
  const float SC = 0.125f * LOG2E;
  int lane = threadIdx.x & 63; const int wave = __builtin_amdgcn_readfirstlane(threadIdx.x >> 6);
  asm volatile("" : "+v"(lane));
  const int ql = lane & 15, g = lane >> 4;
  const int q0 = 64 * qg + 16 * wave, qrow0 = b * S + q0;
  int wlo = (q0 - 128) >> 5, whi = (q0 + 143) >> 5; if (wlo < 0) wlo = 0; if (whi > 255) whi = 255;
  int blo = (64 * qg - 128) >> 5, bhi = (64 * qg + 48 + 143) >> 5; if (blo < 0) blo = 0; if (bhi > 255) bhi = 255;
  const int nlocb = bhi - blo + 1, nit = nlocb + 8;
  bf16x8 qf[4][2];
#pragma unroll
  for (int hh = 0; hh < 4; ++hh)
#pragma unroll
    for (int s2 = 0; s2 < 2; ++s2)
      qf[hh][s2] = ld16(Qp + (size_t)(qrow0 + ql) * 1024 + (hk * 4 + hh) * 64 + 32 * s2 + 8 * g);
#pragma unroll
  for (int hh = 0; hh < 4; ++hh) { asm volatile("" : "+v"(qf[hh][0]), "+v"(qf[hh][1])); }
  f32x4_t o[4][4]; float mrun[4], lrun[4];
#pragma unroll
  for (int hh = 0; hh < 4; ++hh) {
    mrun[hh] = -1e30f; lrun[hh] = 0.f;
#pragma unroll
    for (int dt = 0; dt < 4; ++dt) o[hh][dt] = (f32x4_t){0.f, 0.f, 0.f, 0.f};
  }
  const int slot = 64 * wave + lane;
  const int kr = slot >> 3, kc = (slot & 7) ^ (((kr >> 1) & 1) | (((kr >> 3) & 1) << 1) | (((kr >> 4) & 1) << 2));
  const int vd = slot >> 2, vc = (slot & 3) ^ (((vd >> 3) & 1) << 1);
  const bf16_t* kbase_l = Kp + (size_t)(b * S + kr) * 256 + hk * 64 + kc * 8;
  const bf16_t* kbase_c = Kp + (size_t)(T + b * CL + kr) * 256 + hk * 64 + kc * 8;
  const bf16_t* vbase_l = VTl + (size_t)(b * (S / 32)) * 8192 + (size_t)hk * 2048 + vc * 512 + vd * 8;
  const bf16_t* vbase_c = VTl + (size_t)((T + b * CL) / 32) * 8192 + (size_t)hk * 2048 + vc * 512 + vd * 8; (void)VTc;
#define GQ_ISSUE(j) { const int j_ = (j); char* st_ = smem + ((j_ >> 2) & 1) * 32768 + (j_ & 3) * 8192 + slot * 16; \
    const bf16_t* ks_; const bf16_t* vs_; \
    if (j_ < nlocb) { ks_ = kbase_l + (size_t)(32 * (blo + j_)) * 256; vs_ = vbase_l + (size_t)(blo + j_) * 8192; } \
    else { ks_ = kbase_c + (size_t)(32 * (j_ - nlocb)) * 256; vs_ = vbase_c + (size_t)(j_ - nlocb) * 8192; } \
    __builtin_amdgcn_global_load_lds((const unsigned*)ks_, (unsigned*)st_, 16, 0, 0); \
    __builtin_amdgcn_global_load_lds((const unsigned*)vs_, (unsigned*)(st_ + 4096), 16, 0, 0); }
  int koff[2][2], voff[4];
#pragma unroll
  for (int t = 0; t < 2; ++t)
#pragma unroll
    for (int s2 = 0; s2 < 2; ++s2) {
      int r = 8 * (ql >> 2) + 4 * t + (ql & 3); int c = 4 * s2 + g;
      koff[t][s2] = r * 128 + ((c ^ (((r >> 1) & 1) | (((r >> 3) & 1) << 1) | (((r >> 4) & 1) << 2))) << 4);
    }
#pragma unroll
  for (int dt = 0; dt < 4; ++dt) { int row = 16 * dt + ql; voff[dt] = 4096 + row * 64 + ((g ^ (((row >> 3) & 1) << 1)) << 4); }
  __syncthreads();
  const int nit2 = (nit + 3) >> 2;
#pragma unroll
  for (int u_ = 0; u_ < 4; ++u_) { if (u_ < nit) GQ_ISSUE(u_) }
#pragma unroll 1
  for (int jj = 0; jj < nit2; ++jj) {
    asm volatile("s_waitcnt vmcnt(0)" ::: "memory");
    asm volatile("s_waitcnt lgkmcnt(0)" ::: "memory"); __builtin_amdgcn_s_barrier();
#pragma unroll
    for (int u_ = 0; u_ < 4; ++u_) { if (4 * jj + 4 + u_ < nit) GQ_ISSUE(4 * jj + 4 + u_) }
#pragma unroll
    for (int sub = 0; sub < 4; ++sub) {
    const int j = 4 * jj + sub;
    if (j < nit && !((j < nlocb) && ((blo + j) < wlo || (blo + j) > whi))) {
    const bool loc = j < nlocb; const int kb = blo + j;
    const char* st = smem + ((j >> 2) & 1) * 32768 + (j & 3) * 8192;
    bf16x8 kf[2][2], vf[4];
#pragma unroll
    for (int t = 0; t < 2; ++t)
#pragma unroll
      for (int s2 = 0; s2 < 2; ++s2) kf[t][s2] = *(const bf16x8*)(st + koff[t][s2]);
#pragma unroll
    for (int dt = 0; dt < 4; ++dt) vf[dt] = *(const bf16x8*)(st + voff[dt]);
    float bias[2][4];
#pragma unroll
    for (int t = 0; t < 2; ++t)
#pragma unroll
      for (int i = 0; i < 4; ++i) {
        bias[t][i] = 0.f;
        if (loc) { int kpos = 32 * kb + 8 * g + 4 * t + i; int dq = (q0 + ql) - kpos; bias[t][i] = ((dq <= 128) && (dq >= -128)) ? 0.f : -1e30f; }
      }
#pragma unroll
    for (int hh = 0; hh < 4; ++hh) {
      f32x4_t sc[2];
#pragma unroll
      for (int t = 0; t < 2; ++t) {
        sc[t] = (f32x4_t){0.f, 0.f, 0.f, 0.f};
        sc[t] = __builtin_amdgcn_mfma_f32_16x16x32_bf16(kf[t][0], qf[hh][0], sc[t], 0, 0, 0);
        sc[t] = __builtin_amdgcn_mfma_f32_16x16x32_bf16(kf[t][1], qf[hh][1], sc[t], 0, 0, 0);
      }
      float lg[2][4]; float bm = -1e30f;
#pragma unroll
      for (int t = 0; t < 2; ++t)
#pragma unroll
        for (int i = 0; i < 4; ++i) { float v = fmaf(sc[t][i], SC, bias[t][i]); lg[t][i] = v; bm = fmaxf(bm, v); }
      bm = xrow16_max(bm);
      float mn = fmaxf(mrun[hh], bm);
      float alpha = fast_exp2(mrun[hh] - mn);
      mrun[hh] = mn;
      float ps = 0.f; float pv[8];
#pragma unroll
      for (int t = 0; t < 2; ++t)
#pragma unroll
        for (int i = 0; i < 4; ++i) { float p_ = fast_exp2(lg[t][i] - mn); pv[4 * t + i] = p_; ps += p_; }
      typedef __attribute__((ext_vector_type(4))) unsigned u32x4;
      u32x4 uu = {pack2bf(pv[0], pv[1]), pack2bf(pv[2], pv[3]), pack2bf(pv[4], pv[5]), pack2bf(pv[6], pv[7])};
      bf16x8 pf = __builtin_bit_cast(bf16x8, uu);
      lrun[hh] = lrun[hh] * alpha + ps;
#pragma unroll
      for (int dt = 0; dt < 4; ++dt) {
        o[hh][dt] *= alpha;
        o[hh][dt] = __builtin_amdgcn_mfma_f32_16x16x32_bf16(vf[dt], pf, o[hh][dt], 0, 0, 0);
      }
    }
    }
    }
  }
#undef GQ_ISSUE
#pragma unroll
  for (int hh = 0; hh < 4; ++hh) {
    float l = xrow16_sum(lrun[hh]);
    float m = mrun[hh];
    float sk = sink[hk * 4 + hh] * LOG2E;
    float mf = fmaxf(m, sk);
    float a = fast_exp2(m - mf);
    l = l * a + fast_exp2(sk - mf);
    float inv = a / l;
    bf16_t* orow = Op + (size_t)(qrow0 + ql) * 1024 + (hk * 4 + hh) * 64 + 4 * g;
#pragma unroll
    for (int dt = 0; dt < 4; ++dt) {
      f32x4_t v = o[hh][dt] * inv;
      *(uint2*)(orow + 16 * dt) = make_uint2(pack2bf(v[0], v[1]), pack2bf(v[2], v[3]));
    }
  }
}

struct NaState { f32x4_t o[4][4]; float m[4], l[4]; };
template <int HB>
__device__ __forceinline__ void na_block(NaState& st, const bf16x8 (&qf)[4][2], const bf16x8 (&kf)[2][2], const bf16x8 (&vf)[4],
                                         const float* rpbrow  , const unsigned* idxl  ) {
  const float SC = 0.125f * 1.4426950408889634f;
#pragma unroll
  for (int jb = 0; jb < 4; ++jb) {
    if (HB == 0 && jb == 3) continue;
    if (HB == 1 && jb == 0) continue;
    f32x4_t s2[2];
#pragma unroll
    for (int t = 0; t < 2; ++t) {
      s2[t] = (f32x4_t){0.f, 0.f, 0.f, 0.f};
      s2[t] = __builtin_amdgcn_mfma_f32_16x16x32_bf16(kf[t][0], qf[jb][0], s2[t], 0, 0, 0);
      s2[t] = __builtin_amdgcn_mfma_f32_16x16x32_bf16(kf[t][1], qf[jb][1], s2[t], 0, 0, 0);
    }
    float lg[8]; float bm = -1e30f;
#pragma unroll
    for (int t = 0; t < 2; ++t)
#pragma unroll
      for (int i = 0; i < 4; ++i) {
        float v;
        if (HB < 2) {
          unsigned off = __builtin_amdgcn_ubfe(idxl[((jb * 2 + HB) * 2 + t) * 64], 8 * i, 8);
          v = fmaf(s2[t][i], SC, *(const float*)((const char*)rpbrow + off));
        } else { v = s2[t][i] * SC; }
        lg[4 * t + i] = v; bm = fmaxf(bm, v);
      }
    bm = xrow16_max(bm);
    float mn = fmaxf(st.m[jb], bm);
    float alpha = fast_exp2(st.m[jb] - mn);
    st.m[jb] = mn;
    float ps = 0.f; float pv[8];
#pragma unroll
    for (int e = 0; e < 8; ++e) { float p = fast_exp2(lg[e] - mn); pv[e] = p; ps += p; }
    st.l[jb] = st.l[jb] * alpha + ps;
    typedef __attribute__((ext_vector_type(4))) unsigned u32x4;
    u32x4 uu = {pack2bf(pv[0], pv[1]), pack2bf(pv[2], pv[3]), pack2bf(pv[4], pv[5]), pack2bf(pv[6], pv[7])};
    bf16x8 pf = __builtin_bit_cast(bf16x8, uu);
#pragma unroll
    for (int dt = 0; dt < 4; ++dt) {
      st.o[jb][dt] *= alpha;
      st.o[jb][dt] = __builtin_amdgcn_mfma_f32_16x16x32_bf16(vf[dt], pf, st.o[jb][dt], 0, 0, 0);
    }
    if (jb & 1) __builtin_amdgcn_sched_barrier(0);
  }
}
__device__ __forceinline__ void na_unit(int b, int h, int r, const bf16_t* __restrict__ FQKV, const bf16_t* __restrict__ VTl,
                                        const bf16_t* __restrict__ VTc, const float* rpbs, bf16_t* __restrict__ MIX, int lane) {
  asm volatile("" : "+v"(lane));
  int ql = lane & 15, g = lane >> 4;
  int qrow0 = b * S + r * 64;
  int r_start = min(max(r - 4, 0), 120);
  bf16x8 qf[4][2];
#pragma unroll
  for (int jb = 0; jb < 4; ++jb)
#pragma unroll
    for (int s2 = 0; s2 < 2; ++s2)
      qf[jb][s2] = ld16(FQKV + (size_t)(qrow0 + 16 * jb + ql) * 2048 + 512 + h * 64 + 32 * s2 + 8 * g);
  const unsigned* idxl = (const unsigned*)(rpbs + 3840) + lane;
  NaState st;
#pragma unroll
  for (int jb = 0; jb < 4; ++jb) {
    st.m[jb] = -1e30f; st.l[jb] = 0.f;
#pragma unroll
    for (int dt = 0; dt < 4; ++dt) st.o[jb][dt] = (f32x4_t){0.f, 0.f, 0.f, 0.f};
  }
  unsigned koff = (unsigned)(h * 4 * 2048 + 1024 + 8 * lane);
  unsigned voff = (unsigned)(h * 4 * 512 + 8 * lane);
  (void)VTc;
#define NA_LOADK(kb2, KF) { \
    int krow0_; \
    if ((kb2) < 16) krow0_ = b * S + (r_start + ((kb2) >> 1)) * 64 + 32 * ((kb2) & 1); \
    else krow0_ = T + b * CL + 32 * ((kb2) - 16); \
    const bf16_t* kb_ = FQKV + (size_t)krow0_ * 2048; \
    _Pragma("unroll") for (int t = 0; t < 2; ++t) _Pragma("unroll") for (int s2 = 0; s2 < 2; ++s2) \
      KF[t][s2] = ld16(kb_ + (koff + (unsigned)((t * 2 + s2) * 2048))); }
#define NA_LOADV(kb2, VF) { \
    int vrow0_; \
    if ((kb2) < 16) vrow0_ = b * S + (r_start + ((kb2) >> 1)) * 64 + 32 * ((kb2) & 1); \
    else vrow0_ = T + b * CL + 32 * ((kb2) - 16); \
    const bf16_t* vt_ = VTl + (size_t)(vrow0_ >> 5) * (8 * 4 * 512); \
    _Pragma("unroll") for (int dt = 0; dt < 4; ++dt) VF[dt] = ld16(vt_ + (voff + (unsigned)(dt * 512))); }
  bf16x8 kfa[2][2], kfb[2][2], vfa[4], vfb[4];
  NA_LOADK(0, kfa) NA_LOADV(0, vfa)
#pragma unroll 1
  for (int rr = 0; rr < 8; ++rr) {
    const float* rpbrow = rpbs + (h * 15 + (r_start + rr - r + 7)) * 32;
    asm volatile("" : "+v"(lane)); ql = lane & 15; g = lane >> 4;
    koff = (unsigned)(h * 4 * 2048 + 1024 + 8 * lane); voff = (unsigned)(h * 4 * 512 + 8 * lane);
    NA_LOADK(2 * rr + 1, kfb) NA_LOADV(2 * rr + 1, vfb)
    na_block<0>(st, qf, kfa, vfa, rpbrow, idxl);
    NA_LOADK(2 * rr + 2, kfa) NA_LOADV(2 * rr + 2, vfa)
    na_block<1>(st, qf, kfb, vfb, rpbrow, idxl);
  }
#pragma unroll 1
  for (int cb = 0; cb < 8; cb += 2) {
    asm volatile("" : "+v"(lane)); ql = lane & 15; g = lane >> 4;
    koff = (unsigned)(h * 4 * 2048 + 1024 + 8 * lane); voff = (unsigned)(h * 4 * 512 + 8 * lane);
    NA_LOADK(16 + cb + 1, kfb) NA_LOADV(16 + cb + 1, vfb)
    na_block<2>(st, qf, kfa, vfa, rpbs, idxl);
    if (cb + 2 < 8) { NA_LOADK(16 + cb + 2, kfa) NA_LOADV(16 + cb + 2, vfa) }
    na_block<2>(st, qf, kfb, vfb, rpbs, idxl);
  }
#undef NA_LOADK
#undef NA_LOADV
  asm volatile("" : "+v"(lane)); ql = lane & 15; g = lane >> 4;
#pragma unroll
  for (int jb = 0; jb < 4; ++jb) {
    float inv = 1.f / xrow16_sum(st.l[jb]);
    bf16_t* orow = MIX + (size_t)(qrow0 + 16 * jb + ql) * 1024 + 512 + h * 64 + 4 * g;
#pragma unroll
    for (int dt = 0; dt < 4; ++dt) {
      f32x4_t v = st.o[jb][dt] * inv;
      *(uint2*)(orow + 16 * dt) = make_uint2(pack2bf(v[0], v[1]), pack2bf(v[2], v[3]));
    }
  }
}

__device__ __forceinline__ void ph_chan_dft(const float* __restrict__ F, const float* __restrict__ tab, float* __restrict__ PQ) {
  for (int gid = blockIdx.x * 256 + threadIdx.x; gid < R * 512; gid += gridDim.x * 256) {
    int row = gid >> 9; int col = gid & 511; int g = col >> 6, cp = col & 63;
    const float* f = F + (size_t)row * 2048 + g * 64;
    float p = 0.f, q = 0.f;
    for (int ch = 0; ch < 64; ++ch) {
      int idx = ((ch * cp) & 63) * 128;
      float x = f[ch];
      p += x * tab[idx]; q += x * tab[8192 + idx];
    }
    PQ[(size_t)row * 1024 + col] = p;
    PQ[(size_t)row * 1024 + 512 + col] = q;
  }
}

__device__ __forceinline__ void ph_na(const bf16_t* __restrict__ F, const float* __restrict__ rpb, bf16_t* __restrict__ MIX, float* sm) {
  int lane = threadIdx.x & 63, wave = __builtin_amdgcn_readfirstlane(threadIdx.x >> 6);
  float* sq = sm + wave * 1024; float* sp = sq + 64; int* stok = (int*)(sp + 384);
  int nitems = R * 8;
  for (int item0 = blockIdx.x * 4; item0 < nitems; item0 += gridDim.x * 4) {
    int item = item0 + wave;
    int h = item & 7; int row = item >> 3;
    bool is_ctx = row >= T;
    int b = is_ctx ? (row - T) / CL : row / S;
    __syncthreads();
    sq[lane] = bf2f(F[(size_t)row * 2048 + 512 + h * 64 + lane]);
    __syncthreads();
    int r = 0, c = 0, r_start = 0, c_start = 0;
    if (!is_ctx) { int t = row % S; r = t / 64; c = t % 64; r_start = min(max(r - 4, 0), 120); c_start = min(max(c - 8, 0), 48); }
    int nk = is_ctx ? 256 : 384;
    float lg[6]; float mx = -INFINITY;
#pragma unroll
    for (int kk = 0; kk < 6; ++kk) {
      int j = kk * 64 + lane; float s = -INFINITY; int tok = 0;
      if (j < nk) {
        float bias = 0.f;
        if (!is_ctx && j < 128) {
          int kr = j >> 4, kc = j & 15; int rr = r_start + kr, cc = c_start + kc;
          tok = b * S + rr * 64 + cc;
          int dc = min(max(cc - c, -15), 15) + 15;
          bias = rpb[(h * 15 + (rr - r + 7)) * 31 + dc];
        } else {
          int l = is_ctx ? j : j - 128; tok = T + b * CL + l;
        }
        const bf16_t* kp = F + (size_t)tok * 2048 + 1024 + h * 64;
        float acc = 0.f;
#pragma unroll 8
        for (int d = 0; d < 64; ++d) acc += sq[d] * bf2f(kp[d]);
        s = acc * 0.125f + bias;
      }
      lg[kk] = s; stok[j] = tok; mx = fmaxf(mx, s);
    }
    mx = wave_max(mx);
    float sum = 0.f;
#pragma unroll
    for (int kk = 0; kk < 6; ++kk) { float e = (kk * 64 + lane < nk) ? expf(lg[kk] - mx) : 0.f; lg[kk] = e; sum += e; }
    sum = wave_sum(sum);
    float inv = 1.f / sum;
#pragma unroll
    for (int kk = 0; kk < 6; ++kk) sp[kk * 64 + lane] = lg[kk] * inv;
    __syncthreads();
    float o = 0.f;
    for (int j = 0; j < nk; ++j) o += sp[j] * bf2f(F[(size_t)stok[j] * 2048 + 1536 + h * 64 + lane]);
    MIX[(size_t)row * 1024 + 512 + h * 64 + lane] = (bf16_t)f2bf(o);
  }
}

__device__ __forceinline__ void ph_rope(float* __restrict__ F1) {
  for (int gid = blockIdx.x * 256 + threadIdx.x; gid < T * 20 * 32; gid += gridDim.x * 256) {
    int i = gid & 31; int hh = (gid >> 5) % 20; int row = gid / (32 * 20);
    int t = row % S; float rowp = (float)(t / 64), colp = (float)(t % 64);
    int fi = i & 15;
    float inv_freq = powf(10000.0f, -(float)fi / 16.0f);
    float ang = (i < 16 ? rowp : colp) * inv_freq;
    float cs = cosf(ang), sn = sinf(ang);
    float* p = F1 + (size_t)row * 1536 + hh * 64;
    float x1 = p[i], x2 = p[i + 32];
    p[i] = x1 * cs - x2 * sn;
    p[i + 32] = x1 * sn + x2 * cs;
  }
}

__device__ __forceinline__ void ph_gqa(const float* __restrict__ F1, const float* __restrict__ sink, bf16_t* __restrict__ O, float* sm) {
  int lane = threadIdx.x & 63, wave = __builtin_amdgcn_readfirstlane(threadIdx.x >> 6);
  float* sq = sm + wave * 1280; float* sp = sq + 64; int* stok = (int*)(sp + 576);
  int nitems = T * 16;
  for (int item0 = blockIdx.x * 4; item0 < nitems; item0 += gridDim.x * 4) {
    int item = item0 + wave;
    int qh = item & 15; int row = item >> 4; int kvh = qh >> 2;
    int b = row / S; int t = row % S;
    __syncthreads();
    sq[lane] = F1[(size_t)row * 1536 + qh * 64 + lane];
    __syncthreads();
    float lg[9]; float mx = -INFINITY;
#pragma unroll
    for (int kk = 0; kk < 9; ++kk) {
      int j = kk * 64 + lane; float s = -INFINITY; int tok = 0; bool valid = false;
      if (j < 257) { int pos = t - 128 + j; valid = (pos >= 0 && pos < S); tok = b * S + pos; }
      else if (j < 513) { valid = true; tok = T + b * CL + (j - 257); }
      if (valid) {
        const float* kp = F1 + (size_t)tok * 1536 + 1024 + kvh * 64;
        float acc = 0.f;
#pragma unroll 8
        for (int d = 0; d < 64; ++d) acc += sq[d] * kp[d];
        s = acc * 0.125f;
      } else tok = 0;
      lg[kk] = s; stok[j] = tok; mx = fmaxf(mx, s);
    }
    mx = wave_max(mx);
    float sk = sink[qh];
    mx = fmaxf(mx, sk);
    float sum = 0.f;
#pragma unroll
    for (int kk = 0; kk < 9; ++kk) { float e = (lg[kk] == -INFINITY) ? 0.f : expf(lg[kk] - mx); lg[kk] = e; sum += e; }
    sum = wave_sum(sum) + expf(sk - mx);
    float inv = 1.f / sum;
#pragma unroll
    for (int kk = 0; kk < 9; ++kk) sp[kk * 64 + lane] = lg[kk] * inv;
    __syncthreads();
    float o = 0.f;
    for (int j = 0; j < 513; ++j) { float p = sp[j]; if (p != 0.f) o += p * F1[(size_t)stok[j] * 1536 + 1280 + kvh * 64 + lane]; }
    O[(size_t)row * 1024 + qh * 64 + lane] = (bf16_t)f2bf(o);
  }
}

__device__ __forceinline__ void wave_argmax(float& v, int& idx) {
#pragma unroll
  for (int off = 32; off; off >>= 1) {
    float ov = __shfl_xor(v, off); int oi = __shfl_xor(idx, off);
    if (ov > v || (ov == v && oi < idx)) { v = ov; idx = oi; }
  }
}
__device__ __forceinline__ void ph_peer_select_naive(const float* __restrict__ Q, const float* __restrict__ sk, int* __restrict__ EXP,
                                     float* __restrict__ GATE, int nrows, float* sm) {
  int lane = threadIdx.x & 63, wave = __builtin_amdgcn_readfirstlane(threadIdx.x >> 6);
  float* sq = sm + wave * 640; float* tops = sq + 256; int* topi = (int*)(tops + 32);
  for (int row0 = blockIdx.x * 4; row0 < nrows; row0 += gridDim.x * 4) {
    int row = row0 + wave;
    for (int h = 0; h < 8; ++h) {
      __syncthreads();
#pragma unroll
      for (int i = 0; i < 4; ++i) sq[lane + 64 * i] = Q[(size_t)row * 2048 + h * 256 + lane + 64 * i];
      __syncthreads();
      for (int p = 0; p < 2; ++p) {
        float s0 = 0.f, s1 = 0.f;
        const float* k0 = sk + ((size_t)((h * 2 + p) * 128 + lane)) * 128;
        const float* k1 = k0 + 64 * 128;
#pragma unroll 8
        for (int d = 0; d < 128; ++d) { float qv = sq[p * 128 + d]; s0 += qv * k0[d]; s1 += qv * k1[d]; }
        for (int i = 0; i < 16; ++i) {
          float v; int idx;
          if (s0 >= s1) { v = s0; idx = lane; } else { v = s1; idx = lane + 64; }
          wave_argmax(v, idx);
          if (lane == 0) { tops[p * 16 + i] = v; topi[p * 16 + i] = idx; }
          if (idx == lane) s0 = -INFINITY;
          if (idx == lane + 64) s1 = -INFINITY;
        }
      }
      __syncthreads();
      float cs[4];
#pragma unroll
      for (int i = 0; i < 4; ++i) { int ci = lane * 4 + i; cs[i] = tops[ci >> 4] + tops[16 + (ci & 15)]; }
      float bs[16]; int be[16];
#pragma unroll
      for (int k = 0; k < 16; ++k) {
        float v = cs[0]; int idx = lane * 4;
#pragma unroll
        for (int i = 1; i < 4; ++i) if (cs[i] > v) { v = cs[i]; idx = lane * 4 + i; }
        wave_argmax(v, idx);
        bs[k] = v; be[k] = topi[idx >> 4] * 128 + topi[16 + (idx & 15)];
#pragma unroll
        for (int i = 0; i < 4; ++i) if (idx == lane * 4 + i) cs[i] = -INFINITY;
      }
      float mxs = bs[0]; float sum = 0.f;
#pragma unroll
      for (int k = 0; k < 16; ++k) { bs[k] = expf(bs[k] - mxs); sum += bs[k]; }
      float inv = 1.f / sum;
      if (lane == 0) {
#pragma unroll
        for (int k = 0; k < 16; ++k) { EXP[(size_t)row * 128 + h * 16 + k] = be[k]; GATE[(size_t)row * 128 + h * 16 + k] = bs[k] * inv; }
      }
    }
  }
}

__device__ __forceinline__ void unpack8(uint4 v, float* f) {
  f[0] = __uint_as_float(v.x << 16); f[1] = __uint_as_float(v.x & 0xffff0000u);
  f[2] = __uint_as_float(v.y << 16); f[3] = __uint_as_float(v.y & 0xffff0000u);
  f[4] = __uint_as_float(v.z << 16); f[5] = __uint_as_float(v.z & 0xffff0000u);
  f[6] = __uint_as_float(v.w << 16); f[7] = __uint_as_float(v.w & 0xffff0000u);
}
__device__ __forceinline__ void ph_peer_gather(bf16_t* __restrict__ H, const int* __restrict__ EXP, const float* __restrict__ GATE,
                               const bf16_t* __restrict__ U, const bf16_t* __restrict__ V,
                               const float* __restrict__ xin, const float* __restrict__ M, int layer,
                               const float* __restrict__ g, const float* __restrict__ bb, float* __restrict__ xout,
                               bool write_next, int nrows) {
  int lane = threadIdx.x & 63, wave = __builtin_amdgcn_readfirstlane(threadIdx.x >> 6);
  for (int row = blockIdx.x * 4 + wave; row < nrows; row += gridDim.x * 4) {
    float hreg[16];
    {
      const uint4* hp = (const uint4*)(H + (size_t)row * D + 8 * lane);
      unpack8(hp[0], hreg); unpack8(hp[64], hreg + 8);
    }
    float acc[16];
#pragma unroll
    for (int i = 0; i < 16; ++i) acc[i] = 0.f;
    int e_lo = EXP[(size_t)row * 128 + lane], e_hi = EXP[(size_t)row * 128 + 64 + lane];
    float g_lo = GATE[(size_t)row * 128 + lane], g_hi = GATE[(size_t)row * 128 + 64 + lane];
    uint4 ua[4], ub[4], va[4], vb[4];
#pragma unroll
    for (int i = 0; i < 4; ++i) {
      int e = __builtin_amdgcn_readlane(e_lo, i);
      const uint4* up = (const uint4*)(U + (size_t)e * D + 8 * lane); ua[i] = up[0]; ub[i] = up[64];
    }
#pragma unroll 1
    for (int b = 0; b < 32; ++b) {
      int k0 = 4 * b;
      int ev = (b < 16) ? e_lo : e_hi; float gv = (b < 16) ? g_lo : g_hi;
      int en = (b + 1 < 16) ? e_lo : e_hi;
      float gt[4];
#pragma unroll
      for (int i = 0; i < 4; ++i) {
        int e = __builtin_amdgcn_readlane(ev, (k0 + i) & 63);
        gt[i] = __uint_as_float(__builtin_amdgcn_readlane(__float_as_uint(gv), (k0 + i) & 63));
        const uint4* vp = (const uint4*)(V + (size_t)e * D + 8 * lane); va[i] = vp[0]; vb[i] = vp[64];
      }
      float a[4];
#pragma unroll
      for (int i = 0; i < 4; ++i) {
        float f[16]; unpack8(ua[i], f); unpack8(ub[i], f + 8);
        float sacc = 0.f;
#pragma unroll
        for (int j = 0; j < 16; ++j) sacc += f[j] * hreg[j];
        a[i] = sacc;
      }
      if (b + 1 < 32) {
#pragma unroll
        for (int i = 0; i < 4; ++i) {
          int e = __builtin_amdgcn_readlane(en, (k0 + 4 + i) & 63);
          const uint4* up = (const uint4*)(U + (size_t)e * D + 8 * lane); ua[i] = up[0]; ub[i] = up[64];
        }
      }
#pragma unroll
      for (int i = 0; i < 4; ++i) a[i] = wave_sum(a[i]);
#pragma unroll
      for (int i = 0; i < 4; ++i) {
        float w = gt[i] * 0.5f * a[i] * (1.f + erff(a[i] * 0.70710678118654752f));
        float f[16]; unpack8(va[i], f); unpack8(vb[i], f + 8);
#pragma unroll
        for (int j = 0; j < 16; ++j) acc[j] += w * f[j];
      }
    }
    const float* m = M + ((size_t)layer * 3 + mod_index(row)) * 6144;
    const float* xr = xin + (size_t)row * D;
    float v[16];
#pragma unroll
    for (int hh = 0; hh < 2; ++hh) {
      int d0 = hh * 512 + 8 * lane;
      float4 x0 = *(const float4*)(xr + d0), x1 = *(const float4*)(xr + d0 + 4);
      float4 m0 = *(const float4*)(m + 5 * D + d0), m1 = *(const float4*)(m + 5 * D + d0 + 4);
      v[hh * 8 + 0] = DN_ALPHA * x0.x + m0.x * acc[hh * 8 + 0]; v[hh * 8 + 1] = DN_ALPHA * x0.y + m0.y * acc[hh * 8 + 1];
      v[hh * 8 + 2] = DN_ALPHA * x0.z + m0.z * acc[hh * 8 + 2]; v[hh * 8 + 3] = DN_ALPHA * x0.w + m0.w * acc[hh * 8 + 3];
      v[hh * 8 + 4] = DN_ALPHA * x1.x + m1.x * acc[hh * 8 + 4]; v[hh * 8 + 5] = DN_ALPHA * x1.y + m1.y * acc[hh * 8 + 5];
      v[hh * 8 + 6] = DN_ALPHA * x1.z + m1.z * acc[hh * 8 + 6]; v[hh * 8 + 7] = DN_ALPHA * x1.w + m1.w * acc[hh * 8 + 7];
    }
    float s = 0.f;
#pragma unroll
    for (int j = 0; j < 16; ++j) s += v[j];
    float mu = wave_sum(s) * (1.f / D);
    float q = 0.f;
#pragma unroll
    for (int j = 0; j < 16; ++j) { float d = v[j] - mu; q += d * d; }
    float rs = rsqrtf(wave_sum(q) * (1.f / D) + LN_EPS);
    float y[16];
#pragma unroll
    for (int hh = 0; hh < 2; ++hh) {
      int d0 = hh * 512 + 8 * lane;
#pragma unroll
      for (int j = 0; j < 8; ++j) y[hh * 8 + j] = (v[hh * 8 + j] - mu) * rs * g[d0 + j] + bb[d0 + j];
      *(float4*)(xout + (size_t)row * D + d0) = make_float4(y[hh * 8], y[hh * 8 + 1], y[hh * 8 + 2], y[hh * 8 + 3]);
      *(float4*)(xout + (size_t)row * D + d0 + 4) = make_float4(y[hh * 8 + 4], y[hh * 8 + 5], y[hh * 8 + 6], y[hh * 8 + 7]);
    }
    if (write_next) {
      const float* mn = M + ((size_t)(layer + 1) * 3 + mod_index(row)) * 6144;
      float s2 = 0.f;
#pragma unroll
      for (int j = 0; j < 16; ++j) s2 += y[j];
      float mu2 = wave_sum(s2) * (1.f / D);
      float q2 = 0.f;
#pragma unroll
      for (int j = 0; j < 16; ++j) { float d = y[j] - mu2; q2 += d * d; }
      float rs2 = rsqrtf(wave_sum(q2) * (1.f / D) + LN_EPS);
#pragma unroll
      for (int hh = 0; hh < 2; ++hh) {
        int d0 = hh * 512 + 8 * lane;
        float o[8];
#pragma unroll
        for (int j = 0; j < 8; ++j) o[j] = (y[hh * 8 + j] - mu2) * rs2 * (1.f + mn[D + d0 + j]) + mn[d0 + j];
        *(uint4*)(H + (size_t)row * D + d0) = make_uint4(pack2bf(o[0], o[1]), pack2bf(o[2], o[3]), pack2bf(o[4], o[5]), pack2bf(o[6], o[7]));
      }
    }
  }
}


__device__ __forceinline__ void quant_row(const float* __restrict__ src, unsigned char* __restrict__ dst, float* __restrict__ scale, int row, int lane) {
  const float4* sp = (const float4*)(src + (size_t)row * D + 16 * lane);
  float4 v0 = sp[0], v1 = sp[1], v2 = sp[2], v3 = sp[3];
  float x[16] = {v0.x, v0.y, v0.z, v0.w, v1.x, v1.y, v1.z, v1.w, v2.x, v2.y, v2.z, v2.w, v3.x, v3.y, v3.z, v3.w};
  float am = 0.f;
#pragma unroll
  for (int j = 0; j < 16; ++j) am = fmaxf(am, fabsf(x[j]));
  am = wave_max(am);
  float inv = am > 0.f ? 127.f / am : 0.f;
  unsigned wv[4];
#pragma unroll
  for (int k = 0; k < 4; ++k) {
    unsigned w = 0;
#pragma unroll
    for (int j = 0; j < 4; ++j) {
      int q = (int)rintf(x[4 * k + j] * inv);
      w |= ((unsigned)q & 0xffu) << (8 * j);
    }
    wv[k] = w;
  }
  *(uint4*)(dst + ((size_t)(row >> 14) * 8 + (lane >> 3)) * ((size_t)16384 * 128) + (size_t)(row & 16383) * 128 + 16 * (lane & 7)) = make_uint4(wv[0], wv[1], wv[2], wv[3]);
  if (lane == 0) scale[row] = am * (1.f / 127.f);
}
__device__ __forceinline__ void quant_row_u4(const float* __restrict__ src, unsigned char* __restrict__ dst, float* __restrict__ scale, int row, int lane) {
  const float4* sp = (const float4*)(src + (size_t)row * D + 16 * lane);
  float4 v0 = sp[0], v1 = sp[1], v2 = sp[2], v3 = sp[3];
  float x[16] = {v0.x, v0.y, v0.z, v0.w, v1.x, v1.y, v1.z, v1.w, v2.x, v2.y, v2.z, v2.w, v3.x, v3.y, v3.z, v3.w};
  float ss = 0.f;
#pragma unroll
  for (int j = 0; j < 16; ++j) ss += x[j] * x[j];
  ss = wave_sum(ss);
  float delta = 0.3352f * sqrtf(ss * (1.f / D));
  float inv = delta > 0.f ? 1.f / delta : 0.f;
  unsigned wv[2];
#pragma unroll
  for (int k = 0; k < 2; ++k) {
    unsigned w = 0;
#pragma unroll
    for (int j = 0; j < 4; ++j) {
      int qh = (int)fminf(fmaxf(floorf(x[8 * k + j] * inv), -8.f), 7.f);
      int ql = (int)fminf(fmaxf(floorf(x[8 * k + 4 + j] * inv), -8.f), 7.f);
      w |= ((((unsigned)qh & 15u) << 4) | ((unsigned)ql & 15u)) << (8 * j);
    }
    wv[k] = w;
  }
  *(uint2*)(dst + ((size_t)(row >> 14) * 4 + (lane >> 4)) * ((size_t)16384 * 128) + (size_t)(row & 16383) * 128 + 8 * (lane & 15)) = make_uint2(wv[0], wv[1]);
  if (lane == 0) scale[(size_t)2 * row] = delta;
}
__device__ __forceinline__ void quant_fill(unsigned* ctr, int layer, unsigned lo, unsigned hi, const float* __restrict__ pu, const float* __restrict__ pv,
                                           unsigned char* __restrict__ U8, unsigned char* __restrict__ V8, float* __restrict__ USC,
                                           float* __restrict__ VSC, unsigned* sh) {
  int lane = threadIdx.x & 63, wave = __builtin_amdgcn_readfirstlane(threadIdx.x >> 6);
  for (;;) {
    __syncthreads();
    if (threadIdx.x == 0) *sh = lo + __hip_atomic_fetch_add(ctr, 1u, __ATOMIC_RELAXED, __HIP_MEMORY_SCOPE_AGENT);
    __syncthreads();
    unsigned c = *sh;
    if (c >= hi) break;
    const float* src = (c >> 8) ? pv : pu; unsigned char* dst = (c >> 8) ? V8 : U8; float* sc = (c >> 8) ? USC + 1 : USC; (void)VSC;
    int r0 = layer * 16384 + (int)(c & 255u) * 64 + wave * 16;
#pragma unroll 4
    for (int i = 0; i < 16; ++i) quant_row_u4(src, dst, sc, r0 + i, lane);
  }
  __syncthreads();
}
__device__ __forceinline__ void unpack_u8x16(uint4 v, float* f) {
  unsigned w[4] = {v.x, v.y, v.z, v.w};
#pragma unroll
  for (int k = 0; k < 4; ++k) {
    f[4 * k + 0] = (float)(w[k] & 0xffu); f[4 * k + 1] = (float)((w[k] >> 8) & 0xffu);
    f[4 * k + 2] = (float)((w[k] >> 16) & 0xffu); f[4 * k + 3] = (float)(w[k] >> 24);
  }
}
__device__ __forceinline__ void ph_peer_gather8(bf16_t* __restrict__ H, const int* __restrict__ EXP, const float* __restrict__ GATE,
                               const unsigned char* __restrict__ U8, const float* __restrict__ USC,
                               const unsigned char* __restrict__ V8, const float* __restrict__ VSC,
                               const float* __restrict__ xin, const float* __restrict__ M, int layer,
                               const float* __restrict__ g, const float* __restrict__ bb, float* __restrict__ xout,
                               bool write_next, int nrows) {
  int lane = threadIdx.x & 63, wave = __builtin_amdgcn_readfirstlane(threadIdx.x >> 6);
  for (int row = blockIdx.x * 4 + wave; row < nrows; row += gridDim.x * 4) {
    float hreg[16];
    {
      const uint4* hp = (const uint4*)(H + (size_t)row * D + 16 * lane);
      unpack8(hp[0], hreg); unpack8(hp[1], hreg + 8);
    }
    float hs = 0.f;
#pragma unroll
    for (int j = 0; j < 16; ++j) hs += hreg[j];
    float hsum128 = 128.f * wave_sum(hs);
    float acc[16];
#pragma unroll
    for (int i = 0; i < 16; ++i) acc[i] = 0.f;
    float wsum = 0.f;
    int e_lo = EXP[(size_t)row * 128 + lane], e_hi = EXP[(size_t)row * 128 + 64 + lane];
    float g_lo = GATE[(size_t)row * 128 + lane], g_hi = GATE[(size_t)row * 128 + 64 + lane];
    float us_lo = USC[e_lo], us_hi = USC[e_hi], vs_lo = VSC[e_lo], vs_hi = VSC[e_hi];
    uint4 ua[8], va[8];
#pragma unroll
    for (int i = 0; i < 8; ++i) {
      int e = __builtin_amdgcn_readlane(e_lo, i);
      ua[i] = *(const uint4*)(U8 + (size_t)e * D + 16 * lane);
    }
#pragma unroll 1
    for (int b = 0; b < 16; ++b) {
      int k0 = 8 * b;
      bool lo = b < 8, lon = (b + 1) < 8;
      int ev = lo ? e_lo : e_hi; float gv = lo ? g_lo : g_hi; float usv = lo ? us_lo : us_hi; float vsv = lo ? vs_lo : vs_hi;
      int en = lon ? e_lo : e_hi;
      float gt[8], usc[8], vsc[8];
#pragma unroll
      for (int i = 0; i < 8; ++i) {
        int li = (k0 + i) & 63;
        int e = __builtin_amdgcn_readlane(ev, li);
        gt[i] = __uint_as_float(__builtin_amdgcn_readlane(__float_as_uint(gv), li));
        usc[i] = __uint_as_float(__builtin_amdgcn_readlane(__float_as_uint(usv), li));
        vsc[i] = __uint_as_float(__builtin_amdgcn_readlane(__float_as_uint(vsv), li));
        va[i] = *(const uint4*)(V8 + (size_t)e * D + 16 * lane);
      }
      float a[8];
#pragma unroll
      for (int i = 0; i < 8; ++i) {
        float f[16]; unpack_u8x16(ua[i], f);
        float sacc = 0.f;
#pragma unroll
        for (int j = 0; j < 16; ++j) sacc += f[j] * hreg[j];
        a[i] = sacc;
      }
      if (b + 1 < 16) {
#pragma unroll
        for (int i = 0; i < 8; ++i) {
          int e = __builtin_amdgcn_readlane(en, (k0 + 8 + i) & 63);
          ua[i] = *(const uint4*)(U8 + (size_t)e * D + 16 * lane);
        }
      }
#pragma unroll
      for (int i = 0; i < 8; ++i) a[i] = (wave_sum(a[i]) - hsum128) * usc[i];
#pragma unroll
      for (int i = 0; i < 8; ++i) {
        float w = gt[i] * 0.5f * a[i] * (1.f + erff(a[i] * 0.70710678118654752f)) * vsc[i];
        wsum += w;
        float f[16]; unpack_u8x16(va[i], f);
#pragma unroll
        for (int j = 0; j < 16; ++j) acc[j] += w * f[j];
      }
    }
    float corr = 128.f * wsum;
#pragma unroll
    for (int j = 0; j < 16; ++j) acc[j] -= corr;
    const float* m = M + ((size_t)layer * 3 + mod_index(row)) * 6144;
    const float* xr = xin + (size_t)row * D + 16 * lane;
    const float* m5 = m + 5 * D + 16 * lane;
    float v[16];
#pragma unroll
    for (int q4 = 0; q4 < 4; ++q4) {
      float4 x0 = *(const float4*)(xr + 4 * q4); float4 m0 = *(const float4*)(m5 + 4 * q4);
      v[4 * q4 + 0] = DN_ALPHA * x0.x + m0.x * acc[4 * q4 + 0]; v[4 * q4 + 1] = DN_ALPHA * x0.y + m0.y * acc[4 * q4 + 1];
      v[4 * q4 + 2] = DN_ALPHA * x0.z + m0.z * acc[4 * q4 + 2]; v[4 * q4 + 3] = DN_ALPHA * x0.w + m0.w * acc[4 * q4 + 3];
    }
    float s = 0.f;
#pragma unroll
    for (int j = 0; j < 16; ++j) s += v[j];
    float mu = wave_sum(s) * (1.f / D);
    float q = 0.f;
#pragma unroll
    for (int j = 0; j < 16; ++j) { float d = v[j] - mu; q += d * d; }
    float rs = rsqrtf(wave_sum(q) * (1.f / D) + LN_EPS);
    float y[16];
    {
      const float* gp = g + 16 * lane; const float* bp = bb + 16 * lane;
      float* op = xout + (size_t)row * D + 16 * lane;
#pragma unroll
      for (int q4 = 0; q4 < 4; ++q4) {
        float4 g4 = *(const float4*)(gp + 4 * q4); float4 b4 = *(const float4*)(bp + 4 * q4);
        y[4 * q4 + 0] = (v[4 * q4 + 0] - mu) * rs * g4.x + b4.x; y[4 * q4 + 1] = (v[4 * q4 + 1] - mu) * rs * g4.y + b4.y;
        y[4 * q4 + 2] = (v[4 * q4 + 2] - mu) * rs * g4.z + b4.z; y[4 * q4 + 3] = (v[4 * q4 + 3] - mu) * rs * g4.w + b4.w;
        *(float4*)(op + 4 * q4) = make_float4(y[4 * q4], y[4 * q4 + 1], y[4 * q4 + 2], y[4 * q4 + 3]);
      }
    }
    if (write_next) {
      const float* mn = M + ((size_t)(layer + 1) * 3 + mod_index(row)) * 6144 + 16 * lane;
      float s2 = 0.f;
#pragma unroll
      for (int j = 0; j < 16; ++j) s2 += y[j];
      float mu2 = wave_sum(s2) * (1.f / D);
      float q2 = 0.f;
#pragma unroll
      for (int j = 0; j < 16; ++j) { float d = y[j] - mu2; q2 += d * d; }
      float rs2 = rsqrtf(wave_sum(q2) * (1.f / D) + LN_EPS);
      float o[16];
#pragma unroll
      for (int j = 0; j < 16; ++j) o[j] = (y[j] - mu2) * rs2 * (1.f + mn[D + j]) + mn[j];
      uint4* hp = (uint4*)(H + (size_t)row * D + 16 * lane);
      hp[0] = make_uint4(pack2bf(o[0], o[1]), pack2bf(o[2], o[3]), pack2bf(o[4], o[5]), pack2bf(o[6], o[7]));
      hp[1] = make_uint4(pack2bf(o[8], o[9]), pack2bf(o[10], o[11]), pack2bf(o[12], o[13]), pack2bf(o[14], o[15]));
    }
  }
}


__device__ __forceinline__ void ph_ada2(const float* __restrict__ c, const float* __restrict__ c_ctx, const float* __restrict__ ada_w,
                                        const float* __restrict__ ada_b, float* __restrict__ M, float* sm) {
  int tid = threadIdx.x, lane = tid & 63, wave = __builtin_amdgcn_readfirstlane(tid >> 6);
  float* sv = sm;
  float* red = sm + 3072;
  bool filled = false;
  GRID_LOOP(u, 384) {
    if (!filled) {
      for (int i = tid; i < 3072; i += 256) {
        int idx = i >> 10, k = i & 1023;
        float x = idx < 2 ? c[idx * D + k] : c_ctx[k];
        sv[i] = x / (1.f + expf(-x));
      }
      filled = true;
    }
    __syncthreads();
    int layer = u / 192, c0 = (u % 192) * 32;
    int col = lane & 31;
    const float* w = ada_w + (size_t)layer * D * 6144 + c0 + col;
    float a0 = 0.f, a1 = 0.f, a2 = 0.f;
    int kb = wave * 256 + (lane >> 5) * 128;
#pragma unroll 16
    for (int k = 0; k < 128; ++k) {
      float wv = w[(size_t)(kb + k) * 6144];
      a0 += sv[kb + k] * wv; a1 += sv[1024 + kb + k] * wv; a2 += sv[2048 + kb + k] * wv;
    }
    a0 += __shfl_xor(a0, 32); a1 += __shfl_xor(a1, 32); a2 += __shfl_xor(a2, 32);
    if (lane < 32) { red[(wave * 3 + 0) * 64 + lane] = a0; red[(wave * 3 + 1) * 64 + lane] = a1; red[(wave * 3 + 2) * 64 + lane] = a2; }
    __syncthreads();
    if (wave < 3 && lane < 32) {
      float r = red[(0 * 3 + wave) * 64 + lane] + red[(1 * 3 + wave) * 64 + lane] + red[(2 * 3 + wave) * 64 + lane] + red[(3 * 3 + wave) * 64 + lane];
      M[((size_t)layer * 3 + wave) * 6144 + c0 + lane] = r + ada_b[layer * 6144 + c0 + lane];
    }
  }
  __syncthreads();
}

__device__ __forceinline__ float pm_half32_max(float v) {
  v = fmaxf(v, dpp_mov<0xB1>(v)); v = fmaxf(v, dpp_mov<0x4E>(v)); v = fmaxf(v, dpp_mov<0x124>(v)); v = fmaxf(v, dpp_mov<0x128>(v));
  auto s = __builtin_amdgcn_permlane16_swap(__float_as_uint(v), __float_as_uint(v), false, false);
  return fmaxf(__uint_as_float(s[0]), __uint_as_float(s[1]));
}
__device__ __forceinline__ float pm_half32_sum(float v) {
  v += dpp_mov<0xB1>(v); v += dpp_mov<0x4E>(v); v += dpp_mov<0x124>(v); v += dpp_mov<0x128>(v);
  auto s = __builtin_amdgcn_permlane16_swap(__float_as_uint(v), __float_as_uint(v), false, false);
  return __uint_as_float(s[0]) + __uint_as_float(s[1]);
}
template <bool XIN_BF, bool XOUT_BF>
__device__ __forceinline__ void ph_post_mod(const void* __restrict__ xa_, const void* __restrict__ xb_, const bf16_t* __restrict__ Y,
                                            const float* __restrict__ M, int layer, int jres, int mlayer, int jshift, int jscale, bool do_mod,
                                            const float* __restrict__ g, const float* __restrict__ bb,
                                            void* __restrict__ xout_, bf16_t* __restrict__ H, int nrows,
                                            unsigned char* __restrict__ HQ = nullptr, float* __restrict__ HS = nullptr) {
  int lane = threadIdx.x & 63, wave = __builtin_amdgcn_readfirstlane(threadIdx.x >> 6);
#define PM_OFF(q4) ((((q4) >> 1) << 9) + 8 * lane + 4 * ((q4) & 1))
  constexpr int NX = XIN_BF ? 2 : 4;
  uint4 nx[NX], ny[2];
#define PM_FETCH(rr) { int r_ = (rr); const uint4* xp_; \
    if (XIN_BF) { xp_ = (const uint4*)((r_ < T ? (const bf16_t*)xa_ + (size_t)r_ * D : (const bf16_t*)xb_ + (size_t)(r_ - T) * D) + 8 * lane); \
      nx[0] = xp_[0]; nx[1 % NX] = xp_[64]; } \
    else { xp_ = (const uint4*)((r_ < T ? (const float*)xa_ + (size_t)r_ * D : (const float*)xb_ + (size_t)(r_ - T) * D) + 8 * lane); \
      nx[0] = xp_[0]; nx[1 % NX] = xp_[1]; nx[2 % NX] = xp_[128]; nx[3 % NX] = xp_[129]; } \
    const uint4* yp_ = (const uint4*)(Y + (size_t)r_ * D + 8 * lane); ny[0] = yp_[0]; ny[1] = yp_[64]; }
  {
    int row0 = blockIdx.x * 4 + wave;
    if (row0 < nrows) PM_FETCH(row0)
  }
  float4 g4r[4], b4r[4], mres[4], msc[4], msh[4];
#pragma unroll
  for (int q4 = 0; q4 < 4; ++q4) { g4r[q4] = *(const float4*)(g + PM_OFF(q4)); b4r[q4] = *(const float4*)(bb + PM_OFF(q4));
    mres[q4] = make_float4(0.f, 0.f, 0.f, 0.f); msc[q4] = mres[q4]; msh[q4] = mres[q4]; }
  int cur_mi = -1;
  for (int row = blockIdx.x * 4 + wave; row < nrows; row += gridDim.x * 4) {
    {
      int mi = mod_index(row);
      if (mi != cur_mi) {
        cur_mi = mi;
        const float* m_ = M + ((size_t)layer * 3 + mi) * 6144;
        const float* mm_ = M + ((size_t)mlayer * 3 + mi) * 6144;
#pragma unroll
        for (int q4 = 0; q4 < 4; ++q4) { mres[q4] = *(const float4*)(m_ + jres * D + PM_OFF(q4));
          if (do_mod) { msc[q4] = *(const float4*)(mm_ + jscale * D + PM_OFF(q4)); msh[q4] = *(const float4*)(mm_ + jshift * D + PM_OFF(q4)); } }
      }
    }
    float xv[16];
    if (XIN_BF) { unpack8(nx[0], xv); unpack8(nx[1], xv + 8); }
    else {
#pragma unroll
      for (int q4 = 0; q4 < 4; ++q4) { xv[4 * q4] = __uint_as_float(nx[q4 % NX].x); xv[4 * q4 + 1] = __uint_as_float(nx[q4 % NX].y); xv[4 * q4 + 2] = __uint_as_float(nx[q4 % NX].z); xv[4 * q4 + 3] = __uint_as_float(nx[q4 % NX].w); }
    }
    float yv[16];
    unpack8(ny[0], yv); unpack8(ny[1], yv + 8);
    PM_FETCH(min(row + (int)gridDim.x * 4, nrows - 1))
    float v[16];
#pragma unroll
    for (int q4 = 0; q4 < 4; ++q4) {
      float4 m0 = mres[q4];
      v[4 * q4 + 0] = DN_ALPHA * xv[4 * q4 + 0] + m0.x * yv[4 * q4 + 0]; v[4 * q4 + 1] = DN_ALPHA * xv[4 * q4 + 1] + m0.y * yv[4 * q4 + 1];
      v[4 * q4 + 2] = DN_ALPHA * xv[4 * q4 + 2] + m0.z * yv[4 * q4 + 2]; v[4 * q4 + 3] = DN_ALPHA * xv[4 * q4 + 3] + m0.w * yv[4 * q4 + 3];
    }
    float s = sum16_pk(v);
    float mu = wave_sum(s) * (1.f / D);
    float q = sumsq16_pk(v, mu);
    float rs = rsqrtf(wave_sum(q) * (1.f / D) + LN_EPS);
    float y[16];
    {
#pragma unroll
      for (int q4 = 0; q4 < 4; ++q4) {
        float4 g4 = g4r[q4]; float4 b4 = b4r[q4];
        y[4 * q4 + 0] = (v[4 * q4 + 0] - mu) * rs * g4.x + b4.x; y[4 * q4 + 1] = (v[4 * q4 + 1] - mu) * rs * g4.y + b4.y;
        y[4 * q4 + 2] = (v[4 * q4 + 2] - mu) * rs * g4.z + b4.z; y[4 * q4 + 3] = (v[4 * q4 + 3] - mu) * rs * g4.w + b4.w;
      }
      if (XOUT_BF) {
        uint4* op = (uint4*)((bf16_t*)xout_ + (size_t)row * D + 8 * lane);
        op[0] = make_uint4(pack2bf(y[0], y[1]), pack2bf(y[2], y[3]), pack2bf(y[4], y[5]), pack2bf(y[6], y[7]));
        op[64] = make_uint4(pack2bf(y[8], y[9]), pack2bf(y[10], y[11]), pack2bf(y[12], y[13]), pack2bf(y[14], y[15]));
#pragma unroll
        for (int j = 0; j < 16; j += 2) { unsigned pk = pack2bf(y[j], y[j + 1]); y[j] = __uint_as_float(pk << 16); y[j + 1] = __uint_as_float(pk & 0xffff0000u); }
      } else {
        float* op = (float*)xout_ + (size_t)row * D;
#pragma unroll
        for (int q4 = 0; q4 < 4; ++q4) *(float4*)(op + PM_OFF(q4)) = make_float4(y[4 * q4], y[4 * q4 + 1], y[4 * q4 + 2], y[4 * q4 + 3]);
      }
    }
    if (do_mod) {
      float s2 = sum16_pk(y);
      float mu2 = wave_sum(s2) * (1.f / D);
      float q2 = sumsq16_pk(y, mu2);
      float rs2 = rsqrtf(wave_sum(q2) * (1.f / D) + LN_EPS);
      float o[16];
#pragma unroll
      for (int q4 = 0; q4 < 4; ++q4) {
        o[4 * q4 + 0] = (y[4 * q4 + 0] - mu2) * rs2 * (1.f + msc[q4].x) + msh[q4].x; o[4 * q4 + 1] = (y[4 * q4 + 1] - mu2) * rs2 * (1.f + msc[q4].y) + msh[q4].y;
        o[4 * q4 + 2] = (y[4 * q4 + 2] - mu2) * rs2 * (1.f + msc[q4].z) + msh[q4].z; o[4 * q4 + 3] = (y[4 * q4 + 3] - mu2) * rs2 * (1.f + msc[q4].w) + msh[q4].w;
      }
      uint4* hp = (uint4*)(H + (size_t)row * D + 8 * lane);
      hp[0] = make_uint4(pack2bf(o[0], o[1]), pack2bf(o[2], o[3]), pack2bf(o[4], o[5]), pack2bf(o[6], o[7]));
      hp[64] = make_uint4(pack2bf(o[8], o[9]), pack2bf(o[10], o[11]), pack2bf(o[12], o[13]), pack2bf(o[14], o[15]));
      if (HQ) {
        float am0 = 0.f, am1 = 0.f;
#pragma unroll
        for (int j = 0; j < 8; ++j) { am0 = fmaxf(am0, fabsf(o[j])); am1 = fmaxf(am1, fabsf(o[8 + j])); }
        am0 = pm_half32_max(am0); am1 = pm_half32_max(am1);
        float hinv[2], hsc[2], hsum[2]; unsigned pk[4];
        hinv[0] = am0 > 0.f ? 119.f / am0 : 0.f; hsc[0] = am0 * (1.f / 119.f);
        hinv[1] = am1 > 0.f ? 119.f / am1 : 0.f; hsc[1] = am1 * (1.f / 119.f);
#pragma unroll
        for (int k = 0; k < 2; ++k) {
          unsigned w0 = 0, w1 = 0; hsum[k] = 0.f;
#pragma unroll
          for (int j = 0; j < 4; ++j) {
            float r0 = rintf(o[8 * k + j] * hinv[k]), r1 = rintf(o[8 * k + 4 + j] * hinv[k]);
            hsum[k] += r0 + r1;
            w0 = __builtin_amdgcn_cvt_pk_u8_f32(r0 + 128.f, j, w0); w1 = __builtin_amdgcn_cvt_pk_u8_f32(r1 + 128.f, j, w1);
          }
          unsigned t0 = (w0 + 0x08080808u) ^ 0x88888888u, t1 = (w1 + 0x08080808u) ^ 0x88888888u;
          pk[2 * k] = (t0 & 0xF0F0F0F0u) | ((t1 >> 4) & 0x0F0F0F0Fu);
          pk[2 * k + 1] = ((t0 << 4) & 0xF0F0F0F0u) | (t1 & 0x0F0F0F0Fu);
        }
        hsum[0] = pm_half32_sum(hsum[0]); hsum[1] = pm_half32_sum(hsum[1]);
        uint2* qp = (uint2*)(HQ + (size_t)row * D + 8 * lane);
        qp[0] = make_uint2(pk[0], pk[1]); qp[64] = make_uint2(pk[2], pk[3]);
        if ((lane & 31) == 0) {
          float2* sp_ = (float2*)HS + (size_t)row * 4 + (lane >> 5);
          sp_[0] = make_float2(hsc[0], 0.5f * hsc[0] * hsum[0]); sp_[2] = make_float2(hsc[1], 0.5f * hsc[1] * hsum[1]);
        }
      }
    }
  }
}


#undef PM_OFF
#undef PM_FETCH
template <int CTRL> __device__ __forceinline__ float dpp_add(float x) { return x + dpp_mov<CTRL>(x); }
__device__ __forceinline__ float sum8(float v) {
  v = dpp_add<0xB1>(v); v = dpp_add<0x4E>(v); v = dpp_add<0x141>(v); return v;
}
typedef _Float16 half2_t __attribute__((ext_vector_type(2)));
__device__ __forceinline__ float dot2h(unsigned a, unsigned b, float c) {
  return __builtin_amdgcn_fdot2(__builtin_bit_cast(half2_t, a), __builtin_bit_cast(half2_t, b), c, false);
}
__device__ __forceinline__ unsigned pkh(float a, float b) { return __builtin_bit_cast(unsigned, __builtin_amdgcn_cvt_pkrtz(a, b)); }
__device__ __forceinline__ void load_e16(const int* EXP, int t, int g8, int (&e)[16]) {
  const uint4* ep = (const uint4*)((const unsigned short*)EXP + (size_t)t * 128 + 16 * g8);
  uint4 a = ep[0], b = ep[1];
  unsigned w[8] = {a.x, a.y, a.z, a.w, b.x, b.y, b.z, b.w};
#pragma unroll
  for (int i = 0; i < 8; ++i) { e[2 * i] = (int)(w[i] & 0xffffu); e[2 * i + 1] = (int)(w[i] >> 16); }
}
__device__ __forceinline__ int dpp_iadd_b1(int v) { return v + __builtin_amdgcn_mov_dpp(v, 0xB1, 0xf, 0xf, true); }
__device__ __forceinline__ int dpp_iadd_4e(int v) { return v + __builtin_amdgcn_mov_dpp(v, 0x4E, 0xf, 0xf, true); }
__device__ __forceinline__ int dpp_iadd_141(int v) { return v + __builtin_amdgcn_mov_dpp(v, 0x141, 0xf, 0xf, true); }
#define U_TOKEN(tt, UV, UVN, EUSE, ELD, HUSE, HLD, SUSE, SLD) { \
    int tnn_ = min((tt) + 2 * st, nrows - 1); \
    load_e16(EXP, tnn_, g8, ELD); \
    HLD[0] = *(const uint4*)(hb + (size_t)tnn_ * D); HLD[1] = *(const uint4*)(hb + (size_t)tnn_ * D + 16); \
    SLD = *(const float2*)(HS + ((size_t)tnn_ * 4 + x) * 2); \
    __builtin_amdgcn_sched_barrier(0); \
    _Pragma("unroll") for (int i = 0; i < 16; ++i) UVN[i] = *(const uint4*)(ubs + (((unsigned)EUSE[i] << 7) + loff)); \
    __builtin_amdgcn_sched_barrier(0); \
    int a0_ = (int)HUSE[0].x, b0_ = (int)HUSE[0].y, a1_ = (int)HUSE[0].z, b1_ = (int)HUSE[0].w; \
    int a2_ = (int)HUSE[1].x, b2_ = (int)HUSE[1].y, a3_ = (int)HUSE[1].z, b3_ = (int)HUSE[1].w; \
    int k0 = 0, k1 = 0; \
    _Pragma("unroll") for (int i = 0; i < 16; ++i) { \
      int pa_ = __builtin_amdgcn_sdot8((int)UV[i].x, a0_, 0, false); pa_ = __builtin_amdgcn_sdot8((int)UV[i].y, a1_, pa_, false); \
      pa_ = __builtin_amdgcn_sdot8((int)UV[i].z, a2_, pa_, false); pa_ = __builtin_amdgcn_sdot8((int)UV[i].w, a3_, pa_, false); \
      int pb_ = __builtin_amdgcn_sdot8((int)UV[i].x, b0_, 0, false); pb_ = __builtin_amdgcn_sdot8((int)UV[i].y, b1_, pb_, false); \
      pb_ = __builtin_amdgcn_sdot8((int)UV[i].z, b2_, pb_, false); pb_ = __builtin_amdgcn_sdot8((int)UV[i].w, b3_, pb_, false); \
      int p_ = dpp_iadd_141(dpp_iadd_4e(dpp_iadd_b1((pa_ << 4) + pb_))); \
      if ((i >> 1) == j8) { if (i & 1) k1 = p_; else k0 = p_; } } \
    *(unsigned*)((bf16_t*)PA + ((size_t)(tt) * 4 + x) * 128 + 16 * g8 + 2 * j8) = pack2bf(fmaf((float)k0, SUSE.x, SUSE.y), fmaf((float)k1, SUSE.x, SUSE.y)); }
__device__ __forceinline__ void ph_peer_u(const unsigned char* __restrict__ HQ, const float* __restrict__ HS, const int* __restrict__ EXP,
                                          const unsigned char* __restrict__ U4, float* __restrict__ PA, int nrows) {
  int lane = threadIdx.x & 63, wave = __builtin_amdgcn_readfirstlane(threadIdx.x >> 6);
  int x = (blockIdx.x & 7) >> 1; int nb8 = gridDim.x >> 3;
  if ((int)(blockIdx.x >> 3) >= nb8) return;
  int j8 = lane & 7, g8 = lane >> 3;
  const int st = nb8 * 8;
  int t = ((blockIdx.x >> 3) * 2 + (blockIdx.x & 1)) * 4 + wave;
  if (t >= nrows) return;
  const unsigned char* ubs = U4 + (size_t)x * ((size_t)16384 * 128);
  const unsigned loff = 16u * (unsigned)j8;
  const unsigned char* hb = HQ + 256 * x + 32 * j8;
  int eA[16], eB[16]; uint4 hA[2], hB[2], uvA[16], uvB[16]; float2 sA, sB;
  {
    int e0[16]; load_e16(EXP, t, g8, e0);
#pragma unroll
    for (int i = 0; i < 16; ++i) uvA[i] = *(const uint4*)(ubs + (((unsigned)e0[i] << 7) + loff));
    hA[0] = *(const uint4*)(hb + (size_t)t * D); hA[1] = *(const uint4*)(hb + (size_t)t * D + 16);
    sA = *(const float2*)(HS + ((size_t)t * 4 + x) * 2);
    int tn = min(t + st, nrows - 1);
    load_e16(EXP, tn, g8, eA);
    hB[0] = *(const uint4*)(hb + (size_t)tn * D); hB[1] = *(const uint4*)(hb + (size_t)tn * D + 16);
    sB = *(const float2*)(HS + ((size_t)tn * 4 + x) * 2);
  }
#pragma unroll 1
  for (; t < nrows; t += 2 * st) {
    uint4 hC[2]; float2 sC;
    U_TOKEN(t, uvA, uvB, eA, eB, hA, hC, sA, sC)
    if (t + st < nrows) {
      U_TOKEN(t + st, uvB, uvA, eB, eA, hB, hA, sB, sA)
    }
    hB[0] = hA[0]; hB[1] = hA[1]; hA[0] = hC[0]; hA[1] = hC[1]; sB = sA; sA = sC;
  }
}
__device__ __forceinline__ float half32_max(float v) {
  v = fmaxf(v, dpp_mov<0xB1>(v)); v = fmaxf(v, dpp_mov<0x4E>(v)); v = fmaxf(v, dpp_mov<0x124>(v)); v = fmaxf(v, dpp_mov<0x128>(v));
  auto s = __builtin_amdgcn_permlane16_swap(__float_as_uint(v), __float_as_uint(v), false, false);
  return fmaxf(__uint_as_float(s[0]), __uint_as_float(s[1]));
}
__device__ __forceinline__ float half32_sum(float v) {
  v += dpp_mov<0xB1>(v); v += dpp_mov<0x4E>(v); v += dpp_mov<0x124>(v); v += dpp_mov<0x128>(v);
  auto s = __builtin_amdgcn_permlane16_swap(__float_as_uint(v), __float_as_uint(v), false, false);
  return __uint_as_float(s[0]) + __uint_as_float(s[1]);
}
template <int FMT> __device__ __forceinline__ void ph_peer_w(const float* __restrict__ PA, const int* __restrict__ EXP, const float* __restrict__ GATE,
                                          const float* __restrict__ USC, const float* __restrict__ VSC, unsigned* __restrict__ WQ,
                                          float* __restrict__ SW, int nrows) {
  int lane = threadIdx.x & 63, wave = __builtin_amdgcn_readfirstlane(threadIdx.x >> 6);
  int l4 = lane & 31;
  for (int t = (blockIdx.x * 4 + wave) * 2 + (lane >> 5); t < nrows; t += gridDim.x * 8) {
    uint2 e = *(const uint2*)((const unsigned short*)EXP + (size_t)t * 128 + 4 * l4);
    uint2 gt = *(const uint2*)((const bf16_t*)GATE + (size_t)t * 128 + 4 * l4);
    float a[4] = {0.f, 0.f, 0.f, 0.f};
#pragma unroll
    for (int xs = 0; xs < 4; ++xs) {
      uint2 p = *(const uint2*)((const bf16_t*)PA + ((size_t)t * 4 + xs) * 128 + 4 * l4);
      a[0] += __uint_as_float(p.x << 16); a[1] += __uint_as_float(p.x & 0xffff0000u); a[2] += __uint_as_float(p.y << 16); a[3] += __uint_as_float(p.y & 0xffff0000u);
    }
    int ee[4] = {(int)(e.x & 0xffffu), (int)(e.x >> 16), (int)(e.y & 0xffffu), (int)(e.y >> 16)};
    float gg[4] = {__uint_as_float(gt.x << 16), __uint_as_float(gt.x & 0xffff0000u), __uint_as_float(gt.y << 16), __uint_as_float(gt.y & 0xffff0000u)};
    float w[4]; float wm = 0.f;
#pragma unroll
    for (int j = 0; j < 4; ++j) {
      float2 uv = *(const float2*)(USC + 2 * ee[j]);
      float av = a[j] * uv.x;
      w[j] = gg[j] * 0.5f * av * (1.f + erff(av * 0.70710678118654752f)) * uv.y;
      wm = fmaxf(wm, fabsf(w[j]));
    }
    wm = half32_max(wm);
    float winv = wm > 0.f ? 127.f / wm : 0.f;
    unsigned q = 0; float qs = 0.f;
#pragma unroll
    for (int j = 0; j < 4; ++j) { float r = rintf(w[j] * winv); qs += r; q = __builtin_amdgcn_cvt_pk_u8_f32(r + 128.f, j, q); }
    q ^= 0x80808080u;
    if (FMT == 0) { WQ[(size_t)t * 32 + l4] = q; }
    else {
      unsigned char* wp = (unsigned char*)WQ + (size_t)t * 128 + 64 * ((l4 >> 1) & 1) + 32 * (l4 & 1) + (l4 >> 2);
      wp[0] = (unsigned char)q; wp[8] = (unsigned char)(q >> 8); wp[16] = (unsigned char)(q >> 16); wp[24] = (unsigned char)(q >> 24);
    }
    if (FMT == 2) {
      qs = half32_sum(qs);
      if (l4 == 0) *(float2*)(SW + 2 * (size_t)t) = make_float2(wm * (1.f / (127.f * 16.f)), 0.5f * wm * (1.f / 127.f) * qs);
    } else
    if (l4 == 0) SW[t] = wm * (1.f / 127.f);
  }
}
__device__ __forceinline__ void load_w16(const float* __restrict__ W, int t, int g8, float (&w)[16]) {
  const float4* wp = (const float4*)(W + (size_t)t * 128 + 16 * g8);
  float4 wa = wp[0], wb = wp[1], wc = wp[2], wd = wp[3];
  w[0] = wa.x; w[1] = wa.y; w[2] = wa.z; w[3] = wa.w; w[4] = wb.x; w[5] = wb.y; w[6] = wb.z; w[7] = wb.w;
  w[8] = wc.x; w[9] = wc.y; w[10] = wc.z; w[11] = wc.w; w[12] = wd.x; w[13] = wd.y; w[14] = wd.z; w[15] = wd.w;
}
#define V_TOKEN(tt, VV, VVN, EUSE, ELD, WUSE, WLD, SUSE, SLD) { \
    int tnn_ = min((tt) + 2 * st, nrows - 1); \
    load_e16(EXP, tnn_, g8, ELD); \
    WLD = *(const uint4*)(WQ + (size_t)tnn_ * 32 + 4 * g8); SLD = SW[tnn_]; \
    __builtin_amdgcn_sched_barrier(0); \
    _Pragma("unroll") for (int i = 0; i < 16; ++i) VVN[i] = *(const uint4*)(vbs + (((unsigned)EUSE[i] << 7) + loff)); \
    __builtin_amdgcn_sched_barrier(0); \
    int acc[16]; \
    _Pragma("unroll") for (int j = 0; j < 16; ++j) acc[j] = 0; \
    int wq[4] = {(int)WUSE.x, (int)WUSE.y, (int)WUSE.z, (int)WUSE.w}; \
    _Pragma("unroll") for (int m = 0; m < 4; ++m) { \
      unsigned r0[4] = {VV[4 * m].x, VV[4 * m].y, VV[4 * m].z, VV[4 * m].w}; \
      unsigned r1[4] = {VV[4 * m + 1].x, VV[4 * m + 1].y, VV[4 * m + 1].z, VV[4 * m + 1].w}; \
      unsigned r2[4] = {VV[4 * m + 2].x, VV[4 * m + 2].y, VV[4 * m + 2].z, VV[4 * m + 2].w}; \
      unsigned r3[4] = {VV[4 * m + 3].x, VV[4 * m + 3].y, VV[4 * m + 3].z, VV[4 * m + 3].w}; \
      _Pragma("unroll") for (int k = 0; k < 4; ++k) { \
          \
        unsigned a0 = __builtin_amdgcn_perm(r1[k], r0[k], 0x05010400u);     \
        unsigned a1 = __builtin_amdgcn_perm(r1[k], r0[k], 0x07030602u);     \
        unsigned a2 = __builtin_amdgcn_perm(r3[k], r2[k], 0x05010400u); \
        unsigned a3 = __builtin_amdgcn_perm(r3[k], r2[k], 0x07030602u); \
        unsigned t0 = __builtin_amdgcn_perm(a2, a0, 0x05040100u);           \
        unsigned t1 = __builtin_amdgcn_perm(a2, a0, 0x07060302u); \
        unsigned t2 = __builtin_amdgcn_perm(a3, a1, 0x05040100u); \
        unsigned t3 = __builtin_amdgcn_perm(a3, a1, 0x07060302u); \
        acc[4 * k + 0] = __builtin_amdgcn_sdot4((int)t0, wq[m], acc[4 * k + 0], false); \
        acc[4 * k + 1] = __builtin_amdgcn_sdot4((int)t1, wq[m], acc[4 * k + 1], false); \
        acc[4 * k + 2] = __builtin_amdgcn_sdot4((int)t2, wq[m], acc[4 * k + 2], false); \
        acc[4 * k + 3] = __builtin_amdgcn_sdot4((int)t3, wq[m], acc[4 * k + 3], false); } } \
    float of[16]; \
    _Pragma("unroll") for (int j = 0; j < 16; ++j) { float v = (float)acc[j]; v += dpp_mov<0x128>(v); of[j] = xrow16_sum(v) * SUSE; } \
    if (g8 == 0) { \
      uint4* fp = (uint4*)(F + (size_t)(tt) * D + 128 * x + 16 * j8); \
      fp[0] = make_uint4(pack2bf(of[0], of[1]), pack2bf(of[2], of[3]), pack2bf(of[4], of[5]), pack2bf(of[6], of[7])); \
      fp[1] = make_uint4(pack2bf(of[8], of[9]), pack2bf(of[10], of[11]), pack2bf(of[12], of[13]), pack2bf(of[14], of[15])); } }
__device__ __forceinline__ void ph_peer_v(const unsigned* __restrict__ WQ, const float* __restrict__ SW, const int* __restrict__ EXP,
                                          const unsigned char* __restrict__ V8, bf16_t* __restrict__ F, int nrows) {
  int lane = threadIdx.x & 63, wave = __builtin_amdgcn_readfirstlane(threadIdx.x >> 6);
  int x = blockIdx.x & 7; int nb8 = gridDim.x >> 3;
  if ((int)(blockIdx.x >> 3) >= nb8) return;
  int j8 = lane & 7, g8 = lane >> 3;
  const int st = nb8 * 4;
  int t = (blockIdx.x >> 3) * 4 + wave;
  if (t >= nrows) return;
  const unsigned char* vbs = V8 + (size_t)x * ((size_t)16384 * 128);
  const unsigned loff = 16u * (unsigned)j8;
  int eA[16], eB[16]; uint4 wA, wB, vvA[16], vvB[16]; float sA, sB;
  {
    int e0[16]; load_e16(EXP, t, g8, e0);
#pragma unroll
    for (int i = 0; i < 16; ++i) vvA[i] = *(const uint4*)(vbs + (((unsigned)e0[i] << 7) + loff));
    wA = *(const uint4*)(WQ + (size_t)t * 32 + 4 * g8); sA = SW[t];
    int tn = min(t + st, nrows - 1);
    load_e16(EXP, tn, g8, eA);
    wB = *(const uint4*)(WQ + (size_t)tn * 32 + 4 * g8); sB = SW[tn];
  }
#pragma unroll 1
  for (; t < nrows; t += 2 * st) {
    uint4 wC; float sC;
    V_TOKEN(t, vvA, vvB, eA, eB, wA, wC, sA, sC)
    if (t + st < nrows) {
      V_TOKEN(t + st, vvB, vvA, eB, eA, wB, wA, sB, sA)
    }
    wB = wA; sB = sA; wA = wC; sA = sC;
  }
}

typedef int v4i_t __attribute__((ext_vector_type(4)));
typedef int v2i_t __attribute__((ext_vector_type(2)));
__device__ __forceinline__ v2i_t lds_tr8(const char* p) { return __builtin_amdgcn_ds_read_tr8_b64_v2i32((__attribute__((address_space(3))) v2i_t*)p); }
#define V2_DMA_HALF(E, h, buf) { _Pragma("unroll") for (int pi = 0; pi < 8; ++pi) \
    __builtin_amdgcn_global_load_lds((const unsigned*)(vbs + (((unsigned)E[8 * (h) + pi] << 7) + ((pi & 2) ? offO : offE))), \
                                     (unsigned*)((buf) + pi * 1024 + lane * 16), 16, 0, 0); }
#define V2_COMPUTE(buf, WQH) { _Pragma("unroll") for (int mt = 0; mt < 8; ++mt) { \
      v2i_t r0_ = lds_tr8((buf) + rdoff[mt]); v2i_t r1_ = lds_tr8((buf) + rdoff[mt] + 1024); \
      v4i_t a_ = {r0_.x, r0_.y, r1_.x, r1_.y}; \
      acc[mt] = __builtin_amdgcn_mfma_i32_16x16x64_i8(a_, WQH, acc[mt], 0, 0, 0); } }
__device__ __forceinline__ void ph_peer_v2(const unsigned char* WQ2, const float* SW, const int* EXP,
                                           const unsigned char* __restrict__ V8, bf16_t* F, int nrows, char* smem) {
  int lane = threadIdx.x & 63, wave = __builtin_amdgcn_readfirstlane(threadIdx.x >> 6);
  int x = blockIdx.x & 7; int nb8 = gridDim.x >> 3;
  if ((int)(blockIdx.x >> 3) >= nb8) return;
  const int q8 = lane >> 3, c8 = lane & 7, n16 = lane & 15, g = lane >> 4;
  const int st = nb8 * 4;
  int t = (blockIdx.x >> 3) * 4 + wave;
  if (t >= nrows) return;
  const unsigned char* vbs = V8 + (size_t)x * ((size_t)16384 * 128);
  char* buf0 = smem + wave * 16384; char* buf1 = buf0 + 8192;
  const unsigned offE = 16u * (unsigned)(c8 ^ (q8 >> 1)), offO = offE ^ 64u;
  int rdoff[8];
#pragma unroll
  for (int mt = 0; mt < 8; ++mt) rdoff[mt] = 2048 * g + 128 * (n16 >> 1) + 16 * (mt ^ (n16 >> 2) ^ ((g & 1) << 2)) + 8 * (n16 & 1);
  int eC[16], eN[16];
  load_e16(EXP, t, q8, eC);
  v4i_t w0 = *(const v4i_t*)(WQ2 + (size_t)t * 128 + 16 * g), w1 = *(const v4i_t*)(WQ2 + (size_t)t * 128 + 64 + 16 * g);
  float sw = SW[t];
  V2_DMA_HALF(eC, 0, buf0)
#pragma unroll 1
  for (; t < nrows; t += st) {
    int tn = min(t + st, nrows - 1);
    asm volatile("s_waitcnt vmcnt(0)" ::: "memory");
    __builtin_amdgcn_sched_barrier(0);
    V2_DMA_HALF(eC, 1, buf1)
    load_e16(EXP, tn, q8, eN);
    v4i_t w0n = *(const v4i_t*)(WQ2 + (size_t)tn * 128 + 16 * g), w1n = *(const v4i_t*)(WQ2 + (size_t)tn * 128 + 64 + 16 * g);
    float swn = SW[tn];
    __builtin_amdgcn_sched_barrier(0);
    v4i_t acc[8];
#pragma unroll
    for (int mt = 0; mt < 8; ++mt) acc[mt] = (v4i_t){0, 0, 0, 0};
    V2_COMPUTE(buf0, w0)
    __builtin_amdgcn_sched_barrier(0);
    asm volatile("s_waitcnt vmcnt(0)" ::: "memory");
    asm volatile("" : "+v"(eN[0]), "+v"(eN[1]), "+v"(eN[2]), "+v"(eN[3]), "+v"(eN[4]), "+v"(eN[5]), "+v"(eN[6]), "+v"(eN[7]));
    V2_DMA_HALF(eN, 0, buf0)
    __builtin_amdgcn_sched_barrier(0);
    V2_COMPUTE(buf1, w1)
    v4i_t sel = acc[0];
#pragma unroll
    for (int mt = 1; mt < 8; ++mt) { bool pk = (n16 & 7) == mt; sel.x = pk ? acc[mt].x : sel.x; sel.y = pk ? acc[mt].y : sel.y; sel.z = pk ? acc[mt].z : sel.z; sel.w = pk ? acc[mt].w : sel.w; }
    if (n16 < 8)
      *(uint2*)(F + (size_t)t * D + 128 * x + 16 * n16 + 4 * g) = make_uint2(pack2bf((float)sel.x * sw, (float)sel.y * sw), pack2bf((float)sel.z * sw, (float)sel.w * sw));
    __builtin_amdgcn_sched_barrier(0);
#pragma unroll
    for (int i = 0; i < 16; ++i) eC[i] = eN[i];
    w0 = w0n; w1 = w1n; sw = swn;
  }
  asm volatile("s_waitcnt vmcnt(0)" ::: "memory");
}

#define V4_COMPUTE(buf, WQH) { _Pragma("unroll") for (int cg = 0; cg < 8; ++cg) { \
      v2i_t r0_ = lds_tr8((buf) + rdoff[cg]); v2i_t r1_ = lds_tr8((buf) + rdoff[cg] + 1024); \
      const int NM_ = (int)0xF0F0F0F0u; \
      v4i_t ah_ = {r0_.x & NM_, r0_.y & NM_, r1_.x & NM_, r1_.y & NM_}; \
      v4i_t al_ = {(r0_.x << 4) & NM_, (r0_.y << 4) & NM_, (r1_.x << 4) & NM_, (r1_.y << 4) & NM_}; \
      accH[cg] = __builtin_amdgcn_mfma_i32_16x16x64_i8(ah_, WQH, accH[cg], 0, 0, 0); \
      accL[cg] = __builtin_amdgcn_mfma_i32_16x16x64_i8(al_, WQH, accL[cg], 0, 0, 0); } }
__device__ __forceinline__ void ph_peer_v4(const unsigned char* WQ2, const float* SW2, const int* EXP,
                                           const unsigned char* __restrict__ V4, bf16_t* F, int nrows, char* smem) {
  int lane = threadIdx.x & 63, wave = __builtin_amdgcn_readfirstlane(threadIdx.x >> 6);
  int x = (blockIdx.x & 7) >> 1; int nb8 = gridDim.x >> 3;
  if ((int)(blockIdx.x >> 3) >= nb8) return;
  const int q8 = lane >> 3, c8 = lane & 7, n16 = lane & 15, g = lane >> 4;
  const int st = nb8 * 8;
  int t = ((blockIdx.x >> 3) * 2 + (blockIdx.x & 1)) * 4 + wave;
  if (t >= nrows) return;
  const unsigned char* vbs = V4 + (size_t)x * ((size_t)16384 * 128);
  char* buf0 = smem + wave * 16384; char* buf1 = buf0 + 8192;
  const unsigned offE = 16u * (unsigned)(c8 ^ (q8 >> 1)), offO = offE ^ 64u;
  int rdoff[8];
#pragma unroll
  for (int mt = 0; mt < 8; ++mt) rdoff[mt] = 2048 * g + 128 * (n16 >> 1) + 16 * (mt ^ (n16 >> 2) ^ ((g & 1) << 2)) + 8 * (n16 & 1);
  int eC[16], eN[16];
  load_e16(EXP, t, q8, eC);
  v4i_t w0 = *(const v4i_t*)(WQ2 + (size_t)t * 128 + 16 * g), w1 = *(const v4i_t*)(WQ2 + (size_t)t * 128 + 64 + 16 * g);
  float2 sw = *(const float2*)(SW2 + 2 * (size_t)t);
  V2_DMA_HALF(eC, 0, buf0)
#pragma unroll 1
  for (; t < nrows; t += st) {
    int tn = min(t + st, nrows - 1);
    asm volatile("s_waitcnt vmcnt(0)" ::: "memory");
    __builtin_amdgcn_sched_barrier(0);
    V2_DMA_HALF(eC, 1, buf1)
    const uint4* ep_ = (const uint4*)((const unsigned short*)EXP + (size_t)tn * 128 + 16 * q8);
    uint4 rA = ep_[0], rB = ep_[1];
    v4i_t w0n = *(const v4i_t*)(WQ2 + (size_t)tn * 128 + 16 * g), w1n = *(const v4i_t*)(WQ2 + (size_t)tn * 128 + 64 + 16 * g);
    float2 swn = *(const float2*)(SW2 + 2 * (size_t)tn);
    __builtin_amdgcn_sched_barrier(0);
    v4i_t accH[8], accL[8];
#pragma unroll
    for (int cg = 0; cg < 8; ++cg) { accH[cg] = (v4i_t){0, 0, 0, 0}; accL[cg] = (v4i_t){0, 0, 0, 0}; }
    V4_COMPUTE(buf0, w0)
    __builtin_amdgcn_sched_barrier(0);
    asm volatile("s_waitcnt vmcnt(0)" ::: "memory");
    asm volatile("" : "+v"(rA.x), "+v"(rA.y), "+v"(rA.z), "+v"(rA.w), "+v"(rB.x), "+v"(rB.y), "+v"(rB.z), "+v"(rB.w));
    { unsigned w_[8] = {rA.x, rA.y, rA.z, rA.w, rB.x, rB.y, rB.z, rB.w};
#pragma unroll
      for (int i = 0; i < 8; ++i) { eN[2 * i] = (int)(w_[i] & 0xffffu); eN[2 * i + 1] = (int)(w_[i] >> 16); } }
    V2_DMA_HALF(eN, 0, buf0)
    __builtin_amdgcn_sched_barrier(0);
    V4_COMPUTE(buf1, w1)
    v4i_t sh = accH[0], sl = accL[0];
#pragma unroll
    for (int cg = 1; cg < 8; ++cg) { bool pk = (n16 & 7) == cg;
      sh.x = pk ? accH[cg].x : sh.x; sh.y = pk ? accH[cg].y : sh.y; sh.z = pk ? accH[cg].z : sh.z; sh.w = pk ? accH[cg].w : sh.w;
      sl.x = pk ? accL[cg].x : sl.x; sl.y = pk ? accL[cg].y : sl.y; sl.z = pk ? accL[cg].z : sl.z; sl.w = pk ? accL[cg].w : sl.w; }
    if (n16 < 8)
      *(uint4*)(F + (size_t)t * D + 256 * x + 32 * n16 + 8 * g) =
          make_uint4(pack2bf(fmaf((float)sh.x, sw.x, sw.y), fmaf((float)sh.y, sw.x, sw.y)), pack2bf(fmaf((float)sh.z, sw.x, sw.y), fmaf((float)sh.w, sw.x, sw.y)),
                     pack2bf(fmaf((float)sl.x, sw.x, sw.y), fmaf((float)sl.y, sw.x, sw.y)), pack2bf(fmaf((float)sl.z, sw.x, sw.y), fmaf((float)sl.w, sw.x, sw.y)));
    __builtin_amdgcn_sched_barrier(0);
#pragma unroll
    for (int i = 0; i < 16; ++i) eC[i] = eN[i];
    w0 = w0n; w1 = w1n; sw = swn;
  }
  asm volatile("s_waitcnt vmcnt(0)" ::: "memory");
}

#define XB_TMO      128
#define XB_XCNT(j)  (256  + 64 * (j))
#define XB_XSUB(j)  (1280 + 64 * (j))
#define XB_XGEN(j)  (2304 + 64 * (j))
#define XB_TOP      3328
#define XB_TOPGEN   3392
#define XCD_BAR_WORDS 3456
#define XB_SPIN_CAP (1u << 22)
#define LAS __attribute__((address_space(3)))
__device__ __forceinline__ unsigned xb_ld(unsigned* p)              { return __hip_atomic_load(p, __ATOMIC_RELAXED, __HIP_MEMORY_SCOPE_AGENT); }
__device__ __forceinline__ unsigned xb_add(unsigned* p, unsigned v) { return __hip_atomic_fetch_add(p, v, __ATOMIC_RELAXED, __HIP_MEMORY_SCOPE_AGENT); }
__device__ __forceinline__ unsigned xb_xcc_id() { return (unsigned)__builtin_amdgcn_s_getreg((3 << 11) | 20) & 0xFu; }
#define XB_SPIN(cond, bar) do { unsigned _sp = 0; while (cond) { __builtin_amdgcn_s_sleep(1); \
    if ((++_sp & 255u) == 0u) { if (xb_ld(&(bar)[XB_TMO])) break; if (_sp > XB_SPIN_CAP) { atomicAdd(&(bar)[XB_TMO], 1u); break; } } } } while (0)
struct XcdBarrier { unsigned* bar; unsigned x; volatile LAS unsigned* st; };
__device__ __forceinline__ XcdBarrier xcd_barrier_post(unsigned* bar, volatile LAS unsigned* st) {
  XcdBarrier b; b.bar = bar; b.x = xb_xcc_id(); b.st = st;
  if (threadIdx.x == 0) (void)xb_add(&bar[XB_XCNT(b.x)], 1u);
  return b;
}
__device__ __forceinline__ void xcd_barrier_complete(unsigned* bar, unsigned x, unsigned& nloc, unsigned& nx) {
  const unsigned G = gridDim.x * gridDim.y * gridDim.z;
  unsigned sum, cnt, mine, sp = 0u;
  for (;;) {
    sum = 0u; cnt = 0u; mine = 0u;
#pragma unroll
    for (unsigned j = 0; j < 16; ++j) { const unsigned c = xb_ld(&bar[XB_XCNT(j)]); sum += c; cnt += (c > 0u) ? 1u : 0u; mine = (j == x) ? c : mine; }
    if (sum == G) break;
    __builtin_amdgcn_s_sleep(1);
    if ((++sp & 255u) == 0u) { if (xb_ld(&bar[XB_TMO])) break; if (sp > XB_SPIN_CAP) { atomicAdd(&bar[XB_TMO], 1u); break; } }
  }
  nloc = mine > 0u ? mine : 1u; nx = cnt > 0u ? cnt : 1u;
}
__device__ __forceinline__ void xcd_barrier(const XcdBarrier& b) {
  asm volatile("s_waitcnt vmcnt(0)" ::: "memory");
  __syncthreads();
  if (threadIdx.x == 0) {
    unsigned* bar = b.bar;
    __builtin_amdgcn_s_waitcnt(0);
    unsigned nloc = b.st[0], nx = b.st[1];
    if (nloc == 0u) { xcd_barrier_complete(bar, b.x, nloc, nx); b.st[0] = nloc; b.st[1] = nx; }
    const unsigned old = xb_add(&bar[XB_XSUB(b.x)], 1u);
    const unsigned gen = old / nloc;
    if (old + 1u == (gen + 1u) * nloc) {
      __builtin_amdgcn_fence(__ATOMIC_RELEASE, "agent");
      asm volatile("s_waitcnt vmcnt(0)" ::: "memory");
      const unsigned og = xb_add(&bar[XB_TOP], 1u);
      const unsigned tg = og / nx;
      if (og + 1u == (tg + 1u) * nx) xb_add(&bar[XB_TOPGEN], 1u);
      else XB_SPIN(xb_ld(&bar[XB_TOPGEN]) == tg, bar);
      __builtin_amdgcn_fence(__ATOMIC_ACQUIRE, "agent");
      xb_add(&bar[XB_XGEN(b.x)], 1u);
      asm volatile("s_waitcnt vmcnt(0)" ::: "memory");
    } else {
      XB_SPIN(xb_ld(&bar[XB_XGEN(b.x)]) == gen, bar);
      __builtin_amdgcn_fence(__ATOMIC_ACQUIRE, "agent");
      asm volatile("s_waitcnt vmcnt(0)" ::: "memory");
    }
  }
  __syncthreads();
}

constexpr int SMEM_BYTES = 65536;
#ifndef PHMASK
#define PHMASK 0xFFFFFFFFFFFFFFFFull
#endif
#ifndef PHDUP
#define PHDUP 0ull
#endif
#define PH(n, ...) if constexpr ((((unsigned long long)(PHMASK)) >> (n)) & 1ull) { __VA_ARGS__; if constexpr ((((unsigned long long)(PHDUP)) >> (n)) & 1ull) { xcd_barrier(xbar); __VA_ARGS__; } }

__global__ __launch_bounds__(256, 2) void mega(Params p) {
  __shared__ __attribute__((aligned(16))) char smem_raw[SMEM_BYTES + 16];
  if (threadIdx.x == 0) *(uint4*)(smem_raw + SMEM_BYTES) = make_uint4(0u, 0u, 0u, 0u);
  __syncthreads();
  XcdBarrier xbar = xcd_barrier_post((unsigned*)((char*)p.ws + OFF_BAR), (volatile LAS unsigned*)(smem_raw + SMEM_BYTES));
  float* smem = (float*)smem_raw;
  const float* x = p.in[0]; const float* c = p.in[1]; const float* ctx = p.in[2]; const float* c_ctx = p.in[3];
  const float* ada_w = p.in[4]; const float* ada_b = p.in[5]; const float* ln_g = p.in[6]; const float* ln_b = p.in[7];
  const float* even_w_in = p.in[8]; const float* even_w_out = p.in[9]; const float* rpb = p.in[10];
  const float* odd_w_in = p.in[11]; const float* odd_w_out = p.in[12]; const float* sink = p.in[13];
  const float* peer_wq = p.in[14]; const float* peer_sk = p.in[15]; const float* peer_u = p.in[16]; const float* peer_v = p.in[17];
  char* ws = (char*)p.ws;
  float* TAB = (float*)(ws + OFF_TAB); float* Mm = (float*)(ws + OFF_M);
  bf16_t* WIN0 = (bf16_t*)(ws + OFF_WIN0); bf16_t* WOUT0 = (bf16_t*)(ws + OFF_WOUT0);
  bf16_t* WIN1 = (bf16_t*)(ws + OFF_WIN1); bf16_t* WOUT1 = (bf16_t*)(ws + OFF_WOUT1);
  bf16_t* WQ = (bf16_t*)(ws + OFF_WQ); bf16_t* SKB = (bf16_t*)(ws + OFF_SK);
  unsigned char* U8 = (unsigned char*)(ws + OFF_UB); unsigned char* V8 = (unsigned char*)(ws + OFF_VB);
  float* USC = (float*)(ws + OFF_USC); float* VSC = USC + 2 * 16384;
  bf16_t* AB = (bf16_t*)(ws + OFF_AB);
  bf16_t* FD1 = (bf16_t*)(ws + OFF_FT); bf16_t* FD3 = FD1 + 256 * 128; bf16_t* FDC = FD3 + 128 * 128;
  bf16_t* A1 = (bf16_t*)(ws + OFF_A1); bf16_t* VT0 = (bf16_t*)(ws + OFF_VT0); bf16_t* FQKV = (bf16_t*)(ws + OFF_BF);
  float* BF_ = (float*)(ws + OFF_BF); float* BY = (float*)(ws + OFF_BY);
  float* X1 = (float*)(ws + OFF_X1); float* X2 = (float*)(ws + OFF_X2);
  float* RT = TAB + 16384;
  bf16_t* Q1 = (bf16_t*)(ws + OFF_BF); bf16_t* K1 = Q1 + (size_t)T * 1024; bf16_t* VT1 = K1 + (size_t)R * 256;
  bf16_t* YB = (bf16_t*)(ws + OFF_BY + (size_t)2 * R * 128 * 4);
  float* PAB = (float*)(ws + OFF_BF); bf16_t* FB = (bf16_t*)(ws + OFF_BF + (size_t)R * 8 * 128 * 4);
  float* WB = (float*)(ws + OFF_BF + (size_t)R * 8 * 128 * 4 + (size_t)R * 1024 * 2); float* CORRB = WB + (size_t)R * 128;
  unsigned char* HQB = (unsigned char*)(ws + OFF_BF + (size_t)R * 8 * 128 * 4 + (size_t)R * 1024 * 2 + (size_t)R * 130 * 4);
  float* HSB = (float*)(HQB + (size_t)R * 1024);
  int* EXPB = (int*)(ws + OFF_BY); float* GATEB = (float*)(ws + OFF_BY + (size_t)R * 128 * 4);
  float* out = p.out;
  unsigned* QC = (unsigned*)(ws + OFF_BAR) + 32;
#define QFILL(site, layer, lo, hi) quant_fill(QC + (site), (layer), (lo), (hi), peer_u, peer_v, U8, V8, USC, VSC, (unsigned*)(smem_raw + 65024))

  PH(0, ph_tables(TAB); ph_rope_table(RT))
  PH(1, ph_fft_tables(FD1, FD3, FDC))
  const bool ada_late = ((blockIdx.x >> 8) & 1) != 0;
  if (!ada_late) {
  PH(2, ph_ada2(c, c_ctx, ada_w, ada_b, Mm, smem))
  }
  PH(3, ph_transpose_w(even_w_in, 1024, 2048, WIN0, smem))
  PH(4, ph_transpose_w(even_w_out, 1024, 1024, WOUT0, smem))
  PH(5, ph_transpose_w(odd_w_in, 1024, 1536, WIN1, smem))
  PH(6, ph_transpose_w(odd_w_out, 1024, 1024, WOUT1, smem))
  PH(7, ph_transpose_w(peer_wq, 1024, 2048, WQ, smem))
  PH(8, ph_transpose_w(peer_wq + (size_t)1024 * 2048, 1024, 2048, WQ + (size_t)2048 * 1024, smem))
  PH(11, ph_convert_sk(peer_sk, SKB, (size_t)2 * 8 * 2 * 128 * 128 / 8))
  if (ada_late) {
  PH(2, ph_ada2(c, c_ctx, ada_w, ada_b, Mm, smem))
  }
  xcd_barrier(xbar);
  PH(12, ph_modulate(x, ctx, Mm, 0, 0, 1, AB, R, smem))
  xcd_barrier(xbar);
  PH(13, ph_gemm_bf16(AB, 1024, WIN0, 1024, R, 2048, 1024, EpiQKV0{FQKV, VT0}, smem_raw))
  PH(9, QFILL(0, 0, 0u, 330u))
  xcd_barrier(xbar);
#ifdef GPROBE
#if GPROBE == 5
  ph_gemm_probe5(AB, 1024, WIN0, 1024, R, 2048, 1024, X2, smem_raw);
#else
  ph_gemm_probe<GPROBE>(AB, 1024, WIN0, 1024, R, 2048, 1024, X2, smem_raw);
#endif
  xcd_barrier(xbar);
#endif
#ifndef SWAPBIT
#define SWAPBIT 8
#endif
  const bool fft_late = ((blockIdx.x >> SWAPBIT) & 1) != 0;
  if (!fft_late) {
  PH(14, { GRID_LOOP(u, NB * 64 * 8) fft1_unit(u, FQKV, FD1, TAB, A1, smem_raw); })
  }
  PH(15, { int lane = threadIdx.x & 63, wave = __builtin_amdgcn_readfirstlane(threadIdx.x >> 6);
           __syncthreads();
           for (int i = threadIdx.x; i < 8 * 15 * 32; i += 256) smem[i] = (i & 31) < 31 ? rpb[(i >> 5) * 31 + (i & 31)] * 1.4426950408889634f : -1e30f;
           for (int i = threadIdx.x; i < 16 * 64; i += 256) {
             int ln = i & 63, tt = (i >> 6) & 1, hb = (i >> 7) & 1, jb = i >> 8; int ql_ = ln & 15, g_ = ln >> 4; unsigned w = 0;
             for (int e = 0; e < 4; ++e) {
               int qc = 16 * jb + ql_; int c_lo = min(max(qc - 8, 0), 48);
               int kc = 32 * hb + 8 * g_ + 4 * tt + e;
               bool ok = (kc >= c_lo) && (kc < c_lo + 16);
               int dc = min(max(kc - qc, -15), 15) + 15;
               w |= (unsigned)(ok ? 4 * dc : 4 * 31) << (8 * e);
             }
             ((unsigned*)smem)[3840 + i] = w;
           }
           __syncthreads();
           for (int bu = blockIdx.x; bu < 512 + 64; bu += gridDim.x) {
             if (bu < 512) { int h = bu & 7, rg = (bu >> 3) & 31, bb = bu >> 8;
               na_unit(bb, h, rg * 4 + wave, FQKV, VT0, VT0 + (size_t)NB * 8 * 64 * S, smem, AB, lane); }
             else { int cu = bu - 512; int h = cu & 7, qg = (cu >> 3) & 3, bb = cu >> 5;
               attn_unit<1, 1, 2, true>(bb, h, 0, 0, qg * 4 + wave, FQKV + 512, 2048, FQKV + 1024, 2048, VT0, VT0 + (size_t)NB * 8 * 64 * S, 8, smem, nullptr, AB + 512, 1024, lane); } } })
  if (fft_late) {
  PH(14, { GRID_LOOP(u, NB * 64 * 8) fft1_unit(u, FQKV, FD1, TAB, A1, smem_raw); })
  }
  xcd_barrier(xbar);
  PH(16, { bf16x8 d3f[8], dcf[8];
           { int lane_ = threadIdx.x & 63, w_ = threadIdx.x >> 6;
             _Pragma("unroll") for (int s8 = 0; s8 < 8; ++s8) { int ko = 16 * s8 + 8 * (lane_ >> 5);
               d3f[s8] = *(const bf16x8*)(FD3 + (32 * w_ + (lane_ & 31)) * 128 + ko); dcf[s8] = *(const bf16x8*)(FDC + (32 * (w_ & 1) + (lane_ & 31)) * 128 + ko); } }
           GRID_LOOP(u, NB * 128 * 8 + NB * 4 * 8) { if (u < NB * 128 * 8) fft3_unit(u, 0, FQKV, A1, FD3, FDC, TAB, AB, smem_raw, d3f, dcf); else fft3_unit(u - NB * 128 * 8, 1, FQKV, A1, FD3, FDC, TAB, AB, smem_raw, d3f, dcf); } })
  xcd_barrier(xbar);
  PH(17, ph_gemm_bf16(AB, 1024, WOUT0, 1024, R, 1024, 1024, EpiBf16{YB, 1024}, smem_raw))
  PH(9, QFILL(1, 0, 330u, 512u))
  PH(10, QFILL(2, 1, 0u, 100u))
  xcd_barrier(xbar);
  PH(18, (ph_post_mod<false, true>(x, ctx, YB, Mm, 0, 2, 0, 3, 4, true, ln_g + 0, ln_b + 0, X1, AB, R, HQB, HSB)))
  xcd_barrier(xbar);
  PH(21, ph_peer_select(AB, WQ, SKB, EXPB, GATEB, R, smem_raw))
  PH(10, QFILL(3, 1, 100u, 300u))
  xcd_barrier(xbar);
  PH(22, ph_peer_u(HQB, HSB, EXPB, U8, PAB, R))
  xcd_barrier(xbar);
  PH(32, ph_peer_w<2>(PAB, EXPB, GATEB, USC, VSC, (unsigned*)WB, CORRB, R))
  xcd_barrier(xbar);
  PH(33, ph_peer_v4((const unsigned char*)WB, CORRB, EXPB, V8, FB, R, smem_raw))
  xcd_barrier(xbar);
  PH(34, (ph_post_mod<true, true>(X1, (bf16_t*)X1 + (size_t)T * D, FB, Mm, 0, 5, 1, 0, 1, true, ln_g + 1024, ln_b + 1024, X2, AB, R)))
  xcd_barrier(xbar);
  PH(23, ph_gemm_bf16(AB, 1024, WIN1, 1024, R, 1536, 1024, EpiQKV1{Q1, K1, VT1, RT}, smem_raw))
  PH(10, QFILL(4, 1, 300u, 512u))
  xcd_barrier(xbar);
  PH(25, { int lane = threadIdx.x & 63, wave = __builtin_amdgcn_readfirstlane(threadIdx.x >> 6);
           (void)lane; (void)wave;
           for (int bu = blockIdx.x; bu < 1024; bu += gridDim.x) { int kvh = bu & 3, bb = (bu >> 2) & 1, qg = bu >> 3;
             gqa_block(bb, kvh, qg, Q1, K1, VT1, VT1 + (size_t)NB * 4 * 64 * S, sink, AB, smem_raw); } })
  xcd_barrier(xbar);
  PH(26, ph_gemm_bf16(AB, 1024, WOUT1, 1024, T, 1024, 1024, EpiBf16{YB, 1024}, smem_raw))
  xcd_barrier(xbar);
  PH(27, (ph_post_mod<true, true>(X2, X2, YB, Mm, 1, 2, 1, 3, 4, true, ln_g + 2048, ln_b + 2048, X1, AB, T, HQB, HSB)))
  xcd_barrier(xbar);
  PH(30, ph_peer_select(AB, WQ + (size_t)2048 * 1024, SKB + (size_t)8 * 2 * 128 * 128, EXPB, GATEB, T, smem_raw))
  xcd_barrier(xbar);
  PH(31, ph_peer_u(HQB, HSB, EXPB, U8 + (size_t)16384 * 512, PAB, T))
  xcd_barrier(xbar);
  PH(35, ph_peer_w<2>(PAB, EXPB, GATEB, USC + 2 * 16384, VSC, (unsigned*)WB, CORRB, T))
  xcd_barrier(xbar);
  PH(36, ph_peer_v4((const unsigned char*)WB, CORRB, EXPB, V8 + (size_t)16384 * 512, FB, T, smem_raw))
  xcd_barrier(xbar);
  PH(37, (ph_post_mod<true, false>(X1, X1, FB, Mm, 1, 5, 1, 0, 1, false, ln_g + 3072, ln_b + 3072, out, AB, T)))
}

}

extern "C" void kernel_launch(void* const* d_in, const int* in_sizes, int n_in, void* d_out, int out_size, void* d_ws,
                              size_t ws_size, hipStream_t stream) {
  static int grid_blocks = 0;
  if (!grid_blocks) {
    int dev = 0, cus = 0, per_cu = 0;
    hipGetDevice(&dev);
    hipDeviceGetAttribute(&cus, hipDeviceAttributeMultiprocessorCount, dev);
    hipOccupancyMaxActiveBlocksPerMultiprocessor(&per_cu, (const void*)mega, 256, 0);
    if (per_cu > 2) per_cu = 2;
    if (per_cu < 1) per_cu = 1;
    grid_blocks = cus * per_cu;
  }
  Params p{};
  for (int i = 0; i < 18; ++i) p.in[i] = (const float*)d_in[i];
  p.out = (float*)d_out;
  p.ws = (float*)d_ws;
  (void)hipMemsetAsync((char*)d_ws + OFF_BAR, 0, XCD_BAR_WORDS_C * 4, stream);
  void* args[] = {&p};
  hipError_t e = hipLaunchCooperativeKernel((const void*)mega, dim3(grid_blocks), dim3(256), args, 0, stream);
  if (e != hipSuccess) fprintf(stderr, "cooperative launch failed: %s (grid %d)\n", hipGetErrorString(e), grid_blocks);
}
```
